# Optimizing an MI355X kernel written in HIP

```python
import math
import jax, jax.numpy as jnp
from jax import lax
import numpy as np

D_MODEL = 1024
BATCH = 16
SEQ = 2048
DEPTH = 1

CHUNK = 64
Q_BLOCK = 128

A_HEADS = 4
A_QK_DIM = 64
A_V_DIM = 128
B_HEADS = 8
B_LAT = 128
B_V_DIM = 64
IDX_HEADS = 4
IDX_DIM = 64
DSA_TOPK_MAX = 256

A_Q = A_HEADS * 2 * A_QK_DIM
A_K = A_HEADS * 2 * A_QK_DIM
A_V = A_HEADS * A_V_DIM
B_Q = B_HEADS * B_LAT
B_KV = B_LAT
I_Q = IDX_HEADS * IDX_DIM
I_K = IDX_DIM
I_W = IDX_HEADS
IN_SIZES = (A_Q, A_K, A_V, B_Q, B_KV, I_Q, I_K, I_W)
IN_COLS = sum(IN_SIZES)
MIX_WIDTH = A_HEADS * A_V_DIM + B_HEADS * B_V_DIM

PEER_HEADS = 8
PEER_NKEYS = 128
PEER_NEXPERTS = PEER_NKEYS * PEER_NKEYS
PEER_QDIM = 128
PEER_TOPK = 16
PEER_TOKEN_BLOCK = 128

EPS = 1e-6
NEG = -1e30

kernel_name = "hymba_diffattn_dsa_peer_adaln_block"


def rms_norm(x, g):
    xf = x.astype(jnp.float32)
    y = xf * lax.rsqrt(jnp.mean(xf * xf, axis=-1, keepdims=True) + EPS)
    return (y * g.astype(jnp.float32)).astype(x.dtype)


def modulate(h, shift, scale):
    return h * (1.0 + scale[:, None, :]) + shift[:, None, :]


def alibi_slopes(n):
    return jnp.asarray([2.0 ** (-8.0 * (i + 1) / n) for i in range(n)], dtype=jnp.float32)


def chunk_end(pos):
    return (pos // CHUNK + 1) * CHUNK


def to_blocks(a):
    b, s = a.shape[0], a.shape[1]
    return jnp.moveaxis(a.reshape((b, s // Q_BLOCK, Q_BLOCK) + a.shape[2:]), 1, 0)


def from_blocks(a):
    a = jnp.moveaxis(a, 0, 1)
    return a.reshape((a.shape[0], a.shape[1] * a.shape[2]) + a.shape[3:])


def diff_attention(q, k, v, lam, slopes):
    s_len = q.shape[1]
    kpos = jnp.arange(s_len)
    scale = A_QK_DIM ** -0.5
    kf = k.astype(jnp.float32)
    vf = v.astype(jnp.float32)

    def block(args):
        qb, i = args
        qpos = i * Q_BLOCK + jnp.arange(Q_BLOCK)
        s = jnp.einsum('bqhmd,bshmd->bhmqs', qb.astype(jnp.float32), kf) * scale
        dist = jnp.abs(qpos[:, None] - kpos[None, :]).astype(jnp.float32)
        bias = -slopes[:, None, None, None] * dist
        allowed = kpos[None, :] < chunk_end(qpos)[:, None]
        s = jnp.where(allowed, s + bias, NEG)
        p = jax.nn.softmax(s, axis=-1)
        a = p[:, :, 0] - lam * p[:, :, 1]
        return jnp.einsum('bhqs,bshd->bqhd', a, vf)

    o = lax.map(block, (to_blocks(q), jnp.arange(s_len // Q_BLOCK)))
    return from_blocks(o)


def dsa_attention(q, kv, q_idx, k_idx, w_idx, w_uv, slopes):
    s_len = q.shape[1]
    topk = min(DSA_TOPK_MAX, s_len // 4)
    kpos = jnp.arange(s_len)
    kvf = kv.astype(jnp.float32)
    kif = k_idx.astype(jnp.float32)
    wuv = w_uv.astype(jnp.float32)
    idx_scale = (IDX_DIM ** -0.5) * (IDX_HEADS ** -0.5)
    att_scale = B_LAT ** -0.5

    def block(args):
        qb, qib, wib, i = args
        qpos = i * Q_BLOCK + jnp.arange(Q_BLOCK)
        cend = chunk_end(qpos)
        allowed = kpos[None, :] < cend[:, None]
        rel = jax.nn.relu(jnp.einsum('bqhd,bsd->bqhs', qib.astype(jnp.float32), kif))
        score = jnp.einsum('bqhs,bqh->bqs', rel, wib.astype(jnp.float32)) * idx_scale
        score = jnp.where(allowed, score, NEG)
        _, sel = lax.top_k(score, topk)
        valid = sel < cend[None, :, None]
        kv_sel = jax.vmap(lambda a, ix: a[ix])(kvf, sel)
        s = jnp.einsum('bqhl,bqkl->bhqk', qb.astype(jnp.float32), kv_sel) * att_scale
        dist = jnp.abs(qpos[None, :, None] - sel).astype(jnp.float32)
        s = s - slopes[None, :, None, None] * dist[:, None]
        s = jnp.where(valid[:, None], s, NEG)
        p = jax.nn.softmax(s, axis=-1)
        o_lat = jnp.einsum('bhqk,bqkl->bqhl', p, kv_sel)
        return jnp.einsum('bqhl,hld->bqhd', o_lat, wuv)

    o = lax.map(block, (to_blocks(q), to_blocks(q_idx), to_blocks(w_idx),
                        jnp.arange(s_len // Q_BLOCK)))
    return from_blocks(o)


def peer_ffn(h, w_q, sub_keys, u_tab, v_tab):
    b, s_len, d = h.shape
    t = b * s_len
    ht = h.reshape(t, d)
    q = (ht @ w_q).astype(jnp.float32).reshape(t, PEER_HEADS, 2, PEER_QDIM // 2)
    sub = jnp.einsum('thcd,cnd->thcn', q, sub_keys.astype(jnp.float32))
    sv, si = lax.top_k(sub, PEER_TOPK)
    cand = (sv[:, :, 0, :, None] + sv[:, :, 1, None, :]).reshape(t, PEER_HEADS, PEER_TOPK * PEER_TOPK)
    top_s, top_c = lax.top_k(cand, PEER_TOPK)
    i1 = jnp.take_along_axis(si[:, :, 0], top_c // PEER_TOPK, axis=-1)
    i2 = jnp.take_along_axis(si[:, :, 1], top_c % PEER_TOPK, axis=-1)
    experts = i1 * PEER_NKEYS + i2
    g = jax.nn.softmax(top_s, axis=-1)
    nblk = t // PEER_TOKEN_BLOCK

    def block(args):
        xb, eb, gb = args
        u = u_tab[eb].astype(jnp.float32)
        a = jnp.einsum('thkd,td->thk', u, xb.astype(jnp.float32))
        a = jax.nn.gelu(a, approximate=False) * gb
        return jnp.einsum('thk,thkd->td', a, v_tab[eb].astype(jnp.float32))

    out = lax.map(block, (ht.reshape(nblk, PEER_TOKEN_BLOCK, d),
                          experts.reshape(nblk, PEER_TOKEN_BLOCK, PEER_HEADS, PEER_TOPK),
                          g.reshape(nblk, PEER_TOKEN_BLOCK, PEER_HEADS, PEER_TOPK)))
    return out.reshape(b, s_len, d).astype(h.dtype)


def setup_inputs(seed: int = 0) -> dict:
    key = jax.random.key(seed)
    ks = jax.random.split(key, 20)
    L, D = DEPTH, D_MODEL

    def nrm(k, shape, scale):
        return jax.random.normal(k, shape, jnp.float32) * scale

    return {
        "x": nrm(ks[0], (BATCH, SEQ, D), 1.0),
        "c": nrm(ks[1], (BATCH, D), 1.0),
        "ada_w": nrm(ks[2], (L, D, 6 * D), 0.5 * D ** -0.5),
        "ada_b": nrm(ks[3], (L, 6 * D), 0.01),
        "norm1_g": 1.0 + nrm(ks[4], (L, D), 0.02),
        "norm2_g": 1.0 + nrm(ks[5], (L, D), 0.02),
        "w_in": nrm(ks[6], (L, D, IN_COLS), D ** -0.5),
        "a_qk_gain": 1.0 + nrm(ks[7], (L, 2, A_QK_DIM), 0.02),
        "a_lambda": nrm(ks[8], (L, 4, A_QK_DIM), 0.1),
        "a_sub_gain": 1.0 + nrm(ks[9], (L, A_V_DIM), 0.02),
        "b_q_gain": 1.0 + nrm(ks[10], (L, B_LAT), 0.02),
        "b_kv_gain": 1.0 + nrm(ks[11], (L, B_LAT), 0.02),
        "b_w_uv": nrm(ks[12], (L, B_HEADS, B_LAT, B_V_DIM), B_LAT ** -0.5),
        "w_out": nrm(ks[13], (L, MIX_WIDTH, D), MIX_WIDTH ** -0.5),
        "peer_wq": nrm(ks[14], (L, D, PEER_HEADS * PEER_QDIM), D ** -0.5),
        "peer_subkeys": nrm(ks[15], (L, 2, PEER_NKEYS, PEER_QDIM // 2), (PEER_QDIM // 2) ** -0.5),
        "peer_u": nrm(ks[16], (L, PEER_NEXPERTS, D), D ** -0.5),
        "peer_v": nrm(ks[17], (L, PEER_NEXPERTS, D), 1.0),
    }


def reference(x, c, ada_w, ada_b, norm1_g, norm2_g, w_in, a_qk_gain, a_lambda, a_sub_gain,
              b_q_gain, b_kv_gain, b_w_uv, w_out, peer_wq, peer_subkeys, peer_u, peer_v):
    b, s_len, _ = x.shape
    slopes_a = alibi_slopes(A_HEADS)
    slopes_b = alibi_slopes(B_HEADS)
    split_at = [int(v) for v in np.cumsum(IN_SIZES)[:-1]]
    for l in range(DEPTH):
        mod = jax.nn.silu(c) @ ada_w[l] + ada_b[l]
        sh1, sc1, g1, sh2, sc2, g2 = jnp.split(mod, 6, axis=-1)

        h = modulate(rms_norm(x, norm1_g[l]), sh1, sc1)
        proj = h @ w_in[l]
        pqa, pka, pva, pqb, pkv, pqi, pki, pwi = jnp.split(proj, split_at, axis=-1)

        qa = rms_norm(pqa.reshape(b, s_len, A_HEADS, 2, A_QK_DIM), a_qk_gain[l, 0])
        ka = rms_norm(pka.reshape(b, s_len, A_HEADS, 2, A_QK_DIM), a_qk_gain[l, 1])
        va = pva.reshape(b, s_len, A_HEADS, A_V_DIM)
        lam_init = 0.8 - 0.6 * math.exp(-0.3 * l)
        lf = a_lambda[l].astype(jnp.float32)
        lam = jnp.exp(jnp.sum(lf[0] * lf[1])) - jnp.exp(jnp.sum(lf[2] * lf[3])) + lam_init
        oa = diff_attention(qa, ka, va, lam, slopes_a)
        oa = rms_norm(oa, a_sub_gain[l]) * (1.0 - lam_init)

        qb = rms_norm(pqb.reshape(b, s_len, B_HEADS, B_LAT), b_q_gain[l])
        kvb = rms_norm(pkv, b_kv_gain[l])
        qi = pqi.reshape(b, s_len, IDX_HEADS, IDX_DIM)
        ob = dsa_attention(qb, kvb, qi, pki, pwi, b_w_uv[l], slopes_b)

        mix = jnp.concatenate([oa.reshape(b, s_len, -1), ob.reshape(b, s_len, -1)], axis=-1)
        x = x + g1[:, None, :] * (mix.astype(x.dtype) @ w_out[l])

        h2 = modulate(rms_norm(x, norm2_g[l]), sh2, sc2)
        x = x + g2[:, None, :] * peer_ffn(h2, peer_wq[l], peer_subkeys[l], peer_u[l], peer_v[l])
    return x
```

```cpp
#include <hip/hip_runtime.h>
#include <hip/hip_cooperative_groups.h>
#include <cstdio>
#include <cstdint>
#include <cmath>
namespace pg8 {
#define PG8_LAS __attribute__((address_space(3)))
typedef unsigned short bf16_t;
typedef short bf16x8 __attribute__((ext_vector_type(8)));
typedef float f32x4 __attribute__((ext_vector_type(4)));
typedef unsigned u32x4 __attribute__((ext_vector_type(4)));
constexpr int BM = 256, BK = 64, HALF = 128, HTB = HALF * BK * 2  , STAGE_BYTES = 8 * HTB, NXCD = 8, WGM = 8;

__host__ __device__ __forceinline__ int lds_byte(int r, int c) { const int st = (r >> 4) * 2 + (c >> 5), rr = r & 15, cc = c & 31, ob = rr * 64 + cc * 2; return st * 1024 + (ob ^ (((ob >> 9) & 1) << 5)); }
__host__ __device__ __forceinline__ void stage_rc(int b, int& R, int& C) { const int st = b / 1024, sb = b % 1024, swz = sb ^ (((sb >> 9) & 1) << 5); R = (st >> 1) * 16 + swz / 64; C = (st & 1) * 32 + (swz % 64) / 2; }
__host__ __device__ __forceinline__ int perm32(int rho) { const int n = rho >> 4, i = rho & 15; return 8 * (i >> 2) + 4 * n + (i & 3); }

struct Unit { int pm, pn; };
struct Gemm { const bf16_t* A; const bf16_t* Bt; int M, N, K; };

struct StaticOrder {
    int nM, nN, nwg, G, c;
    __host__ __device__ void init(int M, int N, int G_, int c_) { nM = M / BM; nN = N / BM; nwg = nM * nN; G = G_; c = c_; }
    __host__ __device__ bool next(int i, Unit& u) const {
        const long L = (long)i * G + c; if (L >= nwg) return false;
        int wgid = (int)L; { const int q = nwg / NXCD, r = nwg % NXCD, xcd = wgid % NXCD, off = wgid / NXCD; wgid = (xcd < r ? xcd * (q + 1) : r * (q + 1) + (xcd - r) * q) + off; }
        const int nig = WGM * nN, gid = wgid / nig, fm = gid * WGM, gsz = (nM - fm) < WGM ? (nM - fm) : WGM;
        u.pm = fm + ((wgid % nig) % gsz); u.pn = (wgid % nig) / gsz; return true;
    }
    __device__ __forceinline__ void a_ready(const Unit&) const {}
    __device__ __forceinline__ void done(const Unit&) const {}
};

__device__ __forceinline__ unsigned cvt_pk_bf16(float lo, float hi) { unsigned r; asm volatile("v_cvt_pk_bf16_f32 %0, %1, %2" : "=v"(r) : "v"(lo), "v"(hi)); return r; }
typedef float f32x2 __attribute__((ext_vector_type(2)));
__device__ __forceinline__ f32x2 gelu_pk(f32x2 v) {
    const f32x2 av = __builtin_elementwise_abs(v), d = av * 0.2316418882f + 1.0f;
    f32x2 t; t.x = __builtin_amdgcn_rcpf(d.x); t.y = __builtin_amdgcn_rcpf(d.y);
    f32x2 q = t * 0.5307027145f + (-0.7265760135f); q = q * t + 0.7107068705f; q = q * t + (-0.142248368f); q = q * t + 0.127414796f; q = q * t;
    const f32x2 s = (v * v) * (-0.72134752044f);
    f32x2 e; e.x = __builtin_amdgcn_exp2f(s.x); e.y = __builtin_amdgcn_exp2f(s.y);
    const f32x2 m = v * (q * e), r = v - m;
    f32x2 o; o.x = v.x < 0.f ? m.x : r.x; o.y = v.y < 0.f ? m.y : r.y; return o;
}

template <int ACT  > struct EpiBf16 {
    static constexpr bool PERM = true, AFTER_DRAIN = false; static_assert(ACT == 0 || ACT == 1, "EpiBf16: ACT is 0 (none) or 1 (gelu_pk)");
    bf16_t* O; int ldc; const float* bias; int split_cols; size_t split_stride; float scale0;
    __device__ __forceinline__ void operator()(const f32x4 (&acc)[2][2][4][2], const Unit& u, int wr, int wc, int fr, int fq) const {
        const int row0 = u.pm * BM + wr * 64 + fr; int colt = u.pn * BM; bf16_t* base = O;
        float sc = 1.f; if (split_cols) { const int t = colt / split_cols; base += (size_t)t * split_stride; colt -= t * split_cols; if (t == 0) sc = scale0; }
        const int col0 = colt + wc * 32 + 8 * fq, bcol0 = u.pn * BM + wc * 32 + 8 * fq;
        f32x4 bv[2][2];
#pragma unroll
        for (int bj = 0; bj < 2; ++bj)
#pragma unroll
            for (int n = 0; n < 2; ++n) bv[bj][n] = bias ? *(const f32x4*)(bias + bcol0 + bj * HALF + 4 * n) : (f32x4){0.f, 0.f, 0.f, 0.f};
#pragma unroll
        for (int ai = 0; ai < 2; ++ai)
#pragma unroll
            for (int m = 0; m < 4; ++m) { bf16_t* rowp = base + (size_t)(row0 + ai * HALF + m * 16) * ldc + col0;
#pragma unroll
                for (int bj = 0; bj < 2; ++bj) { f32x4 v0 = acc[ai][bj][m][0] + bv[bj][0], v1 = acc[ai][bj][m][1] + bv[bj][1];
                    if (ACT == 1) { f32x2 a = gelu_pk((f32x2){v0[0], v0[1]}), b = gelu_pk((f32x2){v0[2], v0[3]}), c = gelu_pk((f32x2){v1[0], v1[1]}), d = gelu_pk((f32x2){v1[2], v1[3]});
                        v0 = (f32x4){a.x, a.y, b.x, b.y}; v1 = (f32x4){c.x, c.y, d.x, d.y}; }
                    v0 = v0 * sc; v1 = v1 * sc; u32x4 w; w.x = cvt_pk_bf16(v0[0], v0[1]); w.y = cvt_pk_bf16(v0[2], v0[3]); w.z = cvt_pk_bf16(v1[0], v1[1]); w.w = cvt_pk_bf16(v1[2], v1[3]);
                    *(u32x4*)(rowp + bj * HALF) = w; } }
    }
};

template <class Epi, class Sched, bool ALIGN_EPI = false, bool SP2 = false>
__device__ __forceinline__ void gemm_phase(PG8_LAS unsigned char* lds, const Gemm g, const Sched& S, const Epi& E) {
    const int tid = threadIdx.x, wid = __builtin_amdgcn_readfirstlane(tid >> 6), lane = tid & 63, wr = wid >> 2, wc = wid & 3, fr = lane & 15, fq = lane >> 4;
    const int K = g.K, nt = K / BK;
    unsigned voffA[2], voffB[2];
#pragma unroll
    for (int i = 0; i < 2; ++i) { int R, C; stage_rc(tid * 16 + i * 8192, R, C); const int Rb = Epi::PERM ? ((R & ~31) + perm32(R & 31)) : R;
        voffA[i] = (unsigned)(R * K + C) * 2u; voffB[i] = (unsigned)(Rb * K + C) * 2u; }
    const size_t kstep = (size_t)(BK * 2);
    const size_t hstep = (size_t)HALF * K * 2;
    const size_t tstep = 2 * hstep;
    const unsigned ldsw = (unsigned)wid * 1024u;
    const int aoff = lds_byte(wr * 64 + fr, fq * 8), boff = lds_byte(wc * 32 + fr, fq * 8);
#define PG8_SA(b, h) (((b) * 2 + (h)) * HTB)
#define PG8_SB(b, h) ((4 + (b) * 2 + (h)) * HTB)
#define PG8_STAGE(bufoff, gbase, voff) do { _Pragma("unroll") for (int _i = 0; _i < 2; ++_i) \
        __builtin_amdgcn_global_load_lds((const unsigned*)((const char*)(gbase) + (voff)[_i]), (PG8_LAS unsigned*)(lds + (bufoff) + ldsw + _i * 8192), 16, 0, 0); } while (0)
#define PG8_LDA(dst, b, h) do { _Pragma("unroll") for (int m = 0; m < 4; ++m) _Pragma("unroll") for (int k = 0; k < 2; ++k) dst[m][k] = *(const PG8_LAS bf16x8*)(lds + PG8_SA(b, h) + aoff + m * 2048 + k * 1024); } while (0)
#define PG8_LDB(dst, b, h) do { _Pragma("unroll") for (int n = 0; n < 2; ++n) _Pragma("unroll") for (int k = 0; k < 2; ++k) dst[n][k] = *(const PG8_LAS bf16x8*)(lds + PG8_SB(b, h) + boff + n * 2048 + k * 1024); } while (0)
#define PG8_MMA(ai, bj, At, Bt) do { __builtin_amdgcn_s_setprio(1); _Pragma("unroll") for (int m = 0; m < 4; ++m) _Pragma("unroll") for (int n = 0; n < 2; ++n) _Pragma("unroll") for (int k = 0; k < 2; ++k) \
        acc[ai][bj][m][n] = __builtin_amdgcn_mfma_f32_16x16x32_bf16(Bt[n][k], At[m][k], acc[ai][bj][m][n], 0, 0, 0); __builtin_amdgcn_s_setprio(0); } while (0)
#define PG8_WAIT_V(n) asm volatile("s_waitcnt vmcnt(" #n ")" ::: "memory")
#define PG8_WAIT_L(n) asm volatile("s_waitcnt lgkmcnt(" #n ")" ::: "memory")
#define PG8_BAR __builtin_amdgcn_s_barrier()
#define PG8_SCHED __builtin_amdgcn_sched_barrier(0)
    Unit cur, nxt; int ui = 0;
    if (!S.next(0, cur)) return;
    f32x4 acc[2][2][4][2];
#pragma unroll
    for (int a = 0; a < 2; ++a)
#pragma unroll
        for (int b = 0; b < 2; ++b)
#pragma unroll
            for (int m = 0; m < 4; ++m)
#pragma unroll
                for (int n = 0; n < 2; ++n) acc[a][b][m][n] = (f32x4){0.f, 0.f, 0.f, 0.f};
    bf16x8 At[4][2], B0[2][2], B1[2][2];
    const char* cA = (const char*)g.A + (size_t)cur.pm * tstep; const char* cB = (const char*)g.Bt + (size_t)cur.pn * tstep;
    S.a_ready(cur);
    if constexpr (SP2) {
        PG8_STAGE(PG8_SB(0, 0), cB, voffB); PG8_STAGE(PG8_SB(0, 1), cB + hstep, voffB); PG8_STAGE(PG8_SA(0, 0), cA, voffA); PG8_STAGE(PG8_SA(0, 1), cA + hstep, voffA);
        if (wr == 1) PG8_BAR;
        PG8_WAIT_V(2); PG8_BAR;
        PG8_STAGE(PG8_SB(1, 0), cB + kstep, voffB); PG8_STAGE(PG8_SA(1, 0), cA + kstep, voffA); PG8_STAGE(PG8_SB(1, 1), cB + hstep + kstep, voffB);
        PG8_WAIT_V(6); PG8_BAR;
    } else {
        PG8_STAGE(PG8_SB(0, 0), cB, voffB); PG8_STAGE(PG8_SA(0, 0), cA, voffA); PG8_STAGE(PG8_SB(0, 1), cB + hstep, voffB); PG8_STAGE(PG8_SA(0, 1), cA + hstep, voffA);
        if (wr == 1) PG8_BAR;
        PG8_WAIT_V(4); PG8_BAR;
        PG8_STAGE(PG8_SB(1, 0), cB + kstep, voffB); PG8_STAGE(PG8_SA(1, 0), cA + kstep, voffA); PG8_STAGE(PG8_SB(1, 1), cB + hstep + kstep, voffB);
        PG8_WAIT_V(6); PG8_BAR;
    }
    for (;;) {
        const bool has_next = S.next(ui + 1, nxt);
        const char* nA = has_next ? (const char*)g.A + (size_t)nxt.pm * tstep : cA; const char* nB = has_next ? (const char*)g.Bt + (size_t)nxt.pn * tstep : cB;
        for (int t = 0; t < nt; t += 2) {
            const bool last = (t == nt - 2);
            const char* a1 = cA + (size_t)(t + 1) * kstep;
            const char* a2 = last ? nA : cA + (size_t)(t + 2) * kstep; const char* b2 = last ? nB : cB + (size_t)(t + 2) * kstep;
            const char* a3 = a2 + kstep; const char* b3 = b2 + kstep;
            if (last && has_next) S.a_ready(nxt);
            if constexpr (SP2) {
            PG8_LDB(B0, 0, 0); PG8_LDB(B1, 0, 1); PG8_SCHED; PG8_LDA(At, 0, 0); PG8_STAGE(PG8_SA(1, 1), a1 + hstep, voffA);
            PG8_WAIT_V(8); PG8_WAIT_L(0); PG8_BAR; PG8_MMA(0, 0, At, B0); PG8_MMA(0, 1, At, B1); PG8_BAR; PG8_SCHED;
            PG8_LDA(At, 0, 1); PG8_STAGE(PG8_SB(0, 0), b2, voffB); PG8_STAGE(PG8_SB(0, 1), b2 + hstep, voffB); PG8_STAGE(PG8_SA(0, 0), a2, voffA);
            PG8_WAIT_V(8); PG8_WAIT_L(0); PG8_BAR; PG8_MMA(1, 0, At, B0); PG8_MMA(1, 1, At, B1); PG8_BAR; PG8_SCHED;
            PG8_LDB(B0, 1, 0); PG8_LDB(B1, 1, 1); PG8_SCHED; PG8_LDA(At, 1, 0); PG8_STAGE(PG8_SA(0, 1), a2 + hstep, voffA);
            PG8_WAIT_V(8); PG8_WAIT_L(0); PG8_BAR; PG8_MMA(0, 0, At, B0); PG8_MMA(0, 1, At, B1); PG8_BAR; PG8_SCHED;
            PG8_LDA(At, 1, 1); PG8_STAGE(PG8_SB(1, 0), b3, voffB); PG8_STAGE(PG8_SB(1, 1), b3 + hstep, voffB); PG8_STAGE(PG8_SA(1, 0), a3, voffA);
            PG8_WAIT_V(8); PG8_WAIT_L(0); PG8_BAR; PG8_MMA(1, 0, At, B0); PG8_MMA(1, 1, At, B1); PG8_BAR; PG8_SCHED;
            } else {
            PG8_LDB(B0, 0, 0); PG8_SCHED; PG8_LDA(At, 0, 0); PG8_STAGE(PG8_SA(1, 1), a1 + hstep, voffA);
            PG8_WAIT_L(8); PG8_BAR; PG8_WAIT_L(0); PG8_MMA(0, 0, At, B0); PG8_BAR; PG8_SCHED;
            PG8_LDB(B1, 0, 1); PG8_STAGE(PG8_SB(0, 0), b2, voffB);
            PG8_BAR; PG8_WAIT_L(0); PG8_MMA(0, 1, At, B1); PG8_BAR;
            PG8_LDA(At, 0, 1); PG8_STAGE(PG8_SA(0, 0), a2, voffA);
            PG8_BAR; PG8_WAIT_L(0); PG8_MMA(1, 0, At, B0); PG8_BAR; PG8_SCHED;
            PG8_STAGE(PG8_SB(0, 1), b2 + hstep, voffB);
            PG8_WAIT_V(6); PG8_BAR; PG8_MMA(1, 1, At, B1); PG8_BAR;
            PG8_LDB(B0, 1, 0); PG8_SCHED; PG8_LDA(At, 1, 0); PG8_STAGE(PG8_SA(0, 1), a2 + hstep, voffA);
            PG8_WAIT_L(8); PG8_BAR; PG8_WAIT_L(0); PG8_MMA(0, 0, At, B0); PG8_BAR; PG8_SCHED;
            PG8_LDB(B1, 1, 1); PG8_STAGE(PG8_SB(1, 0), b3, voffB);
            PG8_BAR; PG8_WAIT_L(0); PG8_MMA(0, 1, At, B1); PG8_BAR;
            PG8_LDA(At, 1, 1); PG8_STAGE(PG8_SA(1, 0), a3, voffA);
            PG8_BAR; PG8_WAIT_L(0); PG8_MMA(1, 0, At, B0); PG8_BAR; PG8_SCHED;
            PG8_STAGE(PG8_SB(1, 1), b3 + hstep, voffB);
            PG8_WAIT_V(6); PG8_BAR; PG8_MMA(1, 1, At, B1); PG8_BAR;
            }
        }
        if constexpr (ALIGN_EPI) { if (wr == 0) PG8_BAR; }
        if constexpr (!Epi::AFTER_DRAIN) { E(acc, cur, wr, wc, fr, fq); S.done(cur); }
        if (!has_next) break;
#pragma unroll
        for (int a = 0; a < 2; ++a)
#pragma unroll
            for (int b = 0; b < 2; ++b)
#pragma unroll
                for (int m = 0; m < 4; ++m)
#pragma unroll
                    for (int n = 0; n < 2; ++n) acc[a][b][m][n] = (f32x4){0.f, 0.f, 0.f, 0.f};
        cur = nxt; cA = nA; cB = nB; ++ui;
        if constexpr (ALIGN_EPI) { if (wr == 1) PG8_BAR; }
    }
    PG8_WAIT_V(0);
    if constexpr (!ALIGN_EPI) { if (wr == 0) PG8_BAR; }
    PG8_BAR;
    if constexpr (Epi::AFTER_DRAIN) { E.fused(acc, cur, wr, wc, fr, fq, lds, wid, lane); S.done(cur); }
#undef PG8_SA
#undef PG8_SB
#undef PG8_STAGE
#undef PG8_LDA
#undef PG8_LDB
#undef PG8_MMA
#undef PG8_WAIT_V
#undef PG8_WAIT_L
#undef PG8_BAR
#undef PG8_SCHED
}
}
namespace cg = cooperative_groups;
#define LAS __attribute__((address_space(3)))
typedef unsigned short bf16;
typedef float f32x4 __attribute__((ext_vector_type(4)));
typedef float f32x8 __attribute__((ext_vector_type(8)));
typedef float f32x16 __attribute__((ext_vector_type(16)));
typedef unsigned u32x4 __attribute__((ext_vector_type(4)));
typedef unsigned u32x2 __attribute__((ext_vector_type(2)));
typedef short bf16x8 __attribute__((ext_vector_type(8)));
typedef short s16x4 __attribute__((ext_vector_type(4)));

constexpr int BATCH = 16, SEQ = 2048, DM = 1024, T = BATCH * SEQ;
constexpr int NP = 3072;
constexpr int IN_COLS = 3012;
constexpr int C_QA = 0, C_KA = 512, C_VA = 1024, C_QB = 1536, C_KV = 2560, C_QI = 2688, C_KI = 2944, C_WI = 3008;
constexpr int MIXW = 1536;
constexpr int NEXP = 16384;
constexpr float EPS = 1e-6f;
constexpr int NT = 512;
constexpr int NWV = 8;

constexpr size_t MiB = 1u << 20;
constexpr size_t WS_CTL = 0;
constexpr size_t CTL_BYTES = 64 * 1024;
constexpr size_t WS_MOD = 1 * MiB;
constexpr size_t WS_SCAL = WS_MOD + 512 * 1024;
constexpr size_t WS_WIN = 2 * MiB;
constexpr size_t WS_WO2 = 8 * MiB;
constexpr size_t WS_WQ = 11 * MiB;
constexpr size_t WS_SUBK = 13 * MiB;
constexpr size_t WS_U16 = 14 * MiB;
constexpr size_t WS_V16 = 46 * MiB;
constexpr size_t WS_H = 78 * MiB;
constexpr size_t WS_PROJ = 142 * MiB;
constexpr size_t WS_Q3 = WS_PROJ;
constexpr size_t WS_MIX = 334 * MiB;
constexpr size_t WS_EXP = 430 * MiB;
constexpr size_t WS_GATE = 446 * MiB;
constexpr size_t WS_END = 462 * MiB;

struct Params {
    const float *x, *c, *ada_w, *ada_b, *norm1_g, *norm2_g, *w_in, *a_qk_gain, *a_lambda, *a_sub_gain, *b_q_gain, *b_kv_gain, *b_w_uv, *w_out, *peer_wq, *peer_subkeys, *peer_u, *peer_v;
    float* out; unsigned char* ws;
};

enum { SC_LAM = 0, SC_MA = 1, SC_MB = 2 };

__device__ __forceinline__ unsigned f2bf(float f) { unsigned u = __float_as_uint(f); return (u + 0x7fffu + ((u >> 16) & 1u)) >> 16; }
__device__ __forceinline__ float bf2f(unsigned h) { return __uint_as_float(h << 16); }
__device__ __forceinline__ unsigned pk2(float lo, float hi) { return f2bf(lo) | (f2bf(hi) << 16); }
__device__ __forceinline__ float bflo(unsigned w) { return __uint_as_float(w << 16); }
__device__ __forceinline__ float bfhi(unsigned w) { return __uint_as_float(w & 0xffff0000u); }
__device__ __forceinline__ float wave_sum(float v) {
#pragma unroll
    for (int o = 1; o < 64; o <<= 1) v += __shfl_xor(v, o);
    return v;
}
__device__ __forceinline__ float wave_max(float v) {
#pragma unroll
    for (int o = 1; o < 64; o <<= 1) v = fmaxf(v, __shfl_xor(v, o));
    return v;
}
#define LDS_WAIT() asm volatile("s_waitcnt lgkmcnt(0)" ::: "memory")
__device__ __forceinline__ void ph_mod(const Params& p, float* ldsf, int vb, int nvb) {
    if (vb >= 12) return;
    const int tid = threadIdx.x;
    for (int i = tid; i < 16 * 1024; i += NT) { const float v = p.c[i]; ldsf[i] = v / (1.f + __expf(-v)); }
    __syncthreads();
    float* MOD = (float*)(p.ws + WS_MOD);
    for (int it = vb; it < 12; it += nvb) {
        const int j = it * 512 + tid;
        float acc[16];
#pragma unroll
        for (int b = 0; b < 16; ++b) acc[b] = 0.f;
        for (int k = 0; k < 1024; ++k) {
            const float w = p.ada_w[(size_t)k * 6144 + j];
#pragma unroll
            for (int b = 0; b < 16; ++b) acc[b] = fmaf(ldsf[b * 1024 + k], w, acc[b]);
        }
        const float bb = p.ada_b[j];
#pragma unroll
        for (int b = 0; b < 16; ++b) MOD[b * 6144 + j] = acc[b] + bb;
    }
    __syncthreads();
}

__device__ __forceinline__ void transpose_item(const float* W, int N, bf16* WT, int ldt, LAS float* scr, int kb, int nb, int lane) {
    const int k0 = 64 * kb, n0 = 32 * nb;
#pragma unroll 8
    for (int i = 0; i < 32; ++i) { const int kk = 2 * i + (lane >> 5); const int n = n0 + (lane & 31); scr[kk * 33 + (lane & 31)] = (n < N) ? W[(size_t)(k0 + kk) * N + n] : 0.f; }
    LDS_WAIT(); asm volatile("" ::: "memory");
    const int c = lane & 7;
#pragma unroll
    for (int j = 0; j < 4; ++j) { const int n = (lane >> 3) + 8 * j; const LAS float* s = scr + (8 * c) * 33 + n;
        u32x4 o; o.x = pk2(s[0 * 33], s[1 * 33]); o.y = pk2(s[2 * 33], s[3 * 33]); o.z = pk2(s[4 * 33], s[5 * 33]); o.w = pk2(s[6 * 33], s[7 * 33]);
        *(u32x4*)(WT + (size_t)(n0 + n) * ldt + k0 + 8 * c) = o; }
    LDS_WAIT(); asm volatile("" ::: "memory");
}

__device__ __forceinline__ void ph_prep_weights(const Params& p, LAS float* scr, int gw, int ngw, int lane) {
    bf16* WIN = (bf16*)(p.ws + WS_WIN); bf16* WO2 = (bf16*)(p.ws + WS_WO2); bf16* WQ = (bf16*)(p.ws + WS_WQ);
    constexpr int I_IN = 16 * 96, I_O = 8 * 32, I_Q = 16 * 32;
    for (int it = gw; it < I_IN + I_O + I_Q; it += ngw) {
        int r = it;
        if (r < I_IN) { transpose_item(p.w_in, IN_COLS, WIN, 1024, scr, r / 96, r % 96, lane); continue; } r -= I_IN;
        if (r < I_O) { transpose_item(p.w_out, 1024, WO2, MIXW, scr, r / 32, r % 32, lane); continue; } r -= I_O;
        transpose_item(p.peer_wq, 1024, WQ, 1024, scr, r / 32, r % 32, lane);
    }
    const size_t gt = (size_t)gw * 64 + lane, ngt = (size_t)ngw * 64;
    for (size_t i = gt; i < (size_t)1024 * 1024; i += ngt) {
        const int n = (int)(i & 1023), kk = (int)(i >> 10), h = kk >> 7;
        const float* wu = p.b_w_uv + (size_t)kk * 64; const float* wo = p.w_out + (size_t)(512 + 64 * h) * 1024 + n;
        float a = 0.f;
#pragma unroll 8
        for (int e = 0; e < 64; ++e) a = fmaf(wu[e], wo[(size_t)e * 1024], a);
        WO2[(size_t)n * MIXW + 512 + kk] = (bf16)f2bf(a);
    }
    bf16* U16 = (bf16*)(p.ws + WS_U16); bf16* V16 = (bf16*)(p.ws + WS_V16); bf16* SUBK = (bf16*)(p.ws + WS_SUBK);
    constexpr size_t NTAB8 = (size_t)NEXP * 1024 / 8, NSUB8 = 2 * 128 * 64 / 8;
    for (size_t i = gt; i < 2 * NTAB8 + NSUB8; i += ngt) {
        const float* src; bf16* dst; size_t j = i;
        if (j < NTAB8) { src = p.peer_u; dst = U16; } else if (j < 2 * NTAB8) { j -= NTAB8; src = p.peer_v; dst = V16; } else { j -= 2 * NTAB8; src = p.peer_subkeys; dst = SUBK; }
        const f32x8 v = *(const f32x8*)(src + j * 8);
        u32x4 o; o.x = pk2(v[0], v[1]); o.y = pk2(v[2], v[3]); o.z = pk2(v[4], v[5]); o.w = pk2(v[6], v[7]);
        *(u32x4*)(dst + j * 8) = o;
    }
    if (gt == 0) {
        float* SC = (float*)(p.ws + WS_SCAL);
        float s01 = 0.f, s23 = 0.f;
        for (int i = 0; i < 64; ++i) { s01 += p.a_lambda[i] * p.a_lambda[64 + i]; s23 += p.a_lambda[128 + i] * p.a_lambda[192 + i]; }
        SC[SC_LAM] = __expf(s01) - __expf(s23) + 0.2f;
        float g0 = 0.f, g1 = 0.f, gq = 0.f, gk = 0.f;
        for (int i = 0; i < 64; ++i) { g0 = fmaxf(g0, fabsf(p.a_qk_gain[i])); g1 = fmaxf(g1, fabsf(p.a_qk_gain[64 + i])); }
        for (int i = 0; i < 128; ++i) { gq = fmaxf(gq, fabsf(p.b_q_gain[i])); gk = fmaxf(gk, fabsf(p.b_kv_gain[i])); }
        SC[SC_MA] = 8.0f * g0 * g1 * 1.02f;
        SC[SC_MB] = 11.3137085f * gq * gk * 1.02f;
    }
}

__device__ __forceinline__ void ph_hrows(const Params& p, const float* X, const float* g, int shOff, int scOff, int gw, int ngw, int lane) {
    const float* MOD = (const float*)(p.ws + WS_MOD); bf16* H = (bf16*)(p.ws + WS_H);
    for (int m = gw; m < T; m += ngw) {
        const f32x4* xr = (const f32x4*)(X + (size_t)m * 1024) + lane;
        f32x4 v[4]; float s = 0.f;
#pragma unroll
        for (int j = 0; j < 4; ++j) { v[j] = xr[64 * j]; s += (v[j].x * v[j].x + v[j].y * v[j].y) + (v[j].z * v[j].z + v[j].w * v[j].w); }
        const float rstd = rsqrtf(wave_sum(s) * (1.f / 1024.f) + EPS);
        const float* mb = MOD + (size_t)(m >> 11) * 6144;
#pragma unroll
        for (int j = 0; j < 4; ++j) {
            const int col = 4 * (lane + 64 * j);
            const f32x4 gg = *(const f32x4*)(g + col), sc = *(const f32x4*)(mb + scOff + col), sh = *(const f32x4*)(mb + shOff + col);
            const f32x4 y = v[j] * rstd * gg * (sc + 1.0f) + sh;
            u32x2 o; o.x = pk2(y.x, y.y); o.y = pk2(y.z, y.w);
            *(u32x2*)(H + (size_t)m * 1024 + col) = o;
        }
    }
}

__device__ __forceinline__ void ph_norm_proj(const Params& p, int gw, int ngw, int lane) {
    bf16* PROJ = (bf16*)(p.ws + WS_PROJ);
    for (int m = gw; m < T; m += ngw) {
        bf16* row = PROJ + (size_t)m * NP;
#pragma unroll
        for (int j = 0; j < 6; ++j) {
            if (j == 2) continue;
            const int col = 8 * lane + 512 * j;
            const u32x4 raw = *(const u32x4*)(row + col);
            float v[8] = {bflo(raw.x), bfhi(raw.x), bflo(raw.y), bfhi(raw.y), bflo(raw.z), bfhi(raw.z), bflo(raw.w), bfhi(raw.w)};
            float ss = 0.f;
#pragma unroll
            for (int i = 0; i < 8; ++i) ss += v[i] * v[i];
            ss += __shfl_xor(ss, 1); ss += __shfl_xor(ss, 2); ss += __shfl_xor(ss, 4);
            float rstd; const float* gp;
            if (j < 2) { rstd = rsqrtf(ss * (1.f / 64.f) + EPS); gp = p.a_qk_gain + 64 * j + (col & 63); }
            else { ss += __shfl_xor(ss, 8); rstd = rsqrtf(ss * (1.f / 128.f) + EPS); gp = (j == 5 ? p.b_kv_gain : p.b_q_gain) + (col & 127); }
            if (j == 5 && lane >= 16) continue;
            const f32x4 g0 = *(const f32x4*)gp, g1 = *(const f32x4*)(gp + 4);
            u32x4 o; o.x = pk2(v[0] * rstd * g0.x, v[1] * rstd * g0.y); o.y = pk2(v[2] * rstd * g0.z, v[3] * rstd * g0.w);
            o.z = pk2(v[4] * rstd * g1.x, v[5] * rstd * g1.y); o.w = pk2(v[6] * rstd * g1.z, v[7] * rstd * g1.w);
            *(u32x4*)(row + col) = o;
        }
    }
}
__device__ void ph_attnA_naive(const Params& p, float* lds_w, int gw, int ngw, int lane) {
    const bf16* PROJ = (const bf16*)(p.ws + WS_PROJ); bf16* MIX = (bf16*)(p.ws + WS_MIX);
    const float lam = ((const float*)(p.ws + WS_SCAL))[SC_LAM];
    float* qs = lds_w; float* sc0 = lds_w + 128; float* sc1 = sc0 + 2048;
    for (int it = gw; it < BATCH * 4 * SEQ; it += ngw) {
        const int t = it & 2047, h = (it >> 11) & 3, b = it >> 13;
        const int cend = ((t >> 6) + 1) << 6;
        const float slope = exp2f(-2.0f * (h + 1));
        const bf16* qrow = PROJ + (size_t)(b * SEQ + t) * NP + C_QA + h * 128;
        qs[lane] = bf2f(qrow[lane]); qs[64 + lane] = bf2f(qrow[64 + lane]);
        LDS_WAIT(); asm volatile("" ::: "memory");
        float m0 = -3e38f, m1 = -3e38f;
        for (int kk = lane; kk < cend; kk += 64) {
            const bf16* krow = PROJ + (size_t)(b * SEQ + kk) * NP + C_KA + h * 128;
            float d0 = 0.f, d1 = 0.f;
            for (int d = 0; d < 64; ++d) { d0 = fmaf(qs[d], bf2f(krow[d]), d0); d1 = fmaf(qs[64 + d], bf2f(krow[64 + d]), d1); }
            const float bias = slope * fabsf((float)(t - kk));
            d0 = d0 * 0.125f - bias; d1 = d1 * 0.125f - bias;
            sc0[kk] = d0; sc1[kk] = d1; m0 = fmaxf(m0, d0); m1 = fmaxf(m1, d1);
        }
        m0 = wave_max(m0); m1 = wave_max(m1);
        float l0 = 0.f, l1 = 0.f;
        for (int kk = lane; kk < cend; kk += 64) { const float e0 = __expf(sc0[kk] - m0), e1 = __expf(sc1[kk] - m1); sc0[kk] = e0; sc1[kk] = e1; l0 += e0; l1 += e1; }
        l0 = wave_sum(l0); l1 = wave_sum(l1);
        const float i0 = 1.f / l0, i1 = lam / l1;
        for (int kk = lane; kk < cend; kk += 64) sc0[kk] = sc0[kk] * i0 - sc1[kk] * i1;
        LDS_WAIT(); asm volatile("" ::: "memory");
        float a0 = 0.f, a1 = 0.f;
        const bf16* vb = PROJ + (size_t)(b * SEQ) * NP + C_VA + h * 128;
        for (int kk = 0; kk < cend; ++kk) { const float a = sc0[kk]; const bf16* vr = vb + (size_t)kk * NP; a0 = fmaf(a, bf2f(vr[lane]), a0); a1 = fmaf(a, bf2f(vr[64 + lane]), a1); }
        const float ss = wave_sum(a0 * a0 + a1 * a1);
        const float rstd = rsqrtf(ss * (1.f / 128.f) + EPS) * 0.8f;
        bf16* orow = MIX + (size_t)(b * SEQ + t) * MIXW + h * 128;
        orow[lane] = (bf16)f2bf(a0 * rstd * p.a_sub_gain[lane]); orow[64 + lane] = (bf16)f2bf(a1 * rstd * p.a_sub_gain[64 + lane]);
        LDS_WAIT(); asm volatile("" ::: "memory");
    }
}

__device__ void ph_dsa_naive(const Params& p, float* lds, int vb, int nvb) {
    const bf16* PROJ = (const bf16*)(p.ws + WS_PROJ); bf16* MIX = (bf16*)(p.ws + WS_MIX);
    const int tid = threadIdx.x, lane = tid & 63, wv = tid >> 6;
    float* scores = lds; int* sel = (int*)(lds + 2048); float* qi = lds + 2048 + 256; float* wi = qi + 256;
    float* qh = wi + 64 + wv * 384; float* pw = qh + 128;
    for (int it = vb; it < T; it += nvb) {
        const int b = it >> 11, t = it & 2047; const int cend = ((t >> 6) + 1) << 6;
        const bf16* row = PROJ + (size_t)it * NP;
        if (tid < 256) qi[tid] = bf2f(row[C_QI + tid]);
        if (tid < 4) wi[tid] = bf2f(row[C_WI + tid]);
        __syncthreads();
        for (int kk = tid; kk < cend; kk += NT) {
            const bf16* kr = PROJ + (size_t)(b * SEQ + kk) * NP + C_KI;
            float s = 0.f;
            for (int h = 0; h < 4; ++h) { float d = 0.f; for (int e = 0; e < 64; ++e) d = fmaf(qi[h * 64 + e], bf2f(kr[e]), d); s += fmaxf(d, 0.f) * wi[h]; }
            scores[kk] = s * 0.0625f;
        }
        __syncthreads();
        int nvalid;
        if (cend <= 256) { if (tid < 256) sel[tid] = tid; nvalid = cend; }
        else {
            for (int i = tid; i < cend; i += NT) { const float si = scores[i]; int rank = 0;
                for (int j = 0; j < cend; ++j) { const float sj = scores[j]; rank += (sj > si || (sj == si && j < i)) ? 1 : 0; }
                if (rank < 256) sel[rank] = i; }
            nvalid = 256;
        }
        __syncthreads();
        {
            const int h = wv; const float slope = exp2f(-(float)(h + 1));
            qh[lane] = bf2f(row[C_QB + h * 128 + lane]); qh[64 + lane] = bf2f(row[C_QB + h * 128 + 64 + lane]);
            LDS_WAIT(); asm volatile("" ::: "memory");
            float sv[4]; float mx = -3e38f;
#pragma unroll
            for (int jj = 0; jj < 4; ++jj) { const int j = lane + 64 * jj; const int key = sel[j < nvalid ? j : 0];
                const bf16* kv = PROJ + (size_t)(b * SEQ + key) * NP + C_KV; float d = 0.f;
                for (int e = 0; e < 128; ++e) d = fmaf(qh[e], bf2f(kv[e]), d);
                d = d * 0.0883883476f - slope * fabsf((float)(t - key));
                sv[jj] = (j < nvalid) ? d : -3e38f; mx = fmaxf(mx, sv[jj]); }
            mx = wave_max(mx); float l = 0.f;
#pragma unroll
            for (int jj = 0; jj < 4; ++jj) { const int j = lane + 64 * jj; const float e = (j < nvalid) ? __expf(sv[jj] - mx) : 0.f; pw[j] = e; l += e; }
            l = wave_sum(l);
            LDS_WAIT(); asm volatile("" ::: "memory");
            float a0 = 0.f, a1 = 0.f;
            for (int j = 0; j < nvalid; ++j) { const float pj = pw[j]; const bf16* kv = PROJ + (size_t)(b * SEQ + sel[j]) * NP + C_KV; a0 = fmaf(pj, bf2f(kv[lane]), a0); a1 = fmaf(pj, bf2f(kv[64 + lane]), a1); }
            const float il = 1.f / l;
            bf16* orow = MIX + (size_t)it * MIXW + 512 + h * 128;
            orow[lane] = (bf16)f2bf(a0 * il); orow[64 + lane] = (bf16)f2bf(a1 * il);
        }
        __syncthreads();
    }
}

__device__ void ph_route_naive(const Params& p, float* lds, int vb, int nvb) {
    const bf16* Q3 = (const bf16*)(p.ws + WS_Q3); const bf16* SUBK = (const bf16*)(p.ws + WS_SUBK);
    int* EXPI = (int*)(p.ws + WS_EXP); float* GATE = (float*)(p.ws + WS_GATE);
    const int tid = threadIdx.x;
    float* q = lds; float* sub = q + 1024; float* sv = sub + 2048; int* si = (int*)(sv + 256); float* cand = sv + 512; float* ts = cand + 2048; int* te = (int*)(ts + 128);
    for (int it = vb; it < T; it += nvb) {
        q[tid] = bf2f(Q3[(size_t)it * 1024 + tid]); q[tid + 512] = bf2f(Q3[(size_t)it * 1024 + tid + 512]);
        __syncthreads();
        for (int r = 0; r < 4; ++r) { const int idx = tid + 512 * r, h = idx >> 8, c = (idx >> 7) & 1, n = idx & 127;
            const float* qq = q + h * 128 + c * 64; const bf16* kk = SUBK + (size_t)(c * 128 + n) * 64; float d = 0.f;
            for (int e = 0; e < 64; ++e) d = fmaf(qq[e], bf2f(kk[e]), d);
            sub[idx] = d; }
        __syncthreads();
        for (int r = 0; r < 4; ++r) { const int idx = tid + 512 * r, g0 = idx & ~127, n = idx & 127; const float s = sub[idx]; int rank = 0;
            for (int j = 0; j < 128; ++j) { const float sj = sub[g0 + j]; rank += (sj > s || (sj == s && j < n)) ? 1 : 0; }
            if (rank < 16) { sv[(g0 >> 7) * 16 + rank] = s; si[(g0 >> 7) * 16 + rank] = n; } }
        __syncthreads();
        for (int r = 0; r < 4; ++r) { const int idx = tid + 512 * r, h = idx >> 8, i = (idx >> 4) & 15, j = idx & 15; cand[idx] = sv[(h * 2) * 16 + i] + sv[(h * 2 + 1) * 16 + j]; }
        __syncthreads();
        for (int r = 0; r < 4; ++r) { const int idx = tid + 512 * r, h = idx >> 8, ij = idx & 255; const float s = cand[idx]; int rank = 0;
            for (int j = 0; j < 256; ++j) { const float sj = cand[h * 256 + j]; rank += (sj > s || (sj == s && j < ij)) ? 1 : 0; }
            if (rank < 16) { ts[h * 16 + rank] = s; te[h * 16 + rank] = si[(h * 2) * 16 + (ij >> 4)] * 128 + si[(h * 2 + 1) * 16 + (ij & 15)]; } }
        __syncthreads();
        if (tid < 128) { const int h = tid >> 4; const float mx = ts[h * 16]; float l = 0.f;
            for (int k = 0; k < 16; ++k) l += __expf(ts[h * 16 + k] - mx);
            GATE[(size_t)it * 128 + tid] = __expf(ts[tid] - mx) / l; EXPI[(size_t)it * 128 + tid] = te[tid]; }
        __syncthreads();
    }
}

__device__ void ph_peer_naive(const Params& p, float* lds, int vb, int nvb) {
    const bf16* H = (const bf16*)(p.ws + WS_H); const bf16* U16 = (const bf16*)(p.ws + WS_U16); const bf16* V16 = (const bf16*)(p.ws + WS_V16);
    const int* EXPI = (const int*)(p.ws + WS_EXP); const float* GATE = (const float*)(p.ws + WS_GATE); const float* MOD = (const float*)(p.ws + WS_MOD);
    const int tid = threadIdx.x, lane = tid & 63, wv = tid >> 6;
    float* xs = lds; float* coef = lds + 1024; int* ex = (int*)(coef + 128);
    for (int it = vb; it < T; it += nvb) {
        xs[tid] = bf2f(H[(size_t)it * 1024 + tid]); xs[tid + 512] = bf2f(H[(size_t)it * 1024 + tid + 512]);
        if (tid < 128) ex[tid] = EXPI[(size_t)it * 128 + tid];
        __syncthreads();
        for (int jj = 0; jj < 16; ++jj) { const int j = wv * 16 + jj; const bf16* ur = U16 + (size_t)ex[j] * 1024; float d = 0.f;
            for (int i = 0; i < 16; ++i) d = fmaf(xs[lane + 64 * i], bf2f(ur[lane + 64 * i]), d);
            d = wave_sum(d);
            if (lane == 0) coef[j] = 0.5f * d * (1.f + erff(d * 0.70710678f)) * GATE[(size_t)it * 128 + j]; }
        __syncthreads();
        const float* g2 = MOD + (size_t)(it >> 11) * 6144 + 5120;
        for (int r = 0; r < 2; ++r) { const int d = tid + 512 * r; float a = 0.f;
            for (int j = 0; j < 128; ++j) a = fmaf(coef[j], bf2f(V16[(size_t)ex[j] * 1024 + d]), a);
            p.out[(size_t)it * 1024 + d] = p.out[(size_t)it * 1024 + d] + g2[d] * a; }
        __syncthreads();
    }
}
struct EpiResGate {
    static constexpr bool PERM = false, AFTER_DRAIN = false;
    const float* X; float* Out; const float* gate;
    __device__ __forceinline__ void operator()(const pg8::f32x4 (&acc)[2][2][4][2], const pg8::Unit& u, int wr, int wc, int fr, int fq) const {
        const int col0 = u.pn * 256 + wc * 32 + 4 * fq;
#pragma unroll
        for (int ai = 0; ai < 2; ++ai)
#pragma unroll
            for (int m = 0; m < 4; ++m) {
                const int r = u.pm * 256 + ai * 128 + wr * 64 + m * 16 + fr; const float* gb = gate + (size_t)(r >> 11) * 6144;
#pragma unroll
                for (int bj = 0; bj < 2; ++bj)
#pragma unroll
                    for (int n = 0; n < 2; ++n) { const int c = col0 + bj * 128 + n * 16; const size_t off = (size_t)r * 1024 + c;
                        const pg8::f32x4 xv = *(const pg8::f32x4*)(X + off), gv = *(const pg8::f32x4*)(gb + c);
                        *(pg8::f32x4*)(Out + off) = xv + gv * acc[ai][bj][m][n]; }
            }
    }
};

extern __shared__ __attribute__((aligned(16))) unsigned char dyn_lds[];

__global__ void __launch_bounds__(NT, 2) k_mod(Params p) { ph_mod(p, (float*)dyn_lds, blockIdx.x, gridDim.x); }
__global__ void __launch_bounds__(NT, 2) k_prep(Params p) {
    const int lane = threadIdx.x & 63, wv = threadIdx.x >> 6;
    ph_prep_weights(p, (LAS float*)dyn_lds + wv * (64 * 33), blockIdx.x * NWV + wv, gridDim.x * NWV, lane);
}
__global__ void __launch_bounds__(NT, 2) k_h1(Params p) { ph_hrows(p, p.x, p.norm1_g, 0, 1024, blockIdx.x * NWV + (threadIdx.x >> 6), gridDim.x * NWV, threadIdx.x & 63); }
__global__ void __launch_bounds__(NT, 2) k_h2(Params p) { ph_hrows(p, p.out, p.norm2_g, 3072, 4096, blockIdx.x * NWV + (threadIdx.x >> 6), gridDim.x * NWV, threadIdx.x & 63); }
__global__ void __launch_bounds__(NT, 2) k_gemm1(Params p) {
    pg8::Gemm g{(const bf16*)(p.ws + WS_H), (const bf16*)(p.ws + WS_WIN), T, NP, 1024}; pg8::StaticOrder S; S.init(T, NP, gridDim.x, blockIdx.x);
    pg8::EpiBf16<0> E{(bf16*)(p.ws + WS_PROJ), NP, nullptr, 0, 0, 1.f};
    pg8::gemm_phase<pg8::EpiBf16<0>, pg8::StaticOrder, true, true>((LAS unsigned char*)dyn_lds, g, S, E);
}
__global__ void __launch_bounds__(NT, 2) k_gemm2(Params p) {
    pg8::Gemm g{(const bf16*)(p.ws + WS_MIX), (const bf16*)(p.ws + WS_WO2), T, 1024, MIXW}; pg8::StaticOrder S; S.init(T, 1024, gridDim.x, blockIdx.x);
    EpiResGate E{p.x, p.out, (const float*)(p.ws + WS_MOD) + 2048};
    pg8::gemm_phase<EpiResGate, pg8::StaticOrder, true, true>((LAS unsigned char*)dyn_lds, g, S, E);
}
__global__ void __launch_bounds__(NT, 2) k_gemm3(Params p) {
    pg8::Gemm g{(const bf16*)(p.ws + WS_H), (const bf16*)(p.ws + WS_WQ), T, 1024, 1024}; pg8::StaticOrder S; S.init(T, 1024, gridDim.x, blockIdx.x);
    pg8::EpiBf16<0> E{(bf16*)(p.ws + WS_Q3), 1024, nullptr, 0, 0, 1.f};
    pg8::gemm_phase<pg8::EpiBf16<0>, pg8::StaticOrder, true, true>((LAS unsigned char*)dyn_lds, g, S, E);
}
__global__ void __launch_bounds__(NT, 2) k_norm(Params p) { ph_norm_proj(p, blockIdx.x * NWV + (threadIdx.x >> 6), gridDim.x * NWV, threadIdx.x & 63); }
__global__ void __launch_bounds__(NT, 2) k_attnA(Params p) { const int wv = threadIdx.x >> 6; ph_attnA_naive(p, (float*)dyn_lds + wv * (128 + 4096), blockIdx.x * NWV + wv, gridDim.x * NWV, threadIdx.x & 63); }
__global__ void __launch_bounds__(NT, 2) k_dsa(Params p) { ph_dsa_naive(p, (float*)dyn_lds, blockIdx.x, gridDim.x); }
__global__ void __launch_bounds__(NT, 2) k_route(Params p) { ph_route_naive(p, (float*)dyn_lds, blockIdx.x, gridDim.x); }
__global__ void __launch_bounds__(NT, 2) k_peer(Params p) { ph_peer_naive(p, (float*)dyn_lds, blockIdx.x, gridDim.x); }

extern "C" void kernel_launch(void* const* d_in, const int* in_sizes, int n_in, void* d_out, int out_size, void* d_ws, size_t ws_size, hipStream_t stream) {
    static int ok = 0;
    if (ok == 0) {
        if (n_in != 18 || in_sizes[0] != T * DM || out_size != T * DM || ws_size < WS_END) { fprintf(stderr, "kernel_launch: unexpected shapes n_in %d in0 %d out %d ws %zu\n", n_in, n_in > 0 ? in_sizes[0] : -1, out_size, ws_size); ok = -1; return; }
        hipFuncSetAttribute((const void*)k_mod, hipFuncAttributeMaxDynamicSharedMemorySize, 65536);
        hipFuncSetAttribute((const void*)k_prep, hipFuncAttributeMaxDynamicSharedMemorySize, 8 * 64 * 33 * 4);
        hipFuncSetAttribute((const void*)k_gemm1, hipFuncAttributeMaxDynamicSharedMemorySize, 131072);
        hipFuncSetAttribute((const void*)k_gemm2, hipFuncAttributeMaxDynamicSharedMemorySize, 131072);
        hipFuncSetAttribute((const void*)k_gemm3, hipFuncAttributeMaxDynamicSharedMemorySize, 131072);
        hipFuncSetAttribute((const void*)k_attnA, hipFuncAttributeMaxDynamicSharedMemorySize, 8 * (128 + 4096) * 4);
        ok = 1;
    }
    if (ok < 0) return;
    Params p{};
    const float** pp = (const float**)&p;
    for (int i = 0; i < 18; ++i) pp[i] = (const float*)d_in[i];
    p.out = (float*)d_out; p.ws = (unsigned char*)d_ws;
    hipLaunchKernelGGL(k_mod, dim3(12), dim3(NT), 65536, stream, p);
    hipLaunchKernelGGL(k_prep, dim3(1024), dim3(NT), 8 * 64 * 33 * 4, stream, p);
    hipLaunchKernelGGL(k_h1, dim3(1024), dim3(NT), 0, stream, p);
    hipLaunchKernelGGL(k_gemm1, dim3(256), dim3(NT), 131072, stream, p);
    hipLaunchKernelGGL(k_norm, dim3(1024), dim3(NT), 0, stream, p);
    hipLaunchKernelGGL(k_attnA, dim3(1024), dim3(NT), 8 * (128 + 4096) * 4, stream, p);
    hipLaunchKernelGGL(k_dsa, dim3(2048), dim3(NT), 32768, stream, p);
    hipLaunchKernelGGL(k_gemm2, dim3(256), dim3(NT), 131072, stream, p);
    hipLaunchKernelGGL(k_h2, dim3(1024), dim3(NT), 0, stream, p);
    hipLaunchKernelGGL(k_gemm3, dim3(256), dim3(NT), 131072, stream, p);
    hipLaunchKernelGGL(k_route, dim3(2048), dim3(NT), 32768, stream, p);
    hipLaunchKernelGGL(k_peer, dim3(2048), dim3(NT), 8192, stream, p);
    const hipError_t le = hipPeekAtLastError();
    if (le != hipSuccess) fprintf(stderr, "kernel_launch: launch failed: %s\n", hipGetErrorName(le));
}
```

```cpp
#include <hip/hip_runtime.h>
#include <hip/hip_cooperative_groups.h>
#include <cstdio>
#include <cstdint>
#include <cmath>
namespace pg8 {
#define PG8_LAS __attribute__((address_space(3)))
typedef unsigned short bf16_t;
typedef short bf16x8 __attribute__((ext_vector_type(8)));
typedef float f32x4 __attribute__((ext_vector_type(4)));
typedef unsigned u32x4 __attribute__((ext_vector_type(4)));
constexpr int BM = 256, BK = 64, HALF = 128, HTB = HALF * BK * 2  , STAGE_BYTES = 8 * HTB, NXCD = 8, WGM = 8;

__host__ __device__ __forceinline__ int lds_byte(int r, int c) { const int st = (r >> 4) * 2 + (c >> 5), rr = r & 15, cc = c & 31, ob = rr * 64 + cc * 2; return st * 1024 + (ob ^ (((ob >> 9) & 1) << 5)); }
__host__ __device__ __forceinline__ void stage_rc(int b, int& R, int& C) { const int st = b / 1024, sb = b % 1024, swz = sb ^ (((sb >> 9) & 1) << 5); R = (st >> 1) * 16 + swz / 64; C = (st & 1) * 32 + (swz % 64) / 2; }
__host__ __device__ __forceinline__ int perm32(int rho) { const int n = rho >> 4, i = rho & 15; return 8 * (i >> 2) + 4 * n + (i & 3); }

struct Unit { int pm, pn; };
struct Gemm { const bf16_t* A; const bf16_t* Bt; int M, N, K; };

struct StaticOrder {
    int nM, nN, nwg, G, c;
    __host__ __device__ void init(int M, int N, int G_, int c_) { nM = M / BM; nN = N / BM; nwg = nM * nN; G = G_; c = c_; }
    __host__ __device__ bool next(int i, Unit& u) const {
        const long L = (long)i * G + c; if (L >= nwg) return false;
        int wgid = (int)L; { const int q = nwg / NXCD, r = nwg % NXCD, xcd = wgid % NXCD, off = wgid / NXCD; wgid = (xcd < r ? xcd * (q + 1) : r * (q + 1) + (xcd - r) * q) + off; }
        const int nig = WGM * nN, gid = wgid / nig, fm = gid * WGM, gsz = (nM - fm) < WGM ? (nM - fm) : WGM;
        u.pm = fm + ((wgid % nig) % gsz); u.pn = (wgid % nig) / gsz; return true;
    }
    __device__ __forceinline__ void a_ready(const Unit&) const {}
    __device__ __forceinline__ void done(const Unit&) const {}
};

__device__ __forceinline__ unsigned cvt_pk_bf16(float lo, float hi) { unsigned r; asm volatile("v_cvt_pk_bf16_f32 %0, %1, %2" : "=v"(r) : "v"(lo), "v"(hi)); return r; }
typedef float f32x2 __attribute__((ext_vector_type(2)));
__device__ __forceinline__ f32x2 gelu_pk(f32x2 v) {
    const f32x2 av = __builtin_elementwise_abs(v), d = av * 0.2316418882f + 1.0f;
    f32x2 t; t.x = __builtin_amdgcn_rcpf(d.x); t.y = __builtin_amdgcn_rcpf(d.y);
    f32x2 q = t * 0.5307027145f + (-0.7265760135f); q = q * t + 0.7107068705f; q = q * t + (-0.142248368f); q = q * t + 0.127414796f; q = q * t;
    const f32x2 s = (v * v) * (-0.72134752044f);
    f32x2 e; e.x = __builtin_amdgcn_exp2f(s.x); e.y = __builtin_amdgcn_exp2f(s.y);
    const f32x2 m = v * (q * e), r = v - m;
    f32x2 o; o.x = v.x < 0.f ? m.x : r.x; o.y = v.y < 0.f ? m.y : r.y; return o;
}

template <int ACT  > struct EpiBf16 {
    static constexpr bool PERM = true, AFTER_DRAIN = false; static_assert(ACT == 0 || ACT == 1, "EpiBf16: ACT is 0 (none) or 1 (gelu_pk)");
    bf16_t* O; int ldc; const float* bias; int split_cols; size_t split_stride; float scale0;
    __device__ __forceinline__ void operator()(const f32x4 (&acc)[2][2][4][2], const Unit& u, int wr, int wc, int fr, int fq) const {
        const int row0 = u.pm * BM + wr * 64 + fr; int colt = u.pn * BM; bf16_t* base = O;
        float sc = 1.f; if (split_cols) { const int t = colt / split_cols; base += (size_t)t * split_stride; colt -= t * split_cols; if (t == 0) sc = scale0; }
        const int col0 = colt + wc * 32 + 8 * fq, bcol0 = u.pn * BM + wc * 32 + 8 * fq;
        f32x4 bv[2][2];
#pragma unroll
        for (int bj = 0; bj < 2; ++bj)
#pragma unroll
            for (int n = 0; n < 2; ++n) bv[bj][n] = bias ? *(const f32x4*)(bias + bcol0 + bj * HALF + 4 * n) : (f32x4){0.f, 0.f, 0.f, 0.f};
#pragma unroll
        for (int ai = 0; ai < 2; ++ai)
#pragma unroll
            for (int m = 0; m < 4; ++m) { bf16_t* rowp = base + (size_t)(row0 + ai * HALF + m * 16) * ldc + col0;
#pragma unroll
                for (int bj = 0; bj < 2; ++bj) { f32x4 v0 = acc[ai][bj][m][0] + bv[bj][0], v1 = acc[ai][bj][m][1] + bv[bj][1];
                    if (ACT == 1) { f32x2 a = gelu_pk((f32x2){v0[0], v0[1]}), b = gelu_pk((f32x2){v0[2], v0[3]}), c = gelu_pk((f32x2){v1[0], v1[1]}), d = gelu_pk((f32x2){v1[2], v1[3]});
                        v0 = (f32x4){a.x, a.y, b.x, b.y}; v1 = (f32x4){c.x, c.y, d.x, d.y}; }
                    v0 = v0 * sc; v1 = v1 * sc; u32x4 w; w.x = cvt_pk_bf16(v0[0], v0[1]); w.y = cvt_pk_bf16(v0[2], v0[3]); w.z = cvt_pk_bf16(v1[0], v1[1]); w.w = cvt_pk_bf16(v1[2], v1[3]);
                    *(u32x4*)(rowp + bj * HALF) = w; } }
    }
};

template <class Epi, class Sched, bool ALIGN_EPI = false, bool SP2 = false>
__device__ __forceinline__ void gemm_phase(PG8_LAS unsigned char* lds, const Gemm g, const Sched& S, const Epi& E) {
    const int tid = threadIdx.x, wid = __builtin_amdgcn_readfirstlane(tid >> 6), lane = tid & 63, wr = wid >> 2, wc = wid & 3, fr = lane & 15, fq = lane >> 4;
    const int K = g.K, nt = K / BK;
    unsigned voffA[2], voffB[2];
#pragma unroll
    for (int i = 0; i < 2; ++i) { int R, C; stage_rc(tid * 16 + i * 8192, R, C); const int Rb = Epi::PERM ? ((R & ~31) + perm32(R & 31)) : R;
        voffA[i] = (unsigned)(R * K + C) * 2u; voffB[i] = (unsigned)(Rb * K + C) * 2u; }
    const size_t kstep = (size_t)(BK * 2);
    const size_t hstep = (size_t)HALF * K * 2;
    const size_t tstep = 2 * hstep;
    const unsigned ldsw = (unsigned)wid * 1024u;
    const int aoff = lds_byte(wr * 64 + fr, fq * 8), boff = lds_byte(wc * 32 + fr, fq * 8);
#define PG8_SA(b, h) (((b) * 2 + (h)) * HTB)
#define PG8_SB(b, h) ((4 + (b) * 2 + (h)) * HTB)
#define PG8_STAGE(bufoff, gbase, voff) do { _Pragma("unroll") for (int _i = 0; _i < 2; ++_i) \
        __builtin_amdgcn_global_load_lds((const unsigned*)((const char*)(gbase) + (voff)[_i]), (PG8_LAS unsigned*)(lds + (bufoff) + ldsw + _i * 8192), 16, 0, 0); } while (0)
#define PG8_LDA(dst, b, h) do { _Pragma("unroll") for (int m = 0; m < 4; ++m) _Pragma("unroll") for (int k = 0; k < 2; ++k) dst[m][k] = *(const PG8_LAS bf16x8*)(lds + PG8_SA(b, h) + aoff + m * 2048 + k * 1024); } while (0)
#define PG8_LDB(dst, b, h) do { _Pragma("unroll") for (int n = 0; n < 2; ++n) _Pragma("unroll") for (int k = 0; k < 2; ++k) dst[n][k] = *(const PG8_LAS bf16x8*)(lds + PG8_SB(b, h) + boff + n * 2048 + k * 1024); } while (0)
#define PG8_MMA(ai, bj, At, Bt) do { __builtin_amdgcn_s_setprio(1); _Pragma("unroll") for (int m = 0; m < 4; ++m) _Pragma("unroll") for (int n = 0; n < 2; ++n) _Pragma("unroll") for (int k = 0; k < 2; ++k) \
        acc[ai][bj][m][n] = __builtin_amdgcn_mfma_f32_16x16x32_bf16(Bt[n][k], At[m][k], acc[ai][bj][m][n], 0, 0, 0); __builtin_amdgcn_s_setprio(0); } while (0)
#define PG8_WAIT_V(n) asm volatile("s_waitcnt vmcnt(" #n ")" ::: "memory")
#define PG8_WAIT_L(n) asm volatile("s_waitcnt lgkmcnt(" #n ")" ::: "memory")
#define PG8_BAR __builtin_amdgcn_s_barrier()
#define PG8_SCHED __builtin_amdgcn_sched_barrier(0)
    Unit cur, nxt; int ui = 0;
    if (!S.next(0, cur)) return;
    f32x4 acc[2][2][4][2];
#pragma unroll
    for (int a = 0; a < 2; ++a)
#pragma unroll
        for (int b = 0; b < 2; ++b)
#pragma unroll
            for (int m = 0; m < 4; ++m)
#pragma unroll
                for (int n = 0; n < 2; ++n) acc[a][b][m][n] = (f32x4){0.f, 0.f, 0.f, 0.f};
    bf16x8 At[4][2], B0[2][2], B1[2][2];
    const char* cA = (const char*)g.A + (size_t)cur.pm * tstep; const char* cB = (const char*)g.Bt + (size_t)cur.pn * tstep;
    S.a_ready(cur);
    if constexpr (SP2) {
        PG8_STAGE(PG8_SB(0, 0), cB, voffB); PG8_STAGE(PG8_SB(0, 1), cB + hstep, voffB); PG8_STAGE(PG8_SA(0, 0), cA, voffA); PG8_STAGE(PG8_SA(0, 1), cA + hstep, voffA);
        if (wr == 1) PG8_BAR;
        PG8_WAIT_V(2); PG8_BAR;
        PG8_STAGE(PG8_SB(1, 0), cB + kstep, voffB); PG8_STAGE(PG8_SA(1, 0), cA + kstep, voffA); PG8_STAGE(PG8_SB(1, 1), cB + hstep + kstep, voffB);
        PG8_WAIT_V(6); PG8_BAR;
    } else {
        PG8_STAGE(PG8_SB(0, 0), cB, voffB); PG8_STAGE(PG8_SA(0, 0), cA, voffA); PG8_STAGE(PG8_SB(0, 1), cB + hstep, voffB); PG8_STAGE(PG8_SA(0, 1), cA + hstep, voffA);
        if (wr == 1) PG8_BAR;
        PG8_WAIT_V(4); PG8_BAR;
        PG8_STAGE(PG8_SB(1, 0), cB + kstep, voffB); PG8_STAGE(PG8_SA(1, 0), cA + kstep, voffA); PG8_STAGE(PG8_SB(1, 1), cB + hstep + kstep, voffB);
        PG8_WAIT_V(6); PG8_BAR;
    }
    for (;;) {
        const bool has_next = S.next(ui + 1, nxt);
        const char* nA = has_next ? (const char*)g.A + (size_t)nxt.pm * tstep : cA; const char* nB = has_next ? (const char*)g.Bt + (size_t)nxt.pn * tstep : cB;
        for (int t = 0; t < nt; t += 2) {
            const bool last = (t == nt - 2);
            const char* a1 = cA + (size_t)(t + 1) * kstep;
            const char* a2 = last ? nA : cA + (size_t)(t + 2) * kstep; const char* b2 = last ? nB : cB + (size_t)(t + 2) * kstep;
            const char* a3 = a2 + kstep; const char* b3 = b2 + kstep;
            if (last && has_next) S.a_ready(nxt);
            if constexpr (SP2) {
            PG8_LDB(B0, 0, 0); PG8_LDB(B1, 0, 1); PG8_SCHED; PG8_LDA(At, 0, 0); PG8_STAGE(PG8_SA(1, 1), a1 + hstep, voffA);
            PG8_WAIT_V(8); PG8_WAIT_L(0); PG8_BAR; PG8_MMA(0, 0, At, B0); PG8_MMA(0, 1, At, B1); PG8_BAR; PG8_SCHED;
            PG8_LDA(At, 0, 1); PG8_STAGE(PG8_SB(0, 0), b2, voffB); PG8_STAGE(PG8_SB(0, 1), b2 + hstep, voffB); PG8_STAGE(PG8_SA(0, 0), a2, voffA);
            PG8_WAIT_V(8); PG8_WAIT_L(0); PG8_BAR; PG8_MMA(1, 0, At, B0); PG8_MMA(1, 1, At, B1); PG8_BAR; PG8_SCHED;
            PG8_LDB(B0, 1, 0); PG8_LDB(B1, 1, 1); PG8_SCHED; PG8_LDA(At, 1, 0); PG8_STAGE(PG8_SA(0, 1), a2 + hstep, voffA);
            PG8_WAIT_V(8); PG8_WAIT_L(0); PG8_BAR; PG8_MMA(0, 0, At, B0); PG8_MMA(0, 1, At, B1); PG8_BAR; PG8_SCHED;
            PG8_LDA(At, 1, 1); PG8_STAGE(PG8_SB(1, 0), b3, voffB); PG8_STAGE(PG8_SB(1, 1), b3 + hstep, voffB); PG8_STAGE(PG8_SA(1, 0), a3, voffA);
            PG8_WAIT_V(8); PG8_WAIT_L(0); PG8_BAR; PG8_MMA(1, 0, At, B0); PG8_MMA(1, 1, At, B1); PG8_BAR; PG8_SCHED;
            } else {
            PG8_LDB(B0, 0, 0); PG8_SCHED; PG8_LDA(At, 0, 0); PG8_STAGE(PG8_SA(1, 1), a1 + hstep, voffA);
            PG8_WAIT_L(8); PG8_BAR; PG8_WAIT_L(0); PG8_MMA(0, 0, At, B0); PG8_BAR; PG8_SCHED;
            PG8_LDB(B1, 0, 1); PG8_STAGE(PG8_SB(0, 0), b2, voffB);
            PG8_BAR; PG8_WAIT_L(0); PG8_MMA(0, 1, At, B1); PG8_BAR;
            PG8_LDA(At, 0, 1); PG8_STAGE(PG8_SA(0, 0), a2, voffA);
            PG8_BAR; PG8_WAIT_L(0); PG8_MMA(1, 0, At, B0); PG8_BAR; PG8_SCHED;
            PG8_STAGE(PG8_SB(0, 1), b2 + hstep, voffB);
            PG8_WAIT_V(6); PG8_BAR; PG8_MMA(1, 1, At, B1); PG8_BAR;
            PG8_LDB(B0, 1, 0); PG8_SCHED; PG8_LDA(At, 1, 0); PG8_STAGE(PG8_SA(0, 1), a2 + hstep, voffA);
            PG8_WAIT_L(8); PG8_BAR; PG8_WAIT_L(0); PG8_MMA(0, 0, At, B0); PG8_BAR; PG8_SCHED;
            PG8_LDB(B1, 1, 1); PG8_STAGE(PG8_SB(1, 0), b3, voffB);
            PG8_BAR; PG8_WAIT_L(0); PG8_MMA(0, 1, At, B1); PG8_BAR;
            PG8_LDA(At, 1, 1); PG8_STAGE(PG8_SA(1, 0), a3, voffA);
            PG8_BAR; PG8_WAIT_L(0); PG8_MMA(1, 0, At, B0); PG8_BAR; PG8_SCHED;
            PG8_STAGE(PG8_SB(1, 1), b3 + hstep, voffB);
            PG8_WAIT_V(6); PG8_BAR; PG8_MMA(1, 1, At, B1); PG8_BAR;
            }
        }
        if constexpr (ALIGN_EPI) { if (wr == 0) PG8_BAR; }
        if constexpr (!Epi::AFTER_DRAIN) { E(acc, cur, wr, wc, fr, fq); S.done(cur); }
        if (!has_next) break;
#pragma unroll
        for (int a = 0; a < 2; ++a)
#pragma unroll
            for (int b = 0; b < 2; ++b)
#pragma unroll
                for (int m = 0; m < 4; ++m)
#pragma unroll
                    for (int n = 0; n < 2; ++n) acc[a][b][m][n] = (f32x4){0.f, 0.f, 0.f, 0.f};
        cur = nxt; cA = nA; cB = nB; ++ui;
        if constexpr (ALIGN_EPI) { if (wr == 1) PG8_BAR; }
    }
    PG8_WAIT_V(0);
    if constexpr (!ALIGN_EPI) { if (wr == 0) PG8_BAR; }
    PG8_BAR;
    if constexpr (Epi::AFTER_DRAIN) { E.fused(acc, cur, wr, wc, fr, fq, lds, wid, lane); S.done(cur); }
#undef PG8_SA
#undef PG8_SB
#undef PG8_STAGE
#undef PG8_LDA
#undef PG8_LDB
#undef PG8_MMA
#undef PG8_WAIT_V
#undef PG8_WAIT_L
#undef PG8_BAR
#undef PG8_SCHED
}
}
namespace cg = cooperative_groups;
#define LAS __attribute__((address_space(3)))
typedef unsigned short bf16;
typedef float f32x4 __attribute__((ext_vector_type(4)));
typedef float f32x8 __attribute__((ext_vector_type(8)));
typedef float f32x16 __attribute__((ext_vector_type(16)));
typedef unsigned u32x4 __attribute__((ext_vector_type(4)));
typedef unsigned u32x2 __attribute__((ext_vector_type(2)));
typedef short bf16x8 __attribute__((ext_vector_type(8)));
typedef short s16x4 __attribute__((ext_vector_type(4)));

constexpr int BATCH = 16, SEQ = 2048, DM = 1024, T = BATCH * SEQ;
constexpr int NP = 3072;
constexpr int IN_COLS = 3012;
constexpr int C_QA = 0, C_KA = 512, C_VA = 1024, C_QB = 1536, C_KV = 2560, C_QI = 2688, C_KI = 2944, C_WI = 3008;
constexpr int MIXW = 1536;
constexpr int NEXP = 16384;
constexpr float EPS = 1e-6f;
constexpr int NT = 512;
constexpr int NWV = 8;

constexpr size_t MiB = 1u << 20;
constexpr size_t WS_CTL = 0;
constexpr size_t CTL_BYTES = 64 * 1024;
constexpr size_t WS_MOD = 1 * MiB;
constexpr size_t WS_SCAL = WS_MOD + 512 * 1024;
constexpr size_t WS_WIN = 2 * MiB;
constexpr size_t WS_WO2 = 8 * MiB;
constexpr size_t WS_WQ = 11 * MiB;
constexpr size_t WS_SUBK = 13 * MiB;
constexpr size_t WS_U16 = 14 * MiB;
constexpr size_t WS_V16 = 46 * MiB;
constexpr size_t WS_H = 78 * MiB;
constexpr size_t WS_PROJ = 142 * MiB;
constexpr size_t WS_Q3 = WS_PROJ;
constexpr size_t WS_MIX = 334 * MiB;
constexpr size_t WS_EXP = 430 * MiB;
constexpr size_t WS_GATE = 446 * MiB;
constexpr size_t WS_END = 462 * MiB;

struct Params {
    const float *x, *c, *ada_w, *ada_b, *norm1_g, *norm2_g, *w_in, *a_qk_gain, *a_lambda, *a_sub_gain, *b_q_gain, *b_kv_gain, *b_w_uv, *w_out, *peer_wq, *peer_subkeys, *peer_u, *peer_v;
    float* out; unsigned char* ws;
};

enum { SC_LAM = 0, SC_MA = 1, SC_MB = 2 };

__device__ __forceinline__ unsigned f2bf(float f) { unsigned u = __float_as_uint(f); return (u + 0x7fffu + ((u >> 16) & 1u)) >> 16; }
__device__ __forceinline__ float bf2f(unsigned h) { return __uint_as_float(h << 16); }
__device__ __forceinline__ unsigned pk2(float lo, float hi) { return f2bf(lo) | (f2bf(hi) << 16); }
__device__ __forceinline__ float bflo(unsigned w) { return __uint_as_float(w << 16); }
__device__ __forceinline__ float bfhi(unsigned w) { return __uint_as_float(w & 0xffff0000u); }
__device__ __forceinline__ float wave_sum(float v) {
#pragma unroll
    for (int o = 1; o < 64; o <<= 1) v += __shfl_xor(v, o);
    return v;
}
__device__ __forceinline__ float wave_max(float v) {
#pragma unroll
    for (int o = 1; o < 64; o <<= 1) v = fmaxf(v, __shfl_xor(v, o));
    return v;
}
#define LDS_WAIT() asm volatile("s_waitcnt lgkmcnt(0)" ::: "memory")
__device__ __forceinline__ void ph_mod(const Params& p, float* ldsf, int vb, int nvb) {
    if (vb >= 12) return;
    const int tid = threadIdx.x;
    for (int i = tid; i < 16 * 1024; i += NT) { const float v = p.c[i]; ldsf[i] = v / (1.f + __expf(-v)); }
    __syncthreads();
    float* MOD = (float*)(p.ws + WS_MOD);
    for (int it = vb; it < 12; it += nvb) {
        const int j = it * 512 + tid;
        float acc[16];
#pragma unroll
        for (int b = 0; b < 16; ++b) acc[b] = 0.f;
        for (int k = 0; k < 1024; ++k) {
            const float w = p.ada_w[(size_t)k * 6144 + j];
#pragma unroll
            for (int b = 0; b < 16; ++b) acc[b] = fmaf(ldsf[b * 1024 + k], w, acc[b]);
        }
        const float bb = p.ada_b[j];
#pragma unroll
        for (int b = 0; b < 16; ++b) MOD[b * 6144 + j] = acc[b] + bb;
    }
    __syncthreads();
}

__device__ __forceinline__ void transpose_item(const float* W, int N, bf16* WT, int ldt, LAS float* scr, int kb, int nb, int lane) {
    const int k0 = 64 * kb, n0 = 32 * nb;
#pragma unroll 8
    for (int i = 0; i < 32; ++i) { const int kk = 2 * i + (lane >> 5); const int n = n0 + (lane & 31); scr[kk * 33 + (lane & 31)] = (n < N) ? W[(size_t)(k0 + kk) * N + n] : 0.f; }
    LDS_WAIT(); asm volatile("" ::: "memory");
    const int c = lane & 7;
#pragma unroll
    for (int j = 0; j < 4; ++j) { const int n = (lane >> 3) + 8 * j; const LAS float* s = scr + (8 * c) * 33 + n;
        u32x4 o; o.x = pk2(s[0 * 33], s[1 * 33]); o.y = pk2(s[2 * 33], s[3 * 33]); o.z = pk2(s[4 * 33], s[5 * 33]); o.w = pk2(s[6 * 33], s[7 * 33]);
        *(u32x4*)(WT + (size_t)(n0 + n) * ldt + k0 + 8 * c) = o; }
    LDS_WAIT(); asm volatile("" ::: "memory");
}

__device__ __forceinline__ void ph_prep_weights(const Params& p, LAS float* scr, int gw, int ngw, int lane) {
    bf16* WIN = (bf16*)(p.ws + WS_WIN); bf16* WO2 = (bf16*)(p.ws + WS_WO2); bf16* WQ = (bf16*)(p.ws + WS_WQ);
    constexpr int I_IN = 16 * 96, I_O = 8 * 32, I_Q = 16 * 32;
    for (int it = gw; it < I_IN + I_O + I_Q; it += ngw) {
        int r = it;
        if (r < I_IN) { transpose_item(p.w_in, IN_COLS, WIN, 1024, scr, r / 96, r % 96, lane); continue; } r -= I_IN;
        if (r < I_O) { transpose_item(p.w_out, 1024, WO2, MIXW, scr, r / 32, r % 32, lane); continue; } r -= I_O;
        transpose_item(p.peer_wq, 1024, WQ, 1024, scr, r / 32, r % 32, lane);
    }
    const size_t gt = (size_t)gw * 64 + lane, ngt = (size_t)ngw * 64;
    for (size_t i = gt; i < (size_t)1024 * 1024; i += ngt) {
        const int n = (int)(i & 1023), kk = (int)(i >> 10), h = kk >> 7;
        const float* wu = p.b_w_uv + (size_t)kk * 64; const float* wo = p.w_out + (size_t)(512 + 64 * h) * 1024 + n;
        float a = 0.f;
#pragma unroll 8
        for (int e = 0; e < 64; ++e) a = fmaf(wu[e], wo[(size_t)e * 1024], a);
        WO2[(size_t)n * MIXW + 512 + kk] = (bf16)f2bf(a);
    }
    bf16* U16 = (bf16*)(p.ws + WS_U16); bf16* V16 = (bf16*)(p.ws + WS_V16); bf16* SUBK = (bf16*)(p.ws + WS_SUBK);
    constexpr size_t NTAB8 = (size_t)NEXP * 1024 / 8, NSUB8 = 2 * 128 * 64 / 8;
    for (size_t i = gt; i < 2 * NTAB8 + NSUB8; i += ngt) {
        const float* src; bf16* dst; size_t j = i;
        if (j < NTAB8) { src = p.peer_u; dst = U16; } else if (j < 2 * NTAB8) { j -= NTAB8; src = p.peer_v; dst = V16; } else { j -= 2 * NTAB8; src = p.peer_subkeys; dst = SUBK; }
        const f32x8 v = *(const f32x8*)(src + j * 8);
        u32x4 o; o.x = pk2(v[0], v[1]); o.y = pk2(v[2], v[3]); o.z = pk2(v[4], v[5]); o.w = pk2(v[6], v[7]);
        *(u32x4*)(dst + j * 8) = o;
    }
    if (gt == 0) {
        float* SC = (float*)(p.ws + WS_SCAL);
        float s01 = 0.f, s23 = 0.f;
        for (int i = 0; i < 64; ++i) { s01 += p.a_lambda[i] * p.a_lambda[64 + i]; s23 += p.a_lambda[128 + i] * p.a_lambda[192 + i]; }
        SC[SC_LAM] = __expf(s01) - __expf(s23) + 0.2f;
        float g0 = 0.f, g1 = 0.f, gq = 0.f, gk = 0.f;
        for (int i = 0; i < 64; ++i) { g0 = fmaxf(g0, fabsf(p.a_qk_gain[i])); g1 = fmaxf(g1, fabsf(p.a_qk_gain[64 + i])); }
        for (int i = 0; i < 128; ++i) { gq = fmaxf(gq, fabsf(p.b_q_gain[i])); gk = fmaxf(gk, fabsf(p.b_kv_gain[i])); }
        SC[SC_MA] = 8.0f * g0 * g1 * 1.02f;
        SC[SC_MB] = 11.3137085f * gq * gk * 1.02f;
    }
}

__device__ __forceinline__ void ph_hrows(const Params& p, const float* X, const float* g, int shOff, int scOff, int gw, int ngw, int lane) {
    const float* MOD = (const float*)(p.ws + WS_MOD); bf16* H = (bf16*)(p.ws + WS_H);
    for (int m = gw; m < T; m += ngw) {
        const f32x4* xr = (const f32x4*)(X + (size_t)m * 1024) + lane;
        f32x4 v[4]; float s = 0.f;
#pragma unroll
        for (int j = 0; j < 4; ++j) { v[j] = xr[64 * j]; s += (v[j].x * v[j].x + v[j].y * v[j].y) + (v[j].z * v[j].z + v[j].w * v[j].w); }
        const float rstd = rsqrtf(wave_sum(s) * (1.f / 1024.f) + EPS);
        const float* mb = MOD + (size_t)(m >> 11) * 6144;
#pragma unroll
        for (int j = 0; j < 4; ++j) {
            const int col = 4 * (lane + 64 * j);
            const f32x4 gg = *(const f32x4*)(g + col), sc = *(const f32x4*)(mb + scOff + col), sh = *(const f32x4*)(mb + shOff + col);
            const f32x4 y = v[j] * rstd * gg * (sc + 1.0f) + sh;
            u32x2 o; o.x = pk2(y.x, y.y); o.y = pk2(y.z, y.w);
            *(u32x2*)(H + (size_t)m * 1024 + col) = o;
        }
    }
}

__device__ __forceinline__ void ph_norm_proj(const Params& p, int gw, int ngw, int lane) {
    bf16* PROJ = (bf16*)(p.ws + WS_PROJ);
    for (int m = gw; m < T; m += ngw) {
        bf16* row = PROJ + (size_t)m * NP;
#pragma unroll
        for (int j = 0; j < 6; ++j) {
            if (j == 2) continue;
            const int col = 8 * lane + 512 * j;
            const u32x4 raw = *(const u32x4*)(row + col);
            float v[8] = {bflo(raw.x), bfhi(raw.x), bflo(raw.y), bfhi(raw.y), bflo(raw.z), bfhi(raw.z), bflo(raw.w), bfhi(raw.w)};
            float ss = 0.f;
#pragma unroll
            for (int i = 0; i < 8; ++i) ss += v[i] * v[i];
            ss += __shfl_xor(ss, 1); ss += __shfl_xor(ss, 2); ss += __shfl_xor(ss, 4);
            float rstd; const float* gp;
            if (j < 2) { rstd = rsqrtf(ss * (1.f / 64.f) + EPS); gp = p.a_qk_gain + 64 * j + (col & 63); }
            else { ss += __shfl_xor(ss, 8); rstd = rsqrtf(ss * (1.f / 128.f) + EPS); gp = (j == 5 ? p.b_kv_gain : p.b_q_gain) + (col & 127); }
            if (j == 5 && lane >= 16) continue;
            const f32x4 g0 = *(const f32x4*)gp, g1 = *(const f32x4*)(gp + 4);
            u32x4 o; o.x = pk2(v[0] * rstd * g0.x, v[1] * rstd * g0.y); o.y = pk2(v[2] * rstd * g0.z, v[3] * rstd * g0.w);
            o.z = pk2(v[4] * rstd * g1.x, v[5] * rstd * g1.y); o.w = pk2(v[6] * rstd * g1.z, v[7] * rstd * g1.w);
            *(u32x4*)(row + col) = o;
        }
    }
}
__device__ void ph_attnA_naive(const Params& p, float* lds_w, int gw, int ngw, int lane) {
    const bf16* PROJ = (const bf16*)(p.ws + WS_PROJ); bf16* MIX = (bf16*)(p.ws + WS_MIX);
    const float lam = ((const float*)(p.ws + WS_SCAL))[SC_LAM];
    float* qs = lds_w; float* sc0 = lds_w + 128; float* sc1 = sc0 + 2048;
    for (int it = gw; it < BATCH * 4 * SEQ; it += ngw) {
        const int t = it & 2047, h = (it >> 11) & 3, b = it >> 13;
        const int cend = ((t >> 6) + 1) << 6;
        const float slope = exp2f(-2.0f * (h + 1));
        const bf16* qrow = PROJ + (size_t)(b * SEQ + t) * NP + C_QA + h * 128;
        qs[lane] = bf2f(qrow[lane]); qs[64 + lane] = bf2f(qrow[64 + lane]);
        LDS_WAIT(); asm volatile("" ::: "memory");
        float m0 = -3e38f, m1 = -3e38f;
        for (int kk = lane; kk < cend; kk += 64) {
            const bf16* krow = PROJ + (size_t)(b * SEQ + kk) * NP + C_KA + h * 128;
            float d0 = 0.f, d1 = 0.f;
            for (int d = 0; d < 64; ++d) { d0 = fmaf(qs[d], bf2f(krow[d]), d0); d1 = fmaf(qs[64 + d], bf2f(krow[64 + d]), d1); }
            const float bias = slope * fabsf((float)(t - kk));
            d0 = d0 * 0.125f - bias; d1 = d1 * 0.125f - bias;
            sc0[kk] = d0; sc1[kk] = d1; m0 = fmaxf(m0, d0); m1 = fmaxf(m1, d1);
        }
        m0 = wave_max(m0); m1 = wave_max(m1);
        float l0 = 0.f, l1 = 0.f;
        for (int kk = lane; kk < cend; kk += 64) { const float e0 = __expf(sc0[kk] - m0), e1 = __expf(sc1[kk] - m1); sc0[kk] = e0; sc1[kk] = e1; l0 += e0; l1 += e1; }
        l0 = wave_sum(l0); l1 = wave_sum(l1);
        const float i0 = 1.f / l0, i1 = lam / l1;
        for (int kk = lane; kk < cend; kk += 64) sc0[kk] = sc0[kk] * i0 - sc1[kk] * i1;
        LDS_WAIT(); asm volatile("" ::: "memory");
        float a0 = 0.f, a1 = 0.f;
        const bf16* vb = PROJ + (size_t)(b * SEQ) * NP + C_VA + h * 128;
        for (int kk = 0; kk < cend; ++kk) { const float a = sc0[kk]; const bf16* vr = vb + (size_t)kk * NP; a0 = fmaf(a, bf2f(vr[lane]), a0); a1 = fmaf(a, bf2f(vr[64 + lane]), a1); }
        const float ss = wave_sum(a0 * a0 + a1 * a1);
        const float rstd = rsqrtf(ss * (1.f / 128.f) + EPS) * 0.8f;
        bf16* orow = MIX + (size_t)(b * SEQ + t) * MIXW + h * 128;
        orow[lane] = (bf16)f2bf(a0 * rstd * p.a_sub_gain[lane]); orow[64 + lane] = (bf16)f2bf(a1 * rstd * p.a_sub_gain[64 + lane]);
        LDS_WAIT(); asm volatile("" ::: "memory");
    }
}

__device__ void ph_dsa_naive(const Params& p, float* lds, int vb, int nvb) {
    const bf16* PROJ = (const bf16*)(p.ws + WS_PROJ); bf16* MIX = (bf16*)(p.ws + WS_MIX);
    const int tid = threadIdx.x, lane = tid & 63, wv = tid >> 6;
    float* scores = lds; int* sel = (int*)(lds + 2048); float* qi = lds + 2048 + 256; float* wi = qi + 256;
    float* qh = wi + 64 + wv * 384; float* pw = qh + 128;
    for (int it = vb; it < T; it += nvb) {
        const int b = it >> 11, t = it & 2047; const int cend = ((t >> 6) + 1) << 6;
        const bf16* row = PROJ + (size_t)it * NP;
        if (tid < 256) qi[tid] = bf2f(row[C_QI + tid]);
        if (tid < 4) wi[tid] = bf2f(row[C_WI + tid]);
        __syncthreads();
        for (int kk = tid; kk < cend; kk += NT) {
            const bf16* kr = PROJ + (size_t)(b * SEQ + kk) * NP + C_KI;
            float s = 0.f;
            for (int h = 0; h < 4; ++h) { float d = 0.f; for (int e = 0; e < 64; ++e) d = fmaf(qi[h * 64 + e], bf2f(kr[e]), d); s += fmaxf(d, 0.f) * wi[h]; }
            scores[kk] = s * 0.0625f;
        }
        __syncthreads();
        int nvalid;
        if (cend <= 256) { if (tid < 256) sel[tid] = tid; nvalid = cend; }
        else {
            for (int i = tid; i < cend; i += NT) { const float si = scores[i]; int rank = 0;
                for (int j = 0; j < cend; ++j) { const float sj = scores[j]; rank += (sj > si || (sj == si && j < i)) ? 1 : 0; }
                if (rank < 256) sel[rank] = i; }
            nvalid = 256;
        }
        __syncthreads();
        {
            const int h = wv; const float slope = exp2f(-(float)(h + 1));
            qh[lane] = bf2f(row[C_QB + h * 128 + lane]); qh[64 + lane] = bf2f(row[C_QB + h * 128 + 64 + lane]);
            LDS_WAIT(); asm volatile("" ::: "memory");
            float sv[4]; float mx = -3e38f;
#pragma unroll
            for (int jj = 0; jj < 4; ++jj) { const int j = lane + 64 * jj; const int key = sel[j < nvalid ? j : 0];
                const bf16* kv = PROJ + (size_t)(b * SEQ + key) * NP + C_KV; float d = 0.f;
                for (int e = 0; e < 128; ++e) d = fmaf(qh[e], bf2f(kv[e]), d);
                d = d * 0.0883883476f - slope * fabsf((float)(t - key));
                sv[jj] = (j < nvalid) ? d : -3e38f; mx = fmaxf(mx, sv[jj]); }
            mx = wave_max(mx); float l = 0.f;
#pragma unroll
            for (int jj = 0; jj < 4; ++jj) { const int j = lane + 64 * jj; const float e = (j < nvalid) ? __expf(sv[jj] - mx) : 0.f; pw[j] = e; l += e; }
            l = wave_sum(l);
            LDS_WAIT(); asm volatile("" ::: "memory");
            float a0 = 0.f, a1 = 0.f;
            for (int j = 0; j < nvalid; ++j) { const float pj = pw[j]; const bf16* kv = PROJ + (size_t)(b * SEQ + sel[j]) * NP + C_KV; a0 = fmaf(pj, bf2f(kv[lane]), a0); a1 = fmaf(pj, bf2f(kv[64 + lane]), a1); }
            const float il = 1.f / l;
            bf16* orow = MIX + (size_t)it * MIXW + 512 + h * 128;
            orow[lane] = (bf16)f2bf(a0 * il); orow[64 + lane] = (bf16)f2bf(a1 * il);
        }
        __syncthreads();
    }
}

__device__ void ph_route_naive(const Params& p, float* lds, int vb, int nvb) {
    const bf16* Q3 = (const bf16*)(p.ws + WS_Q3); const bf16* SUBK = (const bf16*)(p.ws + WS_SUBK);
    int* EXPI = (int*)(p.ws + WS_EXP); float* GATE = (float*)(p.ws + WS_GATE);
    const int tid = threadIdx.x;
    float* q = lds; float* sub = q + 1024; float* sv = sub + 2048; int* si = (int*)(sv + 256); float* cand = sv + 512; float* ts = cand + 2048; int* te = (int*)(ts + 128);
    for (int it = vb; it < T; it += nvb) {
        q[tid] = bf2f(Q3[(size_t)it * 1024 + tid]); q[tid + 512] = bf2f(Q3[(size_t)it * 1024 + tid + 512]);
        __syncthreads();
        for (int r = 0; r < 4; ++r) { const int idx = tid + 512 * r, h = idx >> 8, c = (idx >> 7) & 1, n = idx & 127;
            const float* qq = q + h * 128 + c * 64; const bf16* kk = SUBK + (size_t)(c * 128 + n) * 64; float d = 0.f;
            for (int e = 0; e < 64; ++e) d = fmaf(qq[e], bf2f(kk[e]), d);
            sub[idx] = d; }
        __syncthreads();
        for (int r = 0; r < 4; ++r) { const int idx = tid + 512 * r, g0 = idx & ~127, n = idx & 127; const float s = sub[idx]; int rank = 0;
            for (int j = 0; j < 128; ++j) { const float sj = sub[g0 + j]; rank += (sj > s || (sj == s && j < n)) ? 1 : 0; }
            if (rank < 16) { sv[(g0 >> 7) * 16 + rank] = s; si[(g0 >> 7) * 16 + rank] = n; } }
        __syncthreads();
        for (int r = 0; r < 4; ++r) { const int idx = tid + 512 * r, h = idx >> 8, i = (idx >> 4) & 15, j = idx & 15; cand[idx] = sv[(h * 2) * 16 + i] + sv[(h * 2 + 1) * 16 + j]; }
        __syncthreads();
        for (int r = 0; r < 4; ++r) { const int idx = tid + 512 * r, h = idx >> 8, ij = idx & 255; const float s = cand[idx]; int rank = 0;
            for (int j = 0; j < 256; ++j) { const float sj = cand[h * 256 + j]; rank += (sj > s || (sj == s && j < ij)) ? 1 : 0; }
            if (rank < 16) { ts[h * 16 + rank] = s; te[h * 16 + rank] = si[(h * 2) * 16 + (ij >> 4)] * 128 + si[(h * 2 + 1) * 16 + (ij & 15)]; } }
        __syncthreads();
        if (tid < 128) { const int h = tid >> 4; const float mx = ts[h * 16]; float l = 0.f;
            for (int k = 0; k < 16; ++k) l += __expf(ts[h * 16 + k] - mx);
            GATE[(size_t)it * 128 + tid] = __expf(ts[tid] - mx) / l; EXPI[(size_t)it * 128 + tid] = te[tid]; }
        __syncthreads();
    }
}

__device__ void ph_peer_naive(const Params& p, float* lds, int vb, int nvb) {
    const bf16* H = (const bf16*)(p.ws + WS_H); const bf16* U16 = (const bf16*)(p.ws + WS_U16); const bf16* V16 = (const bf16*)(p.ws + WS_V16);
    const int* EXPI = (const int*)(p.ws + WS_EXP); const float* GATE = (const float*)(p.ws + WS_GATE); const float* MOD = (const float*)(p.ws + WS_MOD);
    const int tid = threadIdx.x, lane = tid & 63, wv = tid >> 6;
    float* xs = lds; float* coef = lds + 1024; int* ex = (int*)(coef + 128);
    for (int it = vb; it < T; it += nvb) {
        xs[tid] = bf2f(H[(size_t)it * 1024 + tid]); xs[tid + 512] = bf2f(H[(size_t)it * 1024 + tid + 512]);
        if (tid < 128) ex[tid] = EXPI[(size_t)it * 128 + tid];
        __syncthreads();
        for (int jj = 0; jj < 16; ++jj) { const int j = wv * 16 + jj; const bf16* ur = U16 + (size_t)ex[j] * 1024; float d = 0.f;
            for (int i = 0; i < 16; ++i) d = fmaf(xs[lane + 64 * i], bf2f(ur[lane + 64 * i]), d);
            d = wave_sum(d);
            if (lane == 0) coef[j] = 0.5f * d * (1.f + erff(d * 0.70710678f)) * GATE[(size_t)it * 128 + j]; }
        __syncthreads();
        const float* g2 = MOD + (size_t)(it >> 11) * 6144 + 5120;
        for (int r = 0; r < 2; ++r) { const int d = tid + 512 * r; float a = 0.f;
            for (int j = 0; j < 128; ++j) a = fmaf(coef[j], bf2f(V16[(size_t)ex[j] * 1024 + d]), a);
            p.out[(size_t)it * 1024 + d] = p.out[(size_t)it * 1024 + d] + g2[d] * a; }
        __syncthreads();
    }
}
struct EpiResGate {
    static constexpr bool PERM = false, AFTER_DRAIN = false;
    const float* X; float* Out; const float* gate;
    __device__ __forceinline__ void operator()(const pg8::f32x4 (&acc)[2][2][4][2], const pg8::Unit& u, int wr, int wc, int fr, int fq) const {
        const int col0 = u.pn * 256 + wc * 32 + 4 * fq;
#pragma unroll
        for (int ai = 0; ai < 2; ++ai)
#pragma unroll
            for (int m = 0; m < 4; ++m) {
                const int r = u.pm * 256 + ai * 128 + wr * 64 + m * 16 + fr; const float* gb = gate + (size_t)(r >> 11) * 6144;
#pragma unroll
                for (int bj = 0; bj < 2; ++bj)
#pragma unroll
                    for (int n = 0; n < 2; ++n) { const int c = col0 + bj * 128 + n * 16; const size_t off = (size_t)r * 1024 + c;
                        const pg8::f32x4 xv = *(const pg8::f32x4*)(X + off), gv = *(const pg8::f32x4*)(gb + c);
                        *(pg8::f32x4*)(Out + off) = xv + gv * acc[ai][bj][m][n]; }
            }
    }
};

constexpr int LDS_BYTES = 147456;
extern __shared__ __attribute__((aligned(16))) unsigned char dyn_lds[];

__global__ void __launch_bounds__(NT, 2) mega_fwd(Params p) {
    cg::grid_group grid = cg::this_grid();
    const int tid = threadIdx.x, lane = tid & 63, wv = tid >> 6;
    const int vb = blockIdx.x, nvb = gridDim.x, gw = vb * NWV + wv, ngw = nvb * NWV;
    ph_mod(p, (float*)dyn_lds, vb, nvb);
    ph_prep_weights(p, (LAS float*)dyn_lds + wv * (64 * 33), gw, ngw, lane);
    grid.sync();
    ph_hrows(p, p.x, p.norm1_g, 0, 1024, gw, ngw, lane);
    grid.sync();
    {   pg8::Gemm g{(const bf16*)(p.ws + WS_H), (const bf16*)(p.ws + WS_WIN), T, NP, 1024}; pg8::StaticOrder S; S.init(T, NP, nvb, vb);
        pg8::EpiBf16<0> E{(bf16*)(p.ws + WS_PROJ), NP, nullptr, 0, 0, 1.f};
        pg8::gemm_phase<pg8::EpiBf16<0>, pg8::StaticOrder, true, true>((LAS unsigned char*)dyn_lds, g, S, E); }
    grid.sync();
    ph_norm_proj(p, gw, ngw, lane);
    grid.sync();
    ph_attnA_naive(p, (float*)dyn_lds + wv * (128 + 4096), gw, ngw, lane);
    __syncthreads();
    ph_dsa_naive(p, (float*)dyn_lds, vb, nvb);
    grid.sync();
    {   pg8::Gemm g{(const bf16*)(p.ws + WS_MIX), (const bf16*)(p.ws + WS_WO2), T, 1024, MIXW}; pg8::StaticOrder S; S.init(T, 1024, nvb, vb);
        EpiResGate E{p.x, p.out, (const float*)(p.ws + WS_MOD) + 2048};
        pg8::gemm_phase<EpiResGate, pg8::StaticOrder, true, true>((LAS unsigned char*)dyn_lds, g, S, E); }
    grid.sync();
    ph_hrows(p, p.out, p.norm2_g, 3072, 4096, gw, ngw, lane);
    grid.sync();
    {   pg8::Gemm g{(const bf16*)(p.ws + WS_H), (const bf16*)(p.ws + WS_WQ), T, 1024, 1024}; pg8::StaticOrder S; S.init(T, 1024, nvb, vb);
        pg8::EpiBf16<0> E{(bf16*)(p.ws + WS_Q3), 1024, nullptr, 0, 0, 1.f};
        pg8::gemm_phase<pg8::EpiBf16<0>, pg8::StaticOrder, true, true>((LAS unsigned char*)dyn_lds, g, S, E); }
    grid.sync();
    ph_route_naive(p, (float*)dyn_lds, vb, nvb);
    grid.sync();
    ph_peer_naive(p, (float*)dyn_lds, vb, nvb);
}

extern "C" void kernel_launch(void* const* d_in, const int* in_sizes, int n_in, void* d_out, int out_size, void* d_ws, size_t ws_size, hipStream_t stream) {
    static int grid_blocks = 0;
    if (grid_blocks == 0) {
        if (n_in != 18 || in_sizes[0] != T * DM || out_size != T * DM || ws_size < WS_END) { fprintf(stderr, "kernel_launch: unexpected shapes n_in %d in0 %d out %d ws %zu\n", n_in, n_in > 0 ? in_sizes[0] : -1, out_size, ws_size); grid_blocks = -1; return; }
        int dev = 0, cus = 0, per_cu = 0;
        (void)hipGetDevice(&dev);
        (void)hipDeviceGetAttribute(&cus, hipDeviceAttributeMultiprocessorCount, dev);
        (void)hipFuncSetAttribute((const void*)mega_fwd, hipFuncAttributeMaxDynamicSharedMemorySize, LDS_BYTES);
        (void)hipOccupancyMaxActiveBlocksPerMultiprocessor(&per_cu, (const void*)mega_fwd, NT, LDS_BYTES);
        if (per_cu < 1 || cus < 1) { fprintf(stderr, "kernel_launch: occupancy query gave %d blocks/CU on %d CUs\n", per_cu, cus); grid_blocks = -1; return; }
        grid_blocks = cus;
    }
    if (grid_blocks < 0) return;
    Params p{};
    const float** pp = (const float**)&p;
    for (int i = 0; i < 18; ++i) pp[i] = (const float*)d_in[i];
    p.out = (float*)d_out; p.ws = (unsigned char*)d_ws;
    void* args[] = {&p};
    const hipError_t e = hipLaunchCooperativeKernel((const void*)mega_fwd, dim3(grid_blocks), dim3(NT), args, LDS_BYTES, stream);
    if (e != hipSuccess) fprintf(stderr, "kernel_launch: cooperative launch failed: %s (grid %d)\n", hipGetErrorString(e), grid_blocks);
}
```

```cpp
#include <hip/hip_runtime.h>
#include <hip/hip_cooperative_groups.h>
#include <cstdio>
#include <cstdint>
#include <cmath>
namespace pg8 {
#define PG8_LAS __attribute__((address_space(3)))
typedef unsigned short bf16_t;
typedef short bf16x8 __attribute__((ext_vector_type(8)));
typedef float f32x4 __attribute__((ext_vector_type(4)));
typedef unsigned u32x4 __attribute__((ext_vector_type(4)));
constexpr int BM = 256, BK = 64, HALF = 128, HTB = HALF * BK * 2  , STAGE_BYTES = 8 * HTB, NXCD = 8, WGM = 8;

__host__ __device__ __forceinline__ int lds_byte(int r, int c) { const int st = (r >> 4) * 2 + (c >> 5), rr = r & 15, cc = c & 31, ob = rr * 64 + cc * 2; return st * 1024 + (ob ^ (((ob >> 9) & 1) << 5)); }
__host__ __device__ __forceinline__ void stage_rc(int b, int& R, int& C) { const int st = b / 1024, sb = b % 1024, swz = sb ^ (((sb >> 9) & 1) << 5); R = (st >> 1) * 16 + swz / 64; C = (st & 1) * 32 + (swz % 64) / 2; }
__host__ __device__ __forceinline__ int perm32(int rho) { const int n = rho >> 4, i = rho & 15; return 8 * (i >> 2) + 4 * n + (i & 3); }

struct Unit { int pm, pn; };
struct Gemm { const bf16_t* A; const bf16_t* Bt; int M, N, K; };

struct StaticOrder {
    int nM, nN, nwg, G, c;
    __host__ __device__ void init(int M, int N, int G_, int c_) { nM = M / BM; nN = N / BM; nwg = nM * nN; G = G_; c = c_; }
    __host__ __device__ bool next(int i, Unit& u) const {
        const long L = (long)i * G + c; if (L >= nwg) return false;
        int wgid = (int)L; { const int q = nwg / NXCD, r = nwg % NXCD, xcd = wgid % NXCD, off = wgid / NXCD; wgid = (xcd < r ? xcd * (q + 1) : r * (q + 1) + (xcd - r) * q) + off; }
        const int nig = WGM * nN, gid = wgid / nig, fm = gid * WGM, gsz = (nM - fm) < WGM ? (nM - fm) : WGM;
        u.pm = fm + ((wgid % nig) % gsz); u.pn = (wgid % nig) / gsz; return true;
    }
    __device__ __forceinline__ void a_ready(const Unit&) const {}
    __device__ __forceinline__ void done(const Unit&) const {}
};

__device__ __forceinline__ unsigned cvt_pk_bf16(float lo, float hi) { unsigned r; asm volatile("v_cvt_pk_bf16_f32 %0, %1, %2" : "=v"(r) : "v"(lo), "v"(hi)); return r; }
typedef float f32x2 __attribute__((ext_vector_type(2)));
__device__ __forceinline__ f32x2 gelu_pk(f32x2 v) {
    const f32x2 av = __builtin_elementwise_abs(v), d = av * 0.2316418882f + 1.0f;
    f32x2 t; t.x = __builtin_amdgcn_rcpf(d.x); t.y = __builtin_amdgcn_rcpf(d.y);
    f32x2 q = t * 0.5307027145f + (-0.7265760135f); q = q * t + 0.7107068705f; q = q * t + (-0.142248368f); q = q * t + 0.127414796f; q = q * t;
    const f32x2 s = (v * v) * (-0.72134752044f);
    f32x2 e; e.x = __builtin_amdgcn_exp2f(s.x); e.y = __builtin_amdgcn_exp2f(s.y);
    const f32x2 m = v * (q * e), r = v - m;
    f32x2 o; o.x = v.x < 0.f ? m.x : r.x; o.y = v.y < 0.f ? m.y : r.y; return o;
}

template <int ACT  > struct EpiBf16 {
    static constexpr bool PERM = true, AFTER_DRAIN = false; static_assert(ACT == 0 || ACT == 1, "EpiBf16: ACT is 0 (none) or 1 (gelu_pk)");
    bf16_t* O; int ldc; const float* bias; int split_cols; size_t split_stride; float scale0;
    __device__ __forceinline__ void operator()(const f32x4 (&acc)[2][2][4][2], const Unit& u, int wr, int wc, int fr, int fq) const {
        const int row0 = u.pm * BM + wr * 64 + fr; int colt = u.pn * BM; bf16_t* base = O;
        float sc = 1.f; if (split_cols) { const int t = colt / split_cols; base += (size_t)t * split_stride; colt -= t * split_cols; if (t == 0) sc = scale0; }
        const int col0 = colt + wc * 32 + 8 * fq, bcol0 = u.pn * BM + wc * 32 + 8 * fq;
        f32x4 bv[2][2];
#pragma unroll
        for (int bj = 0; bj < 2; ++bj)
#pragma unroll
            for (int n = 0; n < 2; ++n) bv[bj][n] = bias ? *(const f32x4*)(bias + bcol0 + bj * HALF + 4 * n) : (f32x4){0.f, 0.f, 0.f, 0.f};
#pragma unroll
        for (int ai = 0; ai < 2; ++ai)
#pragma unroll
            for (int m = 0; m < 4; ++m) { bf16_t* rowp = base + (size_t)(row0 + ai * HALF + m * 16) * ldc + col0;
#pragma unroll
                for (int bj = 0; bj < 2; ++bj) { f32x4 v0 = acc[ai][bj][m][0] + bv[bj][0], v1 = acc[ai][bj][m][1] + bv[bj][1];
                    if (ACT == 1) { f32x2 a = gelu_pk((f32x2){v0[0], v0[1]}), b = gelu_pk((f32x2){v0[2], v0[3]}), c = gelu_pk((f32x2){v1[0], v1[1]}), d = gelu_pk((f32x2){v1[2], v1[3]});
                        v0 = (f32x4){a.x, a.y, b.x, b.y}; v1 = (f32x4){c.x, c.y, d.x, d.y}; }
                    v0 = v0 * sc; v1 = v1 * sc; u32x4 w; w.x = cvt_pk_bf16(v0[0], v0[1]); w.y = cvt_pk_bf16(v0[2], v0[3]); w.z = cvt_pk_bf16(v1[0], v1[1]); w.w = cvt_pk_bf16(v1[2], v1[3]);
                    *(u32x4*)(rowp + bj * HALF) = w; } }
    }
};

template <class Epi, class Sched, bool ALIGN_EPI = false, bool SP2 = false>
__device__ __forceinline__ void gemm_phase(PG8_LAS unsigned char* lds, const Gemm g, const Sched& S, const Epi& E) {
    const int tid = threadIdx.x, wid = __builtin_amdgcn_readfirstlane(tid >> 6), lane = tid & 63, wr = wid >> 2, wc = wid & 3, fr = lane & 15, fq = lane >> 4;
    const int K = g.K, nt = K / BK;
    unsigned voffA[2], voffB[2];
#pragma unroll
    for (int i = 0; i < 2; ++i) { int R, C; stage_rc(tid * 16 + i * 8192, R, C); const int Rb = Epi::PERM ? ((R & ~31) + perm32(R & 31)) : R;
        voffA[i] = (unsigned)(R * K + C) * 2u; voffB[i] = (unsigned)(Rb * K + C) * 2u; }
    const size_t kstep = (size_t)(BK * 2);
    const size_t hstep = (size_t)HALF * K * 2;
    const size_t tstep = 2 * hstep;
    const unsigned ldsw = (unsigned)wid * 1024u;
    const int aoff = lds_byte(wr * 64 + fr, fq * 8), boff = lds_byte(wc * 32 + fr, fq * 8);
#define PG8_SA(b, h) (((b) * 2 + (h)) * HTB)
#define PG8_SB(b, h) ((4 + (b) * 2 + (h)) * HTB)
#define PG8_STAGE(bufoff, gbase, voff) do { _Pragma("unroll") for (int _i = 0; _i < 2; ++_i) \
        __builtin_amdgcn_global_load_lds((const unsigned*)((const char*)(gbase) + (voff)[_i]), (PG8_LAS unsigned*)(lds + (bufoff) + ldsw + _i * 8192), 16, 0, 0); } while (0)
#define PG8_LDA(dst, b, h) do { _Pragma("unroll") for (int m = 0; m < 4; ++m) _Pragma("unroll") for (int k = 0; k < 2; ++k) dst[m][k] = *(const PG8_LAS bf16x8*)(lds + PG8_SA(b, h) + aoff + m * 2048 + k * 1024); } while (0)
#define PG8_LDB(dst, b, h) do { _Pragma("unroll") for (int n = 0; n < 2; ++n) _Pragma("unroll") for (int k = 0; k < 2; ++k) dst[n][k] = *(const PG8_LAS bf16x8*)(lds + PG8_SB(b, h) + boff + n * 2048 + k * 1024); } while (0)
#define PG8_MMA(ai, bj, At, Bt) do { __builtin_amdgcn_s_setprio(1); _Pragma("unroll") for (int m = 0; m < 4; ++m) _Pragma("unroll") for (int n = 0; n < 2; ++n) _Pragma("unroll") for (int k = 0; k < 2; ++k) \
        acc[ai][bj][m][n] = __builtin_amdgcn_mfma_f32_16x16x32_bf16(Bt[n][k], At[m][k], acc[ai][bj][m][n], 0, 0, 0); __builtin_amdgcn_s_setprio(0); } while (0)
#define PG8_WAIT_V(n) asm volatile("s_waitcnt vmcnt(" #n ")" ::: "memory")
#define PG8_WAIT_L(n) asm volatile("s_waitcnt lgkmcnt(" #n ")" ::: "memory")
#define PG8_BAR __builtin_amdgcn_s_barrier()
#define PG8_SCHED __builtin_amdgcn_sched_barrier(0)
    Unit cur, nxt; int ui = 0;
    if (!S.next(0, cur)) return;
    f32x4 acc[2][2][4][2];
#pragma unroll
    for (int a = 0; a < 2; ++a)
#pragma unroll
        for (int b = 0; b < 2; ++b)
#pragma unroll
            for (int m = 0; m < 4; ++m)
#pragma unroll
                for (int n = 0; n < 2; ++n) acc[a][b][m][n] = (f32x4){0.f, 0.f, 0.f, 0.f};
    bf16x8 At[4][2], B0[2][2], B1[2][2];
    const char* cA = (const char*)g.A + (size_t)cur.pm * tstep; const char* cB = (const char*)g.Bt + (size_t)cur.pn * tstep;
    S.a_ready(cur);
    if constexpr (SP2) {
        PG8_STAGE(PG8_SB(0, 0), cB, voffB); PG8_STAGE(PG8_SB(0, 1), cB + hstep, voffB); PG8_STAGE(PG8_SA(0, 0), cA, voffA); PG8_STAGE(PG8_SA(0, 1), cA + hstep, voffA);
        if (wr == 1) PG8_BAR;
        PG8_WAIT_V(2); PG8_BAR;
        PG8_STAGE(PG8_SB(1, 0), cB + kstep, voffB); PG8_STAGE(PG8_SA(1, 0), cA + kstep, voffA); PG8_STAGE(PG8_SB(1, 1), cB + hstep + kstep, voffB);
        PG8_WAIT_V(6); PG8_BAR;
    } else {
        PG8_STAGE(PG8_SB(0, 0), cB, voffB); PG8_STAGE(PG8_SA(0, 0), cA, voffA); PG8_STAGE(PG8_SB(0, 1), cB + hstep, voffB); PG8_STAGE(PG8_SA(0, 1), cA + hstep, voffA);
        if (wr == 1) PG8_BAR;
        PG8_WAIT_V(4); PG8_BAR;
        PG8_STAGE(PG8_SB(1, 0), cB + kstep, voffB); PG8_STAGE(PG8_SA(1, 0), cA + kstep, voffA); PG8_STAGE(PG8_SB(1, 1), cB + hstep + kstep, voffB);
        PG8_WAIT_V(6); PG8_BAR;
    }
    for (;;) {
        const bool has_next = S.next(ui + 1, nxt);
        const char* nA = has_next ? (const char*)g.A + (size_t)nxt.pm * tstep : cA; const char* nB = has_next ? (const char*)g.Bt + (size_t)nxt.pn * tstep : cB;
        for (int t = 0; t < nt; t += 2) {
            const bool last = (t == nt - 2);
            const char* a1 = cA + (size_t)(t + 1) * kstep;
            const char* a2 = last ? nA : cA + (size_t)(t + 2) * kstep; const char* b2 = last ? nB : cB + (size_t)(t + 2) * kstep;
            const char* a3 = a2 + kstep; const char* b3 = b2 + kstep;
            if (last && has_next) S.a_ready(nxt);
            if constexpr (SP2) {
            PG8_LDB(B0, 0, 0); PG8_LDB(B1, 0, 1); PG8_SCHED; PG8_LDA(At, 0, 0); PG8_STAGE(PG8_SA(1, 1), a1 + hstep, voffA);
            PG8_WAIT_V(8); PG8_WAIT_L(0); PG8_BAR; PG8_MMA(0, 0, At, B0); PG8_MMA(0, 1, At, B1); PG8_BAR; PG8_SCHED;
            PG8_LDA(At, 0, 1); PG8_STAGE(PG8_SB(0, 0), b2, voffB); PG8_STAGE(PG8_SB(0, 1), b2 + hstep, voffB); PG8_STAGE(PG8_SA(0, 0), a2, voffA);
            PG8_WAIT_V(8); PG8_WAIT_L(0); PG8_BAR; PG8_MMA(1, 0, At, B0); PG8_MMA(1, 1, At, B1); PG8_BAR; PG8_SCHED;
            PG8_LDB(B0, 1, 0); PG8_LDB(B1, 1, 1); PG8_SCHED; PG8_LDA(At, 1, 0); PG8_STAGE(PG8_SA(0, 1), a2 + hstep, voffA);
            PG8_WAIT_V(8); PG8_WAIT_L(0); PG8_BAR; PG8_MMA(0, 0, At, B0); PG8_MMA(0, 1, At, B1); PG8_BAR; PG8_SCHED;
            PG8_LDA(At, 1, 1); PG8_STAGE(PG8_SB(1, 0), b3, voffB); PG8_STAGE(PG8_SB(1, 1), b3 + hstep, voffB); PG8_STAGE(PG8_SA(1, 0), a3, voffA);
            PG8_WAIT_V(8); PG8_WAIT_L(0); PG8_BAR; PG8_MMA(1, 0, At, B0); PG8_MMA(1, 1, At, B1); PG8_BAR; PG8_SCHED;
            } else {
            PG8_LDB(B0, 0, 0); PG8_SCHED; PG8_LDA(At, 0, 0); PG8_STAGE(PG8_SA(1, 1), a1 + hstep, voffA);
            PG8_WAIT_L(8); PG8_BAR; PG8_WAIT_L(0); PG8_MMA(0, 0, At, B0); PG8_BAR; PG8_SCHED;
            PG8_LDB(B1, 0, 1); PG8_STAGE(PG8_SB(0, 0), b2, voffB);
            PG8_BAR; PG8_WAIT_L(0); PG8_MMA(0, 1, At, B1); PG8_BAR;
            PG8_LDA(At, 0, 1); PG8_STAGE(PG8_SA(0, 0), a2, voffA);
            PG8_BAR; PG8_WAIT_L(0); PG8_MMA(1, 0, At, B0); PG8_BAR; PG8_SCHED;
            PG8_STAGE(PG8_SB(0, 1), b2 + hstep, voffB);
            PG8_WAIT_V(6); PG8_BAR; PG8_MMA(1, 1, At, B1); PG8_BAR;
            PG8_LDB(B0, 1, 0); PG8_SCHED; PG8_LDA(At, 1, 0); PG8_STAGE(PG8_SA(0, 1), a2 + hstep, voffA);
            PG8_WAIT_L(8); PG8_BAR; PG8_WAIT_L(0); PG8_MMA(0, 0, At, B0); PG8_BAR; PG8_SCHED;
            PG8_LDB(B1, 1, 1); PG8_STAGE(PG8_SB(1, 0), b3, voffB);
            PG8_BAR; PG8_WAIT_L(0); PG8_MMA(0, 1, At, B1); PG8_BAR;
            PG8_LDA(At, 1, 1); PG8_STAGE(PG8_SA(1, 0), a3, voffA);
            PG8_BAR; PG8_WAIT_L(0); PG8_MMA(1, 0, At, B0); PG8_BAR; PG8_SCHED;
            PG8_STAGE(PG8_SB(1, 1), b3 + hstep, voffB);
            PG8_WAIT_V(6); PG8_BAR; PG8_MMA(1, 1, At, B1); PG8_BAR;
            }
        }
        if constexpr (ALIGN_EPI) { if (wr == 0) PG8_BAR; }
        if constexpr (!Epi::AFTER_DRAIN) { E(acc, cur, wr, wc, fr, fq); S.done(cur); }
        if (!has_next) break;
#pragma unroll
        for (int a = 0; a < 2; ++a)
#pragma unroll
            for (int b = 0; b < 2; ++b)
#pragma unroll
                for (int m = 0; m < 4; ++m)
#pragma unroll
                    for (int n = 0; n < 2; ++n) acc[a][b][m][n] = (f32x4){0.f, 0.f, 0.f, 0.f};
        cur = nxt; cA = nA; cB = nB; ++ui;
        if constexpr (ALIGN_EPI) { if (wr == 1) PG8_BAR; }
    }
    PG8_WAIT_V(0);
    if constexpr (!ALIGN_EPI) { if (wr == 0) PG8_BAR; }
    PG8_BAR;
    if constexpr (Epi::AFTER_DRAIN) { E.fused(acc, cur, wr, wc, fr, fq, lds, wid, lane); S.done(cur); }
#undef PG8_SA
#undef PG8_SB
#undef PG8_STAGE
#undef PG8_LDA
#undef PG8_LDB
#undef PG8_MMA
#undef PG8_WAIT_V
#undef PG8_WAIT_L
#undef PG8_BAR
#undef PG8_SCHED
}
}
namespace cg = cooperative_groups;
#define LAS __attribute__((address_space(3)))
typedef unsigned short bf16;
typedef float f32x4 __attribute__((ext_vector_type(4)));
typedef float f32x8 __attribute__((ext_vector_type(8)));
typedef float f32x16 __attribute__((ext_vector_type(16)));
typedef unsigned u32x4 __attribute__((ext_vector_type(4)));
typedef unsigned u32x2 __attribute__((ext_vector_type(2)));
typedef short bf16x8 __attribute__((ext_vector_type(8)));
typedef short s16x4 __attribute__((ext_vector_type(4)));

constexpr int BATCH = 16, SEQ = 2048, DM = 1024, T = BATCH * SEQ;
constexpr int NP = 3072;
constexpr int IN_COLS = 3012;
constexpr int C_QA = 0, C_KA = 512, C_VA = 1024, C_QB = 1536, C_KV = 2560, C_QI = 2688, C_KI = 2944, C_WI = 3008;
constexpr int MIXW = 1536;
constexpr int NEXP = 16384;
constexpr float EPS = 1e-6f;
constexpr int NT = 512;
constexpr int NWV = 8;

constexpr size_t MiB = 1u << 20;
constexpr size_t WS_CTL = 0;
constexpr size_t CTL_BYTES = 64 * 1024;
constexpr size_t WS_MOD = 1 * MiB;
constexpr size_t WS_SCAL = WS_MOD + 512 * 1024;
constexpr size_t WS_WIN = 2 * MiB;
constexpr size_t WS_WO2 = 8 * MiB;
constexpr size_t WS_WQ = 11 * MiB;
constexpr size_t WS_SUBK = 13 * MiB;
constexpr size_t WS_U16 = 14 * MiB;
constexpr size_t WS_V16 = 46 * MiB;
constexpr size_t WS_H = 78 * MiB;
constexpr size_t WS_PROJ = 142 * MiB;
constexpr size_t WS_Q3 = WS_PROJ;
constexpr size_t WS_MIX = 334 * MiB;
constexpr size_t WS_EXP = 430 * MiB;
constexpr size_t WS_GATE = 446 * MiB;
constexpr size_t WS_END = 462 * MiB;

struct Params {
    const float *x, *c, *ada_w, *ada_b, *norm1_g, *norm2_g, *w_in, *a_qk_gain, *a_lambda, *a_sub_gain, *b_q_gain, *b_kv_gain, *b_w_uv, *w_out, *peer_wq, *peer_subkeys, *peer_u, *peer_v;
    float* out; unsigned char* ws;
};

enum { SC_LAM = 0, SC_MA = 1, SC_MB = 2 };

__device__ __forceinline__ unsigned f2bf(float f) { unsigned u = __float_as_uint(f); return (u + 0x7fffu + ((u >> 16) & 1u)) >> 16; }
__device__ __forceinline__ float bf2f(unsigned h) { return __uint_as_float(h << 16); }
__device__ __forceinline__ unsigned pk2(float lo, float hi) { return f2bf(lo) | (f2bf(hi) << 16); }
__device__ __forceinline__ float bflo(unsigned w) { return __uint_as_float(w << 16); }
__device__ __forceinline__ float bfhi(unsigned w) { return __uint_as_float(w & 0xffff0000u); }
__device__ __forceinline__ float wave_sum(float v) {
#pragma unroll
    for (int o = 1; o < 64; o <<= 1) v += __shfl_xor(v, o);
    return v;
}
__device__ __forceinline__ float wave_max(float v) {
#pragma unroll
    for (int o = 1; o < 64; o <<= 1) v = fmaxf(v, __shfl_xor(v, o));
    return v;
}
#define LDS_WAIT() asm volatile("s_waitcnt lgkmcnt(0)" ::: "memory")
__device__ __forceinline__ void ph_mod(const Params& p, float* ldsf, int vb, int nvb) {
    if (vb >= 12) return;
    const int tid = threadIdx.x;
    for (int i = tid; i < 16 * 1024; i += NT) { const float v = p.c[i]; ldsf[i] = v / (1.f + __expf(-v)); }
    __syncthreads();
    float* MOD = (float*)(p.ws + WS_MOD);
    for (int it = vb; it < 12; it += nvb) {
        const int j = it * 512 + tid;
        float acc[16];
#pragma unroll
        for (int b = 0; b < 16; ++b) acc[b] = 0.f;
        for (int k = 0; k < 1024; ++k) {
            const float w = p.ada_w[(size_t)k * 6144 + j];
#pragma unroll
            for (int b = 0; b < 16; ++b) acc[b] = fmaf(ldsf[b * 1024 + k], w, acc[b]);
        }
        const float bb = p.ada_b[j];
#pragma unroll
        for (int b = 0; b < 16; ++b) MOD[b * 6144 + j] = acc[b] + bb;
    }
    __syncthreads();
}

__device__ __forceinline__ void transpose_item(const float* W, int N, bf16* WT, int ldt, LAS float* scr, int kb, int nb, int lane) {
    const int k0 = 64 * kb, n0 = 32 * nb;
#pragma unroll 8
    for (int i = 0; i < 32; ++i) { const int kk = 2 * i + (lane >> 5); const int n = n0 + (lane & 31); scr[kk * 33 + (lane & 31)] = (n < N) ? W[(size_t)(k0 + kk) * N + n] : 0.f; }
    LDS_WAIT(); asm volatile("" ::: "memory");
    const int c = lane & 7;
#pragma unroll
    for (int j = 0; j < 4; ++j) { const int n = (lane >> 3) + 8 * j; const LAS float* s = scr + (8 * c) * 33 + n;
        u32x4 o; o.x = pk2(s[0 * 33], s[1 * 33]); o.y = pk2(s[2 * 33], s[3 * 33]); o.z = pk2(s[4 * 33], s[5 * 33]); o.w = pk2(s[6 * 33], s[7 * 33]);
        *(u32x4*)(WT + (size_t)(n0 + n) * ldt + k0 + 8 * c) = o; }
    LDS_WAIT(); asm volatile("" ::: "memory");
}

__device__ __forceinline__ void ph_prep_weights(const Params& p, LAS float* scr, int gw, int ngw, int lane) {
    bf16* WIN = (bf16*)(p.ws + WS_WIN); bf16* WO2 = (bf16*)(p.ws + WS_WO2); bf16* WQ = (bf16*)(p.ws + WS_WQ);
    constexpr int I_IN = 16 * 96, I_O = 8 * 32, I_Q = 16 * 32;
    for (int it = gw; it < I_IN + I_O + I_Q; it += ngw) {
        int r = it;
        if (r < I_IN) { transpose_item(p.w_in, IN_COLS, WIN, 1024, scr, r / 96, r % 96, lane); continue; } r -= I_IN;
        if (r < I_O) { transpose_item(p.w_out, 1024, WO2, MIXW, scr, r / 32, r % 32, lane); continue; } r -= I_O;
        transpose_item(p.peer_wq, 1024, WQ, 1024, scr, r / 32, r % 32, lane);
    }
    const size_t gt = (size_t)gw * 64 + lane, ngt = (size_t)ngw * 64;
    for (size_t i = gt; i < (size_t)1024 * 1024; i += ngt) {
        const int n = (int)(i & 1023), kk = (int)(i >> 10), h = kk >> 7;
        const float* wu = p.b_w_uv + (size_t)kk * 64; const float* wo = p.w_out + (size_t)(512 + 64 * h) * 1024 + n;
        float a = 0.f;
#pragma unroll 8
        for (int e = 0; e < 64; ++e) a = fmaf(wu[e], wo[(size_t)e * 1024], a);
        WO2[(size_t)n * MIXW + 512 + kk] = (bf16)f2bf(a);
    }
    bf16* U16 = (bf16*)(p.ws + WS_U16); bf16* V16 = (bf16*)(p.ws + WS_V16); bf16* SUBK = (bf16*)(p.ws + WS_SUBK);
    constexpr size_t NTAB8 = (size_t)NEXP * 1024 / 8, NSUB8 = 2 * 128 * 64 / 8;
    for (size_t i = gt; i < 2 * NTAB8 + NSUB8; i += ngt) {
        const float* src; bf16* dst; size_t j = i;
        if (j < NTAB8) { src = p.peer_u; dst = U16; } else if (j < 2 * NTAB8) { j -= NTAB8; src = p.peer_v; dst = V16; } else { j -= 2 * NTAB8; src = p.peer_subkeys; dst = SUBK; }
        const f32x8 v = *(const f32x8*)(src + j * 8);
        u32x4 o; o.x = pk2(v[0], v[1]); o.y = pk2(v[2], v[3]); o.z = pk2(v[4], v[5]); o.w = pk2(v[6], v[7]);
        *(u32x4*)(dst + j * 8) = o;
    }
    if (gt == 0) {
        float* SC = (float*)(p.ws + WS_SCAL);
        float s01 = 0.f, s23 = 0.f;
        for (int i = 0; i < 64; ++i) { s01 += p.a_lambda[i] * p.a_lambda[64 + i]; s23 += p.a_lambda[128 + i] * p.a_lambda[192 + i]; }
        SC[SC_LAM] = __expf(s01) - __expf(s23) + 0.2f;
        float g0 = 0.f, g1 = 0.f, gq = 0.f, gk = 0.f;
        for (int i = 0; i < 64; ++i) { g0 = fmaxf(g0, fabsf(p.a_qk_gain[i])); g1 = fmaxf(g1, fabsf(p.a_qk_gain[64 + i])); }
        for (int i = 0; i < 128; ++i) { gq = fmaxf(gq, fabsf(p.b_q_gain[i])); gk = fmaxf(gk, fabsf(p.b_kv_gain[i])); }
        SC[SC_MA] = 8.0f * g0 * g1 * 1.02f;
        SC[SC_MB] = 11.3137085f * gq * gk * 1.02f;
    }
}

__device__ __forceinline__ void ph_hrows(const Params& p, const float* X, const float* g, int shOff, int scOff, int gw, int ngw, int lane) {
    const float* MOD = (const float*)(p.ws + WS_MOD); bf16* H = (bf16*)(p.ws + WS_H);
    for (int m = gw; m < T; m += ngw) {
        const f32x4* xr = (const f32x4*)(X + (size_t)m * 1024) + lane;
        f32x4 v[4]; float s = 0.f;
#pragma unroll
        for (int j = 0; j < 4; ++j) { v[j] = xr[64 * j]; s += (v[j].x * v[j].x + v[j].y * v[j].y) + (v[j].z * v[j].z + v[j].w * v[j].w); }
        const float rstd = rsqrtf(wave_sum(s) * (1.f / 1024.f) + EPS);
        const float* mb = MOD + (size_t)(m >> 11) * 6144;
#pragma unroll
        for (int j = 0; j < 4; ++j) {
            const int col = 4 * (lane + 64 * j);
            const f32x4 gg = *(const f32x4*)(g + col), sc = *(const f32x4*)(mb + scOff + col), sh = *(const f32x4*)(mb + shOff + col);
            const f32x4 y = v[j] * rstd * gg * (sc + 1.0f) + sh;
            u32x2 o; o.x = pk2(y.x, y.y); o.y = pk2(y.z, y.w);
            *(u32x2*)(H + (size_t)m * 1024 + col) = o;
        }
    }
}

__device__ __forceinline__ void ph_norm_proj(const Params& p, int gw, int ngw, int lane) {
    bf16* PROJ = (bf16*)(p.ws + WS_PROJ);
    for (int m = gw; m < T; m += ngw) {
        bf16* row = PROJ + (size_t)m * NP;
#pragma unroll
        for (int j = 0; j < 6; ++j) {
            if (j == 2) continue;
            const int col = 8 * lane + 512 * j;
            const u32x4 raw = *(const u32x4*)(row + col);
            float v[8] = {bflo(raw.x), bfhi(raw.x), bflo(raw.y), bfhi(raw.y), bflo(raw.z), bfhi(raw.z), bflo(raw.w), bfhi(raw.w)};
            float ss = 0.f;
#pragma unroll
            for (int i = 0; i < 8; ++i) ss += v[i] * v[i];
            ss += __shfl_xor(ss, 1); ss += __shfl_xor(ss, 2); ss += __shfl_xor(ss, 4);
            float rstd; const float* gp;
            if (j < 2) { rstd = rsqrtf(ss * (1.f / 64.f) + EPS); gp = p.a_qk_gain + 64 * j + (col & 63); }
            else { ss += __shfl_xor(ss, 8); rstd = rsqrtf(ss * (1.f / 128.f) + EPS); gp = (j == 5 ? p.b_kv_gain : p.b_q_gain) + (col & 127); }
            if (j == 5 && lane >= 16) continue;
            const f32x4 g0 = *(const f32x4*)gp, g1 = *(const f32x4*)(gp + 4);
            u32x4 o; o.x = pk2(v[0] * rstd * g0.x, v[1] * rstd * g0.y); o.y = pk2(v[2] * rstd * g0.z, v[3] * rstd * g0.w);
            o.z = pk2(v[4] * rstd * g1.x, v[5] * rstd * g1.y); o.w = pk2(v[6] * rstd * g1.z, v[7] * rstd * g1.w);
            *(u32x4*)(row + col) = o;
        }
    }
}
__device__ void ph_attnA_naive(const Params& p, float* lds_w, int gw, int ngw, int lane) {
    const bf16* PROJ = (const bf16*)(p.ws + WS_PROJ); bf16* MIX = (bf16*)(p.ws + WS_MIX);
    const float lam = ((const float*)(p.ws + WS_SCAL))[SC_LAM];
    float* qs = lds_w; float* sc0 = lds_w + 128; float* sc1 = sc0 + 2048;
    for (int it = gw; it < BATCH * 4 * SEQ; it += ngw) {
        const int t = it & 2047, h = (it >> 11) & 3, b = it >> 13;
        const int cend = ((t >> 6) + 1) << 6;
        const float slope = exp2f(-2.0f * (h + 1));
        const bf16* qrow = PROJ + (size_t)(b * SEQ + t) * NP + C_QA + h * 128;
        qs[lane] = bf2f(qrow[lane]); qs[64 + lane] = bf2f(qrow[64 + lane]);
        LDS_WAIT(); asm volatile("" ::: "memory");
        float m0 = -3e38f, m1 = -3e38f;
        for (int kk = lane; kk < cend; kk += 64) {
            const bf16* krow = PROJ + (size_t)(b * SEQ + kk) * NP + C_KA + h * 128;
            float d0 = 0.f, d1 = 0.f;
            for (int d = 0; d < 64; ++d) { d0 = fmaf(qs[d], bf2f(krow[d]), d0); d1 = fmaf(qs[64 + d], bf2f(krow[64 + d]), d1); }
            const float bias = slope * fabsf((float)(t - kk));
            d0 = d0 * 0.125f - bias; d1 = d1 * 0.125f - bias;
            sc0[kk] = d0; sc1[kk] = d1; m0 = fmaxf(m0, d0); m1 = fmaxf(m1, d1);
        }
        m0 = wave_max(m0); m1 = wave_max(m1);
        float l0 = 0.f, l1 = 0.f;
        for (int kk = lane; kk < cend; kk += 64) { const float e0 = __expf(sc0[kk] - m0), e1 = __expf(sc1[kk] - m1); sc0[kk] = e0; sc1[kk] = e1; l0 += e0; l1 += e1; }
        l0 = wave_sum(l0); l1 = wave_sum(l1);
        const float i0 = 1.f / l0, i1 = lam / l1;
        for (int kk = lane; kk < cend; kk += 64) sc0[kk] = sc0[kk] * i0 - sc1[kk] * i1;
        LDS_WAIT(); asm volatile("" ::: "memory");
        float a0 = 0.f, a1 = 0.f;
        const bf16* vb = PROJ + (size_t)(b * SEQ) * NP + C_VA + h * 128;
        for (int kk = 0; kk < cend; ++kk) { const float a = sc0[kk]; const bf16* vr = vb + (size_t)kk * NP; a0 = fmaf(a, bf2f(vr[lane]), a0); a1 = fmaf(a, bf2f(vr[64 + lane]), a1); }
        const float ss = wave_sum(a0 * a0 + a1 * a1);
        const float rstd = rsqrtf(ss * (1.f / 128.f) + EPS) * 0.8f;
        bf16* orow = MIX + (size_t)(b * SEQ + t) * MIXW + h * 128;
        orow[lane] = (bf16)f2bf(a0 * rstd * p.a_sub_gain[lane]); orow[64 + lane] = (bf16)f2bf(a1 * rstd * p.a_sub_gain[64 + lane]);
        LDS_WAIT(); asm volatile("" ::: "memory");
    }
}

__device__ void ph_dsa_naive(const Params& p, float* lds, int vb, int nvb) {
    const bf16* PROJ = (const bf16*)(p.ws + WS_PROJ); bf16* MIX = (bf16*)(p.ws + WS_MIX);
    const int tid = threadIdx.x, lane = tid & 63, wv = tid >> 6;
    float* scores = lds; int* sel = (int*)(lds + 2048); float* qi = lds + 2048 + 256; float* wi = qi + 256;
    float* qh = wi + 64 + wv * 384; float* pw = qh + 128;
    for (int it = vb; it < T; it += nvb) {
        const int b = it >> 11, t = it & 2047; const int cend = ((t >> 6) + 1) << 6;
        const bf16* row = PROJ + (size_t)it * NP;
        if (tid < 256) qi[tid] = bf2f(row[C_QI + tid]);
        if (tid < 4) wi[tid] = bf2f(row[C_WI + tid]);
        __syncthreads();
        for (int kk = tid; kk < cend; kk += NT) {
            const bf16* kr = PROJ + (size_t)(b * SEQ + kk) * NP + C_KI;
            float s = 0.f;
            for (int h = 0; h < 4; ++h) { float d = 0.f; for (int e = 0; e < 64; ++e) d = fmaf(qi[h * 64 + e], bf2f(kr[e]), d); s += fmaxf(d, 0.f) * wi[h]; }
            scores[kk] = s * 0.0625f;
        }
        __syncthreads();
        int nvalid;
        if (cend <= 256) { if (tid < 256) sel[tid] = tid; nvalid = cend; }
        else {
            for (int i = tid; i < cend; i += NT) { const float si = scores[i]; int rank = 0;
                for (int j = 0; j < cend; ++j) { const float sj = scores[j]; rank += (sj > si || (sj == si && j < i)) ? 1 : 0; }
                if (rank < 256) sel[rank] = i; }
            nvalid = 256;
        }
        __syncthreads();
        {
            const int h = wv; const float slope = exp2f(-(float)(h + 1));
            qh[lane] = bf2f(row[C_QB + h * 128 + lane]); qh[64 + lane] = bf2f(row[C_QB + h * 128 + 64 + lane]);
            LDS_WAIT(); asm volatile("" ::: "memory");
            float sv[4]; float mx = -3e38f;
#pragma unroll
            for (int jj = 0; jj < 4; ++jj) { const int j = lane + 64 * jj; const int key = sel[j < nvalid ? j : 0];
                const bf16* kv = PROJ + (size_t)(b * SEQ + key) * NP + C_KV; float d = 0.f;
                for (int e = 0; e < 128; ++e) d = fmaf(qh[e], bf2f(kv[e]), d);
                d = d * 0.0883883476f - slope * fabsf((float)(t - key));
                sv[jj] = (j < nvalid) ? d : -3e38f; mx = fmaxf(mx, sv[jj]); }
            mx = wave_max(mx); float l = 0.f;
#pragma unroll
            for (int jj = 0; jj < 4; ++jj) { const int j = lane + 64 * jj; const float e = (j < nvalid) ? __expf(sv[jj] - mx) : 0.f; pw[j] = e; l += e; }
            l = wave_sum(l);
            LDS_WAIT(); asm volatile("" ::: "memory");
            float a0 = 0.f, a1 = 0.f;
            for (int j = 0; j < nvalid; ++j) { const float pj = pw[j]; const bf16* kv = PROJ + (size_t)(b * SEQ + sel[j]) * NP + C_KV; a0 = fmaf(pj, bf2f(kv[lane]), a0); a1 = fmaf(pj, bf2f(kv[64 + lane]), a1); }
            const float il = 1.f / l;
            bf16* orow = MIX + (size_t)it * MIXW + 512 + h * 128;
            orow[lane] = (bf16)f2bf(a0 * il); orow[64 + lane] = (bf16)f2bf(a1 * il);
        }
        __syncthreads();
    }
}

__device__ void ph_route_naive(const Params& p, float* lds, int vb, int nvb) {
    const bf16* Q3 = (const bf16*)(p.ws + WS_Q3); const bf16* SUBK = (const bf16*)(p.ws + WS_SUBK);
    int* EXPI = (int*)(p.ws + WS_EXP); float* GATE = (float*)(p.ws + WS_GATE);
    const int tid = threadIdx.x;
    float* q = lds; float* sub = q + 1024; float* sv = sub + 2048; int* si = (int*)(sv + 256); float* cand = sv + 512; float* ts = cand + 2048; int* te = (int*)(ts + 128);
    for (int it = vb; it < T; it += nvb) {
        q[tid] = bf2f(Q3[(size_t)it * 1024 + tid]); q[tid + 512] = bf2f(Q3[(size_t)it * 1024 + tid + 512]);
        __syncthreads();
        for (int r = 0; r < 4; ++r) { const int idx = tid + 512 * r, h = idx >> 8, c = (idx >> 7) & 1, n = idx & 127;
            const float* qq = q + h * 128 + c * 64; const bf16* kk = SUBK + (size_t)(c * 128 + n) * 64; float d = 0.f;
            for (int e = 0; e < 64; ++e) d = fmaf(qq[e], bf2f(kk[e]), d);
            sub[idx] = d; }
        __syncthreads();
        for (int r = 0; r < 4; ++r) { const int idx = tid + 512 * r, g0 = idx & ~127, n = idx & 127; const float s = sub[idx]; int rank = 0;
            for (int j = 0; j < 128; ++j) { const float sj = sub[g0 + j]; rank += (sj > s || (sj == s && j < n)) ? 1 : 0; }
            if (rank < 16) { sv[(g0 >> 7) * 16 + rank] = s; si[(g0 >> 7) * 16 + rank] = n; } }
        __syncthreads();
        for (int r = 0; r < 4; ++r) { const int idx = tid + 512 * r, h = idx >> 8, i = (idx >> 4) & 15, j = idx & 15; cand[idx] = sv[(h * 2) * 16 + i] + sv[(h * 2 + 1) * 16 + j]; }
        __syncthreads();
        for (int r = 0; r < 4; ++r) { const int idx = tid + 512 * r, h = idx >> 8, ij = idx & 255; const float s = cand[idx]; int rank = 0;
            for (int j = 0; j < 256; ++j) { const float sj = cand[h * 256 + j]; rank += (sj > s || (sj == s && j < ij)) ? 1 : 0; }
            if (rank < 16) { ts[h * 16 + rank] = s; te[h * 16 + rank] = si[(h * 2) * 16 + (ij >> 4)] * 128 + si[(h * 2 + 1) * 16 + (ij & 15)]; } }
        __syncthreads();
        if (tid < 128) { const int h = tid >> 4; const float mx = ts[h * 16]; float l = 0.f;
            for (int k = 0; k < 16; ++k) l += __expf(ts[h * 16 + k] - mx);
            GATE[(size_t)it * 128 + tid] = __expf(ts[tid] - mx) / l; EXPI[(size_t)it * 128 + tid] = te[tid]; }
        __syncthreads();
    }
}

__device__ void ph_peer_naive(const Params& p, float* lds, int vb, int nvb) {
    const bf16* H = (const bf16*)(p.ws + WS_H); const bf16* U16 = (const bf16*)(p.ws + WS_U16); const bf16* V16 = (const bf16*)(p.ws + WS_V16);
    const int* EXPI = (const int*)(p.ws + WS_EXP); const float* GATE = (const float*)(p.ws + WS_GATE); const float* MOD = (const float*)(p.ws + WS_MOD);
    const int tid = threadIdx.x, lane = tid & 63, wv = tid >> 6;
    float* xs = lds; float* coef = lds + 1024; int* ex = (int*)(coef + 128);
    for (int it = vb; it < T; it += nvb) {
        xs[tid] = bf2f(H[(size_t)it * 1024 + tid]); xs[tid + 512] = bf2f(H[(size_t)it * 1024 + tid + 512]);
        if (tid < 128) ex[tid] = EXPI[(size_t)it * 128 + tid];
        __syncthreads();
        for (int jj = 0; jj < 16; ++jj) { const int j = wv * 16 + jj; const bf16* ur = U16 + (size_t)ex[j] * 1024; float d = 0.f;
            for (int i = 0; i < 16; ++i) d = fmaf(xs[lane + 64 * i], bf2f(ur[lane + 64 * i]), d);
            d = wave_sum(d);
            if (lane == 0) coef[j] = 0.5f * d * (1.f + erff(d * 0.70710678f)) * GATE[(size_t)it * 128 + j]; }
        __syncthreads();
        const float* g2 = MOD + (size_t)(it >> 11) * 6144 + 5120;
        for (int r = 0; r < 2; ++r) { const int d = tid + 512 * r; float a = 0.f;
            for (int j = 0; j < 128; ++j) a = fmaf(coef[j], bf2f(V16[(size_t)ex[j] * 1024 + d]), a);
            p.out[(size_t)it * 1024 + d] = p.out[(size_t)it * 1024 + d] + g2[d] * a; }
        __syncthreads();
    }
}
struct EpiResGate {
    static constexpr bool PERM = false, AFTER_DRAIN = false;
    const float* X; float* Out; const float* gate;
    __device__ __forceinline__ void operator()(const pg8::f32x4 (&acc)[2][2][4][2], const pg8::Unit& u, int wr, int wc, int fr, int fq) const {
        const int col0 = u.pn * 256 + wc * 32 + 4 * fq;
#pragma unroll
        for (int ai = 0; ai < 2; ++ai)
#pragma unroll
            for (int m = 0; m < 4; ++m) {
                const int r = u.pm * 256 + ai * 128 + wr * 64 + m * 16 + fr; const float* gb = gate + (size_t)(r >> 11) * 6144;
#pragma unroll
                for (int bj = 0; bj < 2; ++bj)
#pragma unroll
                    for (int n = 0; n < 2; ++n) { const int c = col0 + bj * 128 + n * 16; const size_t off = (size_t)r * 1024 + c;
                        const pg8::f32x4 xv = *(const pg8::f32x4*)(X + off), gv = *(const pg8::f32x4*)(gb + c);
                        *(pg8::f32x4*)(Out + off) = xv + gv * acc[ai][bj][m][n]; }
            }
    }
};

typedef __bf16 bf16x2_t __attribute__((ext_vector_type(2)));
__device__ __forceinline__ float dot2bf(unsigned a, unsigned b, float acc) { return __builtin_amdgcn_fdot2_f32_bf16(__builtin_bit_cast(bf16x2_t, a), __builtin_bit_cast(bf16x2_t, b), acc, false); }
template <int CTRL> __device__ __forceinline__ float dpp_f(float v) { return __int_as_float(__builtin_amdgcn_update_dpp(0, __float_as_int(v), CTRL, 0xf, 0xf, false)); }
__device__ __forceinline__ float row16_sum(float v) {
    v += dpp_f<0x128>(v); v += dpp_f<0x124>(v); v += dpp_f<0x122>(v); v += dpp_f<0x121>(v); return v;
}
__device__ __forceinline__ float gelu_erf(float a) { return 0.5f * a * (1.f + erff(a * 0.70710678118f)); }

__device__ __forceinline__ void ph_peer(const Params& p, unsigned char* lds_w, int gw, int ngw, int lane) {
    const bf16* H = (const bf16*)(p.ws + WS_H); const bf16* U16 = (const bf16*)(p.ws + WS_U16); const bf16* V16 = (const bf16*)(p.ws + WS_V16);
    const int* EXPI = (const int*)(p.ws + WS_EXP); const float* GATE = (const float*)(p.ws + WS_GATE); const float* MOD = (const float*)(p.ws + WS_MOD);
    int* e_lds = (int*)lds_w; float* a_lds = (float*)(lds_w + 512);
    const int g = lane >> 4, i = lane & 15;
    for (int t = gw; t < T; t += ngw) {
        const int e0 = EXPI[(size_t)t * 128 + lane], e1 = EXPI[(size_t)t * 128 + 64 + lane];
        const float g0 = GATE[(size_t)t * 128 + lane], g1 = GATE[(size_t)t * 128 + 64 + lane];
        e_lds[lane] = e0; e_lds[64 + lane] = e1;
        u32x4 xr[8];
        const u32x4* xrow = (const u32x4*)(H + (size_t)t * 1024) + i;
#pragma unroll
        for (int k = 0; k < 8; ++k) xr[k] = xrow[16 * k];
        LDS_WAIT(); asm volatile("" ::: "memory");
        u32x4 ua[8], ub[8];
        { const u32x4* ur = (const u32x4*)(U16 + (size_t)e_lds[g] * 1024) + i;
#pragma unroll
          for (int k = 0; k < 8; ++k) ua[k] = ur[16 * k]; }
#pragma unroll 1
        for (int s = 0; s < 32; s += 2) {
            { const u32x4* ur = (const u32x4*)(U16 + (size_t)e_lds[4 * (s + 1) + g] * 1024) + i;
#pragma unroll
              for (int k = 0; k < 8; ++k) ub[k] = ur[16 * k]; }
            { float a0 = 0.f, a1 = 0.f, a2 = 0.f, a3 = 0.f;
#pragma unroll
              for (int k = 0; k < 8; ++k) { a0 = dot2bf(ua[k].x, xr[k].x, a0); a1 = dot2bf(ua[k].y, xr[k].y, a1); a2 = dot2bf(ua[k].z, xr[k].z, a2); a3 = dot2bf(ua[k].w, xr[k].w, a3); }
              const float a = row16_sum((a0 + a1) + (a2 + a3));
              if (i == 0) a_lds[4 * s + g] = a; }
            if (s + 2 < 32) { const u32x4* ur = (const u32x4*)(U16 + (size_t)e_lds[4 * (s + 2) + g] * 1024) + i;
#pragma unroll
              for (int k = 0; k < 8; ++k) ua[k] = ur[16 * k]; }
            { float a0 = 0.f, a1 = 0.f, a2 = 0.f, a3 = 0.f;
#pragma unroll
              for (int k = 0; k < 8; ++k) { a0 = dot2bf(ub[k].x, xr[k].x, a0); a1 = dot2bf(ub[k].y, xr[k].y, a1); a2 = dot2bf(ub[k].z, xr[k].z, a2); a3 = dot2bf(ub[k].w, xr[k].w, a3); }
              const float a = row16_sum((a0 + a1) + (a2 + a3));
              if (i == 0) a_lds[4 * (s + 1) + g] = a; }
        }
        LDS_WAIT(); asm volatile("" ::: "memory");
        const float c0 = gelu_erf(a_lds[lane]) * g0, c1 = gelu_erf(a_lds[64 + lane]) * g1;
        const unsigned pw = pk2(c0, c1);
        float acc[16];
#pragma unroll
        for (int q = 0; q < 16; ++q) acc[q] = 0.f;
        u32x4 A0, A1, B0, B1, C0, C1, D0, D1;
#define PEER_VLOAD(j, X0, X1, Y0, Y1) do { const int ea_ = __builtin_amdgcn_readlane(e0, (j)), eb_ = __builtin_amdgcn_readlane(e1, (j)); \
            const u32x4* ra_ = (const u32x4*)(V16 + (size_t)ea_ * 1024) + lane; const u32x4* rb_ = (const u32x4*)(V16 + (size_t)eb_ * 1024) + lane; \
            X0 = ra_[0]; X1 = ra_[64]; Y0 = rb_[0]; Y1 = rb_[64]; } while (0)
#define PEER_VACC(j, X0, X1, Y0, Y1) do { const unsigned cp_ = (unsigned)__builtin_amdgcn_readlane((int)pw, (j)); \
            acc[0] = dot2bf(__builtin_amdgcn_perm(Y0.x, X0.x, 0x05040100u), cp_, acc[0]); acc[1] = dot2bf(__builtin_amdgcn_perm(Y0.x, X0.x, 0x07060302u), cp_, acc[1]); \
            acc[2] = dot2bf(__builtin_amdgcn_perm(Y0.y, X0.y, 0x05040100u), cp_, acc[2]); acc[3] = dot2bf(__builtin_amdgcn_perm(Y0.y, X0.y, 0x07060302u), cp_, acc[3]); \
            acc[4] = dot2bf(__builtin_amdgcn_perm(Y0.z, X0.z, 0x05040100u), cp_, acc[4]); acc[5] = dot2bf(__builtin_amdgcn_perm(Y0.z, X0.z, 0x07060302u), cp_, acc[5]); \
            acc[6] = dot2bf(__builtin_amdgcn_perm(Y0.w, X0.w, 0x05040100u), cp_, acc[6]); acc[7] = dot2bf(__builtin_amdgcn_perm(Y0.w, X0.w, 0x07060302u), cp_, acc[7]); \
            acc[8] = dot2bf(__builtin_amdgcn_perm(Y1.x, X1.x, 0x05040100u), cp_, acc[8]); acc[9] = dot2bf(__builtin_amdgcn_perm(Y1.x, X1.x, 0x07060302u), cp_, acc[9]); \
            acc[10] = dot2bf(__builtin_amdgcn_perm(Y1.y, X1.y, 0x05040100u), cp_, acc[10]); acc[11] = dot2bf(__builtin_amdgcn_perm(Y1.y, X1.y, 0x07060302u), cp_, acc[11]); \
            acc[12] = dot2bf(__builtin_amdgcn_perm(Y1.z, X1.z, 0x05040100u), cp_, acc[12]); acc[13] = dot2bf(__builtin_amdgcn_perm(Y1.z, X1.z, 0x07060302u), cp_, acc[13]); \
            acc[14] = dot2bf(__builtin_amdgcn_perm(Y1.w, X1.w, 0x05040100u), cp_, acc[14]); acc[15] = dot2bf(__builtin_amdgcn_perm(Y1.w, X1.w, 0x07060302u), cp_, acc[15]); } while (0)
        PEER_VLOAD(0, A0, A1, B0, B1);
#pragma unroll 1
        for (int j = 0; j < 64; j += 2) {
            PEER_VLOAD(j + 1, C0, C1, D0, D1);
            PEER_VACC(j, A0, A1, B0, B1);
            if (j + 2 < 64) PEER_VLOAD(j + 2, A0, A1, B0, B1);
            PEER_VACC(j + 1, C0, C1, D0, D1);
        }
#undef PEER_VLOAD
#undef PEER_VACC
        const float* g2 = MOD + (size_t)(t >> 11) * 6144 + 5120;
        float* orow = p.out + (size_t)t * 1024;
#pragma unroll
        for (int h = 0; h < 2; ++h)
#pragma unroll
            for (int q = 0; q < 2; ++q) { const int col = 512 * h + 8 * lane + 4 * q;
                const f32x4 xv = *(const f32x4*)(orow + col), gv = *(const f32x4*)(g2 + col);
                f32x4 a; a.x = acc[8 * h + 4 * q]; a.y = acc[8 * h + 4 * q + 1]; a.z = acc[8 * h + 4 * q + 2]; a.w = acc[8 * h + 4 * q + 3];
                *(f32x4*)(orow + col) = xv + gv * a; }
    }
}
typedef short v4i16_t __attribute__((ext_vector_type(4)));
constexpr int DSA_SROW = 2048 * 4 + 16;
constexpr int DSA_SEL_OFF = 16 * DSA_SROW;
constexpr int DSA_LDS = DSA_SEL_OFF + 16 * 512;
constexpr int DSA_KVROW = 272;

__device__ __forceinline__ unsigned sortkey(float s) { const unsigned u = __float_as_uint(s); return u ^ ((u >> 31) ? 0xffffffffu : 0x80000000u); }
__device__ __forceinline__ unsigned cvtpk_bf16(float lo, float hi) { unsigned r; asm volatile("v_cvt_pk_bf16_f32 %0, %1, %2" : "=v"(r) : "v"(lo), "v"(hi)); return r; }

__device__ __forceinline__ void ph_dsa(const Params& p, unsigned char* lds, int vb, int nvb) {
    const bf16* PROJ = (const bf16*)(p.ws + WS_PROJ); bf16* MIX = (bf16*)(p.ws + WS_MIX);
    const float MB = ((const float*)(p.ws + WS_SCAL))[SC_MB];
    const int tid = threadIdx.x, lane = tid & 63, wv = __builtin_amdgcn_readfirstlane(tid >> 6);
    const int l15 = lane & 15, g = lane >> 4;
    LAS unsigned char* ldsl = (LAS unsigned char*)lds;
    for (int it = vb; it < 2048; it += nvb) {
        const int vbb = it & 255, kk = it >> 8, G = vbb >> 6, ps = vbb & 63, b = ps >> 2, sub = ps & 3;
        const int c = (kk & 1) ? (31 - G - 8 * (kk >> 1)) : (G + 8 * (kk >> 1));
        const int cend = (c + 1) * 64, t0 = c * 64 + sub * 16;
        const bf16* Pb = PROJ + (size_t)b * SEQ * NP;
        if (c >= 4) {
            const bf16* qrow = Pb + (size_t)(t0 + l15) * NP;
            bf16x8 bq[4][2]; float wsc[4];
#pragma unroll
            for (int h = 0; h < 4; ++h) { wsc[h] = bf2f(qrow[C_WI + h]) * 0.0625f;
#pragma unroll
                for (int ks = 0; ks < 2; ++ks) bq[h][ks] = *(const bf16x8*)(qrow + C_QI + h * 64 + 32 * ks + 8 * g); }
            for (int k0 = 16 * wv; k0 < cend; k0 += 128) {
                const bf16* krow = Pb + (size_t)(k0 + l15) * NP + C_KI + 8 * g;
                const bf16x8 ka0 = *(const bf16x8*)krow, ka1 = *(const bf16x8*)(krow + 32);
                f32x4 sc = {0.f, 0.f, 0.f, 0.f};
#pragma unroll
                for (int h = 0; h < 4; ++h) { f32x4 a = {0.f, 0.f, 0.f, 0.f};
                    a = __builtin_amdgcn_mfma_f32_16x16x32_bf16(ka0, bq[h][0], a, 0, 0, 0);
                    a = __builtin_amdgcn_mfma_f32_16x16x32_bf16(ka1, bq[h][1], a, 0, 0, 0);
#pragma unroll
                    for (int r = 0; r < 4; ++r) sc[r] = fmaf(fmaxf(a[r], 0.f), wsc[h], sc[r]); }
#pragma unroll
                for (int r = 0; r < 4; ++r) sc[r] = (sc[r] == 0.f) ? 0.f : sc[r];
                *(LAS f32x4*)(ldsl + l15 * DSA_SROW + (k0 + 4 * g) * 4) = sc;
            }
        }
        __syncthreads();
        LAS unsigned short* selw = (LAS unsigned short*)(ldsl + DSA_SEL_OFF);
        int mind0 = 0, mind1 = 0;
#pragma unroll 1
        for (int qi = 0; qi < 2; ++qi) {
            const int qq = 2 * wv + qi, t = t0 + qq;
            LAS unsigned short* sel = selw + qq * 256;
            if (c < 4) { for (int j = lane; j < 256; j += 64) sel[j] = (unsigned short)j; continue; }
            const int nreg = cend >> 6;
            unsigned key[32];
            const LAS float* srow = (const LAS float*)(ldsl + qq * DSA_SROW) + lane;
#pragma unroll
            for (int i = 0; i < 32; ++i) key[i] = (i < nreg) ? sortkey(srow[64 * i]) : 0u;
            unsigned prefix = 0u; bool exact = false;
#pragma unroll 1
            for (int bit = 31; bit >= 0; --bit) {
                const unsigned cand = prefix | (1u << bit); int cnt = 0;
#pragma unroll
                for (int i = 0; i < 32; ++i) cnt += __popcll(__ballot(key[i] >= cand));
                if (cnt >= 256) { prefix = cand; if (cnt == 256) { exact = true; break; } }
            }
            int need_ties = 0;
            if (!exact) { int cgt = 0;
                if (prefix != 0xffffffffu) {
#pragma unroll
                    for (int i = 0; i < 32; ++i) cgt += __popcll(__ballot(key[i] > prefix)); }
                need_ties = 256 - cgt; }
            int base = 0, tbase = 0, md = 4096;
#pragma unroll
            for (int i = 0; i < 32; ++i) {
                if (i < nreg) {
                    bool selb;
                    if (exact) selb = key[i] >= prefix;
                    else { const bool tie = key[i] == prefix; const unsigned long long mt = __ballot(tie);
                        const int trank = tbase + (int)__builtin_amdgcn_mbcnt_hi((unsigned)(mt >> 32), __builtin_amdgcn_mbcnt_lo((unsigned)mt, 0u));
                        selb = (key[i] > prefix) || (tie && trank < need_ties); tbase += __popcll(mt); }
                    const unsigned long long m = __ballot(selb);
                    const int pos = base + (int)__builtin_amdgcn_mbcnt_hi((unsigned)(m >> 32), __builtin_amdgcn_mbcnt_lo((unsigned)m, 0u));
                    const int kidx = i * 64 + lane;
                    if (selb) { sel[pos] = (unsigned short)kidx; const int d = t > kidx ? t - kidx : kidx - t; md = d < md ? d : md; }
                    base += __popcll(m);
                }
            }
#pragma unroll
            for (int o = 1; o < 64; o <<= 1) { const int x = __shfl_xor(md, o); md = x < md ? x : md; }
            if (qi == 0) mind0 = md; else mind1 = md;
        }
        LDS_WAIT(); asm volatile("" ::: "memory");
        const int nvalid = cend < 256 ? cend : 256;
        const int head = lane & 7;
        const float slopeL2 = exp2f(-(float)(head + 1)) * 1.4426950409f;
#pragma unroll 1
        for (int qi = 0; qi < 2; ++qi) {
            const int qq = 2 * wv + qi, t = t0 + qq;
            const LAS unsigned short* sel = selw + qq * 256;
            LAS unsigned char* stg = ldsl + (2 * wv) * DSA_SROW;
            const bf16* qrow = Pb + (size_t)t * NP + C_QB + head * 128 + 8 * g;
            bf16x8 bq[4];
#pragma unroll
            for (int ks = 0; ks < 4; ++ks) bq[ks] = *(const bf16x8*)(qrow + 32 * ks);
            const float refL2 = MB * 1.4426950409f - slopeL2 * (float)(qi == 0 ? mind0 : mind1);
            f32x4 o[8];
#pragma unroll
            for (int dt = 0; dt < 8; ++dt) o[dt] = (f32x4){0.f, 0.f, 0.f, 0.f};
            float lsum = 0.f;
#pragma unroll 1
            for (int s = 0; s < 8; ++s) {
                if (32 * s >= nvalid) break;
                unsigned pb[4];
#pragma unroll
                for (int tl = 0; tl < 2; ++tl) {
                    const int j0 = 32 * s + 16 * tl;
                    const int jr = j0 + l15; const int keyr = sel[jr < nvalid ? jr : 0];
                    const bf16* kvrow = Pb + (size_t)keyr * NP + C_KV + 8 * g;
                    bf16x8 ka[4];
#pragma unroll
                    for (int ks = 0; ks < 4; ++ks) ka[ks] = *(const bf16x8*)(kvrow + 32 * ks);
                    f32x4 a = {0.f, 0.f, 0.f, 0.f};
#pragma unroll
                    for (int ks = 0; ks < 4; ++ks) { a = __builtin_amdgcn_mfma_f32_16x16x32_bf16(ka[ks], bq[ks], a, 0, 0, 0);
                        *(LAS bf16x8*)(stg + (16 * tl + l15) * DSA_KVROW + (32 * ks + 8 * g) * 2) = ka[ks]; }
                    const u32x2 kw = *(const LAS u32x2*)(sel + j0 + 4 * g);
                    const int kx[4] = {(int)(kw.x & 0xffffu), (int)(kw.x >> 16), (int)(kw.y & 0xffffu), (int)(kw.y >> 16)};
                    float pr[4];
#pragma unroll
                    for (int r = 0; r < 4; ++r) { const int dd = t > kx[r] ? t - kx[r] : kx[r] - t;
                        const float e = __builtin_amdgcn_exp2f(fmaf(a[r], 0.1275174f, -slopeL2 * (float)dd - refL2));
                        pr[r] = (j0 + 4 * g + r < nvalid) ? e : 0.f; lsum += pr[r]; }
                    pb[2 * tl] = cvtpk_bf16(pr[0], pr[1]); pb[2 * tl + 1] = cvtpk_bf16(pr[2], pr[3]);
                }
                LDS_WAIT(); asm volatile("" ::: "memory");
                u32x4 pw4; pw4.x = pb[0]; pw4.y = pb[1]; pw4.z = pb[2]; pw4.w = pb[3];
                const bf16x8 pfrag = __builtin_bit_cast(bf16x8, pw4);
                const LAS unsigned char* trb = stg + (4 * g + (l15 >> 2)) * DSA_KVROW + (4 * (lane & 3)) * 2;
#pragma unroll
                for (int dt = 0; dt < 8; ++dt) {
                    const s16x4 lo = __builtin_bit_cast(s16x4, __builtin_amdgcn_ds_read_tr16_b64_v4i16((LAS v4i16_t*)(trb + dt * 32)));
                    const s16x4 hi = __builtin_bit_cast(s16x4, __builtin_amdgcn_ds_read_tr16_b64_v4i16((LAS v4i16_t*)(trb + 16 * DSA_KVROW + dt * 32)));
                    const bf16x8 af = {lo[0], lo[1], lo[2], lo[3], hi[0], hi[1], hi[2], hi[3]};
                    o[dt] = __builtin_amdgcn_mfma_f32_16x16x32_bf16(af, pfrag, o[dt], 0, 0, 0);
                }
                LDS_WAIT(); asm volatile("" ::: "memory");
            }
            lsum += __shfl_xor(lsum, 16); lsum += __shfl_xor(lsum, 32);
            const float il = 1.f / lsum;
            if (l15 < 8) {
                bf16* orow = MIX + (size_t)(b * SEQ + t) * MIXW + 512 + head * 128 + 4 * g;
#pragma unroll
                for (int dt = 0; dt < 8; ++dt) { u32x2 w; w.x = pk2(o[dt][0] * il, o[dt][1] * il); w.y = pk2(o[dt][2] * il, o[dt][3] * il); *(u32x2*)(orow + 16 * dt) = w; }
            }
        }
        __syncthreads();
    }
}
constexpr int LDS_BYTES = 147456;
extern __shared__ __attribute__((aligned(16))) unsigned char dyn_lds[];

__global__ void __launch_bounds__(NT, 2) mega_fwd(Params p) {
    cg::grid_group grid = cg::this_grid();
    const int tid = threadIdx.x, lane = tid & 63, wv = tid >> 6;
    const int vb = blockIdx.x, nvb = gridDim.x, gw = vb * NWV + wv, ngw = nvb * NWV;
    ph_mod(p, (float*)dyn_lds, vb, nvb);
    ph_prep_weights(p, (LAS float*)dyn_lds + wv * (64 * 33), gw, ngw, lane);
    grid.sync();
    ph_hrows(p, p.x, p.norm1_g, 0, 1024, gw, ngw, lane);
    grid.sync();
    {   pg8::Gemm g{(const bf16*)(p.ws + WS_H), (const bf16*)(p.ws + WS_WIN), T, NP, 1024}; pg8::StaticOrder S; S.init(T, NP, nvb, vb);
        pg8::EpiBf16<0> E{(bf16*)(p.ws + WS_PROJ), NP, nullptr, 0, 0, 1.f};
        pg8::gemm_phase<pg8::EpiBf16<0>, pg8::StaticOrder, true, true>((LAS unsigned char*)dyn_lds, g, S, E); }
    grid.sync();
    ph_norm_proj(p, gw, ngw, lane);
    grid.sync();
    ph_attnA_naive(p, (float*)dyn_lds + wv * (128 + 4096), gw, ngw, lane);
    __syncthreads();
    ph_dsa(p, dyn_lds, vb, nvb);
    grid.sync();
    {   pg8::Gemm g{(const bf16*)(p.ws + WS_MIX), (const bf16*)(p.ws + WS_WO2), T, 1024, MIXW}; pg8::StaticOrder S; S.init(T, 1024, nvb, vb);
        EpiResGate E{p.x, p.out, (const float*)(p.ws + WS_MOD) + 2048};
        pg8::gemm_phase<EpiResGate, pg8::StaticOrder, true, true>((LAS unsigned char*)dyn_lds, g, S, E); }
    grid.sync();
    ph_hrows(p, p.out, p.norm2_g, 3072, 4096, gw, ngw, lane);
    grid.sync();
    {   pg8::Gemm g{(const bf16*)(p.ws + WS_H), (const bf16*)(p.ws + WS_WQ), T, 1024, 1024}; pg8::StaticOrder S; S.init(T, 1024, nvb, vb);
        pg8::EpiBf16<0> E{(bf16*)(p.ws + WS_Q3), 1024, nullptr, 0, 0, 1.f};
        pg8::gemm_phase<pg8::EpiBf16<0>, pg8::StaticOrder, true, true>((LAS unsigned char*)dyn_lds, g, S, E); }
    grid.sync();
    ph_route_naive(p, (float*)dyn_lds, vb, nvb);
    grid.sync();
    ph_peer(p, dyn_lds + wv * 1024, gw, ngw, lane);
}

extern "C" void kernel_launch(void* const* d_in, const int* in_sizes, int n_in, void* d_out, int out_size, void* d_ws, size_t ws_size, hipStream_t stream) {
    static int grid_blocks = 0;
    if (grid_blocks == 0) {
        if (n_in != 18 || in_sizes[0] != T * DM || out_size != T * DM || ws_size < WS_END) { fprintf(stderr, "kernel_launch: unexpected shapes n_in %d in0 %d out %d ws %zu\n", n_in, n_in > 0 ? in_sizes[0] : -1, out_size, ws_size); grid_blocks = -1; return; }
        int dev = 0, cus = 0, per_cu = 0;
        (void)hipGetDevice(&dev);
        (void)hipDeviceGetAttribute(&cus, hipDeviceAttributeMultiprocessorCount, dev);
        (void)hipFuncSetAttribute((const void*)mega_fwd, hipFuncAttributeMaxDynamicSharedMemorySize, LDS_BYTES);
        (void)hipOccupancyMaxActiveBlocksPerMultiprocessor(&per_cu, (const void*)mega_fwd, NT, LDS_BYTES);
        if (per_cu < 1 || cus < 1) { fprintf(stderr, "kernel_launch: occupancy query gave %d blocks/CU on %d CUs\n", per_cu, cus); grid_blocks = -1; return; }
        grid_blocks = cus;
    }
    if (grid_blocks < 0) return;
    Params p{};
    const float** pp = (const float**)&p;
    for (int i = 0; i < 18; ++i) pp[i] = (const float*)d_in[i];
    p.out = (float*)d_out; p.ws = (unsigned char*)d_ws;
    void* args[] = {&p};
    const hipError_t e = hipLaunchCooperativeKernel((const void*)mega_fwd, dim3(grid_blocks), dim3(NT), args, LDS_BYTES, stream);
    if (e != hipSuccess) fprintf(stderr, "kernel_launch: cooperative launch failed: %s (grid %d)\n", hipGetErrorString(e), grid_blocks);
}
```

```cpp
#include <hip/hip_runtime.h>
#include <hip/hip_cooperative_groups.h>
#include <cstdio>
#include <cstdint>
#include <cmath>
namespace pg8 {
#define PG8_LAS __attribute__((address_space(3)))
typedef unsigned short bf16_t;
typedef short bf16x8 __attribute__((ext_vector_type(8)));
typedef float f32x4 __attribute__((ext_vector_type(4)));
typedef unsigned u32x4 __attribute__((ext_vector_type(4)));
constexpr int BM = 256, BK = 64, HALF = 128, HTB = HALF * BK * 2  , STAGE_BYTES = 8 * HTB, NXCD = 8, WGM = 8;

__host__ __device__ __forceinline__ int lds_byte(int r, int c) { const int st = (r >> 4) * 2 + (c >> 5), rr = r & 15, cc = c & 31, ob = rr * 64 + cc * 2; return st * 1024 + (ob ^ (((ob >> 9) & 1) << 5)); }
__host__ __device__ __forceinline__ void stage_rc(int b, int& R, int& C) { const int st = b / 1024, sb = b % 1024, swz = sb ^ (((sb >> 9) & 1) << 5); R = (st >> 1) * 16 + swz / 64; C = (st & 1) * 32 + (swz % 64) / 2; }
__host__ __device__ __forceinline__ int perm32(int rho) { const int n = rho >> 4, i = rho & 15; return 8 * (i >> 2) + 4 * n + (i & 3); }

struct Unit { int pm, pn; };
struct Gemm { const bf16_t* A; const bf16_t* Bt; int M, N, K; };

struct StaticOrder {
    int nM, nN, nwg, G, c;
    __host__ __device__ void init(int M, int N, int G_, int c_) { nM = M / BM; nN = N / BM; nwg = nM * nN; G = G_; c = c_; }
    __host__ __device__ bool next(int i, Unit& u) const {
        const long L = (long)i * G + c; if (L >= nwg) return false;
        int wgid = (int)L; { const int q = nwg / NXCD, r = nwg % NXCD, xcd = wgid % NXCD, off = wgid / NXCD; wgid = (xcd < r ? xcd * (q + 1) : r * (q + 1) + (xcd - r) * q) + off; }
        const int nig = WGM * nN, gid = wgid / nig, fm = gid * WGM, gsz = (nM - fm) < WGM ? (nM - fm) : WGM;
        u.pm = fm + ((wgid % nig) % gsz); u.pn = (wgid % nig) / gsz; return true;
    }
    __device__ __forceinline__ void a_ready(const Unit&) const {}
    __device__ __forceinline__ void done(const Unit&) const {}
};

__device__ __forceinline__ unsigned cvt_pk_bf16(float lo, float hi) { unsigned r; asm volatile("v_cvt_pk_bf16_f32 %0, %1, %2" : "=v"(r) : "v"(lo), "v"(hi)); return r; }
typedef float f32x2 __attribute__((ext_vector_type(2)));
__device__ __forceinline__ f32x2 gelu_pk(f32x2 v) {
    const f32x2 av = __builtin_elementwise_abs(v), d = av * 0.2316418882f + 1.0f;
    f32x2 t; t.x = __builtin_amdgcn_rcpf(d.x); t.y = __builtin_amdgcn_rcpf(d.y);
    f32x2 q = t * 0.5307027145f + (-0.7265760135f); q = q * t + 0.7107068705f; q = q * t + (-0.142248368f); q = q * t + 0.127414796f; q = q * t;
    const f32x2 s = (v * v) * (-0.72134752044f);
    f32x2 e; e.x = __builtin_amdgcn_exp2f(s.x); e.y = __builtin_amdgcn_exp2f(s.y);
    const f32x2 m = v * (q * e), r = v - m;
    f32x2 o; o.x = v.x < 0.f ? m.x : r.x; o.y = v.y < 0.f ? m.y : r.y; return o;
}

template <int ACT  > struct EpiBf16 {
    static constexpr bool PERM = true, AFTER_DRAIN = false; static_assert(ACT == 0 || ACT == 1, "EpiBf16: ACT is 0 (none) or 1 (gelu_pk)");
    bf16_t* O; int ldc; const float* bias; int split_cols; size_t split_stride; float scale0;
    __device__ __forceinline__ void operator()(const f32x4 (&acc)[2][2][4][2], const Unit& u, int wr, int wc, int fr, int fq) const {
        const int row0 = u.pm * BM + wr * 64 + fr; int colt = u.pn * BM; bf16_t* base = O;
        float sc = 1.f; if (split_cols) { const int t = colt / split_cols; base += (size_t)t * split_stride; colt -= t * split_cols; if (t == 0) sc = scale0; }
        const int col0 = colt + wc * 32 + 8 * fq, bcol0 = u.pn * BM + wc * 32 + 8 * fq;
        f32x4 bv[2][2];
#pragma unroll
        for (int bj = 0; bj < 2; ++bj)
#pragma unroll
            for (int n = 0; n < 2; ++n) bv[bj][n] = bias ? *(const f32x4*)(bias + bcol0 + bj * HALF + 4 * n) : (f32x4){0.f, 0.f, 0.f, 0.f};
#pragma unroll
        for (int ai = 0; ai < 2; ++ai)
#pragma unroll
            for (int m = 0; m < 4; ++m) { bf16_t* rowp = base + (size_t)(row0 + ai * HALF + m * 16) * ldc + col0;
#pragma unroll
                for (int bj = 0; bj < 2; ++bj) { f32x4 v0 = acc[ai][bj][m][0] + bv[bj][0], v1 = acc[ai][bj][m][1] + bv[bj][1];
                    if (ACT == 1) { f32x2 a = gelu_pk((f32x2){v0[0], v0[1]}), b = gelu_pk((f32x2){v0[2], v0[3]}), c = gelu_pk((f32x2){v1[0], v1[1]}), d = gelu_pk((f32x2){v1[2], v1[3]});
                        v0 = (f32x4){a.x, a.y, b.x, b.y}; v1 = (f32x4){c.x, c.y, d.x, d.y}; }
                    v0 = v0 * sc; v1 = v1 * sc; u32x4 w; w.x = cvt_pk_bf16(v0[0], v0[1]); w.y = cvt_pk_bf16(v0[2], v0[3]); w.z = cvt_pk_bf16(v1[0], v1[1]); w.w = cvt_pk_bf16(v1[2], v1[3]);
                    *(u32x4*)(rowp + bj * HALF) = w; } }
    }
};

template <class Epi, class Sched, bool ALIGN_EPI = false, bool SP2 = false>
__device__ __forceinline__ void gemm_phase(PG8_LAS unsigned char* lds, const Gemm g, const Sched& S, const Epi& E) {
    int tid = threadIdx.x; asm volatile("" : "+v"(tid)); const int wid = __builtin_amdgcn_readfirstlane(tid >> 6), lane = tid & 63, wr = wid >> 2, wc = wid & 3, fr = lane & 15, fq = lane >> 4;
    const int K = g.K, nt = K / BK;
    unsigned voffA[2], voffB[2];
#pragma unroll
    for (int i = 0; i < 2; ++i) { int R, C; stage_rc(tid * 16 + i * 8192, R, C); const int Rb = Epi::PERM ? ((R & ~31) + perm32(R & 31)) : R;
        voffA[i] = (unsigned)(R * K + C) * 2u; voffB[i] = (unsigned)(Rb * K + C) * 2u; }
    const size_t kstep = (size_t)(BK * 2);
    const size_t hstep = (size_t)HALF * K * 2;
    const size_t tstep = 2 * hstep;
    const unsigned ldsw = (unsigned)wid * 1024u;
    const int aoff = lds_byte(wr * 64 + fr, fq * 8), boff = lds_byte(wc * 32 + fr, fq * 8);
#define PG8_SA(b, h) (((b) * 2 + (h)) * HTB)
#define PG8_SB(b, h) ((4 + (b) * 2 + (h)) * HTB)
#define PG8_STAGE(bufoff, gbase, voff) do { _Pragma("unroll") for (int _i = 0; _i < 2; ++_i) \
        __builtin_amdgcn_global_load_lds((const unsigned*)((const char*)(gbase) + (voff)[_i]), (PG8_LAS unsigned*)(lds + (bufoff) + ldsw + _i * 8192), 16, 0, 0); } while (0)
#define PG8_LDA(dst, b, h) do { _Pragma("unroll") for (int m = 0; m < 4; ++m) _Pragma("unroll") for (int k = 0; k < 2; ++k) dst[m][k] = *(const PG8_LAS bf16x8*)(lds + PG8_SA(b, h) + aoff + m * 2048 + k * 1024); } while (0)
#define PG8_LDB(dst, b, h) do { _Pragma("unroll") for (int n = 0; n < 2; ++n) _Pragma("unroll") for (int k = 0; k < 2; ++k) dst[n][k] = *(const PG8_LAS bf16x8*)(lds + PG8_SB(b, h) + boff + n * 2048 + k * 1024); } while (0)
#define PG8_MMA(ai, bj, At, Bt) do { __builtin_amdgcn_s_setprio(1); _Pragma("unroll") for (int m = 0; m < 4; ++m) _Pragma("unroll") for (int n = 0; n < 2; ++n) _Pragma("unroll") for (int k = 0; k < 2; ++k) \
        acc[ai][bj][m][n] = __builtin_amdgcn_mfma_f32_16x16x32_bf16(Bt[n][k], At[m][k], acc[ai][bj][m][n], 0, 0, 0); __builtin_amdgcn_s_setprio(0); } while (0)
#define PG8_WAIT_V(n) asm volatile("s_waitcnt vmcnt(" #n ")" ::: "memory")
#define PG8_WAIT_L(n) asm volatile("s_waitcnt lgkmcnt(" #n ")" ::: "memory")
#define PG8_BAR __builtin_amdgcn_s_barrier()
#define PG8_SCHED __builtin_amdgcn_sched_barrier(0)
    Unit cur, nxt; int ui = 0;
    if (!S.next(0, cur)) return;
    f32x4 acc[2][2][4][2];
#pragma unroll
    for (int a = 0; a < 2; ++a)
#pragma unroll
        for (int b = 0; b < 2; ++b)
#pragma unroll
            for (int m = 0; m < 4; ++m)
#pragma unroll
                for (int n = 0; n < 2; ++n) acc[a][b][m][n] = (f32x4){0.f, 0.f, 0.f, 0.f};
    bf16x8 At[4][2], B0[2][2], B1[2][2];
    const char* cA = (const char*)g.A + (size_t)cur.pm * tstep; const char* cB = (const char*)g.Bt + (size_t)cur.pn * tstep;
    S.a_ready(cur);
    if constexpr (SP2) {
        PG8_STAGE(PG8_SB(0, 0), cB, voffB); PG8_STAGE(PG8_SB(0, 1), cB + hstep, voffB); PG8_STAGE(PG8_SA(0, 0), cA, voffA); PG8_STAGE(PG8_SA(0, 1), cA + hstep, voffA);
        if (wr == 1) PG8_BAR;
        PG8_WAIT_V(2); PG8_BAR;
        PG8_STAGE(PG8_SB(1, 0), cB + kstep, voffB); PG8_STAGE(PG8_SA(1, 0), cA + kstep, voffA); PG8_STAGE(PG8_SB(1, 1), cB + hstep + kstep, voffB);
        PG8_WAIT_V(6); PG8_BAR;
    } else {
        PG8_STAGE(PG8_SB(0, 0), cB, voffB); PG8_STAGE(PG8_SA(0, 0), cA, voffA); PG8_STAGE(PG8_SB(0, 1), cB + hstep, voffB); PG8_STAGE(PG8_SA(0, 1), cA + hstep, voffA);
        if (wr == 1) PG8_BAR;
        PG8_WAIT_V(4); PG8_BAR;
        PG8_STAGE(PG8_SB(1, 0), cB + kstep, voffB); PG8_STAGE(PG8_SA(1, 0), cA + kstep, voffA); PG8_STAGE(PG8_SB(1, 1), cB + hstep + kstep, voffB);
        PG8_WAIT_V(6); PG8_BAR;
    }
    for (;;) {
        const bool has_next = S.next(ui + 1, nxt);
        const char* nA = has_next ? (const char*)g.A + (size_t)nxt.pm * tstep : cA; const char* nB = has_next ? (const char*)g.Bt + (size_t)nxt.pn * tstep : cB;
        for (int t = 0; t < nt; t += 2) {
            const bool last = (t == nt - 2);
            const char* a1 = cA + (size_t)(t + 1) * kstep;
            const char* a2 = last ? nA : cA + (size_t)(t + 2) * kstep; const char* b2 = last ? nB : cB + (size_t)(t + 2) * kstep;
            const char* a3 = a2 + kstep; const char* b3 = b2 + kstep;
            if (last && has_next) S.a_ready(nxt);
            if constexpr (SP2) {
            PG8_LDB(B0, 0, 0); PG8_LDB(B1, 0, 1); PG8_SCHED; PG8_LDA(At, 0, 0); PG8_STAGE(PG8_SA(1, 1), a1 + hstep, voffA);
            PG8_WAIT_V(8); PG8_WAIT_L(0); PG8_BAR; PG8_MMA(0, 0, At, B0); PG8_MMA(0, 1, At, B1); PG8_BAR; PG8_SCHED;
            PG8_LDA(At, 0, 1); PG8_STAGE(PG8_SB(0, 0), b2, voffB); PG8_STAGE(PG8_SB(0, 1), b2 + hstep, voffB); PG8_STAGE(PG8_SA(0, 0), a2, voffA);
            PG8_WAIT_V(8); PG8_WAIT_L(0); PG8_BAR; PG8_MMA(1, 0, At, B0); PG8_MMA(1, 1, At, B1); PG8_BAR; PG8_SCHED;
            PG8_LDB(B0, 1, 0); PG8_LDB(B1, 1, 1); PG8_SCHED; PG8_LDA(At, 1, 0); PG8_STAGE(PG8_SA(0, 1), a2 + hstep, voffA);
            PG8_WAIT_V(8); PG8_WAIT_L(0); PG8_BAR; PG8_MMA(0, 0, At, B0); PG8_MMA(0, 1, At, B1); PG8_BAR; PG8_SCHED;
            PG8_LDA(At, 1, 1); PG8_STAGE(PG8_SB(1, 0), b3, voffB); PG8_STAGE(PG8_SB(1, 1), b3 + hstep, voffB); PG8_STAGE(PG8_SA(1, 0), a3, voffA);
            PG8_WAIT_V(8); PG8_WAIT_L(0); PG8_BAR; PG8_MMA(1, 0, At, B0); PG8_MMA(1, 1, At, B1); PG8_BAR; PG8_SCHED;
            } else {
            PG8_LDB(B0, 0, 0); PG8_SCHED; PG8_LDA(At, 0, 0); PG8_STAGE(PG8_SA(1, 1), a1 + hstep, voffA);
            PG8_WAIT_L(8); PG8_BAR; PG8_WAIT_L(0); PG8_MMA(0, 0, At, B0); PG8_BAR; PG8_SCHED;
            PG8_LDB(B1, 0, 1); PG8_STAGE(PG8_SB(0, 0), b2, voffB);
            PG8_BAR; PG8_WAIT_L(0); PG8_MMA(0, 1, At, B1); PG8_BAR;
            PG8_LDA(At, 0, 1); PG8_STAGE(PG8_SA(0, 0), a2, voffA);
            PG8_BAR; PG8_WAIT_L(0); PG8_MMA(1, 0, At, B0); PG8_BAR; PG8_SCHED;
            PG8_STAGE(PG8_SB(0, 1), b2 + hstep, voffB);
            PG8_WAIT_V(6); PG8_BAR; PG8_MMA(1, 1, At, B1); PG8_BAR;
            PG8_LDB(B0, 1, 0); PG8_SCHED; PG8_LDA(At, 1, 0); PG8_STAGE(PG8_SA(0, 1), a2 + hstep, voffA);
            PG8_WAIT_L(8); PG8_BAR; PG8_WAIT_L(0); PG8_MMA(0, 0, At, B0); PG8_BAR; PG8_SCHED;
            PG8_LDB(B1, 1, 1); PG8_STAGE(PG8_SB(1, 0), b3, voffB);
            PG8_BAR; PG8_WAIT_L(0); PG8_MMA(0, 1, At, B1); PG8_BAR;
            PG8_LDA(At, 1, 1); PG8_STAGE(PG8_SA(1, 0), a3, voffA);
            PG8_BAR; PG8_WAIT_L(0); PG8_MMA(1, 0, At, B0); PG8_BAR; PG8_SCHED;
            PG8_STAGE(PG8_SB(1, 1), b3 + hstep, voffB);
            PG8_WAIT_V(6); PG8_BAR; PG8_MMA(1, 1, At, B1); PG8_BAR;
            }
        }
        if constexpr (ALIGN_EPI) { if (wr == 0) PG8_BAR; }
        if constexpr (!Epi::AFTER_DRAIN) { E(acc, cur, wr, wc, fr, fq); S.done(cur); }
        if (!has_next) break;
#pragma unroll
        for (int a = 0; a < 2; ++a)
#pragma unroll
            for (int b = 0; b < 2; ++b)
#pragma unroll
                for (int m = 0; m < 4; ++m)
#pragma unroll
                    for (int n = 0; n < 2; ++n) acc[a][b][m][n] = (f32x4){0.f, 0.f, 0.f, 0.f};
        cur = nxt; cA = nA; cB = nB; ++ui;
        if constexpr (ALIGN_EPI) { if (wr == 1) PG8_BAR; }
    }
    PG8_WAIT_V(0);
    if constexpr (!ALIGN_EPI) { if (wr == 0) PG8_BAR; }
    PG8_BAR;
    if constexpr (Epi::AFTER_DRAIN) { E.fused(acc, cur, wr, wc, fr, fq, lds, wid, lane); S.done(cur); }
#undef PG8_SA
#undef PG8_SB
#undef PG8_STAGE
#undef PG8_LDA
#undef PG8_LDB
#undef PG8_MMA
#undef PG8_WAIT_V
#undef PG8_WAIT_L
#undef PG8_BAR
#undef PG8_SCHED
}
}
namespace cg = cooperative_groups;
#define LAS __attribute__((address_space(3)))
typedef unsigned short bf16;
typedef float f32x4 __attribute__((ext_vector_type(4)));
typedef float f32x8 __attribute__((ext_vector_type(8)));
typedef float f32x16 __attribute__((ext_vector_type(16)));
typedef unsigned u32x4 __attribute__((ext_vector_type(4)));
typedef unsigned u32x2 __attribute__((ext_vector_type(2)));
typedef short bf16x8 __attribute__((ext_vector_type(8)));
typedef short s16x4 __attribute__((ext_vector_type(4)));

constexpr int BATCH = 16, SEQ = 2048, DM = 1024, T = BATCH * SEQ;
constexpr int NP = 3072;
constexpr int IN_COLS = 3012;
constexpr int C_QA = 0, C_KA = 512, C_VA = 1024, C_QB = 1536, C_KV = 2560, C_QI = 2688, C_KI = 2944, C_WI = 3008;
constexpr int MIXW = 1536;
constexpr int NEXP = 16384;
constexpr float EPS = 1e-6f;
constexpr int NT = 512;
constexpr int NWV = 8;

constexpr size_t MiB = 1u << 20;
constexpr size_t WS_CTL = 0;
constexpr size_t CTL_BYTES = 64 * 1024;
constexpr size_t WS_MOD = 1 * MiB;
constexpr size_t WS_SCAL = WS_MOD + 512 * 1024;
constexpr size_t WS_WIN = 2 * MiB;
constexpr size_t WS_WO2 = 8 * MiB;
constexpr size_t WS_WQ = 11 * MiB;
constexpr size_t WS_SUBK = 13 * MiB;
constexpr size_t WS_U16 = 14 * MiB;
constexpr size_t WS_V16 = 46 * MiB;
constexpr size_t WS_H = 78 * MiB;
constexpr size_t WS_PROJ = 142 * MiB;
constexpr size_t WS_Q3 = WS_PROJ;
constexpr size_t WS_MIX = 334 * MiB;
constexpr size_t WS_EXP = 430 * MiB;
constexpr size_t WS_GATE = 446 * MiB;
constexpr size_t WS_ATMP = 462 * MiB;
constexpr size_t WS_END = 494 * MiB;

struct Params {
    const float *x, *c, *ada_w, *ada_b, *norm1_g, *norm2_g, *w_in, *a_qk_gain, *a_lambda, *a_sub_gain, *b_q_gain, *b_kv_gain, *b_w_uv, *w_out, *peer_wq, *peer_subkeys, *peer_u, *peer_v;
    float* out; unsigned char* ws;
};

enum { SC_LAM = 0, SC_MA = 1, SC_MB = 2 };

__device__ __forceinline__ unsigned f2bf(float f) { unsigned u = __float_as_uint(f); return (u + 0x7fffu + ((u >> 16) & 1u)) >> 16; }
__device__ __forceinline__ float bf2f(unsigned h) { return __uint_as_float(h << 16); }
__device__ __forceinline__ unsigned pk2(float lo, float hi) { return f2bf(lo) | (f2bf(hi) << 16); }
__device__ __forceinline__ float bflo(unsigned w) { return __uint_as_float(w << 16); }
__device__ __forceinline__ float bfhi(unsigned w) { return __uint_as_float(w & 0xffff0000u); }
__device__ __forceinline__ float wave_sum(float v) {
#pragma unroll
    for (int o = 1; o < 64; o <<= 1) v += __shfl_xor(v, o);
    return v;
}
__device__ __forceinline__ float wave_max(float v) {
#pragma unroll
    for (int o = 1; o < 64; o <<= 1) v = fmaxf(v, __shfl_xor(v, o));
    return v;
}
#define LDS_WAIT() asm volatile("s_waitcnt lgkmcnt(0)" ::: "memory")
__device__ __forceinline__ void ph_mod(const Params& p, float* ldsf, int vb, int nvb) {
    if (vb >= 12) return;
    const int tid = threadIdx.x;
    for (int i = tid; i < 16 * 1024; i += NT) { const float v = p.c[i]; ldsf[i] = v / (1.f + __expf(-v)); }
    __syncthreads();
    float* MOD = (float*)(p.ws + WS_MOD);
    for (int it = vb; it < 12; it += nvb) {
        const int j = it * 512 + tid;
        float acc[16];
#pragma unroll
        for (int b = 0; b < 16; ++b) acc[b] = 0.f;
        for (int k = 0; k < 1024; ++k) {
            const float w = p.ada_w[(size_t)k * 6144 + j];
#pragma unroll
            for (int b = 0; b < 16; ++b) acc[b] = fmaf(ldsf[b * 1024 + k], w, acc[b]);
        }
        const float bb = p.ada_b[j];
#pragma unroll
        for (int b = 0; b < 16; ++b) MOD[b * 6144 + j] = acc[b] + bb;
    }
    __syncthreads();
}

__device__ __forceinline__ void transpose_item(const float* W, int N, bf16* WT, int ldt, LAS float* scr, int kb, int nb, int lane) {
    const int k0 = 64 * kb, n0 = 32 * nb;
#pragma unroll 8
    for (int i = 0; i < 32; ++i) { const int kk = 2 * i + (lane >> 5); const int n = n0 + (lane & 31); scr[kk * 33 + (lane & 31)] = (n < N) ? W[(size_t)(k0 + kk) * N + n] : 0.f; }
    LDS_WAIT(); asm volatile("" ::: "memory");
    const int c = lane & 7;
#pragma unroll
    for (int j = 0; j < 4; ++j) { const int n = (lane >> 3) + 8 * j; const LAS float* s = scr + (8 * c) * 33 + n;
        u32x4 o; o.x = pk2(s[0 * 33], s[1 * 33]); o.y = pk2(s[2 * 33], s[3 * 33]); o.z = pk2(s[4 * 33], s[5 * 33]); o.w = pk2(s[6 * 33], s[7 * 33]);
        *(u32x4*)(WT + (size_t)(n0 + n) * ldt + k0 + 8 * c) = o; }
    LDS_WAIT(); asm volatile("" ::: "memory");
}

__device__ __forceinline__ void ph_prep_weights(const Params& p, LAS float* scr, int gw, int ngw, int lane) {
    bf16* WIN = (bf16*)(p.ws + WS_WIN); bf16* WO2 = (bf16*)(p.ws + WS_WO2); bf16* WQ = (bf16*)(p.ws + WS_WQ);
    constexpr int I_IN = 16 * 96, I_O = 8 * 32, I_Q = 16 * 32;
    for (int it = gw; it < I_IN + I_O + I_Q; it += ngw) {
        int r = it;
        if (r < I_IN) { transpose_item(p.w_in, IN_COLS, WIN, 1024, scr, r / 96, r % 96, lane); continue; } r -= I_IN;
        if (r < I_O) { transpose_item(p.w_out, 1024, WO2, MIXW, scr, r / 32, r % 32, lane); continue; } r -= I_O;
        transpose_item(p.peer_wq, 1024, WQ, 1024, scr, r / 32, r % 32, lane);
    }
    const size_t gt = (size_t)gw * 64 + lane, ngt = (size_t)ngw * 64;
    for (size_t i = gt; i < (size_t)1024 * 1024; i += ngt) {
        const int n = (int)(i & 1023), kk = (int)(i >> 10), h = kk >> 7;
        const float* wu = p.b_w_uv + (size_t)kk * 64; const float* wo = p.w_out + (size_t)(512 + 64 * h) * 1024 + n;
        float a = 0.f;
#pragma unroll 8
        for (int e = 0; e < 64; ++e) a = fmaf(wu[e], wo[(size_t)e * 1024], a);
        WO2[(size_t)n * MIXW + 512 + kk] = (bf16)f2bf(a);
    }
    bf16* U16 = (bf16*)(p.ws + WS_U16); bf16* V16 = (bf16*)(p.ws + WS_V16); bf16* SUBK = (bf16*)(p.ws + WS_SUBK);
    constexpr size_t NTAB8 = (size_t)NEXP * 1024 / 8, NSUB8 = 2 * 128 * 64 / 8;
    for (size_t i = gt; i < 2 * NTAB8 + NSUB8; i += ngt) {
        const float* src; bf16* dst; size_t j = i;
        if (j < NTAB8) { src = p.peer_u; dst = U16; } else if (j < 2 * NTAB8) { j -= NTAB8; src = p.peer_v; dst = V16; } else { j -= 2 * NTAB8; src = p.peer_subkeys; dst = SUBK; }
        const f32x8 v = *(const f32x8*)(src + j * 8);
        u32x4 o; o.x = pk2(v[0], v[1]); o.y = pk2(v[2], v[3]); o.z = pk2(v[4], v[5]); o.w = pk2(v[6], v[7]);
        *(u32x4*)(dst + j * 8) = o;
    }
    if (gt == 0) {
        float* SC = (float*)(p.ws + WS_SCAL);
        float s01 = 0.f, s23 = 0.f;
        for (int i = 0; i < 64; ++i) { s01 += p.a_lambda[i] * p.a_lambda[64 + i]; s23 += p.a_lambda[128 + i] * p.a_lambda[192 + i]; }
        SC[SC_LAM] = __expf(s01) - __expf(s23) + 0.2f;
        float g0 = 0.f, g1 = 0.f, gq = 0.f, gk = 0.f;
        for (int i = 0; i < 64; ++i) { g0 = fmaxf(g0, fabsf(p.a_qk_gain[i])); g1 = fmaxf(g1, fabsf(p.a_qk_gain[64 + i])); }
        for (int i = 0; i < 128; ++i) { gq = fmaxf(gq, fabsf(p.b_q_gain[i])); gk = fmaxf(gk, fabsf(p.b_kv_gain[i])); }
        SC[SC_MA] = 8.0f * g0 * g1 * 1.02f;
        SC[SC_MB] = 11.3137085f * gq * gk * 1.02f;
    }
}

__device__ __forceinline__ void ph_hrows(const Params& p, const float* X, const float* g, int shOff, int scOff, int gw, int ngw, int lane) {
    const float* MOD = (const float*)(p.ws + WS_MOD); bf16* H = (bf16*)(p.ws + WS_H);
    for (int m = gw; m < T; m += ngw) {
        const f32x4* xr = (const f32x4*)(X + (size_t)m * 1024) + lane;
        f32x4 v[4]; float s = 0.f;
#pragma unroll
        for (int j = 0; j < 4; ++j) { v[j] = xr[64 * j]; s += (v[j].x * v[j].x + v[j].y * v[j].y) + (v[j].z * v[j].z + v[j].w * v[j].w); }
        const float rstd = rsqrtf(wave_sum(s) * (1.f / 1024.f) + EPS);
        const float* mb = MOD + (size_t)(m >> 11) * 6144;
#pragma unroll
        for (int j = 0; j < 4; ++j) {
            const int col = 4 * (lane + 64 * j);
            const f32x4 gg = *(const f32x4*)(g + col), sc = *(const f32x4*)(mb + scOff + col), sh = *(const f32x4*)(mb + shOff + col);
            const f32x4 y = v[j] * rstd * gg * (sc + 1.0f) + sh;
            u32x2 o; o.x = pk2(y.x, y.y); o.y = pk2(y.z, y.w);
            *(u32x2*)(H + (size_t)m * 1024 + col) = o;
        }
    }
}

__device__ __forceinline__ void ph_norm_proj(const Params& p, int gw, int ngw, int lane) {
    bf16* PROJ = (bf16*)(p.ws + WS_PROJ);
    for (int m = gw; m < T; m += ngw) {
        bf16* row = PROJ + (size_t)m * NP;
#pragma unroll
        for (int j = 0; j < 6; ++j) {
            if (j == 2) continue;
            const int col = 8 * lane + 512 * j;
            const u32x4 raw = *(const u32x4*)(row + col);
            float v[8] = {bflo(raw.x), bfhi(raw.x), bflo(raw.y), bfhi(raw.y), bflo(raw.z), bfhi(raw.z), bflo(raw.w), bfhi(raw.w)};
            float ss = 0.f;
#pragma unroll
            for (int i = 0; i < 8; ++i) ss += v[i] * v[i];
            ss += __shfl_xor(ss, 1); ss += __shfl_xor(ss, 2); ss += __shfl_xor(ss, 4);
            float rstd; const float* gp;
            if (j < 2) { rstd = rsqrtf(ss * (1.f / 64.f) + EPS); gp = p.a_qk_gain + 64 * j + (col & 63); }
            else { ss += __shfl_xor(ss, 8); rstd = rsqrtf(ss * (1.f / 128.f) + EPS); gp = (j == 5 ? p.b_kv_gain : p.b_q_gain) + (col & 127); }
            if (j == 5 && lane >= 16) continue;
            const f32x4 g0 = *(const f32x4*)gp, g1 = *(const f32x4*)(gp + 4);
            u32x4 o; o.x = pk2(v[0] * rstd * g0.x, v[1] * rstd * g0.y); o.y = pk2(v[2] * rstd * g0.z, v[3] * rstd * g0.w);
            o.z = pk2(v[4] * rstd * g1.x, v[5] * rstd * g1.y); o.w = pk2(v[6] * rstd * g1.z, v[7] * rstd * g1.w);
            *(u32x4*)(row + col) = o;
        }
    }
}
__device__ void ph_attnA_naive(const Params& p, float* lds_w, int gw, int ngw, int lane) {
    const bf16* PROJ = (const bf16*)(p.ws + WS_PROJ); bf16* MIX = (bf16*)(p.ws + WS_MIX);
    const float lam = ((const float*)(p.ws + WS_SCAL))[SC_LAM];
    float* qs = lds_w; float* sc0 = lds_w + 128; float* sc1 = sc0 + 2048;
    for (int it = gw; it < BATCH * 4 * SEQ; it += ngw) {
        const int t = it & 2047, h = (it >> 11) & 3, b = it >> 13;
        const int cend = ((t >> 6) + 1) << 6;
        const float slope = exp2f(-2.0f * (h + 1));
        const bf16* qrow = PROJ + (size_t)(b * SEQ + t) * NP + C_QA + h * 128;
        qs[lane] = bf2f(qrow[lane]); qs[64 + lane] = bf2f(qrow[64 + lane]);
        LDS_WAIT(); asm volatile("" ::: "memory");
        float m0 = -3e38f, m1 = -3e38f;
        for (int kk = lane; kk < cend; kk += 64) {
            const bf16* krow = PROJ + (size_t)(b * SEQ + kk) * NP + C_KA + h * 128;
            float d0 = 0.f, d1 = 0.f;
            for (int d = 0; d < 64; ++d) { d0 = fmaf(qs[d], bf2f(krow[d]), d0); d1 = fmaf(qs[64 + d], bf2f(krow[64 + d]), d1); }
            const float bias = slope * fabsf((float)(t - kk));
            d0 = d0 * 0.125f - bias; d1 = d1 * 0.125f - bias;
            sc0[kk] = d0; sc1[kk] = d1; m0 = fmaxf(m0, d0); m1 = fmaxf(m1, d1);
        }
        m0 = wave_max(m0); m1 = wave_max(m1);
        float l0 = 0.f, l1 = 0.f;
        for (int kk = lane; kk < cend; kk += 64) { const float e0 = __expf(sc0[kk] - m0), e1 = __expf(sc1[kk] - m1); sc0[kk] = e0; sc1[kk] = e1; l0 += e0; l1 += e1; }
        l0 = wave_sum(l0); l1 = wave_sum(l1);
        const float i0 = 1.f / l0, i1 = lam / l1;
        for (int kk = lane; kk < cend; kk += 64) sc0[kk] = sc0[kk] * i0 - sc1[kk] * i1;
        LDS_WAIT(); asm volatile("" ::: "memory");
        float a0 = 0.f, a1 = 0.f;
        const bf16* vb = PROJ + (size_t)(b * SEQ) * NP + C_VA + h * 128;
        for (int kk = 0; kk < cend; ++kk) { const float a = sc0[kk]; const bf16* vr = vb + (size_t)kk * NP; a0 = fmaf(a, bf2f(vr[lane]), a0); a1 = fmaf(a, bf2f(vr[64 + lane]), a1); }
        const float ss = wave_sum(a0 * a0 + a1 * a1);
        const float rstd = rsqrtf(ss * (1.f / 128.f) + EPS) * 0.8f;
        bf16* orow = MIX + (size_t)(b * SEQ + t) * MIXW + h * 128;
        orow[lane] = (bf16)f2bf(a0 * rstd * p.a_sub_gain[lane]); orow[64 + lane] = (bf16)f2bf(a1 * rstd * p.a_sub_gain[64 + lane]);
        LDS_WAIT(); asm volatile("" ::: "memory");
    }
}

__device__ void ph_dsa_naive(const Params& p, float* lds, int vb, int nvb) {
    const bf16* PROJ = (const bf16*)(p.ws + WS_PROJ); bf16* MIX = (bf16*)(p.ws + WS_MIX);
    const int tid = threadIdx.x, lane = tid & 63, wv = tid >> 6;
    float* scores = lds; int* sel = (int*)(lds + 2048); float* qi = lds + 2048 + 256; float* wi = qi + 256;
    float* qh = wi + 64 + wv * 384; float* pw = qh + 128;
    for (int it = vb; it < T; it += nvb) {
        const int b = it >> 11, t = it & 2047; const int cend = ((t >> 6) + 1) << 6;
        const bf16* row = PROJ + (size_t)it * NP;
        if (tid < 256) qi[tid] = bf2f(row[C_QI + tid]);
        if (tid < 4) wi[tid] = bf2f(row[C_WI + tid]);
        __syncthreads();
        for (int kk = tid; kk < cend; kk += NT) {
            const bf16* kr = PROJ + (size_t)(b * SEQ + kk) * NP + C_KI;
            float s = 0.f;
            for (int h = 0; h < 4; ++h) { float d = 0.f; for (int e = 0; e < 64; ++e) d = fmaf(qi[h * 64 + e], bf2f(kr[e]), d); s += fmaxf(d, 0.f) * wi[h]; }
            scores[kk] = s * 0.0625f;
        }
        __syncthreads();
        int nvalid;
        if (cend <= 256) { if (tid < 256) sel[tid] = tid; nvalid = cend; }
        else {
            for (int i = tid; i < cend; i += NT) { const float si = scores[i]; int rank = 0;
                for (int j = 0; j < cend; ++j) { const float sj = scores[j]; rank += (sj > si || (sj == si && j < i)) ? 1 : 0; }
                if (rank < 256) sel[rank] = i; }
            nvalid = 256;
        }
        __syncthreads();
        {
            const int h = wv; const float slope = exp2f(-(float)(h + 1));
            qh[lane] = bf2f(row[C_QB + h * 128 + lane]); qh[64 + lane] = bf2f(row[C_QB + h * 128 + 64 + lane]);
            LDS_WAIT(); asm volatile("" ::: "memory");
            float sv[4]; float mx = -3e38f;
#pragma unroll
            for (int jj = 0; jj < 4; ++jj) { const int j = lane + 64 * jj; const int key = sel[j < nvalid ? j : 0];
                const bf16* kv = PROJ + (size_t)(b * SEQ + key) * NP + C_KV; float d = 0.f;
                for (int e = 0; e < 128; ++e) d = fmaf(qh[e], bf2f(kv[e]), d);
                d = d * 0.0883883476f - slope * fabsf((float)(t - key));
                sv[jj] = (j < nvalid) ? d : -3e38f; mx = fmaxf(mx, sv[jj]); }
            mx = wave_max(mx); float l = 0.f;
#pragma unroll
            for (int jj = 0; jj < 4; ++jj) { const int j = lane + 64 * jj; const float e = (j < nvalid) ? __expf(sv[jj] - mx) : 0.f; pw[j] = e; l += e; }
            l = wave_sum(l);
            LDS_WAIT(); asm volatile("" ::: "memory");
            float a0 = 0.f, a1 = 0.f;
            for (int j = 0; j < nvalid; ++j) { const float pj = pw[j]; const bf16* kv = PROJ + (size_t)(b * SEQ + sel[j]) * NP + C_KV; a0 = fmaf(pj, bf2f(kv[lane]), a0); a1 = fmaf(pj, bf2f(kv[64 + lane]), a1); }
            const float il = 1.f / l;
            bf16* orow = MIX + (size_t)it * MIXW + 512 + h * 128;
            orow[lane] = (bf16)f2bf(a0 * il); orow[64 + lane] = (bf16)f2bf(a1 * il);
        }
        __syncthreads();
    }
}

__device__ void ph_route_naive(const Params& p, float* lds, int vb, int nvb) {
    const bf16* Q3 = (const bf16*)(p.ws + WS_Q3); const bf16* SUBK = (const bf16*)(p.ws + WS_SUBK);
    int* EXPI = (int*)(p.ws + WS_EXP); float* GATE = (float*)(p.ws + WS_GATE);
    const int tid = threadIdx.x;
    float* q = lds; float* sub = q + 1024; float* sv = sub + 2048; int* si = (int*)(sv + 256); float* cand = sv + 512; float* ts = cand + 2048; int* te = (int*)(ts + 128);
    for (int it = vb; it < T; it += nvb) {
        q[tid] = bf2f(Q3[(size_t)it * 1024 + tid]); q[tid + 512] = bf2f(Q3[(size_t)it * 1024 + tid + 512]);
        __syncthreads();
        for (int r = 0; r < 4; ++r) { const int idx = tid + 512 * r, h = idx >> 8, c = (idx >> 7) & 1, n = idx & 127;
            const float* qq = q + h * 128 + c * 64; const bf16* kk = SUBK + (size_t)(c * 128 + n) * 64; float d = 0.f;
            for (int e = 0; e < 64; ++e) d = fmaf(qq[e], bf2f(kk[e]), d);
            sub[idx] = d; }
        __syncthreads();
        for (int r = 0; r < 4; ++r) { const int idx = tid + 512 * r, g0 = idx & ~127, n = idx & 127; const float s = sub[idx]; int rank = 0;
            for (int j = 0; j < 128; ++j) { const float sj = sub[g0 + j]; rank += (sj > s || (sj == s && j < n)) ? 1 : 0; }
            if (rank < 16) { sv[(g0 >> 7) * 16 + rank] = s; si[(g0 >> 7) * 16 + rank] = n; } }
        __syncthreads();
        for (int r = 0; r < 4; ++r) { const int idx = tid + 512 * r, h = idx >> 8, i = (idx >> 4) & 15, j = idx & 15; cand[idx] = sv[(h * 2) * 16 + i] + sv[(h * 2 + 1) * 16 + j]; }
        __syncthreads();
        for (int r = 0; r < 4; ++r) { const int idx = tid + 512 * r, h = idx >> 8, ij = idx & 255; const float s = cand[idx]; int rank = 0;
            for (int j = 0; j < 256; ++j) { const float sj = cand[h * 256 + j]; rank += (sj > s || (sj == s && j < ij)) ? 1 : 0; }
            if (rank < 16) { ts[h * 16 + rank] = s; te[h * 16 + rank] = si[(h * 2) * 16 + (ij >> 4)] * 128 + si[(h * 2 + 1) * 16 + (ij & 15)]; } }
        __syncthreads();
        if (tid < 128) { const int h = tid >> 4; const float mx = ts[h * 16]; float l = 0.f;
            for (int k = 0; k < 16; ++k) l += __expf(ts[h * 16 + k] - mx);
            GATE[(size_t)it * 128 + tid] = __expf(ts[tid] - mx) / l; EXPI[(size_t)it * 128 + tid] = te[tid]; }
        __syncthreads();
    }
}

__device__ void ph_peer_naive(const Params& p, float* lds, int vb, int nvb) {
    const bf16* H = (const bf16*)(p.ws + WS_H); const bf16* U16 = (const bf16*)(p.ws + WS_U16); const bf16* V16 = (const bf16*)(p.ws + WS_V16);
    const int* EXPI = (const int*)(p.ws + WS_EXP); const float* GATE = (const float*)(p.ws + WS_GATE); const float* MOD = (const float*)(p.ws + WS_MOD);
    const int tid = threadIdx.x, lane = tid & 63, wv = tid >> 6;
    float* xs = lds; float* coef = lds + 1024; int* ex = (int*)(coef + 128);
    for (int it = vb; it < T; it += nvb) {
        xs[tid] = bf2f(H[(size_t)it * 1024 + tid]); xs[tid + 512] = bf2f(H[(size_t)it * 1024 + tid + 512]);
        if (tid < 128) ex[tid] = EXPI[(size_t)it * 128 + tid];
        __syncthreads();
        for (int jj = 0; jj < 16; ++jj) { const int j = wv * 16 + jj; const bf16* ur = U16 + (size_t)ex[j] * 1024; float d = 0.f;
            for (int i = 0; i < 16; ++i) d = fmaf(xs[lane + 64 * i], bf2f(ur[lane + 64 * i]), d);
            d = wave_sum(d);
            if (lane == 0) coef[j] = 0.5f * d * (1.f + erff(d * 0.70710678f)) * GATE[(size_t)it * 128 + j]; }
        __syncthreads();
        const float* g2 = MOD + (size_t)(it >> 11) * 6144 + 5120;
        for (int r = 0; r < 2; ++r) { const int d = tid + 512 * r; float a = 0.f;
            for (int j = 0; j < 128; ++j) a = fmaf(coef[j], bf2f(V16[(size_t)ex[j] * 1024 + d]), a);
            p.out[(size_t)it * 1024 + d] = p.out[(size_t)it * 1024 + d] + g2[d] * a; }
        __syncthreads();
    }
}
struct EpiResGate {
    static constexpr bool PERM = false, AFTER_DRAIN = false;
    const float* X; float* Out; const float* gate;
    __device__ __forceinline__ void operator()(const pg8::f32x4 (&acc)[2][2][4][2], const pg8::Unit& u, int wr, int wc, int fr, int fq) const {
        const int col0 = u.pn * 256 + wc * 32 + 4 * fq;
#pragma unroll
        for (int ai = 0; ai < 2; ++ai)
#pragma unroll
            for (int m = 0; m < 4; ++m) {
                const int r = u.pm * 256 + ai * 128 + wr * 64 + m * 16 + fr; const float* gb = gate + (size_t)(r >> 11) * 6144;
#pragma unroll
                for (int bj = 0; bj < 2; ++bj)
#pragma unroll
                    for (int n = 0; n < 2; ++n) { const int c = col0 + bj * 128 + n * 16; const size_t off = (size_t)r * 1024 + c;
                        const pg8::f32x4 xv = *(const pg8::f32x4*)(X + off), gv = *(const pg8::f32x4*)(gb + c);
                        *(pg8::f32x4*)(Out + off) = xv + gv * acc[ai][bj][m][n]; }
            }
    }
};

typedef __bf16 bf16x2_t __attribute__((ext_vector_type(2)));
__device__ __forceinline__ float dot2bf(unsigned a, unsigned b, float acc) { return __builtin_amdgcn_fdot2_f32_bf16(__builtin_bit_cast(bf16x2_t, a), __builtin_bit_cast(bf16x2_t, b), acc, false); }
template <int CTRL> __device__ __forceinline__ float dpp_f(float v) { return __int_as_float(__builtin_amdgcn_update_dpp(0, __float_as_int(v), CTRL, 0xf, 0xf, false)); }
__device__ __forceinline__ float row16_sum(float v) {
    v += dpp_f<0x128>(v); v += dpp_f<0x124>(v); v += dpp_f<0x122>(v); v += dpp_f<0x121>(v); return v;
}
__device__ __forceinline__ float gelu_erf(float a) { return 0.5f * a * (1.f + erff(a * 0.70710678118f)); }

__device__ __forceinline__ void ph_peer(const Params& p, unsigned char* lds_w, int gw, int ngw, int lane_) {
    int lane = lane_; asm volatile("" : "+v"(lane));
    const bf16* H = (const bf16*)(p.ws + WS_H); const bf16* U16 = (const bf16*)(p.ws + WS_U16); const bf16* V16 = (const bf16*)(p.ws + WS_V16);
    const int* EXPI = (const int*)(p.ws + WS_EXP); const float* GATE = (const float*)(p.ws + WS_GATE); const float* MOD = (const float*)(p.ws + WS_MOD);
    int* e_lds = (int*)lds_w; float* a_lds = (float*)(lds_w + 512);
    const int g = lane >> 4, i = lane & 15;
    for (int t = gw; t < T; t += ngw) {
        const int e0 = EXPI[(size_t)t * 128 + lane], e1 = EXPI[(size_t)t * 128 + 64 + lane];
        const float g0 = GATE[(size_t)t * 128 + lane], g1 = GATE[(size_t)t * 128 + 64 + lane];
        e_lds[lane] = e0; e_lds[64 + lane] = e1;
        u32x4 xr[8];
        const u32x4* xrow = (const u32x4*)(H + (size_t)t * 1024) + i;
#pragma unroll
        for (int k = 0; k < 8; ++k) xr[k] = xrow[16 * k];
        LDS_WAIT(); asm volatile("" ::: "memory");
        u32x4 ua[8], ub[8];
        { const u32x4* ur = (const u32x4*)(U16 + (size_t)e_lds[g] * 1024) + i;
#pragma unroll
          for (int k = 0; k < 8; ++k) ua[k] = ur[16 * k]; }
#pragma unroll 1
        for (int s = 0; s < 32; s += 2) {
            { const u32x4* ur = (const u32x4*)(U16 + (size_t)e_lds[4 * (s + 1) + g] * 1024) + i;
#pragma unroll
              for (int k = 0; k < 8; ++k) ub[k] = ur[16 * k]; }
            { float a0 = 0.f, a1 = 0.f, a2 = 0.f, a3 = 0.f;
#pragma unroll
              for (int k = 0; k < 8; ++k) { a0 = dot2bf(ua[k].x, xr[k].x, a0); a1 = dot2bf(ua[k].y, xr[k].y, a1); a2 = dot2bf(ua[k].z, xr[k].z, a2); a3 = dot2bf(ua[k].w, xr[k].w, a3); }
              const float a = row16_sum((a0 + a1) + (a2 + a3));
              if (i == 0) a_lds[4 * s + g] = a; }
            if (s + 2 < 32) { const u32x4* ur = (const u32x4*)(U16 + (size_t)e_lds[4 * (s + 2) + g] * 1024) + i;
#pragma unroll
              for (int k = 0; k < 8; ++k) ua[k] = ur[16 * k]; }
            { float a0 = 0.f, a1 = 0.f, a2 = 0.f, a3 = 0.f;
#pragma unroll
              for (int k = 0; k < 8; ++k) { a0 = dot2bf(ub[k].x, xr[k].x, a0); a1 = dot2bf(ub[k].y, xr[k].y, a1); a2 = dot2bf(ub[k].z, xr[k].z, a2); a3 = dot2bf(ub[k].w, xr[k].w, a3); }
              const float a = row16_sum((a0 + a1) + (a2 + a3));
              if (i == 0) a_lds[4 * (s + 1) + g] = a; }
        }
        LDS_WAIT(); asm volatile("" ::: "memory");
        const float c0 = gelu_erf(a_lds[lane]) * g0, c1 = gelu_erf(a_lds[64 + lane]) * g1;
        const unsigned pw = pk2(c0, c1);
        float acc[16];
#pragma unroll
        for (int q = 0; q < 16; ++q) acc[q] = 0.f;
        u32x4 A0, A1, B0, B1, C0, C1, D0, D1;
#define PEER_VLOAD(j, X0, X1, Y0, Y1) do { const int ea_ = __builtin_amdgcn_readlane(e0, (j)), eb_ = __builtin_amdgcn_readlane(e1, (j)); \
            const u32x4* ra_ = (const u32x4*)(V16 + (size_t)ea_ * 1024) + lane; const u32x4* rb_ = (const u32x4*)(V16 + (size_t)eb_ * 1024) + lane; \
            X0 = ra_[0]; X1 = ra_[64]; Y0 = rb_[0]; Y1 = rb_[64]; } while (0)
#define PEER_VACC(j, X0, X1, Y0, Y1) do { const unsigned cp_ = (unsigned)__builtin_amdgcn_readlane((int)pw, (j)); \
            acc[0] = dot2bf(__builtin_amdgcn_perm(Y0.x, X0.x, 0x05040100u), cp_, acc[0]); acc[1] = dot2bf(__builtin_amdgcn_perm(Y0.x, X0.x, 0x07060302u), cp_, acc[1]); \
            acc[2] = dot2bf(__builtin_amdgcn_perm(Y0.y, X0.y, 0x05040100u), cp_, acc[2]); acc[3] = dot2bf(__builtin_amdgcn_perm(Y0.y, X0.y, 0x07060302u), cp_, acc[3]); \
            acc[4] = dot2bf(__builtin_amdgcn_perm(Y0.z, X0.z, 0x05040100u), cp_, acc[4]); acc[5] = dot2bf(__builtin_amdgcn_perm(Y0.z, X0.z, 0x07060302u), cp_, acc[5]); \
            acc[6] = dot2bf(__builtin_amdgcn_perm(Y0.w, X0.w, 0x05040100u), cp_, acc[6]); acc[7] = dot2bf(__builtin_amdgcn_perm(Y0.w, X0.w, 0x07060302u), cp_, acc[7]); \
            acc[8] = dot2bf(__builtin_amdgcn_perm(Y1.x, X1.x, 0x05040100u), cp_, acc[8]); acc[9] = dot2bf(__builtin_amdgcn_perm(Y1.x, X1.x, 0x07060302u), cp_, acc[9]); \
            acc[10] = dot2bf(__builtin_amdgcn_perm(Y1.y, X1.y, 0x05040100u), cp_, acc[10]); acc[11] = dot2bf(__builtin_amdgcn_perm(Y1.y, X1.y, 0x07060302u), cp_, acc[11]); \
            acc[12] = dot2bf(__builtin_amdgcn_perm(Y1.z, X1.z, 0x05040100u), cp_, acc[12]); acc[13] = dot2bf(__builtin_amdgcn_perm(Y1.z, X1.z, 0x07060302u), cp_, acc[13]); \
            acc[14] = dot2bf(__builtin_amdgcn_perm(Y1.w, X1.w, 0x05040100u), cp_, acc[14]); acc[15] = dot2bf(__builtin_amdgcn_perm(Y1.w, X1.w, 0x07060302u), cp_, acc[15]); } while (0)
        PEER_VLOAD(0, A0, A1, B0, B1);
#pragma unroll 1
        for (int j = 0; j < 64; j += 2) {
            PEER_VLOAD(j + 1, C0, C1, D0, D1);
            PEER_VACC(j, A0, A1, B0, B1);
            if (j + 2 < 64) PEER_VLOAD(j + 2, A0, A1, B0, B1);
            PEER_VACC(j + 1, C0, C1, D0, D1);
        }
#undef PEER_VLOAD
#undef PEER_VACC
        const float* g2 = MOD + (size_t)(t >> 11) * 6144 + 5120;
        float* orow = p.out + (size_t)t * 1024;
#pragma unroll
        for (int h = 0; h < 2; ++h)
#pragma unroll
            for (int q = 0; q < 2; ++q) { const int col = 512 * h + 8 * lane + 4 * q;
                const f32x4 xv = *(const f32x4*)(orow + col), gv = *(const f32x4*)(g2 + col);
                f32x4 a; a.x = acc[8 * h + 4 * q]; a.y = acc[8 * h + 4 * q + 1]; a.z = acc[8 * h + 4 * q + 2]; a.w = acc[8 * h + 4 * q + 3];
                *(f32x4*)(orow + col) = xv + gv * a; }
    }
}
typedef short v4i16_t __attribute__((ext_vector_type(4)));
constexpr int DSA_SROW = 2048 * 4 + 16;
constexpr int DSA_SEL_OFF = 16 * DSA_SROW;
constexpr int DSA_LDS = DSA_SEL_OFF + 16 * 512;
constexpr int DSA_KVROW = 272;

__device__ __forceinline__ unsigned sortkey(float s) { const unsigned u = __float_as_uint(s); return u ^ ((u >> 31) ? 0xffffffffu : 0x80000000u); }
__device__ __forceinline__ unsigned cvtpk_bf16(float lo, float hi) { unsigned r; asm volatile("v_cvt_pk_bf16_f32 %0, %1, %2" : "=v"(r) : "v"(lo), "v"(hi)); return r; }

__device__ __forceinline__ void ph_dsa(const Params& p, unsigned char* lds, int vb, int nvb) {
    const bf16* PROJ = (const bf16*)(p.ws + WS_PROJ); bf16* MIX = (bf16*)(p.ws + WS_MIX);
    const float MB = ((const float*)(p.ws + WS_SCAL))[SC_MB];
    int tid = threadIdx.x; asm volatile("" : "+v"(tid)); const int lane = tid & 63, wv = __builtin_amdgcn_readfirstlane(tid >> 6);
    const int l15 = lane & 15, g = lane >> 4;
    LAS unsigned char* ldsl = (LAS unsigned char*)lds;
    for (int it = vb; it < 2048; it += nvb) {
        const int vbb = it & 255, kk = it >> 8, G = vbb >> 6, ps = vbb & 63, b = ps >> 2, sub = ps & 3;
        const int c = (kk & 1) ? (31 - G - 8 * (kk >> 1)) : (G + 8 * (kk >> 1));
        const int cend = (c + 1) * 64, t0 = c * 64 + sub * 16;
        const bf16* Pb = PROJ + (size_t)b * SEQ * NP;
        if (c >= 4) {
            const bf16* qrow = Pb + (size_t)(t0 + l15) * NP;
            bf16x8 bq[4][2]; float wsc[4];
#pragma unroll
            for (int h = 0; h < 4; ++h) { wsc[h] = bf2f(qrow[C_WI + h]) * 0.0625f;
#pragma unroll
                for (int ks = 0; ks < 2; ++ks) bq[h][ks] = *(const bf16x8*)(qrow + C_QI + h * 64 + 32 * ks + 8 * g); }
            for (int k0 = 16 * wv; k0 < cend; k0 += 128) {
                const bf16* krow = Pb + (size_t)(k0 + l15) * NP + C_KI + 8 * g;
                const bf16x8 ka0 = *(const bf16x8*)krow, ka1 = *(const bf16x8*)(krow + 32);
                f32x4 sc = {0.f, 0.f, 0.f, 0.f};
#pragma unroll
                for (int h = 0; h < 4; ++h) { f32x4 a = {0.f, 0.f, 0.f, 0.f};
                    a = __builtin_amdgcn_mfma_f32_16x16x32_bf16(ka0, bq[h][0], a, 0, 0, 0);
                    a = __builtin_amdgcn_mfma_f32_16x16x32_bf16(ka1, bq[h][1], a, 0, 0, 0);
#pragma unroll
                    for (int r = 0; r < 4; ++r) sc[r] = fmaf(fmaxf(a[r], 0.f), wsc[h], sc[r]); }
#pragma unroll
                for (int r = 0; r < 4; ++r) sc[r] = (sc[r] == 0.f) ? 0.f : sc[r];
                *(LAS f32x4*)(ldsl + l15 * DSA_SROW + (k0 + 4 * g) * 4) = sc;
            }
        }
        __syncthreads();
        LAS unsigned short* selw = (LAS unsigned short*)(ldsl + DSA_SEL_OFF);
        int mind0 = 0, mind1 = 0;
#pragma unroll 1
        for (int qi = 0; qi < 2; ++qi) {
            const int qq = 2 * wv + qi, t = t0 + qq;
            LAS unsigned short* sel = selw + qq * 256;
            if (c < 4) { for (int j = lane; j < 256; j += 64) sel[j] = (unsigned short)j; continue; }
            const int nreg = cend >> 6;
            unsigned key[32];
            const LAS float* srow = (const LAS float*)(ldsl + qq * DSA_SROW) + lane;
#pragma unroll
            for (int i = 0; i < 32; ++i) key[i] = (i < nreg) ? sortkey(srow[64 * i]) : 0u;
            unsigned prefix = 0u; bool exact = false;
#pragma unroll 1
            for (int bit = 31; bit >= 0; --bit) {
                const unsigned cand = prefix | (1u << bit); int cnt = 0;
#pragma unroll
                for (int i = 0; i < 32; ++i) cnt += __popcll(__ballot(key[i] >= cand));
                if (cnt >= 256) { prefix = cand; if (cnt == 256) { exact = true; break; } }
            }
            int need_ties = 0;
            if (!exact) { int cgt = 0;
                if (prefix != 0xffffffffu) {
#pragma unroll
                    for (int i = 0; i < 32; ++i) cgt += __popcll(__ballot(key[i] > prefix)); }
                need_ties = 256 - cgt; }
            int base = 0, tbase = 0, md = 4096;
#pragma unroll
            for (int i = 0; i < 32; ++i) {
                if (i < nreg) {
                    bool selb;
                    if (exact) selb = key[i] >= prefix;
                    else { const bool tie = key[i] == prefix; const unsigned long long mt = __ballot(tie);
                        const int trank = tbase + (int)__builtin_amdgcn_mbcnt_hi((unsigned)(mt >> 32), __builtin_amdgcn_mbcnt_lo((unsigned)mt, 0u));
                        selb = (key[i] > prefix) || (tie && trank < need_ties); tbase += __popcll(mt); }
                    const unsigned long long m = __ballot(selb);
                    const int pos = base + (int)__builtin_amdgcn_mbcnt_hi((unsigned)(m >> 32), __builtin_amdgcn_mbcnt_lo((unsigned)m, 0u));
                    const int kidx = i * 64 + lane;
                    if (selb) { sel[pos] = (unsigned short)kidx; const int d = t > kidx ? t - kidx : kidx - t; md = d < md ? d : md; }
                    base += __popcll(m);
                }
            }
#pragma unroll
            for (int o = 1; o < 64; o <<= 1) { const int x = __shfl_xor(md, o); md = x < md ? x : md; }
            if (qi == 0) mind0 = md; else mind1 = md;
        }
        LDS_WAIT(); asm volatile("" ::: "memory");
        const int nvalid = cend < 256 ? cend : 256;
        const int head = lane & 7;
        const float slopeL2 = exp2f(-(float)(head + 1)) * 1.4426950409f;
#pragma unroll 1
        for (int qi = 0; qi < 2; ++qi) {
            const int qq = 2 * wv + qi, t = t0 + qq;
            const LAS unsigned short* sel = selw + qq * 256;
            LAS unsigned char* stg = ldsl + (2 * wv) * DSA_SROW;
            const bf16* qrow = Pb + (size_t)t * NP + C_QB + head * 128 + 8 * g;
            bf16x8 bq[4];
#pragma unroll
            for (int ks = 0; ks < 4; ++ks) bq[ks] = *(const bf16x8*)(qrow + 32 * ks);
            const float refL2 = MB * 1.4426950409f - slopeL2 * (float)(qi == 0 ? mind0 : mind1);
            f32x4 o[8];
#pragma unroll
            for (int dt = 0; dt < 8; ++dt) o[dt] = (f32x4){0.f, 0.f, 0.f, 0.f};
            float lsum = 0.f;
#pragma unroll 1
            for (int s = 0; s < 8; ++s) {
                if (32 * s >= nvalid) break;
                unsigned pb[4];
#pragma unroll
                for (int tl = 0; tl < 2; ++tl) {
                    const int j0 = 32 * s + 16 * tl;
                    const int jr = j0 + l15; const int keyr = sel[jr < nvalid ? jr : 0];
                    const bf16* kvrow = Pb + (size_t)keyr * NP + C_KV + 8 * g;
                    bf16x8 ka[4];
#pragma unroll
                    for (int ks = 0; ks < 4; ++ks) ka[ks] = *(const bf16x8*)(kvrow + 32 * ks);
                    f32x4 a = {0.f, 0.f, 0.f, 0.f};
#pragma unroll
                    for (int ks = 0; ks < 4; ++ks) { a = __builtin_amdgcn_mfma_f32_16x16x32_bf16(ka[ks], bq[ks], a, 0, 0, 0);
                        *(LAS bf16x8*)(stg + (16 * tl + l15) * DSA_KVROW + (32 * ks + 8 * g) * 2) = ka[ks]; }
                    const u32x2 kw = *(const LAS u32x2*)(sel + j0 + 4 * g);
                    const int kx[4] = {(int)(kw.x & 0xffffu), (int)(kw.x >> 16), (int)(kw.y & 0xffffu), (int)(kw.y >> 16)};
                    float pr[4];
#pragma unroll
                    for (int r = 0; r < 4; ++r) { const int dd = t > kx[r] ? t - kx[r] : kx[r] - t;
                        const float e = __builtin_amdgcn_exp2f(fmaf(a[r], 0.1275174f, -slopeL2 * (float)dd - refL2));
                        pr[r] = (j0 + 4 * g + r < nvalid) ? e : 0.f; lsum += pr[r]; }
                    pb[2 * tl] = cvtpk_bf16(pr[0], pr[1]); pb[2 * tl + 1] = cvtpk_bf16(pr[2], pr[3]);
                }
                LDS_WAIT(); asm volatile("" ::: "memory");
                u32x4 pw4; pw4.x = pb[0]; pw4.y = pb[1]; pw4.z = pb[2]; pw4.w = pb[3];
                const bf16x8 pfrag = __builtin_bit_cast(bf16x8, pw4);
                const LAS unsigned char* trb = stg + (4 * g + (l15 >> 2)) * DSA_KVROW + (4 * (lane & 3)) * 2;
#pragma unroll
                for (int dt = 0; dt < 8; ++dt) {
                    const s16x4 lo = __builtin_bit_cast(s16x4, __builtin_amdgcn_ds_read_tr16_b64_v4i16((LAS v4i16_t*)(trb + dt * 32)));
                    const s16x4 hi = __builtin_bit_cast(s16x4, __builtin_amdgcn_ds_read_tr16_b64_v4i16((LAS v4i16_t*)(trb + 16 * DSA_KVROW + dt * 32)));
                    const bf16x8 af = {lo[0], lo[1], lo[2], lo[3], hi[0], hi[1], hi[2], hi[3]};
                    o[dt] = __builtin_amdgcn_mfma_f32_16x16x32_bf16(af, pfrag, o[dt], 0, 0, 0);
                }
                LDS_WAIT(); asm volatile("" ::: "memory");
            }
            lsum += __shfl_xor(lsum, 16); lsum += __shfl_xor(lsum, 32);
            const float il = 1.f / lsum;
            if (l15 < 8) {
                bf16* orow = MIX + (size_t)(b * SEQ + t) * MIXW + 512 + head * 128 + 4 * g;
#pragma unroll
                for (int dt = 0; dt < 8; ++dt) { u32x2 w; w.x = pk2(o[dt][0] * il, o[dt][1] * il); w.y = pk2(o[dt][2] * il, o[dt][3] * il); *(u32x2*)(orow + 16 * dt) = w; }
            }
        }
        __syncthreads();
    }
}
typedef __attribute__((address_space(1))) float GASF;
__device__ __forceinline__ int crow(int r, int hi) { return (r & 3) + 8 * (r >> 2) + 4 * hi; }
#define KSWZ64(row, cb) ((row) * 128 + ((cb) ^ ((((row) >> 1) & 7) << 4)))
__device__ __forceinline__ int v_st(int k, int c) { const int kk = (k & ~0xC) | ((k & 4) << 1) | ((k & 8) >> 1); return ((kk >> 3) * 4 + (c >> 5)) * 512 + ((kk & 7) * 32 + (c & 31)) * 2; }
__device__ __forceinline__ int v_rd_base(int lane) { return ((lane & 3) << 3) | (((lane >> 2) & 3) << 6) | (((lane >> 4) & 1) << 5) | (((lane >> 5) & 1) << 8); }
constexpr int v_rd_off(int d0, int ks, int half) { return d0 * 512 + ks * 4096 + half * 2048; }
template <int OFF> __device__ __forceinline__ s16x4 tr_read(int vb) {
    s16x4 r; asm volatile("ds_read_b64_tr_b16 %0, %1 offset:%2" : "=&v"(r) : "v"(vb), "i"(OFF) : "memory"); return r;
}
template <int D0> __device__ __forceinline__ void pv_one(f32x16& od, int vb, bf16x8 pa0, bf16x8 pa1, bf16x8 pa2, bf16x8 pa3) {
    const s16x4 l0 = tr_read<v_rd_off(D0, 0, 0)>(vb), h0 = tr_read<v_rd_off(D0, 0, 1)>(vb), l1 = tr_read<v_rd_off(D0, 1, 0)>(vb), h1 = tr_read<v_rd_off(D0, 1, 1)>(vb);
    const s16x4 l2 = tr_read<v_rd_off(D0, 2, 0)>(vb), h2 = tr_read<v_rd_off(D0, 2, 1)>(vb), l3 = tr_read<v_rd_off(D0, 3, 0)>(vb), h3 = tr_read<v_rd_off(D0, 3, 1)>(vb);
    asm volatile("s_waitcnt lgkmcnt(0)" ::: "memory"); __builtin_amdgcn_sched_barrier(0);
#define PK(L, H) (bf16x8){L[0], L[1], L[2], L[3], H[0], H[1], H[2], H[3]}
    od = __builtin_amdgcn_mfma_f32_32x32x16_bf16(pa0, PK(l0, h0), od, 0, 0, 0);
    od = __builtin_amdgcn_mfma_f32_32x32x16_bf16(pa1, PK(l1, h1), od, 0, 0, 0);
    od = __builtin_amdgcn_mfma_f32_32x32x16_bf16(pa2, PK(l2, h2), od, 0, 0, 0);
    od = __builtin_amdgcn_mfma_f32_32x32x16_bf16(pa3, PK(l3, h3), od, 0, 0, 0);
#undef PK
}
constexpr int ATT_LDS = 2 * 16384 + 2 * 8192 + 8 * 256;

__device__ __forceinline__ void ph_attnA(const Params& p, unsigned char* lds, int vb, int nvb) {
    const bf16* PROJ = (const bf16*)(p.ws + WS_PROJ); bf16* MIX = (bf16*)(p.ws + WS_MIX);
    const float* SC = (const float*)(p.ws + WS_SCAL);
    const float lam = SC[SC_LAM], refL2 = SC[SC_MA] * 1.4426950409f;
    constexpr float C = 0.125f * 1.4426950409f;
    int tid = threadIdx.x; asm volatile("" : "+v"(tid)); const int lane = tid & 63, wid = __builtin_amdgcn_readfirstlane(tid >> 6), r32 = lane & 31, hi = lane >> 5;
    unsigned char* V_lds = lds; unsigned char* K_lds = lds + 32768;
    float* wsf = (float*)(lds + 49152) + wid * 64;
    GASF* tmpw = (GASF*)(p.ws + WS_ATMP) + ((size_t)(vb * NWV + wid) * 64) * 64 + lane;
    const int vbase = (int)(uintptr_t)V_lds + v_rd_base(lane);
    const int krow = tid >> 3, kch = tid & 7, kdst = KSWZ64(krow, kch * 16);
    const int sr = tid >> 4, sc = (tid & 15) * 8, vst0 = v_st(sr, sc), vst1 = v_st(32 + sr, sc);
    for (int it = vb; it < 256; it += nvb) {
        const int b = it >> 4, h = (it >> 2) & 3, qbl = it & 3;
        const float slopeL2 = exp2f(-2.0f * (float)(h + 1)) * 1.4426950409f;
        const bf16* Pb = PROJ + (size_t)b * SEQ * NP;
#pragma unroll 1
        for (int half = 0; half < 2; ++half) {
            const int qb = half ? 7 - qbl : qbl, q0 = 256 * qb, NTu = 4 * (qb + 1), cw = 4 * qb + (wid >> 1);
            const int tq = q0 + 32 * wid + r32;
#pragma unroll 1
            for (int mi = 0; mi < 2; ++mi) {
                const int m = 1 - mi;
                const bf16* Kg = Pb + C_KA + h * 128 + m * 64 + (size_t)krow * NP + kch * 8;
                const bf16* Vg = Pb + C_VA + h * 128 + (size_t)sr * NP + sc;
                bf16x8 qr[4];
                { const bf16* qp = Pb + (size_t)tq * NP + C_QA + h * 128 + m * 64 + hi * 8;
#pragma unroll
                  for (int d0 = 0; d0 < 4; ++d0) qr[d0] = *(const bf16x8*)(qp + d0 * 16); }
                f32x16 o[4];
#pragma unroll
                for (int d = 0; d < 4; ++d) o[d] = f32x16{};
                float lsum = 0.f;
                bf16x8 sk, sv0, sv1;
                sk = *(const bf16x8*)Kg; sv0 = *(const bf16x8*)Vg; sv1 = *(const bf16x8*)(Vg + (size_t)32 * NP);
                *(bf16x8*)(K_lds + kdst) = sk; *(bf16x8*)(V_lds + vst0) = sv0; *(bf16x8*)(V_lds + vst1) = sv1;
                __syncthreads();
#pragma unroll 1
                for (int j = 0; j < NTu; ++j) {
                    const int buf = j & 1;
                    if (j + 1 < NTu) { const size_t go = (size_t)(j + 1) * 64 * NP; sk = *(const bf16x8*)(Kg + go); sv0 = *(const bf16x8*)(Vg + go); sv1 = *(const bf16x8*)(Vg + go + (size_t)32 * NP); }
                    if (j <= cw) {
                        const unsigned char* Kb = K_lds + buf * 8192;
                        const float dq = (float)(tq - 64 * j - 4 * hi);
                        const float B0 = -slopeL2 * dq - refL2;
                        const bool past = j < cw;
                        float ps = 0.f;
                        bf16x8 pa0, pa1, pa2, pa3;
#define PK4(P, BASE, OUT) do { unsigned a0 = cvtpk_bf16(P[BASE + 0], P[BASE + 1]), a1 = cvtpk_bf16(P[BASE + 2], P[BASE + 3]);   \
    unsigned b0_ = cvtpk_bf16(P[BASE + 4], P[BASE + 5]), b1_ = cvtpk_bf16(P[BASE + 6], P[BASE + 7]);                              \
    auto r0 = __builtin_amdgcn_permlane32_swap(a0, b0_, false, false); auto r1 = __builtin_amdgcn_permlane32_swap(a1, b1_, false, false); \
    u32x4 w = {r0[0], r1[0], r0[1], r1[1]}; OUT = __builtin_bit_cast(bf16x8, w); } while (0)
#define HALF_TILE(KOFF, FOFF, PA, PB) do { f32x16 pp = f32x16{};                                                                     \
    _Pragma("unroll") for (int d0 = 0; d0 < 4; ++d0) { const int cb = (d0 * 16 + hi * 8) * 2;                                        \
        const bf16x8 bk = *(const bf16x8*)(Kb + KSWZ64((KOFF) + r32, cb)); pp = __builtin_amdgcn_mfma_f32_32x32x16_bf16(bk, qr[d0], pp, 0, 0, 0); } \
    if (past) { _Pragma("unroll") for (int r = 0; r < 16; ++r) { const float off = (float)((r & 3) + 8 * (r >> 2)) + (FOFF);          \
            pp[r] = __builtin_amdgcn_exp2f(fmaf(pp[r], C, fmaf(slopeL2, off, B0))); } }                                               \
    else { _Pragma("unroll") for (int r = 0; r < 16; ++r) { const float off = (float)((r & 3) + 8 * (r >> 2)) + (FOFF);               \
            pp[r] = __builtin_amdgcn_exp2f(fmaf(pp[r], C, -slopeL2 * fabsf(dq - off) - refL2)); } }                                   \
    _Pragma("unroll") for (int r = 0; r < 16; ++r) ps += pp[r];                                                                       \
    PK4(pp, 0, PA); PK4(pp, 8, PB); __builtin_amdgcn_sched_barrier(0); } while (0)
                        HALF_TILE(0, 0.f, pa0, pa1);
                        HALF_TILE(32, 32.f, pa2, pa3);
#undef HALF_TILE
#undef PK4
                        { auto rr = __builtin_amdgcn_permlane32_swap(__float_as_uint(ps), __float_as_uint(ps), false, false);
                          ps = __uint_as_float(rr[0]) + __uint_as_float(rr[1]); }
                        lsum += ps;
                        const int vb0 = vbase + buf * 16384;
                        pv_one<0>(o[0], vb0, pa0, pa1, pa2, pa3); pv_one<1>(o[1], vb0, pa0, pa1, pa2, pa3); pv_one<2>(o[2], vb0, pa0, pa1, pa2, pa3); pv_one<3>(o[3], vb0, pa0, pa1, pa2, pa3);
                    }
                    if (j + 1 < NTu) { const int nb = buf ^ 1;
                        *(bf16x8*)(K_lds + nb * 8192 + kdst) = sk; *(bf16x8*)(V_lds + nb * 16384 + vst0) = sv0; *(bf16x8*)(V_lds + nb * 16384 + vst1) = sv1; }
                    __syncthreads();
                }
                if (hi == 0) wsf[r32] = lsum;
                LDS_WAIT(); asm volatile("" ::: "memory");
                float rli[16];
#pragma unroll
                for (int r = 0; r < 16; ++r) rli[r] = 1.f / wsf[crow(r, hi)];
                LDS_WAIT(); asm volatile("" ::: "memory");
                if (mi == 0) {
#pragma unroll
                    for (int d = 0; d < 4; ++d) { GASF* td = tmpw + d * 1024; asm volatile("" : "+v"(td));
#pragma unroll
                        for (int r = 0; r < 16; ++r) td[r * 64] = o[d][r] * rli[r]; }
                } else {
                    float gsub[4];
#pragma unroll
                    for (int d = 0; d < 4; ++d) gsub[d] = p.a_sub_gain[32 * d + r32];
                    GASF* tdp[4];
#pragma unroll
                    for (int d = 0; d < 4; ++d) { tdp[d] = tmpw + d * 1024; asm volatile("" : "+v"(tdp[d])); }
#pragma unroll
                    for (int r = 0; r < 16; ++r) {
                        float v[4]; float ss = 0.f;
#pragma unroll
                        for (int d = 0; d < 4; ++d) { v[d] = o[d][r] * rli[r] - lam * tdp[d][r * 64]; ss += v[d] * v[d]; }
                        ss += __shfl_xor(ss, 1); ss += __shfl_xor(ss, 2); ss += __shfl_xor(ss, 4); ss += __shfl_xor(ss, 8); ss += __shfl_xor(ss, 16);
                        const float rs = rsqrtf(ss * (1.f / 128.f) + EPS) * 0.8f;
                        bf16* orow = MIX + (size_t)(b * SEQ + q0 + 32 * wid + crow(r, hi)) * MIXW + h * 128 + r32;
#pragma unroll
                        for (int d = 0; d < 4; ++d) orow[32 * d] = (bf16)f2bf(v[d] * rs * gsub[d]);
                        asm volatile("" ::: "memory");
                    }
                }
            }
        }
    }
}
constexpr int LDS_BYTES = 147456;
extern __shared__ __attribute__((aligned(16))) unsigned char dyn_lds[];

__global__ void __launch_bounds__(NT, 2) mega_fwd(Params p) {
    cg::grid_group grid = cg::this_grid();
    const int vb = blockIdx.x, nvb = gridDim.x, ngw = nvb * NWV;
#define TID_LAUNDER int tid_ = threadIdx.x; asm volatile("" : "+v"(tid_)); const int lane = tid_ & 63, wv = tid_ >> 6, gw = vb * NWV + wv; (void)lane; (void)gw;
    ph_mod(p, (float*)dyn_lds, vb, nvb);
    { TID_LAUNDER ph_prep_weights(p, (LAS float*)dyn_lds + wv * (64 * 33), gw, ngw, lane); }
    grid.sync();
    { TID_LAUNDER ph_hrows(p, p.x, p.norm1_g, 0, 1024, gw, ngw, lane); }
    grid.sync();
    {   pg8::Gemm g{(const bf16*)(p.ws + WS_H), (const bf16*)(p.ws + WS_WIN), T, NP, 1024}; pg8::StaticOrder S; S.init(T, NP, nvb, vb);
        pg8::EpiBf16<0> E{(bf16*)(p.ws + WS_PROJ), NP, nullptr, 0, 0, 1.f};
        pg8::gemm_phase<pg8::EpiBf16<0>, pg8::StaticOrder, true, true>((LAS unsigned char*)dyn_lds, g, S, E); }
    grid.sync();
    { TID_LAUNDER ph_norm_proj(p, gw, ngw, lane); }
    grid.sync();
    ph_attnA(p, dyn_lds, vb, nvb);
    __syncthreads();
    ph_dsa(p, dyn_lds, vb, nvb);
    grid.sync();
    {   pg8::Gemm g{(const bf16*)(p.ws + WS_MIX), (const bf16*)(p.ws + WS_WO2), T, 1024, MIXW}; pg8::StaticOrder S; S.init(T, 1024, nvb, vb);
        EpiResGate E{p.x, p.out, (const float*)(p.ws + WS_MOD) + 2048};
        pg8::gemm_phase<EpiResGate, pg8::StaticOrder, true, true>((LAS unsigned char*)dyn_lds, g, S, E); }
    grid.sync();
    { TID_LAUNDER ph_hrows(p, p.out, p.norm2_g, 3072, 4096, gw, ngw, lane); }
    grid.sync();
    {   pg8::Gemm g{(const bf16*)(p.ws + WS_H), (const bf16*)(p.ws + WS_WQ), T, 1024, 1024}; pg8::StaticOrder S; S.init(T, 1024, nvb, vb);
        pg8::EpiBf16<0> E{(bf16*)(p.ws + WS_Q3), 1024, nullptr, 0, 0, 1.f};
        pg8::gemm_phase<pg8::EpiBf16<0>, pg8::StaticOrder, true, true>((LAS unsigned char*)dyn_lds, g, S, E); }
    grid.sync();
    ph_route_naive(p, (float*)dyn_lds, vb, nvb);
    grid.sync();
    { TID_LAUNDER ph_peer(p, dyn_lds + wv * 1024, gw, ngw, lane); }
}

extern "C" void kernel_launch(void* const* d_in, const int* in_sizes, int n_in, void* d_out, int out_size, void* d_ws, size_t ws_size, hipStream_t stream) {
    static int grid_blocks = 0;
    if (grid_blocks == 0) {
        if (n_in != 18 || in_sizes[0] != T * DM || out_size != T * DM || ws_size < WS_END) { fprintf(stderr, "kernel_launch: unexpected shapes n_in %d in0 %d out %d ws %zu\n", n_in, n_in > 0 ? in_sizes[0] : -1, out_size, ws_size); grid_blocks = -1; return; }
        int dev = 0, cus = 0, per_cu = 0;
        (void)hipGetDevice(&dev);
        (void)hipDeviceGetAttribute(&cus, hipDeviceAttributeMultiprocessorCount, dev);
        (void)hipFuncSetAttribute((const void*)mega_fwd, hipFuncAttributeMaxDynamicSharedMemorySize, LDS_BYTES);
        (void)hipOccupancyMaxActiveBlocksPerMultiprocessor(&per_cu, (const void*)mega_fwd, NT, LDS_BYTES);
        if (per_cu < 1 || cus < 1) { fprintf(stderr, "kernel_launch: occupancy query gave %d blocks/CU on %d CUs\n", per_cu, cus); grid_blocks = -1; return; }
        grid_blocks = cus;
    }
    if (grid_blocks < 0) return;
    Params p{};
    const float** pp = (const float**)&p;
    for (int i = 0; i < 18; ++i) pp[i] = (const float*)d_in[i];
    p.out = (float*)d_out; p.ws = (unsigned char*)d_ws;
    void* args[] = {&p};
    const hipError_t e = hipLaunchCooperativeKernel((const void*)mega_fwd, dim3(grid_blocks), dim3(NT), args, LDS_BYTES, stream);
    if (e != hipSuccess) fprintf(stderr, "kernel_launch: cooperative launch failed: %s (grid %d)\n", hipGetErrorString(e), grid_blocks);
}
```

```cpp
#include <hip/hip_runtime.h>
#include <hip/hip_cooperative_groups.h>
#include <cstdio>
#include <cstdint>
#include <cmath>
namespace pg8 {
#define PG8_LAS __attribute__((address_space(3)))
typedef unsigned short bf16_t;
typedef short bf16x8 __attribute__((ext_vector_type(8)));
typedef float f32x4 __attribute__((ext_vector_type(4)));
typedef unsigned u32x4 __attribute__((ext_vector_type(4)));
constexpr int BM = 256, BK = 64, HALF = 128, HTB = HALF * BK * 2  , STAGE_BYTES = 8 * HTB, NXCD = 8, WGM = 8;

__host__ __device__ __forceinline__ int lds_byte(int r, int c) { const int st = (r >> 4) * 2 + (c >> 5), rr = r & 15, cc = c & 31, ob = rr * 64 + cc * 2; return st * 1024 + (ob ^ (((ob >> 9) & 1) << 5)); }
__host__ __device__ __forceinline__ void stage_rc(int b, int& R, int& C) { const int st = b / 1024, sb = b % 1024, swz = sb ^ (((sb >> 9) & 1) << 5); R = (st >> 1) * 16 + swz / 64; C = (st & 1) * 32 + (swz % 64) / 2; }
__host__ __device__ __forceinline__ int perm32(int rho) { const int n = rho >> 4, i = rho & 15; return 8 * (i >> 2) + 4 * n + (i & 3); }

struct Unit { int pm, pn; };
struct Gemm { const bf16_t* A; const bf16_t* Bt; int M, N, K; };

struct StaticOrder {
    int nM, nN, nwg, G, c;
    __host__ __device__ void init(int M, int N, int G_, int c_) { nM = M / BM; nN = N / BM; nwg = nM * nN; G = G_; c = c_; }
    __host__ __device__ bool next(int i, Unit& u) const {
        const long L = (long)i * G + c; if (L >= nwg) return false;
        int wgid = (int)L; { const int q = nwg / NXCD, r = nwg % NXCD, xcd = wgid % NXCD, off = wgid / NXCD; wgid = (xcd < r ? xcd * (q + 1) : r * (q + 1) + (xcd - r) * q) + off; }
        const int nig = WGM * nN, gid = wgid / nig, fm = gid * WGM, gsz = (nM - fm) < WGM ? (nM - fm) : WGM;
        u.pm = fm + ((wgid % nig) % gsz); u.pn = (wgid % nig) / gsz; return true;
    }
    __device__ __forceinline__ void a_ready(const Unit&) const {}
    __device__ __forceinline__ void done(const Unit&) const {}
};

__device__ __forceinline__ unsigned cvt_pk_bf16(float lo, float hi) { unsigned r; asm volatile("v_cvt_pk_bf16_f32 %0, %1, %2" : "=v"(r) : "v"(lo), "v"(hi)); return r; }
typedef float f32x2 __attribute__((ext_vector_type(2)));
__device__ __forceinline__ f32x2 gelu_pk(f32x2 v) {
    const f32x2 av = __builtin_elementwise_abs(v), d = av * 0.2316418882f + 1.0f;
    f32x2 t; t.x = __builtin_amdgcn_rcpf(d.x); t.y = __builtin_amdgcn_rcpf(d.y);
    f32x2 q = t * 0.5307027145f + (-0.7265760135f); q = q * t + 0.7107068705f; q = q * t + (-0.142248368f); q = q * t + 0.127414796f; q = q * t;
    const f32x2 s = (v * v) * (-0.72134752044f);
    f32x2 e; e.x = __builtin_amdgcn_exp2f(s.x); e.y = __builtin_amdgcn_exp2f(s.y);
    const f32x2 m = v * (q * e), r = v - m;
    f32x2 o; o.x = v.x < 0.f ? m.x : r.x; o.y = v.y < 0.f ? m.y : r.y; return o;
}

template <int ACT  > struct EpiBf16 {
    static constexpr bool PERM = true, AFTER_DRAIN = false; static_assert(ACT == 0 || ACT == 1, "EpiBf16: ACT is 0 (none) or 1 (gelu_pk)");
    bf16_t* O; int ldc; const float* bias; int split_cols; size_t split_stride; float scale0;
    __device__ __forceinline__ void operator()(const f32x4 (&acc)[2][2][4][2], const Unit& u, int wr, int wc, int fr, int fq) const {
        const int row0 = u.pm * BM + wr * 64 + fr; int colt = u.pn * BM; bf16_t* base = O;
        float sc = 1.f; if (split_cols) { const int t = colt / split_cols; base += (size_t)t * split_stride; colt -= t * split_cols; if (t == 0) sc = scale0; }
        const int col0 = colt + wc * 32 + 8 * fq, bcol0 = u.pn * BM + wc * 32 + 8 * fq;
        f32x4 bv[2][2];
#pragma unroll
        for (int bj = 0; bj < 2; ++bj)
#pragma unroll
            for (int n = 0; n < 2; ++n) bv[bj][n] = bias ? *(const f32x4*)(bias + bcol0 + bj * HALF + 4 * n) : (f32x4){0.f, 0.f, 0.f, 0.f};
#pragma unroll
        for (int ai = 0; ai < 2; ++ai)
#pragma unroll
            for (int m = 0; m < 4; ++m) { bf16_t* rowp = base + (size_t)(row0 + ai * HALF + m * 16) * ldc + col0;
#pragma unroll
                for (int bj = 0; bj < 2; ++bj) { f32x4 v0 = acc[ai][bj][m][0] + bv[bj][0], v1 = acc[ai][bj][m][1] + bv[bj][1];
                    if (ACT == 1) { f32x2 a = gelu_pk((f32x2){v0[0], v0[1]}), b = gelu_pk((f32x2){v0[2], v0[3]}), c = gelu_pk((f32x2){v1[0], v1[1]}), d = gelu_pk((f32x2){v1[2], v1[3]});
                        v0 = (f32x4){a.x, a.y, b.x, b.y}; v1 = (f32x4){c.x, c.y, d.x, d.y}; }
                    v0 = v0 * sc; v1 = v1 * sc; u32x4 w; w.x = cvt_pk_bf16(v0[0], v0[1]); w.y = cvt_pk_bf16(v0[2], v0[3]); w.z = cvt_pk_bf16(v1[0], v1[1]); w.w = cvt_pk_bf16(v1[2], v1[3]);
                    *(u32x4*)(rowp + bj * HALF) = w; } }
    }
};

template <class Epi, class Sched, bool ALIGN_EPI = false, bool SP2 = false>
__device__ __forceinline__ void gemm_phase(PG8_LAS unsigned char* lds, const Gemm g, const Sched& S, const Epi& E) {
    int tid = threadIdx.x; asm volatile("" : "+v"(tid)); const int wid = __builtin_amdgcn_readfirstlane(tid >> 6), lane = tid & 63, wr = wid >> 2, wc = wid & 3, fr = lane & 15, fq = lane >> 4;
    const int K = g.K, nt = K / BK;
    unsigned voffA[2], voffB[2];
#pragma unroll
    for (int i = 0; i < 2; ++i) { int R, C; stage_rc(tid * 16 + i * 8192, R, C); const int Rb = Epi::PERM ? ((R & ~31) + perm32(R & 31)) : R;
        voffA[i] = (unsigned)(R * K + C) * 2u; voffB[i] = (unsigned)(Rb * K + C) * 2u; }
    const size_t kstep = (size_t)(BK * 2);
    const size_t hstep = (size_t)HALF * K * 2;
    const size_t tstep = 2 * hstep;
    const unsigned ldsw = (unsigned)wid * 1024u;
    const int aoff = lds_byte(wr * 64 + fr, fq * 8), boff = lds_byte(wc * 32 + fr, fq * 8);
#define PG8_SA(b, h) (((b) * 2 + (h)) * HTB)
#define PG8_SB(b, h) ((4 + (b) * 2 + (h)) * HTB)
#define PG8_STAGE(bufoff, gbase, voff) do { _Pragma("unroll") for (int _i = 0; _i < 2; ++_i) \
        __builtin_amdgcn_global_load_lds((const unsigned*)((const char*)(gbase) + (voff)[_i]), (PG8_LAS unsigned*)(lds + (bufoff) + ldsw + _i * 8192), 16, 0, 0); } while (0)
#define PG8_LDA(dst, b, h) do { _Pragma("unroll") for (int m = 0; m < 4; ++m) _Pragma("unroll") for (int k = 0; k < 2; ++k) dst[m][k] = *(const PG8_LAS bf16x8*)(lds + PG8_SA(b, h) + aoff + m * 2048 + k * 1024); } while (0)
#define PG8_LDB(dst, b, h) do { _Pragma("unroll") for (int n = 0; n < 2; ++n) _Pragma("unroll") for (int k = 0; k < 2; ++k) dst[n][k] = *(const PG8_LAS bf16x8*)(lds + PG8_SB(b, h) + boff + n * 2048 + k * 1024); } while (0)
#define PG8_MMA(ai, bj, At, Bt) do { __builtin_amdgcn_s_setprio(1); _Pragma("unroll") for (int m = 0; m < 4; ++m) _Pragma("unroll") for (int n = 0; n < 2; ++n) _Pragma("unroll") for (int k = 0; k < 2; ++k) \
        acc[ai][bj][m][n] = __builtin_amdgcn_mfma_f32_16x16x32_bf16(Bt[n][k], At[m][k], acc[ai][bj][m][n], 0, 0, 0); __builtin_amdgcn_s_setprio(0); } while (0)
#define PG8_WAIT_V(n) asm volatile("s_waitcnt vmcnt(" #n ")" ::: "memory")
#define PG8_WAIT_L(n) asm volatile("s_waitcnt lgkmcnt(" #n ")" ::: "memory")
#define PG8_BAR __builtin_amdgcn_s_barrier()
#define PG8_SCHED __builtin_amdgcn_sched_barrier(0)
    Unit cur, nxt; int ui = 0;
    if (!S.next(0, cur)) return;
    f32x4 acc[2][2][4][2];
#pragma unroll
    for (int a = 0; a < 2; ++a)
#pragma unroll
        for (int b = 0; b < 2; ++b)
#pragma unroll
            for (int m = 0; m < 4; ++m)
#pragma unroll
                for (int n = 0; n < 2; ++n) acc[a][b][m][n] = (f32x4){0.f, 0.f, 0.f, 0.f};
    bf16x8 At[4][2], B0[2][2], B1[2][2];
    const char* cA = (const char*)g.A + (size_t)cur.pm * tstep; const char* cB = (const char*)g.Bt + (size_t)cur.pn * tstep;
    S.a_ready(cur);
    if constexpr (SP2) {
        PG8_STAGE(PG8_SB(0, 0), cB, voffB); PG8_STAGE(PG8_SB(0, 1), cB + hstep, voffB); PG8_STAGE(PG8_SA(0, 0), cA, voffA); PG8_STAGE(PG8_SA(0, 1), cA + hstep, voffA);
        if (wr == 1) PG8_BAR;
        PG8_WAIT_V(2); PG8_BAR;
        PG8_STAGE(PG8_SB(1, 0), cB + kstep, voffB); PG8_STAGE(PG8_SA(1, 0), cA + kstep, voffA); PG8_STAGE(PG8_SB(1, 1), cB + hstep + kstep, voffB);
        PG8_WAIT_V(6); PG8_BAR;
    } else {
        PG8_STAGE(PG8_SB(0, 0), cB, voffB); PG8_STAGE(PG8_SA(0, 0), cA, voffA); PG8_STAGE(PG8_SB(0, 1), cB + hstep, voffB); PG8_STAGE(PG8_SA(0, 1), cA + hstep, voffA);
        if (wr == 1) PG8_BAR;
        PG8_WAIT_V(4); PG8_BAR;
        PG8_STAGE(PG8_SB(1, 0), cB + kstep, voffB); PG8_STAGE(PG8_SA(1, 0), cA + kstep, voffA); PG8_STAGE(PG8_SB(1, 1), cB + hstep + kstep, voffB);
        PG8_WAIT_V(6); PG8_BAR;
    }
    for (;;) {
        const bool has_next = S.next(ui + 1, nxt);
        const char* nA = has_next ? (const char*)g.A + (size_t)nxt.pm * tstep : cA; const char* nB = has_next ? (const char*)g.Bt + (size_t)nxt.pn * tstep : cB;
        for (int t = 0; t < nt; t += 2) {
            const bool last = (t == nt - 2);
            const char* a1 = cA + (size_t)(t + 1) * kstep;
            const char* a2 = last ? nA : cA + (size_t)(t + 2) * kstep; const char* b2 = last ? nB : cB + (size_t)(t + 2) * kstep;
            const char* a3 = a2 + kstep; const char* b3 = b2 + kstep;
            if (last && has_next) S.a_ready(nxt);
            if constexpr (SP2) {
            PG8_LDB(B0, 0, 0); PG8_LDB(B1, 0, 1); PG8_SCHED; PG8_LDA(At, 0, 0); PG8_STAGE(PG8_SA(1, 1), a1 + hstep, voffA);
            PG8_WAIT_V(8); PG8_WAIT_L(0); PG8_BAR; PG8_MMA(0, 0, At, B0); PG8_MMA(0, 1, At, B1); PG8_BAR; PG8_SCHED;
            PG8_LDA(At, 0, 1); PG8_STAGE(PG8_SB(0, 0), b2, voffB); PG8_STAGE(PG8_SB(0, 1), b2 + hstep, voffB); PG8_STAGE(PG8_SA(0, 0), a2, voffA);
            PG8_WAIT_V(8); PG8_WAIT_L(0); PG8_BAR; PG8_MMA(1, 0, At, B0); PG8_MMA(1, 1, At, B1); PG8_BAR; PG8_SCHED;
            PG8_LDB(B0, 1, 0); PG8_LDB(B1, 1, 1); PG8_SCHED; PG8_LDA(At, 1, 0); PG8_STAGE(PG8_SA(0, 1), a2 + hstep, voffA);
            PG8_WAIT_V(8); PG8_WAIT_L(0); PG8_BAR; PG8_MMA(0, 0, At, B0); PG8_MMA(0, 1, At, B1); PG8_BAR; PG8_SCHED;
            PG8_LDA(At, 1, 1); PG8_STAGE(PG8_SB(1, 0), b3, voffB); PG8_STAGE(PG8_SB(1, 1), b3 + hstep, voffB); PG8_STAGE(PG8_SA(1, 0), a3, voffA);
            PG8_WAIT_V(8); PG8_WAIT_L(0); PG8_BAR; PG8_MMA(1, 0, At, B0); PG8_MMA(1, 1, At, B1); PG8_BAR; PG8_SCHED;
            } else {
            PG8_LDB(B0, 0, 0); PG8_SCHED; PG8_LDA(At, 0, 0); PG8_STAGE(PG8_SA(1, 1), a1 + hstep, voffA);
            PG8_WAIT_L(8); PG8_BAR; PG8_WAIT_L(0); PG8_MMA(0, 0, At, B0); PG8_BAR; PG8_SCHED;
            PG8_LDB(B1, 0, 1); PG8_STAGE(PG8_SB(0, 0), b2, voffB);
            PG8_BAR; PG8_WAIT_L(0); PG8_MMA(0, 1, At, B1); PG8_BAR;
            PG8_LDA(At, 0, 1); PG8_STAGE(PG8_SA(0, 0), a2, voffA);
            PG8_BAR; PG8_WAIT_L(0); PG8_MMA(1, 0, At, B0); PG8_BAR; PG8_SCHED;
            PG8_STAGE(PG8_SB(0, 1), b2 + hstep, voffB);
            PG8_WAIT_V(6); PG8_BAR; PG8_MMA(1, 1, At, B1); PG8_BAR;
            PG8_LDB(B0, 1, 0); PG8_SCHED; PG8_LDA(At, 1, 0); PG8_STAGE(PG8_SA(0, 1), a2 + hstep, voffA);
            PG8_WAIT_L(8); PG8_BAR; PG8_WAIT_L(0); PG8_MMA(0, 0, At, B0); PG8_BAR; PG8_SCHED;
            PG8_LDB(B1, 1, 1); PG8_STAGE(PG8_SB(1, 0), b3, voffB);
            PG8_BAR; PG8_WAIT_L(0); PG8_MMA(0, 1, At, B1); PG8_BAR;
            PG8_LDA(At, 1, 1); PG8_STAGE(PG8_SA(1, 0), a3, voffA);
            PG8_BAR; PG8_WAIT_L(0); PG8_MMA(1, 0, At, B0); PG8_BAR; PG8_SCHED;
            PG8_STAGE(PG8_SB(1, 1), b3 + hstep, voffB);
            PG8_WAIT_V(6); PG8_BAR; PG8_MMA(1, 1, At, B1); PG8_BAR;
            }
        }
        if constexpr (ALIGN_EPI) { if (wr == 0) PG8_BAR; }
        if constexpr (!Epi::AFTER_DRAIN) { E(acc, cur, wr, wc, fr, fq); S.done(cur); }
        if (!has_next) break;
#pragma unroll
        for (int a = 0; a < 2; ++a)
#pragma unroll
            for (int b = 0; b < 2; ++b)
#pragma unroll
                for (int m = 0; m < 4; ++m)
#pragma unroll
                    for (int n = 0; n < 2; ++n) acc[a][b][m][n] = (f32x4){0.f, 0.f, 0.f, 0.f};
        cur = nxt; cA = nA; cB = nB; ++ui;
        if constexpr (ALIGN_EPI) { if (wr == 1) PG8_BAR; }
    }
    PG8_WAIT_V(0);
    if constexpr (!ALIGN_EPI) { if (wr == 0) PG8_BAR; }
    PG8_BAR;
    if constexpr (Epi::AFTER_DRAIN) { E.fused(acc, cur, wr, wc, fr, fq, lds, wid, lane); S.done(cur); }
#undef PG8_SA
#undef PG8_SB
#undef PG8_STAGE
#undef PG8_LDA
#undef PG8_LDB
#undef PG8_MMA
#undef PG8_WAIT_V
#undef PG8_WAIT_L
#undef PG8_BAR
#undef PG8_SCHED
}
}
namespace cg = cooperative_groups;
#define LAS __attribute__((address_space(3)))
typedef unsigned short bf16;
typedef float f32x4 __attribute__((ext_vector_type(4)));
typedef float f32x8 __attribute__((ext_vector_type(8)));
typedef float f32x16 __attribute__((ext_vector_type(16)));
typedef unsigned u32x4 __attribute__((ext_vector_type(4)));
typedef unsigned u32x2 __attribute__((ext_vector_type(2)));
typedef short bf16x8 __attribute__((ext_vector_type(8)));
typedef short s16x4 __attribute__((ext_vector_type(4)));

constexpr int BATCH = 16, SEQ = 2048, DM = 1024, T = BATCH * SEQ;
constexpr int NP = 3072;
constexpr int IN_COLS = 3012;
constexpr int C_QA = 0, C_KA = 512, C_VA = 1024, C_QB = 1536, C_KV = 2560, C_QI = 2688, C_KI = 2944, C_WI = 3008;
constexpr int MIXW = 1536;
constexpr int NEXP = 16384;
constexpr float EPS = 1e-6f;
constexpr int NT = 512;
constexpr int NWV = 8;

constexpr size_t MiB = 1u << 20;
constexpr size_t WS_CTL = 0;
constexpr size_t CTL_BYTES = 64 * 1024;
constexpr size_t WS_MOD = 1 * MiB;
constexpr size_t WS_SCAL = WS_MOD + 512 * 1024;
constexpr size_t WS_WIN = 2 * MiB;
constexpr size_t WS_WO2 = 8 * MiB;
constexpr size_t WS_WQ = 11 * MiB;
constexpr size_t WS_SUBK = 13 * MiB;
constexpr size_t WS_U16 = 14 * MiB;
constexpr size_t WS_V16 = 46 * MiB;
constexpr size_t WS_H = 78 * MiB;
constexpr size_t WS_PROJ = 142 * MiB;
constexpr size_t WS_Q3 = WS_PROJ;
constexpr size_t WS_MIX = 334 * MiB;
constexpr size_t WS_EXP = 430 * MiB;
constexpr size_t WS_GATE = 446 * MiB;
constexpr size_t WS_ATMP = 462 * MiB;
constexpr size_t WS_END = 494 * MiB;

struct Params {
    const float *x, *c, *ada_w, *ada_b, *norm1_g, *norm2_g, *w_in, *a_qk_gain, *a_lambda, *a_sub_gain, *b_q_gain, *b_kv_gain, *b_w_uv, *w_out, *peer_wq, *peer_subkeys, *peer_u, *peer_v;
    float* out; unsigned char* ws;
};

enum { SC_LAM = 0, SC_MA = 1, SC_MB = 2 };

__device__ __forceinline__ unsigned f2bf(float f) { unsigned u = __float_as_uint(f); return (u + 0x7fffu + ((u >> 16) & 1u)) >> 16; }
__device__ __forceinline__ float bf2f(unsigned h) { return __uint_as_float(h << 16); }
__device__ __forceinline__ unsigned pk2(float lo, float hi) { return f2bf(lo) | (f2bf(hi) << 16); }
__device__ __forceinline__ float bflo(unsigned w) { return __uint_as_float(w << 16); }
__device__ __forceinline__ float bfhi(unsigned w) { return __uint_as_float(w & 0xffff0000u); }
__device__ __forceinline__ float wave_sum(float v) {
#pragma unroll
    for (int o = 1; o < 64; o <<= 1) v += __shfl_xor(v, o);
    return v;
}
__device__ __forceinline__ float wave_max(float v) {
#pragma unroll
    for (int o = 1; o < 64; o <<= 1) v = fmaxf(v, __shfl_xor(v, o));
    return v;
}
#define LDS_WAIT() asm volatile("s_waitcnt lgkmcnt(0)" ::: "memory")
__device__ __forceinline__ void ph_mod(const Params& p, float* ldsf, int vb, int nvb) {
    if (vb >= 12) return;
    const int tid = threadIdx.x;
    for (int i = tid; i < 16 * 1024; i += NT) { const float v = p.c[i]; ldsf[i] = v / (1.f + __expf(-v)); }
    __syncthreads();
    float* MOD = (float*)(p.ws + WS_MOD);
    for (int it = vb; it < 12; it += nvb) {
        const int j = it * 512 + tid;
        float acc[16];
#pragma unroll
        for (int b = 0; b < 16; ++b) acc[b] = 0.f;
        for (int k = 0; k < 1024; ++k) {
            const float w = p.ada_w[(size_t)k * 6144 + j];
#pragma unroll
            for (int b = 0; b < 16; ++b) acc[b] = fmaf(ldsf[b * 1024 + k], w, acc[b]);
        }
        const float bb = p.ada_b[j];
#pragma unroll
        for (int b = 0; b < 16; ++b) MOD[b * 6144 + j] = acc[b] + bb;
    }
    __syncthreads();
}

__device__ __forceinline__ void transpose_item(const float* W, int N, bf16* WT, int ldt, LAS float* scr, int kb, int nb, int lane) {
    const int k0 = 64 * kb, n0 = 32 * nb;
#pragma unroll 8
    for (int i = 0; i < 32; ++i) { const int kk = 2 * i + (lane >> 5); const int n = n0 + (lane & 31); scr[kk * 33 + (lane & 31)] = (n < N) ? W[(size_t)(k0 + kk) * N + n] : 0.f; }
    LDS_WAIT(); asm volatile("" ::: "memory");
    const int c = lane & 7;
#pragma unroll
    for (int j = 0; j < 4; ++j) { const int n = (lane >> 3) + 8 * j; const LAS float* s = scr + (8 * c) * 33 + n;
        u32x4 o; o.x = pk2(s[0 * 33], s[1 * 33]); o.y = pk2(s[2 * 33], s[3 * 33]); o.z = pk2(s[4 * 33], s[5 * 33]); o.w = pk2(s[6 * 33], s[7 * 33]);
        *(u32x4*)(WT + (size_t)(n0 + n) * ldt + k0 + 8 * c) = o; }
    LDS_WAIT(); asm volatile("" ::: "memory");
}

__device__ __forceinline__ void ph_prep_weights(const Params& p, LAS float* scr, int gw, int ngw, int lane) {
    bf16* WIN = (bf16*)(p.ws + WS_WIN); bf16* WO2 = (bf16*)(p.ws + WS_WO2); bf16* WQ = (bf16*)(p.ws + WS_WQ);
    constexpr int I_IN = 16 * 96, I_O = 8 * 32, I_Q = 16 * 32;
    for (int it = gw; it < I_IN + I_O + I_Q; it += ngw) {
        int r = it;
        if (r < I_IN) { transpose_item(p.w_in, IN_COLS, WIN, 1024, scr, r / 96, r % 96, lane); continue; } r -= I_IN;
        if (r < I_O) { transpose_item(p.w_out, 1024, WO2, MIXW, scr, r / 32, r % 32, lane); continue; } r -= I_O;
        transpose_item(p.peer_wq, 1024, WQ, 1024, scr, r / 32, r % 32, lane);
    }
    const size_t gt = (size_t)gw * 64 + lane, ngt = (size_t)ngw * 64;
    for (size_t i = gt; i < (size_t)1024 * 1024; i += ngt) {
        const int n = (int)(i & 1023), kk = (int)(i >> 10), h = kk >> 7;
        const float* wu = p.b_w_uv + (size_t)kk * 64; const float* wo = p.w_out + (size_t)(512 + 64 * h) * 1024 + n;
        float a = 0.f;
#pragma unroll 8
        for (int e = 0; e < 64; ++e) a = fmaf(wu[e], wo[(size_t)e * 1024], a);
        WO2[(size_t)n * MIXW + 512 + kk] = (bf16)f2bf(a);
    }
    bf16* U16 = (bf16*)(p.ws + WS_U16); bf16* V16 = (bf16*)(p.ws + WS_V16); bf16* SUBK = (bf16*)(p.ws + WS_SUBK);
    constexpr size_t NTAB8 = (size_t)NEXP * 1024 / 8, NSUB8 = 2 * 128 * 64 / 8;
    for (size_t i = gt; i < 2 * NTAB8 + NSUB8; i += ngt) {
        const float* src; bf16* dst; size_t j = i;
        if (j < NTAB8) { src = p.peer_u; dst = U16; } else if (j < 2 * NTAB8) { j -= NTAB8; src = p.peer_v; dst = V16; } else { j -= 2 * NTAB8; src = p.peer_subkeys; dst = SUBK; }
        const f32x8 v = *(const f32x8*)(src + j * 8);
        u32x4 o; o.x = pk2(v[0], v[1]); o.y = pk2(v[2], v[3]); o.z = pk2(v[4], v[5]); o.w = pk2(v[6], v[7]);
        *(u32x4*)(dst + j * 8) = o;
    }
    if (gt == 0) {
        float* SC = (float*)(p.ws + WS_SCAL);
        float s01 = 0.f, s23 = 0.f;
        for (int i = 0; i < 64; ++i) { s01 += p.a_lambda[i] * p.a_lambda[64 + i]; s23 += p.a_lambda[128 + i] * p.a_lambda[192 + i]; }
        SC[SC_LAM] = __expf(s01) - __expf(s23) + 0.2f;
        float g0 = 0.f, g1 = 0.f, gq = 0.f, gk = 0.f;
        for (int i = 0; i < 64; ++i) { g0 = fmaxf(g0, fabsf(p.a_qk_gain[i])); g1 = fmaxf(g1, fabsf(p.a_qk_gain[64 + i])); }
        for (int i = 0; i < 128; ++i) { gq = fmaxf(gq, fabsf(p.b_q_gain[i])); gk = fmaxf(gk, fabsf(p.b_kv_gain[i])); }
        SC[SC_MA] = 8.0f * g0 * g1 * 1.02f;
        SC[SC_MB] = 11.3137085f * gq * gk * 1.02f;
    }
}

__device__ __forceinline__ void ph_hrows(const Params& p, const float* X, const float* g, int shOff, int scOff, int gw, int ngw, int lane) {
    const float* MOD = (const float*)(p.ws + WS_MOD); bf16* H = (bf16*)(p.ws + WS_H);
    for (int m = gw; m < T; m += ngw) {
        const f32x4* xr = (const f32x4*)(X + (size_t)m * 1024) + lane;
        f32x4 v[4]; float s = 0.f;
#pragma unroll
        for (int j = 0; j < 4; ++j) { v[j] = xr[64 * j]; s += (v[j].x * v[j].x + v[j].y * v[j].y) + (v[j].z * v[j].z + v[j].w * v[j].w); }
        const float rstd = rsqrtf(wave_sum(s) * (1.f / 1024.f) + EPS);
        const float* mb = MOD + (size_t)(m >> 11) * 6144;
#pragma unroll
        for (int j = 0; j < 4; ++j) {
            const int col = 4 * (lane + 64 * j);
            const f32x4 gg = *(const f32x4*)(g + col), sc = *(const f32x4*)(mb + scOff + col), sh = *(const f32x4*)(mb + shOff + col);
            const f32x4 y = v[j] * rstd * gg * (sc + 1.0f) + sh;
            u32x2 o; o.x = pk2(y.x, y.y); o.y = pk2(y.z, y.w);
            *(u32x2*)(H + (size_t)m * 1024 + col) = o;
        }
    }
}

__device__ __forceinline__ void ph_norm_proj(const Params& p, int gw, int ngw, int lane) {
    bf16* PROJ = (bf16*)(p.ws + WS_PROJ);
    for (int m = gw; m < T; m += ngw) {
        bf16* row = PROJ + (size_t)m * NP;
#pragma unroll
        for (int j = 0; j < 6; ++j) {
            if (j == 2) continue;
            const int col = 8 * lane + 512 * j;
            const u32x4 raw = *(const u32x4*)(row + col);
            float v[8] = {bflo(raw.x), bfhi(raw.x), bflo(raw.y), bfhi(raw.y), bflo(raw.z), bfhi(raw.z), bflo(raw.w), bfhi(raw.w)};
            float ss = 0.f;
#pragma unroll
            for (int i = 0; i < 8; ++i) ss += v[i] * v[i];
            ss += __shfl_xor(ss, 1); ss += __shfl_xor(ss, 2); ss += __shfl_xor(ss, 4);
            float rstd; const float* gp;
            if (j < 2) { rstd = rsqrtf(ss * (1.f / 64.f) + EPS); gp = p.a_qk_gain + 64 * j + (col & 63); }
            else { ss += __shfl_xor(ss, 8); rstd = rsqrtf(ss * (1.f / 128.f) + EPS); gp = (j == 5 ? p.b_kv_gain : p.b_q_gain) + (col & 127); }
            if (j == 5 && lane >= 16) continue;
            const f32x4 g0 = *(const f32x4*)gp, g1 = *(const f32x4*)(gp + 4);
            u32x4 o; o.x = pk2(v[0] * rstd * g0.x, v[1] * rstd * g0.y); o.y = pk2(v[2] * rstd * g0.z, v[3] * rstd * g0.w);
            o.z = pk2(v[4] * rstd * g1.x, v[5] * rstd * g1.y); o.w = pk2(v[6] * rstd * g1.z, v[7] * rstd * g1.w);
            *(u32x4*)(row + col) = o;
        }
    }
}
__device__ void ph_attnA_naive(const Params& p, float* lds_w, int gw, int ngw, int lane) {
    const bf16* PROJ = (const bf16*)(p.ws + WS_PROJ); bf16* MIX = (bf16*)(p.ws + WS_MIX);
    const float lam = ((const float*)(p.ws + WS_SCAL))[SC_LAM];
    float* qs = lds_w; float* sc0 = lds_w + 128; float* sc1 = sc0 + 2048;
    for (int it = gw; it < BATCH * 4 * SEQ; it += ngw) {
        const int t = it & 2047, h = (it >> 11) & 3, b = it >> 13;
        const int cend = ((t >> 6) + 1) << 6;
        const float slope = exp2f(-2.0f * (h + 1));
        const bf16* qrow = PROJ + (size_t)(b * SEQ + t) * NP + C_QA + h * 128;
        qs[lane] = bf2f(qrow[lane]); qs[64 + lane] = bf2f(qrow[64 + lane]);
        LDS_WAIT(); asm volatile("" ::: "memory");
        float m0 = -3e38f, m1 = -3e38f;
        for (int kk = lane; kk < cend; kk += 64) {
            const bf16* krow = PROJ + (size_t)(b * SEQ + kk) * NP + C_KA + h * 128;
            float d0 = 0.f, d1 = 0.f;
            for (int d = 0; d < 64; ++d) { d0 = fmaf(qs[d], bf2f(krow[d]), d0); d1 = fmaf(qs[64 + d], bf2f(krow[64 + d]), d1); }
            const float bias = slope * fabsf((float)(t - kk));
            d0 = d0 * 0.125f - bias; d1 = d1 * 0.125f - bias;
            sc0[kk] = d0; sc1[kk] = d1; m0 = fmaxf(m0, d0); m1 = fmaxf(m1, d1);
        }
        m0 = wave_max(m0); m1 = wave_max(m1);
        float l0 = 0.f, l1 = 0.f;
        for (int kk = lane; kk < cend; kk += 64) { const float e0 = __expf(sc0[kk] - m0), e1 = __expf(sc1[kk] - m1); sc0[kk] = e0; sc1[kk] = e1; l0 += e0; l1 += e1; }
        l0 = wave_sum(l0); l1 = wave_sum(l1);
        const float i0 = 1.f / l0, i1 = lam / l1;
        for (int kk = lane; kk < cend; kk += 64) sc0[kk] = sc0[kk] * i0 - sc1[kk] * i1;
        LDS_WAIT(); asm volatile("" ::: "memory");
        float a0 = 0.f, a1 = 0.f;
        const bf16* vb = PROJ + (size_t)(b * SEQ) * NP + C_VA + h * 128;
        for (int kk = 0; kk < cend; ++kk) { const float a = sc0[kk]; const bf16* vr = vb + (size_t)kk * NP; a0 = fmaf(a, bf2f(vr[lane]), a0); a1 = fmaf(a, bf2f(vr[64 + lane]), a1); }
        const float ss = wave_sum(a0 * a0 + a1 * a1);
        const float rstd = rsqrtf(ss * (1.f / 128.f) + EPS) * 0.8f;
        bf16* orow = MIX + (size_t)(b * SEQ + t) * MIXW + h * 128;
        orow[lane] = (bf16)f2bf(a0 * rstd * p.a_sub_gain[lane]); orow[64 + lane] = (bf16)f2bf(a1 * rstd * p.a_sub_gain[64 + lane]);
        LDS_WAIT(); asm volatile("" ::: "memory");
    }
}

__device__ void ph_dsa_naive(const Params& p, float* lds, int vb, int nvb) {
    const bf16* PROJ = (const bf16*)(p.ws + WS_PROJ); bf16* MIX = (bf16*)(p.ws + WS_MIX);
    const int tid = threadIdx.x, lane = tid & 63, wv = tid >> 6;
    float* scores = lds; int* sel = (int*)(lds + 2048); float* qi = lds + 2048 + 256; float* wi = qi + 256;
    float* qh = wi + 64 + wv * 384; float* pw = qh + 128;
    for (int it = vb; it < T; it += nvb) {
        const int b = it >> 11, t = it & 2047; const int cend = ((t >> 6) + 1) << 6;
        const bf16* row = PROJ + (size_t)it * NP;
        if (tid < 256) qi[tid] = bf2f(row[C_QI + tid]);
        if (tid < 4) wi[tid] = bf2f(row[C_WI + tid]);
        __syncthreads();
        for (int kk = tid; kk < cend; kk += NT) {
            const bf16* kr = PROJ + (size_t)(b * SEQ + kk) * NP + C_KI;
            float s = 0.f;
            for (int h = 0; h < 4; ++h) { float d = 0.f; for (int e = 0; e < 64; ++e) d = fmaf(qi[h * 64 + e], bf2f(kr[e]), d); s += fmaxf(d, 0.f) * wi[h]; }
            scores[kk] = s * 0.0625f;
        }
        __syncthreads();
        int nvalid;
        if (cend <= 256) { if (tid < 256) sel[tid] = tid; nvalid = cend; }
        else {
            for (int i = tid; i < cend; i += NT) { const float si = scores[i]; int rank = 0;
                for (int j = 0; j < cend; ++j) { const float sj = scores[j]; rank += (sj > si || (sj == si && j < i)) ? 1 : 0; }
                if (rank < 256) sel[rank] = i; }
            nvalid = 256;
        }
        __syncthreads();
        {
            const int h = wv; const float slope = exp2f(-(float)(h + 1));
            qh[lane] = bf2f(row[C_QB + h * 128 + lane]); qh[64 + lane] = bf2f(row[C_QB + h * 128 + 64 + lane]);
            LDS_WAIT(); asm volatile("" ::: "memory");
            float sv[4]; float mx = -3e38f;
#pragma unroll
            for (int jj = 0; jj < 4; ++jj) { const int j = lane + 64 * jj; const int key = sel[j < nvalid ? j : 0];
                const bf16* kv = PROJ + (size_t)(b * SEQ + key) * NP + C_KV; float d = 0.f;
                for (int e = 0; e < 128; ++e) d = fmaf(qh[e], bf2f(kv[e]), d);
                d = d * 0.0883883476f - slope * fabsf((float)(t - key));
                sv[jj] = (j < nvalid) ? d : -3e38f; mx = fmaxf(mx, sv[jj]); }
            mx = wave_max(mx); float l = 0.f;
#pragma unroll
            for (int jj = 0; jj < 4; ++jj) { const int j = lane + 64 * jj; const float e = (j < nvalid) ? __expf(sv[jj] - mx) : 0.f; pw[j] = e; l += e; }
            l = wave_sum(l);
            LDS_WAIT(); asm volatile("" ::: "memory");
            float a0 = 0.f, a1 = 0.f;
            for (int j = 0; j < nvalid; ++j) { const float pj = pw[j]; const bf16* kv = PROJ + (size_t)(b * SEQ + sel[j]) * NP + C_KV; a0 = fmaf(pj, bf2f(kv[lane]), a0); a1 = fmaf(pj, bf2f(kv[64 + lane]), a1); }
            const float il = 1.f / l;
            bf16* orow = MIX + (size_t)it * MIXW + 512 + h * 128;
            orow[lane] = (bf16)f2bf(a0 * il); orow[64 + lane] = (bf16)f2bf(a1 * il);
        }
        __syncthreads();
    }
}

__device__ void ph_route_naive(const Params& p, float* lds, int vb, int nvb) {
    const bf16* Q3 = (const bf16*)(p.ws + WS_Q3); const bf16* SUBK = (const bf16*)(p.ws + WS_SUBK);
    int* EXPI = (int*)(p.ws + WS_EXP); float* GATE = (float*)(p.ws + WS_GATE);
    const int tid = threadIdx.x;
    float* q = lds; float* sub = q + 1024; float* sv = sub + 2048; int* si = (int*)(sv + 256); float* cand = sv + 512; float* ts = cand + 2048; int* te = (int*)(ts + 128);
    for (int it = vb; it < T; it += nvb) {
        q[tid] = bf2f(Q3[(size_t)it * 1024 + tid]); q[tid + 512] = bf2f(Q3[(size_t)it * 1024 + tid + 512]);
        __syncthreads();
        for (int r = 0; r < 4; ++r) { const int idx = tid + 512 * r, h = idx >> 8, c = (idx >> 7) & 1, n = idx & 127;
            const float* qq = q + h * 128 + c * 64; const bf16* kk = SUBK + (size_t)(c * 128 + n) * 64; float d = 0.f;
            for (int e = 0; e < 64; ++e) d = fmaf(qq[e], bf2f(kk[e]), d);
            sub[idx] = d; }
        __syncthreads();
        for (int r = 0; r < 4; ++r) { const int idx = tid + 512 * r, g0 = idx & ~127, n = idx & 127; const float s = sub[idx]; int rank = 0;
            for (int j = 0; j < 128; ++j) { const float sj = sub[g0 + j]; rank += (sj > s || (sj == s && j < n)) ? 1 : 0; }
            if (rank < 16) { sv[(g0 >> 7) * 16 + rank] = s; si[(g0 >> 7) * 16 + rank] = n; } }
        __syncthreads();
        for (int r = 0; r < 4; ++r) { const int idx = tid + 512 * r, h = idx >> 8, i = (idx >> 4) & 15, j = idx & 15; cand[idx] = sv[(h * 2) * 16 + i] + sv[(h * 2 + 1) * 16 + j]; }
        __syncthreads();
        for (int r = 0; r < 4; ++r) { const int idx = tid + 512 * r, h = idx >> 8, ij = idx & 255; const float s = cand[idx]; int rank = 0;
            for (int j = 0; j < 256; ++j) { const float sj = cand[h * 256 + j]; rank += (sj > s || (sj == s && j < ij)) ? 1 : 0; }
            if (rank < 16) { ts[h * 16 + rank] = s; te[h * 16 + rank] = si[(h * 2) * 16 + (ij >> 4)] * 128 + si[(h * 2 + 1) * 16 + (ij & 15)]; } }
        __syncthreads();
        if (tid < 128) { const int h = tid >> 4; const float mx = ts[h * 16]; float l = 0.f;
            for (int k = 0; k < 16; ++k) l += __expf(ts[h * 16 + k] - mx);
            GATE[(size_t)it * 128 + tid] = __expf(ts[tid] - mx) / l; EXPI[(size_t)it * 128 + tid] = te[tid]; }
        __syncthreads();
    }
}

__device__ void ph_peer_naive(const Params& p, float* lds, int vb, int nvb) {
    const bf16* H = (const bf16*)(p.ws + WS_H); const bf16* U16 = (const bf16*)(p.ws + WS_U16); const bf16* V16 = (const bf16*)(p.ws + WS_V16);
    const int* EXPI = (const int*)(p.ws + WS_EXP); const float* GATE = (const float*)(p.ws + WS_GATE); const float* MOD = (const float*)(p.ws + WS_MOD);
    const int tid = threadIdx.x, lane = tid & 63, wv = tid >> 6;
    float* xs = lds; float* coef = lds + 1024; int* ex = (int*)(coef + 128);
    for (int it = vb; it < T; it += nvb) {
        xs[tid] = bf2f(H[(size_t)it * 1024 + tid]); xs[tid + 512] = bf2f(H[(size_t)it * 1024 + tid + 512]);
        if (tid < 128) ex[tid] = EXPI[(size_t)it * 128 + tid];
        __syncthreads();
        for (int jj = 0; jj < 16; ++jj) { const int j = wv * 16 + jj; const bf16* ur = U16 + (size_t)ex[j] * 1024; float d = 0.f;
            for (int i = 0; i < 16; ++i) d = fmaf(xs[lane + 64 * i], bf2f(ur[lane + 64 * i]), d);
            d = wave_sum(d);
            if (lane == 0) coef[j] = 0.5f * d * (1.f + erff(d * 0.70710678f)) * GATE[(size_t)it * 128 + j]; }
        __syncthreads();
        const float* g2 = MOD + (size_t)(it >> 11) * 6144 + 5120;
        for (int r = 0; r < 2; ++r) { const int d = tid + 512 * r; float a = 0.f;
            for (int j = 0; j < 128; ++j) a = fmaf(coef[j], bf2f(V16[(size_t)ex[j] * 1024 + d]), a);
            p.out[(size_t)it * 1024 + d] = p.out[(size_t)it * 1024 + d] + g2[d] * a; }
        __syncthreads();
    }
}
struct EpiResGate {
    static constexpr bool PERM = false, AFTER_DRAIN = false;
    const float* X; float* Out; const float* gate;
    __device__ __forceinline__ void operator()(const pg8::f32x4 (&acc)[2][2][4][2], const pg8::Unit& u, int wr, int wc, int fr, int fq) const {
        const int col0 = u.pn * 256 + wc * 32 + 4 * fq;
#pragma unroll
        for (int ai = 0; ai < 2; ++ai)
#pragma unroll
            for (int m = 0; m < 4; ++m) {
                const int r = u.pm * 256 + ai * 128 + wr * 64 + m * 16 + fr; const float* gb = gate + (size_t)(r >> 11) * 6144;
#pragma unroll
                for (int bj = 0; bj < 2; ++bj)
#pragma unroll
                    for (int n = 0; n < 2; ++n) { const int c = col0 + bj * 128 + n * 16; const size_t off = (size_t)r * 1024 + c;
                        const pg8::f32x4 xv = *(const pg8::f32x4*)(X + off), gv = *(const pg8::f32x4*)(gb + c);
                        *(pg8::f32x4*)(Out + off) = xv + gv * acc[ai][bj][m][n]; }
            }
    }
};

typedef __bf16 bf16x2_t __attribute__((ext_vector_type(2)));
__device__ __forceinline__ float dot2bf(unsigned a, unsigned b, float acc) { return __builtin_amdgcn_fdot2_f32_bf16(__builtin_bit_cast(bf16x2_t, a), __builtin_bit_cast(bf16x2_t, b), acc, false); }
template <int CTRL> __device__ __forceinline__ float dpp_f(float v) { return __int_as_float(__builtin_amdgcn_update_dpp(0, __float_as_int(v), CTRL, 0xf, 0xf, false)); }
__device__ __forceinline__ float row16_sum(float v) {
    v += dpp_f<0x128>(v); v += dpp_f<0x124>(v); v += dpp_f<0x122>(v); v += dpp_f<0x121>(v); return v;
}
__device__ __forceinline__ float gelu_erf(float a) { return 0.5f * a * (1.f + erff(a * 0.70710678118f)); }

__device__ __forceinline__ void ph_peer(const Params& p, unsigned char* lds_w, int gw, int ngw, int lane_) {
    int lane = lane_; asm volatile("" : "+v"(lane));
    const bf16* H = (const bf16*)(p.ws + WS_H); const bf16* U16 = (const bf16*)(p.ws + WS_U16); const bf16* V16 = (const bf16*)(p.ws + WS_V16);
    const int* EXPI = (const int*)(p.ws + WS_EXP); const float* GATE = (const float*)(p.ws + WS_GATE); const float* MOD = (const float*)(p.ws + WS_MOD);
    int* e_lds = (int*)lds_w; float* a_lds = (float*)(lds_w + 512);
    const int g = lane >> 4, i = lane & 15;
    for (int t = gw; t < T; t += ngw) {
        const int e0 = EXPI[(size_t)t * 128 + lane], e1 = EXPI[(size_t)t * 128 + 64 + lane];
        const float g0 = GATE[(size_t)t * 128 + lane], g1 = GATE[(size_t)t * 128 + 64 + lane];
        e_lds[lane] = e0; e_lds[64 + lane] = e1;
        u32x4 xr[8];
        const u32x4* xrow = (const u32x4*)(H + (size_t)t * 1024) + i;
#pragma unroll
        for (int k = 0; k < 8; ++k) xr[k] = xrow[16 * k];
        LDS_WAIT(); asm volatile("" ::: "memory");
        u32x4 ua[8], ub[8];
        { const u32x4* ur = (const u32x4*)(U16 + (size_t)e_lds[g] * 1024) + i;
#pragma unroll
          for (int k = 0; k < 8; ++k) ua[k] = ur[16 * k]; }
#pragma unroll 1
        for (int s = 0; s < 32; s += 2) {
            { const u32x4* ur = (const u32x4*)(U16 + (size_t)e_lds[4 * (s + 1) + g] * 1024) + i;
#pragma unroll
              for (int k = 0; k < 8; ++k) ub[k] = ur[16 * k]; }
            { float a0 = 0.f, a1 = 0.f, a2 = 0.f, a3 = 0.f;
#pragma unroll
              for (int k = 0; k < 8; ++k) { a0 = dot2bf(ua[k].x, xr[k].x, a0); a1 = dot2bf(ua[k].y, xr[k].y, a1); a2 = dot2bf(ua[k].z, xr[k].z, a2); a3 = dot2bf(ua[k].w, xr[k].w, a3); }
              const float a = row16_sum((a0 + a1) + (a2 + a3));
              if (i == 0) a_lds[4 * s + g] = a; }
            if (s + 2 < 32) { const u32x4* ur = (const u32x4*)(U16 + (size_t)e_lds[4 * (s + 2) + g] * 1024) + i;
#pragma unroll
              for (int k = 0; k < 8; ++k) ua[k] = ur[16 * k]; }
            { float a0 = 0.f, a1 = 0.f, a2 = 0.f, a3 = 0.f;
#pragma unroll
              for (int k = 0; k < 8; ++k) { a0 = dot2bf(ub[k].x, xr[k].x, a0); a1 = dot2bf(ub[k].y, xr[k].y, a1); a2 = dot2bf(ub[k].z, xr[k].z, a2); a3 = dot2bf(ub[k].w, xr[k].w, a3); }
              const float a = row16_sum((a0 + a1) + (a2 + a3));
              if (i == 0) a_lds[4 * (s + 1) + g] = a; }
        }
        LDS_WAIT(); asm volatile("" ::: "memory");
        const float c0 = gelu_erf(a_lds[lane]) * g0, c1 = gelu_erf(a_lds[64 + lane]) * g1;
        const unsigned pw = pk2(c0, c1);
        float acc[16];
#pragma unroll
        for (int q = 0; q < 16; ++q) acc[q] = 0.f;
        u32x4 A0, A1, B0, B1, C0, C1, D0, D1;
#define PEER_VLOAD(j, X0, X1, Y0, Y1) do { const int ea_ = __builtin_amdgcn_readlane(e0, (j)), eb_ = __builtin_amdgcn_readlane(e1, (j)); \
            const u32x4* ra_ = (const u32x4*)(V16 + (size_t)ea_ * 1024) + lane; const u32x4* rb_ = (const u32x4*)(V16 + (size_t)eb_ * 1024) + lane; \
            X0 = ra_[0]; X1 = ra_[64]; Y0 = rb_[0]; Y1 = rb_[64]; } while (0)
#define PEER_VACC(j, X0, X1, Y0, Y1) do { const unsigned cp_ = (unsigned)__builtin_amdgcn_readlane((int)pw, (j)); \
            acc[0] = dot2bf(__builtin_amdgcn_perm(Y0.x, X0.x, 0x05040100u), cp_, acc[0]); acc[1] = dot2bf(__builtin_amdgcn_perm(Y0.x, X0.x, 0x07060302u), cp_, acc[1]); \
            acc[2] = dot2bf(__builtin_amdgcn_perm(Y0.y, X0.y, 0x05040100u), cp_, acc[2]); acc[3] = dot2bf(__builtin_amdgcn_perm(Y0.y, X0.y, 0x07060302u), cp_, acc[3]); \
            acc[4] = dot2bf(__builtin_amdgcn_perm(Y0.z, X0.z, 0x05040100u), cp_, acc[4]); acc[5] = dot2bf(__builtin_amdgcn_perm(Y0.z, X0.z, 0x07060302u), cp_, acc[5]); \
            acc[6] = dot2bf(__builtin_amdgcn_perm(Y0.w, X0.w, 0x05040100u), cp_, acc[6]); acc[7] = dot2bf(__builtin_amdgcn_perm(Y0.w, X0.w, 0x07060302u), cp_, acc[7]); \
            acc[8] = dot2bf(__builtin_amdgcn_perm(Y1.x, X1.x, 0x05040100u), cp_, acc[8]); acc[9] = dot2bf(__builtin_amdgcn_perm(Y1.x, X1.x, 0x07060302u), cp_, acc[9]); \
            acc[10] = dot2bf(__builtin_amdgcn_perm(Y1.y, X1.y, 0x05040100u), cp_, acc[10]); acc[11] = dot2bf(__builtin_amdgcn_perm(Y1.y, X1.y, 0x07060302u), cp_, acc[11]); \
            acc[12] = dot2bf(__builtin_amdgcn_perm(Y1.z, X1.z, 0x05040100u), cp_, acc[12]); acc[13] = dot2bf(__builtin_amdgcn_perm(Y1.z, X1.z, 0x07060302u), cp_, acc[13]); \
            acc[14] = dot2bf(__builtin_amdgcn_perm(Y1.w, X1.w, 0x05040100u), cp_, acc[14]); acc[15] = dot2bf(__builtin_amdgcn_perm(Y1.w, X1.w, 0x07060302u), cp_, acc[15]); } while (0)
        PEER_VLOAD(0, A0, A1, B0, B1);
#pragma unroll 1
        for (int j = 0; j < 64; j += 2) {
            PEER_VLOAD(j + 1, C0, C1, D0, D1);
            PEER_VACC(j, A0, A1, B0, B1);
            if (j + 2 < 64) PEER_VLOAD(j + 2, A0, A1, B0, B1);
            PEER_VACC(j + 1, C0, C1, D0, D1);
        }
#undef PEER_VLOAD
#undef PEER_VACC
        const float* g2 = MOD + (size_t)(t >> 11) * 6144 + 5120;
        float* orow = p.out + (size_t)t * 1024;
#pragma unroll
        for (int h = 0; h < 2; ++h)
#pragma unroll
            for (int q = 0; q < 2; ++q) { const int col = 512 * h + 8 * lane + 4 * q;
                const f32x4 xv = *(const f32x4*)(orow + col), gv = *(const f32x4*)(g2 + col);
                f32x4 a; a.x = acc[8 * h + 4 * q]; a.y = acc[8 * h + 4 * q + 1]; a.z = acc[8 * h + 4 * q + 2]; a.w = acc[8 * h + 4 * q + 3];
                *(f32x4*)(orow + col) = xv + gv * a; }
    }
}
typedef short v4i16_t __attribute__((ext_vector_type(4)));
constexpr int DSA_SROW = 2048 * 4 + 16;
constexpr int DSA_SEL_OFF = 16 * DSA_SROW;
constexpr int DSA_LDS = DSA_SEL_OFF + 16 * 512;
constexpr int DSA_KVROW = 272;

__device__ __forceinline__ unsigned sortkey(float s) { const unsigned u = __float_as_uint(s); return u ^ ((u >> 31) ? 0xffffffffu : 0x80000000u); }
__device__ __forceinline__ unsigned cvtpk_bf16(float lo, float hi) { unsigned r; asm volatile("v_cvt_pk_bf16_f32 %0, %1, %2" : "=v"(r) : "v"(lo), "v"(hi)); return r; }

__device__ __forceinline__ void ph_dsa(const Params& p, unsigned char* lds, int vb, int nvb) {
    const bf16* PROJ = (const bf16*)(p.ws + WS_PROJ); bf16* MIX = (bf16*)(p.ws + WS_MIX);
    const float MB = ((const float*)(p.ws + WS_SCAL))[SC_MB];
    int tid = threadIdx.x; asm volatile("" : "+v"(tid)); const int lane = tid & 63, wv = __builtin_amdgcn_readfirstlane(tid >> 6);
    const int l15 = lane & 15, g = lane >> 4;
    LAS unsigned char* ldsl = (LAS unsigned char*)lds;
    for (int it = vb; it < 2048; it += nvb) {
        const int vbb = it & 255, kk = it >> 8, G = vbb >> 6, ps = vbb & 63, b = ps >> 2, sub = ps & 3;
        const int c = (kk & 1) ? (31 - G - 8 * (kk >> 1)) : (G + 8 * (kk >> 1));
        const int cend = (c + 1) * 64, t0 = c * 64 + sub * 16;
        const bf16* Pb = PROJ + (size_t)b * SEQ * NP;
        if (c >= 4) {
            const bf16* qrow = Pb + (size_t)(t0 + l15) * NP;
            bf16x8 bq[4][2]; float wsc[4];
#pragma unroll
            for (int h = 0; h < 4; ++h) { wsc[h] = bf2f(qrow[C_WI + h]) * 0.0625f;
#pragma unroll
                for (int ks = 0; ks < 2; ++ks) bq[h][ks] = *(const bf16x8*)(qrow + C_QI + h * 64 + 32 * ks + 8 * g); }
            for (int k0 = 16 * wv; k0 < cend; k0 += 128) {
                const bf16* krow = Pb + (size_t)(k0 + l15) * NP + C_KI + 8 * g;
                const bf16x8 ka0 = *(const bf16x8*)krow, ka1 = *(const bf16x8*)(krow + 32);
                f32x4 sc = {0.f, 0.f, 0.f, 0.f};
#pragma unroll
                for (int h = 0; h < 4; ++h) { f32x4 a = {0.f, 0.f, 0.f, 0.f};
                    a = __builtin_amdgcn_mfma_f32_16x16x32_bf16(ka0, bq[h][0], a, 0, 0, 0);
                    a = __builtin_amdgcn_mfma_f32_16x16x32_bf16(ka1, bq[h][1], a, 0, 0, 0);
#pragma unroll
                    for (int r = 0; r < 4; ++r) sc[r] = fmaf(fmaxf(a[r], 0.f), wsc[h], sc[r]); }
#pragma unroll
                for (int r = 0; r < 4; ++r) sc[r] = (sc[r] == 0.f) ? 0.f : sc[r];
                *(LAS f32x4*)(ldsl + l15 * DSA_SROW + (k0 + 4 * g) * 4) = sc;
            }
        }
        __syncthreads();
        LAS unsigned short* selw = (LAS unsigned short*)(ldsl + DSA_SEL_OFF);
        int mind0 = 0, mind1 = 0;
#pragma unroll 1
        for (int qi = 0; qi < 2; ++qi) {
            const int qq = 2 * wv + qi, t = t0 + qq;
            LAS unsigned short* sel = selw + qq * 256;
            if (c < 4) { for (int j = lane; j < 256; j += 64) sel[j] = (unsigned short)j; continue; }
            const int nreg = cend >> 6;
            unsigned key[32];
            const LAS float* srow = (const LAS float*)(ldsl + qq * DSA_SROW) + lane;
#pragma unroll
            for (int i = 0; i < 32; ++i) key[i] = (i < nreg) ? sortkey(srow[64 * i]) : 0u;
            unsigned prefix = 0u; bool exact = false;
#pragma unroll 1
            for (int bit = 31; bit >= 0; --bit) {
                const unsigned cand = prefix | (1u << bit); int cnt = 0;
#pragma unroll
                for (int i = 0; i < 32; ++i) cnt += __popcll(__ballot(key[i] >= cand));
                if (cnt >= 256) { prefix = cand; if (cnt == 256) { exact = true; break; } }
            }
            int need_ties = 0;
            if (!exact) { int cgt = 0;
                if (prefix != 0xffffffffu) {
#pragma unroll
                    for (int i = 0; i < 32; ++i) cgt += __popcll(__ballot(key[i] > prefix)); }
                need_ties = 256 - cgt; }
            int base = 0, tbase = 0, md = 4096;
#pragma unroll
            for (int i = 0; i < 32; ++i) {
                if (i < nreg) {
                    bool selb;
                    if (exact) selb = key[i] >= prefix;
                    else { const bool tie = key[i] == prefix; const unsigned long long mt = __ballot(tie);
                        const int trank = tbase + (int)__builtin_amdgcn_mbcnt_hi((unsigned)(mt >> 32), __builtin_amdgcn_mbcnt_lo((unsigned)mt, 0u));
                        selb = (key[i] > prefix) || (tie && trank < need_ties); tbase += __popcll(mt); }
                    const unsigned long long m = __ballot(selb);
                    const int pos = base + (int)__builtin_amdgcn_mbcnt_hi((unsigned)(m >> 32), __builtin_amdgcn_mbcnt_lo((unsigned)m, 0u));
                    const int kidx = i * 64 + lane;
                    if (selb) { sel[pos] = (unsigned short)kidx; const int d = t > kidx ? t - kidx : kidx - t; md = d < md ? d : md; }
                    base += __popcll(m);
                }
            }
#pragma unroll
            for (int o = 1; o < 64; o <<= 1) { const int x = __shfl_xor(md, o); md = x < md ? x : md; }
            if (qi == 0) mind0 = md; else mind1 = md;
        }
        LDS_WAIT(); asm volatile("" ::: "memory");
        const int nvalid = cend < 256 ? cend : 256;
        const int head = lane & 7;
        const float slopeL2 = exp2f(-(float)(head + 1)) * 1.4426950409f;
#pragma unroll 1
        for (int qi = 0; qi < 2; ++qi) {
            const int qq = 2 * wv + qi, t = t0 + qq;
            const LAS unsigned short* sel = selw + qq * 256;
            LAS unsigned char* stg = ldsl + (2 * wv) * DSA_SROW;
            const bf16* qrow = Pb + (size_t)t * NP + C_QB + head * 128 + 8 * g;
            bf16x8 bq[4];
#pragma unroll
            for (int ks = 0; ks < 4; ++ks) bq[ks] = *(const bf16x8*)(qrow + 32 * ks);
            const float refL2 = MB * 1.4426950409f - slopeL2 * (float)(qi == 0 ? mind0 : mind1);
            f32x4 o[8];
#pragma unroll
            for (int dt = 0; dt < 8; ++dt) o[dt] = (f32x4){0.f, 0.f, 0.f, 0.f};
            float lsum = 0.f;
#pragma unroll 1
            for (int s = 0; s < 8; ++s) {
                if (32 * s >= nvalid) break;
                unsigned pb[4];
#pragma unroll
                for (int tl = 0; tl < 2; ++tl) {
                    const int j0 = 32 * s + 16 * tl;
                    const int jr = j0 + l15; const int keyr = sel[jr < nvalid ? jr : 0];
                    const bf16* kvrow = Pb + (size_t)keyr * NP + C_KV + 8 * g;
                    bf16x8 ka[4];
#pragma unroll
                    for (int ks = 0; ks < 4; ++ks) ka[ks] = *(const bf16x8*)(kvrow + 32 * ks);
                    f32x4 a = {0.f, 0.f, 0.f, 0.f};
#pragma unroll
                    for (int ks = 0; ks < 4; ++ks) { a = __builtin_amdgcn_mfma_f32_16x16x32_bf16(ka[ks], bq[ks], a, 0, 0, 0);
                        *(LAS bf16x8*)(stg + (16 * tl + l15) * DSA_KVROW + (32 * ks + 8 * g) * 2) = ka[ks]; }
                    const u32x2 kw = *(const LAS u32x2*)(sel + j0 + 4 * g);
                    const int kx[4] = {(int)(kw.x & 0xffffu), (int)(kw.x >> 16), (int)(kw.y & 0xffffu), (int)(kw.y >> 16)};
                    float pr[4];
#pragma unroll
                    for (int r = 0; r < 4; ++r) { const int dd = t > kx[r] ? t - kx[r] : kx[r] - t;
                        const float e = __builtin_amdgcn_exp2f(fmaf(a[r], 0.1275174f, -slopeL2 * (float)dd - refL2));
                        pr[r] = (j0 + 4 * g + r < nvalid) ? e : 0.f; lsum += pr[r]; }
                    pb[2 * tl] = cvtpk_bf16(pr[0], pr[1]); pb[2 * tl + 1] = cvtpk_bf16(pr[2], pr[3]);
                }
                LDS_WAIT(); asm volatile("" ::: "memory");
                u32x4 pw4; pw4.x = pb[0]; pw4.y = pb[1]; pw4.z = pb[2]; pw4.w = pb[3];
                const bf16x8 pfrag = __builtin_bit_cast(bf16x8, pw4);
                const LAS unsigned char* trb = stg + (4 * g + (l15 >> 2)) * DSA_KVROW + (4 * (lane & 3)) * 2;
#pragma unroll
                for (int dt = 0; dt < 8; ++dt) {
                    const s16x4 lo = __builtin_bit_cast(s16x4, __builtin_amdgcn_ds_read_tr16_b64_v4i16((LAS v4i16_t*)(trb + dt * 32)));
                    const s16x4 hi = __builtin_bit_cast(s16x4, __builtin_amdgcn_ds_read_tr16_b64_v4i16((LAS v4i16_t*)(trb + 16 * DSA_KVROW + dt * 32)));
                    const bf16x8 af = {lo[0], lo[1], lo[2], lo[3], hi[0], hi[1], hi[2], hi[3]};
                    o[dt] = __builtin_amdgcn_mfma_f32_16x16x32_bf16(af, pfrag, o[dt], 0, 0, 0);
                }
                LDS_WAIT(); asm volatile("" ::: "memory");
            }
            lsum += __shfl_xor(lsum, 16); lsum += __shfl_xor(lsum, 32);
            const float il = 1.f / lsum;
            if (l15 < 8) {
                bf16* orow = MIX + (size_t)(b * SEQ + t) * MIXW + 512 + head * 128 + 4 * g;
#pragma unroll
                for (int dt = 0; dt < 8; ++dt) { u32x2 w; w.x = pk2(o[dt][0] * il, o[dt][1] * il); w.y = pk2(o[dt][2] * il, o[dt][3] * il); *(u32x2*)(orow + 16 * dt) = w; }
            }
        }
        __syncthreads();
    }
}
typedef __attribute__((address_space(1))) float GASF;
__device__ __forceinline__ int crow(int r, int hi) { return (r & 3) + 8 * (r >> 2) + 4 * hi; }
#define KSWZ64(row, cb) ((row) * 128 + ((cb) ^ ((((row) >> 1) & 7) << 4)))
__device__ __forceinline__ int v_st(int k, int c) { const int kk = (k & ~0xC) | ((k & 4) << 1) | ((k & 8) >> 1); return ((kk >> 3) * 4 + (c >> 5)) * 512 + ((kk & 7) * 32 + (c & 31)) * 2; }
__device__ __forceinline__ int v_rd_base(int lane) { return ((lane & 3) << 3) | (((lane >> 2) & 3) << 6) | (((lane >> 4) & 1) << 5) | (((lane >> 5) & 1) << 8); }
constexpr int v_rd_off(int d0, int ks, int half) { return d0 * 512 + ks * 4096 + half * 2048; }
template <int OFF> __device__ __forceinline__ s16x4 tr_read(int vb) {
    s16x4 r; asm volatile("ds_read_b64_tr_b16 %0, %1 offset:%2" : "=&v"(r) : "v"(vb), "i"(OFF) : "memory"); return r;
}
template <int D0> __device__ __forceinline__ void pv_one(f32x16& od, int vb, bf16x8 pa0, bf16x8 pa1, bf16x8 pa2, bf16x8 pa3) {
    const s16x4 l0 = tr_read<v_rd_off(D0, 0, 0)>(vb), h0 = tr_read<v_rd_off(D0, 0, 1)>(vb), l1 = tr_read<v_rd_off(D0, 1, 0)>(vb), h1 = tr_read<v_rd_off(D0, 1, 1)>(vb);
    const s16x4 l2 = tr_read<v_rd_off(D0, 2, 0)>(vb), h2 = tr_read<v_rd_off(D0, 2, 1)>(vb), l3 = tr_read<v_rd_off(D0, 3, 0)>(vb), h3 = tr_read<v_rd_off(D0, 3, 1)>(vb);
    asm volatile("s_waitcnt lgkmcnt(0)" ::: "memory"); __builtin_amdgcn_sched_barrier(0);
#define PK(L, H) (bf16x8){L[0], L[1], L[2], L[3], H[0], H[1], H[2], H[3]}
    od = __builtin_amdgcn_mfma_f32_32x32x16_bf16(pa0, PK(l0, h0), od, 0, 0, 0);
    od = __builtin_amdgcn_mfma_f32_32x32x16_bf16(pa1, PK(l1, h1), od, 0, 0, 0);
    od = __builtin_amdgcn_mfma_f32_32x32x16_bf16(pa2, PK(l2, h2), od, 0, 0, 0);
    od = __builtin_amdgcn_mfma_f32_32x32x16_bf16(pa3, PK(l3, h3), od, 0, 0, 0);
#undef PK
}
constexpr int ATT_LDS = 2 * 16384 + 2 * 8192 + 8 * 256;

__device__ __forceinline__ void ph_attnA(const Params& p, unsigned char* lds, int vb, int nvb) {
    const bf16* PROJ = (const bf16*)(p.ws + WS_PROJ); bf16* MIX = (bf16*)(p.ws + WS_MIX);
    const float* SC = (const float*)(p.ws + WS_SCAL);
    const float lam = SC[SC_LAM], refL2 = SC[SC_MA] * 1.4426950409f;
    constexpr float C = 0.125f * 1.4426950409f;
    int tid = threadIdx.x; asm volatile("" : "+v"(tid)); const int lane = tid & 63, wid = __builtin_amdgcn_readfirstlane(tid >> 6), r32 = lane & 31, hi = lane >> 5;
    unsigned char* V_lds = lds; unsigned char* K_lds = lds + 32768;
    float* wsf = (float*)(lds + 49152) + wid * 64;
    GASF* tmpw = (GASF*)(p.ws + WS_ATMP) + ((size_t)(vb * NWV + wid) * 64) * 64 + lane;
    const int vbase = (int)(uintptr_t)V_lds + v_rd_base(lane);
    const int krow = tid >> 3, kch = tid & 7, kdst = KSWZ64(krow, kch * 16);
    const int sr = tid >> 4, sc = (tid & 15) * 8, vst0 = v_st(sr, sc), vst1 = v_st(32 + sr, sc);
    for (int it = vb; it < 256; it += nvb) {
        const int b = it >> 4, h = (it >> 2) & 3, qbl = it & 3;
        const float slopeL2 = exp2f(-2.0f * (float)(h + 1)) * 1.4426950409f;
        const bf16* Pb = PROJ + (size_t)b * SEQ * NP;
#pragma unroll 1
        for (int half = 0; half < 2; ++half) {
            const int qb = half ? 7 - qbl : qbl, q0 = 256 * qb, NTu = 4 * (qb + 1), cw = 4 * qb + (wid >> 1);
            const int tq = q0 + 32 * wid + r32;
#pragma unroll 1
            for (int mi = 0; mi < 2; ++mi) {
                const int m = 1 - mi;
                const bf16* Kg = Pb + C_KA + h * 128 + m * 64 + (size_t)krow * NP + kch * 8;
                const bf16* Vg = Pb + C_VA + h * 128 + (size_t)sr * NP + sc;
                bf16x8 qr[4];
                { const bf16* qp = Pb + (size_t)tq * NP + C_QA + h * 128 + m * 64 + hi * 8;
#pragma unroll
                  for (int d0 = 0; d0 < 4; ++d0) qr[d0] = *(const bf16x8*)(qp + d0 * 16); }
                f32x16 o[4];
#pragma unroll
                for (int d = 0; d < 4; ++d) o[d] = f32x16{};
                float lsum = 0.f;
                bf16x8 sk, sv0, sv1;
                sk = *(const bf16x8*)Kg; sv0 = *(const bf16x8*)Vg; sv1 = *(const bf16x8*)(Vg + (size_t)32 * NP);
                *(bf16x8*)(K_lds + kdst) = sk; *(bf16x8*)(V_lds + vst0) = sv0; *(bf16x8*)(V_lds + vst1) = sv1;
                __syncthreads();
#pragma unroll 1
                for (int j = 0; j < NTu; ++j) {
                    const int buf = j & 1;
                    if (j + 1 < NTu) { const size_t go = (size_t)(j + 1) * 64 * NP; sk = *(const bf16x8*)(Kg + go); sv0 = *(const bf16x8*)(Vg + go); sv1 = *(const bf16x8*)(Vg + go + (size_t)32 * NP); }
                    if (j <= cw) {
                        const unsigned char* Kb = K_lds + buf * 8192;
                        const float dq = (float)(tq - 64 * j - 4 * hi);
                        const float B0 = -slopeL2 * dq - refL2;
                        const bool past = j < cw;
                        float ps = 0.f;
                        bf16x8 pa0, pa1, pa2, pa3;
#define PK4(P, BASE, OUT) do { unsigned a0 = cvtpk_bf16(P[BASE + 0], P[BASE + 1]), a1 = cvtpk_bf16(P[BASE + 2], P[BASE + 3]);   \
    unsigned b0_ = cvtpk_bf16(P[BASE + 4], P[BASE + 5]), b1_ = cvtpk_bf16(P[BASE + 6], P[BASE + 7]);                              \
    auto r0 = __builtin_amdgcn_permlane32_swap(a0, b0_, false, false); auto r1 = __builtin_amdgcn_permlane32_swap(a1, b1_, false, false); \
    u32x4 w = {r0[0], r1[0], r0[1], r1[1]}; OUT = __builtin_bit_cast(bf16x8, w); } while (0)
#define HALF_TILE(KOFF, FOFF, PA, PB) do { f32x16 pp = f32x16{};                                                                     \
    _Pragma("unroll") for (int d0 = 0; d0 < 4; ++d0) { const int cb = (d0 * 16 + hi * 8) * 2;                                        \
        const bf16x8 bk = *(const bf16x8*)(Kb + KSWZ64((KOFF) + r32, cb)); pp = __builtin_amdgcn_mfma_f32_32x32x16_bf16(bk, qr[d0], pp, 0, 0, 0); } \
    if (past) { _Pragma("unroll") for (int r = 0; r < 16; ++r) { const float off = (float)((r & 3) + 8 * (r >> 2)) + (FOFF);          \
            pp[r] = __builtin_amdgcn_exp2f(fmaf(pp[r], C, fmaf(slopeL2, off, B0))); } }                                               \
    else { _Pragma("unroll") for (int r = 0; r < 16; ++r) { const float off = (float)((r & 3) + 8 * (r >> 2)) + (FOFF);               \
            pp[r] = __builtin_amdgcn_exp2f(fmaf(pp[r], C, -slopeL2 * fabsf(dq - off) - refL2)); } }                                   \
    _Pragma("unroll") for (int r = 0; r < 16; ++r) ps += pp[r];                                                                       \
    PK4(pp, 0, PA); PK4(pp, 8, PB); __builtin_amdgcn_sched_barrier(0); } while (0)
                        HALF_TILE(0, 0.f, pa0, pa1);
                        HALF_TILE(32, 32.f, pa2, pa3);
#undef HALF_TILE
#undef PK4
                        { auto rr = __builtin_amdgcn_permlane32_swap(__float_as_uint(ps), __float_as_uint(ps), false, false);
                          ps = __uint_as_float(rr[0]) + __uint_as_float(rr[1]); }
                        lsum += ps;
                        const int vb0 = vbase + buf * 16384;
                        pv_one<0>(o[0], vb0, pa0, pa1, pa2, pa3); pv_one<1>(o[1], vb0, pa0, pa1, pa2, pa3); pv_one<2>(o[2], vb0, pa0, pa1, pa2, pa3); pv_one<3>(o[3], vb0, pa0, pa1, pa2, pa3);
                    }
                    if (j + 1 < NTu) { const int nb = buf ^ 1;
                        *(bf16x8*)(K_lds + nb * 8192 + kdst) = sk; *(bf16x8*)(V_lds + nb * 16384 + vst0) = sv0; *(bf16x8*)(V_lds + nb * 16384 + vst1) = sv1; }
                    __syncthreads();
                }
                if (hi == 0) wsf[r32] = lsum;
                LDS_WAIT(); asm volatile("" ::: "memory");
                float rli[16];
#pragma unroll
                for (int r = 0; r < 16; ++r) rli[r] = 1.f / wsf[crow(r, hi)];
                LDS_WAIT(); asm volatile("" ::: "memory");
                if (mi == 0) {
#pragma unroll
                    for (int d = 0; d < 4; ++d) { GASF* td = tmpw + d * 1024; asm volatile("" : "+v"(td));
#pragma unroll
                        for (int r = 0; r < 16; ++r) td[r * 64] = o[d][r] * rli[r]; }
                } else {
                    float gsub[4];
#pragma unroll
                    for (int d = 0; d < 4; ++d) gsub[d] = p.a_sub_gain[32 * d + r32];
                    GASF* tdp[4];
#pragma unroll
                    for (int d = 0; d < 4; ++d) { tdp[d] = tmpw + d * 1024; asm volatile("" : "+v"(tdp[d])); }
#pragma unroll
                    for (int r = 0; r < 16; ++r) {
                        float v[4]; float ss = 0.f;
#pragma unroll
                        for (int d = 0; d < 4; ++d) { v[d] = o[d][r] * rli[r] - lam * tdp[d][r * 64]; ss += v[d] * v[d]; }
                        ss += __shfl_xor(ss, 1); ss += __shfl_xor(ss, 2); ss += __shfl_xor(ss, 4); ss += __shfl_xor(ss, 8); ss += __shfl_xor(ss, 16);
                        const float rs = rsqrtf(ss * (1.f / 128.f) + EPS) * 0.8f;
                        bf16* orow = MIX + (size_t)(b * SEQ + q0 + 32 * wid + crow(r, hi)) * MIXW + h * 128 + r32;
#pragma unroll
                        for (int d = 0; d < 4; ++d) orow[32 * d] = (bf16)f2bf(v[d] * rs * gsub[d]);
                        asm volatile("" ::: "memory");
                    }
                }
            }
        }
    }
}
constexpr int RT_WAVE_BYTES = 12288;
constexpr int RT_LDS = 32768 + 8 * RT_WAVE_BYTES;

__device__ __forceinline__ int pl32_sum(int v) { auto rr = __builtin_amdgcn_permlane32_swap((unsigned)v, (unsigned)v, false, false); return (int)(rr[0] + rr[1]); }
__device__ __forceinline__ int pl32_other(int v) { auto rr = __builtin_amdgcn_permlane32_swap((unsigned)v, (unsigned)v, false, false); return (int)(rr[0] + rr[1]) - v; }
__device__ __forceinline__ float unsortkey(unsigned k) { return __uint_as_float((k & 0x80000000u) ? (k ^ 0x80000000u) : ~k); }

template <int N> __device__ __forceinline__ unsigned bisect16(const unsigned (&key)[N]) {
    unsigned prefix = 0u; bool done = false;
#pragma unroll 1
    for (int bit = 31; bit >= 0; --bit) {
        const unsigned cand = done ? prefix : (prefix | (1u << bit));
        int cnt = 0;
#pragma unroll
        for (int i = 0; i < N; ++i) cnt += (key[i] >= cand) ? 1 : 0;
        const int tot = pl32_sum(cnt);
        if (!done && tot >= 16) { prefix = cand; done = (tot == 16); }
        if (__all(done)) break;
    }
    return prefix;
}

__device__ __forceinline__ void ph_route(const Params& p, unsigned char* lds, int vb, int nvb) {
    const bf16* Q3 = (const bf16*)(p.ws + WS_Q3); const bf16* SUBK = (const bf16*)(p.ws + WS_SUBK);
    int* EXPI = (int*)(p.ws + WS_EXP); float* GATE = (float*)(p.ws + WS_GATE);
    int tid = threadIdx.x; asm volatile("" : "+v"(tid));
    const int lane = tid & 63, wv = __builtin_amdgcn_readfirstlane(tid >> 6), r32 = lane & 31, hi = lane >> 5;
    for (int i = tid; i < 2048; i += NT) ((u32x4*)lds)[i] = ((const u32x4*)SUBK)[i];
    __syncthreads();
    unsigned char* wl = lds + 32768 + wv * RT_WAVE_BYTES;
    float* sv = (float*)wl; int* si = (int*)(wl + 4096); float* fv = (float*)(wl + 8192); int* fe = (int*)(wl + 10240);
    const int gw = vb * NWV + wv, ngw = nvb * NWV;
    for (int item = gw; item < (T / 32) * 8; item += ngw) {
        const int h = item & 7, tok0 = (item >> 3) * 32;
        const bf16* qrow = Q3 + (size_t)(tok0 + r32) * 1024 + h * 128 + hi * 8;
#pragma unroll 1
        for (int c = 0; c < 2; ++c) {
            bf16x8 bq[4];
#pragma unroll
            for (int d0 = 0; d0 < 4; ++d0) bq[d0] = *(const bf16x8*)(qrow + c * 64 + d0 * 16);
            unsigned key[64];
#pragma unroll
            for (int nt = 0; nt < 4; ++nt) {
                f32x16 acc = f32x16{};
                const unsigned char* kp = lds + ((c * 128 + nt * 32 + r32) * 64 + hi * 8) * 2;
#pragma unroll
                for (int d0 = 0; d0 < 4; ++d0) { const bf16x8 ak = *(const bf16x8*)(kp + d0 * 32); acc = __builtin_amdgcn_mfma_f32_32x32x16_bf16(ak, bq[d0], acc, 0, 0, 0); }
#pragma unroll
                for (int r = 0; r < 16; ++r) key[nt * 16 + r] = sortkey(acc[r]);
            }
            const unsigned thr = bisect16<64>(key);
            int cnt = 0;
#pragma unroll
            for (int i = 0; i < 64; ++i) cnt += (key[i] >= thr) ? 1 : 0;
            const int other_ = pl32_other(cnt); int slot = hi ? other_ : 0;
            float* svp = sv + (r32 * 2 + c) * 16; int* sip = si + (r32 * 2 + c) * 16;
#pragma unroll
            for (int i = 0; i < 64; ++i) {
                if (key[i] >= thr && slot < 16) { svp[slot] = unsortkey(key[i]); sip[slot] = 32 * (i >> 4) + ((i & 3) + 8 * ((i & 15) >> 2)) + 4 * hi; ++slot; }
            }
        }
        LDS_WAIT(); asm volatile("" ::: "memory");
        {
            const float* s0 = sv + (r32 * 2) * 16 + 8 * hi; const float* s1 = sv + (r32 * 2 + 1) * 16;
            float a0[8], a1[16];
#pragma unroll
            for (int i = 0; i < 8; ++i) a0[i] = s0[i];
#pragma unroll
            for (int j = 0; j < 16; ++j) a1[j] = s1[j];
            unsigned key[128];
#pragma unroll
            for (int i = 0; i < 8; ++i)
#pragma unroll
                for (int j = 0; j < 16; ++j) key[i * 16 + j] = sortkey(a0[i] + a1[j]);
            const unsigned thr = bisect16<128>(key);
            int cnt = 0;
#pragma unroll
            for (int i = 0; i < 128; ++i) cnt += (key[i] >= thr) ? 1 : 0;
            const int other_ = pl32_other(cnt); int slot = hi ? other_ : 0;
            const int* i0 = si + (r32 * 2) * 16 + 8 * hi; const int* i1 = si + (r32 * 2 + 1) * 16;
            float* fvp = fv + r32 * 16; int* fep = fe + r32 * 16;
#pragma unroll
            for (int i = 0; i < 128; ++i) {
                if (key[i] >= thr && slot < 16) { fvp[slot] = unsortkey(key[i]); fep[slot] = i0[i >> 4] * 128 + i1[i & 15]; ++slot; }
            }
        }
        LDS_WAIT(); asm volatile("" ::: "memory");
        {
            const float* fvp = fv + r32 * 16;
            float v[16]; float mx = -3e38f;
#pragma unroll
            for (int k = 0; k < 16; ++k) { v[k] = fvp[k]; mx = fmaxf(mx, v[k]); }
            float l = 0.f;
#pragma unroll
            for (int k = 0; k < 16; ++k) { v[k] = __expf(v[k] - mx); l += v[k]; }
            const float il = 1.f / l;
            const size_t ob = (size_t)(tok0 + r32) * 128 + h * 16 + 8 * hi;
            const int* fep = fe + r32 * 16 + 8 * hi;
            f32x4 g0, g1; u32x4 e0, e1;
            if (hi == 0) { g0 = (f32x4){v[0] * il, v[1] * il, v[2] * il, v[3] * il}; g1 = (f32x4){v[4] * il, v[5] * il, v[6] * il, v[7] * il}; }
            else { g0 = (f32x4){v[8] * il, v[9] * il, v[10] * il, v[11] * il}; g1 = (f32x4){v[12] * il, v[13] * il, v[14] * il, v[15] * il}; }
            e0 = *(const u32x4*)fep; e1 = *(const u32x4*)(fep + 4);
            *(f32x4*)(GATE + ob) = g0; *(f32x4*)(GATE + ob + 4) = g1;
            *(u32x4*)(EXPI + ob) = e0; *(u32x4*)(EXPI + ob + 4) = e1;
        }
        LDS_WAIT(); asm volatile("" ::: "memory");
    }
    __syncthreads();
}
constexpr int LDS_BYTES = 147456;
extern __shared__ __attribute__((aligned(16))) unsigned char dyn_lds[];

__global__ void __launch_bounds__(NT, 2) mega_fwd(Params p) {
    cg::grid_group grid = cg::this_grid();
    const int vb = blockIdx.x, nvb = gridDim.x, ngw = nvb * NWV;
#define TID_LAUNDER int tid_ = threadIdx.x; asm volatile("" : "+v"(tid_)); const int lane = tid_ & 63, wv = tid_ >> 6, gw = vb * NWV + wv; (void)lane; (void)gw;
    ph_mod(p, (float*)dyn_lds, vb, nvb);
    { TID_LAUNDER ph_prep_weights(p, (LAS float*)dyn_lds + wv * (64 * 33), gw, ngw, lane); }
    grid.sync();
    { TID_LAUNDER ph_hrows(p, p.x, p.norm1_g, 0, 1024, gw, ngw, lane); }
    grid.sync();
    {   pg8::Gemm g{(const bf16*)(p.ws + WS_H), (const bf16*)(p.ws + WS_WIN), T, NP, 1024}; pg8::StaticOrder S; S.init(T, NP, nvb, vb);
        pg8::EpiBf16<0> E{(bf16*)(p.ws + WS_PROJ), NP, nullptr, 0, 0, 1.f};
        pg8::gemm_phase<pg8::EpiBf16<0>, pg8::StaticOrder, true, true>((LAS unsigned char*)dyn_lds, g, S, E); }
    grid.sync();
    { TID_LAUNDER ph_norm_proj(p, gw, ngw, lane); }
    grid.sync();
    ph_attnA(p, dyn_lds, vb, nvb);
    __syncthreads();
    ph_dsa(p, dyn_lds, vb, nvb);
    grid.sync();
    {   pg8::Gemm g{(const bf16*)(p.ws + WS_MIX), (const bf16*)(p.ws + WS_WO2), T, 1024, MIXW}; pg8::StaticOrder S; S.init(T, 1024, nvb, vb);
        EpiResGate E{p.x, p.out, (const float*)(p.ws + WS_MOD) + 2048};
        pg8::gemm_phase<EpiResGate, pg8::StaticOrder, true, true>((LAS unsigned char*)dyn_lds, g, S, E); }
    grid.sync();
    { TID_LAUNDER ph_hrows(p, p.out, p.norm2_g, 3072, 4096, gw, ngw, lane); }
    grid.sync();
    {   pg8::Gemm g{(const bf16*)(p.ws + WS_H), (const bf16*)(p.ws + WS_WQ), T, 1024, 1024}; pg8::StaticOrder S; S.init(T, 1024, nvb, vb);
        pg8::EpiBf16<0> E{(bf16*)(p.ws + WS_Q3), 1024, nullptr, 0, 0, 1.f};
        pg8::gemm_phase<pg8::EpiBf16<0>, pg8::StaticOrder, true, true>((LAS unsigned char*)dyn_lds, g, S, E); }
    grid.sync();
    ph_route(p, dyn_lds, vb, nvb);
    grid.sync();
    { TID_LAUNDER ph_peer(p, dyn_lds + wv * 1024, gw, ngw, lane); }
}

extern "C" void kernel_launch(void* const* d_in, const int* in_sizes, int n_in, void* d_out, int out_size, void* d_ws, size_t ws_size, hipStream_t stream) {
    static int grid_blocks = 0;
    if (grid_blocks == 0) {
        if (n_in != 18 || in_sizes[0] != T * DM || out_size != T * DM || ws_size < WS_END) { fprintf(stderr, "kernel_launch: unexpected shapes n_in %d in0 %d out %d ws %zu\n", n_in, n_in > 0 ? in_sizes[0] : -1, out_size, ws_size); grid_blocks = -1; return; }
        int dev = 0, cus = 0, per_cu = 0;
        (void)hipGetDevice(&dev);
        (void)hipDeviceGetAttribute(&cus, hipDeviceAttributeMultiprocessorCount, dev);
        (void)hipFuncSetAttribute((const void*)mega_fwd, hipFuncAttributeMaxDynamicSharedMemorySize, LDS_BYTES);
        (void)hipOccupancyMaxActiveBlocksPerMultiprocessor(&per_cu, (const void*)mega_fwd, NT, LDS_BYTES);
        if (per_cu < 1 || cus < 1) { fprintf(stderr, "kernel_launch: occupancy query gave %d blocks/CU on %d CUs\n", per_cu, cus); grid_blocks = -1; return; }
        grid_blocks = cus;
    }
    if (grid_blocks < 0) return;
    Params p{};
    const float** pp = (const float**)&p;
    for (int i = 0; i < 18; ++i) pp[i] = (const float*)d_in[i];
    p.out = (float*)d_out; p.ws = (unsigned char*)d_ws;
    void* args[] = {&p};
    const hipError_t e = hipLaunchCooperativeKernel((const void*)mega_fwd, dim3(grid_blocks), dim3(NT), args, LDS_BYTES, stream);
    if (e != hipSuccess) fprintf(stderr, "kernel_launch: cooperative launch failed: %s (grid %d)\n", hipGetErrorString(e), grid_blocks);
}
```

```cpp
#include <hip/hip_runtime.h>
#include <hip/hip_cooperative_groups.h>
#include <cstdio>
#include <cstdint>
#include <cmath>
namespace pg8 {
#define PG8_LAS __attribute__((address_space(3)))
typedef unsigned short bf16_t;
typedef short bf16x8 __attribute__((ext_vector_type(8)));
typedef float f32x4 __attribute__((ext_vector_type(4)));
typedef unsigned u32x4 __attribute__((ext_vector_type(4)));
constexpr int BM = 256, BK = 64, HALF = 128, HTB = HALF * BK * 2  , STAGE_BYTES = 8 * HTB, NXCD = 8, WGM = 8;

__host__ __device__ __forceinline__ int lds_byte(int r, int c) { const int st = (r >> 4) * 2 + (c >> 5), rr = r & 15, cc = c & 31, ob = rr * 64 + cc * 2; return st * 1024 + (ob ^ (((ob >> 9) & 1) << 5)); }
__host__ __device__ __forceinline__ void stage_rc(int b, int& R, int& C) { const int st = b / 1024, sb = b % 1024, swz = sb ^ (((sb >> 9) & 1) << 5); R = (st >> 1) * 16 + swz / 64; C = (st & 1) * 32 + (swz % 64) / 2; }
__host__ __device__ __forceinline__ int perm32(int rho) { const int n = rho >> 4, i = rho & 15; return 8 * (i >> 2) + 4 * n + (i & 3); }

struct Unit { int pm, pn; };
struct Gemm { const bf16_t* A; const bf16_t* Bt; int M, N, K; };

struct StaticOrder {
    int nM, nN, nwg, G, c;
    __host__ __device__ void init(int M, int N, int G_, int c_) { nM = M / BM; nN = N / BM; nwg = nM * nN; G = G_; c = c_; }
    __host__ __device__ bool next(int i, Unit& u) const {
        const long L = (long)i * G + c; if (L >= nwg) return false;
        int wgid = (int)L; { const int q = nwg / NXCD, r = nwg % NXCD, xcd = wgid % NXCD, off = wgid / NXCD; wgid = (xcd < r ? xcd * (q + 1) : r * (q + 1) + (xcd - r) * q) + off; }
        const int nig = WGM * nN, gid = wgid / nig, fm = gid * WGM, gsz = (nM - fm) < WGM ? (nM - fm) : WGM;
        u.pm = fm + ((wgid % nig) % gsz); u.pn = (wgid % nig) / gsz; return true;
    }
    __device__ __forceinline__ void a_ready(const Unit&) const {}
    __device__ __forceinline__ void done(const Unit&) const {}
};

__device__ __forceinline__ unsigned cvt_pk_bf16(float lo, float hi) { unsigned r; asm volatile("v_cvt_pk_bf16_f32 %0, %1, %2" : "=v"(r) : "v"(lo), "v"(hi)); return r; }
typedef float f32x2 __attribute__((ext_vector_type(2)));
__device__ __forceinline__ f32x2 gelu_pk(f32x2 v) {
    const f32x2 av = __builtin_elementwise_abs(v), d = av * 0.2316418882f + 1.0f;
    f32x2 t; t.x = __builtin_amdgcn_rcpf(d.x); t.y = __builtin_amdgcn_rcpf(d.y);
    f32x2 q = t * 0.5307027145f + (-0.7265760135f); q = q * t + 0.7107068705f; q = q * t + (-0.142248368f); q = q * t + 0.127414796f; q = q * t;
    const f32x2 s = (v * v) * (-0.72134752044f);
    f32x2 e; e.x = __builtin_amdgcn_exp2f(s.x); e.y = __builtin_amdgcn_exp2f(s.y);
    const f32x2 m = v * (q * e), r = v - m;
    f32x2 o; o.x = v.x < 0.f ? m.x : r.x; o.y = v.y < 0.f ? m.y : r.y; return o;
}

template <int ACT  > struct EpiBf16 {
    static constexpr bool PERM = true, AFTER_DRAIN = false; static_assert(ACT == 0 || ACT == 1, "EpiBf16: ACT is 0 (none) or 1 (gelu_pk)");
    bf16_t* O; int ldc; const float* bias; int split_cols; size_t split_stride; float scale0;
    __device__ __forceinline__ void operator()(const f32x4 (&acc)[2][2][4][2], const Unit& u, int wr, int wc, int fr, int fq) const {
        const int row0 = u.pm * BM + wr * 64 + fr; int colt = u.pn * BM; bf16_t* base = O;
        float sc = 1.f; if (split_cols) { const int t = colt / split_cols; base += (size_t)t * split_stride; colt -= t * split_cols; if (t == 0) sc = scale0; }
        const int col0 = colt + wc * 32 + 8 * fq, bcol0 = u.pn * BM + wc * 32 + 8 * fq;
        f32x4 bv[2][2];
#pragma unroll
        for (int bj = 0; bj < 2; ++bj)
#pragma unroll
            for (int n = 0; n < 2; ++n) bv[bj][n] = bias ? *(const f32x4*)(bias + bcol0 + bj * HALF + 4 * n) : (f32x4){0.f, 0.f, 0.f, 0.f};
#pragma unroll
        for (int ai = 0; ai < 2; ++ai)
#pragma unroll
            for (int m = 0; m < 4; ++m) { bf16_t* rowp = base + (size_t)(row0 + ai * HALF + m * 16) * ldc + col0;
#pragma unroll
                for (int bj = 0; bj < 2; ++bj) { f32x4 v0 = acc[ai][bj][m][0] + bv[bj][0], v1 = acc[ai][bj][m][1] + bv[bj][1];
                    if (ACT == 1) { f32x2 a = gelu_pk((f32x2){v0[0], v0[1]}), b = gelu_pk((f32x2){v0[2], v0[3]}), c = gelu_pk((f32x2){v1[0], v1[1]}), d = gelu_pk((f32x2){v1[2], v1[3]});
                        v0 = (f32x4){a.x, a.y, b.x, b.y}; v1 = (f32x4){c.x, c.y, d.x, d.y}; }
                    v0 = v0 * sc; v1 = v1 * sc; u32x4 w; w.x = cvt_pk_bf16(v0[0], v0[1]); w.y = cvt_pk_bf16(v0[2], v0[3]); w.z = cvt_pk_bf16(v1[0], v1[1]); w.w = cvt_pk_bf16(v1[2], v1[3]);
                    *(u32x4*)(rowp + bj * HALF) = w; } }
    }
};

template <class Epi, class Sched, bool ALIGN_EPI = false, bool SP2 = false>
__device__ __forceinline__ void gemm_phase(PG8_LAS unsigned char* lds, const Gemm g, const Sched& S, const Epi& E) {
    int tid = threadIdx.x; asm volatile("" : "+v"(tid)); const int wid = __builtin_amdgcn_readfirstlane(tid >> 6), lane = tid & 63, wr = wid >> 2, wc = wid & 3, fr = lane & 15, fq = lane >> 4;
    const int K = g.K, nt = K / BK;
    unsigned voffA[2], voffB[2];
#pragma unroll
    for (int i = 0; i < 2; ++i) { int R, C; stage_rc(tid * 16 + i * 8192, R, C); const int Rb = Epi::PERM ? ((R & ~31) + perm32(R & 31)) : R;
        voffA[i] = (unsigned)(R * K + C) * 2u; voffB[i] = (unsigned)(Rb * K + C) * 2u; }
    const size_t kstep = (size_t)(BK * 2);
    const size_t hstep = (size_t)HALF * K * 2;
    const size_t tstep = 2 * hstep;
    const unsigned ldsw = (unsigned)wid * 1024u;
    const int aoff = lds_byte(wr * 64 + fr, fq * 8), boff = lds_byte(wc * 32 + fr, fq * 8);
#define PG8_SA(b, h) (((b) * 2 + (h)) * HTB)
#define PG8_SB(b, h) ((4 + (b) * 2 + (h)) * HTB)
#define PG8_STAGE(bufoff, gbase, voff) do { _Pragma("unroll") for (int _i = 0; _i < 2; ++_i) \
        __builtin_amdgcn_global_load_lds((const unsigned*)((const char*)(gbase) + (voff)[_i]), (PG8_LAS unsigned*)(lds + (bufoff) + ldsw + _i * 8192), 16, 0, 0); } while (0)
#define PG8_LDA(dst, b, h) do { _Pragma("unroll") for (int m = 0; m < 4; ++m) _Pragma("unroll") for (int k = 0; k < 2; ++k) dst[m][k] = *(const PG8_LAS bf16x8*)(lds + PG8_SA(b, h) + aoff + m * 2048 + k * 1024); } while (0)
#define PG8_LDB(dst, b, h) do { _Pragma("unroll") for (int n = 0; n < 2; ++n) _Pragma("unroll") for (int k = 0; k < 2; ++k) dst[n][k] = *(const PG8_LAS bf16x8*)(lds + PG8_SB(b, h) + boff + n * 2048 + k * 1024); } while (0)
#define PG8_MMA(ai, bj, At, Bt) do { __builtin_amdgcn_s_setprio(1); _Pragma("unroll") for (int m = 0; m < 4; ++m) _Pragma("unroll") for (int n = 0; n < 2; ++n) _Pragma("unroll") for (int k = 0; k < 2; ++k) \
        acc[ai][bj][m][n] = __builtin_amdgcn_mfma_f32_16x16x32_bf16(Bt[n][k], At[m][k], acc[ai][bj][m][n], 0, 0, 0); __builtin_amdgcn_s_setprio(0); } while (0)
#define PG8_WAIT_V(n) asm volatile("s_waitcnt vmcnt(" #n ")" ::: "memory")
#define PG8_WAIT_L(n) asm volatile("s_waitcnt lgkmcnt(" #n ")" ::: "memory")
#define PG8_BAR __builtin_amdgcn_s_barrier()
#define PG8_SCHED __builtin_amdgcn_sched_barrier(0)
    Unit cur, nxt; int ui = 0;
    if (!S.next(0, cur)) return;
    f32x4 acc[2][2][4][2];
#pragma unroll
    for (int a = 0; a < 2; ++a)
#pragma unroll
        for (int b = 0; b < 2; ++b)
#pragma unroll
            for (int m = 0; m < 4; ++m)
#pragma unroll
                for (int n = 0; n < 2; ++n) acc[a][b][m][n] = (f32x4){0.f, 0.f, 0.f, 0.f};
    bf16x8 At[4][2], B0[2][2], B1[2][2];
    const char* cA = (const char*)g.A + (size_t)cur.pm * tstep; const char* cB = (const char*)g.Bt + (size_t)cur.pn * tstep;
    S.a_ready(cur);
    if constexpr (SP2) {
        PG8_STAGE(PG8_SB(0, 0), cB, voffB); PG8_STAGE(PG8_SB(0, 1), cB + hstep, voffB); PG8_STAGE(PG8_SA(0, 0), cA, voffA); PG8_STAGE(PG8_SA(0, 1), cA + hstep, voffA);
        if (wr == 1) PG8_BAR;
        PG8_WAIT_V(2); PG8_BAR;
        PG8_STAGE(PG8_SB(1, 0), cB + kstep, voffB); PG8_STAGE(PG8_SA(1, 0), cA + kstep, voffA); PG8_STAGE(PG8_SB(1, 1), cB + hstep + kstep, voffB);
        PG8_WAIT_V(6); PG8_BAR;
    } else {
        PG8_STAGE(PG8_SB(0, 0), cB, voffB); PG8_STAGE(PG8_SA(0, 0), cA, voffA); PG8_STAGE(PG8_SB(0, 1), cB + hstep, voffB); PG8_STAGE(PG8_SA(0, 1), cA + hstep, voffA);
        if (wr == 1) PG8_BAR;
        PG8_WAIT_V(4); PG8_BAR;
        PG8_STAGE(PG8_SB(1, 0), cB + kstep, voffB); PG8_STAGE(PG8_SA(1, 0), cA + kstep, voffA); PG8_STAGE(PG8_SB(1, 1), cB + hstep + kstep, voffB);
        PG8_WAIT_V(6); PG8_BAR;
    }
    for (;;) {
        const bool has_next = S.next(ui + 1, nxt);
        const char* nA = has_next ? (const char*)g.A + (size_t)nxt.pm * tstep : cA; const char* nB = has_next ? (const char*)g.Bt + (size_t)nxt.pn * tstep : cB;
        for (int t = 0; t < nt; t += 2) {
            const bool last = (t == nt - 2);
            const char* a1 = cA + (size_t)(t + 1) * kstep;
            const char* a2 = last ? nA : cA + (size_t)(t + 2) * kstep; const char* b2 = last ? nB : cB + (size_t)(t + 2) * kstep;
            const char* a3 = a2 + kstep; const char* b3 = b2 + kstep;
            if (last && has_next) S.a_ready(nxt);
            if constexpr (SP2) {
            PG8_LDB(B0, 0, 0); PG8_LDB(B1, 0, 1); PG8_SCHED; PG8_LDA(At, 0, 0); PG8_STAGE(PG8_SA(1, 1), a1 + hstep, voffA);
            PG8_WAIT_V(8); PG8_WAIT_L(0); PG8_BAR; PG8_MMA(0, 0, At, B0); PG8_MMA(0, 1, At, B1); PG8_BAR; PG8_SCHED;
            PG8_LDA(At, 0, 1); PG8_STAGE(PG8_SB(0, 0), b2, voffB); PG8_STAGE(PG8_SB(0, 1), b2 + hstep, voffB); PG8_STAGE(PG8_SA(0, 0), a2, voffA);
            PG8_WAIT_V(8); PG8_WAIT_L(0); PG8_BAR; PG8_MMA(1, 0, At, B0); PG8_MMA(1, 1, At, B1); PG8_BAR; PG8_SCHED;
            PG8_LDB(B0, 1, 0); PG8_LDB(B1, 1, 1); PG8_SCHED; PG8_LDA(At, 1, 0); PG8_STAGE(PG8_SA(0, 1), a2 + hstep, voffA);
            PG8_WAIT_V(8); PG8_WAIT_L(0); PG8_BAR; PG8_MMA(0, 0, At, B0); PG8_MMA(0, 1, At, B1); PG8_BAR; PG8_SCHED;
            PG8_LDA(At, 1, 1); PG8_STAGE(PG8_SB(1, 0), b3, voffB); PG8_STAGE(PG8_SB(1, 1), b3 + hstep, voffB); PG8_STAGE(PG8_SA(1, 0), a3, voffA);
            PG8_WAIT_V(8); PG8_WAIT_L(0); PG8_BAR; PG8_MMA(1, 0, At, B0); PG8_MMA(1, 1, At, B1); PG8_BAR; PG8_SCHED;
            } else {
            PG8_LDB(B0, 0, 0); PG8_SCHED; PG8_LDA(At, 0, 0); PG8_STAGE(PG8_SA(1, 1), a1 + hstep, voffA);
            PG8_WAIT_L(8); PG8_BAR; PG8_WAIT_L(0); PG8_MMA(0, 0, At, B0); PG8_BAR; PG8_SCHED;
            PG8_LDB(B1, 0, 1); PG8_STAGE(PG8_SB(0, 0), b2, voffB);
            PG8_BAR; PG8_WAIT_L(0); PG8_MMA(0, 1, At, B1); PG8_BAR;
            PG8_LDA(At, 0, 1); PG8_STAGE(PG8_SA(0, 0), a2, voffA);
            PG8_BAR; PG8_WAIT_L(0); PG8_MMA(1, 0, At, B0); PG8_BAR; PG8_SCHED;
            PG8_STAGE(PG8_SB(0, 1), b2 + hstep, voffB);
            PG8_WAIT_V(6); PG8_BAR; PG8_MMA(1, 1, At, B1); PG8_BAR;
            PG8_LDB(B0, 1, 0); PG8_SCHED; PG8_LDA(At, 1, 0); PG8_STAGE(PG8_SA(0, 1), a2 + hstep, voffA);
            PG8_WAIT_L(8); PG8_BAR; PG8_WAIT_L(0); PG8_MMA(0, 0, At, B0); PG8_BAR; PG8_SCHED;
            PG8_LDB(B1, 1, 1); PG8_STAGE(PG8_SB(1, 0), b3, voffB);
            PG8_BAR; PG8_WAIT_L(0); PG8_MMA(0, 1, At, B1); PG8_BAR;
            PG8_LDA(At, 1, 1); PG8_STAGE(PG8_SA(1, 0), a3, voffA);
            PG8_BAR; PG8_WAIT_L(0); PG8_MMA(1, 0, At, B0); PG8_BAR; PG8_SCHED;
            PG8_STAGE(PG8_SB(1, 1), b3 + hstep, voffB);
            PG8_WAIT_V(6); PG8_BAR; PG8_MMA(1, 1, At, B1); PG8_BAR;
            }
        }
        if constexpr (ALIGN_EPI) { if (wr == 0) PG8_BAR; }
        if constexpr (!Epi::AFTER_DRAIN) { E(acc, cur, wr, wc, fr, fq); S.done(cur); }
        if (!has_next) break;
#pragma unroll
        for (int a = 0; a < 2; ++a)
#pragma unroll
            for (int b = 0; b < 2; ++b)
#pragma unroll
                for (int m = 0; m < 4; ++m)
#pragma unroll
                    for (int n = 0; n < 2; ++n) acc[a][b][m][n] = (f32x4){0.f, 0.f, 0.f, 0.f};
        cur = nxt; cA = nA; cB = nB; ++ui;
        if constexpr (ALIGN_EPI) { if (wr == 1) PG8_BAR; }
    }
    PG8_WAIT_V(0);
    if constexpr (!ALIGN_EPI) { if (wr == 0) PG8_BAR; }
    PG8_BAR;
    if constexpr (Epi::AFTER_DRAIN) { E.fused(acc, cur, wr, wc, fr, fq, lds, wid, lane); S.done(cur); }
#undef PG8_SA
#undef PG8_SB
#undef PG8_STAGE
#undef PG8_LDA
#undef PG8_LDB
#undef PG8_MMA
#undef PG8_WAIT_V
#undef PG8_WAIT_L
#undef PG8_BAR
#undef PG8_SCHED
}
}
namespace cg = cooperative_groups;
#define LAS __attribute__((address_space(3)))
typedef unsigned short bf16;
typedef float f32x4 __attribute__((ext_vector_type(4)));
typedef float f32x8 __attribute__((ext_vector_type(8)));
typedef float f32x16 __attribute__((ext_vector_type(16)));
typedef unsigned u32x4 __attribute__((ext_vector_type(4)));
typedef unsigned u32x2 __attribute__((ext_vector_type(2)));
typedef short bf16x8 __attribute__((ext_vector_type(8)));
typedef short s16x4 __attribute__((ext_vector_type(4)));

constexpr int BATCH = 16, SEQ = 2048, DM = 1024, T = BATCH * SEQ;
constexpr int NP = 3072;
constexpr int IN_COLS = 3012;
constexpr int C_QA = 0, C_KA = 512, C_VA = 1024, C_QB = 1536, C_KV = 2560, C_QI = 2688, C_KI = 2944, C_WI = 3008;
constexpr int MIXW = 1536;
constexpr int NEXP = 16384;
constexpr float EPS = 1e-6f;
constexpr int NT = 512;
constexpr int NWV = 8;

constexpr size_t MiB = 1u << 20;
constexpr size_t WS_CTL = 0;
constexpr size_t CTL_BYTES = 64 * 1024;
constexpr size_t WS_MOD = 1 * MiB;
constexpr size_t WS_SCAL = WS_MOD + 512 * 1024;
constexpr size_t WS_WIN = 2 * MiB;
constexpr size_t WS_WO2 = 8 * MiB;
constexpr size_t WS_WQ = 11 * MiB;
constexpr size_t WS_SUBK = 13 * MiB;
constexpr size_t WS_U16 = 14 * MiB;
constexpr size_t WS_V16 = 46 * MiB;
constexpr size_t WS_H = 78 * MiB;
constexpr size_t WS_PROJ = 142 * MiB;
constexpr size_t WS_Q3 = WS_PROJ;
constexpr size_t WS_MIX = 334 * MiB;
constexpr size_t WS_EXP = 430 * MiB;
constexpr size_t WS_GATE = 446 * MiB;
constexpr size_t WS_ATMP = 462 * MiB;
constexpr size_t WS_END = 494 * MiB;

struct Params {
    const float *x, *c, *ada_w, *ada_b, *norm1_g, *norm2_g, *w_in, *a_qk_gain, *a_lambda, *a_sub_gain, *b_q_gain, *b_kv_gain, *b_w_uv, *w_out, *peer_wq, *peer_subkeys, *peer_u, *peer_v;
    float* out; unsigned char* ws;
};

enum { SC_LAM = 0, SC_MA = 1, SC_MB = 2 };

__device__ __forceinline__ unsigned f2bf(float f) { unsigned u = __float_as_uint(f); return (u + 0x7fffu + ((u >> 16) & 1u)) >> 16; }
__device__ __forceinline__ float bf2f(unsigned h) { return __uint_as_float(h << 16); }
__device__ __forceinline__ unsigned pk2(float lo, float hi) { return f2bf(lo) | (f2bf(hi) << 16); }
__device__ __forceinline__ float bflo(unsigned w) { return __uint_as_float(w << 16); }
__device__ __forceinline__ float bfhi(unsigned w) { return __uint_as_float(w & 0xffff0000u); }
__device__ __forceinline__ float wave_sum(float v) {
#pragma unroll
    for (int o = 1; o < 64; o <<= 1) v += __shfl_xor(v, o);
    return v;
}
__device__ __forceinline__ float wave_max(float v) {
#pragma unroll
    for (int o = 1; o < 64; o <<= 1) v = fmaxf(v, __shfl_xor(v, o));
    return v;
}
#define LDS_WAIT() asm volatile("s_waitcnt lgkmcnt(0)" ::: "memory")
__device__ __forceinline__ void ph_mod(const Params& p, float* ldsf, int vb, int nvb) {
    if (vb >= 12) return;
    const int tid = threadIdx.x;
    for (int i = tid; i < 16 * 1024; i += NT) { const float v = p.c[i]; ldsf[i] = v / (1.f + __expf(-v)); }
    __syncthreads();
    float* MOD = (float*)(p.ws + WS_MOD);
    for (int it = vb; it < 12; it += nvb) {
        const int j = it * 512 + tid;
        float acc[16];
#pragma unroll
        for (int b = 0; b < 16; ++b) acc[b] = 0.f;
        for (int k = 0; k < 1024; ++k) {
            const float w = p.ada_w[(size_t)k * 6144 + j];
#pragma unroll
            for (int b = 0; b < 16; ++b) acc[b] = fmaf(ldsf[b * 1024 + k], w, acc[b]);
        }
        const float bb = p.ada_b[j];
#pragma unroll
        for (int b = 0; b < 16; ++b) MOD[b * 6144 + j] = acc[b] + bb;
    }
    __syncthreads();
}

__device__ __forceinline__ void transpose_item(const float* W, int N, bf16* WT, int ldt, LAS float* scr, int kb, int nb, int lane) {
    const int k0 = 64 * kb, n0 = 32 * nb;
#pragma unroll 8
    for (int i = 0; i < 32; ++i) { const int kk = 2 * i + (lane >> 5); const int n = n0 + (lane & 31); scr[kk * 33 + (lane & 31)] = (n < N) ? W[(size_t)(k0 + kk) * N + n] : 0.f; }
    LDS_WAIT(); asm volatile("" ::: "memory");
    const int c = lane & 7;
#pragma unroll
    for (int j = 0; j < 4; ++j) { const int n = (lane >> 3) + 8 * j; const LAS float* s = scr + (8 * c) * 33 + n;
        u32x4 o; o.x = pk2(s[0 * 33], s[1 * 33]); o.y = pk2(s[2 * 33], s[3 * 33]); o.z = pk2(s[4 * 33], s[5 * 33]); o.w = pk2(s[6 * 33], s[7 * 33]);
        *(u32x4*)(WT + (size_t)(n0 + n) * ldt + k0 + 8 * c) = o; }
    LDS_WAIT(); asm volatile("" ::: "memory");
}

__device__ __forceinline__ void ph_prep_weights(const Params& p, LAS float* scr, int gw, int ngw, int lane) {
    bf16* WIN = (bf16*)(p.ws + WS_WIN); bf16* WO2 = (bf16*)(p.ws + WS_WO2); bf16* WQ = (bf16*)(p.ws + WS_WQ);
    constexpr int I_IN = 16 * 96, I_O = 8 * 32, I_Q = 16 * 32;
    for (int it = gw; it < I_IN + I_O + I_Q; it += ngw) {
        int r = it;
        if (r < I_IN) { transpose_item(p.w_in, IN_COLS, WIN, 1024, scr, r / 96, r % 96, lane); continue; } r -= I_IN;
        if (r < I_O) { transpose_item(p.w_out, 1024, WO2, MIXW, scr, r / 32, r % 32, lane); continue; } r -= I_O;
        transpose_item(p.peer_wq, 1024, WQ, 1024, scr, r / 32, r % 32, lane);
    }
    const size_t gt = (size_t)gw * 64 + lane, ngt = (size_t)ngw * 64;
    for (size_t i = gt; i < (size_t)1024 * 1024; i += ngt) {
        const int n = (int)(i & 1023), kk = (int)(i >> 10), h = kk >> 7;
        const float* wu = p.b_w_uv + (size_t)kk * 64; const float* wo = p.w_out + (size_t)(512 + 64 * h) * 1024 + n;
        float a = 0.f;
#pragma unroll 8
        for (int e = 0; e < 64; ++e) a = fmaf(wu[e], wo[(size_t)e * 1024], a);
        WO2[(size_t)n * MIXW + 512 + kk] = (bf16)f2bf(a);
    }
    bf16* U16 = (bf16*)(p.ws + WS_U16); bf16* V16 = (bf16*)(p.ws + WS_V16); bf16* SUBK = (bf16*)(p.ws + WS_SUBK);
    constexpr size_t NTAB8 = (size_t)NEXP * 1024 / 8, NSUB8 = 2 * 128 * 64 / 8;
    for (size_t i = gt; i < 2 * NTAB8 + NSUB8; i += ngt) {
        const float* src; bf16* dst; size_t j = i;
        if (j < NTAB8) { src = p.peer_u; dst = U16; } else if (j < 2 * NTAB8) { j -= NTAB8; src = p.peer_v; dst = V16; } else { j -= 2 * NTAB8; src = p.peer_subkeys; dst = SUBK; }
        const f32x8 v = *(const f32x8*)(src + j * 8);
        u32x4 o; o.x = pk2(v[0], v[1]); o.y = pk2(v[2], v[3]); o.z = pk2(v[4], v[5]); o.w = pk2(v[6], v[7]);
        *(u32x4*)(dst + j * 8) = o;
    }
    if (gt == 0) {
        float* SC = (float*)(p.ws + WS_SCAL);
        float s01 = 0.f, s23 = 0.f;
        for (int i = 0; i < 64; ++i) { s01 += p.a_lambda[i] * p.a_lambda[64 + i]; s23 += p.a_lambda[128 + i] * p.a_lambda[192 + i]; }
        SC[SC_LAM] = __expf(s01) - __expf(s23) + 0.2f;
        float g0 = 0.f, g1 = 0.f, gq = 0.f, gk = 0.f;
        for (int i = 0; i < 64; ++i) { g0 = fmaxf(g0, fabsf(p.a_qk_gain[i])); g1 = fmaxf(g1, fabsf(p.a_qk_gain[64 + i])); }
        for (int i = 0; i < 128; ++i) { gq = fmaxf(gq, fabsf(p.b_q_gain[i])); gk = fmaxf(gk, fabsf(p.b_kv_gain[i])); }
        SC[SC_MA] = 8.0f * g0 * g1 * 1.02f;
        SC[SC_MB] = 11.3137085f * gq * gk * 1.02f;
    }
}

__device__ __forceinline__ void ph_hrows(const Params& p, const float* X, const float* g, int shOff, int scOff, int gw, int ngw, int lane) {
    const float* MOD = (const float*)(p.ws + WS_MOD); bf16* H = (bf16*)(p.ws + WS_H);
    for (int m = gw; m < T; m += ngw) {
        const f32x4* xr = (const f32x4*)(X + (size_t)m * 1024) + lane;
        f32x4 v[4]; float s = 0.f;
#pragma unroll
        for (int j = 0; j < 4; ++j) { v[j] = xr[64 * j]; s += (v[j].x * v[j].x + v[j].y * v[j].y) + (v[j].z * v[j].z + v[j].w * v[j].w); }
        const float rstd = rsqrtf(wave_sum(s) * (1.f / 1024.f) + EPS);
        const float* mb = MOD + (size_t)(m >> 11) * 6144;
#pragma unroll
        for (int j = 0; j < 4; ++j) {
            const int col = 4 * (lane + 64 * j);
            const f32x4 gg = *(const f32x4*)(g + col), sc = *(const f32x4*)(mb + scOff + col), sh = *(const f32x4*)(mb + shOff + col);
            const f32x4 y = v[j] * rstd * gg * (sc + 1.0f) + sh;
            u32x2 o; o.x = pk2(y.x, y.y); o.y = pk2(y.z, y.w);
            *(u32x2*)(H + (size_t)m * 1024 + col) = o;
        }
    }
}

__device__ __forceinline__ void ph_norm_proj(const Params& p, int gw, int ngw, int lane) {
    bf16* PROJ = (bf16*)(p.ws + WS_PROJ);
    for (int m = gw; m < T; m += ngw) {
        bf16* row = PROJ + (size_t)m * NP;
#pragma unroll
        for (int j = 0; j < 6; ++j) {
            if (j == 2) continue;
            const int col = 8 * lane + 512 * j;
            const u32x4 raw = *(const u32x4*)(row + col);
            float v[8] = {bflo(raw.x), bfhi(raw.x), bflo(raw.y), bfhi(raw.y), bflo(raw.z), bfhi(raw.z), bflo(raw.w), bfhi(raw.w)};
            float ss = 0.f;
#pragma unroll
            for (int i = 0; i < 8; ++i) ss += v[i] * v[i];
            ss += __shfl_xor(ss, 1); ss += __shfl_xor(ss, 2); ss += __shfl_xor(ss, 4);
            float rstd; const float* gp;
            if (j < 2) { rstd = rsqrtf(ss * (1.f / 64.f) + EPS); gp = p.a_qk_gain + 64 * j + (col & 63); }
            else { ss += __shfl_xor(ss, 8); rstd = rsqrtf(ss * (1.f / 128.f) + EPS); gp = (j == 5 ? p.b_kv_gain : p.b_q_gain) + (col & 127); }
            if (j == 5 && lane >= 16) continue;
            const f32x4 g0 = *(const f32x4*)gp, g1 = *(const f32x4*)(gp + 4);
            u32x4 o; o.x = pk2(v[0] * rstd * g0.x, v[1] * rstd * g0.y); o.y = pk2(v[2] * rstd * g0.z, v[3] * rstd * g0.w);
            o.z = pk2(v[4] * rstd * g1.x, v[5] * rstd * g1.y); o.w = pk2(v[6] * rstd * g1.z, v[7] * rstd * g1.w);
            *(u32x4*)(row + col) = o;
        }
    }
}
__device__ void ph_attnA_naive(const Params& p, float* lds_w, int gw, int ngw, int lane) {
    const bf16* PROJ = (const bf16*)(p.ws + WS_PROJ); bf16* MIX = (bf16*)(p.ws + WS_MIX);
    const float lam = ((const float*)(p.ws + WS_SCAL))[SC_LAM];
    float* qs = lds_w; float* sc0 = lds_w + 128; float* sc1 = sc0 + 2048;
    for (int it = gw; it < BATCH * 4 * SEQ; it += ngw) {
        const int t = it & 2047, h = (it >> 11) & 3, b = it >> 13;
        const int cend = ((t >> 6) + 1) << 6;
        const float slope = exp2f(-2.0f * (h + 1));
        const bf16* qrow = PROJ + (size_t)(b * SEQ + t) * NP + C_QA + h * 128;
        qs[lane] = bf2f(qrow[lane]); qs[64 + lane] = bf2f(qrow[64 + lane]);
        LDS_WAIT(); asm volatile("" ::: "memory");
        float m0 = -3e38f, m1 = -3e38f;
        for (int kk = lane; kk < cend; kk += 64) {
            const bf16* krow = PROJ + (size_t)(b * SEQ + kk) * NP + C_KA + h * 128;
            float d0 = 0.f, d1 = 0.f;
            for (int d = 0; d < 64; ++d) { d0 = fmaf(qs[d], bf2f(krow[d]), d0); d1 = fmaf(qs[64 + d], bf2f(krow[64 + d]), d1); }
            const float bias = slope * fabsf((float)(t - kk));
            d0 = d0 * 0.125f - bias; d1 = d1 * 0.125f - bias;
            sc0[kk] = d0; sc1[kk] = d1; m0 = fmaxf(m0, d0); m1 = fmaxf(m1, d1);
        }
        m0 = wave_max(m0); m1 = wave_max(m1);
        float l0 = 0.f, l1 = 0.f;
        for (int kk = lane; kk < cend; kk += 64) { const float e0 = __expf(sc0[kk] - m0), e1 = __expf(sc1[kk] - m1); sc0[kk] = e0; sc1[kk] = e1; l0 += e0; l1 += e1; }
        l0 = wave_sum(l0); l1 = wave_sum(l1);
        const float i0 = 1.f / l0, i1 = lam / l1;
        for (int kk = lane; kk < cend; kk += 64) sc0[kk] = sc0[kk] * i0 - sc1[kk] * i1;
        LDS_WAIT(); asm volatile("" ::: "memory");
        float a0 = 0.f, a1 = 0.f;
        const bf16* vb = PROJ + (size_t)(b * SEQ) * NP + C_VA + h * 128;
        for (int kk = 0; kk < cend; ++kk) { const float a = sc0[kk]; const bf16* vr = vb + (size_t)kk * NP; a0 = fmaf(a, bf2f(vr[lane]), a0); a1 = fmaf(a, bf2f(vr[64 + lane]), a1); }
        const float ss = wave_sum(a0 * a0 + a1 * a1);
        const float rstd = rsqrtf(ss * (1.f / 128.f) + EPS) * 0.8f;
        bf16* orow = MIX + (size_t)(b * SEQ + t) * MIXW + h * 128;
        orow[lane] = (bf16)f2bf(a0 * rstd * p.a_sub_gain[lane]); orow[64 + lane] = (bf16)f2bf(a1 * rstd * p.a_sub_gain[64 + lane]);
        LDS_WAIT(); asm volatile("" ::: "memory");
    }
}

__device__ void ph_dsa_naive(const Params& p, float* lds, int vb, int nvb) {
    const bf16* PROJ = (const bf16*)(p.ws + WS_PROJ); bf16* MIX = (bf16*)(p.ws + WS_MIX);
    const int tid = threadIdx.x, lane = tid & 63, wv = tid >> 6;
    float* scores = lds; int* sel = (int*)(lds + 2048); float* qi = lds + 2048 + 256; float* wi = qi + 256;
    float* qh = wi + 64 + wv * 384; float* pw = qh + 128;
    for (int it = vb; it < T; it += nvb) {
        const int b = it >> 11, t = it & 2047; const int cend = ((t >> 6) + 1) << 6;
        const bf16* row = PROJ + (size_t)it * NP;
        if (tid < 256) qi[tid] = bf2f(row[C_QI + tid]);
        if (tid < 4) wi[tid] = bf2f(row[C_WI + tid]);
        __syncthreads();
        for (int kk = tid; kk < cend; kk += NT) {
            const bf16* kr = PROJ + (size_t)(b * SEQ + kk) * NP + C_KI;
            float s = 0.f;
            for (int h = 0; h < 4; ++h) { float d = 0.f; for (int e = 0; e < 64; ++e) d = fmaf(qi[h * 64 + e], bf2f(kr[e]), d); s += fmaxf(d, 0.f) * wi[h]; }
            scores[kk] = s * 0.0625f;
        }
        __syncthreads();
        int nvalid;
        if (cend <= 256) { if (tid < 256) sel[tid] = tid; nvalid = cend; }
        else {
            for (int i = tid; i < cend; i += NT) { const float si = scores[i]; int rank = 0;
                for (int j = 0; j < cend; ++j) { const float sj = scores[j]; rank += (sj > si || (sj == si && j < i)) ? 1 : 0; }
                if (rank < 256) sel[rank] = i; }
            nvalid = 256;
        }
        __syncthreads();
        {
            const int h = wv; const float slope = exp2f(-(float)(h + 1));
            qh[lane] = bf2f(row[C_QB + h * 128 + lane]); qh[64 + lane] = bf2f(row[C_QB + h * 128 + 64 + lane]);
            LDS_WAIT(); asm volatile("" ::: "memory");
            float sv[4]; float mx = -3e38f;
#pragma unroll
            for (int jj = 0; jj < 4; ++jj) { const int j = lane + 64 * jj; const int key = sel[j < nvalid ? j : 0];
                const bf16* kv = PROJ + (size_t)(b * SEQ + key) * NP + C_KV; float d = 0.f;
                for (int e = 0; e < 128; ++e) d = fmaf(qh[e], bf2f(kv[e]), d);
                d = d * 0.0883883476f - slope * fabsf((float)(t - key));
                sv[jj] = (j < nvalid) ? d : -3e38f; mx = fmaxf(mx, sv[jj]); }
            mx = wave_max(mx); float l = 0.f;
#pragma unroll
            for (int jj = 0; jj < 4; ++jj) { const int j = lane + 64 * jj; const float e = (j < nvalid) ? __expf(sv[jj] - mx) : 0.f; pw[j] = e; l += e; }
            l = wave_sum(l);
            LDS_WAIT(); asm volatile("" ::: "memory");
            float a0 = 0.f, a1 = 0.f;
            for (int j = 0; j < nvalid; ++j) { const float pj = pw[j]; const bf16* kv = PROJ + (size_t)(b * SEQ + sel[j]) * NP + C_KV; a0 = fmaf(pj, bf2f(kv[lane]), a0); a1 = fmaf(pj, bf2f(kv[64 + lane]), a1); }
            const float il = 1.f / l;
            bf16* orow = MIX + (size_t)it * MIXW + 512 + h * 128;
            orow[lane] = (bf16)f2bf(a0 * il); orow[64 + lane] = (bf16)f2bf(a1 * il);
        }
        __syncthreads();
    }
}

__device__ void ph_route_naive(const Params& p, float* lds, int vb, int nvb) {
    const bf16* Q3 = (const bf16*)(p.ws + WS_Q3); const bf16* SUBK = (const bf16*)(p.ws + WS_SUBK);
    int* EXPI = (int*)(p.ws + WS_EXP); float* GATE = (float*)(p.ws + WS_GATE);
    const int tid = threadIdx.x;
    float* q = lds; float* sub = q + 1024; float* sv = sub + 2048; int* si = (int*)(sv + 256); float* cand = sv + 512; float* ts = cand + 2048; int* te = (int*)(ts + 128);
    for (int it = vb; it < T; it += nvb) {
        q[tid] = bf2f(Q3[(size_t)it * 1024 + tid]); q[tid + 512] = bf2f(Q3[(size_t)it * 1024 + tid + 512]);
        __syncthreads();
        for (int r = 0; r < 4; ++r) { const int idx = tid + 512 * r, h = idx >> 8, c = (idx >> 7) & 1, n = idx & 127;
            const float* qq = q + h * 128 + c * 64; const bf16* kk = SUBK + (size_t)(c * 128 + n) * 64; float d = 0.f;
            for (int e = 0; e < 64; ++e) d = fmaf(qq[e], bf2f(kk[e]), d);
            sub[idx] = d; }
        __syncthreads();
        for (int r = 0; r < 4; ++r) { const int idx = tid + 512 * r, g0 = idx & ~127, n = idx & 127; const float s = sub[idx]; int rank = 0;
            for (int j = 0; j < 128; ++j) { const float sj = sub[g0 + j]; rank += (sj > s || (sj == s && j < n)) ? 1 : 0; }
            if (rank < 16) { sv[(g0 >> 7) * 16 + rank] = s; si[(g0 >> 7) * 16 + rank] = n; } }
        __syncthreads();
        for (int r = 0; r < 4; ++r) { const int idx = tid + 512 * r, h = idx >> 8, i = (idx >> 4) & 15, j = idx & 15; cand[idx] = sv[(h * 2) * 16 + i] + sv[(h * 2 + 1) * 16 + j]; }
        __syncthreads();
        for (int r = 0; r < 4; ++r) { const int idx = tid + 512 * r, h = idx >> 8, ij = idx & 255; const float s = cand[idx]; int rank = 0;
            for (int j = 0; j < 256; ++j) { const float sj = cand[h * 256 + j]; rank += (sj > s || (sj == s && j < ij)) ? 1 : 0; }
            if (rank < 16) { ts[h * 16 + rank] = s; te[h * 16 + rank] = si[(h * 2) * 16 + (ij >> 4)] * 128 + si[(h * 2 + 1) * 16 + (ij & 15)]; } }
        __syncthreads();
        if (tid < 128) { const int h = tid >> 4; const float mx = ts[h * 16]; float l = 0.f;
            for (int k = 0; k < 16; ++k) l += __expf(ts[h * 16 + k] - mx);
            GATE[(size_t)it * 128 + tid] = __expf(ts[tid] - mx) / l; EXPI[(size_t)it * 128 + tid] = te[tid]; }
        __syncthreads();
    }
}

__device__ void ph_peer_naive(const Params& p, float* lds, int vb, int nvb) {
    const bf16* H = (const bf16*)(p.ws + WS_H); const bf16* U16 = (const bf16*)(p.ws + WS_U16); const bf16* V16 = (const bf16*)(p.ws + WS_V16);
    const int* EXPI = (const int*)(p.ws + WS_EXP); const float* GATE = (const float*)(p.ws + WS_GATE); const float* MOD = (const float*)(p.ws + WS_MOD);
    const int tid = threadIdx.x, lane = tid & 63, wv = tid >> 6;
    float* xs = lds; float* coef = lds + 1024; int* ex = (int*)(coef + 128);
    for (int it = vb; it < T; it += nvb) {
        xs[tid] = bf2f(H[(size_t)it * 1024 + tid]); xs[tid + 512] = bf2f(H[(size_t)it * 1024 + tid + 512]);
        if (tid < 128) ex[tid] = EXPI[(size_t)it * 128 + tid];
        __syncthreads();
        for (int jj = 0; jj < 16; ++jj) { const int j = wv * 16 + jj; const bf16* ur = U16 + (size_t)ex[j] * 1024; float d = 0.f;
            for (int i = 0; i < 16; ++i) d = fmaf(xs[lane + 64 * i], bf2f(ur[lane + 64 * i]), d);
            d = wave_sum(d);
            if (lane == 0) coef[j] = 0.5f * d * (1.f + erff(d * 0.70710678f)) * GATE[(size_t)it * 128 + j]; }
        __syncthreads();
        const float* g2 = MOD + (size_t)(it >> 11) * 6144 + 5120;
        for (int r = 0; r < 2; ++r) { const int d = tid + 512 * r; float a = 0.f;
            for (int j = 0; j < 128; ++j) a = fmaf(coef[j], bf2f(V16[(size_t)ex[j] * 1024 + d]), a);
            p.out[(size_t)it * 1024 + d] = p.out[(size_t)it * 1024 + d] + g2[d] * a; }
        __syncthreads();
    }
}
struct EpiResGate {
    static constexpr bool PERM = false, AFTER_DRAIN = false;
    const float* X; float* Out; const float* gate;
    __device__ __forceinline__ void operator()(const pg8::f32x4 (&acc)[2][2][4][2], const pg8::Unit& u, int wr, int wc, int fr, int fq) const {
        const int col0 = u.pn * 256 + wc * 32 + 4 * fq;
#pragma unroll
        for (int ai = 0; ai < 2; ++ai)
#pragma unroll
            for (int m = 0; m < 4; ++m) {
                const int r = u.pm * 256 + ai * 128 + wr * 64 + m * 16 + fr; const float* gb = gate + (size_t)(r >> 11) * 6144;
#pragma unroll
                for (int bj = 0; bj < 2; ++bj)
#pragma unroll
                    for (int n = 0; n < 2; ++n) { const int c = col0 + bj * 128 + n * 16; const size_t off = (size_t)r * 1024 + c;
                        const pg8::f32x4 xv = *(const pg8::f32x4*)(X + off), gv = *(const pg8::f32x4*)(gb + c);
                        *(pg8::f32x4*)(Out + off) = xv + gv * acc[ai][bj][m][n]; }
            }
    }
};

typedef __bf16 bf16x2_t __attribute__((ext_vector_type(2)));
__device__ __forceinline__ float dot2bf(unsigned a, unsigned b, float acc) { return __builtin_amdgcn_fdot2_f32_bf16(__builtin_bit_cast(bf16x2_t, a), __builtin_bit_cast(bf16x2_t, b), acc, false); }
template <int CTRL> __device__ __forceinline__ float dpp_f(float v) { return __int_as_float(__builtin_amdgcn_update_dpp(0, __float_as_int(v), CTRL, 0xf, 0xf, false)); }
__device__ __forceinline__ float row16_sum(float v) {
    v += dpp_f<0x128>(v); v += dpp_f<0x124>(v); v += dpp_f<0x122>(v); v += dpp_f<0x121>(v); return v;
}
__device__ __forceinline__ float gelu_erf(float a) { return 0.5f * a * (1.f + erff(a * 0.70710678118f)); }

__device__ __forceinline__ void ph_peer(const Params& p, unsigned char* lds_w, int gw, int ngw, int lane_, float* outp) {
    int lane = lane_; asm volatile("" : "+v"(lane));
    const bf16* H = (const bf16*)(p.ws + WS_H); const bf16* U16 = (const bf16*)(p.ws + WS_U16); const bf16* V16 = (const bf16*)(p.ws + WS_V16);
    const int* EXPI = (const int*)(p.ws + WS_EXP); const float* GATE = (const float*)(p.ws + WS_GATE); const float* MOD = (const float*)(p.ws + WS_MOD);
    int* e_lds = (int*)lds_w; float* a_lds = (float*)(lds_w + 512);
    const int g = lane >> 4, i = lane & 15;
    for (int t = gw; t < T; t += ngw) {
        const int e0 = EXPI[(size_t)t * 128 + lane], e1 = EXPI[(size_t)t * 128 + 64 + lane];
        const float g0 = GATE[(size_t)t * 128 + lane], g1 = GATE[(size_t)t * 128 + 64 + lane];
        e_lds[lane] = e0; e_lds[64 + lane] = e1;
        u32x4 xr[8];
        const u32x4* xrow = (const u32x4*)(H + (size_t)t * 1024) + i;
#pragma unroll
        for (int k = 0; k < 8; ++k) xr[k] = xrow[16 * k];
        LDS_WAIT(); asm volatile("" ::: "memory");
        u32x4 ua[8], ub[8];
        { const u32x4* ur = (const u32x4*)(U16 + (size_t)e_lds[g] * 1024) + i;
#pragma unroll
          for (int k = 0; k < 8; ++k) ua[k] = ur[16 * k]; }
#pragma unroll 1
        for (int s = 0; s < 32; s += 2) {
            { const u32x4* ur = (const u32x4*)(U16 + (size_t)e_lds[4 * (s + 1) + g] * 1024) + i;
#pragma unroll
              for (int k = 0; k < 8; ++k) ub[k] = ur[16 * k]; }
            { float a0 = 0.f, a1 = 0.f, a2 = 0.f, a3 = 0.f;
#pragma unroll
              for (int k = 0; k < 8; ++k) { a0 = dot2bf(ua[k].x, xr[k].x, a0); a1 = dot2bf(ua[k].y, xr[k].y, a1); a2 = dot2bf(ua[k].z, xr[k].z, a2); a3 = dot2bf(ua[k].w, xr[k].w, a3); }
              const float a = row16_sum((a0 + a1) + (a2 + a3));
              if (i == 0) a_lds[4 * s + g] = a; }
            if (s + 2 < 32) { const u32x4* ur = (const u32x4*)(U16 + (size_t)e_lds[4 * (s + 2) + g] * 1024) + i;
#pragma unroll
              for (int k = 0; k < 8; ++k) ua[k] = ur[16 * k]; }
            { float a0 = 0.f, a1 = 0.f, a2 = 0.f, a3 = 0.f;
#pragma unroll
              for (int k = 0; k < 8; ++k) { a0 = dot2bf(ub[k].x, xr[k].x, a0); a1 = dot2bf(ub[k].y, xr[k].y, a1); a2 = dot2bf(ub[k].z, xr[k].z, a2); a3 = dot2bf(ub[k].w, xr[k].w, a3); }
              const float a = row16_sum((a0 + a1) + (a2 + a3));
              if (i == 0) a_lds[4 * (s + 1) + g] = a; }
        }
        LDS_WAIT(); asm volatile("" ::: "memory");
        const float c0 = gelu_erf(a_lds[lane]) * g0, c1 = gelu_erf(a_lds[64 + lane]) * g1;
        const unsigned pw = pk2(c0, c1);
        float acc[16];
#pragma unroll
        for (int q = 0; q < 16; ++q) acc[q] = 0.f;
        u32x4 A0, A1, B0, B1, C0, C1, D0, D1;
#define PEER_VLOAD(j, X0, X1, Y0, Y1) do { const int ea_ = __builtin_amdgcn_readlane(e0, (j)), eb_ = __builtin_amdgcn_readlane(e1, (j)); \
            const u32x4* ra_ = (const u32x4*)(V16 + (size_t)ea_ * 1024) + lane; const u32x4* rb_ = (const u32x4*)(V16 + (size_t)eb_ * 1024) + lane; \
            X0 = ra_[0]; X1 = ra_[64]; Y0 = rb_[0]; Y1 = rb_[64]; } while (0)
#define PEER_VACC(j, X0, X1, Y0, Y1) do { const unsigned cp_ = (unsigned)__builtin_amdgcn_readlane((int)pw, (j)); \
            acc[0] = dot2bf(__builtin_amdgcn_perm(Y0.x, X0.x, 0x05040100u), cp_, acc[0]); acc[1] = dot2bf(__builtin_amdgcn_perm(Y0.x, X0.x, 0x07060302u), cp_, acc[1]); \
            acc[2] = dot2bf(__builtin_amdgcn_perm(Y0.y, X0.y, 0x05040100u), cp_, acc[2]); acc[3] = dot2bf(__builtin_amdgcn_perm(Y0.y, X0.y, 0x07060302u), cp_, acc[3]); \
            acc[4] = dot2bf(__builtin_amdgcn_perm(Y0.z, X0.z, 0x05040100u), cp_, acc[4]); acc[5] = dot2bf(__builtin_amdgcn_perm(Y0.z, X0.z, 0x07060302u), cp_, acc[5]); \
            acc[6] = dot2bf(__builtin_amdgcn_perm(Y0.w, X0.w, 0x05040100u), cp_, acc[6]); acc[7] = dot2bf(__builtin_amdgcn_perm(Y0.w, X0.w, 0x07060302u), cp_, acc[7]); \
            acc[8] = dot2bf(__builtin_amdgcn_perm(Y1.x, X1.x, 0x05040100u), cp_, acc[8]); acc[9] = dot2bf(__builtin_amdgcn_perm(Y1.x, X1.x, 0x07060302u), cp_, acc[9]); \
            acc[10] = dot2bf(__builtin_amdgcn_perm(Y1.y, X1.y, 0x05040100u), cp_, acc[10]); acc[11] = dot2bf(__builtin_amdgcn_perm(Y1.y, X1.y, 0x07060302u), cp_, acc[11]); \
            acc[12] = dot2bf(__builtin_amdgcn_perm(Y1.z, X1.z, 0x05040100u), cp_, acc[12]); acc[13] = dot2bf(__builtin_amdgcn_perm(Y1.z, X1.z, 0x07060302u), cp_, acc[13]); \
            acc[14] = dot2bf(__builtin_amdgcn_perm(Y1.w, X1.w, 0x05040100u), cp_, acc[14]); acc[15] = dot2bf(__builtin_amdgcn_perm(Y1.w, X1.w, 0x07060302u), cp_, acc[15]); } while (0)
        PEER_VLOAD(0, A0, A1, B0, B1);
#pragma unroll 1
        for (int j = 0; j < 64; j += 2) {
            PEER_VLOAD(j + 1, C0, C1, D0, D1);
            PEER_VACC(j, A0, A1, B0, B1);
            if (j + 2 < 64) PEER_VLOAD(j + 2, A0, A1, B0, B1);
            PEER_VACC(j + 1, C0, C1, D0, D1);
        }
#undef PEER_VLOAD
#undef PEER_VACC
        const float* g2 = MOD + (size_t)(t >> 11) * 6144 + 5120;
        const float* xrow1 = p.out + (size_t)t * 1024; float* orow = outp + (size_t)t * 1024;
#pragma unroll
        for (int h = 0; h < 2; ++h)
#pragma unroll
            for (int q = 0; q < 2; ++q) { const int col = 512 * h + 8 * lane + 4 * q;
                const f32x4 xv = *(const f32x4*)(xrow1 + col), gv = *(const f32x4*)(g2 + col);
                f32x4 a; a.x = acc[8 * h + 4 * q]; a.y = acc[8 * h + 4 * q + 1]; a.z = acc[8 * h + 4 * q + 2]; a.w = acc[8 * h + 4 * q + 3];
                *(f32x4*)(orow + col) = xv + gv * a; }
    }
}
typedef short v4i16_t __attribute__((ext_vector_type(4)));
constexpr int DSA_SROW = 2048 * 4 + 16;
constexpr int DSA_SEL_OFF = 16 * DSA_SROW;
constexpr int DSA_LDS = DSA_SEL_OFF + 16 * 512;
constexpr int DSA_KVROW = 272;

__device__ __forceinline__ unsigned sortkey(float s) { const unsigned u = __float_as_uint(s); return u ^ ((u >> 31) ? 0xffffffffu : 0x80000000u); }
__device__ __forceinline__ unsigned cvtpk_bf16(float lo, float hi) { unsigned r; asm volatile("v_cvt_pk_bf16_f32 %0, %1, %2" : "=v"(r) : "v"(lo), "v"(hi)); return r; }

__device__ __forceinline__ void ph_dsa(const Params& p, unsigned char* lds, int vb, int nvb) {
    const bf16* PROJ = (const bf16*)(p.ws + WS_PROJ); bf16* MIX = (bf16*)(p.ws + WS_MIX);
    const float MB = ((const float*)(p.ws + WS_SCAL))[SC_MB];
    int tid = threadIdx.x; asm volatile("" : "+v"(tid)); const int lane = tid & 63, wv = __builtin_amdgcn_readfirstlane(tid >> 6);
    const int l15 = lane & 15, g = lane >> 4;
    LAS unsigned char* ldsl = (LAS unsigned char*)lds;
    for (int it = vb; it < 2048; it += nvb) {
        const int vbb = it & 255, kk = it >> 8, G = vbb >> 6, ps = vbb & 63, b = ps >> 2, sub = ps & 3;
        const int c = (kk & 1) ? (31 - G - 8 * (kk >> 1)) : (G + 8 * (kk >> 1));
        const int cend = (c + 1) * 64, t0 = c * 64 + sub * 16;
        const bf16* Pb = PROJ + (size_t)b * SEQ * NP;
        if (c >= 4) {
            const bf16* qrow = Pb + (size_t)(t0 + l15) * NP;
            bf16x8 bq[4][2]; float wsc[4];
#pragma unroll
            for (int h = 0; h < 4; ++h) { wsc[h] = bf2f(qrow[C_WI + h]) * 0.0625f;
#pragma unroll
                for (int ks = 0; ks < 2; ++ks) bq[h][ks] = *(const bf16x8*)(qrow + C_QI + h * 64 + 32 * ks + 8 * g); }
            for (int k0 = 16 * wv; k0 < cend; k0 += 128) {
                const bf16* krow = Pb + (size_t)(k0 + l15) * NP + C_KI + 8 * g;
                const bf16x8 ka0 = *(const bf16x8*)krow, ka1 = *(const bf16x8*)(krow + 32);
                f32x4 sc = {0.f, 0.f, 0.f, 0.f};
#pragma unroll
                for (int h = 0; h < 4; ++h) { f32x4 a = {0.f, 0.f, 0.f, 0.f};
                    a = __builtin_amdgcn_mfma_f32_16x16x32_bf16(ka0, bq[h][0], a, 0, 0, 0);
                    a = __builtin_amdgcn_mfma_f32_16x16x32_bf16(ka1, bq[h][1], a, 0, 0, 0);
#pragma unroll
                    for (int r = 0; r < 4; ++r) sc[r] = fmaf(fmaxf(a[r], 0.f), wsc[h], sc[r]); }
#pragma unroll
                for (int r = 0; r < 4; ++r) sc[r] = (sc[r] == 0.f) ? 0.f : sc[r];
                *(LAS f32x4*)(ldsl + l15 * DSA_SROW + (k0 + 4 * g) * 4) = sc;
            }
        }
        __syncthreads();
        LAS unsigned short* selw = (LAS unsigned short*)(ldsl + DSA_SEL_OFF);
        int mind0 = 0, mind1 = 0;
#pragma unroll 1
        for (int qi = 0; qi < 2; ++qi) {
            const int qq = 2 * wv + qi, t = t0 + qq;
            LAS unsigned short* sel = selw + qq * 256;
            if (c < 4) { for (int j = lane; j < 256; j += 64) sel[j] = (unsigned short)j; continue; }
            const int nreg = cend >> 6;
            unsigned key[32];
            const LAS float* srow = (const LAS float*)(ldsl + qq * DSA_SROW) + lane;
#pragma unroll
            for (int i = 0; i < 32; ++i) key[i] = (i < nreg) ? sortkey(srow[64 * i]) : 0u;
            unsigned prefix = 0u; bool exact = false;
#pragma unroll 1
            for (int bit = 31; bit >= 0; --bit) {
                const unsigned cand = prefix | (1u << bit); int cnt = 0;
#pragma unroll
                for (int i = 0; i < 32; ++i) cnt += __popcll(__ballot(key[i] >= cand));
                if (cnt >= 256) { prefix = cand; if (cnt == 256) { exact = true; break; } }
            }
            int need_ties = 0;
            if (!exact) { int cgt = 0;
                if (prefix != 0xffffffffu) {
#pragma unroll
                    for (int i = 0; i < 32; ++i) cgt += __popcll(__ballot(key[i] > prefix)); }
                need_ties = 256 - cgt; }
            int base = 0, tbase = 0, md = 4096;
#pragma unroll
            for (int i = 0; i < 32; ++i) {
                if (i < nreg) {
                    bool selb;
                    if (exact) selb = key[i] >= prefix;
                    else { const bool tie = key[i] == prefix; const unsigned long long mt = __ballot(tie);
                        const int trank = tbase + (int)__builtin_amdgcn_mbcnt_hi((unsigned)(mt >> 32), __builtin_amdgcn_mbcnt_lo((unsigned)mt, 0u));
                        selb = (key[i] > prefix) || (tie && trank < need_ties); tbase += __popcll(mt); }
                    const unsigned long long m = __ballot(selb);
                    const int pos = base + (int)__builtin_amdgcn_mbcnt_hi((unsigned)(m >> 32), __builtin_amdgcn_mbcnt_lo((unsigned)m, 0u));
                    const int kidx = i * 64 + lane;
                    if (selb) { sel[pos] = (unsigned short)kidx; const int d = t > kidx ? t - kidx : kidx - t; md = d < md ? d : md; }
                    base += __popcll(m);
                }
            }
#pragma unroll
            for (int o = 1; o < 64; o <<= 1) { const int x = __shfl_xor(md, o); md = x < md ? x : md; }
            if (qi == 0) mind0 = md; else mind1 = md;
        }
        LDS_WAIT(); asm volatile("" ::: "memory");
        const int nvalid = cend < 256 ? cend : 256;
        const int head = lane & 7;
        const float slopeL2 = exp2f(-(float)(head + 1)) * 1.4426950409f;
#pragma unroll 1
        for (int qi = 0; qi < 2; ++qi) {
            const int qq = 2 * wv + qi, t = t0 + qq;
            const LAS unsigned short* sel = selw + qq * 256;
            LAS unsigned char* stg = ldsl + (2 * wv) * DSA_SROW;
            const bf16* qrow = Pb + (size_t)t * NP + C_QB + head * 128 + 8 * g;
            bf16x8 bq[4];
#pragma unroll
            for (int ks = 0; ks < 4; ++ks) bq[ks] = *(const bf16x8*)(qrow + 32 * ks);
            const float refL2 = MB * 1.4426950409f - slopeL2 * (float)(qi == 0 ? mind0 : mind1);
            f32x4 o[8];
#pragma unroll
            for (int dt = 0; dt < 8; ++dt) o[dt] = (f32x4){0.f, 0.f, 0.f, 0.f};
            float lsum = 0.f;
#pragma unroll 1
            for (int s = 0; s < 8; ++s) {
                if (32 * s >= nvalid) break;
                unsigned pb[4];
#pragma unroll
                for (int tl = 0; tl < 2; ++tl) {
                    const int j0 = 32 * s + 16 * tl;
                    const int jr = j0 + l15; const int keyr = sel[jr < nvalid ? jr : 0];
                    const bf16* kvrow = Pb + (size_t)keyr * NP + C_KV + 8 * g;
                    bf16x8 ka[4];
#pragma unroll
                    for (int ks = 0; ks < 4; ++ks) ka[ks] = *(const bf16x8*)(kvrow + 32 * ks);
                    f32x4 a = {0.f, 0.f, 0.f, 0.f};
#pragma unroll
                    for (int ks = 0; ks < 4; ++ks) { a = __builtin_amdgcn_mfma_f32_16x16x32_bf16(ka[ks], bq[ks], a, 0, 0, 0);
                        *(LAS bf16x8*)(stg + (16 * tl + l15) * DSA_KVROW + (32 * ks + 8 * g) * 2) = ka[ks]; }
                    const u32x2 kw = *(const LAS u32x2*)(sel + j0 + 4 * g);
                    const int kx[4] = {(int)(kw.x & 0xffffu), (int)(kw.x >> 16), (int)(kw.y & 0xffffu), (int)(kw.y >> 16)};
                    float pr[4];
#pragma unroll
                    for (int r = 0; r < 4; ++r) { const int dd = t > kx[r] ? t - kx[r] : kx[r] - t;
                        const float e = __builtin_amdgcn_exp2f(fmaf(a[r], 0.1275174f, -slopeL2 * (float)dd - refL2));
                        pr[r] = (j0 + 4 * g + r < nvalid) ? e : 0.f; lsum += pr[r]; }
                    pb[2 * tl] = cvtpk_bf16(pr[0], pr[1]); pb[2 * tl + 1] = cvtpk_bf16(pr[2], pr[3]);
                }
                LDS_WAIT(); asm volatile("" ::: "memory");
                u32x4 pw4; pw4.x = pb[0]; pw4.y = pb[1]; pw4.z = pb[2]; pw4.w = pb[3];
                const bf16x8 pfrag = __builtin_bit_cast(bf16x8, pw4);
                const LAS unsigned char* trb = stg + (4 * g + (l15 >> 2)) * DSA_KVROW + (4 * (lane & 3)) * 2;
#pragma unroll
                for (int dt = 0; dt < 8; ++dt) {
                    const s16x4 lo = __builtin_bit_cast(s16x4, __builtin_amdgcn_ds_read_tr16_b64_v4i16((LAS v4i16_t*)(trb + dt * 32)));
                    const s16x4 hi = __builtin_bit_cast(s16x4, __builtin_amdgcn_ds_read_tr16_b64_v4i16((LAS v4i16_t*)(trb + 16 * DSA_KVROW + dt * 32)));
                    const bf16x8 af = {lo[0], lo[1], lo[2], lo[3], hi[0], hi[1], hi[2], hi[3]};
                    o[dt] = __builtin_amdgcn_mfma_f32_16x16x32_bf16(af, pfrag, o[dt], 0, 0, 0);
                }
                LDS_WAIT(); asm volatile("" ::: "memory");
            }
            lsum += __shfl_xor(lsum, 16); lsum += __shfl_xor(lsum, 32);
            const float il = 1.f / lsum;
            if (l15 < 8) {
                bf16* orow = MIX + (size_t)(b * SEQ + t) * MIXW + 512 + head * 128 + 4 * g;
#pragma unroll
                for (int dt = 0; dt < 8; ++dt) { u32x2 w; w.x = pk2(o[dt][0] * il, o[dt][1] * il); w.y = pk2(o[dt][2] * il, o[dt][3] * il); *(u32x2*)(orow + 16 * dt) = w; }
            }
        }
        __syncthreads();
    }
}
typedef __attribute__((address_space(1))) float GASF;
__device__ __forceinline__ int crow(int r, int hi) { return (r & 3) + 8 * (r >> 2) + 4 * hi; }
#define KSWZ64(row, cb) ((row) * 128 + ((cb) ^ ((((row) >> 1) & 7) << 4)))
__device__ __forceinline__ int v_st(int k, int c) { const int kk = (k & ~0xC) | ((k & 4) << 1) | ((k & 8) >> 1); return ((kk >> 3) * 4 + (c >> 5)) * 512 + ((kk & 7) * 32 + (c & 31)) * 2; }
__device__ __forceinline__ int v_rd_base(int lane) { return ((lane & 3) << 3) | (((lane >> 2) & 3) << 6) | (((lane >> 4) & 1) << 5) | (((lane >> 5) & 1) << 8); }
constexpr int v_rd_off(int d0, int ks, int half) { return d0 * 512 + ks * 4096 + half * 2048; }
template <int OFF> __device__ __forceinline__ s16x4 tr_read(int vb) {
    s16x4 r; asm volatile("ds_read_b64_tr_b16 %0, %1 offset:%2" : "=&v"(r) : "v"(vb), "i"(OFF) : "memory"); return r;
}
template <int D0> __device__ __forceinline__ void pv_one(f32x16& od, int vb, bf16x8 pa0, bf16x8 pa1, bf16x8 pa2, bf16x8 pa3) {
    const s16x4 l0 = tr_read<v_rd_off(D0, 0, 0)>(vb), h0 = tr_read<v_rd_off(D0, 0, 1)>(vb), l1 = tr_read<v_rd_off(D0, 1, 0)>(vb), h1 = tr_read<v_rd_off(D0, 1, 1)>(vb);
    const s16x4 l2 = tr_read<v_rd_off(D0, 2, 0)>(vb), h2 = tr_read<v_rd_off(D0, 2, 1)>(vb), l3 = tr_read<v_rd_off(D0, 3, 0)>(vb), h3 = tr_read<v_rd_off(D0, 3, 1)>(vb);
    asm volatile("s_waitcnt lgkmcnt(0)" ::: "memory"); __builtin_amdgcn_sched_barrier(0);
#define PK(L, H) (bf16x8){L[0], L[1], L[2], L[3], H[0], H[1], H[2], H[3]}
    od = __builtin_amdgcn_mfma_f32_32x32x16_bf16(pa0, PK(l0, h0), od, 0, 0, 0);
    od = __builtin_amdgcn_mfma_f32_32x32x16_bf16(pa1, PK(l1, h1), od, 0, 0, 0);
    od = __builtin_amdgcn_mfma_f32_32x32x16_bf16(pa2, PK(l2, h2), od, 0, 0, 0);
    od = __builtin_amdgcn_mfma_f32_32x32x16_bf16(pa3, PK(l3, h3), od, 0, 0, 0);
#undef PK
}
constexpr int ATT_LDS = 2 * 16384 + 2 * 8192 + 8 * 256;

__device__ __forceinline__ void ph_attnA(const Params& p, unsigned char* lds, int vb, int nvb) {
    const bf16* PROJ = (const bf16*)(p.ws + WS_PROJ); bf16* MIX = (bf16*)(p.ws + WS_MIX);
    const float* SC = (const float*)(p.ws + WS_SCAL);
    const float lam = SC[SC_LAM], refL2 = SC[SC_MA] * 1.4426950409f;
    constexpr float C = 0.125f * 1.4426950409f;
    int tid = threadIdx.x; asm volatile("" : "+v"(tid)); const int lane = tid & 63, wid = __builtin_amdgcn_readfirstlane(tid >> 6), r32 = lane & 31, hi = lane >> 5;
    unsigned char* V_lds = lds; unsigned char* K_lds = lds + 32768;
    float* wsf = (float*)(lds + 49152) + wid * 64;
    GASF* tmpw = (GASF*)(p.ws + WS_ATMP) + ((size_t)(vb * NWV + wid) * 64) * 64 + lane;
    const int vbase = (int)(uintptr_t)V_lds + v_rd_base(lane);
    const int krow = tid >> 3, kch = tid & 7, kdst = KSWZ64(krow, kch * 16);
    const int sr = tid >> 4, sc = (tid & 15) * 8, vst0 = v_st(sr, sc), vst1 = v_st(32 + sr, sc);
    for (int it = vb; it < 256; it += nvb) {
        const int b = it >> 4, h = (it >> 2) & 3, qbl = it & 3;
        const float slopeL2 = exp2f(-2.0f * (float)(h + 1)) * 1.4426950409f;
        const bf16* Pb = PROJ + (size_t)b * SEQ * NP;
#pragma unroll 1
        for (int half = 0; half < 2; ++half) {
            const int qb = half ? 7 - qbl : qbl, q0 = 256 * qb, NTu = 4 * (qb + 1), cw = 4 * qb + (wid >> 1);
            const int tq = q0 + 32 * wid + r32;
#pragma unroll 1
            for (int mi = 0; mi < 2; ++mi) {
                const int m = 1 - mi;
                const bf16* Kg = Pb + C_KA + h * 128 + m * 64 + (size_t)krow * NP + kch * 8;
                const bf16* Vg = Pb + C_VA + h * 128 + (size_t)sr * NP + sc;
                bf16x8 qr[4];
                { const bf16* qp = Pb + (size_t)tq * NP + C_QA + h * 128 + m * 64 + hi * 8;
#pragma unroll
                  for (int d0 = 0; d0 < 4; ++d0) qr[d0] = *(const bf16x8*)(qp + d0 * 16); }
                f32x16 o[4];
#pragma unroll
                for (int d = 0; d < 4; ++d) o[d] = f32x16{};
                float lsum = 0.f;
                bf16x8 sk, sv0, sv1;
                sk = *(const bf16x8*)Kg; sv0 = *(const bf16x8*)Vg; sv1 = *(const bf16x8*)(Vg + (size_t)32 * NP);
                *(bf16x8*)(K_lds + kdst) = sk; *(bf16x8*)(V_lds + vst0) = sv0; *(bf16x8*)(V_lds + vst1) = sv1;
                __syncthreads();
#pragma unroll 1
                for (int j = 0; j < NTu; ++j) {
                    const int buf = j & 1;
                    if (j + 1 < NTu) { const size_t go = (size_t)(j + 1) * 64 * NP; sk = *(const bf16x8*)(Kg + go); sv0 = *(const bf16x8*)(Vg + go); sv1 = *(const bf16x8*)(Vg + go + (size_t)32 * NP); }
                    if (j <= cw) {
                        const unsigned char* Kb = K_lds + buf * 8192;
                        const float dq = (float)(tq - 64 * j - 4 * hi);
                        const float B0 = -slopeL2 * dq - refL2;
                        const bool past = j < cw;
                        float ps = 0.f;
                        bf16x8 pa0, pa1, pa2, pa3;
#define PK4(P, BASE, OUT) do { unsigned a0 = cvtpk_bf16(P[BASE + 0], P[BASE + 1]), a1 = cvtpk_bf16(P[BASE + 2], P[BASE + 3]);   \
    unsigned b0_ = cvtpk_bf16(P[BASE + 4], P[BASE + 5]), b1_ = cvtpk_bf16(P[BASE + 6], P[BASE + 7]);                              \
    auto r0 = __builtin_amdgcn_permlane32_swap(a0, b0_, false, false); auto r1 = __builtin_amdgcn_permlane32_swap(a1, b1_, false, false); \
    u32x4 w = {r0[0], r1[0], r0[1], r1[1]}; OUT = __builtin_bit_cast(bf16x8, w); } while (0)
#define HALF_TILE(KOFF, FOFF, PA, PB) do { f32x16 pp = f32x16{};                                                                     \
    _Pragma("unroll") for (int d0 = 0; d0 < 4; ++d0) { const int cb = (d0 * 16 + hi * 8) * 2;                                        \
        const bf16x8 bk = *(const bf16x8*)(Kb + KSWZ64((KOFF) + r32, cb)); pp = __builtin_amdgcn_mfma_f32_32x32x16_bf16(bk, qr[d0], pp, 0, 0, 0); } \
    if (past) { _Pragma("unroll") for (int r = 0; r < 16; ++r) { const float off = (float)((r & 3) + 8 * (r >> 2)) + (FOFF);          \
            pp[r] = __builtin_amdgcn_exp2f(fmaf(pp[r], C, fmaf(slopeL2, off, B0))); } }                                               \
    else { _Pragma("unroll") for (int r = 0; r < 16; ++r) { const float off = (float)((r & 3) + 8 * (r >> 2)) + (FOFF);               \
            pp[r] = __builtin_amdgcn_exp2f(fmaf(pp[r], C, -slopeL2 * fabsf(dq - off) - refL2)); } }                                   \
    _Pragma("unroll") for (int r = 0; r < 16; ++r) ps += pp[r];                                                                       \
    PK4(pp, 0, PA); PK4(pp, 8, PB); __builtin_amdgcn_sched_barrier(0); } while (0)
                        HALF_TILE(0, 0.f, pa0, pa1);
                        HALF_TILE(32, 32.f, pa2, pa3);
#undef HALF_TILE
#undef PK4
                        { auto rr = __builtin_amdgcn_permlane32_swap(__float_as_uint(ps), __float_as_uint(ps), false, false);
                          ps = __uint_as_float(rr[0]) + __uint_as_float(rr[1]); }
                        lsum += ps;
                        const int vb0 = vbase + buf * 16384;
                        pv_one<0>(o[0], vb0, pa0, pa1, pa2, pa3); pv_one<1>(o[1], vb0, pa0, pa1, pa2, pa3); pv_one<2>(o[2], vb0, pa0, pa1, pa2, pa3); pv_one<3>(o[3], vb0, pa0, pa1, pa2, pa3);
                    }
                    if (j + 1 < NTu) { const int nb = buf ^ 1;
                        *(bf16x8*)(K_lds + nb * 8192 + kdst) = sk; *(bf16x8*)(V_lds + nb * 16384 + vst0) = sv0; *(bf16x8*)(V_lds + nb * 16384 + vst1) = sv1; }
                    __syncthreads();
                }
                if (hi == 0) wsf[r32] = lsum;
                LDS_WAIT(); asm volatile("" ::: "memory");
                float rli[16];
#pragma unroll
                for (int r = 0; r < 16; ++r) rli[r] = 1.f / wsf[crow(r, hi)];
                LDS_WAIT(); asm volatile("" ::: "memory");
                if (mi == 0) {
#pragma unroll
                    for (int d = 0; d < 4; ++d) { GASF* td = tmpw + d * 1024; asm volatile("" : "+v"(td));
#pragma unroll
                        for (int r = 0; r < 16; ++r) td[r * 64] = o[d][r] * rli[r]; }
                } else {
                    float gsub[4];
#pragma unroll
                    for (int d = 0; d < 4; ++d) gsub[d] = p.a_sub_gain[32 * d + r32];
                    GASF* tdp[4];
#pragma unroll
                    for (int d = 0; d < 4; ++d) { tdp[d] = tmpw + d * 1024; asm volatile("" : "+v"(tdp[d])); }
#pragma unroll
                    for (int r = 0; r < 16; ++r) {
                        float v[4]; float ss = 0.f;
#pragma unroll
                        for (int d = 0; d < 4; ++d) { v[d] = o[d][r] * rli[r] - lam * tdp[d][r * 64]; ss += v[d] * v[d]; }
                        ss += __shfl_xor(ss, 1); ss += __shfl_xor(ss, 2); ss += __shfl_xor(ss, 4); ss += __shfl_xor(ss, 8); ss += __shfl_xor(ss, 16);
                        const float rs = rsqrtf(ss * (1.f / 128.f) + EPS) * 0.8f;
                        bf16* orow = MIX + (size_t)(b * SEQ + q0 + 32 * wid + crow(r, hi)) * MIXW + h * 128 + r32;
#pragma unroll
                        for (int d = 0; d < 4; ++d) orow[32 * d] = (bf16)f2bf(v[d] * rs * gsub[d]);
                        asm volatile("" ::: "memory");
                    }
                }
            }
        }
    }
}
constexpr int RT_WAVE_BYTES = 12288;
constexpr int RT_LDS = 32768 + 8 * RT_WAVE_BYTES;

__device__ __forceinline__ int pl32_sum(int v) { auto rr = __builtin_amdgcn_permlane32_swap((unsigned)v, (unsigned)v, false, false); return (int)(rr[0] + rr[1]); }
__device__ __forceinline__ int pl32_other(int v) { auto rr = __builtin_amdgcn_permlane32_swap((unsigned)v, (unsigned)v, false, false); return (int)(rr[0] + rr[1]) - v; }
__device__ __forceinline__ float unsortkey(unsigned k) { return __uint_as_float((k & 0x80000000u) ? (k ^ 0x80000000u) : ~k); }

template <int N> __device__ __forceinline__ unsigned bisect16(const unsigned (&key)[N]) {
    unsigned prefix = 0u; bool done = false;
#pragma unroll 1
    for (int bit = 31; bit >= 0; --bit) {
        const unsigned cand = done ? prefix : (prefix | (1u << bit));
        int cnt = 0;
#pragma unroll
        for (int i = 0; i < N; ++i) cnt += (key[i] >= cand) ? 1 : 0;
        const int tot = pl32_sum(cnt);
        if (!done && tot >= 16) { prefix = cand; done = (tot == 16); }
        if (__all(done)) break;
    }
    return prefix;
}

__device__ __forceinline__ void ph_route(const Params& p, unsigned char* lds, int vb, int nvb) {
    const bf16* Q3 = (const bf16*)(p.ws + WS_Q3); const bf16* SUBK = (const bf16*)(p.ws + WS_SUBK);
    int* EXPI = (int*)(p.ws + WS_EXP); float* GATE = (float*)(p.ws + WS_GATE);
    int tid = threadIdx.x; asm volatile("" : "+v"(tid));
    const int lane = tid & 63, wv = __builtin_amdgcn_readfirstlane(tid >> 6), r32 = lane & 31, hi = lane >> 5;
    for (int i = tid; i < 2048; i += NT) ((u32x4*)lds)[i] = ((const u32x4*)SUBK)[i];
    __syncthreads();
    unsigned char* wl = lds + 32768 + wv * RT_WAVE_BYTES;
    float* sv = (float*)wl; int* si = (int*)(wl + 4096); float* fv = (float*)(wl + 8192); int* fe = (int*)(wl + 10240);
    const int gw = vb * NWV + wv, ngw = nvb * NWV;
    for (int item = gw; item < (T / 32) * 8; item += ngw) {
        const int h = item & 7, tok0 = (item >> 3) * 32;
        const bf16* qrow = Q3 + (size_t)(tok0 + r32) * 1024 + h * 128 + hi * 8;
#pragma unroll 1
        for (int c = 0; c < 2; ++c) {
            bf16x8 bq[4];
#pragma unroll
            for (int d0 = 0; d0 < 4; ++d0) bq[d0] = *(const bf16x8*)(qrow + c * 64 + d0 * 16);
            unsigned key[64];
#pragma unroll
            for (int nt = 0; nt < 4; ++nt) {
                f32x16 acc = f32x16{};
                const unsigned char* kp = lds + ((c * 128 + nt * 32 + r32) * 64 + hi * 8) * 2;
#pragma unroll
                for (int d0 = 0; d0 < 4; ++d0) { const bf16x8 ak = *(const bf16x8*)(kp + d0 * 32); acc = __builtin_amdgcn_mfma_f32_32x32x16_bf16(ak, bq[d0], acc, 0, 0, 0); }
#pragma unroll
                for (int r = 0; r < 16; ++r) key[nt * 16 + r] = sortkey(acc[r]);
            }
            const unsigned thr = bisect16<64>(key);
            int cnt = 0;
#pragma unroll
            for (int i = 0; i < 64; ++i) cnt += (key[i] >= thr) ? 1 : 0;
            const int other_ = pl32_other(cnt); int slot = hi ? other_ : 0;
            float* svp = sv + (r32 * 2 + c) * 16; int* sip = si + (r32 * 2 + c) * 16;
#pragma unroll
            for (int i = 0; i < 64; ++i) {
                if (key[i] >= thr && slot < 16) { svp[slot] = unsortkey(key[i]); sip[slot] = 32 * (i >> 4) + ((i & 3) + 8 * ((i & 15) >> 2)) + 4 * hi; ++slot; }
            }
        }
        LDS_WAIT(); asm volatile("" ::: "memory");
        {
            const float* s0 = sv + (r32 * 2) * 16 + 8 * hi; const float* s1 = sv + (r32 * 2 + 1) * 16;
            float a0[8], a1[16];
#pragma unroll
            for (int i = 0; i < 8; ++i) a0[i] = s0[i];
#pragma unroll
            for (int j = 0; j < 16; ++j) a1[j] = s1[j];
            unsigned key[128];
#pragma unroll
            for (int i = 0; i < 8; ++i)
#pragma unroll
                for (int j = 0; j < 16; ++j) key[i * 16 + j] = sortkey(a0[i] + a1[j]);
            const unsigned thr = bisect16<128>(key);
            int cnt = 0;
#pragma unroll
            for (int i = 0; i < 128; ++i) cnt += (key[i] >= thr) ? 1 : 0;
            const int other_ = pl32_other(cnt); int slot = hi ? other_ : 0;
            const int* i0 = si + (r32 * 2) * 16 + 8 * hi; const int* i1 = si + (r32 * 2 + 1) * 16;
            float* fvp = fv + r32 * 16; int* fep = fe + r32 * 16;
#pragma unroll
            for (int i = 0; i < 128; ++i) {
                if (key[i] >= thr && slot < 16) { fvp[slot] = unsortkey(key[i]); fep[slot] = i0[i >> 4] * 128 + i1[i & 15]; ++slot; }
            }
        }
        LDS_WAIT(); asm volatile("" ::: "memory");
        {
            const float* fvp = fv + r32 * 16;
            float v[16]; float mx = -3e38f;
#pragma unroll
            for (int k = 0; k < 16; ++k) { v[k] = fvp[k]; mx = fmaxf(mx, v[k]); }
            float l = 0.f;
#pragma unroll
            for (int k = 0; k < 16; ++k) { v[k] = __expf(v[k] - mx); l += v[k]; }
            const float il = 1.f / l;
            const size_t ob = (size_t)(tok0 + r32) * 128 + h * 16 + 8 * hi;
            const int* fep = fe + r32 * 16 + 8 * hi;
            f32x4 g0, g1; u32x4 e0, e1;
            if (hi == 0) { g0 = (f32x4){v[0] * il, v[1] * il, v[2] * il, v[3] * il}; g1 = (f32x4){v[4] * il, v[5] * il, v[6] * il, v[7] * il}; }
            else { g0 = (f32x4){v[8] * il, v[9] * il, v[10] * il, v[11] * il}; g1 = (f32x4){v[12] * il, v[13] * il, v[14] * il, v[15] * il}; }
            e0 = *(const u32x4*)fep; e1 = *(const u32x4*)(fep + 4);
            *(f32x4*)(GATE + ob) = g0; *(f32x4*)(GATE + ob + 4) = g1;
            *(u32x4*)(EXPI + ob) = e0; *(u32x4*)(EXPI + ob + 4) = e1;
        }
        LDS_WAIT(); asm volatile("" ::: "memory");
    }
    __syncthreads();
}
#define XB_TMO      128
#define XB_XCNT(j)  (256  + 64 * (j))
#define XB_XSUB(j)  (1280 + 64 * (j))
#define XB_XGEN(j)  (2304 + 64 * (j))
#define XB_TOP      3328
#define XB_TOPGEN   3392
#define XCD_BAR_WORDS 3456
#define XB_SPIN_CAP (1u << 18)

__device__ __forceinline__ unsigned xb_ld(unsigned* p)              { return __hip_atomic_load(p, __ATOMIC_RELAXED, __HIP_MEMORY_SCOPE_AGENT); }
__device__ __forceinline__ unsigned xb_add(unsigned* p, unsigned v) { return __hip_atomic_fetch_add(p, v, __ATOMIC_RELAXED, __HIP_MEMORY_SCOPE_AGENT); }
__device__ __forceinline__ unsigned xb_xcc_id() { return (unsigned)__builtin_amdgcn_s_getreg((3 << 11) | 20) & 0xFu; }
#define XB_SPIN(cond, bar) do { unsigned _sp = 0; while (cond) { __builtin_amdgcn_s_sleep(1); \
    if ((++_sp & 255u) == 0u) { if (xb_ld(&(bar)[XB_TMO])) break; if (_sp > XB_SPIN_CAP) { atomicAdd(&(bar)[XB_TMO], 1u); break; } } } } while (0)

struct XcdBarrier {
    unsigned* bar; unsigned x;
    volatile LAS unsigned* st;
};

__device__ __forceinline__ XcdBarrier xcd_barrier_post(unsigned* bar, volatile LAS unsigned* st) {
    XcdBarrier b; b.bar = bar; b.x = xb_xcc_id(); b.st = st;
    if (threadIdx.x == 0) (void)xb_add(&bar[XB_XCNT(b.x)], 1u);
    return b;
}
__device__ __forceinline__ void xcd_barrier_complete(unsigned* bar, unsigned x, unsigned& nloc, unsigned& nx) {
    const unsigned G = gridDim.x * gridDim.y * gridDim.z;
    unsigned sum, cnt, mine, sp = 0u;
    for (;;) {
        sum = 0u; cnt = 0u; mine = 0u;
#pragma unroll
        for (unsigned j = 0; j < 16; ++j) { const unsigned c = xb_ld(&bar[XB_XCNT(j)]); sum += c; cnt += (c > 0u) ? 1u : 0u; mine = (j == x) ? c : mine; }
        if (sum == G) break;
        __builtin_amdgcn_s_sleep(1);
        if ((++sp & 255u) == 0u) { if (xb_ld(&bar[XB_TMO])) break; if (sp > XB_SPIN_CAP) { atomicAdd(&bar[XB_TMO], 1u); break; } }
    }
    nloc = mine > 0u ? mine : 1u; nx = cnt > 0u ? cnt : 1u;
}

__device__ __forceinline__ void xcd_barrier(const XcdBarrier& b) {
    asm volatile("s_waitcnt vmcnt(0)" ::: "memory");
    __syncthreads();
    if (threadIdx.x == 0) {
        unsigned* bar = b.bar;
        __builtin_amdgcn_s_waitcnt(0);
        unsigned nloc = b.st[0], nx = b.st[1];
        if (nloc == 0u) { xcd_barrier_complete(bar, b.x, nloc, nx); b.st[0] = nloc; b.st[1] = nx; }
        const unsigned old = xb_add(&bar[XB_XSUB(b.x)], 1u);
        const unsigned gen = old / nloc;
        if (old + 1u == (gen + 1u) * nloc) {
            __builtin_amdgcn_fence(__ATOMIC_RELEASE, "agent");
            asm volatile("s_waitcnt vmcnt(0)" ::: "memory");
            const unsigned og = xb_add(&bar[XB_TOP], 1u);
            const unsigned tg = og / nx;
            if (og + 1u == (tg + 1u) * nx) xb_add(&bar[XB_TOPGEN], 1u);
            else XB_SPIN(xb_ld(&bar[XB_TOPGEN]) == tg, bar);
            __builtin_amdgcn_fence(__ATOMIC_ACQUIRE, "agent");
            xb_add(&bar[XB_XGEN(b.x)], 1u);
            asm volatile("s_waitcnt vmcnt(0)" ::: "memory");
        } else {
            XB_SPIN(xb_ld(&bar[XB_XGEN(b.x)]) == gen, bar);
            __builtin_amdgcn_fence(__ATOMIC_ACQUIRE, "agent");
            asm volatile("s_waitcnt vmcnt(0)" ::: "memory");
        }
    }
    __syncthreads();
}

#ifndef PROBE_DUP
#define PROBE_DUP 0
#endif
constexpr int LDS_BYTES = 147456;
extern __shared__ __attribute__((aligned(16))) unsigned char dyn_lds[];

__global__ void __launch_bounds__(NT, 2) mega_fwd(Params p) {
    cg::grid_group grid = cg::this_grid();
    const int vb = blockIdx.x, nvb = gridDim.x, ngw = nvb * NWV;
    volatile LAS unsigned* xst = (volatile LAS unsigned*)((LAS unsigned char*)dyn_lds + (LDS_BYTES - 16));
    if (threadIdx.x < 4) xst[threadIdx.x] = 0u;
    __syncthreads();
    const XcdBarrier xbar = xcd_barrier_post((unsigned*)(p.ws + WS_CTL), xst);
#define TID_LAUNDER int tid_ = threadIdx.x; asm volatile("" : "+v"(tid_)); const int lane = tid_ & 63, wv = tid_ >> 6, gw = vb * NWV + wv; (void)lane; (void)gw;
    ph_mod(p, (float*)dyn_lds, vb, nvb);
    { TID_LAUNDER ph_prep_weights(p, (LAS float*)dyn_lds + wv * (64 * 33), gw, ngw, lane); }
    grid.sync();
    { TID_LAUNDER ph_hrows(p, p.x, p.norm1_g, 0, 1024, gw, ngw, lane); }
    xcd_barrier(xbar);
    {   pg8::Gemm g{(const bf16*)(p.ws + WS_H), (const bf16*)(p.ws + WS_WIN), T, NP, 1024}; pg8::StaticOrder S; S.init(T, NP, nvb, vb);
        pg8::EpiBf16<0> E{(bf16*)(p.ws + WS_PROJ), NP, nullptr, 0, 0, 1.f};
        pg8::gemm_phase<pg8::EpiBf16<0>, pg8::StaticOrder, true, true>((LAS unsigned char*)dyn_lds, g, S, E); }
    xcd_barrier(xbar);
    { TID_LAUNDER ph_norm_proj(p, gw, ngw, lane); }
    xcd_barrier(xbar);
    ph_attnA(p, dyn_lds, vb, nvb);
#if PROBE_DUP == 1
    __syncthreads(); ph_attnA(p, dyn_lds, vb, nvb);
#endif
    __syncthreads();
    ph_dsa(p, dyn_lds, vb, nvb);
#if PROBE_DUP == 2
    __syncthreads(); ph_dsa(p, dyn_lds, vb, nvb);
#endif
    xcd_barrier(xbar);
    {   pg8::Gemm g{(const bf16*)(p.ws + WS_MIX), (const bf16*)(p.ws + WS_WO2), T, 1024, MIXW}; pg8::StaticOrder S; S.init(T, 1024, nvb, vb);
        EpiResGate E{p.x, p.out, (const float*)(p.ws + WS_MOD) + 2048};
        pg8::gemm_phase<EpiResGate, pg8::StaticOrder, true, true>((LAS unsigned char*)dyn_lds, g, S, E); }
    xcd_barrier(xbar);
    { TID_LAUNDER ph_hrows(p, p.out, p.norm2_g, 3072, 4096, gw, ngw, lane); }
    xcd_barrier(xbar);
    {   pg8::Gemm g{(const bf16*)(p.ws + WS_H), (const bf16*)(p.ws + WS_WQ), T, 1024, 1024}; pg8::StaticOrder S; S.init(T, 1024, nvb, vb);
        pg8::EpiBf16<0> E{(bf16*)(p.ws + WS_Q3), 1024, nullptr, 0, 0, 1.f};
        pg8::gemm_phase<pg8::EpiBf16<0>, pg8::StaticOrder, true, true>((LAS unsigned char*)dyn_lds, g, S, E); }
    xcd_barrier(xbar);
    ph_route(p, dyn_lds, vb, nvb);
#if PROBE_DUP == 3
    __syncthreads(); ph_route(p, dyn_lds, vb, nvb);
#endif
    xcd_barrier(xbar);
#if PROBE_DUP == 4
    { TID_LAUNDER ph_peer(p, dyn_lds + wv * 1024, gw, ngw, lane, (float*)(p.ws + WS_PROJ)); }
#endif
    { TID_LAUNDER ph_peer(p, dyn_lds + wv * 1024, gw, ngw, lane, p.out); }
}

extern "C" void kernel_launch(void* const* d_in, const int* in_sizes, int n_in, void* d_out, int out_size, void* d_ws, size_t ws_size, hipStream_t stream) {
    static int grid_blocks = 0;
    if (grid_blocks == 0) {
        if (n_in != 18 || in_sizes[0] != T * DM || out_size != T * DM || ws_size < WS_END) { fprintf(stderr, "kernel_launch: unexpected shapes n_in %d in0 %d out %d ws %zu\n", n_in, n_in > 0 ? in_sizes[0] : -1, out_size, ws_size); grid_blocks = -1; return; }
        int dev = 0, cus = 0, per_cu = 0;
        (void)hipGetDevice(&dev);
        (void)hipDeviceGetAttribute(&cus, hipDeviceAttributeMultiprocessorCount, dev);
        (void)hipFuncSetAttribute((const void*)mega_fwd, hipFuncAttributeMaxDynamicSharedMemorySize, LDS_BYTES);
        (void)hipOccupancyMaxActiveBlocksPerMultiprocessor(&per_cu, (const void*)mega_fwd, NT, LDS_BYTES);
        if (per_cu < 1 || cus < 1) { fprintf(stderr, "kernel_launch: occupancy query gave %d blocks/CU on %d CUs\n", per_cu, cus); grid_blocks = -1; return; }
        grid_blocks = cus;
    }
    if (grid_blocks < 0) return;
    Params p{};
    const float** pp = (const float**)&p;
    for (int i = 0; i < 18; ++i) pp[i] = (const float*)d_in[i];
    p.out = (float*)d_out; p.ws = (unsigned char*)d_ws;
    if (hipMemsetAsync((char*)d_ws + WS_CTL, 0, CTL_BYTES, stream) != hipSuccess) { fprintf(stderr, "kernel_launch: memset failed\n"); return; }
    void* args[] = {&p};
    const hipError_t e = hipLaunchCooperativeKernel((const void*)mega_fwd, dim3(grid_blocks), dim3(NT), args, LDS_BYTES, stream);
    if (e != hipSuccess) fprintf(stderr, "kernel_launch: cooperative launch failed: %s (grid %d)\n", hipGetErrorString(e), grid_blocks);
}
```

```cpp
#include <hip/hip_runtime.h>
#include <hip/hip_cooperative_groups.h>
#include <cstdio>
#include <cstdint>
#include <cmath>
namespace pg8 {
#define PG8_LAS __attribute__((address_space(3)))
typedef unsigned short bf16_t;
typedef short bf16x8 __attribute__((ext_vector_type(8)));
typedef float f32x4 __attribute__((ext_vector_type(4)));
typedef unsigned u32x4 __attribute__((ext_vector_type(4)));
constexpr int BM = 256, BK = 64, HALF = 128, HTB = HALF * BK * 2  , STAGE_BYTES = 8 * HTB, NXCD = 8, WGM = 8;

__host__ __device__ __forceinline__ int lds_byte(int r, int c) { const int st = (r >> 4) * 2 + (c >> 5), rr = r & 15, cc = c & 31, ob = rr * 64 + cc * 2; return st * 1024 + (ob ^ (((ob >> 9) & 1) << 5)); }
__host__ __device__ __forceinline__ void stage_rc(int b, int& R, int& C) { const int st = b / 1024, sb = b % 1024, swz = sb ^ (((sb >> 9) & 1) << 5); R = (st >> 1) * 16 + swz / 64; C = (st & 1) * 32 + (swz % 64) / 2; }
__host__ __device__ __forceinline__ int perm32(int rho) { const int n = rho >> 4, i = rho & 15; return 8 * (i >> 2) + 4 * n + (i & 3); }

struct Unit { int pm, pn; };
struct Gemm { const bf16_t* A; const bf16_t* Bt; int M, N, K; };

struct StaticOrder {
    int nM, nN, nwg, G, c;
    __host__ __device__ void init(int M, int N, int G_, int c_) { nM = M / BM; nN = N / BM; nwg = nM * nN; G = G_; c = c_; }
    __host__ __device__ bool next(int i, Unit& u) const {
        const long L = (long)i * G + c; if (L >= nwg) return false;
        int wgid = (int)L; { const int q = nwg / NXCD, r = nwg % NXCD, xcd = wgid % NXCD, off = wgid / NXCD; wgid = (xcd < r ? xcd * (q + 1) : r * (q + 1) + (xcd - r) * q) + off; }
        const int nig = WGM * nN, gid = wgid / nig, fm = gid * WGM, gsz = (nM - fm) < WGM ? (nM - fm) : WGM;
        u.pm = fm + ((wgid % nig) % gsz); u.pn = (wgid % nig) / gsz; return true;
    }
    __device__ __forceinline__ void a_ready(const Unit&) const {}
    __device__ __forceinline__ void done(const Unit&) const {}
};

__device__ __forceinline__ unsigned cvt_pk_bf16(float lo, float hi) { unsigned r; asm volatile("v_cvt_pk_bf16_f32 %0, %1, %2" : "=v"(r) : "v"(lo), "v"(hi)); return r; }
typedef float f32x2 __attribute__((ext_vector_type(2)));
__device__ __forceinline__ f32x2 gelu_pk(f32x2 v) {
    const f32x2 av = __builtin_elementwise_abs(v), d = av * 0.2316418882f + 1.0f;
    f32x2 t; t.x = __builtin_amdgcn_rcpf(d.x); t.y = __builtin_amdgcn_rcpf(d.y);
    f32x2 q = t * 0.5307027145f + (-0.7265760135f); q = q * t + 0.7107068705f; q = q * t + (-0.142248368f); q = q * t + 0.127414796f; q = q * t;
    const f32x2 s = (v * v) * (-0.72134752044f);
    f32x2 e; e.x = __builtin_amdgcn_exp2f(s.x); e.y = __builtin_amdgcn_exp2f(s.y);
    const f32x2 m = v * (q * e), r = v - m;
    f32x2 o; o.x = v.x < 0.f ? m.x : r.x; o.y = v.y < 0.f ? m.y : r.y; return o;
}

template <int ACT  > struct EpiBf16 {
    static constexpr bool PERM = true, AFTER_DRAIN = false; static_assert(ACT == 0 || ACT == 1, "EpiBf16: ACT is 0 (none) or 1 (gelu_pk)");
    bf16_t* O; int ldc; const float* bias; int split_cols; size_t split_stride; float scale0;
    __device__ __forceinline__ void operator()(const f32x4 (&acc)[2][2][4][2], const Unit& u, int wr, int wc, int fr, int fq) const {
        const int row0 = u.pm * BM + wr * 64 + fr; int colt = u.pn * BM; bf16_t* base = O;
        float sc = 1.f; if (split_cols) { const int t = colt / split_cols; base += (size_t)t * split_stride; colt -= t * split_cols; if (t == 0) sc = scale0; }
        const int col0 = colt + wc * 32 + 8 * fq, bcol0 = u.pn * BM + wc * 32 + 8 * fq;
        f32x4 bv[2][2];
#pragma unroll
        for (int bj = 0; bj < 2; ++bj)
#pragma unroll
            for (int n = 0; n < 2; ++n) bv[bj][n] = bias ? *(const f32x4*)(bias + bcol0 + bj * HALF + 4 * n) : (f32x4){0.f, 0.f, 0.f, 0.f};
#pragma unroll
        for (int ai = 0; ai < 2; ++ai)
#pragma unroll
            for (int m = 0; m < 4; ++m) { bf16_t* rowp = base + (size_t)(row0 + ai * HALF + m * 16) * ldc + col0;
#pragma unroll
                for (int bj = 0; bj < 2; ++bj) { f32x4 v0 = acc[ai][bj][m][0] + bv[bj][0], v1 = acc[ai][bj][m][1] + bv[bj][1];
                    if (ACT == 1) { f32x2 a = gelu_pk((f32x2){v0[0], v0[1]}), b = gelu_pk((f32x2){v0[2], v0[3]}), c = gelu_pk((f32x2){v1[0], v1[1]}), d = gelu_pk((f32x2){v1[2], v1[3]});
                        v0 = (f32x4){a.x, a.y, b.x, b.y}; v1 = (f32x4){c.x, c.y, d.x, d.y}; }
                    v0 = v0 * sc; v1 = v1 * sc; u32x4 w; w.x = cvt_pk_bf16(v0[0], v0[1]); w.y = cvt_pk_bf16(v0[2], v0[3]); w.z = cvt_pk_bf16(v1[0], v1[1]); w.w = cvt_pk_bf16(v1[2], v1[3]);
                    *(u32x4*)(rowp + bj * HALF) = w; } }
    }
};

template <class Epi, class Sched, bool ALIGN_EPI = false, bool SP2 = false>
__device__ __forceinline__ void gemm_phase(PG8_LAS unsigned char* lds, const Gemm g, const Sched& S, const Epi& E) {
    int tid = threadIdx.x; asm volatile("" : "+v"(tid)); const int wid = __builtin_amdgcn_readfirstlane(tid >> 6), lane = tid & 63, wr = wid >> 2, wc = wid & 3, fr = lane & 15, fq = lane >> 4;
    const int K = g.K, nt = K / BK;
    unsigned voffA[2], voffB[2];
#pragma unroll
    for (int i = 0; i < 2; ++i) { int R, C; stage_rc(tid * 16 + i * 8192, R, C); const int Rb = Epi::PERM ? ((R & ~31) + perm32(R & 31)) : R;
        voffA[i] = (unsigned)(R * K + C) * 2u; voffB[i] = (unsigned)(Rb * K + C) * 2u; }
    const size_t kstep = (size_t)(BK * 2);
    const size_t hstep = (size_t)HALF * K * 2;
    const size_t tstep = 2 * hstep;
    const unsigned ldsw = (unsigned)wid * 1024u;
    const int aoff = lds_byte(wr * 64 + fr, fq * 8), boff = lds_byte(wc * 32 + fr, fq * 8);
#define PG8_SA(b, h) (((b) * 2 + (h)) * HTB)
#define PG8_SB(b, h) ((4 + (b) * 2 + (h)) * HTB)
#define PG8_STAGE(bufoff, gbase, voff) do { _Pragma("unroll") for (int _i = 0; _i < 2; ++_i) \
        __builtin_amdgcn_global_load_lds((const unsigned*)((const char*)(gbase) + (voff)[_i]), (PG8_LAS unsigned*)(lds + (bufoff) + ldsw + _i * 8192), 16, 0, 0); } while (0)
#define PG8_LDA(dst, b, h) do { _Pragma("unroll") for (int m = 0; m < 4; ++m) _Pragma("unroll") for (int k = 0; k < 2; ++k) dst[m][k] = *(const PG8_LAS bf16x8*)(lds + PG8_SA(b, h) + aoff + m * 2048 + k * 1024); } while (0)
#define PG8_LDB(dst, b, h) do { _Pragma("unroll") for (int n = 0; n < 2; ++n) _Pragma("unroll") for (int k = 0; k < 2; ++k) dst[n][k] = *(const PG8_LAS bf16x8*)(lds + PG8_SB(b, h) + boff + n * 2048 + k * 1024); } while (0)
#define PG8_MMA(ai, bj, At, Bt) do { __builtin_amdgcn_s_setprio(1); _Pragma("unroll") for (int m = 0; m < 4; ++m) _Pragma("unroll") for (int n = 0; n < 2; ++n) _Pragma("unroll") for (int k = 0; k < 2; ++k) \
        acc[ai][bj][m][n] = __builtin_amdgcn_mfma_f32_16x16x32_bf16(Bt[n][k], At[m][k], acc[ai][bj][m][n], 0, 0, 0); __builtin_amdgcn_s_setprio(0); } while (0)
#define PG8_WAIT_V(n) asm volatile("s_waitcnt vmcnt(" #n ")" ::: "memory")
#define PG8_WAIT_L(n) asm volatile("s_waitcnt lgkmcnt(" #n ")" ::: "memory")
#define PG8_BAR __builtin_amdgcn_s_barrier()
#define PG8_SCHED __builtin_amdgcn_sched_barrier(0)
    Unit cur, nxt; int ui = 0;
    if (!S.next(0, cur)) return;
    f32x4 acc[2][2][4][2];
#pragma unroll
    for (int a = 0; a < 2; ++a)
#pragma unroll
        for (int b = 0; b < 2; ++b)
#pragma unroll
            for (int m = 0; m < 4; ++m)
#pragma unroll
                for (int n = 0; n < 2; ++n) acc[a][b][m][n] = (f32x4){0.f, 0.f, 0.f, 0.f};
    bf16x8 At[4][2], B0[2][2], B1[2][2];
    const char* cA = (const char*)g.A + (size_t)cur.pm * tstep; const char* cB = (const char*)g.Bt + (size_t)cur.pn * tstep;
    S.a_ready(cur);
    if constexpr (SP2) {
        PG8_STAGE(PG8_SB(0, 0), cB, voffB); PG8_STAGE(PG8_SB(0, 1), cB + hstep, voffB); PG8_STAGE(PG8_SA(0, 0), cA, voffA); PG8_STAGE(PG8_SA(0, 1), cA + hstep, voffA);
        if (wr == 1) PG8_BAR;
        PG8_WAIT_V(2); PG8_BAR;
        PG8_STAGE(PG8_SB(1, 0), cB + kstep, voffB); PG8_STAGE(PG8_SA(1, 0), cA + kstep, voffA); PG8_STAGE(PG8_SB(1, 1), cB + hstep + kstep, voffB);
        PG8_WAIT_V(6); PG8_BAR;
    } else {
        PG8_STAGE(PG8_SB(0, 0), cB, voffB); PG8_STAGE(PG8_SA(0, 0), cA, voffA); PG8_STAGE(PG8_SB(0, 1), cB + hstep, voffB); PG8_STAGE(PG8_SA(0, 1), cA + hstep, voffA);
        if (wr == 1) PG8_BAR;
        PG8_WAIT_V(4); PG8_BAR;
        PG8_STAGE(PG8_SB(1, 0), cB + kstep, voffB); PG8_STAGE(PG8_SA(1, 0), cA + kstep, voffA); PG8_STAGE(PG8_SB(1, 1), cB + hstep + kstep, voffB);
        PG8_WAIT_V(6); PG8_BAR;
    }
    for (;;) {
        const bool has_next = S.next(ui + 1, nxt);
        const char* nA = has_next ? (const char*)g.A + (size_t)nxt.pm * tstep : cA; const char* nB = has_next ? (const char*)g.Bt + (size_t)nxt.pn * tstep : cB;
        for (int t = 0; t < nt; t += 2) {
            const bool last = (t == nt - 2);
            const char* a1 = cA + (size_t)(t + 1) * kstep;
            const char* a2 = last ? nA : cA + (size_t)(t + 2) * kstep; const char* b2 = last ? nB : cB + (size_t)(t + 2) * kstep;
            const char* a3 = a2 + kstep; const char* b3 = b2 + kstep;
            if (last && has_next) S.a_ready(nxt);
            if constexpr (SP2) {
            PG8_LDB(B0, 0, 0); PG8_LDB(B1, 0, 1); PG8_SCHED; PG8_LDA(At, 0, 0); PG8_STAGE(PG8_SA(1, 1), a1 + hstep, voffA);
            PG8_WAIT_V(8); PG8_WAIT_L(0); PG8_BAR; PG8_MMA(0, 0, At, B0); PG8_MMA(0, 1, At, B1); PG8_BAR; PG8_SCHED;
            PG8_LDA(At, 0, 1); PG8_STAGE(PG8_SB(0, 0), b2, voffB); PG8_STAGE(PG8_SB(0, 1), b2 + hstep, voffB); PG8_STAGE(PG8_SA(0, 0), a2, voffA);
            PG8_WAIT_V(8); PG8_WAIT_L(0); PG8_BAR; PG8_MMA(1, 0, At, B0); PG8_MMA(1, 1, At, B1); PG8_BAR; PG8_SCHED;
            PG8_LDB(B0, 1, 0); PG8_LDB(B1, 1, 1); PG8_SCHED; PG8_LDA(At, 1, 0); PG8_STAGE(PG8_SA(0, 1), a2 + hstep, voffA);
            PG8_WAIT_V(8); PG8_WAIT_L(0); PG8_BAR; PG8_MMA(0, 0, At, B0); PG8_MMA(0, 1, At, B1); PG8_BAR; PG8_SCHED;
            PG8_LDA(At, 1, 1); PG8_STAGE(PG8_SB(1, 0), b3, voffB); PG8_STAGE(PG8_SB(1, 1), b3 + hstep, voffB); PG8_STAGE(PG8_SA(1, 0), a3, voffA);
            PG8_WAIT_V(8); PG8_WAIT_L(0); PG8_BAR; PG8_MMA(1, 0, At, B0); PG8_MMA(1, 1, At, B1); PG8_BAR; PG8_SCHED;
            } else {
            PG8_LDB(B0, 0, 0); PG8_SCHED; PG8_LDA(At, 0, 0); PG8_STAGE(PG8_SA(1, 1), a1 + hstep, voffA);
            PG8_WAIT_L(8); PG8_BAR; PG8_WAIT_L(0); PG8_MMA(0, 0, At, B0); PG8_BAR; PG8_SCHED;
            PG8_LDB(B1, 0, 1); PG8_STAGE(PG8_SB(0, 0), b2, voffB);
            PG8_BAR; PG8_WAIT_L(0); PG8_MMA(0, 1, At, B1); PG8_BAR;
            PG8_LDA(At, 0, 1); PG8_STAGE(PG8_SA(0, 0), a2, voffA);
            PG8_BAR; PG8_WAIT_L(0); PG8_MMA(1, 0, At, B0); PG8_BAR; PG8_SCHED;
            PG8_STAGE(PG8_SB(0, 1), b2 + hstep, voffB);
            PG8_WAIT_V(6); PG8_BAR; PG8_MMA(1, 1, At, B1); PG8_BAR;
            PG8_LDB(B0, 1, 0); PG8_SCHED; PG8_LDA(At, 1, 0); PG8_STAGE(PG8_SA(0, 1), a2 + hstep, voffA);
            PG8_WAIT_L(8); PG8_BAR; PG8_WAIT_L(0); PG8_MMA(0, 0, At, B0); PG8_BAR; PG8_SCHED;
            PG8_LDB(B1, 1, 1); PG8_STAGE(PG8_SB(1, 0), b3, voffB);
            PG8_BAR; PG8_WAIT_L(0); PG8_MMA(0, 1, At, B1); PG8_BAR;
            PG8_LDA(At, 1, 1); PG8_STAGE(PG8_SA(1, 0), a3, voffA);
            PG8_BAR; PG8_WAIT_L(0); PG8_MMA(1, 0, At, B0); PG8_BAR; PG8_SCHED;
            PG8_STAGE(PG8_SB(1, 1), b3 + hstep, voffB);
            PG8_WAIT_V(6); PG8_BAR; PG8_MMA(1, 1, At, B1); PG8_BAR;
            }
        }
        if constexpr (ALIGN_EPI) { if (wr == 0) PG8_BAR; }
        if constexpr (!Epi::AFTER_DRAIN) { E(acc, cur, wr, wc, fr, fq); S.done(cur); }
        if (!has_next) break;
#pragma unroll
        for (int a = 0; a < 2; ++a)
#pragma unroll
            for (int b = 0; b < 2; ++b)
#pragma unroll
                for (int m = 0; m < 4; ++m)
#pragma unroll
                    for (int n = 0; n < 2; ++n) acc[a][b][m][n] = (f32x4){0.f, 0.f, 0.f, 0.f};
        cur = nxt; cA = nA; cB = nB; ++ui;
        if constexpr (ALIGN_EPI) { if (wr == 1) PG8_BAR; }
    }
    PG8_WAIT_V(0);
    if constexpr (!ALIGN_EPI) { if (wr == 0) PG8_BAR; }
    PG8_BAR;
    if constexpr (Epi::AFTER_DRAIN) { E.fused(acc, cur, wr, wc, fr, fq, lds, wid, lane); S.done(cur); }
#undef PG8_SA
#undef PG8_SB
#undef PG8_STAGE
#undef PG8_LDA
#undef PG8_LDB
#undef PG8_MMA
#undef PG8_WAIT_V
#undef PG8_WAIT_L
#undef PG8_BAR
#undef PG8_SCHED
}
}
namespace cg = cooperative_groups;
#define LAS __attribute__((address_space(3)))
typedef unsigned short bf16;
typedef float f32x4 __attribute__((ext_vector_type(4)));
typedef float f32x8 __attribute__((ext_vector_type(8)));
typedef float f32x16 __attribute__((ext_vector_type(16)));
typedef unsigned u32x4 __attribute__((ext_vector_type(4)));
typedef unsigned u32x2 __attribute__((ext_vector_type(2)));
typedef short bf16x8 __attribute__((ext_vector_type(8)));
typedef short s16x4 __attribute__((ext_vector_type(4)));

constexpr int BATCH = 16, SEQ = 2048, DM = 1024, T = BATCH * SEQ;
constexpr int NP = 3072;
constexpr int IN_COLS = 3012;
constexpr int C_QA = 0, C_KA = 512, C_VA = 1024, C_QB = 1536, C_KV = 2560, C_QI = 2688, C_KI = 2944, C_WI = 3008;
constexpr int MIXW = 1536;
constexpr int NEXP = 16384;
constexpr float EPS = 1e-6f;
constexpr int NT = 512;
constexpr int NWV = 8;

constexpr size_t MiB = 1u << 20;
constexpr size_t WS_CTL = 0;
constexpr size_t CTL_BYTES = 64 * 1024;
constexpr size_t WS_MOD = 1 * MiB;
constexpr size_t WS_SCAL = WS_MOD + 512 * 1024;
constexpr size_t WS_WIN = 2 * MiB;
constexpr size_t WS_WO2 = 8 * MiB;
constexpr size_t WS_WQ = 11 * MiB;
constexpr size_t WS_SUBK = 13 * MiB;
constexpr size_t WS_U16 = 14 * MiB;
constexpr size_t WS_V16 = 46 * MiB;
constexpr size_t WS_H = 78 * MiB;
constexpr size_t WS_PROJ = 142 * MiB;
constexpr size_t WS_Q3 = WS_PROJ;
constexpr size_t WS_MIX = 334 * MiB;
constexpr size_t WS_EXP = 430 * MiB;
constexpr size_t WS_GATE = 446 * MiB;
constexpr size_t WS_ATMP = 462 * MiB;
constexpr size_t WS_CBUF = 494 * MiB;
constexpr size_t WS_END = 510 * MiB;

struct Params {
    const float *x, *c, *ada_w, *ada_b, *norm1_g, *norm2_g, *w_in, *a_qk_gain, *a_lambda, *a_sub_gain, *b_q_gain, *b_kv_gain, *b_w_uv, *w_out, *peer_wq, *peer_subkeys, *peer_u, *peer_v;
    float* out; unsigned char* ws;
};

enum { SC_LAM = 0, SC_MA = 1, SC_MB = 2 };

__device__ __forceinline__ unsigned f2bf(float f) { unsigned u = __float_as_uint(f); return (u + 0x7fffu + ((u >> 16) & 1u)) >> 16; }
__device__ __forceinline__ float bf2f(unsigned h) { return __uint_as_float(h << 16); }
__device__ __forceinline__ unsigned pk2(float lo, float hi) { return f2bf(lo) | (f2bf(hi) << 16); }
__device__ __forceinline__ float bflo(unsigned w) { return __uint_as_float(w << 16); }
__device__ __forceinline__ float bfhi(unsigned w) { return __uint_as_float(w & 0xffff0000u); }
__device__ __forceinline__ float wave_sum(float v) {
#pragma unroll
    for (int o = 1; o < 64; o <<= 1) v += __shfl_xor(v, o);
    return v;
}
__device__ __forceinline__ float wave_max(float v) {
#pragma unroll
    for (int o = 1; o < 64; o <<= 1) v = fmaxf(v, __shfl_xor(v, o));
    return v;
}
#define LDS_WAIT() asm volatile("s_waitcnt lgkmcnt(0)" ::: "memory")
__device__ __forceinline__ void ph_mod(const Params& p, float* ldsf, int vb, int nvb) {
    if (vb >= 12) return;
    const int tid = threadIdx.x;
    for (int i = tid; i < 16 * 1024; i += NT) { const float v = p.c[i]; ldsf[i] = v / (1.f + __expf(-v)); }
    __syncthreads();
    float* MOD = (float*)(p.ws + WS_MOD);
    for (int it = vb; it < 12; it += nvb) {
        const int j = it * 512 + tid;
        float acc[16];
#pragma unroll
        for (int b = 0; b < 16; ++b) acc[b] = 0.f;
        for (int k = 0; k < 1024; ++k) {
            const float w = p.ada_w[(size_t)k * 6144 + j];
#pragma unroll
            for (int b = 0; b < 16; ++b) acc[b] = fmaf(ldsf[b * 1024 + k], w, acc[b]);
        }
        const float bb = p.ada_b[j];
#pragma unroll
        for (int b = 0; b < 16; ++b) MOD[b * 6144 + j] = acc[b] + bb;
    }
    __syncthreads();
}

__device__ __forceinline__ void transpose_item(const float* W, int N, bf16* WT, int ldt, LAS float* scr, int kb, int nb, int lane) {
    const int k0 = 64 * kb, n0 = 32 * nb;
#pragma unroll 8
    for (int i = 0; i < 32; ++i) { const int kk = 2 * i + (lane >> 5); const int n = n0 + (lane & 31); scr[kk * 33 + (lane & 31)] = (n < N) ? W[(size_t)(k0 + kk) * N + n] : 0.f; }
    LDS_WAIT(); asm volatile("" ::: "memory");
    const int c = lane & 7;
#pragma unroll
    for (int j = 0; j < 4; ++j) { const int n = (lane >> 3) + 8 * j; const LAS float* s = scr + (8 * c) * 33 + n;
        u32x4 o; o.x = pk2(s[0 * 33], s[1 * 33]); o.y = pk2(s[2 * 33], s[3 * 33]); o.z = pk2(s[4 * 33], s[5 * 33]); o.w = pk2(s[6 * 33], s[7 * 33]);
        *(u32x4*)(WT + (size_t)(n0 + n) * ldt + k0 + 8 * c) = o; }
    LDS_WAIT(); asm volatile("" ::: "memory");
}

__device__ __forceinline__ void ph_prep_weights(const Params& p, LAS float* scr, int gw, int ngw, int lane) {
    bf16* WIN = (bf16*)(p.ws + WS_WIN); bf16* WO2 = (bf16*)(p.ws + WS_WO2); bf16* WQ = (bf16*)(p.ws + WS_WQ);
    constexpr int I_IN = 16 * 96, I_O = 8 * 32, I_Q = 16 * 32;
    for (int it = gw; it < I_IN + I_O + I_Q; it += ngw) {
        int r = it;
        if (r < I_IN) { transpose_item(p.w_in, IN_COLS, WIN, 1024, scr, r / 96, r % 96, lane); continue; } r -= I_IN;
        if (r < I_O) { transpose_item(p.w_out, 1024, WO2, MIXW, scr, r / 32, r % 32, lane); continue; } r -= I_O;
        transpose_item(p.peer_wq, 1024, WQ, 1024, scr, r / 32, r % 32, lane);
    }
    const size_t gt = (size_t)gw * 64 + lane, ngt = (size_t)ngw * 64;
    for (size_t i = gt; i < (size_t)1024 * 1024; i += ngt) {
        const int n = (int)(i & 1023), kk = (int)(i >> 10), h = kk >> 7;
        const float* wu = p.b_w_uv + (size_t)kk * 64; const float* wo = p.w_out + (size_t)(512 + 64 * h) * 1024 + n;
        float a = 0.f;
#pragma unroll 8
        for (int e = 0; e < 64; ++e) a = fmaf(wu[e], wo[(size_t)e * 1024], a);
        WO2[(size_t)n * MIXW + 512 + kk] = (bf16)f2bf(a);
    }
    unsigned char* U8 = (unsigned char*)(p.ws + WS_U16); unsigned char* V8 = (unsigned char*)(p.ws + WS_V16); bf16* SUBK = (bf16*)(p.ws + WS_SUBK);
    constexpr size_t NTAB8 = (size_t)NEXP * 1024 / 8, NSUB8 = 2 * 128 * 64 / 8;
    for (size_t i = gt; i < 2 * NTAB8 + NSUB8; i += ngt) {
        if (i < 2 * NTAB8) {
            const bool isu = i < NTAB8; const size_t j = isu ? i : i - NTAB8; const float sc = isu ? 32.0f : 1.0f;
            const f32x8 v = *(const f32x8*)((isu ? p.peer_u : p.peer_v) + j * 8);
            int w0 = 0, w1 = 0;
            w0 = __builtin_amdgcn_cvt_pk_fp8_f32(v[0] * sc, v[1] * sc, w0, false); w0 = __builtin_amdgcn_cvt_pk_fp8_f32(v[2] * sc, v[3] * sc, w0, true);
            w1 = __builtin_amdgcn_cvt_pk_fp8_f32(v[4] * sc, v[5] * sc, w1, false); w1 = __builtin_amdgcn_cvt_pk_fp8_f32(v[6] * sc, v[7] * sc, w1, true);
            u32x2 o; o.x = (unsigned)w0; o.y = (unsigned)w1;
            *(u32x2*)((isu ? U8 : V8) + j * 8) = o;
        } else {
            const size_t j = i - 2 * NTAB8;
            const f32x8 v = *(const f32x8*)(p.peer_subkeys + j * 8);
            u32x4 o; o.x = pk2(v[0], v[1]); o.y = pk2(v[2], v[3]); o.z = pk2(v[4], v[5]); o.w = pk2(v[6], v[7]);
            *(u32x4*)(SUBK + j * 8) = o;
        }
    }
    if (gt == 0) {
        float* SC = (float*)(p.ws + WS_SCAL);
        float s01 = 0.f, s23 = 0.f;
        for (int i = 0; i < 64; ++i) { s01 += p.a_lambda[i] * p.a_lambda[64 + i]; s23 += p.a_lambda[128 + i] * p.a_lambda[192 + i]; }
        SC[SC_LAM] = __expf(s01) - __expf(s23) + 0.2f;
        float g0 = 0.f, g1 = 0.f, gq = 0.f, gk = 0.f;
        for (int i = 0; i < 64; ++i) { g0 = fmaxf(g0, fabsf(p.a_qk_gain[i])); g1 = fmaxf(g1, fabsf(p.a_qk_gain[64 + i])); }
        for (int i = 0; i < 128; ++i) { gq = fmaxf(gq, fabsf(p.b_q_gain[i])); gk = fmaxf(gk, fabsf(p.b_kv_gain[i])); }
        SC[SC_MA] = 8.0f * g0 * g1 * 1.02f;
        SC[SC_MB] = 11.3137085f * gq * gk * 1.02f;
    }
}

__device__ __forceinline__ void ph_hrows(const Params& p, const float* X, const float* g, int shOff, int scOff, int gw, int ngw, int lane) {
    const float* MOD = (const float*)(p.ws + WS_MOD); bf16* H = (bf16*)(p.ws + WS_H);
    for (int m = gw; m < T; m += ngw) {
        const f32x4* xr = (const f32x4*)(X + (size_t)m * 1024) + lane;
        f32x4 v[4]; float s = 0.f;
#pragma unroll
        for (int j = 0; j < 4; ++j) { v[j] = xr[64 * j]; s += (v[j].x * v[j].x + v[j].y * v[j].y) + (v[j].z * v[j].z + v[j].w * v[j].w); }
        const float rstd = rsqrtf(wave_sum(s) * (1.f / 1024.f) + EPS);
        const float* mb = MOD + (size_t)(m >> 11) * 6144;
#pragma unroll
        for (int j = 0; j < 4; ++j) {
            const int col = 4 * (lane + 64 * j);
            const f32x4 gg = *(const f32x4*)(g + col), sc = *(const f32x4*)(mb + scOff + col), sh = *(const f32x4*)(mb + shOff + col);
            const f32x4 y = v[j] * rstd * gg * (sc + 1.0f) + sh;
            u32x2 o; o.x = pk2(y.x, y.y); o.y = pk2(y.z, y.w);
            *(u32x2*)(H + (size_t)m * 1024 + col) = o;
        }
    }
}

__device__ __forceinline__ void ph_norm_proj(const Params& p, int gw, int ngw, int lane) {
    bf16* PROJ = (bf16*)(p.ws + WS_PROJ);
    for (int m = gw; m < T; m += ngw) {
        bf16* row = PROJ + (size_t)m * NP;
#pragma unroll
        for (int j = 0; j < 6; ++j) {
            if (j == 2) continue;
            const int col = 8 * lane + 512 * j;
            const u32x4 raw = *(const u32x4*)(row + col);
            float v[8] = {bflo(raw.x), bfhi(raw.x), bflo(raw.y), bfhi(raw.y), bflo(raw.z), bfhi(raw.z), bflo(raw.w), bfhi(raw.w)};
            float ss = 0.f;
#pragma unroll
            for (int i = 0; i < 8; ++i) ss += v[i] * v[i];
            ss += __shfl_xor(ss, 1); ss += __shfl_xor(ss, 2); ss += __shfl_xor(ss, 4);
            float rstd; const float* gp;
            if (j < 2) { rstd = rsqrtf(ss * (1.f / 64.f) + EPS); gp = p.a_qk_gain + 64 * j + (col & 63); }
            else { ss += __shfl_xor(ss, 8); rstd = rsqrtf(ss * (1.f / 128.f) + EPS); gp = (j == 5 ? p.b_kv_gain : p.b_q_gain) + (col & 127); }
            if (j == 5 && lane >= 16) continue;
            const f32x4 g0 = *(const f32x4*)gp, g1 = *(const f32x4*)(gp + 4);
            u32x4 o; o.x = pk2(v[0] * rstd * g0.x, v[1] * rstd * g0.y); o.y = pk2(v[2] * rstd * g0.z, v[3] * rstd * g0.w);
            o.z = pk2(v[4] * rstd * g1.x, v[5] * rstd * g1.y); o.w = pk2(v[6] * rstd * g1.z, v[7] * rstd * g1.w);
            *(u32x4*)(row + col) = o;
        }
    }
}
__device__ void ph_attnA_naive(const Params& p, float* lds_w, int gw, int ngw, int lane) {
    const bf16* PROJ = (const bf16*)(p.ws + WS_PROJ); bf16* MIX = (bf16*)(p.ws + WS_MIX);
    const float lam = ((const float*)(p.ws + WS_SCAL))[SC_LAM];
    float* qs = lds_w; float* sc0 = lds_w + 128; float* sc1 = sc0 + 2048;
    for (int it = gw; it < BATCH * 4 * SEQ; it += ngw) {
        const int t = it & 2047, h = (it >> 11) & 3, b = it >> 13;
        const int cend = ((t >> 6) + 1) << 6;
        const float slope = exp2f(-2.0f * (h + 1));
        const bf16* qrow = PROJ + (size_t)(b * SEQ + t) * NP + C_QA + h * 128;
        qs[lane] = bf2f(qrow[lane]); qs[64 + lane] = bf2f(qrow[64 + lane]);
        LDS_WAIT(); asm volatile("" ::: "memory");
        float m0 = -3e38f, m1 = -3e38f;
        for (int kk = lane; kk < cend; kk += 64) {
            const bf16* krow = PROJ + (size_t)(b * SEQ + kk) * NP + C_KA + h * 128;
            float d0 = 0.f, d1 = 0.f;
            for (int d = 0; d < 64; ++d) { d0 = fmaf(qs[d], bf2f(krow[d]), d0); d1 = fmaf(qs[64 + d], bf2f(krow[64 + d]), d1); }
            const float bias = slope * fabsf((float)(t - kk));
            d0 = d0 * 0.125f - bias; d1 = d1 * 0.125f - bias;
            sc0[kk] = d0; sc1[kk] = d1; m0 = fmaxf(m0, d0); m1 = fmaxf(m1, d1);
        }
        m0 = wave_max(m0); m1 = wave_max(m1);
        float l0 = 0.f, l1 = 0.f;
        for (int kk = lane; kk < cend; kk += 64) { const float e0 = __expf(sc0[kk] - m0), e1 = __expf(sc1[kk] - m1); sc0[kk] = e0; sc1[kk] = e1; l0 += e0; l1 += e1; }
        l0 = wave_sum(l0); l1 = wave_sum(l1);
        const float i0 = 1.f / l0, i1 = lam / l1;
        for (int kk = lane; kk < cend; kk += 64) sc0[kk] = sc0[kk] * i0 - sc1[kk] * i1;
        LDS_WAIT(); asm volatile("" ::: "memory");
        float a0 = 0.f, a1 = 0.f;
        const bf16* vb = PROJ + (size_t)(b * SEQ) * NP + C_VA + h * 128;
        for (int kk = 0; kk < cend; ++kk) { const float a = sc0[kk]; const bf16* vr = vb + (size_t)kk * NP; a0 = fmaf(a, bf2f(vr[lane]), a0); a1 = fmaf(a, bf2f(vr[64 + lane]), a1); }
        const float ss = wave_sum(a0 * a0 + a1 * a1);
        const float rstd = rsqrtf(ss * (1.f / 128.f) + EPS) * 0.8f;
        bf16* orow = MIX + (size_t)(b * SEQ + t) * MIXW + h * 128;
        orow[lane] = (bf16)f2bf(a0 * rstd * p.a_sub_gain[lane]); orow[64 + lane] = (bf16)f2bf(a1 * rstd * p.a_sub_gain[64 + lane]);
        LDS_WAIT(); asm volatile("" ::: "memory");
    }
}

__device__ void ph_dsa_naive(const Params& p, float* lds, int vb, int nvb) {
    const bf16* PROJ = (const bf16*)(p.ws + WS_PROJ); bf16* MIX = (bf16*)(p.ws + WS_MIX);
    const int tid = threadIdx.x, lane = tid & 63, wv = tid >> 6;
    float* scores = lds; int* sel = (int*)(lds + 2048); float* qi = lds + 2048 + 256; float* wi = qi + 256;
    float* qh = wi + 64 + wv * 384; float* pw = qh + 128;
    for (int it = vb; it < T; it += nvb) {
        const int b = it >> 11, t = it & 2047; const int cend = ((t >> 6) + 1) << 6;
        const bf16* row = PROJ + (size_t)it * NP;
        if (tid < 256) qi[tid] = bf2f(row[C_QI + tid]);
        if (tid < 4) wi[tid] = bf2f(row[C_WI + tid]);
        __syncthreads();
        for (int kk = tid; kk < cend; kk += NT) {
            const bf16* kr = PROJ + (size_t)(b * SEQ + kk) * NP + C_KI;
            float s = 0.f;
            for (int h = 0; h < 4; ++h) { float d = 0.f; for (int e = 0; e < 64; ++e) d = fmaf(qi[h * 64 + e], bf2f(kr[e]), d); s += fmaxf(d, 0.f) * wi[h]; }
            scores[kk] = s * 0.0625f;
        }
        __syncthreads();
        int nvalid;
        if (cend <= 256) { if (tid < 256) sel[tid] = tid; nvalid = cend; }
        else {
            for (int i = tid; i < cend; i += NT) { const float si = scores[i]; int rank = 0;
                for (int j = 0; j < cend; ++j) { const float sj = scores[j]; rank += (sj > si || (sj == si && j < i)) ? 1 : 0; }
                if (rank < 256) sel[rank] = i; }
            nvalid = 256;
        }
        __syncthreads();
        {
            const int h = wv; const float slope = exp2f(-(float)(h + 1));
            qh[lane] = bf2f(row[C_QB + h * 128 + lane]); qh[64 + lane] = bf2f(row[C_QB + h * 128 + 64 + lane]);
            LDS_WAIT(); asm volatile("" ::: "memory");
            float sv[4]; float mx = -3e38f;
#pragma unroll
            for (int jj = 0; jj < 4; ++jj) { const int j = lane + 64 * jj; const int key = sel[j < nvalid ? j : 0];
                const bf16* kv = PROJ + (size_t)(b * SEQ + key) * NP + C_KV; float d = 0.f;
                for (int e = 0; e < 128; ++e) d = fmaf(qh[e], bf2f(kv[e]), d);
                d = d * 0.0883883476f - slope * fabsf((float)(t - key));
                sv[jj] = (j < nvalid) ? d : -3e38f; mx = fmaxf(mx, sv[jj]); }
            mx = wave_max(mx); float l = 0.f;
#pragma unroll
            for (int jj = 0; jj < 4; ++jj) { const int j = lane + 64 * jj; const float e = (j < nvalid) ? __expf(sv[jj] - mx) : 0.f; pw[j] = e; l += e; }
            l = wave_sum(l);
            LDS_WAIT(); asm volatile("" ::: "memory");
            float a0 = 0.f, a1 = 0.f;
            for (int j = 0; j < nvalid; ++j) { const float pj = pw[j]; const bf16* kv = PROJ + (size_t)(b * SEQ + sel[j]) * NP + C_KV; a0 = fmaf(pj, bf2f(kv[lane]), a0); a1 = fmaf(pj, bf2f(kv[64 + lane]), a1); }
            const float il = 1.f / l;
            bf16* orow = MIX + (size_t)it * MIXW + 512 + h * 128;
            orow[lane] = (bf16)f2bf(a0 * il); orow[64 + lane] = (bf16)f2bf(a1 * il);
        }
        __syncthreads();
    }
}

__device__ void ph_route_naive(const Params& p, float* lds, int vb, int nvb) {
    const bf16* Q3 = (const bf16*)(p.ws + WS_Q3); const bf16* SUBK = (const bf16*)(p.ws + WS_SUBK);
    int* EXPI = (int*)(p.ws + WS_EXP); float* GATE = (float*)(p.ws + WS_GATE);
    const int tid = threadIdx.x;
    float* q = lds; float* sub = q + 1024; float* sv = sub + 2048; int* si = (int*)(sv + 256); float* cand = sv + 512; float* ts = cand + 2048; int* te = (int*)(ts + 128);
    for (int it = vb; it < T; it += nvb) {
        q[tid] = bf2f(Q3[(size_t)it * 1024 + tid]); q[tid + 512] = bf2f(Q3[(size_t)it * 1024 + tid + 512]);
        __syncthreads();
        for (int r = 0; r < 4; ++r) { const int idx = tid + 512 * r, h = idx >> 8, c = (idx >> 7) & 1, n = idx & 127;
            const float* qq = q + h * 128 + c * 64; const bf16* kk = SUBK + (size_t)(c * 128 + n) * 64; float d = 0.f;
            for (int e = 0; e < 64; ++e) d = fmaf(qq[e], bf2f(kk[e]), d);
            sub[idx] = d; }
        __syncthreads();
        for (int r = 0; r < 4; ++r) { const int idx = tid + 512 * r, g0 = idx & ~127, n = idx & 127; const float s = sub[idx]; int rank = 0;
            for (int j = 0; j < 128; ++j) { const float sj = sub[g0 + j]; rank += (sj > s || (sj == s && j < n)) ? 1 : 0; }
            if (rank < 16) { sv[(g0 >> 7) * 16 + rank] = s; si[(g0 >> 7) * 16 + rank] = n; } }
        __syncthreads();
        for (int r = 0; r < 4; ++r) { const int idx = tid + 512 * r, h = idx >> 8, i = (idx >> 4) & 15, j = idx & 15; cand[idx] = sv[(h * 2) * 16 + i] + sv[(h * 2 + 1) * 16 + j]; }
        __syncthreads();
        for (int r = 0; r < 4; ++r) { const int idx = tid + 512 * r, h = idx >> 8, ij = idx & 255; const float s = cand[idx]; int rank = 0;
            for (int j = 0; j < 256; ++j) { const float sj = cand[h * 256 + j]; rank += (sj > s || (sj == s && j < ij)) ? 1 : 0; }
            if (rank < 16) { ts[h * 16 + rank] = s; te[h * 16 + rank] = si[(h * 2) * 16 + (ij >> 4)] * 128 + si[(h * 2 + 1) * 16 + (ij & 15)]; } }
        __syncthreads();
        if (tid < 128) { const int h = tid >> 4; const float mx = ts[h * 16]; float l = 0.f;
            for (int k = 0; k < 16; ++k) l += __expf(ts[h * 16 + k] - mx);
            GATE[(size_t)it * 128 + tid] = __expf(ts[tid] - mx) / l; EXPI[(size_t)it * 128 + tid] = te[tid]; }
        __syncthreads();
    }
}

__device__ void ph_peer_naive(const Params& p, float* lds, int vb, int nvb) {
    const bf16* H = (const bf16*)(p.ws + WS_H); const bf16* U16 = (const bf16*)(p.ws + WS_U16); const bf16* V16 = (const bf16*)(p.ws + WS_V16);
    const int* EXPI = (const int*)(p.ws + WS_EXP); const float* GATE = (const float*)(p.ws + WS_GATE); const float* MOD = (const float*)(p.ws + WS_MOD);
    const int tid = threadIdx.x, lane = tid & 63, wv = tid >> 6;
    float* xs = lds; float* coef = lds + 1024; int* ex = (int*)(coef + 128);
    for (int it = vb; it < T; it += nvb) {
        xs[tid] = bf2f(H[(size_t)it * 1024 + tid]); xs[tid + 512] = bf2f(H[(size_t)it * 1024 + tid + 512]);
        if (tid < 128) ex[tid] = EXPI[(size_t)it * 128 + tid];
        __syncthreads();
        for (int jj = 0; jj < 16; ++jj) { const int j = wv * 16 + jj; const bf16* ur = U16 + (size_t)ex[j] * 1024; float d = 0.f;
            for (int i = 0; i < 16; ++i) d = fmaf(xs[lane + 64 * i], bf2f(ur[lane + 64 * i]), d);
            d = wave_sum(d);
            if (lane == 0) coef[j] = 0.5f * d * (1.f + erff(d * 0.70710678f)) * GATE[(size_t)it * 128 + j]; }
        __syncthreads();
        const float* g2 = MOD + (size_t)(it >> 11) * 6144 + 5120;
        for (int r = 0; r < 2; ++r) { const int d = tid + 512 * r; float a = 0.f;
            for (int j = 0; j < 128; ++j) a = fmaf(coef[j], bf2f(V16[(size_t)ex[j] * 1024 + d]), a);
            p.out[(size_t)it * 1024 + d] = p.out[(size_t)it * 1024 + d] + g2[d] * a; }
        __syncthreads();
    }
}
struct EpiResGate {
    static constexpr bool PERM = false, AFTER_DRAIN = false;
    const float* X; float* Out; const float* gate;
    __device__ __forceinline__ void operator()(const pg8::f32x4 (&acc)[2][2][4][2], const pg8::Unit& u, int wr, int wc, int fr, int fq) const {
        const int col0 = u.pn * 256 + wc * 32 + 4 * fq;
#pragma unroll
        for (int ai = 0; ai < 2; ++ai)
#pragma unroll
            for (int m = 0; m < 4; ++m) {
                const int r = u.pm * 256 + ai * 128 + wr * 64 + m * 16 + fr; const float* gb = gate + (size_t)(r >> 11) * 6144;
#pragma unroll
                for (int bj = 0; bj < 2; ++bj)
#pragma unroll
                    for (int n = 0; n < 2; ++n) { const int c = col0 + bj * 128 + n * 16; const size_t off = (size_t)r * 1024 + c;
                        const pg8::f32x4 xv = *(const pg8::f32x4*)(X + off), gv = *(const pg8::f32x4*)(gb + c);
                        *(pg8::f32x4*)(Out + off) = xv + gv * acc[ai][bj][m][n]; }
            }
    }
};

typedef __bf16 bf16x2_t __attribute__((ext_vector_type(2)));
__device__ __forceinline__ float dot2bf(unsigned a, unsigned b, float acc) { return __builtin_amdgcn_fdot2_f32_bf16(__builtin_bit_cast(bf16x2_t, a), __builtin_bit_cast(bf16x2_t, b), acc, false); }
template <int CTRL> __device__ __forceinline__ float dpp_f(float v) { return __int_as_float(__builtin_amdgcn_update_dpp(0, __float_as_int(v), CTRL, 0xf, 0xf, false)); }
__device__ __forceinline__ float row16_sum(float v) {
    v += dpp_f<0x128>(v); v += dpp_f<0x124>(v); v += dpp_f<0x122>(v); v += dpp_f<0x121>(v); return v;
}
__device__ __forceinline__ float gelu_erf(float a) { return 0.5f * a * (1.f + erff(a * 0.70710678118f)); }

__device__ __forceinline__ void ph_peer(const Params& p, unsigned char* lds_w, int gw, int ngw, int lane_, float* outp) {
    int lane = lane_; asm volatile("" : "+v"(lane));
    const bf16* H = (const bf16*)(p.ws + WS_H); const bf16* U16 = (const bf16*)(p.ws + WS_U16); const bf16* V16 = (const bf16*)(p.ws + WS_V16);
    const int* EXPI = (const int*)(p.ws + WS_EXP); const float* GATE = (const float*)(p.ws + WS_GATE); const float* MOD = (const float*)(p.ws + WS_MOD);
    int* e_lds = (int*)lds_w; float* a_lds = (float*)(lds_w + 512);
    const int g = lane >> 4, i = lane & 15;
    for (int t = gw; t < T; t += ngw) {
        const int e0 = EXPI[(size_t)t * 128 + lane], e1 = EXPI[(size_t)t * 128 + 64 + lane];
        const float g0 = GATE[(size_t)t * 128 + lane], g1 = GATE[(size_t)t * 128 + 64 + lane];
        e_lds[lane] = e0; e_lds[64 + lane] = e1;
        u32x4 xr[8];
        const u32x4* xrow = (const u32x4*)(H + (size_t)t * 1024) + i;
#pragma unroll
        for (int k = 0; k < 8; ++k) xr[k] = xrow[16 * k];
        LDS_WAIT(); asm volatile("" ::: "memory");
        u32x4 ua[8], ub[8];
        { const u32x4* ur = (const u32x4*)(U16 + (size_t)e_lds[g] * 1024) + i;
#pragma unroll
          for (int k = 0; k < 8; ++k) ua[k] = ur[16 * k]; }
#pragma unroll 1
        for (int s = 0; s < 32; s += 2) {
            { const u32x4* ur = (const u32x4*)(U16 + (size_t)e_lds[4 * (s + 1) + g] * 1024) + i;
#pragma unroll
              for (int k = 0; k < 8; ++k) ub[k] = ur[16 * k]; }
            { float a0 = 0.f, a1 = 0.f, a2 = 0.f, a3 = 0.f;
#pragma unroll
              for (int k = 0; k < 8; ++k) { a0 = dot2bf(ua[k].x, xr[k].x, a0); a1 = dot2bf(ua[k].y, xr[k].y, a1); a2 = dot2bf(ua[k].z, xr[k].z, a2); a3 = dot2bf(ua[k].w, xr[k].w, a3); }
              const float a = row16_sum((a0 + a1) + (a2 + a3));
              if (i == 0) a_lds[4 * s + g] = a; }
            if (s + 2 < 32) { const u32x4* ur = (const u32x4*)(U16 + (size_t)e_lds[4 * (s + 2) + g] * 1024) + i;
#pragma unroll
              for (int k = 0; k < 8; ++k) ua[k] = ur[16 * k]; }
            { float a0 = 0.f, a1 = 0.f, a2 = 0.f, a3 = 0.f;
#pragma unroll
              for (int k = 0; k < 8; ++k) { a0 = dot2bf(ub[k].x, xr[k].x, a0); a1 = dot2bf(ub[k].y, xr[k].y, a1); a2 = dot2bf(ub[k].z, xr[k].z, a2); a3 = dot2bf(ub[k].w, xr[k].w, a3); }
              const float a = row16_sum((a0 + a1) + (a2 + a3));
              if (i == 0) a_lds[4 * (s + 1) + g] = a; }
        }
        LDS_WAIT(); asm volatile("" ::: "memory");
        const float c0 = gelu_erf(a_lds[lane]) * g0, c1 = gelu_erf(a_lds[64 + lane]) * g1;
        const unsigned pw = pk2(c0, c1);
        float acc[16];
#pragma unroll
        for (int q = 0; q < 16; ++q) acc[q] = 0.f;
        u32x4 A0, A1, B0, B1, C0, C1, D0, D1;
#define PEER_VLOAD(j, X0, X1, Y0, Y1) do { const int ea_ = __builtin_amdgcn_readlane(e0, (j)), eb_ = __builtin_amdgcn_readlane(e1, (j)); \
            const u32x4* ra_ = (const u32x4*)(V16 + (size_t)ea_ * 1024) + lane; const u32x4* rb_ = (const u32x4*)(V16 + (size_t)eb_ * 1024) + lane; \
            X0 = ra_[0]; X1 = ra_[64]; Y0 = rb_[0]; Y1 = rb_[64]; } while (0)
#define PEER_VACC(j, X0, X1, Y0, Y1) do { const unsigned cp_ = (unsigned)__builtin_amdgcn_readlane((int)pw, (j)); \
            acc[0] = dot2bf(__builtin_amdgcn_perm(Y0.x, X0.x, 0x05040100u), cp_, acc[0]); acc[1] = dot2bf(__builtin_amdgcn_perm(Y0.x, X0.x, 0x07060302u), cp_, acc[1]); \
            acc[2] = dot2bf(__builtin_amdgcn_perm(Y0.y, X0.y, 0x05040100u), cp_, acc[2]); acc[3] = dot2bf(__builtin_amdgcn_perm(Y0.y, X0.y, 0x07060302u), cp_, acc[3]); \
            acc[4] = dot2bf(__builtin_amdgcn_perm(Y0.z, X0.z, 0x05040100u), cp_, acc[4]); acc[5] = dot2bf(__builtin_amdgcn_perm(Y0.z, X0.z, 0x07060302u), cp_, acc[5]); \
            acc[6] = dot2bf(__builtin_amdgcn_perm(Y0.w, X0.w, 0x05040100u), cp_, acc[6]); acc[7] = dot2bf(__builtin_amdgcn_perm(Y0.w, X0.w, 0x07060302u), cp_, acc[7]); \
            acc[8] = dot2bf(__builtin_amdgcn_perm(Y1.x, X1.x, 0x05040100u), cp_, acc[8]); acc[9] = dot2bf(__builtin_amdgcn_perm(Y1.x, X1.x, 0x07060302u), cp_, acc[9]); \
            acc[10] = dot2bf(__builtin_amdgcn_perm(Y1.y, X1.y, 0x05040100u), cp_, acc[10]); acc[11] = dot2bf(__builtin_amdgcn_perm(Y1.y, X1.y, 0x07060302u), cp_, acc[11]); \
            acc[12] = dot2bf(__builtin_amdgcn_perm(Y1.z, X1.z, 0x05040100u), cp_, acc[12]); acc[13] = dot2bf(__builtin_amdgcn_perm(Y1.z, X1.z, 0x07060302u), cp_, acc[13]); \
            acc[14] = dot2bf(__builtin_amdgcn_perm(Y1.w, X1.w, 0x05040100u), cp_, acc[14]); acc[15] = dot2bf(__builtin_amdgcn_perm(Y1.w, X1.w, 0x07060302u), cp_, acc[15]); } while (0)
        PEER_VLOAD(0, A0, A1, B0, B1);
#pragma unroll 1
        for (int j = 0; j < 64; j += 2) {
            PEER_VLOAD(j + 1, C0, C1, D0, D1);
            PEER_VACC(j, A0, A1, B0, B1);
            if (j + 2 < 64) PEER_VLOAD(j + 2, A0, A1, B0, B1);
            PEER_VACC(j + 1, C0, C1, D0, D1);
        }
#undef PEER_VLOAD
#undef PEER_VACC
        const float* g2 = MOD + (size_t)(t >> 11) * 6144 + 5120;
        const float* xrow1 = p.out + (size_t)t * 1024; float* orow = outp + (size_t)t * 1024;
#pragma unroll
        for (int h = 0; h < 2; ++h)
#pragma unroll
            for (int q = 0; q < 2; ++q) { const int col = 512 * h + 8 * lane + 4 * q;
                const f32x4 xv = *(const f32x4*)(xrow1 + col), gv = *(const f32x4*)(g2 + col);
                f32x4 a; a.x = acc[8 * h + 4 * q]; a.y = acc[8 * h + 4 * q + 1]; a.z = acc[8 * h + 4 * q + 2]; a.w = acc[8 * h + 4 * q + 3];
                *(f32x4*)(orow + col) = xv + gv * a; }
    }
}
typedef short v4i16_t __attribute__((ext_vector_type(4)));
constexpr int DSA_SROW = 2048 * 4 + 16;
constexpr int DSA_SEL_OFF = 16 * DSA_SROW;
constexpr int DSA_LDS = DSA_SEL_OFF + 16 * 512;
constexpr int DSA_KVROW = 272;

__device__ __forceinline__ unsigned sortkey(float s) { const unsigned u = __float_as_uint(s); return u ^ ((u >> 31) ? 0xffffffffu : 0x80000000u); }
__device__ __forceinline__ unsigned cvtpk_bf16(float lo, float hi) { unsigned r; asm volatile("v_cvt_pk_bf16_f32 %0, %1, %2" : "=v"(r) : "v"(lo), "v"(hi)); return r; }

__device__ __forceinline__ void ph_dsa(const Params& p, unsigned char* lds, int vb, int nvb) {
    const bf16* PROJ = (const bf16*)(p.ws + WS_PROJ); bf16* MIX = (bf16*)(p.ws + WS_MIX);
    const float MB = ((const float*)(p.ws + WS_SCAL))[SC_MB];
    int tid = threadIdx.x; asm volatile("" : "+v"(tid)); const int lane = tid & 63, wv = __builtin_amdgcn_readfirstlane(tid >> 6);
    const int l15 = lane & 15, g = lane >> 4;
    LAS unsigned char* ldsl = (LAS unsigned char*)lds;
    for (int it = vb; it < 2048; it += nvb) {
        const int vbb = it & 255, kk = it >> 8, G = vbb >> 6, ps = vbb & 63, b = ps >> 2, sub = ps & 3;
        const int c = (kk & 1) ? (31 - G - 8 * (kk >> 1)) : (G + 8 * (kk >> 1));
        const int cend = (c + 1) * 64, t0 = c * 64 + sub * 16;
        const bf16* Pb = PROJ + (size_t)b * SEQ * NP;
        if (c >= 4) {
            const bf16* qrow = Pb + (size_t)(t0 + l15) * NP;
            bf16x8 bq[4][2]; float wsc[4];
#pragma unroll
            for (int h = 0; h < 4; ++h) { wsc[h] = bf2f(qrow[C_WI + h]) * 0.0625f;
#pragma unroll
                for (int ks = 0; ks < 2; ++ks) bq[h][ks] = *(const bf16x8*)(qrow + C_QI + h * 64 + 32 * ks + 8 * g); }
            for (int k0 = 16 * wv; k0 < cend; k0 += 128) {
                const bf16* krow = Pb + (size_t)(k0 + l15) * NP + C_KI + 8 * g;
                const bf16x8 ka0 = *(const bf16x8*)krow, ka1 = *(const bf16x8*)(krow + 32);
                f32x4 sc = {0.f, 0.f, 0.f, 0.f};
#pragma unroll
                for (int h = 0; h < 4; ++h) { f32x4 a = {0.f, 0.f, 0.f, 0.f};
                    a = __builtin_amdgcn_mfma_f32_16x16x32_bf16(ka0, bq[h][0], a, 0, 0, 0);
                    a = __builtin_amdgcn_mfma_f32_16x16x32_bf16(ka1, bq[h][1], a, 0, 0, 0);
#pragma unroll
                    for (int r = 0; r < 4; ++r) sc[r] = fmaf(fmaxf(a[r], 0.f), wsc[h], sc[r]); }
#pragma unroll
                for (int r = 0; r < 4; ++r) sc[r] = (sc[r] == 0.f) ? 0.f : sc[r];
                *(LAS f32x4*)(ldsl + l15 * DSA_SROW + (k0 + 4 * g) * 4) = sc;
            }
        }
        __syncthreads();
        LAS unsigned short* selw = (LAS unsigned short*)(ldsl + DSA_SEL_OFF);
        int mind0 = 0, mind1 = 0;
#pragma unroll 1
        for (int qi = 0; qi < 2; ++qi) {
            const int qq = 2 * wv + qi, t = t0 + qq;
            LAS unsigned short* sel = selw + qq * 256;
            if (c < 4) { for (int j = lane; j < 256; j += 64) sel[j] = (unsigned short)j; continue; }
            const int nreg = cend >> 6;
            unsigned key[32];
            const LAS float* srow = (const LAS float*)(ldsl + qq * DSA_SROW) + lane;
#pragma unroll
            for (int i = 0; i < 32; ++i) key[i] = (i < nreg) ? sortkey(srow[64 * i]) : 0u;
            unsigned prefix = 0u; bool exact = false;
#pragma unroll 1
            for (int bit = 31; bit >= 0; --bit) {
                const unsigned cand = prefix | (1u << bit); int cnt = 0;
#pragma unroll
                for (int i = 0; i < 32; ++i) cnt += __popcll(__ballot(key[i] >= cand));
                if (cnt >= 256) { prefix = cand; if (cnt == 256) { exact = true; break; } }
            }
            int need_ties = 0;
            if (!exact) { int cgt = 0;
                if (prefix != 0xffffffffu) {
#pragma unroll
                    for (int i = 0; i < 32; ++i) cgt += __popcll(__ballot(key[i] > prefix)); }
                need_ties = 256 - cgt; }
            int base = 0, tbase = 0, md = 4096;
#pragma unroll
            for (int i = 0; i < 32; ++i) {
                if (i < nreg) {
                    bool selb;
                    if (exact) selb = key[i] >= prefix;
                    else { const bool tie = key[i] == prefix; const unsigned long long mt = __ballot(tie);
                        const int trank = tbase + (int)__builtin_amdgcn_mbcnt_hi((unsigned)(mt >> 32), __builtin_amdgcn_mbcnt_lo((unsigned)mt, 0u));
                        selb = (key[i] > prefix) || (tie && trank < need_ties); tbase += __popcll(mt); }
                    const unsigned long long m = __ballot(selb);
                    const int pos = base + (int)__builtin_amdgcn_mbcnt_hi((unsigned)(m >> 32), __builtin_amdgcn_mbcnt_lo((unsigned)m, 0u));
                    const int kidx = i * 64 + lane;
                    if (selb) { sel[pos] = (unsigned short)kidx; const int d = t > kidx ? t - kidx : kidx - t; md = d < md ? d : md; }
                    base += __popcll(m);
                }
            }
#pragma unroll
            for (int o = 1; o < 64; o <<= 1) { const int x = __shfl_xor(md, o); md = x < md ? x : md; }
            if (qi == 0) mind0 = md; else mind1 = md;
        }
        LDS_WAIT(); asm volatile("" ::: "memory");
        const int nvalid = cend < 256 ? cend : 256;
        const int head = lane & 7;
        const float slopeL2 = exp2f(-(float)(head + 1)) * 1.4426950409f;
#pragma unroll 1
        for (int qi = 0; qi < 2; ++qi) {
            const int qq = 2 * wv + qi, t = t0 + qq;
            const LAS unsigned short* sel = selw + qq * 256;
            LAS unsigned char* stg = ldsl + (2 * wv) * DSA_SROW;
            const bf16* qrow = Pb + (size_t)t * NP + C_QB + head * 128 + 8 * g;
            bf16x8 bq[4];
#pragma unroll
            for (int ks = 0; ks < 4; ++ks) bq[ks] = *(const bf16x8*)(qrow + 32 * ks);
            const float refL2 = MB * 1.4426950409f - slopeL2 * (float)(qi == 0 ? mind0 : mind1);
            f32x4 o[8];
#pragma unroll
            for (int dt = 0; dt < 8; ++dt) o[dt] = (f32x4){0.f, 0.f, 0.f, 0.f};
            float lsum = 0.f;
#pragma unroll 1
            for (int s = 0; s < 8; ++s) {
                if (32 * s >= nvalid) break;
                unsigned pb[4];
#pragma unroll
                for (int tl = 0; tl < 2; ++tl) {
                    const int j0 = 32 * s + 16 * tl;
                    const int jr = j0 + l15; const int keyr = sel[jr < nvalid ? jr : 0];
                    const bf16* kvrow = Pb + (size_t)keyr * NP + C_KV + 8 * g;
                    bf16x8 ka[4];
#pragma unroll
                    for (int ks = 0; ks < 4; ++ks) ka[ks] = *(const bf16x8*)(kvrow + 32 * ks);
                    f32x4 a = {0.f, 0.f, 0.f, 0.f};
#pragma unroll
                    for (int ks = 0; ks < 4; ++ks) { a = __builtin_amdgcn_mfma_f32_16x16x32_bf16(ka[ks], bq[ks], a, 0, 0, 0);
                        *(LAS bf16x8*)(stg + (16 * tl + l15) * DSA_KVROW + (32 * ks + 8 * g) * 2) = ka[ks]; }
                    const u32x2 kw = *(const LAS u32x2*)(sel + j0 + 4 * g);
                    const int kx[4] = {(int)(kw.x & 0xffffu), (int)(kw.x >> 16), (int)(kw.y & 0xffffu), (int)(kw.y >> 16)};
                    float pr[4];
#pragma unroll
                    for (int r = 0; r < 4; ++r) { const int dd = t > kx[r] ? t - kx[r] : kx[r] - t;
                        const float e = __builtin_amdgcn_exp2f(fmaf(a[r], 0.1275174f, -slopeL2 * (float)dd - refL2));
                        pr[r] = (j0 + 4 * g + r < nvalid) ? e : 0.f; lsum += pr[r]; }
                    pb[2 * tl] = cvtpk_bf16(pr[0], pr[1]); pb[2 * tl + 1] = cvtpk_bf16(pr[2], pr[3]);
                }
                LDS_WAIT(); asm volatile("" ::: "memory");
                u32x4 pw4; pw4.x = pb[0]; pw4.y = pb[1]; pw4.z = pb[2]; pw4.w = pb[3];
                const bf16x8 pfrag = __builtin_bit_cast(bf16x8, pw4);
                const LAS unsigned char* trb = stg + (4 * g + (l15 >> 2)) * DSA_KVROW + (4 * (lane & 3)) * 2;
#pragma unroll
                for (int dt = 0; dt < 8; ++dt) {
                    const s16x4 lo = __builtin_bit_cast(s16x4, __builtin_amdgcn_ds_read_tr16_b64_v4i16((LAS v4i16_t*)(trb + dt * 32)));
                    const s16x4 hi = __builtin_bit_cast(s16x4, __builtin_amdgcn_ds_read_tr16_b64_v4i16((LAS v4i16_t*)(trb + 16 * DSA_KVROW + dt * 32)));
                    const bf16x8 af = {lo[0], lo[1], lo[2], lo[3], hi[0], hi[1], hi[2], hi[3]};
                    o[dt] = __builtin_amdgcn_mfma_f32_16x16x32_bf16(af, pfrag, o[dt], 0, 0, 0);
                }
                LDS_WAIT(); asm volatile("" ::: "memory");
            }
            lsum += __shfl_xor(lsum, 16); lsum += __shfl_xor(lsum, 32);
            const float il = 1.f / lsum;
            if (l15 < 8) {
                bf16* orow = MIX + (size_t)(b * SEQ + t) * MIXW + 512 + head * 128 + 4 * g;
#pragma unroll
                for (int dt = 0; dt < 8; ++dt) { u32x2 w; w.x = pk2(o[dt][0] * il, o[dt][1] * il); w.y = pk2(o[dt][2] * il, o[dt][3] * il); *(u32x2*)(orow + 16 * dt) = w; }
            }
        }
        __syncthreads();
    }
}
typedef __attribute__((address_space(1))) float GASF;
__device__ __forceinline__ int crow(int r, int hi) { return (r & 3) + 8 * (r >> 2) + 4 * hi; }
#define KSWZ64(row, cb) ((row) * 128 + ((cb) ^ ((((row) >> 1) & 7) << 4)))
__device__ __forceinline__ int v_st(int k, int c) { const int kk = (k & ~0xC) | ((k & 4) << 1) | ((k & 8) >> 1); return ((kk >> 3) * 4 + (c >> 5)) * 512 + ((kk & 7) * 32 + (c & 31)) * 2; }
__device__ __forceinline__ int v_rd_base(int lane) { return ((lane & 3) << 3) | (((lane >> 2) & 3) << 6) | (((lane >> 4) & 1) << 5) | (((lane >> 5) & 1) << 8); }
constexpr int v_rd_off(int d0, int ks, int half) { return d0 * 512 + ks * 4096 + half * 2048; }
template <int OFF> __device__ __forceinline__ s16x4 tr_read(int vb) {
    s16x4 r; asm volatile("ds_read_b64_tr_b16 %0, %1 offset:%2" : "=&v"(r) : "v"(vb), "i"(OFF) : "memory"); return r;
}
template <int D0> __device__ __forceinline__ void pv_one(f32x16& od, int vb, bf16x8 pa0, bf16x8 pa1, bf16x8 pa2, bf16x8 pa3) {
    const s16x4 l0 = tr_read<v_rd_off(D0, 0, 0)>(vb), h0 = tr_read<v_rd_off(D0, 0, 1)>(vb), l1 = tr_read<v_rd_off(D0, 1, 0)>(vb), h1 = tr_read<v_rd_off(D0, 1, 1)>(vb);
    const s16x4 l2 = tr_read<v_rd_off(D0, 2, 0)>(vb), h2 = tr_read<v_rd_off(D0, 2, 1)>(vb), l3 = tr_read<v_rd_off(D0, 3, 0)>(vb), h3 = tr_read<v_rd_off(D0, 3, 1)>(vb);
    asm volatile("s_waitcnt lgkmcnt(0)" ::: "memory"); __builtin_amdgcn_sched_barrier(0);
#define PK(L, H) (bf16x8){L[0], L[1], L[2], L[3], H[0], H[1], H[2], H[3]}
    od = __builtin_amdgcn_mfma_f32_32x32x16_bf16(pa0, PK(l0, h0), od, 0, 0, 0);
    od = __builtin_amdgcn_mfma_f32_32x32x16_bf16(pa1, PK(l1, h1), od, 0, 0, 0);
    od = __builtin_amdgcn_mfma_f32_32x32x16_bf16(pa2, PK(l2, h2), od, 0, 0, 0);
    od = __builtin_amdgcn_mfma_f32_32x32x16_bf16(pa3, PK(l3, h3), od, 0, 0, 0);
#undef PK
}
constexpr int ATT_LDS = 2 * 16384 + 2 * 8192 + 8 * 256;

__device__ __forceinline__ void ph_attnA(const Params& p, unsigned char* lds, int vb, int nvb) {
    const bf16* PROJ = (const bf16*)(p.ws + WS_PROJ); bf16* MIX = (bf16*)(p.ws + WS_MIX);
    const float* SC = (const float*)(p.ws + WS_SCAL);
    const float lam = SC[SC_LAM], refL2 = SC[SC_MA] * 1.4426950409f;
    constexpr float C = 0.125f * 1.4426950409f;
    int tid = threadIdx.x; asm volatile("" : "+v"(tid)); const int lane = tid & 63, wid = __builtin_amdgcn_readfirstlane(tid >> 6), r32 = lane & 31, hi = lane >> 5;
    unsigned char* V_lds = lds; unsigned char* K_lds = lds + 32768;
    float* wsf = (float*)(lds + 49152) + wid * 64;
    GASF* tmpw = (GASF*)(p.ws + WS_ATMP) + ((size_t)(vb * NWV + wid) * 64) * 64 + lane;
    const int vbase = (int)(uintptr_t)V_lds + v_rd_base(lane);
    const int krow = tid >> 3, kch = tid & 7, kdst = KSWZ64(krow, kch * 16);
    const int sr = tid >> 4, sc = (tid & 15) * 8, vst0 = v_st(sr, sc), vst1 = v_st(32 + sr, sc);
    for (int it = vb; it < 256; it += nvb) {
        const int b = it >> 4, h = (it >> 2) & 3, qbl = it & 3;
        const float slopeL2 = exp2f(-2.0f * (float)(h + 1)) * 1.4426950409f;
        const bf16* Pb = PROJ + (size_t)b * SEQ * NP;
#pragma unroll 1
        for (int half = 0; half < 2; ++half) {
            const int qb = half ? 7 - qbl : qbl, q0 = 256 * qb, NTu = 4 * (qb + 1), cw = 4 * qb + (wid >> 1);
            const int tq = q0 + 32 * wid + r32;
#pragma unroll 1
            for (int mi = 0; mi < 2; ++mi) {
                const int m = 1 - mi;
                const bf16* Kg = Pb + C_KA + h * 128 + m * 64 + (size_t)krow * NP + kch * 8;
                const bf16* Vg = Pb + C_VA + h * 128 + (size_t)sr * NP + sc;
                bf16x8 qr[4];
                { const bf16* qp = Pb + (size_t)tq * NP + C_QA + h * 128 + m * 64 + hi * 8;
#pragma unroll
                  for (int d0 = 0; d0 < 4; ++d0) qr[d0] = *(const bf16x8*)(qp + d0 * 16); }
                f32x16 o[4];
#pragma unroll
                for (int d = 0; d < 4; ++d) o[d] = f32x16{};
                float lsum = 0.f;
                bf16x8 sk, sv0, sv1;
                sk = *(const bf16x8*)Kg; sv0 = *(const bf16x8*)Vg; sv1 = *(const bf16x8*)(Vg + (size_t)32 * NP);
                *(bf16x8*)(K_lds + kdst) = sk; *(bf16x8*)(V_lds + vst0) = sv0; *(bf16x8*)(V_lds + vst1) = sv1;
                __syncthreads();
#pragma unroll 1
                for (int j = 0; j < NTu; ++j) {
                    const int buf = j & 1;
                    if (j + 1 < NTu) { const size_t go = (size_t)(j + 1) * 64 * NP; sk = *(const bf16x8*)(Kg + go); sv0 = *(const bf16x8*)(Vg + go); sv1 = *(const bf16x8*)(Vg + go + (size_t)32 * NP); }
                    if (j <= cw) {
                        const unsigned char* Kb = K_lds + buf * 8192;
                        const float dq = (float)(tq - 64 * j - 4 * hi);
                        const float B0 = -slopeL2 * dq - refL2;
                        const bool past = j < cw;
                        float ps = 0.f;
                        bf16x8 pa0, pa1, pa2, pa3;
#define PK4(P, BASE, OUT) do { unsigned a0 = cvtpk_bf16(P[BASE + 0], P[BASE + 1]), a1 = cvtpk_bf16(P[BASE + 2], P[BASE + 3]);   \
    unsigned b0_ = cvtpk_bf16(P[BASE + 4], P[BASE + 5]), b1_ = cvtpk_bf16(P[BASE + 6], P[BASE + 7]);                              \
    auto r0 = __builtin_amdgcn_permlane32_swap(a0, b0_, false, false); auto r1 = __builtin_amdgcn_permlane32_swap(a1, b1_, false, false); \
    u32x4 w = {r0[0], r1[0], r0[1], r1[1]}; OUT = __builtin_bit_cast(bf16x8, w); } while (0)
#define HALF_TILE(KOFF, FOFF, PA, PB) do { f32x16 pp = f32x16{};                                                                     \
    _Pragma("unroll") for (int d0 = 0; d0 < 4; ++d0) { const int cb = (d0 * 16 + hi * 8) * 2;                                        \
        const bf16x8 bk = *(const bf16x8*)(Kb + KSWZ64((KOFF) + r32, cb)); pp = __builtin_amdgcn_mfma_f32_32x32x16_bf16(bk, qr[d0], pp, 0, 0, 0); } \
    if (past) { _Pragma("unroll") for (int r = 0; r < 16; ++r) { const float off = (float)((r & 3) + 8 * (r >> 2)) + (FOFF);          \
            pp[r] = __builtin_amdgcn_exp2f(fmaf(pp[r], C, fmaf(slopeL2, off, B0))); } }                                               \
    else { _Pragma("unroll") for (int r = 0; r < 16; ++r) { const float off = (float)((r & 3) + 8 * (r >> 2)) + (FOFF);               \
            pp[r] = __builtin_amdgcn_exp2f(fmaf(pp[r], C, -slopeL2 * fabsf(dq - off) - refL2)); } }                                   \
    _Pragma("unroll") for (int r = 0; r < 16; ++r) ps += pp[r];                                                                       \
    PK4(pp, 0, PA); PK4(pp, 8, PB); __builtin_amdgcn_sched_barrier(0); } while (0)
                        HALF_TILE(0, 0.f, pa0, pa1);
                        HALF_TILE(32, 32.f, pa2, pa3);
#undef HALF_TILE
#undef PK4
                        { auto rr = __builtin_amdgcn_permlane32_swap(__float_as_uint(ps), __float_as_uint(ps), false, false);
                          ps = __uint_as_float(rr[0]) + __uint_as_float(rr[1]); }
                        lsum += ps;
                        const int vb0 = vbase + buf * 16384;
                        pv_one<0>(o[0], vb0, pa0, pa1, pa2, pa3); pv_one<1>(o[1], vb0, pa0, pa1, pa2, pa3); pv_one<2>(o[2], vb0, pa0, pa1, pa2, pa3); pv_one<3>(o[3], vb0, pa0, pa1, pa2, pa3);
                    }
                    if (j + 1 < NTu) { const int nb = buf ^ 1;
                        *(bf16x8*)(K_lds + nb * 8192 + kdst) = sk; *(bf16x8*)(V_lds + nb * 16384 + vst0) = sv0; *(bf16x8*)(V_lds + nb * 16384 + vst1) = sv1; }
                    __syncthreads();
                }
                if (hi == 0) wsf[r32] = lsum;
                LDS_WAIT(); asm volatile("" ::: "memory");
                float rli[16];
#pragma unroll
                for (int r = 0; r < 16; ++r) rli[r] = 1.f / wsf[crow(r, hi)];
                LDS_WAIT(); asm volatile("" ::: "memory");
                if (mi == 0) {
#pragma unroll
                    for (int d = 0; d < 4; ++d) { GASF* td = tmpw + d * 1024; asm volatile("" : "+v"(td));
#pragma unroll
                        for (int r = 0; r < 16; ++r) td[r * 64] = o[d][r] * rli[r]; }
                } else {
                    float gsub[4];
#pragma unroll
                    for (int d = 0; d < 4; ++d) gsub[d] = p.a_sub_gain[32 * d + r32];
                    GASF* tdp[4];
#pragma unroll
                    for (int d = 0; d < 4; ++d) { tdp[d] = tmpw + d * 1024; asm volatile("" : "+v"(tdp[d])); }
#pragma unroll
                    for (int r = 0; r < 16; ++r) {
                        float v[4]; float ss = 0.f;
#pragma unroll
                        for (int d = 0; d < 4; ++d) { v[d] = o[d][r] * rli[r] - lam * tdp[d][r * 64]; ss += v[d] * v[d]; }
                        ss += __shfl_xor(ss, 1); ss += __shfl_xor(ss, 2); ss += __shfl_xor(ss, 4); ss += __shfl_xor(ss, 8); ss += __shfl_xor(ss, 16);
                        const float rs = rsqrtf(ss * (1.f / 128.f) + EPS) * 0.8f;
                        bf16* orow = MIX + (size_t)(b * SEQ + q0 + 32 * wid + crow(r, hi)) * MIXW + h * 128 + r32;
#pragma unroll
                        for (int d = 0; d < 4; ++d) orow[32 * d] = (bf16)f2bf(v[d] * rs * gsub[d]);
                        asm volatile("" ::: "memory");
                    }
                }
            }
        }
    }
}
constexpr int RT_WAVE_BYTES = 12288;
constexpr int RT_LDS = 32768 + 8 * RT_WAVE_BYTES;

__device__ __forceinline__ int pl32_sum(int v) { auto rr = __builtin_amdgcn_permlane32_swap((unsigned)v, (unsigned)v, false, false); return (int)(rr[0] + rr[1]); }
__device__ __forceinline__ int pl32_other(int v) { auto rr = __builtin_amdgcn_permlane32_swap((unsigned)v, (unsigned)v, false, false); return (int)(rr[0] + rr[1]) - v; }
__device__ __forceinline__ float unsortkey(unsigned k) { return __uint_as_float((k & 0x80000000u) ? (k ^ 0x80000000u) : ~k); }

template <int N> __device__ __forceinline__ unsigned bisect16(const unsigned (&key)[N]) {
    unsigned prefix = 0u; bool done = false;
#pragma unroll 1
    for (int bit = 31; bit >= 0; --bit) {
        const unsigned cand = done ? prefix : (prefix | (1u << bit));
        int cnt = 0;
#pragma unroll
        for (int i = 0; i < N; ++i) cnt += (key[i] >= cand) ? 1 : 0;
        const int tot = pl32_sum(cnt);
        if (!done && tot >= 16) { prefix = cand; done = (tot == 16); }
        if (__all(done)) break;
    }
    return prefix;
}

__device__ __forceinline__ void ph_route(const Params& p, unsigned char* lds, int vb, int nvb) {
    const bf16* Q3 = (const bf16*)(p.ws + WS_Q3); const bf16* SUBK = (const bf16*)(p.ws + WS_SUBK);
    int* EXPI = (int*)(p.ws + WS_EXP); float* GATE = (float*)(p.ws + WS_GATE);
    int tid = threadIdx.x; asm volatile("" : "+v"(tid));
    const int lane = tid & 63, wv = __builtin_amdgcn_readfirstlane(tid >> 6), r32 = lane & 31, hi = lane >> 5;
    for (int i = tid; i < 2048; i += NT) ((u32x4*)lds)[i] = ((const u32x4*)SUBK)[i];
    __syncthreads();
    unsigned char* wl = lds + 32768 + wv * RT_WAVE_BYTES;
    float* sv = (float*)wl; int* si = (int*)(wl + 4096); float* fv = (float*)(wl + 8192); int* fe = (int*)(wl + 10240);
    const int gw = vb * NWV + wv, ngw = nvb * NWV;
    for (int item = gw; item < (T / 32) * 8; item += ngw) {
        const int h = item & 7, tok0 = (item >> 3) * 32;
        const bf16* qrow = Q3 + (size_t)(tok0 + r32) * 1024 + h * 128 + hi * 8;
#pragma unroll 1
        for (int c = 0; c < 2; ++c) {
            bf16x8 bq[4];
#pragma unroll
            for (int d0 = 0; d0 < 4; ++d0) bq[d0] = *(const bf16x8*)(qrow + c * 64 + d0 * 16);
            unsigned key[64];
#pragma unroll
            for (int nt = 0; nt < 4; ++nt) {
                f32x16 acc = f32x16{};
                const unsigned char* kp = lds + ((c * 128 + nt * 32 + r32) * 64 + hi * 8) * 2;
#pragma unroll
                for (int d0 = 0; d0 < 4; ++d0) { const bf16x8 ak = *(const bf16x8*)(kp + d0 * 32); acc = __builtin_amdgcn_mfma_f32_32x32x16_bf16(ak, bq[d0], acc, 0, 0, 0); }
#pragma unroll
                for (int r = 0; r < 16; ++r) key[nt * 16 + r] = sortkey(acc[r]);
            }
            const unsigned thr = bisect16<64>(key);
            int cnt = 0;
#pragma unroll
            for (int i = 0; i < 64; ++i) cnt += (key[i] >= thr) ? 1 : 0;
            const int other_ = pl32_other(cnt); int slot = hi ? other_ : 0;
            float* svp = sv + (r32 * 2 + c) * 16; int* sip = si + (r32 * 2 + c) * 16;
#pragma unroll
            for (int i = 0; i < 64; ++i) {
                if (key[i] >= thr && slot < 16) { svp[slot] = unsortkey(key[i]); sip[slot] = 32 * (i >> 4) + ((i & 3) + 8 * ((i & 15) >> 2)) + 4 * hi; ++slot; }
            }
        }
        LDS_WAIT(); asm volatile("" ::: "memory");
        {
            const float* s0 = sv + (r32 * 2) * 16 + 8 * hi; const float* s1 = sv + (r32 * 2 + 1) * 16;
            float a0[8], a1[16];
#pragma unroll
            for (int i = 0; i < 8; ++i) a0[i] = s0[i];
#pragma unroll
            for (int j = 0; j < 16; ++j) a1[j] = s1[j];
            unsigned key[128];
#pragma unroll
            for (int i = 0; i < 8; ++i)
#pragma unroll
                for (int j = 0; j < 16; ++j) key[i * 16 + j] = sortkey(a0[i] + a1[j]);
            const unsigned thr = bisect16<128>(key);
            int cnt = 0;
#pragma unroll
            for (int i = 0; i < 128; ++i) cnt += (key[i] >= thr) ? 1 : 0;
            const int other_ = pl32_other(cnt); int slot = hi ? other_ : 0;
            const int* i0 = si + (r32 * 2) * 16 + 8 * hi; const int* i1 = si + (r32 * 2 + 1) * 16;
            float* fvp = fv + r32 * 16; int* fep = fe + r32 * 16;
#pragma unroll
            for (int i = 0; i < 128; ++i) {
                if (key[i] >= thr && slot < 16) { fvp[slot] = unsortkey(key[i]); fep[slot] = i0[i >> 4] * 128 + i1[i & 15]; ++slot; }
            }
        }
        LDS_WAIT(); asm volatile("" ::: "memory");
        {
            const float* fvp = fv + r32 * 16;
            float v[16]; float mx = -3e38f;
#pragma unroll
            for (int k = 0; k < 16; ++k) { v[k] = fvp[k]; mx = fmaxf(mx, v[k]); }
            float l = 0.f;
#pragma unroll
            for (int k = 0; k < 16; ++k) { v[k] = __expf(v[k] - mx); l += v[k]; }
            const float il = 1.f / l;
            const size_t ob = (size_t)(tok0 + r32) * 128 + h * 16 + 8 * hi;
            const int* fep = fe + r32 * 16 + 8 * hi;
            f32x4 g0, g1; u32x4 e0, e1;
            if (hi == 0) { g0 = (f32x4){v[0] * il, v[1] * il, v[2] * il, v[3] * il}; g1 = (f32x4){v[4] * il, v[5] * il, v[6] * il, v[7] * il}; }
            else { g0 = (f32x4){v[8] * il, v[9] * il, v[10] * il, v[11] * il}; g1 = (f32x4){v[12] * il, v[13] * il, v[14] * il, v[15] * il}; }
            e0 = *(const u32x4*)fep; e1 = *(const u32x4*)(fep + 4);
            *(f32x4*)(GATE + ob) = g0; *(f32x4*)(GATE + ob + 4) = g1;
            *(u32x4*)(EXPI + ob) = e0; *(u32x4*)(EXPI + ob + 4) = e1;
        }
        LDS_WAIT(); asm volatile("" ::: "memory");
    }
    __syncthreads();
}
constexpr int PU_UNITS = T / 64;
constexpr int CW_PEER_U = 4096, CW_PEER_V = 4096 + 16 * 64;

__device__ __forceinline__ unsigned peer_xcc() { return (unsigned)__builtin_amdgcn_s_getreg((3 << 11) | 20) & 7u; }

__device__ __forceinline__ void ph_peer_u(const Params& p, unsigned char* lds, int cwbase) {
    const bf16* H = (const bf16*)(p.ws + WS_H); const bf16* U16 = (const bf16*)(p.ws + WS_U16);
    const int* EXPI = (const int*)(p.ws + WS_EXP); const float* GATE = (const float*)(p.ws + WS_GATE); float* CBUF = (float*)(p.ws + WS_CBUF);
    unsigned* ctl = (unsigned*)(p.ws + WS_CTL);
    int tid = threadIdx.x; asm volatile("" : "+v"(tid));
    const int lane = tid & 63, wv = __builtin_amdgcn_readfirstlane(tid >> 6), g = lane >> 4, i = lane & 15;
    volatile LAS unsigned* slot = (volatile LAS unsigned*)(LAS unsigned char*)lds;
    int* le = (int*)(lds + 1024 + wv * 1024); int* lj = le + 128;
    const unsigned xcc = peer_xcc();
#pragma unroll 1
    for (int k = 0; k < 16; ++k) {
        const int part = (int)((2u * xcc + (unsigned)k) & 15u);
#pragma unroll 1
        for (;;) {
            if (tid == 0) *slot = __hip_atomic_fetch_add(ctl + cwbase + 64 * part, 1u, __ATOMIC_RELAXED, __HIP_MEMORY_SCOPE_AGENT);
            __syncthreads();
            const unsigned unit = *slot;
            __syncthreads();
            if (unit >= (unsigned)PU_UNITS) break;
#pragma unroll 1
            for (int tt = 0; tt < 8; ++tt) {
                const int t = (int)unit * 64 + wv * 8 + tt;
                const int e0 = EXPI[(size_t)t * 128 + lane], e1 = EXPI[(size_t)t * 128 + 64 + lane];
                const bool in0 = (e0 >> 10) == part, in1 = (e1 >> 10) == part;
                const unsigned long long m0 = __ballot(in0), m1 = __ballot(in1);
                const int n0 = __popcll(m0), n = n0 + __popcll(m1);
                if (n == 0) continue;
                if (in0) { const int pos = (int)__builtin_amdgcn_mbcnt_hi((unsigned)(m0 >> 32), __builtin_amdgcn_mbcnt_lo((unsigned)m0, 0u)); le[pos] = e0; lj[pos] = lane; }
                if (in1) { const int pos = n0 + (int)__builtin_amdgcn_mbcnt_hi((unsigned)(m1 >> 32), __builtin_amdgcn_mbcnt_lo((unsigned)m1, 0u)); le[pos] = e1; lj[pos] = 64 + lane; }
                u32x4 xr[8];
                { const u32x4* xrow = (const u32x4*)(H + (size_t)t * 1024) + i;
#pragma unroll
                  for (int q = 0; q < 8; ++q) xr[q] = xrow[16 * q]; }
                LDS_WAIT(); asm volatile("" ::: "memory");
#pragma unroll 1
                for (int s = 0; 4 * s < n; ++s) {
                    const int idx = 4 * s + g; const bool valid = idx < n;
                    const int e = le[valid ? idx : 0];
                    const u32x4* ur = (const u32x4*)(U16 + (size_t)e * 1024) + i;
                    u32x4 ua[8];
#pragma unroll
                    for (int q = 0; q < 8; ++q) ua[q] = ur[16 * q];
                    float a0 = 0.f, a1 = 0.f, a2 = 0.f, a3 = 0.f;
#pragma unroll
                    for (int q = 0; q < 8; ++q) { a0 = dot2bf(ua[q].x, xr[q].x, a0); a1 = dot2bf(ua[q].y, xr[q].y, a1); a2 = dot2bf(ua[q].z, xr[q].z, a2); a3 = dot2bf(ua[q].w, xr[q].w, a3); }
                    const float a = row16_sum((a0 + a1) + (a2 + a3));
                    if (i == 0 && valid) { const size_t gi = (size_t)t * 128 + lj[idx]; __hip_atomic_store(CBUF + gi, gelu_erf(a) * GATE[gi], __ATOMIC_RELAXED, __HIP_MEMORY_SCOPE_AGENT); }
                }
                LDS_WAIT(); asm volatile("" ::: "memory");
            }
        }
    }
}

__device__ __forceinline__ void ph_peer_v(const Params& p, unsigned char* lds) {
    const bf16* V16 = (const bf16*)(p.ws + WS_V16);
    const int* EXPI = (const int*)(p.ws + WS_EXP); const float* GATE = (const float*)(p.ws + WS_CBUF); const float* MOD = (const float*)(p.ws + WS_MOD);
    unsigned* ctl = (unsigned*)(p.ws + WS_CTL);
    int tid = threadIdx.x; asm volatile("" : "+v"(tid));
    const int lane = tid & 63, wv = __builtin_amdgcn_readfirstlane(tid >> 6), g8 = lane >> 3, i8 = lane & 7;
    volatile LAS unsigned* slot = (volatile LAS unsigned*)(LAS unsigned char*)lds;
    int* le = (int*)(lds + 1024 + wv * 1024); float* lc = (float*)(le + 128);
    const unsigned xcc = peer_xcc();
#pragma unroll 1
    for (int k = 0; k < 16; ++k) {
        const int sl = (int)((2u * xcc + (unsigned)k) & 15u);
#pragma unroll 1
        for (;;) {
            if (tid == 0) *slot = __hip_atomic_fetch_add(ctl + CW_PEER_V + 64 * sl, 1u, __ATOMIC_RELAXED, __HIP_MEMORY_SCOPE_AGENT);
            __syncthreads();
            const unsigned unit = *slot;
            __syncthreads();
            if (unit >= (unsigned)PU_UNITS) break;
#pragma unroll 1
            for (int tt = 0; tt < 8; ++tt) {
                const int t = (int)unit * 64 + wv * 8 + tt;
                le[lane] = EXPI[(size_t)t * 128 + lane]; le[64 + lane] = EXPI[(size_t)t * 128 + 64 + lane];
                lc[lane] = GATE[(size_t)t * 128 + lane]; lc[64 + lane] = GATE[(size_t)t * 128 + 64 + lane];
                LDS_WAIT(); asm volatile("" ::: "memory");
                float acc[8];
#pragma unroll
                for (int q = 0; q < 8; ++q) acc[q] = 0.f;
                const bf16* vcol = V16 + 64 * sl + 8 * i8;
#pragma unroll
                for (int kk = 0; kk < 8; ++kk) {
                    const int ja = 8 * kk + g8, jb = 64 + 8 * kk + g8;
                    const u32x4 A = *(const u32x4*)(vcol + (size_t)le[ja] * 1024), B = *(const u32x4*)(vcol + (size_t)le[jb] * 1024);
                    const unsigned cp = pk2(lc[ja], lc[jb]);
                    acc[0] = dot2bf(__builtin_amdgcn_perm(B.x, A.x, 0x05040100u), cp, acc[0]); acc[1] = dot2bf(__builtin_amdgcn_perm(B.x, A.x, 0x07060302u), cp, acc[1]);
                    acc[2] = dot2bf(__builtin_amdgcn_perm(B.y, A.y, 0x05040100u), cp, acc[2]); acc[3] = dot2bf(__builtin_amdgcn_perm(B.y, A.y, 0x07060302u), cp, acc[3]);
                    acc[4] = dot2bf(__builtin_amdgcn_perm(B.z, A.z, 0x05040100u), cp, acc[4]); acc[5] = dot2bf(__builtin_amdgcn_perm(B.z, A.z, 0x07060302u), cp, acc[5]);
                    acc[6] = dot2bf(__builtin_amdgcn_perm(B.w, A.w, 0x05040100u), cp, acc[6]); acc[7] = dot2bf(__builtin_amdgcn_perm(B.w, A.w, 0x07060302u), cp, acc[7]);
                }
#pragma unroll
                for (int q = 0; q < 8; ++q) { acc[q] += dpp_f<0x128>(acc[q]); acc[q] += __shfl_xor(acc[q], 16); acc[q] += __shfl_xor(acc[q], 32); }
                if (g8 == 0) {
                    const int col = 64 * sl + 8 * i8;
                    const float* g2 = MOD + (size_t)(t >> 11) * 6144 + 5120 + col;
                    float* orow = p.out + (size_t)t * 1024 + col;
                    const f32x4 x0 = *(const f32x4*)orow, x1v = *(const f32x4*)(orow + 4), h0 = *(const f32x4*)g2, h1 = *(const f32x4*)(g2 + 4);
                    f32x4 r0, r1; r0.x = acc[0]; r0.y = acc[1]; r0.z = acc[2]; r0.w = acc[3]; r1.x = acc[4]; r1.y = acc[5]; r1.z = acc[6]; r1.w = acc[7];
                    *(f32x4*)orow = x0 + h0 * r0; *(f32x4*)(orow + 4) = x1v + h1 * r1;
                }
                LDS_WAIT(); asm volatile("" ::: "memory");
            }
        }
    }
}
typedef float f32x2_t __attribute__((ext_vector_type(2)));
constexpr int P8_UNITS = T / 64;
constexpr int CW_P8_U = 4096, CW_P8_V = 4096 + 8 * 64;
constexpr float U8_SCALE = 32.0f;

__device__ __forceinline__ void ph_peer_u8(const Params& p, unsigned char* lds) {
    const bf16* H = (const bf16*)(p.ws + WS_H); const unsigned char* U8 = (const unsigned char*)(p.ws + WS_U16);
    const int* EXPI = (const int*)(p.ws + WS_EXP); const float* GATE = (const float*)(p.ws + WS_GATE); float* CBUF = (float*)(p.ws + WS_CBUF);
    unsigned* ctl = (unsigned*)(p.ws + WS_CTL);
    int tid = threadIdx.x; asm volatile("" : "+v"(tid));
    const int lane = tid & 63, wv = __builtin_amdgcn_readfirstlane(tid >> 6), g = lane >> 4, i = lane & 15;
    volatile LAS unsigned* slot = (volatile LAS unsigned*)(LAS unsigned char*)lds;
    int* le = (int*)(lds + 1024 + wv * 2048); int* lj = le + 128; float* lg = (float*)(le + 256);
    const unsigned xcc = peer_xcc();
#pragma unroll 1
    for (int k = 0; k < 8; ++k) {
        const int part = (int)((xcc + (unsigned)k) & 7u);
#pragma unroll 1
        for (;;) {
            if (tid == 0) *slot = __hip_atomic_fetch_add(ctl + CW_P8_U + 64 * part, 1u, __ATOMIC_RELAXED, __HIP_MEMORY_SCOPE_AGENT);
            __syncthreads();
            const unsigned unit = *slot;
            __syncthreads();
            if (unit >= (unsigned)P8_UNITS) break;
            const int tbase = (int)unit * 64 + wv * 8;
            int ne0 = EXPI[(size_t)tbase * 128 + lane], ne1 = EXPI[(size_t)tbase * 128 + 64 + lane];
            float ng0 = GATE[(size_t)tbase * 128 + lane], ng1 = GATE[(size_t)tbase * 128 + 64 + lane];
            u32x4 nx[8];
            { const u32x4* xrow = (const u32x4*)(H + (size_t)tbase * 1024) + 2 * i;
#pragma unroll
              for (int q = 0; q < 4; ++q) { nx[2 * q] = xrow[32 * q]; nx[2 * q + 1] = xrow[32 * q + 1]; } }
#pragma unroll 1
            for (int tt = 0; tt < 8; ++tt) {
                const int t = tbase + tt;
                const int e0 = ne0, e1 = ne1; const float g0 = ng0, g1 = ng1;
                float xf[64];
#pragma unroll
                for (int q = 0; q < 8; ++q) { xf[8 * q] = bflo(nx[q].x); xf[8 * q + 1] = bfhi(nx[q].x); xf[8 * q + 2] = bflo(nx[q].y); xf[8 * q + 3] = bfhi(nx[q].y);
                    xf[8 * q + 4] = bflo(nx[q].z); xf[8 * q + 5] = bfhi(nx[q].z); xf[8 * q + 6] = bflo(nx[q].w); xf[8 * q + 7] = bfhi(nx[q].w); }
                if (tt + 1 < 8) { const size_t tn = (size_t)(t + 1);
                    ne0 = EXPI[tn * 128 + lane]; ne1 = EXPI[tn * 128 + 64 + lane]; ng0 = GATE[tn * 128 + lane]; ng1 = GATE[tn * 128 + 64 + lane];
                    const u32x4* xrow = (const u32x4*)(H + tn * 1024) + 2 * i;
#pragma unroll
                    for (int q = 0; q < 4; ++q) { nx[2 * q] = xrow[32 * q]; nx[2 * q + 1] = xrow[32 * q + 1]; } }
                const bool in0 = (e0 >> 11) == part, in1 = (e1 >> 11) == part;
                const unsigned long long m0 = __ballot(in0), m1 = __ballot(in1);
                const int n0 = __popcll(m0), n = n0 + __popcll(m1);
                if (in0) { const int pos = (int)__builtin_amdgcn_mbcnt_hi((unsigned)(m0 >> 32), __builtin_amdgcn_mbcnt_lo((unsigned)m0, 0u)); le[pos] = e0; lj[pos] = lane; lg[pos] = g0; }
                if (in1) { const int pos = n0 + (int)__builtin_amdgcn_mbcnt_hi((unsigned)(m1 >> 32), __builtin_amdgcn_mbcnt_lo((unsigned)m1, 0u)); le[pos] = e1; lj[pos] = 64 + lane; lg[pos] = g1; }
                LDS_WAIT(); asm volatile("" ::: "memory");
#pragma unroll 1
                for (int s = 0; 4 * s < n; s += 2) {
                    const int idxA = 4 * s + g, idxB = idxA + 4; const bool vA = idxA < n, vB = idxB < n;
                    const u32x4* ra = (const u32x4*)(U8 + (size_t)le[vA ? idxA : 0] * 1024) + i;
                    const u32x4* rb = (const u32x4*)(U8 + (size_t)le[vB ? idxB : 0] * 1024) + i;
                    u32x4 A[4], B[4];
#pragma unroll
                    for (int q = 0; q < 4; ++q) A[q] = ra[16 * q];
#pragma unroll
                    for (int q = 0; q < 4; ++q) B[q] = rb[16 * q];
#define P8_DOT(R, OUT) do { float a0 = 0.f, a1 = 0.f, a2 = 0.f, a3 = 0.f;                                                           \
    _Pragma("unroll") for (int q = 0; q < 4; ++q) {                                                                                   \
        const unsigned w_[4] = {R[q].x, R[q].y, R[q].z, R[q].w};                                                                      \
        _Pragma("unroll") for (int c = 0; c < 4; ++c) { const f32x2_t lo = __builtin_amdgcn_cvt_pk_f32_fp8((int)w_[c], false), hi = __builtin_amdgcn_cvt_pk_f32_fp8((int)w_[c], true); \
            a0 = fmaf(lo.x, xf[16 * q + 4 * c], a0); a1 = fmaf(lo.y, xf[16 * q + 4 * c + 1], a1); a2 = fmaf(hi.x, xf[16 * q + 4 * c + 2], a2); a3 = fmaf(hi.y, xf[16 * q + 4 * c + 3], a3); } } \
    OUT = row16_sum((a0 + a1) + (a2 + a3)) * (1.0f / U8_SCALE); } while (0)
                    float aA, aB;
                    P8_DOT(A, aA); P8_DOT(B, aB);
#undef P8_DOT
                    if (i == 0 && vA) __hip_atomic_store(CBUF + (size_t)t * 128 + lj[idxA], gelu_erf(aA) * lg[idxA], __ATOMIC_RELAXED, __HIP_MEMORY_SCOPE_AGENT);
                    if (i == 0 && vB) __hip_atomic_store(CBUF + (size_t)t * 128 + lj[idxB], gelu_erf(aB) * lg[idxB], __ATOMIC_RELAXED, __HIP_MEMORY_SCOPE_AGENT);
                }
                LDS_WAIT(); asm volatile("" ::: "memory");
            }
        }
    }
}

__device__ __forceinline__ void ph_peer_v8(const Params& p, unsigned char* lds) {
    const unsigned char* V8 = (const unsigned char*)(p.ws + WS_V16);
    const int* EXPI = (const int*)(p.ws + WS_EXP); const float* CBUF = (const float*)(p.ws + WS_CBUF); const float* MOD = (const float*)(p.ws + WS_MOD);
    unsigned* ctl = (unsigned*)(p.ws + WS_CTL);
    int tid = threadIdx.x; asm volatile("" : "+v"(tid));
    const int lane = tid & 63, wv = __builtin_amdgcn_readfirstlane(tid >> 6), g8 = lane >> 3, i8 = lane & 7;
    volatile LAS unsigned* slot = (volatile LAS unsigned*)(LAS unsigned char*)lds;
    int* le = (int*)(lds + 1024 + wv * 2048); float* lc = (float*)(le + 128);
    const unsigned xcc = peer_xcc();
#pragma unroll 1
    for (int k = 0; k < 8; ++k) {
        const int sl = (int)((xcc + (unsigned)k) & 7u);
#pragma unroll 1
        for (;;) {
            if (tid == 0) *slot = __hip_atomic_fetch_add(ctl + CW_P8_V + 64 * sl, 1u, __ATOMIC_RELAXED, __HIP_MEMORY_SCOPE_AGENT);
            __syncthreads();
            const unsigned unit = *slot;
            __syncthreads();
            if (unit >= (unsigned)P8_UNITS) break;
            const int tbase = (int)unit * 64 + wv * 8;
            int ne0 = EXPI[(size_t)tbase * 128 + lane], ne1 = EXPI[(size_t)tbase * 128 + 64 + lane];
            float nc0 = CBUF[(size_t)tbase * 128 + lane], nc1 = CBUF[(size_t)tbase * 128 + 64 + lane];
#pragma unroll 1
            for (int tt = 0; tt < 8; ++tt) {
                const int t = tbase + tt;
                le[lane] = ne0; le[64 + lane] = ne1; lc[lane] = nc0; lc[64 + lane] = nc1;
                if (tt + 1 < 8) { const size_t tn = (size_t)(t + 1); ne0 = EXPI[tn * 128 + lane]; ne1 = EXPI[tn * 128 + 64 + lane]; nc0 = CBUF[tn * 128 + lane]; nc1 = CBUF[tn * 128 + 64 + lane]; }
                LDS_WAIT(); asm volatile("" ::: "memory");
                const unsigned char* vcol = V8 + 128 * sl + 16 * i8;
                u32x4 R[16];
#pragma unroll
                for (int kk = 0; kk < 16; ++kk) R[kk] = *(const u32x4*)(vcol + (size_t)le[8 * kk + g8] * 1024);
                float acc[16];
#pragma unroll
                for (int q = 0; q < 16; ++q) acc[q] = 0.f;
#pragma unroll
                for (int kk = 0; kk < 16; ++kk) {
                    const float cj = lc[8 * kk + g8];
                    const unsigned w_[4] = {R[kk].x, R[kk].y, R[kk].z, R[kk].w};
#pragma unroll
                    for (int c = 0; c < 4; ++c) { const f32x2_t lo = __builtin_amdgcn_cvt_pk_f32_fp8((int)w_[c], false), hi = __builtin_amdgcn_cvt_pk_f32_fp8((int)w_[c], true);
                        acc[4 * c] = fmaf(cj, lo.x, acc[4 * c]); acc[4 * c + 1] = fmaf(cj, lo.y, acc[4 * c + 1]); acc[4 * c + 2] = fmaf(cj, hi.x, acc[4 * c + 2]); acc[4 * c + 3] = fmaf(cj, hi.y, acc[4 * c + 3]); }
                }
#pragma unroll
                for (int q = 0; q < 16; ++q) { acc[q] += dpp_f<0x128>(acc[q]); acc[q] += __shfl_xor(acc[q], 16); acc[q] += __shfl_xor(acc[q], 32); }
                if (g8 == 0) {
                    const int col = 128 * sl + 16 * i8;
                    const float* g2 = MOD + (size_t)(t >> 11) * 6144 + 5120 + col;
                    float* orow = p.out + (size_t)t * 1024 + col;
#pragma unroll
                    for (int q = 0; q < 4; ++q) { const f32x4 xv = *(const f32x4*)(orow + 4 * q), hv = *(const f32x4*)(g2 + 4 * q);
                        f32x4 r; r.x = acc[4 * q]; r.y = acc[4 * q + 1]; r.z = acc[4 * q + 2]; r.w = acc[4 * q + 3];
                        *(f32x4*)(orow + 4 * q) = xv + hv * r; }
                }
                LDS_WAIT(); asm volatile("" ::: "memory");
            }
        }
    }
}
#define XB_TMO      128
#define XB_XCNT(j)  (256  + 64 * (j))
#define XB_XSUB(j)  (1280 + 64 * (j))
#define XB_XGEN(j)  (2304 + 64 * (j))
#define XB_TOP      3328
#define XB_TOPGEN   3392
#define XCD_BAR_WORDS 3456
#define XB_SPIN_CAP (1u << 18)

__device__ __forceinline__ unsigned xb_ld(unsigned* p)              { return __hip_atomic_load(p, __ATOMIC_RELAXED, __HIP_MEMORY_SCOPE_AGENT); }
__device__ __forceinline__ unsigned xb_add(unsigned* p, unsigned v) { return __hip_atomic_fetch_add(p, v, __ATOMIC_RELAXED, __HIP_MEMORY_SCOPE_AGENT); }
__device__ __forceinline__ unsigned xb_xcc_id() { return (unsigned)__builtin_amdgcn_s_getreg((3 << 11) | 20) & 0xFu; }
#define XB_SPIN(cond, bar) do { unsigned _sp = 0; while (cond) { __builtin_amdgcn_s_sleep(1); \
    if ((++_sp & 255u) == 0u) { if (xb_ld(&(bar)[XB_TMO])) break; if (_sp > XB_SPIN_CAP) { atomicAdd(&(bar)[XB_TMO], 1u); break; } } } } while (0)

struct XcdBarrier {
    unsigned* bar; unsigned x;
    volatile LAS unsigned* st;
};

__device__ __forceinline__ XcdBarrier xcd_barrier_post(unsigned* bar, volatile LAS unsigned* st) {
    XcdBarrier b; b.bar = bar; b.x = xb_xcc_id(); b.st = st;
    if (threadIdx.x == 0) (void)xb_add(&bar[XB_XCNT(b.x)], 1u);
    return b;
}
__device__ __forceinline__ void xcd_barrier_complete(unsigned* bar, unsigned x, unsigned& nloc, unsigned& nx) {
    const unsigned G = gridDim.x * gridDim.y * gridDim.z;
    unsigned sum, cnt, mine, sp = 0u;
    for (;;) {
        sum = 0u; cnt = 0u; mine = 0u;
#pragma unroll
        for (unsigned j = 0; j < 16; ++j) { const unsigned c = xb_ld(&bar[XB_XCNT(j)]); sum += c; cnt += (c > 0u) ? 1u : 0u; mine = (j == x) ? c : mine; }
        if (sum == G) break;
        __builtin_amdgcn_s_sleep(1);
        if ((++sp & 255u) == 0u) { if (xb_ld(&bar[XB_TMO])) break; if (sp > XB_SPIN_CAP) { atomicAdd(&bar[XB_TMO], 1u); break; } }
    }
    nloc = mine > 0u ? mine : 1u; nx = cnt > 0u ? cnt : 1u;
}

__device__ __forceinline__ void xcd_barrier(const XcdBarrier& b) {
    asm volatile("s_waitcnt vmcnt(0)" ::: "memory");
    __syncthreads();
    if (threadIdx.x == 0) {
        unsigned* bar = b.bar;
        __builtin_amdgcn_s_waitcnt(0);
        unsigned nloc = b.st[0], nx = b.st[1];
        if (nloc == 0u) { xcd_barrier_complete(bar, b.x, nloc, nx); b.st[0] = nloc; b.st[1] = nx; }
        const unsigned old = xb_add(&bar[XB_XSUB(b.x)], 1u);
        const unsigned gen = old / nloc;
        if (old + 1u == (gen + 1u) * nloc) {
            __builtin_amdgcn_fence(__ATOMIC_RELEASE, "agent");
            asm volatile("s_waitcnt vmcnt(0)" ::: "memory");
            const unsigned og = xb_add(&bar[XB_TOP], 1u);
            const unsigned tg = og / nx;
            if (og + 1u == (tg + 1u) * nx) xb_add(&bar[XB_TOPGEN], 1u);
            else XB_SPIN(xb_ld(&bar[XB_TOPGEN]) == tg, bar);
            __builtin_amdgcn_fence(__ATOMIC_ACQUIRE, "agent");
            xb_add(&bar[XB_XGEN(b.x)], 1u);
            asm volatile("s_waitcnt vmcnt(0)" ::: "memory");
        } else {
            XB_SPIN(xb_ld(&bar[XB_XGEN(b.x)]) == gen, bar);
            __builtin_amdgcn_fence(__ATOMIC_ACQUIRE, "agent");
            asm volatile("s_waitcnt vmcnt(0)" ::: "memory");
        }
    }
    __syncthreads();
}

#ifndef PROBE_DUP
#define PROBE_DUP 0
#endif
constexpr int LDS_BYTES = 147456;
extern __shared__ __attribute__((aligned(16))) unsigned char dyn_lds[];

__global__ void __launch_bounds__(NT, 2) mega_fwd(Params p) {
    cg::grid_group grid = cg::this_grid();
    const int vb = blockIdx.x, nvb = gridDim.x, ngw = nvb * NWV;
    volatile LAS unsigned* xst = (volatile LAS unsigned*)((LAS unsigned char*)dyn_lds + (LDS_BYTES - 16));
    if (threadIdx.x < 4) xst[threadIdx.x] = 0u;
    __syncthreads();
    const XcdBarrier xbar = xcd_barrier_post((unsigned*)(p.ws + WS_CTL), xst);
#define TID_LAUNDER int tid_ = threadIdx.x; asm volatile("" : "+v"(tid_)); const int lane = tid_ & 63, wv = tid_ >> 6, gw = vb * NWV + wv; (void)lane; (void)gw;
    ph_mod(p, (float*)dyn_lds, vb, nvb);
    { TID_LAUNDER ph_prep_weights(p, (LAS float*)dyn_lds + wv * (64 * 33), gw, ngw, lane); }
#if PROBE_DUP == 7
    __syncthreads();
    ph_mod(p, (float*)dyn_lds, vb, nvb);
    { TID_LAUNDER ph_prep_weights(p, (LAS float*)dyn_lds + wv * (64 * 33), gw, ngw, lane); }
#endif
    grid.sync();
    { TID_LAUNDER ph_hrows(p, p.x, p.norm1_g, 0, 1024, gw, ngw, lane); }
    xcd_barrier(xbar);
    {   pg8::Gemm g{(const bf16*)(p.ws + WS_H), (const bf16*)(p.ws + WS_WIN), T, NP, 1024}; pg8::StaticOrder S; S.init(T, NP, nvb, vb);
        pg8::EpiBf16<0> E{(bf16*)(p.ws + WS_PROJ), NP, nullptr, 0, 0, 1.f};
        pg8::gemm_phase<pg8::EpiBf16<0>, pg8::StaticOrder, true, true>((LAS unsigned char*)dyn_lds, g, S, E); }
#if PROBE_DUP == 6
    {   pg8::Gemm g{(const bf16*)(p.ws + WS_H), (const bf16*)(p.ws + WS_WIN), T, NP, 1024}; pg8::StaticOrder S; S.init(T, NP, nvb, vb);
        pg8::EpiBf16<0> E{(bf16*)(p.ws + WS_PROJ), NP, nullptr, 0, 0, 1.f};
        pg8::gemm_phase<pg8::EpiBf16<0>, pg8::StaticOrder, true, true>((LAS unsigned char*)dyn_lds, g, S, E); }
#endif
    xcd_barrier(xbar);
    { TID_LAUNDER ph_norm_proj(p, gw, ngw, lane); }
    xcd_barrier(xbar);
    ph_attnA(p, dyn_lds, vb, nvb);
#if PROBE_DUP == 1
    __syncthreads(); ph_attnA(p, dyn_lds, vb, nvb);
#endif
    __syncthreads();
    ph_dsa(p, dyn_lds, vb, nvb);
#if PROBE_DUP == 2
    __syncthreads(); ph_dsa(p, dyn_lds, vb, nvb);
#endif
    xcd_barrier(xbar);
    {   pg8::Gemm g{(const bf16*)(p.ws + WS_MIX), (const bf16*)(p.ws + WS_WO2), T, 1024, MIXW}; pg8::StaticOrder S; S.init(T, 1024, nvb, vb);
        EpiResGate E{p.x, p.out, (const float*)(p.ws + WS_MOD) + 2048};
        pg8::gemm_phase<EpiResGate, pg8::StaticOrder, true, true>((LAS unsigned char*)dyn_lds, g, S, E); }
#if PROBE_DUP == 8
    {   pg8::Gemm g{(const bf16*)(p.ws + WS_MIX), (const bf16*)(p.ws + WS_WO2), T, 1024, MIXW}; pg8::StaticOrder S; S.init(T, 1024, nvb, vb);
        EpiResGate E{p.x, p.out, (const float*)(p.ws + WS_MOD) + 2048};
        pg8::gemm_phase<EpiResGate, pg8::StaticOrder, true, true>((LAS unsigned char*)dyn_lds, g, S, E); }
#endif
    xcd_barrier(xbar);
    { TID_LAUNDER ph_hrows(p, p.out, p.norm2_g, 3072, 4096, gw, ngw, lane); }
    xcd_barrier(xbar);
    {   pg8::Gemm g{(const bf16*)(p.ws + WS_H), (const bf16*)(p.ws + WS_WQ), T, 1024, 1024}; pg8::StaticOrder S; S.init(T, 1024, nvb, vb);
        pg8::EpiBf16<0> E{(bf16*)(p.ws + WS_Q3), 1024, nullptr, 0, 0, 1.f};
        pg8::gemm_phase<pg8::EpiBf16<0>, pg8::StaticOrder, true, true>((LAS unsigned char*)dyn_lds, g, S, E); }
#if PROBE_DUP == 8
    {   pg8::Gemm g{(const bf16*)(p.ws + WS_H), (const bf16*)(p.ws + WS_WQ), T, 1024, 1024}; pg8::StaticOrder S; S.init(T, 1024, nvb, vb);
        pg8::EpiBf16<0> E{(bf16*)(p.ws + WS_Q3), 1024, nullptr, 0, 0, 1.f};
        pg8::gemm_phase<pg8::EpiBf16<0>, pg8::StaticOrder, true, true>((LAS unsigned char*)dyn_lds, g, S, E); }
#endif
    xcd_barrier(xbar);
    ph_route(p, dyn_lds, vb, nvb);
#if PROBE_DUP == 3
    __syncthreads(); ph_route(p, dyn_lds, vb, nvb);
#endif
    xcd_barrier(xbar);
ph_peer_u8(p, dyn_lds);
    xcd_barrier(xbar);
    ph_peer_v8(p, dyn_lds);
}

extern "C" void kernel_launch(void* const* d_in, const int* in_sizes, int n_in, void* d_out, int out_size, void* d_ws, size_t ws_size, hipStream_t stream) {
    static int grid_blocks = 0;
    if (grid_blocks == 0) {
        if (n_in != 18 || in_sizes[0] != T * DM || out_size != T * DM || ws_size < WS_END) { fprintf(stderr, "kernel_launch: unexpected shapes n_in %d in0 %d out %d ws %zu\n", n_in, n_in > 0 ? in_sizes[0] : -1, out_size, ws_size); grid_blocks = -1; return; }
        int dev = 0, cus = 0, per_cu = 0;
        (void)hipGetDevice(&dev);
        (void)hipDeviceGetAttribute(&cus, hipDeviceAttributeMultiprocessorCount, dev);
        (void)hipFuncSetAttribute((const void*)mega_fwd, hipFuncAttributeMaxDynamicSharedMemorySize, LDS_BYTES);
        (void)hipOccupancyMaxActiveBlocksPerMultiprocessor(&per_cu, (const void*)mega_fwd, NT, LDS_BYTES);
        if (per_cu < 1 || cus < 1) { fprintf(stderr, "kernel_launch: occupancy query gave %d blocks/CU on %d CUs\n", per_cu, cus); grid_blocks = -1; return; }
        grid_blocks = cus;
    }
    if (grid_blocks < 0) return;
    Params p{};
    const float** pp = (const float**)&p;
    for (int i = 0; i < 18; ++i) pp[i] = (const float*)d_in[i];
    p.out = (float*)d_out; p.ws = (unsigned char*)d_ws;
    if (hipMemsetAsync((char*)d_ws + WS_CTL, 0, CTL_BYTES, stream) != hipSuccess) { fprintf(stderr, "kernel_launch: memset failed\n"); return; }
    void* args[] = {&p};
    const hipError_t e = hipLaunchCooperativeKernel((const void*)mega_fwd, dim3(grid_blocks), dim3(NT), args, LDS_BYTES, stream);
    if (e != hipSuccess) fprintf(stderr, "kernel_launch: cooperative launch failed: %s (grid %d)\n", hipGetErrorString(e), grid_blocks);
}
```

```cpp
#include <hip/hip_runtime.h>
#include <hip/hip_cooperative_groups.h>
#include <cstdio>
#include <cstdint>
#include <cmath>
namespace pg8 {
#define PG8_LAS __attribute__((address_space(3)))
typedef unsigned short bf16_t;
typedef short bf16x8 __attribute__((ext_vector_type(8)));
typedef float f32x4 __attribute__((ext_vector_type(4)));
typedef unsigned u32x4 __attribute__((ext_vector_type(4)));
constexpr int BM = 256, BK = 64, HALF = 128, HTB = HALF * BK * 2  , STAGE_BYTES = 8 * HTB, NXCD = 8, WGM = 8;

__host__ __device__ __forceinline__ int lds_byte(int r, int c) { const int st = (r >> 4) * 2 + (c >> 5), rr = r & 15, cc = c & 31, ob = rr * 64 + cc * 2; return st * 1024 + (ob ^ (((ob >> 9) & 1) << 5)); }
__host__ __device__ __forceinline__ void stage_rc(int b, int& R, int& C) { const int st = b / 1024, sb = b % 1024, swz = sb ^ (((sb >> 9) & 1) << 5); R = (st >> 1) * 16 + swz / 64; C = (st & 1) * 32 + (swz % 64) / 2; }
__host__ __device__ __forceinline__ int perm32(int rho) { const int n = rho >> 4, i = rho & 15; return 8 * (i >> 2) + 4 * n + (i & 3); }

struct Unit { int pm, pn; };
struct Gemm { const bf16_t* A; const bf16_t* Bt; int M, N, K; };

struct StaticOrder {
    int nM, nN, nwg, G, c;
    __host__ __device__ void init(int M, int N, int G_, int c_) { nM = M / BM; nN = N / BM; nwg = nM * nN; G = G_; c = c_; }
    __host__ __device__ bool next(int i, Unit& u) const {
        const long L = (long)i * G + c; if (L >= nwg) return false;
        int wgid = (int)L; { const int q = nwg / NXCD, r = nwg % NXCD, xcd = wgid % NXCD, off = wgid / NXCD; wgid = (xcd < r ? xcd * (q + 1) : r * (q + 1) + (xcd - r) * q) + off; }
        const int nig = WGM * nN, gid = wgid / nig, fm = gid * WGM, gsz = (nM - fm) < WGM ? (nM - fm) : WGM;
        u.pm = fm + ((wgid % nig) % gsz); u.pn = (wgid % nig) / gsz; return true;
    }
    __device__ __forceinline__ void a_ready(const Unit&) const {}
    __device__ __forceinline__ void done(const Unit&) const {}
};

__device__ __forceinline__ unsigned cvt_pk_bf16(float lo, float hi) { unsigned r; asm volatile("v_cvt_pk_bf16_f32 %0, %1, %2" : "=v"(r) : "v"(lo), "v"(hi)); return r; }
typedef float f32x2 __attribute__((ext_vector_type(2)));
__device__ __forceinline__ f32x2 gelu_pk(f32x2 v) {
    const f32x2 av = __builtin_elementwise_abs(v), d = av * 0.2316418882f + 1.0f;
    f32x2 t; t.x = __builtin_amdgcn_rcpf(d.x); t.y = __builtin_amdgcn_rcpf(d.y);
    f32x2 q = t * 0.5307027145f + (-0.7265760135f); q = q * t + 0.7107068705f; q = q * t + (-0.142248368f); q = q * t + 0.127414796f; q = q * t;
    const f32x2 s = (v * v) * (-0.72134752044f);
    f32x2 e; e.x = __builtin_amdgcn_exp2f(s.x); e.y = __builtin_amdgcn_exp2f(s.y);
    const f32x2 m = v * (q * e), r = v - m;
    f32x2 o; o.x = v.x < 0.f ? m.x : r.x; o.y = v.y < 0.f ? m.y : r.y; return o;
}

template <int ACT  > struct EpiBf16 {
    static constexpr bool PERM = true, AFTER_DRAIN = false; static_assert(ACT == 0 || ACT == 1, "EpiBf16: ACT is 0 (none) or 1 (gelu_pk)");
    bf16_t* O; int ldc; const float* bias; int split_cols; size_t split_stride; float scale0;
    __device__ __forceinline__ void operator()(const f32x4 (&acc)[2][2][4][2], const Unit& u, int wr, int wc, int fr, int fq) const {
        const int row0 = u.pm * BM + wr * 64 + fr; int colt = u.pn * BM; bf16_t* base = O;
        float sc = 1.f; if (split_cols) { const int t = colt / split_cols; base += (size_t)t * split_stride; colt -= t * split_cols; if (t == 0) sc = scale0; }
        const int col0 = colt + wc * 32 + 8 * fq, bcol0 = u.pn * BM + wc * 32 + 8 * fq;
        f32x4 bv[2][2];
#pragma unroll
        for (int bj = 0; bj < 2; ++bj)
#pragma unroll
            for (int n = 0; n < 2; ++n) bv[bj][n] = bias ? *(const f32x4*)(bias + bcol0 + bj * HALF + 4 * n) : (f32x4){0.f, 0.f, 0.f, 0.f};
#pragma unroll
        for (int ai = 0; ai < 2; ++ai)
#pragma unroll
            for (int m = 0; m < 4; ++m) { bf16_t* rowp = base + (size_t)(row0 + ai * HALF + m * 16) * ldc + col0;
#pragma unroll
                for (int bj = 0; bj < 2; ++bj) { f32x4 v0 = acc[ai][bj][m][0] + bv[bj][0], v1 = acc[ai][bj][m][1] + bv[bj][1];
                    if (ACT == 1) { f32x2 a = gelu_pk((f32x2){v0[0], v0[1]}), b = gelu_pk((f32x2){v0[2], v0[3]}), c = gelu_pk((f32x2){v1[0], v1[1]}), d = gelu_pk((f32x2){v1[2], v1[3]});
                        v0 = (f32x4){a.x, a.y, b.x, b.y}; v1 = (f32x4){c.x, c.y, d.x, d.y}; }
                    v0 = v0 * sc; v1 = v1 * sc; u32x4 w; w.x = cvt_pk_bf16(v0[0], v0[1]); w.y = cvt_pk_bf16(v0[2], v0[3]); w.z = cvt_pk_bf16(v1[0], v1[1]); w.w = cvt_pk_bf16(v1[2], v1[3]);
                    *(u32x4*)(rowp + bj * HALF) = w; } }
    }
};

template <class Epi, class Sched, bool ALIGN_EPI = false, bool SP2 = false>
__device__ __forceinline__ void gemm_phase(PG8_LAS unsigned char* lds, const Gemm g, const Sched& S, const Epi& E) {
    int tid = threadIdx.x; asm volatile("" : "+v"(tid)); const int wid = __builtin_amdgcn_readfirstlane(tid >> 6), lane = tid & 63, wr = wid >> 2, wc = wid & 3, fr = lane & 15, fq = lane >> 4;
    const int K = g.K, nt = K / BK;
    unsigned voffA[2], voffB[2];
#pragma unroll
    for (int i = 0; i < 2; ++i) { int R, C; stage_rc(tid * 16 + i * 8192, R, C); const int Rb = Epi::PERM ? ((R & ~31) + perm32(R & 31)) : R;
        voffA[i] = (unsigned)(R * K + C) * 2u; voffB[i] = (unsigned)(Rb * K + C) * 2u; }
    const size_t kstep = (size_t)(BK * 2);
    const size_t hstep = (size_t)HALF * K * 2;
    const size_t tstep = 2 * hstep;
    const unsigned ldsw = (unsigned)wid * 1024u;
    const int aoff = lds_byte(wr * 64 + fr, fq * 8), boff = lds_byte(wc * 32 + fr, fq * 8);
#define PG8_SA(b, h) (((b) * 2 + (h)) * HTB)
#define PG8_SB(b, h) ((4 + (b) * 2 + (h)) * HTB)
#define PG8_STAGE(bufoff, gbase, voff) do { _Pragma("unroll") for (int _i = 0; _i < 2; ++_i) \
        __builtin_amdgcn_global_load_lds((const unsigned*)((const char*)(gbase) + (voff)[_i]), (PG8_LAS unsigned*)(lds + (bufoff) + ldsw + _i * 8192), 16, 0, 0); } while (0)
#define PG8_LDA(dst, b, h) do { _Pragma("unroll") for (int m = 0; m < 4; ++m) _Pragma("unroll") for (int k = 0; k < 2; ++k) dst[m][k] = *(const PG8_LAS bf16x8*)(lds + PG8_SA(b, h) + aoff + m * 2048 + k * 1024); } while (0)
#define PG8_LDB(dst, b, h) do { _Pragma("unroll") for (int n = 0; n < 2; ++n) _Pragma("unroll") for (int k = 0; k < 2; ++k) dst[n][k] = *(const PG8_LAS bf16x8*)(lds + PG8_SB(b, h) + boff + n * 2048 + k * 1024); } while (0)
#define PG8_MMA(ai, bj, At, Bt) do { __builtin_amdgcn_s_setprio(1); _Pragma("unroll") for (int m = 0; m < 4; ++m) _Pragma("unroll") for (int n = 0; n < 2; ++n) _Pragma("unroll") for (int k = 0; k < 2; ++k) \
        acc[ai][bj][m][n] = __builtin_amdgcn_mfma_f32_16x16x32_bf16(Bt[n][k], At[m][k], acc[ai][bj][m][n], 0, 0, 0); __builtin_amdgcn_s_setprio(0); } while (0)
#define PG8_WAIT_V(n) asm volatile("s_waitcnt vmcnt(" #n ")" ::: "memory")
#define PG8_WAIT_L(n) asm volatile("s_waitcnt lgkmcnt(" #n ")" ::: "memory")
#define PG8_BAR __builtin_amdgcn_s_barrier()
#define PG8_SCHED __builtin_amdgcn_sched_barrier(0)
    Unit cur, nxt; int ui = 0;
    if (!S.next(0, cur)) return;
    f32x4 acc[2][2][4][2];
#pragma unroll
    for (int a = 0; a < 2; ++a)
#pragma unroll
        for (int b = 0; b < 2; ++b)
#pragma unroll
            for (int m = 0; m < 4; ++m)
#pragma unroll
                for (int n = 0; n < 2; ++n) acc[a][b][m][n] = (f32x4){0.f, 0.f, 0.f, 0.f};
    bf16x8 At[4][2], B0[2][2], B1[2][2];
    const char* cA = (const char*)g.A + (size_t)cur.pm * tstep; const char* cB = (const char*)g.Bt + (size_t)cur.pn * tstep;
    S.a_ready(cur);
    if constexpr (SP2) {
        PG8_STAGE(PG8_SB(0, 0), cB, voffB); PG8_STAGE(PG8_SB(0, 1), cB + hstep, voffB); PG8_STAGE(PG8_SA(0, 0), cA, voffA); PG8_STAGE(PG8_SA(0, 1), cA + hstep, voffA);
        if (wr == 1) PG8_BAR;
        PG8_WAIT_V(2); PG8_BAR;
        PG8_STAGE(PG8_SB(1, 0), cB + kstep, voffB); PG8_STAGE(PG8_SA(1, 0), cA + kstep, voffA); PG8_STAGE(PG8_SB(1, 1), cB + hstep + kstep, voffB);
        PG8_WAIT_V(6); PG8_BAR;
    } else {
        PG8_STAGE(PG8_SB(0, 0), cB, voffB); PG8_STAGE(PG8_SA(0, 0), cA, voffA); PG8_STAGE(PG8_SB(0, 1), cB + hstep, voffB); PG8_STAGE(PG8_SA(0, 1), cA + hstep, voffA);
        if (wr == 1) PG8_BAR;
        PG8_WAIT_V(4); PG8_BAR;
        PG8_STAGE(PG8_SB(1, 0), cB + kstep, voffB); PG8_STAGE(PG8_SA(1, 0), cA + kstep, voffA); PG8_STAGE(PG8_SB(1, 1), cB + hstep + kstep, voffB);
        PG8_WAIT_V(6); PG8_BAR;
    }
    for (;;) {
        const bool has_next = S.next(ui + 1, nxt);
        const char* nA = has_next ? (const char*)g.A + (size_t)nxt.pm * tstep : cA; const char* nB = has_next ? (const char*)g.Bt + (size_t)nxt.pn * tstep : cB;
        for (int t = 0; t < nt; t += 2) {
            const bool last = (t == nt - 2);
            const char* a1 = cA + (size_t)(t + 1) * kstep;
            const char* a2 = last ? nA : cA + (size_t)(t + 2) * kstep; const char* b2 = last ? nB : cB + (size_t)(t + 2) * kstep;
            const char* a3 = a2 + kstep; const char* b3 = b2 + kstep;
            if (last && has_next) S.a_ready(nxt);
            if constexpr (SP2) {
            PG8_LDB(B0, 0, 0); PG8_LDB(B1, 0, 1); PG8_SCHED; PG8_LDA(At, 0, 0); PG8_STAGE(PG8_SA(1, 1), a1 + hstep, voffA);
            PG8_WAIT_V(8); PG8_WAIT_L(0); PG8_BAR; PG8_MMA(0, 0, At, B0); PG8_MMA(0, 1, At, B1); PG8_BAR; PG8_SCHED;
            PG8_LDA(At, 0, 1); PG8_STAGE(PG8_SB(0, 0), b2, voffB); PG8_STAGE(PG8_SB(0, 1), b2 + hstep, voffB); PG8_STAGE(PG8_SA(0, 0), a2, voffA);
            PG8_WAIT_V(8); PG8_WAIT_L(0); PG8_BAR; PG8_MMA(1, 0, At, B0); PG8_MMA(1, 1, At, B1); PG8_BAR; PG8_SCHED;
            PG8_LDB(B0, 1, 0); PG8_LDB(B1, 1, 1); PG8_SCHED; PG8_LDA(At, 1, 0); PG8_STAGE(PG8_SA(0, 1), a2 + hstep, voffA);
            PG8_WAIT_V(8); PG8_WAIT_L(0); PG8_BAR; PG8_MMA(0, 0, At, B0); PG8_MMA(0, 1, At, B1); PG8_BAR; PG8_SCHED;
            PG8_LDA(At, 1, 1); PG8_STAGE(PG8_SB(1, 0), b3, voffB); PG8_STAGE(PG8_SB(1, 1), b3 + hstep, voffB); PG8_STAGE(PG8_SA(1, 0), a3, voffA);
            PG8_WAIT_V(8); PG8_WAIT_L(0); PG8_BAR; PG8_MMA(1, 0, At, B0); PG8_MMA(1, 1, At, B1); PG8_BAR; PG8_SCHED;
            } else {
            PG8_LDB(B0, 0, 0); PG8_SCHED; PG8_LDA(At, 0, 0); PG8_STAGE(PG8_SA(1, 1), a1 + hstep, voffA);
            PG8_WAIT_L(8); PG8_BAR; PG8_WAIT_L(0); PG8_MMA(0, 0, At, B0); PG8_BAR; PG8_SCHED;
            PG8_LDB(B1, 0, 1); PG8_STAGE(PG8_SB(0, 0), b2, voffB);
            PG8_BAR; PG8_WAIT_L(0); PG8_MMA(0, 1, At, B1); PG8_BAR;
            PG8_LDA(At, 0, 1); PG8_STAGE(PG8_SA(0, 0), a2, voffA);
            PG8_BAR; PG8_WAIT_L(0); PG8_MMA(1, 0, At, B0); PG8_BAR; PG8_SCHED;
            PG8_STAGE(PG8_SB(0, 1), b2 + hstep, voffB);
            PG8_WAIT_V(6); PG8_BAR; PG8_MMA(1, 1, At, B1); PG8_BAR;
            PG8_LDB(B0, 1, 0); PG8_SCHED; PG8_LDA(At, 1, 0); PG8_STAGE(PG8_SA(0, 1), a2 + hstep, voffA);
            PG8_WAIT_L(8); PG8_BAR; PG8_WAIT_L(0); PG8_MMA(0, 0, At, B0); PG8_BAR; PG8_SCHED;
            PG8_LDB(B1, 1, 1); PG8_STAGE(PG8_SB(1, 0), b3, voffB);
            PG8_BAR; PG8_WAIT_L(0); PG8_MMA(0, 1, At, B1); PG8_BAR;
            PG8_LDA(At, 1, 1); PG8_STAGE(PG8_SA(1, 0), a3, voffA);
            PG8_BAR; PG8_WAIT_L(0); PG8_MMA(1, 0, At, B0); PG8_BAR; PG8_SCHED;
            PG8_STAGE(PG8_SB(1, 1), b3 + hstep, voffB);
            PG8_WAIT_V(6); PG8_BAR; PG8_MMA(1, 1, At, B1); PG8_BAR;
            }
        }
        if constexpr (ALIGN_EPI) { if (wr == 0) PG8_BAR; }
        if constexpr (!Epi::AFTER_DRAIN) { E(acc, cur, wr, wc, fr, fq); S.done(cur); }
        if (!has_next) break;
#pragma unroll
        for (int a = 0; a < 2; ++a)
#pragma unroll
            for (int b = 0; b < 2; ++b)
#pragma unroll
                for (int m = 0; m < 4; ++m)
#pragma unroll
                    for (int n = 0; n < 2; ++n) acc[a][b][m][n] = (f32x4){0.f, 0.f, 0.f, 0.f};
        cur = nxt; cA = nA; cB = nB; ++ui;
        if constexpr (ALIGN_EPI) { if (wr == 1) PG8_BAR; }
    }
    PG8_WAIT_V(0);
    if constexpr (!ALIGN_EPI) { if (wr == 0) PG8_BAR; }
    PG8_BAR;
    if constexpr (Epi::AFTER_DRAIN) { E.fused(acc, cur, wr, wc, fr, fq, lds, wid, lane); S.done(cur); }
#undef PG8_SA
#undef PG8_SB
#undef PG8_STAGE
#undef PG8_LDA
#undef PG8_LDB
#undef PG8_MMA
#undef PG8_WAIT_V
#undef PG8_WAIT_L
#undef PG8_BAR
#undef PG8_SCHED
}
}
namespace cg = cooperative_groups;
#define LAS __attribute__((address_space(3)))
typedef unsigned short bf16;
typedef float f32x4 __attribute__((ext_vector_type(4)));
typedef float f32x8 __attribute__((ext_vector_type(8)));
typedef float f32x16 __attribute__((ext_vector_type(16)));
typedef unsigned u32x4 __attribute__((ext_vector_type(4)));
typedef unsigned u32x2 __attribute__((ext_vector_type(2)));
typedef short bf16x8 __attribute__((ext_vector_type(8)));
typedef short s16x4 __attribute__((ext_vector_type(4)));

constexpr int BATCH = 16, SEQ = 2048, DM = 1024, T = BATCH * SEQ;
constexpr int NP = 3072;
constexpr int IN_COLS = 3012;
constexpr int C_QA = 0, C_KA = 512, C_VA = 1024, C_QB = 1536, C_KV = 2560, C_QI = 2688, C_KI = 2944, C_WI = 3008;
constexpr int MIXW = 1536;
constexpr int NEXP = 16384;
constexpr float EPS = 1e-6f;
constexpr int NT = 512;
constexpr int NWV = 8;

constexpr size_t MiB = 1u << 20;
constexpr size_t WS_CTL = 0;
constexpr size_t CTL_BYTES = 64 * 1024;
constexpr size_t WS_MOD = 1 * MiB;
constexpr size_t WS_SCAL = WS_MOD + 512 * 1024;
constexpr size_t WS_WIN = 2 * MiB;
constexpr size_t WS_WO2 = 8 * MiB;
constexpr size_t WS_WQ = 11 * MiB;
constexpr size_t WS_SUBK = 13 * MiB;
constexpr size_t WS_U16 = 14 * MiB;
constexpr size_t WS_V16 = 46 * MiB;
constexpr size_t WS_H = 78 * MiB;
constexpr size_t WS_PROJ = 142 * MiB;
constexpr size_t WS_Q3 = WS_PROJ;
constexpr size_t WS_MIX = 334 * MiB;
constexpr size_t WS_EXP = 430 * MiB;
constexpr size_t WS_GATE = 446 * MiB;
constexpr size_t WS_ATMP = 462 * MiB;
constexpr size_t WS_CBUF = 494 * MiB;
constexpr size_t WS_END = 510 * MiB;

struct Params {
    const float *x, *c, *ada_w, *ada_b, *norm1_g, *norm2_g, *w_in, *a_qk_gain, *a_lambda, *a_sub_gain, *b_q_gain, *b_kv_gain, *b_w_uv, *w_out, *peer_wq, *peer_subkeys, *peer_u, *peer_v;
    float* out; unsigned char* ws;
};

enum { SC_LAM = 0, SC_MA = 1, SC_MB = 2 };

__device__ __forceinline__ unsigned f2bf(float f) { unsigned u = __float_as_uint(f); return (u + 0x7fffu + ((u >> 16) & 1u)) >> 16; }
__device__ __forceinline__ float bf2f(unsigned h) { return __uint_as_float(h << 16); }
__device__ __forceinline__ unsigned pk2(float lo, float hi) { return f2bf(lo) | (f2bf(hi) << 16); }
__device__ __forceinline__ float bflo(unsigned w) { return __uint_as_float(w << 16); }
__device__ __forceinline__ float bfhi(unsigned w) { return __uint_as_float(w & 0xffff0000u); }
__device__ __forceinline__ float wave_sum(float v) {
#pragma unroll
    for (int o = 1; o < 64; o <<= 1) v += __shfl_xor(v, o);
    return v;
}
__device__ __forceinline__ float wave_max(float v) {
#pragma unroll
    for (int o = 1; o < 64; o <<= 1) v = fmaxf(v, __shfl_xor(v, o));
    return v;
}
#define LDS_WAIT() asm volatile("s_waitcnt lgkmcnt(0)" ::: "memory")
__device__ __forceinline__ void ph_mod(const Params& p, float* ldsf, int vb, int nvb) {
    if (vb >= 96) return;
    int tid = threadIdx.x; asm volatile("" : "+v"(tid));
    const int lane = tid & 63, wv = tid >> 6;
    for (int i = tid; i < 16 * 1024; i += NT) { const float v = p.c[i]; ldsf[i] = v / (1.f + __expf(-v)); }
    __syncthreads();
    float* MOD = (float*)(p.ws + WS_MOD); float* part = ldsf + 16 * 1024;
    for (int it = vb; it < 96; it += nvb) {
        const int j = it * 64 + lane;
        float acc[16];
#pragma unroll
        for (int b = 0; b < 16; ++b) acc[b] = 0.f;
        const float* wp = p.ada_w + (size_t)(128 * wv) * 6144 + j;
#pragma unroll 1
        for (int k0 = 0; k0 < 128; k0 += 8) {
            float w[8];
#pragma unroll
            for (int u = 0; u < 8; ++u) w[u] = wp[(size_t)(k0 + u) * 6144];
#pragma unroll
            for (int u = 0; u < 8; ++u)
#pragma unroll
                for (int b = 0; b < 16; ++b) acc[b] = fmaf(ldsf[b * 1024 + 128 * wv + k0 + u], w[u], acc[b]);
        }
#pragma unroll
        for (int b = 0; b < 16; ++b) part[(wv * 16 + b) * 64 + lane] = acc[b];
        __syncthreads();
        for (int o = tid; o < 16 * 64; o += NT) { const int b = o >> 6, c = o & 63; float s = 0.f;
#pragma unroll
            for (int w = 0; w < 8; ++w) s += part[(w * 16 + b) * 64 + c];
            MOD[b * 6144 + it * 64 + c] = s + p.ada_b[it * 64 + c]; }
        __syncthreads();
    }
}

__device__ __forceinline__ void transpose_item(const float* W, int N, bf16* WT, int ldt, LAS float* scr, int kb, int nb, int lane) {
    const int k0 = 64 * kb, n0 = 32 * nb;
#pragma unroll 8
    for (int i = 0; i < 32; ++i) { const int kk = 2 * i + (lane >> 5); const int n = n0 + (lane & 31); scr[kk * 33 + (lane & 31)] = (n < N) ? W[(size_t)(k0 + kk) * N + n] : 0.f; }
    LDS_WAIT(); asm volatile("" ::: "memory");
    const int c = lane & 7;
#pragma unroll
    for (int j = 0; j < 4; ++j) { const int n = (lane >> 3) + 8 * j; const LAS float* s = scr + (8 * c) * 33 + n;
        u32x4 o; o.x = pk2(s[0 * 33], s[1 * 33]); o.y = pk2(s[2 * 33], s[3 * 33]); o.z = pk2(s[4 * 33], s[5 * 33]); o.w = pk2(s[6 * 33], s[7 * 33]);
        *(u32x4*)(WT + (size_t)(n0 + n) * ldt + k0 + 8 * c) = o; }
    LDS_WAIT(); asm volatile("" ::: "memory");
}

__device__ __forceinline__ void ph_prep_weights(const Params& p, LAS float* scr, int gw, int ngw, int lane) {
    bf16* WIN = (bf16*)(p.ws + WS_WIN); bf16* WO2 = (bf16*)(p.ws + WS_WO2); bf16* WQ = (bf16*)(p.ws + WS_WQ);
    constexpr int I_IN = 16 * 96, I_O = 8 * 32, I_Q = 16 * 32;
    for (int it = gw; it < I_IN + I_O + I_Q; it += ngw) {
        int r = it;
        if (r < I_IN) { transpose_item(p.w_in, IN_COLS, WIN, 1024, scr, r / 96, r % 96, lane); continue; } r -= I_IN;
        if (r < I_O) { transpose_item(p.w_out, 1024, WO2, MIXW, scr, r / 32, r % 32, lane); continue; } r -= I_O;
        transpose_item(p.peer_wq, 1024, WQ, 1024, scr, r / 32, r % 32, lane);
    }
    const size_t gt = (size_t)gw * 64 + lane, ngt = (size_t)ngw * 64;
    for (size_t i = gt; i < (size_t)1024 * 1024; i += ngt) {
        const int n = (int)(i & 1023), kk = (int)(i >> 10), h = kk >> 7;
        const float* wu = p.b_w_uv + (size_t)kk * 64; const float* wo = p.w_out + (size_t)(512 + 64 * h) * 1024 + n;
        float a = 0.f;
#pragma unroll 8
        for (int e = 0; e < 64; ++e) a = fmaf(wu[e], wo[(size_t)e * 1024], a);
        WO2[(size_t)n * MIXW + 512 + kk] = (bf16)f2bf(a);
    }
    unsigned char* U8 = (unsigned char*)(p.ws + WS_U16); unsigned char* V8 = (unsigned char*)(p.ws + WS_V16); bf16* SUBK = (bf16*)(p.ws + WS_SUBK);
    constexpr size_t NTAB8 = (size_t)NEXP * 1024 / 8, NSUB8 = 2 * 128 * 64 / 8;
    for (size_t i = gt; i < 2 * NTAB8 + NSUB8; i += ngt) {
        if (i < 2 * NTAB8) {
            const bool isu = i < NTAB8; const size_t j = isu ? i : i - NTAB8; const float sc = isu ? 32.0f : 1.0f;
            const f32x8 v = *(const f32x8*)((isu ? p.peer_u : p.peer_v) + j * 8);
            int w0 = 0, w1 = 0;
            w0 = __builtin_amdgcn_cvt_pk_fp8_f32(v[0] * sc, v[1] * sc, w0, false); w0 = __builtin_amdgcn_cvt_pk_fp8_f32(v[2] * sc, v[3] * sc, w0, true);
            w1 = __builtin_amdgcn_cvt_pk_fp8_f32(v[4] * sc, v[5] * sc, w1, false); w1 = __builtin_amdgcn_cvt_pk_fp8_f32(v[6] * sc, v[7] * sc, w1, true);
            u32x2 o; o.x = (unsigned)w0; o.y = (unsigned)w1;
            *(u32x2*)((isu ? U8 : V8) + j * 8) = o;
        } else {
            const size_t j = i - 2 * NTAB8;
            const f32x8 v = *(const f32x8*)(p.peer_subkeys + j * 8);
            u32x4 o; o.x = pk2(v[0], v[1]); o.y = pk2(v[2], v[3]); o.z = pk2(v[4], v[5]); o.w = pk2(v[6], v[7]);
            *(u32x4*)(SUBK + j * 8) = o;
        }
    }
    if (gt == 0) {
        float* SC = (float*)(p.ws + WS_SCAL);
        float s01 = 0.f, s23 = 0.f;
        for (int i = 0; i < 64; ++i) { s01 += p.a_lambda[i] * p.a_lambda[64 + i]; s23 += p.a_lambda[128 + i] * p.a_lambda[192 + i]; }
        SC[SC_LAM] = __expf(s01) - __expf(s23) + 0.2f;
        float g0 = 0.f, g1 = 0.f, gq = 0.f, gk = 0.f;
        for (int i = 0; i < 64; ++i) { g0 = fmaxf(g0, fabsf(p.a_qk_gain[i])); g1 = fmaxf(g1, fabsf(p.a_qk_gain[64 + i])); }
        for (int i = 0; i < 128; ++i) { gq = fmaxf(gq, fabsf(p.b_q_gain[i])); gk = fmaxf(gk, fabsf(p.b_kv_gain[i])); }
        SC[SC_MA] = 8.0f * g0 * g1 * 1.02f;
        SC[SC_MB] = 11.3137085f * gq * gk * 1.02f;
    }
}

__device__ __forceinline__ void ph_hrows(const Params& p, const float* X, const float* g, int shOff, int scOff, int gw, int ngw, int lane) {
    const float* MOD = (const float*)(p.ws + WS_MOD); bf16* H = (bf16*)(p.ws + WS_H);
    for (int m = gw; m < T; m += ngw) {
        const f32x4* xr = (const f32x4*)(X + (size_t)m * 1024) + lane;
        f32x4 v[4]; float s = 0.f;
#pragma unroll
        for (int j = 0; j < 4; ++j) { v[j] = xr[64 * j]; s += (v[j].x * v[j].x + v[j].y * v[j].y) + (v[j].z * v[j].z + v[j].w * v[j].w); }
        const float rstd = rsqrtf(wave_sum(s) * (1.f / 1024.f) + EPS);
        const float* mb = MOD + (size_t)(m >> 11) * 6144;
#pragma unroll
        for (int j = 0; j < 4; ++j) {
            const int col = 4 * (lane + 64 * j);
            const f32x4 gg = *(const f32x4*)(g + col), sc = *(const f32x4*)(mb + scOff + col), sh = *(const f32x4*)(mb + shOff + col);
            const f32x4 y = v[j] * rstd * gg * (sc + 1.0f) + sh;
            u32x2 o; o.x = pk2(y.x, y.y); o.y = pk2(y.z, y.w);
            *(u32x2*)(H + (size_t)m * 1024 + col) = o;
        }
    }
}

__device__ __forceinline__ void ph_norm_proj(const Params& p, int gw, int ngw, int lane) {
    bf16* PROJ = (bf16*)(p.ws + WS_PROJ);
    for (int m = gw; m < T; m += ngw) {
        bf16* row = PROJ + (size_t)m * NP;
#pragma unroll
        for (int j = 0; j < 6; ++j) {
            if (j == 2) continue;
            const int col = 8 * lane + 512 * j;
            const u32x4 raw = *(const u32x4*)(row + col);
            float v[8] = {bflo(raw.x), bfhi(raw.x), bflo(raw.y), bfhi(raw.y), bflo(raw.z), bfhi(raw.z), bflo(raw.w), bfhi(raw.w)};
            float ss = 0.f;
#pragma unroll
            for (int i = 0; i < 8; ++i) ss += v[i] * v[i];
            ss += __shfl_xor(ss, 1); ss += __shfl_xor(ss, 2); ss += __shfl_xor(ss, 4);
            float rstd; const float* gp;
            if (j < 2) { rstd = rsqrtf(ss * (1.f / 64.f) + EPS); gp = p.a_qk_gain + 64 * j + (col & 63); }
            else { ss += __shfl_xor(ss, 8); rstd = rsqrtf(ss * (1.f / 128.f) + EPS); gp = (j == 5 ? p.b_kv_gain : p.b_q_gain) + (col & 127); }
            if (j == 5 && lane >= 16) continue;
            const f32x4 g0 = *(const f32x4*)gp, g1 = *(const f32x4*)(gp + 4);
            u32x4 o; o.x = pk2(v[0] * rstd * g0.x, v[1] * rstd * g0.y); o.y = pk2(v[2] * rstd * g0.z, v[3] * rstd * g0.w);
            o.z = pk2(v[4] * rstd * g1.x, v[5] * rstd * g1.y); o.w = pk2(v[6] * rstd * g1.z, v[7] * rstd * g1.w);
            *(u32x4*)(row + col) = o;
        }
    }
}
__device__ void ph_attnA_naive(const Params& p, float* lds_w, int gw, int ngw, int lane) {
    const bf16* PROJ = (const bf16*)(p.ws + WS_PROJ); bf16* MIX = (bf16*)(p.ws + WS_MIX);
    const float lam = ((const float*)(p.ws + WS_SCAL))[SC_LAM];
    float* qs = lds_w; float* sc0 = lds_w + 128; float* sc1 = sc0 + 2048;
    for (int it = gw; it < BATCH * 4 * SEQ; it += ngw) {
        const int t = it & 2047, h = (it >> 11) & 3, b = it >> 13;
        const int cend = ((t >> 6) + 1) << 6;
        const float slope = exp2f(-2.0f * (h + 1));
        const bf16* qrow = PROJ + (size_t)(b * SEQ + t) * NP + C_QA + h * 128;
        qs[lane] = bf2f(qrow[lane]); qs[64 + lane] = bf2f(qrow[64 + lane]);
        LDS_WAIT(); asm volatile("" ::: "memory");
        float m0 = -3e38f, m1 = -3e38f;
        for (int kk = lane; kk < cend; kk += 64) {
            const bf16* krow = PROJ + (size_t)(b * SEQ + kk) * NP + C_KA + h * 128;
            float d0 = 0.f, d1 = 0.f;
            for (int d = 0; d < 64; ++d) { d0 = fmaf(qs[d], bf2f(krow[d]), d0); d1 = fmaf(qs[64 + d], bf2f(krow[64 + d]), d1); }
            const float bias = slope * fabsf((float)(t - kk));
            d0 = d0 * 0.125f - bias; d1 = d1 * 0.125f - bias;
            sc0[kk] = d0; sc1[kk] = d1; m0 = fmaxf(m0, d0); m1 = fmaxf(m1, d1);
        }
        m0 = wave_max(m0); m1 = wave_max(m1);
        float l0 = 0.f, l1 = 0.f;
        for (int kk = lane; kk < cend; kk += 64) { const float e0 = __expf(sc0[kk] - m0), e1 = __expf(sc1[kk] - m1); sc0[kk] = e0; sc1[kk] = e1; l0 += e0; l1 += e1; }
        l0 = wave_sum(l0); l1 = wave_sum(l1);
        const float i0 = 1.f / l0, i1 = lam / l1;
        for (int kk = lane; kk < cend; kk += 64) sc0[kk] = sc0[kk] * i0 - sc1[kk] * i1;
        LDS_WAIT(); asm volatile("" ::: "memory");
        float a0 = 0.f, a1 = 0.f;
        const bf16* vb = PROJ + (size_t)(b * SEQ) * NP + C_VA + h * 128;
        for (int kk = 0; kk < cend; ++kk) { const float a = sc0[kk]; const bf16* vr = vb + (size_t)kk * NP; a0 = fmaf(a, bf2f(vr[lane]), a0); a1 = fmaf(a, bf2f(vr[64 + lane]), a1); }
        const float ss = wave_sum(a0 * a0 + a1 * a1);
        const float rstd = rsqrtf(ss * (1.f / 128.f) + EPS) * 0.8f;
        bf16* orow = MIX + (size_t)(b * SEQ + t) * MIXW + h * 128;
        orow[lane] = (bf16)f2bf(a0 * rstd * p.a_sub_gain[lane]); orow[64 + lane] = (bf16)f2bf(a1 * rstd * p.a_sub_gain[64 + lane]);
        LDS_WAIT(); asm volatile("" ::: "memory");
    }
}

__device__ void ph_dsa_naive(const Params& p, float* lds, int vb, int nvb) {
    const bf16* PROJ = (const bf16*)(p.ws + WS_PROJ); bf16* MIX = (bf16*)(p.ws + WS_MIX);
    const int tid = threadIdx.x, lane = tid & 63, wv = tid >> 6;
    float* scores = lds; int* sel = (int*)(lds + 2048); float* qi = lds + 2048 + 256; float* wi = qi + 256;
    float* qh = wi + 64 + wv * 384; float* pw = qh + 128;
    for (int it = vb; it < T; it += nvb) {
        const int b = it >> 11, t = it & 2047; const int cend = ((t >> 6) + 1) << 6;
        const bf16* row = PROJ + (size_t)it * NP;
        if (tid < 256) qi[tid] = bf2f(row[C_QI + tid]);
        if (tid < 4) wi[tid] = bf2f(row[C_WI + tid]);
        __syncthreads();
        for (int kk = tid; kk < cend; kk += NT) {
            const bf16* kr = PROJ + (size_t)(b * SEQ + kk) * NP + C_KI;
            float s = 0.f;
            for (int h = 0; h < 4; ++h) { float d = 0.f; for (int e = 0; e < 64; ++e) d = fmaf(qi[h * 64 + e], bf2f(kr[e]), d); s += fmaxf(d, 0.f) * wi[h]; }
            scores[kk] = s * 0.0625f;
        }
        __syncthreads();
        int nvalid;
        if (cend <= 256) { if (tid < 256) sel[tid] = tid; nvalid = cend; }
        else {
            for (int i = tid; i < cend; i += NT) { const float si = scores[i]; int rank = 0;
                for (int j = 0; j < cend; ++j) { const float sj = scores[j]; rank += (sj > si || (sj == si && j < i)) ? 1 : 0; }
                if (rank < 256) sel[rank] = i; }
            nvalid = 256;
        }
        __syncthreads();
        {
            const int h = wv; const float slope = exp2f(-(float)(h + 1));
            qh[lane] = bf2f(row[C_QB + h * 128 + lane]); qh[64 + lane] = bf2f(row[C_QB + h * 128 + 64 + lane]);
            LDS_WAIT(); asm volatile("" ::: "memory");
            float sv[4]; float mx = -3e38f;
#pragma unroll
            for (int jj = 0; jj < 4; ++jj) { const int j = lane + 64 * jj; const int key = sel[j < nvalid ? j : 0];
                const bf16* kv = PROJ + (size_t)(b * SEQ + key) * NP + C_KV; float d = 0.f;
                for (int e = 0; e < 128; ++e) d = fmaf(qh[e], bf2f(kv[e]), d);
                d = d * 0.0883883476f - slope * fabsf((float)(t - key));
                sv[jj] = (j < nvalid) ? d : -3e38f; mx = fmaxf(mx, sv[jj]); }
            mx = wave_max(mx); float l = 0.f;
#pragma unroll
            for (int jj = 0; jj < 4; ++jj) { const int j = lane + 64 * jj; const float e = (j < nvalid) ? __expf(sv[jj] - mx) : 0.f; pw[j] = e; l += e; }
            l = wave_sum(l);
            LDS_WAIT(); asm volatile("" ::: "memory");
            float a0 = 0.f, a1 = 0.f;
            for (int j = 0; j < nvalid; ++j) { const float pj = pw[j]; const bf16* kv = PROJ + (size_t)(b * SEQ + sel[j]) * NP + C_KV; a0 = fmaf(pj, bf2f(kv[lane]), a0); a1 = fmaf(pj, bf2f(kv[64 + lane]), a1); }
            const float il = 1.f / l;
            bf16* orow = MIX + (size_t)it * MIXW + 512 + h * 128;
            orow[lane] = (bf16)f2bf(a0 * il); orow[64 + lane] = (bf16)f2bf(a1 * il);
        }
        __syncthreads();
    }
}

__device__ void ph_route_naive(const Params& p, float* lds, int vb, int nvb) {
    const bf16* Q3 = (const bf16*)(p.ws + WS_Q3); const bf16* SUBK = (const bf16*)(p.ws + WS_SUBK);
    int* EXPI = (int*)(p.ws + WS_EXP); float* GATE = (float*)(p.ws + WS_GATE);
    const int tid = threadIdx.x;
    float* q = lds; float* sub = q + 1024; float* sv = sub + 2048; int* si = (int*)(sv + 256); float* cand = sv + 512; float* ts = cand + 2048; int* te = (int*)(ts + 128);
    for (int it = vb; it < T; it += nvb) {
        q[tid] = bf2f(Q3[(size_t)it * 1024 + tid]); q[tid + 512] = bf2f(Q3[(size_t)it * 1024 + tid + 512]);
        __syncthreads();
        for (int r = 0; r < 4; ++r) { const int idx = tid + 512 * r, h = idx >> 8, c = (idx >> 7) & 1, n = idx & 127;
            const float* qq = q + h * 128 + c * 64; const bf16* kk = SUBK + (size_t)(c * 128 + n) * 64; float d = 0.f;
            for (int e = 0; e < 64; ++e) d = fmaf(qq[e], bf2f(kk[e]), d);
            sub[idx] = d; }
        __syncthreads();
        for (int r = 0; r < 4; ++r) { const int idx = tid + 512 * r, g0 = idx & ~127, n = idx & 127; const float s = sub[idx]; int rank = 0;
            for (int j = 0; j < 128; ++j) { const float sj = sub[g0 + j]; rank += (sj > s || (sj == s && j < n)) ? 1 : 0; }
            if (rank < 16) { sv[(g0 >> 7) * 16 + rank] = s; si[(g0 >> 7) * 16 + rank] = n; } }
        __syncthreads();
        for (int r = 0; r < 4; ++r) { const int idx = tid + 512 * r, h = idx >> 8, i = (idx >> 4) & 15, j = idx & 15; cand[idx] = sv[(h * 2) * 16 + i] + sv[(h * 2 + 1) * 16 + j]; }
        __syncthreads();
        for (int r = 0; r < 4; ++r) { const int idx = tid + 512 * r, h = idx >> 8, ij = idx & 255; const float s = cand[idx]; int rank = 0;
            for (int j = 0; j < 256; ++j) { const float sj = cand[h * 256 + j]; rank += (sj > s || (sj == s && j < ij)) ? 1 : 0; }
            if (rank < 16) { ts[h * 16 + rank] = s; te[h * 16 + rank] = si[(h * 2) * 16 + (ij >> 4)] * 128 + si[(h * 2 + 1) * 16 + (ij & 15)]; } }
        __syncthreads();
        if (tid < 128) { const int h = tid >> 4; const float mx = ts[h * 16]; float l = 0.f;
            for (int k = 0; k < 16; ++k) l += __expf(ts[h * 16 + k] - mx);
            GATE[(size_t)it * 128 + tid] = __expf(ts[tid] - mx) / l; EXPI[(size_t)it * 128 + tid] = te[tid]; }
        __syncthreads();
    }
}

__device__ void ph_peer_naive(const Params& p, float* lds, int vb, int nvb) {
    const bf16* H = (const bf16*)(p.ws + WS_H); const bf16* U16 = (const bf16*)(p.ws + WS_U16); const bf16* V16 = (const bf16*)(p.ws + WS_V16);
    const int* EXPI = (const int*)(p.ws + WS_EXP); const float* GATE = (const float*)(p.ws + WS_GATE); const float* MOD = (const float*)(p.ws + WS_MOD);
    const int tid = threadIdx.x, lane = tid & 63, wv = tid >> 6;
    float* xs = lds; float* coef = lds + 1024; int* ex = (int*)(coef + 128);
    for (int it = vb; it < T; it += nvb) {
        xs[tid] = bf2f(H[(size_t)it * 1024 + tid]); xs[tid + 512] = bf2f(H[(size_t)it * 1024 + tid + 512]);
        if (tid < 128) ex[tid] = EXPI[(size_t)it * 128 + tid];
        __syncthreads();
        for (int jj = 0; jj < 16; ++jj) { const int j = wv * 16 + jj; const bf16* ur = U16 + (size_t)ex[j] * 1024; float d = 0.f;
            for (int i = 0; i < 16; ++i) d = fmaf(xs[lane + 64 * i], bf2f(ur[lane + 64 * i]), d);
            d = wave_sum(d);
            if (lane == 0) coef[j] = 0.5f * d * (1.f + erff(d * 0.70710678f)) * GATE[(size_t)it * 128 + j]; }
        __syncthreads();
        const float* g2 = MOD + (size_t)(it >> 11) * 6144 + 5120;
        for (int r = 0; r < 2; ++r) { const int d = tid + 512 * r; float a = 0.f;
            for (int j = 0; j < 128; ++j) a = fmaf(coef[j], bf2f(V16[(size_t)ex[j] * 1024 + d]), a);
            p.out[(size_t)it * 1024 + d] = p.out[(size_t)it * 1024 + d] + g2[d] * a; }
        __syncthreads();
    }
}
struct EpiResGate {
    static constexpr bool PERM = false, AFTER_DRAIN = false;
    const float* X; float* Out; const float* gate;
    __device__ __forceinline__ void operator()(const pg8::f32x4 (&acc)[2][2][4][2], const pg8::Unit& u, int wr, int wc, int fr, int fq) const {
        const int col0 = u.pn * 256 + wc * 32 + 4 * fq;
#pragma unroll
        for (int ai = 0; ai < 2; ++ai)
#pragma unroll
            for (int m = 0; m < 4; ++m) {
                const int r = u.pm * 256 + ai * 128 + wr * 64 + m * 16 + fr; const float* gb = gate + (size_t)(r >> 11) * 6144;
#pragma unroll
                for (int bj = 0; bj < 2; ++bj)
#pragma unroll
                    for (int n = 0; n < 2; ++n) { const int c = col0 + bj * 128 + n * 16; const size_t off = (size_t)r * 1024 + c;
                        const pg8::f32x4 xv = *(const pg8::f32x4*)(X + off), gv = *(const pg8::f32x4*)(gb + c);
                        *(pg8::f32x4*)(Out + off) = xv + gv * acc[ai][bj][m][n]; }
            }
    }
};

typedef __bf16 bf16x2_t __attribute__((ext_vector_type(2)));
__device__ __forceinline__ float dot2bf(unsigned a, unsigned b, float acc) { return __builtin_amdgcn_fdot2_f32_bf16(__builtin_bit_cast(bf16x2_t, a), __builtin_bit_cast(bf16x2_t, b), acc, false); }
template <int CTRL> __device__ __forceinline__ float dpp_f(float v) { return __int_as_float(__builtin_amdgcn_update_dpp(0, __float_as_int(v), CTRL, 0xf, 0xf, false)); }
__device__ __forceinline__ float row16_sum(float v) {
    v += dpp_f<0x128>(v); v += dpp_f<0x124>(v); v += dpp_f<0x122>(v); v += dpp_f<0x121>(v); return v;
}
__device__ __forceinline__ float gelu_erf(float v) {
    const float av = fabsf(v), t = __builtin_amdgcn_rcpf(fmaf(av, 0.2316418882f, 1.0f));
    float q = fmaf(t, 0.5307027145f, -0.7265760135f); q = fmaf(q, t, 0.7107068705f); q = fmaf(q, t, -0.142248368f); q = fmaf(q, t, 0.127414796f); q = q * t;
    const float e = __builtin_amdgcn_exp2f(v * v * -0.72134752044f);
    const float m = v * (q * e);
    return v < 0.f ? m : v - m;
}

__device__ __forceinline__ void ph_peer(const Params& p, unsigned char* lds_w, int gw, int ngw, int lane_, float* outp) {
    int lane = lane_; asm volatile("" : "+v"(lane));
    const bf16* H = (const bf16*)(p.ws + WS_H); const bf16* U16 = (const bf16*)(p.ws + WS_U16); const bf16* V16 = (const bf16*)(p.ws + WS_V16);
    const int* EXPI = (const int*)(p.ws + WS_EXP); const float* GATE = (const float*)(p.ws + WS_GATE); const float* MOD = (const float*)(p.ws + WS_MOD);
    int* e_lds = (int*)lds_w; float* a_lds = (float*)(lds_w + 512);
    const int g = lane >> 4, i = lane & 15;
    for (int t = gw; t < T; t += ngw) {
        const int e0 = EXPI[(size_t)t * 128 + lane], e1 = EXPI[(size_t)t * 128 + 64 + lane];
        const float g0 = GATE[(size_t)t * 128 + lane], g1 = GATE[(size_t)t * 128 + 64 + lane];
        e_lds[lane] = e0; e_lds[64 + lane] = e1;
        u32x4 xr[8];
        const u32x4* xrow = (const u32x4*)(H + (size_t)t * 1024) + i;
#pragma unroll
        for (int k = 0; k < 8; ++k) xr[k] = xrow[16 * k];
        LDS_WAIT(); asm volatile("" ::: "memory");
        u32x4 ua[8], ub[8];
        { const u32x4* ur = (const u32x4*)(U16 + (size_t)e_lds[g] * 1024) + i;
#pragma unroll
          for (int k = 0; k < 8; ++k) ua[k] = ur[16 * k]; }
#pragma unroll 1
        for (int s = 0; s < 32; s += 2) {
            { const u32x4* ur = (const u32x4*)(U16 + (size_t)e_lds[4 * (s + 1) + g] * 1024) + i;
#pragma unroll
              for (int k = 0; k < 8; ++k) ub[k] = ur[16 * k]; }
            { float a0 = 0.f, a1 = 0.f, a2 = 0.f, a3 = 0.f;
#pragma unroll
              for (int k = 0; k < 8; ++k) { a0 = dot2bf(ua[k].x, xr[k].x, a0); a1 = dot2bf(ua[k].y, xr[k].y, a1); a2 = dot2bf(ua[k].z, xr[k].z, a2); a3 = dot2bf(ua[k].w, xr[k].w, a3); }
              const float a = row16_sum((a0 + a1) + (a2 + a3));
              if (i == 0) a_lds[4 * s + g] = a; }
            if (s + 2 < 32) { const u32x4* ur = (const u32x4*)(U16 + (size_t)e_lds[4 * (s + 2) + g] * 1024) + i;
#pragma unroll
              for (int k = 0; k < 8; ++k) ua[k] = ur[16 * k]; }
            { float a0 = 0.f, a1 = 0.f, a2 = 0.f, a3 = 0.f;
#pragma unroll
              for (int k = 0; k < 8; ++k) { a0 = dot2bf(ub[k].x, xr[k].x, a0); a1 = dot2bf(ub[k].y, xr[k].y, a1); a2 = dot2bf(ub[k].z, xr[k].z, a2); a3 = dot2bf(ub[k].w, xr[k].w, a3); }
              const float a = row16_sum((a0 + a1) + (a2 + a3));
              if (i == 0) a_lds[4 * (s + 1) + g] = a; }
        }
        LDS_WAIT(); asm volatile("" ::: "memory");
        const float c0 = gelu_erf(a_lds[lane]) * g0, c1 = gelu_erf(a_lds[64 + lane]) * g1;
        const unsigned pw = pk2(c0, c1);
        float acc[16];
#pragma unroll
        for (int q = 0; q < 16; ++q) acc[q] = 0.f;
        u32x4 A0, A1, B0, B1, C0, C1, D0, D1;
#define PEER_VLOAD(j, X0, X1, Y0, Y1) do { const int ea_ = __builtin_amdgcn_readlane(e0, (j)), eb_ = __builtin_amdgcn_readlane(e1, (j)); \
            const u32x4* ra_ = (const u32x4*)(V16 + (size_t)ea_ * 1024) + lane; const u32x4* rb_ = (const u32x4*)(V16 + (size_t)eb_ * 1024) + lane; \
            X0 = ra_[0]; X1 = ra_[64]; Y0 = rb_[0]; Y1 = rb_[64]; } while (0)
#define PEER_VACC(j, X0, X1, Y0, Y1) do { const unsigned cp_ = (unsigned)__builtin_amdgcn_readlane((int)pw, (j)); \
            acc[0] = dot2bf(__builtin_amdgcn_perm(Y0.x, X0.x, 0x05040100u), cp_, acc[0]); acc[1] = dot2bf(__builtin_amdgcn_perm(Y0.x, X0.x, 0x07060302u), cp_, acc[1]); \
            acc[2] = dot2bf(__builtin_amdgcn_perm(Y0.y, X0.y, 0x05040100u), cp_, acc[2]); acc[3] = dot2bf(__builtin_amdgcn_perm(Y0.y, X0.y, 0x07060302u), cp_, acc[3]); \
            acc[4] = dot2bf(__builtin_amdgcn_perm(Y0.z, X0.z, 0x05040100u), cp_, acc[4]); acc[5] = dot2bf(__builtin_amdgcn_perm(Y0.z, X0.z, 0x07060302u), cp_, acc[5]); \
            acc[6] = dot2bf(__builtin_amdgcn_perm(Y0.w, X0.w, 0x05040100u), cp_, acc[6]); acc[7] = dot2bf(__builtin_amdgcn_perm(Y0.w, X0.w, 0x07060302u), cp_, acc[7]); \
            acc[8] = dot2bf(__builtin_amdgcn_perm(Y1.x, X1.x, 0x05040100u), cp_, acc[8]); acc[9] = dot2bf(__builtin_amdgcn_perm(Y1.x, X1.x, 0x07060302u), cp_, acc[9]); \
            acc[10] = dot2bf(__builtin_amdgcn_perm(Y1.y, X1.y, 0x05040100u), cp_, acc[10]); acc[11] = dot2bf(__builtin_amdgcn_perm(Y1.y, X1.y, 0x07060302u), cp_, acc[11]); \
            acc[12] = dot2bf(__builtin_amdgcn_perm(Y1.z, X1.z, 0x05040100u), cp_, acc[12]); acc[13] = dot2bf(__builtin_amdgcn_perm(Y1.z, X1.z, 0x07060302u), cp_, acc[13]); \
            acc[14] = dot2bf(__builtin_amdgcn_perm(Y1.w, X1.w, 0x05040100u), cp_, acc[14]); acc[15] = dot2bf(__builtin_amdgcn_perm(Y1.w, X1.w, 0x07060302u), cp_, acc[15]); } while (0)
        PEER_VLOAD(0, A0, A1, B0, B1);
#pragma unroll 1
        for (int j = 0; j < 64; j += 2) {
            PEER_VLOAD(j + 1, C0, C1, D0, D1);
            PEER_VACC(j, A0, A1, B0, B1);
            if (j + 2 < 64) PEER_VLOAD(j + 2, A0, A1, B0, B1);
            PEER_VACC(j + 1, C0, C1, D0, D1);
        }
#undef PEER_VLOAD
#undef PEER_VACC
        const float* g2 = MOD + (size_t)(t >> 11) * 6144 + 5120;
        const float* xrow1 = p.out + (size_t)t * 1024; float* orow = outp + (size_t)t * 1024;
#pragma unroll
        for (int h = 0; h < 2; ++h)
#pragma unroll
            for (int q = 0; q < 2; ++q) { const int col = 512 * h + 8 * lane + 4 * q;
                const f32x4 xv = *(const f32x4*)(xrow1 + col), gv = *(const f32x4*)(g2 + col);
                f32x4 a; a.x = acc[8 * h + 4 * q]; a.y = acc[8 * h + 4 * q + 1]; a.z = acc[8 * h + 4 * q + 2]; a.w = acc[8 * h + 4 * q + 3];
                *(f32x4*)(orow + col) = xv + gv * a; }
    }
}
typedef short v4i16_t __attribute__((ext_vector_type(4)));
#ifndef DSA_REP_A
#define DSA_REP_A 1
#endif
#ifndef DSA_REP_B
#define DSA_REP_B 1
#endif
#ifndef DSA_REP_C
#define DSA_REP_C 1
#endif
constexpr int DSA_SROW = 2048 * 4 + 16;
constexpr int DSA_SEL_OFF = 16 * DSA_SROW;
constexpr int DSA_LDS = DSA_SEL_OFF + 16 * 512;
constexpr int DSA_KVROW = 272;

__device__ __forceinline__ unsigned sortkey(float s) { const unsigned u = __float_as_uint(s); return u ^ ((u >> 31) ? 0xffffffffu : 0x80000000u); }
__device__ __forceinline__ unsigned cvtpk_bf16(float lo, float hi) { unsigned r; asm volatile("v_cvt_pk_bf16_f32 %0, %1, %2" : "=v"(r) : "v"(lo), "v"(hi)); return r; }

__device__ __forceinline__ void ph_dsa(const Params& p, unsigned char* lds, int vb, int nvb) {
    const bf16* PROJ = (const bf16*)(p.ws + WS_PROJ); bf16* MIX = (bf16*)(p.ws + WS_MIX);
    const float MB = ((const float*)(p.ws + WS_SCAL))[SC_MB];
    int tid = threadIdx.x; asm volatile("" : "+v"(tid)); const int lane = tid & 63, wv = __builtin_amdgcn_readfirstlane(tid >> 6);
    const int l15 = lane & 15, g = lane >> 4;
    LAS unsigned char* ldsl = (LAS unsigned char*)lds;
    for (int it = vb; it < 2048; it += nvb) {
        const int vbb = it & 255, kk = it >> 8, xg = vbb & 7, ix = vbb >> 3, b = 2 * xg + (ix & 1), G = (ix >> 1) & 3, sub = ix >> 3;
        const int c = (kk & 1) ? (31 - G - 8 * (kk >> 1)) : (G + 8 * (kk >> 1));
        const int cend = (c + 1) * 64, t0 = c * 64 + sub * 16;
        const bf16* Pb = PROJ + (size_t)b * SEQ * NP;
#pragma unroll 1
        for (int repa = 0; repa < DSA_REP_A; ++repa)
        if (c >= 4) {
            const bf16* qrow = Pb + (size_t)(t0 + l15) * NP;
            bf16x8 bq[4][2]; float wsc[4];
#pragma unroll
            for (int h = 0; h < 4; ++h) { wsc[h] = bf2f(qrow[C_WI + h]) * 0.0625f;
#pragma unroll
                for (int ks = 0; ks < 2; ++ks) bq[h][ks] = *(const bf16x8*)(qrow + C_QI + h * 64 + 32 * ks + 8 * g); }
            for (int k0 = 16 * wv; k0 < cend; k0 += 128) {
                const bf16* krow = Pb + (size_t)(k0 + l15) * NP + C_KI + 8 * g;
                const bf16x8 ka0 = *(const bf16x8*)krow, ka1 = *(const bf16x8*)(krow + 32);
                f32x4 sc = {0.f, 0.f, 0.f, 0.f};
#pragma unroll
                for (int h = 0; h < 4; ++h) { f32x4 a = {0.f, 0.f, 0.f, 0.f};
                    a = __builtin_amdgcn_mfma_f32_16x16x32_bf16(ka0, bq[h][0], a, 0, 0, 0);
                    a = __builtin_amdgcn_mfma_f32_16x16x32_bf16(ka1, bq[h][1], a, 0, 0, 0);
#pragma unroll
                    for (int r = 0; r < 4; ++r) sc[r] = fmaf(fmaxf(a[r], 0.f), wsc[h], sc[r]); }
#pragma unroll
                for (int r = 0; r < 4; ++r) sc[r] = (sc[r] == 0.f) ? 0.f : sc[r];
                *(LAS f32x4*)(ldsl + l15 * DSA_SROW + (k0 + 4 * g) * 4) = sc;
            }
        }
        __syncthreads();
        LAS unsigned short* selw = (LAS unsigned short*)(ldsl + DSA_SEL_OFF);
        int mind0 = 0, mind1 = 0;
#pragma unroll 1
        for (int qi2 = 0; qi2 < 2 * DSA_REP_B; ++qi2) { const int qi = qi2 & 1;
            const int qq = 2 * wv + qi, t = t0 + qq;
            LAS unsigned short* sel = selw + qq * 256;
            if (c < 4) { for (int j = lane; j < 256; j += 64) sel[j] = (unsigned short)j; continue; }
            const int nreg = cend >> 6;
            unsigned key[32];
            const LAS float* srow = (const LAS float*)(ldsl + qq * DSA_SROW) + lane;
#pragma unroll
            for (int i = 0; i < 32; ++i) key[i] = (i < nreg) ? sortkey(srow[64 * i]) : 0u;
            unsigned prefix = 0u; bool exact = false;
#pragma unroll 1
            for (int bit = 31; bit >= 0; --bit) {
                const unsigned cand = prefix | (1u << bit); int cnt = 0;
#pragma unroll
                for (int i = 0; i < 32; ++i) cnt += __popcll(__ballot(key[i] >= cand));
                if (cnt >= 256) { prefix = cand; if (cnt == 256) { exact = true; break; } }
            }
            int need_ties = 0;
            if (!exact) { int cgt = 0;
                if (prefix != 0xffffffffu) {
#pragma unroll
                    for (int i = 0; i < 32; ++i) cgt += __popcll(__ballot(key[i] > prefix)); }
                need_ties = 256 - cgt; }
            int base = 0, tbase = 0, md = 4096;
#pragma unroll
            for (int i = 0; i < 32; ++i) {
                if (i < nreg) {
                    bool selb;
                    if (exact) selb = key[i] >= prefix;
                    else { const bool tie = key[i] == prefix; const unsigned long long mt = __ballot(tie);
                        const int trank = tbase + (int)__builtin_amdgcn_mbcnt_hi((unsigned)(mt >> 32), __builtin_amdgcn_mbcnt_lo((unsigned)mt, 0u));
                        selb = (key[i] > prefix) || (tie && trank < need_ties); tbase += __popcll(mt); }
                    const unsigned long long m = __ballot(selb);
                    const int pos = base + (int)__builtin_amdgcn_mbcnt_hi((unsigned)(m >> 32), __builtin_amdgcn_mbcnt_lo((unsigned)m, 0u));
                    const int kidx = i * 64 + lane;
                    if (selb) { sel[pos] = (unsigned short)kidx; const int d = t > kidx ? t - kidx : kidx - t; md = d < md ? d : md; }
                    base += __popcll(m);
                }
            }
#pragma unroll
            for (int o = 1; o < 64; o <<= 1) { const int x = __shfl_xor(md, o); md = x < md ? x : md; }
            if (qi == 0) mind0 = md; else mind1 = md;
        }
        LDS_WAIT(); asm volatile("" ::: "memory");
        const int nvalid = cend < 256 ? cend : 256;
        const int head = lane & 7;
        const float slopeL2 = exp2f(-(float)(head + 1)) * 1.4426950409f;
#pragma unroll 1
        for (int qi2 = 0; qi2 < 2 * DSA_REP_C; ++qi2) { const int qi = qi2 & 1;
            const int qq = 2 * wv + qi, t = t0 + qq;
            const LAS unsigned short* sel = selw + qq * 256;
            LAS unsigned char* stg = ldsl + (2 * wv) * DSA_SROW;
            const bf16* qrow = Pb + (size_t)t * NP + C_QB + head * 128 + 8 * g;
            bf16x8 bq[4];
#pragma unroll
            for (int ks = 0; ks < 4; ++ks) bq[ks] = *(const bf16x8*)(qrow + 32 * ks);
            const float refL2 = MB * 1.4426950409f - slopeL2 * (float)(qi == 0 ? mind0 : mind1);
            f32x4 o[8];
#pragma unroll
            for (int dt = 0; dt < 8; ++dt) o[dt] = (f32x4){0.f, 0.f, 0.f, 0.f};
            float lsum = 0.f;
#define DSA_GATHER(S, KA) do { _Pragma("unroll") for (int tl = 0; tl < 2; ++tl) { const int jr = 32 * (S) + 16 * tl + l15; const int keyr = sel[jr < nvalid ? jr : 0];   \
        const bf16* kvrow = Pb + (size_t)keyr * NP + C_KV + 8 * g;                                                                                     \
        _Pragma("unroll") for (int ks = 0; ks < 4; ++ks) KA[tl][ks] = *(const bf16x8*)(kvrow + 32 * ks); } } while (0)
#define DSA_COMPUTE(S, KA) do { unsigned pb[4];                                                                                                        \
        _Pragma("unroll") for (int tl = 0; tl < 2; ++tl) { const int j0 = 32 * (S) + 16 * tl;                                                           \
            f32x4 a = {0.f, 0.f, 0.f, 0.f};                                                                                                             \
            _Pragma("unroll") for (int ks = 0; ks < 4; ++ks) { a = __builtin_amdgcn_mfma_f32_16x16x32_bf16(KA[tl][ks], bq[ks], a, 0, 0, 0);             \
                *(LAS bf16x8*)(stg + (16 * tl + l15) * DSA_KVROW + (32 * ks + 8 * g) * 2) = KA[tl][ks]; }                                               \
            const u32x2 kw = *(const LAS u32x2*)(sel + j0 + 4 * g);                                                                                     \
            const int kx[4] = {(int)(kw.x & 0xffffu), (int)(kw.x >> 16), (int)(kw.y & 0xffffu), (int)(kw.y >> 16)};                                     \
            float pr[4];                                                                                                                                \
            _Pragma("unroll") for (int r = 0; r < 4; ++r) { const int dd = t > kx[r] ? t - kx[r] : kx[r] - t;                                            \
                const float e = __builtin_amdgcn_exp2f(fmaf(a[r], 0.1275174f, -slopeL2 * (float)dd - refL2));                                            \
                pr[r] = (j0 + 4 * g + r < nvalid) ? e : 0.f; lsum += pr[r]; }                                                                           \
            pb[2 * tl] = cvtpk_bf16(pr[0], pr[1]); pb[2 * tl + 1] = cvtpk_bf16(pr[2], pr[3]); }                                                         \
        LDS_WAIT(); asm volatile("" ::: "memory");                                                                                                      \
        u32x4 pw4; pw4.x = pb[0]; pw4.y = pb[1]; pw4.z = pb[2]; pw4.w = pb[3];                                                                          \
        const bf16x8 pfrag = __builtin_bit_cast(bf16x8, pw4);                                                                                           \
        const LAS unsigned char* trb = stg + (4 * g + (l15 >> 2)) * DSA_KVROW + (4 * (lane & 3)) * 2;                                                   \
        _Pragma("unroll") for (int dt = 0; dt < 8; ++dt) {                                                                                              \
            const s16x4 lo = __builtin_bit_cast(s16x4, __builtin_amdgcn_ds_read_tr16_b64_v4i16((LAS v4i16_t*)(trb + dt * 32)));                         \
            const s16x4 hi = __builtin_bit_cast(s16x4, __builtin_amdgcn_ds_read_tr16_b64_v4i16((LAS v4i16_t*)(trb + 16 * DSA_KVROW + dt * 32)));        \
            const bf16x8 af = {lo[0], lo[1], lo[2], lo[3], hi[0], hi[1], hi[2], hi[3]};                                                                 \
            o[dt] = __builtin_amdgcn_mfma_f32_16x16x32_bf16(af, pfrag, o[dt], 0, 0, 0); }                                                               \
        LDS_WAIT(); asm volatile("" ::: "memory"); } while (0)
            const int nch = (nvalid + 31) >> 5;
            bf16x8 KA[2][4], KB[2][4];
            DSA_GATHER(0, KA);
#pragma unroll 1
            for (int s = 0; s < nch; s += 2) {
                if (s + 1 < nch) DSA_GATHER(s + 1, KB);
                DSA_COMPUTE(s, KA);
                if (s + 1 < nch) { if (s + 2 < nch) DSA_GATHER(s + 2, KA); DSA_COMPUTE(s + 1, KB); }
            }
#undef DSA_GATHER
#undef DSA_COMPUTE
            lsum += __shfl_xor(lsum, 16); lsum += __shfl_xor(lsum, 32);
            const float il = 1.f / lsum;
            if (l15 < 8) {
                bf16* orow = MIX + (size_t)(b * SEQ + t) * MIXW + 512 + head * 128 + 4 * g;
#pragma unroll
                for (int dt = 0; dt < 8; ++dt) { u32x2 w; w.x = pk2(o[dt][0] * il, o[dt][1] * il); w.y = pk2(o[dt][2] * il, o[dt][3] * il); *(u32x2*)(orow + 16 * dt) = w; }
            }
        }
        __syncthreads();
    }
}
typedef __attribute__((address_space(1))) float GASF;
__device__ __forceinline__ int crow(int r, int hi) { return (r & 3) + 8 * (r >> 2) + 4 * hi; }
#define KSWZ64(row, cb) ((row) * 128 + ((cb) ^ ((((row) >> 1) & 7) << 4)))
__device__ __forceinline__ int v_st(int k, int c) { const int kk = (k & ~0xC) | ((k & 4) << 1) | ((k & 8) >> 1); return ((kk >> 3) * 4 + (c >> 5)) * 512 + ((kk & 7) * 32 + (c & 31)) * 2; }
__device__ __forceinline__ int v_rd_base(int lane) { return ((lane & 3) << 3) | (((lane >> 2) & 3) << 6) | (((lane >> 4) & 1) << 5) | (((lane >> 5) & 1) << 8); }
constexpr int v_rd_off(int d0, int ks, int half) { return d0 * 512 + ks * 4096 + half * 2048; }
template <int OFF> __device__ __forceinline__ s16x4 tr_read(int vb) {
    s16x4 r; asm volatile("ds_read_b64_tr_b16 %0, %1 offset:%2" : "=&v"(r) : "v"(vb), "i"(OFF) : "memory"); return r;
}
template <int D0> __device__ __forceinline__ void pv_one(f32x16& od, int vb, bf16x8 pa0, bf16x8 pa1, bf16x8 pa2, bf16x8 pa3) {
    const s16x4 l0 = tr_read<v_rd_off(D0, 0, 0)>(vb), h0 = tr_read<v_rd_off(D0, 0, 1)>(vb), l1 = tr_read<v_rd_off(D0, 1, 0)>(vb), h1 = tr_read<v_rd_off(D0, 1, 1)>(vb);
    const s16x4 l2 = tr_read<v_rd_off(D0, 2, 0)>(vb), h2 = tr_read<v_rd_off(D0, 2, 1)>(vb), l3 = tr_read<v_rd_off(D0, 3, 0)>(vb), h3 = tr_read<v_rd_off(D0, 3, 1)>(vb);
    asm volatile("s_waitcnt lgkmcnt(0)" ::: "memory"); __builtin_amdgcn_sched_barrier(0);
#define PK(L, H) (bf16x8){L[0], L[1], L[2], L[3], H[0], H[1], H[2], H[3]}
    od = __builtin_amdgcn_mfma_f32_32x32x16_bf16(pa0, PK(l0, h0), od, 0, 0, 0);
    od = __builtin_amdgcn_mfma_f32_32x32x16_bf16(pa1, PK(l1, h1), od, 0, 0, 0);
    od = __builtin_amdgcn_mfma_f32_32x32x16_bf16(pa2, PK(l2, h2), od, 0, 0, 0);
    od = __builtin_amdgcn_mfma_f32_32x32x16_bf16(pa3, PK(l3, h3), od, 0, 0, 0);
#undef PK
}
constexpr int ATT_LDS = 2 * 16384 + 2 * 8192 + 8 * 256;

__device__ __forceinline__ void ph_attnA(const Params& p, unsigned char* lds, int vb, int nvb) {
    const bf16* PROJ = (const bf16*)(p.ws + WS_PROJ); bf16* MIX = (bf16*)(p.ws + WS_MIX);
    const float* SC = (const float*)(p.ws + WS_SCAL);
    const float lam = SC[SC_LAM], refL2 = SC[SC_MA] * 1.4426950409f;
    constexpr float C = 0.125f * 1.4426950409f;
    int tid = threadIdx.x; asm volatile("" : "+v"(tid)); const int lane = tid & 63, wid = __builtin_amdgcn_readfirstlane(tid >> 6), r32 = lane & 31, hi = lane >> 5;
    unsigned char* V_lds = lds; unsigned char* K_lds = lds + 32768;
    float* wsf = (float*)(lds + 49152) + wid * 64;
    GASF* tmpw = (GASF*)(p.ws + WS_ATMP) + ((size_t)(vb * NWV + wid) * 64) * 64 + lane;
    const int vbase = (int)(uintptr_t)V_lds + v_rd_base(lane);
    const int krow = tid >> 3, kch = tid & 7, kdst = KSWZ64(krow, kch * 16);
    const int sr = tid >> 4, sc = (tid & 15) * 8, vst0 = v_st(sr, sc), vst1 = v_st(32 + sr, sc);
    for (int it = vb; it < 256; it += nvb) {
        const int xg_ = it & 7, m_ = it >> 3, pidx = xg_ * 8 + (m_ >> 2), qbl = m_ & 3, b = pidx >> 2, h = pidx & 3;
        const float slopeL2 = exp2f(-2.0f * (float)(h + 1)) * 1.4426950409f;
        const bf16* Pb = PROJ + (size_t)b * SEQ * NP;
#pragma unroll 1
        for (int half = 0; half < 2; ++half) {
            const int qb = half ? 7 - qbl : qbl, q0 = 256 * qb, NTu = 4 * (qb + 1), cw = 4 * qb + (wid >> 1);
            const int tq = q0 + 32 * wid + r32;
#pragma unroll 1
            for (int mi = 0; mi < 2; ++mi) {
                const int m = 1 - mi;
                const bf16* Kg = Pb + C_KA + h * 128 + m * 64 + (size_t)krow * NP + kch * 8;
                const bf16* Vg = Pb + C_VA + h * 128 + (size_t)sr * NP + sc;
                bf16x8 qr[4];
                { const bf16* qp = Pb + (size_t)tq * NP + C_QA + h * 128 + m * 64 + hi * 8;
#pragma unroll
                  for (int d0 = 0; d0 < 4; ++d0) qr[d0] = *(const bf16x8*)(qp + d0 * 16); }
                f32x16 o[4];
#pragma unroll
                for (int d = 0; d < 4; ++d) o[d] = f32x16{};
                float lsum = 0.f;
                bf16x8 sk, sv0, sv1;
                sk = *(const bf16x8*)Kg; sv0 = *(const bf16x8*)Vg; sv1 = *(const bf16x8*)(Vg + (size_t)32 * NP);
                *(bf16x8*)(K_lds + kdst) = sk; *(bf16x8*)(V_lds + vst0) = sv0; *(bf16x8*)(V_lds + vst1) = sv1;
                __syncthreads();
#pragma unroll 1
                for (int j = 0; j < NTu; ++j) {
                    const int buf = j & 1;
                    if (j + 1 < NTu) { const size_t go = (size_t)(j + 1) * 64 * NP; sk = *(const bf16x8*)(Kg + go); sv0 = *(const bf16x8*)(Vg + go); sv1 = *(const bf16x8*)(Vg + go + (size_t)32 * NP); }
                    if (j <= cw) {
                        const unsigned char* Kb = K_lds + buf * 8192;
                        const float dq = (float)(tq - 64 * j - 4 * hi);
                        const float B0 = -slopeL2 * dq - refL2;
                        const bool past = j < cw;
                        float ps = 0.f;
                        bf16x8 pa0, pa1, pa2, pa3;
#define PK4(P, BASE, OUT) do { unsigned a0 = cvtpk_bf16(P[BASE + 0], P[BASE + 1]), a1 = cvtpk_bf16(P[BASE + 2], P[BASE + 3]);   \
    unsigned b0_ = cvtpk_bf16(P[BASE + 4], P[BASE + 5]), b1_ = cvtpk_bf16(P[BASE + 6], P[BASE + 7]);                              \
    auto r0 = __builtin_amdgcn_permlane32_swap(a0, b0_, false, false); auto r1 = __builtin_amdgcn_permlane32_swap(a1, b1_, false, false); \
    u32x4 w = {r0[0], r1[0], r0[1], r1[1]}; OUT = __builtin_bit_cast(bf16x8, w); } while (0)
#define HALF_TILE(KOFF, FOFF, PA, PB) do { f32x16 pp = f32x16{};                                                                     \
    _Pragma("unroll") for (int d0 = 0; d0 < 4; ++d0) { const int cb = (d0 * 16 + hi * 8) * 2;                                        \
        const bf16x8 bk = *(const bf16x8*)(Kb + KSWZ64((KOFF) + r32, cb)); pp = __builtin_amdgcn_mfma_f32_32x32x16_bf16(bk, qr[d0], pp, 0, 0, 0); } \
    if (past) { _Pragma("unroll") for (int r = 0; r < 16; ++r) { const float off = (float)((r & 3) + 8 * (r >> 2)) + (FOFF);          \
            pp[r] = __builtin_amdgcn_exp2f(fmaf(pp[r], C, fmaf(slopeL2, off, B0))); } }                                               \
    else { _Pragma("unroll") for (int r = 0; r < 16; ++r) { const float off = (float)((r & 3) + 8 * (r >> 2)) + (FOFF);               \
            pp[r] = __builtin_amdgcn_exp2f(fmaf(pp[r], C, -slopeL2 * fabsf(dq - off) - refL2)); } }                                   \
    _Pragma("unroll") for (int r = 0; r < 16; ++r) ps += pp[r];                                                                       \
    PK4(pp, 0, PA); PK4(pp, 8, PB); __builtin_amdgcn_sched_barrier(0); } while (0)
                        HALF_TILE(0, 0.f, pa0, pa1);
                        HALF_TILE(32, 32.f, pa2, pa3);
#undef HALF_TILE
#undef PK4
                        { auto rr = __builtin_amdgcn_permlane32_swap(__float_as_uint(ps), __float_as_uint(ps), false, false);
                          ps = __uint_as_float(rr[0]) + __uint_as_float(rr[1]); }
                        lsum += ps;
                        const int vb0 = vbase + buf * 16384;
                        pv_one<0>(o[0], vb0, pa0, pa1, pa2, pa3); pv_one<1>(o[1], vb0, pa0, pa1, pa2, pa3); pv_one<2>(o[2], vb0, pa0, pa1, pa2, pa3); pv_one<3>(o[3], vb0, pa0, pa1, pa2, pa3);
                    }
                    if (j + 1 < NTu) { const int nb = buf ^ 1;
                        *(bf16x8*)(K_lds + nb * 8192 + kdst) = sk; *(bf16x8*)(V_lds + nb * 16384 + vst0) = sv0; *(bf16x8*)(V_lds + nb * 16384 + vst1) = sv1; }
                    __syncthreads();
                }
                if (hi == 0) wsf[r32] = lsum;
                LDS_WAIT(); asm volatile("" ::: "memory");
                float rli[16];
#pragma unroll
                for (int r = 0; r < 16; ++r) rli[r] = 1.f / wsf[crow(r, hi)];
                LDS_WAIT(); asm volatile("" ::: "memory");
                if (mi == 0) {
#pragma unroll
                    for (int d = 0; d < 4; ++d) { GASF* td = tmpw + d * 1024; asm volatile("" : "+v"(td));
#pragma unroll
                        for (int r = 0; r < 16; ++r) td[r * 64] = o[d][r] * rli[r]; }
                } else {
                    float gsub[4];
#pragma unroll
                    for (int d = 0; d < 4; ++d) gsub[d] = p.a_sub_gain[32 * d + r32];
                    GASF* tdp[4];
#pragma unroll
                    for (int d = 0; d < 4; ++d) { tdp[d] = tmpw + d * 1024; asm volatile("" : "+v"(tdp[d])); }
#pragma unroll
                    for (int r = 0; r < 16; ++r) {
                        float v[4]; float ss = 0.f;
#pragma unroll
                        for (int d = 0; d < 4; ++d) { v[d] = o[d][r] * rli[r] - lam * tdp[d][r * 64]; ss += v[d] * v[d]; }
                        ss += __shfl_xor(ss, 1); ss += __shfl_xor(ss, 2); ss += __shfl_xor(ss, 4); ss += __shfl_xor(ss, 8); ss += __shfl_xor(ss, 16);
                        const float rs = rsqrtf(ss * (1.f / 128.f) + EPS) * 0.8f;
                        bf16* orow = MIX + (size_t)(b * SEQ + q0 + 32 * wid + crow(r, hi)) * MIXW + h * 128 + r32;
#pragma unroll
                        for (int d = 0; d < 4; ++d) orow[32 * d] = (bf16)f2bf(v[d] * rs * gsub[d]);
                        asm volatile("" ::: "memory");
                    }
                }
            }
        }
    }
}
constexpr int RT_WAVE_BYTES = 12288;
constexpr int RT_LDS = 32768 + 8 * RT_WAVE_BYTES;

__device__ __forceinline__ int pl32_sum(int v) { auto rr = __builtin_amdgcn_permlane32_swap((unsigned)v, (unsigned)v, false, false); return (int)(rr[0] + rr[1]); }
__device__ __forceinline__ int pl32_other(int v) { auto rr = __builtin_amdgcn_permlane32_swap((unsigned)v, (unsigned)v, false, false); return (int)(rr[0] + rr[1]) - v; }
__device__ __forceinline__ float unsortkey(unsigned k) { return __uint_as_float((k & 0x80000000u) ? (k ^ 0x80000000u) : ~k); }

template <int N> __device__ __forceinline__ unsigned bisect16(const unsigned (&key)[N]) {
    unsigned prefix = 0u; bool done = false;
#pragma unroll 1
    for (int bit = 31; bit >= 0; --bit) {
        const unsigned cand = done ? prefix : (prefix | (1u << bit));
        int cnt = 0;
#pragma unroll
        for (int i = 0; i < N; ++i) cnt += (key[i] >= cand) ? 1 : 0;
        const int tot = pl32_sum(cnt);
        if (!done && tot >= 16) { prefix = cand; done = (tot == 16); }
        if (__all(done)) break;
    }
    return prefix;
}

__device__ __forceinline__ void ph_route(const Params& p, unsigned char* lds, int vb, int nvb) {
    const bf16* Q3 = (const bf16*)(p.ws + WS_Q3); const bf16* SUBK = (const bf16*)(p.ws + WS_SUBK);
    int* EXPI = (int*)(p.ws + WS_EXP); float* GATE = (float*)(p.ws + WS_GATE);
    int tid = threadIdx.x; asm volatile("" : "+v"(tid));
    const int lane = tid & 63, wv = __builtin_amdgcn_readfirstlane(tid >> 6), r32 = lane & 31, hi = lane >> 5;
    for (int i = tid; i < 2048; i += NT) ((u32x4*)lds)[i] = ((const u32x4*)SUBK)[i];
    __syncthreads();
    unsigned char* wl = lds + 32768 + wv * RT_WAVE_BYTES;
    float* sv = (float*)wl; int* si = (int*)(wl + 4096); float* fv = (float*)(wl + 8192); int* fe = (int*)(wl + 10240);
    const int gw = vb * NWV + wv, ngw = nvb * NWV;
    for (int item = gw; item < (T / 32) * 8; item += ngw) {
        const int h = item & 7, tok0 = (item >> 3) * 32;
        const bf16* qrow = Q3 + (size_t)(tok0 + r32) * 1024 + h * 128 + hi * 8;
#pragma unroll 1
        for (int c = 0; c < 2; ++c) {
            bf16x8 bq[4];
#pragma unroll
            for (int d0 = 0; d0 < 4; ++d0) bq[d0] = *(const bf16x8*)(qrow + c * 64 + d0 * 16);
            unsigned key[64];
#pragma unroll
            for (int nt = 0; nt < 4; ++nt) {
                f32x16 acc = f32x16{};
                const unsigned char* kp = lds + ((c * 128 + nt * 32 + r32) * 64 + hi * 8) * 2;
#pragma unroll
                for (int d0 = 0; d0 < 4; ++d0) { const bf16x8 ak = *(const bf16x8*)(kp + d0 * 32); acc = __builtin_amdgcn_mfma_f32_32x32x16_bf16(ak, bq[d0], acc, 0, 0, 0); }
#pragma unroll
                for (int r = 0; r < 16; ++r) key[nt * 16 + r] = sortkey(acc[r]);
            }
            const unsigned thr = bisect16<64>(key);
            int cnt = 0;
#pragma unroll
            for (int i = 0; i < 64; ++i) cnt += (key[i] >= thr) ? 1 : 0;
            const int other_ = pl32_other(cnt); int slot = hi ? other_ : 0;
            float* svp = sv + (r32 * 2 + c) * 16; int* sip = si + (r32 * 2 + c) * 16;
#pragma unroll
            for (int i = 0; i < 64; ++i) {
                if (key[i] >= thr && slot < 16) { svp[slot] = unsortkey(key[i]); sip[slot] = 32 * (i >> 4) + ((i & 3) + 8 * ((i & 15) >> 2)) + 4 * hi; ++slot; }
            }
        }
        LDS_WAIT(); asm volatile("" ::: "memory");
        {
            const float* s0 = sv + (r32 * 2) * 16 + 8 * hi; const float* s1 = sv + (r32 * 2 + 1) * 16;
            float a0[8], a1[16];
#pragma unroll
            for (int i = 0; i < 8; ++i) a0[i] = s0[i];
#pragma unroll
            for (int j = 0; j < 16; ++j) a1[j] = s1[j];
            unsigned key[128];
#pragma unroll
            for (int i = 0; i < 8; ++i)
#pragma unroll
                for (int j = 0; j < 16; ++j) key[i * 16 + j] = sortkey(a0[i] + a1[j]);
            const unsigned thr = bisect16<128>(key);
            int cnt = 0;
#pragma unroll
            for (int i = 0; i < 128; ++i) cnt += (key[i] >= thr) ? 1 : 0;
            const int other_ = pl32_other(cnt); int slot = hi ? other_ : 0;
            const int* i0 = si + (r32 * 2) * 16 + 8 * hi; const int* i1 = si + (r32 * 2 + 1) * 16;
            float* fvp = fv + r32 * 16; int* fep = fe + r32 * 16;
#pragma unroll
            for (int i = 0; i < 128; ++i) {
                if (key[i] >= thr && slot < 16) { fvp[slot] = unsortkey(key[i]); fep[slot] = i0[i >> 4] * 128 + i1[i & 15]; ++slot; }
            }
        }
        LDS_WAIT(); asm volatile("" ::: "memory");
        {
            const float* fvp = fv + r32 * 16;
            float v[16]; float mx = -3e38f;
#pragma unroll
            for (int k = 0; k < 16; ++k) { v[k] = fvp[k]; mx = fmaxf(mx, v[k]); }
            float l = 0.f;
#pragma unroll
            for (int k = 0; k < 16; ++k) { v[k] = __expf(v[k] - mx); l += v[k]; }
            const float il = 1.f / l;
            const size_t ob = (size_t)(tok0 + r32) * 128 + h * 16 + 8 * hi;
            const int* fep = fe + r32 * 16 + 8 * hi;
            f32x4 g0, g1; u32x4 e0, e1;
            if (hi == 0) { g0 = (f32x4){v[0] * il, v[1] * il, v[2] * il, v[3] * il}; g1 = (f32x4){v[4] * il, v[5] * il, v[6] * il, v[7] * il}; }
            else { g0 = (f32x4){v[8] * il, v[9] * il, v[10] * il, v[11] * il}; g1 = (f32x4){v[12] * il, v[13] * il, v[14] * il, v[15] * il}; }
            e0 = *(const u32x4*)fep; e1 = *(const u32x4*)(fep + 4);
            *(f32x4*)(GATE + ob) = g0; *(f32x4*)(GATE + ob + 4) = g1;
            *(u32x4*)(EXPI + ob) = e0; *(u32x4*)(EXPI + ob + 4) = e1;
        }
        LDS_WAIT(); asm volatile("" ::: "memory");
    }
    __syncthreads();
}
constexpr int PU_UNITS = T / 64;
constexpr int CW_PEER_U = 4096, CW_PEER_V = 4096 + 16 * 64;

__device__ __forceinline__ unsigned peer_xcc() { return (unsigned)__builtin_amdgcn_s_getreg((3 << 11) | 20) & 7u; }

__device__ __forceinline__ void ph_peer_u(const Params& p, unsigned char* lds, int cwbase) {
    const bf16* H = (const bf16*)(p.ws + WS_H); const bf16* U16 = (const bf16*)(p.ws + WS_U16);
    const int* EXPI = (const int*)(p.ws + WS_EXP); const float* GATE = (const float*)(p.ws + WS_GATE); float* CBUF = (float*)(p.ws + WS_CBUF);
    unsigned* ctl = (unsigned*)(p.ws + WS_CTL);
    int tid = threadIdx.x; asm volatile("" : "+v"(tid));
    const int lane = tid & 63, wv = __builtin_amdgcn_readfirstlane(tid >> 6), g = lane >> 4, i = lane & 15;
    volatile LAS unsigned* slot = (volatile LAS unsigned*)(LAS unsigned char*)lds;
    int* le = (int*)(lds + 1024 + wv * 1024); int* lj = le + 128;
    const unsigned xcc = peer_xcc();
#pragma unroll 1
    for (int k = 0; k < 16; ++k) {
        const int part = (int)((2u * xcc + (unsigned)k) & 15u);
#pragma unroll 1
        for (;;) {
            if (tid == 0) *slot = __hip_atomic_fetch_add(ctl + cwbase + 64 * part, 1u, __ATOMIC_RELAXED, __HIP_MEMORY_SCOPE_AGENT);
            __syncthreads();
            const unsigned unit = *slot;
            __syncthreads();
            if (unit >= (unsigned)PU_UNITS) break;
#pragma unroll 1
            for (int tt = 0; tt < 8; ++tt) {
                const int t = (int)unit * 64 + wv * 8 + tt;
                const int e0 = EXPI[(size_t)t * 128 + lane], e1 = EXPI[(size_t)t * 128 + 64 + lane];
                const bool in0 = (e0 >> 10) == part, in1 = (e1 >> 10) == part;
                const unsigned long long m0 = __ballot(in0), m1 = __ballot(in1);
                const int n0 = __popcll(m0), n = n0 + __popcll(m1);
                if (n == 0) continue;
                if (in0) { const int pos = (int)__builtin_amdgcn_mbcnt_hi((unsigned)(m0 >> 32), __builtin_amdgcn_mbcnt_lo((unsigned)m0, 0u)); le[pos] = e0; lj[pos] = lane; }
                if (in1) { const int pos = n0 + (int)__builtin_amdgcn_mbcnt_hi((unsigned)(m1 >> 32), __builtin_amdgcn_mbcnt_lo((unsigned)m1, 0u)); le[pos] = e1; lj[pos] = 64 + lane; }
                u32x4 xr[8];
                { const u32x4* xrow = (const u32x4*)(H + (size_t)t * 1024) + i;
#pragma unroll
                  for (int q = 0; q < 8; ++q) xr[q] = xrow[16 * q]; }
                LDS_WAIT(); asm volatile("" ::: "memory");
#pragma unroll 1
                for (int s = 0; 4 * s < n; ++s) {
                    const int idx = 4 * s + g; const bool valid = idx < n;
                    const int e = le[valid ? idx : 0];
                    const u32x4* ur = (const u32x4*)(U16 + (size_t)e * 1024) + i;
                    u32x4 ua[8];
#pragma unroll
                    for (int q = 0; q < 8; ++q) ua[q] = ur[16 * q];
                    float a0 = 0.f, a1 = 0.f, a2 = 0.f, a3 = 0.f;
#pragma unroll
                    for (int q = 0; q < 8; ++q) { a0 = dot2bf(ua[q].x, xr[q].x, a0); a1 = dot2bf(ua[q].y, xr[q].y, a1); a2 = dot2bf(ua[q].z, xr[q].z, a2); a3 = dot2bf(ua[q].w, xr[q].w, a3); }
                    const float a = row16_sum((a0 + a1) + (a2 + a3));
                    if (i == 0 && valid) { const size_t gi = (size_t)t * 128 + lj[idx]; __hip_atomic_store(CBUF + gi, gelu_erf(a) * GATE[gi], __ATOMIC_RELAXED, __HIP_MEMORY_SCOPE_AGENT); }
                }
                LDS_WAIT(); asm volatile("" ::: "memory");
            }
        }
    }
}

__device__ __forceinline__ void ph_peer_v(const Params& p, unsigned char* lds) {
    const bf16* V16 = (const bf16*)(p.ws + WS_V16);
    const int* EXPI = (const int*)(p.ws + WS_EXP); const float* GATE = (const float*)(p.ws + WS_CBUF); const float* MOD = (const float*)(p.ws + WS_MOD);
    unsigned* ctl = (unsigned*)(p.ws + WS_CTL);
    int tid = threadIdx.x; asm volatile("" : "+v"(tid));
    const int lane = tid & 63, wv = __builtin_amdgcn_readfirstlane(tid >> 6), g8 = lane >> 3, i8 = lane & 7;
    volatile LAS unsigned* slot = (volatile LAS unsigned*)(LAS unsigned char*)lds;
    int* le = (int*)(lds + 1024 + wv * 1024); float* lc = (float*)(le + 128);
    const unsigned xcc = peer_xcc();
#pragma unroll 1
    for (int k = 0; k < 16; ++k) {
        const int sl = (int)((2u * xcc + (unsigned)k) & 15u);
#pragma unroll 1
        for (;;) {
            if (tid == 0) *slot = __hip_atomic_fetch_add(ctl + CW_PEER_V + 64 * sl, 1u, __ATOMIC_RELAXED, __HIP_MEMORY_SCOPE_AGENT);
            __syncthreads();
            const unsigned unit = *slot;
            __syncthreads();
            if (unit >= (unsigned)PU_UNITS) break;
#pragma unroll 1
            for (int tt = 0; tt < 8; ++tt) {
                const int t = (int)unit * 64 + wv * 8 + tt;
                le[lane] = EXPI[(size_t)t * 128 + lane]; le[64 + lane] = EXPI[(size_t)t * 128 + 64 + lane];
                lc[lane] = GATE[(size_t)t * 128 + lane]; lc[64 + lane] = GATE[(size_t)t * 128 + 64 + lane];
                LDS_WAIT(); asm volatile("" ::: "memory");
                float acc[8];
#pragma unroll
                for (int q = 0; q < 8; ++q) acc[q] = 0.f;
                const bf16* vcol = V16 + 64 * sl + 8 * i8;
#pragma unroll
                for (int kk = 0; kk < 8; ++kk) {
                    const int ja = 8 * kk + g8, jb = 64 + 8 * kk + g8;
                    const u32x4 A = *(const u32x4*)(vcol + (size_t)le[ja] * 1024), B = *(const u32x4*)(vcol + (size_t)le[jb] * 1024);
                    const unsigned cp = pk2(lc[ja], lc[jb]);
                    acc[0] = dot2bf(__builtin_amdgcn_perm(B.x, A.x, 0x05040100u), cp, acc[0]); acc[1] = dot2bf(__builtin_amdgcn_perm(B.x, A.x, 0x07060302u), cp, acc[1]);
                    acc[2] = dot2bf(__builtin_amdgcn_perm(B.y, A.y, 0x05040100u), cp, acc[2]); acc[3] = dot2bf(__builtin_amdgcn_perm(B.y, A.y, 0x07060302u), cp, acc[3]);
                    acc[4] = dot2bf(__builtin_amdgcn_perm(B.z, A.z, 0x05040100u), cp, acc[4]); acc[5] = dot2bf(__builtin_amdgcn_perm(B.z, A.z, 0x07060302u), cp, acc[5]);
                    acc[6] = dot2bf(__builtin_amdgcn_perm(B.w, A.w, 0x05040100u), cp, acc[6]); acc[7] = dot2bf(__builtin_amdgcn_perm(B.w, A.w, 0x07060302u), cp, acc[7]);
                }
#pragma unroll
                for (int q = 0; q < 8; ++q) { acc[q] += dpp_f<0x128>(acc[q]); acc[q] += __shfl_xor(acc[q], 16); acc[q] += __shfl_xor(acc[q], 32); }
                if (g8 == 0) {
                    const int col = 64 * sl + 8 * i8;
                    const float* g2 = MOD + (size_t)(t >> 11) * 6144 + 5120 + col;
                    float* orow = p.out + (size_t)t * 1024 + col;
                    const f32x4 x0 = *(const f32x4*)orow, x1v = *(const f32x4*)(orow + 4), h0 = *(const f32x4*)g2, h1 = *(const f32x4*)(g2 + 4);
                    f32x4 r0, r1; r0.x = acc[0]; r0.y = acc[1]; r0.z = acc[2]; r0.w = acc[3]; r1.x = acc[4]; r1.y = acc[5]; r1.z = acc[6]; r1.w = acc[7];
                    *(f32x4*)orow = x0 + h0 * r0; *(f32x4*)(orow + 4) = x1v + h1 * r1;
                }
                LDS_WAIT(); asm volatile("" ::: "memory");
            }
        }
    }
}
typedef float f32x2_t __attribute__((ext_vector_type(2)));
constexpr int P8_UNITS = T / 64;
constexpr int CW_P8_U = 4096, CW_P8_V = 4096 + 32 * 64;
constexpr float U8_SCALE = 32.0f;

__device__ __forceinline__ void ph_peer_u8(const Params& p, unsigned char* lds) {
    const bf16* H = (const bf16*)(p.ws + WS_H); const unsigned char* U8 = (const unsigned char*)(p.ws + WS_U16);
    const int* EXPI = (const int*)(p.ws + WS_EXP); const float* GATE = (const float*)(p.ws + WS_GATE); float* CBUF = (float*)(p.ws + WS_CBUF);
    unsigned* ctl = (unsigned*)(p.ws + WS_CTL);
    int tid = threadIdx.x; asm volatile("" : "+v"(tid));
    const int lane = tid & 63, wv = __builtin_amdgcn_readfirstlane(tid >> 6), g = lane >> 4, i = lane & 15;
    volatile LAS unsigned* slot = (volatile LAS unsigned*)(LAS unsigned char*)lds;
    int* lw = (int*)(lds + 1024 + wv * 6144);
    int* myle = lw + g * 384; int* mylj = myle + 128; float* mylg = (float*)(myle + 256);
    const unsigned xcc = peer_xcc();
#pragma unroll 1
    for (int k = 0; k < 8; ++k) {
        const int part = (int)((xcc + (unsigned)k) & 7u);
#pragma unroll 1
        for (;;) {
            if (tid == 0) *slot = __hip_atomic_fetch_add(ctl + CW_P8_U + 64 * part, 1u, __ATOMIC_RELAXED, __HIP_MEMORY_SCOPE_AGENT);
            __syncthreads();
            const unsigned unit = *slot;
            __syncthreads();
            if (unit >= (unsigned)P8_UNITS) break;
#pragma unroll 1
            for (int rd = 0; rd < 2; ++rd) {
                const int tb4 = (int)unit * 64 + wv * 8 + rd * 4;
                u32x4 nx[8];
                { const u32x4* xrow = (const u32x4*)(H + (size_t)(tb4 + g) * 1024) + 2 * i;
#pragma unroll
                  for (int q = 0; q < 4; ++q) { nx[2 * q] = xrow[32 * q]; nx[2 * q + 1] = xrow[32 * q + 1]; } }
                int nmine = 0, nmax = 0;
#pragma unroll
                for (int q = 0; q < 4; ++q) {
                    const size_t tq = (size_t)(tb4 + q);
                    const int e0 = EXPI[tq * 128 + lane], e1 = EXPI[tq * 128 + 64 + lane];
                    const float g0 = GATE[tq * 128 + lane], g1 = GATE[tq * 128 + 64 + lane];
                    const bool in0 = (e0 >> 11) == part, in1 = (e1 >> 11) == part;
                    const unsigned long long m0 = __ballot(in0), m1 = __ballot(in1);
                    const int n0 = __popcll(m0), n = n0 + __popcll(m1);
                    int* qle = lw + q * 384;
                    if (in0) { const int pos = (int)__builtin_amdgcn_mbcnt_hi((unsigned)(m0 >> 32), __builtin_amdgcn_mbcnt_lo((unsigned)m0, 0u)); qle[pos] = e0; qle[128 + pos] = lane; ((float*)qle)[256 + pos] = g0; }
                    if (in1) { const int pos = n0 + (int)__builtin_amdgcn_mbcnt_hi((unsigned)(m1 >> 32), __builtin_amdgcn_mbcnt_lo((unsigned)m1, 0u)); qle[pos] = e1; qle[128 + pos] = 64 + lane; ((float*)qle)[256 + pos] = g1; }
                    nmine = (g == q) ? n : nmine; nmax = n > nmax ? n : nmax;
                }
                float xf[64];
#pragma unroll
                for (int q = 0; q < 8; ++q) { xf[8 * q] = bflo(nx[q].x); xf[8 * q + 1] = bfhi(nx[q].x); xf[8 * q + 2] = bflo(nx[q].y); xf[8 * q + 3] = bfhi(nx[q].y);
                    xf[8 * q + 4] = bflo(nx[q].z); xf[8 * q + 5] = bfhi(nx[q].z); xf[8 * q + 6] = bflo(nx[q].w); xf[8 * q + 7] = bfhi(nx[q].w); }
                LDS_WAIT(); asm volatile("" ::: "memory");
                const size_t cb = (size_t)(tb4 + g) * 128;
#define U8_LOAD(R, S) do { const int s_ = (S); const int e_ = (s_ < nmine) ? myle[s_] : 0; const u32x4* r_ = (const u32x4*)(U8 + (size_t)e_ * 1024) + i;                     \
        _Pragma("unroll") for (int q = 0; q < 4; ++q) R[q] = r_[16 * q]; } while (0)
#define U8_DOT(R, S) do { const int s_ = (S); float a0 = 0.f, a1 = 0.f, a2 = 0.f, a3 = 0.f;                                                            \
        _Pragma("unroll") for (int q = 0; q < 4; ++q) { const unsigned w_[4] = {R[q].x, R[q].y, R[q].z, R[q].w};                                           \
            _Pragma("unroll") for (int c = 0; c < 4; ++c) { const f32x2_t lo = __builtin_amdgcn_cvt_pk_f32_fp8((int)w_[c], false), hi = __builtin_amdgcn_cvt_pk_f32_fp8((int)w_[c], true); \
                a0 = fmaf(lo.x, xf[16 * q + 4 * c], a0); a1 = fmaf(lo.y, xf[16 * q + 4 * c + 1], a1); a2 = fmaf(hi.x, xf[16 * q + 4 * c + 2], a2); a3 = fmaf(hi.y, xf[16 * q + 4 * c + 3], a3); } } \
        const float a_ = row16_sum((a0 + a1) + (a2 + a3)) * (1.0f / U8_SCALE);                                                                         \
        if (i == 0 && s_ < nmine) __hip_atomic_store(CBUF + cb + mylj[s_], gelu_erf(a_) * mylg[s_], __ATOMIC_RELAXED, __HIP_MEMORY_SCOPE_AGENT); } while (0)
                u32x4 RA[4], RB[4], RC[4], RD[4];
                U8_LOAD(RA, 0); U8_LOAD(RB, 1); U8_LOAD(RC, 2);
#pragma unroll 1
                for (int s = 0; s < nmax; s += 4) {
                    U8_LOAD(RD, s + 3); U8_DOT(RA, s);
                    if (s + 1 < nmax) { U8_LOAD(RA, s + 4); U8_DOT(RB, s + 1); }
                    if (s + 2 < nmax) { U8_LOAD(RB, s + 5); U8_DOT(RC, s + 2); }
                    if (s + 3 < nmax) { U8_LOAD(RC, s + 6); U8_DOT(RD, s + 3); }
                }
#undef U8_LOAD
#undef U8_DOT
                LDS_WAIT(); asm volatile("" ::: "memory");
            }
        }
    }
}

__device__ __forceinline__ void ph_peer_v8(const Params& p, unsigned char* lds) {
    const unsigned char* V8 = (const unsigned char*)(p.ws + WS_V16);
    const int* EXPI = (const int*)(p.ws + WS_EXP); const float* CBUF = (const float*)(p.ws + WS_CBUF); const float* MOD = (const float*)(p.ws + WS_MOD);
    unsigned* ctl = (unsigned*)(p.ws + WS_CTL);
    int tid = threadIdx.x; asm volatile("" : "+v"(tid));
    const int lane = tid & 63, wv = __builtin_amdgcn_readfirstlane(tid >> 6), g8 = lane >> 3, i8 = lane & 7;
    volatile LAS unsigned* slot = (volatile LAS unsigned*)(LAS unsigned char*)lds;
    int* le0 = (int*)(lds + 1024 + wv * 2048); float* lc0 = (float*)(le0 + 128); int* le1 = le0 + 256; float* lc1 = (float*)(le0 + 384);
    const unsigned xcc = peer_xcc();
#pragma unroll 1
    for (int k = 0; k < 8; ++k) {
        const int sl = (int)((xcc + (unsigned)k) & 7u);
        const unsigned char* vcol = V8 + 128 * sl + 16 * i8;
#pragma unroll 1
        for (;;) {
            if (tid == 0) *slot = __hip_atomic_fetch_add(ctl + CW_P8_V + 64 * sl, 1u, __ATOMIC_RELAXED, __HIP_MEMORY_SCOPE_AGENT);
            __syncthreads();
            const unsigned unit = *slot;
            __syncthreads();
            if (unit >= (unsigned)P8_UNITS) break;
            const int tbase = (int)unit * 64 + wv * 8;
            int ne0, ne1; float nc0, nc1;
#define V8_FETCH(T) do { const size_t tn_ = (size_t)(T); ne0 = EXPI[tn_ * 128 + lane]; ne1 = EXPI[tn_ * 128 + 64 + lane]; nc0 = CBUF[tn_ * 128 + lane]; nc1 = CBUF[tn_ * 128 + 64 + lane]; } while (0)
#define V8_LISTS(LE, LC) do { LE[lane] = ne0; LE[64 + lane] = ne1; LC[lane] = nc0; LC[64 + lane] = nc1; } while (0)
#define V8_ROWS(R, LE, HH) do { _Pragma("unroll") for (int kk = 0; kk < 8; ++kk) R[kk] = *(const u32x4*)(vcol + (size_t)LE[8 * (8 * (HH) + kk) + g8] * 1024); } while (0)
#define V8_HALF(R, LC, HH) do { _Pragma("unroll") for (int kk = 0; kk < 8; ++kk) { const float cj = LC[8 * (8 * (HH) + kk) + g8];               \
            const unsigned w_[4] = {R[kk].x, R[kk].y, R[kk].z, R[kk].w};                                                                       \
            _Pragma("unroll") for (int c = 0; c < 4; ++c) { const f32x2_t lo = __builtin_amdgcn_cvt_pk_f32_fp8((int)w_[c], false), hi = __builtin_amdgcn_cvt_pk_f32_fp8((int)w_[c], true); \
                acc[4 * c] = fmaf(cj, lo.x, acc[4 * c]); acc[4 * c + 1] = fmaf(cj, lo.y, acc[4 * c + 1]); acc[4 * c + 2] = fmaf(cj, hi.x, acc[4 * c + 2]); acc[4 * c + 3] = fmaf(cj, hi.y, acc[4 * c + 3]); } } } while (0)
            u32x4 RA[8], RB[8];
            int* lecur = (int*)(lds + 1024 + wv * 2048); int* lenxt = lecur + 256;
            V8_FETCH(tbase); V8_LISTS(lecur, ((float*)(lecur + 128))); V8_FETCH(tbase + 1);
            LDS_WAIT(); asm volatile("" ::: "memory");
            V8_ROWS(RA, lecur, 0);
#pragma unroll 1
            for (int tt = 0; tt < 8; ++tt) {
                const int t = tbase + tt;
                float* lccur = (float*)(lecur + 128); float* lcnxt = (float*)(lenxt + 128);
                float acc[16];
#pragma unroll
                for (int q = 0; q < 16; ++q) acc[q] = 0.f;
                V8_ROWS(RB, lecur, 1);
                if (tt + 1 < 8) { V8_LISTS(lenxt, lcnxt); if (tt + 2 < 8) V8_FETCH(t + 2); }
                V8_HALF(RA, lccur, 0);
                LDS_WAIT(); asm volatile("" ::: "memory");
                if (tt + 1 < 8) V8_ROWS(RA, lenxt, 0);
                V8_HALF(RB, lccur, 1);
#pragma unroll
                for (int q = 0; q < 16; ++q) { acc[q] += dpp_f<0x128>(acc[q]); acc[q] += __shfl_xor(acc[q], 16); acc[q] += __shfl_xor(acc[q], 32); }
                if (g8 == 0) { const int col = 128 * sl + 16 * i8; const float* g2 = MOD + (size_t)(t >> 11) * 6144 + 5120 + col; float* orow = p.out + (size_t)t * 1024 + col;
#pragma unroll
                    for (int q = 0; q < 4; ++q) { const f32x4 xv = *(const f32x4*)(orow + 4 * q), hv = *(const f32x4*)(g2 + 4 * q);
                        f32x4 r; r.x = acc[4 * q]; r.y = acc[4 * q + 1]; r.z = acc[4 * q + 2]; r.w = acc[4 * q + 3]; *(f32x4*)(orow + 4 * q) = xv + hv * r; } }
                { int* tmp_ = lecur; lecur = lenxt; lenxt = tmp_; }
            }
#undef V8_FETCH
#undef V8_LISTS
#undef V8_ROWS
#undef V8_HALF
            LDS_WAIT(); asm volatile("" ::: "memory");
        }
    }
}
#ifndef U8_PARTS
#define U8_PARTS 8
#endif
#define U8_SHIFT (U8_PARTS == 8 ? 11 : (U8_PARTS == 16 ? 10 : 9))
__device__ __forceinline__ void ph_peer_u8_old(const Params& p, unsigned char* lds) {
    const bf16* H = (const bf16*)(p.ws + WS_H); const unsigned char* U8 = (const unsigned char*)(p.ws + WS_U16);
    const int* EXPI = (const int*)(p.ws + WS_EXP); const float* GATE = (const float*)(p.ws + WS_GATE); float* CBUF = (float*)(p.ws + WS_CBUF);
    unsigned* ctl = (unsigned*)(p.ws + WS_CTL);
    int tid = threadIdx.x; asm volatile("" : "+v"(tid));
    const int lane = tid & 63, wv = __builtin_amdgcn_readfirstlane(tid >> 6), g = lane >> 4, i = lane & 15;
    volatile LAS unsigned* slot = (volatile LAS unsigned*)(LAS unsigned char*)lds;
    int* le = (int*)(lds + 1024 + wv * 2048); int* lj = le + 128; float* lg = (float*)(le + 256);
    const unsigned xcc = peer_xcc();
#pragma unroll 1
    for (int k = 0; k < U8_PARTS; ++k) {
        const int part = (int)(((U8_PARTS / 8) * xcc + (unsigned)k) & (unsigned)(U8_PARTS - 1));
#pragma unroll 1
        for (;;) {
            if (tid == 0) *slot = __hip_atomic_fetch_add(ctl + CW_P8_U + 64 * part, 1u, __ATOMIC_RELAXED, __HIP_MEMORY_SCOPE_AGENT);
            __syncthreads();
            const unsigned unit = *slot;
            __syncthreads();
            if (unit >= (unsigned)P8_UNITS) break;
            const int tbase = (int)unit * 64 + wv * 8;
            int ne0 = EXPI[(size_t)tbase * 128 + lane], ne1 = EXPI[(size_t)tbase * 128 + 64 + lane];
            float ng0 = GATE[(size_t)tbase * 128 + lane], ng1 = GATE[(size_t)tbase * 128 + 64 + lane];
            u32x4 nx[8];
            { const u32x4* xrow = (const u32x4*)(H + (size_t)tbase * 1024) + 2 * i;
#pragma unroll
              for (int q = 0; q < 4; ++q) { nx[2 * q] = xrow[32 * q]; nx[2 * q + 1] = xrow[32 * q + 1]; } }
#pragma unroll 1
            for (int tt = 0; tt < 8; ++tt) {
                const int t = tbase + tt;
                const int e0 = ne0, e1 = ne1; const float g0 = ng0, g1 = ng1;
                float xf[64];
#pragma unroll
                for (int q = 0; q < 8; ++q) { xf[8 * q] = bflo(nx[q].x); xf[8 * q + 1] = bfhi(nx[q].x); xf[8 * q + 2] = bflo(nx[q].y); xf[8 * q + 3] = bfhi(nx[q].y);
                    xf[8 * q + 4] = bflo(nx[q].z); xf[8 * q + 5] = bfhi(nx[q].z); xf[8 * q + 6] = bflo(nx[q].w); xf[8 * q + 7] = bfhi(nx[q].w); }
                if (tt + 1 < 8) { const size_t tn = (size_t)(t + 1);
                    ne0 = EXPI[tn * 128 + lane]; ne1 = EXPI[tn * 128 + 64 + lane]; ng0 = GATE[tn * 128 + lane]; ng1 = GATE[tn * 128 + 64 + lane];
                    const u32x4* xrow = (const u32x4*)(H + tn * 1024) + 2 * i;
#pragma unroll
                    for (int q = 0; q < 4; ++q) { nx[2 * q] = xrow[32 * q]; nx[2 * q + 1] = xrow[32 * q + 1]; } }
                const bool in0 = (e0 >> U8_SHIFT) == part, in1 = (e1 >> U8_SHIFT) == part;
                const unsigned long long m0 = __ballot(in0), m1 = __ballot(in1);
                const int n0 = __popcll(m0), n = n0 + __popcll(m1);
                if (in0) { const int pos = (int)__builtin_amdgcn_mbcnt_hi((unsigned)(m0 >> 32), __builtin_amdgcn_mbcnt_lo((unsigned)m0, 0u)); le[pos] = e0; lj[pos] = lane; lg[pos] = g0; }
                if (in1) { const int pos = n0 + (int)__builtin_amdgcn_mbcnt_hi((unsigned)(m1 >> 32), __builtin_amdgcn_mbcnt_lo((unsigned)m1, 0u)); le[pos] = e1; lj[pos] = 64 + lane; lg[pos] = g1; }
                LDS_WAIT(); asm volatile("" ::: "memory");
#pragma unroll 1
                for (int s = 0; 4 * s < n; s += 2) {
                    const int idxA = 4 * s + g, idxB = idxA + 4; const bool vA = idxA < n, vB = idxB < n;
                    const u32x4* ra = (const u32x4*)(U8 + (size_t)le[vA ? idxA : 0] * 1024) + i;
                    const u32x4* rb = (const u32x4*)(U8 + (size_t)le[vB ? idxB : 0] * 1024) + i;
                    u32x4 A[4], B[4];
#pragma unroll
                    for (int q = 0; q < 4; ++q) A[q] = ra[16 * q];
#pragma unroll
                    for (int q = 0; q < 4; ++q) B[q] = rb[16 * q];
#define P8_DOT(R, OUT) do { float a0 = 0.f, a1 = 0.f, a2 = 0.f, a3 = 0.f;                                                           \
    _Pragma("unroll") for (int q = 0; q < 4; ++q) {                                                                                   \
        const unsigned w_[4] = {R[q].x, R[q].y, R[q].z, R[q].w};                                                                      \
        _Pragma("unroll") for (int c = 0; c < 4; ++c) { const f32x2_t lo = __builtin_amdgcn_cvt_pk_f32_fp8((int)w_[c], false), hi = __builtin_amdgcn_cvt_pk_f32_fp8((int)w_[c], true); \
            a0 = fmaf(lo.x, xf[16 * q + 4 * c], a0); a1 = fmaf(lo.y, xf[16 * q + 4 * c + 1], a1); a2 = fmaf(hi.x, xf[16 * q + 4 * c + 2], a2); a3 = fmaf(hi.y, xf[16 * q + 4 * c + 3], a3); } } \
    OUT = row16_sum((a0 + a1) + (a2 + a3)) * (1.0f / U8_SCALE); } while (0)
                    float aA, aB;
                    P8_DOT(A, aA); P8_DOT(B, aB);
#undef P8_DOT
                    if (i == 0 && vA) __hip_atomic_store(CBUF + (size_t)t * 128 + lj[idxA], gelu_erf(aA) * lg[idxA], __ATOMIC_RELAXED, __HIP_MEMORY_SCOPE_AGENT);
                    if (i == 0 && vB) __hip_atomic_store(CBUF + (size_t)t * 128 + lj[idxB], gelu_erf(aB) * lg[idxB], __ATOMIC_RELAXED, __HIP_MEMORY_SCOPE_AGENT);
                }
                LDS_WAIT(); asm volatile("" ::: "memory");
            }
        }
    }
}

__device__ __forceinline__ void ph_peer_v8_old(const Params& p, unsigned char* lds) {
    const unsigned char* V8 = (const unsigned char*)(p.ws + WS_V16);
    const int* EXPI = (const int*)(p.ws + WS_EXP); const float* CBUF = (const float*)(p.ws + WS_CBUF); const float* MOD = (const float*)(p.ws + WS_MOD);
    unsigned* ctl = (unsigned*)(p.ws + WS_CTL);
    int tid = threadIdx.x; asm volatile("" : "+v"(tid));
    const int lane = tid & 63, wv = __builtin_amdgcn_readfirstlane(tid >> 6), g8 = lane >> 3, i8 = lane & 7;
    volatile LAS unsigned* slot = (volatile LAS unsigned*)(LAS unsigned char*)lds;
    int* le = (int*)(lds + 1024 + wv * 2048); float* lc = (float*)(le + 128);
    const unsigned xcc = peer_xcc();
#pragma unroll 1
    for (int k = 0; k < 8; ++k) {
        const int sl = (int)((xcc + (unsigned)k) & 7u);
#pragma unroll 1
        for (;;) {
            if (tid == 0) *slot = __hip_atomic_fetch_add(ctl + CW_P8_V + 64 * sl, 1u, __ATOMIC_RELAXED, __HIP_MEMORY_SCOPE_AGENT);
            __syncthreads();
            const unsigned unit = *slot;
            __syncthreads();
            if (unit >= (unsigned)P8_UNITS) break;
            const int tbase = (int)unit * 64 + wv * 8;
            int ne0 = EXPI[(size_t)tbase * 128 + lane], ne1 = EXPI[(size_t)tbase * 128 + 64 + lane];
            float nc0 = CBUF[(size_t)tbase * 128 + lane], nc1 = CBUF[(size_t)tbase * 128 + 64 + lane];
#pragma unroll 1
            for (int tt = 0; tt < 8; ++tt) {
                const int t = tbase + tt;
                le[lane] = ne0; le[64 + lane] = ne1; lc[lane] = nc0; lc[64 + lane] = nc1;
                if (tt + 1 < 8) { const size_t tn = (size_t)(t + 1); ne0 = EXPI[tn * 128 + lane]; ne1 = EXPI[tn * 128 + 64 + lane]; nc0 = CBUF[tn * 128 + lane]; nc1 = CBUF[tn * 128 + 64 + lane]; }
                LDS_WAIT(); asm volatile("" ::: "memory");
                const unsigned char* vcol = V8 + 128 * sl + 16 * i8;
                u32x4 R[16];
#pragma unroll
                for (int kk = 0; kk < 16; ++kk) R[kk] = *(const u32x4*)(vcol + (size_t)le[8 * kk + g8] * 1024);
                float acc[16];
#pragma unroll
                for (int q = 0; q < 16; ++q) acc[q] = 0.f;
#pragma unroll
                for (int kk = 0; kk < 16; ++kk) {
                    const float cj = lc[8 * kk + g8];
                    const unsigned w_[4] = {R[kk].x, R[kk].y, R[kk].z, R[kk].w};
#pragma unroll
                    for (int c = 0; c < 4; ++c) { const f32x2_t lo = __builtin_amdgcn_cvt_pk_f32_fp8((int)w_[c], false), hi = __builtin_amdgcn_cvt_pk_f32_fp8((int)w_[c], true);
                        acc[4 * c] = fmaf(cj, lo.x, acc[4 * c]); acc[4 * c + 1] = fmaf(cj, lo.y, acc[4 * c + 1]); acc[4 * c + 2] = fmaf(cj, hi.x, acc[4 * c + 2]); acc[4 * c + 3] = fmaf(cj, hi.y, acc[4 * c + 3]); }
                }
#pragma unroll
                for (int q = 0; q < 16; ++q) { acc[q] += dpp_f<0x128>(acc[q]); acc[q] += __shfl_xor(acc[q], 16); acc[q] += __shfl_xor(acc[q], 32); }
                if (g8 == 0) {
                    const int col = 128 * sl + 16 * i8;
                    const float* g2 = MOD + (size_t)(t >> 11) * 6144 + 5120 + col;
                    float* orow = p.out + (size_t)t * 1024 + col;
#pragma unroll
                    for (int q = 0; q < 4; ++q) { const f32x4 xv = *(const f32x4*)(orow + 4 * q), hv = *(const f32x4*)(g2 + 4 * q);
                        f32x4 r; r.x = acc[4 * q]; r.y = acc[4 * q + 1]; r.z = acc[4 * q + 2]; r.w = acc[4 * q + 3];
                        *(f32x4*)(orow + 4 * q) = xv + hv * r; }
                }
                LDS_WAIT(); asm volatile("" ::: "memory");
            }
        }
    }
}
__device__ __forceinline__ void ph_dsa_old(const Params& p, unsigned char* lds, int vb, int nvb) {
    const bf16* PROJ = (const bf16*)(p.ws + WS_PROJ); bf16* MIX = (bf16*)(p.ws + WS_MIX);
    const float MB = ((const float*)(p.ws + WS_SCAL))[SC_MB];
    int tid = threadIdx.x; asm volatile("" : "+v"(tid)); const int lane = tid & 63, wv = __builtin_amdgcn_readfirstlane(tid >> 6);
    const int l15 = lane & 15, g = lane >> 4;
    LAS unsigned char* ldsl = (LAS unsigned char*)lds;
    for (int it = vb; it < 2048; it += nvb) {
        const int vbb = it & 255, kk = it >> 8, xg = vbb & 7, ix = vbb >> 3, b = 2 * xg + (ix & 1), G = (ix >> 1) & 3, sub = ix >> 3;
        const int c = (kk & 1) ? (31 - G - 8 * (kk >> 1)) : (G + 8 * (kk >> 1));
        const int cend = (c + 1) * 64, t0 = c * 64 + sub * 16;
        const bf16* Pb = PROJ + (size_t)b * SEQ * NP;
        if (c >= 4) {
            const bf16* qrow = Pb + (size_t)(t0 + l15) * NP;
            bf16x8 bq[4][2]; float wsc[4];
#pragma unroll
            for (int h = 0; h < 4; ++h) { wsc[h] = bf2f(qrow[C_WI + h]) * 0.0625f;
#pragma unroll
                for (int ks = 0; ks < 2; ++ks) bq[h][ks] = *(const bf16x8*)(qrow + C_QI + h * 64 + 32 * ks + 8 * g); }
            for (int k0 = 16 * wv; k0 < cend; k0 += 128) {
                const bf16* krow = Pb + (size_t)(k0 + l15) * NP + C_KI + 8 * g;
                const bf16x8 ka0 = *(const bf16x8*)krow, ka1 = *(const bf16x8*)(krow + 32);
                f32x4 sc = {0.f, 0.f, 0.f, 0.f};
#pragma unroll
                for (int h = 0; h < 4; ++h) { f32x4 a = {0.f, 0.f, 0.f, 0.f};
                    a = __builtin_amdgcn_mfma_f32_16x16x32_bf16(ka0, bq[h][0], a, 0, 0, 0);
                    a = __builtin_amdgcn_mfma_f32_16x16x32_bf16(ka1, bq[h][1], a, 0, 0, 0);
#pragma unroll
                    for (int r = 0; r < 4; ++r) sc[r] = fmaf(fmaxf(a[r], 0.f), wsc[h], sc[r]); }
#pragma unroll
                for (int r = 0; r < 4; ++r) sc[r] = (sc[r] == 0.f) ? 0.f : sc[r];
                *(LAS f32x4*)(ldsl + l15 * DSA_SROW + (k0 + 4 * g) * 4) = sc;
            }
        }
        __syncthreads();
        LAS unsigned short* selw = (LAS unsigned short*)(ldsl + DSA_SEL_OFF);
        int mind0 = 0, mind1 = 0;
#pragma unroll 1
        for (int qi = 0; qi < 2; ++qi) {
            const int qq = 2 * wv + qi, t = t0 + qq;
            LAS unsigned short* sel = selw + qq * 256;
            if (c < 4) { for (int j = lane; j < 256; j += 64) sel[j] = (unsigned short)j; continue; }
            const int nreg = cend >> 6;
            unsigned key[32];
            const LAS float* srow = (const LAS float*)(ldsl + qq * DSA_SROW) + lane;
#pragma unroll
            for (int i = 0; i < 32; ++i) key[i] = (i < nreg) ? sortkey(srow[64 * i]) : 0u;
            unsigned prefix = 0u; bool exact = false;
#pragma unroll 1
            for (int bit = 31; bit >= 0; --bit) {
                const unsigned cand = prefix | (1u << bit); int cnt = 0;
#pragma unroll
                for (int i = 0; i < 32; ++i) cnt += __popcll(__ballot(key[i] >= cand));
                if (cnt >= 256) { prefix = cand; if (cnt == 256) { exact = true; break; } }
            }
            int need_ties = 0;
            if (!exact) { int cgt = 0;
                if (prefix != 0xffffffffu) {
#pragma unroll
                    for (int i = 0; i < 32; ++i) cgt += __popcll(__ballot(key[i] > prefix)); }
                need_ties = 256 - cgt; }
            int base = 0, tbase = 0, md = 4096;
#pragma unroll
            for (int i = 0; i < 32; ++i) {
                if (i < nreg) {
                    bool selb;
                    if (exact) selb = key[i] >= prefix;
                    else { const bool tie = key[i] == prefix; const unsigned long long mt = __ballot(tie);
                        const int trank = tbase + (int)__builtin_amdgcn_mbcnt_hi((unsigned)(mt >> 32), __builtin_amdgcn_mbcnt_lo((unsigned)mt, 0u));
                        selb = (key[i] > prefix) || (tie && trank < need_ties); tbase += __popcll(mt); }
                    const unsigned long long m = __ballot(selb);
                    const int pos = base + (int)__builtin_amdgcn_mbcnt_hi((unsigned)(m >> 32), __builtin_amdgcn_mbcnt_lo((unsigned)m, 0u));
                    const int kidx = i * 64 + lane;
                    if (selb) { sel[pos] = (unsigned short)kidx; const int d = t > kidx ? t - kidx : kidx - t; md = d < md ? d : md; }
                    base += __popcll(m);
                }
            }
#pragma unroll
            for (int o = 1; o < 64; o <<= 1) { const int x = __shfl_xor(md, o); md = x < md ? x : md; }
            if (qi == 0) mind0 = md; else mind1 = md;
        }
        LDS_WAIT(); asm volatile("" ::: "memory");
        const int nvalid = cend < 256 ? cend : 256;
        const int head = lane & 7;
        const float slopeL2 = exp2f(-(float)(head + 1)) * 1.4426950409f;
#pragma unroll 1
        for (int qi = 0; qi < 2; ++qi) {
            const int qq = 2 * wv + qi, t = t0 + qq;
            const LAS unsigned short* sel = selw + qq * 256;
            LAS unsigned char* stg = ldsl + (2 * wv) * DSA_SROW;
            const bf16* qrow = Pb + (size_t)t * NP + C_QB + head * 128 + 8 * g;
            bf16x8 bq[4];
#pragma unroll
            for (int ks = 0; ks < 4; ++ks) bq[ks] = *(const bf16x8*)(qrow + 32 * ks);
            const float refL2 = MB * 1.4426950409f - slopeL2 * (float)(qi == 0 ? mind0 : mind1);
            f32x4 o[8];
#pragma unroll
            for (int dt = 0; dt < 8; ++dt) o[dt] = (f32x4){0.f, 0.f, 0.f, 0.f};
            float lsum = 0.f;
#pragma unroll 1
            for (int s = 0; s < 8; ++s) {
                if (32 * s >= nvalid) break;
                unsigned pb[4];
#pragma unroll
                for (int tl = 0; tl < 2; ++tl) {
                    const int j0 = 32 * s + 16 * tl;
                    const int jr = j0 + l15; const int keyr = sel[jr < nvalid ? jr : 0];
                    const bf16* kvrow = Pb + (size_t)keyr * NP + C_KV + 8 * g;
                    bf16x8 ka[4];
#pragma unroll
                    for (int ks = 0; ks < 4; ++ks) ka[ks] = *(const bf16x8*)(kvrow + 32 * ks);
                    f32x4 a = {0.f, 0.f, 0.f, 0.f};
#pragma unroll
                    for (int ks = 0; ks < 4; ++ks) { a = __builtin_amdgcn_mfma_f32_16x16x32_bf16(ka[ks], bq[ks], a, 0, 0, 0);
                        *(LAS bf16x8*)(stg + (16 * tl + l15) * DSA_KVROW + (32 * ks + 8 * g) * 2) = ka[ks]; }
                    const u32x2 kw = *(const LAS u32x2*)(sel + j0 + 4 * g);
                    const int kx[4] = {(int)(kw.x & 0xffffu), (int)(kw.x >> 16), (int)(kw.y & 0xffffu), (int)(kw.y >> 16)};
                    float pr[4];
#pragma unroll
                    for (int r = 0; r < 4; ++r) { const int dd = t > kx[r] ? t - kx[r] : kx[r] - t;
                        const float e = __builtin_amdgcn_exp2f(fmaf(a[r], 0.1275174f, -slopeL2 * (float)dd - refL2));
                        pr[r] = (j0 + 4 * g + r < nvalid) ? e : 0.f; lsum += pr[r]; }
                    pb[2 * tl] = cvtpk_bf16(pr[0], pr[1]); pb[2 * tl + 1] = cvtpk_bf16(pr[2], pr[3]);
                }
                LDS_WAIT(); asm volatile("" ::: "memory");
                u32x4 pw4; pw4.x = pb[0]; pw4.y = pb[1]; pw4.z = pb[2]; pw4.w = pb[3];
                const bf16x8 pfrag = __builtin_bit_cast(bf16x8, pw4);
                const LAS unsigned char* trb = stg + (4 * g + (l15 >> 2)) * DSA_KVROW + (4 * (lane & 3)) * 2;
#pragma unroll
                for (int dt = 0; dt < 8; ++dt) {
                    const s16x4 lo = __builtin_bit_cast(s16x4, __builtin_amdgcn_ds_read_tr16_b64_v4i16((LAS v4i16_t*)(trb + dt * 32)));
                    const s16x4 hi = __builtin_bit_cast(s16x4, __builtin_amdgcn_ds_read_tr16_b64_v4i16((LAS v4i16_t*)(trb + 16 * DSA_KVROW + dt * 32)));
                    const bf16x8 af = {lo[0], lo[1], lo[2], lo[3], hi[0], hi[1], hi[2], hi[3]};
                    o[dt] = __builtin_amdgcn_mfma_f32_16x16x32_bf16(af, pfrag, o[dt], 0, 0, 0);
                }
                LDS_WAIT(); asm volatile("" ::: "memory");
            }
            lsum += __shfl_xor(lsum, 16); lsum += __shfl_xor(lsum, 32);
            const float il = 1.f / lsum;
            if (l15 < 8) {
                bf16* orow = MIX + (size_t)(b * SEQ + t) * MIXW + 512 + head * 128 + 4 * g;
#pragma unroll
                for (int dt = 0; dt < 8; ++dt) { u32x2 w; w.x = pk2(o[dt][0] * il, o[dt][1] * il); w.y = pk2(o[dt][2] * il, o[dt][3] * il); *(u32x2*)(orow + 16 * dt) = w; }
            }
        }
        __syncthreads();
    }
}
#define XB_TMO      128
#define XB_XCNT(j)  (256  + 64 * (j))
#define XB_XSUB(j)  (1280 + 64 * (j))
#define XB_XGEN(j)  (2304 + 64 * (j))
#define XB_TOP      3328
#define XB_TOPGEN   3392
#define XCD_BAR_WORDS 3456
#define XB_SPIN_CAP (1u << 18)

__device__ __forceinline__ unsigned xb_ld(unsigned* p)              { return __hip_atomic_load(p, __ATOMIC_RELAXED, __HIP_MEMORY_SCOPE_AGENT); }
__device__ __forceinline__ unsigned xb_add(unsigned* p, unsigned v) { return __hip_atomic_fetch_add(p, v, __ATOMIC_RELAXED, __HIP_MEMORY_SCOPE_AGENT); }
__device__ __forceinline__ unsigned xb_xcc_id() { return (unsigned)__builtin_amdgcn_s_getreg((3 << 11) | 20) & 0xFu; }
#define XB_SPIN(cond, bar) do { unsigned _sp = 0; while (cond) { __builtin_amdgcn_s_sleep(1); \
    if ((++_sp & 255u) == 0u) { if (xb_ld(&(bar)[XB_TMO])) break; if (_sp > XB_SPIN_CAP) { atomicAdd(&(bar)[XB_TMO], 1u); break; } } } } while (0)

struct XcdBarrier {
    unsigned* bar; unsigned x;
    volatile LAS unsigned* st;
};

__device__ __forceinline__ XcdBarrier xcd_barrier_post(unsigned* bar, volatile LAS unsigned* st) {
    XcdBarrier b; b.bar = bar; b.x = xb_xcc_id(); b.st = st;
    if (threadIdx.x == 0) (void)xb_add(&bar[XB_XCNT(b.x)], 1u);
    return b;
}
__device__ __forceinline__ void xcd_barrier_complete(unsigned* bar, unsigned x, unsigned& nloc, unsigned& nx) {
    const unsigned G = gridDim.x * gridDim.y * gridDim.z;
    unsigned sum, cnt, mine, sp = 0u;
    for (;;) {
        sum = 0u; cnt = 0u; mine = 0u;
#pragma unroll
        for (unsigned j = 0; j < 16; ++j) { const unsigned c = xb_ld(&bar[XB_XCNT(j)]); sum += c; cnt += (c > 0u) ? 1u : 0u; mine = (j == x) ? c : mine; }
        if (sum == G) break;
        __builtin_amdgcn_s_sleep(1);
        if ((++sp & 255u) == 0u) { if (xb_ld(&bar[XB_TMO])) break; if (sp > XB_SPIN_CAP) { atomicAdd(&bar[XB_TMO], 1u); break; } }
    }
    nloc = mine > 0u ? mine : 1u; nx = cnt > 0u ? cnt : 1u;
}

__device__ __forceinline__ void xcd_barrier(const XcdBarrier& b) {
    asm volatile("s_waitcnt vmcnt(0)" ::: "memory");
    __syncthreads();
    if (threadIdx.x == 0) {
        unsigned* bar = b.bar;
        __builtin_amdgcn_s_waitcnt(0);
        unsigned nloc = b.st[0], nx = b.st[1];
        if (nloc == 0u) { xcd_barrier_complete(bar, b.x, nloc, nx); b.st[0] = nloc; b.st[1] = nx; }
        const unsigned old = xb_add(&bar[XB_XSUB(b.x)], 1u);
        const unsigned gen = old / nloc;
        if (old + 1u == (gen + 1u) * nloc) {
            __builtin_amdgcn_fence(__ATOMIC_RELEASE, "agent");
            asm volatile("s_waitcnt vmcnt(0)" ::: "memory");
            const unsigned og = xb_add(&bar[XB_TOP], 1u);
            const unsigned tg = og / nx;
            if (og + 1u == (tg + 1u) * nx) xb_add(&bar[XB_TOPGEN], 1u);
            else XB_SPIN(xb_ld(&bar[XB_TOPGEN]) == tg, bar);
            __builtin_amdgcn_fence(__ATOMIC_ACQUIRE, "agent");
            xb_add(&bar[XB_XGEN(b.x)], 1u);
            asm volatile("s_waitcnt vmcnt(0)" ::: "memory");
        } else {
            XB_SPIN(xb_ld(&bar[XB_XGEN(b.x)]) == gen, bar);
            __builtin_amdgcn_fence(__ATOMIC_ACQUIRE, "agent");
            asm volatile("s_waitcnt vmcnt(0)" ::: "memory");
        }
    }
    __syncthreads();
}

#ifndef VAR_DSA_OLD
#define VAR_DSA_OLD 0
#endif
#ifndef VAR_U8_OLD
#define VAR_U8_OLD 1
#endif
#ifndef VAR_V8_OLD
#define VAR_V8_OLD 0
#endif
#ifndef PROBE_DUP
#define PROBE_DUP 0
#endif
constexpr int LDS_BYTES = 147456;
extern __shared__ __attribute__((aligned(16))) unsigned char dyn_lds[];

__global__ void __launch_bounds__(NT, 2) mega_fwd(Params p) {
    cg::grid_group grid = cg::this_grid();
    const int vb = blockIdx.x, nvb = gridDim.x, ngw = nvb * NWV;
    volatile LAS unsigned* xst = (volatile LAS unsigned*)((LAS unsigned char*)dyn_lds + (LDS_BYTES - 16));
    if (threadIdx.x < 4) xst[threadIdx.x] = 0u;
    __syncthreads();
    const XcdBarrier xbar = xcd_barrier_post((unsigned*)(p.ws + WS_CTL), xst);
#define TID_LAUNDER int tid_ = threadIdx.x; asm volatile("" : "+v"(tid_)); const int lane = tid_ & 63, wv = tid_ >> 6, gw = vb * NWV + wv; (void)lane; (void)gw;
    ph_mod(p, (float*)dyn_lds, vb, nvb);
    { TID_LAUNDER ph_prep_weights(p, (LAS float*)dyn_lds + wv * (64 * 33), gw, ngw, lane); }
#if PROBE_DUP == 7
    __syncthreads();
    ph_mod(p, (float*)dyn_lds, vb, nvb);
    { TID_LAUNDER ph_prep_weights(p, (LAS float*)dyn_lds + wv * (64 * 33), gw, ngw, lane); }
#endif
    grid.sync();
    { TID_LAUNDER ph_hrows(p, p.x, p.norm1_g, 0, 1024, gw, ngw, lane); }
#if PROBE_DUP == 9
    { TID_LAUNDER ph_hrows(p, p.x, p.norm1_g, 0, 1024, gw, ngw, lane); }
#endif
    xcd_barrier(xbar);
    {   pg8::Gemm g{(const bf16*)(p.ws + WS_H), (const bf16*)(p.ws + WS_WIN), T, NP, 1024}; pg8::StaticOrder S; S.init(T, NP, nvb, vb);
        pg8::EpiBf16<0> E{(bf16*)(p.ws + WS_PROJ), NP, nullptr, 0, 0, 1.f};
        pg8::gemm_phase<pg8::EpiBf16<0>, pg8::StaticOrder, true, true>((LAS unsigned char*)dyn_lds, g, S, E); }
#if PROBE_DUP == 6
    {   pg8::Gemm g{(const bf16*)(p.ws + WS_H), (const bf16*)(p.ws + WS_WIN), T, NP, 1024}; pg8::StaticOrder S; S.init(T, NP, nvb, vb);
        pg8::EpiBf16<0> E{(bf16*)(p.ws + WS_PROJ), NP, nullptr, 0, 0, 1.f};
        pg8::gemm_phase<pg8::EpiBf16<0>, pg8::StaticOrder, true, true>((LAS unsigned char*)dyn_lds, g, S, E); }
#endif
    xcd_barrier(xbar);
    { TID_LAUNDER ph_norm_proj(p, gw, ngw, lane); }
#if PROBE_DUP == 10
    { TID_LAUNDER ph_norm_proj(p, gw, ngw, lane); }
#endif
    xcd_barrier(xbar);
    ph_attnA(p, dyn_lds, vb, nvb);
#if PROBE_DUP == 1
    __syncthreads(); ph_attnA(p, dyn_lds, vb, nvb);
#endif
    __syncthreads();
#if VAR_DSA_OLD
    ph_dsa_old(p, dyn_lds, vb, nvb);
#else
    ph_dsa(p, dyn_lds, vb, nvb);
#endif
#if PROBE_DUP == 2
    __syncthreads(); ph_dsa(p, dyn_lds, vb, nvb);
#endif
    xcd_barrier(xbar);
    {   pg8::Gemm g{(const bf16*)(p.ws + WS_MIX), (const bf16*)(p.ws + WS_WO2), T, 1024, MIXW}; pg8::StaticOrder S; S.init(T, 1024, nvb, vb);
        EpiResGate E{p.x, p.out, (const float*)(p.ws + WS_MOD) + 2048};
        pg8::gemm_phase<EpiResGate, pg8::StaticOrder, true, true>((LAS unsigned char*)dyn_lds, g, S, E); }
#if PROBE_DUP == 8
    {   pg8::Gemm g{(const bf16*)(p.ws + WS_MIX), (const bf16*)(p.ws + WS_WO2), T, 1024, MIXW}; pg8::StaticOrder S; S.init(T, 1024, nvb, vb);
        EpiResGate E{p.x, p.out, (const float*)(p.ws + WS_MOD) + 2048};
        pg8::gemm_phase<EpiResGate, pg8::StaticOrder, true, true>((LAS unsigned char*)dyn_lds, g, S, E); }
#endif
    xcd_barrier(xbar);
    { TID_LAUNDER ph_hrows(p, p.out, p.norm2_g, 3072, 4096, gw, ngw, lane); }
    xcd_barrier(xbar);
    {   pg8::Gemm g{(const bf16*)(p.ws + WS_H), (const bf16*)(p.ws + WS_WQ), T, 1024, 1024}; pg8::StaticOrder S; S.init(T, 1024, nvb, vb);
        pg8::EpiBf16<0> E{(bf16*)(p.ws + WS_Q3), 1024, nullptr, 0, 0, 1.f};
        pg8::gemm_phase<pg8::EpiBf16<0>, pg8::StaticOrder, true, true>((LAS unsigned char*)dyn_lds, g, S, E); }
#if PROBE_DUP == 8
    {   pg8::Gemm g{(const bf16*)(p.ws + WS_H), (const bf16*)(p.ws + WS_WQ), T, 1024, 1024}; pg8::StaticOrder S; S.init(T, 1024, nvb, vb);
        pg8::EpiBf16<0> E{(bf16*)(p.ws + WS_Q3), 1024, nullptr, 0, 0, 1.f};
        pg8::gemm_phase<pg8::EpiBf16<0>, pg8::StaticOrder, true, true>((LAS unsigned char*)dyn_lds, g, S, E); }
#endif
    xcd_barrier(xbar);
    ph_route(p, dyn_lds, vb, nvb);
#if PROBE_DUP == 3
    __syncthreads(); ph_route(p, dyn_lds, vb, nvb);
#endif
    xcd_barrier(xbar);

#if VAR_U8_OLD
    ph_peer_u8_old(p, dyn_lds);
#else
    ph_peer_u8(p, dyn_lds);
#endif

    xcd_barrier(xbar);

#if VAR_V8_OLD
    ph_peer_v8_old(p, dyn_lds);
#else
    ph_peer_v8(p, dyn_lds);
#endif

}

extern "C" void kernel_launch(void* const* d_in, const int* in_sizes, int n_in, void* d_out, int out_size, void* d_ws, size_t ws_size, hipStream_t stream) {
    static int grid_blocks = 0;
    if (grid_blocks == 0) {
        if (n_in != 18 || in_sizes[0] != T * DM || out_size != T * DM || ws_size < WS_END) { fprintf(stderr, "kernel_launch: unexpected shapes n_in %d in0 %d out %d ws %zu\n", n_in, n_in > 0 ? in_sizes[0] : -1, out_size, ws_size); grid_blocks = -1; return; }
        int dev = 0, cus = 0, per_cu = 0;
        (void)hipGetDevice(&dev);
        (void)hipDeviceGetAttribute(&cus, hipDeviceAttributeMultiprocessorCount, dev);
        (void)hipFuncSetAttribute((const void*)mega_fwd, hipFuncAttributeMaxDynamicSharedMemorySize, LDS_BYTES);
        (void)hipOccupancyMaxActiveBlocksPerMultiprocessor(&per_cu, (const void*)mega_fwd, NT, LDS_BYTES);
        if (per_cu < 1 || cus < 1) { fprintf(stderr, "kernel_launch: occupancy query gave %d blocks/CU on %d CUs\n", per_cu, cus); grid_blocks = -1; return; }
        grid_blocks = cus;
    }
    if (grid_blocks < 0) return;
    Params p{};
    const float** pp = (const float**)&p;
    for (int i = 0; i < 18; ++i) pp[i] = (const float*)d_in[i];
    p.out = (float*)d_out; p.ws = (unsigned char*)d_ws;
    if (hipMemsetAsync((char*)d_ws + WS_CTL, 0, CTL_BYTES, stream) != hipSuccess) { fprintf(stderr, "kernel_launch: memset failed\n"); return; }
    void* args[] = {&p};
    const hipError_t e = hipLaunchCooperativeKernel((const void*)mega_fwd, dim3(grid_blocks), dim3(NT), args, LDS_BYTES, stream);
    if (e != hipSuccess) fprintf(stderr, "kernel_launch: cooperative launch failed: %s (grid %d)\n", hipGetErrorString(e), grid_blocks);
}
```

```cpp
#include <hip/hip_runtime.h>
#include <hip/hip_cooperative_groups.h>
#include <cstdio>
#include <cstdint>
#include <cmath>
namespace pg8 {
#define PG8_LAS __attribute__((address_space(3)))
typedef unsigned short bf16_t;
typedef short bf16x8 __attribute__((ext_vector_type(8)));
typedef float f32x4 __attribute__((ext_vector_type(4)));
typedef unsigned u32x4 __attribute__((ext_vector_type(4)));
constexpr int BM = 256, BK = 64, HALF = 128, HTB = HALF * BK * 2  , STAGE_BYTES = 8 * HTB, NXCD = 8, WGM = 8;

__host__ __device__ __forceinline__ int lds_byte(int r, int c) { const int st = (r >> 4) * 2 + (c >> 5), rr = r & 15, cc = c & 31, ob = rr * 64 + cc * 2; return st * 1024 + (ob ^ (((ob >> 9) & 1) << 5)); }
__host__ __device__ __forceinline__ void stage_rc(int b, int& R, int& C) { const int st = b / 1024, sb = b % 1024, swz = sb ^ (((sb >> 9) & 1) << 5); R = (st >> 1) * 16 + swz / 64; C = (st & 1) * 32 + (swz % 64) / 2; }
__host__ __device__ __forceinline__ int perm32(int rho) { const int n = rho >> 4, i = rho & 15; return 8 * (i >> 2) + 4 * n + (i & 3); }

struct Unit { int pm, pn; };
struct Gemm { const bf16_t* A; const bf16_t* Bt; int M, N, K; };

struct StaticOrder {
    int nM, nN, nwg, G, c;
    __host__ __device__ void init(int M, int N, int G_, int c_) { nM = M / BM; nN = N / BM; nwg = nM * nN; G = G_; c = c_; }
    __host__ __device__ bool next(int i, Unit& u) const {
        const long L = (long)i * G + c; if (L >= nwg) return false;
        int wgid = (int)L; { const int q = nwg / NXCD, r = nwg % NXCD, xcd = wgid % NXCD, off = wgid / NXCD; wgid = (xcd < r ? xcd * (q + 1) : r * (q + 1) + (xcd - r) * q) + off; }
        const int nig = WGM * nN, gid = wgid / nig, fm = gid * WGM, gsz = (nM - fm) < WGM ? (nM - fm) : WGM;
        u.pm = fm + ((wgid % nig) % gsz); u.pn = (wgid % nig) / gsz; return true;
    }
    __device__ __forceinline__ void a_ready(const Unit&) const {}
    __device__ __forceinline__ void done(const Unit&) const {}
};

__device__ __forceinline__ unsigned cvt_pk_bf16(float lo, float hi) { unsigned r; asm volatile("v_cvt_pk_bf16_f32 %0, %1, %2" : "=v"(r) : "v"(lo), "v"(hi)); return r; }
typedef float f32x2 __attribute__((ext_vector_type(2)));
__device__ __forceinline__ f32x2 gelu_pk(f32x2 v) {
    const f32x2 av = __builtin_elementwise_abs(v), d = av * 0.2316418882f + 1.0f;
    f32x2 t; t.x = __builtin_amdgcn_rcpf(d.x); t.y = __builtin_amdgcn_rcpf(d.y);
    f32x2 q = t * 0.5307027145f + (-0.7265760135f); q = q * t + 0.7107068705f; q = q * t + (-0.142248368f); q = q * t + 0.127414796f; q = q * t;
    const f32x2 s = (v * v) * (-0.72134752044f);
    f32x2 e; e.x = __builtin_amdgcn_exp2f(s.x); e.y = __builtin_amdgcn_exp2f(s.y);
    const f32x2 m = v * (q * e), r = v - m;
    f32x2 o; o.x = v.x < 0.f ? m.x : r.x; o.y = v.y < 0.f ? m.y : r.y; return o;
}

template <int ACT  > struct EpiBf16 {
    static constexpr bool PERM = true, AFTER_DRAIN = false; static_assert(ACT == 0 || ACT == 1, "EpiBf16: ACT is 0 (none) or 1 (gelu_pk)");
    bf16_t* O; int ldc; const float* bias; int split_cols; size_t split_stride; float scale0;
    __device__ __forceinline__ void operator()(const f32x4 (&acc)[2][2][4][2], const Unit& u, int wr, int wc, int fr, int fq) const {
        const int row0 = u.pm * BM + wr * 64 + fr; int colt = u.pn * BM; bf16_t* base = O;
        float sc = 1.f; if (split_cols) { const int t = colt / split_cols; base += (size_t)t * split_stride; colt -= t * split_cols; if (t == 0) sc = scale0; }
        const int col0 = colt + wc * 32 + 8 * fq, bcol0 = u.pn * BM + wc * 32 + 8 * fq;
        f32x4 bv[2][2];
#pragma unroll
        for (int bj = 0; bj < 2; ++bj)
#pragma unroll
            for (int n = 0; n < 2; ++n) bv[bj][n] = bias ? *(const f32x4*)(bias + bcol0 + bj * HALF + 4 * n) : (f32x4){0.f, 0.f, 0.f, 0.f};
#pragma unroll
        for (int ai = 0; ai < 2; ++ai)
#pragma unroll
            for (int m = 0; m < 4; ++m) { bf16_t* rowp = base + (size_t)(row0 + ai * HALF + m * 16) * ldc + col0;
#pragma unroll
                for (int bj = 0; bj < 2; ++bj) { f32x4 v0 = acc[ai][bj][m][0] + bv[bj][0], v1 = acc[ai][bj][m][1] + bv[bj][1];
                    if (ACT == 1) { f32x2 a = gelu_pk((f32x2){v0[0], v0[1]}), b = gelu_pk((f32x2){v0[2], v0[3]}), c = gelu_pk((f32x2){v1[0], v1[1]}), d = gelu_pk((f32x2){v1[2], v1[3]});
                        v0 = (f32x4){a.x, a.y, b.x, b.y}; v1 = (f32x4){c.x, c.y, d.x, d.y}; }
                    v0 = v0 * sc; v1 = v1 * sc; u32x4 w; w.x = cvt_pk_bf16(v0[0], v0[1]); w.y = cvt_pk_bf16(v0[2], v0[3]); w.z = cvt_pk_bf16(v1[0], v1[1]); w.w = cvt_pk_bf16(v1[2], v1[3]);
                    *(u32x4*)(rowp + bj * HALF) = w; } }
    }
};

template <class Epi, class Sched, bool ALIGN_EPI = false, bool SP2 = false>
__device__ __forceinline__ void gemm_phase(PG8_LAS unsigned char* lds, const Gemm g, const Sched& S, const Epi& E) {
    int tid = threadIdx.x; asm volatile("" : "+v"(tid)); const int wid = __builtin_amdgcn_readfirstlane(tid >> 6), lane = tid & 63, wr = wid >> 2, wc = wid & 3, fr = lane & 15, fq = lane >> 4;
    const int K = g.K, nt = K / BK;
    unsigned voffA[2], voffB[2];
#pragma unroll
    for (int i = 0; i < 2; ++i) { int R, C; stage_rc(tid * 16 + i * 8192, R, C); const int Rb = Epi::PERM ? ((R & ~31) + perm32(R & 31)) : R;
        voffA[i] = (unsigned)(R * K + C) * 2u; voffB[i] = (unsigned)(Rb * K + C) * 2u; }
    const size_t kstep = (size_t)(BK * 2);
    const size_t hstep = (size_t)HALF * K * 2;
    const size_t tstep = 2 * hstep;
    const unsigned ldsw = (unsigned)wid * 1024u;
    const int aoff = lds_byte(wr * 64 + fr, fq * 8), boff = lds_byte(wc * 32 + fr, fq * 8);
#define PG8_SA(b, h) (((b) * 2 + (h)) * HTB)
#define PG8_SB(b, h) ((4 + (b) * 2 + (h)) * HTB)
#define PG8_STAGE(bufoff, gbase, voff) do { _Pragma("unroll") for (int _i = 0; _i < 2; ++_i) \
        __builtin_amdgcn_global_load_lds((const unsigned*)((const char*)(gbase) + (voff)[_i]), (PG8_LAS unsigned*)(lds + (bufoff) + ldsw + _i * 8192), 16, 0, 0); } while (0)
#define PG8_LDA(dst, b, h) do { _Pragma("unroll") for (int m = 0; m < 4; ++m) _Pragma("unroll") for (int k = 0; k < 2; ++k) dst[m][k] = *(const PG8_LAS bf16x8*)(lds + PG8_SA(b, h) + aoff + m * 2048 + k * 1024); } while (0)
#define PG8_LDB(dst, b, h) do { _Pragma("unroll") for (int n = 0; n < 2; ++n) _Pragma("unroll") for (int k = 0; k < 2; ++k) dst[n][k] = *(const PG8_LAS bf16x8*)(lds + PG8_SB(b, h) + boff + n * 2048 + k * 1024); } while (0)
#define PG8_MMA(ai, bj, At, Bt) do { __builtin_amdgcn_s_setprio(1); _Pragma("unroll") for (int m = 0; m < 4; ++m) _Pragma("unroll") for (int n = 0; n < 2; ++n) _Pragma("unroll") for (int k = 0; k < 2; ++k) \
        acc[ai][bj][m][n] = __builtin_amdgcn_mfma_f32_16x16x32_bf16(Bt[n][k], At[m][k], acc[ai][bj][m][n], 0, 0, 0); __builtin_amdgcn_s_setprio(0); } while (0)
#define PG8_WAIT_V(n) asm volatile("s_waitcnt vmcnt(" #n ")" ::: "memory")
#define PG8_WAIT_L(n) asm volatile("s_waitcnt lgkmcnt(" #n ")" ::: "memory")
#define PG8_BAR __builtin_amdgcn_s_barrier()
#define PG8_SCHED __builtin_amdgcn_sched_barrier(0)
    Unit cur, nxt; int ui = 0;
    if (!S.next(0, cur)) return;
    f32x4 acc[2][2][4][2];
#pragma unroll
    for (int a = 0; a < 2; ++a)
#pragma unroll
        for (int b = 0; b < 2; ++b)
#pragma unroll
            for (int m = 0; m < 4; ++m)
#pragma unroll
                for (int n = 0; n < 2; ++n) acc[a][b][m][n] = (f32x4){0.f, 0.f, 0.f, 0.f};
    bf16x8 At[4][2], B0[2][2], B1[2][2];
    const char* cA = (const char*)g.A + (size_t)cur.pm * tstep; const char* cB = (const char*)g.Bt + (size_t)cur.pn * tstep;
    S.a_ready(cur);
    if constexpr (SP2) {
        PG8_STAGE(PG8_SB(0, 0), cB, voffB); PG8_STAGE(PG8_SB(0, 1), cB + hstep, voffB); PG8_STAGE(PG8_SA(0, 0), cA, voffA); PG8_STAGE(PG8_SA(0, 1), cA + hstep, voffA);
        if (wr == 1) PG8_BAR;
        PG8_WAIT_V(2); PG8_BAR;
        PG8_STAGE(PG8_SB(1, 0), cB + kstep, voffB); PG8_STAGE(PG8_SA(1, 0), cA + kstep, voffA); PG8_STAGE(PG8_SB(1, 1), cB + hstep + kstep, voffB);
        PG8_WAIT_V(6); PG8_BAR;
    } else {
        PG8_STAGE(PG8_SB(0, 0), cB, voffB); PG8_STAGE(PG8_SA(0, 0), cA, voffA); PG8_STAGE(PG8_SB(0, 1), cB + hstep, voffB); PG8_STAGE(PG8_SA(0, 1), cA + hstep, voffA);
        if (wr == 1) PG8_BAR;
        PG8_WAIT_V(4); PG8_BAR;
        PG8_STAGE(PG8_SB(1, 0), cB + kstep, voffB); PG8_STAGE(PG8_SA(1, 0), cA + kstep, voffA); PG8_STAGE(PG8_SB(1, 1), cB + hstep + kstep, voffB);
        PG8_WAIT_V(6); PG8_BAR;
    }
    for (;;) {
        const bool has_next = S.next(ui + 1, nxt);
        const char* nA = has_next ? (const char*)g.A + (size_t)nxt.pm * tstep : cA; const char* nB = has_next ? (const char*)g.Bt + (size_t)nxt.pn * tstep : cB;
        for (int t = 0; t < nt; t += 2) {
            const bool last = (t == nt - 2);
            const char* a1 = cA + (size_t)(t + 1) * kstep;
            const char* a2 = last ? nA : cA + (size_t)(t + 2) * kstep; const char* b2 = last ? nB : cB + (size_t)(t + 2) * kstep;
            const char* a3 = a2 + kstep; const char* b3 = b2 + kstep;
            if (last && has_next) S.a_ready(nxt);
            if constexpr (SP2) {
            PG8_LDB(B0, 0, 0); PG8_LDB(B1, 0, 1); PG8_SCHED; PG8_LDA(At, 0, 0); PG8_STAGE(PG8_SA(1, 1), a1 + hstep, voffA);
            PG8_WAIT_V(8); PG8_WAIT_L(0); PG8_BAR; PG8_MMA(0, 0, At, B0); PG8_MMA(0, 1, At, B1); PG8_BAR; PG8_SCHED;
            PG8_LDA(At, 0, 1); PG8_STAGE(PG8_SB(0, 0), b2, voffB); PG8_STAGE(PG8_SB(0, 1), b2 + hstep, voffB); PG8_STAGE(PG8_SA(0, 0), a2, voffA);
            PG8_WAIT_V(8); PG8_WAIT_L(0); PG8_BAR; PG8_MMA(1, 0, At, B0); PG8_MMA(1, 1, At, B1); PG8_BAR; PG8_SCHED;
            PG8_LDB(B0, 1, 0); PG8_LDB(B1, 1, 1); PG8_SCHED; PG8_LDA(At, 1, 0); PG8_STAGE(PG8_SA(0, 1), a2 + hstep, voffA);
            PG8_WAIT_V(8); PG8_WAIT_L(0); PG8_BAR; PG8_MMA(0, 0, At, B0); PG8_MMA(0, 1, At, B1); PG8_BAR; PG8_SCHED;
            PG8_LDA(At, 1, 1); PG8_STAGE(PG8_SB(1, 0), b3, voffB); PG8_STAGE(PG8_SB(1, 1), b3 + hstep, voffB); PG8_STAGE(PG8_SA(1, 0), a3, voffA);
            PG8_WAIT_V(8); PG8_WAIT_L(0); PG8_BAR; PG8_MMA(1, 0, At, B0); PG8_MMA(1, 1, At, B1); PG8_BAR; PG8_SCHED;
            } else {
            PG8_LDB(B0, 0, 0); PG8_SCHED; PG8_LDA(At, 0, 0); PG8_STAGE(PG8_SA(1, 1), a1 + hstep, voffA);
            PG8_WAIT_L(8); PG8_BAR; PG8_WAIT_L(0); PG8_MMA(0, 0, At, B0); PG8_BAR; PG8_SCHED;
            PG8_LDB(B1, 0, 1); PG8_STAGE(PG8_SB(0, 0), b2, voffB);
            PG8_BAR; PG8_WAIT_L(0); PG8_MMA(0, 1, At, B1); PG8_BAR;
            PG8_LDA(At, 0, 1); PG8_STAGE(PG8_SA(0, 0), a2, voffA);
            PG8_BAR; PG8_WAIT_L(0); PG8_MMA(1, 0, At, B0); PG8_BAR; PG8_SCHED;
            PG8_STAGE(PG8_SB(0, 1), b2 + hstep, voffB);
            PG8_WAIT_V(6); PG8_BAR; PG8_MMA(1, 1, At, B1); PG8_BAR;
            PG8_LDB(B0, 1, 0); PG8_SCHED; PG8_LDA(At, 1, 0); PG8_STAGE(PG8_SA(0, 1), a2 + hstep, voffA);
            PG8_WAIT_L(8); PG8_BAR; PG8_WAIT_L(0); PG8_MMA(0, 0, At, B0); PG8_BAR; PG8_SCHED;
            PG8_LDB(B1, 1, 1); PG8_STAGE(PG8_SB(1, 0), b3, voffB);
            PG8_BAR; PG8_WAIT_L(0); PG8_MMA(0, 1, At, B1); PG8_BAR;
            PG8_LDA(At, 1, 1); PG8_STAGE(PG8_SA(1, 0), a3, voffA);
            PG8_BAR; PG8_WAIT_L(0); PG8_MMA(1, 0, At, B0); PG8_BAR; PG8_SCHED;
            PG8_STAGE(PG8_SB(1, 1), b3 + hstep, voffB);
            PG8_WAIT_V(6); PG8_BAR; PG8_MMA(1, 1, At, B1); PG8_BAR;
            }
        }
        if constexpr (ALIGN_EPI) { if (wr == 0) PG8_BAR; }
        if constexpr (!Epi::AFTER_DRAIN) { E(acc, cur, wr, wc, fr, fq); S.done(cur); }
        if (!has_next) break;
#pragma unroll
        for (int a = 0; a < 2; ++a)
#pragma unroll
            for (int b = 0; b < 2; ++b)
#pragma unroll
                for (int m = 0; m < 4; ++m)
#pragma unroll
                    for (int n = 0; n < 2; ++n) acc[a][b][m][n] = (f32x4){0.f, 0.f, 0.f, 0.f};
        cur = nxt; cA = nA; cB = nB; ++ui;
        if constexpr (ALIGN_EPI) { if (wr == 1) PG8_BAR; }
    }
    PG8_WAIT_V(0);
    if constexpr (!ALIGN_EPI) { if (wr == 0) PG8_BAR; }
    PG8_BAR;
    if constexpr (Epi::AFTER_DRAIN) { E.fused(acc, cur, wr, wc, fr, fq, lds, wid, lane); S.done(cur); }
#undef PG8_SA
#undef PG8_SB
#undef PG8_STAGE
#undef PG8_LDA
#undef PG8_LDB
#undef PG8_MMA
#undef PG8_WAIT_V
#undef PG8_WAIT_L
#undef PG8_BAR
#undef PG8_SCHED
}
}
namespace cg = cooperative_groups;
#define LAS __attribute__((address_space(3)))
typedef unsigned short bf16;
typedef float f32x4 __attribute__((ext_vector_type(4)));
typedef float f32x8 __attribute__((ext_vector_type(8)));
typedef float f32x16 __attribute__((ext_vector_type(16)));
typedef unsigned u32x4 __attribute__((ext_vector_type(4)));
typedef unsigned u32x2 __attribute__((ext_vector_type(2)));
typedef short bf16x8 __attribute__((ext_vector_type(8)));
typedef short s16x4 __attribute__((ext_vector_type(4)));

constexpr int BATCH = 16, SEQ = 2048, DM = 1024, T = BATCH * SEQ;
constexpr int NP = 3072;
constexpr int IN_COLS = 3012;
constexpr int C_QA = 0, C_KA = 512, C_VA = 1024, C_QB = 1536, C_KV = 2560, C_QI = 2688, C_KI = 2944, C_WI = 3008;
constexpr int MIXW = 1536;
constexpr int NEXP = 16384;
constexpr float EPS = 1e-6f;
constexpr int NT = 512;
constexpr int NWV = 8;

constexpr size_t MiB = 1u << 20;
constexpr size_t WS_CTL = 0;
constexpr size_t CTL_BYTES = 64 * 1024;
constexpr size_t WS_MOD = 1 * MiB;
constexpr size_t WS_SCAL = WS_MOD + 512 * 1024;
constexpr size_t WS_WIN = 2 * MiB;
constexpr size_t WS_WO2 = 8 * MiB;
constexpr size_t WS_WQ = 11 * MiB;
constexpr size_t WS_SUBK = 13 * MiB;
constexpr size_t WS_U16 = 14 * MiB;
constexpr size_t WS_V16 = 46 * MiB;
constexpr size_t WS_H = 78 * MiB;
constexpr size_t WS_PROJ = 142 * MiB;
constexpr size_t WS_Q3 = WS_PROJ;
constexpr size_t WS_MIX = 334 * MiB;
constexpr size_t WS_EXP = 430 * MiB;
constexpr size_t WS_GATE = 446 * MiB;
constexpr size_t WS_ATMP = 462 * MiB;
constexpr size_t WS_CBUF = 494 * MiB;
constexpr size_t WS_END = 510 * MiB;

struct Params {
    const float *x, *c, *ada_w, *ada_b, *norm1_g, *norm2_g, *w_in, *a_qk_gain, *a_lambda, *a_sub_gain, *b_q_gain, *b_kv_gain, *b_w_uv, *w_out, *peer_wq, *peer_subkeys, *peer_u, *peer_v;
    float* out; unsigned char* ws;
};

enum { SC_LAM = 0, SC_MA = 1, SC_MB = 2 };

__device__ __forceinline__ unsigned f2bf(float f) { unsigned u = __float_as_uint(f); return (u + 0x7fffu + ((u >> 16) & 1u)) >> 16; }
__device__ __forceinline__ float bf2f(unsigned h) { return __uint_as_float(h << 16); }
__device__ __forceinline__ unsigned pk2(float lo, float hi) { return f2bf(lo) | (f2bf(hi) << 16); }
__device__ __forceinline__ float bflo(unsigned w) { return __uint_as_float(w << 16); }
__device__ __forceinline__ float bfhi(unsigned w) { return __uint_as_float(w & 0xffff0000u); }
__device__ __forceinline__ float wave_sum(float v) {
#pragma unroll
    for (int o = 1; o < 64; o <<= 1) v += __shfl_xor(v, o);
    return v;
}
__device__ __forceinline__ float wave_max(float v) {
#pragma unroll
    for (int o = 1; o < 64; o <<= 1) v = fmaxf(v, __shfl_xor(v, o));
    return v;
}
#define LDS_WAIT() asm volatile("s_waitcnt lgkmcnt(0)" ::: "memory")
__device__ __forceinline__ void ph_mod(const Params& p, float* ldsf, int vb, int nvb) {
    if (vb >= 96) return;
    int tid = threadIdx.x; asm volatile("" : "+v"(tid));
    const int lane = tid & 63, wv = tid >> 6;
    for (int i = tid; i < 16 * 1024; i += NT) { const float v = p.c[i]; ldsf[i] = v / (1.f + __expf(-v)); }
    __syncthreads();
    float* MOD = (float*)(p.ws + WS_MOD); float* part = ldsf + 16 * 1024;
    for (int it = vb; it < 96; it += nvb) {
        const int j = it * 64 + lane;
        float acc[16];
#pragma unroll
        for (int b = 0; b < 16; ++b) acc[b] = 0.f;
        const float* wp = p.ada_w + (size_t)(128 * wv) * 6144 + j;
#pragma unroll 1
        for (int k0 = 0; k0 < 128; k0 += 8) {
            float w[8];
#pragma unroll
            for (int u = 0; u < 8; ++u) w[u] = wp[(size_t)(k0 + u) * 6144];
#pragma unroll
            for (int u = 0; u < 8; ++u)
#pragma unroll
                for (int b = 0; b < 16; ++b) acc[b] = fmaf(ldsf[b * 1024 + 128 * wv + k0 + u], w[u], acc[b]);
        }
#pragma unroll
        for (int b = 0; b < 16; ++b) part[(wv * 16 + b) * 64 + lane] = acc[b];
        __syncthreads();
        for (int o = tid; o < 16 * 64; o += NT) { const int b = o >> 6, c = o & 63; float s = 0.f;
#pragma unroll
            for (int w = 0; w < 8; ++w) s += part[(w * 16 + b) * 64 + c];
            MOD[b * 6144 + it * 64 + c] = s + p.ada_b[it * 64 + c]; }
        __syncthreads();
    }
}

__device__ __forceinline__ void transpose_item(const float* W, int N, bf16* WT, int ldt, LAS float* scr, int kb, int nb, int lane) {
    const int k0 = 64 * kb, n0 = 32 * nb;
#pragma unroll 8
    for (int i = 0; i < 32; ++i) { const int kk = 2 * i + (lane >> 5); const int n = n0 + (lane & 31); scr[kk * 33 + (lane & 31)] = (n < N) ? W[(size_t)(k0 + kk) * N + n] : 0.f; }
    LDS_WAIT(); asm volatile("" ::: "memory");
    const int c = lane & 7;
#pragma unroll
    for (int j = 0; j < 4; ++j) { const int n = (lane >> 3) + 8 * j; const LAS float* s = scr + (8 * c) * 33 + n;
        u32x4 o; o.x = pk2(s[0 * 33], s[1 * 33]); o.y = pk2(s[2 * 33], s[3 * 33]); o.z = pk2(s[4 * 33], s[5 * 33]); o.w = pk2(s[6 * 33], s[7 * 33]);
        *(u32x4*)(WT + (size_t)(n0 + n) * ldt + k0 + 8 * c) = o; }
    LDS_WAIT(); asm volatile("" ::: "memory");
}

__device__ __forceinline__ void ph_prep_weights(const Params& p, LAS float* scr, int gw, int ngw, int lane) {
    bf16* WIN = (bf16*)(p.ws + WS_WIN); bf16* WO2 = (bf16*)(p.ws + WS_WO2); bf16* WQ = (bf16*)(p.ws + WS_WQ);
    constexpr int I_IN = 16 * 96, I_O = 8 * 32, I_Q = 16 * 32;
    for (int it = gw; it < I_IN + I_O + I_Q; it += ngw) {
        int r = it;
        if (r < I_IN) { transpose_item(p.w_in, IN_COLS, WIN, 1024, scr, r / 96, r % 96, lane); continue; } r -= I_IN;
        if (r < I_O) { transpose_item(p.w_out, 1024, WO2, MIXW, scr, r / 32, r % 32, lane); continue; } r -= I_O;
        transpose_item(p.peer_wq, 1024, WQ, 1024, scr, r / 32, r % 32, lane);
    }
    const size_t gt = (size_t)gw * 64 + lane, ngt = (size_t)ngw * 64;
    for (size_t i = gt; i < (size_t)1024 * 1024; i += ngt) {
        const int n = (int)(i & 1023), kk = (int)(i >> 10), h = kk >> 7;
        const float* wu = p.b_w_uv + (size_t)kk * 64; const float* wo = p.w_out + (size_t)(512 + 64 * h) * 1024 + n;
        float a = 0.f;
#pragma unroll 8
        for (int e = 0; e < 64; ++e) a = fmaf(wu[e], wo[(size_t)e * 1024], a);
        WO2[(size_t)n * MIXW + 512 + kk] = (bf16)f2bf(a);
    }
    unsigned char* U8 = (unsigned char*)(p.ws + WS_U16); unsigned char* V8 = (unsigned char*)(p.ws + WS_V16); bf16* SUBK = (bf16*)(p.ws + WS_SUBK);
    constexpr size_t NTAB8 = (size_t)NEXP * 1024 / 8, NSUB8 = 2 * 128 * 64 / 8;
    for (size_t i = gt; i < 2 * NTAB8 + NSUB8; i += ngt) {
        if (i < 2 * NTAB8) {
            const bool isu = i < NTAB8; const size_t j = isu ? i : i - NTAB8; const float sc = isu ? 32.0f : 1.0f;
            const f32x8 v = *(const f32x8*)((isu ? p.peer_u : p.peer_v) + j * 8);
            int w0 = 0, w1 = 0;
            w0 = __builtin_amdgcn_cvt_pk_fp8_f32(v[0] * sc, v[1] * sc, w0, false); w0 = __builtin_amdgcn_cvt_pk_fp8_f32(v[2] * sc, v[3] * sc, w0, true);
            w1 = __builtin_amdgcn_cvt_pk_fp8_f32(v[4] * sc, v[5] * sc, w1, false); w1 = __builtin_amdgcn_cvt_pk_fp8_f32(v[6] * sc, v[7] * sc, w1, true);
            u32x2 o; o.x = (unsigned)w0; o.y = (unsigned)w1;
            *(u32x2*)((isu ? U8 : V8) + j * 8) = o;
        } else {
            const size_t j = i - 2 * NTAB8;
            const f32x8 v = *(const f32x8*)(p.peer_subkeys + j * 8);
            u32x4 o; o.x = pk2(v[0], v[1]); o.y = pk2(v[2], v[3]); o.z = pk2(v[4], v[5]); o.w = pk2(v[6], v[7]);
            *(u32x4*)(SUBK + j * 8) = o;
        }
    }
    if (gt == 0) {
        float* SC = (float*)(p.ws + WS_SCAL);
        float s01 = 0.f, s23 = 0.f;
        for (int i = 0; i < 64; ++i) { s01 += p.a_lambda[i] * p.a_lambda[64 + i]; s23 += p.a_lambda[128 + i] * p.a_lambda[192 + i]; }
        SC[SC_LAM] = __expf(s01) - __expf(s23) + 0.2f;
        float g0 = 0.f, g1 = 0.f, gq = 0.f, gk = 0.f;
        for (int i = 0; i < 64; ++i) { g0 = fmaxf(g0, fabsf(p.a_qk_gain[i])); g1 = fmaxf(g1, fabsf(p.a_qk_gain[64 + i])); }
        for (int i = 0; i < 128; ++i) { gq = fmaxf(gq, fabsf(p.b_q_gain[i])); gk = fmaxf(gk, fabsf(p.b_kv_gain[i])); }
        SC[SC_MA] = 8.0f * g0 * g1 * 1.02f;
        SC[SC_MB] = 11.3137085f * gq * gk * 1.02f;
    }
}

__device__ __forceinline__ void ph_hrows(const Params& p, const float* X, const float* g, int shOff, int scOff, int gw, int ngw, int lane) {
    const float* MOD = (const float*)(p.ws + WS_MOD); bf16* H = (bf16*)(p.ws + WS_H);
    for (int m = gw; m < T; m += ngw) {
        const f32x4* xr = (const f32x4*)(X + (size_t)m * 1024) + lane;
        f32x4 v[4]; float s = 0.f;
#pragma unroll
        for (int j = 0; j < 4; ++j) { v[j] = xr[64 * j]; s += (v[j].x * v[j].x + v[j].y * v[j].y) + (v[j].z * v[j].z + v[j].w * v[j].w); }
        const float rstd = rsqrtf(wave_sum(s) * (1.f / 1024.f) + EPS);
        const float* mb = MOD + (size_t)(m >> 11) * 6144;
#pragma unroll
        for (int j = 0; j < 4; ++j) {
            const int col = 4 * (lane + 64 * j);
            const f32x4 gg = *(const f32x4*)(g + col), sc = *(const f32x4*)(mb + scOff + col), sh = *(const f32x4*)(mb + shOff + col);
            const f32x4 y = v[j] * rstd * gg * (sc + 1.0f) + sh;
            u32x2 o; o.x = pk2(y.x, y.y); o.y = pk2(y.z, y.w);
            *(u32x2*)(H + (size_t)m * 1024 + col) = o;
        }
    }
}

__device__ __forceinline__ void ph_norm_proj(const Params& p, int gw, int ngw, int lane) {
    bf16* PROJ = (bf16*)(p.ws + WS_PROJ);
    for (int m = gw; m < T; m += ngw) {
        bf16* row = PROJ + (size_t)m * NP;
#pragma unroll
        for (int j = 0; j < 6; ++j) {
            if (j == 2) continue;
            const int col = 8 * lane + 512 * j;
            const u32x4 raw = *(const u32x4*)(row + col);
            float v[8] = {bflo(raw.x), bfhi(raw.x), bflo(raw.y), bfhi(raw.y), bflo(raw.z), bfhi(raw.z), bflo(raw.w), bfhi(raw.w)};
            float ss = 0.f;
#pragma unroll
            for (int i = 0; i < 8; ++i) ss += v[i] * v[i];
            ss += __shfl_xor(ss, 1); ss += __shfl_xor(ss, 2); ss += __shfl_xor(ss, 4);
            float rstd; const float* gp;
            if (j < 2) { rstd = rsqrtf(ss * (1.f / 64.f) + EPS); gp = p.a_qk_gain + 64 * j + (col & 63); }
            else { ss += __shfl_xor(ss, 8); rstd = rsqrtf(ss * (1.f / 128.f) + EPS); gp = (j == 5 ? p.b_kv_gain : p.b_q_gain) + (col & 127); }
            if (j == 5 && lane >= 16) continue;
            const f32x4 g0 = *(const f32x4*)gp, g1 = *(const f32x4*)(gp + 4);
            u32x4 o; o.x = pk2(v[0] * rstd * g0.x, v[1] * rstd * g0.y); o.y = pk2(v[2] * rstd * g0.z, v[3] * rstd * g0.w);
            o.z = pk2(v[4] * rstd * g1.x, v[5] * rstd * g1.y); o.w = pk2(v[6] * rstd * g1.z, v[7] * rstd * g1.w);
            *(u32x4*)(row + col) = o;
        }
    }
}
__device__ void ph_attnA_naive(const Params& p, float* lds_w, int gw, int ngw, int lane) {
    const bf16* PROJ = (const bf16*)(p.ws + WS_PROJ); bf16* MIX = (bf16*)(p.ws + WS_MIX);
    const float lam = ((const float*)(p.ws + WS_SCAL))[SC_LAM];
    float* qs = lds_w; float* sc0 = lds_w + 128; float* sc1 = sc0 + 2048;
    for (int it = gw; it < BATCH * 4 * SEQ; it += ngw) {
        const int t = it & 2047, h = (it >> 11) & 3, b = it >> 13;
        const int cend = ((t >> 6) + 1) << 6;
        const float slope = exp2f(-2.0f * (h + 1));
        const bf16* qrow = PROJ + (size_t)(b * SEQ + t) * NP + C_QA + h * 128;
        qs[lane] = bf2f(qrow[lane]); qs[64 + lane] = bf2f(qrow[64 + lane]);
        LDS_WAIT(); asm volatile("" ::: "memory");
        float m0 = -3e38f, m1 = -3e38f;
        for (int kk = lane; kk < cend; kk += 64) {
            const bf16* krow = PROJ + (size_t)(b * SEQ + kk) * NP + C_KA + h * 128;
            float d0 = 0.f, d1 = 0.f;
            for (int d = 0; d < 64; ++d) { d0 = fmaf(qs[d], bf2f(krow[d]), d0); d1 = fmaf(qs[64 + d], bf2f(krow[64 + d]), d1); }
            const float bias = slope * fabsf((float)(t - kk));
            d0 = d0 * 0.125f - bias; d1 = d1 * 0.125f - bias;
            sc0[kk] = d0; sc1[kk] = d1; m0 = fmaxf(m0, d0); m1 = fmaxf(m1, d1);
        }
        m0 = wave_max(m0); m1 = wave_max(m1);
        float l0 = 0.f, l1 = 0.f;
        for (int kk = lane; kk < cend; kk += 64) { const float e0 = __expf(sc0[kk] - m0), e1 = __expf(sc1[kk] - m1); sc0[kk] = e0; sc1[kk] = e1; l0 += e0; l1 += e1; }
        l0 = wave_sum(l0); l1 = wave_sum(l1);
        const float i0 = 1.f / l0, i1 = lam / l1;
        for (int kk = lane; kk < cend; kk += 64) sc0[kk] = sc0[kk] * i0 - sc1[kk] * i1;
        LDS_WAIT(); asm volatile("" ::: "memory");
        float a0 = 0.f, a1 = 0.f;
        const bf16* vb = PROJ + (size_t)(b * SEQ) * NP + C_VA + h * 128;
        for (int kk = 0; kk < cend; ++kk) { const float a = sc0[kk]; const bf16* vr = vb + (size_t)kk * NP; a0 = fmaf(a, bf2f(vr[lane]), a0); a1 = fmaf(a, bf2f(vr[64 + lane]), a1); }
        const float ss = wave_sum(a0 * a0 + a1 * a1);
        const float rstd = rsqrtf(ss * (1.f / 128.f) + EPS) * 0.8f;
        bf16* orow = MIX + (size_t)(b * SEQ + t) * MIXW + h * 128;
        orow[lane] = (bf16)f2bf(a0 * rstd * p.a_sub_gain[lane]); orow[64 + lane] = (bf16)f2bf(a1 * rstd * p.a_sub_gain[64 + lane]);
        LDS_WAIT(); asm volatile("" ::: "memory");
    }
}

__device__ void ph_dsa_naive(const Params& p, float* lds, int vb, int nvb) {
    const bf16* PROJ = (const bf16*)(p.ws + WS_PROJ); bf16* MIX = (bf16*)(p.ws + WS_MIX);
    const int tid = threadIdx.x, lane = tid & 63, wv = tid >> 6;
    float* scores = lds; int* sel = (int*)(lds + 2048); float* qi = lds + 2048 + 256; float* wi = qi + 256;
    float* qh = wi + 64 + wv * 384; float* pw = qh + 128;
    for (int it = vb; it < T; it += nvb) {
        const int b = it >> 11, t = it & 2047; const int cend = ((t >> 6) + 1) << 6;
        const bf16* row = PROJ + (size_t)it * NP;
        if (tid < 256) qi[tid] = bf2f(row[C_QI + tid]);
        if (tid < 4) wi[tid] = bf2f(row[C_WI + tid]);
        __syncthreads();
        for (int kk = tid; kk < cend; kk += NT) {
            const bf16* kr = PROJ + (size_t)(b * SEQ + kk) * NP + C_KI;
            float s = 0.f;
            for (int h = 0; h < 4; ++h) { float d = 0.f; for (int e = 0; e < 64; ++e) d = fmaf(qi[h * 64 + e], bf2f(kr[e]), d); s += fmaxf(d, 0.f) * wi[h]; }
            scores[kk] = s * 0.0625f;
        }
        __syncthreads();
        int nvalid;
        if (cend <= 256) { if (tid < 256) sel[tid] = tid; nvalid = cend; }
        else {
            for (int i = tid; i < cend; i += NT) { const float si = scores[i]; int rank = 0;
                for (int j = 0; j < cend; ++j) { const float sj = scores[j]; rank += (sj > si || (sj == si && j < i)) ? 1 : 0; }
                if (rank < 256) sel[rank] = i; }
            nvalid = 256;
        }
        __syncthreads();
        {
            const int h = wv; const float slope = exp2f(-(float)(h + 1));
            qh[lane] = bf2f(row[C_QB + h * 128 + lane]); qh[64 + lane] = bf2f(row[C_QB + h * 128 + 64 + lane]);
            LDS_WAIT(); asm volatile("" ::: "memory");
            float sv[4]; float mx = -3e38f;
#pragma unroll
            for (int jj = 0; jj < 4; ++jj) { const int j = lane + 64 * jj; const int key = sel[j < nvalid ? j : 0];
                const bf16* kv = PROJ + (size_t)(b * SEQ + key) * NP + C_KV; float d = 0.f;
                for (int e = 0; e < 128; ++e) d = fmaf(qh[e], bf2f(kv[e]), d);
                d = d * 0.0883883476f - slope * fabsf((float)(t - key));
                sv[jj] = (j < nvalid) ? d : -3e38f; mx = fmaxf(mx, sv[jj]); }
            mx = wave_max(mx); float l = 0.f;
#pragma unroll
            for (int jj = 0; jj < 4; ++jj) { const int j = lane + 64 * jj; const float e = (j < nvalid) ? __expf(sv[jj] - mx) : 0.f; pw[j] = e; l += e; }
            l = wave_sum(l);
            LDS_WAIT(); asm volatile("" ::: "memory");
            float a0 = 0.f, a1 = 0.f;
            for (int j = 0; j < nvalid; ++j) { const float pj = pw[j]; const bf16* kv = PROJ + (size_t)(b * SEQ + sel[j]) * NP + C_KV; a0 = fmaf(pj, bf2f(kv[lane]), a0); a1 = fmaf(pj, bf2f(kv[64 + lane]), a1); }
            const float il = 1.f / l;
            bf16* orow = MIX + (size_t)it * MIXW + 512 + h * 128;
            orow[lane] = (bf16)f2bf(a0 * il); orow[64 + lane] = (bf16)f2bf(a1 * il);
        }
        __syncthreads();
    }
}

__device__ void ph_route_naive(const Params& p, float* lds, int vb, int nvb) {
    const bf16* Q3 = (const bf16*)(p.ws + WS_Q3); const bf16* SUBK = (const bf16*)(p.ws + WS_SUBK);
    int* EXPI = (int*)(p.ws + WS_EXP); float* GATE = (float*)(p.ws + WS_GATE);
    const int tid = threadIdx.x;
    float* q = lds; float* sub = q + 1024; float* sv = sub + 2048; int* si = (int*)(sv + 256); float* cand = sv + 512; float* ts = cand + 2048; int* te = (int*)(ts + 128);
    for (int it = vb; it < T; it += nvb) {
        q[tid] = bf2f(Q3[(size_t)it * 1024 + tid]); q[tid + 512] = bf2f(Q3[(size_t)it * 1024 + tid + 512]);
        __syncthreads();
        for (int r = 0; r < 4; ++r) { const int idx = tid + 512 * r, h = idx >> 8, c = (idx >> 7) & 1, n = idx & 127;
            const float* qq = q + h * 128 + c * 64; const bf16* kk = SUBK + (size_t)(c * 128 + n) * 64; float d = 0.f;
            for (int e = 0; e < 64; ++e) d = fmaf(qq[e], bf2f(kk[e]), d);
            sub[idx] = d; }
        __syncthreads();
        for (int r = 0; r < 4; ++r) { const int idx = tid + 512 * r, g0 = idx & ~127, n = idx & 127; const float s = sub[idx]; int rank = 0;
            for (int j = 0; j < 128; ++j) { const float sj = sub[g0 + j]; rank += (sj > s || (sj == s && j < n)) ? 1 : 0; }
            if (rank < 16) { sv[(g0 >> 7) * 16 + rank] = s; si[(g0 >> 7) * 16 + rank] = n; } }
        __syncthreads();
        for (int r = 0; r < 4; ++r) { const int idx = tid + 512 * r, h = idx >> 8, i = (idx >> 4) & 15, j = idx & 15; cand[idx] = sv[(h * 2) * 16 + i] + sv[(h * 2 + 1) * 16 + j]; }
        __syncthreads();
        for (int r = 0; r < 4; ++r) { const int idx = tid + 512 * r, h = idx >> 8, ij = idx & 255; const float s = cand[idx]; int rank = 0;
            for (int j = 0; j < 256; ++j) { const float sj = cand[h * 256 + j]; rank += (sj > s || (sj == s && j < ij)) ? 1 : 0; }
            if (rank < 16) { ts[h * 16 + rank] = s; te[h * 16 + rank] = si[(h * 2) * 16 + (ij >> 4)] * 128 + si[(h * 2 + 1) * 16 + (ij & 15)]; } }
        __syncthreads();
        if (tid < 128) { const int h = tid >> 4; const float mx = ts[h * 16]; float l = 0.f;
            for (int k = 0; k < 16; ++k) l += __expf(ts[h * 16 + k] - mx);
            GATE[(size_t)it * 128 + tid] = __expf(ts[tid] - mx) / l; EXPI[(size_t)it * 128 + tid] = te[tid]; }
        __syncthreads();
    }
}

__device__ void ph_peer_naive(const Params& p, float* lds, int vb, int nvb) {
    const bf16* H = (const bf16*)(p.ws + WS_H); const bf16* U16 = (const bf16*)(p.ws + WS_U16); const bf16* V16 = (const bf16*)(p.ws + WS_V16);
    const int* EXPI = (const int*)(p.ws + WS_EXP); const float* GATE = (const float*)(p.ws + WS_GATE); const float* MOD = (const float*)(p.ws + WS_MOD);
    const int tid = threadIdx.x, lane = tid & 63, wv = tid >> 6;
    float* xs = lds; float* coef = lds + 1024; int* ex = (int*)(coef + 128);
    for (int it = vb; it < T; it += nvb) {
        xs[tid] = bf2f(H[(size_t)it * 1024 + tid]); xs[tid + 512] = bf2f(H[(size_t)it * 1024 + tid + 512]);
        if (tid < 128) ex[tid] = EXPI[(size_t)it * 128 + tid];
        __syncthreads();
        for (int jj = 0; jj < 16; ++jj) { const int j = wv * 16 + jj; const bf16* ur = U16 + (size_t)ex[j] * 1024; float d = 0.f;
            for (int i = 0; i < 16; ++i) d = fmaf(xs[lane + 64 * i], bf2f(ur[lane + 64 * i]), d);
            d = wave_sum(d);
            if (lane == 0) coef[j] = 0.5f * d * (1.f + erff(d * 0.70710678f)) * GATE[(size_t)it * 128 + j]; }
        __syncthreads();
        const float* g2 = MOD + (size_t)(it >> 11) * 6144 + 5120;
        for (int r = 0; r < 2; ++r) { const int d = tid + 512 * r; float a = 0.f;
            for (int j = 0; j < 128; ++j) a = fmaf(coef[j], bf2f(V16[(size_t)ex[j] * 1024 + d]), a);
            p.out[(size_t)it * 1024 + d] = p.out[(size_t)it * 1024 + d] + g2[d] * a; }
        __syncthreads();
    }
}
struct EpiResGate {
    static constexpr bool PERM = false, AFTER_DRAIN = false;
    const float* X; float* Out; const float* gate;
    __device__ __forceinline__ void operator()(const pg8::f32x4 (&acc)[2][2][4][2], const pg8::Unit& u, int wr, int wc, int fr, int fq) const {
        const int col0 = u.pn * 256 + wc * 32 + 4 * fq;
#pragma unroll
        for (int ai = 0; ai < 2; ++ai)
#pragma unroll
            for (int m = 0; m < 4; ++m) {
                const int r = u.pm * 256 + ai * 128 + wr * 64 + m * 16 + fr; const float* gb = gate + (size_t)(r >> 11) * 6144;
#pragma unroll
                for (int bj = 0; bj < 2; ++bj)
#pragma unroll
                    for (int n = 0; n < 2; ++n) { const int c = col0 + bj * 128 + n * 16; const size_t off = (size_t)r * 1024 + c;
                        const pg8::f32x4 xv = *(const pg8::f32x4*)(X + off), gv = *(const pg8::f32x4*)(gb + c);
                        *(pg8::f32x4*)(Out + off) = xv + gv * acc[ai][bj][m][n]; }
            }
    }
};


struct EpiNormBf16 {
    static constexpr bool PERM = true, AFTER_DRAIN = false;
    bf16* O; const float* gqk; const float* gbq; const float* gbkv; LAS float* P;
    __device__ __forceinline__ void operator()(const pg8::f32x4 (&acc)[2][2][4][2], const pg8::Unit& u, int wr, int wc, int fr, int fq) const {
        const int pn = u.pn;
        const int mode = pn < 4 ? 1 : ((pn == 4 || pn == 5 || pn == 11) ? 0 : (pn == 10 ? 3 : 2));
        if (mode != 0) {
#pragma unroll
            for (int ai = 0; ai < 2; ++ai)
#pragma unroll
                for (int m = 0; m < 4; ++m)
#pragma unroll
                    for (int bj = 0; bj < 2; ++bj) {
                        const pg8::f32x4 a = acc[ai][bj][m][0], b = acc[ai][bj][m][1];
                        float ss = (a[0] * a[0] + a[1] * a[1]) + (a[2] * a[2] + a[3] * a[3]) + (b[0] * b[0] + b[1] * b[1]) + (b[2] * b[2] + b[3] * b[3]);
                        ss += __shfl_xor(ss, 16); ss += __shfl_xor(ss, 32);
                        if (fq == 0) P[(ai * 128 + wr * 64 + m * 16 + fr) * 8 + bj * 4 + wc] = ss;
                    }
            asm volatile("s_waitcnt lgkmcnt(0)" ::: "memory"); __builtin_amdgcn_s_barrier(); asm volatile("" ::: "memory");
        }
        const int row0 = u.pm * 256 + wr * 64 + fr, col0 = u.pn * 256 + wc * 32 + 8 * fq;
        pg8::f32x4 g0[2], g1[2];
#pragma unroll
        for (int bj = 0; bj < 2; ++bj) {
            const float* gp = nullptr;
            if (mode == 1) gp = gqk + (pn >= 2 ? 64 : 0) + 32 * (wc & 1) + 8 * fq;
            else if (mode == 2) gp = gbq + 32 * wc + 8 * fq;
            else if (mode == 3 && bj == 0) gp = gbkv + 32 * wc + 8 * fq;
            if (gp) { g0[bj] = *(const pg8::f32x4*)gp; g1[bj] = *(const pg8::f32x4*)(gp + 4); } else { g0[bj] = (pg8::f32x4){1.f, 1.f, 1.f, 1.f}; g1[bj] = g0[bj]; }
        }
#pragma unroll
        for (int ai = 0; ai < 2; ++ai)
#pragma unroll
            for (int m = 0; m < 4; ++m) { bf16* rowp = O + (size_t)(row0 + ai * 128 + m * 16) * NP + col0;
#pragma unroll
                for (int bj = 0; bj < 2; ++bj) {
                    float s = 1.f;
                    if (mode != 0 && !(mode == 3 && bj == 1)) {
                        const pg8::f32x4 q = *(const LAS pg8::f32x4*)(P + (ai * 128 + wr * 64 + m * 16 + fr) * 8 + bj * 4);
                        s = (mode == 1) ? rsqrtf(((wc < 2) ? (q[0] + q[1]) : (q[2] + q[3])) * (1.f / 64.f) + EPS) : rsqrtf(((q[0] + q[1]) + (q[2] + q[3])) * (1.f / 128.f) + EPS);
                    }
                    const pg8::f32x4 v0 = acc[ai][bj][m][0] * s * g0[bj], v1 = acc[ai][bj][m][1] * s * g1[bj];
                    pg8::u32x4 w; w.x = pg8::cvt_pk_bf16(v0[0], v0[1]); w.y = pg8::cvt_pk_bf16(v0[2], v0[3]); w.z = pg8::cvt_pk_bf16(v1[0], v1[1]); w.w = pg8::cvt_pk_bf16(v1[2], v1[3]);
                    *(pg8::u32x4*)(rowp + bj * 128) = w; } }
    }
};
typedef __bf16 bf16x2_t __attribute__((ext_vector_type(2)));
__device__ __forceinline__ float dot2bf(unsigned a, unsigned b, float acc) { return __builtin_amdgcn_fdot2_f32_bf16(__builtin_bit_cast(bf16x2_t, a), __builtin_bit_cast(bf16x2_t, b), acc, false); }
template <int CTRL> __device__ __forceinline__ float dpp_f(float v) { return __int_as_float(__builtin_amdgcn_update_dpp(0, __float_as_int(v), CTRL, 0xf, 0xf, false)); }
__device__ __forceinline__ float row16_sum(float v) {
    v += dpp_f<0x128>(v); v += dpp_f<0x124>(v); v += dpp_f<0x122>(v); v += dpp_f<0x121>(v); return v;
}
__device__ __forceinline__ float gelu_erf(float v) {
    const float av = fabsf(v), t = __builtin_amdgcn_rcpf(fmaf(av, 0.2316418882f, 1.0f));
    float q = fmaf(t, 0.5307027145f, -0.7265760135f); q = fmaf(q, t, 0.7107068705f); q = fmaf(q, t, -0.142248368f); q = fmaf(q, t, 0.127414796f); q = q * t;
    const float e = __builtin_amdgcn_exp2f(v * v * -0.72134752044f);
    const float m = v * (q * e);
    return v < 0.f ? m : v - m;
}

__device__ __forceinline__ void ph_peer(const Params& p, unsigned char* lds_w, int gw, int ngw, int lane_, float* outp) {
    int lane = lane_; asm volatile("" : "+v"(lane));
    const bf16* H = (const bf16*)(p.ws + WS_H); const bf16* U16 = (const bf16*)(p.ws + WS_U16); const bf16* V16 = (const bf16*)(p.ws + WS_V16);
    const int* EXPI = (const int*)(p.ws + WS_EXP); const float* GATE = (const float*)(p.ws + WS_GATE); const float* MOD = (const float*)(p.ws + WS_MOD);
    int* e_lds = (int*)lds_w; float* a_lds = (float*)(lds_w + 512);
    const int g = lane >> 4, i = lane & 15;
    for (int t = gw; t < T; t += ngw) {
        const int e0 = EXPI[(size_t)t * 128 + lane], e1 = EXPI[(size_t)t * 128 + 64 + lane];
        const float g0 = GATE[(size_t)t * 128 + lane], g1 = GATE[(size_t)t * 128 + 64 + lane];
        e_lds[lane] = e0; e_lds[64 + lane] = e1;
        u32x4 xr[8];
        const u32x4* xrow = (const u32x4*)(H + (size_t)t * 1024) + i;
#pragma unroll
        for (int k = 0; k < 8; ++k) xr[k] = xrow[16 * k];
        LDS_WAIT(); asm volatile("" ::: "memory");
        u32x4 ua[8], ub[8];
        { const u32x4* ur = (const u32x4*)(U16 + (size_t)e_lds[g] * 1024) + i;
#pragma unroll
          for (int k = 0; k < 8; ++k) ua[k] = ur[16 * k]; }
#pragma unroll 1
        for (int s = 0; s < 32; s += 2) {
            { const u32x4* ur = (const u32x4*)(U16 + (size_t)e_lds[4 * (s + 1) + g] * 1024) + i;
#pragma unroll
              for (int k = 0; k < 8; ++k) ub[k] = ur[16 * k]; }
            { float a0 = 0.f, a1 = 0.f, a2 = 0.f, a3 = 0.f;
#pragma unroll
              for (int k = 0; k < 8; ++k) { a0 = dot2bf(ua[k].x, xr[k].x, a0); a1 = dot2bf(ua[k].y, xr[k].y, a1); a2 = dot2bf(ua[k].z, xr[k].z, a2); a3 = dot2bf(ua[k].w, xr[k].w, a3); }
              const float a = row16_sum((a0 + a1) + (a2 + a3));
              if (i == 0) a_lds[4 * s + g] = a; }
            if (s + 2 < 32) { const u32x4* ur = (const u32x4*)(U16 + (size_t)e_lds[4 * (s + 2) + g] * 1024) + i;
#pragma unroll
              for (int k = 0; k < 8; ++k) ua[k] = ur[16 * k]; }
            { float a0 = 0.f, a1 = 0.f, a2 = 0.f, a3 = 0.f;
#pragma unroll
              for (int k = 0; k < 8; ++k) { a0 = dot2bf(ub[k].x, xr[k].x, a0); a1 = dot2bf(ub[k].y, xr[k].y, a1); a2 = dot2bf(ub[k].z, xr[k].z, a2); a3 = dot2bf(ub[k].w, xr[k].w, a3); }
              const float a = row16_sum((a0 + a1) + (a2 + a3));
              if (i == 0) a_lds[4 * (s + 1) + g] = a; }
        }
        LDS_WAIT(); asm volatile("" ::: "memory");
        const float c0 = gelu_erf(a_lds[lane]) * g0, c1 = gelu_erf(a_lds[64 + lane]) * g1;
        const unsigned pw = pk2(c0, c1);
        float acc[16];
#pragma unroll
        for (int q = 0; q < 16; ++q) acc[q] = 0.f;
        u32x4 A0, A1, B0, B1, C0, C1, D0, D1;
#define PEER_VLOAD(j, X0, X1, Y0, Y1) do { const int ea_ = __builtin_amdgcn_readlane(e0, (j)), eb_ = __builtin_amdgcn_readlane(e1, (j)); \
            const u32x4* ra_ = (const u32x4*)(V16 + (size_t)ea_ * 1024) + lane; const u32x4* rb_ = (const u32x4*)(V16 + (size_t)eb_ * 1024) + lane; \
            X0 = ra_[0]; X1 = ra_[64]; Y0 = rb_[0]; Y1 = rb_[64]; } while (0)
#define PEER_VACC(j, X0, X1, Y0, Y1) do { const unsigned cp_ = (unsigned)__builtin_amdgcn_readlane((int)pw, (j)); \
            acc[0] = dot2bf(__builtin_amdgcn_perm(Y0.x, X0.x, 0x05040100u), cp_, acc[0]); acc[1] = dot2bf(__builtin_amdgcn_perm(Y0.x, X0.x, 0x07060302u), cp_, acc[1]); \
            acc[2] = dot2bf(__builtin_amdgcn_perm(Y0.y, X0.y, 0x05040100u), cp_, acc[2]); acc[3] = dot2bf(__builtin_amdgcn_perm(Y0.y, X0.y, 0x07060302u), cp_, acc[3]); \
            acc[4] = dot2bf(__builtin_amdgcn_perm(Y0.z, X0.z, 0x05040100u), cp_, acc[4]); acc[5] = dot2bf(__builtin_amdgcn_perm(Y0.z, X0.z, 0x07060302u), cp_, acc[5]); \
            acc[6] = dot2bf(__builtin_amdgcn_perm(Y0.w, X0.w, 0x05040100u), cp_, acc[6]); acc[7] = dot2bf(__builtin_amdgcn_perm(Y0.w, X0.w, 0x07060302u), cp_, acc[7]); \
            acc[8] = dot2bf(__builtin_amdgcn_perm(Y1.x, X1.x, 0x05040100u), cp_, acc[8]); acc[9] = dot2bf(__builtin_amdgcn_perm(Y1.x, X1.x, 0x07060302u), cp_, acc[9]); \
            acc[10] = dot2bf(__builtin_amdgcn_perm(Y1.y, X1.y, 0x05040100u), cp_, acc[10]); acc[11] = dot2bf(__builtin_amdgcn_perm(Y1.y, X1.y, 0x07060302u), cp_, acc[11]); \
            acc[12] = dot2bf(__builtin_amdgcn_perm(Y1.z, X1.z, 0x05040100u), cp_, acc[12]); acc[13] = dot2bf(__builtin_amdgcn_perm(Y1.z, X1.z, 0x07060302u), cp_, acc[13]); \
            acc[14] = dot2bf(__builtin_amdgcn_perm(Y1.w, X1.w, 0x05040100u), cp_, acc[14]); acc[15] = dot2bf(__builtin_amdgcn_perm(Y1.w, X1.w, 0x07060302u), cp_, acc[15]); } while (0)
        PEER_VLOAD(0, A0, A1, B0, B1);
#pragma unroll 1
        for (int j = 0; j < 64; j += 2) {
            PEER_VLOAD(j + 1, C0, C1, D0, D1);
            PEER_VACC(j, A0, A1, B0, B1);
            if (j + 2 < 64) PEER_VLOAD(j + 2, A0, A1, B0, B1);
            PEER_VACC(j + 1, C0, C1, D0, D1);
        }
#undef PEER_VLOAD
#undef PEER_VACC
        const float* g2 = MOD + (size_t)(t >> 11) * 6144 + 5120;
        const float* xrow1 = p.out + (size_t)t * 1024; float* orow = outp + (size_t)t * 1024;
#pragma unroll
        for (int h = 0; h < 2; ++h)
#pragma unroll
            for (int q = 0; q < 2; ++q) { const int col = 512 * h + 8 * lane + 4 * q;
                const f32x4 xv = *(const f32x4*)(xrow1 + col), gv = *(const f32x4*)(g2 + col);
                f32x4 a; a.x = acc[8 * h + 4 * q]; a.y = acc[8 * h + 4 * q + 1]; a.z = acc[8 * h + 4 * q + 2]; a.w = acc[8 * h + 4 * q + 3];
                *(f32x4*)(orow + col) = xv + gv * a; }
    }
}
typedef short v4i16_t __attribute__((ext_vector_type(4)));
#ifndef DSA_REP_A
#define DSA_REP_A 1
#endif
#ifndef DSA_REP_B
#define DSA_REP_B 1
#endif
#ifndef DSA_REP_C
#define DSA_REP_C 1
#endif
constexpr int DSA_SROW = 2048 * 4 + 16;
constexpr int DSA_SEL_OFF = 16 * DSA_SROW;
constexpr int DSA_LDS = DSA_SEL_OFF + 16 * 512;
constexpr int DSA_KVROW = 272;

__device__ __forceinline__ unsigned sortkey(float s) { const unsigned u = __float_as_uint(s); return u ^ ((u >> 31) ? 0xffffffffu : 0x80000000u); }
__device__ __forceinline__ unsigned cvtpk_bf16(float lo, float hi) { unsigned r; asm volatile("v_cvt_pk_bf16_f32 %0, %1, %2" : "=v"(r) : "v"(lo), "v"(hi)); return r; }

__device__ __forceinline__ void ph_dsa(const Params& p, unsigned char* lds, int vb, int nvb) {
    const bf16* PROJ = (const bf16*)(p.ws + WS_PROJ); bf16* MIX = (bf16*)(p.ws + WS_MIX);
    const float MB = ((const float*)(p.ws + WS_SCAL))[SC_MB];
    int tid = threadIdx.x; asm volatile("" : "+v"(tid)); const int lane = tid & 63, wv = __builtin_amdgcn_readfirstlane(tid >> 6);
    const int l15 = lane & 15, g = lane >> 4;
    LAS unsigned char* ldsl = (LAS unsigned char*)lds;
    for (int it = vb; it < 2048; it += nvb) {
        const int vbb = it & 255, kk = it >> 8, xg = vbb & 7, ix = vbb >> 3, b = 2 * xg + (ix & 1), G = (ix >> 1) & 3, sub = ix >> 3;
        const int c = (kk & 1) ? (31 - G - 8 * (kk >> 1)) : (G + 8 * (kk >> 1));
        const int cend = (c + 1) * 64, t0 = c * 64 + sub * 16;
        const bf16* Pb = PROJ + (size_t)b * SEQ * NP;
#pragma unroll 1
        for (int repa = 0; repa < DSA_REP_A; ++repa)
        if (c >= 4) {
            const bf16* qrow = Pb + (size_t)(t0 + l15) * NP;
            bf16x8 bq[4][2]; float wsc[4];
#pragma unroll
            for (int h = 0; h < 4; ++h) { wsc[h] = bf2f(qrow[C_WI + h]) * 0.0625f;
#pragma unroll
                for (int ks = 0; ks < 2; ++ks) bq[h][ks] = *(const bf16x8*)(qrow + C_QI + h * 64 + 32 * ks + 8 * g); }
            for (int k0 = 16 * wv; k0 < cend; k0 += 128) {
                const bf16* krow = Pb + (size_t)(k0 + l15) * NP + C_KI + 8 * g;
                const bf16x8 ka0 = *(const bf16x8*)krow, ka1 = *(const bf16x8*)(krow + 32);
                f32x4 sc = {0.f, 0.f, 0.f, 0.f};
#pragma unroll
                for (int h = 0; h < 4; ++h) { f32x4 a = {0.f, 0.f, 0.f, 0.f};
                    a = __builtin_amdgcn_mfma_f32_16x16x32_bf16(ka0, bq[h][0], a, 0, 0, 0);
                    a = __builtin_amdgcn_mfma_f32_16x16x32_bf16(ka1, bq[h][1], a, 0, 0, 0);
#pragma unroll
                    for (int r = 0; r < 4; ++r) sc[r] = fmaf(fmaxf(a[r], 0.f), wsc[h], sc[r]); }
#pragma unroll
                for (int r = 0; r < 4; ++r) sc[r] = (sc[r] == 0.f) ? 0.f : sc[r];
                *(LAS f32x4*)(ldsl + l15 * DSA_SROW + (k0 + 4 * g) * 4) = sc;
            }
        }
        __syncthreads();
        LAS unsigned short* selw = (LAS unsigned short*)(ldsl + DSA_SEL_OFF);
        int mind0 = 0, mind1 = 0;
#pragma unroll 1
        for (int qi2 = 0; qi2 < 2 * DSA_REP_B; ++qi2) { const int qi = qi2 & 1;
            const int qq = 2 * wv + qi, t = t0 + qq;
            LAS unsigned short* sel = selw + qq * 256;
            if (c < 4) { for (int j = lane; j < 256; j += 64) sel[j] = (unsigned short)j; continue; }
            const int nreg = cend >> 6;
            unsigned key[32];
            const LAS float* srow = (const LAS float*)(ldsl + qq * DSA_SROW) + lane;
#pragma unroll
            for (int i = 0; i < 32; ++i) key[i] = (i < nreg) ? sortkey(srow[64 * i]) : 0u;
            unsigned prefix = 0u; bool exact = false;
#pragma unroll 1
            for (int bit = 31; bit >= 0; --bit) {
                const unsigned cand = prefix | (1u << bit); int cnt = 0;
#pragma unroll
                for (int i = 0; i < 32; ++i) cnt += __popcll(__ballot(key[i] >= cand));
                if (cnt >= 256) { prefix = cand; if (cnt == 256) { exact = true; break; } }
            }
            int need_ties = 0;
            if (!exact) { int cgt = 0;
                if (prefix != 0xffffffffu) {
#pragma unroll
                    for (int i = 0; i < 32; ++i) cgt += __popcll(__ballot(key[i] > prefix)); }
                need_ties = 256 - cgt; }
            int base = 0, tbase = 0, md = 4096;
#pragma unroll
            for (int i = 0; i < 32; ++i) {
                if (i < nreg) {
                    bool selb;
                    if (exact) selb = key[i] >= prefix;
                    else { const bool tie = key[i] == prefix; const unsigned long long mt = __ballot(tie);
                        const int trank = tbase + (int)__builtin_amdgcn_mbcnt_hi((unsigned)(mt >> 32), __builtin_amdgcn_mbcnt_lo((unsigned)mt, 0u));
                        selb = (key[i] > prefix) || (tie && trank < need_ties); tbase += __popcll(mt); }
                    const unsigned long long m = __ballot(selb);
                    const int pos = base + (int)__builtin_amdgcn_mbcnt_hi((unsigned)(m >> 32), __builtin_amdgcn_mbcnt_lo((unsigned)m, 0u));
                    const int kidx = i * 64 + lane;
                    if (selb) { sel[pos] = (unsigned short)kidx; const int d = t > kidx ? t - kidx : kidx - t; md = d < md ? d : md; }
                    base += __popcll(m);
                }
            }
#pragma unroll
            for (int o = 1; o < 64; o <<= 1) { const int x = __shfl_xor(md, o); md = x < md ? x : md; }
            if (qi == 0) mind0 = md; else mind1 = md;
        }
        LDS_WAIT(); asm volatile("" ::: "memory");
        const int nvalid = cend < 256 ? cend : 256;
        const int head = lane & 7;
        const float slopeL2 = exp2f(-(float)(head + 1)) * 1.4426950409f;
#pragma unroll 1
        for (int qi2 = 0; qi2 < 2 * DSA_REP_C; ++qi2) { const int qi = qi2 & 1;
            const int qq = 2 * wv + qi, t = t0 + qq;
            const LAS unsigned short* sel = selw + qq * 256;
            LAS unsigned char* stg = ldsl + (2 * wv) * DSA_SROW;
            const bf16* qrow = Pb + (size_t)t * NP + C_QB + head * 128 + 8 * g;
            bf16x8 bq[4];
#pragma unroll
            for (int ks = 0; ks < 4; ++ks) bq[ks] = *(const bf16x8*)(qrow + 32 * ks);
            const float refL2 = MB * 1.4426950409f - slopeL2 * (float)(qi == 0 ? mind0 : mind1);
            f32x4 o[8];
#pragma unroll
            for (int dt = 0; dt < 8; ++dt) o[dt] = (f32x4){0.f, 0.f, 0.f, 0.f};
            float lsum = 0.f;
#define DSA_GATHER(S, KA) do { _Pragma("unroll") for (int i_ = 0; i_ < 8; ++i_) { const int jr = 32 * (S) + 4 * i_ + g; const int keyr = sel[jr < nvalid ? jr : 0];   \
        KA[i_] = *(const bf16x8*)(Pb + (size_t)keyr * NP + C_KV + 8 * l15); } } while (0)
#define DSA_COMPUTE(S, KA) do { unsigned pb[4];                                                                                                        \
        _Pragma("unroll") for (int i_ = 0; i_ < 8; ++i_) *(LAS bf16x8*)(stg + (4 * i_ + g) * DSA_KVROW + 16 * l15) = KA[i_];                              \
        LDS_WAIT(); asm volatile("" ::: "memory");                                                                                                        \
        _Pragma("unroll") for (int tl = 0; tl < 2; ++tl) { const int j0 = 32 * (S) + 16 * tl;                                                           \
            f32x4 a = {0.f, 0.f, 0.f, 0.f};                                                                                                             \
            _Pragma("unroll") for (int ks = 0; ks < 4; ++ks) { const bf16x8 ka_ = *(const LAS bf16x8*)(stg + (16 * tl + l15) * DSA_KVROW + (32 * ks + 8 * g) * 2); \
                a = __builtin_amdgcn_mfma_f32_16x16x32_bf16(ka_, bq[ks], a, 0, 0, 0); }                                                                 \
            const u32x2 kw = *(const LAS u32x2*)(sel + j0 + 4 * g);                                                                                     \
            const int kx[4] = {(int)(kw.x & 0xffffu), (int)(kw.x >> 16), (int)(kw.y & 0xffffu), (int)(kw.y >> 16)};                                     \
            float pr[4];                                                                                                                                \
            _Pragma("unroll") for (int r = 0; r < 4; ++r) { const int dd = t > kx[r] ? t - kx[r] : kx[r] - t;                                            \
                const float e = __builtin_amdgcn_exp2f(fmaf(a[r], 0.1275174f, -slopeL2 * (float)dd - refL2));                                            \
                pr[r] = (j0 + 4 * g + r < nvalid) ? e : 0.f; lsum += pr[r]; }                                                                           \
            pb[2 * tl] = cvtpk_bf16(pr[0], pr[1]); pb[2 * tl + 1] = cvtpk_bf16(pr[2], pr[3]); }                                                         \
        LDS_WAIT(); asm volatile("" ::: "memory");                                                                                                      \
        u32x4 pw4; pw4.x = pb[0]; pw4.y = pb[1]; pw4.z = pb[2]; pw4.w = pb[3];                                                                          \
        const bf16x8 pfrag = __builtin_bit_cast(bf16x8, pw4);                                                                                           \
        const LAS unsigned char* trb = stg + (4 * g + (l15 >> 2)) * DSA_KVROW + (4 * (lane & 3)) * 2;                                                   \
        _Pragma("unroll") for (int dt = 0; dt < 8; ++dt) {                                                                                              \
            const s16x4 lo = __builtin_bit_cast(s16x4, __builtin_amdgcn_ds_read_tr16_b64_v4i16((LAS v4i16_t*)(trb + dt * 32)));                         \
            const s16x4 hi = __builtin_bit_cast(s16x4, __builtin_amdgcn_ds_read_tr16_b64_v4i16((LAS v4i16_t*)(trb + 16 * DSA_KVROW + dt * 32)));        \
            const bf16x8 af = {lo[0], lo[1], lo[2], lo[3], hi[0], hi[1], hi[2], hi[3]};                                                                 \
            o[dt] = __builtin_amdgcn_mfma_f32_16x16x32_bf16(af, pfrag, o[dt], 0, 0, 0); }                                                               \
        LDS_WAIT(); asm volatile("" ::: "memory"); } while (0)
            const int nch = (nvalid + 31) >> 5;
            bf16x8 KA[8], KB[8];
            DSA_GATHER(0, KA);
#pragma unroll 1
            for (int s = 0; s < nch; s += 2) {
                if (s + 1 < nch) DSA_GATHER(s + 1, KB);
                DSA_COMPUTE(s, KA);
                if (s + 1 < nch) { if (s + 2 < nch) DSA_GATHER(s + 2, KA); DSA_COMPUTE(s + 1, KB); }
            }
#undef DSA_GATHER
#undef DSA_COMPUTE
            lsum += __shfl_xor(lsum, 16); lsum += __shfl_xor(lsum, 32);
            const float il = 1.f / lsum;
            if (l15 < 8) {
                bf16* orow = MIX + (size_t)(b * SEQ + t) * MIXW + 512 + head * 128 + 4 * g;
#pragma unroll
                for (int dt = 0; dt < 8; ++dt) { u32x2 w; w.x = pk2(o[dt][0] * il, o[dt][1] * il); w.y = pk2(o[dt][2] * il, o[dt][3] * il); *(u32x2*)(orow + 16 * dt) = w; }
            }
        }
        __syncthreads();
    }
}
typedef __attribute__((address_space(1))) float GASF;
#ifndef ATT_REMAP
#define ATT_REMAP 1
#endif
__device__ __forceinline__ int crow(int r, int hi) { return (r & 3) + 8 * (r >> 2) + 4 * hi; }
#define KSWZ64(row, cb) ((row) * 128 + ((cb) ^ ((((row) >> 1) & 7) << 4)))
__device__ __forceinline__ int v_st(int k, int c) { const int kk = (k & ~0xC) | ((k & 4) << 1) | ((k & 8) >> 1); return ((kk >> 3) * 4 + (c >> 5)) * 512 + ((kk & 7) * 32 + (c & 31)) * 2; }
__device__ __forceinline__ int v_rd_base(int lane) { return ((lane & 3) << 3) | (((lane >> 2) & 3) << 6) | (((lane >> 4) & 1) << 5) | (((lane >> 5) & 1) << 8); }
constexpr int v_rd_off(int d0, int ks, int half) { return d0 * 512 + ks * 4096 + half * 2048; }
template <int OFF> __device__ __forceinline__ s16x4 tr_read(int vb) {
    s16x4 r; asm volatile("ds_read_b64_tr_b16 %0, %1 offset:%2" : "=&v"(r) : "v"(vb), "i"(OFF) : "memory"); return r;
}
template <int D0> __device__ __forceinline__ void pv_one(f32x16& od, int vb, bf16x8 pa0, bf16x8 pa1, bf16x8 pa2, bf16x8 pa3) {
    const s16x4 l0 = tr_read<v_rd_off(D0, 0, 0)>(vb), h0 = tr_read<v_rd_off(D0, 0, 1)>(vb), l1 = tr_read<v_rd_off(D0, 1, 0)>(vb), h1 = tr_read<v_rd_off(D0, 1, 1)>(vb);
    const s16x4 l2 = tr_read<v_rd_off(D0, 2, 0)>(vb), h2 = tr_read<v_rd_off(D0, 2, 1)>(vb), l3 = tr_read<v_rd_off(D0, 3, 0)>(vb), h3 = tr_read<v_rd_off(D0, 3, 1)>(vb);
    asm volatile("s_waitcnt lgkmcnt(0)" ::: "memory"); __builtin_amdgcn_sched_barrier(0);
#define PK(L, H) (bf16x8){L[0], L[1], L[2], L[3], H[0], H[1], H[2], H[3]}
    od = __builtin_amdgcn_mfma_f32_32x32x16_bf16(pa0, PK(l0, h0), od, 0, 0, 0);
    od = __builtin_amdgcn_mfma_f32_32x32x16_bf16(pa1, PK(l1, h1), od, 0, 0, 0);
    od = __builtin_amdgcn_mfma_f32_32x32x16_bf16(pa2, PK(l2, h2), od, 0, 0, 0);
    od = __builtin_amdgcn_mfma_f32_32x32x16_bf16(pa3, PK(l3, h3), od, 0, 0, 0);
#undef PK
}
constexpr int ATT_LDS = 2 * 16384 + 2 * 8192 + 8 * 256;

__device__ __forceinline__ void ph_attnA(const Params& p, unsigned char* lds, int vb, int nvb) {
    const bf16* PROJ = (const bf16*)(p.ws + WS_PROJ); bf16* MIX = (bf16*)(p.ws + WS_MIX);
    const float* SC = (const float*)(p.ws + WS_SCAL);
    const float lam = SC[SC_LAM], refL2 = SC[SC_MA] * 1.4426950409f;
    constexpr float C = 0.125f * 1.4426950409f;
    int tid = threadIdx.x; asm volatile("" : "+v"(tid)); const int lane = tid & 63, wid = __builtin_amdgcn_readfirstlane(tid >> 6), r32 = lane & 31, hi = lane >> 5;
    unsigned char* V_lds = lds; unsigned char* K_lds = lds + 32768;
    float* wsf = (float*)(lds + 49152) + wid * 64;
    GASF* tmpw = (GASF*)(p.ws + WS_ATMP) + ((size_t)(vb * NWV + wid) * 64) * 64 + lane;
    const int vbase = (int)(uintptr_t)V_lds + v_rd_base(lane);
    const int krow = tid >> 3, kch = tid & 7, kdst = KSWZ64(krow, kch * 16);
    const int sr = tid >> 4, sc = (tid & 15) * 8, vst0 = v_st(sr, sc), vst1 = v_st(32 + sr, sc);
    for (int it = vb; it < 256; it += nvb) {
        #if ATT_REMAP
        const int xg_ = it & 7, m_ = it >> 3, pidx = xg_ * 8 + (m_ >> 2), qbl = m_ & 3, b = pidx >> 2, h = pidx & 3;
#else
        const int b = it >> 4, h = (it >> 2) & 3, qbl = it & 3;
#endif
        const float slopeL2 = exp2f(-2.0f * (float)(h + 1)) * 1.4426950409f;
        const bf16* Pb = PROJ + (size_t)b * SEQ * NP;
#pragma unroll 1
        for (int half = 0; half < 2; ++half) {
            const int qb = half ? 7 - qbl : qbl, q0 = 256 * qb, NTu = 4 * (qb + 1), cw = 4 * qb + (wid >> 1);
            const int tq = q0 + 32 * wid + r32;
#pragma unroll 1
            for (int mi = 0; mi < 2; ++mi) {
                const int m = 1 - mi;
                const bf16* Kg = Pb + C_KA + h * 128 + m * 64 + (size_t)krow * NP + kch * 8;
                const bf16* Vg = Pb + C_VA + h * 128 + (size_t)sr * NP + sc;
                bf16x8 qr[4];
                { const bf16* qp = Pb + (size_t)tq * NP + C_QA + h * 128 + m * 64 + hi * 8;
#pragma unroll
                  for (int d0 = 0; d0 < 4; ++d0) qr[d0] = *(const bf16x8*)(qp + d0 * 16); }
                f32x16 o[4];
#pragma unroll
                for (int d = 0; d < 4; ++d) o[d] = f32x16{};
                float lsum = 0.f;
                bf16x8 sk, sv0, sv1;
                sk = *(const bf16x8*)Kg; sv0 = *(const bf16x8*)Vg; sv1 = *(const bf16x8*)(Vg + (size_t)32 * NP);
                *(bf16x8*)(K_lds + kdst) = sk; *(bf16x8*)(V_lds + vst0) = sv0; *(bf16x8*)(V_lds + vst1) = sv1;
                __syncthreads();
#pragma unroll 1
                for (int j = 0; j < NTu; ++j) {
                    const int buf = j & 1;
                    if (j + 1 < NTu) { const size_t go = (size_t)(j + 1) * 64 * NP; sk = *(const bf16x8*)(Kg + go); sv0 = *(const bf16x8*)(Vg + go); sv1 = *(const bf16x8*)(Vg + go + (size_t)32 * NP); }
                    if (j <= cw) {
                        const unsigned char* Kb = K_lds + buf * 8192;
                        const float dq = (float)(tq - 64 * j - 4 * hi);
                        const float B0 = -slopeL2 * dq - refL2;
                        const bool past = j < cw;
                        float ps = 0.f;
                        bf16x8 pa0, pa1, pa2, pa3;
#define PK4(P, BASE, OUT) do { unsigned a0 = cvtpk_bf16(P[BASE + 0], P[BASE + 1]), a1 = cvtpk_bf16(P[BASE + 2], P[BASE + 3]);   \
    unsigned b0_ = cvtpk_bf16(P[BASE + 4], P[BASE + 5]), b1_ = cvtpk_bf16(P[BASE + 6], P[BASE + 7]);                              \
    auto r0 = __builtin_amdgcn_permlane32_swap(a0, b0_, false, false); auto r1 = __builtin_amdgcn_permlane32_swap(a1, b1_, false, false); \
    u32x4 w = {r0[0], r1[0], r0[1], r1[1]}; OUT = __builtin_bit_cast(bf16x8, w); } while (0)
#define HALF_TILE(KOFF, FOFF, PA, PB) do { f32x16 pp = f32x16{};                                                                     \
    _Pragma("unroll") for (int d0 = 0; d0 < 4; ++d0) { const int cb = (d0 * 16 + hi * 8) * 2;                                        \
        const bf16x8 bk = *(const bf16x8*)(Kb + KSWZ64((KOFF) + r32, cb)); pp = __builtin_amdgcn_mfma_f32_32x32x16_bf16(bk, qr[d0], pp, 0, 0, 0); } \
    if (past) { _Pragma("unroll") for (int r = 0; r < 16; ++r) { const float off = (float)((r & 3) + 8 * (r >> 2)) + (FOFF);          \
            pp[r] = __builtin_amdgcn_exp2f(fmaf(pp[r], C, fmaf(slopeL2, off, B0))); } }                                               \
    else { _Pragma("unroll") for (int r = 0; r < 16; ++r) { const float off = (float)((r & 3) + 8 * (r >> 2)) + (FOFF);               \
            pp[r] = __builtin_amdgcn_exp2f(fmaf(pp[r], C, -slopeL2 * fabsf(dq - off) - refL2)); } }                                   \
    _Pragma("unroll") for (int r = 0; r < 16; ++r) ps += pp[r];                                                                       \
    PK4(pp, 0, PA); PK4(pp, 8, PB); __builtin_amdgcn_sched_barrier(0); } while (0)
                        HALF_TILE(0, 0.f, pa0, pa1);
                        HALF_TILE(32, 32.f, pa2, pa3);
#undef HALF_TILE
#undef PK4
                        { auto rr = __builtin_amdgcn_permlane32_swap(__float_as_uint(ps), __float_as_uint(ps), false, false);
                          ps = __uint_as_float(rr[0]) + __uint_as_float(rr[1]); }
                        lsum += ps;
                        const int vb0 = vbase + buf * 16384;
                        pv_one<0>(o[0], vb0, pa0, pa1, pa2, pa3); pv_one<1>(o[1], vb0, pa0, pa1, pa2, pa3); pv_one<2>(o[2], vb0, pa0, pa1, pa2, pa3); pv_one<3>(o[3], vb0, pa0, pa1, pa2, pa3);
                    }
                    if (j + 1 < NTu) { const int nb = buf ^ 1;
                        *(bf16x8*)(K_lds + nb * 8192 + kdst) = sk; *(bf16x8*)(V_lds + nb * 16384 + vst0) = sv0; *(bf16x8*)(V_lds + nb * 16384 + vst1) = sv1; }
                    __syncthreads();
                }
                if (hi == 0) wsf[r32] = lsum;
                LDS_WAIT(); asm volatile("" ::: "memory");
                float rli[16];
#pragma unroll
                for (int r = 0; r < 16; ++r) rli[r] = 1.f / wsf[crow(r, hi)];
                LDS_WAIT(); asm volatile("" ::: "memory");
                if (mi == 0) {
#pragma unroll
                    for (int d = 0; d < 4; ++d) { GASF* td = tmpw + d * 1024; asm volatile("" : "+v"(td));
#pragma unroll
                        for (int r = 0; r < 16; ++r) td[r * 64] = o[d][r] * rli[r]; }
                } else {
                    float gsub[4];
#pragma unroll
                    for (int d = 0; d < 4; ++d) gsub[d] = p.a_sub_gain[32 * d + r32];
                    GASF* tdp[4];
#pragma unroll
                    for (int d = 0; d < 4; ++d) { tdp[d] = tmpw + d * 1024; asm volatile("" : "+v"(tdp[d])); }
#pragma unroll
                    for (int r = 0; r < 16; ++r) {
                        float v[4]; float ss = 0.f;
#pragma unroll
                        for (int d = 0; d < 4; ++d) { v[d] = o[d][r] * rli[r] - lam * tdp[d][r * 64]; ss += v[d] * v[d]; }
                        ss += __shfl_xor(ss, 1); ss += __shfl_xor(ss, 2); ss += __shfl_xor(ss, 4); ss += __shfl_xor(ss, 8); ss += __shfl_xor(ss, 16);
                        const float rs = rsqrtf(ss * (1.f / 128.f) + EPS) * 0.8f;
                        bf16* orow = MIX + (size_t)(b * SEQ + q0 + 32 * wid + crow(r, hi)) * MIXW + h * 128 + r32;
#pragma unroll
                        for (int d = 0; d < 4; ++d) orow[32 * d] = (bf16)f2bf(v[d] * rs * gsub[d]);
                        asm volatile("" ::: "memory");
                    }
                }
            }
        }
    }
}
constexpr int RT_WAVE_BYTES = 12288;
constexpr int RT_LDS = 32768 + 8 * RT_WAVE_BYTES;

__device__ __forceinline__ int pl32_sum(int v) { auto rr = __builtin_amdgcn_permlane32_swap((unsigned)v, (unsigned)v, false, false); return (int)(rr[0] + rr[1]); }
__device__ __forceinline__ int pl32_other(int v) { auto rr = __builtin_amdgcn_permlane32_swap((unsigned)v, (unsigned)v, false, false); return (int)(rr[0] + rr[1]) - v; }
__device__ __forceinline__ float unsortkey(unsigned k) { return __uint_as_float((k & 0x80000000u) ? (k ^ 0x80000000u) : ~k); }

template <int N> __device__ __forceinline__ unsigned bisect16(const unsigned (&key)[N]) {
    unsigned prefix = 0u; bool done = false;
#pragma unroll 1
    for (int bit = 31; bit >= 0; --bit) {
        const unsigned cand = done ? prefix : (prefix | (1u << bit));
        int cnt = 0;
#pragma unroll
        for (int i = 0; i < N; ++i) cnt += (key[i] >= cand) ? 1 : 0;
        const int tot = pl32_sum(cnt);
        if (!done && tot >= 16) { prefix = cand; done = (tot == 16); }
        if (__all(done)) break;
    }
    return prefix;
}

__device__ __forceinline__ void ph_route(const Params& p, unsigned char* lds, int vb, int nvb) {
    const bf16* Q3 = (const bf16*)(p.ws + WS_Q3); const bf16* SUBK = (const bf16*)(p.ws + WS_SUBK);
    int* EXPI = (int*)(p.ws + WS_EXP); float* GATE = (float*)(p.ws + WS_GATE);
    int tid = threadIdx.x; asm volatile("" : "+v"(tid));
    const int lane = tid & 63, wv = __builtin_amdgcn_readfirstlane(tid >> 6), r32 = lane & 31, hi = lane >> 5;
    for (int i = tid; i < 2048; i += NT) { const int row = i >> 3, ch = i & 7; ((u32x4*)lds)[row * 8 + (ch ^ ((row >> 1) & 7))] = ((const u32x4*)SUBK)[i]; }
    __syncthreads();
    unsigned char* wl = lds + 32768 + wv * RT_WAVE_BYTES;
    float* sv = (float*)wl; int* si = (int*)(wl + 4096); float* fv = (float*)(wl + 8192); int* fe = (int*)(wl + 10240);
    const int gw = vb * NWV + wv, ngw = nvb * NWV;
    for (int item = gw; item < (T / 32) * 8; item += ngw) {
        const int h = item & 7, tok0 = (item >> 3) * 32;
        const bf16* qrow = Q3 + (size_t)(tok0 + r32) * 1024 + h * 128 + hi * 8;
#pragma unroll 1
        for (int c = 0; c < 2; ++c) {
            bf16x8 bq[4];
#pragma unroll
            for (int d0 = 0; d0 < 4; ++d0) bq[d0] = *(const bf16x8*)(qrow + c * 64 + d0 * 16);
            unsigned key[64];
#pragma unroll
            for (int nt = 0; nt < 4; ++nt) {
                f32x16 acc = f32x16{};
                const int krow = c * 128 + nt * 32 + r32, ksw = (krow >> 1) & 7;
                const unsigned char* kp = lds + krow * 128;
#pragma unroll
                for (int d0 = 0; d0 < 4; ++d0) { const bf16x8 ak = *(const bf16x8*)(kp + (((2 * d0 + hi) ^ ksw) << 4)); acc = __builtin_amdgcn_mfma_f32_32x32x16_bf16(ak, bq[d0], acc, 0, 0, 0); }
#pragma unroll
                for (int r = 0; r < 16; ++r) key[nt * 16 + r] = sortkey(acc[r]);
            }
            const unsigned thr = bisect16<64>(key);
            int cnt = 0;
#pragma unroll
            for (int i = 0; i < 64; ++i) cnt += (key[i] >= thr) ? 1 : 0;
            const int other_ = pl32_other(cnt); int slot = hi ? other_ : 0;
            float* svp = sv + (r32 * 2 + c) * 16; int* sip = si + (r32 * 2 + c) * 16;
#pragma unroll
            for (int i = 0; i < 64; ++i) {
                if (key[i] >= thr && slot < 16) { svp[slot] = unsortkey(key[i]); sip[slot] = 32 * (i >> 4) + ((i & 3) + 8 * ((i & 15) >> 2)) + 4 * hi; ++slot; }
            }
        }
        LDS_WAIT(); asm volatile("" ::: "memory");
        {
            const float* s0 = sv + (r32 * 2) * 16 + 8 * hi; const float* s1 = sv + (r32 * 2 + 1) * 16;
            float a0[8], a1[16];
#pragma unroll
            for (int i = 0; i < 8; ++i) a0[i] = s0[i];
#pragma unroll
            for (int j = 0; j < 16; ++j) a1[j] = s1[j];
            unsigned key[128];
#pragma unroll
            for (int i = 0; i < 8; ++i)
#pragma unroll
                for (int j = 0; j < 16; ++j) key[i * 16 + j] = sortkey(a0[i] + a1[j]);
            const unsigned thr = bisect16<128>(key);
            int cnt = 0;
#pragma unroll
            for (int i = 0; i < 128; ++i) cnt += (key[i] >= thr) ? 1 : 0;
            const int other_ = pl32_other(cnt); int slot = hi ? other_ : 0;
            const int* i0 = si + (r32 * 2) * 16 + 8 * hi; const int* i1 = si + (r32 * 2 + 1) * 16;
            float* fvp = fv + r32 * 16; int* fep = fe + r32 * 16;
#pragma unroll
            for (int i = 0; i < 128; ++i) {
                if (key[i] >= thr && slot < 16) { fvp[slot] = unsortkey(key[i]); fep[slot] = i0[i >> 4] * 128 + i1[i & 15]; ++slot; }
            }
        }
        LDS_WAIT(); asm volatile("" ::: "memory");
        {
            const float* fvp = fv + r32 * 16;
            float v[16]; float mx = -3e38f;
#pragma unroll
            for (int k = 0; k < 16; ++k) { v[k] = fvp[k]; mx = fmaxf(mx, v[k]); }
            float l = 0.f;
#pragma unroll
            for (int k = 0; k < 16; ++k) { v[k] = __expf(v[k] - mx); l += v[k]; }
            const float il = 1.f / l;
            const size_t ob = (size_t)(tok0 + r32) * 128 + h * 16 + 8 * hi;
            const int* fep = fe + r32 * 16 + 8 * hi;
            f32x4 g0, g1; u32x4 e0, e1;
            if (hi == 0) { g0 = (f32x4){v[0] * il, v[1] * il, v[2] * il, v[3] * il}; g1 = (f32x4){v[4] * il, v[5] * il, v[6] * il, v[7] * il}; }
            else { g0 = (f32x4){v[8] * il, v[9] * il, v[10] * il, v[11] * il}; g1 = (f32x4){v[12] * il, v[13] * il, v[14] * il, v[15] * il}; }
            e0 = *(const u32x4*)fep; e1 = *(const u32x4*)(fep + 4);
            *(f32x4*)(GATE + ob) = g0; *(f32x4*)(GATE + ob + 4) = g1;
            *(u32x4*)(EXPI + ob) = e0; *(u32x4*)(EXPI + ob + 4) = e1;
        }
        LDS_WAIT(); asm volatile("" ::: "memory");
    }
    __syncthreads();
}
constexpr int PU_UNITS = T / 64;
constexpr int CW_PEER_U = 4096, CW_PEER_V = 4096 + 16 * 64;

__device__ __forceinline__ unsigned peer_xcc() { return (unsigned)__builtin_amdgcn_s_getreg((3 << 11) | 20) & 7u; }

__device__ __forceinline__ void ph_peer_u(const Params& p, unsigned char* lds, int cwbase) {
    const bf16* H = (const bf16*)(p.ws + WS_H); const bf16* U16 = (const bf16*)(p.ws + WS_U16);
    const int* EXPI = (const int*)(p.ws + WS_EXP); const float* GATE = (const float*)(p.ws + WS_GATE); float* CBUF = (float*)(p.ws + WS_CBUF);
    unsigned* ctl = (unsigned*)(p.ws + WS_CTL);
    int tid = threadIdx.x; asm volatile("" : "+v"(tid));
    const int lane = tid & 63, wv = __builtin_amdgcn_readfirstlane(tid >> 6), g = lane >> 4, i = lane & 15;
    volatile LAS unsigned* slot = (volatile LAS unsigned*)(LAS unsigned char*)lds;
    int* le = (int*)(lds + 1024 + wv * 1024); int* lj = le + 128;
    const unsigned xcc = peer_xcc();
#pragma unroll 1
    for (int k = 0; k < 16; ++k) {
        const int part = (int)((2u * xcc + (unsigned)k) & 15u);
#pragma unroll 1
        for (;;) {
            if (tid == 0) *slot = __hip_atomic_fetch_add(ctl + cwbase + 64 * part, 1u, __ATOMIC_RELAXED, __HIP_MEMORY_SCOPE_AGENT);
            __syncthreads();
            const unsigned unit = *slot;
            __syncthreads();
            if (unit >= (unsigned)PU_UNITS) break;
#pragma unroll 1
            for (int tt = 0; tt < 8; ++tt) {
                const int t = (int)unit * 64 + wv * 8 + tt;
                const int e0 = EXPI[(size_t)t * 128 + lane], e1 = EXPI[(size_t)t * 128 + 64 + lane];
                const bool in0 = (e0 >> 10) == part, in1 = (e1 >> 10) == part;
                const unsigned long long m0 = __ballot(in0), m1 = __ballot(in1);
                const int n0 = __popcll(m0), n = n0 + __popcll(m1);
                if (n == 0) continue;
                if (in0) { const int pos = (int)__builtin_amdgcn_mbcnt_hi((unsigned)(m0 >> 32), __builtin_amdgcn_mbcnt_lo((unsigned)m0, 0u)); le[pos] = e0; lj[pos] = lane; }
                if (in1) { const int pos = n0 + (int)__builtin_amdgcn_mbcnt_hi((unsigned)(m1 >> 32), __builtin_amdgcn_mbcnt_lo((unsigned)m1, 0u)); le[pos] = e1; lj[pos] = 64 + lane; }
                u32x4 xr[8];
                { const u32x4* xrow = (const u32x4*)(H + (size_t)t * 1024) + i;
#pragma unroll
                  for (int q = 0; q < 8; ++q) xr[q] = xrow[16 * q]; }
                LDS_WAIT(); asm volatile("" ::: "memory");
#pragma unroll 1
                for (int s = 0; 4 * s < n; ++s) {
                    const int idx = 4 * s + g; const bool valid = idx < n;
                    const int e = le[valid ? idx : 0];
                    const u32x4* ur = (const u32x4*)(U16 + (size_t)e * 1024) + i;
                    u32x4 ua[8];
#pragma unroll
                    for (int q = 0; q < 8; ++q) ua[q] = ur[16 * q];
                    float a0 = 0.f, a1 = 0.f, a2 = 0.f, a3 = 0.f;
#pragma unroll
                    for (int q = 0; q < 8; ++q) { a0 = dot2bf(ua[q].x, xr[q].x, a0); a1 = dot2bf(ua[q].y, xr[q].y, a1); a2 = dot2bf(ua[q].z, xr[q].z, a2); a3 = dot2bf(ua[q].w, xr[q].w, a3); }
                    const float a = row16_sum((a0 + a1) + (a2 + a3));
                    if (i == 0 && valid) { const size_t gi = (size_t)t * 128 + lj[idx]; __hip_atomic_store(CBUF + gi, gelu_erf(a) * GATE[gi], __ATOMIC_RELAXED, __HIP_MEMORY_SCOPE_AGENT); }
                }
                LDS_WAIT(); asm volatile("" ::: "memory");
            }
        }
    }
}

__device__ __forceinline__ void ph_peer_v(const Params& p, unsigned char* lds) {
    const bf16* V16 = (const bf16*)(p.ws + WS_V16);
    const int* EXPI = (const int*)(p.ws + WS_EXP); const float* GATE = (const float*)(p.ws + WS_CBUF); const float* MOD = (const float*)(p.ws + WS_MOD);
    unsigned* ctl = (unsigned*)(p.ws + WS_CTL);
    int tid = threadIdx.x; asm volatile("" : "+v"(tid));
    const int lane = tid & 63, wv = __builtin_amdgcn_readfirstlane(tid >> 6), g8 = lane >> 3, i8 = lane & 7;
    volatile LAS unsigned* slot = (volatile LAS unsigned*)(LAS unsigned char*)lds;
    int* le = (int*)(lds + 1024 + wv * 1024); float* lc = (float*)(le + 128);
    const unsigned xcc = peer_xcc();
#pragma unroll 1
    for (int k = 0; k < 16; ++k) {
        const int sl = (int)((2u * xcc + (unsigned)k) & 15u);
#pragma unroll 1
        for (;;) {
            if (tid == 0) *slot = __hip_atomic_fetch_add(ctl + CW_PEER_V + 64 * sl, 1u, __ATOMIC_RELAXED, __HIP_MEMORY_SCOPE_AGENT);
            __syncthreads();
            const unsigned unit = *slot;
            __syncthreads();
            if (unit >= (unsigned)PU_UNITS) break;
#pragma unroll 1
            for (int tt = 0; tt < 8; ++tt) {
                const int t = (int)unit * 64 + wv * 8 + tt;
                le[lane] = EXPI[(size_t)t * 128 + lane]; le[64 + lane] = EXPI[(size_t)t * 128 + 64 + lane];
                lc[lane] = GATE[(size_t)t * 128 + lane]; lc[64 + lane] = GATE[(size_t)t * 128 + 64 + lane];
                LDS_WAIT(); asm volatile("" ::: "memory");
                float acc[8];
#pragma unroll
                for (int q = 0; q < 8; ++q) acc[q] = 0.f;
                const bf16* vcol = V16 + 64 * sl + 8 * i8;
#pragma unroll
                for (int kk = 0; kk < 8; ++kk) {
                    const int ja = 8 * kk + g8, jb = 64 + 8 * kk + g8;
                    const u32x4 A = *(const u32x4*)(vcol + (size_t)le[ja] * 1024), B = *(const u32x4*)(vcol + (size_t)le[jb] * 1024);
                    const unsigned cp = pk2(lc[ja], lc[jb]);
                    acc[0] = dot2bf(__builtin_amdgcn_perm(B.x, A.x, 0x05040100u), cp, acc[0]); acc[1] = dot2bf(__builtin_amdgcn_perm(B.x, A.x, 0x07060302u), cp, acc[1]);
                    acc[2] = dot2bf(__builtin_amdgcn_perm(B.y, A.y, 0x05040100u), cp, acc[2]); acc[3] = dot2bf(__builtin_amdgcn_perm(B.y, A.y, 0x07060302u), cp, acc[3]);
                    acc[4] = dot2bf(__builtin_amdgcn_perm(B.z, A.z, 0x05040100u), cp, acc[4]); acc[5] = dot2bf(__builtin_amdgcn_perm(B.z, A.z, 0x07060302u), cp, acc[5]);
                    acc[6] = dot2bf(__builtin_amdgcn_perm(B.w, A.w, 0x05040100u), cp, acc[6]); acc[7] = dot2bf(__builtin_amdgcn_perm(B.w, A.w, 0x07060302u), cp, acc[7]);
                }
#pragma unroll
                for (int q = 0; q < 8; ++q) { acc[q] += dpp_f<0x128>(acc[q]); acc[q] += __shfl_xor(acc[q], 16); acc[q] += __shfl_xor(acc[q], 32); }
                if (g8 == 0) {
                    const int col = 64 * sl + 8 * i8;
                    const float* g2 = MOD + (size_t)(t >> 11) * 6144 + 5120 + col;
                    float* orow = p.out + (size_t)t * 1024 + col;
                    const f32x4 x0 = *(const f32x4*)orow, x1v = *(const f32x4*)(orow + 4), h0 = *(const f32x4*)g2, h1 = *(const f32x4*)(g2 + 4);
                    f32x4 r0, r1; r0.x = acc[0]; r0.y = acc[1]; r0.z = acc[2]; r0.w = acc[3]; r1.x = acc[4]; r1.y = acc[5]; r1.z = acc[6]; r1.w = acc[7];
                    *(f32x4*)orow = x0 + h0 * r0; *(f32x4*)(orow + 4) = x1v + h1 * r1;
                }
                LDS_WAIT(); asm volatile("" ::: "memory");
            }
        }
    }
}
typedef float f32x2_t __attribute__((ext_vector_type(2)));
constexpr int P8_UNITS = T / 64;
constexpr int CW_P8_U = 4096, CW_P8_V = 4096 + 32 * 64;
constexpr float U8_SCALE = 32.0f;

__device__ __forceinline__ void ph_peer_u8(const Params& p, unsigned char* lds) {
    const bf16* H = (const bf16*)(p.ws + WS_H); const unsigned char* U8 = (const unsigned char*)(p.ws + WS_U16);
    const int* EXPI = (const int*)(p.ws + WS_EXP); const float* GATE = (const float*)(p.ws + WS_GATE); float* CBUF = (float*)(p.ws + WS_CBUF);
    unsigned* ctl = (unsigned*)(p.ws + WS_CTL);
    int tid = threadIdx.x; asm volatile("" : "+v"(tid));
    const int lane = tid & 63, wv = __builtin_amdgcn_readfirstlane(tid >> 6), g = lane >> 4, i = lane & 15;
    volatile LAS unsigned* slot = (volatile LAS unsigned*)(LAS unsigned char*)lds;
    int* lw = (int*)(lds + 1024 + wv * 6144);
    int* myle = lw + g * 384; int* mylj = myle + 128; float* mylg = (float*)(myle + 256);
    const unsigned xcc = peer_xcc();
#pragma unroll 1
    for (int k = 0; k < 8; ++k) {
        const int part = (int)((xcc + (unsigned)k) & 7u);
#pragma unroll 1
        for (;;) {
            if (tid == 0) *slot = __hip_atomic_fetch_add(ctl + CW_P8_U + 64 * part, 1u, __ATOMIC_RELAXED, __HIP_MEMORY_SCOPE_AGENT);
            __syncthreads();
            const unsigned unit = *slot;
            __syncthreads();
            if (unit >= (unsigned)P8_UNITS) break;
#pragma unroll 1
            for (int rd = 0; rd < 2; ++rd) {
                const int tb4 = (int)unit * 64 + wv * 8 + rd * 4;
                u32x4 nx[8];
                { const u32x4* xrow = (const u32x4*)(H + (size_t)(tb4 + g) * 1024) + 2 * i;
#pragma unroll
                  for (int q = 0; q < 4; ++q) { nx[2 * q] = xrow[32 * q]; nx[2 * q + 1] = xrow[32 * q + 1]; } }
                int nmine = 0, nmax = 0;
#pragma unroll
                for (int q = 0; q < 4; ++q) {
                    const size_t tq = (size_t)(tb4 + q);
                    const int e0 = EXPI[tq * 128 + lane], e1 = EXPI[tq * 128 + 64 + lane];
                    const float g0 = GATE[tq * 128 + lane], g1 = GATE[tq * 128 + 64 + lane];
                    const bool in0 = (e0 >> 11) == part, in1 = (e1 >> 11) == part;
                    const unsigned long long m0 = __ballot(in0), m1 = __ballot(in1);
                    const int n0 = __popcll(m0), n = n0 + __popcll(m1);
                    int* qle = lw + q * 384;
                    if (in0) { const int pos = (int)__builtin_amdgcn_mbcnt_hi((unsigned)(m0 >> 32), __builtin_amdgcn_mbcnt_lo((unsigned)m0, 0u)); qle[pos] = e0; qle[128 + pos] = lane; ((float*)qle)[256 + pos] = g0; }
                    if (in1) { const int pos = n0 + (int)__builtin_amdgcn_mbcnt_hi((unsigned)(m1 >> 32), __builtin_amdgcn_mbcnt_lo((unsigned)m1, 0u)); qle[pos] = e1; qle[128 + pos] = 64 + lane; ((float*)qle)[256 + pos] = g1; }
                    nmine = (g == q) ? n : nmine; nmax = n > nmax ? n : nmax;
                }
                float xf[64];
#pragma unroll
                for (int q = 0; q < 8; ++q) { xf[8 * q] = bflo(nx[q].x); xf[8 * q + 1] = bfhi(nx[q].x); xf[8 * q + 2] = bflo(nx[q].y); xf[8 * q + 3] = bfhi(nx[q].y);
                    xf[8 * q + 4] = bflo(nx[q].z); xf[8 * q + 5] = bfhi(nx[q].z); xf[8 * q + 6] = bflo(nx[q].w); xf[8 * q + 7] = bfhi(nx[q].w); }
                LDS_WAIT(); asm volatile("" ::: "memory");
                const size_t cb = (size_t)(tb4 + g) * 128;
#define U8_LOAD(R, S) do { const int s_ = (S); const int e_ = (s_ < nmine) ? myle[s_] : 0; const u32x4* r_ = (const u32x4*)(U8 + (size_t)e_ * 1024) + i;                     \
        _Pragma("unroll") for (int q = 0; q < 4; ++q) R[q] = r_[16 * q]; } while (0)
#define U8_DOT(R, S) do { const int s_ = (S); float a0 = 0.f, a1 = 0.f, a2 = 0.f, a3 = 0.f;                                                            \
        _Pragma("unroll") for (int q = 0; q < 4; ++q) { const unsigned w_[4] = {R[q].x, R[q].y, R[q].z, R[q].w};                                           \
            _Pragma("unroll") for (int c = 0; c < 4; ++c) { const f32x2_t lo = __builtin_amdgcn_cvt_pk_f32_fp8((int)w_[c], false), hi = __builtin_amdgcn_cvt_pk_f32_fp8((int)w_[c], true); \
                a0 = fmaf(lo.x, xf[16 * q + 4 * c], a0); a1 = fmaf(lo.y, xf[16 * q + 4 * c + 1], a1); a2 = fmaf(hi.x, xf[16 * q + 4 * c + 2], a2); a3 = fmaf(hi.y, xf[16 * q + 4 * c + 3], a3); } } \
        const float a_ = row16_sum((a0 + a1) + (a2 + a3)) * (1.0f / U8_SCALE);                                                                         \
        if (i == 0 && s_ < nmine) __hip_atomic_store(CBUF + cb + mylj[s_], gelu_erf(a_) * mylg[s_], __ATOMIC_RELAXED, __HIP_MEMORY_SCOPE_AGENT); } while (0)
                u32x4 RA[4], RB[4], RC[4], RD[4];
                U8_LOAD(RA, 0); U8_LOAD(RB, 1); U8_LOAD(RC, 2);
#pragma unroll 1
                for (int s = 0; s < nmax; s += 4) {
                    U8_LOAD(RD, s + 3); U8_DOT(RA, s);
                    if (s + 1 < nmax) { U8_LOAD(RA, s + 4); U8_DOT(RB, s + 1); }
                    if (s + 2 < nmax) { U8_LOAD(RB, s + 5); U8_DOT(RC, s + 2); }
                    if (s + 3 < nmax) { U8_LOAD(RC, s + 6); U8_DOT(RD, s + 3); }
                }
#undef U8_LOAD
#undef U8_DOT
                LDS_WAIT(); asm volatile("" ::: "memory");
            }
        }
    }
}

__device__ __forceinline__ void ph_peer_v8(const Params& p, unsigned char* lds) {
    const unsigned char* V8 = (const unsigned char*)(p.ws + WS_V16);
    const int* EXPI = (const int*)(p.ws + WS_EXP); const float* CBUF = (const float*)(p.ws + WS_CBUF); const float* MOD = (const float*)(p.ws + WS_MOD);
    unsigned* ctl = (unsigned*)(p.ws + WS_CTL);
    int tid = threadIdx.x; asm volatile("" : "+v"(tid));
    const int lane = tid & 63, wv = __builtin_amdgcn_readfirstlane(tid >> 6), g8 = lane >> 3, i8 = lane & 7;
    volatile LAS unsigned* slot = (volatile LAS unsigned*)(LAS unsigned char*)lds;
    int* le0 = (int*)(lds + 1024 + wv * 2048); float* lc0 = (float*)(le0 + 128); int* le1 = le0 + 256; float* lc1 = (float*)(le0 + 384);
    const unsigned xcc = peer_xcc();
#pragma unroll 1
    for (int k = 0; k < 8; ++k) {
        const int sl = (int)((xcc + (unsigned)k) & 7u);
        const unsigned char* vcol = V8 + 128 * sl + 16 * i8;
#pragma unroll 1
        for (;;) {
            if (tid == 0) *slot = __hip_atomic_fetch_add(ctl + CW_P8_V + 64 * sl, 1u, __ATOMIC_RELAXED, __HIP_MEMORY_SCOPE_AGENT);
            __syncthreads();
            const unsigned unit = *slot;
            __syncthreads();
            if (unit >= (unsigned)P8_UNITS) break;
            const int tbase = (int)unit * 64 + wv * 8;
            int ne0, ne1; float nc0, nc1;
#define V8_FETCH(T) do { const size_t tn_ = (size_t)(T); ne0 = EXPI[tn_ * 128 + lane]; ne1 = EXPI[tn_ * 128 + 64 + lane]; nc0 = CBUF[tn_ * 128 + lane]; nc1 = CBUF[tn_ * 128 + 64 + lane]; } while (0)
#define V8_LISTS(LE, LC) do { LE[lane] = ne0; LE[64 + lane] = ne1; LC[lane] = nc0; LC[64 + lane] = nc1; } while (0)
#define V8_ROWS(R, LE, HH) do { _Pragma("unroll") for (int kk = 0; kk < 8; ++kk) R[kk] = *(const u32x4*)(vcol + (size_t)LE[8 * (8 * (HH) + kk) + g8] * 1024); } while (0)
#define V8_HALF(R, LC, HH) do { _Pragma("unroll") for (int kk = 0; kk < 8; ++kk) { const float cj = LC[8 * (8 * (HH) + kk) + g8];               \
            const unsigned w_[4] = {R[kk].x, R[kk].y, R[kk].z, R[kk].w};                                                                       \
            _Pragma("unroll") for (int c = 0; c < 4; ++c) { const f32x2_t lo = __builtin_amdgcn_cvt_pk_f32_fp8((int)w_[c], false), hi = __builtin_amdgcn_cvt_pk_f32_fp8((int)w_[c], true); \
                acc[4 * c] = fmaf(cj, lo.x, acc[4 * c]); acc[4 * c + 1] = fmaf(cj, lo.y, acc[4 * c + 1]); acc[4 * c + 2] = fmaf(cj, hi.x, acc[4 * c + 2]); acc[4 * c + 3] = fmaf(cj, hi.y, acc[4 * c + 3]); } } } while (0)
            u32x4 RA[8], RB[8];
            int* lecur = (int*)(lds + 1024 + wv * 2048); int* lenxt = lecur + 256;
            V8_FETCH(tbase); V8_LISTS(lecur, ((float*)(lecur + 128))); V8_FETCH(tbase + 1);
            LDS_WAIT(); asm volatile("" ::: "memory");
            V8_ROWS(RA, lecur, 0);
#pragma unroll 1
            for (int tt = 0; tt < 8; ++tt) {
                const int t = tbase + tt;
                float* lccur = (float*)(lecur + 128); float* lcnxt = (float*)(lenxt + 128);
                float acc[16];
#pragma unroll
                for (int q = 0; q < 16; ++q) acc[q] = 0.f;
                V8_ROWS(RB, lecur, 1);
                if (tt + 1 < 8) { V8_LISTS(lenxt, lcnxt); if (tt + 2 < 8) V8_FETCH(t + 2); }
                V8_HALF(RA, lccur, 0);
                LDS_WAIT(); asm volatile("" ::: "memory");
                if (tt + 1 < 8) V8_ROWS(RA, lenxt, 0);
                V8_HALF(RB, lccur, 1);
#pragma unroll
                for (int q = 0; q < 16; ++q) { acc[q] += dpp_f<0x128>(acc[q]); acc[q] += __shfl_xor(acc[q], 16); acc[q] += __shfl_xor(acc[q], 32); }
                if (g8 == 0) { const int col = 128 * sl + 16 * i8; const float* g2 = MOD + (size_t)(t >> 11) * 6144 + 5120 + col; float* orow = p.out + (size_t)t * 1024 + col;
#pragma unroll
                    for (int q = 0; q < 4; ++q) { const f32x4 xv = *(const f32x4*)(orow + 4 * q), hv = *(const f32x4*)(g2 + 4 * q);
                        f32x4 r; r.x = acc[4 * q]; r.y = acc[4 * q + 1]; r.z = acc[4 * q + 2]; r.w = acc[4 * q + 3]; *(f32x4*)(orow + 4 * q) = xv + hv * r; } }
                { int* tmp_ = lecur; lecur = lenxt; lenxt = tmp_; }
            }
#undef V8_FETCH
#undef V8_LISTS
#undef V8_ROWS
#undef V8_HALF
            LDS_WAIT(); asm volatile("" ::: "memory");
        }
    }
}
#ifndef U8_PARTS
#define U8_PARTS 8
#endif
#define U8_SHIFT (U8_PARTS == 8 ? 11 : (U8_PARTS == 16 ? 10 : 9))
__device__ __forceinline__ void ph_peer_u8_old(const Params& p, unsigned char* lds) {
    const bf16* H = (const bf16*)(p.ws + WS_H); const unsigned char* U8 = (const unsigned char*)(p.ws + WS_U16);
    const int* EXPI = (const int*)(p.ws + WS_EXP); const float* GATE = (const float*)(p.ws + WS_GATE); float* CBUF = (float*)(p.ws + WS_CBUF);
    unsigned* ctl = (unsigned*)(p.ws + WS_CTL);
    int tid = threadIdx.x; asm volatile("" : "+v"(tid));
    const int lane = tid & 63, wv = __builtin_amdgcn_readfirstlane(tid >> 6), g = lane >> 4, i = lane & 15;
    volatile LAS unsigned* slot = (volatile LAS unsigned*)(LAS unsigned char*)lds;
    int* le = (int*)(lds + 1024 + wv * 2048); int* lj = le + 128; float* lg = (float*)(le + 256);
    const unsigned xcc = peer_xcc();
#pragma unroll 1
    for (int k = 0; k < U8_PARTS; ++k) {
        const int part = (int)(((U8_PARTS / 8) * xcc + (unsigned)k) & (unsigned)(U8_PARTS - 1));
#pragma unroll 1
        for (;;) {
            if (tid == 0) *slot = __hip_atomic_fetch_add(ctl + CW_P8_U + 64 * part, 1u, __ATOMIC_RELAXED, __HIP_MEMORY_SCOPE_AGENT);
            __syncthreads();
            const unsigned unit = *slot;
            __syncthreads();
            if (unit >= (unsigned)P8_UNITS) break;
            const int tbase = (int)unit * 64 + wv * 8;
            int ne0 = EXPI[(size_t)tbase * 128 + lane], ne1 = EXPI[(size_t)tbase * 128 + 64 + lane];
            float ng0 = GATE[(size_t)tbase * 128 + lane], ng1 = GATE[(size_t)tbase * 128 + 64 + lane];
            u32x4 nx[8];
            { const u32x4* xrow = (const u32x4*)(H + (size_t)tbase * 1024) + 2 * i;
#pragma unroll
              for (int q = 0; q < 4; ++q) { nx[2 * q] = xrow[32 * q]; nx[2 * q + 1] = xrow[32 * q + 1]; } }
#pragma unroll 1
            for (int tt = 0; tt < 8; ++tt) {
                const int t = tbase + tt;
                const int e0 = ne0, e1 = ne1; const float g0 = ng0, g1 = ng1;
                float xf[64];
#pragma unroll
                for (int q = 0; q < 8; ++q) { xf[8 * q] = bflo(nx[q].x); xf[8 * q + 1] = bfhi(nx[q].x); xf[8 * q + 2] = bflo(nx[q].y); xf[8 * q + 3] = bfhi(nx[q].y);
                    xf[8 * q + 4] = bflo(nx[q].z); xf[8 * q + 5] = bfhi(nx[q].z); xf[8 * q + 6] = bflo(nx[q].w); xf[8 * q + 7] = bfhi(nx[q].w); }
                if (tt + 1 < 8) { const size_t tn = (size_t)(t + 1);
                    ne0 = EXPI[tn * 128 + lane]; ne1 = EXPI[tn * 128 + 64 + lane]; ng0 = GATE[tn * 128 + lane]; ng1 = GATE[tn * 128 + 64 + lane];
                    const u32x4* xrow = (const u32x4*)(H + tn * 1024) + 2 * i;
#pragma unroll
                    for (int q = 0; q < 4; ++q) { nx[2 * q] = xrow[32 * q]; nx[2 * q + 1] = xrow[32 * q + 1]; } }
                const bool in0 = (e0 >> U8_SHIFT) == part, in1 = (e1 >> U8_SHIFT) == part;
                const unsigned long long m0 = __ballot(in0), m1 = __ballot(in1);
                const int n0 = __popcll(m0), n = n0 + __popcll(m1);
                if (in0) { const int pos = (int)__builtin_amdgcn_mbcnt_hi((unsigned)(m0 >> 32), __builtin_amdgcn_mbcnt_lo((unsigned)m0, 0u)); le[pos] = e0; lj[pos] = lane; lg[pos] = g0; }
                if (in1) { const int pos = n0 + (int)__builtin_amdgcn_mbcnt_hi((unsigned)(m1 >> 32), __builtin_amdgcn_mbcnt_lo((unsigned)m1, 0u)); le[pos] = e1; lj[pos] = 64 + lane; lg[pos] = g1; }
                LDS_WAIT(); asm volatile("" ::: "memory");
#pragma unroll 1
                for (int s = 0; 4 * s < n; s += 2) {
                    const int idxA = 4 * s + g, idxB = idxA + 4; const bool vA = idxA < n, vB = idxB < n;
                    const u32x4* ra = (const u32x4*)(U8 + (size_t)le[vA ? idxA : 0] * 1024) + i;
                    const u32x4* rb = (const u32x4*)(U8 + (size_t)le[vB ? idxB : 0] * 1024) + i;
                    u32x4 A[4], B[4];
#pragma unroll
                    for (int q = 0; q < 4; ++q) A[q] = ra[16 * q];
#pragma unroll
                    for (int q = 0; q < 4; ++q) B[q] = rb[16 * q];
#define P8_DOT(R, OUT) do { float a0 = 0.f, a1 = 0.f, a2 = 0.f, a3 = 0.f;                                                           \
    _Pragma("unroll") for (int q = 0; q < 4; ++q) {                                                                                   \
        const unsigned w_[4] = {R[q].x, R[q].y, R[q].z, R[q].w};                                                                      \
        _Pragma("unroll") for (int c = 0; c < 4; ++c) { const f32x2_t lo = __builtin_amdgcn_cvt_pk_f32_fp8((int)w_[c], false), hi = __builtin_amdgcn_cvt_pk_f32_fp8((int)w_[c], true); \
            a0 = fmaf(lo.x, xf[16 * q + 4 * c], a0); a1 = fmaf(lo.y, xf[16 * q + 4 * c + 1], a1); a2 = fmaf(hi.x, xf[16 * q + 4 * c + 2], a2); a3 = fmaf(hi.y, xf[16 * q + 4 * c + 3], a3); } } \
    OUT = row16_sum((a0 + a1) + (a2 + a3)) * (1.0f / U8_SCALE); } while (0)
                    float aA, aB;
                    P8_DOT(A, aA); P8_DOT(B, aB);
#undef P8_DOT
                    if (i == 0 && vA) __hip_atomic_store(CBUF + (size_t)t * 128 + lj[idxA], gelu_erf(aA) * lg[idxA], __ATOMIC_RELAXED, __HIP_MEMORY_SCOPE_AGENT);
                    if (i == 0 && vB) __hip_atomic_store(CBUF + (size_t)t * 128 + lj[idxB], gelu_erf(aB) * lg[idxB], __ATOMIC_RELAXED, __HIP_MEMORY_SCOPE_AGENT);
                }
                LDS_WAIT(); asm volatile("" ::: "memory");
            }
        }
    }
}

__device__ __forceinline__ void ph_peer_v8_old(const Params& p, unsigned char* lds) {
    const unsigned char* V8 = (const unsigned char*)(p.ws + WS_V16);
    const int* EXPI = (const int*)(p.ws + WS_EXP); const float* CBUF = (const float*)(p.ws + WS_CBUF); const float* MOD = (const float*)(p.ws + WS_MOD);
    unsigned* ctl = (unsigned*)(p.ws + WS_CTL);
    int tid = threadIdx.x; asm volatile("" : "+v"(tid));
    const int lane = tid & 63, wv = __builtin_amdgcn_readfirstlane(tid >> 6), g8 = lane >> 3, i8 = lane & 7;
    volatile LAS unsigned* slot = (volatile LAS unsigned*)(LAS unsigned char*)lds;
    int* le = (int*)(lds + 1024 + wv * 2048); float* lc = (float*)(le + 128);
    const unsigned xcc = peer_xcc();
#pragma unroll 1
    for (int k = 0; k < 8; ++k) {
        const int sl = (int)((xcc + (unsigned)k) & 7u);
#pragma unroll 1
        for (;;) {
            if (tid == 0) *slot = __hip_atomic_fetch_add(ctl + CW_P8_V + 64 * sl, 1u, __ATOMIC_RELAXED, __HIP_MEMORY_SCOPE_AGENT);
            __syncthreads();
            const unsigned unit = *slot;
            __syncthreads();
            if (unit >= (unsigned)P8_UNITS) break;
            const int tbase = (int)unit * 64 + wv * 8;
            int ne0 = EXPI[(size_t)tbase * 128 + lane], ne1 = EXPI[(size_t)tbase * 128 + 64 + lane];
            float nc0 = CBUF[(size_t)tbase * 128 + lane], nc1 = CBUF[(size_t)tbase * 128 + 64 + lane];
#pragma unroll 1
            for (int tt = 0; tt < 8; ++tt) {
                const int t = tbase + tt;
                le[lane] = ne0; le[64 + lane] = ne1; lc[lane] = nc0; lc[64 + lane] = nc1;
                if (tt + 1 < 8) { const size_t tn = (size_t)(t + 1); ne0 = EXPI[tn * 128 + lane]; ne1 = EXPI[tn * 128 + 64 + lane]; nc0 = CBUF[tn * 128 + lane]; nc1 = CBUF[tn * 128 + 64 + lane]; }
                LDS_WAIT(); asm volatile("" ::: "memory");
                const unsigned char* vcol = V8 + 128 * sl + 16 * i8;
                u32x4 R[16];
#pragma unroll
                for (int kk = 0; kk < 16; ++kk) R[kk] = *(const u32x4*)(vcol + (size_t)le[8 * kk + g8] * 1024);
                float acc[16];
#pragma unroll
                for (int q = 0; q < 16; ++q) acc[q] = 0.f;
#pragma unroll
                for (int kk = 0; kk < 16; ++kk) {
                    const float cj = lc[8 * kk + g8];
                    const unsigned w_[4] = {R[kk].x, R[kk].y, R[kk].z, R[kk].w};
#pragma unroll
                    for (int c = 0; c < 4; ++c) { const f32x2_t lo = __builtin_amdgcn_cvt_pk_f32_fp8((int)w_[c], false), hi = __builtin_amdgcn_cvt_pk_f32_fp8((int)w_[c], true);
                        acc[4 * c] = fmaf(cj, lo.x, acc[4 * c]); acc[4 * c + 1] = fmaf(cj, lo.y, acc[4 * c + 1]); acc[4 * c + 2] = fmaf(cj, hi.x, acc[4 * c + 2]); acc[4 * c + 3] = fmaf(cj, hi.y, acc[4 * c + 3]); }
                }
#pragma unroll
                for (int q = 0; q < 16; ++q) { acc[q] += dpp_f<0x128>(acc[q]); acc[q] += __shfl_xor(acc[q], 16); acc[q] += __shfl_xor(acc[q], 32); }
                if (g8 == 0) {
                    const int col = 128 * sl + 16 * i8;
                    const float* g2 = MOD + (size_t)(t >> 11) * 6144 + 5120 + col;
                    float* orow = p.out + (size_t)t * 1024 + col;
#pragma unroll
                    for (int q = 0; q < 4; ++q) { const f32x4 xv = *(const f32x4*)(orow + 4 * q), hv = *(const f32x4*)(g2 + 4 * q);
                        f32x4 r; r.x = acc[4 * q]; r.y = acc[4 * q + 1]; r.z = acc[4 * q + 2]; r.w = acc[4 * q + 3];
                        *(f32x4*)(orow + 4 * q) = xv + hv * r; }
                }
                LDS_WAIT(); asm volatile("" ::: "memory");
            }
        }
    }
}
__device__ __forceinline__ void ph_dsa_old(const Params& p, unsigned char* lds, int vb, int nvb) {
    const bf16* PROJ = (const bf16*)(p.ws + WS_PROJ); bf16* MIX = (bf16*)(p.ws + WS_MIX);
    const float MB = ((const float*)(p.ws + WS_SCAL))[SC_MB];
    int tid = threadIdx.x; asm volatile("" : "+v"(tid)); const int lane = tid & 63, wv = __builtin_amdgcn_readfirstlane(tid >> 6);
    const int l15 = lane & 15, g = lane >> 4;
    LAS unsigned char* ldsl = (LAS unsigned char*)lds;
    for (int it = vb; it < 2048; it += nvb) {
        const int vbb = it & 255, kk = it >> 8, xg = vbb & 7, ix = vbb >> 3, b = 2 * xg + (ix & 1), G = (ix >> 1) & 3, sub = ix >> 3;
        const int c = (kk & 1) ? (31 - G - 8 * (kk >> 1)) : (G + 8 * (kk >> 1));
        const int cend = (c + 1) * 64, t0 = c * 64 + sub * 16;
        const bf16* Pb = PROJ + (size_t)b * SEQ * NP;
        if (c >= 4) {
            const bf16* qrow = Pb + (size_t)(t0 + l15) * NP;
            bf16x8 bq[4][2]; float wsc[4];
#pragma unroll
            for (int h = 0; h < 4; ++h) { wsc[h] = bf2f(qrow[C_WI + h]) * 0.0625f;
#pragma unroll
                for (int ks = 0; ks < 2; ++ks) bq[h][ks] = *(const bf16x8*)(qrow + C_QI + h * 64 + 32 * ks + 8 * g); }
            for (int k0 = 16 * wv; k0 < cend; k0 += 128) {
                const bf16* krow = Pb + (size_t)(k0 + l15) * NP + C_KI + 8 * g;
                const bf16x8 ka0 = *(const bf16x8*)krow, ka1 = *(const bf16x8*)(krow + 32);
                f32x4 sc = {0.f, 0.f, 0.f, 0.f};
#pragma unroll
                for (int h = 0; h < 4; ++h) { f32x4 a = {0.f, 0.f, 0.f, 0.f};
                    a = __builtin_amdgcn_mfma_f32_16x16x32_bf16(ka0, bq[h][0], a, 0, 0, 0);
                    a = __builtin_amdgcn_mfma_f32_16x16x32_bf16(ka1, bq[h][1], a, 0, 0, 0);
#pragma unroll
                    for (int r = 0; r < 4; ++r) sc[r] = fmaf(fmaxf(a[r], 0.f), wsc[h], sc[r]); }
#pragma unroll
                for (int r = 0; r < 4; ++r) sc[r] = (sc[r] == 0.f) ? 0.f : sc[r];
                *(LAS f32x4*)(ldsl + l15 * DSA_SROW + (k0 + 4 * g) * 4) = sc;
            }
        }
        __syncthreads();
        LAS unsigned short* selw = (LAS unsigned short*)(ldsl + DSA_SEL_OFF);
        int mind0 = 0, mind1 = 0;
#pragma unroll 1
        for (int qi = 0; qi < 2; ++qi) {
            const int qq = 2 * wv + qi, t = t0 + qq;
            LAS unsigned short* sel = selw + qq * 256;
            if (c < 4) { for (int j = lane; j < 256; j += 64) sel[j] = (unsigned short)j; continue; }
            const int nreg = cend >> 6;
            unsigned key[32];
            const LAS float* srow = (const LAS float*)(ldsl + qq * DSA_SROW) + lane;
#pragma unroll
            for (int i = 0; i < 32; ++i) key[i] = (i < nreg) ? sortkey(srow[64 * i]) : 0u;
            unsigned prefix = 0u; bool exact = false;
#pragma unroll 1
            for (int bit = 31; bit >= 0; --bit) {
                const unsigned cand = prefix | (1u << bit); int cnt = 0;
#pragma unroll
                for (int i = 0; i < 32; ++i) cnt += __popcll(__ballot(key[i] >= cand));
                if (cnt >= 256) { prefix = cand; if (cnt == 256) { exact = true; break; } }
            }
            int need_ties = 0;
            if (!exact) { int cgt = 0;
                if (prefix != 0xffffffffu) {
#pragma unroll
                    for (int i = 0; i < 32; ++i) cgt += __popcll(__ballot(key[i] > prefix)); }
                need_ties = 256 - cgt; }
            int base = 0, tbase = 0, md = 4096;
#pragma unroll
            for (int i = 0; i < 32; ++i) {
                if (i < nreg) {
                    bool selb;
                    if (exact) selb = key[i] >= prefix;
                    else { const bool tie = key[i] == prefix; const unsigned long long mt = __ballot(tie);
                        const int trank = tbase + (int)__builtin_amdgcn_mbcnt_hi((unsigned)(mt >> 32), __builtin_amdgcn_mbcnt_lo((unsigned)mt, 0u));
                        selb = (key[i] > prefix) || (tie && trank < need_ties); tbase += __popcll(mt); }
                    const unsigned long long m = __ballot(selb);
                    const int pos = base + (int)__builtin_amdgcn_mbcnt_hi((unsigned)(m >> 32), __builtin_amdgcn_mbcnt_lo((unsigned)m, 0u));
                    const int kidx = i * 64 + lane;
                    if (selb) { sel[pos] = (unsigned short)kidx; const int d = t > kidx ? t - kidx : kidx - t; md = d < md ? d : md; }
                    base += __popcll(m);
                }
            }
#pragma unroll
            for (int o = 1; o < 64; o <<= 1) { const int x = __shfl_xor(md, o); md = x < md ? x : md; }
            if (qi == 0) mind0 = md; else mind1 = md;
        }
        LDS_WAIT(); asm volatile("" ::: "memory");
        const int nvalid = cend < 256 ? cend : 256;
        const int head = lane & 7;
        const float slopeL2 = exp2f(-(float)(head + 1)) * 1.4426950409f;
#pragma unroll 1
        for (int qi = 0; qi < 2; ++qi) {
            const int qq = 2 * wv + qi, t = t0 + qq;
            const LAS unsigned short* sel = selw + qq * 256;
            LAS unsigned char* stg = ldsl + (2 * wv) * DSA_SROW;
            const bf16* qrow = Pb + (size_t)t * NP + C_QB + head * 128 + 8 * g;
            bf16x8 bq[4];
#pragma unroll
            for (int ks = 0; ks < 4; ++ks) bq[ks] = *(const bf16x8*)(qrow + 32 * ks);
            const float refL2 = MB * 1.4426950409f - slopeL2 * (float)(qi == 0 ? mind0 : mind1);
            f32x4 o[8];
#pragma unroll
            for (int dt = 0; dt < 8; ++dt) o[dt] = (f32x4){0.f, 0.f, 0.f, 0.f};
            float lsum = 0.f;
#pragma unroll 1
            for (int s = 0; s < 8; ++s) {
                if (32 * s >= nvalid) break;
                unsigned pb[4];
#pragma unroll
                for (int tl = 0; tl < 2; ++tl) {
                    const int j0 = 32 * s + 16 * tl;
                    const int jr = j0 + l15; const int keyr = sel[jr < nvalid ? jr : 0];
                    const bf16* kvrow = Pb + (size_t)keyr * NP + C_KV + 8 * g;
                    bf16x8 ka[4];
#pragma unroll
                    for (int ks = 0; ks < 4; ++ks) ka[ks] = *(const bf16x8*)(kvrow + 32 * ks);
                    f32x4 a = {0.f, 0.f, 0.f, 0.f};
#pragma unroll
                    for (int ks = 0; ks < 4; ++ks) { a = __builtin_amdgcn_mfma_f32_16x16x32_bf16(ka[ks], bq[ks], a, 0, 0, 0);
                        *(LAS bf16x8*)(stg + (16 * tl + l15) * DSA_KVROW + (32 * ks + 8 * g) * 2) = ka[ks]; }
                    const u32x2 kw = *(const LAS u32x2*)(sel + j0 + 4 * g);
                    const int kx[4] = {(int)(kw.x & 0xffffu), (int)(kw.x >> 16), (int)(kw.y & 0xffffu), (int)(kw.y >> 16)};
                    float pr[4];
#pragma unroll
                    for (int r = 0; r < 4; ++r) { const int dd = t > kx[r] ? t - kx[r] : kx[r] - t;
                        const float e = __builtin_amdgcn_exp2f(fmaf(a[r], 0.1275174f, -slopeL2 * (float)dd - refL2));
                        pr[r] = (j0 + 4 * g + r < nvalid) ? e : 0.f; lsum += pr[r]; }
                    pb[2 * tl] = cvtpk_bf16(pr[0], pr[1]); pb[2 * tl + 1] = cvtpk_bf16(pr[2], pr[3]);
                }
                LDS_WAIT(); asm volatile("" ::: "memory");
                u32x4 pw4; pw4.x = pb[0]; pw4.y = pb[1]; pw4.z = pb[2]; pw4.w = pb[3];
                const bf16x8 pfrag = __builtin_bit_cast(bf16x8, pw4);
                const LAS unsigned char* trb = stg + (4 * g + (l15 >> 2)) * DSA_KVROW + (4 * (lane & 3)) * 2;
#pragma unroll
                for (int dt = 0; dt < 8; ++dt) {
                    const s16x4 lo = __builtin_bit_cast(s16x4, __builtin_amdgcn_ds_read_tr16_b64_v4i16((LAS v4i16_t*)(trb + dt * 32)));
                    const s16x4 hi = __builtin_bit_cast(s16x4, __builtin_amdgcn_ds_read_tr16_b64_v4i16((LAS v4i16_t*)(trb + 16 * DSA_KVROW + dt * 32)));
                    const bf16x8 af = {lo[0], lo[1], lo[2], lo[3], hi[0], hi[1], hi[2], hi[3]};
                    o[dt] = __builtin_amdgcn_mfma_f32_16x16x32_bf16(af, pfrag, o[dt], 0, 0, 0);
                }
                LDS_WAIT(); asm volatile("" ::: "memory");
            }
            lsum += __shfl_xor(lsum, 16); lsum += __shfl_xor(lsum, 32);
            const float il = 1.f / lsum;
            if (l15 < 8) {
                bf16* orow = MIX + (size_t)(b * SEQ + t) * MIXW + 512 + head * 128 + 4 * g;
#pragma unroll
                for (int dt = 0; dt < 8; ++dt) { u32x2 w; w.x = pk2(o[dt][0] * il, o[dt][1] * il); w.y = pk2(o[dt][2] * il, o[dt][3] * il); *(u32x2*)(orow + 16 * dt) = w; }
            }
        }
        __syncthreads();
    }
}
#define XB_TMO      128
#define XB_XCNT(j)  (256  + 64 * (j))
#define XB_XSUB(j)  (1280 + 64 * (j))
#define XB_XGEN(j)  (2304 + 64 * (j))
#define XB_TOP      3328
#define XB_TOPGEN   3392
#define XCD_BAR_WORDS 3456
#define XB_SPIN_CAP (1u << 18)

__device__ __forceinline__ unsigned xb_ld(unsigned* p)              { return __hip_atomic_load(p, __ATOMIC_RELAXED, __HIP_MEMORY_SCOPE_AGENT); }
__device__ __forceinline__ unsigned xb_add(unsigned* p, unsigned v) { return __hip_atomic_fetch_add(p, v, __ATOMIC_RELAXED, __HIP_MEMORY_SCOPE_AGENT); }
__device__ __forceinline__ unsigned xb_xcc_id() { return (unsigned)__builtin_amdgcn_s_getreg((3 << 11) | 20) & 0xFu; }
#define XB_SPIN(cond, bar) do { unsigned _sp = 0; while (cond) { __builtin_amdgcn_s_sleep(1); \
    if ((++_sp & 255u) == 0u) { if (xb_ld(&(bar)[XB_TMO])) break; if (_sp > XB_SPIN_CAP) { atomicAdd(&(bar)[XB_TMO], 1u); break; } } } } while (0)

struct XcdBarrier {
    unsigned* bar; unsigned x;
    volatile LAS unsigned* st;
};

__device__ __forceinline__ XcdBarrier xcd_barrier_post(unsigned* bar, volatile LAS unsigned* st) {
    XcdBarrier b; b.bar = bar; b.x = xb_xcc_id(); b.st = st;
    if (threadIdx.x == 0) (void)xb_add(&bar[XB_XCNT(b.x)], 1u);
    return b;
}
__device__ __forceinline__ void xcd_barrier_complete(unsigned* bar, unsigned x, unsigned& nloc, unsigned& nx) {
    const unsigned G = gridDim.x * gridDim.y * gridDim.z;
    unsigned sum, cnt, mine, sp = 0u;
    for (;;) {
        sum = 0u; cnt = 0u; mine = 0u;
#pragma unroll
        for (unsigned j = 0; j < 16; ++j) { const unsigned c = xb_ld(&bar[XB_XCNT(j)]); sum += c; cnt += (c > 0u) ? 1u : 0u; mine = (j == x) ? c : mine; }
        if (sum == G) break;
        __builtin_amdgcn_s_sleep(1);
        if ((++sp & 255u) == 0u) { if (xb_ld(&bar[XB_TMO])) break; if (sp > XB_SPIN_CAP) { atomicAdd(&bar[XB_TMO], 1u); break; } }
    }
    nloc = mine > 0u ? mine : 1u; nx = cnt > 0u ? cnt : 1u;
}

__device__ __forceinline__ void xcd_barrier(const XcdBarrier& b) {
    asm volatile("s_waitcnt vmcnt(0)" ::: "memory");
    __syncthreads();
    if (threadIdx.x == 0) {
        unsigned* bar = b.bar;
        __builtin_amdgcn_s_waitcnt(0);
        unsigned nloc = b.st[0], nx = b.st[1];
        if (nloc == 0u) { xcd_barrier_complete(bar, b.x, nloc, nx); b.st[0] = nloc; b.st[1] = nx; }
        const unsigned old = xb_add(&bar[XB_XSUB(b.x)], 1u);
        const unsigned gen = old / nloc;
        if (old + 1u == (gen + 1u) * nloc) {
            __builtin_amdgcn_fence(__ATOMIC_RELEASE, "agent");
            asm volatile("s_waitcnt vmcnt(0)" ::: "memory");
            const unsigned og = xb_add(&bar[XB_TOP], 1u);
            const unsigned tg = og / nx;
            if (og + 1u == (tg + 1u) * nx) xb_add(&bar[XB_TOPGEN], 1u);
            else XB_SPIN(xb_ld(&bar[XB_TOPGEN]) == tg, bar);
            __builtin_amdgcn_fence(__ATOMIC_ACQUIRE, "agent");
            xb_add(&bar[XB_XGEN(b.x)], 1u);
            asm volatile("s_waitcnt vmcnt(0)" ::: "memory");
        } else {
            XB_SPIN(xb_ld(&bar[XB_XGEN(b.x)]) == gen, bar);
            __builtin_amdgcn_fence(__ATOMIC_ACQUIRE, "agent");
            asm volatile("s_waitcnt vmcnt(0)" ::: "memory");
        }
    }
    __syncthreads();
}

#ifndef VAR_DSA_OLD
#define VAR_DSA_OLD 0
#endif
#ifndef VAR_U8_OLD
#define VAR_U8_OLD 1
#endif
#ifndef VAR_V8_OLD
#define VAR_V8_OLD 0
#endif
#ifndef PROBE_DUP
#define PROBE_DUP 0
#endif
constexpr int LDS_BYTES = 147456;
extern __shared__ __attribute__((aligned(16))) unsigned char dyn_lds[];

__global__ void __launch_bounds__(NT, 2) mega_fwd(Params p) {
    cg::grid_group grid = cg::this_grid();
    const int vb = blockIdx.x, nvb = gridDim.x, ngw = nvb * NWV;
    volatile LAS unsigned* xst = (volatile LAS unsigned*)((LAS unsigned char*)dyn_lds + (LDS_BYTES - 16));
    if (threadIdx.x < 4) xst[threadIdx.x] = 0u;
    __syncthreads();
    const XcdBarrier xbar = xcd_barrier_post((unsigned*)(p.ws + WS_CTL), xst);
#define TID_LAUNDER int tid_ = threadIdx.x; asm volatile("" : "+v"(tid_)); const int lane = tid_ & 63, wv = tid_ >> 6, gw = vb * NWV + wv; (void)lane; (void)gw;
    ph_mod(p, (float*)dyn_lds, vb, nvb);
    { TID_LAUNDER ph_prep_weights(p, (LAS float*)dyn_lds + wv * (64 * 33), gw, ngw, lane); }
#if PROBE_DUP == 7
    __syncthreads();
    ph_mod(p, (float*)dyn_lds, vb, nvb);
    { TID_LAUNDER ph_prep_weights(p, (LAS float*)dyn_lds + wv * (64 * 33), gw, ngw, lane); }
#endif
    grid.sync();
    { TID_LAUNDER ph_hrows(p, p.x, p.norm1_g, 0, 1024, gw, ngw, lane); }
#if PROBE_DUP == 9
    { TID_LAUNDER ph_hrows(p, p.x, p.norm1_g, 0, 1024, gw, ngw, lane); }
#endif
    xcd_barrier(xbar);
    {   pg8::Gemm g{(const bf16*)(p.ws + WS_H), (const bf16*)(p.ws + WS_WIN), T, NP, 1024}; pg8::StaticOrder S; S.init(T, NP, nvb, vb);
        EpiNormBf16 E{(bf16*)(p.ws + WS_PROJ), p.a_qk_gain, p.b_q_gain, p.b_kv_gain, (LAS float*)((LAS unsigned char*)dyn_lds + 131072)};
        pg8::gemm_phase<EpiNormBf16, pg8::StaticOrder, true, true>((LAS unsigned char*)dyn_lds, g, S, E); }
    xcd_barrier(xbar);
    ph_attnA(p, dyn_lds, vb, nvb);
#if PROBE_DUP == 1
    __syncthreads(); ph_attnA(p, dyn_lds, vb, nvb);
#endif
    __syncthreads();
#if VAR_DSA_OLD
    ph_dsa_old(p, dyn_lds, vb, nvb);
#else
    ph_dsa(p, dyn_lds, vb, nvb);
#endif
#if PROBE_DUP == 2
    __syncthreads(); ph_dsa(p, dyn_lds, vb, nvb);
#endif
    xcd_barrier(xbar);
    {   pg8::Gemm g{(const bf16*)(p.ws + WS_MIX), (const bf16*)(p.ws + WS_WO2), T, 1024, MIXW}; pg8::StaticOrder S; S.init(T, 1024, nvb, vb);
        EpiResGate E{p.x, p.out, (const float*)(p.ws + WS_MOD) + 2048};
        pg8::gemm_phase<EpiResGate, pg8::StaticOrder, true, true>((LAS unsigned char*)dyn_lds, g, S, E); }
#if PROBE_DUP == 8
    {   pg8::Gemm g{(const bf16*)(p.ws + WS_MIX), (const bf16*)(p.ws + WS_WO2), T, 1024, MIXW}; pg8::StaticOrder S; S.init(T, 1024, nvb, vb);
        EpiResGate E{p.x, p.out, (const float*)(p.ws + WS_MOD) + 2048};
        pg8::gemm_phase<EpiResGate, pg8::StaticOrder, true, true>((LAS unsigned char*)dyn_lds, g, S, E); }
#endif
    xcd_barrier(xbar);
    { TID_LAUNDER ph_hrows(p, p.out, p.norm2_g, 3072, 4096, gw, ngw, lane); }
    xcd_barrier(xbar);
    {   pg8::Gemm g{(const bf16*)(p.ws + WS_H), (const bf16*)(p.ws + WS_WQ), T, 1024, 1024}; pg8::StaticOrder S; S.init(T, 1024, nvb, vb);
        pg8::EpiBf16<0> E{(bf16*)(p.ws + WS_Q3), 1024, nullptr, 0, 0, 1.f};
        pg8::gemm_phase<pg8::EpiBf16<0>, pg8::StaticOrder, true, true>((LAS unsigned char*)dyn_lds, g, S, E); }
#if PROBE_DUP == 8
    {   pg8::Gemm g{(const bf16*)(p.ws + WS_H), (const bf16*)(p.ws + WS_WQ), T, 1024, 1024}; pg8::StaticOrder S; S.init(T, 1024, nvb, vb);
        pg8::EpiBf16<0> E{(bf16*)(p.ws + WS_Q3), 1024, nullptr, 0, 0, 1.f};
        pg8::gemm_phase<pg8::EpiBf16<0>, pg8::StaticOrder, true, true>((LAS unsigned char*)dyn_lds, g, S, E); }
#endif
    xcd_barrier(xbar);
    ph_route(p, dyn_lds, vb, nvb);
#if PROBE_DUP == 3
    __syncthreads(); ph_route(p, dyn_lds, vb, nvb);
#endif
    xcd_barrier(xbar);

#if VAR_U8_OLD
    ph_peer_u8_old(p, dyn_lds);
#else
    ph_peer_u8(p, dyn_lds);
#endif

    xcd_barrier(xbar);

#if VAR_V8_OLD
    ph_peer_v8_old(p, dyn_lds);
#else
    ph_peer_v8(p, dyn_lds);
#endif

}

extern "C" void kernel_launch(void* const* d_in, const int* in_sizes, int n_in, void* d_out, int out_size, void* d_ws, size_t ws_size, hipStream_t stream) {
    static int grid_blocks = 0;
    if (grid_blocks == 0) {
        if (n_in != 18 || in_sizes[0] != T * DM || out_size != T * DM || ws_size < WS_END) { fprintf(stderr, "kernel_launch: unexpected shapes n_in %d in0 %d out %d ws %zu\n", n_in, n_in > 0 ? in_sizes[0] : -1, out_size, ws_size); grid_blocks = -1; return; }
        int dev = 0, cus = 0, per_cu = 0;
        (void)hipGetDevice(&dev);
        (void)hipDeviceGetAttribute(&cus, hipDeviceAttributeMultiprocessorCount, dev);
        (void)hipFuncSetAttribute((const void*)mega_fwd, hipFuncAttributeMaxDynamicSharedMemorySize, LDS_BYTES);
        (void)hipOccupancyMaxActiveBlocksPerMultiprocessor(&per_cu, (const void*)mega_fwd, NT, LDS_BYTES);
        if (per_cu < 1 || cus < 1) { fprintf(stderr, "kernel_launch: occupancy query gave %d blocks/CU on %d CUs\n", per_cu, cus); grid_blocks = -1; return; }
        grid_blocks = cus;
    }
    if (grid_blocks < 0) return;
    Params p{};
    const float** pp = (const float**)&p;
    for (int i = 0; i < 18; ++i) pp[i] = (const float*)d_in[i];
    p.out = (float*)d_out; p.ws = (unsigned char*)d_ws;
    if (hipMemsetAsync((char*)d_ws + WS_CTL, 0, CTL_BYTES, stream) != hipSuccess) { fprintf(stderr, "kernel_launch: memset failed\n"); return; }
    void* args[] = {&p};
    const hipError_t e = hipLaunchCooperativeKernel((const void*)mega_fwd, dim3(grid_blocks), dim3(NT), args, LDS_BYTES, stream);
    if (e != hipSuccess) fprintf(stderr, "kernel_launch: cooperative launch failed: %s (grid %d)\n", hipGetErrorString(e), grid_blocks);
}
```

```cpp
#include <hip/hip_runtime.h>
#include <hip/hip_cooperative_groups.h>
#include <cstdio>
#include <cstdint>
#include <cmath>
namespace pg8 {
#define PG8_LAS __attribute__((address_space(3)))
typedef unsigned short bf16_t;
typedef short bf16x8 __attribute__((ext_vector_type(8)));
typedef float f32x4 __attribute__((ext_vector_type(4)));
typedef unsigned u32x4 __attribute__((ext_vector_type(4)));
constexpr int BM = 256, BK = 64, HALF = 128, HTB = HALF * BK * 2  , STAGE_BYTES = 8 * HTB, NXCD = 8, WGM = 8;

__host__ __device__ __forceinline__ int lds_byte(int r, int c) { const int st = (r >> 4) * 2 + (c >> 5), rr = r & 15, cc = c & 31, ob = rr * 64 + cc * 2; return st * 1024 + (ob ^ (((ob >> 9) & 1) << 5)); }
__host__ __device__ __forceinline__ void stage_rc(int b, int& R, int& C) { const int st = b / 1024, sb = b % 1024, swz = sb ^ (((sb >> 9) & 1) << 5); R = (st >> 1) * 16 + swz / 64; C = (st & 1) * 32 + (swz % 64) / 2; }
__host__ __device__ __forceinline__ int perm32(int rho) { const int n = rho >> 4, i = rho & 15; return 8 * (i >> 2) + 4 * n + (i & 3); }

struct Unit { int pm, pn; };
struct Gemm { const bf16_t* A; const bf16_t* Bt; int M, N, K; };

struct StaticOrder {
    int nM, nN, nwg, G, c;
    __host__ __device__ void init(int M, int N, int G_, int c_) { nM = M / BM; nN = N / BM; nwg = nM * nN; G = G_; c = c_; }
    __host__ __device__ bool next(int i, Unit& u) const {
        const long L = (long)i * G + c; if (L >= nwg) return false;
        int wgid = (int)L; { const int q = nwg / NXCD, r = nwg % NXCD, xcd = wgid % NXCD, off = wgid / NXCD; wgid = (xcd < r ? xcd * (q + 1) : r * (q + 1) + (xcd - r) * q) + off; }
        const int nig = WGM * nN, gid = wgid / nig, fm = gid * WGM, gsz = (nM - fm) < WGM ? (nM - fm) : WGM;
        u.pm = fm + ((wgid % nig) % gsz); u.pn = (wgid % nig) / gsz; return true;
    }
    __device__ __forceinline__ void a_ready(const Unit&) const {}
    __device__ __forceinline__ void done(const Unit&) const {}
};

__device__ __forceinline__ unsigned cvt_pk_bf16(float lo, float hi) { unsigned r; asm volatile("v_cvt_pk_bf16_f32 %0, %1, %2" : "=v"(r) : "v"(lo), "v"(hi)); return r; }
typedef float f32x2 __attribute__((ext_vector_type(2)));
__device__ __forceinline__ f32x2 gelu_pk(f32x2 v) {
    const f32x2 av = __builtin_elementwise_abs(v), d = av * 0.2316418882f + 1.0f;
    f32x2 t; t.x = __builtin_amdgcn_rcpf(d.x); t.y = __builtin_amdgcn_rcpf(d.y);
    f32x2 q = t * 0.5307027145f + (-0.7265760135f); q = q * t + 0.7107068705f; q = q * t + (-0.142248368f); q = q * t + 0.127414796f; q = q * t;
    const f32x2 s = (v * v) * (-0.72134752044f);
    f32x2 e; e.x = __builtin_amdgcn_exp2f(s.x); e.y = __builtin_amdgcn_exp2f(s.y);
    const f32x2 m = v * (q * e), r = v - m;
    f32x2 o; o.x = v.x < 0.f ? m.x : r.x; o.y = v.y < 0.f ? m.y : r.y; return o;
}

template <int ACT  > struct EpiBf16 {
    static constexpr bool PERM = true, AFTER_DRAIN = false; static_assert(ACT == 0 || ACT == 1, "EpiBf16: ACT is 0 (none) or 1 (gelu_pk)");
    bf16_t* O; int ldc; const float* bias; int split_cols; size_t split_stride; float scale0;
    __device__ __forceinline__ void operator()(const f32x4 (&acc)[2][2][4][2], const Unit& u, int wr, int wc, int fr, int fq) const {
        const int row0 = u.pm * BM + wr * 64 + fr; int colt = u.pn * BM; bf16_t* base = O;
        float sc = 1.f; if (split_cols) { const int t = colt / split_cols; base += (size_t)t * split_stride; colt -= t * split_cols; if (t == 0) sc = scale0; }
        const int col0 = colt + wc * 32 + 8 * fq, bcol0 = u.pn * BM + wc * 32 + 8 * fq;
        f32x4 bv[2][2];
#pragma unroll
        for (int bj = 0; bj < 2; ++bj)
#pragma unroll
            for (int n = 0; n < 2; ++n) bv[bj][n] = bias ? *(const f32x4*)(bias + bcol0 + bj * HALF + 4 * n) : (f32x4){0.f, 0.f, 0.f, 0.f};
#pragma unroll
        for (int ai = 0; ai < 2; ++ai)
#pragma unroll
            for (int m = 0; m < 4; ++m) { bf16_t* rowp = base + (size_t)(row0 + ai * HALF + m * 16) * ldc + col0;
#pragma unroll
                for (int bj = 0; bj < 2; ++bj) { f32x4 v0 = acc[ai][bj][m][0] + bv[bj][0], v1 = acc[ai][bj][m][1] + bv[bj][1];
                    if (ACT == 1) { f32x2 a = gelu_pk((f32x2){v0[0], v0[1]}), b = gelu_pk((f32x2){v0[2], v0[3]}), c = gelu_pk((f32x2){v1[0], v1[1]}), d = gelu_pk((f32x2){v1[2], v1[3]});
                        v0 = (f32x4){a.x, a.y, b.x, b.y}; v1 = (f32x4){c.x, c.y, d.x, d.y}; }
                    v0 = v0 * sc; v1 = v1 * sc; u32x4 w; w.x = cvt_pk_bf16(v0[0], v0[1]); w.y = cvt_pk_bf16(v0[2], v0[3]); w.z = cvt_pk_bf16(v1[0], v1[1]); w.w = cvt_pk_bf16(v1[2], v1[3]);
                    *(u32x4*)(rowp + bj * HALF) = w; } }
    }
};

template <class Epi, class Sched, bool ALIGN_EPI = false, bool SP2 = false>
__device__ __forceinline__ void gemm_phase(PG8_LAS unsigned char* lds, const Gemm g, const Sched& S, const Epi& E) {
    int tid = threadIdx.x; asm volatile("" : "+v"(tid)); const int wid = __builtin_amdgcn_readfirstlane(tid >> 6), lane = tid & 63, wr = wid >> 2, wc = wid & 3, fr = lane & 15, fq = lane >> 4;
    const int K = g.K, nt = K / BK;
    unsigned voffA[2], voffB[2];
#pragma unroll
    for (int i = 0; i < 2; ++i) { int R, C; stage_rc(tid * 16 + i * 8192, R, C); const int Rb = Epi::PERM ? ((R & ~31) + perm32(R & 31)) : R;
        voffA[i] = (unsigned)(R * K + C) * 2u; voffB[i] = (unsigned)(Rb * K + C) * 2u; }
    const size_t kstep = (size_t)(BK * 2);
    const size_t hstep = (size_t)HALF * K * 2;
    const size_t tstep = 2 * hstep;
    const unsigned ldsw = (unsigned)wid * 1024u;
    const int aoff = lds_byte(wr * 64 + fr, fq * 8), boff = lds_byte(wc * 32 + fr, fq * 8);
#define PG8_SA(b, h) (((b) * 2 + (h)) * HTB)
#define PG8_SB(b, h) ((4 + (b) * 2 + (h)) * HTB)
#define PG8_STAGE(bufoff, gbase, voff) do { _Pragma("unroll") for (int _i = 0; _i < 2; ++_i) \
        __builtin_amdgcn_global_load_lds((const unsigned*)((const char*)(gbase) + (voff)[_i]), (PG8_LAS unsigned*)(lds + (bufoff) + ldsw + _i * 8192), 16, 0, 0); } while (0)
#define PG8_LDA(dst, b, h) do { _Pragma("unroll") for (int m = 0; m < 4; ++m) _Pragma("unroll") for (int k = 0; k < 2; ++k) dst[m][k] = *(const PG8_LAS bf16x8*)(lds + PG8_SA(b, h) + aoff + m * 2048 + k * 1024); } while (0)
#define PG8_LDB(dst, b, h) do { _Pragma("unroll") for (int n = 0; n < 2; ++n) _Pragma("unroll") for (int k = 0; k < 2; ++k) dst[n][k] = *(const PG8_LAS bf16x8*)(lds + PG8_SB(b, h) + boff + n * 2048 + k * 1024); } while (0)
#define PG8_MMA(ai, bj, At, Bt) do { __builtin_amdgcn_s_setprio(1); _Pragma("unroll") for (int m = 0; m < 4; ++m) _Pragma("unroll") for (int n = 0; n < 2; ++n) _Pragma("unroll") for (int k = 0; k < 2; ++k) \
        acc[ai][bj][m][n] = __builtin_amdgcn_mfma_f32_16x16x32_bf16(Bt[n][k], At[m][k], acc[ai][bj][m][n], 0, 0, 0); __builtin_amdgcn_s_setprio(0); } while (0)
#define PG8_WAIT_V(n) asm volatile("s_waitcnt vmcnt(" #n ")" ::: "memory")
#define PG8_WAIT_L(n) asm volatile("s_waitcnt lgkmcnt(" #n ")" ::: "memory")
#define PG8_BAR __builtin_amdgcn_s_barrier()
#define PG8_SCHED __builtin_amdgcn_sched_barrier(0)
    Unit cur, nxt; int ui = 0;
    if (!S.next(0, cur)) return;
    f32x4 acc[2][2][4][2];
#pragma unroll
    for (int a = 0; a < 2; ++a)
#pragma unroll
        for (int b = 0; b < 2; ++b)
#pragma unroll
            for (int m = 0; m < 4; ++m)
#pragma unroll
                for (int n = 0; n < 2; ++n) acc[a][b][m][n] = (f32x4){0.f, 0.f, 0.f, 0.f};
    bf16x8 At[4][2], B0[2][2], B1[2][2];
    const char* cA = (const char*)g.A + (size_t)cur.pm * tstep; const char* cB = (const char*)g.Bt + (size_t)cur.pn * tstep;
    S.a_ready(cur);
    if constexpr (SP2) {
        PG8_STAGE(PG8_SB(0, 0), cB, voffB); PG8_STAGE(PG8_SB(0, 1), cB + hstep, voffB); PG8_STAGE(PG8_SA(0, 0), cA, voffA); PG8_STAGE(PG8_SA(0, 1), cA + hstep, voffA);
        if (wr == 1) PG8_BAR;
        PG8_WAIT_V(2); PG8_BAR;
        PG8_STAGE(PG8_SB(1, 0), cB + kstep, voffB); PG8_STAGE(PG8_SA(1, 0), cA + kstep, voffA); PG8_STAGE(PG8_SB(1, 1), cB + hstep + kstep, voffB);
        PG8_WAIT_V(6); PG8_BAR;
    } else {
        PG8_STAGE(PG8_SB(0, 0), cB, voffB); PG8_STAGE(PG8_SA(0, 0), cA, voffA); PG8_STAGE(PG8_SB(0, 1), cB + hstep, voffB); PG8_STAGE(PG8_SA(0, 1), cA + hstep, voffA);
        if (wr == 1) PG8_BAR;
        PG8_WAIT_V(4); PG8_BAR;
        PG8_STAGE(PG8_SB(1, 0), cB + kstep, voffB); PG8_STAGE(PG8_SA(1, 0), cA + kstep, voffA); PG8_STAGE(PG8_SB(1, 1), cB + hstep + kstep, voffB);
        PG8_WAIT_V(6); PG8_BAR;
    }
    for (;;) {
        const bool has_next = S.next(ui + 1, nxt);
        const char* nA = has_next ? (const char*)g.A + (size_t)nxt.pm * tstep : cA; const char* nB = has_next ? (const char*)g.Bt + (size_t)nxt.pn * tstep : cB;
        for (int t = 0; t < nt; t += 2) {
            const bool last = (t == nt - 2);
            const char* a1 = cA + (size_t)(t + 1) * kstep;
            const char* a2 = last ? nA : cA + (size_t)(t + 2) * kstep; const char* b2 = last ? nB : cB + (size_t)(t + 2) * kstep;
            const char* a3 = a2 + kstep; const char* b3 = b2 + kstep;
            if (last && has_next) S.a_ready(nxt);
            if constexpr (SP2) {
            PG8_LDB(B0, 0, 0); PG8_LDB(B1, 0, 1); PG8_SCHED; PG8_LDA(At, 0, 0); PG8_STAGE(PG8_SA(1, 1), a1 + hstep, voffA);
            PG8_WAIT_V(8); PG8_WAIT_L(0); PG8_BAR; PG8_MMA(0, 0, At, B0); PG8_MMA(0, 1, At, B1); PG8_BAR; PG8_SCHED;
            PG8_LDA(At, 0, 1); PG8_STAGE(PG8_SB(0, 0), b2, voffB); PG8_STAGE(PG8_SB(0, 1), b2 + hstep, voffB); PG8_STAGE(PG8_SA(0, 0), a2, voffA);
            PG8_WAIT_V(8); PG8_WAIT_L(0); PG8_BAR; PG8_MMA(1, 0, At, B0); PG8_MMA(1, 1, At, B1); PG8_BAR; PG8_SCHED;
            PG8_LDB(B0, 1, 0); PG8_LDB(B1, 1, 1); PG8_SCHED; PG8_LDA(At, 1, 0); PG8_STAGE(PG8_SA(0, 1), a2 + hstep, voffA);
            PG8_WAIT_V(8); PG8_WAIT_L(0); PG8_BAR; PG8_MMA(0, 0, At, B0); PG8_MMA(0, 1, At, B1); PG8_BAR; PG8_SCHED;
            PG8_LDA(At, 1, 1); PG8_STAGE(PG8_SB(1, 0), b3, voffB); PG8_STAGE(PG8_SB(1, 1), b3 + hstep, voffB); PG8_STAGE(PG8_SA(1, 0), a3, voffA);
            PG8_WAIT_V(8); PG8_WAIT_L(0); PG8_BAR; PG8_MMA(1, 0, At, B0); PG8_MMA(1, 1, At, B1); PG8_BAR; PG8_SCHED;
            } else {
            PG8_LDB(B0, 0, 0); PG8_SCHED; PG8_LDA(At, 0, 0); PG8_STAGE(PG8_SA(1, 1), a1 + hstep, voffA);
            PG8_WAIT_L(8); PG8_BAR; PG8_WAIT_L(0); PG8_MMA(0, 0, At, B0); PG8_BAR; PG8_SCHED;
            PG8_LDB(B1, 0, 1); PG8_STAGE(PG8_SB(0, 0), b2, voffB);
            PG8_BAR; PG8_WAIT_L(0); PG8_MMA(0, 1, At, B1); PG8_BAR;
            PG8_LDA(At, 0, 1); PG8_STAGE(PG8_SA(0, 0), a2, voffA);
            PG8_BAR; PG8_WAIT_L(0); PG8_MMA(1, 0, At, B0); PG8_BAR; PG8_SCHED;
            PG8_STAGE(PG8_SB(0, 1), b2 + hstep, voffB);
            PG8_WAIT_V(6); PG8_BAR; PG8_MMA(1, 1, At, B1); PG8_BAR;
            PG8_LDB(B0, 1, 0); PG8_SCHED; PG8_LDA(At, 1, 0); PG8_STAGE(PG8_SA(0, 1), a2 + hstep, voffA);
            PG8_WAIT_L(8); PG8_BAR; PG8_WAIT_L(0); PG8_MMA(0, 0, At, B0); PG8_BAR; PG8_SCHED;
            PG8_LDB(B1, 1, 1); PG8_STAGE(PG8_SB(1, 0), b3, voffB);
            PG8_BAR; PG8_WAIT_L(0); PG8_MMA(0, 1, At, B1); PG8_BAR;
            PG8_LDA(At, 1, 1); PG8_STAGE(PG8_SA(1, 0), a3, voffA);
            PG8_BAR; PG8_WAIT_L(0); PG8_MMA(1, 0, At, B0); PG8_BAR; PG8_SCHED;
            PG8_STAGE(PG8_SB(1, 1), b3 + hstep, voffB);
            PG8_WAIT_V(6); PG8_BAR; PG8_MMA(1, 1, At, B1); PG8_BAR;
            }
        }
        if constexpr (ALIGN_EPI) { if (wr == 0) PG8_BAR; }
        if constexpr (!Epi::AFTER_DRAIN) { E(acc, cur, wr, wc, fr, fq); S.done(cur); }
        if (!has_next) break;
#pragma unroll
        for (int a = 0; a < 2; ++a)
#pragma unroll
            for (int b = 0; b < 2; ++b)
#pragma unroll
                for (int m = 0; m < 4; ++m)
#pragma unroll
                    for (int n = 0; n < 2; ++n) acc[a][b][m][n] = (f32x4){0.f, 0.f, 0.f, 0.f};
        cur = nxt; cA = nA; cB = nB; ++ui;
        if constexpr (ALIGN_EPI) { if (wr == 1) PG8_BAR; }
    }
    PG8_WAIT_V(0);
    if constexpr (!ALIGN_EPI) { if (wr == 0) PG8_BAR; }
    PG8_BAR;
    if constexpr (Epi::AFTER_DRAIN) { E.fused(acc, cur, wr, wc, fr, fq, lds, wid, lane); S.done(cur); }
#undef PG8_SA
#undef PG8_SB
#undef PG8_STAGE
#undef PG8_LDA
#undef PG8_LDB
#undef PG8_MMA
#undef PG8_WAIT_V
#undef PG8_WAIT_L
#undef PG8_BAR
#undef PG8_SCHED
}
}
namespace cg = cooperative_groups;
#define LAS __attribute__((address_space(3)))
typedef unsigned short bf16;
typedef float f32x4 __attribute__((ext_vector_type(4)));
typedef float f32x8 __attribute__((ext_vector_type(8)));
typedef float f32x16 __attribute__((ext_vector_type(16)));
typedef unsigned u32x4 __attribute__((ext_vector_type(4)));
typedef unsigned u32x2 __attribute__((ext_vector_type(2)));
typedef short bf16x8 __attribute__((ext_vector_type(8)));
typedef short s16x4 __attribute__((ext_vector_type(4)));

constexpr int BATCH = 16, SEQ = 2048, DM = 1024, T = BATCH * SEQ;
constexpr int NP = 3072;
constexpr int IN_COLS = 3012;
constexpr int C_QA = 0, C_KA = 512, C_VA = 1024, C_QB = 1536, C_KV = 2560, C_QI = 2688, C_KI = 2944, C_WI = 3008;
constexpr int MIXW = 1536;
constexpr int NEXP = 16384;
constexpr float EPS = 1e-6f;
constexpr int NT = 512;
constexpr int NWV = 8;

constexpr size_t MiB = 1u << 20;
constexpr size_t WS_CTL = 0;
constexpr size_t CTL_BYTES = 64 * 1024;
constexpr size_t WS_MOD = 1 * MiB;
constexpr size_t WS_SCAL = WS_MOD + 512 * 1024;
constexpr size_t WS_WIN = 2 * MiB;
constexpr size_t WS_WO2 = 8 * MiB;
constexpr size_t WS_WQ = 11 * MiB;
constexpr size_t WS_SUBK = 13 * MiB;
constexpr size_t WS_U16 = 14 * MiB;
constexpr size_t WS_V16 = 46 * MiB;
constexpr size_t WS_H = 78 * MiB;
constexpr size_t WS_PROJ = 142 * MiB;
constexpr size_t WS_Q3 = WS_PROJ;
constexpr size_t WS_MIX = 334 * MiB;
constexpr size_t WS_EXP = 430 * MiB;
constexpr size_t WS_GATE = 446 * MiB;
constexpr size_t WS_ATMP = 462 * MiB;
constexpr size_t WS_CBUF = 494 * MiB;
constexpr size_t WS_END = 510 * MiB;

struct Params {
    const float *x, *c, *ada_w, *ada_b, *norm1_g, *norm2_g, *w_in, *a_qk_gain, *a_lambda, *a_sub_gain, *b_q_gain, *b_kv_gain, *b_w_uv, *w_out, *peer_wq, *peer_subkeys, *peer_u, *peer_v;
    float* out; unsigned char* ws;
};

enum { SC_LAM = 0, SC_MA = 1, SC_MB = 2 };

__device__ __forceinline__ unsigned f2bf(float f) { unsigned u = __float_as_uint(f); return (u + 0x7fffu + ((u >> 16) & 1u)) >> 16; }
__device__ __forceinline__ float bf2f(unsigned h) { return __uint_as_float(h << 16); }
__device__ __forceinline__ unsigned pk2(float lo, float hi) { return f2bf(lo) | (f2bf(hi) << 16); }
__device__ __forceinline__ float bflo(unsigned w) { return __uint_as_float(w << 16); }
__device__ __forceinline__ float bfhi(unsigned w) { return __uint_as_float(w & 0xffff0000u); }
__device__ __forceinline__ float wave_sum(float v) {
#pragma unroll
    for (int o = 1; o < 64; o <<= 1) v += __shfl_xor(v, o);
    return v;
}
__device__ __forceinline__ float wave_max(float v) {
#pragma unroll
    for (int o = 1; o < 64; o <<= 1) v = fmaxf(v, __shfl_xor(v, o));
    return v;
}
#define LDS_WAIT() asm volatile("s_waitcnt lgkmcnt(0)" ::: "memory")
__device__ __forceinline__ void ph_mod(const Params& p, float* ldsf, int vb, int nvb) {
    if (vb >= 96) return;
    int tid = threadIdx.x; asm volatile("" : "+v"(tid));
    const int lane = tid & 63, wv = tid >> 6;
    for (int i = tid; i < 16 * 1024; i += NT) { const float v = p.c[i]; ldsf[i] = v / (1.f + __expf(-v)); }
    __syncthreads();
    float* MOD = (float*)(p.ws + WS_MOD); float* part = ldsf + 16 * 1024;
    for (int it = vb; it < 96; it += nvb) {
        const int j = it * 64 + lane;
        float acc[16];
#pragma unroll
        for (int b = 0; b < 16; ++b) acc[b] = 0.f;
        const float* wp = p.ada_w + (size_t)(128 * wv) * 6144 + j;
#pragma unroll 1
        for (int k0 = 0; k0 < 128; k0 += 8) {
            float w[8];
#pragma unroll
            for (int u = 0; u < 8; ++u) w[u] = wp[(size_t)(k0 + u) * 6144];
#pragma unroll
            for (int u = 0; u < 8; ++u)
#pragma unroll
                for (int b = 0; b < 16; ++b) acc[b] = fmaf(ldsf[b * 1024 + 128 * wv + k0 + u], w[u], acc[b]);
        }
#pragma unroll
        for (int b = 0; b < 16; ++b) part[(wv * 16 + b) * 64 + lane] = acc[b];
        __syncthreads();
        for (int o = tid; o < 16 * 64; o += NT) { const int b = o >> 6, c = o & 63; float s = 0.f;
#pragma unroll
            for (int w = 0; w < 8; ++w) s += part[(w * 16 + b) * 64 + c];
            MOD[b * 6144 + it * 64 + c] = s + p.ada_b[it * 64 + c]; }
        __syncthreads();
    }
}

__device__ __forceinline__ void transpose_item(const float* W, int N, bf16* WT, int ldt, LAS float* scr, int kb, int nb, int lane) {
    const int k0 = 64 * kb, n0 = 32 * nb;
#pragma unroll 8
    for (int i = 0; i < 32; ++i) { const int kk = 2 * i + (lane >> 5); const int n = n0 + (lane & 31); scr[kk * 33 + (lane & 31)] = (n < N) ? W[(size_t)(k0 + kk) * N + n] : 0.f; }
    LDS_WAIT(); asm volatile("" ::: "memory");
    const int c = lane & 7;
#pragma unroll
    for (int j = 0; j < 4; ++j) { const int n = (lane >> 3) + 8 * j; const LAS float* s = scr + (8 * c) * 33 + n;
        u32x4 o; o.x = pk2(s[0 * 33], s[1 * 33]); o.y = pk2(s[2 * 33], s[3 * 33]); o.z = pk2(s[4 * 33], s[5 * 33]); o.w = pk2(s[6 * 33], s[7 * 33]);
        *(u32x4*)(WT + (size_t)(n0 + n) * ldt + k0 + 8 * c) = o; }
    LDS_WAIT(); asm volatile("" ::: "memory");
}

__device__ __forceinline__ void ph_prep_weights(const Params& p, LAS float* scr, int gw, int ngw, int lane) {
    bf16* WIN = (bf16*)(p.ws + WS_WIN); bf16* WO2 = (bf16*)(p.ws + WS_WO2); bf16* WQ = (bf16*)(p.ws + WS_WQ);
    constexpr int I_IN = 16 * 96, I_O = 8 * 32, I_Q = 16 * 32;
    for (int it = gw; it < I_IN + I_O + I_Q; it += ngw) {
        int r = it;
        if (r < I_IN) { transpose_item(p.w_in, IN_COLS, WIN, 1024, scr, r / 96, r % 96, lane); continue; } r -= I_IN;
        if (r < I_O) { transpose_item(p.w_out, 1024, WO2, MIXW, scr, r / 32, r % 32, lane); continue; } r -= I_O;
        transpose_item(p.peer_wq, 1024, WQ, 1024, scr, r / 32, r % 32, lane);
    }
    const size_t gt = (size_t)gw * 64 + lane, ngt = (size_t)ngw * 64;
    for (size_t i = gt; i < (size_t)1024 * 1024; i += ngt) {
        const int n = (int)(i & 1023), kk = (int)(i >> 10), h = kk >> 7;
        const float* wu = p.b_w_uv + (size_t)kk * 64; const float* wo = p.w_out + (size_t)(512 + 64 * h) * 1024 + n;
        float a = 0.f;
#pragma unroll 8
        for (int e = 0; e < 64; ++e) a = fmaf(wu[e], wo[(size_t)e * 1024], a);
        WO2[(size_t)n * MIXW + 512 + kk] = (bf16)f2bf(a);
    }
    unsigned char* U8 = (unsigned char*)(p.ws + WS_U16); unsigned char* V8 = (unsigned char*)(p.ws + WS_V16); bf16* SUBK = (bf16*)(p.ws + WS_SUBK);
    constexpr size_t NTAB8 = (size_t)NEXP * 1024 / 8, NSUB8 = 2 * 128 * 64 / 8;
    for (size_t i = gt; i < 2 * NTAB8 + NSUB8; i += ngt) {
        if (i < 2 * NTAB8) {
            const bool isu = i < NTAB8; const size_t j = isu ? i : i - NTAB8; const float sc = isu ? 32.0f : 1.0f;
            const f32x8 v = *(const f32x8*)((isu ? p.peer_u : p.peer_v) + j * 8);
            int w0 = 0, w1 = 0;
            w0 = __builtin_amdgcn_cvt_pk_fp8_f32(v[0] * sc, v[1] * sc, w0, false); w0 = __builtin_amdgcn_cvt_pk_fp8_f32(v[2] * sc, v[3] * sc, w0, true);
            w1 = __builtin_amdgcn_cvt_pk_fp8_f32(v[4] * sc, v[5] * sc, w1, false); w1 = __builtin_amdgcn_cvt_pk_fp8_f32(v[6] * sc, v[7] * sc, w1, true);
            u32x2 o; o.x = (unsigned)w0; o.y = (unsigned)w1;
            *(u32x2*)((isu ? U8 : V8) + j * 8) = o;
        } else {
            const size_t j = i - 2 * NTAB8;
            const f32x8 v = *(const f32x8*)(p.peer_subkeys + j * 8);
            u32x4 o; o.x = pk2(v[0], v[1]); o.y = pk2(v[2], v[3]); o.z = pk2(v[4], v[5]); o.w = pk2(v[6], v[7]);
            *(u32x4*)(SUBK + j * 8) = o;
        }
    }
    if (gt == 0) {
        float* SC = (float*)(p.ws + WS_SCAL);
        float s01 = 0.f, s23 = 0.f;
        for (int i = 0; i < 64; ++i) { s01 += p.a_lambda[i] * p.a_lambda[64 + i]; s23 += p.a_lambda[128 + i] * p.a_lambda[192 + i]; }
        SC[SC_LAM] = __expf(s01) - __expf(s23) + 0.2f;
        float g0 = 0.f, g1 = 0.f, gq = 0.f, gk = 0.f;
        for (int i = 0; i < 64; ++i) { g0 = fmaxf(g0, fabsf(p.a_qk_gain[i])); g1 = fmaxf(g1, fabsf(p.a_qk_gain[64 + i])); }
        for (int i = 0; i < 128; ++i) { gq = fmaxf(gq, fabsf(p.b_q_gain[i])); gk = fmaxf(gk, fabsf(p.b_kv_gain[i])); }
        SC[SC_MA] = 8.0f * g0 * g1 * 1.02f;
        SC[SC_MB] = 11.3137085f * gq * gk * 1.02f;
    }
}

__device__ __forceinline__ void ph_hrows(const Params& p, const float* X, const float* g, int shOff, int scOff, int gw, int ngw, int lane) {
    const float* MOD = (const float*)(p.ws + WS_MOD); bf16* H = (bf16*)(p.ws + WS_H);
    for (int m = gw; m < T; m += ngw) {
        const f32x4* xr = (const f32x4*)(X + (size_t)m * 1024) + lane;
        f32x4 v[4]; float s = 0.f;
#pragma unroll
        for (int j = 0; j < 4; ++j) { v[j] = xr[64 * j]; s += (v[j].x * v[j].x + v[j].y * v[j].y) + (v[j].z * v[j].z + v[j].w * v[j].w); }
        const float rstd = rsqrtf(wave_sum(s) * (1.f / 1024.f) + EPS);
        const float* mb = MOD + (size_t)(m >> 11) * 6144;
#pragma unroll
        for (int j = 0; j < 4; ++j) {
            const int col = 4 * (lane + 64 * j);
            const f32x4 gg = *(const f32x4*)(g + col), sc = *(const f32x4*)(mb + scOff + col), sh = *(const f32x4*)(mb + shOff + col);
            const f32x4 y = v[j] * rstd * gg * (sc + 1.0f) + sh;
            u32x2 o; o.x = pk2(y.x, y.y); o.y = pk2(y.z, y.w);
            *(u32x2*)(H + (size_t)m * 1024 + col) = o;
        }
    }
}

__device__ __forceinline__ void ph_norm_proj(const Params& p, int gw, int ngw, int lane) {
    bf16* PROJ = (bf16*)(p.ws + WS_PROJ);
    for (int m = gw; m < T; m += ngw) {
        bf16* row = PROJ + (size_t)m * NP;
#pragma unroll
        for (int j = 0; j < 6; ++j) {
            if (j == 2) continue;
            const int col = 8 * lane + 512 * j;
            const u32x4 raw = *(const u32x4*)(row + col);
            float v[8] = {bflo(raw.x), bfhi(raw.x), bflo(raw.y), bfhi(raw.y), bflo(raw.z), bfhi(raw.z), bflo(raw.w), bfhi(raw.w)};
            float ss = 0.f;
#pragma unroll
            for (int i = 0; i < 8; ++i) ss += v[i] * v[i];
            ss += __shfl_xor(ss, 1); ss += __shfl_xor(ss, 2); ss += __shfl_xor(ss, 4);
            float rstd; const float* gp;
            if (j < 2) { rstd = rsqrtf(ss * (1.f / 64.f) + EPS); gp = p.a_qk_gain + 64 * j + (col & 63); }
            else { ss += __shfl_xor(ss, 8); rstd = rsqrtf(ss * (1.f / 128.f) + EPS); gp = (j == 5 ? p.b_kv_gain : p.b_q_gain) + (col & 127); }
            if (j == 5 && lane >= 16) continue;
            const f32x4 g0 = *(const f32x4*)gp, g1 = *(const f32x4*)(gp + 4);
            u32x4 o; o.x = pk2(v[0] * rstd * g0.x, v[1] * rstd * g0.y); o.y = pk2(v[2] * rstd * g0.z, v[3] * rstd * g0.w);
            o.z = pk2(v[4] * rstd * g1.x, v[5] * rstd * g1.y); o.w = pk2(v[6] * rstd * g1.z, v[7] * rstd * g1.w);
            *(u32x4*)(row + col) = o;
        }
    }
}
__device__ void ph_attnA_naive(const Params& p, float* lds_w, int gw, int ngw, int lane) {
    const bf16* PROJ = (const bf16*)(p.ws + WS_PROJ); bf16* MIX = (bf16*)(p.ws + WS_MIX);
    const float lam = ((const float*)(p.ws + WS_SCAL))[SC_LAM];
    float* qs = lds_w; float* sc0 = lds_w + 128; float* sc1 = sc0 + 2048;
    for (int it = gw; it < BATCH * 4 * SEQ; it += ngw) {
        const int t = it & 2047, h = (it >> 11) & 3, b = it >> 13;
        const int cend = ((t >> 6) + 1) << 6;
        const float slope = exp2f(-2.0f * (h + 1));
        const bf16* qrow = PROJ + (size_t)(b * SEQ + t) * NP + C_QA + h * 128;
        qs[lane] = bf2f(qrow[lane]); qs[64 + lane] = bf2f(qrow[64 + lane]);
        LDS_WAIT(); asm volatile("" ::: "memory");
        float m0 = -3e38f, m1 = -3e38f;
        for (int kk = lane; kk < cend; kk += 64) {
            const bf16* krow = PROJ + (size_t)(b * SEQ + kk) * NP + C_KA + h * 128;
            float d0 = 0.f, d1 = 0.f;
            for (int d = 0; d < 64; ++d) { d0 = fmaf(qs[d], bf2f(krow[d]), d0); d1 = fmaf(qs[64 + d], bf2f(krow[64 + d]), d1); }
            const float bias = slope * fabsf((float)(t - kk));
            d0 = d0 * 0.125f - bias; d1 = d1 * 0.125f - bias;
            sc0[kk] = d0; sc1[kk] = d1; m0 = fmaxf(m0, d0); m1 = fmaxf(m1, d1);
        }
        m0 = wave_max(m0); m1 = wave_max(m1);
        float l0 = 0.f, l1 = 0.f;
        for (int kk = lane; kk < cend; kk += 64) { const float e0 = __expf(sc0[kk] - m0), e1 = __expf(sc1[kk] - m1); sc0[kk] = e0; sc1[kk] = e1; l0 += e0; l1 += e1; }
        l0 = wave_sum(l0); l1 = wave_sum(l1);
        const float i0 = 1.f / l0, i1 = lam / l1;
        for (int kk = lane; kk < cend; kk += 64) sc0[kk] = sc0[kk] * i0 - sc1[kk] * i1;
        LDS_WAIT(); asm volatile("" ::: "memory");
        float a0 = 0.f, a1 = 0.f;
        const bf16* vb = PROJ + (size_t)(b * SEQ) * NP + C_VA + h * 128;
        for (int kk = 0; kk < cend; ++kk) { const float a = sc0[kk]; const bf16* vr = vb + (size_t)kk * NP; a0 = fmaf(a, bf2f(vr[lane]), a0); a1 = fmaf(a, bf2f(vr[64 + lane]), a1); }
        const float ss = wave_sum(a0 * a0 + a1 * a1);
        const float rstd = rsqrtf(ss * (1.f / 128.f) + EPS) * 0.8f;
        bf16* orow = MIX + (size_t)(b * SEQ + t) * MIXW + h * 128;
        orow[lane] = (bf16)f2bf(a0 * rstd * p.a_sub_gain[lane]); orow[64 + lane] = (bf16)f2bf(a1 * rstd * p.a_sub_gain[64 + lane]);
        LDS_WAIT(); asm volatile("" ::: "memory");
    }
}

__device__ void ph_dsa_naive(const Params& p, float* lds, int vb, int nvb) {
    const bf16* PROJ = (const bf16*)(p.ws + WS_PROJ); bf16* MIX = (bf16*)(p.ws + WS_MIX);
    const int tid = threadIdx.x, lane = tid & 63, wv = tid >> 6;
    float* scores = lds; int* sel = (int*)(lds + 2048); float* qi = lds + 2048 + 256; float* wi = qi + 256;
    float* qh = wi + 64 + wv * 384; float* pw = qh + 128;
    for (int it = vb; it < T; it += nvb) {
        const int b = it >> 11, t = it & 2047; const int cend = ((t >> 6) + 1) << 6;
        const bf16* row = PROJ + (size_t)it * NP;
        if (tid < 256) qi[tid] = bf2f(row[C_QI + tid]);
        if (tid < 4) wi[tid] = bf2f(row[C_WI + tid]);
        __syncthreads();
        for (int kk = tid; kk < cend; kk += NT) {
            const bf16* kr = PROJ + (size_t)(b * SEQ + kk) * NP + C_KI;
            float s = 0.f;
            for (int h = 0; h < 4; ++h) { float d = 0.f; for (int e = 0; e < 64; ++e) d = fmaf(qi[h * 64 + e], bf2f(kr[e]), d); s += fmaxf(d, 0.f) * wi[h]; }
            scores[kk] = s * 0.0625f;
        }
        __syncthreads();
        int nvalid;
        if (cend <= 256) { if (tid < 256) sel[tid] = tid; nvalid = cend; }
        else {
            for (int i = tid; i < cend; i += NT) { const float si = scores[i]; int rank = 0;
                for (int j = 0; j < cend; ++j) { const float sj = scores[j]; rank += (sj > si || (sj == si && j < i)) ? 1 : 0; }
                if (rank < 256) sel[rank] = i; }
            nvalid = 256;
        }
        __syncthreads();
        {
            const int h = wv; const float slope = exp2f(-(float)(h + 1));
            qh[lane] = bf2f(row[C_QB + h * 128 + lane]); qh[64 + lane] = bf2f(row[C_QB + h * 128 + 64 + lane]);
            LDS_WAIT(); asm volatile("" ::: "memory");
            float sv[4]; float mx = -3e38f;
#pragma unroll
            for (int jj = 0; jj < 4; ++jj) { const int j = lane + 64 * jj; const int key = sel[j < nvalid ? j : 0];
                const bf16* kv = PROJ + (size_t)(b * SEQ + key) * NP + C_KV; float d = 0.f;
                for (int e = 0; e < 128; ++e) d = fmaf(qh[e], bf2f(kv[e]), d);
                d = d * 0.0883883476f - slope * fabsf((float)(t - key));
                sv[jj] = (j < nvalid) ? d : -3e38f; mx = fmaxf(mx, sv[jj]); }
            mx = wave_max(mx); float l = 0.f;
#pragma unroll
            for (int jj = 0; jj < 4; ++jj) { const int j = lane + 64 * jj; const float e = (j < nvalid) ? __expf(sv[jj] - mx) : 0.f; pw[j] = e; l += e; }
            l = wave_sum(l);
            LDS_WAIT(); asm volatile("" ::: "memory");
            float a0 = 0.f, a1 = 0.f;
            for (int j = 0; j < nvalid; ++j) { const float pj = pw[j]; const bf16* kv = PROJ + (size_t)(b * SEQ + sel[j]) * NP + C_KV; a0 = fmaf(pj, bf2f(kv[lane]), a0); a1 = fmaf(pj, bf2f(kv[64 + lane]), a1); }
            const float il = 1.f / l;
            bf16* orow = MIX + (size_t)it * MIXW + 512 + h * 128;
            orow[lane] = (bf16)f2bf(a0 * il); orow[64 + lane] = (bf16)f2bf(a1 * il);
        }
        __syncthreads();
    }
}

__device__ void ph_route_naive(const Params& p, float* lds, int vb, int nvb) {
    const bf16* Q3 = (const bf16*)(p.ws + WS_Q3); const bf16* SUBK = (const bf16*)(p.ws + WS_SUBK);
    int* EXPI = (int*)(p.ws + WS_EXP); float* GATE = (float*)(p.ws + WS_GATE);
    const int tid = threadIdx.x;
    float* q = lds; float* sub = q + 1024; float* sv = sub + 2048; int* si = (int*)(sv + 256); float* cand = sv + 512; float* ts = cand + 2048; int* te = (int*)(ts + 128);
    for (int it = vb; it < T; it += nvb) {
        q[tid] = bf2f(Q3[(size_t)it * 1024 + tid]); q[tid + 512] = bf2f(Q3[(size_t)it * 1024 + tid + 512]);
        __syncthreads();
        for (int r = 0; r < 4; ++r) { const int idx = tid + 512 * r, h = idx >> 8, c = (idx >> 7) & 1, n = idx & 127;
            const float* qq = q + h * 128 + c * 64; const bf16* kk = SUBK + (size_t)(c * 128 + n) * 64; float d = 0.f;
            for (int e = 0; e < 64; ++e) d = fmaf(qq[e], bf2f(kk[e]), d);
            sub[idx] = d; }
        __syncthreads();
        for (int r = 0; r < 4; ++r) { const int idx = tid + 512 * r, g0 = idx & ~127, n = idx & 127; const float s = sub[idx]; int rank = 0;
            for (int j = 0; j < 128; ++j) { const float sj = sub[g0 + j]; rank += (sj > s || (sj == s && j < n)) ? 1 : 0; }
            if (rank < 16) { sv[(g0 >> 7) * 16 + rank] = s; si[(g0 >> 7) * 16 + rank] = n; } }
        __syncthreads();
        for (int r = 0; r < 4; ++r) { const int idx = tid + 512 * r, h = idx >> 8, i = (idx >> 4) & 15, j = idx & 15; cand[idx] = sv[(h * 2) * 16 + i] + sv[(h * 2 + 1) * 16 + j]; }
        __syncthreads();
        for (int r = 0; r < 4; ++r) { const int idx = tid + 512 * r, h = idx >> 8, ij = idx & 255; const float s = cand[idx]; int rank = 0;
            for (int j = 0; j < 256; ++j) { const float sj = cand[h * 256 + j]; rank += (sj > s || (sj == s && j < ij)) ? 1 : 0; }
            if (rank < 16) { ts[h * 16 + rank] = s; te[h * 16 + rank] = si[(h * 2) * 16 + (ij >> 4)] * 128 + si[(h * 2 + 1) * 16 + (ij & 15)]; } }
        __syncthreads();
        if (tid < 128) { const int h = tid >> 4; const float mx = ts[h * 16]; float l = 0.f;
            for (int k = 0; k < 16; ++k) l += __expf(ts[h * 16 + k] - mx);
            GATE[(size_t)it * 128 + tid] = __expf(ts[tid] - mx) / l; EXPI[(size_t)it * 128 + tid] = te[tid]; }
        __syncthreads();
    }
}

__device__ void ph_peer_naive(const Params& p, float* lds, int vb, int nvb) {
    const bf16* H = (const bf16*)(p.ws + WS_H); const bf16* U16 = (const bf16*)(p.ws + WS_U16); const bf16* V16 = (const bf16*)(p.ws + WS_V16);
    const int* EXPI = (const int*)(p.ws + WS_EXP); const float* GATE = (const float*)(p.ws + WS_GATE); const float* MOD = (const float*)(p.ws + WS_MOD);
    const int tid = threadIdx.x, lane = tid & 63, wv = tid >> 6;
    float* xs = lds; float* coef = lds + 1024; int* ex = (int*)(coef + 128);
    for (int it = vb; it < T; it += nvb) {
        xs[tid] = bf2f(H[(size_t)it * 1024 + tid]); xs[tid + 512] = bf2f(H[(size_t)it * 1024 + tid + 512]);
        if (tid < 128) ex[tid] = EXPI[(size_t)it * 128 + tid];
        __syncthreads();
        for (int jj = 0; jj < 16; ++jj) { const int j = wv * 16 + jj; const bf16* ur = U16 + (size_t)ex[j] * 1024; float d = 0.f;
            for (int i = 0; i < 16; ++i) d = fmaf(xs[lane + 64 * i], bf2f(ur[lane + 64 * i]), d);
            d = wave_sum(d);
            if (lane == 0) coef[j] = 0.5f * d * (1.f + erff(d * 0.70710678f)) * GATE[(size_t)it * 128 + j]; }
        __syncthreads();
        const float* g2 = MOD + (size_t)(it >> 11) * 6144 + 5120;
        for (int r = 0; r < 2; ++r) { const int d = tid + 512 * r; float a = 0.f;
            for (int j = 0; j < 128; ++j) a = fmaf(coef[j], bf2f(V16[(size_t)ex[j] * 1024 + d]), a);
            p.out[(size_t)it * 1024 + d] = p.out[(size_t)it * 1024 + d] + g2[d] * a; }
        __syncthreads();
    }
}
struct EpiResGate {
    static constexpr bool PERM = false, AFTER_DRAIN = false;
    const float* X; float* Out; const float* gate;
    __device__ __forceinline__ void operator()(const pg8::f32x4 (&acc)[2][2][4][2], const pg8::Unit& u, int wr, int wc, int fr, int fq) const {
        const int col0 = u.pn * 256 + wc * 32 + 4 * fq;
#pragma unroll
        for (int ai = 0; ai < 2; ++ai)
#pragma unroll
            for (int m = 0; m < 4; ++m) {
                const int r = u.pm * 256 + ai * 128 + wr * 64 + m * 16 + fr; const float* gb = gate + (size_t)(r >> 11) * 6144;
#pragma unroll
                for (int bj = 0; bj < 2; ++bj)
#pragma unroll
                    for (int n = 0; n < 2; ++n) { const int c = col0 + bj * 128 + n * 16; const size_t off = (size_t)r * 1024 + c;
                        const pg8::f32x4 xv = *(const pg8::f32x4*)(X + off), gv = *(const pg8::f32x4*)(gb + c);
                        *(pg8::f32x4*)(Out + off) = xv + gv * acc[ai][bj][m][n]; }
            }
    }
};


struct EpiNormBf16 {
    static constexpr bool PERM = true, AFTER_DRAIN = false;
    bf16* O; const float* gqk; const float* gbq; const float* gbkv; LAS float* P;
    __device__ __forceinline__ void operator()(const pg8::f32x4 (&acc)[2][2][4][2], const pg8::Unit& u, int wr, int wc, int fr, int fq) const {
        const int pn = u.pn;
        const int mode = pn < 4 ? 1 : ((pn == 4 || pn == 5 || pn == 11) ? 0 : (pn == 10 ? 3 : 2));
        if (mode != 0) {
#pragma unroll
            for (int ai = 0; ai < 2; ++ai)
#pragma unroll
                for (int m = 0; m < 4; ++m)
#pragma unroll
                    for (int bj = 0; bj < 2; ++bj) {
                        const pg8::f32x4 a = acc[ai][bj][m][0], b = acc[ai][bj][m][1];
                        float ss = (a[0] * a[0] + a[1] * a[1]) + (a[2] * a[2] + a[3] * a[3]) + (b[0] * b[0] + b[1] * b[1]) + (b[2] * b[2] + b[3] * b[3]);
                        ss += __shfl_xor(ss, 16); ss += __shfl_xor(ss, 32);
                        if (fq == 0) P[(ai * 128 + wr * 64 + m * 16 + fr) * 8 + bj * 4 + wc] = ss;
                    }
            asm volatile("s_waitcnt lgkmcnt(0)" ::: "memory"); __builtin_amdgcn_s_barrier(); asm volatile("" ::: "memory");
        }
        const int row0 = u.pm * 256 + wr * 64 + fr, col0 = u.pn * 256 + wc * 32 + 8 * fq;
        pg8::f32x4 g0[2], g1[2];
#pragma unroll
        for (int bj = 0; bj < 2; ++bj) {
            const float* gp = nullptr;
            if (mode == 1) gp = gqk + (pn >= 2 ? 64 : 0) + 32 * (wc & 1) + 8 * fq;
            else if (mode == 2) gp = gbq + 32 * wc + 8 * fq;
            else if (mode == 3 && bj == 0) gp = gbkv + 32 * wc + 8 * fq;
            if (gp) { g0[bj] = *(const pg8::f32x4*)gp; g1[bj] = *(const pg8::f32x4*)(gp + 4); } else { g0[bj] = (pg8::f32x4){1.f, 1.f, 1.f, 1.f}; g1[bj] = g0[bj]; }
        }
#pragma unroll
        for (int ai = 0; ai < 2; ++ai)
#pragma unroll
            for (int m = 0; m < 4; ++m) { bf16* rowp = O + (size_t)(row0 + ai * 128 + m * 16) * NP + col0;
#pragma unroll
                for (int bj = 0; bj < 2; ++bj) {
                    float s = 1.f;
                    if (mode != 0 && !(mode == 3 && bj == 1)) {
                        const pg8::f32x4 q = *(const LAS pg8::f32x4*)(P + (ai * 128 + wr * 64 + m * 16 + fr) * 8 + bj * 4);
                        s = (mode == 1) ? rsqrtf(((wc < 2) ? (q[0] + q[1]) : (q[2] + q[3])) * (1.f / 64.f) + EPS) : rsqrtf(((q[0] + q[1]) + (q[2] + q[3])) * (1.f / 128.f) + EPS);
                    }
                    const pg8::f32x4 v0 = acc[ai][bj][m][0] * s * g0[bj], v1 = acc[ai][bj][m][1] * s * g1[bj];
                    pg8::u32x4 w; w.x = pg8::cvt_pk_bf16(v0[0], v0[1]); w.y = pg8::cvt_pk_bf16(v0[2], v0[3]); w.z = pg8::cvt_pk_bf16(v1[0], v1[1]); w.w = pg8::cvt_pk_bf16(v1[2], v1[3]);
                    *(pg8::u32x4*)(rowp + bj * 128) = w; } }
    }
};
typedef __bf16 bf16x2_t __attribute__((ext_vector_type(2)));
__device__ __forceinline__ float dot2bf(unsigned a, unsigned b, float acc) { return __builtin_amdgcn_fdot2_f32_bf16(__builtin_bit_cast(bf16x2_t, a), __builtin_bit_cast(bf16x2_t, b), acc, false); }
template <int CTRL> __device__ __forceinline__ float dpp_f(float v) { return __int_as_float(__builtin_amdgcn_update_dpp(0, __float_as_int(v), CTRL, 0xf, 0xf, false)); }
__device__ __forceinline__ float row16_sum(float v) {
    v += dpp_f<0x128>(v); v += dpp_f<0x124>(v); v += dpp_f<0x122>(v); v += dpp_f<0x121>(v); return v;
}
__device__ __forceinline__ float gelu_erf(float v) {
    const float av = fabsf(v), t = __builtin_amdgcn_rcpf(fmaf(av, 0.2316418882f, 1.0f));
    float q = fmaf(t, 0.5307027145f, -0.7265760135f); q = fmaf(q, t, 0.7107068705f); q = fmaf(q, t, -0.142248368f); q = fmaf(q, t, 0.127414796f); q = q * t;
    const float e = __builtin_amdgcn_exp2f(v * v * -0.72134752044f);
    const float m = v * (q * e);
    return v < 0.f ? m : v - m;
}

__device__ __forceinline__ void ph_peer(const Params& p, unsigned char* lds_w, int gw, int ngw, int lane_, float* outp) {
    int lane = lane_; asm volatile("" : "+v"(lane));
    const bf16* H = (const bf16*)(p.ws + WS_H); const bf16* U16 = (const bf16*)(p.ws + WS_U16); const bf16* V16 = (const bf16*)(p.ws + WS_V16);
    const int* EXPI = (const int*)(p.ws + WS_EXP); const float* GATE = (const float*)(p.ws + WS_GATE); const float* MOD = (const float*)(p.ws + WS_MOD);
    int* e_lds = (int*)lds_w; float* a_lds = (float*)(lds_w + 512);
    const int g = lane >> 4, i = lane & 15;
    for (int t = gw; t < T; t += ngw) {
        const int e0 = EXPI[(size_t)t * 128 + lane], e1 = EXPI[(size_t)t * 128 + 64 + lane];
        const float g0 = GATE[(size_t)t * 128 + lane], g1 = GATE[(size_t)t * 128 + 64 + lane];
        e_lds[lane] = e0; e_lds[64 + lane] = e1;
        u32x4 xr[8];
        const u32x4* xrow = (const u32x4*)(H + (size_t)t * 1024) + i;
#pragma unroll
        for (int k = 0; k < 8; ++k) xr[k] = xrow[16 * k];
        LDS_WAIT(); asm volatile("" ::: "memory");
        u32x4 ua[8], ub[8];
        { const u32x4* ur = (const u32x4*)(U16 + (size_t)e_lds[g] * 1024) + i;
#pragma unroll
          for (int k = 0; k < 8; ++k) ua[k] = ur[16 * k]; }
#pragma unroll 1
        for (int s = 0; s < 32; s += 2) {
            { const u32x4* ur = (const u32x4*)(U16 + (size_t)e_lds[4 * (s + 1) + g] * 1024) + i;
#pragma unroll
              for (int k = 0; k < 8; ++k) ub[k] = ur[16 * k]; }
            { float a0 = 0.f, a1 = 0.f, a2 = 0.f, a3 = 0.f;
#pragma unroll
              for (int k = 0; k < 8; ++k) { a0 = dot2bf(ua[k].x, xr[k].x, a0); a1 = dot2bf(ua[k].y, xr[k].y, a1); a2 = dot2bf(ua[k].z, xr[k].z, a2); a3 = dot2bf(ua[k].w, xr[k].w, a3); }
              const float a = row16_sum((a0 + a1) + (a2 + a3));
              if (i == 0) a_lds[4 * s + g] = a; }
            if (s + 2 < 32) { const u32x4* ur = (const u32x4*)(U16 + (size_t)e_lds[4 * (s + 2) + g] * 1024) + i;
#pragma unroll
              for (int k = 0; k < 8; ++k) ua[k] = ur[16 * k]; }
            { float a0 = 0.f, a1 = 0.f, a2 = 0.f, a3 = 0.f;
#pragma unroll
              for (int k = 0; k < 8; ++k) { a0 = dot2bf(ub[k].x, xr[k].x, a0); a1 = dot2bf(ub[k].y, xr[k].y, a1); a2 = dot2bf(ub[k].z, xr[k].z, a2); a3 = dot2bf(ub[k].w, xr[k].w, a3); }
              const float a = row16_sum((a0 + a1) + (a2 + a3));
              if (i == 0) a_lds[4 * (s + 1) + g] = a; }
        }
        LDS_WAIT(); asm volatile("" ::: "memory");
        const float c0 = gelu_erf(a_lds[lane]) * g0, c1 = gelu_erf(a_lds[64 + lane]) * g1;
        const unsigned pw = pk2(c0, c1);
        float acc[16];
#pragma unroll
        for (int q = 0; q < 16; ++q) acc[q] = 0.f;
        u32x4 A0, A1, B0, B1, C0, C1, D0, D1;
#define PEER_VLOAD(j, X0, X1, Y0, Y1) do { const int ea_ = __builtin_amdgcn_readlane(e0, (j)), eb_ = __builtin_amdgcn_readlane(e1, (j)); \
            const u32x4* ra_ = (const u32x4*)(V16 + (size_t)ea_ * 1024) + lane; const u32x4* rb_ = (const u32x4*)(V16 + (size_t)eb_ * 1024) + lane; \
            X0 = ra_[0]; X1 = ra_[64]; Y0 = rb_[0]; Y1 = rb_[64]; } while (0)
#define PEER_VACC(j, X0, X1, Y0, Y1) do { const unsigned cp_ = (unsigned)__builtin_amdgcn_readlane((int)pw, (j)); \
            acc[0] = dot2bf(__builtin_amdgcn_perm(Y0.x, X0.x, 0x05040100u), cp_, acc[0]); acc[1] = dot2bf(__builtin_amdgcn_perm(Y0.x, X0.x, 0x07060302u), cp_, acc[1]); \
            acc[2] = dot2bf(__builtin_amdgcn_perm(Y0.y, X0.y, 0x05040100u), cp_, acc[2]); acc[3] = dot2bf(__builtin_amdgcn_perm(Y0.y, X0.y, 0x07060302u), cp_, acc[3]); \
            acc[4] = dot2bf(__builtin_amdgcn_perm(Y0.z, X0.z, 0x05040100u), cp_, acc[4]); acc[5] = dot2bf(__builtin_amdgcn_perm(Y0.z, X0.z, 0x07060302u), cp_, acc[5]); \
            acc[6] = dot2bf(__builtin_amdgcn_perm(Y0.w, X0.w, 0x05040100u), cp_, acc[6]); acc[7] = dot2bf(__builtin_amdgcn_perm(Y0.w, X0.w, 0x07060302u), cp_, acc[7]); \
            acc[8] = dot2bf(__builtin_amdgcn_perm(Y1.x, X1.x, 0x05040100u), cp_, acc[8]); acc[9] = dot2bf(__builtin_amdgcn_perm(Y1.x, X1.x, 0x07060302u), cp_, acc[9]); \
            acc[10] = dot2bf(__builtin_amdgcn_perm(Y1.y, X1.y, 0x05040100u), cp_, acc[10]); acc[11] = dot2bf(__builtin_amdgcn_perm(Y1.y, X1.y, 0x07060302u), cp_, acc[11]); \
            acc[12] = dot2bf(__builtin_amdgcn_perm(Y1.z, X1.z, 0x05040100u), cp_, acc[12]); acc[13] = dot2bf(__builtin_amdgcn_perm(Y1.z, X1.z, 0x07060302u), cp_, acc[13]); \
            acc[14] = dot2bf(__builtin_amdgcn_perm(Y1.w, X1.w, 0x05040100u), cp_, acc[14]); acc[15] = dot2bf(__builtin_amdgcn_perm(Y1.w, X1.w, 0x07060302u), cp_, acc[15]); } while (0)
        PEER_VLOAD(0, A0, A1, B0, B1);
#pragma unroll 1
        for (int j = 0; j < 64; j += 2) {
            PEER_VLOAD(j + 1, C0, C1, D0, D1);
            PEER_VACC(j, A0, A1, B0, B1);
            if (j + 2 < 64) PEER_VLOAD(j + 2, A0, A1, B0, B1);
            PEER_VACC(j + 1, C0, C1, D0, D1);
        }
#undef PEER_VLOAD
#undef PEER_VACC
        const float* g2 = MOD + (size_t)(t >> 11) * 6144 + 5120;
        const float* xrow1 = p.out + (size_t)t * 1024; float* orow = outp + (size_t)t * 1024;
#pragma unroll
        for (int h = 0; h < 2; ++h)
#pragma unroll
            for (int q = 0; q < 2; ++q) { const int col = 512 * h + 8 * lane + 4 * q;
                const f32x4 xv = *(const f32x4*)(xrow1 + col), gv = *(const f32x4*)(g2 + col);
                f32x4 a; a.x = acc[8 * h + 4 * q]; a.y = acc[8 * h + 4 * q + 1]; a.z = acc[8 * h + 4 * q + 2]; a.w = acc[8 * h + 4 * q + 3];
                *(f32x4*)(orow + col) = xv + gv * a; }
    }
}
typedef short v4i16_t __attribute__((ext_vector_type(4)));
#ifndef DSA_REP_A
#define DSA_REP_A 1
#endif
#ifndef DSA_REP_B
#define DSA_REP_B 1
#endif
#ifndef DSA_REP_C
#define DSA_REP_C 1
#endif
constexpr int DSA_SROW = 2048 * 4 + 16;
constexpr int DSA_SEL_OFF = 16 * DSA_SROW;
constexpr int DSA_LDS = DSA_SEL_OFF + 16 * 512;
constexpr int DSA_KVROW = 272;

__device__ __forceinline__ unsigned sortkey(float s) { const unsigned u = __float_as_uint(s); return u ^ ((u >> 31) ? 0xffffffffu : 0x80000000u); }
__device__ __forceinline__ unsigned cvtpk_bf16(float lo, float hi) { unsigned r; asm volatile("v_cvt_pk_bf16_f32 %0, %1, %2" : "=v"(r) : "v"(lo), "v"(hi)); return r; }

__device__ __forceinline__ void ph_dsa(const Params& p, unsigned char* lds, int vb, int nvb) {
    const bf16* PROJ = (const bf16*)(p.ws + WS_PROJ); bf16* MIX = (bf16*)(p.ws + WS_MIX);
    const float MB = ((const float*)(p.ws + WS_SCAL))[SC_MB];
    int tid = threadIdx.x; asm volatile("" : "+v"(tid)); const int lane = tid & 63, wv = __builtin_amdgcn_readfirstlane(tid >> 6);
    const int l15 = lane & 15, g = lane >> 4;
    LAS unsigned char* ldsl = (LAS unsigned char*)lds;
    for (int it = vb; it < 2048; it += nvb) {
        const int vbb = it & 255, kk = it >> 8, xg = vbb & 7, ix = vbb >> 3, b = 2 * xg + (ix & 1), G = (ix >> 1) & 3, sub = ix >> 3;
        const int c = (kk & 1) ? (31 - G - 8 * (kk >> 1)) : (G + 8 * (kk >> 1));
        const int cend = (c + 1) * 64, t0 = c * 64 + sub * 16;
        const bf16* Pb = PROJ + (size_t)b * SEQ * NP;
#pragma unroll 1
        for (int repa = 0; repa < DSA_REP_A; ++repa)
        if (c >= 4) {
            const bf16* qrow = Pb + (size_t)(t0 + l15) * NP;
            bf16x8 bq[4][2]; float wsc[4];
#pragma unroll
            for (int h = 0; h < 4; ++h) { wsc[h] = bf2f(qrow[C_WI + h]) * 0.0625f;
#pragma unroll
                for (int ks = 0; ks < 2; ++ks) bq[h][ks] = *(const bf16x8*)(qrow + C_QI + h * 64 + 32 * ks + 8 * g); }
            for (int k0 = 16 * wv; k0 < cend; k0 += 128) {
                const bf16* krow = Pb + (size_t)(k0 + l15) * NP + C_KI + 8 * g;
                const bf16x8 ka0 = *(const bf16x8*)krow, ka1 = *(const bf16x8*)(krow + 32);
                f32x4 sc = {0.f, 0.f, 0.f, 0.f};
#pragma unroll
                for (int h = 0; h < 4; ++h) { f32x4 a = {0.f, 0.f, 0.f, 0.f};
                    a = __builtin_amdgcn_mfma_f32_16x16x32_bf16(ka0, bq[h][0], a, 0, 0, 0);
                    a = __builtin_amdgcn_mfma_f32_16x16x32_bf16(ka1, bq[h][1], a, 0, 0, 0);
#pragma unroll
                    for (int r = 0; r < 4; ++r) sc[r] = fmaf(fmaxf(a[r], 0.f), wsc[h], sc[r]); }
#pragma unroll
                for (int r = 0; r < 4; ++r) sc[r] = (sc[r] == 0.f) ? 0.f : sc[r];
                *(LAS f32x4*)(ldsl + l15 * DSA_SROW + (k0 + 4 * g) * 4) = sc;
            }
        }
        __syncthreads();
        LAS unsigned short* selw = (LAS unsigned short*)(ldsl + DSA_SEL_OFF);
        int mind0 = 0, mind1 = 0;
        if (c < 4) {
            for (int j = lane; j < 256; j += 64) { selw[(2 * wv) * 256 + j] = (unsigned short)j; selw[(2 * wv + 1) * 256 + j] = (unsigned short)j; }
        } else {
            const int nreg = cend >> 6;
            unsigned keyA[32], keyB[32];
            { const LAS float* srA = (const LAS float*)(ldsl + (2 * wv) * DSA_SROW) + lane; const LAS float* srB = (const LAS float*)(ldsl + (2 * wv + 1) * DSA_SROW) + lane;
#pragma unroll
              for (int i = 0; i < 32; ++i) { keyA[i] = (i < nreg) ? sortkey(srA[64 * i]) : 0u; keyB[i] = (i < nreg) ? sortkey(srB[64 * i]) : 0u; } }
#define DSA_WSUM(V, OUT) do { int v_ = (V); v_ += __builtin_amdgcn_update_dpp(0, v_, 0x128, 0xf, 0xf, false); v_ += __builtin_amdgcn_update_dpp(0, v_, 0x124, 0xf, 0xf, false); \
        v_ += __builtin_amdgcn_update_dpp(0, v_, 0x122, 0xf, 0xf, false); v_ += __builtin_amdgcn_update_dpp(0, v_, 0x121, 0xf, 0xf, false);                                     \
        OUT = __builtin_amdgcn_readlane(v_, 0) + __builtin_amdgcn_readlane(v_, 16) + __builtin_amdgcn_readlane(v_, 32) + __builtin_amdgcn_readlane(v_, 48); } while (0)
            unsigned prefA = 0u, prefB = 0u; bool exA = false, exB = false;
#pragma unroll 1
            for (int bit = 31; bit >= 0; --bit) {
                const unsigned candA = exA ? prefA : (prefA | (1u << bit)), candB = exB ? prefB : (prefB | (1u << bit));
                int ca = 0, cb = 0;
#pragma unroll
                for (int i = 0; i < 32; ++i) { ca += (keyA[i] >= candA) ? 1 : 0; cb += (keyB[i] >= candB) ? 1 : 0; }
                int cntA, cntB; DSA_WSUM(ca, cntA); DSA_WSUM(cb, cntB);
                if (!exA && cntA >= 256) { prefA = candA; exA = (cntA == 256); }
                if (!exB && cntB >= 256) { prefB = candB; exB = (cntB == 256); }
                if (exA && exB) break;
            }
#define DSA_COMPACT(KEY, PREFIX, EXACT, QQ, MIND) do {                                                                                              \
            const int t_ = t0 + (QQ); LAS unsigned short* sel = selw + (QQ) * 256;                                                                    \
            int need_ties = 0;                                                                                                                        \
            if (!(EXACT)) { int cg_ = 0; if ((PREFIX) != 0xffffffffu) { _Pragma("unroll") for (int i = 0; i < 32; ++i) cg_ += (KEY[i] > (PREFIX)) ? 1 : 0; } \
                int cgt; DSA_WSUM(cg_, cgt); need_ties = 256 - cgt; }                                                                                 \
            int base = 0, tbase = 0, md = 4096;                                                                                                       \
            _Pragma("unroll") for (int i = 0; i < 32; ++i) { if (i < nreg) {                                                                          \
                bool selb;                                                                                                                            \
                if (EXACT) selb = KEY[i] >= (PREFIX);                                                                                                 \
                else { const bool tie = KEY[i] == (PREFIX); const unsigned long long mt = __ballot(tie);                                              \
                    const int trank = tbase + (int)__builtin_amdgcn_mbcnt_hi((unsigned)(mt >> 32), __builtin_amdgcn_mbcnt_lo((unsigned)mt, 0u));      \
                    selb = (KEY[i] > (PREFIX)) || (tie && trank < need_ties); tbase += __popcll(mt); }                                                \
                const unsigned long long m = __ballot(selb);                                                                                          \
                const int pos = base + (int)__builtin_amdgcn_mbcnt_hi((unsigned)(m >> 32), __builtin_amdgcn_mbcnt_lo((unsigned)m, 0u));               \
                const int kidx = i * 64 + lane;                                                                                                       \
                if (selb) { sel[pos] = (unsigned short)kidx; const int d = t_ > kidx ? t_ - kidx : kidx - t_; md = d < md ? d : md; }                 \
                base += __popcll(m); } }                                                                                                              \
            _Pragma("unroll") for (int o = 1; o < 64; o <<= 1) { const int x = __shfl_xor(md, o); md = x < md ? x : md; }                             \
            MIND = md; } while (0)
            DSA_COMPACT(keyA, prefA, exA, 2 * wv, mind0);
            DSA_COMPACT(keyB, prefB, exB, 2 * wv + 1, mind1);
#undef DSA_COMPACT
#undef DSA_WSUM
        }
        LDS_WAIT(); asm volatile("" ::: "memory");
        const int nvalid = cend < 256 ? cend : 256;
        const int head = lane & 7;
        const float slopeL2 = exp2f(-(float)(head + 1)) * 1.4426950409f;
#pragma unroll 1
        for (int qi2 = 0; qi2 < 2 * DSA_REP_C; ++qi2) { const int qi = qi2 & 1;
            const int qq = 2 * wv + qi, t = t0 + qq;
            const LAS unsigned short* sel = selw + qq * 256;
            LAS unsigned char* stg = ldsl + (2 * wv) * DSA_SROW;
            const bf16* qrow = Pb + (size_t)t * NP + C_QB + head * 128 + 8 * g;
            bf16x8 bq[4];
#pragma unroll
            for (int ks = 0; ks < 4; ++ks) bq[ks] = *(const bf16x8*)(qrow + 32 * ks);
            const float refL2 = MB * 1.4426950409f - slopeL2 * (float)(qi == 0 ? mind0 : mind1);
            f32x4 o[8];
#pragma unroll
            for (int dt = 0; dt < 8; ++dt) o[dt] = (f32x4){0.f, 0.f, 0.f, 0.f};
            float lsum = 0.f;
#define DSA_GATHER(S, KA) do { _Pragma("unroll") for (int i_ = 0; i_ < 8; ++i_) { const int jr = 32 * (S) + 4 * i_ + g; const int keyr = sel[jr < nvalid ? jr : 0];   \
        KA[i_] = *(const bf16x8*)(Pb + (size_t)keyr * NP + C_KV + 8 * l15); } } while (0)
#define DSA_COMPUTE(S, KA) do { unsigned pb[4];                                                                                                        \
        _Pragma("unroll") for (int i_ = 0; i_ < 8; ++i_) *(LAS bf16x8*)(stg + (4 * i_ + g) * DSA_KVROW + 16 * l15) = KA[i_];                              \
        LDS_WAIT(); asm volatile("" ::: "memory");                                                                                                        \
        _Pragma("unroll") for (int tl = 0; tl < 2; ++tl) { const int j0 = 32 * (S) + 16 * tl;                                                           \
            f32x4 a = {0.f, 0.f, 0.f, 0.f};                                                                                                             \
            _Pragma("unroll") for (int ks = 0; ks < 4; ++ks) { const bf16x8 ka_ = *(const LAS bf16x8*)(stg + (16 * tl + l15) * DSA_KVROW + (32 * ks + 8 * g) * 2); \
                a = __builtin_amdgcn_mfma_f32_16x16x32_bf16(ka_, bq[ks], a, 0, 0, 0); }                                                                 \
            const u32x2 kw = *(const LAS u32x2*)(sel + j0 + 4 * g);                                                                                     \
            const int kx[4] = {(int)(kw.x & 0xffffu), (int)(kw.x >> 16), (int)(kw.y & 0xffffu), (int)(kw.y >> 16)};                                     \
            float pr[4];                                                                                                                                \
            _Pragma("unroll") for (int r = 0; r < 4; ++r) { const int dd = t > kx[r] ? t - kx[r] : kx[r] - t;                                            \
                const float e = __builtin_amdgcn_exp2f(fmaf(a[r], 0.1275174f, -slopeL2 * (float)dd - refL2));                                            \
                pr[r] = (j0 + 4 * g + r < nvalid) ? e : 0.f; lsum += pr[r]; }                                                                           \
            pb[2 * tl] = cvtpk_bf16(pr[0], pr[1]); pb[2 * tl + 1] = cvtpk_bf16(pr[2], pr[3]); }                                                         \
        LDS_WAIT(); asm volatile("" ::: "memory");                                                                                                      \
        u32x4 pw4; pw4.x = pb[0]; pw4.y = pb[1]; pw4.z = pb[2]; pw4.w = pb[3];                                                                          \
        const bf16x8 pfrag = __builtin_bit_cast(bf16x8, pw4);                                                                                           \
        const LAS unsigned char* trb = stg + (4 * g + (l15 >> 2)) * DSA_KVROW + (4 * (lane & 3)) * 2;                                                   \
        _Pragma("unroll") for (int dt = 0; dt < 8; ++dt) {                                                                                              \
            const s16x4 lo = __builtin_bit_cast(s16x4, __builtin_amdgcn_ds_read_tr16_b64_v4i16((LAS v4i16_t*)(trb + dt * 32)));                         \
            const s16x4 hi = __builtin_bit_cast(s16x4, __builtin_amdgcn_ds_read_tr16_b64_v4i16((LAS v4i16_t*)(trb + 16 * DSA_KVROW + dt * 32)));        \
            const bf16x8 af = {lo[0], lo[1], lo[2], lo[3], hi[0], hi[1], hi[2], hi[3]};                                                                 \
            o[dt] = __builtin_amdgcn_mfma_f32_16x16x32_bf16(af, pfrag, o[dt], 0, 0, 0); }                                                               \
        LDS_WAIT(); asm volatile("" ::: "memory"); } while (0)
            const int nch = (nvalid + 31) >> 5;
            bf16x8 KA[8], KB[8];
            DSA_GATHER(0, KA);
#pragma unroll 1
            for (int s = 0; s < nch; s += 2) {
                if (s + 1 < nch) DSA_GATHER(s + 1, KB);
                DSA_COMPUTE(s, KA);
                if (s + 1 < nch) { if (s + 2 < nch) DSA_GATHER(s + 2, KA); DSA_COMPUTE(s + 1, KB); }
            }
#undef DSA_GATHER
#undef DSA_COMPUTE
            lsum += __shfl_xor(lsum, 16); lsum += __shfl_xor(lsum, 32);
            const float il = 1.f / lsum;
            if (l15 < 8) {
                bf16* orow = MIX + (size_t)(b * SEQ + t) * MIXW + 512 + head * 128 + 4 * g;
#pragma unroll
                for (int dt = 0; dt < 8; ++dt) { u32x2 w; w.x = pk2(o[dt][0] * il, o[dt][1] * il); w.y = pk2(o[dt][2] * il, o[dt][3] * il); *(u32x2*)(orow + 16 * dt) = w; }
            }
        }
        __syncthreads();
    }
}
typedef __attribute__((address_space(1))) float GASF;
#ifndef ATT_REMAP
#define ATT_REMAP 1
#endif
__device__ __forceinline__ int crow(int r, int hi) { return (r & 3) + 8 * (r >> 2) + 4 * hi; }
#define KSWZ64(row, cb) ((row) * 128 + ((cb) ^ ((((row) >> 1) & 7) << 4)))
__device__ __forceinline__ int v_st(int k, int c) { const int kk = (k & ~0xC) | ((k & 4) << 1) | ((k & 8) >> 1); return ((kk >> 3) * 4 + (c >> 5)) * 512 + ((kk & 7) * 32 + (c & 31)) * 2; }
__device__ __forceinline__ int v_rd_base(int lane) { return ((lane & 3) << 3) | (((lane >> 2) & 3) << 6) | (((lane >> 4) & 1) << 5) | (((lane >> 5) & 1) << 8); }
constexpr int v_rd_off(int d0, int ks, int half) { return d0 * 512 + ks * 4096 + half * 2048; }
template <int OFF> __device__ __forceinline__ s16x4 tr_read(int vb) {
    s16x4 r; asm volatile("ds_read_b64_tr_b16 %0, %1 offset:%2" : "=&v"(r) : "v"(vb), "i"(OFF) : "memory"); return r;
}
template <int D0> __device__ __forceinline__ void pv_one(f32x16& od, int vb, bf16x8 pa0, bf16x8 pa1, bf16x8 pa2, bf16x8 pa3) {
    const s16x4 l0 = tr_read<v_rd_off(D0, 0, 0)>(vb), h0 = tr_read<v_rd_off(D0, 0, 1)>(vb), l1 = tr_read<v_rd_off(D0, 1, 0)>(vb), h1 = tr_read<v_rd_off(D0, 1, 1)>(vb);
    const s16x4 l2 = tr_read<v_rd_off(D0, 2, 0)>(vb), h2 = tr_read<v_rd_off(D0, 2, 1)>(vb), l3 = tr_read<v_rd_off(D0, 3, 0)>(vb), h3 = tr_read<v_rd_off(D0, 3, 1)>(vb);
    asm volatile("s_waitcnt lgkmcnt(0)" ::: "memory"); __builtin_amdgcn_sched_barrier(0);
#define PK(L, H) (bf16x8){L[0], L[1], L[2], L[3], H[0], H[1], H[2], H[3]}
    od = __builtin_amdgcn_mfma_f32_32x32x16_bf16(pa0, PK(l0, h0), od, 0, 0, 0);
    od = __builtin_amdgcn_mfma_f32_32x32x16_bf16(pa1, PK(l1, h1), od, 0, 0, 0);
    od = __builtin_amdgcn_mfma_f32_32x32x16_bf16(pa2, PK(l2, h2), od, 0, 0, 0);
    od = __builtin_amdgcn_mfma_f32_32x32x16_bf16(pa3, PK(l3, h3), od, 0, 0, 0);
#undef PK
}
constexpr int ATT_LDS = 2 * 16384 + 2 * 8192 + 8 * 256;

__device__ __forceinline__ void ph_attnA(const Params& p, unsigned char* lds, int vb, int nvb) {
    const bf16* PROJ = (const bf16*)(p.ws + WS_PROJ); bf16* MIX = (bf16*)(p.ws + WS_MIX);
    const float* SC = (const float*)(p.ws + WS_SCAL);
    const float lam = SC[SC_LAM], refL2 = SC[SC_MA] * 1.4426950409f;
    constexpr float C = 0.125f * 1.4426950409f;
    int tid = threadIdx.x; asm volatile("" : "+v"(tid)); const int lane = tid & 63, wid = __builtin_amdgcn_readfirstlane(tid >> 6), r32 = lane & 31, hi = lane >> 5;
    unsigned char* V_lds = lds; unsigned char* K_lds = lds + 32768;
    float* wsf = (float*)(lds + 49152) + wid * 64;
    GASF* tmpw = (GASF*)(p.ws + WS_ATMP) + ((size_t)(vb * NWV + wid) * 64) * 64 + lane;
    const int vbase = (int)(uintptr_t)V_lds + v_rd_base(lane);
    const int krow = tid >> 3, kch = tid & 7, kdst = KSWZ64(krow, kch * 16);
    const int sr = tid >> 4, sc = (tid & 15) * 8, vst0 = v_st(sr, sc), vst1 = v_st(32 + sr, sc);
    for (int it = vb; it < 256; it += nvb) {
        #if ATT_REMAP
        const int xg_ = it & 7, m_ = it >> 3, pidx = xg_ * 8 + (m_ >> 2), qbl = m_ & 3, b = pidx >> 2, h = pidx & 3;
#else
        const int b = it >> 4, h = (it >> 2) & 3, qbl = it & 3;
#endif
        const float slopeL2 = exp2f(-2.0f * (float)(h + 1)) * 1.4426950409f;
        const bf16* Pb = PROJ + (size_t)b * SEQ * NP;
#pragma unroll 1
        for (int half = 0; half < 2; ++half) {
            const int qb = half ? 7 - qbl : qbl, q0 = 256 * qb, NTu = 4 * (qb + 1), cw = 4 * qb + (wid >> 1);
            const int tq = q0 + 32 * wid + r32;
#pragma unroll 1
            for (int mi = 0; mi < 2; ++mi) {
                const int m = 1 - mi;
                const bf16* Kg = Pb + C_KA + h * 128 + m * 64 + (size_t)krow * NP + kch * 8;
                const bf16* Vg = Pb + C_VA + h * 128 + (size_t)sr * NP + sc;
                bf16x8 qr[4];
                { const bf16* qp = Pb + (size_t)tq * NP + C_QA + h * 128 + m * 64 + hi * 8;
#pragma unroll
                  for (int d0 = 0; d0 < 4; ++d0) qr[d0] = *(const bf16x8*)(qp + d0 * 16); }
                f32x16 o[4];
#pragma unroll
                for (int d = 0; d < 4; ++d) o[d] = f32x16{};
                float lsum = 0.f;
                bf16x8 sk, sv0, sv1;
                sk = *(const bf16x8*)Kg; sv0 = *(const bf16x8*)Vg; sv1 = *(const bf16x8*)(Vg + (size_t)32 * NP);
                *(bf16x8*)(K_lds + kdst) = sk; *(bf16x8*)(V_lds + vst0) = sv0; *(bf16x8*)(V_lds + vst1) = sv1;
                __syncthreads();
#pragma unroll 1
                for (int j = 0; j < NTu; ++j) {
                    const int buf = j & 1;
                    if (j + 1 < NTu) { const size_t go = (size_t)(j + 1) * 64 * NP; sk = *(const bf16x8*)(Kg + go); sv0 = *(const bf16x8*)(Vg + go); sv1 = *(const bf16x8*)(Vg + go + (size_t)32 * NP); }
                    if (j <= cw) {
                        const unsigned char* Kb = K_lds + buf * 8192;
                        const float dq = (float)(tq - 64 * j - 4 * hi);
                        const float B0 = -slopeL2 * dq - refL2;
                        const bool past = j < cw;
                        float ps = 0.f;
                        bf16x8 pa0, pa1, pa2, pa3;
#define PK4(P, BASE, OUT) do { unsigned a0 = cvtpk_bf16(P[BASE + 0], P[BASE + 1]), a1 = cvtpk_bf16(P[BASE + 2], P[BASE + 3]);   \
    unsigned b0_ = cvtpk_bf16(P[BASE + 4], P[BASE + 5]), b1_ = cvtpk_bf16(P[BASE + 6], P[BASE + 7]);                              \
    auto r0 = __builtin_amdgcn_permlane32_swap(a0, b0_, false, false); auto r1 = __builtin_amdgcn_permlane32_swap(a1, b1_, false, false); \
    u32x4 w = {r0[0], r1[0], r0[1], r1[1]}; OUT = __builtin_bit_cast(bf16x8, w); } while (0)
#define HALF_TILE(KOFF, FOFF, PA, PB) do { f32x16 pp = f32x16{};                                                                     \
    _Pragma("unroll") for (int d0 = 0; d0 < 4; ++d0) { const int cb = (d0 * 16 + hi * 8) * 2;                                        \
        const bf16x8 bk = *(const bf16x8*)(Kb + KSWZ64((KOFF) + r32, cb)); pp = __builtin_amdgcn_mfma_f32_32x32x16_bf16(bk, qr[d0], pp, 0, 0, 0); } \
    if (past) { _Pragma("unroll") for (int r = 0; r < 16; ++r) { const float off = (float)((r & 3) + 8 * (r >> 2)) + (FOFF);          \
            pp[r] = __builtin_amdgcn_exp2f(fmaf(pp[r], C, fmaf(slopeL2, off, B0))); } }                                               \
    else { _Pragma("unroll") for (int r = 0; r < 16; ++r) { const float off = (float)((r & 3) + 8 * (r >> 2)) + (FOFF);               \
            pp[r] = __builtin_amdgcn_exp2f(fmaf(pp[r], C, -slopeL2 * fabsf(dq - off) - refL2)); } }                                   \
    _Pragma("unroll") for (int r = 0; r < 16; ++r) ps += pp[r];                                                                       \
    PK4(pp, 0, PA); PK4(pp, 8, PB); __builtin_amdgcn_sched_barrier(0); } while (0)
                        HALF_TILE(0, 0.f, pa0, pa1);
                        HALF_TILE(32, 32.f, pa2, pa3);
#undef HALF_TILE
#undef PK4
                        { auto rr = __builtin_amdgcn_permlane32_swap(__float_as_uint(ps), __float_as_uint(ps), false, false);
                          ps = __uint_as_float(rr[0]) + __uint_as_float(rr[1]); }
                        lsum += ps;
                        const int vb0 = vbase + buf * 16384;
                        pv_one<0>(o[0], vb0, pa0, pa1, pa2, pa3); pv_one<1>(o[1], vb0, pa0, pa1, pa2, pa3); pv_one<2>(o[2], vb0, pa0, pa1, pa2, pa3); pv_one<3>(o[3], vb0, pa0, pa1, pa2, pa3);
                    }
                    if (j + 1 < NTu) { const int nb = buf ^ 1;
                        *(bf16x8*)(K_lds + nb * 8192 + kdst) = sk; *(bf16x8*)(V_lds + nb * 16384 + vst0) = sv0; *(bf16x8*)(V_lds + nb * 16384 + vst1) = sv1; }
                    __syncthreads();
                }
                if (hi == 0) wsf[r32] = lsum;
                LDS_WAIT(); asm volatile("" ::: "memory");
                float rli[16];
#pragma unroll
                for (int r = 0; r < 16; ++r) rli[r] = 1.f / wsf[crow(r, hi)];
                LDS_WAIT(); asm volatile("" ::: "memory");
                if (mi == 0) {
#pragma unroll
                    for (int d = 0; d < 4; ++d) { GASF* td = tmpw + d * 1024; asm volatile("" : "+v"(td));
#pragma unroll
                        for (int r = 0; r < 16; ++r) td[r * 64] = o[d][r] * rli[r]; }
                } else {
                    float gsub[4];
#pragma unroll
                    for (int d = 0; d < 4; ++d) gsub[d] = p.a_sub_gain[32 * d + r32];
                    GASF* tdp[4];
#pragma unroll
                    for (int d = 0; d < 4; ++d) { tdp[d] = tmpw + d * 1024; asm volatile("" : "+v"(tdp[d])); }
#pragma unroll
                    for (int r = 0; r < 16; ++r) {
                        float v[4]; float ss = 0.f;
#pragma unroll
                        for (int d = 0; d < 4; ++d) { v[d] = o[d][r] * rli[r] - lam * tdp[d][r * 64]; ss += v[d] * v[d]; }
                        ss += __shfl_xor(ss, 1); ss += __shfl_xor(ss, 2); ss += __shfl_xor(ss, 4); ss += __shfl_xor(ss, 8); ss += __shfl_xor(ss, 16);
                        const float rs = rsqrtf(ss * (1.f / 128.f) + EPS) * 0.8f;
                        bf16* orow = MIX + (size_t)(b * SEQ + q0 + 32 * wid + crow(r, hi)) * MIXW + h * 128 + r32;
#pragma unroll
                        for (int d = 0; d < 4; ++d) orow[32 * d] = (bf16)f2bf(v[d] * rs * gsub[d]);
                        asm volatile("" ::: "memory");
                    }
                }
            }
        }
    }
}
constexpr int RT_WAVE_BYTES = 12288;
constexpr int RT_LDS = 32768 + 8 * RT_WAVE_BYTES;

__device__ __forceinline__ int pl32_sum(int v) { auto rr = __builtin_amdgcn_permlane32_swap((unsigned)v, (unsigned)v, false, false); return (int)(rr[0] + rr[1]); }
__device__ __forceinline__ int pl32_other(int v) { auto rr = __builtin_amdgcn_permlane32_swap((unsigned)v, (unsigned)v, false, false); return (int)(rr[0] + rr[1]) - v; }
__device__ __forceinline__ float unsortkey(unsigned k) { return __uint_as_float((k & 0x80000000u) ? (k ^ 0x80000000u) : ~k); }

template <int N> __device__ __forceinline__ unsigned bisect16(const unsigned (&key)[N]) {
    unsigned prefix = 0u; bool done = false;
#pragma unroll 1
    for (int bit = 31; bit >= 0; --bit) {
        const unsigned cand = done ? prefix : (prefix | (1u << bit));
        int cnt = 0;
#pragma unroll
        for (int i = 0; i < N; ++i) cnt += (key[i] >= cand) ? 1 : 0;
        const int tot = pl32_sum(cnt);
        if (!done && tot >= 16) { prefix = cand; done = (tot == 16); }
        if (__all(done)) break;
    }
    return prefix;
}

__device__ __forceinline__ void ph_route(const Params& p, unsigned char* lds, int vb, int nvb) {
    const bf16* Q3 = (const bf16*)(p.ws + WS_Q3); const bf16* SUBK = (const bf16*)(p.ws + WS_SUBK);
    int* EXPI = (int*)(p.ws + WS_EXP); float* GATE = (float*)(p.ws + WS_GATE);
    int tid = threadIdx.x; asm volatile("" : "+v"(tid));
    const int lane = tid & 63, wv = __builtin_amdgcn_readfirstlane(tid >> 6), r32 = lane & 31, hi = lane >> 5;
    for (int i = tid; i < 2048; i += NT) { const int row = i >> 3, ch = i & 7; ((u32x4*)lds)[row * 8 + (ch ^ ((row >> 1) & 7))] = ((const u32x4*)SUBK)[i]; }
    __syncthreads();
    unsigned char* wl = lds + 32768 + wv * RT_WAVE_BYTES;
    float* sv = (float*)wl; int* si = (int*)(wl + 4096); float* fv = (float*)(wl + 8192); int* fe = (int*)(wl + 10240);
    const int gw = vb * NWV + wv, ngw = nvb * NWV;
    for (int item = gw; item < (T / 32) * 8; item += ngw) {
        const int h = item & 7, tok0 = (item >> 3) * 32;
        const bf16* qrow = Q3 + (size_t)(tok0 + r32) * 1024 + h * 128 + hi * 8;
#pragma unroll 1
        for (int c = 0; c < 2; ++c) {
            bf16x8 bq[4];
#pragma unroll
            for (int d0 = 0; d0 < 4; ++d0) bq[d0] = *(const bf16x8*)(qrow + c * 64 + d0 * 16);
            unsigned key[64];
#pragma unroll
            for (int nt = 0; nt < 4; ++nt) {
                f32x16 acc = f32x16{};
                const int krow = c * 128 + nt * 32 + r32, ksw = (krow >> 1) & 7;
                const unsigned char* kp = lds + krow * 128;
#pragma unroll
                for (int d0 = 0; d0 < 4; ++d0) { const bf16x8 ak = *(const bf16x8*)(kp + (((2 * d0 + hi) ^ ksw) << 4)); acc = __builtin_amdgcn_mfma_f32_32x32x16_bf16(ak, bq[d0], acc, 0, 0, 0); }
#pragma unroll
                for (int r = 0; r < 16; ++r) key[nt * 16 + r] = sortkey(acc[r]);
            }
            const unsigned thr = bisect16<64>(key);
            int cnt = 0;
#pragma unroll
            for (int i = 0; i < 64; ++i) cnt += (key[i] >= thr) ? 1 : 0;
            const int other_ = pl32_other(cnt); int slot = hi ? other_ : 0;
            float* svp = sv + (r32 * 2 + c) * 16; int* sip = si + (r32 * 2 + c) * 16;
#pragma unroll
            for (int i = 0; i < 64; ++i) {
                if (key[i] >= thr && slot < 16) { svp[slot] = unsortkey(key[i]); sip[slot] = 32 * (i >> 4) + ((i & 3) + 8 * ((i & 15) >> 2)) + 4 * hi; ++slot; }
            }
        }
        LDS_WAIT(); asm volatile("" ::: "memory");
        {
            float* sv0 = sv + (r32 * 2) * 16; float* sv1 = sv0 + 16; int* si0 = si + (r32 * 2) * 16; int* si1 = si0 + 16;
            {
                float a[16], bl[16];
#pragma unroll
                for (int k = 0; k < 16; ++k) { a[k] = sv0[k]; bl[k] = sv1[k]; }
                int ia[8], ib[8], ra[8], rb[8]; float va[8], vb[8];
#pragma unroll
                for (int q = 0; q < 8; ++q) { const int e = 8 * hi + q; va[q] = sv0[e]; vb[q] = sv1[e]; ia[q] = si0[e]; ib[q] = si1[e]; int r0 = 0, r1 = 0;
#pragma unroll
                    for (int k = 0; k < 16; ++k) { r0 += (a[k] > va[q] || (a[k] == va[q] && k < e)) ? 1 : 0; r1 += (bl[k] > vb[q] || (bl[k] == vb[q] && k < e)) ? 1 : 0; }
                    ra[q] = r0; rb[q] = r1; }
                LDS_WAIT(); asm volatile("" ::: "memory");
                { auto rr = __builtin_amdgcn_permlane32_swap(0u, 0u, false, false); (void)rr; }
#pragma unroll
                for (int q = 0; q < 8; ++q) { sv0[ra[q]] = va[q]; si0[ra[q]] = ia[q]; sv1[rb[q]] = vb[q]; si1[rb[q]] = ib[q]; }
                LDS_WAIT(); asm volatile("" ::: "memory");
            }
            const float* X = hi ? sv1 : sv0; const float* Y = hi ? sv0 : sv1;
            float x[4], y[16];
#pragma unroll
            for (int k = 0; k < 4; ++k) x[k] = X[k];
#pragma unroll
            for (int k = 0; k < 16; ++k) y[k] = Y[k];
            unsigned key[27]; int pi[27], pj[27]; int np = 0;
#pragma unroll
            for (int i = 0; i < 3; ++i)
#pragma unroll
                for (int j = i + 1; j < 16; ++j) if ((i + 1) * (j + 1) <= 16) { key[np] = sortkey(x[i] + y[j]); pi[np] = i; pj[np] = j; ++np; }
#pragma unroll
            for (int i = 0; i < 4; ++i) { key[23 + i] = hi ? 0u : sortkey(x[i] + y[i]); pi[23 + i] = i; pj[23 + i] = i; }
            const unsigned thr = bisect16<27>(key);
            int cnt = 0;
#pragma unroll
            for (int i = 0; i < 27; ++i) cnt += (key[i] >= thr) ? 1 : 0;
            const int other_ = pl32_other(cnt); int slot = hi ? other_ : 0;
            const int* IX = hi ? si1 : si0; const int* IY = hi ? si0 : si1;
            float* fvp = fv + r32 * 16; int* fep = fe + r32 * 16;
#pragma unroll
            for (int i = 0; i < 27; ++i) {
                if (key[i] >= thr && slot < 16) { const int ex = IX[pi[i]], ey = IY[pj[i]]; fvp[slot] = unsortkey(key[i]); fep[slot] = hi ? (ey * 128 + ex) : (ex * 128 + ey); ++slot; }
            }
        }
        LDS_WAIT(); asm volatile("" ::: "memory");
        {
            const float* fvp = fv + r32 * 16;
            float v[16]; float mx = -3e38f;
#pragma unroll
            for (int k = 0; k < 16; ++k) { v[k] = fvp[k]; mx = fmaxf(mx, v[k]); }
            float l = 0.f;
#pragma unroll
            for (int k = 0; k < 16; ++k) { v[k] = __expf(v[k] - mx); l += v[k]; }
            const float il = 1.f / l;
            const size_t ob = (size_t)(tok0 + r32) * 128 + h * 16 + 8 * hi;
            const int* fep = fe + r32 * 16 + 8 * hi;
            f32x4 g0, g1; u32x4 e0, e1;
            if (hi == 0) { g0 = (f32x4){v[0] * il, v[1] * il, v[2] * il, v[3] * il}; g1 = (f32x4){v[4] * il, v[5] * il, v[6] * il, v[7] * il}; }
            else { g0 = (f32x4){v[8] * il, v[9] * il, v[10] * il, v[11] * il}; g1 = (f32x4){v[12] * il, v[13] * il, v[14] * il, v[15] * il}; }
            e0 = *(const u32x4*)fep; e1 = *(const u32x4*)(fep + 4);
            *(f32x4*)(GATE + ob) = g0; *(f32x4*)(GATE + ob + 4) = g1;
            *(u32x4*)(EXPI + ob) = e0; *(u32x4*)(EXPI + ob + 4) = e1;
        }
        LDS_WAIT(); asm volatile("" ::: "memory");
    }
    __syncthreads();
}
constexpr int PU_UNITS = T / 64;
constexpr int CW_PEER_U = 4096, CW_PEER_V = 4096 + 16 * 64;

__device__ __forceinline__ unsigned peer_xcc() { return (unsigned)__builtin_amdgcn_s_getreg((3 << 11) | 20) & 7u; }

__device__ __forceinline__ void ph_peer_u(const Params& p, unsigned char* lds, int cwbase) {
    const bf16* H = (const bf16*)(p.ws + WS_H); const bf16* U16 = (const bf16*)(p.ws + WS_U16);
    const int* EXPI = (const int*)(p.ws + WS_EXP); const float* GATE = (const float*)(p.ws + WS_GATE); float* CBUF = (float*)(p.ws + WS_CBUF);
    unsigned* ctl = (unsigned*)(p.ws + WS_CTL);
    int tid = threadIdx.x; asm volatile("" : "+v"(tid));
    const int lane = tid & 63, wv = __builtin_amdgcn_readfirstlane(tid >> 6), g = lane >> 4, i = lane & 15;
    volatile LAS unsigned* slot = (volatile LAS unsigned*)(LAS unsigned char*)lds;
    int* le = (int*)(lds + 1024 + wv * 1024); int* lj = le + 128;
    const unsigned xcc = peer_xcc();
#pragma unroll 1
    for (int k = 0; k < 16; ++k) {
        const int part = (int)((2u * xcc + (unsigned)k) & 15u);
#pragma unroll 1
        for (;;) {
            if (tid == 0) *slot = __hip_atomic_fetch_add(ctl + cwbase + 64 * part, 1u, __ATOMIC_RELAXED, __HIP_MEMORY_SCOPE_AGENT);
            __syncthreads();
            const unsigned unit = *slot;
            __syncthreads();
            if (unit >= (unsigned)PU_UNITS) break;
#pragma unroll 1
            for (int tt = 0; tt < 8; ++tt) {
                const int t = (int)unit * 64 + wv * 8 + tt;
                const int e0 = EXPI[(size_t)t * 128 + lane], e1 = EXPI[(size_t)t * 128 + 64 + lane];
                const bool in0 = (e0 >> 10) == part, in1 = (e1 >> 10) == part;
                const unsigned long long m0 = __ballot(in0), m1 = __ballot(in1);
                const int n0 = __popcll(m0), n = n0 + __popcll(m1);
                if (n == 0) continue;
                if (in0) { const int pos = (int)__builtin_amdgcn_mbcnt_hi((unsigned)(m0 >> 32), __builtin_amdgcn_mbcnt_lo((unsigned)m0, 0u)); le[pos] = e0; lj[pos] = lane; }
                if (in1) { const int pos = n0 + (int)__builtin_amdgcn_mbcnt_hi((unsigned)(m1 >> 32), __builtin_amdgcn_mbcnt_lo((unsigned)m1, 0u)); le[pos] = e1; lj[pos] = 64 + lane; }
                u32x4 xr[8];
                { const u32x4* xrow = (const u32x4*)(H + (size_t)t * 1024) + i;
#pragma unroll
                  for (int q = 0; q < 8; ++q) xr[q] = xrow[16 * q]; }
                LDS_WAIT(); asm volatile("" ::: "memory");
#pragma unroll 1
                for (int s = 0; 4 * s < n; ++s) {
                    const int idx = 4 * s + g; const bool valid = idx < n;
                    const int e = le[valid ? idx : 0];
                    const u32x4* ur = (const u32x4*)(U16 + (size_t)e * 1024) + i;
                    u32x4 ua[8];
#pragma unroll
                    for (int q = 0; q < 8; ++q) ua[q] = ur[16 * q];
                    float a0 = 0.f, a1 = 0.f, a2 = 0.f, a3 = 0.f;
#pragma unroll
                    for (int q = 0; q < 8; ++q) { a0 = dot2bf(ua[q].x, xr[q].x, a0); a1 = dot2bf(ua[q].y, xr[q].y, a1); a2 = dot2bf(ua[q].z, xr[q].z, a2); a3 = dot2bf(ua[q].w, xr[q].w, a3); }
                    const float a = row16_sum((a0 + a1) + (a2 + a3));
                    if (i == 0 && valid) { const size_t gi = (size_t)t * 128 + lj[idx]; __hip_atomic_store(CBUF + gi, gelu_erf(a) * GATE[gi], __ATOMIC_RELAXED, __HIP_MEMORY_SCOPE_AGENT); }
                }
                LDS_WAIT(); asm volatile("" ::: "memory");
            }
        }
    }
}

__device__ __forceinline__ void ph_peer_v(const Params& p, unsigned char* lds) {
    const bf16* V16 = (const bf16*)(p.ws + WS_V16);
    const int* EXPI = (const int*)(p.ws + WS_EXP); const float* GATE = (const float*)(p.ws + WS_CBUF); const float* MOD = (const float*)(p.ws + WS_MOD);
    unsigned* ctl = (unsigned*)(p.ws + WS_CTL);
    int tid = threadIdx.x; asm volatile("" : "+v"(tid));
    const int lane = tid & 63, wv = __builtin_amdgcn_readfirstlane(tid >> 6), g8 = lane >> 3, i8 = lane & 7;
    volatile LAS unsigned* slot = (volatile LAS unsigned*)(LAS unsigned char*)lds;
    int* le = (int*)(lds + 1024 + wv * 1024); float* lc = (float*)(le + 128);
    const unsigned xcc = peer_xcc();
#pragma unroll 1
    for (int k = 0; k < 16; ++k) {
        const int sl = (int)((2u * xcc + (unsigned)k) & 15u);
#pragma unroll 1
        for (;;) {
            if (tid == 0) *slot = __hip_atomic_fetch_add(ctl + CW_PEER_V + 64 * sl, 1u, __ATOMIC_RELAXED, __HIP_MEMORY_SCOPE_AGENT);
            __syncthreads();
            const unsigned unit = *slot;
            __syncthreads();
            if (unit >= (unsigned)PU_UNITS) break;
#pragma unroll 1
            for (int tt = 0; tt < 8; ++tt) {
                const int t = (int)unit * 64 + wv * 8 + tt;
                le[lane] = EXPI[(size_t)t * 128 + lane]; le[64 + lane] = EXPI[(size_t)t * 128 + 64 + lane];
                lc[lane] = GATE[(size_t)t * 128 + lane]; lc[64 + lane] = GATE[(size_t)t * 128 + 64 + lane];
                LDS_WAIT(); asm volatile("" ::: "memory");
                float acc[8];
#pragma unroll
                for (int q = 0; q < 8; ++q) acc[q] = 0.f;
                const bf16* vcol = V16 + 64 * sl + 8 * i8;
#pragma unroll
                for (int kk = 0; kk < 8; ++kk) {
                    const int ja = 8 * kk + g8, jb = 64 + 8 * kk + g8;
                    const u32x4 A = *(const u32x4*)(vcol + (size_t)le[ja] * 1024), B = *(const u32x4*)(vcol + (size_t)le[jb] * 1024);
                    const unsigned cp = pk2(lc[ja], lc[jb]);
                    acc[0] = dot2bf(__builtin_amdgcn_perm(B.x, A.x, 0x05040100u), cp, acc[0]); acc[1] = dot2bf(__builtin_amdgcn_perm(B.x, A.x, 0x07060302u), cp, acc[1]);
                    acc[2] = dot2bf(__builtin_amdgcn_perm(B.y, A.y, 0x05040100u), cp, acc[2]); acc[3] = dot2bf(__builtin_amdgcn_perm(B.y, A.y, 0x07060302u), cp, acc[3]);
                    acc[4] = dot2bf(__builtin_amdgcn_perm(B.z, A.z, 0x05040100u), cp, acc[4]); acc[5] = dot2bf(__builtin_amdgcn_perm(B.z, A.z, 0x07060302u), cp, acc[5]);
                    acc[6] = dot2bf(__builtin_amdgcn_perm(B.w, A.w, 0x05040100u), cp, acc[6]); acc[7] = dot2bf(__builtin_amdgcn_perm(B.w, A.w, 0x07060302u), cp, acc[7]);
                }
#pragma unroll
                for (int q = 0; q < 8; ++q) { acc[q] += dpp_f<0x128>(acc[q]); acc[q] += __shfl_xor(acc[q], 16); acc[q] += __shfl_xor(acc[q], 32); }
                if (g8 == 0) {
                    const int col = 64 * sl + 8 * i8;
                    const float* g2 = MOD + (size_t)(t >> 11) * 6144 + 5120 + col;
                    float* orow = p.out + (size_t)t * 1024 + col;
                    const f32x4 x0 = *(const f32x4*)orow, x1v = *(const f32x4*)(orow + 4), h0 = *(const f32x4*)g2, h1 = *(const f32x4*)(g2 + 4);
                    f32x4 r0, r1; r0.x = acc[0]; r0.y = acc[1]; r0.z = acc[2]; r0.w = acc[3]; r1.x = acc[4]; r1.y = acc[5]; r1.z = acc[6]; r1.w = acc[7];
                    *(f32x4*)orow = x0 + h0 * r0; *(f32x4*)(orow + 4) = x1v + h1 * r1;
                }
                LDS_WAIT(); asm volatile("" ::: "memory");
            }
        }
    }
}
typedef float f32x2_t __attribute__((ext_vector_type(2)));
constexpr int P8_UNITS = T / 64;
constexpr int CW_P8_U = 4096, CW_P8_V = 4096 + 32 * 64;
constexpr float U8_SCALE = 32.0f;

__device__ __forceinline__ void ph_peer_u8(const Params& p, unsigned char* lds) {
    const bf16* H = (const bf16*)(p.ws + WS_H); const unsigned char* U8 = (const unsigned char*)(p.ws + WS_U16);
    const int* EXPI = (const int*)(p.ws + WS_EXP); const float* GATE = (const float*)(p.ws + WS_GATE); float* CBUF = (float*)(p.ws + WS_CBUF);
    unsigned* ctl = (unsigned*)(p.ws + WS_CTL);
    int tid = threadIdx.x; asm volatile("" : "+v"(tid));
    const int lane = tid & 63, wv = __builtin_amdgcn_readfirstlane(tid >> 6), g = lane >> 4, i = lane & 15;
    volatile LAS unsigned* slot = (volatile LAS unsigned*)(LAS unsigned char*)lds;
    int* lw = (int*)(lds + 1024 + wv * 6144);
    int* myle = lw + g * 384; int* mylj = myle + 128; float* mylg = (float*)(myle + 256);
    const unsigned xcc = peer_xcc();
#pragma unroll 1
    for (int k = 0; k < 8; ++k) {
        const int part = (int)((xcc + (unsigned)k) & 7u);
#pragma unroll 1
        for (;;) {
            if (tid == 0) *slot = __hip_atomic_fetch_add(ctl + CW_P8_U + 64 * part, 1u, __ATOMIC_RELAXED, __HIP_MEMORY_SCOPE_AGENT);
            __syncthreads();
            const unsigned unit = *slot;
            __syncthreads();
            if (unit >= (unsigned)P8_UNITS) break;
#pragma unroll 1
            for (int rd = 0; rd < 2; ++rd) {
                const int tb4 = (int)unit * 64 + wv * 8 + rd * 4;
                u32x4 nx[8];
                { const u32x4* xrow = (const u32x4*)(H + (size_t)(tb4 + g) * 1024) + 2 * i;
#pragma unroll
                  for (int q = 0; q < 4; ++q) { nx[2 * q] = xrow[32 * q]; nx[2 * q + 1] = xrow[32 * q + 1]; } }
                int nmine = 0, nmax = 0;
#pragma unroll
                for (int q = 0; q < 4; ++q) {
                    const size_t tq = (size_t)(tb4 + q);
                    const int e0 = EXPI[tq * 128 + lane], e1 = EXPI[tq * 128 + 64 + lane];
                    const float g0 = GATE[tq * 128 + lane], g1 = GATE[tq * 128 + 64 + lane];
                    const bool in0 = (e0 >> 11) == part, in1 = (e1 >> 11) == part;
                    const unsigned long long m0 = __ballot(in0), m1 = __ballot(in1);
                    const int n0 = __popcll(m0), n = n0 + __popcll(m1);
                    int* qle = lw + q * 384;
                    if (in0) { const int pos = (int)__builtin_amdgcn_mbcnt_hi((unsigned)(m0 >> 32), __builtin_amdgcn_mbcnt_lo((unsigned)m0, 0u)); qle[pos] = e0; qle[128 + pos] = lane; ((float*)qle)[256 + pos] = g0; }
                    if (in1) { const int pos = n0 + (int)__builtin_amdgcn_mbcnt_hi((unsigned)(m1 >> 32), __builtin_amdgcn_mbcnt_lo((unsigned)m1, 0u)); qle[pos] = e1; qle[128 + pos] = 64 + lane; ((float*)qle)[256 + pos] = g1; }
                    nmine = (g == q) ? n : nmine; nmax = n > nmax ? n : nmax;
                }
                float xf[64];
#pragma unroll
                for (int q = 0; q < 8; ++q) { xf[8 * q] = bflo(nx[q].x); xf[8 * q + 1] = bfhi(nx[q].x); xf[8 * q + 2] = bflo(nx[q].y); xf[8 * q + 3] = bfhi(nx[q].y);
                    xf[8 * q + 4] = bflo(nx[q].z); xf[8 * q + 5] = bfhi(nx[q].z); xf[8 * q + 6] = bflo(nx[q].w); xf[8 * q + 7] = bfhi(nx[q].w); }
                LDS_WAIT(); asm volatile("" ::: "memory");
                const size_t cb = (size_t)(tb4 + g) * 128;
#define U8_LOAD(R, S) do { const int s_ = (S); const int e_ = (s_ < nmine) ? myle[s_] : 0; const u32x4* r_ = (const u32x4*)(U8 + (size_t)e_ * 1024) + i;                     \
        _Pragma("unroll") for (int q = 0; q < 4; ++q) R[q] = r_[16 * q]; } while (0)
#define U8_DOT(R, S) do { const int s_ = (S); float a0 = 0.f, a1 = 0.f, a2 = 0.f, a3 = 0.f;                                                            \
        _Pragma("unroll") for (int q = 0; q < 4; ++q) { const unsigned w_[4] = {R[q].x, R[q].y, R[q].z, R[q].w};                                           \
            _Pragma("unroll") for (int c = 0; c < 4; ++c) { const f32x2_t lo = __builtin_amdgcn_cvt_pk_f32_fp8((int)w_[c], false), hi = __builtin_amdgcn_cvt_pk_f32_fp8((int)w_[c], true); \
                a0 = fmaf(lo.x, xf[16 * q + 4 * c], a0); a1 = fmaf(lo.y, xf[16 * q + 4 * c + 1], a1); a2 = fmaf(hi.x, xf[16 * q + 4 * c + 2], a2); a3 = fmaf(hi.y, xf[16 * q + 4 * c + 3], a3); } } \
        const float a_ = row16_sum((a0 + a1) + (a2 + a3)) * (1.0f / U8_SCALE);                                                                         \
        if (i == 0 && s_ < nmine) __hip_atomic_store(CBUF + cb + mylj[s_], gelu_erf(a_) * mylg[s_], __ATOMIC_RELAXED, __HIP_MEMORY_SCOPE_AGENT); } while (0)
                u32x4 RA[4], RB[4], RC[4], RD[4];
                U8_LOAD(RA, 0); U8_LOAD(RB, 1); U8_LOAD(RC, 2);
#pragma unroll 1
                for (int s = 0; s < nmax; s += 4) {
                    U8_LOAD(RD, s + 3); U8_DOT(RA, s);
                    if (s + 1 < nmax) { U8_LOAD(RA, s + 4); U8_DOT(RB, s + 1); }
                    if (s + 2 < nmax) { U8_LOAD(RB, s + 5); U8_DOT(RC, s + 2); }
                    if (s + 3 < nmax) { U8_LOAD(RC, s + 6); U8_DOT(RD, s + 3); }
                }
#undef U8_LOAD
#undef U8_DOT
                LDS_WAIT(); asm volatile("" ::: "memory");
            }
        }
    }
}

__device__ __forceinline__ void ph_peer_v8(const Params& p, unsigned char* lds) {
    const unsigned char* V8 = (const unsigned char*)(p.ws + WS_V16);
    const int* EXPI = (const int*)(p.ws + WS_EXP); const float* CBUF = (const float*)(p.ws + WS_CBUF); const float* MOD = (const float*)(p.ws + WS_MOD);
    unsigned* ctl = (unsigned*)(p.ws + WS_CTL);
    int tid = threadIdx.x; asm volatile("" : "+v"(tid));
    const int lane = tid & 63, wv = __builtin_amdgcn_readfirstlane(tid >> 6), g8 = lane >> 3, i8 = lane & 7;
    volatile LAS unsigned* slot = (volatile LAS unsigned*)(LAS unsigned char*)lds;
    int* le0 = (int*)(lds + 1024 + wv * 2048); float* lc0 = (float*)(le0 + 128); int* le1 = le0 + 256; float* lc1 = (float*)(le0 + 384);
    const unsigned xcc = peer_xcc();
#pragma unroll 1
    for (int k = 0; k < 8; ++k) {
        const int sl = (int)((xcc + (unsigned)k) & 7u);
        const unsigned char* vcol = V8 + 128 * sl + 16 * i8;
#pragma unroll 1
        for (;;) {
            if (tid == 0) *slot = __hip_atomic_fetch_add(ctl + CW_P8_V + 64 * sl, 1u, __ATOMIC_RELAXED, __HIP_MEMORY_SCOPE_AGENT);
            __syncthreads();
            const unsigned unit = *slot;
            __syncthreads();
            if (unit >= (unsigned)P8_UNITS) break;
            const int tbase = (int)unit * 64 + wv * 8;
            int ne0, ne1; float nc0, nc1;
#define V8_FETCH(T) do { const size_t tn_ = (size_t)(T); ne0 = EXPI[tn_ * 128 + lane]; ne1 = EXPI[tn_ * 128 + 64 + lane]; nc0 = CBUF[tn_ * 128 + lane]; nc1 = CBUF[tn_ * 128 + 64 + lane]; } while (0)
#define V8_LISTS(LE, LC) do { LE[lane] = ne0; LE[64 + lane] = ne1; LC[lane] = nc0; LC[64 + lane] = nc1; } while (0)
#define V8_ROWS(R, LE, HH) do { _Pragma("unroll") for (int kk = 0; kk < 8; ++kk) R[kk] = *(const u32x4*)(vcol + (size_t)LE[8 * (8 * (HH) + kk) + g8] * 1024); } while (0)
#define V8_HALF(R, LC, HH) do { _Pragma("unroll") for (int kk = 0; kk < 8; ++kk) { const float cj = LC[8 * (8 * (HH) + kk) + g8];               \
            const unsigned w_[4] = {R[kk].x, R[kk].y, R[kk].z, R[kk].w};                                                                       \
            _Pragma("unroll") for (int c = 0; c < 4; ++c) { const f32x2_t lo = __builtin_amdgcn_cvt_pk_f32_fp8((int)w_[c], false), hi = __builtin_amdgcn_cvt_pk_f32_fp8((int)w_[c], true); \
                acc[4 * c] = fmaf(cj, lo.x, acc[4 * c]); acc[4 * c + 1] = fmaf(cj, lo.y, acc[4 * c + 1]); acc[4 * c + 2] = fmaf(cj, hi.x, acc[4 * c + 2]); acc[4 * c + 3] = fmaf(cj, hi.y, acc[4 * c + 3]); } } } while (0)
            u32x4 RA[8], RB[8];
            int* lecur = (int*)(lds + 1024 + wv * 2048); int* lenxt = lecur + 256;
            V8_FETCH(tbase); V8_LISTS(lecur, ((float*)(lecur + 128))); V8_FETCH(tbase + 1);
            LDS_WAIT(); asm volatile("" ::: "memory");
            V8_ROWS(RA, lecur, 0);
#pragma unroll 1
            for (int tt = 0; tt < 8; ++tt) {
                const int t = tbase + tt;
                float* lccur = (float*)(lecur + 128); float* lcnxt = (float*)(lenxt + 128);
                float acc[16];
#pragma unroll
                for (int q = 0; q < 16; ++q) acc[q] = 0.f;
                V8_ROWS(RB, lecur, 1);
                if (tt + 1 < 8) { V8_LISTS(lenxt, lcnxt); if (tt + 2 < 8) V8_FETCH(t + 2); }
                V8_HALF(RA, lccur, 0);
                LDS_WAIT(); asm volatile("" ::: "memory");
                if (tt + 1 < 8) V8_ROWS(RA, lenxt, 0);
                V8_HALF(RB, lccur, 1);
#pragma unroll
                for (int q = 0; q < 16; ++q) { acc[q] += dpp_f<0x128>(acc[q]); acc[q] += __shfl_xor(acc[q], 16); acc[q] += __shfl_xor(acc[q], 32); }
                if (g8 == 0) { const int col = 128 * sl + 16 * i8; const float* g2 = MOD + (size_t)(t >> 11) * 6144 + 5120 + col; float* orow = p.out + (size_t)t * 1024 + col;
#pragma unroll
                    for (int q = 0; q < 4; ++q) { const f32x4 xv = *(const f32x4*)(orow + 4 * q), hv = *(const f32x4*)(g2 + 4 * q);
                        f32x4 r; r.x = acc[4 * q]; r.y = acc[4 * q + 1]; r.z = acc[4 * q + 2]; r.w = acc[4 * q + 3]; *(f32x4*)(orow + 4 * q) = xv + hv * r; } }
                { int* tmp_ = lecur; lecur = lenxt; lenxt = tmp_; }
            }
#undef V8_FETCH
#undef V8_LISTS
#undef V8_ROWS
#undef V8_HALF
            LDS_WAIT(); asm volatile("" ::: "memory");
        }
    }
}
#ifndef U8_PARTS
#define U8_PARTS 1
#endif
#define U8_SHIFT (U8_PARTS == 1 ? 14 : (U8_PARTS == 2 ? 13 : (U8_PARTS == 4 ? 12 : (U8_PARTS == 8 ? 11 : (U8_PARTS == 16 ? 10 : 9)))))
__device__ __forceinline__ void ph_peer_u8_old(const Params& p, unsigned char* lds) {
    const bf16* H = (const bf16*)(p.ws + WS_H); const unsigned char* U8 = (const unsigned char*)(p.ws + WS_U16);
    const int* EXPI = (const int*)(p.ws + WS_EXP); const float* GATE = (const float*)(p.ws + WS_GATE); float* CBUF = (float*)(p.ws + WS_CBUF);
    unsigned* ctl = (unsigned*)(p.ws + WS_CTL);
    int tid = threadIdx.x; asm volatile("" : "+v"(tid));
    const int lane = tid & 63, wv = __builtin_amdgcn_readfirstlane(tid >> 6), g = lane >> 4, i = lane & 15;
    volatile LAS unsigned* slot = (volatile LAS unsigned*)(LAS unsigned char*)lds;
    int* le = (int*)(lds + 1024 + wv * 2048); int* lj = le + 128; float* lg = (float*)(le + 256);
    const unsigned xcc = peer_xcc();
#pragma unroll 1
    for (int k = 0; k < U8_PARTS; ++k) {
        const int part = (int)((((xcc * U8_PARTS) >> 3) + (unsigned)k) & (unsigned)(U8_PARTS - 1));
#pragma unroll 1
        for (;;) {
            if (tid == 0) *slot = __hip_atomic_fetch_add(ctl + CW_P8_U + 64 * part, 1u, __ATOMIC_RELAXED, __HIP_MEMORY_SCOPE_AGENT);
            __syncthreads();
            const unsigned unit = *slot;
            __syncthreads();
            if (unit >= (unsigned)P8_UNITS) break;
            const int tbase = (int)unit * 64 + wv * 8;
            int ne0 = EXPI[(size_t)tbase * 128 + lane], ne1 = EXPI[(size_t)tbase * 128 + 64 + lane];
            float ng0 = GATE[(size_t)tbase * 128 + lane], ng1 = GATE[(size_t)tbase * 128 + 64 + lane];
            u32x4 nx[8];
            { const u32x4* xrow = (const u32x4*)(H + (size_t)tbase * 1024) + 2 * i;
#pragma unroll
              for (int q = 0; q < 4; ++q) { nx[2 * q] = xrow[32 * q]; nx[2 * q + 1] = xrow[32 * q + 1]; } }
#pragma unroll 1
            for (int tt = 0; tt < 8; ++tt) {
                const int t = tbase + tt;
                const int e0 = ne0, e1 = ne1; const float g0 = ng0, g1 = ng1;
                float xf[64];
#pragma unroll
                for (int q = 0; q < 8; ++q) { xf[8 * q] = bflo(nx[q].x); xf[8 * q + 1] = bfhi(nx[q].x); xf[8 * q + 2] = bflo(nx[q].y); xf[8 * q + 3] = bfhi(nx[q].y);
                    xf[8 * q + 4] = bflo(nx[q].z); xf[8 * q + 5] = bfhi(nx[q].z); xf[8 * q + 6] = bflo(nx[q].w); xf[8 * q + 7] = bfhi(nx[q].w); }
                if (tt + 1 < 8) { const size_t tn = (size_t)(t + 1);
                    ne0 = EXPI[tn * 128 + lane]; ne1 = EXPI[tn * 128 + 64 + lane]; ng0 = GATE[tn * 128 + lane]; ng1 = GATE[tn * 128 + 64 + lane];
                    const u32x4* xrow = (const u32x4*)(H + tn * 1024) + 2 * i;
#pragma unroll
                    for (int q = 0; q < 4; ++q) { nx[2 * q] = xrow[32 * q]; nx[2 * q + 1] = xrow[32 * q + 1]; } }
                const bool in0 = (e0 >> U8_SHIFT) == part, in1 = (e1 >> U8_SHIFT) == part;
                const unsigned long long m0 = __ballot(in0), m1 = __ballot(in1);
                const int n0 = __popcll(m0), n = n0 + __popcll(m1);
                if (in0) { const int pos = (int)__builtin_amdgcn_mbcnt_hi((unsigned)(m0 >> 32), __builtin_amdgcn_mbcnt_lo((unsigned)m0, 0u)); le[pos] = e0; lj[pos] = lane; lg[pos] = g0; }
                if (in1) { const int pos = n0 + (int)__builtin_amdgcn_mbcnt_hi((unsigned)(m1 >> 32), __builtin_amdgcn_mbcnt_lo((unsigned)m1, 0u)); le[pos] = e1; lj[pos] = 64 + lane; lg[pos] = g1; }
                LDS_WAIT(); asm volatile("" ::: "memory");
#pragma unroll 1
                for (int s = 0; 4 * s < n; s += 2) {
                    const int idxA = 4 * s + g, idxB = idxA + 4; const bool vA = idxA < n, vB = idxB < n;
                    const u32x4* ra = (const u32x4*)(U8 + (size_t)le[vA ? idxA : 0] * 1024) + i;
                    const u32x4* rb = (const u32x4*)(U8 + (size_t)le[vB ? idxB : 0] * 1024) + i;
                    u32x4 A[4], B[4];
#pragma unroll
                    for (int q = 0; q < 4; ++q) A[q] = ra[16 * q];
#pragma unroll
                    for (int q = 0; q < 4; ++q) B[q] = rb[16 * q];
#define P8_DOT(R, OUT) do { float a0 = 0.f, a1 = 0.f, a2 = 0.f, a3 = 0.f;                                                           \
    _Pragma("unroll") for (int q = 0; q < 4; ++q) {                                                                                   \
        const unsigned w_[4] = {R[q].x, R[q].y, R[q].z, R[q].w};                                                                      \
        _Pragma("unroll") for (int c = 0; c < 4; ++c) { const f32x2_t lo = __builtin_amdgcn_cvt_pk_f32_fp8((int)w_[c], false), hi = __builtin_amdgcn_cvt_pk_f32_fp8((int)w_[c], true); \
            a0 = fmaf(lo.x, xf[16 * q + 4 * c], a0); a1 = fmaf(lo.y, xf[16 * q + 4 * c + 1], a1); a2 = fmaf(hi.x, xf[16 * q + 4 * c + 2], a2); a3 = fmaf(hi.y, xf[16 * q + 4 * c + 3], a3); } } \
    OUT = row16_sum((a0 + a1) + (a2 + a3)) * (1.0f / U8_SCALE); } while (0)
                    float aA, aB;
                    P8_DOT(A, aA); P8_DOT(B, aB);
#undef P8_DOT
                    if (i == 0 && vA) __hip_atomic_store(CBUF + (size_t)t * 128 + lj[idxA], gelu_erf(aA) * lg[idxA], __ATOMIC_RELAXED, __HIP_MEMORY_SCOPE_AGENT);
                    if (i == 0 && vB) __hip_atomic_store(CBUF + (size_t)t * 128 + lj[idxB], gelu_erf(aB) * lg[idxB], __ATOMIC_RELAXED, __HIP_MEMORY_SCOPE_AGENT);
                }
                LDS_WAIT(); asm volatile("" ::: "memory");
            }
        }
    }
}

__device__ __forceinline__ void ph_peer_v8_old(const Params& p, unsigned char* lds) {
    const unsigned char* V8 = (const unsigned char*)(p.ws + WS_V16);
    const int* EXPI = (const int*)(p.ws + WS_EXP); const float* CBUF = (const float*)(p.ws + WS_CBUF); const float* MOD = (const float*)(p.ws + WS_MOD);
    unsigned* ctl = (unsigned*)(p.ws + WS_CTL);
    int tid = threadIdx.x; asm volatile("" : "+v"(tid));
    const int lane = tid & 63, wv = __builtin_amdgcn_readfirstlane(tid >> 6), g8 = lane >> 3, i8 = lane & 7;
    volatile LAS unsigned* slot = (volatile LAS unsigned*)(LAS unsigned char*)lds;
    int* le = (int*)(lds + 1024 + wv * 2048); float* lc = (float*)(le + 128);
    const unsigned xcc = peer_xcc();
#pragma unroll 1
    for (int k = 0; k < 8; ++k) {
        const int sl = (int)((xcc + (unsigned)k) & 7u);
#pragma unroll 1
        for (;;) {
            if (tid == 0) *slot = __hip_atomic_fetch_add(ctl + CW_P8_V + 64 * sl, 1u, __ATOMIC_RELAXED, __HIP_MEMORY_SCOPE_AGENT);
            __syncthreads();
            const unsigned unit = *slot;
            __syncthreads();
            if (unit >= (unsigned)P8_UNITS) break;
            const int tbase = (int)unit * 64 + wv * 8;
            int ne0 = EXPI[(size_t)tbase * 128 + lane], ne1 = EXPI[(size_t)tbase * 128 + 64 + lane];
            float nc0 = CBUF[(size_t)tbase * 128 + lane], nc1 = CBUF[(size_t)tbase * 128 + 64 + lane];
#pragma unroll 1
            for (int tt = 0; tt < 8; ++tt) {
                const int t = tbase + tt;
                le[lane] = ne0; le[64 + lane] = ne1; lc[lane] = nc0; lc[64 + lane] = nc1;
                if (tt + 1 < 8) { const size_t tn = (size_t)(t + 1); ne0 = EXPI[tn * 128 + lane]; ne1 = EXPI[tn * 128 + 64 + lane]; nc0 = CBUF[tn * 128 + lane]; nc1 = CBUF[tn * 128 + 64 + lane]; }
                LDS_WAIT(); asm volatile("" ::: "memory");
                const unsigned char* vcol = V8 + 128 * sl + 16 * i8;
                u32x4 R[16];
#pragma unroll
                for (int kk = 0; kk < 16; ++kk) R[kk] = *(const u32x4*)(vcol + (size_t)le[8 * kk + g8] * 1024);
                float acc[16];
#pragma unroll
                for (int q = 0; q < 16; ++q) acc[q] = 0.f;
#pragma unroll
                for (int kk = 0; kk < 16; ++kk) {
                    const float cj = lc[8 * kk + g8];
                    const unsigned w_[4] = {R[kk].x, R[kk].y, R[kk].z, R[kk].w};
#pragma unroll
                    for (int c = 0; c < 4; ++c) { const f32x2_t lo = __builtin_amdgcn_cvt_pk_f32_fp8((int)w_[c], false), hi = __builtin_amdgcn_cvt_pk_f32_fp8((int)w_[c], true);
                        acc[4 * c] = fmaf(cj, lo.x, acc[4 * c]); acc[4 * c + 1] = fmaf(cj, lo.y, acc[4 * c + 1]); acc[4 * c + 2] = fmaf(cj, hi.x, acc[4 * c + 2]); acc[4 * c + 3] = fmaf(cj, hi.y, acc[4 * c + 3]); }
                }
#pragma unroll
                for (int q = 0; q < 16; ++q) { acc[q] += dpp_f<0x128>(acc[q]); acc[q] += __shfl_xor(acc[q], 16); acc[q] += __shfl_xor(acc[q], 32); }
                if (g8 == 0) {
                    const int col = 128 * sl + 16 * i8;
                    const float* g2 = MOD + (size_t)(t >> 11) * 6144 + 5120 + col;
                    float* orow = p.out + (size_t)t * 1024 + col;
#pragma unroll
                    for (int q = 0; q < 4; ++q) { const f32x4 xv = *(const f32x4*)(orow + 4 * q), hv = *(const f32x4*)(g2 + 4 * q);
                        f32x4 r; r.x = acc[4 * q]; r.y = acc[4 * q + 1]; r.z = acc[4 * q + 2]; r.w = acc[4 * q + 3];
                        *(f32x4*)(orow + 4 * q) = xv + hv * r; }
                }
                LDS_WAIT(); asm volatile("" ::: "memory");
            }
        }
    }
}
__device__ __forceinline__ void ph_dsa_old(const Params& p, unsigned char* lds, int vb, int nvb) {
    const bf16* PROJ = (const bf16*)(p.ws + WS_PROJ); bf16* MIX = (bf16*)(p.ws + WS_MIX);
    const float MB = ((const float*)(p.ws + WS_SCAL))[SC_MB];
    int tid = threadIdx.x; asm volatile("" : "+v"(tid)); const int lane = tid & 63, wv = __builtin_amdgcn_readfirstlane(tid >> 6);
    const int l15 = lane & 15, g = lane >> 4;
    LAS unsigned char* ldsl = (LAS unsigned char*)lds;
    for (int it = vb; it < 2048; it += nvb) {
        const int vbb = it & 255, kk = it >> 8, xg = vbb & 7, ix = vbb >> 3, b = 2 * xg + (ix & 1), G = (ix >> 1) & 3, sub = ix >> 3;
        const int c = (kk & 1) ? (31 - G - 8 * (kk >> 1)) : (G + 8 * (kk >> 1));
        const int cend = (c + 1) * 64, t0 = c * 64 + sub * 16;
        const bf16* Pb = PROJ + (size_t)b * SEQ * NP;
        if (c >= 4) {
            const bf16* qrow = Pb + (size_t)(t0 + l15) * NP;
            bf16x8 bq[4][2]; float wsc[4];
#pragma unroll
            for (int h = 0; h < 4; ++h) { wsc[h] = bf2f(qrow[C_WI + h]) * 0.0625f;
#pragma unroll
                for (int ks = 0; ks < 2; ++ks) bq[h][ks] = *(const bf16x8*)(qrow + C_QI + h * 64 + 32 * ks + 8 * g); }
            for (int k0 = 16 * wv; k0 < cend; k0 += 128) {
                const bf16* krow = Pb + (size_t)(k0 + l15) * NP + C_KI + 8 * g;
                const bf16x8 ka0 = *(const bf16x8*)krow, ka1 = *(const bf16x8*)(krow + 32);
                f32x4 sc = {0.f, 0.f, 0.f, 0.f};
#pragma unroll
                for (int h = 0; h < 4; ++h) { f32x4 a = {0.f, 0.f, 0.f, 0.f};
                    a = __builtin_amdgcn_mfma_f32_16x16x32_bf16(ka0, bq[h][0], a, 0, 0, 0);
                    a = __builtin_amdgcn_mfma_f32_16x16x32_bf16(ka1, bq[h][1], a, 0, 0, 0);
#pragma unroll
                    for (int r = 0; r < 4; ++r) sc[r] = fmaf(fmaxf(a[r], 0.f), wsc[h], sc[r]); }
#pragma unroll
                for (int r = 0; r < 4; ++r) sc[r] = (sc[r] == 0.f) ? 0.f : sc[r];
                *(LAS f32x4*)(ldsl + l15 * DSA_SROW + (k0 + 4 * g) * 4) = sc;
            }
        }
        __syncthreads();
        LAS unsigned short* selw = (LAS unsigned short*)(ldsl + DSA_SEL_OFF);
        int mind0 = 0, mind1 = 0;
#pragma unroll 1
        for (int qi = 0; qi < 2; ++qi) {
            const int qq = 2 * wv + qi, t = t0 + qq;
            LAS unsigned short* sel = selw + qq * 256;
            if (c < 4) { for (int j = lane; j < 256; j += 64) sel[j] = (unsigned short)j; continue; }
            const int nreg = cend >> 6;
            unsigned key[32];
            const LAS float* srow = (const LAS float*)(ldsl + qq * DSA_SROW) + lane;
#pragma unroll
            for (int i = 0; i < 32; ++i) key[i] = (i < nreg) ? sortkey(srow[64 * i]) : 0u;
            unsigned prefix = 0u; bool exact = false;
#pragma unroll 1
            for (int bit = 31; bit >= 0; --bit) {
                const unsigned cand = prefix | (1u << bit); int cnt = 0;
#pragma unroll
                for (int i = 0; i < 32; ++i) cnt += __popcll(__ballot(key[i] >= cand));
                if (cnt >= 256) { prefix = cand; if (cnt == 256) { exact = true; break; } }
            }
            int need_ties = 0;
            if (!exact) { int cgt = 0;
                if (prefix != 0xffffffffu) {
#pragma unroll
                    for (int i = 0; i < 32; ++i) cgt += __popcll(__ballot(key[i] > prefix)); }
                need_ties = 256 - cgt; }
            int base = 0, tbase = 0, md = 4096;
#pragma unroll
            for (int i = 0; i < 32; ++i) {
                if (i < nreg) {
                    bool selb;
                    if (exact) selb = key[i] >= prefix;
                    else { const bool tie = key[i] == prefix; const unsigned long long mt = __ballot(tie);
                        const int trank = tbase + (int)__builtin_amdgcn_mbcnt_hi((unsigned)(mt >> 32), __builtin_amdgcn_mbcnt_lo((unsigned)mt, 0u));
                        selb = (key[i] > prefix) || (tie && trank < need_ties); tbase += __popcll(mt); }
                    const unsigned long long m = __ballot(selb);
                    const int pos = base + (int)__builtin_amdgcn_mbcnt_hi((unsigned)(m >> 32), __builtin_amdgcn_mbcnt_lo((unsigned)m, 0u));
                    const int kidx = i * 64 + lane;
                    if (selb) { sel[pos] = (unsigned short)kidx; const int d = t > kidx ? t - kidx : kidx - t; md = d < md ? d : md; }
                    base += __popcll(m);
                }
            }
#pragma unroll
            for (int o = 1; o < 64; o <<= 1) { const int x = __shfl_xor(md, o); md = x < md ? x : md; }
            if (qi == 0) mind0 = md; else mind1 = md;
        }
        LDS_WAIT(); asm volatile("" ::: "memory");
        const int nvalid = cend < 256 ? cend : 256;
        const int head = lane & 7;
        const float slopeL2 = exp2f(-(float)(head + 1)) * 1.4426950409f;
#pragma unroll 1
        for (int qi = 0; qi < 2; ++qi) {
            const int qq = 2 * wv + qi, t = t0 + qq;
            const LAS unsigned short* sel = selw + qq * 256;
            LAS unsigned char* stg = ldsl + (2 * wv) * DSA_SROW;
            const bf16* qrow = Pb + (size_t)t * NP + C_QB + head * 128 + 8 * g;
            bf16x8 bq[4];
#pragma unroll
            for (int ks = 0; ks < 4; ++ks) bq[ks] = *(const bf16x8*)(qrow + 32 * ks);
            const float refL2 = MB * 1.4426950409f - slopeL2 * (float)(qi == 0 ? mind0 : mind1);
            f32x4 o[8];
#pragma unroll
            for (int dt = 0; dt < 8; ++dt) o[dt] = (f32x4){0.f, 0.f, 0.f, 0.f};
            float lsum = 0.f;
#pragma unroll 1
            for (int s = 0; s < 8; ++s) {
                if (32 * s >= nvalid) break;
                unsigned pb[4];
#pragma unroll
                for (int tl = 0; tl < 2; ++tl) {
                    const int j0 = 32 * s + 16 * tl;
                    const int jr = j0 + l15; const int keyr = sel[jr < nvalid ? jr : 0];
                    const bf16* kvrow = Pb + (size_t)keyr * NP + C_KV + 8 * g;
                    bf16x8 ka[4];
#pragma unroll
                    for (int ks = 0; ks < 4; ++ks) ka[ks] = *(const bf16x8*)(kvrow + 32 * ks);
                    f32x4 a = {0.f, 0.f, 0.f, 0.f};
#pragma unroll
                    for (int ks = 0; ks < 4; ++ks) { a = __builtin_amdgcn_mfma_f32_16x16x32_bf16(ka[ks], bq[ks], a, 0, 0, 0);
                        *(LAS bf16x8*)(stg + (16 * tl + l15) * DSA_KVROW + (32 * ks + 8 * g) * 2) = ka[ks]; }
                    const u32x2 kw = *(const LAS u32x2*)(sel + j0 + 4 * g);
                    const int kx[4] = {(int)(kw.x & 0xffffu), (int)(kw.x >> 16), (int)(kw.y & 0xffffu), (int)(kw.y >> 16)};
                    float pr[4];
#pragma unroll
                    for (int r = 0; r < 4; ++r) { const int dd = t > kx[r] ? t - kx[r] : kx[r] - t;
                        const float e = __builtin_amdgcn_exp2f(fmaf(a[r], 0.1275174f, -slopeL2 * (float)dd - refL2));
                        pr[r] = (j0 + 4 * g + r < nvalid) ? e : 0.f; lsum += pr[r]; }
                    pb[2 * tl] = cvtpk_bf16(pr[0], pr[1]); pb[2 * tl + 1] = cvtpk_bf16(pr[2], pr[3]);
                }
                LDS_WAIT(); asm volatile("" ::: "memory");
                u32x4 pw4; pw4.x = pb[0]; pw4.y = pb[1]; pw4.z = pb[2]; pw4.w = pb[3];
                const bf16x8 pfrag = __builtin_bit_cast(bf16x8, pw4);
                const LAS unsigned char* trb = stg + (4 * g + (l15 >> 2)) * DSA_KVROW + (4 * (lane & 3)) * 2;
#pragma unroll
                for (int dt = 0; dt < 8; ++dt) {
                    const s16x4 lo = __builtin_bit_cast(s16x4, __builtin_amdgcn_ds_read_tr16_b64_v4i16((LAS v4i16_t*)(trb + dt * 32)));
                    const s16x4 hi = __builtin_bit_cast(s16x4, __builtin_amdgcn_ds_read_tr16_b64_v4i16((LAS v4i16_t*)(trb + 16 * DSA_KVROW + dt * 32)));
                    const bf16x8 af = {lo[0], lo[1], lo[2], lo[3], hi[0], hi[1], hi[2], hi[3]};
                    o[dt] = __builtin_amdgcn_mfma_f32_16x16x32_bf16(af, pfrag, o[dt], 0, 0, 0);
                }
                LDS_WAIT(); asm volatile("" ::: "memory");
            }
            lsum += __shfl_xor(lsum, 16); lsum += __shfl_xor(lsum, 32);
            const float il = 1.f / lsum;
            if (l15 < 8) {
                bf16* orow = MIX + (size_t)(b * SEQ + t) * MIXW + 512 + head * 128 + 4 * g;
#pragma unroll
                for (int dt = 0; dt < 8; ++dt) { u32x2 w; w.x = pk2(o[dt][0] * il, o[dt][1] * il); w.y = pk2(o[dt][2] * il, o[dt][3] * il); *(u32x2*)(orow + 16 * dt) = w; }
            }
        }
        __syncthreads();
    }
}
__device__ __forceinline__ void ph_peer8t(const Params& p, unsigned char* lds_w, int gw, int ngw, int lane_) {
    int lane = lane_; asm volatile("" : "+v"(lane));
    const bf16* H = (const bf16*)(p.ws + WS_H); const unsigned char* U8 = (const unsigned char*)(p.ws + WS_U16); const unsigned char* V8 = (const unsigned char*)(p.ws + WS_V16);
    const int* EXPI = (const int*)(p.ws + WS_EXP); const float* GATE = (const float*)(p.ws + WS_GATE); const float* MOD = (const float*)(p.ws + WS_MOD);
    int* e_lds = (int*)lds_w; float* a_lds = (float*)(lds_w + 512);
    const int g = lane >> 4, i = lane & 15;
#pragma unroll 1
    for (int t = gw; t < T; t += ngw) {
        const int e0 = EXPI[(size_t)t * 128 + lane], e1 = EXPI[(size_t)t * 128 + 64 + lane];
        const float g0 = GATE[(size_t)t * 128 + lane], g1 = GATE[(size_t)t * 128 + 64 + lane];
        e_lds[lane] = e0; e_lds[64 + lane] = e1;
        float xf[64];
        { const u32x4* xrow = (const u32x4*)(H + (size_t)t * 1024) + 2 * i;
#pragma unroll
          for (int q = 0; q < 4; ++q) { const u32x4 a = xrow[32 * q], b = xrow[32 * q + 1];
              xf[16 * q] = bflo(a.x); xf[16 * q + 1] = bfhi(a.x); xf[16 * q + 2] = bflo(a.y); xf[16 * q + 3] = bfhi(a.y); xf[16 * q + 4] = bflo(a.z); xf[16 * q + 5] = bfhi(a.z); xf[16 * q + 6] = bflo(a.w); xf[16 * q + 7] = bfhi(a.w);
              xf[16 * q + 8] = bflo(b.x); xf[16 * q + 9] = bfhi(b.x); xf[16 * q + 10] = bflo(b.y); xf[16 * q + 11] = bfhi(b.y); xf[16 * q + 12] = bflo(b.z); xf[16 * q + 13] = bfhi(b.z); xf[16 * q + 14] = bflo(b.w); xf[16 * q + 15] = bfhi(b.w); } }
        LDS_WAIT(); asm volatile("" ::: "memory");
#define P8T_ULOAD(R, S) do { const u32x4* r_ = (const u32x4*)(U8 + (size_t)e_lds[4 * (S) + g] * 1024) + i; _Pragma("unroll") for (int q = 0; q < 4; ++q) R[q] = r_[16 * q]; } while (0)
#define P8T_UDOT(R, S) do { float a0 = 0.f, a1 = 0.f, a2 = 0.f, a3 = 0.f;                                                                               \
        _Pragma("unroll") for (int q = 0; q < 4; ++q) { const unsigned w_[4] = {R[q].x, R[q].y, R[q].z, R[q].w};                                           \
            _Pragma("unroll") for (int c = 0; c < 4; ++c) { const f32x2_t lo = __builtin_amdgcn_cvt_pk_f32_fp8((int)w_[c], false), hi = __builtin_amdgcn_cvt_pk_f32_fp8((int)w_[c], true); \
                a0 = fmaf(lo.x, xf[16 * q + 4 * c], a0); a1 = fmaf(lo.y, xf[16 * q + 4 * c + 1], a1); a2 = fmaf(hi.x, xf[16 * q + 4 * c + 2], a2); a3 = fmaf(hi.y, xf[16 * q + 4 * c + 3], a3); } } \
        const float a_ = row16_sum((a0 + a1) + (a2 + a3)) * (1.0f / U8_SCALE); if (i == 0) a_lds[4 * (S) + g] = a_; } while (0)
        { u32x4 RA[4], RB[4], RC[4];
          P8T_ULOAD(RA, 0); P8T_ULOAD(RB, 1);
#pragma unroll 1
          for (int s = 0; s < 30; s += 3) {
              P8T_ULOAD(RC, s + 2); P8T_UDOT(RA, s);
              P8T_ULOAD(RA, s + 3); P8T_UDOT(RB, s + 1);
              P8T_ULOAD(RB, s + 4); P8T_UDOT(RC, s + 2);
          }
          P8T_UDOT(RA, 30); P8T_UDOT(RB, 31); }
#undef P8T_ULOAD
#undef P8T_UDOT
        LDS_WAIT(); asm volatile("" ::: "memory");
        const float c0 = gelu_erf(a_lds[lane]) * g0, c1 = gelu_erf(a_lds[64 + lane]) * g1;
        float acc[16];
#pragma unroll
        for (int q = 0; q < 16; ++q) acc[q] = 0.f;
#define P8T_VLOAD(R, J) do { _Pragma("unroll") for (int k_ = 0; k_ < 4; ++k_) { const int j_ = (J) + k_; const int e_ = __builtin_amdgcn_readlane(j_ < 64 ? e0 : e1, j_ & 63); \
            R[k_] = *((const u32x4*)(V8 + (size_t)e_ * 1024) + lane); } } while (0)
#define P8T_VACC(R, J) do { _Pragma("unroll") for (int k_ = 0; k_ < 4; ++k_) { const int j_ = (J) + k_; const float cj = __int_as_float(__builtin_amdgcn_readlane(__float_as_int(j_ < 64 ? c0 : c1), j_ & 63));   \
            const unsigned w_[4] = {R[k_].x, R[k_].y, R[k_].z, R[k_].w};                                                                                  \
            _Pragma("unroll") for (int c = 0; c < 4; ++c) { const f32x2_t lo = __builtin_amdgcn_cvt_pk_f32_fp8((int)w_[c], false), hi = __builtin_amdgcn_cvt_pk_f32_fp8((int)w_[c], true); \
                acc[4 * c] = fmaf(cj, lo.x, acc[4 * c]); acc[4 * c + 1] = fmaf(cj, lo.y, acc[4 * c + 1]); acc[4 * c + 2] = fmaf(cj, hi.x, acc[4 * c + 2]); acc[4 * c + 3] = fmaf(cj, hi.y, acc[4 * c + 3]); } } } while (0)
        { u32x4 VA[4], VB[4], VC[4];
          P8T_VLOAD(VA, 0); P8T_VLOAD(VB, 4);
#pragma unroll 1
          for (int j = 0; j < 120; j += 12) {
              P8T_VLOAD(VC, j + 8); P8T_VACC(VA, j);
              P8T_VLOAD(VA, j + 12); P8T_VACC(VB, j + 4);
              P8T_VLOAD(VB, j + 16); P8T_VACC(VC, j + 8);
          }
          P8T_VACC(VA, 120); P8T_VACC(VB, 124); }
#undef P8T_VLOAD
#undef P8T_VACC
        const float* g2 = MOD + (size_t)(t >> 11) * 6144 + 5120 + 16 * lane;
        float* orow = p.out + (size_t)t * 1024 + 16 * lane;
#pragma unroll
        for (int q = 0; q < 4; ++q) { const f32x4 xv = *(const f32x4*)(orow + 4 * q), hv = *(const f32x4*)(g2 + 4 * q);
            f32x4 r; r.x = acc[4 * q]; r.y = acc[4 * q + 1]; r.z = acc[4 * q + 2]; r.w = acc[4 * q + 3]; *(f32x4*)(orow + 4 * q) = xv + hv * r; }
    }
}
#define XB_TMO      128
#define XB_XCNT(j)  (256  + 64 * (j))
#define XB_XSUB(j)  (1280 + 64 * (j))
#define XB_XGEN(j)  (2304 + 64 * (j))
#define XB_TOP      3328
#define XB_TOPGEN   3392
#define XCD_BAR_WORDS 3456
#define XB_SPIN_CAP (1u << 18)

__device__ __forceinline__ unsigned xb_ld(unsigned* p)              { return __hip_atomic_load(p, __ATOMIC_RELAXED, __HIP_MEMORY_SCOPE_AGENT); }
__device__ __forceinline__ unsigned xb_add(unsigned* p, unsigned v) { return __hip_atomic_fetch_add(p, v, __ATOMIC_RELAXED, __HIP_MEMORY_SCOPE_AGENT); }
__device__ __forceinline__ unsigned xb_xcc_id() { return (unsigned)__builtin_amdgcn_s_getreg((3 << 11) | 20) & 0xFu; }
#define XB_SPIN(cond, bar) do { unsigned _sp = 0; while (cond) { __builtin_amdgcn_s_sleep(1); \
    if ((++_sp & 255u) == 0u) { if (xb_ld(&(bar)[XB_TMO])) break; if (_sp > XB_SPIN_CAP) { atomicAdd(&(bar)[XB_TMO], 1u); break; } } } } while (0)

struct XcdBarrier {
    unsigned* bar; unsigned x;
    volatile LAS unsigned* st;
};

__device__ __forceinline__ XcdBarrier xcd_barrier_post(unsigned* bar, volatile LAS unsigned* st) {
    XcdBarrier b; b.bar = bar; b.x = xb_xcc_id(); b.st = st;
    if (threadIdx.x == 0) (void)xb_add(&bar[XB_XCNT(b.x)], 1u);
    return b;
}
__device__ __forceinline__ void xcd_barrier_complete(unsigned* bar, unsigned x, unsigned& nloc, unsigned& nx) {
    const unsigned G = gridDim.x * gridDim.y * gridDim.z;
    unsigned sum, cnt, mine, sp = 0u;
    for (;;) {
        sum = 0u; cnt = 0u; mine = 0u;
#pragma unroll
        for (unsigned j = 0; j < 16; ++j) { const unsigned c = xb_ld(&bar[XB_XCNT(j)]); sum += c; cnt += (c > 0u) ? 1u : 0u; mine = (j == x) ? c : mine; }
        if (sum == G) break;
        __builtin_amdgcn_s_sleep(1);
        if ((++sp & 255u) == 0u) { if (xb_ld(&bar[XB_TMO])) break; if (sp > XB_SPIN_CAP) { atomicAdd(&bar[XB_TMO], 1u); break; } }
    }
    nloc = mine > 0u ? mine : 1u; nx = cnt > 0u ? cnt : 1u;
}

__device__ __forceinline__ void xcd_barrier(const XcdBarrier& b) {
    asm volatile("s_waitcnt vmcnt(0)" ::: "memory");
    __syncthreads();
    if (threadIdx.x == 0) {
        unsigned* bar = b.bar;
        __builtin_amdgcn_s_waitcnt(0);
        unsigned nloc = b.st[0], nx = b.st[1];
        if (nloc == 0u) { xcd_barrier_complete(bar, b.x, nloc, nx); b.st[0] = nloc; b.st[1] = nx; }
        const unsigned old = xb_add(&bar[XB_XSUB(b.x)], 1u);
        const unsigned gen = old / nloc;
        if (old + 1u == (gen + 1u) * nloc) {
            __builtin_amdgcn_fence(__ATOMIC_RELEASE, "agent");
            asm volatile("s_waitcnt vmcnt(0)" ::: "memory");
            const unsigned og = xb_add(&bar[XB_TOP], 1u);
            const unsigned tg = og / nx;
            if (og + 1u == (tg + 1u) * nx) xb_add(&bar[XB_TOPGEN], 1u);
            else XB_SPIN(xb_ld(&bar[XB_TOPGEN]) == tg, bar);
            __builtin_amdgcn_fence(__ATOMIC_ACQUIRE, "agent");
            xb_add(&bar[XB_XGEN(b.x)], 1u);
            asm volatile("s_waitcnt vmcnt(0)" ::: "memory");
        } else {
            XB_SPIN(xb_ld(&bar[XB_XGEN(b.x)]) == gen, bar);
            __builtin_amdgcn_fence(__ATOMIC_ACQUIRE, "agent");
            asm volatile("s_waitcnt vmcnt(0)" ::: "memory");
        }
    }
    __syncthreads();
}

#ifndef VAR_DSA_OLD
#define VAR_DSA_OLD 0
#endif
#ifndef VAR_U8_OLD
#define VAR_U8_OLD 1
#endif
#ifndef VAR_V8_OLD
#define VAR_V8_OLD 0
#endif
#ifndef PEER_FUSED
#define PEER_FUSED 0
#endif
#ifndef PROBE_DUP
#define PROBE_DUP 0
#endif
constexpr int LDS_BYTES = 147456;
extern __shared__ __attribute__((aligned(16))) unsigned char dyn_lds[];

__global__ void __launch_bounds__(NT, 2) mega_fwd(Params p) {
    cg::grid_group grid = cg::this_grid();
    const int vb = blockIdx.x, nvb = gridDim.x, ngw = nvb * NWV;
    volatile LAS unsigned* xst = (volatile LAS unsigned*)((LAS unsigned char*)dyn_lds + (LDS_BYTES - 16));
    if (threadIdx.x < 4) xst[threadIdx.x] = 0u;
    __syncthreads();
    const XcdBarrier xbar = xcd_barrier_post((unsigned*)(p.ws + WS_CTL), xst);
#define TID_LAUNDER int tid_ = threadIdx.x; asm volatile("" : "+v"(tid_)); const int lane = tid_ & 63, wv = tid_ >> 6, gw = vb * NWV + wv; (void)lane; (void)gw;
    ph_mod(p, (float*)dyn_lds, vb, nvb);
    { TID_LAUNDER ph_prep_weights(p, (LAS float*)dyn_lds + wv * (64 * 33), gw, ngw, lane); }
#if PROBE_DUP == 7
    __syncthreads();
    ph_mod(p, (float*)dyn_lds, vb, nvb);
    { TID_LAUNDER ph_prep_weights(p, (LAS float*)dyn_lds + wv * (64 * 33), gw, ngw, lane); }
#endif
    grid.sync();
    { TID_LAUNDER ph_hrows(p, p.x, p.norm1_g, 0, 1024, gw, ngw, lane); }
#if PROBE_DUP == 9
    { TID_LAUNDER ph_hrows(p, p.x, p.norm1_g, 0, 1024, gw, ngw, lane); }
#endif
    xcd_barrier(xbar);
    {   pg8::Gemm g{(const bf16*)(p.ws + WS_H), (const bf16*)(p.ws + WS_WIN), T, NP, 1024}; pg8::StaticOrder S; S.init(T, NP, nvb, vb);
        EpiNormBf16 E{(bf16*)(p.ws + WS_PROJ), p.a_qk_gain, p.b_q_gain, p.b_kv_gain, (LAS float*)((LAS unsigned char*)dyn_lds + 131072)};
        pg8::gemm_phase<EpiNormBf16, pg8::StaticOrder, true, true>((LAS unsigned char*)dyn_lds, g, S, E); }
    xcd_barrier(xbar);
    ph_attnA(p, dyn_lds, vb, nvb);
#if PROBE_DUP == 1
    __syncthreads(); ph_attnA(p, dyn_lds, vb, nvb);
#endif
    __syncthreads();
#if VAR_DSA_OLD
    ph_dsa_old(p, dyn_lds, vb, nvb);
#else
    ph_dsa(p, dyn_lds, vb, nvb);
#endif
#if PROBE_DUP == 2
    __syncthreads(); ph_dsa(p, dyn_lds, vb, nvb);
#endif
    xcd_barrier(xbar);
    {   pg8::Gemm g{(const bf16*)(p.ws + WS_MIX), (const bf16*)(p.ws + WS_WO2), T, 1024, MIXW}; pg8::StaticOrder S; S.init(T, 1024, nvb, vb);
        EpiResGate E{p.x, p.out, (const float*)(p.ws + WS_MOD) + 2048};
        pg8::gemm_phase<EpiResGate, pg8::StaticOrder, true, true>((LAS unsigned char*)dyn_lds, g, S, E); }
#if PROBE_DUP == 8
    {   pg8::Gemm g{(const bf16*)(p.ws + WS_MIX), (const bf16*)(p.ws + WS_WO2), T, 1024, MIXW}; pg8::StaticOrder S; S.init(T, 1024, nvb, vb);
        EpiResGate E{p.x, p.out, (const float*)(p.ws + WS_MOD) + 2048};
        pg8::gemm_phase<EpiResGate, pg8::StaticOrder, true, true>((LAS unsigned char*)dyn_lds, g, S, E); }
#endif
    xcd_barrier(xbar);
    { TID_LAUNDER ph_hrows(p, p.out, p.norm2_g, 3072, 4096, gw, ngw, lane); }
    xcd_barrier(xbar);
    {   pg8::Gemm g{(const bf16*)(p.ws + WS_H), (const bf16*)(p.ws + WS_WQ), T, 1024, 1024}; pg8::StaticOrder S; S.init(T, 1024, nvb, vb);
        pg8::EpiBf16<0> E{(bf16*)(p.ws + WS_Q3), 1024, nullptr, 0, 0, 1.f};
        pg8::gemm_phase<pg8::EpiBf16<0>, pg8::StaticOrder, true, true>((LAS unsigned char*)dyn_lds, g, S, E); }
#if PROBE_DUP == 8
    {   pg8::Gemm g{(const bf16*)(p.ws + WS_H), (const bf16*)(p.ws + WS_WQ), T, 1024, 1024}; pg8::StaticOrder S; S.init(T, 1024, nvb, vb);
        pg8::EpiBf16<0> E{(bf16*)(p.ws + WS_Q3), 1024, nullptr, 0, 0, 1.f};
        pg8::gemm_phase<pg8::EpiBf16<0>, pg8::StaticOrder, true, true>((LAS unsigned char*)dyn_lds, g, S, E); }
#endif
    xcd_barrier(xbar);
    ph_route(p, dyn_lds, vb, nvb);
#if PROBE_DUP == 3
    __syncthreads(); ph_route(p, dyn_lds, vb, nvb);
#endif
    xcd_barrier(xbar);

#if PEER_FUSED
    { TID_LAUNDER ph_peer8t(p, dyn_lds + wv * 1024, gw, ngw, lane); }
#else
    ph_peer_u8_old(p, dyn_lds);
    xcd_barrier(xbar);
    ph_peer_v8(p, dyn_lds);
#endif

}

extern "C" void kernel_launch(void* const* d_in, const int* in_sizes, int n_in, void* d_out, int out_size, void* d_ws, size_t ws_size, hipStream_t stream) {
    static int grid_blocks = 0;
    if (grid_blocks == 0) {
        if (n_in != 18 || in_sizes[0] != T * DM || out_size != T * DM || ws_size < WS_END) { fprintf(stderr, "kernel_launch: unexpected shapes n_in %d in0 %d out %d ws %zu\n", n_in, n_in > 0 ? in_sizes[0] : -1, out_size, ws_size); grid_blocks = -1; return; }
        int dev = 0, cus = 0, per_cu = 0;
        (void)hipGetDevice(&dev);
        (void)hipDeviceGetAttribute(&cus, hipDeviceAttributeMultiprocessorCount, dev);
        (void)hipFuncSetAttribute((const void*)mega_fwd, hipFuncAttributeMaxDynamicSharedMemorySize, LDS_BYTES);
        (void)hipOccupancyMaxActiveBlocksPerMultiprocessor(&per_cu, (const void*)mega_fwd, NT, LDS_BYTES);
        if (per_cu < 1 || cus < 1) { fprintf(stderr, "kernel_launch: occupancy query gave %d blocks/CU on %d CUs\n", per_cu, cus); grid_blocks = -1; return; }
        grid_blocks = cus;
    }
    if (grid_blocks < 0) return;
    Params p{};
    const float** pp = (const float**)&p;
    for (int i = 0; i < 18; ++i) pp[i] = (const float*)d_in[i];
    p.out = (float*)d_out; p.ws = (unsigned char*)d_ws;
    if (hipMemsetAsync((char*)d_ws + WS_CTL, 0, CTL_BYTES, stream) != hipSuccess) { fprintf(stderr, "kernel_launch: memset failed\n"); return; }
    void* args[] = {&p};
    const hipError_t e = hipLaunchCooperativeKernel((const void*)mega_fwd, dim3(grid_blocks), dim3(NT), args, LDS_BYTES, stream);
    if (e != hipSuccess) fprintf(stderr, "kernel_launch: cooperative launch failed: %s (grid %d)\n", hipGetErrorString(e), grid_blocks);
}
```

```cpp
#include <hip/hip_runtime.h>
#include <hip/hip_cooperative_groups.h>
#include <cstdio>
#include <cstdint>
#include <cmath>
namespace pg8 {
#define PG8_LAS __attribute__((address_space(3)))
typedef unsigned short bf16_t;
typedef short bf16x8 __attribute__((ext_vector_type(8)));
typedef float f32x4 __attribute__((ext_vector_type(4)));
typedef unsigned u32x4 __attribute__((ext_vector_type(4)));
constexpr int BM = 256, BK = 64, HALF = 128, HTB = HALF * BK * 2  , STAGE_BYTES = 8 * HTB, NXCD = 8, WGM = 8;

__host__ __device__ __forceinline__ int lds_byte(int r, int c) { const int st = (r >> 4) * 2 + (c >> 5), rr = r & 15, cc = c & 31, ob = rr * 64 + cc * 2; return st * 1024 + (ob ^ (((ob >> 9) & 1) << 5)); }
__host__ __device__ __forceinline__ void stage_rc(int b, int& R, int& C) { const int st = b / 1024, sb = b % 1024, swz = sb ^ (((sb >> 9) & 1) << 5); R = (st >> 1) * 16 + swz / 64; C = (st & 1) * 32 + (swz % 64) / 2; }
__host__ __device__ __forceinline__ int perm32(int rho) { const int n = rho >> 4, i = rho & 15; return 8 * (i >> 2) + 4 * n + (i & 3); }

struct Unit { int pm, pn; };
struct Gemm { const bf16_t* A; const bf16_t* Bt; int M, N, K; };

struct StaticOrder {
    int nM, nN, nwg, G, c;
    __host__ __device__ void init(int M, int N, int G_, int c_) { nM = M / BM; nN = N / BM; nwg = nM * nN; G = G_; c = c_; }
    __host__ __device__ bool next(int i, Unit& u) const {
        const long L = (long)i * G + c; if (L >= nwg) return false;
        int wgid = (int)L; { const int q = nwg / NXCD, r = nwg % NXCD, xcd = wgid % NXCD, off = wgid / NXCD; wgid = (xcd < r ? xcd * (q + 1) : r * (q + 1) + (xcd - r) * q) + off; }
        const int nig = WGM * nN, gid = wgid / nig, fm = gid * WGM, gsz = (nM - fm) < WGM ? (nM - fm) : WGM;
        u.pm = fm + ((wgid % nig) % gsz); u.pn = (wgid % nig) / gsz; return true;
    }
    __device__ __forceinline__ void a_ready(const Unit&) const {}
    __device__ __forceinline__ void done(const Unit&) const {}
};

__device__ __forceinline__ unsigned cvt_pk_bf16(float lo, float hi) { unsigned r; asm volatile("v_cvt_pk_bf16_f32 %0, %1, %2" : "=v"(r) : "v"(lo), "v"(hi)); return r; }
typedef float f32x2 __attribute__((ext_vector_type(2)));
__device__ __forceinline__ f32x2 gelu_pk(f32x2 v) {
    const f32x2 av = __builtin_elementwise_abs(v), d = av * 0.2316418882f + 1.0f;
    f32x2 t; t.x = __builtin_amdgcn_rcpf(d.x); t.y = __builtin_amdgcn_rcpf(d.y);
    f32x2 q = t * 0.5307027145f + (-0.7265760135f); q = q * t + 0.7107068705f; q = q * t + (-0.142248368f); q = q * t + 0.127414796f; q = q * t;
    const f32x2 s = (v * v) * (-0.72134752044f);
    f32x2 e; e.x = __builtin_amdgcn_exp2f(s.x); e.y = __builtin_amdgcn_exp2f(s.y);
    const f32x2 m = v * (q * e), r = v - m;
    f32x2 o; o.x = v.x < 0.f ? m.x : r.x; o.y = v.y < 0.f ? m.y : r.y; return o;
}

template <int ACT  > struct EpiBf16 {
    static constexpr bool PERM = true, AFTER_DRAIN = false; static_assert(ACT == 0 || ACT == 1, "EpiBf16: ACT is 0 (none) or 1 (gelu_pk)");
    bf16_t* O; int ldc; const float* bias; int split_cols; size_t split_stride; float scale0;
    __device__ __forceinline__ void operator()(const f32x4 (&acc)[2][2][4][2], const Unit& u, int wr, int wc, int fr, int fq) const {
        const int row0 = u.pm * BM + wr * 64 + fr; int colt = u.pn * BM; bf16_t* base = O;
        float sc = 1.f; if (split_cols) { const int t = colt / split_cols; base += (size_t)t * split_stride; colt -= t * split_cols; if (t == 0) sc = scale0; }
        const int col0 = colt + wc * 32 + 8 * fq, bcol0 = u.pn * BM + wc * 32 + 8 * fq;
        f32x4 bv[2][2];
#pragma unroll
        for (int bj = 0; bj < 2; ++bj)
#pragma unroll
            for (int n = 0; n < 2; ++n) bv[bj][n] = bias ? *(const f32x4*)(bias + bcol0 + bj * HALF + 4 * n) : (f32x4){0.f, 0.f, 0.f, 0.f};
#pragma unroll
        for (int ai = 0; ai < 2; ++ai)
#pragma unroll
            for (int m = 0; m < 4; ++m) { bf16_t* rowp = base + (size_t)(row0 + ai * HALF + m * 16) * ldc + col0;
#pragma unroll
                for (int bj = 0; bj < 2; ++bj) { f32x4 v0 = acc[ai][bj][m][0] + bv[bj][0], v1 = acc[ai][bj][m][1] + bv[bj][1];
                    if (ACT == 1) { f32x2 a = gelu_pk((f32x2){v0[0], v0[1]}), b = gelu_pk((f32x2){v0[2], v0[3]}), c = gelu_pk((f32x2){v1[0], v1[1]}), d = gelu_pk((f32x2){v1[2], v1[3]});
                        v0 = (f32x4){a.x, a.y, b.x, b.y}; v1 = (f32x4){c.x, c.y, d.x, d.y}; }
                    v0 = v0 * sc; v1 = v1 * sc; u32x4 w; w.x = cvt_pk_bf16(v0[0], v0[1]); w.y = cvt_pk_bf16(v0[2], v0[3]); w.z = cvt_pk_bf16(v1[0], v1[1]); w.w = cvt_pk_bf16(v1[2], v1[3]);
                    *(u32x4*)(rowp + bj * HALF) = w; } }
    }
};

template <class Epi, class Sched, bool ALIGN_EPI = false, bool SP2 = false>
__device__ __forceinline__ void gemm_phase(PG8_LAS unsigned char* lds, const Gemm g, const Sched& S, const Epi& E) {
    int tid = threadIdx.x; asm volatile("" : "+v"(tid)); const int wid = __builtin_amdgcn_readfirstlane(tid >> 6), lane = tid & 63, wr = wid >> 2, wc = wid & 3, fr = lane & 15, fq = lane >> 4;
    const int K = g.K, nt = K / BK;
    unsigned voffA[2], voffB[2];
#pragma unroll
    for (int i = 0; i < 2; ++i) { int R, C; stage_rc(tid * 16 + i * 8192, R, C); const int Rb = Epi::PERM ? ((R & ~31) + perm32(R & 31)) : R;
        voffA[i] = (unsigned)(R * K + C) * 2u; voffB[i] = (unsigned)(Rb * K + C) * 2u; }
    const size_t kstep = (size_t)(BK * 2);
    const size_t hstep = (size_t)HALF * K * 2;
    const size_t tstep = 2 * hstep;
    const unsigned ldsw = (unsigned)wid * 1024u;
    const int aoff = lds_byte(wr * 64 + fr, fq * 8), boff = lds_byte(wc * 32 + fr, fq * 8);
#define PG8_SA(b, h) (((b) * 2 + (h)) * HTB)
#define PG8_SB(b, h) ((4 + (b) * 2 + (h)) * HTB)
#define PG8_STAGE(bufoff, gbase, voff) do { _Pragma("unroll") for (int _i = 0; _i < 2; ++_i) \
        __builtin_amdgcn_global_load_lds((const unsigned*)((const char*)(gbase) + (voff)[_i]), (PG8_LAS unsigned*)(lds + (bufoff) + ldsw + _i * 8192), 16, 0, 0); } while (0)
#define PG8_LDA(dst, b, h) do { _Pragma("unroll") for (int m = 0; m < 4; ++m) _Pragma("unroll") for (int k = 0; k < 2; ++k) dst[m][k] = *(const PG8_LAS bf16x8*)(lds + PG8_SA(b, h) + aoff + m * 2048 + k * 1024); } while (0)
#define PG8_LDB(dst, b, h) do { _Pragma("unroll") for (int n = 0; n < 2; ++n) _Pragma("unroll") for (int k = 0; k < 2; ++k) dst[n][k] = *(const PG8_LAS bf16x8*)(lds + PG8_SB(b, h) + boff + n * 2048 + k * 1024); } while (0)
#define PG8_MMA(ai, bj, At, Bt) do { __builtin_amdgcn_s_setprio(1); _Pragma("unroll") for (int m = 0; m < 4; ++m) _Pragma("unroll") for (int n = 0; n < 2; ++n) _Pragma("unroll") for (int k = 0; k < 2; ++k) \
        acc[ai][bj][m][n] = __builtin_amdgcn_mfma_f32_16x16x32_bf16(Bt[n][k], At[m][k], acc[ai][bj][m][n], 0, 0, 0); __builtin_amdgcn_s_setprio(0); } while (0)
#define PG8_WAIT_V(n) asm volatile("s_waitcnt vmcnt(" #n ")" ::: "memory")
#define PG8_WAIT_L(n) asm volatile("s_waitcnt lgkmcnt(" #n ")" ::: "memory")
#define PG8_BAR __builtin_amdgcn_s_barrier()
#define PG8_SCHED __builtin_amdgcn_sched_barrier(0)
    Unit cur, nxt; int ui = 0;
    if (!S.next(0, cur)) return;
    f32x4 acc[2][2][4][2];
#pragma unroll
    for (int a = 0; a < 2; ++a)
#pragma unroll
        for (int b = 0; b < 2; ++b)
#pragma unroll
            for (int m = 0; m < 4; ++m)
#pragma unroll
                for (int n = 0; n < 2; ++n) acc[a][b][m][n] = (f32x4){0.f, 0.f, 0.f, 0.f};
    bf16x8 At[4][2], B0[2][2], B1[2][2];
    const char* cA = (const char*)g.A + (size_t)cur.pm * tstep; const char* cB = (const char*)g.Bt + (size_t)cur.pn * tstep;
    S.a_ready(cur);
    if constexpr (SP2) {
        PG8_STAGE(PG8_SB(0, 0), cB, voffB); PG8_STAGE(PG8_SB(0, 1), cB + hstep, voffB); PG8_STAGE(PG8_SA(0, 0), cA, voffA); PG8_STAGE(PG8_SA(0, 1), cA + hstep, voffA);
        if (wr == 1) PG8_BAR;
        PG8_WAIT_V(2); PG8_BAR;
        PG8_STAGE(PG8_SB(1, 0), cB + kstep, voffB); PG8_STAGE(PG8_SA(1, 0), cA + kstep, voffA); PG8_STAGE(PG8_SB(1, 1), cB + hstep + kstep, voffB);
        PG8_WAIT_V(6); PG8_BAR;
    } else {
        PG8_STAGE(PG8_SB(0, 0), cB, voffB); PG8_STAGE(PG8_SA(0, 0), cA, voffA); PG8_STAGE(PG8_SB(0, 1), cB + hstep, voffB); PG8_STAGE(PG8_SA(0, 1), cA + hstep, voffA);
        if (wr == 1) PG8_BAR;
        PG8_WAIT_V(4); PG8_BAR;
        PG8_STAGE(PG8_SB(1, 0), cB + kstep, voffB); PG8_STAGE(PG8_SA(1, 0), cA + kstep, voffA); PG8_STAGE(PG8_SB(1, 1), cB + hstep + kstep, voffB);
        PG8_WAIT_V(6); PG8_BAR;
    }
    for (;;) {
        const bool has_next = S.next(ui + 1, nxt);
        const char* nA = has_next ? (const char*)g.A + (size_t)nxt.pm * tstep : cA; const char* nB = has_next ? (const char*)g.Bt + (size_t)nxt.pn * tstep : cB;
        for (int t = 0; t < nt; t += 2) {
            const bool last = (t == nt - 2);
            const char* a1 = cA + (size_t)(t + 1) * kstep;
            const char* a2 = last ? nA : cA + (size_t)(t + 2) * kstep; const char* b2 = last ? nB : cB + (size_t)(t + 2) * kstep;
            const char* a3 = a2 + kstep; const char* b3 = b2 + kstep;
            if (last && has_next) S.a_ready(nxt);
            if constexpr (SP2) {
            PG8_LDB(B0, 0, 0); PG8_LDB(B1, 0, 1); PG8_SCHED; PG8_LDA(At, 0, 0); PG8_STAGE(PG8_SA(1, 1), a1 + hstep, voffA);
            PG8_WAIT_V(8); PG8_WAIT_L(0); PG8_BAR; PG8_MMA(0, 0, At, B0); PG8_MMA(0, 1, At, B1); PG8_BAR; PG8_SCHED;
            PG8_LDA(At, 0, 1); PG8_STAGE(PG8_SB(0, 0), b2, voffB); PG8_STAGE(PG8_SB(0, 1), b2 + hstep, voffB); PG8_STAGE(PG8_SA(0, 0), a2, voffA);
            PG8_WAIT_V(8); PG8_WAIT_L(0); PG8_BAR; PG8_MMA(1, 0, At, B0); PG8_MMA(1, 1, At, B1); PG8_BAR; PG8_SCHED;
            PG8_LDB(B0, 1, 0); PG8_LDB(B1, 1, 1); PG8_SCHED; PG8_LDA(At, 1, 0); PG8_STAGE(PG8_SA(0, 1), a2 + hstep, voffA);
            PG8_WAIT_V(8); PG8_WAIT_L(0); PG8_BAR; PG8_MMA(0, 0, At, B0); PG8_MMA(0, 1, At, B1); PG8_BAR; PG8_SCHED;
            PG8_LDA(At, 1, 1); PG8_STAGE(PG8_SB(1, 0), b3, voffB); PG8_STAGE(PG8_SB(1, 1), b3 + hstep, voffB); PG8_STAGE(PG8_SA(1, 0), a3, voffA);
            PG8_WAIT_V(8); PG8_WAIT_L(0); PG8_BAR; PG8_MMA(1, 0, At, B0); PG8_MMA(1, 1, At, B1); PG8_BAR; PG8_SCHED;
            } else {
            PG8_LDB(B0, 0, 0); PG8_SCHED; PG8_LDA(At, 0, 0); PG8_STAGE(PG8_SA(1, 1), a1 + hstep, voffA);
            PG8_WAIT_L(8); PG8_BAR; PG8_WAIT_L(0); PG8_MMA(0, 0, At, B0); PG8_BAR; PG8_SCHED;
            PG8_LDB(B1, 0, 1); PG8_STAGE(PG8_SB(0, 0), b2, voffB);
            PG8_BAR; PG8_WAIT_L(0); PG8_MMA(0, 1, At, B1); PG8_BAR;
            PG8_LDA(At, 0, 1); PG8_STAGE(PG8_SA(0, 0), a2, voffA);
            PG8_BAR; PG8_WAIT_L(0); PG8_MMA(1, 0, At, B0); PG8_BAR; PG8_SCHED;
            PG8_STAGE(PG8_SB(0, 1), b2 + hstep, voffB);
            PG8_WAIT_V(6); PG8_BAR; PG8_MMA(1, 1, At, B1); PG8_BAR;
            PG8_LDB(B0, 1, 0); PG8_SCHED; PG8_LDA(At, 1, 0); PG8_STAGE(PG8_SA(0, 1), a2 + hstep, voffA);
            PG8_WAIT_L(8); PG8_BAR; PG8_WAIT_L(0); PG8_MMA(0, 0, At, B0); PG8_BAR; PG8_SCHED;
            PG8_LDB(B1, 1, 1); PG8_STAGE(PG8_SB(1, 0), b3, voffB);
            PG8_BAR; PG8_WAIT_L(0); PG8_MMA(0, 1, At, B1); PG8_BAR;
            PG8_LDA(At, 1, 1); PG8_STAGE(PG8_SA(1, 0), a3, voffA);
            PG8_BAR; PG8_WAIT_L(0); PG8_MMA(1, 0, At, B0); PG8_BAR; PG8_SCHED;
            PG8_STAGE(PG8_SB(1, 1), b3 + hstep, voffB);
            PG8_WAIT_V(6); PG8_BAR; PG8_MMA(1, 1, At, B1); PG8_BAR;
            }
        }
        if constexpr (ALIGN_EPI) { if (wr == 0) PG8_BAR; }
        if constexpr (!Epi::AFTER_DRAIN) { E(acc, cur, wr, wc, fr, fq); S.done(cur); }
        if (!has_next) break;
#pragma unroll
        for (int a = 0; a < 2; ++a)
#pragma unroll
            for (int b = 0; b < 2; ++b)
#pragma unroll
                for (int m = 0; m < 4; ++m)
#pragma unroll
                    for (int n = 0; n < 2; ++n) acc[a][b][m][n] = (f32x4){0.f, 0.f, 0.f, 0.f};
        cur = nxt; cA = nA; cB = nB; ++ui;
        if constexpr (ALIGN_EPI) { if (wr == 1) PG8_BAR; }
    }
    PG8_WAIT_V(0);
    if constexpr (!ALIGN_EPI) { if (wr == 0) PG8_BAR; }
    PG8_BAR;
    if constexpr (Epi::AFTER_DRAIN) { E.fused(acc, cur, wr, wc, fr, fq, lds, wid, lane); S.done(cur); }
#undef PG8_SA
#undef PG8_SB
#undef PG8_STAGE
#undef PG8_LDA
#undef PG8_LDB
#undef PG8_MMA
#undef PG8_WAIT_V
#undef PG8_WAIT_L
#undef PG8_BAR
#undef PG8_SCHED
}
}
namespace cg = cooperative_groups;
#define LAS __attribute__((address_space(3)))
typedef unsigned short bf16;
typedef float f32x4 __attribute__((ext_vector_type(4)));
typedef float f32x8 __attribute__((ext_vector_type(8)));
typedef float f32x16 __attribute__((ext_vector_type(16)));
typedef unsigned u32x4 __attribute__((ext_vector_type(4)));
typedef unsigned u32x2 __attribute__((ext_vector_type(2)));
typedef short bf16x8 __attribute__((ext_vector_type(8)));
typedef short s16x4 __attribute__((ext_vector_type(4)));

constexpr int BATCH = 16, SEQ = 2048, DM = 1024, T = BATCH * SEQ;
constexpr int NP = 3072;
constexpr int IN_COLS = 3012;
constexpr int C_QA = 0, C_KA = 512, C_VA = 1024, C_QB = 1536, C_KV = 2560, C_QI = 2688, C_KI = 2944, C_WI = 3008;
constexpr int MIXW = 1536;
constexpr int NEXP = 16384;
constexpr float EPS = 1e-6f;
constexpr int NT = 512;
constexpr int NWV = 8;

constexpr size_t MiB = 1u << 20;
constexpr size_t WS_CTL = 0;
constexpr size_t CTL_BYTES = 64 * 1024;
constexpr size_t WS_MOD = 1 * MiB;
constexpr size_t WS_SCAL = WS_MOD + 512 * 1024;
constexpr size_t WS_WIN = 2 * MiB;
constexpr size_t WS_WO2 = 8 * MiB;
constexpr size_t WS_WQ = 11 * MiB;
constexpr size_t WS_SUBK = 13 * MiB;
constexpr size_t WS_U16 = 14 * MiB;
constexpr size_t WS_V16 = 46 * MiB;
constexpr size_t WS_H = 78 * MiB;
constexpr size_t WS_PROJ = 142 * MiB;
constexpr size_t WS_Q3 = WS_PROJ;
constexpr size_t WS_MIX = 334 * MiB;
constexpr size_t WS_EXP = 430 * MiB;
constexpr size_t WS_GATE = 446 * MiB;
constexpr size_t WS_ATMP = 462 * MiB;
constexpr size_t WS_CBUF = 494 * MiB;
constexpr size_t WS_END = 510 * MiB;

struct Params {
    const float *x, *c, *ada_w, *ada_b, *norm1_g, *norm2_g, *w_in, *a_qk_gain, *a_lambda, *a_sub_gain, *b_q_gain, *b_kv_gain, *b_w_uv, *w_out, *peer_wq, *peer_subkeys, *peer_u, *peer_v;
    float* out; unsigned char* ws;
};

enum { SC_LAM = 0, SC_MA = 1, SC_MB = 2 };

__device__ __forceinline__ unsigned f2bf(float f) { unsigned u = __float_as_uint(f); return (u + 0x7fffu + ((u >> 16) & 1u)) >> 16; }
__device__ __forceinline__ float bf2f(unsigned h) { return __uint_as_float(h << 16); }
__device__ __forceinline__ unsigned pk2(float lo, float hi) { return f2bf(lo) | (f2bf(hi) << 16); }
__device__ __forceinline__ float bflo(unsigned w) { return __uint_as_float(w << 16); }
__device__ __forceinline__ float bfhi(unsigned w) { return __uint_as_float(w & 0xffff0000u); }
__device__ __forceinline__ float wave_sum(float v) {
#pragma unroll
    for (int o = 1; o < 64; o <<= 1) v += __shfl_xor(v, o);
    return v;
}
__device__ __forceinline__ float wave_max(float v) {
#pragma unroll
    for (int o = 1; o < 64; o <<= 1) v = fmaxf(v, __shfl_xor(v, o));
    return v;
}
#define LDS_WAIT() asm volatile("s_waitcnt lgkmcnt(0)" ::: "memory")
__device__ __forceinline__ void ph_mod(const Params& p, float* ldsf, int vb, int nvb) {
    if (vb >= 96) return;
    int tid = threadIdx.x; asm volatile("" : "+v"(tid));
    const int lane = tid & 63, wv = tid >> 6;
    for (int i = tid; i < 16 * 1024; i += NT) { const float v = p.c[i]; ldsf[i] = v / (1.f + __expf(-v)); }
    __syncthreads();
    float* MOD = (float*)(p.ws + WS_MOD); float* part = ldsf + 16 * 1024;
    for (int it = vb; it < 96; it += nvb) {
        const int j = it * 64 + lane;
        float acc[16];
#pragma unroll
        for (int b = 0; b < 16; ++b) acc[b] = 0.f;
        const float* wp = p.ada_w + (size_t)(128 * wv) * 6144 + j;
#pragma unroll 1
        for (int k0 = 0; k0 < 128; k0 += 8) {
            float w[8];
#pragma unroll
            for (int u = 0; u < 8; ++u) w[u] = wp[(size_t)(k0 + u) * 6144];
#pragma unroll
            for (int u = 0; u < 8; ++u)
#pragma unroll
                for (int b = 0; b < 16; ++b) acc[b] = fmaf(ldsf[b * 1024 + 128 * wv + k0 + u], w[u], acc[b]);
        }
#pragma unroll
        for (int b = 0; b < 16; ++b) part[(wv * 16 + b) * 64 + lane] = acc[b];
        __syncthreads();
        for (int o = tid; o < 16 * 64; o += NT) { const int b = o >> 6, c = o & 63; float s = 0.f;
#pragma unroll
            for (int w = 0; w < 8; ++w) s += part[(w * 16 + b) * 64 + c];
            MOD[b * 6144 + it * 64 + c] = s + p.ada_b[it * 64 + c]; }
        __syncthreads();
    }
}

__device__ __forceinline__ void transpose_item(const float* W, int N, bf16* WT, int ldt, LAS float* scr, int kb, int nb, int lane) {
    const int k0 = 64 * kb, n0 = 32 * nb;
#pragma unroll 8
    for (int i = 0; i < 32; ++i) { const int kk = 2 * i + (lane >> 5); const int n = n0 + (lane & 31); scr[kk * 33 + (lane & 31)] = (n < N) ? W[(size_t)(k0 + kk) * N + n] : 0.f; }
    LDS_WAIT(); asm volatile("" ::: "memory");
    const int c = lane & 7;
#pragma unroll
    for (int j = 0; j < 4; ++j) { const int n = (lane >> 3) + 8 * j; const LAS float* s = scr + (8 * c) * 33 + n;
        u32x4 o; o.x = pk2(s[0 * 33], s[1 * 33]); o.y = pk2(s[2 * 33], s[3 * 33]); o.z = pk2(s[4 * 33], s[5 * 33]); o.w = pk2(s[6 * 33], s[7 * 33]);
        *(u32x4*)(WT + (size_t)(n0 + n) * ldt + k0 + 8 * c) = o; }
    LDS_WAIT(); asm volatile("" ::: "memory");
}

__device__ __forceinline__ void ph_prep_weights(const Params& p, LAS float* scr, int gw, int ngw, int lane) {
    bf16* WIN = (bf16*)(p.ws + WS_WIN); bf16* WO2 = (bf16*)(p.ws + WS_WO2); bf16* WQ = (bf16*)(p.ws + WS_WQ);
    constexpr int I_IN = 16 * 96, I_O = 8 * 32, I_Q = 16 * 32;
    for (int it = gw; it < I_IN + I_O + I_Q; it += ngw) {
        int r = it;
        if (r < I_IN) { transpose_item(p.w_in, IN_COLS, WIN, 1024, scr, r / 96, r % 96, lane); continue; } r -= I_IN;
        if (r < I_O) { transpose_item(p.w_out, 1024, WO2, MIXW, scr, r / 32, r % 32, lane); continue; } r -= I_O;
        transpose_item(p.peer_wq, 1024, WQ, 1024, scr, r / 32, r % 32, lane);
    }
    const size_t gt = (size_t)gw * 64 + lane, ngt = (size_t)ngw * 64;
    for (size_t i = gt; i < (size_t)1024 * 1024; i += ngt) {
        const int n = (int)(i & 1023), kk = (int)(i >> 10), h = kk >> 7;
        const float* wu = p.b_w_uv + (size_t)kk * 64; const float* wo = p.w_out + (size_t)(512 + 64 * h) * 1024 + n;
        float a = 0.f;
#pragma unroll 8
        for (int e = 0; e < 64; ++e) a = fmaf(wu[e], wo[(size_t)e * 1024], a);
        WO2[(size_t)n * MIXW + 512 + kk] = (bf16)f2bf(a);
    }
    unsigned char* U8 = (unsigned char*)(p.ws + WS_U16); unsigned char* V8 = (unsigned char*)(p.ws + WS_V16); bf16* SUBK = (bf16*)(p.ws + WS_SUBK);
    constexpr size_t NTAB8 = (size_t)NEXP * 1024 / 8, NSUB8 = 2 * 128 * 64 / 8;
    for (size_t i = gt; i < 2 * NTAB8 + NSUB8; i += ngt) {
        if (i < 2 * NTAB8) {
            const bool isu = i < NTAB8; const size_t j = isu ? i : i - NTAB8; const float sc = isu ? 32.0f : 1.0f;
            const f32x8 v = *(const f32x8*)((isu ? p.peer_u : p.peer_v) + j * 8);
            int w0 = 0, w1 = 0;
            w0 = __builtin_amdgcn_cvt_pk_fp8_f32(v[0] * sc, v[1] * sc, w0, false); w0 = __builtin_amdgcn_cvt_pk_fp8_f32(v[2] * sc, v[3] * sc, w0, true);
            w1 = __builtin_amdgcn_cvt_pk_fp8_f32(v[4] * sc, v[5] * sc, w1, false); w1 = __builtin_amdgcn_cvt_pk_fp8_f32(v[6] * sc, v[7] * sc, w1, true);
            u32x2 o; o.x = (unsigned)w0; o.y = (unsigned)w1;
            *(u32x2*)((isu ? U8 : V8) + j * 8) = o;
        } else {
            const size_t j = i - 2 * NTAB8;
            const f32x8 v = *(const f32x8*)(p.peer_subkeys + j * 8);
            u32x4 o; o.x = pk2(v[0], v[1]); o.y = pk2(v[2], v[3]); o.z = pk2(v[4], v[5]); o.w = pk2(v[6], v[7]);
            *(u32x4*)(SUBK + j * 8) = o;
        }
    }
    if (gt == 0) {
        float* SC = (float*)(p.ws + WS_SCAL);
        float s01 = 0.f, s23 = 0.f;
        for (int i = 0; i < 64; ++i) { s01 += p.a_lambda[i] * p.a_lambda[64 + i]; s23 += p.a_lambda[128 + i] * p.a_lambda[192 + i]; }
        SC[SC_LAM] = __expf(s01) - __expf(s23) + 0.2f;
        float g0 = 0.f, g1 = 0.f, gq = 0.f, gk = 0.f;
        for (int i = 0; i < 64; ++i) { g0 = fmaxf(g0, fabsf(p.a_qk_gain[i])); g1 = fmaxf(g1, fabsf(p.a_qk_gain[64 + i])); }
        for (int i = 0; i < 128; ++i) { gq = fmaxf(gq, fabsf(p.b_q_gain[i])); gk = fmaxf(gk, fabsf(p.b_kv_gain[i])); }
        SC[SC_MA] = 8.0f * g0 * g1 * 1.02f;
        SC[SC_MB] = 11.3137085f * gq * gk * 1.02f;
    }
}

__device__ __forceinline__ void ph_hrows(const Params& p, const float* X, const float* g, int shOff, int scOff, int gw, int ngw, int lane) {
    const float* MOD = (const float*)(p.ws + WS_MOD); bf16* H = (bf16*)(p.ws + WS_H);
    for (int m = gw; m < T; m += ngw) {
        const f32x4* xr = (const f32x4*)(X + (size_t)m * 1024) + lane;
        f32x4 v[4]; float s = 0.f;
#pragma unroll
        for (int j = 0; j < 4; ++j) { v[j] = xr[64 * j]; s += (v[j].x * v[j].x + v[j].y * v[j].y) + (v[j].z * v[j].z + v[j].w * v[j].w); }
        const float rstd = rsqrtf(wave_sum(s) * (1.f / 1024.f) + EPS);
        const float* mb = MOD + (size_t)(m >> 11) * 6144;
#pragma unroll
        for (int j = 0; j < 4; ++j) {
            const int col = 4 * (lane + 64 * j);
            const f32x4 gg = *(const f32x4*)(g + col), sc = *(const f32x4*)(mb + scOff + col), sh = *(const f32x4*)(mb + shOff + col);
            const f32x4 y = v[j] * rstd * gg * (sc + 1.0f) + sh;
            u32x2 o; o.x = pk2(y.x, y.y); o.y = pk2(y.z, y.w);
            *(u32x2*)(H + (size_t)m * 1024 + col) = o;
        }
    }
}

__device__ __forceinline__ void ph_norm_proj(const Params& p, int gw, int ngw, int lane) {
    bf16* PROJ = (bf16*)(p.ws + WS_PROJ);
    for (int m = gw; m < T; m += ngw) {
        bf16* row = PROJ + (size_t)m * NP;
#pragma unroll
        for (int j = 0; j < 6; ++j) {
            if (j == 2) continue;
            const int col = 8 * lane + 512 * j;
            const u32x4 raw = *(const u32x4*)(row + col);
            float v[8] = {bflo(raw.x), bfhi(raw.x), bflo(raw.y), bfhi(raw.y), bflo(raw.z), bfhi(raw.z), bflo(raw.w), bfhi(raw.w)};
            float ss = 0.f;
#pragma unroll
            for (int i = 0; i < 8; ++i) ss += v[i] * v[i];
            ss += __shfl_xor(ss, 1); ss += __shfl_xor(ss, 2); ss += __shfl_xor(ss, 4);
            float rstd; const float* gp;
            if (j < 2) { rstd = rsqrtf(ss * (1.f / 64.f) + EPS); gp = p.a_qk_gain + 64 * j + (col & 63); }
            else { ss += __shfl_xor(ss, 8); rstd = rsqrtf(ss * (1.f / 128.f) + EPS); gp = (j == 5 ? p.b_kv_gain : p.b_q_gain) + (col & 127); }
            if (j == 5 && lane >= 16) continue;
            const f32x4 g0 = *(const f32x4*)gp, g1 = *(const f32x4*)(gp + 4);
            u32x4 o; o.x = pk2(v[0] * rstd * g0.x, v[1] * rstd * g0.y); o.y = pk2(v[2] * rstd * g0.z, v[3] * rstd * g0.w);
            o.z = pk2(v[4] * rstd * g1.x, v[5] * rstd * g1.y); o.w = pk2(v[6] * rstd * g1.z, v[7] * rstd * g1.w);
            *(u32x4*)(row + col) = o;
        }
    }
}
__device__ void ph_attnA_naive(const Params& p, float* lds_w, int gw, int ngw, int lane) {
    const bf16* PROJ = (const bf16*)(p.ws + WS_PROJ); bf16* MIX = (bf16*)(p.ws + WS_MIX);
    const float lam = ((const float*)(p.ws + WS_SCAL))[SC_LAM];
    float* qs = lds_w; float* sc0 = lds_w + 128; float* sc1 = sc0 + 2048;
    for (int it = gw; it < BATCH * 4 * SEQ; it += ngw) {
        const int t = it & 2047, h = (it >> 11) & 3, b = it >> 13;
        const int cend = ((t >> 6) + 1) << 6;
        const float slope = exp2f(-2.0f * (h + 1));
        const bf16* qrow = PROJ + (size_t)(b * SEQ + t) * NP + C_QA + h * 128;
        qs[lane] = bf2f(qrow[lane]); qs[64 + lane] = bf2f(qrow[64 + lane]);
        LDS_WAIT(); asm volatile("" ::: "memory");
        float m0 = -3e38f, m1 = -3e38f;
        for (int kk = lane; kk < cend; kk += 64) {
            const bf16* krow = PROJ + (size_t)(b * SEQ + kk) * NP + C_KA + h * 128;
            float d0 = 0.f, d1 = 0.f;
            for (int d = 0; d < 64; ++d) { d0 = fmaf(qs[d], bf2f(krow[d]), d0); d1 = fmaf(qs[64 + d], bf2f(krow[64 + d]), d1); }
            const float bias = slope * fabsf((float)(t - kk));
            d0 = d0 * 0.125f - bias; d1 = d1 * 0.125f - bias;
            sc0[kk] = d0; sc1[kk] = d1; m0 = fmaxf(m0, d0); m1 = fmaxf(m1, d1);
        }
        m0 = wave_max(m0); m1 = wave_max(m1);
        float l0 = 0.f, l1 = 0.f;
        for (int kk = lane; kk < cend; kk += 64) { const float e0 = __expf(sc0[kk] - m0), e1 = __expf(sc1[kk] - m1); sc0[kk] = e0; sc1[kk] = e1; l0 += e0; l1 += e1; }
        l0 = wave_sum(l0); l1 = wave_sum(l1);
        const float i0 = 1.f / l0, i1 = lam / l1;
        for (int kk = lane; kk < cend; kk += 64) sc0[kk] = sc0[kk] * i0 - sc1[kk] * i1;
        LDS_WAIT(); asm volatile("" ::: "memory");
        float a0 = 0.f, a1 = 0.f;
        const bf16* vb = PROJ + (size_t)(b * SEQ) * NP + C_VA + h * 128;
        for (int kk = 0; kk < cend; ++kk) { const float a = sc0[kk]; const bf16* vr = vb + (size_t)kk * NP; a0 = fmaf(a, bf2f(vr[lane]), a0); a1 = fmaf(a, bf2f(vr[64 + lane]), a1); }
        const float ss = wave_sum(a0 * a0 + a1 * a1);
        const float rstd = rsqrtf(ss * (1.f / 128.f) + EPS) * 0.8f;
        bf16* orow = MIX + (size_t)(b * SEQ + t) * MIXW + h * 128;
        orow[lane] = (bf16)f2bf(a0 * rstd * p.a_sub_gain[lane]); orow[64 + lane] = (bf16)f2bf(a1 * rstd * p.a_sub_gain[64 + lane]);
        LDS_WAIT(); asm volatile("" ::: "memory");
    }
}

__device__ void ph_dsa_naive(const Params& p, float* lds, int vb, int nvb) {
    const bf16* PROJ = (const bf16*)(p.ws + WS_PROJ); bf16* MIX = (bf16*)(p.ws + WS_MIX);
    const int tid = threadIdx.x, lane = tid & 63, wv = tid >> 6;
    float* scores = lds; int* sel = (int*)(lds + 2048); float* qi = lds + 2048 + 256; float* wi = qi + 256;
    float* qh = wi + 64 + wv * 384; float* pw = qh + 128;
    for (int it = vb; it < T; it += nvb) {
        const int b = it >> 11, t = it & 2047; const int cend = ((t >> 6) + 1) << 6;
        const bf16* row = PROJ + (size_t)it * NP;
        if (tid < 256) qi[tid] = bf2f(row[C_QI + tid]);
        if (tid < 4) wi[tid] = bf2f(row[C_WI + tid]);
        __syncthreads();
        for (int kk = tid; kk < cend; kk += NT) {
            const bf16* kr = PROJ + (size_t)(b * SEQ + kk) * NP + C_KI;
            float s = 0.f;
            for (int h = 0; h < 4; ++h) { float d = 0.f; for (int e = 0; e < 64; ++e) d = fmaf(qi[h * 64 + e], bf2f(kr[e]), d); s += fmaxf(d, 0.f) * wi[h]; }
            scores[kk] = s * 0.0625f;
        }
        __syncthreads();
        int nvalid;
        if (cend <= 256) { if (tid < 256) sel[tid] = tid; nvalid = cend; }
        else {
            for (int i = tid; i < cend; i += NT) { const float si = scores[i]; int rank = 0;
                for (int j = 0; j < cend; ++j) { const float sj = scores[j]; rank += (sj > si || (sj == si && j < i)) ? 1 : 0; }
                if (rank < 256) sel[rank] = i; }
            nvalid = 256;
        }
        __syncthreads();
        {
            const int h = wv; const float slope = exp2f(-(float)(h + 1));
            qh[lane] = bf2f(row[C_QB + h * 128 + lane]); qh[64 + lane] = bf2f(row[C_QB + h * 128 + 64 + lane]);
            LDS_WAIT(); asm volatile("" ::: "memory");
            float sv[4]; float mx = -3e38f;
#pragma unroll
            for (int jj = 0; jj < 4; ++jj) { const int j = lane + 64 * jj; const int key = sel[j < nvalid ? j : 0];
                const bf16* kv = PROJ + (size_t)(b * SEQ + key) * NP + C_KV; float d = 0.f;
                for (int e = 0; e < 128; ++e) d = fmaf(qh[e], bf2f(kv[e]), d);
                d = d * 0.0883883476f - slope * fabsf((float)(t - key));
                sv[jj] = (j < nvalid) ? d : -3e38f; mx = fmaxf(mx, sv[jj]); }
            mx = wave_max(mx); float l = 0.f;
#pragma unroll
            for (int jj = 0; jj < 4; ++jj) { const int j = lane + 64 * jj; const float e = (j < nvalid) ? __expf(sv[jj] - mx) : 0.f; pw[j] = e; l += e; }
            l = wave_sum(l);
            LDS_WAIT(); asm volatile("" ::: "memory");
            float a0 = 0.f, a1 = 0.f;
            for (int j = 0; j < nvalid; ++j) { const float pj = pw[j]; const bf16* kv = PROJ + (size_t)(b * SEQ + sel[j]) * NP + C_KV; a0 = fmaf(pj, bf2f(kv[lane]), a0); a1 = fmaf(pj, bf2f(kv[64 + lane]), a1); }
            const float il = 1.f / l;
            bf16* orow = MIX + (size_t)it * MIXW + 512 + h * 128;
            orow[lane] = (bf16)f2bf(a0 * il); orow[64 + lane] = (bf16)f2bf(a1 * il);
        }
        __syncthreads();
    }
}

__device__ void ph_route_naive(const Params& p, float* lds, int vb, int nvb) {
    const bf16* Q3 = (const bf16*)(p.ws + WS_Q3); const bf16* SUBK = (const bf16*)(p.ws + WS_SUBK);
    int* EXPI = (int*)(p.ws + WS_EXP); float* GATE = (float*)(p.ws + WS_GATE);
    const int tid = threadIdx.x;
    float* q = lds; float* sub = q + 1024; float* sv = sub + 2048; int* si = (int*)(sv + 256); float* cand = sv + 512; float* ts = cand + 2048; int* te = (int*)(ts + 128);
    for (int it = vb; it < T; it += nvb) {
        q[tid] = bf2f(Q3[(size_t)it * 1024 + tid]); q[tid + 512] = bf2f(Q3[(size_t)it * 1024 + tid + 512]);
        __syncthreads();
        for (int r = 0; r < 4; ++r) { const int idx = tid + 512 * r, h = idx >> 8, c = (idx >> 7) & 1, n = idx & 127;
            const float* qq = q + h * 128 + c * 64; const bf16* kk = SUBK + (size_t)(c * 128 + n) * 64; float d = 0.f;
            for (int e = 0; e < 64; ++e) d = fmaf(qq[e], bf2f(kk[e]), d);
            sub[idx] = d; }
        __syncthreads();
        for (int r = 0; r < 4; ++r) { const int idx = tid + 512 * r, g0 = idx & ~127, n = idx & 127; const float s = sub[idx]; int rank = 0;
            for (int j = 0; j < 128; ++j) { const float sj = sub[g0 + j]; rank += (sj > s || (sj == s && j < n)) ? 1 : 0; }
            if (rank < 16) { sv[(g0 >> 7) * 16 + rank] = s; si[(g0 >> 7) * 16 + rank] = n; } }
        __syncthreads();
        for (int r = 0; r < 4; ++r) { const int idx = tid + 512 * r, h = idx >> 8, i = (idx >> 4) & 15, j = idx & 15; cand[idx] = sv[(h * 2) * 16 + i] + sv[(h * 2 + 1) * 16 + j]; }
        __syncthreads();
        for (int r = 0; r < 4; ++r) { const int idx = tid + 512 * r, h = idx >> 8, ij = idx & 255; const float s = cand[idx]; int rank = 0;
            for (int j = 0; j < 256; ++j) { const float sj = cand[h * 256 + j]; rank += (sj > s || (sj == s && j < ij)) ? 1 : 0; }
            if (rank < 16) { ts[h * 16 + rank] = s; te[h * 16 + rank] = si[(h * 2) * 16 + (ij >> 4)] * 128 + si[(h * 2 + 1) * 16 + (ij & 15)]; } }
        __syncthreads();
        if (tid < 128) { const int h = tid >> 4; const float mx = ts[h * 16]; float l = 0.f;
            for (int k = 0; k < 16; ++k) l += __expf(ts[h * 16 + k] - mx);
            GATE[(size_t)it * 128 + tid] = __expf(ts[tid] - mx) / l; EXPI[(size_t)it * 128 + tid] = te[tid]; }
        __syncthreads();
    }
}

__device__ void ph_peer_naive(const Params& p, float* lds, int vb, int nvb) {
    const bf16* H = (const bf16*)(p.ws + WS_H); const bf16* U16 = (const bf16*)(p.ws + WS_U16); const bf16* V16 = (const bf16*)(p.ws + WS_V16);
    const int* EXPI = (const int*)(p.ws + WS_EXP); const float* GATE = (const float*)(p.ws + WS_GATE); const float* MOD = (const float*)(p.ws + WS_MOD);
    const int tid = threadIdx.x, lane = tid & 63, wv = tid >> 6;
    float* xs = lds; float* coef = lds + 1024; int* ex = (int*)(coef + 128);
    for (int it = vb; it < T; it += nvb) {
        xs[tid] = bf2f(H[(size_t)it * 1024 + tid]); xs[tid + 512] = bf2f(H[(size_t)it * 1024 + tid + 512]);
        if (tid < 128) ex[tid] = EXPI[(size_t)it * 128 + tid];
        __syncthreads();
        for (int jj = 0; jj < 16; ++jj) { const int j = wv * 16 + jj; const bf16* ur = U16 + (size_t)ex[j] * 1024; float d = 0.f;
            for (int i = 0; i < 16; ++i) d = fmaf(xs[lane + 64 * i], bf2f(ur[lane + 64 * i]), d);
            d = wave_sum(d);
            if (lane == 0) coef[j] = 0.5f * d * (1.f + erff(d * 0.70710678f)) * GATE[(size_t)it * 128 + j]; }
        __syncthreads();
        const float* g2 = MOD + (size_t)(it >> 11) * 6144 + 5120;
        for (int r = 0; r < 2; ++r) { const int d = tid + 512 * r; float a = 0.f;
            for (int j = 0; j < 128; ++j) a = fmaf(coef[j], bf2f(V16[(size_t)ex[j] * 1024 + d]), a);
            p.out[(size_t)it * 1024 + d] = p.out[(size_t)it * 1024 + d] + g2[d] * a; }
        __syncthreads();
    }
}
struct EpiResGate {
    static constexpr bool PERM = false, AFTER_DRAIN = false;
    const float* X; float* Out; const float* gate;
    __device__ __forceinline__ void operator()(const pg8::f32x4 (&acc)[2][2][4][2], const pg8::Unit& u, int wr, int wc, int fr, int fq) const {
        const int col0 = u.pn * 256 + wc * 32 + 4 * fq;
#pragma unroll
        for (int ai = 0; ai < 2; ++ai)
#pragma unroll
            for (int m = 0; m < 4; ++m) {
                const int r = u.pm * 256 + ai * 128 + wr * 64 + m * 16 + fr; const float* gb = gate + (size_t)(r >> 11) * 6144;
#pragma unroll
                for (int bj = 0; bj < 2; ++bj)
#pragma unroll
                    for (int n = 0; n < 2; ++n) { const int c = col0 + bj * 128 + n * 16; const size_t off = (size_t)r * 1024 + c;
                        const pg8::f32x4 xv = *(const pg8::f32x4*)(X + off), gv = *(const pg8::f32x4*)(gb + c);
                        *(pg8::f32x4*)(Out + off) = xv + gv * acc[ai][bj][m][n]; }
            }
    }
};


struct EpiNormBf16 {
    static constexpr bool PERM = true, AFTER_DRAIN = false;
    bf16* O; const float* gqk; const float* gbq; const float* gbkv; LAS float* P;
    __device__ __forceinline__ void operator()(const pg8::f32x4 (&acc)[2][2][4][2], const pg8::Unit& u, int wr, int wc, int fr, int fq) const {
        const int pn = u.pn;
        const int mode = pn < 4 ? 1 : ((pn == 4 || pn == 5 || pn == 11) ? 0 : (pn == 10 ? 3 : 2));
        if (mode != 0) {
#pragma unroll
            for (int ai = 0; ai < 2; ++ai)
#pragma unroll
                for (int m = 0; m < 4; ++m)
#pragma unroll
                    for (int bj = 0; bj < 2; ++bj) {
                        const pg8::f32x4 a = acc[ai][bj][m][0], b = acc[ai][bj][m][1];
                        float ss = (a[0] * a[0] + a[1] * a[1]) + (a[2] * a[2] + a[3] * a[3]) + (b[0] * b[0] + b[1] * b[1]) + (b[2] * b[2] + b[3] * b[3]);
                        ss += __shfl_xor(ss, 16); ss += __shfl_xor(ss, 32);
                        if (fq == 0) P[(ai * 128 + wr * 64 + m * 16 + fr) * 8 + bj * 4 + wc] = ss;
                    }
            asm volatile("s_waitcnt lgkmcnt(0)" ::: "memory"); __builtin_amdgcn_s_barrier(); asm volatile("" ::: "memory");
        }
        const int row0 = u.pm * 256 + wr * 64 + fr, col0 = u.pn * 256 + wc * 32 + 8 * fq;
        pg8::f32x4 g0[2], g1[2];
#pragma unroll
        for (int bj = 0; bj < 2; ++bj) {
            const float* gp = nullptr;
            if (mode == 1) gp = gqk + (pn >= 2 ? 64 : 0) + 32 * (wc & 1) + 8 * fq;
            else if (mode == 2) gp = gbq + 32 * wc + 8 * fq;
            else if (mode == 3 && bj == 0) gp = gbkv + 32 * wc + 8 * fq;
            if (gp) { g0[bj] = *(const pg8::f32x4*)gp; g1[bj] = *(const pg8::f32x4*)(gp + 4); } else { g0[bj] = (pg8::f32x4){1.f, 1.f, 1.f, 1.f}; g1[bj] = g0[bj]; }
        }
#pragma unroll
        for (int ai = 0; ai < 2; ++ai)
#pragma unroll
            for (int m = 0; m < 4; ++m) { bf16* rowp = O + (size_t)(row0 + ai * 128 + m * 16) * NP + col0;
#pragma unroll
                for (int bj = 0; bj < 2; ++bj) {
                    float s = 1.f;
                    if (mode != 0 && !(mode == 3 && bj == 1)) {
                        const pg8::f32x4 q = *(const LAS pg8::f32x4*)(P + (ai * 128 + wr * 64 + m * 16 + fr) * 8 + bj * 4);
                        s = (mode == 1) ? rsqrtf(((wc < 2) ? (q[0] + q[1]) : (q[2] + q[3])) * (1.f / 64.f) + EPS) : rsqrtf(((q[0] + q[1]) + (q[2] + q[3])) * (1.f / 128.f) + EPS);
                    }
                    const pg8::f32x4 v0 = acc[ai][bj][m][0] * s * g0[bj], v1 = acc[ai][bj][m][1] * s * g1[bj];
                    pg8::u32x4 w; w.x = pg8::cvt_pk_bf16(v0[0], v0[1]); w.y = pg8::cvt_pk_bf16(v0[2], v0[3]); w.z = pg8::cvt_pk_bf16(v1[0], v1[1]); w.w = pg8::cvt_pk_bf16(v1[2], v1[3]);
                    *(pg8::u32x4*)(rowp + bj * 128) = w; } }
    }
};
typedef __bf16 bf16x2_t __attribute__((ext_vector_type(2)));
__device__ __forceinline__ float dot2bf(unsigned a, unsigned b, float acc) { return __builtin_amdgcn_fdot2_f32_bf16(__builtin_bit_cast(bf16x2_t, a), __builtin_bit_cast(bf16x2_t, b), acc, false); }
template <int CTRL> __device__ __forceinline__ float dpp_f(float v) { return __int_as_float(__builtin_amdgcn_update_dpp(0, __float_as_int(v), CTRL, 0xf, 0xf, false)); }
__device__ __forceinline__ float row16_sum(float v) {
    v += dpp_f<0x128>(v); v += dpp_f<0x124>(v); v += dpp_f<0x122>(v); v += dpp_f<0x121>(v); return v;
}
__device__ __forceinline__ float gelu_erf(float v) {
    const float av = fabsf(v), t = __builtin_amdgcn_rcpf(fmaf(av, 0.2316418882f, 1.0f));
    float q = fmaf(t, 0.5307027145f, -0.7265760135f); q = fmaf(q, t, 0.7107068705f); q = fmaf(q, t, -0.142248368f); q = fmaf(q, t, 0.127414796f); q = q * t;
    const float e = __builtin_amdgcn_exp2f(v * v * -0.72134752044f);
    const float m = v * (q * e);
    return v < 0.f ? m : v - m;
}

__device__ __forceinline__ void ph_peer(const Params& p, unsigned char* lds_w, int gw, int ngw, int lane_, float* outp) {
    int lane = lane_; asm volatile("" : "+v"(lane));
    const bf16* H = (const bf16*)(p.ws + WS_H); const bf16* U16 = (const bf16*)(p.ws + WS_U16); const bf16* V16 = (const bf16*)(p.ws + WS_V16);
    const int* EXPI = (const int*)(p.ws + WS_EXP); const float* GATE = (const float*)(p.ws + WS_GATE); const float* MOD = (const float*)(p.ws + WS_MOD);
    int* e_lds = (int*)lds_w; float* a_lds = (float*)(lds_w + 512);
    const int g = lane >> 4, i = lane & 15;
    for (int t = gw; t < T; t += ngw) {
        const int e0 = EXPI[(size_t)t * 128 + lane], e1 = EXPI[(size_t)t * 128 + 64 + lane];
        const float g0 = GATE[(size_t)t * 128 + lane], g1 = GATE[(size_t)t * 128 + 64 + lane];
        e_lds[lane] = e0; e_lds[64 + lane] = e1;
        u32x4 xr[8];
        const u32x4* xrow = (const u32x4*)(H + (size_t)t * 1024) + i;
#pragma unroll
        for (int k = 0; k < 8; ++k) xr[k] = xrow[16 * k];
        LDS_WAIT(); asm volatile("" ::: "memory");
        u32x4 ua[8], ub[8];
        { const u32x4* ur = (const u32x4*)(U16 + (size_t)e_lds[g] * 1024) + i;
#pragma unroll
          for (int k = 0; k < 8; ++k) ua[k] = ur[16 * k]; }
#pragma unroll 1
        for (int s = 0; s < 32; s += 2) {
            { const u32x4* ur = (const u32x4*)(U16 + (size_t)e_lds[4 * (s + 1) + g] * 1024) + i;
#pragma unroll
              for (int k = 0; k < 8; ++k) ub[k] = ur[16 * k]; }
            { float a0 = 0.f, a1 = 0.f, a2 = 0.f, a3 = 0.f;
#pragma unroll
              for (int k = 0; k < 8; ++k) { a0 = dot2bf(ua[k].x, xr[k].x, a0); a1 = dot2bf(ua[k].y, xr[k].y, a1); a2 = dot2bf(ua[k].z, xr[k].z, a2); a3 = dot2bf(ua[k].w, xr[k].w, a3); }
              const float a = row16_sum((a0 + a1) + (a2 + a3));
              if (i == 0) a_lds[4 * s + g] = a; }
            if (s + 2 < 32) { const u32x4* ur = (const u32x4*)(U16 + (size_t)e_lds[4 * (s + 2) + g] * 1024) + i;
#pragma unroll
              for (int k = 0; k < 8; ++k) ua[k] = ur[16 * k]; }
            { float a0 = 0.f, a1 = 0.f, a2 = 0.f, a3 = 0.f;
#pragma unroll
              for (int k = 0; k < 8; ++k) { a0 = dot2bf(ub[k].x, xr[k].x, a0); a1 = dot2bf(ub[k].y, xr[k].y, a1); a2 = dot2bf(ub[k].z, xr[k].z, a2); a3 = dot2bf(ub[k].w, xr[k].w, a3); }
              const float a = row16_sum((a0 + a1) + (a2 + a3));
              if (i == 0) a_lds[4 * (s + 1) + g] = a; }
        }
        LDS_WAIT(); asm volatile("" ::: "memory");
        const float c0 = gelu_erf(a_lds[lane]) * g0, c1 = gelu_erf(a_lds[64 + lane]) * g1;
        const unsigned pw = pk2(c0, c1);
        float acc[16];
#pragma unroll
        for (int q = 0; q < 16; ++q) acc[q] = 0.f;
        u32x4 A0, A1, B0, B1, C0, C1, D0, D1;
#define PEER_VLOAD(j, X0, X1, Y0, Y1) do { const int ea_ = __builtin_amdgcn_readlane(e0, (j)), eb_ = __builtin_amdgcn_readlane(e1, (j)); \
            const u32x4* ra_ = (const u32x4*)(V16 + (size_t)ea_ * 1024) + lane; const u32x4* rb_ = (const u32x4*)(V16 + (size_t)eb_ * 1024) + lane; \
            X0 = ra_[0]; X1 = ra_[64]; Y0 = rb_[0]; Y1 = rb_[64]; } while (0)
#define PEER_VACC(j, X0, X1, Y0, Y1) do { const unsigned cp_ = (unsigned)__builtin_amdgcn_readlane((int)pw, (j)); \
            acc[0] = dot2bf(__builtin_amdgcn_perm(Y0.x, X0.x, 0x05040100u), cp_, acc[0]); acc[1] = dot2bf(__builtin_amdgcn_perm(Y0.x, X0.x, 0x07060302u), cp_, acc[1]); \
            acc[2] = dot2bf(__builtin_amdgcn_perm(Y0.y, X0.y, 0x05040100u), cp_, acc[2]); acc[3] = dot2bf(__builtin_amdgcn_perm(Y0.y, X0.y, 0x07060302u), cp_, acc[3]); \
            acc[4] = dot2bf(__builtin_amdgcn_perm(Y0.z, X0.z, 0x05040100u), cp_, acc[4]); acc[5] = dot2bf(__builtin_amdgcn_perm(Y0.z, X0.z, 0x07060302u), cp_, acc[5]); \
            acc[6] = dot2bf(__builtin_amdgcn_perm(Y0.w, X0.w, 0x05040100u), cp_, acc[6]); acc[7] = dot2bf(__builtin_amdgcn_perm(Y0.w, X0.w, 0x07060302u), cp_, acc[7]); \
            acc[8] = dot2bf(__builtin_amdgcn_perm(Y1.x, X1.x, 0x05040100u), cp_, acc[8]); acc[9] = dot2bf(__builtin_amdgcn_perm(Y1.x, X1.x, 0x07060302u), cp_, acc[9]); \
            acc[10] = dot2bf(__builtin_amdgcn_perm(Y1.y, X1.y, 0x05040100u), cp_, acc[10]); acc[11] = dot2bf(__builtin_amdgcn_perm(Y1.y, X1.y, 0x07060302u), cp_, acc[11]); \
            acc[12] = dot2bf(__builtin_amdgcn_perm(Y1.z, X1.z, 0x05040100u), cp_, acc[12]); acc[13] = dot2bf(__builtin_amdgcn_perm(Y1.z, X1.z, 0x07060302u), cp_, acc[13]); \
            acc[14] = dot2bf(__builtin_amdgcn_perm(Y1.w, X1.w, 0x05040100u), cp_, acc[14]); acc[15] = dot2bf(__builtin_amdgcn_perm(Y1.w, X1.w, 0x07060302u), cp_, acc[15]); } while (0)
        PEER_VLOAD(0, A0, A1, B0, B1);
#pragma unroll 1
        for (int j = 0; j < 64; j += 2) {
            PEER_VLOAD(j + 1, C0, C1, D0, D1);
            PEER_VACC(j, A0, A1, B0, B1);
            if (j + 2 < 64) PEER_VLOAD(j + 2, A0, A1, B0, B1);
            PEER_VACC(j + 1, C0, C1, D0, D1);
        }
#undef PEER_VLOAD
#undef PEER_VACC
        const float* g2 = MOD + (size_t)(t >> 11) * 6144 + 5120;
        const float* xrow1 = p.out + (size_t)t * 1024; float* orow = outp + (size_t)t * 1024;
#pragma unroll
        for (int h = 0; h < 2; ++h)
#pragma unroll
            for (int q = 0; q < 2; ++q) { const int col = 512 * h + 8 * lane + 4 * q;
                const f32x4 xv = *(const f32x4*)(xrow1 + col), gv = *(const f32x4*)(g2 + col);
                f32x4 a; a.x = acc[8 * h + 4 * q]; a.y = acc[8 * h + 4 * q + 1]; a.z = acc[8 * h + 4 * q + 2]; a.w = acc[8 * h + 4 * q + 3];
                *(f32x4*)(orow + col) = xv + gv * a; }
    }
}
typedef short v4i16_t __attribute__((ext_vector_type(4)));
#ifndef DSA_REP_A
#define DSA_REP_A 1
#endif
#ifndef DSA_REP_B
#define DSA_REP_B 1
#endif
#ifndef DSA_REP_C
#define DSA_REP_C 1
#endif
constexpr int DSA_SROW = 2048 * 4 + 16;
constexpr int DSA_SEL_OFF = 16 * DSA_SROW;
constexpr int DSA_LDS = DSA_SEL_OFF + 16 * 512;
constexpr int DSA_KVROW = 272;

__device__ __forceinline__ unsigned sortkey(float s) { const unsigned u = __float_as_uint(s); return u ^ ((u >> 31) ? 0xffffffffu : 0x80000000u); }
__device__ __forceinline__ unsigned cvtpk_bf16(float lo, float hi) { unsigned r; asm volatile("v_cvt_pk_bf16_f32 %0, %1, %2" : "=v"(r) : "v"(lo), "v"(hi)); return r; }

__device__ __forceinline__ void ph_dsa(const Params& p, unsigned char* lds, int vb, int nvb) {
    const bf16* PROJ = (const bf16*)(p.ws + WS_PROJ); bf16* MIX = (bf16*)(p.ws + WS_MIX);
    const float MB = ((const float*)(p.ws + WS_SCAL))[SC_MB];
    int tid = threadIdx.x; asm volatile("" : "+v"(tid)); const int lane = tid & 63, wv = __builtin_amdgcn_readfirstlane(tid >> 6);
    const int l15 = lane & 15, g = lane >> 4;
    LAS unsigned char* ldsl = (LAS unsigned char*)lds;
    for (int it = vb; it < 2048; it += nvb) {
        const int vbb = it & 255, kk = it >> 8, xg = vbb & 7, ix = vbb >> 3, b = 2 * xg + (ix & 1), G = (ix >> 1) & 3, sub = ix >> 3;
        const int c = (kk & 1) ? (31 - G - 8 * (kk >> 1)) : (G + 8 * (kk >> 1));
        const int cend = (c + 1) * 64, t0 = c * 64 + sub * 16;
        const bf16* Pb = PROJ + (size_t)b * SEQ * NP;
#pragma unroll 1
        for (int repa = 0; repa < DSA_REP_A; ++repa)
        if (c >= 4) {
            const bf16* qrow = Pb + (size_t)(t0 + l15) * NP;
            bf16x8 bq[4][2]; float wsc[4];
#pragma unroll
            for (int h = 0; h < 4; ++h) { wsc[h] = bf2f(qrow[C_WI + h]) * 0.0625f;
#pragma unroll
                for (int ks = 0; ks < 2; ++ks) bq[h][ks] = *(const bf16x8*)(qrow + C_QI + h * 64 + 32 * ks + 8 * g); }
            for (int k0 = 16 * wv; k0 < cend; k0 += 128) {
                const bf16* krow = Pb + (size_t)(k0 + l15) * NP + C_KI + 8 * g;
                const bf16x8 ka0 = *(const bf16x8*)krow, ka1 = *(const bf16x8*)(krow + 32);
                f32x4 sc = {0.f, 0.f, 0.f, 0.f};
#pragma unroll
                for (int h = 0; h < 4; ++h) { f32x4 a = {0.f, 0.f, 0.f, 0.f};
                    a = __builtin_amdgcn_mfma_f32_16x16x32_bf16(ka0, bq[h][0], a, 0, 0, 0);
                    a = __builtin_amdgcn_mfma_f32_16x16x32_bf16(ka1, bq[h][1], a, 0, 0, 0);
#pragma unroll
                    for (int r = 0; r < 4; ++r) sc[r] = fmaf(fmaxf(a[r], 0.f), wsc[h], sc[r]); }
#pragma unroll
                for (int r = 0; r < 4; ++r) sc[r] = (sc[r] == 0.f) ? 0.f : sc[r];
                *(LAS f32x4*)(ldsl + l15 * DSA_SROW + (k0 + 4 * g) * 4) = sc;
            }
        }
        __syncthreads();
        LAS unsigned short* selw = (LAS unsigned short*)(ldsl + DSA_SEL_OFF);
        int mind0 = 0, mind1 = 0;
        if (c < 4) {
            for (int j = lane; j < 256; j += 64) { selw[(2 * wv) * 256 + j] = (unsigned short)j; selw[(2 * wv + 1) * 256 + j] = (unsigned short)j; }
        } else {
            const int nreg = cend >> 6;
            unsigned keyA[32], keyB[32];
            { const LAS float* srA = (const LAS float*)(ldsl + (2 * wv) * DSA_SROW) + lane; const LAS float* srB = (const LAS float*)(ldsl + (2 * wv + 1) * DSA_SROW) + lane;
#pragma unroll
              for (int i = 0; i < 32; ++i) { keyA[i] = (i < nreg) ? sortkey(srA[64 * i]) : 0u; keyB[i] = (i < nreg) ? sortkey(srB[64 * i]) : 0u; } }
#define DSA_WSUM(V, OUT) do { int v_ = (V); v_ += __builtin_amdgcn_update_dpp(0, v_, 0x128, 0xf, 0xf, false); v_ += __builtin_amdgcn_update_dpp(0, v_, 0x124, 0xf, 0xf, false); \
        v_ += __builtin_amdgcn_update_dpp(0, v_, 0x122, 0xf, 0xf, false); v_ += __builtin_amdgcn_update_dpp(0, v_, 0x121, 0xf, 0xf, false);                                     \
        OUT = __builtin_amdgcn_readlane(v_, 0) + __builtin_amdgcn_readlane(v_, 16) + __builtin_amdgcn_readlane(v_, 32) + __builtin_amdgcn_readlane(v_, 48); } while (0)
            unsigned prefA = 0u, prefB = 0u; bool exA = false, exB = false;
#pragma unroll 1
            for (int bit = 31; bit >= 0; --bit) {
                const unsigned candA = exA ? prefA : (prefA | (1u << bit)), candB = exB ? prefB : (prefB | (1u << bit));
                int ca = 0, cb = 0;
#pragma unroll
                for (int i = 0; i < 32; ++i) { ca += (keyA[i] >= candA) ? 1 : 0; cb += (keyB[i] >= candB) ? 1 : 0; }
                int cntA, cntB; DSA_WSUM(ca, cntA); DSA_WSUM(cb, cntB);
                if (!exA && cntA >= 256) { prefA = candA; exA = (cntA == 256); }
                if (!exB && cntB >= 256) { prefB = candB; exB = (cntB == 256); }
                if (exA && exB) break;
            }
#define DSA_COMPACT(KEY, PREFIX, EXACT, QQ, MIND) do {                                                                                              \
            const int t_ = t0 + (QQ); LAS unsigned short* sel = selw + (QQ) * 256;                                                                    \
            int need_ties = 0;                                                                                                                        \
            if (!(EXACT)) { int cg_ = 0; if ((PREFIX) != 0xffffffffu) { _Pragma("unroll") for (int i = 0; i < 32; ++i) cg_ += (KEY[i] > (PREFIX)) ? 1 : 0; } \
                int cgt; DSA_WSUM(cg_, cgt); need_ties = 256 - cgt; }                                                                                 \
            int base = 0, tbase = 0, md = 4096;                                                                                                       \
            _Pragma("unroll") for (int i = 0; i < 32; ++i) { if (i < nreg) {                                                                          \
                bool selb;                                                                                                                            \
                if (EXACT) selb = KEY[i] >= (PREFIX);                                                                                                 \
                else { const bool tie = KEY[i] == (PREFIX); const unsigned long long mt = __ballot(tie);                                              \
                    const int trank = tbase + (int)__builtin_amdgcn_mbcnt_hi((unsigned)(mt >> 32), __builtin_amdgcn_mbcnt_lo((unsigned)mt, 0u));      \
                    selb = (KEY[i] > (PREFIX)) || (tie && trank < need_ties); tbase += __popcll(mt); }                                                \
                const unsigned long long m = __ballot(selb);                                                                                          \
                const int pos = base + (int)__builtin_amdgcn_mbcnt_hi((unsigned)(m >> 32), __builtin_amdgcn_mbcnt_lo((unsigned)m, 0u));               \
                const int kidx = i * 64 + lane;                                                                                                       \
                if (selb) { sel[pos] = (unsigned short)kidx; const int d = t_ > kidx ? t_ - kidx : kidx - t_; md = d < md ? d : md; }                 \
                base += __popcll(m); } }                                                                                                              \
            _Pragma("unroll") for (int o = 1; o < 64; o <<= 1) { const int x = __shfl_xor(md, o); md = x < md ? x : md; }                             \
            MIND = md; } while (0)
            DSA_COMPACT(keyA, prefA, exA, 2 * wv, mind0);
            DSA_COMPACT(keyB, prefB, exB, 2 * wv + 1, mind1);
#undef DSA_COMPACT
#undef DSA_WSUM
        }
        LDS_WAIT(); asm volatile("" ::: "memory");
        const int nvalid = cend < 256 ? cend : 256;
        const int head = lane & 7;
        const float slopeL2 = exp2f(-(float)(head + 1)) * 1.4426950409f;
#pragma unroll 1
        for (int qi2 = 0; qi2 < 2 * DSA_REP_C; ++qi2) { const int qi = qi2 & 1;
            const int qq = 2 * wv + qi, t = t0 + qq;
            const LAS unsigned short* sel = selw + qq * 256;
            LAS unsigned char* stg = ldsl + (2 * wv) * DSA_SROW;
            const bf16* qrow = Pb + (size_t)t * NP + C_QB + head * 128 + 8 * g;
            bf16x8 bq[4];
#pragma unroll
            for (int ks = 0; ks < 4; ++ks) bq[ks] = *(const bf16x8*)(qrow + 32 * ks);
            const float refL2 = MB * 1.4426950409f - slopeL2 * (float)(qi == 0 ? mind0 : mind1);
            f32x4 o[8];
#pragma unroll
            for (int dt = 0; dt < 8; ++dt) o[dt] = (f32x4){0.f, 0.f, 0.f, 0.f};
            float lsum = 0.f;
#define DSA_GATHER(S, KA) do { _Pragma("unroll") for (int i_ = 0; i_ < 8; ++i_) { const int jr = 32 * (S) + 4 * i_ + g; const int keyr = sel[jr < nvalid ? jr : 0];   \
        KA[i_] = *(const bf16x8*)(Pb + (size_t)keyr * NP + C_KV + 8 * l15); } } while (0)
#define DSA_COMPUTE(S, KA) do { unsigned pb[4];                                                                                                        \
        _Pragma("unroll") for (int i_ = 0; i_ < 8; ++i_) *(LAS bf16x8*)(stg + (4 * i_ + g) * DSA_KVROW + 16 * l15) = KA[i_];                              \
        LDS_WAIT(); asm volatile("" ::: "memory");                                                                                                        \
        _Pragma("unroll") for (int tl = 0; tl < 2; ++tl) { const int j0 = 32 * (S) + 16 * tl;                                                           \
            f32x4 a = {0.f, 0.f, 0.f, 0.f};                                                                                                             \
            _Pragma("unroll") for (int ks = 0; ks < 4; ++ks) { const bf16x8 ka_ = *(const LAS bf16x8*)(stg + (16 * tl + l15) * DSA_KVROW + (32 * ks + 8 * g) * 2); \
                a = __builtin_amdgcn_mfma_f32_16x16x32_bf16(ka_, bq[ks], a, 0, 0, 0); }                                                                 \
            const u32x2 kw = *(const LAS u32x2*)(sel + j0 + 4 * g);                                                                                     \
            const int kx[4] = {(int)(kw.x & 0xffffu), (int)(kw.x >> 16), (int)(kw.y & 0xffffu), (int)(kw.y >> 16)};                                     \
            float pr[4];                                                                                                                                \
            _Pragma("unroll") for (int r = 0; r < 4; ++r) { const int dd = t > kx[r] ? t - kx[r] : kx[r] - t;                                            \
                const float e = __builtin_amdgcn_exp2f(fmaf(a[r], 0.1275174f, -slopeL2 * (float)dd - refL2));                                            \
                pr[r] = (j0 + 4 * g + r < nvalid) ? e : 0.f; lsum += pr[r]; }                                                                           \
            pb[2 * tl] = cvtpk_bf16(pr[0], pr[1]); pb[2 * tl + 1] = cvtpk_bf16(pr[2], pr[3]); }                                                         \
        LDS_WAIT(); asm volatile("" ::: "memory");                                                                                                      \
        u32x4 pw4; pw4.x = pb[0]; pw4.y = pb[1]; pw4.z = pb[2]; pw4.w = pb[3];                                                                          \
        const bf16x8 pfrag = __builtin_bit_cast(bf16x8, pw4);                                                                                           \
        const LAS unsigned char* trb = stg + (4 * g + (l15 >> 2)) * DSA_KVROW + (4 * (lane & 3)) * 2;                                                   \
        _Pragma("unroll") for (int dt = 0; dt < 8; ++dt) {                                                                                              \
            const s16x4 lo = __builtin_bit_cast(s16x4, __builtin_amdgcn_ds_read_tr16_b64_v4i16((LAS v4i16_t*)(trb + dt * 32)));                         \
            const s16x4 hi = __builtin_bit_cast(s16x4, __builtin_amdgcn_ds_read_tr16_b64_v4i16((LAS v4i16_t*)(trb + 16 * DSA_KVROW + dt * 32)));        \
            const bf16x8 af = {lo[0], lo[1], lo[2], lo[3], hi[0], hi[1], hi[2], hi[3]};                                                                 \
            o[dt] = __builtin_amdgcn_mfma_f32_16x16x32_bf16(af, pfrag, o[dt], 0, 0, 0); }                                                               \
        LDS_WAIT(); asm volatile("" ::: "memory"); } while (0)
            const int nch = (nvalid + 31) >> 5;
            bf16x8 KA[8], KB[8];
            DSA_GATHER(0, KA);
#pragma unroll 1
            for (int s = 0; s < nch; s += 2) {
                if (s + 1 < nch) DSA_GATHER(s + 1, KB);
                DSA_COMPUTE(s, KA);
                if (s + 1 < nch) { if (s + 2 < nch) DSA_GATHER(s + 2, KA); DSA_COMPUTE(s + 1, KB); }
            }
#undef DSA_GATHER
#undef DSA_COMPUTE
            lsum += __shfl_xor(lsum, 16); lsum += __shfl_xor(lsum, 32);
            const float il = 1.f / lsum;
            if (l15 < 8) {
                bf16* orow = MIX + (size_t)(b * SEQ + t) * MIXW + 512 + head * 128 + 4 * g;
#pragma unroll
                for (int dt = 0; dt < 8; ++dt) { u32x2 w; w.x = pk2(o[dt][0] * il, o[dt][1] * il); w.y = pk2(o[dt][2] * il, o[dt][3] * il); *(u32x2*)(orow + 16 * dt) = w; }
            }
        }
        __syncthreads();
    }
}
typedef __attribute__((address_space(1))) float GASF;
#ifndef ATT_REMAP
#define ATT_REMAP 1
#endif
__device__ __forceinline__ int crow(int r, int hi) { return (r & 3) + 8 * (r >> 2) + 4 * hi; }
#define KSWZ64(row, cb) ((row) * 128 + ((cb) ^ ((((row) >> 1) & 7) << 4)))
__device__ __forceinline__ int v_st(int k, int c) { const int kk = (k & ~0xC) | ((k & 4) << 1) | ((k & 8) >> 1); return ((kk >> 3) * 4 + (c >> 5)) * 512 + ((kk & 7) * 32 + (c & 31)) * 2; }
__device__ __forceinline__ int v_rd_base(int lane) { return ((lane & 3) << 3) | (((lane >> 2) & 3) << 6) | (((lane >> 4) & 1) << 5) | (((lane >> 5) & 1) << 8); }
constexpr int v_rd_off(int d0, int ks, int half) { return d0 * 512 + ks * 4096 + half * 2048; }
template <int OFF> __device__ __forceinline__ s16x4 tr_read(int vb) {
    s16x4 r; asm volatile("ds_read_b64_tr_b16 %0, %1 offset:%2" : "=&v"(r) : "v"(vb), "i"(OFF) : "memory"); return r;
}
template <int D0> __device__ __forceinline__ void pv_one(f32x16& od, int vb, bf16x8 pa0, bf16x8 pa1, bf16x8 pa2, bf16x8 pa3) {
    const s16x4 l0 = tr_read<v_rd_off(D0, 0, 0)>(vb), h0 = tr_read<v_rd_off(D0, 0, 1)>(vb), l1 = tr_read<v_rd_off(D0, 1, 0)>(vb), h1 = tr_read<v_rd_off(D0, 1, 1)>(vb);
    const s16x4 l2 = tr_read<v_rd_off(D0, 2, 0)>(vb), h2 = tr_read<v_rd_off(D0, 2, 1)>(vb), l3 = tr_read<v_rd_off(D0, 3, 0)>(vb), h3 = tr_read<v_rd_off(D0, 3, 1)>(vb);
    asm volatile("s_waitcnt lgkmcnt(0)" ::: "memory"); __builtin_amdgcn_sched_barrier(0);
#define PK(L, H) (bf16x8){L[0], L[1], L[2], L[3], H[0], H[1], H[2], H[3]}
    od = __builtin_amdgcn_mfma_f32_32x32x16_bf16(pa0, PK(l0, h0), od, 0, 0, 0);
    od = __builtin_amdgcn_mfma_f32_32x32x16_bf16(pa1, PK(l1, h1), od, 0, 0, 0);
    od = __builtin_amdgcn_mfma_f32_32x32x16_bf16(pa2, PK(l2, h2), od, 0, 0, 0);
    od = __builtin_amdgcn_mfma_f32_32x32x16_bf16(pa3, PK(l3, h3), od, 0, 0, 0);
#undef PK
}
constexpr int ATT_LDS = 2 * 16384 + 2 * 8192 + 8 * 256;

__device__ __forceinline__ void ph_attnA(const Params& p, unsigned char* lds, int vb, int nvb) {
    const bf16* PROJ = (const bf16*)(p.ws + WS_PROJ); bf16* MIX = (bf16*)(p.ws + WS_MIX);
    const float* SC = (const float*)(p.ws + WS_SCAL);
    const float lam = SC[SC_LAM], refL2 = SC[SC_MA] * 1.4426950409f;
    constexpr float C = 0.125f * 1.4426950409f;
    int tid = threadIdx.x; asm volatile("" : "+v"(tid)); const int lane = tid & 63, wid = __builtin_amdgcn_readfirstlane(tid >> 6), r32 = lane & 31, hi = lane >> 5;
    unsigned char* V_lds = lds; unsigned char* K_lds = lds + 32768;
    float* wsf = (float*)(lds + 49152) + wid * 64;
    GASF* tmpw = (GASF*)(p.ws + WS_ATMP) + ((size_t)(vb * NWV + wid) * 64) * 64 + lane;
    const int vbase = (int)(uintptr_t)V_lds + v_rd_base(lane);
    const int krow = tid >> 3, kch = tid & 7, kdst = KSWZ64(krow, kch * 16);
    const int sr = tid >> 4, sc = (tid & 15) * 8, vst0 = v_st(sr, sc), vst1 = v_st(32 + sr, sc);
    for (int it = vb; it < 256; it += nvb) {
        #if ATT_REMAP
        const int xg_ = it & 7, m_ = it >> 3, pidx = xg_ * 8 + (m_ >> 2), qbl = m_ & 3, b = pidx >> 2, h = pidx & 3;
#else
        const int b = it >> 4, h = (it >> 2) & 3, qbl = it & 3;
#endif
        const float slopeL2 = exp2f(-2.0f * (float)(h + 1)) * 1.4426950409f;
        const bf16* Pb = PROJ + (size_t)b * SEQ * NP;
#pragma unroll 1
        for (int half = 0; half < 2; ++half) {
            const int qb = half ? 7 - qbl : qbl, q0 = 256 * qb, NTu = 4 * (qb + 1), cw = 4 * qb + (wid >> 1);
            const int tq = q0 + 32 * wid + r32;
#pragma unroll 1
            for (int mi = 0; mi < 2; ++mi) {
                const int m = 1 - mi;
                const bf16* Kg = Pb + C_KA + h * 128 + m * 64 + (size_t)krow * NP + kch * 8;
                const bf16* Vg = Pb + C_VA + h * 128 + (size_t)sr * NP + sc;
                bf16x8 qr[4];
                { const bf16* qp = Pb + (size_t)tq * NP + C_QA + h * 128 + m * 64 + hi * 8;
#pragma unroll
                  for (int d0 = 0; d0 < 4; ++d0) qr[d0] = *(const bf16x8*)(qp + d0 * 16); }
                f32x16 o[4];
#pragma unroll
                for (int d = 0; d < 4; ++d) o[d] = f32x16{};
                float lsum = 0.f;
                bf16x8 sk, sv0, sv1;
                sk = *(const bf16x8*)Kg; sv0 = *(const bf16x8*)Vg; sv1 = *(const bf16x8*)(Vg + (size_t)32 * NP);
                *(bf16x8*)(K_lds + kdst) = sk; *(bf16x8*)(V_lds + vst0) = sv0; *(bf16x8*)(V_lds + vst1) = sv1;
                __syncthreads();
#pragma unroll 1
                for (int j = 0; j < NTu; ++j) {
                    const int buf = j & 1;
                    if (j + 1 < NTu) { const size_t go = (size_t)(j + 1) * 64 * NP; sk = *(const bf16x8*)(Kg + go); sv0 = *(const bf16x8*)(Vg + go); sv1 = *(const bf16x8*)(Vg + go + (size_t)32 * NP); }
                    if (j <= cw) {
                        const unsigned char* Kb = K_lds + buf * 8192;
                        const float dq = (float)(tq - 64 * j - 4 * hi);
                        const float B0 = -slopeL2 * dq - refL2;
                        const bool past = j < cw;
                        float ps = 0.f;
                        bf16x8 pa0, pa1, pa2, pa3;
#define PK4(P, BASE, OUT) do { unsigned a0 = cvtpk_bf16(P[BASE + 0], P[BASE + 1]), a1 = cvtpk_bf16(P[BASE + 2], P[BASE + 3]);   \
    unsigned b0_ = cvtpk_bf16(P[BASE + 4], P[BASE + 5]), b1_ = cvtpk_bf16(P[BASE + 6], P[BASE + 7]);                              \
    auto r0 = __builtin_amdgcn_permlane32_swap(a0, b0_, false, false); auto r1 = __builtin_amdgcn_permlane32_swap(a1, b1_, false, false); \
    u32x4 w = {r0[0], r1[0], r0[1], r1[1]}; OUT = __builtin_bit_cast(bf16x8, w); } while (0)
#define HALF_TILE(KOFF, FOFF, PA, PB) do { f32x16 pp = f32x16{};                                                                     \
    _Pragma("unroll") for (int d0 = 0; d0 < 4; ++d0) { const int cb = (d0 * 16 + hi * 8) * 2;                                        \
        const bf16x8 bk = *(const bf16x8*)(Kb + KSWZ64((KOFF) + r32, cb)); pp = __builtin_amdgcn_mfma_f32_32x32x16_bf16(bk, qr[d0], pp, 0, 0, 0); } \
    if (past) { _Pragma("unroll") for (int r = 0; r < 16; ++r) { const float off = (float)((r & 3) + 8 * (r >> 2)) + (FOFF);          \
            pp[r] = __builtin_amdgcn_exp2f(fmaf(pp[r], C, fmaf(slopeL2, off, B0))); } }                                               \
    else { _Pragma("unroll") for (int r = 0; r < 16; ++r) { const float off = (float)((r & 3) + 8 * (r >> 2)) + (FOFF);               \
            pp[r] = __builtin_amdgcn_exp2f(fmaf(pp[r], C, -slopeL2 * fabsf(dq - off) - refL2)); } }                                   \
    _Pragma("unroll") for (int r = 0; r < 16; ++r) ps += pp[r];                                                                       \
    PK4(pp, 0, PA); PK4(pp, 8, PB); __builtin_amdgcn_sched_barrier(0); } while (0)
                        HALF_TILE(0, 0.f, pa0, pa1);
                        HALF_TILE(32, 32.f, pa2, pa3);
#undef HALF_TILE
#undef PK4
                        { auto rr = __builtin_amdgcn_permlane32_swap(__float_as_uint(ps), __float_as_uint(ps), false, false);
                          ps = __uint_as_float(rr[0]) + __uint_as_float(rr[1]); }
                        lsum += ps;
                        const int vb0 = vbase + buf * 16384;
                        pv_one<0>(o[0], vb0, pa0, pa1, pa2, pa3); pv_one<1>(o[1], vb0, pa0, pa1, pa2, pa3); pv_one<2>(o[2], vb0, pa0, pa1, pa2, pa3); pv_one<3>(o[3], vb0, pa0, pa1, pa2, pa3);
                    }
                    if (j + 1 < NTu) { const int nb = buf ^ 1;
                        *(bf16x8*)(K_lds + nb * 8192 + kdst) = sk; *(bf16x8*)(V_lds + nb * 16384 + vst0) = sv0; *(bf16x8*)(V_lds + nb * 16384 + vst1) = sv1; }
                    __syncthreads();
                }
                if (hi == 0) wsf[r32] = lsum;
                LDS_WAIT(); asm volatile("" ::: "memory");
                float rli[16];
#pragma unroll
                for (int r = 0; r < 16; ++r) rli[r] = 1.f / wsf[crow(r, hi)];
                LDS_WAIT(); asm volatile("" ::: "memory");
                if (mi == 0) {
#pragma unroll
                    for (int d = 0; d < 4; ++d) { GASF* td = tmpw + d * 1024; asm volatile("" : "+v"(td));
#pragma unroll
                        for (int r = 0; r < 16; ++r) td[r * 64] = o[d][r] * rli[r]; }
                } else {
                    float gsub[4];
#pragma unroll
                    for (int d = 0; d < 4; ++d) gsub[d] = p.a_sub_gain[32 * d + r32];
                    GASF* tdp[4];
#pragma unroll
                    for (int d = 0; d < 4; ++d) { tdp[d] = tmpw + d * 1024; asm volatile("" : "+v"(tdp[d])); }
#pragma unroll
                    for (int r = 0; r < 16; ++r) {
                        float v[4]; float ss = 0.f;
#pragma unroll
                        for (int d = 0; d < 4; ++d) { v[d] = o[d][r] * rli[r] - lam * tdp[d][r * 64]; ss += v[d] * v[d]; }
                        ss += __shfl_xor(ss, 1); ss += __shfl_xor(ss, 2); ss += __shfl_xor(ss, 4); ss += __shfl_xor(ss, 8); ss += __shfl_xor(ss, 16);
                        const float rs = rsqrtf(ss * (1.f / 128.f) + EPS) * 0.8f;
                        bf16* orow = MIX + (size_t)(b * SEQ + q0 + 32 * wid + crow(r, hi)) * MIXW + h * 128 + r32;
#pragma unroll
                        for (int d = 0; d < 4; ++d) orow[32 * d] = (bf16)f2bf(v[d] * rs * gsub[d]);
                        asm volatile("" ::: "memory");
                    }
                }
            }
        }
    }
}
constexpr int RT_WAVE_BYTES = 12288;
constexpr int RT_LDS = 32768 + 8 * RT_WAVE_BYTES;

__device__ __forceinline__ int pl32_sum(int v) { auto rr = __builtin_amdgcn_permlane32_swap((unsigned)v, (unsigned)v, false, false); return (int)(rr[0] + rr[1]); }
__device__ __forceinline__ int pl32_other(int v) { auto rr = __builtin_amdgcn_permlane32_swap((unsigned)v, (unsigned)v, false, false); return (int)(rr[0] + rr[1]) - v; }
__device__ __forceinline__ float unsortkey(unsigned k) { return __uint_as_float((k & 0x80000000u) ? (k ^ 0x80000000u) : ~k); }

template <int N> __device__ __forceinline__ unsigned bisect16(const unsigned (&key)[N]) {
    unsigned prefix = 0u; bool done = false;
#pragma unroll 1
    for (int bit = 31; bit >= 0; --bit) {
        const unsigned cand = done ? prefix : (prefix | (1u << bit));
        int cnt = 0;
#pragma unroll
        for (int i = 0; i < N; ++i) cnt += (key[i] >= cand) ? 1 : 0;
        const int tot = pl32_sum(cnt);
        if (!done && tot >= 16) { prefix = cand; done = (tot == 16); }
        if (__all(done)) break;
    }
    return prefix;
}

__device__ __forceinline__ void ph_route(const Params& p, unsigned char* lds, int vb, int nvb) {
    const bf16* Q3 = (const bf16*)(p.ws + WS_Q3); const bf16* SUBK = (const bf16*)(p.ws + WS_SUBK);
    int* EXPI = (int*)(p.ws + WS_EXP); float* GATE = (float*)(p.ws + WS_GATE);
    int tid = threadIdx.x; asm volatile("" : "+v"(tid));
    const int lane = tid & 63, wv = __builtin_amdgcn_readfirstlane(tid >> 6), r32 = lane & 31, hi = lane >> 5;
    for (int i = tid; i < 2048; i += NT) { const int row = i >> 3, ch = i & 7; ((u32x4*)lds)[row * 8 + (ch ^ ((row >> 1) & 7))] = ((const u32x4*)SUBK)[i]; }
    __syncthreads();
    unsigned char* wl = lds + 32768 + wv * RT_WAVE_BYTES;
    float* sv = (float*)wl; int* si = (int*)(wl + 4096); float* fv = (float*)(wl + 8192); int* fe = (int*)(wl + 10240);
    const int gw = vb * NWV + wv, ngw = nvb * NWV;
    for (int item = gw; item < (T / 32) * 8; item += ngw) {
        const int h = item & 7, tok0 = (item >> 3) * 32;
        const bf16* qrow = Q3 + (size_t)(tok0 + r32) * 1024 + h * 128 + hi * 8;
#pragma unroll 1
        for (int c = 0; c < 2; ++c) {
            bf16x8 bq[4];
#pragma unroll
            for (int d0 = 0; d0 < 4; ++d0) bq[d0] = *(const bf16x8*)(qrow + c * 64 + d0 * 16);
            unsigned key[64];
#pragma unroll
            for (int nt = 0; nt < 4; ++nt) {
                f32x16 acc = f32x16{};
                const int krow = c * 128 + nt * 32 + r32, ksw = (krow >> 1) & 7;
                const unsigned char* kp = lds + krow * 128;
#pragma unroll
                for (int d0 = 0; d0 < 4; ++d0) { const bf16x8 ak = *(const bf16x8*)(kp + (((2 * d0 + hi) ^ ksw) << 4)); acc = __builtin_amdgcn_mfma_f32_32x32x16_bf16(ak, bq[d0], acc, 0, 0, 0); }
#pragma unroll
                for (int r = 0; r < 16; ++r) key[nt * 16 + r] = sortkey(acc[r]);
            }
            const unsigned thr = bisect16<64>(key);
            int cnt = 0;
#pragma unroll
            for (int i = 0; i < 64; ++i) cnt += (key[i] >= thr) ? 1 : 0;
            const int other_ = pl32_other(cnt); int slot = hi ? other_ : 0;
            float* svp = sv + (r32 * 2 + c) * 16; int* sip = si + (r32 * 2 + c) * 16;
#pragma unroll
            for (int i = 0; i < 64; ++i) {
                if (key[i] >= thr && slot < 16) { svp[slot] = unsortkey(key[i]); sip[slot] = 32 * (i >> 4) + ((i & 3) + 8 * ((i & 15) >> 2)) + 4 * hi; ++slot; }
            }
        }
        LDS_WAIT(); asm volatile("" ::: "memory");
        {
            float* sv0 = sv + (r32 * 2) * 16; float* sv1 = sv0 + 16; int* si0 = si + (r32 * 2) * 16; int* si1 = si0 + 16;
            {
                float a[16], bl[16];
#pragma unroll
                for (int k = 0; k < 16; ++k) { a[k] = sv0[k]; bl[k] = sv1[k]; }
                int ia[8], ib[8], ra[8], rb[8]; float va[8], vb[8];
#pragma unroll
                for (int q = 0; q < 8; ++q) { const int e = 8 * hi + q; va[q] = sv0[e]; vb[q] = sv1[e]; ia[q] = si0[e]; ib[q] = si1[e]; int r0 = 0, r1 = 0;
#pragma unroll
                    for (int k = 0; k < 16; ++k) { r0 += (a[k] > va[q] || (a[k] == va[q] && k < e)) ? 1 : 0; r1 += (bl[k] > vb[q] || (bl[k] == vb[q] && k < e)) ? 1 : 0; }
                    ra[q] = r0; rb[q] = r1; }
                LDS_WAIT(); asm volatile("" ::: "memory");
                { auto rr = __builtin_amdgcn_permlane32_swap(0u, 0u, false, false); (void)rr; }
#pragma unroll
                for (int q = 0; q < 8; ++q) { sv0[ra[q]] = va[q]; si0[ra[q]] = ia[q]; sv1[rb[q]] = vb[q]; si1[rb[q]] = ib[q]; }
                LDS_WAIT(); asm volatile("" ::: "memory");
            }
            const float* X = hi ? sv1 : sv0; const float* Y = hi ? sv0 : sv1;
            float x[4], y[16];
#pragma unroll
            for (int k = 0; k < 4; ++k) x[k] = X[k];
#pragma unroll
            for (int k = 0; k < 16; ++k) y[k] = Y[k];
            unsigned key[27]; int pi[27], pj[27]; int np = 0;
#pragma unroll
            for (int i = 0; i < 3; ++i)
#pragma unroll
                for (int j = i + 1; j < 16; ++j) if ((i + 1) * (j + 1) <= 16) { key[np] = sortkey(x[i] + y[j]); pi[np] = i; pj[np] = j; ++np; }
#pragma unroll
            for (int i = 0; i < 4; ++i) { key[23 + i] = hi ? 0u : sortkey(x[i] + y[i]); pi[23 + i] = i; pj[23 + i] = i; }
            const unsigned thr = bisect16<27>(key);
            int cnt = 0;
#pragma unroll
            for (int i = 0; i < 27; ++i) cnt += (key[i] >= thr) ? 1 : 0;
            const int other_ = pl32_other(cnt); int slot = hi ? other_ : 0;
            const int* IX = hi ? si1 : si0; const int* IY = hi ? si0 : si1;
            float* fvp = fv + r32 * 16; int* fep = fe + r32 * 16;
#pragma unroll
            for (int i = 0; i < 27; ++i) {
                if (key[i] >= thr && slot < 16) { const int ex = IX[pi[i]], ey = IY[pj[i]]; fvp[slot] = unsortkey(key[i]); fep[slot] = hi ? (ey * 128 + ex) : (ex * 128 + ey); ++slot; }
            }
        }
        LDS_WAIT(); asm volatile("" ::: "memory");
        {
            const float* fvp = fv + r32 * 16;
            float v[16]; float mx = -3e38f;
#pragma unroll
            for (int k = 0; k < 16; ++k) { v[k] = fvp[k]; mx = fmaxf(mx, v[k]); }
            float l = 0.f;
#pragma unroll
            for (int k = 0; k < 16; ++k) { v[k] = __expf(v[k] - mx); l += v[k]; }
            const float il = 1.f / l;
            const size_t ob = (size_t)(tok0 + r32) * 128 + h * 16 + 8 * hi;
            const int* fep = fe + r32 * 16 + 8 * hi;
            f32x4 g0, g1; u32x4 e0, e1;
            if (hi == 0) { g0 = (f32x4){v[0] * il, v[1] * il, v[2] * il, v[3] * il}; g1 = (f32x4){v[4] * il, v[5] * il, v[6] * il, v[7] * il}; }
            else { g0 = (f32x4){v[8] * il, v[9] * il, v[10] * il, v[11] * il}; g1 = (f32x4){v[12] * il, v[13] * il, v[14] * il, v[15] * il}; }
            e0 = *(const u32x4*)fep; e1 = *(const u32x4*)(fep + 4);
            *(f32x4*)(GATE + ob) = g0; *(f32x4*)(GATE + ob + 4) = g1;
            *(u32x4*)(EXPI + ob) = e0; *(u32x4*)(EXPI + ob + 4) = e1;
        }
        LDS_WAIT(); asm volatile("" ::: "memory");
    }
    __syncthreads();
}
constexpr int PU_UNITS = T / 64;
constexpr int CW_PEER_U = 4096, CW_PEER_V = 4096 + 16 * 64;

__device__ __forceinline__ unsigned peer_xcc() { return (unsigned)__builtin_amdgcn_s_getreg((3 << 11) | 20) & 7u; }

__device__ __forceinline__ void ph_peer_u(const Params& p, unsigned char* lds, int cwbase) {
    const bf16* H = (const bf16*)(p.ws + WS_H); const bf16* U16 = (const bf16*)(p.ws + WS_U16);
    const int* EXPI = (const int*)(p.ws + WS_EXP); const float* GATE = (const float*)(p.ws + WS_GATE); float* CBUF = (float*)(p.ws + WS_CBUF);
    unsigned* ctl = (unsigned*)(p.ws + WS_CTL);
    int tid = threadIdx.x; asm volatile("" : "+v"(tid));
    const int lane = tid & 63, wv = __builtin_amdgcn_readfirstlane(tid >> 6), g = lane >> 4, i = lane & 15;
    volatile LAS unsigned* slot = (volatile LAS unsigned*)(LAS unsigned char*)lds;
    int* le = (int*)(lds + 1024 + wv * 1024); int* lj = le + 128;
    const unsigned xcc = peer_xcc();
#pragma unroll 1
    for (int k = 0; k < 16; ++k) {
        const int part = (int)((2u * xcc + (unsigned)k) & 15u);
#pragma unroll 1
        for (;;) {
            if (tid == 0) *slot = __hip_atomic_fetch_add(ctl + cwbase + 64 * part, 1u, __ATOMIC_RELAXED, __HIP_MEMORY_SCOPE_AGENT);
            __syncthreads();
            const unsigned unit = *slot;
            __syncthreads();
            if (unit >= (unsigned)PU_UNITS) break;
#pragma unroll 1
            for (int tt = 0; tt < 8; ++tt) {
                const int t = (int)unit * 64 + wv * 8 + tt;
                const int e0 = EXPI[(size_t)t * 128 + lane], e1 = EXPI[(size_t)t * 128 + 64 + lane];
                const bool in0 = (e0 >> 10) == part, in1 = (e1 >> 10) == part;
                const unsigned long long m0 = __ballot(in0), m1 = __ballot(in1);
                const int n0 = __popcll(m0), n = n0 + __popcll(m1);
                if (n == 0) continue;
                if (in0) { const int pos = (int)__builtin_amdgcn_mbcnt_hi((unsigned)(m0 >> 32), __builtin_amdgcn_mbcnt_lo((unsigned)m0, 0u)); le[pos] = e0; lj[pos] = lane; }
                if (in1) { const int pos = n0 + (int)__builtin_amdgcn_mbcnt_hi((unsigned)(m1 >> 32), __builtin_amdgcn_mbcnt_lo((unsigned)m1, 0u)); le[pos] = e1; lj[pos] = 64 + lane; }
                u32x4 xr[8];
                { const u32x4* xrow = (const u32x4*)(H + (size_t)t * 1024) + i;
#pragma unroll
                  for (int q = 0; q < 8; ++q) xr[q] = xrow[16 * q]; }
                LDS_WAIT(); asm volatile("" ::: "memory");
#pragma unroll 1
                for (int s = 0; 4 * s < n; ++s) {
                    const int idx = 4 * s + g; const bool valid = idx < n;
                    const int e = le[valid ? idx : 0];
                    const u32x4* ur = (const u32x4*)(U16 + (size_t)e * 1024) + i;
                    u32x4 ua[8];
#pragma unroll
                    for (int q = 0; q < 8; ++q) ua[q] = ur[16 * q];
                    float a0 = 0.f, a1 = 0.f, a2 = 0.f, a3 = 0.f;
#pragma unroll
                    for (int q = 0; q < 8; ++q) { a0 = dot2bf(ua[q].x, xr[q].x, a0); a1 = dot2bf(ua[q].y, xr[q].y, a1); a2 = dot2bf(ua[q].z, xr[q].z, a2); a3 = dot2bf(ua[q].w, xr[q].w, a3); }
                    const float a = row16_sum((a0 + a1) + (a2 + a3));
                    if (i == 0 && valid) { const size_t gi = (size_t)t * 128 + lj[idx]; __hip_atomic_store(CBUF + gi, gelu_erf(a) * GATE[gi], __ATOMIC_RELAXED, __HIP_MEMORY_SCOPE_AGENT); }
                }
                LDS_WAIT(); asm volatile("" ::: "memory");
            }
        }
    }
}

__device__ __forceinline__ void ph_peer_v(const Params& p, unsigned char* lds) {
    const bf16* V16 = (const bf16*)(p.ws + WS_V16);
    const int* EXPI = (const int*)(p.ws + WS_EXP); const float* GATE = (const float*)(p.ws + WS_CBUF); const float* MOD = (const float*)(p.ws + WS_MOD);
    unsigned* ctl = (unsigned*)(p.ws + WS_CTL);
    int tid = threadIdx.x; asm volatile("" : "+v"(tid));
    const int lane = tid & 63, wv = __builtin_amdgcn_readfirstlane(tid >> 6), g8 = lane >> 3, i8 = lane & 7;
    volatile LAS unsigned* slot = (volatile LAS unsigned*)(LAS unsigned char*)lds;
    int* le = (int*)(lds + 1024 + wv * 1024); float* lc = (float*)(le + 128);
    const unsigned xcc = peer_xcc();
#pragma unroll 1
    for (int k = 0; k < 16; ++k) {
        const int sl = (int)((2u * xcc + (unsigned)k) & 15u);
#pragma unroll 1
        for (;;) {
            if (tid == 0) *slot = __hip_atomic_fetch_add(ctl + CW_PEER_V + 64 * sl, 1u, __ATOMIC_RELAXED, __HIP_MEMORY_SCOPE_AGENT);
            __syncthreads();
            const unsigned unit = *slot;
            __syncthreads();
            if (unit >= (unsigned)PU_UNITS) break;
#pragma unroll 1
            for (int tt = 0; tt < 8; ++tt) {
                const int t = (int)unit * 64 + wv * 8 + tt;
                le[lane] = EXPI[(size_t)t * 128 + lane]; le[64 + lane] = EXPI[(size_t)t * 128 + 64 + lane];
                lc[lane] = GATE[(size_t)t * 128 + lane]; lc[64 + lane] = GATE[(size_t)t * 128 + 64 + lane];
                LDS_WAIT(); asm volatile("" ::: "memory");
                float acc[8];
#pragma unroll
                for (int q = 0; q < 8; ++q) acc[q] = 0.f;
                const bf16* vcol = V16 + 64 * sl + 8 * i8;
#pragma unroll
                for (int kk = 0; kk < 8; ++kk) {
                    const int ja = 8 * kk + g8, jb = 64 + 8 * kk + g8;
                    const u32x4 A = *(const u32x4*)(vcol + (size_t)le[ja] * 1024), B = *(const u32x4*)(vcol + (size_t)le[jb] * 1024);
                    const unsigned cp = pk2(lc[ja], lc[jb]);
                    acc[0] = dot2bf(__builtin_amdgcn_perm(B.x, A.x, 0x05040100u), cp, acc[0]); acc[1] = dot2bf(__builtin_amdgcn_perm(B.x, A.x, 0x07060302u), cp, acc[1]);
                    acc[2] = dot2bf(__builtin_amdgcn_perm(B.y, A.y, 0x05040100u), cp, acc[2]); acc[3] = dot2bf(__builtin_amdgcn_perm(B.y, A.y, 0x07060302u), cp, acc[3]);
                    acc[4] = dot2bf(__builtin_amdgcn_perm(B.z, A.z, 0x05040100u), cp, acc[4]); acc[5] = dot2bf(__builtin_amdgcn_perm(B.z, A.z, 0x07060302u), cp, acc[5]);
                    acc[6] = dot2bf(__builtin_amdgcn_perm(B.w, A.w, 0x05040100u), cp, acc[6]); acc[7] = dot2bf(__builtin_amdgcn_perm(B.w, A.w, 0x07060302u), cp, acc[7]);
                }
#pragma unroll
                for (int q = 0; q < 8; ++q) { acc[q] += dpp_f<0x128>(acc[q]); acc[q] += __shfl_xor(acc[q], 16); acc[q] += __shfl_xor(acc[q], 32); }
                if (g8 == 0) {
                    const int col = 64 * sl + 8 * i8;
                    const float* g2 = MOD + (size_t)(t >> 11) * 6144 + 5120 + col;
                    float* orow = p.out + (size_t)t * 1024 + col;
                    const f32x4 x0 = *(const f32x4*)orow, x1v = *(const f32x4*)(orow + 4), h0 = *(const f32x4*)g2, h1 = *(const f32x4*)(g2 + 4);
                    f32x4 r0, r1; r0.x = acc[0]; r0.y = acc[1]; r0.z = acc[2]; r0.w = acc[3]; r1.x = acc[4]; r1.y = acc[5]; r1.z = acc[6]; r1.w = acc[7];
                    *(f32x4*)orow = x0 + h0 * r0; *(f32x4*)(orow + 4) = x1v + h1 * r1;
                }
                LDS_WAIT(); asm volatile("" ::: "memory");
            }
        }
    }
}
typedef float f32x2_t __attribute__((ext_vector_type(2)));
constexpr int P8_UNITS = T / 64;
constexpr int CW_P8_U = 4096, CW_P8_V = 4096 + 32 * 64;
constexpr float U8_SCALE = 32.0f;

__device__ __forceinline__ void ph_peer_u8(const Params& p, unsigned char* lds) {
    const bf16* H = (const bf16*)(p.ws + WS_H); const unsigned char* U8 = (const unsigned char*)(p.ws + WS_U16);
    const int* EXPI = (const int*)(p.ws + WS_EXP); const float* GATE = (const float*)(p.ws + WS_GATE); float* CBUF = (float*)(p.ws + WS_CBUF);
    unsigned* ctl = (unsigned*)(p.ws + WS_CTL);
    int tid = threadIdx.x; asm volatile("" : "+v"(tid));
    const int lane = tid & 63, wv = __builtin_amdgcn_readfirstlane(tid >> 6), g = lane >> 4, i = lane & 15;
    volatile LAS unsigned* slot = (volatile LAS unsigned*)(LAS unsigned char*)lds;
    int* lw = (int*)(lds + 1024 + wv * 6144);
    int* myle = lw + g * 384; int* mylj = myle + 128; float* mylg = (float*)(myle + 256);
    const unsigned xcc = peer_xcc();
#pragma unroll 1
    for (int k = 0; k < 8; ++k) {
        const int part = (int)((xcc + (unsigned)k) & 7u);
#pragma unroll 1
        for (;;) {
            if (tid == 0) *slot = __hip_atomic_fetch_add(ctl + CW_P8_U + 64 * part, 1u, __ATOMIC_RELAXED, __HIP_MEMORY_SCOPE_AGENT);
            __syncthreads();
            const unsigned unit = *slot;
            __syncthreads();
            if (unit >= (unsigned)P8_UNITS) break;
#pragma unroll 1
            for (int rd = 0; rd < 2; ++rd) {
                const int tb4 = (int)unit * 64 + wv * 8 + rd * 4;
                u32x4 nx[8];
                { const u32x4* xrow = (const u32x4*)(H + (size_t)(tb4 + g) * 1024) + 2 * i;
#pragma unroll
                  for (int q = 0; q < 4; ++q) { nx[2 * q] = xrow[32 * q]; nx[2 * q + 1] = xrow[32 * q + 1]; } }
                int nmine = 0, nmax = 0;
#pragma unroll
                for (int q = 0; q < 4; ++q) {
                    const size_t tq = (size_t)(tb4 + q);
                    const int e0 = EXPI[tq * 128 + lane], e1 = EXPI[tq * 128 + 64 + lane];
                    const float g0 = GATE[tq * 128 + lane], g1 = GATE[tq * 128 + 64 + lane];
                    const bool in0 = (e0 >> 11) == part, in1 = (e1 >> 11) == part;
                    const unsigned long long m0 = __ballot(in0), m1 = __ballot(in1);
                    const int n0 = __popcll(m0), n = n0 + __popcll(m1);
                    int* qle = lw + q * 384;
                    if (in0) { const int pos = (int)__builtin_amdgcn_mbcnt_hi((unsigned)(m0 >> 32), __builtin_amdgcn_mbcnt_lo((unsigned)m0, 0u)); qle[pos] = e0; qle[128 + pos] = lane; ((float*)qle)[256 + pos] = g0; }
                    if (in1) { const int pos = n0 + (int)__builtin_amdgcn_mbcnt_hi((unsigned)(m1 >> 32), __builtin_amdgcn_mbcnt_lo((unsigned)m1, 0u)); qle[pos] = e1; qle[128 + pos] = 64 + lane; ((float*)qle)[256 + pos] = g1; }
                    nmine = (g == q) ? n : nmine; nmax = n > nmax ? n : nmax;
                }
                float xf[64];
#pragma unroll
                for (int q = 0; q < 8; ++q) { xf[8 * q] = bflo(nx[q].x); xf[8 * q + 1] = bfhi(nx[q].x); xf[8 * q + 2] = bflo(nx[q].y); xf[8 * q + 3] = bfhi(nx[q].y);
                    xf[8 * q + 4] = bflo(nx[q].z); xf[8 * q + 5] = bfhi(nx[q].z); xf[8 * q + 6] = bflo(nx[q].w); xf[8 * q + 7] = bfhi(nx[q].w); }
                LDS_WAIT(); asm volatile("" ::: "memory");
                const size_t cb = (size_t)(tb4 + g) * 128;
#define U8_LOAD(R, S) do { const int s_ = (S); const int e_ = (s_ < nmine) ? myle[s_] : 0; const u32x4* r_ = (const u32x4*)(U8 + (size_t)e_ * 1024) + i;                     \
        _Pragma("unroll") for (int q = 0; q < 4; ++q) R[q] = r_[16 * q]; } while (0)
#define U8_DOT(R, S) do { const int s_ = (S); float a0 = 0.f, a1 = 0.f, a2 = 0.f, a3 = 0.f;                                                            \
        _Pragma("unroll") for (int q = 0; q < 4; ++q) { const unsigned w_[4] = {R[q].x, R[q].y, R[q].z, R[q].w};                                           \
            _Pragma("unroll") for (int c = 0; c < 4; ++c) { const f32x2_t lo = __builtin_amdgcn_cvt_pk_f32_fp8((int)w_[c], false), hi = __builtin_amdgcn_cvt_pk_f32_fp8((int)w_[c], true); \
                a0 = fmaf(lo.x, xf[16 * q + 4 * c], a0); a1 = fmaf(lo.y, xf[16 * q + 4 * c + 1], a1); a2 = fmaf(hi.x, xf[16 * q + 4 * c + 2], a2); a3 = fmaf(hi.y, xf[16 * q + 4 * c + 3], a3); } } \
        const float a_ = row16_sum((a0 + a1) + (a2 + a3)) * (1.0f / U8_SCALE);                                                                         \
        if (i == 0 && s_ < nmine) __hip_atomic_store(CBUF + cb + mylj[s_], gelu_erf(a_) * mylg[s_], __ATOMIC_RELAXED, __HIP_MEMORY_SCOPE_AGENT); } while (0)
                u32x4 RA[4], RB[4], RC[4], RD[4];
                U8_LOAD(RA, 0); U8_LOAD(RB, 1); U8_LOAD(RC, 2);
#pragma unroll 1
                for (int s = 0; s < nmax; s += 4) {
                    U8_LOAD(RD, s + 3); U8_DOT(RA, s);
                    if (s + 1 < nmax) { U8_LOAD(RA, s + 4); U8_DOT(RB, s + 1); }
                    if (s + 2 < nmax) { U8_LOAD(RB, s + 5); U8_DOT(RC, s + 2); }
                    if (s + 3 < nmax) { U8_LOAD(RC, s + 6); U8_DOT(RD, s + 3); }
                }
#undef U8_LOAD
#undef U8_DOT
                LDS_WAIT(); asm volatile("" ::: "memory");
            }
        }
    }
}

__device__ __forceinline__ void ph_peer_v8(const Params& p, unsigned char* lds) {
    const unsigned char* V8 = (const unsigned char*)(p.ws + WS_V16);
    const int* EXPI = (const int*)(p.ws + WS_EXP); const float* CBUF = (const float*)(p.ws + WS_CBUF); const float* MOD = (const float*)(p.ws + WS_MOD);
    unsigned* ctl = (unsigned*)(p.ws + WS_CTL);
    int tid = threadIdx.x; asm volatile("" : "+v"(tid));
    const int lane = tid & 63, wv = __builtin_amdgcn_readfirstlane(tid >> 6), g8 = lane >> 3, i8 = lane & 7;
    volatile LAS unsigned* slot = (volatile LAS unsigned*)(LAS unsigned char*)lds;
    int* le0 = (int*)(lds + 1024 + wv * 2048); float* lc0 = (float*)(le0 + 128); int* le1 = le0 + 256; float* lc1 = (float*)(le0 + 384);
    const unsigned xcc = peer_xcc();
#pragma unroll 1
    for (int k = 0; k < 8; ++k) {
        const int sl = (int)((xcc + (unsigned)k) & 7u);
        const unsigned char* vcol = V8 + 128 * sl + 16 * i8;
#pragma unroll 1
        for (;;) {
            if (tid == 0) *slot = __hip_atomic_fetch_add(ctl + CW_P8_V + 64 * sl, 1u, __ATOMIC_RELAXED, __HIP_MEMORY_SCOPE_AGENT);
            __syncthreads();
            const unsigned unit = *slot;
            __syncthreads();
            if (unit >= (unsigned)P8_UNITS) break;
            const int tbase = (int)unit * 64 + wv * 8;
            int ne0, ne1; float nc0, nc1;
#define V8_FETCH(T) do { const size_t tn_ = (size_t)(T); ne0 = EXPI[tn_ * 128 + lane]; ne1 = EXPI[tn_ * 128 + 64 + lane]; nc0 = CBUF[tn_ * 128 + lane]; nc1 = CBUF[tn_ * 128 + 64 + lane]; } while (0)
#define V8_LISTS(LE, LC) do { LE[lane] = ne0; LE[64 + lane] = ne1; LC[lane] = nc0; LC[64 + lane] = nc1; } while (0)
#define V8_ROWS(R, LE, HH) do { _Pragma("unroll") for (int kk = 0; kk < 8; ++kk) R[kk] = *(const u32x4*)(vcol + (size_t)LE[8 * (8 * (HH) + kk) + g8] * 1024); } while (0)
#define V8_HALF(R, LC, HH) do { _Pragma("unroll") for (int kk = 0; kk < 8; ++kk) { const float cj = LC[8 * (8 * (HH) + kk) + g8];               \
            const unsigned w_[4] = {R[kk].x, R[kk].y, R[kk].z, R[kk].w};                                                                       \
            _Pragma("unroll") for (int c = 0; c < 4; ++c) { const f32x2_t lo = __builtin_amdgcn_cvt_pk_f32_fp8((int)w_[c], false), hi = __builtin_amdgcn_cvt_pk_f32_fp8((int)w_[c], true); \
                acc[4 * c] = fmaf(cj, lo.x, acc[4 * c]); acc[4 * c + 1] = fmaf(cj, lo.y, acc[4 * c + 1]); acc[4 * c + 2] = fmaf(cj, hi.x, acc[4 * c + 2]); acc[4 * c + 3] = fmaf(cj, hi.y, acc[4 * c + 3]); } } } while (0)
            u32x4 RA[8], RB[8];
            int* lecur = (int*)(lds + 1024 + wv * 2048); int* lenxt = lecur + 256;
            V8_FETCH(tbase); V8_LISTS(lecur, ((float*)(lecur + 128))); V8_FETCH(tbase + 1);
            LDS_WAIT(); asm volatile("" ::: "memory");
            V8_ROWS(RA, lecur, 0);
#pragma unroll 1
            for (int tt = 0; tt < 8; ++tt) {
                const int t = tbase + tt;
                float* lccur = (float*)(lecur + 128); float* lcnxt = (float*)(lenxt + 128);
                float acc[16];
#pragma unroll
                for (int q = 0; q < 16; ++q) acc[q] = 0.f;
                V8_ROWS(RB, lecur, 1);
                if (tt + 1 < 8) { V8_LISTS(lenxt, lcnxt); if (tt + 2 < 8) V8_FETCH(t + 2); }
                V8_HALF(RA, lccur, 0);
                LDS_WAIT(); asm volatile("" ::: "memory");
                if (tt + 1 < 8) V8_ROWS(RA, lenxt, 0);
                V8_HALF(RB, lccur, 1);
#pragma unroll
                for (int q = 0; q < 16; ++q) { acc[q] += dpp_f<0x128>(acc[q]); acc[q] += __shfl_xor(acc[q], 16); acc[q] += __shfl_xor(acc[q], 32); }
                if (g8 == 0) { const int col = 128 * sl + 16 * i8; const float* g2 = MOD + (size_t)(t >> 11) * 6144 + 5120 + col; float* orow = p.out + (size_t)t * 1024 + col;
#pragma unroll
                    for (int q = 0; q < 4; ++q) { const f32x4 xv = *(const f32x4*)(orow + 4 * q), hv = *(const f32x4*)(g2 + 4 * q);
                        f32x4 r; r.x = acc[4 * q]; r.y = acc[4 * q + 1]; r.z = acc[4 * q + 2]; r.w = acc[4 * q + 3]; *(f32x4*)(orow + 4 * q) = xv + hv * r; } }
                { int* tmp_ = lecur; lecur = lenxt; lenxt = tmp_; }
            }
#undef V8_FETCH
#undef V8_LISTS
#undef V8_ROWS
#undef V8_HALF
            LDS_WAIT(); asm volatile("" ::: "memory");
        }
    }
}
#ifndef U8_PARTS
#define U8_PARTS 1
#endif
#define U8_SHIFT (U8_PARTS == 1 ? 14 : (U8_PARTS == 2 ? 13 : (U8_PARTS == 4 ? 12 : (U8_PARTS == 8 ? 11 : (U8_PARTS == 16 ? 10 : 9)))))
__device__ __forceinline__ void ph_peer_u8_old(const Params& p, unsigned char* lds) {
    const bf16* H = (const bf16*)(p.ws + WS_H); const unsigned char* U8 = (const unsigned char*)(p.ws + WS_U16);
    const int* EXPI = (const int*)(p.ws + WS_EXP); const float* GATE = (const float*)(p.ws + WS_GATE); float* CBUF = (float*)(p.ws + WS_CBUF);
    unsigned* ctl = (unsigned*)(p.ws + WS_CTL);
    int tid = threadIdx.x; asm volatile("" : "+v"(tid));
    const int lane = tid & 63, wv = __builtin_amdgcn_readfirstlane(tid >> 6), g = lane >> 4, i = lane & 15;
    volatile LAS unsigned* slot = (volatile LAS unsigned*)(LAS unsigned char*)lds;
    int* le = (int*)(lds + 1024 + wv * 2048); int* lj = le + 128; float* lg = (float*)(le + 256);
    const unsigned xcc = peer_xcc();
#pragma unroll 1
    for (int k = 0; k < U8_PARTS; ++k) {
        const int part = (int)((((xcc * U8_PARTS) >> 3) + (unsigned)k) & (unsigned)(U8_PARTS - 1));
#pragma unroll 1
        for (;;) {
            if (tid == 0) *slot = __hip_atomic_fetch_add(ctl + CW_P8_U + 64 * part, 1u, __ATOMIC_RELAXED, __HIP_MEMORY_SCOPE_AGENT);
            __syncthreads();
            const unsigned unit = *slot;
            __syncthreads();
            if (unit >= (unsigned)P8_UNITS) break;
            const int tbase = (int)unit * 64 + wv * 8;
            int ne0 = EXPI[(size_t)tbase * 128 + lane], ne1 = EXPI[(size_t)tbase * 128 + 64 + lane];
            float ng0 = GATE[(size_t)tbase * 128 + lane], ng1 = GATE[(size_t)tbase * 128 + 64 + lane];
            u32x4 nx[8];
            { const u32x4* xrow = (const u32x4*)(H + (size_t)tbase * 1024) + 2 * i;
#pragma unroll
              for (int q = 0; q < 4; ++q) { nx[2 * q] = xrow[32 * q]; nx[2 * q + 1] = xrow[32 * q + 1]; } }
#pragma unroll 1
            for (int tt = 0; tt < 8; ++tt) {
                const int t = tbase + tt;
                const int e0 = ne0, e1 = ne1; const float g0 = ng0, g1 = ng1;
                float xf[64];
#pragma unroll
                for (int q = 0; q < 8; ++q) { xf[8 * q] = bflo(nx[q].x); xf[8 * q + 1] = bfhi(nx[q].x); xf[8 * q + 2] = bflo(nx[q].y); xf[8 * q + 3] = bfhi(nx[q].y);
                    xf[8 * q + 4] = bflo(nx[q].z); xf[8 * q + 5] = bfhi(nx[q].z); xf[8 * q + 6] = bflo(nx[q].w); xf[8 * q + 7] = bfhi(nx[q].w); }
                if (tt + 1 < 8) { const size_t tn = (size_t)(t + 1);
                    ne0 = EXPI[tn * 128 + lane]; ne1 = EXPI[tn * 128 + 64 + lane]; ng0 = GATE[tn * 128 + lane]; ng1 = GATE[tn * 128 + 64 + lane];
                    const u32x4* xrow = (const u32x4*)(H + tn * 1024) + 2 * i;
#pragma unroll
                    for (int q = 0; q < 4; ++q) { nx[2 * q] = xrow[32 * q]; nx[2 * q + 1] = xrow[32 * q + 1]; } }
                const bool in0 = (e0 >> U8_SHIFT) == part, in1 = (e1 >> U8_SHIFT) == part;
                const unsigned long long m0 = __ballot(in0), m1 = __ballot(in1);
                const int n0 = __popcll(m0), n = n0 + __popcll(m1);
                if (in0) { const int pos = (int)__builtin_amdgcn_mbcnt_hi((unsigned)(m0 >> 32), __builtin_amdgcn_mbcnt_lo((unsigned)m0, 0u)); le[pos] = e0; lj[pos] = lane; lg[pos] = g0; }
                if (in1) { const int pos = n0 + (int)__builtin_amdgcn_mbcnt_hi((unsigned)(m1 >> 32), __builtin_amdgcn_mbcnt_lo((unsigned)m1, 0u)); le[pos] = e1; lj[pos] = 64 + lane; lg[pos] = g1; }
                LDS_WAIT(); asm volatile("" ::: "memory");
#pragma unroll 1
                for (int s = 0; 4 * s < n; s += 2) {
                    const int idxA = 4 * s + g, idxB = idxA + 4; const bool vA = idxA < n, vB = idxB < n;
                    const u32x4* ra = (const u32x4*)(U8 + (size_t)le[vA ? idxA : 0] * 1024) + i;
                    const u32x4* rb = (const u32x4*)(U8 + (size_t)le[vB ? idxB : 0] * 1024) + i;
                    u32x4 A[4], B[4];
#pragma unroll
                    for (int q = 0; q < 4; ++q) A[q] = ra[16 * q];
#pragma unroll
                    for (int q = 0; q < 4; ++q) B[q] = rb[16 * q];
#define P8_DOT(R, OUT) do { float a0 = 0.f, a1 = 0.f, a2 = 0.f, a3 = 0.f;                                                           \
    _Pragma("unroll") for (int q = 0; q < 4; ++q) {                                                                                   \
        const unsigned w_[4] = {R[q].x, R[q].y, R[q].z, R[q].w};                                                                      \
        _Pragma("unroll") for (int c = 0; c < 4; ++c) { const f32x2_t lo = __builtin_amdgcn_cvt_pk_f32_fp8((int)w_[c], false), hi = __builtin_amdgcn_cvt_pk_f32_fp8((int)w_[c], true); \
            a0 = fmaf(lo.x, xf[16 * q + 4 * c], a0); a1 = fmaf(lo.y, xf[16 * q + 4 * c + 1], a1); a2 = fmaf(hi.x, xf[16 * q + 4 * c + 2], a2); a3 = fmaf(hi.y, xf[16 * q + 4 * c + 3], a3); } } \
    OUT = row16_sum((a0 + a1) + (a2 + a3)) * (1.0f / U8_SCALE); } while (0)
                    float aA, aB;
                    P8_DOT(A, aA); P8_DOT(B, aB);
#undef P8_DOT
                    if (i == 0 && vA) __hip_atomic_store(CBUF + (size_t)t * 128 + lj[idxA], gelu_erf(aA) * lg[idxA], __ATOMIC_RELAXED, __HIP_MEMORY_SCOPE_AGENT);
                    if (i == 0 && vB) __hip_atomic_store(CBUF + (size_t)t * 128 + lj[idxB], gelu_erf(aB) * lg[idxB], __ATOMIC_RELAXED, __HIP_MEMORY_SCOPE_AGENT);
                }
                LDS_WAIT(); asm volatile("" ::: "memory");
            }
        }
    }
}

__device__ __forceinline__ void ph_peer_v8_old(const Params& p, unsigned char* lds) {
    const unsigned char* V8 = (const unsigned char*)(p.ws + WS_V16);
    const int* EXPI = (const int*)(p.ws + WS_EXP); const float* CBUF = (const float*)(p.ws + WS_CBUF); const float* MOD = (const float*)(p.ws + WS_MOD);
    unsigned* ctl = (unsigned*)(p.ws + WS_CTL);
    int tid = threadIdx.x; asm volatile("" : "+v"(tid));
    const int lane = tid & 63, wv = __builtin_amdgcn_readfirstlane(tid >> 6), g8 = lane >> 3, i8 = lane & 7;
    volatile LAS unsigned* slot = (volatile LAS unsigned*)(LAS unsigned char*)lds;
    int* le = (int*)(lds + 1024 + wv * 2048); float* lc = (float*)(le + 128);
    const unsigned xcc = peer_xcc();
#pragma unroll 1
    for (int k = 0; k < 8; ++k) {
        const int sl = (int)((xcc + (unsigned)k) & 7u);
#pragma unroll 1
        for (;;) {
            if (tid == 0) *slot = __hip_atomic_fetch_add(ctl + CW_P8_V + 64 * sl, 1u, __ATOMIC_RELAXED, __HIP_MEMORY_SCOPE_AGENT);
            __syncthreads();
            const unsigned unit = *slot;
            __syncthreads();
            if (unit >= (unsigned)P8_UNITS) break;
            const int tbase = (int)unit * 64 + wv * 8;
            int ne0 = EXPI[(size_t)tbase * 128 + lane], ne1 = EXPI[(size_t)tbase * 128 + 64 + lane];
            float nc0 = CBUF[(size_t)tbase * 128 + lane], nc1 = CBUF[(size_t)tbase * 128 + 64 + lane];
#pragma unroll 1
            for (int tt = 0; tt < 8; ++tt) {
                const int t = tbase + tt;
                le[lane] = ne0; le[64 + lane] = ne1; lc[lane] = nc0; lc[64 + lane] = nc1;
                if (tt + 1 < 8) { const size_t tn = (size_t)(t + 1); ne0 = EXPI[tn * 128 + lane]; ne1 = EXPI[tn * 128 + 64 + lane]; nc0 = CBUF[tn * 128 + lane]; nc1 = CBUF[tn * 128 + 64 + lane]; }
                LDS_WAIT(); asm volatile("" ::: "memory");
                const unsigned char* vcol = V8 + 128 * sl + 16 * i8;
                u32x4 R[16];
#pragma unroll
                for (int kk = 0; kk < 16; ++kk) R[kk] = *(const u32x4*)(vcol + (size_t)le[8 * kk + g8] * 1024);
                float acc[16];
#pragma unroll
                for (int q = 0; q < 16; ++q) acc[q] = 0.f;
#pragma unroll
                for (int kk = 0; kk < 16; ++kk) {
                    const float cj = lc[8 * kk + g8];
                    const unsigned w_[4] = {R[kk].x, R[kk].y, R[kk].z, R[kk].w};
#pragma unroll
                    for (int c = 0; c < 4; ++c) { const f32x2_t lo = __builtin_amdgcn_cvt_pk_f32_fp8((int)w_[c], false), hi = __builtin_amdgcn_cvt_pk_f32_fp8((int)w_[c], true);
                        acc[4 * c] = fmaf(cj, lo.x, acc[4 * c]); acc[4 * c + 1] = fmaf(cj, lo.y, acc[4 * c + 1]); acc[4 * c + 2] = fmaf(cj, hi.x, acc[4 * c + 2]); acc[4 * c + 3] = fmaf(cj, hi.y, acc[4 * c + 3]); }
                }
#pragma unroll
                for (int q = 0; q < 16; ++q) { acc[q] += dpp_f<0x128>(acc[q]); acc[q] += __shfl_xor(acc[q], 16); acc[q] += __shfl_xor(acc[q], 32); }
                if (g8 == 0) {
                    const int col = 128 * sl + 16 * i8;
                    const float* g2 = MOD + (size_t)(t >> 11) * 6144 + 5120 + col;
                    float* orow = p.out + (size_t)t * 1024 + col;
#pragma unroll
                    for (int q = 0; q < 4; ++q) { const f32x4 xv = *(const f32x4*)(orow + 4 * q), hv = *(const f32x4*)(g2 + 4 * q);
                        f32x4 r; r.x = acc[4 * q]; r.y = acc[4 * q + 1]; r.z = acc[4 * q + 2]; r.w = acc[4 * q + 3];
                        *(f32x4*)(orow + 4 * q) = xv + hv * r; }
                }
                LDS_WAIT(); asm volatile("" ::: "memory");
            }
        }
    }
}
__device__ __forceinline__ void ph_dsa_old(const Params& p, unsigned char* lds, int vb, int nvb) {
    const bf16* PROJ = (const bf16*)(p.ws + WS_PROJ); bf16* MIX = (bf16*)(p.ws + WS_MIX);
    const float MB = ((const float*)(p.ws + WS_SCAL))[SC_MB];
    int tid = threadIdx.x; asm volatile("" : "+v"(tid)); const int lane = tid & 63, wv = __builtin_amdgcn_readfirstlane(tid >> 6);
    const int l15 = lane & 15, g = lane >> 4;
    LAS unsigned char* ldsl = (LAS unsigned char*)lds;
    for (int it = vb; it < 2048; it += nvb) {
        const int vbb = it & 255, kk = it >> 8, xg = vbb & 7, ix = vbb >> 3, b = 2 * xg + (ix & 1), G = (ix >> 1) & 3, sub = ix >> 3;
        const int c = (kk & 1) ? (31 - G - 8 * (kk >> 1)) : (G + 8 * (kk >> 1));
        const int cend = (c + 1) * 64, t0 = c * 64 + sub * 16;
        const bf16* Pb = PROJ + (size_t)b * SEQ * NP;
        if (c >= 4) {
            const bf16* qrow = Pb + (size_t)(t0 + l15) * NP;
            bf16x8 bq[4][2]; float wsc[4];
#pragma unroll
            for (int h = 0; h < 4; ++h) { wsc[h] = bf2f(qrow[C_WI + h]) * 0.0625f;
#pragma unroll
                for (int ks = 0; ks < 2; ++ks) bq[h][ks] = *(const bf16x8*)(qrow + C_QI + h * 64 + 32 * ks + 8 * g); }
            for (int k0 = 16 * wv; k0 < cend; k0 += 128) {
                const bf16* krow = Pb + (size_t)(k0 + l15) * NP + C_KI + 8 * g;
                const bf16x8 ka0 = *(const bf16x8*)krow, ka1 = *(const bf16x8*)(krow + 32);
                f32x4 sc = {0.f, 0.f, 0.f, 0.f};
#pragma unroll
                for (int h = 0; h < 4; ++h) { f32x4 a = {0.f, 0.f, 0.f, 0.f};
                    a = __builtin_amdgcn_mfma_f32_16x16x32_bf16(ka0, bq[h][0], a, 0, 0, 0);
                    a = __builtin_amdgcn_mfma_f32_16x16x32_bf16(ka1, bq[h][1], a, 0, 0, 0);
#pragma unroll
                    for (int r = 0; r < 4; ++r) sc[r] = fmaf(fmaxf(a[r], 0.f), wsc[h], sc[r]); }
#pragma unroll
                for (int r = 0; r < 4; ++r) sc[r] = (sc[r] == 0.f) ? 0.f : sc[r];
                *(LAS f32x4*)(ldsl + l15 * DSA_SROW + (k0 + 4 * g) * 4) = sc;
            }
        }
        __syncthreads();
        LAS unsigned short* selw = (LAS unsigned short*)(ldsl + DSA_SEL_OFF);
        int mind0 = 0, mind1 = 0;
#pragma unroll 1
        for (int qi = 0; qi < 2; ++qi) {
            const int qq = 2 * wv + qi, t = t0 + qq;
            LAS unsigned short* sel = selw + qq * 256;
            if (c < 4) { for (int j = lane; j < 256; j += 64) sel[j] = (unsigned short)j; continue; }
            const int nreg = cend >> 6;
            unsigned key[32];
            const LAS float* srow = (const LAS float*)(ldsl + qq * DSA_SROW) + lane;
#pragma unroll
            for (int i = 0; i < 32; ++i) key[i] = (i < nreg) ? sortkey(srow[64 * i]) : 0u;
            unsigned prefix = 0u; bool exact = false;
#pragma unroll 1
            for (int bit = 31; bit >= 0; --bit) {
                const unsigned cand = prefix | (1u << bit); int cnt = 0;
#pragma unroll
                for (int i = 0; i < 32; ++i) cnt += __popcll(__ballot(key[i] >= cand));
                if (cnt >= 256) { prefix = cand; if (cnt == 256) { exact = true; break; } }
            }
            int need_ties = 0;
            if (!exact) { int cgt = 0;
                if (prefix != 0xffffffffu) {
#pragma unroll
                    for (int i = 0; i < 32; ++i) cgt += __popcll(__ballot(key[i] > prefix)); }
                need_ties = 256 - cgt; }
            int base = 0, tbase = 0, md = 4096;
#pragma unroll
            for (int i = 0; i < 32; ++i) {
                if (i < nreg) {
                    bool selb;
                    if (exact) selb = key[i] >= prefix;
                    else { const bool tie = key[i] == prefix; const unsigned long long mt = __ballot(tie);
                        const int trank = tbase + (int)__builtin_amdgcn_mbcnt_hi((unsigned)(mt >> 32), __builtin_amdgcn_mbcnt_lo((unsigned)mt, 0u));
                        selb = (key[i] > prefix) || (tie && trank < need_ties); tbase += __popcll(mt); }
                    const unsigned long long m = __ballot(selb);
                    const int pos = base + (int)__builtin_amdgcn_mbcnt_hi((unsigned)(m >> 32), __builtin_amdgcn_mbcnt_lo((unsigned)m, 0u));
                    const int kidx = i * 64 + lane;
                    if (selb) { sel[pos] = (unsigned short)kidx; const int d = t > kidx ? t - kidx : kidx - t; md = d < md ? d : md; }
                    base += __popcll(m);
                }
            }
#pragma unroll
            for (int o = 1; o < 64; o <<= 1) { const int x = __shfl_xor(md, o); md = x < md ? x : md; }
            if (qi == 0) mind0 = md; else mind1 = md;
        }
        LDS_WAIT(); asm volatile("" ::: "memory");
        const int nvalid = cend < 256 ? cend : 256;
        const int head = lane & 7;
        const float slopeL2 = exp2f(-(float)(head + 1)) * 1.4426950409f;
#pragma unroll 1
        for (int qi = 0; qi < 2; ++qi) {
            const int qq = 2 * wv + qi, t = t0 + qq;
            const LAS unsigned short* sel = selw + qq * 256;
            LAS unsigned char* stg = ldsl + (2 * wv) * DSA_SROW;
            const bf16* qrow = Pb + (size_t)t * NP + C_QB + head * 128 + 8 * g;
            bf16x8 bq[4];
#pragma unroll
            for (int ks = 0; ks < 4; ++ks) bq[ks] = *(const bf16x8*)(qrow + 32 * ks);
            const float refL2 = MB * 1.4426950409f - slopeL2 * (float)(qi == 0 ? mind0 : mind1);
            f32x4 o[8];
#pragma unroll
            for (int dt = 0; dt < 8; ++dt) o[dt] = (f32x4){0.f, 0.f, 0.f, 0.f};
            float lsum = 0.f;
#pragma unroll 1
            for (int s = 0; s < 8; ++s) {
                if (32 * s >= nvalid) break;
                unsigned pb[4];
#pragma unroll
                for (int tl = 0; tl < 2; ++tl) {
                    const int j0 = 32 * s + 16 * tl;
                    const int jr = j0 + l15; const int keyr = sel[jr < nvalid ? jr : 0];
                    const bf16* kvrow = Pb + (size_t)keyr * NP + C_KV + 8 * g;
                    bf16x8 ka[4];
#pragma unroll
                    for (int ks = 0; ks < 4; ++ks) ka[ks] = *(const bf16x8*)(kvrow + 32 * ks);
                    f32x4 a = {0.f, 0.f, 0.f, 0.f};
#pragma unroll
                    for (int ks = 0; ks < 4; ++ks) { a = __builtin_amdgcn_mfma_f32_16x16x32_bf16(ka[ks], bq[ks], a, 0, 0, 0);
                        *(LAS bf16x8*)(stg + (16 * tl + l15) * DSA_KVROW + (32 * ks + 8 * g) * 2) = ka[ks]; }
                    const u32x2 kw = *(const LAS u32x2*)(sel + j0 + 4 * g);
                    const int kx[4] = {(int)(kw.x & 0xffffu), (int)(kw.x >> 16), (int)(kw.y & 0xffffu), (int)(kw.y >> 16)};
                    float pr[4];
#pragma unroll
                    for (int r = 0; r < 4; ++r) { const int dd = t > kx[r] ? t - kx[r] : kx[r] - t;
                        const float e = __builtin_amdgcn_exp2f(fmaf(a[r], 0.1275174f, -slopeL2 * (float)dd - refL2));
                        pr[r] = (j0 + 4 * g + r < nvalid) ? e : 0.f; lsum += pr[r]; }
                    pb[2 * tl] = cvtpk_bf16(pr[0], pr[1]); pb[2 * tl + 1] = cvtpk_bf16(pr[2], pr[3]);
                }
                LDS_WAIT(); asm volatile("" ::: "memory");
                u32x4 pw4; pw4.x = pb[0]; pw4.y = pb[1]; pw4.z = pb[2]; pw4.w = pb[3];
                const bf16x8 pfrag = __builtin_bit_cast(bf16x8, pw4);
                const LAS unsigned char* trb = stg + (4 * g + (l15 >> 2)) * DSA_KVROW + (4 * (lane & 3)) * 2;
#pragma unroll
                for (int dt = 0; dt < 8; ++dt) {
                    const s16x4 lo = __builtin_bit_cast(s16x4, __builtin_amdgcn_ds_read_tr16_b64_v4i16((LAS v4i16_t*)(trb + dt * 32)));
                    const s16x4 hi = __builtin_bit_cast(s16x4, __builtin_amdgcn_ds_read_tr16_b64_v4i16((LAS v4i16_t*)(trb + 16 * DSA_KVROW + dt * 32)));
                    const bf16x8 af = {lo[0], lo[1], lo[2], lo[3], hi[0], hi[1], hi[2], hi[3]};
                    o[dt] = __builtin_amdgcn_mfma_f32_16x16x32_bf16(af, pfrag, o[dt], 0, 0, 0);
                }
                LDS_WAIT(); asm volatile("" ::: "memory");
            }
            lsum += __shfl_xor(lsum, 16); lsum += __shfl_xor(lsum, 32);
            const float il = 1.f / lsum;
            if (l15 < 8) {
                bf16* orow = MIX + (size_t)(b * SEQ + t) * MIXW + 512 + head * 128 + 4 * g;
#pragma unroll
                for (int dt = 0; dt < 8; ++dt) { u32x2 w; w.x = pk2(o[dt][0] * il, o[dt][1] * il); w.y = pk2(o[dt][2] * il, o[dt][3] * il); *(u32x2*)(orow + 16 * dt) = w; }
            }
        }
        __syncthreads();
    }
}
__device__ __forceinline__ void ph_peer8t(const Params& p, unsigned char* lds_w, int gw, int ngw, int lane_) {
    int lane = lane_; asm volatile("" : "+v"(lane));
    const bf16* H = (const bf16*)(p.ws + WS_H); const unsigned char* U8 = (const unsigned char*)(p.ws + WS_U16); const unsigned char* V8 = (const unsigned char*)(p.ws + WS_V16);
    const int* EXPI = (const int*)(p.ws + WS_EXP); const float* GATE = (const float*)(p.ws + WS_GATE); const float* MOD = (const float*)(p.ws + WS_MOD);
    int* e_lds = (int*)lds_w; float* a_lds = (float*)(lds_w + 512);
    const int g = lane >> 4, i = lane & 15;
#pragma unroll 1
    for (int t = gw; t < T; t += ngw) {
        const int e0 = EXPI[(size_t)t * 128 + lane], e1 = EXPI[(size_t)t * 128 + 64 + lane];
        const float g0 = GATE[(size_t)t * 128 + lane], g1 = GATE[(size_t)t * 128 + 64 + lane];
        e_lds[lane] = e0; e_lds[64 + lane] = e1;
        float xf[64];
        { const u32x4* xrow = (const u32x4*)(H + (size_t)t * 1024) + 2 * i;
#pragma unroll
          for (int q = 0; q < 4; ++q) { const u32x4 a = xrow[32 * q], b = xrow[32 * q + 1];
              xf[16 * q] = bflo(a.x); xf[16 * q + 1] = bfhi(a.x); xf[16 * q + 2] = bflo(a.y); xf[16 * q + 3] = bfhi(a.y); xf[16 * q + 4] = bflo(a.z); xf[16 * q + 5] = bfhi(a.z); xf[16 * q + 6] = bflo(a.w); xf[16 * q + 7] = bfhi(a.w);
              xf[16 * q + 8] = bflo(b.x); xf[16 * q + 9] = bfhi(b.x); xf[16 * q + 10] = bflo(b.y); xf[16 * q + 11] = bfhi(b.y); xf[16 * q + 12] = bflo(b.z); xf[16 * q + 13] = bfhi(b.z); xf[16 * q + 14] = bflo(b.w); xf[16 * q + 15] = bfhi(b.w); } }
        LDS_WAIT(); asm volatile("" ::: "memory");
#define P8T_ULOAD(R, S) do { const u32x4* r_ = (const u32x4*)(U8 + (size_t)e_lds[4 * (S) + g] * 1024) + i; _Pragma("unroll") for (int q = 0; q < 4; ++q) R[q] = r_[16 * q]; } while (0)
#define P8T_UDOT(R, S) do { float a0 = 0.f, a1 = 0.f, a2 = 0.f, a3 = 0.f;                                                                               \
        _Pragma("unroll") for (int q = 0; q < 4; ++q) { const unsigned w_[4] = {R[q].x, R[q].y, R[q].z, R[q].w};                                           \
            _Pragma("unroll") for (int c = 0; c < 4; ++c) { const f32x2_t lo = __builtin_amdgcn_cvt_pk_f32_fp8((int)w_[c], false), hi = __builtin_amdgcn_cvt_pk_f32_fp8((int)w_[c], true); \
                a0 = fmaf(lo.x, xf[16 * q + 4 * c], a0); a1 = fmaf(lo.y, xf[16 * q + 4 * c + 1], a1); a2 = fmaf(hi.x, xf[16 * q + 4 * c + 2], a2); a3 = fmaf(hi.y, xf[16 * q + 4 * c + 3], a3); } } \
        const float a_ = row16_sum((a0 + a1) + (a2 + a3)) * (1.0f / U8_SCALE); if (i == 0) a_lds[4 * (S) + g] = a_; } while (0)
        { u32x4 RA[4], RB[4], RC[4];
          P8T_ULOAD(RA, 0); P8T_ULOAD(RB, 1);
#pragma unroll 1
          for (int s = 0; s < 30; s += 3) {
              P8T_ULOAD(RC, s + 2); P8T_UDOT(RA, s);
              P8T_ULOAD(RA, s + 3); P8T_UDOT(RB, s + 1);
              P8T_ULOAD(RB, s + 4); P8T_UDOT(RC, s + 2);
          }
          P8T_UDOT(RA, 30); P8T_UDOT(RB, 31); }
#undef P8T_ULOAD
#undef P8T_UDOT
        LDS_WAIT(); asm volatile("" ::: "memory");
        const float c0 = gelu_erf(a_lds[lane]) * g0, c1 = gelu_erf(a_lds[64 + lane]) * g1;
        float acc[16];
#pragma unroll
        for (int q = 0; q < 16; ++q) acc[q] = 0.f;
#define P8T_VLOAD(R, J) do { _Pragma("unroll") for (int k_ = 0; k_ < 4; ++k_) { const int j_ = (J) + k_; const int e_ = __builtin_amdgcn_readlane(j_ < 64 ? e0 : e1, j_ & 63); \
            R[k_] = *((const u32x4*)(V8 + (size_t)e_ * 1024) + lane); } } while (0)
#define P8T_VACC(R, J) do { _Pragma("unroll") for (int k_ = 0; k_ < 4; ++k_) { const int j_ = (J) + k_; const float cj = __int_as_float(__builtin_amdgcn_readlane(__float_as_int(j_ < 64 ? c0 : c1), j_ & 63));   \
            const unsigned w_[4] = {R[k_].x, R[k_].y, R[k_].z, R[k_].w};                                                                                  \
            _Pragma("unroll") for (int c = 0; c < 4; ++c) { const f32x2_t lo = __builtin_amdgcn_cvt_pk_f32_fp8((int)w_[c], false), hi = __builtin_amdgcn_cvt_pk_f32_fp8((int)w_[c], true); \
                acc[4 * c] = fmaf(cj, lo.x, acc[4 * c]); acc[4 * c + 1] = fmaf(cj, lo.y, acc[4 * c + 1]); acc[4 * c + 2] = fmaf(cj, hi.x, acc[4 * c + 2]); acc[4 * c + 3] = fmaf(cj, hi.y, acc[4 * c + 3]); } } } while (0)
        { u32x4 VA[4], VB[4], VC[4];
          P8T_VLOAD(VA, 0); P8T_VLOAD(VB, 4);
#pragma unroll 1
          for (int j = 0; j < 120; j += 12) {
              P8T_VLOAD(VC, j + 8); P8T_VACC(VA, j);
              P8T_VLOAD(VA, j + 12); P8T_VACC(VB, j + 4);
              P8T_VLOAD(VB, j + 16); P8T_VACC(VC, j + 8);
          }
          P8T_VACC(VA, 120); P8T_VACC(VB, 124); }
#undef P8T_VLOAD
#undef P8T_VACC
        const float* g2 = MOD + (size_t)(t >> 11) * 6144 + 5120 + 16 * lane;
        float* orow = p.out + (size_t)t * 1024 + 16 * lane;
#pragma unroll
        for (int q = 0; q < 4; ++q) { const f32x4 xv = *(const f32x4*)(orow + 4 * q), hv = *(const f32x4*)(g2 + 4 * q);
            f32x4 r; r.x = acc[4 * q]; r.y = acc[4 * q + 1]; r.z = acc[4 * q + 2]; r.w = acc[4 * q + 3]; *(f32x4*)(orow + 4 * q) = xv + hv * r; }
    }
}
template <int LPR>
__device__ __forceinline__ void ph_peer_v8g(const Params& p, unsigned char* lds) {
    constexpr int RPI = 64 / LPR, NI = 128 / RPI, G = NI / 8, NS = 64 / LPR, SLB = 16 * LPR;
    const unsigned char* V8 = (const unsigned char*)(p.ws + WS_V16);
    const int* EXPI = (const int*)(p.ws + WS_EXP); const float* CBUF = (const float*)(p.ws + WS_CBUF); const float* MOD = (const float*)(p.ws + WS_MOD);
    unsigned* ctl = (unsigned*)(p.ws + WS_CTL);
    int tid = threadIdx.x; asm volatile("" : "+v"(tid));
    const int lane = tid & 63, wv = __builtin_amdgcn_readfirstlane(tid >> 6), gR = lane / LPR, iC = lane % LPR;
    volatile LAS unsigned* slot = (volatile LAS unsigned*)(LAS unsigned char*)lds;
    const unsigned xcc = peer_xcc();
#pragma unroll 1
    for (int k = 0; k < NS; ++k) {
        const int sl = (int)((((xcc * NS) >> 3) + (unsigned)k) % (unsigned)NS);
        const unsigned char* vcol = V8 + SLB * sl + 16 * iC;
#pragma unroll 1
        for (;;) {
            if (tid == 0) *slot = __hip_atomic_fetch_add(ctl + CW_P8_V + 64 * sl, 1u, __ATOMIC_RELAXED, __HIP_MEMORY_SCOPE_AGENT);
            __syncthreads();
            const unsigned unit = *slot;
            __syncthreads();
            if (unit >= (unsigned)P8_UNITS) break;
            const int tbase = (int)unit * 64 + wv * 8;
            int ne0, ne1; float nc0, nc1;
#define VG_FETCH(T) do { const size_t tn_ = (size_t)(T); ne0 = EXPI[tn_ * 128 + lane]; ne1 = EXPI[tn_ * 128 + 64 + lane]; nc0 = CBUF[tn_ * 128 + lane]; nc1 = CBUF[tn_ * 128 + 64 + lane]; } while (0)
#define VG_LISTS(LE, LC) do { LE[lane] = ne0; LE[64 + lane] = ne1; LC[lane] = nc0; LC[64 + lane] = nc1; } while (0)
#define VG_ROWS(R, LE, GI) do { _Pragma("unroll") for (int kk = 0; kk < 8; ++kk) R[kk] = *(const u32x4*)(vcol + (size_t)LE[RPI * (8 * (GI) + kk) + gR] * 1024); } while (0)
#define VG_GROUP(R, LC, GI) do { _Pragma("unroll") for (int kk = 0; kk < 8; ++kk) { const float cj = LC[RPI * (8 * (GI) + kk) + gR];                       \
            const unsigned w_[4] = {R[kk].x, R[kk].y, R[kk].z, R[kk].w};                                                                       \
            _Pragma("unroll") for (int c = 0; c < 4; ++c) { const f32x2_t lo = __builtin_amdgcn_cvt_pk_f32_fp8((int)w_[c], false), hi = __builtin_amdgcn_cvt_pk_f32_fp8((int)w_[c], true); \
                acc[4 * c] = fmaf(cj, lo.x, acc[4 * c]); acc[4 * c + 1] = fmaf(cj, lo.y, acc[4 * c + 1]); acc[4 * c + 2] = fmaf(cj, hi.x, acc[4 * c + 2]); acc[4 * c + 3] = fmaf(cj, hi.y, acc[4 * c + 3]); } } } while (0)
            u32x4 RA[8], RB[8];
            int* lecur = (int*)(lds + 1024 + wv * 2048); int* lenxt = lecur + 256;
            VG_FETCH(tbase); VG_LISTS(lecur, ((float*)(lecur + 128))); VG_FETCH(tbase + 1);
            LDS_WAIT(); asm volatile("" ::: "memory");
            VG_ROWS(RA, lecur, 0);
#pragma unroll 1
            for (int tt = 0; tt < 8; ++tt) {
                const int t = tbase + tt;
                float* lccur = (float*)(lecur + 128); float* lcnxt = (float*)(lenxt + 128);
                float acc[16];
#pragma unroll
                for (int q = 0; q < 16; ++q) acc[q] = 0.f;
                if (tt + 1 < 8) { VG_LISTS(lenxt, lcnxt); if (tt + 2 < 8) VG_FETCH(t + 2); }
#pragma unroll 1
                for (int gi = 0; gi < G; gi += 2) {
                    VG_ROWS(RB, lecur, gi + 1);
                    VG_GROUP(RA, lccur, gi);
                    if (gi + 2 < G) VG_ROWS(RA, lecur, gi + 2);
                    else if (tt + 1 < 8) { LDS_WAIT(); asm volatile("" ::: "memory"); VG_ROWS(RA, lenxt, 0); }
                    VG_GROUP(RB, lccur, gi + 1);
                }
#pragma unroll
                for (int q = 0; q < 16; ++q) { if (LPR <= 8) acc[q] += dpp_f<0x128>(acc[q]); if (LPR <= 16) acc[q] += __shfl_xor(acc[q], 16); if (LPR <= 32) acc[q] += __shfl_xor(acc[q], 32); }
                if (gR == 0) { const int col = SLB * sl + 16 * iC; const float* g2 = MOD + (size_t)(t >> 11) * 6144 + 5120 + col; float* orow = p.out + (size_t)t * 1024 + col;
#pragma unroll
                    for (int q = 0; q < 4; ++q) { const f32x4 xv = *(const f32x4*)(orow + 4 * q), hv = *(const f32x4*)(g2 + 4 * q);
                        f32x4 r; r.x = acc[4 * q]; r.y = acc[4 * q + 1]; r.z = acc[4 * q + 2]; r.w = acc[4 * q + 3]; *(f32x4*)(orow + 4 * q) = xv + hv * r; } }
                { int* tmp_ = lecur; lecur = lenxt; lenxt = tmp_; }
            }
#undef VG_FETCH
#undef VG_LISTS
#undef VG_ROWS
#undef VG_GROUP
            LDS_WAIT(); asm volatile("" ::: "memory");
        }
    }
}
#define XB_TMO      128
#define XB_XCNT(j)  (256  + 64 * (j))
#define XB_XSUB(j)  (1280 + 64 * (j))
#define XB_XGEN(j)  (2304 + 64 * (j))
#define XB_TOP      3328
#define XB_TOPGEN   3392
#define XCD_BAR_WORDS 3456
#define XB_SPIN_CAP (1u << 18)

__device__ __forceinline__ unsigned xb_ld(unsigned* p)              { return __hip_atomic_load(p, __ATOMIC_RELAXED, __HIP_MEMORY_SCOPE_AGENT); }
__device__ __forceinline__ unsigned xb_add(unsigned* p, unsigned v) { return __hip_atomic_fetch_add(p, v, __ATOMIC_RELAXED, __HIP_MEMORY_SCOPE_AGENT); }
__device__ __forceinline__ unsigned xb_xcc_id() { return (unsigned)__builtin_amdgcn_s_getreg((3 << 11) | 20) & 0xFu; }
#define XB_SPIN(cond, bar) do { unsigned _sp = 0; while (cond) { __builtin_amdgcn_s_sleep(1); \
    if ((++_sp & 255u) == 0u) { if (xb_ld(&(bar)[XB_TMO])) break; if (_sp > XB_SPIN_CAP) { atomicAdd(&(bar)[XB_TMO], 1u); break; } } } } while (0)

struct XcdBarrier {
    unsigned* bar; unsigned x;
    volatile LAS unsigned* st;
};

__device__ __forceinline__ XcdBarrier xcd_barrier_post(unsigned* bar, volatile LAS unsigned* st) {
    XcdBarrier b; b.bar = bar; b.x = xb_xcc_id(); b.st = st;
    if (threadIdx.x == 0) (void)xb_add(&bar[XB_XCNT(b.x)], 1u);
    return b;
}
__device__ __forceinline__ void xcd_barrier_complete(unsigned* bar, unsigned x, unsigned& nloc, unsigned& nx) {
    const unsigned G = gridDim.x * gridDim.y * gridDim.z;
    unsigned sum, cnt, mine, sp = 0u;
    for (;;) {
        sum = 0u; cnt = 0u; mine = 0u;
#pragma unroll
        for (unsigned j = 0; j < 16; ++j) { const unsigned c = xb_ld(&bar[XB_XCNT(j)]); sum += c; cnt += (c > 0u) ? 1u : 0u; mine = (j == x) ? c : mine; }
        if (sum == G) break;
        __builtin_amdgcn_s_sleep(1);
        if ((++sp & 255u) == 0u) { if (xb_ld(&bar[XB_TMO])) break; if (sp > XB_SPIN_CAP) { atomicAdd(&bar[XB_TMO], 1u); break; } }
    }
    nloc = mine > 0u ? mine : 1u; nx = cnt > 0u ? cnt : 1u;
}

__device__ __forceinline__ void xcd_barrier(const XcdBarrier& b) {
    asm volatile("s_waitcnt vmcnt(0)" ::: "memory");
    __syncthreads();
    if (threadIdx.x == 0) {
        unsigned* bar = b.bar;
        __builtin_amdgcn_s_waitcnt(0);
        unsigned nloc = b.st[0], nx = b.st[1];
        if (nloc == 0u) { xcd_barrier_complete(bar, b.x, nloc, nx); b.st[0] = nloc; b.st[1] = nx; }
        const unsigned old = xb_add(&bar[XB_XSUB(b.x)], 1u);
        const unsigned gen = old / nloc;
        if (old + 1u == (gen + 1u) * nloc) {
            __builtin_amdgcn_fence(__ATOMIC_RELEASE, "agent");
            asm volatile("s_waitcnt vmcnt(0)" ::: "memory");
            const unsigned og = xb_add(&bar[XB_TOP], 1u);
            const unsigned tg = og / nx;
            if (og + 1u == (tg + 1u) * nx) xb_add(&bar[XB_TOPGEN], 1u);
            else XB_SPIN(xb_ld(&bar[XB_TOPGEN]) == tg, bar);
            __builtin_amdgcn_fence(__ATOMIC_ACQUIRE, "agent");
            xb_add(&bar[XB_XGEN(b.x)], 1u);
            asm volatile("s_waitcnt vmcnt(0)" ::: "memory");
        } else {
            XB_SPIN(xb_ld(&bar[XB_XGEN(b.x)]) == gen, bar);
            __builtin_amdgcn_fence(__ATOMIC_ACQUIRE, "agent");
            asm volatile("s_waitcnt vmcnt(0)" ::: "memory");
        }
    }
    __syncthreads();
}

#ifndef VAR_DSA_OLD
#define VAR_DSA_OLD 0
#endif
#ifndef VAR_U8_OLD
#define VAR_U8_OLD 1
#endif
#ifndef VAR_V8_OLD
#define VAR_V8_OLD 0
#endif
#ifndef V8_LPR
#define V8_LPR 32
#endif
#ifndef PEER_FUSED
#define PEER_FUSED 0
#endif
#ifndef PROBE_DUP
#define PROBE_DUP 0
#endif
constexpr int LDS_BYTES = 147456;
extern __shared__ __attribute__((aligned(16))) unsigned char dyn_lds[];

__global__ void __launch_bounds__(NT, 2) mega_fwd(Params p) {
    cg::grid_group grid = cg::this_grid();
    const int vb = blockIdx.x, nvb = gridDim.x, ngw = nvb * NWV;
    volatile LAS unsigned* xst = (volatile LAS unsigned*)((LAS unsigned char*)dyn_lds + (LDS_BYTES - 16));
    if (threadIdx.x < 4) xst[threadIdx.x] = 0u;
    __syncthreads();
    const XcdBarrier xbar = xcd_barrier_post((unsigned*)(p.ws + WS_CTL), xst);
#define TID_LAUNDER int tid_ = threadIdx.x; asm volatile("" : "+v"(tid_)); const int lane = tid_ & 63, wv = tid_ >> 6, gw = vb * NWV + wv; (void)lane; (void)gw;
    ph_mod(p, (float*)dyn_lds, vb, nvb);
    { TID_LAUNDER ph_prep_weights(p, (LAS float*)dyn_lds + wv * (64 * 33), gw, ngw, lane); }
#if PROBE_DUP == 7
    __syncthreads();
    ph_mod(p, (float*)dyn_lds, vb, nvb);
    { TID_LAUNDER ph_prep_weights(p, (LAS float*)dyn_lds + wv * (64 * 33), gw, ngw, lane); }
#endif
    grid.sync();
    { TID_LAUNDER ph_hrows(p, p.x, p.norm1_g, 0, 1024, gw, ngw, lane); }
#if PROBE_DUP == 9
    { TID_LAUNDER ph_hrows(p, p.x, p.norm1_g, 0, 1024, gw, ngw, lane); }
#endif
    xcd_barrier(xbar);
    {   pg8::Gemm g{(const bf16*)(p.ws + WS_H), (const bf16*)(p.ws + WS_WIN), T, NP, 1024}; pg8::StaticOrder S; S.init(T, NP, nvb, vb);
        EpiNormBf16 E{(bf16*)(p.ws + WS_PROJ), p.a_qk_gain, p.b_q_gain, p.b_kv_gain, (LAS float*)((LAS unsigned char*)dyn_lds + 131072)};
        pg8::gemm_phase<EpiNormBf16, pg8::StaticOrder, true, true>((LAS unsigned char*)dyn_lds, g, S, E); }
    xcd_barrier(xbar);
    ph_attnA(p, dyn_lds, vb, nvb);
#if PROBE_DUP == 1
    __syncthreads(); ph_attnA(p, dyn_lds, vb, nvb);
#endif
    __syncthreads();
#if VAR_DSA_OLD
    ph_dsa_old(p, dyn_lds, vb, nvb);
#else
    ph_dsa(p, dyn_lds, vb, nvb);
#endif
#if PROBE_DUP == 2
    __syncthreads(); ph_dsa(p, dyn_lds, vb, nvb);
#endif
    xcd_barrier(xbar);
    {   pg8::Gemm g{(const bf16*)(p.ws + WS_MIX), (const bf16*)(p.ws + WS_WO2), T, 1024, MIXW}; pg8::StaticOrder S; S.init(T, 1024, nvb, vb);
        EpiResGate E{p.x, p.out, (const float*)(p.ws + WS_MOD) + 2048};
        pg8::gemm_phase<EpiResGate, pg8::StaticOrder, true, true>((LAS unsigned char*)dyn_lds, g, S, E); }
#if PROBE_DUP == 8
    {   pg8::Gemm g{(const bf16*)(p.ws + WS_MIX), (const bf16*)(p.ws + WS_WO2), T, 1024, MIXW}; pg8::StaticOrder S; S.init(T, 1024, nvb, vb);
        EpiResGate E{p.x, p.out, (const float*)(p.ws + WS_MOD) + 2048};
        pg8::gemm_phase<EpiResGate, pg8::StaticOrder, true, true>((LAS unsigned char*)dyn_lds, g, S, E); }
#endif
    xcd_barrier(xbar);
    { TID_LAUNDER ph_hrows(p, p.out, p.norm2_g, 3072, 4096, gw, ngw, lane); }
    xcd_barrier(xbar);
    {   pg8::Gemm g{(const bf16*)(p.ws + WS_H), (const bf16*)(p.ws + WS_WQ), T, 1024, 1024}; pg8::StaticOrder S; S.init(T, 1024, nvb, vb);
        pg8::EpiBf16<0> E{(bf16*)(p.ws + WS_Q3), 1024, nullptr, 0, 0, 1.f};
        pg8::gemm_phase<pg8::EpiBf16<0>, pg8::StaticOrder, true, true>((LAS unsigned char*)dyn_lds, g, S, E); }
#if PROBE_DUP == 8
    {   pg8::Gemm g{(const bf16*)(p.ws + WS_H), (const bf16*)(p.ws + WS_WQ), T, 1024, 1024}; pg8::StaticOrder S; S.init(T, 1024, nvb, vb);
        pg8::EpiBf16<0> E{(bf16*)(p.ws + WS_Q3), 1024, nullptr, 0, 0, 1.f};
        pg8::gemm_phase<pg8::EpiBf16<0>, pg8::StaticOrder, true, true>((LAS unsigned char*)dyn_lds, g, S, E); }
#endif
    xcd_barrier(xbar);
    ph_route(p, dyn_lds, vb, nvb);
#if PROBE_DUP == 3
    __syncthreads(); ph_route(p, dyn_lds, vb, nvb);
#endif
    xcd_barrier(xbar);

#if PEER_FUSED
    { TID_LAUNDER ph_peer8t(p, dyn_lds + wv * 1024, gw, ngw, lane); }
#else
    ph_peer_u8_old(p, dyn_lds);
    xcd_barrier(xbar);
    ph_peer_v8g<V8_LPR>(p, dyn_lds);
#endif

}

extern "C" void kernel_launch(void* const* d_in, const int* in_sizes, int n_in, void* d_out, int out_size, void* d_ws, size_t ws_size, hipStream_t stream) {
    static int grid_blocks = 0;
    if (grid_blocks == 0) {
        if (n_in != 18 || in_sizes[0] != T * DM || out_size != T * DM || ws_size < WS_END) { fprintf(stderr, "kernel_launch: unexpected shapes n_in %d in0 %d out %d ws %zu\n", n_in, n_in > 0 ? in_sizes[0] : -1, out_size, ws_size); grid_blocks = -1; return; }
        int dev = 0, cus = 0, per_cu = 0;
        (void)hipGetDevice(&dev);
        (void)hipDeviceGetAttribute(&cus, hipDeviceAttributeMultiprocessorCount, dev);
        (void)hipFuncSetAttribute((const void*)mega_fwd, hipFuncAttributeMaxDynamicSharedMemorySize, LDS_BYTES);
        (void)hipOccupancyMaxActiveBlocksPerMultiprocessor(&per_cu, (const void*)mega_fwd, NT, LDS_BYTES);
        if (per_cu < 1 || cus < 1) { fprintf(stderr, "kernel_launch: occupancy query gave %d blocks/CU on %d CUs\n", per_cu, cus); grid_blocks = -1; return; }
        grid_blocks = cus;
    }
    if (grid_blocks < 0) return;
    Params p{};
    const float** pp = (const float**)&p;
    for (int i = 0; i < 18; ++i) pp[i] = (const float*)d_in[i];
    p.out = (float*)d_out; p.ws = (unsigned char*)d_ws;
    if (hipMemsetAsync((char*)d_ws + WS_CTL, 0, CTL_BYTES, stream) != hipSuccess) { fprintf(stderr, "kernel_launch: memset failed\n"); return; }
    void* args[] = {&p};
    const hipError_t e = hipLaunchCooperativeKernel((const void*)mega_fwd, dim3(grid_blocks), dim3(NT), args, LDS_BYTES, stream);
    if (e != hipSuccess) fprintf(stderr, "kernel_launch: cooperative launch failed: %s (grid %d)\n", hipGetErrorString(e), grid_blocks);
}
```

```cpp
#include <hip/hip_runtime.h>
#include <hip/hip_cooperative_groups.h>
#include <cstdio>
#include <cstdint>
#include <cmath>
namespace pg8 {
#define PG8_LAS __attribute__((address_space(3)))
typedef unsigned short bf16_t;
typedef short bf16x8 __attribute__((ext_vector_type(8)));
typedef float f32x4 __attribute__((ext_vector_type(4)));
typedef unsigned u32x4 __attribute__((ext_vector_type(4)));
constexpr int BM = 256, BK = 64, HALF = 128, HTB = HALF * BK * 2  , STAGE_BYTES = 8 * HTB, NXCD = 8, WGM = 8;

__host__ __device__ __forceinline__ int lds_byte(int r, int c) { const int st = (r >> 4) * 2 + (c >> 5), rr = r & 15, cc = c & 31, ob = rr * 64 + cc * 2; return st * 1024 + (ob ^ (((ob >> 9) & 1) << 5)); }
__host__ __device__ __forceinline__ void stage_rc(int b, int& R, int& C) { const int st = b / 1024, sb = b % 1024, swz = sb ^ (((sb >> 9) & 1) << 5); R = (st >> 1) * 16 + swz / 64; C = (st & 1) * 32 + (swz % 64) / 2; }
__host__ __device__ __forceinline__ int perm32(int rho) { const int n = rho >> 4, i = rho & 15; return 8 * (i >> 2) + 4 * n + (i & 3); }

struct Unit { int pm, pn; };
struct Gemm { const bf16_t* A; const bf16_t* Bt; int M, N, K; };

struct StaticOrder {
    int nM, nN, nwg, G, c;
    __host__ __device__ void init(int M, int N, int G_, int c_) { nM = M / BM; nN = N / BM; nwg = nM * nN; G = G_; c = c_; }
    __host__ __device__ bool next(int i, Unit& u) const {
        const long L = (long)i * G + c; if (L >= nwg) return false;
        int wgid = (int)L; { const int q = nwg / NXCD, r = nwg % NXCD, xcd = wgid % NXCD, off = wgid / NXCD; wgid = (xcd < r ? xcd * (q + 1) : r * (q + 1) + (xcd - r) * q) + off; }
        const int nig = WGM * nN, gid = wgid / nig, fm = gid * WGM, gsz = (nM - fm) < WGM ? (nM - fm) : WGM;
        u.pm = fm + ((wgid % nig) % gsz); u.pn = (wgid % nig) / gsz; return true;
    }
    __device__ __forceinline__ void a_ready(const Unit&) const {}
    __device__ __forceinline__ void done(const Unit&) const {}
};

__device__ __forceinline__ unsigned cvt_pk_bf16(float lo, float hi) { unsigned r; asm volatile("v_cvt_pk_bf16_f32 %0, %1, %2" : "=v"(r) : "v"(lo), "v"(hi)); return r; }
typedef float f32x2 __attribute__((ext_vector_type(2)));
__device__ __forceinline__ f32x2 gelu_pk(f32x2 v) {
    const f32x2 av = __builtin_elementwise_abs(v), d = av * 0.2316418882f + 1.0f;
    f32x2 t; t.x = __builtin_amdgcn_rcpf(d.x); t.y = __builtin_amdgcn_rcpf(d.y);
    f32x2 q = t * 0.5307027145f + (-0.7265760135f); q = q * t + 0.7107068705f; q = q * t + (-0.142248368f); q = q * t + 0.127414796f; q = q * t;
    const f32x2 s = (v * v) * (-0.72134752044f);
    f32x2 e; e.x = __builtin_amdgcn_exp2f(s.x); e.y = __builtin_amdgcn_exp2f(s.y);
    const f32x2 m = v * (q * e), r = v - m;
    f32x2 o; o.x = v.x < 0.f ? m.x : r.x; o.y = v.y < 0.f ? m.y : r.y; return o;
}

template <int ACT  > struct EpiBf16 {
    static constexpr bool PERM = true, AFTER_DRAIN = false; static_assert(ACT == 0 || ACT == 1, "EpiBf16: ACT is 0 (none) or 1 (gelu_pk)");
    bf16_t* O; int ldc; const float* bias; int split_cols; size_t split_stride; float scale0;
    __device__ __forceinline__ void operator()(const f32x4 (&acc)[2][2][4][2], const Unit& u, int wr, int wc, int fr, int fq) const {
        const int row0 = u.pm * BM + wr * 64 + fr; int colt = u.pn * BM; bf16_t* base = O;
        float sc = 1.f; if (split_cols) { const int t = colt / split_cols; base += (size_t)t * split_stride; colt -= t * split_cols; if (t == 0) sc = scale0; }
        const int col0 = colt + wc * 32 + 8 * fq, bcol0 = u.pn * BM + wc * 32 + 8 * fq;
        f32x4 bv[2][2];
#pragma unroll
        for (int bj = 0; bj < 2; ++bj)
#pragma unroll
            for (int n = 0; n < 2; ++n) bv[bj][n] = bias ? *(const f32x4*)(bias + bcol0 + bj * HALF + 4 * n) : (f32x4){0.f, 0.f, 0.f, 0.f};
#pragma unroll
        for (int ai = 0; ai < 2; ++ai)
#pragma unroll
            for (int m = 0; m < 4; ++m) { bf16_t* rowp = base + (size_t)(row0 + ai * HALF + m * 16) * ldc + col0;
#pragma unroll
                for (int bj = 0; bj < 2; ++bj) { f32x4 v0 = acc[ai][bj][m][0] + bv[bj][0], v1 = acc[ai][bj][m][1] + bv[bj][1];
                    if (ACT == 1) { f32x2 a = gelu_pk((f32x2){v0[0], v0[1]}), b = gelu_pk((f32x2){v0[2], v0[3]}), c = gelu_pk((f32x2){v1[0], v1[1]}), d = gelu_pk((f32x2){v1[2], v1[3]});
                        v0 = (f32x4){a.x, a.y, b.x, b.y}; v1 = (f32x4){c.x, c.y, d.x, d.y}; }
                    v0 = v0 * sc; v1 = v1 * sc; u32x4 w; w.x = cvt_pk_bf16(v0[0], v0[1]); w.y = cvt_pk_bf16(v0[2], v0[3]); w.z = cvt_pk_bf16(v1[0], v1[1]); w.w = cvt_pk_bf16(v1[2], v1[3]);
                    *(u32x4*)(rowp + bj * HALF) = w; } }
    }
};

template <class Epi, class Sched, bool ALIGN_EPI = false, bool SP2 = false>
__device__ __forceinline__ void gemm_phase(PG8_LAS unsigned char* lds, const Gemm g, const Sched& S, const Epi& E) {
    int tid = threadIdx.x; asm volatile("" : "+v"(tid)); const int wid = __builtin_amdgcn_readfirstlane(tid >> 6), lane = tid & 63, wr = wid >> 2, wc = wid & 3, fr = lane & 15, fq = lane >> 4;
    const int K = g.K, nt = K / BK;
    unsigned voffA[2], voffB[2];
#pragma unroll
    for (int i = 0; i < 2; ++i) { int R, C; stage_rc(tid * 16 + i * 8192, R, C); const int Rb = Epi::PERM ? ((R & ~31) + perm32(R & 31)) : R;
        voffA[i] = (unsigned)(R * K + C) * 2u; voffB[i] = (unsigned)(Rb * K + C) * 2u; }
    const size_t kstep = (size_t)(BK * 2);
    const size_t hstep = (size_t)HALF * K * 2;
    const size_t tstep = 2 * hstep;
    const unsigned ldsw = (unsigned)wid * 1024u;
    const int aoff = lds_byte(wr * 64 + fr, fq * 8), boff = lds_byte(wc * 32 + fr, fq * 8);
#define PG8_SA(b, h) (((b) * 2 + (h)) * HTB)
#define PG8_SB(b, h) ((4 + (b) * 2 + (h)) * HTB)
#define PG8_STAGE(bufoff, gbase, voff) do { _Pragma("unroll") for (int _i = 0; _i < 2; ++_i) \
        __builtin_amdgcn_global_load_lds((const unsigned*)((const char*)(gbase) + (voff)[_i]), (PG8_LAS unsigned*)(lds + (bufoff) + ldsw + _i * 8192), 16, 0, 0); } while (0)
#define PG8_LDA(dst, b, h) do { _Pragma("unroll") for (int m = 0; m < 4; ++m) _Pragma("unroll") for (int k = 0; k < 2; ++k) dst[m][k] = *(const PG8_LAS bf16x8*)(lds + PG8_SA(b, h) + aoff + m * 2048 + k * 1024); } while (0)
#define PG8_LDB(dst, b, h) do { _Pragma("unroll") for (int n = 0; n < 2; ++n) _Pragma("unroll") for (int k = 0; k < 2; ++k) dst[n][k] = *(const PG8_LAS bf16x8*)(lds + PG8_SB(b, h) + boff + n * 2048 + k * 1024); } while (0)
#define PG8_MMA(ai, bj, At, Bt) do { __builtin_amdgcn_s_setprio(1); _Pragma("unroll") for (int m = 0; m < 4; ++m) _Pragma("unroll") for (int n = 0; n < 2; ++n) _Pragma("unroll") for (int k = 0; k < 2; ++k) \
        acc[ai][bj][m][n] = __builtin_amdgcn_mfma_f32_16x16x32_bf16(Bt[n][k], At[m][k], acc[ai][bj][m][n], 0, 0, 0); __builtin_amdgcn_s_setprio(0); } while (0)
#define PG8_WAIT_V(n) asm volatile("s_waitcnt vmcnt(" #n ")" ::: "memory")
#define PG8_WAIT_L(n) asm volatile("s_waitcnt lgkmcnt(" #n ")" ::: "memory")
#define PG8_BAR __builtin_amdgcn_s_barrier()
#define PG8_SCHED __builtin_amdgcn_sched_barrier(0)
    Unit cur, nxt; int ui = 0;
    if (!S.next(0, cur)) return;
    f32x4 acc[2][2][4][2];
#pragma unroll
    for (int a = 0; a < 2; ++a)
#pragma unroll
        for (int b = 0; b < 2; ++b)
#pragma unroll
            for (int m = 0; m < 4; ++m)
#pragma unroll
                for (int n = 0; n < 2; ++n) acc[a][b][m][n] = (f32x4){0.f, 0.f, 0.f, 0.f};
    bf16x8 At[4][2], B0[2][2], B1[2][2];
    const char* cA = (const char*)g.A + (size_t)cur.pm * tstep; const char* cB = (const char*)g.Bt + (size_t)cur.pn * tstep;
    S.a_ready(cur);
    if constexpr (SP2) {
        PG8_STAGE(PG8_SB(0, 0), cB, voffB); PG8_STAGE(PG8_SB(0, 1), cB + hstep, voffB); PG8_STAGE(PG8_SA(0, 0), cA, voffA); PG8_STAGE(PG8_SA(0, 1), cA + hstep, voffA);
        if (wr == 1) PG8_BAR;
        PG8_WAIT_V(2); PG8_BAR;
        PG8_STAGE(PG8_SB(1, 0), cB + kstep, voffB); PG8_STAGE(PG8_SA(1, 0), cA + kstep, voffA); PG8_STAGE(PG8_SB(1, 1), cB + hstep + kstep, voffB);
        PG8_WAIT_V(6); PG8_BAR;
    } else {
        PG8_STAGE(PG8_SB(0, 0), cB, voffB); PG8_STAGE(PG8_SA(0, 0), cA, voffA); PG8_STAGE(PG8_SB(0, 1), cB + hstep, voffB); PG8_STAGE(PG8_SA(0, 1), cA + hstep, voffA);
        if (wr == 1) PG8_BAR;
        PG8_WAIT_V(4); PG8_BAR;
        PG8_STAGE(PG8_SB(1, 0), cB + kstep, voffB); PG8_STAGE(PG8_SA(1, 0), cA + kstep, voffA); PG8_STAGE(PG8_SB(1, 1), cB + hstep + kstep, voffB);
        PG8_WAIT_V(6); PG8_BAR;
    }
    for (;;) {
        const bool has_next = S.next(ui + 1, nxt);
        const char* nA = has_next ? (const char*)g.A + (size_t)nxt.pm * tstep : cA; const char* nB = has_next ? (const char*)g.Bt + (size_t)nxt.pn * tstep : cB;
        for (int t = 0; t < nt; t += 2) {
            const bool last = (t == nt - 2);
            const char* a1 = cA + (size_t)(t + 1) * kstep;
            const char* a2 = last ? nA : cA + (size_t)(t + 2) * kstep; const char* b2 = last ? nB : cB + (size_t)(t + 2) * kstep;
            const char* a3 = a2 + kstep; const char* b3 = b2 + kstep;
            if (last && has_next) S.a_ready(nxt);
            if constexpr (SP2) {
            PG8_LDB(B0, 0, 0); PG8_LDB(B1, 0, 1); PG8_SCHED; PG8_LDA(At, 0, 0); PG8_STAGE(PG8_SA(1, 1), a1 + hstep, voffA);
            PG8_WAIT_V(8); PG8_WAIT_L(0); PG8_BAR; PG8_MMA(0, 0, At, B0); PG8_MMA(0, 1, At, B1); PG8_BAR; PG8_SCHED;
            PG8_LDA(At, 0, 1); PG8_STAGE(PG8_SB(0, 0), b2, voffB); PG8_STAGE(PG8_SB(0, 1), b2 + hstep, voffB); PG8_STAGE(PG8_SA(0, 0), a2, voffA);
            PG8_WAIT_V(8); PG8_WAIT_L(0); PG8_BAR; PG8_MMA(1, 0, At, B0); PG8_MMA(1, 1, At, B1); PG8_BAR; PG8_SCHED;
            PG8_LDB(B0, 1, 0); PG8_LDB(B1, 1, 1); PG8_SCHED; PG8_LDA(At, 1, 0); PG8_STAGE(PG8_SA(0, 1), a2 + hstep, voffA);
            PG8_WAIT_V(8); PG8_WAIT_L(0); PG8_BAR; PG8_MMA(0, 0, At, B0); PG8_MMA(0, 1, At, B1); PG8_BAR; PG8_SCHED;
            PG8_LDA(At, 1, 1); PG8_STAGE(PG8_SB(1, 0), b3, voffB); PG8_STAGE(PG8_SB(1, 1), b3 + hstep, voffB); PG8_STAGE(PG8_SA(1, 0), a3, voffA);
            PG8_WAIT_V(8); PG8_WAIT_L(0); PG8_BAR; PG8_MMA(1, 0, At, B0); PG8_MMA(1, 1, At, B1); PG8_BAR; PG8_SCHED;
            } else {
            PG8_LDB(B0, 0, 0); PG8_SCHED; PG8_LDA(At, 0, 0); PG8_STAGE(PG8_SA(1, 1), a1 + hstep, voffA);
            PG8_WAIT_L(8); PG8_BAR; PG8_WAIT_L(0); PG8_MMA(0, 0, At, B0); PG8_BAR; PG8_SCHED;
            PG8_LDB(B1, 0, 1); PG8_STAGE(PG8_SB(0, 0), b2, voffB);
            PG8_BAR; PG8_WAIT_L(0); PG8_MMA(0, 1, At, B1); PG8_BAR;
            PG8_LDA(At, 0, 1); PG8_STAGE(PG8_SA(0, 0), a2, voffA);
            PG8_BAR; PG8_WAIT_L(0); PG8_MMA(1, 0, At, B0); PG8_BAR; PG8_SCHED;
            PG8_STAGE(PG8_SB(0, 1), b2 + hstep, voffB);
            PG8_WAIT_V(6); PG8_BAR; PG8_MMA(1, 1, At, B1); PG8_BAR;
            PG8_LDB(B0, 1, 0); PG8_SCHED; PG8_LDA(At, 1, 0); PG8_STAGE(PG8_SA(0, 1), a2 + hstep, voffA);
            PG8_WAIT_L(8); PG8_BAR; PG8_WAIT_L(0); PG8_MMA(0, 0, At, B0); PG8_BAR; PG8_SCHED;
            PG8_LDB(B1, 1, 1); PG8_STAGE(PG8_SB(1, 0), b3, voffB);
            PG8_BAR; PG8_WAIT_L(0); PG8_MMA(0, 1, At, B1); PG8_BAR;
            PG8_LDA(At, 1, 1); PG8_STAGE(PG8_SA(1, 0), a3, voffA);
            PG8_BAR; PG8_WAIT_L(0); PG8_MMA(1, 0, At, B0); PG8_BAR; PG8_SCHED;
            PG8_STAGE(PG8_SB(1, 1), b3 + hstep, voffB);
            PG8_WAIT_V(6); PG8_BAR; PG8_MMA(1, 1, At, B1); PG8_BAR;
            }
        }
        if constexpr (ALIGN_EPI) { if (wr == 0) PG8_BAR; }
        if constexpr (!Epi::AFTER_DRAIN) { E(acc, cur, wr, wc, fr, fq); S.done(cur); }
        if (!has_next) break;
#pragma unroll
        for (int a = 0; a < 2; ++a)
#pragma unroll
            for (int b = 0; b < 2; ++b)
#pragma unroll
                for (int m = 0; m < 4; ++m)
#pragma unroll
                    for (int n = 0; n < 2; ++n) acc[a][b][m][n] = (f32x4){0.f, 0.f, 0.f, 0.f};
        cur = nxt; cA = nA; cB = nB; ++ui;
        if constexpr (ALIGN_EPI) { if (wr == 1) PG8_BAR; }
    }
    PG8_WAIT_V(0);
    if constexpr (!ALIGN_EPI) { if (wr == 0) PG8_BAR; }
    PG8_BAR;
    if constexpr (Epi::AFTER_DRAIN) { E.fused(acc, cur, wr, wc, fr, fq, lds, wid, lane); S.done(cur); }
#undef PG8_SA
#undef PG8_SB
#undef PG8_STAGE
#undef PG8_LDA
#undef PG8_LDB
#undef PG8_MMA
#undef PG8_WAIT_V
#undef PG8_WAIT_L
#undef PG8_BAR
#undef PG8_SCHED
}
}
namespace cg = cooperative_groups;
#define LAS __attribute__((address_space(3)))
typedef unsigned short bf16;
typedef float f32x4 __attribute__((ext_vector_type(4)));
typedef float f32x8 __attribute__((ext_vector_type(8)));
typedef float f32x16 __attribute__((ext_vector_type(16)));
typedef unsigned u32x4 __attribute__((ext_vector_type(4)));
typedef unsigned u32x2 __attribute__((ext_vector_type(2)));
typedef short bf16x8 __attribute__((ext_vector_type(8)));
typedef short s16x4 __attribute__((ext_vector_type(4)));

constexpr int BATCH = 16, SEQ = 2048, DM = 1024, T = BATCH * SEQ;
constexpr int NP = 3072;
constexpr int IN_COLS = 3012;
constexpr int C_QA = 0, C_KA = 512, C_VA = 1024, C_QB = 1536, C_KV = 2560, C_QI = 2688, C_KI = 2944, C_WI = 3008;
constexpr int MIXW = 1536;
constexpr int NEXP = 16384;
constexpr float EPS = 1e-6f;
constexpr int NT = 512;
constexpr int NWV = 8;

constexpr size_t MiB = 1u << 20;
constexpr size_t WS_CTL = 0;
constexpr size_t CTL_BYTES = 64 * 1024;
constexpr size_t WS_MOD = 1 * MiB;
constexpr size_t WS_SCAL = WS_MOD + 512 * 1024;
constexpr size_t WS_WIN = 2 * MiB;
constexpr size_t WS_WO2 = 8 * MiB;
constexpr size_t WS_WQ = 11 * MiB;
constexpr size_t WS_SUBK = 13 * MiB;
constexpr size_t WS_U16 = 14 * MiB;
constexpr size_t WS_V16 = 46 * MiB;
constexpr size_t WS_H = 78 * MiB;
constexpr size_t WS_PROJ = 142 * MiB;
constexpr size_t WS_Q3 = WS_PROJ;
constexpr size_t WS_MIX = 334 * MiB;
constexpr size_t WS_EXP = 430 * MiB;
constexpr size_t WS_GATE = 446 * MiB;
constexpr size_t WS_ATMP = 462 * MiB;
constexpr size_t WS_CBUF = 494 * MiB;
constexpr size_t WS_END = 510 * MiB;

struct Params {
    const float *x, *c, *ada_w, *ada_b, *norm1_g, *norm2_g, *w_in, *a_qk_gain, *a_lambda, *a_sub_gain, *b_q_gain, *b_kv_gain, *b_w_uv, *w_out, *peer_wq, *peer_subkeys, *peer_u, *peer_v;
    float* out; unsigned char* ws;
};

enum { SC_LAM = 0, SC_MA = 1, SC_MB = 2 };

__device__ __forceinline__ unsigned f2bf(float f) { unsigned u = __float_as_uint(f); return (u + 0x7fffu + ((u >> 16) & 1u)) >> 16; }
__device__ __forceinline__ float bf2f(unsigned h) { return __uint_as_float(h << 16); }
__device__ __forceinline__ unsigned pk2(float lo, float hi) { return f2bf(lo) | (f2bf(hi) << 16); }
__device__ __forceinline__ float bflo(unsigned w) { return __uint_as_float(w << 16); }
__device__ __forceinline__ float bfhi(unsigned w) { return __uint_as_float(w & 0xffff0000u); }
__device__ __forceinline__ float wave_sum(float v) {
#pragma unroll
    for (int o = 1; o < 64; o <<= 1) v += __shfl_xor(v, o);
    return v;
}
__device__ __forceinline__ float wave_max(float v) {
#pragma unroll
    for (int o = 1; o < 64; o <<= 1) v = fmaxf(v, __shfl_xor(v, o));
    return v;
}
#define LDS_WAIT() asm volatile("s_waitcnt lgkmcnt(0)" ::: "memory")
__device__ __forceinline__ void ph_mod(const Params& p, float* ldsf, int vb, int nvb) {
    if (vb >= 96) return;
    int tid = threadIdx.x; asm volatile("" : "+v"(tid));
    const int lane = tid & 63, wv = tid >> 6;
    for (int i = tid; i < 16 * 1024; i += NT) { const float v = p.c[i]; ldsf[i] = v / (1.f + __expf(-v)); }
    __syncthreads();
    float* MOD = (float*)(p.ws + WS_MOD); float* part = ldsf + 16 * 1024;
    for (int it = vb; it < 96; it += nvb) {
        const int j = it * 64 + lane;
        float acc[16];
#pragma unroll
        for (int b = 0; b < 16; ++b) acc[b] = 0.f;
        const float* wp = p.ada_w + (size_t)(128 * wv) * 6144 + j;
#pragma unroll 1
        for (int k0 = 0; k0 < 128; k0 += 8) {
            float w[8];
#pragma unroll
            for (int u = 0; u < 8; ++u) w[u] = wp[(size_t)(k0 + u) * 6144];
#pragma unroll
            for (int u = 0; u < 8; ++u)
#pragma unroll
                for (int b = 0; b < 16; ++b) acc[b] = fmaf(ldsf[b * 1024 + 128 * wv + k0 + u], w[u], acc[b]);
        }
#pragma unroll
        for (int b = 0; b < 16; ++b) part[(wv * 16 + b) * 64 + lane] = acc[b];
        __syncthreads();
        for (int o = tid; o < 16 * 64; o += NT) { const int b = o >> 6, c = o & 63; float s = 0.f;
#pragma unroll
            for (int w = 0; w < 8; ++w) s += part[(w * 16 + b) * 64 + c];
            MOD[b * 6144 + it * 64 + c] = s + p.ada_b[it * 64 + c]; }
        __syncthreads();
    }
}

__device__ __forceinline__ void transpose_item(const float* W, int N, bf16* WT, int ldt, LAS float* scr, int kb, int nb, int lane) {
    const int k0 = 64 * kb, n0 = 32 * nb;
#pragma unroll 8
    for (int i = 0; i < 32; ++i) { const int kk = 2 * i + (lane >> 5); const int n = n0 + (lane & 31); scr[kk * 33 + (lane & 31)] = (n < N) ? W[(size_t)(k0 + kk) * N + n] : 0.f; }
    LDS_WAIT(); asm volatile("" ::: "memory");
    const int c = lane & 7;
#pragma unroll
    for (int j = 0; j < 4; ++j) { const int n = (lane >> 3) + 8 * j; const LAS float* s = scr + (8 * c) * 33 + n;
        u32x4 o; o.x = pk2(s[0 * 33], s[1 * 33]); o.y = pk2(s[2 * 33], s[3 * 33]); o.z = pk2(s[4 * 33], s[5 * 33]); o.w = pk2(s[6 * 33], s[7 * 33]);
        *(u32x4*)(WT + (size_t)(n0 + n) * ldt + k0 + 8 * c) = o; }
    LDS_WAIT(); asm volatile("" ::: "memory");
}

__device__ __forceinline__ void ph_prep_weights(const Params& p, LAS float* scr, int gw, int ngw, int lane) {
    bf16* WIN = (bf16*)(p.ws + WS_WIN); bf16* WO2 = (bf16*)(p.ws + WS_WO2); bf16* WQ = (bf16*)(p.ws + WS_WQ);
    constexpr int I_IN = 16 * 96, I_O = 8 * 32, I_Q = 16 * 32;
    for (int it = gw; it < I_IN + I_O + I_Q; it += ngw) {
        int r = it;
        if (r < I_IN) { transpose_item(p.w_in, IN_COLS, WIN, 1024, scr, r / 96, r % 96, lane); continue; } r -= I_IN;
        if (r < I_O) { transpose_item(p.w_out, 1024, WO2, MIXW, scr, r / 32, r % 32, lane); continue; } r -= I_O;
        transpose_item(p.peer_wq, 1024, WQ, 1024, scr, r / 32, r % 32, lane);
    }
    const size_t gt = (size_t)gw * 64 + lane, ngt = (size_t)ngw * 64;
    for (size_t i = gt; i < (size_t)1024 * 1024; i += ngt) {
        const int n = (int)(i & 1023), kk = (int)(i >> 10), h = kk >> 7;
        const float* wu = p.b_w_uv + (size_t)kk * 64; const float* wo = p.w_out + (size_t)(512 + 64 * h) * 1024 + n;
        float a = 0.f;
#pragma unroll 8
        for (int e = 0; e < 64; ++e) a = fmaf(wu[e], wo[(size_t)e * 1024], a);
        WO2[(size_t)n * MIXW + 512 + kk] = (bf16)f2bf(a);
    }
    unsigned char* U8 = (unsigned char*)(p.ws + WS_U16); unsigned char* V8 = (unsigned char*)(p.ws + WS_V16); bf16* SUBK = (bf16*)(p.ws + WS_SUBK);
    constexpr size_t NTAB8 = (size_t)NEXP * 1024 / 8, NSUB8 = 2 * 128 * 64 / 8;
    for (size_t i = gt; i < 2 * NTAB8 + NSUB8; i += ngt) {
        if (i < 2 * NTAB8) {
            const bool isu = i < NTAB8; const size_t j = isu ? i : i - NTAB8; const float sc = isu ? 32.0f : 1.0f;
            const f32x8 v = *(const f32x8*)((isu ? p.peer_u : p.peer_v) + j * 8);
            int w0 = 0, w1 = 0;
            w0 = __builtin_amdgcn_cvt_pk_fp8_f32(v[0] * sc, v[1] * sc, w0, false); w0 = __builtin_amdgcn_cvt_pk_fp8_f32(v[2] * sc, v[3] * sc, w0, true);
            w1 = __builtin_amdgcn_cvt_pk_fp8_f32(v[4] * sc, v[5] * sc, w1, false); w1 = __builtin_amdgcn_cvt_pk_fp8_f32(v[6] * sc, v[7] * sc, w1, true);
            u32x2 o; o.x = (unsigned)w0; o.y = (unsigned)w1;
            *(u32x2*)((isu ? U8 : V8) + j * 8) = o;
        } else {
            const size_t j = i - 2 * NTAB8;
            const f32x8 v = *(const f32x8*)(p.peer_subkeys + j * 8);
            u32x4 o; o.x = pk2(v[0], v[1]); o.y = pk2(v[2], v[3]); o.z = pk2(v[4], v[5]); o.w = pk2(v[6], v[7]);
            *(u32x4*)(SUBK + j * 8) = o;
        }
    }
    if (gt == 0) {
        float* SC = (float*)(p.ws + WS_SCAL);
        float s01 = 0.f, s23 = 0.f;
        for (int i = 0; i < 64; ++i) { s01 += p.a_lambda[i] * p.a_lambda[64 + i]; s23 += p.a_lambda[128 + i] * p.a_lambda[192 + i]; }
        SC[SC_LAM] = __expf(s01) - __expf(s23) + 0.2f;
        float g0 = 0.f, g1 = 0.f, gq = 0.f, gk = 0.f;
        for (int i = 0; i < 64; ++i) { g0 = fmaxf(g0, fabsf(p.a_qk_gain[i])); g1 = fmaxf(g1, fabsf(p.a_qk_gain[64 + i])); }
        for (int i = 0; i < 128; ++i) { gq = fmaxf(gq, fabsf(p.b_q_gain[i])); gk = fmaxf(gk, fabsf(p.b_kv_gain[i])); }
        SC[SC_MA] = 8.0f * g0 * g1 * 1.02f;
        SC[SC_MB] = 11.3137085f * gq * gk * 1.02f;
    }
}

__device__ __forceinline__ void ph_hrows(const Params& p, const float* X, const float* g, int shOff, int scOff, int gw, int ngw, int lane) {
    const float* MOD = (const float*)(p.ws + WS_MOD); bf16* H = (bf16*)(p.ws + WS_H);
    for (int m = gw; m < T; m += ngw) {
        const f32x4* xr = (const f32x4*)(X + (size_t)m * 1024) + lane;
        f32x4 v[4]; float s = 0.f;
#pragma unroll
        for (int j = 0; j < 4; ++j) { v[j] = xr[64 * j]; s += (v[j].x * v[j].x + v[j].y * v[j].y) + (v[j].z * v[j].z + v[j].w * v[j].w); }
        const float rstd = rsqrtf(wave_sum(s) * (1.f / 1024.f) + EPS);
        const float* mb = MOD + (size_t)(m >> 11) * 6144;
#pragma unroll
        for (int j = 0; j < 4; ++j) {
            const int col = 4 * (lane + 64 * j);
            const f32x4 gg = *(const f32x4*)(g + col), sc = *(const f32x4*)(mb + scOff + col), sh = *(const f32x4*)(mb + shOff + col);
            const f32x4 y = v[j] * rstd * gg * (sc + 1.0f) + sh;
            u32x2 o; o.x = pk2(y.x, y.y); o.y = pk2(y.z, y.w);
            *(u32x2*)(H + (size_t)m * 1024 + col) = o;
        }
    }
}

__device__ __forceinline__ void ph_norm_proj(const Params& p, int gw, int ngw, int lane) {
    bf16* PROJ = (bf16*)(p.ws + WS_PROJ);
    for (int m = gw; m < T; m += ngw) {
        bf16* row = PROJ + (size_t)m * NP;
#pragma unroll
        for (int j = 0; j < 6; ++j) {
            if (j == 2) continue;
            const int col = 8 * lane + 512 * j;
            const u32x4 raw = *(const u32x4*)(row + col);
            float v[8] = {bflo(raw.x), bfhi(raw.x), bflo(raw.y), bfhi(raw.y), bflo(raw.z), bfhi(raw.z), bflo(raw.w), bfhi(raw.w)};
            float ss = 0.f;
#pragma unroll
            for (int i = 0; i < 8; ++i) ss += v[i] * v[i];
            ss += __shfl_xor(ss, 1); ss += __shfl_xor(ss, 2); ss += __shfl_xor(ss, 4);
            float rstd; const float* gp;
            if (j < 2) { rstd = rsqrtf(ss * (1.f / 64.f) + EPS); gp = p.a_qk_gain + 64 * j + (col & 63); }
            else { ss += __shfl_xor(ss, 8); rstd = rsqrtf(ss * (1.f / 128.f) + EPS); gp = (j == 5 ? p.b_kv_gain : p.b_q_gain) + (col & 127); }
            if (j == 5 && lane >= 16) continue;
            const f32x4 g0 = *(const f32x4*)gp, g1 = *(const f32x4*)(gp + 4);
            u32x4 o; o.x = pk2(v[0] * rstd * g0.x, v[1] * rstd * g0.y); o.y = pk2(v[2] * rstd * g0.z, v[3] * rstd * g0.w);
            o.z = pk2(v[4] * rstd * g1.x, v[5] * rstd * g1.y); o.w = pk2(v[6] * rstd * g1.z, v[7] * rstd * g1.w);
            *(u32x4*)(row + col) = o;
        }
    }
}
struct EpiResGate {
    static constexpr bool PERM = false, AFTER_DRAIN = false;
    const float* X; float* Out; const float* gate;
    __device__ __forceinline__ void operator()(const pg8::f32x4 (&acc)[2][2][4][2], const pg8::Unit& u, int wr, int wc, int fr, int fq) const {
        const int col0 = u.pn * 256 + wc * 32 + 4 * fq;
#pragma unroll
        for (int ai = 0; ai < 2; ++ai)
#pragma unroll
            for (int m = 0; m < 4; ++m) {
                const int r = u.pm * 256 + ai * 128 + wr * 64 + m * 16 + fr; const float* gb = gate + (size_t)(r >> 11) * 6144;
#pragma unroll
                for (int bj = 0; bj < 2; ++bj)
#pragma unroll
                    for (int n = 0; n < 2; ++n) { const int c = col0 + bj * 128 + n * 16; const size_t off = (size_t)r * 1024 + c;
                        const pg8::f32x4 xv = *(const pg8::f32x4*)(X + off), gv = *(const pg8::f32x4*)(gb + c);
                        *(pg8::f32x4*)(Out + off) = xv + gv * acc[ai][bj][m][n]; }
            }
    }
};


struct EpiNormBf16 {
    static constexpr bool PERM = true, AFTER_DRAIN = false;
    bf16* O; const float* gqk; const float* gbq; const float* gbkv; LAS float* P;
    __device__ __forceinline__ void operator()(const pg8::f32x4 (&acc)[2][2][4][2], const pg8::Unit& u, int wr, int wc, int fr, int fq) const {
        const int pn = u.pn;
        const int mode = pn < 4 ? 1 : ((pn == 4 || pn == 5 || pn == 11) ? 0 : (pn == 10 ? 3 : 2));
        if (mode != 0) {
#pragma unroll
            for (int ai = 0; ai < 2; ++ai)
#pragma unroll
                for (int m = 0; m < 4; ++m)
#pragma unroll
                    for (int bj = 0; bj < 2; ++bj) {
                        const pg8::f32x4 a = acc[ai][bj][m][0], b = acc[ai][bj][m][1];
                        float ss = (a[0] * a[0] + a[1] * a[1]) + (a[2] * a[2] + a[3] * a[3]) + (b[0] * b[0] + b[1] * b[1]) + (b[2] * b[2] + b[3] * b[3]);
                        ss += __shfl_xor(ss, 16); ss += __shfl_xor(ss, 32);
                        if (fq == 0) P[(ai * 128 + wr * 64 + m * 16 + fr) * 8 + bj * 4 + wc] = ss;
                    }
            asm volatile("s_waitcnt lgkmcnt(0)" ::: "memory"); __builtin_amdgcn_s_barrier(); asm volatile("" ::: "memory");
        }
        const int row0 = u.pm * 256 + wr * 64 + fr, col0 = u.pn * 256 + wc * 32 + 8 * fq;
        pg8::f32x4 g0[2], g1[2];
#pragma unroll
        for (int bj = 0; bj < 2; ++bj) {
            const float* gp = nullptr;
            if (mode == 1) gp = gqk + (pn >= 2 ? 64 : 0) + 32 * (wc & 1) + 8 * fq;
            else if (mode == 2) gp = gbq + 32 * wc + 8 * fq;
            else if (mode == 3 && bj == 0) gp = gbkv + 32 * wc + 8 * fq;
            if (gp) { g0[bj] = *(const pg8::f32x4*)gp; g1[bj] = *(const pg8::f32x4*)(gp + 4); } else { g0[bj] = (pg8::f32x4){1.f, 1.f, 1.f, 1.f}; g1[bj] = g0[bj]; }
        }
#pragma unroll
        for (int ai = 0; ai < 2; ++ai)
#pragma unroll
            for (int m = 0; m < 4; ++m) { bf16* rowp = O + (size_t)(row0 + ai * 128 + m * 16) * NP + col0;
#pragma unroll
                for (int bj = 0; bj < 2; ++bj) {
                    float s = 1.f;
                    if (mode != 0 && !(mode == 3 && bj == 1)) {
                        const pg8::f32x4 q = *(const LAS pg8::f32x4*)(P + (ai * 128 + wr * 64 + m * 16 + fr) * 8 + bj * 4);
                        s = (mode == 1) ? rsqrtf(((wc < 2) ? (q[0] + q[1]) : (q[2] + q[3])) * (1.f / 64.f) + EPS) : rsqrtf(((q[0] + q[1]) + (q[2] + q[3])) * (1.f / 128.f) + EPS);
                    }
                    const pg8::f32x4 v0 = acc[ai][bj][m][0] * s * g0[bj], v1 = acc[ai][bj][m][1] * s * g1[bj];
                    pg8::u32x4 w; w.x = pg8::cvt_pk_bf16(v0[0], v0[1]); w.y = pg8::cvt_pk_bf16(v0[2], v0[3]); w.z = pg8::cvt_pk_bf16(v1[0], v1[1]); w.w = pg8::cvt_pk_bf16(v1[2], v1[3]);
                    *(pg8::u32x4*)(rowp + bj * 128) = w; } }
    }
};
typedef __bf16 bf16x2_t __attribute__((ext_vector_type(2)));
__device__ __forceinline__ float dot2bf(unsigned a, unsigned b, float acc) { return __builtin_amdgcn_fdot2_f32_bf16(__builtin_bit_cast(bf16x2_t, a), __builtin_bit_cast(bf16x2_t, b), acc, false); }
template <int CTRL> __device__ __forceinline__ float dpp_f(float v) { return __int_as_float(__builtin_amdgcn_update_dpp(0, __float_as_int(v), CTRL, 0xf, 0xf, false)); }
__device__ __forceinline__ float row16_sum(float v) {
    v += dpp_f<0x128>(v); v += dpp_f<0x124>(v); v += dpp_f<0x122>(v); v += dpp_f<0x121>(v); return v;
}
__device__ __forceinline__ float gelu_erf(float v) {
    const float av = fabsf(v), t = __builtin_amdgcn_rcpf(fmaf(av, 0.2316418882f, 1.0f));
    float q = fmaf(t, 0.5307027145f, -0.7265760135f); q = fmaf(q, t, 0.7107068705f); q = fmaf(q, t, -0.142248368f); q = fmaf(q, t, 0.127414796f); q = q * t;
    const float e = __builtin_amdgcn_exp2f(v * v * -0.72134752044f);
    const float m = v * (q * e);
    return v < 0.f ? m : v - m;
}

typedef short v4i16_t __attribute__((ext_vector_type(4)));
#ifndef DSA_REP_A
#define DSA_REP_A 1
#endif
#ifndef DSA_REP_B
#define DSA_REP_B 1
#endif
#ifndef DSA_REP_C
#define DSA_REP_C 1
#endif
constexpr int DSA_SROW = 2048 * 4 + 16;
constexpr int DSA_SEL_OFF = 16 * DSA_SROW;
constexpr int DSA_LDS = DSA_SEL_OFF + 16 * 512;
constexpr int DSA_KVROW = 272;

__device__ __forceinline__ unsigned sortkey(float s) { const unsigned u = __float_as_uint(s); return u ^ ((u >> 31) ? 0xffffffffu : 0x80000000u); }
__device__ __forceinline__ unsigned cvtpk_bf16(float lo, float hi) { unsigned r; asm volatile("v_cvt_pk_bf16_f32 %0, %1, %2" : "=v"(r) : "v"(lo), "v"(hi)); return r; }

__device__ __forceinline__ void ph_dsa(const Params& p, unsigned char* lds, int vb, int nvb) {
    const bf16* PROJ = (const bf16*)(p.ws + WS_PROJ); bf16* MIX = (bf16*)(p.ws + WS_MIX);
    const float MB = ((const float*)(p.ws + WS_SCAL))[SC_MB];
    int tid = threadIdx.x; asm volatile("" : "+v"(tid)); const int lane = tid & 63, wv = __builtin_amdgcn_readfirstlane(tid >> 6);
    const int l15 = lane & 15, g = lane >> 4;
    LAS unsigned char* ldsl = (LAS unsigned char*)lds;
    for (int it = vb; it < 2048; it += nvb) {
        const int vbb = it & 255, kk = it >> 8, xg = vbb & 7, ix = vbb >> 3, b = 2 * xg + (ix & 1), G = (ix >> 1) & 3, sub = ix >> 3;
        const int c = (kk & 1) ? (31 - G - 8 * (kk >> 1)) : (G + 8 * (kk >> 1));
        const int cend = (c + 1) * 64, t0 = c * 64 + sub * 16;
        const bf16* Pb = PROJ + (size_t)b * SEQ * NP;
#pragma unroll 1
        for (int repa = 0; repa < DSA_REP_A; ++repa)
        if (c >= 4) {
            const bf16* qrow = Pb + (size_t)(t0 + l15) * NP;
            bf16x8 bq[4][2]; float wsc[4];
#pragma unroll
            for (int h = 0; h < 4; ++h) { wsc[h] = bf2f(qrow[C_WI + h]) * 0.0625f;
#pragma unroll
                for (int ks = 0; ks < 2; ++ks) bq[h][ks] = *(const bf16x8*)(qrow + C_QI + h * 64 + 32 * ks + 8 * g); }
            for (int k0 = 16 * wv; k0 < cend; k0 += 128) {
                const bf16* krow = Pb + (size_t)(k0 + l15) * NP + C_KI + 8 * g;
                const bf16x8 ka0 = *(const bf16x8*)krow, ka1 = *(const bf16x8*)(krow + 32);
                f32x4 sc = {0.f, 0.f, 0.f, 0.f};
#pragma unroll
                for (int h = 0; h < 4; ++h) { f32x4 a = {0.f, 0.f, 0.f, 0.f};
                    a = __builtin_amdgcn_mfma_f32_16x16x32_bf16(ka0, bq[h][0], a, 0, 0, 0);
                    a = __builtin_amdgcn_mfma_f32_16x16x32_bf16(ka1, bq[h][1], a, 0, 0, 0);
#pragma unroll
                    for (int r = 0; r < 4; ++r) sc[r] = fmaf(fmaxf(a[r], 0.f), wsc[h], sc[r]); }
#pragma unroll
                for (int r = 0; r < 4; ++r) sc[r] = (sc[r] == 0.f) ? 0.f : sc[r];
                *(LAS f32x4*)(ldsl + l15 * DSA_SROW + (k0 + 4 * g) * 4) = sc;
            }
        }
        __syncthreads();
        LAS unsigned short* selw = (LAS unsigned short*)(ldsl + DSA_SEL_OFF);
        int mind0 = 0, mind1 = 0;
        if (c < 4) {
            for (int j = lane; j < 256; j += 64) { selw[(2 * wv) * 256 + j] = (unsigned short)j; selw[(2 * wv + 1) * 256 + j] = (unsigned short)j; }
        } else {
            const int nreg = cend >> 6;
            unsigned keyA[32], keyB[32];
            { const LAS float* srA = (const LAS float*)(ldsl + (2 * wv) * DSA_SROW) + lane; const LAS float* srB = (const LAS float*)(ldsl + (2 * wv + 1) * DSA_SROW) + lane;
#pragma unroll
              for (int i = 0; i < 32; ++i) { keyA[i] = (i < nreg) ? sortkey(srA[64 * i]) : 0u; keyB[i] = (i < nreg) ? sortkey(srB[64 * i]) : 0u; } }
#define DSA_WSUM(V, OUT) do { int v_ = (V); v_ += __builtin_amdgcn_update_dpp(0, v_, 0x128, 0xf, 0xf, false); v_ += __builtin_amdgcn_update_dpp(0, v_, 0x124, 0xf, 0xf, false); \
        v_ += __builtin_amdgcn_update_dpp(0, v_, 0x122, 0xf, 0xf, false); v_ += __builtin_amdgcn_update_dpp(0, v_, 0x121, 0xf, 0xf, false);                                     \
        OUT = __builtin_amdgcn_readlane(v_, 0) + __builtin_amdgcn_readlane(v_, 16) + __builtin_amdgcn_readlane(v_, 32) + __builtin_amdgcn_readlane(v_, 48); } while (0)
            unsigned prefA = 0u, prefB = 0u; bool exA = false, exB = false;
#pragma unroll 1
            for (int bit = 31; bit >= 0; --bit) {
                const unsigned candA = exA ? prefA : (prefA | (1u << bit)), candB = exB ? prefB : (prefB | (1u << bit));
                int ca = 0, cb = 0;
#pragma unroll
                for (int i = 0; i < 32; ++i) { ca += (keyA[i] >= candA) ? 1 : 0; cb += (keyB[i] >= candB) ? 1 : 0; }
                int cntA, cntB; DSA_WSUM(ca, cntA); DSA_WSUM(cb, cntB);
                if (!exA && cntA >= 256) { prefA = candA; exA = (cntA == 256); }
                if (!exB && cntB >= 256) { prefB = candB; exB = (cntB == 256); }
                if (exA && exB) break;
            }
#define DSA_COMPACT(KEY, PREFIX, EXACT, QQ, MIND) do {                                                                                              \
            const int t_ = t0 + (QQ); LAS unsigned short* sel = selw + (QQ) * 256;                                                                    \
            int need_ties = 0;                                                                                                                        \
            if (!(EXACT)) { int cg_ = 0; if ((PREFIX) != 0xffffffffu) { _Pragma("unroll") for (int i = 0; i < 32; ++i) cg_ += (KEY[i] > (PREFIX)) ? 1 : 0; } \
                int cgt; DSA_WSUM(cg_, cgt); need_ties = 256 - cgt; }                                                                                 \
            int base = 0, tbase = 0, md = 4096;                                                                                                       \
            _Pragma("unroll") for (int i = 0; i < 32; ++i) { if (i < nreg) {                                                                          \
                bool selb;                                                                                                                            \
                if (EXACT) selb = KEY[i] >= (PREFIX);                                                                                                 \
                else { const bool tie = KEY[i] == (PREFIX); const unsigned long long mt = __ballot(tie);                                              \
                    const int trank = tbase + (int)__builtin_amdgcn_mbcnt_hi((unsigned)(mt >> 32), __builtin_amdgcn_mbcnt_lo((unsigned)mt, 0u));      \
                    selb = (KEY[i] > (PREFIX)) || (tie && trank < need_ties); tbase += __popcll(mt); }                                                \
                const unsigned long long m = __ballot(selb);                                                                                          \
                const int pos = base + (int)__builtin_amdgcn_mbcnt_hi((unsigned)(m >> 32), __builtin_amdgcn_mbcnt_lo((unsigned)m, 0u));               \
                const int kidx = i * 64 + lane;                                                                                                       \
                if (selb) { sel[pos] = (unsigned short)kidx; const int d = t_ > kidx ? t_ - kidx : kidx - t_; md = d < md ? d : md; }                 \
                base += __popcll(m); } }                                                                                                              \
            _Pragma("unroll") for (int o = 1; o < 64; o <<= 1) { const int x = __shfl_xor(md, o); md = x < md ? x : md; }                             \
            MIND = md; } while (0)
            DSA_COMPACT(keyA, prefA, exA, 2 * wv, mind0);
            DSA_COMPACT(keyB, prefB, exB, 2 * wv + 1, mind1);
#undef DSA_COMPACT
#undef DSA_WSUM
        }
        LDS_WAIT(); asm volatile("" ::: "memory");
        const int nvalid = cend < 256 ? cend : 256;
        const int head = lane & 7;
        const float slopeL2 = exp2f(-(float)(head + 1)) * 1.4426950409f;
#pragma unroll 1
        for (int qi2 = 0; qi2 < 2 * DSA_REP_C; ++qi2) { const int qi = qi2 & 1;
            const int qq = 2 * wv + qi, t = t0 + qq;
            const LAS unsigned short* sel = selw + qq * 256;
            LAS unsigned char* stg = ldsl + (2 * wv) * DSA_SROW;
            const bf16* qrow = Pb + (size_t)t * NP + C_QB + head * 128 + 8 * g;
            bf16x8 bq[4];
#pragma unroll
            for (int ks = 0; ks < 4; ++ks) bq[ks] = *(const bf16x8*)(qrow + 32 * ks);
            const float refL2 = MB * 1.4426950409f - slopeL2 * (float)(qi == 0 ? mind0 : mind1);
            f32x4 o[8];
#pragma unroll
            for (int dt = 0; dt < 8; ++dt) o[dt] = (f32x4){0.f, 0.f, 0.f, 0.f};
            float lsum = 0.f;
#define DSA_GATHER(S, KA) do { _Pragma("unroll") for (int i_ = 0; i_ < 8; ++i_) { const int jr = 32 * (S) + 4 * i_ + g; const int keyr = sel[jr < nvalid ? jr : 0];   \
        KA[i_] = *(const bf16x8*)(Pb + (size_t)keyr * NP + C_KV + 8 * l15); } } while (0)
#define DSA_COMPUTE(S, KA) do { unsigned pb[4];                                                                                                        \
        _Pragma("unroll") for (int i_ = 0; i_ < 8; ++i_) *(LAS bf16x8*)(stg + (4 * i_ + g) * DSA_KVROW + 16 * l15) = KA[i_];                              \
        LDS_WAIT(); asm volatile("" ::: "memory");                                                                                                        \
        _Pragma("unroll") for (int tl = 0; tl < 2; ++tl) { const int j0 = 32 * (S) + 16 * tl;                                                           \
            f32x4 a = {0.f, 0.f, 0.f, 0.f};                                                                                                             \
            _Pragma("unroll") for (int ks = 0; ks < 4; ++ks) { const bf16x8 ka_ = *(const LAS bf16x8*)(stg + (16 * tl + l15) * DSA_KVROW + (32 * ks + 8 * g) * 2); \
                a = __builtin_amdgcn_mfma_f32_16x16x32_bf16(ka_, bq[ks], a, 0, 0, 0); }                                                                 \
            const u32x2 kw = *(const LAS u32x2*)(sel + j0 + 4 * g);                                                                                     \
            const int kx[4] = {(int)(kw.x & 0xffffu), (int)(kw.x >> 16), (int)(kw.y & 0xffffu), (int)(kw.y >> 16)};                                     \
            float pr[4];                                                                                                                                \
            _Pragma("unroll") for (int r = 0; r < 4; ++r) { const int dd = t > kx[r] ? t - kx[r] : kx[r] - t;                                            \
                const float e = __builtin_amdgcn_exp2f(fmaf(a[r], 0.1275174f, -slopeL2 * (float)dd - refL2));                                            \
                pr[r] = (j0 + 4 * g + r < nvalid) ? e : 0.f; lsum += pr[r]; }                                                                           \
            pb[2 * tl] = cvtpk_bf16(pr[0], pr[1]); pb[2 * tl + 1] = cvtpk_bf16(pr[2], pr[3]); }                                                         \
        LDS_WAIT(); asm volatile("" ::: "memory");                                                                                                      \
        u32x4 pw4; pw4.x = pb[0]; pw4.y = pb[1]; pw4.z = pb[2]; pw4.w = pb[3];                                                                          \
        const bf16x8 pfrag = __builtin_bit_cast(bf16x8, pw4);                                                                                           \
        const LAS unsigned char* trb = stg + (4 * g + (l15 >> 2)) * DSA_KVROW + (4 * (lane & 3)) * 2;                                                   \
        _Pragma("unroll") for (int dt = 0; dt < 8; ++dt) {                                                                                              \
            const s16x4 lo = __builtin_bit_cast(s16x4, __builtin_amdgcn_ds_read_tr16_b64_v4i16((LAS v4i16_t*)(trb + dt * 32)));                         \
            const s16x4 hi = __builtin_bit_cast(s16x4, __builtin_amdgcn_ds_read_tr16_b64_v4i16((LAS v4i16_t*)(trb + 16 * DSA_KVROW + dt * 32)));        \
            const bf16x8 af = {lo[0], lo[1], lo[2], lo[3], hi[0], hi[1], hi[2], hi[3]};                                                                 \
            o[dt] = __builtin_amdgcn_mfma_f32_16x16x32_bf16(af, pfrag, o[dt], 0, 0, 0); }                                                               \
        LDS_WAIT(); asm volatile("" ::: "memory"); } while (0)
            const int nch = (nvalid + 31) >> 5;
            bf16x8 KA[8], KB[8];
            DSA_GATHER(0, KA);
#pragma unroll 1
            for (int s = 0; s < nch; s += 2) {
                if (s + 1 < nch) DSA_GATHER(s + 1, KB);
                DSA_COMPUTE(s, KA);
                if (s + 1 < nch) { if (s + 2 < nch) DSA_GATHER(s + 2, KA); DSA_COMPUTE(s + 1, KB); }
            }
#undef DSA_GATHER
#undef DSA_COMPUTE
            lsum += __shfl_xor(lsum, 16); lsum += __shfl_xor(lsum, 32);
            const float il = 1.f / lsum;
            if (l15 < 8) {
                bf16* orow = MIX + (size_t)(b * SEQ + t) * MIXW + 512 + head * 128 + 4 * g;
#pragma unroll
                for (int dt = 0; dt < 8; ++dt) { u32x2 w; w.x = pk2(o[dt][0] * il, o[dt][1] * il); w.y = pk2(o[dt][2] * il, o[dt][3] * il); *(u32x2*)(orow + 16 * dt) = w; }
            }
        }
        __syncthreads();
    }
}
typedef __attribute__((address_space(1))) float GASF;
#ifndef ATT_REMAP
#define ATT_REMAP 1
#endif
__device__ __forceinline__ int crow(int r, int hi) { return (r & 3) + 8 * (r >> 2) + 4 * hi; }
#define KSWZ64(row, cb) ((row) * 128 + ((cb) ^ ((((row) >> 1) & 7) << 4)))
__device__ __forceinline__ int v_st(int k, int c) { const int kk = (k & ~0xC) | ((k & 4) << 1) | ((k & 8) >> 1); return ((kk >> 3) * 4 + (c >> 5)) * 512 + ((kk & 7) * 32 + (c & 31)) * 2; }
__device__ __forceinline__ int v_rd_base(int lane) { return ((lane & 3) << 3) | (((lane >> 2) & 3) << 6) | (((lane >> 4) & 1) << 5) | (((lane >> 5) & 1) << 8); }
constexpr int v_rd_off(int d0, int ks, int half) { return d0 * 512 + ks * 4096 + half * 2048; }
template <int OFF> __device__ __forceinline__ s16x4 tr_read(int vb) {
    s16x4 r; asm volatile("ds_read_b64_tr_b16 %0, %1 offset:%2" : "=&v"(r) : "v"(vb), "i"(OFF) : "memory"); return r;
}
template <int D0> __device__ __forceinline__ void pv_one(f32x16& od, int vb, bf16x8 pa0, bf16x8 pa1, bf16x8 pa2, bf16x8 pa3) {
    const s16x4 l0 = tr_read<v_rd_off(D0, 0, 0)>(vb), h0 = tr_read<v_rd_off(D0, 0, 1)>(vb), l1 = tr_read<v_rd_off(D0, 1, 0)>(vb), h1 = tr_read<v_rd_off(D0, 1, 1)>(vb);
    const s16x4 l2 = tr_read<v_rd_off(D0, 2, 0)>(vb), h2 = tr_read<v_rd_off(D0, 2, 1)>(vb), l3 = tr_read<v_rd_off(D0, 3, 0)>(vb), h3 = tr_read<v_rd_off(D0, 3, 1)>(vb);
    asm volatile("s_waitcnt lgkmcnt(0)" ::: "memory"); __builtin_amdgcn_sched_barrier(0);
#define PK(L, H) (bf16x8){L[0], L[1], L[2], L[3], H[0], H[1], H[2], H[3]}
    od = __builtin_amdgcn_mfma_f32_32x32x16_bf16(pa0, PK(l0, h0), od, 0, 0, 0);
    od = __builtin_amdgcn_mfma_f32_32x32x16_bf16(pa1, PK(l1, h1), od, 0, 0, 0);
    od = __builtin_amdgcn_mfma_f32_32x32x16_bf16(pa2, PK(l2, h2), od, 0, 0, 0);
    od = __builtin_amdgcn_mfma_f32_32x32x16_bf16(pa3, PK(l3, h3), od, 0, 0, 0);
#undef PK
}
constexpr int ATT_LDS = 2 * 16384 + 2 * 8192 + 8 * 256;

__device__ __forceinline__ void ph_attnA(const Params& p, unsigned char* lds, int vb, int nvb) {
    const bf16* PROJ = (const bf16*)(p.ws + WS_PROJ); bf16* MIX = (bf16*)(p.ws + WS_MIX);
    const float* SC = (const float*)(p.ws + WS_SCAL);
    const float lam = SC[SC_LAM], refL2 = SC[SC_MA] * 1.4426950409f;
    constexpr float C = 0.125f * 1.4426950409f;
    int tid = threadIdx.x; asm volatile("" : "+v"(tid)); const int lane = tid & 63, wid = __builtin_amdgcn_readfirstlane(tid >> 6), r32 = lane & 31, hi = lane >> 5;
    unsigned char* V_lds = lds; unsigned char* K_lds = lds + 32768;
    float* wsf = (float*)(lds + 49152) + wid * 64;
    GASF* tmpw = (GASF*)(p.ws + WS_ATMP) + ((size_t)(vb * NWV + wid) * 64) * 64 + lane;
    const int vbase = (int)(uintptr_t)V_lds + v_rd_base(lane);
    const int krow = tid >> 3, kch = tid & 7, kdst = KSWZ64(krow, kch * 16);
    const int sr = tid >> 4, sc = (tid & 15) * 8, vst0 = v_st(sr, sc), vst1 = v_st(32 + sr, sc);
    for (int it = vb; it < 256; it += nvb) {
        #if ATT_REMAP
        const int xg_ = it & 7, m_ = it >> 3, pidx = xg_ * 8 + (m_ >> 2), qbl = m_ & 3, b = pidx >> 2, h = pidx & 3;
#else
        const int b = it >> 4, h = (it >> 2) & 3, qbl = it & 3;
#endif
        const float slopeL2 = exp2f(-2.0f * (float)(h + 1)) * 1.4426950409f;
        const bf16* Pb = PROJ + (size_t)b * SEQ * NP;
#pragma unroll 1
        for (int half = 0; half < 2; ++half) {
            const int qb = half ? 7 - qbl : qbl, q0 = 256 * qb, NTu = 4 * (qb + 1), cw = 4 * qb + (wid >> 1);
            const int tq = q0 + 32 * wid + r32;
#pragma unroll 1
            for (int mi = 0; mi < 2; ++mi) {
                const int m = 1 - mi;
                const bf16* Kg = Pb + C_KA + h * 128 + m * 64 + (size_t)krow * NP + kch * 8;
                const bf16* Vg = Pb + C_VA + h * 128 + (size_t)sr * NP + sc;
                bf16x8 qr[4];
                { const bf16* qp = Pb + (size_t)tq * NP + C_QA + h * 128 + m * 64 + hi * 8;
#pragma unroll
                  for (int d0 = 0; d0 < 4; ++d0) qr[d0] = *(const bf16x8*)(qp + d0 * 16); }
                f32x16 o[4];
#pragma unroll
                for (int d = 0; d < 4; ++d) o[d] = f32x16{};
                float lsum = 0.f;
                bf16x8 sk, sv0, sv1;
                sk = *(const bf16x8*)Kg; sv0 = *(const bf16x8*)Vg; sv1 = *(const bf16x8*)(Vg + (size_t)32 * NP);
                *(bf16x8*)(K_lds + kdst) = sk; *(bf16x8*)(V_lds + vst0) = sv0; *(bf16x8*)(V_lds + vst1) = sv1;
                __syncthreads();
#pragma unroll 1
                for (int j = 0; j < NTu; ++j) {
                    const int buf = j & 1;
                    if (j + 1 < NTu) { const size_t go = (size_t)(j + 1) * 64 * NP; sk = *(const bf16x8*)(Kg + go); sv0 = *(const bf16x8*)(Vg + go); sv1 = *(const bf16x8*)(Vg + go + (size_t)32 * NP); }
                    if (j <= cw) {
                        const unsigned char* Kb = K_lds + buf * 8192;
                        const float dq = (float)(tq - 64 * j - 4 * hi);
                        const float B0 = -slopeL2 * dq - refL2;
                        const bool past = j < cw;
                        float ps = 0.f;
                        bf16x8 pa0, pa1, pa2, pa3;
#define PK4(P, BASE, OUT) do { unsigned a0 = cvtpk_bf16(P[BASE + 0], P[BASE + 1]), a1 = cvtpk_bf16(P[BASE + 2], P[BASE + 3]);   \
    unsigned b0_ = cvtpk_bf16(P[BASE + 4], P[BASE + 5]), b1_ = cvtpk_bf16(P[BASE + 6], P[BASE + 7]);                              \
    auto r0 = __builtin_amdgcn_permlane32_swap(a0, b0_, false, false); auto r1 = __builtin_amdgcn_permlane32_swap(a1, b1_, false, false); \
    u32x4 w = {r0[0], r1[0], r0[1], r1[1]}; OUT = __builtin_bit_cast(bf16x8, w); } while (0)
#define HALF_TILE(KOFF, FOFF, PA, PB) do { f32x16 pp = f32x16{};                                                                     \
    _Pragma("unroll") for (int d0 = 0; d0 < 4; ++d0) { const int cb = (d0 * 16 + hi * 8) * 2;                                        \
        const bf16x8 bk = *(const bf16x8*)(Kb + KSWZ64((KOFF) + r32, cb)); pp = __builtin_amdgcn_mfma_f32_32x32x16_bf16(bk, qr[d0], pp, 0, 0, 0); } \
    if (past) { _Pragma("unroll") for (int r = 0; r < 16; ++r) { const float off = (float)((r & 3) + 8 * (r >> 2)) + (FOFF);          \
            pp[r] = __builtin_amdgcn_exp2f(fmaf(pp[r], C, fmaf(slopeL2, off, B0))); } }                                               \
    else { _Pragma("unroll") for (int r = 0; r < 16; ++r) { const float off = (float)((r & 3) + 8 * (r >> 2)) + (FOFF);               \
            pp[r] = __builtin_amdgcn_exp2f(fmaf(pp[r], C, -slopeL2 * fabsf(dq - off) - refL2)); } }                                   \
    _Pragma("unroll") for (int r = 0; r < 16; ++r) ps += pp[r];                                                                       \
    PK4(pp, 0, PA); PK4(pp, 8, PB); __builtin_amdgcn_sched_barrier(0); } while (0)
                        HALF_TILE(0, 0.f, pa0, pa1);
                        HALF_TILE(32, 32.f, pa2, pa3);
#undef HALF_TILE
#undef PK4
                        { auto rr = __builtin_amdgcn_permlane32_swap(__float_as_uint(ps), __float_as_uint(ps), false, false);
                          ps = __uint_as_float(rr[0]) + __uint_as_float(rr[1]); }
                        lsum += ps;
                        const int vb0 = vbase + buf * 16384;
                        pv_one<0>(o[0], vb0, pa0, pa1, pa2, pa3); pv_one<1>(o[1], vb0, pa0, pa1, pa2, pa3); pv_one<2>(o[2], vb0, pa0, pa1, pa2, pa3); pv_one<3>(o[3], vb0, pa0, pa1, pa2, pa3);
                    }
                    if (j + 1 < NTu) { const int nb = buf ^ 1;
                        *(bf16x8*)(K_lds + nb * 8192 + kdst) = sk; *(bf16x8*)(V_lds + nb * 16384 + vst0) = sv0; *(bf16x8*)(V_lds + nb * 16384 + vst1) = sv1; }
                    __syncthreads();
                }
                if (hi == 0) wsf[r32] = lsum;
                LDS_WAIT(); asm volatile("" ::: "memory");
                float rli[16];
#pragma unroll
                for (int r = 0; r < 16; ++r) rli[r] = 1.f / wsf[crow(r, hi)];
                LDS_WAIT(); asm volatile("" ::: "memory");
                if (mi == 0) {
#pragma unroll
                    for (int d = 0; d < 4; ++d) { GASF* td = tmpw + d * 1024; asm volatile("" : "+v"(td));
#pragma unroll
                        for (int r = 0; r < 16; ++r) td[r * 64] = o[d][r] * rli[r]; }
                } else {
                    float gsub[4];
#pragma unroll
                    for (int d = 0; d < 4; ++d) gsub[d] = p.a_sub_gain[32 * d + r32];
                    GASF* tdp[4];
#pragma unroll
                    for (int d = 0; d < 4; ++d) { tdp[d] = tmpw + d * 1024; asm volatile("" : "+v"(tdp[d])); }
#pragma unroll
                    for (int r = 0; r < 16; ++r) {
                        float v[4]; float ss = 0.f;
#pragma unroll
                        for (int d = 0; d < 4; ++d) { v[d] = o[d][r] * rli[r] - lam * tdp[d][r * 64]; ss += v[d] * v[d]; }
                        ss += __shfl_xor(ss, 1); ss += __shfl_xor(ss, 2); ss += __shfl_xor(ss, 4); ss += __shfl_xor(ss, 8); ss += __shfl_xor(ss, 16);
                        const float rs = rsqrtf(ss * (1.f / 128.f) + EPS) * 0.8f;
                        bf16* orow = MIX + (size_t)(b * SEQ + q0 + 32 * wid + crow(r, hi)) * MIXW + h * 128 + r32;
#pragma unroll
                        for (int d = 0; d < 4; ++d) orow[32 * d] = (bf16)f2bf(v[d] * rs * gsub[d]);
                        asm volatile("" ::: "memory");
                    }
                }
            }
        }
    }
}
constexpr int RT_WAVE_BYTES = 12288;
constexpr int RT_LDS = 32768 + 8 * RT_WAVE_BYTES;

__device__ __forceinline__ int pl32_sum(int v) { auto rr = __builtin_amdgcn_permlane32_swap((unsigned)v, (unsigned)v, false, false); return (int)(rr[0] + rr[1]); }
__device__ __forceinline__ int pl32_other(int v) { auto rr = __builtin_amdgcn_permlane32_swap((unsigned)v, (unsigned)v, false, false); return (int)(rr[0] + rr[1]) - v; }
__device__ __forceinline__ float unsortkey(unsigned k) { return __uint_as_float((k & 0x80000000u) ? (k ^ 0x80000000u) : ~k); }

template <int N> __device__ __forceinline__ unsigned bisect16(const unsigned (&key)[N]) {
    unsigned prefix = 0u; bool done = false;
#pragma unroll 1
    for (int bit = 31; bit >= 0; --bit) {
        const unsigned cand = done ? prefix : (prefix | (1u << bit));
        int cnt = 0;
#pragma unroll
        for (int i = 0; i < N; ++i) cnt += (key[i] >= cand) ? 1 : 0;
        const int tot = pl32_sum(cnt);
        if (!done && tot >= 16) { prefix = cand; done = (tot == 16); }
        if (__all(done)) break;
    }
    return prefix;
}

__device__ __forceinline__ void ph_route(const Params& p, unsigned char* lds, int vb, int nvb) {
    const bf16* Q3 = (const bf16*)(p.ws + WS_Q3); const bf16* SUBK = (const bf16*)(p.ws + WS_SUBK);
    int* EXPI = (int*)(p.ws + WS_EXP); float* GATE = (float*)(p.ws + WS_GATE);
    int tid = threadIdx.x; asm volatile("" : "+v"(tid));
    const int lane = tid & 63, wv = __builtin_amdgcn_readfirstlane(tid >> 6), r32 = lane & 31, hi = lane >> 5;
    for (int i = tid; i < 2048; i += NT) { const int row = i >> 3, ch = i & 7; ((u32x4*)lds)[row * 8 + (ch ^ ((row >> 1) & 7))] = ((const u32x4*)SUBK)[i]; }
    __syncthreads();
    unsigned char* wl = lds + 32768 + wv * RT_WAVE_BYTES;
    float* sv = (float*)wl; int* si = (int*)(wl + 4096); float* fv = (float*)(wl + 8192); int* fe = (int*)(wl + 10240);
    const int gw = vb * NWV + wv, ngw = nvb * NWV;
    for (int item = gw; item < (T / 32) * 8; item += ngw) {
        const int h = item & 7, tok0 = (item >> 3) * 32;
        const bf16* qrow = Q3 + (size_t)(tok0 + r32) * 1024 + h * 128 + hi * 8;
#pragma unroll 1
        for (int c = 0; c < 2; ++c) {
            bf16x8 bq[4];
#pragma unroll
            for (int d0 = 0; d0 < 4; ++d0) bq[d0] = *(const bf16x8*)(qrow + c * 64 + d0 * 16);
            unsigned key[64];
#pragma unroll
            for (int nt = 0; nt < 4; ++nt) {
                f32x16 acc = f32x16{};
                const int krow = c * 128 + nt * 32 + r32, ksw = (krow >> 1) & 7;
                const unsigned char* kp = lds + krow * 128;
#pragma unroll
                for (int d0 = 0; d0 < 4; ++d0) { const bf16x8 ak = *(const bf16x8*)(kp + (((2 * d0 + hi) ^ ksw) << 4)); acc = __builtin_amdgcn_mfma_f32_32x32x16_bf16(ak, bq[d0], acc, 0, 0, 0); }
#pragma unroll
                for (int r = 0; r < 16; ++r) key[nt * 16 + r] = sortkey(acc[r]);
            }
            const unsigned thr = bisect16<64>(key);
            int cnt = 0;
#pragma unroll
            for (int i = 0; i < 64; ++i) cnt += (key[i] >= thr) ? 1 : 0;
            const int other_ = pl32_other(cnt); int slot = hi ? other_ : 0;
            float* svp = sv + (r32 * 2 + c) * 16; int* sip = si + (r32 * 2 + c) * 16;
#pragma unroll
            for (int i = 0; i < 64; ++i) {
                if (key[i] >= thr && slot < 16) { svp[slot] = unsortkey(key[i]); sip[slot] = 32 * (i >> 4) + ((i & 3) + 8 * ((i & 15) >> 2)) + 4 * hi; ++slot; }
            }
        }
        LDS_WAIT(); asm volatile("" ::: "memory");
        {
            float* sv0 = sv + (r32 * 2) * 16; float* sv1 = sv0 + 16; int* si0 = si + (r32 * 2) * 16; int* si1 = si0 + 16;
            {
                float a[16], bl[16];
#pragma unroll
                for (int k = 0; k < 16; ++k) { a[k] = sv0[k]; bl[k] = sv1[k]; }
                int ia[8], ib[8], ra[8], rb[8]; float va[8], vb[8];
#pragma unroll
                for (int q = 0; q < 8; ++q) { const int e = 8 * hi + q; va[q] = sv0[e]; vb[q] = sv1[e]; ia[q] = si0[e]; ib[q] = si1[e]; int r0 = 0, r1 = 0;
#pragma unroll
                    for (int k = 0; k < 16; ++k) { r0 += (a[k] > va[q] || (a[k] == va[q] && k < e)) ? 1 : 0; r1 += (bl[k] > vb[q] || (bl[k] == vb[q] && k < e)) ? 1 : 0; }
                    ra[q] = r0; rb[q] = r1; }
                LDS_WAIT(); asm volatile("" ::: "memory");
                { auto rr = __builtin_amdgcn_permlane32_swap(0u, 0u, false, false); (void)rr; }
#pragma unroll
                for (int q = 0; q < 8; ++q) { sv0[ra[q]] = va[q]; si0[ra[q]] = ia[q]; sv1[rb[q]] = vb[q]; si1[rb[q]] = ib[q]; }
                LDS_WAIT(); asm volatile("" ::: "memory");
            }
            const float* X = hi ? sv1 : sv0; const float* Y = hi ? sv0 : sv1;
            float x[4], y[16];
#pragma unroll
            for (int k = 0; k < 4; ++k) x[k] = X[k];
#pragma unroll
            for (int k = 0; k < 16; ++k) y[k] = Y[k];
            unsigned key[27]; int pi[27], pj[27]; int np = 0;
#pragma unroll
            for (int i = 0; i < 3; ++i)
#pragma unroll
                for (int j = i + 1; j < 16; ++j) if ((i + 1) * (j + 1) <= 16) { key[np] = sortkey(x[i] + y[j]); pi[np] = i; pj[np] = j; ++np; }
#pragma unroll
            for (int i = 0; i < 4; ++i) { key[23 + i] = hi ? 0u : sortkey(x[i] + y[i]); pi[23 + i] = i; pj[23 + i] = i; }
            const unsigned thr = bisect16<27>(key);
            int cnt = 0;
#pragma unroll
            for (int i = 0; i < 27; ++i) cnt += (key[i] >= thr) ? 1 : 0;
            const int other_ = pl32_other(cnt); int slot = hi ? other_ : 0;
            const int* IX = hi ? si1 : si0; const int* IY = hi ? si0 : si1;
            float* fvp = fv + r32 * 16; int* fep = fe + r32 * 16;
#pragma unroll
            for (int i = 0; i < 27; ++i) {
                if (key[i] >= thr && slot < 16) { const int ex = IX[pi[i]], ey = IY[pj[i]]; fvp[slot] = unsortkey(key[i]); fep[slot] = hi ? (ey * 128 + ex) : (ex * 128 + ey); ++slot; }
            }
        }
        LDS_WAIT(); asm volatile("" ::: "memory");
        {
            const float* fvp = fv + r32 * 16;
            float v[16]; float mx = -3e38f;
#pragma unroll
            for (int k = 0; k < 16; ++k) { v[k] = fvp[k]; mx = fmaxf(mx, v[k]); }
            float l = 0.f;
#pragma unroll
            for (int k = 0; k < 16; ++k) { v[k] = __expf(v[k] - mx); l += v[k]; }
            const float il = 1.f / l;
            const size_t ob = (size_t)(tok0 + r32) * 128 + h * 16 + 8 * hi;
            const int* fep = fe + r32 * 16 + 8 * hi;
            f32x4 g0, g1; u32x4 e0, e1;
            if (hi == 0) { g0 = (f32x4){v[0] * il, v[1] * il, v[2] * il, v[3] * il}; g1 = (f32x4){v[4] * il, v[5] * il, v[6] * il, v[7] * il}; }
            else { g0 = (f32x4){v[8] * il, v[9] * il, v[10] * il, v[11] * il}; g1 = (f32x4){v[12] * il, v[13] * il, v[14] * il, v[15] * il}; }
            e0 = *(const u32x4*)fep; e1 = *(const u32x4*)(fep + 4);
            *(f32x4*)(GATE + ob) = g0; *(f32x4*)(GATE + ob + 4) = g1;
            *(u32x4*)(EXPI + ob) = e0; *(u32x4*)(EXPI + ob + 4) = e1;
        }
        LDS_WAIT(); asm volatile("" ::: "memory");
    }
    __syncthreads();
}
typedef float f32x2_t __attribute__((ext_vector_type(2)));
constexpr int P8_UNITS = T / 64;
constexpr int CW_P8_U = 4096, CW_P8_V = 4096 + 32 * 64;
constexpr float U8_SCALE = 32.0f;
__device__ __forceinline__ unsigned peer_xcc() { return (unsigned)__builtin_amdgcn_s_getreg((3 << 11) | 20) & 7u; }
template <int LPR>
__device__ __forceinline__ void ph_peer_v8g(const Params& p, unsigned char* lds) {
    constexpr int RPI = 64 / LPR, NI = 128 / RPI, G = NI / 8, NS = 64 / LPR, SLB = 16 * LPR;
    const unsigned char* V8 = (const unsigned char*)(p.ws + WS_V16);
    const int* EXPI = (const int*)(p.ws + WS_EXP); const float* CBUF = (const float*)(p.ws + WS_CBUF); const float* MOD = (const float*)(p.ws + WS_MOD);
    unsigned* ctl = (unsigned*)(p.ws + WS_CTL);
    int tid = threadIdx.x; asm volatile("" : "+v"(tid));
    const int lane = tid & 63, wv = __builtin_amdgcn_readfirstlane(tid >> 6), gR = lane / LPR, iC = lane % LPR;
    volatile LAS unsigned* slot = (volatile LAS unsigned*)(LAS unsigned char*)lds;
    const unsigned xcc = peer_xcc();
#pragma unroll 1
    for (int k = 0; k < NS; ++k) {
        const int sl = (int)((((xcc * NS) >> 3) + (unsigned)k) % (unsigned)NS);
        const unsigned char* vcol = V8 + SLB * sl + 16 * iC;
#pragma unroll 1
        for (;;) {
            if (tid == 0) *slot = __hip_atomic_fetch_add(ctl + CW_P8_V + 64 * sl, 1u, __ATOMIC_RELAXED, __HIP_MEMORY_SCOPE_AGENT);
            __syncthreads();
            const unsigned unit = *slot;
            __syncthreads();
            if (unit >= (unsigned)P8_UNITS) break;
            const int tbase = (int)unit * 64 + wv * 8;
            int ne0, ne1; float nc0, nc1;
#define VG_FETCH(T) do { const size_t tn_ = (size_t)(T); ne0 = EXPI[tn_ * 128 + lane]; ne1 = EXPI[tn_ * 128 + 64 + lane]; nc0 = CBUF[tn_ * 128 + lane]; nc1 = CBUF[tn_ * 128 + 64 + lane]; } while (0)
#define VG_LISTS(LE, LC) do { LE[lane] = ne0; LE[64 + lane] = ne1; LC[lane] = nc0; LC[64 + lane] = nc1; } while (0)
#define VG_ROWS(R, LE, GI) do { _Pragma("unroll") for (int kk = 0; kk < 8; ++kk) R[kk] = *(const u32x4*)(vcol + (size_t)LE[RPI * (8 * (GI) + kk) + gR] * 1024); } while (0)
#define VG_GROUP(R, LC, GI) do { _Pragma("unroll") for (int kk = 0; kk < 8; ++kk) { const float cj = LC[RPI * (8 * (GI) + kk) + gR];                       \
            const unsigned w_[4] = {R[kk].x, R[kk].y, R[kk].z, R[kk].w};                                                                       \
            _Pragma("unroll") for (int c = 0; c < 4; ++c) { const f32x2_t lo = __builtin_amdgcn_cvt_pk_f32_fp8((int)w_[c], false), hi = __builtin_amdgcn_cvt_pk_f32_fp8((int)w_[c], true); \
                acc[4 * c] = fmaf(cj, lo.x, acc[4 * c]); acc[4 * c + 1] = fmaf(cj, lo.y, acc[4 * c + 1]); acc[4 * c + 2] = fmaf(cj, hi.x, acc[4 * c + 2]); acc[4 * c + 3] = fmaf(cj, hi.y, acc[4 * c + 3]); } } } while (0)
            u32x4 RA[8], RB[8];
            int* lecur = (int*)(lds + 1024 + wv * 2048); int* lenxt = lecur + 256;
            VG_FETCH(tbase); VG_LISTS(lecur, ((float*)(lecur + 128))); VG_FETCH(tbase + 1);
            LDS_WAIT(); asm volatile("" ::: "memory");
            VG_ROWS(RA, lecur, 0);
#pragma unroll 1
            for (int tt = 0; tt < 8; ++tt) {
                const int t = tbase + tt;
                float* lccur = (float*)(lecur + 128); float* lcnxt = (float*)(lenxt + 128);
                float acc[16];
#pragma unroll
                for (int q = 0; q < 16; ++q) acc[q] = 0.f;
                if (tt + 1 < 8) { VG_LISTS(lenxt, lcnxt); if (tt + 2 < 8) VG_FETCH(t + 2); }
#pragma unroll 1
                for (int gi = 0; gi < G; gi += 2) {
                    VG_ROWS(RB, lecur, gi + 1);
                    VG_GROUP(RA, lccur, gi);
                    if (gi + 2 < G) VG_ROWS(RA, lecur, gi + 2);
                    else if (tt + 1 < 8) { LDS_WAIT(); asm volatile("" ::: "memory"); VG_ROWS(RA, lenxt, 0); }
                    VG_GROUP(RB, lccur, gi + 1);
                }
#pragma unroll
                for (int q = 0; q < 16; ++q) { if (LPR <= 8) acc[q] += dpp_f<0x128>(acc[q]); if (LPR <= 16) acc[q] += __shfl_xor(acc[q], 16); if (LPR <= 32) acc[q] += __shfl_xor(acc[q], 32); }
                if (gR == 0) { const int col = SLB * sl + 16 * iC; const float* g2 = MOD + (size_t)(t >> 11) * 6144 + 5120 + col; float* orow = p.out + (size_t)t * 1024 + col;
#pragma unroll
                    for (int q = 0; q < 4; ++q) { const f32x4 xv = *(const f32x4*)(orow + 4 * q), hv = *(const f32x4*)(g2 + 4 * q);
                        f32x4 r; r.x = acc[4 * q]; r.y = acc[4 * q + 1]; r.z = acc[4 * q + 2]; r.w = acc[4 * q + 3]; *(f32x4*)(orow + 4 * q) = xv + hv * r; } }
                { int* tmp_ = lecur; lecur = lenxt; lenxt = tmp_; }
            }
#undef VG_FETCH
#undef VG_LISTS
#undef VG_ROWS
#undef VG_GROUP
            LDS_WAIT(); asm volatile("" ::: "memory");
        }
    }
}
__device__ __forceinline__ void ph_peer_u8p(const Params& p, unsigned char* lds_w, int gw, int ngw, int lane_) {
    int lane = lane_; asm volatile("" : "+v"(lane));
    const bf16* H = (const bf16*)(p.ws + WS_H); const unsigned char* U8 = (const unsigned char*)(p.ws + WS_U16); const unsigned char* V8 = (const unsigned char*)(p.ws + WS_V16);
    const int* EXPI = (const int*)(p.ws + WS_EXP); const float* GATE = (const float*)(p.ws + WS_GATE); const float* MOD = (const float*)(p.ws + WS_MOD);
    int* e_lds = (int*)lds_w; float* a_lds = (float*)(lds_w + 512);
    const int g = lane >> 4, i = lane & 15;
#pragma unroll 1
    for (int t = gw; t < T; t += ngw) {
        const int e0 = EXPI[(size_t)t * 128 + lane], e1 = EXPI[(size_t)t * 128 + 64 + lane];
        const float g0 = GATE[(size_t)t * 128 + lane], g1 = GATE[(size_t)t * 128 + 64 + lane];
        e_lds[lane] = e0; e_lds[64 + lane] = e1;
        float xf[64];
        { const u32x4* xrow = (const u32x4*)(H + (size_t)t * 1024) + 2 * i;
#pragma unroll
          for (int q = 0; q < 4; ++q) { const u32x4 a = xrow[32 * q], b = xrow[32 * q + 1];
              xf[16 * q] = bflo(a.x); xf[16 * q + 1] = bfhi(a.x); xf[16 * q + 2] = bflo(a.y); xf[16 * q + 3] = bfhi(a.y); xf[16 * q + 4] = bflo(a.z); xf[16 * q + 5] = bfhi(a.z); xf[16 * q + 6] = bflo(a.w); xf[16 * q + 7] = bfhi(a.w);
              xf[16 * q + 8] = bflo(b.x); xf[16 * q + 9] = bfhi(b.x); xf[16 * q + 10] = bflo(b.y); xf[16 * q + 11] = bfhi(b.y); xf[16 * q + 12] = bflo(b.z); xf[16 * q + 13] = bfhi(b.z); xf[16 * q + 14] = bflo(b.w); xf[16 * q + 15] = bfhi(b.w); } }
        LDS_WAIT(); asm volatile("" ::: "memory");
#define P8T_ULOAD(R, S) do { const u32x4* r_ = (const u32x4*)(U8 + (size_t)e_lds[4 * (S) + g] * 1024) + i; _Pragma("unroll") for (int q = 0; q < 4; ++q) R[q] = r_[16 * q]; } while (0)
#define P8T_UDOT(R, S) do { float a0 = 0.f, a1 = 0.f, a2 = 0.f, a3 = 0.f;                                                                               \
        _Pragma("unroll") for (int q = 0; q < 4; ++q) { const unsigned w_[4] = {R[q].x, R[q].y, R[q].z, R[q].w};                                           \
            _Pragma("unroll") for (int c = 0; c < 4; ++c) { const f32x2_t lo = __builtin_amdgcn_cvt_pk_f32_fp8((int)w_[c], false), hi = __builtin_amdgcn_cvt_pk_f32_fp8((int)w_[c], true); \
                a0 = fmaf(lo.x, xf[16 * q + 4 * c], a0); a1 = fmaf(lo.y, xf[16 * q + 4 * c + 1], a1); a2 = fmaf(hi.x, xf[16 * q + 4 * c + 2], a2); a3 = fmaf(hi.y, xf[16 * q + 4 * c + 3], a3); } } \
        const float a_ = row16_sum((a0 + a1) + (a2 + a3)) * (1.0f / U8_SCALE); if (i == 0) a_lds[4 * (S) + g] = a_; } while (0)
        { u32x4 RA[4], RB[4], RC[4];
          P8T_ULOAD(RA, 0); P8T_ULOAD(RB, 1);
#pragma unroll 1
          for (int s = 0; s < 30; s += 3) {
              P8T_ULOAD(RC, s + 2); P8T_UDOT(RA, s);
              P8T_ULOAD(RA, s + 3); P8T_UDOT(RB, s + 1);
              P8T_ULOAD(RB, s + 4); P8T_UDOT(RC, s + 2);
          }
          P8T_UDOT(RA, 30); P8T_UDOT(RB, 31); }
#undef P8T_ULOAD
#undef P8T_UDOT
        LDS_WAIT(); asm volatile("" ::: "memory");
        const float c0 = gelu_erf(a_lds[lane]) * g0, c1 = gelu_erf(a_lds[64 + lane]) * g1;
        float* CB = (float*)(p.ws + WS_CBUF) + (size_t)t * 128; CB[lane] = c0; CB[64 + lane] = c1;
    }
}
#define XB_TMO      128
#define XB_XCNT(j)  (256  + 64 * (j))
#define XB_XSUB(j)  (1280 + 64 * (j))
#define XB_XGEN(j)  (2304 + 64 * (j))
#define XB_TOP      3328
#define XB_TOPGEN   3392
#define XCD_BAR_WORDS 3456
#define XB_SPIN_CAP (1u << 18)

__device__ __forceinline__ unsigned xb_ld(unsigned* p)              { return __hip_atomic_load(p, __ATOMIC_RELAXED, __HIP_MEMORY_SCOPE_AGENT); }
__device__ __forceinline__ unsigned xb_add(unsigned* p, unsigned v) { return __hip_atomic_fetch_add(p, v, __ATOMIC_RELAXED, __HIP_MEMORY_SCOPE_AGENT); }
__device__ __forceinline__ unsigned xb_xcc_id() { return (unsigned)__builtin_amdgcn_s_getreg((3 << 11) | 20) & 0xFu; }
#define XB_SPIN(cond, bar) do { unsigned _sp = 0; while (cond) { __builtin_amdgcn_s_sleep(1); \
    if ((++_sp & 255u) == 0u) { if (xb_ld(&(bar)[XB_TMO])) break; if (_sp > XB_SPIN_CAP) { atomicAdd(&(bar)[XB_TMO], 1u); break; } } } } while (0)

struct XcdBarrier {
    unsigned* bar; unsigned x;
    volatile LAS unsigned* st;
};

__device__ __forceinline__ XcdBarrier xcd_barrier_post(unsigned* bar, volatile LAS unsigned* st) {
    XcdBarrier b; b.bar = bar; b.x = xb_xcc_id(); b.st = st;
    if (threadIdx.x == 0) (void)xb_add(&bar[XB_XCNT(b.x)], 1u);
    return b;
}
__device__ __forceinline__ void xcd_barrier_complete(unsigned* bar, unsigned x, unsigned& nloc, unsigned& nx) {
    const unsigned G = gridDim.x * gridDim.y * gridDim.z;
    unsigned sum, cnt, mine, sp = 0u;
    for (;;) {
        sum = 0u; cnt = 0u; mine = 0u;
#pragma unroll
        for (unsigned j = 0; j < 16; ++j) { const unsigned c = xb_ld(&bar[XB_XCNT(j)]); sum += c; cnt += (c > 0u) ? 1u : 0u; mine = (j == x) ? c : mine; }
        if (sum == G) break;
        __builtin_amdgcn_s_sleep(1);
        if ((++sp & 255u) == 0u) { if (xb_ld(&bar[XB_TMO])) break; if (sp > XB_SPIN_CAP) { atomicAdd(&bar[XB_TMO], 1u); break; } }
    }
    nloc = mine > 0u ? mine : 1u; nx = cnt > 0u ? cnt : 1u;
}

__device__ __forceinline__ void xcd_barrier(const XcdBarrier& b) {
    asm volatile("s_waitcnt vmcnt(0)" ::: "memory");
    __syncthreads();
    if (threadIdx.x == 0) {
        unsigned* bar = b.bar;
        __builtin_amdgcn_s_waitcnt(0);
        unsigned nloc = b.st[0], nx = b.st[1];
        if (nloc == 0u) { xcd_barrier_complete(bar, b.x, nloc, nx); b.st[0] = nloc; b.st[1] = nx; }
        const unsigned old = xb_add(&bar[XB_XSUB(b.x)], 1u);
        const unsigned gen = old / nloc;
        if (old + 1u == (gen + 1u) * nloc) {
            __builtin_amdgcn_fence(__ATOMIC_RELEASE, "agent");
            asm volatile("s_waitcnt vmcnt(0)" ::: "memory");
            const unsigned og = xb_add(&bar[XB_TOP], 1u);
            const unsigned tg = og / nx;
            if (og + 1u == (tg + 1u) * nx) xb_add(&bar[XB_TOPGEN], 1u);
            else XB_SPIN(xb_ld(&bar[XB_TOPGEN]) == tg, bar);
            __builtin_amdgcn_fence(__ATOMIC_ACQUIRE, "agent");
            xb_add(&bar[XB_XGEN(b.x)], 1u);
            asm volatile("s_waitcnt vmcnt(0)" ::: "memory");
        } else {
            XB_SPIN(xb_ld(&bar[XB_XGEN(b.x)]) == gen, bar);
            __builtin_amdgcn_fence(__ATOMIC_ACQUIRE, "agent");
            asm volatile("s_waitcnt vmcnt(0)" ::: "memory");
        }
    }
    __syncthreads();
}

#ifndef V8_LPR
#define V8_LPR 32
#endif
constexpr int LDS_BYTES = 147456;
extern __shared__ __attribute__((aligned(16))) unsigned char dyn_lds[];

__global__ void __launch_bounds__(NT, 2) mega_fwd(Params p) {
    cg::grid_group grid = cg::this_grid();
    const int vb = blockIdx.x, nvb = gridDim.x, ngw = nvb * NWV;
    volatile LAS unsigned* xst = (volatile LAS unsigned*)((LAS unsigned char*)dyn_lds + (LDS_BYTES - 16));
    if (threadIdx.x < 4) xst[threadIdx.x] = 0u;
    __syncthreads();
    const XcdBarrier xbar = xcd_barrier_post((unsigned*)(p.ws + WS_CTL), xst);
#define TID_LAUNDER int tid_ = threadIdx.x; asm volatile("" : "+v"(tid_)); const int lane = tid_ & 63, wv = tid_ >> 6, gw = vb * NWV + wv; (void)lane; (void)gw;
    ph_mod(p, (float*)dyn_lds, vb, nvb);
    { TID_LAUNDER ph_prep_weights(p, (LAS float*)dyn_lds + wv * (64 * 33), gw, ngw, lane); }
    grid.sync();
    { TID_LAUNDER ph_hrows(p, p.x, p.norm1_g, 0, 1024, gw, ngw, lane); }
    xcd_barrier(xbar);
    {   pg8::Gemm g{(const bf16*)(p.ws + WS_H), (const bf16*)(p.ws + WS_WIN), T, NP, 1024}; pg8::StaticOrder S; S.init(T, NP, nvb, vb);
        EpiNormBf16 E{(bf16*)(p.ws + WS_PROJ), p.a_qk_gain, p.b_q_gain, p.b_kv_gain, (LAS float*)((LAS unsigned char*)dyn_lds + 131072)};
        pg8::gemm_phase<EpiNormBf16, pg8::StaticOrder, true, true>((LAS unsigned char*)dyn_lds, g, S, E); }
    xcd_barrier(xbar);
    ph_attnA(p, dyn_lds, vb, nvb);
    __syncthreads();
    ph_dsa(p, dyn_lds, vb, nvb);
    xcd_barrier(xbar);
    {   pg8::Gemm g{(const bf16*)(p.ws + WS_MIX), (const bf16*)(p.ws + WS_WO2), T, 1024, MIXW}; pg8::StaticOrder S; S.init(T, 1024, nvb, vb);
        EpiResGate E{p.x, p.out, (const float*)(p.ws + WS_MOD) + 2048};
        pg8::gemm_phase<EpiResGate, pg8::StaticOrder, true, true>((LAS unsigned char*)dyn_lds, g, S, E); }
    xcd_barrier(xbar);
    { TID_LAUNDER ph_hrows(p, p.out, p.norm2_g, 3072, 4096, gw, ngw, lane); }
    xcd_barrier(xbar);
    {   pg8::Gemm g{(const bf16*)(p.ws + WS_H), (const bf16*)(p.ws + WS_WQ), T, 1024, 1024}; pg8::StaticOrder S; S.init(T, 1024, nvb, vb);
        pg8::EpiBf16<0> E{(bf16*)(p.ws + WS_Q3), 1024, nullptr, 0, 0, 1.f};
        pg8::gemm_phase<pg8::EpiBf16<0>, pg8::StaticOrder, true, true>((LAS unsigned char*)dyn_lds, g, S, E); }
    xcd_barrier(xbar);
    ph_route(p, dyn_lds, vb, nvb);
    xcd_barrier(xbar);

    { TID_LAUNDER ph_peer_u8p(p, dyn_lds + wv * 1024, gw, ngw, lane); }
    xcd_barrier(xbar);
    ph_peer_v8g<V8_LPR>(p, dyn_lds);

}

extern "C" void kernel_launch(void* const* d_in, const int* in_sizes, int n_in, void* d_out, int out_size, void* d_ws, size_t ws_size, hipStream_t stream) {
    static int grid_blocks = 0;
    if (grid_blocks == 0) {
        if (n_in != 18 || in_sizes[0] != T * DM || out_size != T * DM || ws_size < WS_END) { fprintf(stderr, "kernel_launch: unexpected shapes n_in %d in0 %d out %d ws %zu\n", n_in, n_in > 0 ? in_sizes[0] : -1, out_size, ws_size); grid_blocks = -1; return; }
        int dev = 0, cus = 0, per_cu = 0;
        (void)hipGetDevice(&dev);
        (void)hipDeviceGetAttribute(&cus, hipDeviceAttributeMultiprocessorCount, dev);
        (void)hipFuncSetAttribute((const void*)mega_fwd, hipFuncAttributeMaxDynamicSharedMemorySize, LDS_BYTES);
        (void)hipOccupancyMaxActiveBlocksPerMultiprocessor(&per_cu, (const void*)mega_fwd, NT, LDS_BYTES);
        if (per_cu < 1 || cus < 1) { fprintf(stderr, "kernel_launch: occupancy query gave %d blocks/CU on %d CUs\n", per_cu, cus); grid_blocks = -1; return; }
        grid_blocks = cus;
    }
    if (grid_blocks < 0) return;
    Params p{};
    const float** pp = (const float**)&p;
    for (int i = 0; i < 18; ++i) pp[i] = (const float*)d_in[i];
    p.out = (float*)d_out; p.ws = (unsigned char*)d_ws;
    if (hipMemsetAsync((char*)d_ws + WS_CTL, 0, CTL_BYTES, stream) != hipSuccess) { fprintf(stderr, "kernel_launch: memset failed\n"); return; }
    void* args[] = {&p};
    const hipError_t e = hipLaunchCooperativeKernel((const void*)mega_fwd, dim3(grid_blocks), dim3(NT), args, LDS_BYTES, stream);
    if (e != hipSuccess) fprintf(stderr, "kernel_launch: cooperative launch failed: %s (grid %d)\n", hipGetErrorString(e), grid_blocks);
}
```

```cpp
#include <hip/hip_runtime.h>
#include <hip/hip_cooperative_groups.h>
#include <cstdio>
#include <cstdint>
#include <cmath>
namespace pg8 {
#define PG8_LAS __attribute__((address_space(3)))
typedef unsigned short bf16_t;
typedef short bf16x8 __attribute__((ext_vector_type(8)));
typedef float f32x4 __attribute__((ext_vector_type(4)));
typedef unsigned u32x4 __attribute__((ext_vector_type(4)));
constexpr int BM = 256, BK = 64, HALF = 128, HTB = HALF * BK * 2  , STAGE_BYTES = 8 * HTB, NXCD = 8, WGM = 8;

__host__ __device__ __forceinline__ int lds_byte(int r, int c) { const int st = (r >> 4) * 2 + (c >> 5), rr = r & 15, cc = c & 31, ob = rr * 64 + cc * 2; return st * 1024 + (ob ^ (((ob >> 9) & 1) << 5)); }
__host__ __device__ __forceinline__ void stage_rc(int b, int& R, int& C) { const int st = b / 1024, sb = b % 1024, swz = sb ^ (((sb >> 9) & 1) << 5); R = (st >> 1) * 16 + swz / 64; C = (st & 1) * 32 + (swz % 64) / 2; }
__host__ __device__ __forceinline__ int perm32(int rho) { const int n = rho >> 4, i = rho & 15; return 8 * (i >> 2) + 4 * n + (i & 3); }

struct Unit { int pm, pn; };
struct Gemm { const bf16_t* A; const bf16_t* Bt; int M, N, K; };

struct StaticOrder {
    int nM, nN, nwg, G, c;
    __host__ __device__ void init(int M, int N, int G_, int c_) { nM = M / BM; nN = N / BM; nwg = nM * nN; G = G_; c = c_; }
    __host__ __device__ bool next(int i, Unit& u) const {
        const long L = (long)i * G + c; if (L >= nwg) return false;
        int wgid = (int)L; { const int q = nwg / NXCD, r = nwg % NXCD, xcd = wgid % NXCD, off = wgid / NXCD; wgid = (xcd < r ? xcd * (q + 1) : r * (q + 1) + (xcd - r) * q) + off; }
        const int nig = WGM * nN, gid = wgid / nig, fm = gid * WGM, gsz = (nM - fm) < WGM ? (nM - fm) : WGM;
        u.pm = fm + ((wgid % nig) % gsz); u.pn = (wgid % nig) / gsz; return true;
    }
    __device__ __forceinline__ void a_ready(const Unit&) const {}
    __device__ __forceinline__ void done(const Unit&) const {}
};

__device__ __forceinline__ unsigned cvt_pk_bf16(float lo, float hi) { unsigned r; asm volatile("v_cvt_pk_bf16_f32 %0, %1, %2" : "=v"(r) : "v"(lo), "v"(hi)); return r; }
typedef float f32x2 __attribute__((ext_vector_type(2)));
__device__ __forceinline__ f32x2 gelu_pk(f32x2 v) {
    const f32x2 av = __builtin_elementwise_abs(v), d = av * 0.2316418882f + 1.0f;
    f32x2 t; t.x = __builtin_amdgcn_rcpf(d.x); t.y = __builtin_amdgcn_rcpf(d.y);
    f32x2 q = t * 0.5307027145f + (-0.7265760135f); q = q * t + 0.7107068705f; q = q * t + (-0.142248368f); q = q * t + 0.127414796f; q = q * t;
    const f32x2 s = (v * v) * (-0.72134752044f);
    f32x2 e; e.x = __builtin_amdgcn_exp2f(s.x); e.y = __builtin_amdgcn_exp2f(s.y);
    const f32x2 m = v * (q * e), r = v - m;
    f32x2 o; o.x = v.x < 0.f ? m.x : r.x; o.y = v.y < 0.f ? m.y : r.y; return o;
}

template <int ACT  > struct EpiBf16 {
    static constexpr bool PERM = true, AFTER_DRAIN = false; static_assert(ACT == 0 || ACT == 1, "EpiBf16: ACT is 0 (none) or 1 (gelu_pk)");
    bf16_t* O; int ldc; const float* bias; int split_cols; size_t split_stride; float scale0;
    __device__ __forceinline__ void operator()(const f32x4 (&acc)[2][2][4][2], const Unit& u, int wr, int wc, int fr, int fq) const {
        const int row0 = u.pm * BM + wr * 64 + fr; int colt = u.pn * BM; bf16_t* base = O;
        float sc = 1.f; if (split_cols) { const int t = colt / split_cols; base += (size_t)t * split_stride; colt -= t * split_cols; if (t == 0) sc = scale0; }
        const int col0 = colt + wc * 32 + 8 * fq, bcol0 = u.pn * BM + wc * 32 + 8 * fq;
        f32x4 bv[2][2];
#pragma unroll
        for (int bj = 0; bj < 2; ++bj)
#pragma unroll
            for (int n = 0; n < 2; ++n) bv[bj][n] = bias ? *(const f32x4*)(bias + bcol0 + bj * HALF + 4 * n) : (f32x4){0.f, 0.f, 0.f, 0.f};
#pragma unroll
        for (int ai = 0; ai < 2; ++ai)
#pragma unroll
            for (int m = 0; m < 4; ++m) { bf16_t* rowp = base + (size_t)(row0 + ai * HALF + m * 16) * ldc + col0;
#pragma unroll
                for (int bj = 0; bj < 2; ++bj) { f32x4 v0 = acc[ai][bj][m][0] + bv[bj][0], v1 = acc[ai][bj][m][1] + bv[bj][1];
                    if (ACT == 1) { f32x2 a = gelu_pk((f32x2){v0[0], v0[1]}), b = gelu_pk((f32x2){v0[2], v0[3]}), c = gelu_pk((f32x2){v1[0], v1[1]}), d = gelu_pk((f32x2){v1[2], v1[3]});
                        v0 = (f32x4){a.x, a.y, b.x, b.y}; v1 = (f32x4){c.x, c.y, d.x, d.y}; }
                    v0 = v0 * sc; v1 = v1 * sc; u32x4 w; w.x = cvt_pk_bf16(v0[0], v0[1]); w.y = cvt_pk_bf16(v0[2], v0[3]); w.z = cvt_pk_bf16(v1[0], v1[1]); w.w = cvt_pk_bf16(v1[2], v1[3]);
                    *(u32x4*)(rowp + bj * HALF) = w; } }
    }
};

template <class Epi, class Sched, bool ALIGN_EPI = false, bool SP2 = false>
__device__ __forceinline__ void gemm_phase(PG8_LAS unsigned char* lds, const Gemm g, const Sched& S, const Epi& E) {
    int tid = threadIdx.x; asm volatile("" : "+v"(tid)); const int wid = __builtin_amdgcn_readfirstlane(tid >> 6), lane = tid & 63, wr = wid >> 2, wc = wid & 3, fr = lane & 15, fq = lane >> 4;
    const int K = g.K, nt = K / BK;
    unsigned voffA[2], voffB[2];
#pragma unroll
    for (int i = 0; i < 2; ++i) { int R, C; stage_rc(tid * 16 + i * 8192, R, C); const int Rb = Epi::PERM ? ((R & ~31) + perm32(R & 31)) : R;
        voffA[i] = (unsigned)(R * K + C) * 2u; voffB[i] = (unsigned)(Rb * K + C) * 2u; }
    const size_t kstep = (size_t)(BK * 2);
    const size_t hstep = (size_t)HALF * K * 2;
    const size_t tstep = 2 * hstep;
    const unsigned ldsw = (unsigned)wid * 1024u;
    const int aoff = lds_byte(wr * 64 + fr, fq * 8), boff = lds_byte(wc * 32 + fr, fq * 8);
#define PG8_SA(b, h) (((b) * 2 + (h)) * HTB)
#define PG8_SB(b, h) ((4 + (b) * 2 + (h)) * HTB)
#define PG8_STAGE(bufoff, gbase, voff) do { _Pragma("unroll") for (int _i = 0; _i < 2; ++_i) \
        __builtin_amdgcn_global_load_lds((const unsigned*)((const char*)(gbase) + (voff)[_i]), (PG8_LAS unsigned*)(lds + (bufoff) + ldsw + _i * 8192), 16, 0, 0); } while (0)
#define PG8_LDA(dst, b, h) do { _Pragma("unroll") for (int m = 0; m < 4; ++m) _Pragma("unroll") for (int k = 0; k < 2; ++k) dst[m][k] = *(const PG8_LAS bf16x8*)(lds + PG8_SA(b, h) + aoff + m * 2048 + k * 1024); } while (0)
#define PG8_LDB(dst, b, h) do { _Pragma("unroll") for (int n = 0; n < 2; ++n) _Pragma("unroll") for (int k = 0; k < 2; ++k) dst[n][k] = *(const PG8_LAS bf16x8*)(lds + PG8_SB(b, h) + boff + n * 2048 + k * 1024); } while (0)
#define PG8_MMA(ai, bj, At, Bt) do { __builtin_amdgcn_s_setprio(1); _Pragma("unroll") for (int m = 0; m < 4; ++m) _Pragma("unroll") for (int n = 0; n < 2; ++n) _Pragma("unroll") for (int k = 0; k < 2; ++k) \
        acc[ai][bj][m][n] = __builtin_amdgcn_mfma_f32_16x16x32_bf16(Bt[n][k], At[m][k], acc[ai][bj][m][n], 0, 0, 0); __builtin_amdgcn_s_setprio(0); } while (0)
#define PG8_WAIT_V(n) asm volatile("s_waitcnt vmcnt(" #n ")" ::: "memory")
#define PG8_WAIT_L(n) asm volatile("s_waitcnt lgkmcnt(" #n ")" ::: "memory")
#define PG8_BAR __builtin_amdgcn_s_barrier()
#define PG8_SCHED __builtin_amdgcn_sched_barrier(0)
    Unit cur, nxt; int ui = 0;
    if (!S.next(0, cur)) return;
    f32x4 acc[2][2][4][2];
#pragma unroll
    for (int a = 0; a < 2; ++a)
#pragma unroll
        for (int b = 0; b < 2; ++b)
#pragma unroll
            for (int m = 0; m < 4; ++m)
#pragma unroll
                for (int n = 0; n < 2; ++n) acc[a][b][m][n] = (f32x4){0.f, 0.f, 0.f, 0.f};
    bf16x8 At[4][2], B0[2][2], B1[2][2];
    const char* cA = (const char*)g.A + (size_t)cur.pm * tstep; const char* cB = (const char*)g.Bt + (size_t)cur.pn * tstep;
    S.a_ready(cur);
    if constexpr (SP2) {
        PG8_STAGE(PG8_SB(0, 0), cB, voffB); PG8_STAGE(PG8_SB(0, 1), cB + hstep, voffB); PG8_STAGE(PG8_SA(0, 0), cA, voffA); PG8_STAGE(PG8_SA(0, 1), cA + hstep, voffA);
        if (wr == 1) PG8_BAR;
        PG8_WAIT_V(2); PG8_BAR;
        PG8_STAGE(PG8_SB(1, 0), cB + kstep, voffB); PG8_STAGE(PG8_SA(1, 0), cA + kstep, voffA); PG8_STAGE(PG8_SB(1, 1), cB + hstep + kstep, voffB);
        PG8_WAIT_V(6); PG8_BAR;
    } else {
        PG8_STAGE(PG8_SB(0, 0), cB, voffB); PG8_STAGE(PG8_SA(0, 0), cA, voffA); PG8_STAGE(PG8_SB(0, 1), cB + hstep, voffB); PG8_STAGE(PG8_SA(0, 1), cA + hstep, voffA);
        if (wr == 1) PG8_BAR;
        PG8_WAIT_V(4); PG8_BAR;
        PG8_STAGE(PG8_SB(1, 0), cB + kstep, voffB); PG8_STAGE(PG8_SA(1, 0), cA + kstep, voffA); PG8_STAGE(PG8_SB(1, 1), cB + hstep + kstep, voffB);
        PG8_WAIT_V(6); PG8_BAR;
    }
    for (;;) {
        const bool has_next = S.next(ui + 1, nxt);
        const char* nA = has_next ? (const char*)g.A + (size_t)nxt.pm * tstep : cA; const char* nB = has_next ? (const char*)g.Bt + (size_t)nxt.pn * tstep : cB;
        for (int t = 0; t < nt; t += 2) {
            const bool last = (t == nt - 2);
            const char* a1 = cA + (size_t)(t + 1) * kstep;
            const char* a2 = last ? nA : cA + (size_t)(t + 2) * kstep; const char* b2 = last ? nB : cB + (size_t)(t + 2) * kstep;
            const char* a3 = a2 + kstep; const char* b3 = b2 + kstep;
            if (last && has_next) S.a_ready(nxt);
            if constexpr (SP2) {
            PG8_LDB(B0, 0, 0); PG8_LDB(B1, 0, 1); PG8_SCHED; PG8_LDA(At, 0, 0); PG8_STAGE(PG8_SA(1, 1), a1 + hstep, voffA);
            PG8_WAIT_V(8); PG8_WAIT_L(0); PG8_BAR; PG8_MMA(0, 0, At, B0); PG8_MMA(0, 1, At, B1); PG8_BAR; PG8_SCHED;
            PG8_LDA(At, 0, 1); PG8_STAGE(PG8_SB(0, 0), b2, voffB); PG8_STAGE(PG8_SB(0, 1), b2 + hstep, voffB); PG8_STAGE(PG8_SA(0, 0), a2, voffA);
            PG8_WAIT_V(8); PG8_WAIT_L(0); PG8_BAR; PG8_MMA(1, 0, At, B0); PG8_MMA(1, 1, At, B1); PG8_BAR; PG8_SCHED;
            PG8_LDB(B0, 1, 0); PG8_LDB(B1, 1, 1); PG8_SCHED; PG8_LDA(At, 1, 0); PG8_STAGE(PG8_SA(0, 1), a2 + hstep, voffA);
            PG8_WAIT_V(8); PG8_WAIT_L(0); PG8_BAR; PG8_MMA(0, 0, At, B0); PG8_MMA(0, 1, At, B1); PG8_BAR; PG8_SCHED;
            PG8_LDA(At, 1, 1); PG8_STAGE(PG8_SB(1, 0), b3, voffB); PG8_STAGE(PG8_SB(1, 1), b3 + hstep, voffB); PG8_STAGE(PG8_SA(1, 0), a3, voffA);
            PG8_WAIT_V(8); PG8_WAIT_L(0); PG8_BAR; PG8_MMA(1, 0, At, B0); PG8_MMA(1, 1, At, B1); PG8_BAR; PG8_SCHED;
            } else {
            PG8_LDB(B0, 0, 0); PG8_SCHED; PG8_LDA(At, 0, 0); PG8_STAGE(PG8_SA(1, 1), a1 + hstep, voffA);
            PG8_WAIT_L(8); PG8_BAR; PG8_WAIT_L(0); PG8_MMA(0, 0, At, B0); PG8_BAR; PG8_SCHED;
            PG8_LDB(B1, 0, 1); PG8_STAGE(PG8_SB(0, 0), b2, voffB);
            PG8_BAR; PG8_WAIT_L(0); PG8_MMA(0, 1, At, B1); PG8_BAR;
            PG8_LDA(At, 0, 1); PG8_STAGE(PG8_SA(0, 0), a2, voffA);
            PG8_BAR; PG8_WAIT_L(0); PG8_MMA(1, 0, At, B0); PG8_BAR; PG8_SCHED;
            PG8_STAGE(PG8_SB(0, 1), b2 + hstep, voffB);
            PG8_WAIT_V(6); PG8_BAR; PG8_MMA(1, 1, At, B1); PG8_BAR;
            PG8_LDB(B0, 1, 0); PG8_SCHED; PG8_LDA(At, 1, 0); PG8_STAGE(PG8_SA(0, 1), a2 + hstep, voffA);
            PG8_WAIT_L(8); PG8_BAR; PG8_WAIT_L(0); PG8_MMA(0, 0, At, B0); PG8_BAR; PG8_SCHED;
            PG8_LDB(B1, 1, 1); PG8_STAGE(PG8_SB(1, 0), b3, voffB);
            PG8_BAR; PG8_WAIT_L(0); PG8_MMA(0, 1, At, B1); PG8_BAR;
            PG8_LDA(At, 1, 1); PG8_STAGE(PG8_SA(1, 0), a3, voffA);
            PG8_BAR; PG8_WAIT_L(0); PG8_MMA(1, 0, At, B0); PG8_BAR; PG8_SCHED;
            PG8_STAGE(PG8_SB(1, 1), b3 + hstep, voffB);
            PG8_WAIT_V(6); PG8_BAR; PG8_MMA(1, 1, At, B1); PG8_BAR;
            }
        }
        if constexpr (ALIGN_EPI) { if (wr == 0) PG8_BAR; }
        if constexpr (!Epi::AFTER_DRAIN) { E(acc, cur, wr, wc, fr, fq); S.done(cur); }
        if (!has_next) break;
#pragma unroll
        for (int a = 0; a < 2; ++a)
#pragma unroll
            for (int b = 0; b < 2; ++b)
#pragma unroll
                for (int m = 0; m < 4; ++m)
#pragma unroll
                    for (int n = 0; n < 2; ++n) acc[a][b][m][n] = (f32x4){0.f, 0.f, 0.f, 0.f};
        cur = nxt; cA = nA; cB = nB; ++ui;
        if constexpr (ALIGN_EPI) { if (wr == 1) PG8_BAR; }
    }
    PG8_WAIT_V(0);
    if constexpr (!ALIGN_EPI) { if (wr == 0) PG8_BAR; }
    PG8_BAR;
    if constexpr (Epi::AFTER_DRAIN) { E.fused(acc, cur, wr, wc, fr, fq, lds, wid, lane); S.done(cur); }
#undef PG8_SA
#undef PG8_SB
#undef PG8_STAGE
#undef PG8_LDA
#undef PG8_LDB
#undef PG8_MMA
#undef PG8_WAIT_V
#undef PG8_WAIT_L
#undef PG8_BAR
#undef PG8_SCHED
}
}
namespace cg = cooperative_groups;
#define LAS __attribute__((address_space(3)))
typedef unsigned short bf16;
typedef float f32x4 __attribute__((ext_vector_type(4)));
typedef float f32x8 __attribute__((ext_vector_type(8)));
typedef float f32x16 __attribute__((ext_vector_type(16)));
typedef unsigned u32x4 __attribute__((ext_vector_type(4)));
typedef unsigned u32x2 __attribute__((ext_vector_type(2)));
typedef short bf16x8 __attribute__((ext_vector_type(8)));
typedef short s16x4 __attribute__((ext_vector_type(4)));

constexpr int BATCH = 16, SEQ = 2048, DM = 1024, T = BATCH * SEQ;
constexpr int NP = 3072;
constexpr int IN_COLS = 3012;
constexpr int C_QA = 0, C_KA = 512, C_VA = 1024, C_QB = 1536, C_KV = 2560, C_QI = 2688, C_KI = 2944, C_WI = 3008;
constexpr int MIXW = 1536;
constexpr int NEXP = 16384;
constexpr float EPS = 1e-6f;
constexpr int NT = 512;
constexpr int NWV = 8;

constexpr size_t MiB = 1u << 20;
constexpr size_t WS_CTL = 0;
constexpr size_t CTL_BYTES = 64 * 1024;
constexpr size_t WS_MOD = 1 * MiB;
constexpr size_t WS_SCAL = WS_MOD + 512 * 1024;
constexpr size_t WS_WIN = 2 * MiB;
constexpr size_t WS_WO2 = 8 * MiB;
constexpr size_t WS_WQ = 11 * MiB;
constexpr size_t WS_SUBK = 13 * MiB;
constexpr size_t WS_U16 = 14 * MiB;
constexpr size_t WS_V16 = 46 * MiB;
constexpr size_t WS_H = 78 * MiB;
constexpr size_t WS_PROJ = 142 * MiB;
constexpr size_t WS_Q3 = WS_PROJ;
constexpr size_t WS_MIX = 334 * MiB;
constexpr size_t WS_EXP = 430 * MiB;
constexpr size_t WS_KVC = WS_EXP;
constexpr size_t WS_GATE = 446 * MiB;
constexpr size_t WS_ATMP = 462 * MiB;
constexpr size_t WS_CBUF = 494 * MiB;
constexpr size_t WS_END = 510 * MiB;

struct Params {
    const float *x, *c, *ada_w, *ada_b, *norm1_g, *norm2_g, *w_in, *a_qk_gain, *a_lambda, *a_sub_gain, *b_q_gain, *b_kv_gain, *b_w_uv, *w_out, *peer_wq, *peer_subkeys, *peer_u, *peer_v;
    float* out; unsigned char* ws;
};

enum { SC_LAM = 0, SC_MA = 1, SC_MB = 2 };

__device__ __forceinline__ unsigned f2bf(float f) { unsigned u = __float_as_uint(f); return (u + 0x7fffu + ((u >> 16) & 1u)) >> 16; }
__device__ __forceinline__ float bf2f(unsigned h) { return __uint_as_float(h << 16); }
__device__ __forceinline__ unsigned pk2(float lo, float hi) { return f2bf(lo) | (f2bf(hi) << 16); }
__device__ __forceinline__ float bflo(unsigned w) { return __uint_as_float(w << 16); }
__device__ __forceinline__ float bfhi(unsigned w) { return __uint_as_float(w & 0xffff0000u); }
__device__ __forceinline__ float wave_sum(float v) {
#pragma unroll
    for (int o = 1; o < 64; o <<= 1) v += __shfl_xor(v, o);
    return v;
}
__device__ __forceinline__ float wave_max(float v) {
#pragma unroll
    for (int o = 1; o < 64; o <<= 1) v = fmaxf(v, __shfl_xor(v, o));
    return v;
}
#define LDS_WAIT() asm volatile("s_waitcnt lgkmcnt(0)" ::: "memory")
__device__ __forceinline__ void ph_mod(const Params& p, float* ldsf, int vb, int nvb) {
    if (vb >= 96) return;
    int tid = threadIdx.x; asm volatile("" : "+v"(tid));
    const int lane = tid & 63, wv = tid >> 6;
    for (int i = tid; i < 16 * 1024; i += NT) { const float v = p.c[i]; ldsf[i] = v / (1.f + __expf(-v)); }
    __syncthreads();
    float* MOD = (float*)(p.ws + WS_MOD); float* part = ldsf + 16 * 1024;
    for (int it = vb; it < 96; it += nvb) {
        const int j = it * 64 + lane;
        float acc[16];
#pragma unroll
        for (int b = 0; b < 16; ++b) acc[b] = 0.f;
        const float* wp = p.ada_w + (size_t)(128 * wv) * 6144 + j;
#pragma unroll 1
        for (int k0 = 0; k0 < 128; k0 += 8) {
            float w[8];
#pragma unroll
            for (int u = 0; u < 8; ++u) w[u] = wp[(size_t)(k0 + u) * 6144];
#pragma unroll
            for (int u = 0; u < 8; ++u)
#pragma unroll
                for (int b = 0; b < 16; ++b) acc[b] = fmaf(ldsf[b * 1024 + 128 * wv + k0 + u], w[u], acc[b]);
        }
#pragma unroll
        for (int b = 0; b < 16; ++b) part[(wv * 16 + b) * 64 + lane] = acc[b];
        __syncthreads();
        for (int o = tid; o < 16 * 64; o += NT) { const int b = o >> 6, c = o & 63; float s = 0.f;
#pragma unroll
            for (int w = 0; w < 8; ++w) s += part[(w * 16 + b) * 64 + c];
            MOD[b * 6144 + it * 64 + c] = s + p.ada_b[it * 64 + c]; }
        __syncthreads();
    }
}

__device__ __forceinline__ void transpose_item(const float* W, int N, bf16* WT, int ldt, LAS float* scr, int kb, int nb, int lane) {
    const int k0 = 64 * kb, n0 = 32 * nb;
#pragma unroll 8
    for (int i = 0; i < 32; ++i) { const int kk = 2 * i + (lane >> 5); const int n = n0 + (lane & 31); scr[kk * 33 + (lane & 31)] = (n < N) ? W[(size_t)(k0 + kk) * N + n] : 0.f; }
    LDS_WAIT(); asm volatile("" ::: "memory");
    const int c = lane & 7;
#pragma unroll
    for (int j = 0; j < 4; ++j) { const int n = (lane >> 3) + 8 * j; const LAS float* s = scr + (8 * c) * 33 + n;
        u32x4 o; o.x = pk2(s[0 * 33], s[1 * 33]); o.y = pk2(s[2 * 33], s[3 * 33]); o.z = pk2(s[4 * 33], s[5 * 33]); o.w = pk2(s[6 * 33], s[7 * 33]);
        *(u32x4*)(WT + (size_t)(n0 + n) * ldt + k0 + 8 * c) = o; }
    LDS_WAIT(); asm volatile("" ::: "memory");
}

__device__ __forceinline__ void ph_prep_weights(const Params& p, LAS float* scr, int gw, int ngw, int lane) {
    bf16* WIN = (bf16*)(p.ws + WS_WIN); bf16* WO2 = (bf16*)(p.ws + WS_WO2); bf16* WQ = (bf16*)(p.ws + WS_WQ);
    constexpr int I_IN = 16 * 96, I_O = 8 * 32, I_Q = 16 * 32;
    for (int it = gw; it < I_IN + I_O + I_Q; it += ngw) {
        int r = it;
        if (r < I_IN) { transpose_item(p.w_in, IN_COLS, WIN, 1024, scr, r / 96, r % 96, lane); continue; } r -= I_IN;
        if (r < I_O) { transpose_item(p.w_out, 1024, WO2, MIXW, scr, r / 32, r % 32, lane); continue; } r -= I_O;
        transpose_item(p.peer_wq, 1024, WQ, 1024, scr, r / 32, r % 32, lane);
    }
    const size_t gt = (size_t)gw * 64 + lane, ngt = (size_t)ngw * 64;
    for (size_t i = gt; i < (size_t)1024 * 1024; i += ngt) {
        const int n = (int)(i & 1023), kk = (int)(i >> 10), h = kk >> 7;
        const float* wu = p.b_w_uv + (size_t)kk * 64; const float* wo = p.w_out + (size_t)(512 + 64 * h) * 1024 + n;
        float a = 0.f;
#pragma unroll 8
        for (int e = 0; e < 64; ++e) a = fmaf(wu[e], wo[(size_t)e * 1024], a);
        WO2[(size_t)n * MIXW + 512 + kk] = (bf16)f2bf(a);
    }
    unsigned char* U8 = (unsigned char*)(p.ws + WS_U16); unsigned char* V8 = (unsigned char*)(p.ws + WS_V16); bf16* SUBK = (bf16*)(p.ws + WS_SUBK);
    constexpr size_t NTAB8 = (size_t)NEXP * 1024 / 8, NSUB8 = 2 * 128 * 64 / 8;
    for (size_t i = gt; i < 2 * NTAB8 + NSUB8; i += ngt) {
        if (i < 2 * NTAB8) {
            const bool isu = i < NTAB8; const size_t j = isu ? i : i - NTAB8; const float sc = isu ? 32.0f : 1.0f;
            const f32x8 v = *(const f32x8*)((isu ? p.peer_u : p.peer_v) + j * 8);
            int w0 = 0, w1 = 0;
            w0 = __builtin_amdgcn_cvt_pk_fp8_f32(v[0] * sc, v[1] * sc, w0, false); w0 = __builtin_amdgcn_cvt_pk_fp8_f32(v[2] * sc, v[3] * sc, w0, true);
            w1 = __builtin_amdgcn_cvt_pk_fp8_f32(v[4] * sc, v[5] * sc, w1, false); w1 = __builtin_amdgcn_cvt_pk_fp8_f32(v[6] * sc, v[7] * sc, w1, true);
            u32x2 o; o.x = (unsigned)w0; o.y = (unsigned)w1;
            *(u32x2*)((isu ? U8 : V8) + j * 8) = o;
        } else {
            const size_t j = i - 2 * NTAB8;
            const f32x8 v = *(const f32x8*)(p.peer_subkeys + j * 8);
            u32x4 o; o.x = pk2(v[0], v[1]); o.y = pk2(v[2], v[3]); o.z = pk2(v[4], v[5]); o.w = pk2(v[6], v[7]);
            *(u32x4*)(SUBK + j * 8) = o;
        }
    }
    if (gt == 0) {
        float* SC = (float*)(p.ws + WS_SCAL);
        float s01 = 0.f, s23 = 0.f;
        for (int i = 0; i < 64; ++i) { s01 += p.a_lambda[i] * p.a_lambda[64 + i]; s23 += p.a_lambda[128 + i] * p.a_lambda[192 + i]; }
        SC[SC_LAM] = __expf(s01) - __expf(s23) + 0.2f;
        float g0 = 0.f, g1 = 0.f, gq = 0.f, gk = 0.f;
        for (int i = 0; i < 64; ++i) { g0 = fmaxf(g0, fabsf(p.a_qk_gain[i])); g1 = fmaxf(g1, fabsf(p.a_qk_gain[64 + i])); }
        for (int i = 0; i < 128; ++i) { gq = fmaxf(gq, fabsf(p.b_q_gain[i])); gk = fmaxf(gk, fabsf(p.b_kv_gain[i])); }
        SC[SC_MA] = 8.0f * g0 * g1 * 1.02f;
        SC[SC_MB] = 11.3137085f * gq * gk * 1.02f;
    }
}

__device__ __forceinline__ void ph_hrows(const Params& p, const float* X, const float* g, int shOff, int scOff, int gw, int ngw, int lane) {
    const float* MOD = (const float*)(p.ws + WS_MOD); bf16* H = (bf16*)(p.ws + WS_H);
    for (int m = gw; m < T; m += ngw) {
        const f32x4* xr = (const f32x4*)(X + (size_t)m * 1024) + lane;
        f32x4 v[4]; float s = 0.f;
#pragma unroll
        for (int j = 0; j < 4; ++j) { v[j] = xr[64 * j]; s += (v[j].x * v[j].x + v[j].y * v[j].y) + (v[j].z * v[j].z + v[j].w * v[j].w); }
        const float rstd = rsqrtf(wave_sum(s) * (1.f / 1024.f) + EPS);
        const float* mb = MOD + (size_t)(m >> 11) * 6144;
#pragma unroll
        for (int j = 0; j < 4; ++j) {
            const int col = 4 * (lane + 64 * j);
            const f32x4 gg = *(const f32x4*)(g + col), sc = *(const f32x4*)(mb + scOff + col), sh = *(const f32x4*)(mb + shOff + col);
            const f32x4 y = v[j] * rstd * gg * (sc + 1.0f) + sh;
            u32x2 o; o.x = pk2(y.x, y.y); o.y = pk2(y.z, y.w);
            *(u32x2*)(H + (size_t)m * 1024 + col) = o;
        }
    }
}

__device__ __forceinline__ void ph_norm_proj(const Params& p, int gw, int ngw, int lane) {
    bf16* PROJ = (bf16*)(p.ws + WS_PROJ);
    for (int m = gw; m < T; m += ngw) {
        bf16* row = PROJ + (size_t)m * NP;
#pragma unroll
        for (int j = 0; j < 6; ++j) {
            if (j == 2) continue;
            const int col = 8 * lane + 512 * j;
            const u32x4 raw = *(const u32x4*)(row + col);
            float v[8] = {bflo(raw.x), bfhi(raw.x), bflo(raw.y), bfhi(raw.y), bflo(raw.z), bfhi(raw.z), bflo(raw.w), bfhi(raw.w)};
            float ss = 0.f;
#pragma unroll
            for (int i = 0; i < 8; ++i) ss += v[i] * v[i];
            ss += __shfl_xor(ss, 1); ss += __shfl_xor(ss, 2); ss += __shfl_xor(ss, 4);
            float rstd; const float* gp;
            if (j < 2) { rstd = rsqrtf(ss * (1.f / 64.f) + EPS); gp = p.a_qk_gain + 64 * j + (col & 63); }
            else { ss += __shfl_xor(ss, 8); rstd = rsqrtf(ss * (1.f / 128.f) + EPS); gp = (j == 5 ? p.b_kv_gain : p.b_q_gain) + (col & 127); }
            if (j == 5 && lane >= 16) continue;
            const f32x4 g0 = *(const f32x4*)gp, g1 = *(const f32x4*)(gp + 4);
            u32x4 o; o.x = pk2(v[0] * rstd * g0.x, v[1] * rstd * g0.y); o.y = pk2(v[2] * rstd * g0.z, v[3] * rstd * g0.w);
            o.z = pk2(v[4] * rstd * g1.x, v[5] * rstd * g1.y); o.w = pk2(v[6] * rstd * g1.z, v[7] * rstd * g1.w);
            *(u32x4*)(row + col) = o;
        }
    }
}
struct EpiResGate {
    static constexpr bool PERM = false, AFTER_DRAIN = false;
    const float* X; float* Out; const float* gate;
    __device__ __forceinline__ void operator()(const pg8::f32x4 (&acc)[2][2][4][2], const pg8::Unit& u, int wr, int wc, int fr, int fq) const {
        const int col0 = u.pn * 256 + wc * 32 + 4 * fq;
#pragma unroll
        for (int ai = 0; ai < 2; ++ai)
#pragma unroll
            for (int m = 0; m < 4; ++m) {
                const int r = u.pm * 256 + ai * 128 + wr * 64 + m * 16 + fr; const float* gb = gate + (size_t)(r >> 11) * 6144;
#pragma unroll
                for (int bj = 0; bj < 2; ++bj)
#pragma unroll
                    for (int n = 0; n < 2; ++n) { const int c = col0 + bj * 128 + n * 16; const size_t off = (size_t)r * 1024 + c;
                        const pg8::f32x4 xv = *(const pg8::f32x4*)(X + off), gv = *(const pg8::f32x4*)(gb + c);
                        *(pg8::f32x4*)(Out + off) = xv + gv * acc[ai][bj][m][n]; }
            }
    }
};


struct EpiNormBf16 {
    static constexpr bool PERM = true, AFTER_DRAIN = false;
    bf16* O; const float* gqk; const float* gbq; const float* gbkv; LAS float* P; bf16* KVC;
    __device__ __forceinline__ void operator()(const pg8::f32x4 (&acc)[2][2][4][2], const pg8::Unit& u, int wr, int wc, int fr, int fq) const {
        const int pn = u.pn;
        const int mode = pn < 4 ? 1 : ((pn == 4 || pn == 5 || pn == 11) ? 0 : (pn == 10 ? 3 : 2));
        if (mode != 0) {
#pragma unroll
            for (int ai = 0; ai < 2; ++ai)
#pragma unroll
                for (int m = 0; m < 4; ++m)
#pragma unroll
                    for (int bj = 0; bj < 2; ++bj) {
                        const pg8::f32x4 a = acc[ai][bj][m][0], b = acc[ai][bj][m][1];
                        float ss = (a[0] * a[0] + a[1] * a[1]) + (a[2] * a[2] + a[3] * a[3]) + (b[0] * b[0] + b[1] * b[1]) + (b[2] * b[2] + b[3] * b[3]);
                        ss += __shfl_xor(ss, 16); ss += __shfl_xor(ss, 32);
                        if (fq == 0) P[(ai * 128 + wr * 64 + m * 16 + fr) * 8 + bj * 4 + wc] = ss;
                    }
            asm volatile("s_waitcnt lgkmcnt(0)" ::: "memory"); __builtin_amdgcn_s_barrier(); asm volatile("" ::: "memory");
        }
        const int row0 = u.pm * 256 + wr * 64 + fr, col0 = u.pn * 256 + wc * 32 + 8 * fq;
        pg8::f32x4 g0[2], g1[2];
#pragma unroll
        for (int bj = 0; bj < 2; ++bj) {
            const float* gp = nullptr;
            if (mode == 1) gp = gqk + (pn >= 2 ? 64 : 0) + 32 * (wc & 1) + 8 * fq;
            else if (mode == 2) gp = gbq + 32 * wc + 8 * fq;
            else if (mode == 3 && bj == 0) gp = gbkv + 32 * wc + 8 * fq;
            if (gp) { g0[bj] = *(const pg8::f32x4*)gp; g1[bj] = *(const pg8::f32x4*)(gp + 4); } else { g0[bj] = (pg8::f32x4){1.f, 1.f, 1.f, 1.f}; g1[bj] = g0[bj]; }
        }
#pragma unroll
        for (int ai = 0; ai < 2; ++ai)
#pragma unroll
            for (int m = 0; m < 4; ++m) { bf16* rowp = O + (size_t)(row0 + ai * 128 + m * 16) * NP + col0;
#pragma unroll
                for (int bj = 0; bj < 2; ++bj) {
                    float s = 1.f;
                    if (mode != 0 && !(mode == 3 && bj == 1)) {
                        const pg8::f32x4 q = *(const LAS pg8::f32x4*)(P + (ai * 128 + wr * 64 + m * 16 + fr) * 8 + bj * 4);
                        s = (mode == 1) ? rsqrtf(((wc < 2) ? (q[0] + q[1]) : (q[2] + q[3])) * (1.f / 64.f) + EPS) : rsqrtf(((q[0] + q[1]) + (q[2] + q[3])) * (1.f / 128.f) + EPS);
                    }
                    const pg8::f32x4 v0 = acc[ai][bj][m][0] * s * g0[bj], v1 = acc[ai][bj][m][1] * s * g1[bj];
                    pg8::u32x4 w; w.x = pg8::cvt_pk_bf16(v0[0], v0[1]); w.y = pg8::cvt_pk_bf16(v0[2], v0[3]); w.z = pg8::cvt_pk_bf16(v1[0], v1[1]); w.w = pg8::cvt_pk_bf16(v1[2], v1[3]);
                    if (pn == 10 && bj == 0) *(pg8::u32x4*)(KVC + (size_t)(row0 + ai * 128 + m * 16) * 128 + wc * 32 + 8 * fq) = w;
                    else *(pg8::u32x4*)(rowp + bj * 128) = w; } }
    }
};
typedef __bf16 bf16x2_t __attribute__((ext_vector_type(2)));
__device__ __forceinline__ float dot2bf(unsigned a, unsigned b, float acc) { return __builtin_amdgcn_fdot2_f32_bf16(__builtin_bit_cast(bf16x2_t, a), __builtin_bit_cast(bf16x2_t, b), acc, false); }
template <int CTRL> __device__ __forceinline__ float dpp_f(float v) { return __int_as_float(__builtin_amdgcn_update_dpp(0, __float_as_int(v), CTRL, 0xf, 0xf, false)); }
__device__ __forceinline__ float row16_sum(float v) {
    v += dpp_f<0x128>(v); v += dpp_f<0x124>(v); v += dpp_f<0x122>(v); v += dpp_f<0x121>(v); return v;
}
__device__ __forceinline__ float gelu_erf(float v) {
    const float av = fabsf(v), t = __builtin_amdgcn_rcpf(fmaf(av, 0.2316418882f, 1.0f));
    float q = fmaf(t, 0.5307027145f, -0.7265760135f); q = fmaf(q, t, 0.7107068705f); q = fmaf(q, t, -0.142248368f); q = fmaf(q, t, 0.127414796f); q = q * t;
    const float e = __builtin_amdgcn_exp2f(v * v * -0.72134752044f);
    const float m = v * (q * e);
    return v < 0.f ? m : v - m;
}

typedef short v4i16_t __attribute__((ext_vector_type(4)));
#ifndef DSA_REP_A
#define DSA_REP_A 1
#endif
#ifndef DSA_REP_B
#define DSA_REP_B 1
#endif
#ifndef DSA_REP_C
#define DSA_REP_C 1
#endif
constexpr int DSA_SROW = 2048 * 4 + 16;
constexpr int DSA_SEL_OFF = 16 * DSA_SROW;
constexpr int DSA_LDS = DSA_SEL_OFF + 16 * 512;
constexpr int DSA_KVROW = 272;

__device__ __forceinline__ unsigned sortkey(float s) { const unsigned u = __float_as_uint(s); return u ^ ((u >> 31) ? 0xffffffffu : 0x80000000u); }
__device__ __forceinline__ unsigned cvtpk_bf16(float lo, float hi) { unsigned r; asm volatile("v_cvt_pk_bf16_f32 %0, %1, %2" : "=v"(r) : "v"(lo), "v"(hi)); return r; }

__device__ __forceinline__ void ph_dsa(const Params& p, unsigned char* lds, int vb, int nvb) {
    const bf16* PROJ = (const bf16*)(p.ws + WS_PROJ); bf16* MIX = (bf16*)(p.ws + WS_MIX);
    const float MB = ((const float*)(p.ws + WS_SCAL))[SC_MB];
    int tid = threadIdx.x; asm volatile("" : "+v"(tid)); const int lane = tid & 63, wv = __builtin_amdgcn_readfirstlane(tid >> 6);
    const int l15 = lane & 15, g = lane >> 4;
    LAS unsigned char* ldsl = (LAS unsigned char*)lds;
    for (int it = vb; it < 2048; it += nvb) {
        const int vbb = it & 255, kk = it >> 8, xg = vbb & 7, ix = vbb >> 3, b = 2 * xg + (ix & 1), G = (ix >> 1) & 3, sub = ix >> 3;
        const int c = (kk & 1) ? (31 - G - 8 * (kk >> 1)) : (G + 8 * (kk >> 1));
        const int cend = (c + 1) * 64, t0 = c * 64 + sub * 16;
        const bf16* Pb = PROJ + (size_t)b * SEQ * NP;
        const bf16* KVb = (const bf16*)(p.ws + WS_KVC) + (size_t)b * SEQ * 128;
#pragma unroll 1
        for (int repa = 0; repa < DSA_REP_A; ++repa)
        if (c >= 4) {
            const bf16* qrow = Pb + (size_t)(t0 + l15) * NP;
            bf16x8 bq[4][2]; float wsc[4];
#pragma unroll
            for (int h = 0; h < 4; ++h) { wsc[h] = bf2f(qrow[C_WI + h]) * 0.0625f;
#pragma unroll
                for (int ks = 0; ks < 2; ++ks) bq[h][ks] = *(const bf16x8*)(qrow + C_QI + h * 64 + 32 * ks + 8 * g); }
            for (int k0 = 16 * wv; k0 < cend; k0 += 128) {
                const bf16* krow = Pb + (size_t)(k0 + l15) * NP + C_KI + 8 * g;
                const bf16x8 ka0 = *(const bf16x8*)krow, ka1 = *(const bf16x8*)(krow + 32);
                f32x4 sc = {0.f, 0.f, 0.f, 0.f};
#pragma unroll
                for (int h = 0; h < 4; ++h) { f32x4 a = {0.f, 0.f, 0.f, 0.f};
                    a = __builtin_amdgcn_mfma_f32_16x16x32_bf16(ka0, bq[h][0], a, 0, 0, 0);
                    a = __builtin_amdgcn_mfma_f32_16x16x32_bf16(ka1, bq[h][1], a, 0, 0, 0);
#pragma unroll
                    for (int r = 0; r < 4; ++r) sc[r] = fmaf(fmaxf(a[r], 0.f), wsc[h], sc[r]); }
#pragma unroll
                for (int r = 0; r < 4; ++r) sc[r] = (sc[r] == 0.f) ? 0.f : sc[r];
                *(LAS f32x4*)(ldsl + l15 * DSA_SROW + (k0 + 4 * g) * 4) = sc;
            }
        }
        __syncthreads();
        LAS unsigned short* selw = (LAS unsigned short*)(ldsl + DSA_SEL_OFF);
        int mind0 = 0, mind1 = 0;
        if (c < 4) {
            for (int j = lane; j < 256; j += 64) { selw[(2 * wv) * 256 + j] = (unsigned short)j; selw[(2 * wv + 1) * 256 + j] = (unsigned short)j; }
        } else {
            const int nreg = cend >> 6;
            unsigned keyA[32], keyB[32];
            { const LAS float* srA = (const LAS float*)(ldsl + (2 * wv) * DSA_SROW) + lane; const LAS float* srB = (const LAS float*)(ldsl + (2 * wv + 1) * DSA_SROW) + lane;
#pragma unroll
              for (int i = 0; i < 32; ++i) { keyA[i] = (i < nreg) ? sortkey(srA[64 * i]) : 0u; keyB[i] = (i < nreg) ? sortkey(srB[64 * i]) : 0u; } }
#define DSA_WSUM(V, OUT) do { int v_ = (V); v_ += __builtin_amdgcn_update_dpp(0, v_, 0x128, 0xf, 0xf, false); v_ += __builtin_amdgcn_update_dpp(0, v_, 0x124, 0xf, 0xf, false); \
        v_ += __builtin_amdgcn_update_dpp(0, v_, 0x122, 0xf, 0xf, false); v_ += __builtin_amdgcn_update_dpp(0, v_, 0x121, 0xf, 0xf, false);                                     \
        OUT = __builtin_amdgcn_readlane(v_, 0) + __builtin_amdgcn_readlane(v_, 16) + __builtin_amdgcn_readlane(v_, 32) + __builtin_amdgcn_readlane(v_, 48); } while (0)
            unsigned prefA = 0u, prefB = 0u; bool exA = false, exB = false;
#pragma unroll 1
            for (int bit = 31; bit >= 0; --bit) {
                const unsigned candA = exA ? prefA : (prefA | (1u << bit)), candB = exB ? prefB : (prefB | (1u << bit));
                int ca = 0, cb = 0;
#pragma unroll
                for (int i = 0; i < 32; ++i) { ca += (keyA[i] >= candA) ? 1 : 0; cb += (keyB[i] >= candB) ? 1 : 0; }
                int cntA, cntB; DSA_WSUM(ca, cntA); DSA_WSUM(cb, cntB);
                if (!exA && cntA >= 256) { prefA = candA; exA = (cntA == 256); }
                if (!exB && cntB >= 256) { prefB = candB; exB = (cntB == 256); }
                if (exA && exB) break;
            }
#define DSA_COMPACT(KEY, PREFIX, EXACT, QQ, MIND) do {                                                                                              \
            const int t_ = t0 + (QQ); LAS unsigned short* sel = selw + (QQ) * 256;                                                                    \
            int need_ties = 0;                                                                                                                        \
            if (!(EXACT)) { int cg_ = 0; if ((PREFIX) != 0xffffffffu) { _Pragma("unroll") for (int i = 0; i < 32; ++i) cg_ += (KEY[i] > (PREFIX)) ? 1 : 0; } \
                int cgt; DSA_WSUM(cg_, cgt); need_ties = 256 - cgt; }                                                                                 \
            int base = 0, tbase = 0, md = 4096;                                                                                                       \
            _Pragma("unroll") for (int i = 0; i < 32; ++i) { if (i < nreg) {                                                                          \
                bool selb;                                                                                                                            \
                if (EXACT) selb = KEY[i] >= (PREFIX);                                                                                                 \
                else { const bool tie = KEY[i] == (PREFIX); const unsigned long long mt = __ballot(tie);                                              \
                    const int trank = tbase + (int)__builtin_amdgcn_mbcnt_hi((unsigned)(mt >> 32), __builtin_amdgcn_mbcnt_lo((unsigned)mt, 0u));      \
                    selb = (KEY[i] > (PREFIX)) || (tie && trank < need_ties); tbase += __popcll(mt); }                                                \
                const unsigned long long m = __ballot(selb);                                                                                          \
                const int pos = base + (int)__builtin_amdgcn_mbcnt_hi((unsigned)(m >> 32), __builtin_amdgcn_mbcnt_lo((unsigned)m, 0u));               \
                const int kidx = i * 64 + lane;                                                                                                       \
                if (selb) { sel[pos] = (unsigned short)kidx; const int d = t_ > kidx ? t_ - kidx : kidx - t_; md = d < md ? d : md; }                 \
                base += __popcll(m); } }                                                                                                              \
            _Pragma("unroll") for (int o = 1; o < 64; o <<= 1) { const int x = __shfl_xor(md, o); md = x < md ? x : md; }                             \
            MIND = md; } while (0)
            DSA_COMPACT(keyA, prefA, exA, 2 * wv, mind0);
            DSA_COMPACT(keyB, prefB, exB, 2 * wv + 1, mind1);
#undef DSA_COMPACT
#undef DSA_WSUM
        }
        LDS_WAIT(); asm volatile("" ::: "memory");
        const int nvalid = cend < 256 ? cend : 256;
        const int head = lane & 7;
        const float slopeL2 = exp2f(-(float)(head + 1)) * 1.4426950409f;
#pragma unroll 1
        for (int qi2 = 0; qi2 < 2 * DSA_REP_C; ++qi2) { const int qi = qi2 & 1;
            const int qq = 2 * wv + qi, t = t0 + qq;
            const LAS unsigned short* sel = selw + qq * 256;
            LAS unsigned char* stg = ldsl + (2 * wv) * DSA_SROW;
            const bf16* qrow = Pb + (size_t)t * NP + C_QB + head * 128 + 8 * g;
            bf16x8 bq[4];
#pragma unroll
            for (int ks = 0; ks < 4; ++ks) bq[ks] = *(const bf16x8*)(qrow + 32 * ks);
            const float refL2 = MB * 1.4426950409f - slopeL2 * (float)(qi == 0 ? mind0 : mind1);
            f32x4 o[8];
#pragma unroll
            for (int dt = 0; dt < 8; ++dt) o[dt] = (f32x4){0.f, 0.f, 0.f, 0.f};
            float lsum = 0.f;
#define DSA_GATHER(S, KA) do { _Pragma("unroll") for (int i_ = 0; i_ < 8; ++i_) { const int jr = 32 * (S) + 4 * i_ + g; const int keyr = sel[jr < nvalid ? jr : 0];   \
        KA[i_] = *(const bf16x8*)(KVb + (size_t)keyr * 128 + 8 * l15); } } while (0)
#define DSA_COMPUTE(S, KA) do { unsigned pb[4];                                                                                                        \
        _Pragma("unroll") for (int i_ = 0; i_ < 8; ++i_) *(LAS bf16x8*)(stg + (4 * i_ + g) * DSA_KVROW + 16 * l15) = KA[i_];                              \
        LDS_WAIT(); asm volatile("" ::: "memory");                                                                                                        \
        _Pragma("unroll") for (int tl = 0; tl < 2; ++tl) { const int j0 = 32 * (S) + 16 * tl;                                                           \
            f32x4 a = {0.f, 0.f, 0.f, 0.f};                                                                                                             \
            _Pragma("unroll") for (int ks = 0; ks < 4; ++ks) { const bf16x8 ka_ = *(const LAS bf16x8*)(stg + (16 * tl + l15) * DSA_KVROW + (32 * ks + 8 * g) * 2); \
                a = __builtin_amdgcn_mfma_f32_16x16x32_bf16(ka_, bq[ks], a, 0, 0, 0); }                                                                 \
            const u32x2 kw = *(const LAS u32x2*)(sel + j0 + 4 * g);                                                                                     \
            const int kx[4] = {(int)(kw.x & 0xffffu), (int)(kw.x >> 16), (int)(kw.y & 0xffffu), (int)(kw.y >> 16)};                                     \
            float pr[4];                                                                                                                                \
            _Pragma("unroll") for (int r = 0; r < 4; ++r) { const int dd = t > kx[r] ? t - kx[r] : kx[r] - t;                                            \
                const float e = __builtin_amdgcn_exp2f(fmaf(a[r], 0.1275174f, -slopeL2 * (float)dd - refL2));                                            \
                pr[r] = (j0 + 4 * g + r < nvalid) ? e : 0.f; lsum += pr[r]; }                                                                           \
            pb[2 * tl] = cvtpk_bf16(pr[0], pr[1]); pb[2 * tl + 1] = cvtpk_bf16(pr[2], pr[3]); }                                                         \
        LDS_WAIT(); asm volatile("" ::: "memory");                                                                                                      \
        u32x4 pw4; pw4.x = pb[0]; pw4.y = pb[1]; pw4.z = pb[2]; pw4.w = pb[3];                                                                          \
        const bf16x8 pfrag = __builtin_bit_cast(bf16x8, pw4);                                                                                           \
        const LAS unsigned char* trb = stg + (4 * g + (l15 >> 2)) * DSA_KVROW + (4 * (lane & 3)) * 2;                                                   \
        _Pragma("unroll") for (int dt = 0; dt < 8; ++dt) {                                                                                              \
            const s16x4 lo = __builtin_bit_cast(s16x4, __builtin_amdgcn_ds_read_tr16_b64_v4i16((LAS v4i16_t*)(trb + dt * 32)));                         \
            const s16x4 hi = __builtin_bit_cast(s16x4, __builtin_amdgcn_ds_read_tr16_b64_v4i16((LAS v4i16_t*)(trb + 16 * DSA_KVROW + dt * 32)));        \
            const bf16x8 af = {lo[0], lo[1], lo[2], lo[3], hi[0], hi[1], hi[2], hi[3]};                                                                 \
            o[dt] = __builtin_amdgcn_mfma_f32_16x16x32_bf16(af, pfrag, o[dt], 0, 0, 0); }                                                               \
        LDS_WAIT(); asm volatile("" ::: "memory"); } while (0)
            const int nch = (nvalid + 31) >> 5;
            bf16x8 KA[8], KB[8];
            DSA_GATHER(0, KA);
#pragma unroll 1
            for (int s = 0; s < nch; s += 2) {
                if (s + 1 < nch) DSA_GATHER(s + 1, KB);
                DSA_COMPUTE(s, KA);
                if (s + 1 < nch) { if (s + 2 < nch) DSA_GATHER(s + 2, KA); DSA_COMPUTE(s + 1, KB); }
            }
#undef DSA_GATHER
#undef DSA_COMPUTE
            lsum += __shfl_xor(lsum, 16); lsum += __shfl_xor(lsum, 32);
            const float il = 1.f / lsum;
            if (l15 < 8) {
                bf16* orow = MIX + (size_t)(b * SEQ + t) * MIXW + 512 + head * 128 + 4 * g;
#pragma unroll
                for (int dt = 0; dt < 8; ++dt) { u32x2 w; w.x = pk2(o[dt][0] * il, o[dt][1] * il); w.y = pk2(o[dt][2] * il, o[dt][3] * il); *(u32x2*)(orow + 16 * dt) = w; }
            }
        }
        __syncthreads();
    }
}
typedef __attribute__((address_space(1))) float GASF;
#ifndef ATT_PROBE
#define ATT_PROBE 0
#endif
#ifndef ATT_REMAP
#define ATT_REMAP 1
#endif
__device__ __forceinline__ int crow(int r, int hi) { return (r & 3) + 8 * (r >> 2) + 4 * hi; }
#define KSWZ64(row, cb) ((row) * 128 + ((cb) ^ ((((row) >> 1) & 7) << 4)))
__device__ __forceinline__ int v_st(int k, int c) { const int kk = (k & ~0xC) | ((k & 4) << 1) | ((k & 8) >> 1); return ((kk >> 3) * 4 + (c >> 5)) * 512 + ((kk & 7) * 32 + (c & 31)) * 2; }
__device__ __forceinline__ int v_rd_base(int lane) { return ((lane & 3) << 3) | (((lane >> 2) & 3) << 6) | (((lane >> 4) & 1) << 5) | (((lane >> 5) & 1) << 8); }
constexpr int v_rd_off(int d0, int ks, int half) { return d0 * 512 + ks * 4096 + half * 2048; }
template <int OFF> __device__ __forceinline__ s16x4 tr_read(int vb) {
    s16x4 r; asm volatile("ds_read_b64_tr_b16 %0, %1 offset:%2" : "=&v"(r) : "v"(vb), "i"(OFF) : "memory"); return r;
}
template <int D0> __device__ __forceinline__ void pv_one(f32x16& od, int vb, bf16x8 pa0, bf16x8 pa1, bf16x8 pa2, bf16x8 pa3) {
    const s16x4 l0 = tr_read<v_rd_off(D0, 0, 0)>(vb), h0 = tr_read<v_rd_off(D0, 0, 1)>(vb), l1 = tr_read<v_rd_off(D0, 1, 0)>(vb), h1 = tr_read<v_rd_off(D0, 1, 1)>(vb);
    const s16x4 l2 = tr_read<v_rd_off(D0, 2, 0)>(vb), h2 = tr_read<v_rd_off(D0, 2, 1)>(vb), l3 = tr_read<v_rd_off(D0, 3, 0)>(vb), h3 = tr_read<v_rd_off(D0, 3, 1)>(vb);
    asm volatile("s_waitcnt lgkmcnt(0)" ::: "memory"); __builtin_amdgcn_sched_barrier(0);
#define PK(L, H) (bf16x8){L[0], L[1], L[2], L[3], H[0], H[1], H[2], H[3]}
    od = __builtin_amdgcn_mfma_f32_32x32x16_bf16(pa0, PK(l0, h0), od, 0, 0, 0);
    od = __builtin_amdgcn_mfma_f32_32x32x16_bf16(pa1, PK(l1, h1), od, 0, 0, 0);
    od = __builtin_amdgcn_mfma_f32_32x32x16_bf16(pa2, PK(l2, h2), od, 0, 0, 0);
    od = __builtin_amdgcn_mfma_f32_32x32x16_bf16(pa3, PK(l3, h3), od, 0, 0, 0);
#undef PK
}

__device__ __forceinline__ void att_tile(f32x16 (&o)[4], float& lsum, const unsigned char* Kb, int vb0, const unsigned char* Qw, int r32, int hi, int tq, int j, bool past, float slopeL2, float refL2) {
    constexpr float C = 0.125f * 1.4426950409f;
    bf16x8 qr[4];
#pragma unroll
    for (int d0 = 0; d0 < 4; ++d0) qr[d0] = *(const bf16x8*)(Qw + KSWZ64(r32, (d0 * 16 + hi * 8) * 2));
    const float dq = (float)(tq - 64 * j - 4 * hi);
    const float B0 = -slopeL2 * dq - refL2;
    float ps = 0.f;
    bf16x8 pa0, pa1, pa2, pa3;
#define PK4(P, BASE, OUT) do { unsigned a0 = cvtpk_bf16(P[BASE + 0], P[BASE + 1]), a1 = cvtpk_bf16(P[BASE + 2], P[BASE + 3]);   \
    unsigned b0_ = cvtpk_bf16(P[BASE + 4], P[BASE + 5]), b1_ = cvtpk_bf16(P[BASE + 6], P[BASE + 7]);                              \
    auto r0 = __builtin_amdgcn_permlane32_swap(a0, b0_, false, false); auto r1 = __builtin_amdgcn_permlane32_swap(a1, b1_, false, false); \
    u32x4 w = {r0[0], r1[0], r0[1], r1[1]}; OUT = __builtin_bit_cast(bf16x8, w); } while (0)
#define HALF_TILE(KOFF, FOFF, PA, PB) do { f32x16 pp = f32x16{};                                                                     \
    _Pragma("unroll") for (int d0 = 0; d0 < 4; ++d0) { const int cb = (d0 * 16 + hi * 8) * 2;                                        \
        const bf16x8 bk = *(const bf16x8*)(Kb + KSWZ64((KOFF) + r32, cb)); pp = __builtin_amdgcn_mfma_f32_32x32x16_bf16(bk, qr[d0], pp, 0, 0, 0); } \
    if (past) { _Pragma("unroll") for (int r = 0; r < 16; ++r) { const float off = (float)((r & 3) + 8 * (r >> 2)) + (FOFF);          \
            pp[r] = __builtin_amdgcn_exp2f(fmaf(pp[r], C, fmaf(slopeL2, off, B0))); } }                                               \
    else { _Pragma("unroll") for (int r = 0; r < 16; ++r) { const float off = (float)((r & 3) + 8 * (r >> 2)) + (FOFF);               \
            pp[r] = __builtin_amdgcn_exp2f(fmaf(pp[r], C, -slopeL2 * fabsf(dq - off) - refL2)); } }                                   \
    _Pragma("unroll") for (int r = 0; r < 16; ++r) ps += pp[r];                                                                       \
    PK4(pp, 0, PA); PK4(pp, 8, PB); __builtin_amdgcn_sched_barrier(0); } while (0)
    HALF_TILE(0, 0.f, pa0, pa1);
    HALF_TILE(32, 32.f, pa2, pa3);
#undef HALF_TILE
#undef PK4
    { auto rr = __builtin_amdgcn_permlane32_swap(__float_as_uint(ps), __float_as_uint(ps), false, false);
      ps = __uint_as_float(rr[0]) + __uint_as_float(rr[1]); }
    lsum += ps;
    pv_one<0>(o[0], vb0, pa0, pa1, pa2, pa3); pv_one<1>(o[1], vb0, pa0, pa1, pa2, pa3); pv_one<2>(o[2], vb0, pa0, pa1, pa2, pa3); pv_one<3>(o[3], vb0, pa0, pa1, pa2, pa3);
}
constexpr int ATT_LDS = 2 * 16384 + 2 * 8192 + 8 * 256 + 8 * 4096;

__device__ __forceinline__ void ph_attnA(const Params& p, unsigned char* lds, int vb, int nvb) {
    const bf16* PROJ = (const bf16*)(p.ws + WS_PROJ); bf16* MIX = (bf16*)(p.ws + WS_MIX);
    const float* SC = (const float*)(p.ws + WS_SCAL);
    const float lam = SC[SC_LAM], refL2 = SC[SC_MA] * 1.4426950409f;
    constexpr float C = 0.125f * 1.4426950409f;
    int tid = threadIdx.x; asm volatile("" : "+v"(tid)); const int lane = tid & 63, wid = __builtin_amdgcn_readfirstlane(tid >> 6), r32 = lane & 31, hi = lane >> 5;
    unsigned char* V_lds = lds; unsigned char* K_lds = lds + 32768;
    float* wsf = (float*)(lds + 49152) + wid * 64;
    GASF* tmpw = (GASF*)(p.ws + WS_ATMP) + ((size_t)(vb * NWV + wid) * 64) * 64 + lane;
    const int vbase = (int)(uintptr_t)V_lds + v_rd_base(lane);
    const int krow = tid >> 3, kch = tid & 7, kdst = KSWZ64(krow, kch * 16);
    const int sr = tid >> 4, sc = (tid & 15) * 8, vst0 = v_st(sr, sc), vst1 = v_st(32 + sr, sc);
    for (int it = vb; it < 256; it += nvb) {
        #if ATT_REMAP
        const int xg_ = it & 7, m_ = it >> 3, pidx = xg_ * 8 + (m_ >> 2), qbl = m_ & 3, b = pidx >> 2, h = pidx & 3;
#else
        const int b = it >> 4, h = (it >> 2) & 3, qbl = it & 3;
#endif
        const float slopeL2 = exp2f(-2.0f * (float)(h + 1)) * 1.4426950409f;
        const bf16* Pb = PROJ + (size_t)b * SEQ * NP;
#pragma unroll 1
        for (int half = 0; half < 2; ++half) {
            const int qb = half ? 7 - qbl : qbl, q0 = 256 * qb, NTu = 4 * (qb + 1), cw = 4 * qb + (wid >> 1);
            const int tq = q0 + 32 * wid + r32;
#pragma unroll 1
            for (int mi = 0; mi < 2; ++mi) {
                const int m = 1 - mi;
                const bf16* Kg = Pb + C_KA + h * 128 + m * 64 + (size_t)krow * NP + kch * 8;
                const bf16* Vg = Pb + C_VA + h * 128 + (size_t)sr * NP + sc;
                unsigned char* Qw = lds + 51200 + wid * 4096;
                { const bf16* qp = Pb + (size_t)tq * NP + C_QA + h * 128 + m * 64 + hi * 8;
#pragma unroll
                  for (int d0 = 0; d0 < 4; ++d0) *(bf16x8*)(Qw + KSWZ64(r32, (d0 * 16 + hi * 8) * 2)) = *(const bf16x8*)(qp + d0 * 16); }
                f32x16 o[4];
#pragma unroll
                for (int d = 0; d < 4; ++d) o[d] = f32x16{};
                float lsum = 0.f;
                bf16x8 ak, av0, av1;
#define ATT_LOAD(K_, V0_, V1_, TJ) do { const size_t go_ = (size_t)(TJ) * 64 * NP; K_ = *(const bf16x8*)(Kg + go_); V0_ = *(const bf16x8*)(Vg + go_); V1_ = *(const bf16x8*)(Vg + go_ + (size_t)32 * NP); \
        if (ATT_PROBE == 2) { bf16x8 d0_ = *(const volatile bf16x8*)(Kg + go_); bf16x8 d1_ = *(const volatile bf16x8*)(Vg + go_); bf16x8 d2_ = *(const volatile bf16x8*)(Vg + go_ + (size_t)32 * NP); asm volatile("" :: "v"(d0_), "v"(d1_), "v"(d2_)); } } while (0)
#define ATT_WRITE(K_, V0_, V1_, NB) do { *(bf16x8*)(K_lds + (NB) * 8192 + kdst) = K_; *(bf16x8*)(V_lds + (NB) * 16384 + vst0) = V0_; *(bf16x8*)(V_lds + (NB) * 16384 + vst1) = V1_; } while (0)
                ATT_LOAD(ak, av0, av1, 0); ATT_WRITE(ak, av0, av1, 0);
                __syncthreads();
#pragma unroll 1
                for (int j = 0; j < NTu; ++j) {
                    const int buf = j & 1;
                    if (j + 1 < NTu) ATT_LOAD(ak, av0, av1, j + 1);
                    if (j <= cw) { att_tile(o, lsum, K_lds + buf * 8192, vbase + buf * 16384, Qw, r32, hi, tq, j, j < cw, slopeL2, refL2);
#if ATT_PROBE == 1
                        { f32x16 o2[4]; o2[0] = o[0]; o2[1] = o[1]; o2[2] = o[2]; o2[3] = o[3]; float l2 = 0.f; att_tile(o2, l2, K_lds + buf * 8192, vbase + buf * 16384, Qw, r32, hi, tq, j, j < cw, slopeL2, refL2);
                          asm volatile("" :: "v"(o2[0]), "v"(o2[1]), "v"(o2[2]), "v"(o2[3]), "v"(l2)); }
#endif
                    }
                    if (j + 1 < NTu) ATT_WRITE(ak, av0, av1, buf ^ 1);
                    __syncthreads();
                }
#undef ATT_LOAD
#undef ATT_WRITE
                if (hi == 0) wsf[r32] = lsum;
                LDS_WAIT(); asm volatile("" ::: "memory");
                float rli[16];
#pragma unroll
                for (int r = 0; r < 16; ++r) rli[r] = 1.f / wsf[crow(r, hi)];
                LDS_WAIT(); asm volatile("" ::: "memory");
                if (mi == 0) {
#pragma unroll
                    for (int d = 0; d < 4; ++d) { GASF* td = tmpw + d * 1024; asm volatile("" : "+v"(td));
#pragma unroll
                        for (int r = 0; r < 16; ++r) td[r * 64] = o[d][r] * rli[r]; }
                } else {
                    float gsub[4];
#pragma unroll
                    for (int d = 0; d < 4; ++d) gsub[d] = p.a_sub_gain[32 * d + r32];
                    GASF* tdp[4];
#pragma unroll
                    for (int d = 0; d < 4; ++d) { tdp[d] = tmpw + d * 1024; asm volatile("" : "+v"(tdp[d])); }
#pragma unroll
                    for (int r = 0; r < 16; ++r) {
                        float v[4]; float ss = 0.f;
#pragma unroll
                        for (int d = 0; d < 4; ++d) { v[d] = o[d][r] * rli[r] - lam * tdp[d][r * 64]; ss += v[d] * v[d]; }
                        ss += __shfl_xor(ss, 1); ss += __shfl_xor(ss, 2); ss += __shfl_xor(ss, 4); ss += __shfl_xor(ss, 8); ss += __shfl_xor(ss, 16);
                        const float rs = rsqrtf(ss * (1.f / 128.f) + EPS) * 0.8f;
                        bf16* orow = MIX + (size_t)(b * SEQ + q0 + 32 * wid + crow(r, hi)) * MIXW + h * 128 + r32;
#pragma unroll
                        for (int d = 0; d < 4; ++d) orow[32 * d] = (bf16)f2bf(v[d] * rs * gsub[d]);
                        asm volatile("" ::: "memory");
                    }
                }
            }
        }
    }
}
constexpr int RT_WAVE_BYTES = 12288;
constexpr int RT_LDS = 32768 + 8 * RT_WAVE_BYTES;

__device__ __forceinline__ int pl32_sum(int v) { auto rr = __builtin_amdgcn_permlane32_swap((unsigned)v, (unsigned)v, false, false); return (int)(rr[0] + rr[1]); }
__device__ __forceinline__ int pl32_other(int v) { auto rr = __builtin_amdgcn_permlane32_swap((unsigned)v, (unsigned)v, false, false); return (int)(rr[0] + rr[1]) - v; }
__device__ __forceinline__ float unsortkey(unsigned k) { return __uint_as_float((k & 0x80000000u) ? (k ^ 0x80000000u) : ~k); }

template <int N> __device__ __forceinline__ unsigned bisect16(const unsigned (&key)[N]) {
    unsigned prefix = 0u; bool done = false;
#pragma unroll 1
    for (int bit = 31; bit >= 0; --bit) {
        const unsigned cand = done ? prefix : (prefix | (1u << bit));
        int cnt = 0;
#pragma unroll
        for (int i = 0; i < N; ++i) cnt += (key[i] >= cand) ? 1 : 0;
        const int tot = pl32_sum(cnt);
        if (!done && tot >= 16) { prefix = cand; done = (tot == 16); }
        if (__all(done)) break;
    }
    return prefix;
}

__device__ __forceinline__ void ph_route(const Params& p, unsigned char* lds, int vb, int nvb) {
    const bf16* Q3 = (const bf16*)(p.ws + WS_Q3); const bf16* SUBK = (const bf16*)(p.ws + WS_SUBK);
    int* EXPI = (int*)(p.ws + WS_EXP); float* GATE = (float*)(p.ws + WS_GATE);
    int tid = threadIdx.x; asm volatile("" : "+v"(tid));
    const int lane = tid & 63, wv = __builtin_amdgcn_readfirstlane(tid >> 6), r32 = lane & 31, hi = lane >> 5;
    for (int i = tid; i < 2048; i += NT) { const int row = i >> 3, ch = i & 7; ((u32x4*)lds)[row * 8 + (ch ^ ((row >> 1) & 7))] = ((const u32x4*)SUBK)[i]; }
    __syncthreads();
    unsigned char* wl = lds + 32768 + wv * RT_WAVE_BYTES;
    float* sv = (float*)wl; int* si = (int*)(wl + 4096); float* fv = (float*)(wl + 8192); int* fe = (int*)(wl + 10240);
    const int gw = vb * NWV + wv, ngw = nvb * NWV;
    for (int item = gw; item < (T / 32) * 8; item += ngw) {
        const int h = item & 7, tok0 = (item >> 3) * 32;
        const bf16* qrow = Q3 + (size_t)(tok0 + r32) * 1024 + h * 128 + hi * 8;
#pragma unroll 1
        for (int c = 0; c < 2; ++c) {
            bf16x8 bq[4];
#pragma unroll
            for (int d0 = 0; d0 < 4; ++d0) bq[d0] = *(const bf16x8*)(qrow + c * 64 + d0 * 16);
            unsigned key[64];
#pragma unroll
            for (int nt = 0; nt < 4; ++nt) {
                f32x16 acc = f32x16{};
                const int krow = c * 128 + nt * 32 + r32, ksw = (krow >> 1) & 7;
                const unsigned char* kp = lds + krow * 128;
#pragma unroll
                for (int d0 = 0; d0 < 4; ++d0) { const bf16x8 ak = *(const bf16x8*)(kp + (((2 * d0 + hi) ^ ksw) << 4)); acc = __builtin_amdgcn_mfma_f32_32x32x16_bf16(ak, bq[d0], acc, 0, 0, 0); }
#pragma unroll
                for (int r = 0; r < 16; ++r) key[nt * 16 + r] = sortkey(acc[r]);
            }
            const unsigned thr = bisect16<64>(key);
            int cnt = 0;
#pragma unroll
            for (int i = 0; i < 64; ++i) cnt += (key[i] >= thr) ? 1 : 0;
            const int other_ = pl32_other(cnt); int slot = hi ? other_ : 0;
            float* svp = sv + (r32 * 2 + c) * 16; int* sip = si + (r32 * 2 + c) * 16;
#pragma unroll
            for (int i = 0; i < 64; ++i) {
                if (key[i] >= thr && slot < 16) { svp[slot] = unsortkey(key[i]); sip[slot] = 32 * (i >> 4) + ((i & 3) + 8 * ((i & 15) >> 2)) + 4 * hi; ++slot; }
            }
        }
        LDS_WAIT(); asm volatile("" ::: "memory");
        {
            float* sv0 = sv + (r32 * 2) * 16; float* sv1 = sv0 + 16; int* si0 = si + (r32 * 2) * 16; int* si1 = si0 + 16;
            {
                float a[16], bl[16];
#pragma unroll
                for (int k = 0; k < 16; ++k) { a[k] = sv0[k]; bl[k] = sv1[k]; }
                int ia[8], ib[8], ra[8], rb[8]; float va[8], vb[8];
#pragma unroll
                for (int q = 0; q < 8; ++q) { const int e = 8 * hi + q; va[q] = sv0[e]; vb[q] = sv1[e]; ia[q] = si0[e]; ib[q] = si1[e]; int r0 = 0, r1 = 0;
#pragma unroll
                    for (int k = 0; k < 16; ++k) { r0 += (a[k] > va[q] || (a[k] == va[q] && k < e)) ? 1 : 0; r1 += (bl[k] > vb[q] || (bl[k] == vb[q] && k < e)) ? 1 : 0; }
                    ra[q] = r0; rb[q] = r1; }
                LDS_WAIT(); asm volatile("" ::: "memory");
                { auto rr = __builtin_amdgcn_permlane32_swap(0u, 0u, false, false); (void)rr; }
#pragma unroll
                for (int q = 0; q < 8; ++q) { sv0[ra[q]] = va[q]; si0[ra[q]] = ia[q]; sv1[rb[q]] = vb[q]; si1[rb[q]] = ib[q]; }
                LDS_WAIT(); asm volatile("" ::: "memory");
            }
            const float* X = hi ? sv1 : sv0; const float* Y = hi ? sv0 : sv1;
            float x[4], y[16];
#pragma unroll
            for (int k = 0; k < 4; ++k) x[k] = X[k];
#pragma unroll
            for (int k = 0; k < 16; ++k) y[k] = Y[k];
            unsigned key[27]; int pi[27], pj[27]; int np = 0;
#pragma unroll
            for (int i = 0; i < 3; ++i)
#pragma unroll
                for (int j = i + 1; j < 16; ++j) if ((i + 1) * (j + 1) <= 16) { key[np] = sortkey(x[i] + y[j]); pi[np] = i; pj[np] = j; ++np; }
#pragma unroll
            for (int i = 0; i < 4; ++i) { key[23 + i] = hi ? 0u : sortkey(x[i] + y[i]); pi[23 + i] = i; pj[23 + i] = i; }
            const unsigned thr = bisect16<27>(key);
            int cnt = 0;
#pragma unroll
            for (int i = 0; i < 27; ++i) cnt += (key[i] >= thr) ? 1 : 0;
            const int other_ = pl32_other(cnt); int slot = hi ? other_ : 0;
            const int* IX = hi ? si1 : si0; const int* IY = hi ? si0 : si1;
            float* fvp = fv + r32 * 16; int* fep = fe + r32 * 16;
#pragma unroll
            for (int i = 0; i < 27; ++i) {
                if (key[i] >= thr && slot < 16) { const int ex = IX[pi[i]], ey = IY[pj[i]]; fvp[slot] = unsortkey(key[i]); fep[slot] = hi ? (ey * 128 + ex) : (ex * 128 + ey); ++slot; }
            }
        }
        LDS_WAIT(); asm volatile("" ::: "memory");
        {
            const float* fvp = fv + r32 * 16;
            float v[16]; float mx = -3e38f;
#pragma unroll
            for (int k = 0; k < 16; ++k) { v[k] = fvp[k]; mx = fmaxf(mx, v[k]); }
            float l = 0.f;
#pragma unroll
            for (int k = 0; k < 16; ++k) { v[k] = __expf(v[k] - mx); l += v[k]; }
            const float il = 1.f / l;
            const size_t ob = (size_t)(tok0 + r32) * 128 + h * 16 + 8 * hi;
            const int* fep = fe + r32 * 16 + 8 * hi;
            f32x4 g0, g1; u32x4 e0, e1;
            if (hi == 0) { g0 = (f32x4){v[0] * il, v[1] * il, v[2] * il, v[3] * il}; g1 = (f32x4){v[4] * il, v[5] * il, v[6] * il, v[7] * il}; }
            else { g0 = (f32x4){v[8] * il, v[9] * il, v[10] * il, v[11] * il}; g1 = (f32x4){v[12] * il, v[13] * il, v[14] * il, v[15] * il}; }
            e0 = *(const u32x4*)fep; e1 = *(const u32x4*)(fep + 4);
            *(f32x4*)(GATE + ob) = g0; *(f32x4*)(GATE + ob + 4) = g1;
            *(u32x4*)(EXPI + ob) = e0; *(u32x4*)(EXPI + ob + 4) = e1;
        }
        LDS_WAIT(); asm volatile("" ::: "memory");
    }
    __syncthreads();
}
typedef float f32x2_t __attribute__((ext_vector_type(2)));
constexpr int P8_UNITS = T / 64;
constexpr int CW_P8_U = 4096, CW_P8_V = 4096 + 32 * 64;
constexpr float U8_SCALE = 32.0f;
__device__ __forceinline__ unsigned peer_xcc() { return (unsigned)__builtin_amdgcn_s_getreg((3 << 11) | 20) & 7u; }
template <int LPR>
__device__ __forceinline__ void ph_peer_v8g(const Params& p, unsigned char* lds) {
    constexpr int RPI = 64 / LPR, NI = 128 / RPI, G = NI / 8, NS = 64 / LPR, SLB = 16 * LPR;
    const unsigned char* V8 = (const unsigned char*)(p.ws + WS_V16);
    const int* EXPI = (const int*)(p.ws + WS_EXP); const float* CBUF = (const float*)(p.ws + WS_CBUF); const float* MOD = (const float*)(p.ws + WS_MOD);
    unsigned* ctl = (unsigned*)(p.ws + WS_CTL);
    int tid = threadIdx.x; asm volatile("" : "+v"(tid));
    const int lane = tid & 63, wv = __builtin_amdgcn_readfirstlane(tid >> 6), gR = lane / LPR, iC = lane % LPR;
    volatile LAS unsigned* slot = (volatile LAS unsigned*)(LAS unsigned char*)lds;
    const unsigned xcc = peer_xcc();
#pragma unroll 1
    for (int k = 0; k < NS; ++k) {
        const int sl = (int)((((xcc * NS) >> 3) + (unsigned)k) % (unsigned)NS);
        const unsigned char* vcol = V8 + SLB * sl + 16 * iC;
#pragma unroll 1
        for (;;) {
            if (tid == 0) *slot = __hip_atomic_fetch_add(ctl + CW_P8_V + 64 * sl, 1u, __ATOMIC_RELAXED, __HIP_MEMORY_SCOPE_AGENT);
            __syncthreads();
            const unsigned unit = *slot;
            __syncthreads();
            if (unit >= (unsigned)P8_UNITS) break;
            const int tbase = (int)unit * 64 + wv * 8;
            int ne0, ne1; float nc0, nc1;
#define VG_FETCH(T) do { const size_t tn_ = (size_t)(T); ne0 = EXPI[tn_ * 128 + lane]; ne1 = EXPI[tn_ * 128 + 64 + lane]; nc0 = CBUF[tn_ * 128 + lane]; nc1 = CBUF[tn_ * 128 + 64 + lane]; } while (0)
#define VG_LISTS(LE, LC) do { LE[lane] = ne0; LE[64 + lane] = ne1; LC[lane] = nc0; LC[64 + lane] = nc1; } while (0)
#define VG_ROWS(R, LE, GI) do { _Pragma("unroll") for (int kk = 0; kk < 8; ++kk) R[kk] = *(const u32x4*)(vcol + (size_t)LE[RPI * (8 * (GI) + kk) + gR] * 1024); } while (0)
#define VG_GROUP(R, LC, GI) do { _Pragma("unroll") for (int kk = 0; kk < 8; ++kk) { const float cj = LC[RPI * (8 * (GI) + kk) + gR];                       \
            const unsigned w_[4] = {R[kk].x, R[kk].y, R[kk].z, R[kk].w};                                                                       \
            _Pragma("unroll") for (int c = 0; c < 4; ++c) { const f32x2_t lo = __builtin_amdgcn_cvt_pk_f32_fp8((int)w_[c], false), hi = __builtin_amdgcn_cvt_pk_f32_fp8((int)w_[c], true); \
                acc[4 * c] = fmaf(cj, lo.x, acc[4 * c]); acc[4 * c + 1] = fmaf(cj, lo.y, acc[4 * c + 1]); acc[4 * c + 2] = fmaf(cj, hi.x, acc[4 * c + 2]); acc[4 * c + 3] = fmaf(cj, hi.y, acc[4 * c + 3]); } } } while (0)
            u32x4 RA[8], RB[8];
            int* lecur = (int*)(lds + 1024 + wv * 2048); int* lenxt = lecur + 256;
            VG_FETCH(tbase); VG_LISTS(lecur, ((float*)(lecur + 128))); VG_FETCH(tbase + 1);
            LDS_WAIT(); asm volatile("" ::: "memory");
            VG_ROWS(RA, lecur, 0);
#pragma unroll 1
            for (int tt = 0; tt < 8; ++tt) {
                const int t = tbase + tt;
                float* lccur = (float*)(lecur + 128); float* lcnxt = (float*)(lenxt + 128);
                float acc[16];
#pragma unroll
                for (int q = 0; q < 16; ++q) acc[q] = 0.f;
                if (tt + 1 < 8) { VG_LISTS(lenxt, lcnxt); if (tt + 2 < 8) VG_FETCH(t + 2); }
#pragma unroll 1
                for (int gi = 0; gi < G; gi += 2) {
                    VG_ROWS(RB, lecur, gi + 1);
                    VG_GROUP(RA, lccur, gi);
                    if (gi + 2 < G) VG_ROWS(RA, lecur, gi + 2);
                    else if (tt + 1 < 8) { LDS_WAIT(); asm volatile("" ::: "memory"); VG_ROWS(RA, lenxt, 0); }
                    VG_GROUP(RB, lccur, gi + 1);
                }
#pragma unroll
                for (int q = 0; q < 16; ++q) { if (LPR <= 8) acc[q] += dpp_f<0x128>(acc[q]); if (LPR <= 16) acc[q] += __shfl_xor(acc[q], 16); if (LPR <= 32) acc[q] += __shfl_xor(acc[q], 32); }
                if (gR == 0) { const int col = SLB * sl + 16 * iC; const float* g2 = MOD + (size_t)(t >> 11) * 6144 + 5120 + col; float* orow = p.out + (size_t)t * 1024 + col;
#pragma unroll
                    for (int q = 0; q < 4; ++q) { const f32x4 xv = *(const f32x4*)(orow + 4 * q), hv = *(const f32x4*)(g2 + 4 * q);
                        f32x4 r; r.x = acc[4 * q]; r.y = acc[4 * q + 1]; r.z = acc[4 * q + 2]; r.w = acc[4 * q + 3]; *(f32x4*)(orow + 4 * q) = xv + hv * r; } }
                { int* tmp_ = lecur; lecur = lenxt; lenxt = tmp_; }
            }
#undef VG_FETCH
#undef VG_LISTS
#undef VG_ROWS
#undef VG_GROUP
            LDS_WAIT(); asm volatile("" ::: "memory");
        }
    }
}
__device__ __forceinline__ void ph_peer_u8p(const Params& p, unsigned char* lds_w, int gw, int ngw, int lane_) {
    int lane = lane_; asm volatile("" : "+v"(lane));
    const bf16* H = (const bf16*)(p.ws + WS_H); const unsigned char* U8 = (const unsigned char*)(p.ws + WS_U16); const unsigned char* V8 = (const unsigned char*)(p.ws + WS_V16);
    const int* EXPI = (const int*)(p.ws + WS_EXP); const float* GATE = (const float*)(p.ws + WS_GATE); const float* MOD = (const float*)(p.ws + WS_MOD);
    int* e_lds = (int*)lds_w; float* a_lds = (float*)(lds_w + 512);
    const int g = lane >> 4, i = lane & 15;
#pragma unroll 1
    for (int t = gw; t < T; t += ngw) {
        const int e0 = EXPI[(size_t)t * 128 + lane], e1 = EXPI[(size_t)t * 128 + 64 + lane];
        const float g0 = GATE[(size_t)t * 128 + lane], g1 = GATE[(size_t)t * 128 + 64 + lane];
        e_lds[lane] = e0; e_lds[64 + lane] = e1;
        float xf[64];
        { const u32x4* xrow = (const u32x4*)(H + (size_t)t * 1024) + 2 * i;
#pragma unroll
          for (int q = 0; q < 4; ++q) { const u32x4 a = xrow[32 * q], b = xrow[32 * q + 1];
              xf[16 * q] = bflo(a.x); xf[16 * q + 1] = bfhi(a.x); xf[16 * q + 2] = bflo(a.y); xf[16 * q + 3] = bfhi(a.y); xf[16 * q + 4] = bflo(a.z); xf[16 * q + 5] = bfhi(a.z); xf[16 * q + 6] = bflo(a.w); xf[16 * q + 7] = bfhi(a.w);
              xf[16 * q + 8] = bflo(b.x); xf[16 * q + 9] = bfhi(b.x); xf[16 * q + 10] = bflo(b.y); xf[16 * q + 11] = bfhi(b.y); xf[16 * q + 12] = bflo(b.z); xf[16 * q + 13] = bfhi(b.z); xf[16 * q + 14] = bflo(b.w); xf[16 * q + 15] = bfhi(b.w); } }
        LDS_WAIT(); asm volatile("" ::: "memory");
#define P8T_ULOAD(R, S) do { const u32x4* r_ = (const u32x4*)(U8 + (size_t)e_lds[4 * (S) + g] * 1024) + i; _Pragma("unroll") for (int q = 0; q < 4; ++q) R[q] = r_[16 * q]; } while (0)
#define P8T_UDOT(R, S) do { float a0 = 0.f, a1 = 0.f, a2 = 0.f, a3 = 0.f;                                                                               \
        _Pragma("unroll") for (int q = 0; q < 4; ++q) { const unsigned w_[4] = {R[q].x, R[q].y, R[q].z, R[q].w};                                           \
            _Pragma("unroll") for (int c = 0; c < 4; ++c) { const f32x2_t lo = __builtin_amdgcn_cvt_pk_f32_fp8((int)w_[c], false), hi = __builtin_amdgcn_cvt_pk_f32_fp8((int)w_[c], true); \
                a0 = fmaf(lo.x, xf[16 * q + 4 * c], a0); a1 = fmaf(lo.y, xf[16 * q + 4 * c + 1], a1); a2 = fmaf(hi.x, xf[16 * q + 4 * c + 2], a2); a3 = fmaf(hi.y, xf[16 * q + 4 * c + 3], a3); } } \
        const float a_ = row16_sum((a0 + a1) + (a2 + a3)) * (1.0f / U8_SCALE); if (i == 0) a_lds[4 * (S) + g] = a_; } while (0)
        { u32x4 RA[4], RB[4], RC[4];
          P8T_ULOAD(RA, 0); P8T_ULOAD(RB, 1);
#pragma unroll 1
          for (int s = 0; s < 30; s += 3) {
              P8T_ULOAD(RC, s + 2); P8T_UDOT(RA, s);
              P8T_ULOAD(RA, s + 3); P8T_UDOT(RB, s + 1);
              P8T_ULOAD(RB, s + 4); P8T_UDOT(RC, s + 2);
          }
          P8T_UDOT(RA, 30); P8T_UDOT(RB, 31); }
#undef P8T_ULOAD
#undef P8T_UDOT
        LDS_WAIT(); asm volatile("" ::: "memory");
        const float c0 = gelu_erf(a_lds[lane]) * g0, c1 = gelu_erf(a_lds[64 + lane]) * g1;
        float* CB = (float*)(p.ws + WS_CBUF) + (size_t)t * 128; CB[lane] = c0; CB[64 + lane] = c1;
    }
}
#define XB_TMO      128
#define XB_XCNT(j)  (256  + 64 * (j))
#define XB_XSUB(j)  (1280 + 64 * (j))
#define XB_XGEN(j)  (2304 + 64 * (j))
#define XB_TOP      3328
#define XB_TOPGEN   3392
#define XCD_BAR_WORDS 3456
#define XB_SPIN_CAP (1u << 18)

__device__ __forceinline__ unsigned xb_ld(unsigned* p)              { return __hip_atomic_load(p, __ATOMIC_RELAXED, __HIP_MEMORY_SCOPE_AGENT); }
__device__ __forceinline__ unsigned xb_add(unsigned* p, unsigned v) { return __hip_atomic_fetch_add(p, v, __ATOMIC_RELAXED, __HIP_MEMORY_SCOPE_AGENT); }
__device__ __forceinline__ unsigned xb_xcc_id() { return (unsigned)__builtin_amdgcn_s_getreg((3 << 11) | 20) & 0xFu; }
#define XB_SPIN(cond, bar) do { unsigned _sp = 0; while (cond) { __builtin_amdgcn_s_sleep(1); \
    if ((++_sp & 255u) == 0u) { if (xb_ld(&(bar)[XB_TMO])) break; if (_sp > XB_SPIN_CAP) { atomicAdd(&(bar)[XB_TMO], 1u); break; } } } } while (0)

struct XcdBarrier {
    unsigned* bar; unsigned x;
    volatile LAS unsigned* st;
};

__device__ __forceinline__ XcdBarrier xcd_barrier_post(unsigned* bar, volatile LAS unsigned* st) {
    XcdBarrier b; b.bar = bar; b.x = xb_xcc_id(); b.st = st;
    if (threadIdx.x == 0) (void)xb_add(&bar[XB_XCNT(b.x)], 1u);
    return b;
}
__device__ __forceinline__ void xcd_barrier_complete(unsigned* bar, unsigned x, unsigned& nloc, unsigned& nx) {
    const unsigned G = gridDim.x * gridDim.y * gridDim.z;
    unsigned sum, cnt, mine, sp = 0u;
    for (;;) {
        sum = 0u; cnt = 0u; mine = 0u;
#pragma unroll
        for (unsigned j = 0; j < 16; ++j) { const unsigned c = xb_ld(&bar[XB_XCNT(j)]); sum += c; cnt += (c > 0u) ? 1u : 0u; mine = (j == x) ? c : mine; }
        if (sum == G) break;
        __builtin_amdgcn_s_sleep(1);
        if ((++sp & 255u) == 0u) { if (xb_ld(&bar[XB_TMO])) break; if (sp > XB_SPIN_CAP) { atomicAdd(&bar[XB_TMO], 1u); break; } }
    }
    nloc = mine > 0u ? mine : 1u; nx = cnt > 0u ? cnt : 1u;
}

__device__ __forceinline__ void xcd_barrier(const XcdBarrier& b) {
    asm volatile("s_waitcnt vmcnt(0)" ::: "memory");
    __syncthreads();
    if (threadIdx.x == 0) {
        unsigned* bar = b.bar;
        __builtin_amdgcn_s_waitcnt(0);
        unsigned nloc = b.st[0], nx = b.st[1];
        if (nloc == 0u) { xcd_barrier_complete(bar, b.x, nloc, nx); b.st[0] = nloc; b.st[1] = nx; }
        const unsigned old = xb_add(&bar[XB_XSUB(b.x)], 1u);
        const unsigned gen = old / nloc;
        if (old + 1u == (gen + 1u) * nloc) {
            __builtin_amdgcn_fence(__ATOMIC_RELEASE, "agent");
            asm volatile("s_waitcnt vmcnt(0)" ::: "memory");
            const unsigned og = xb_add(&bar[XB_TOP], 1u);
            const unsigned tg = og / nx;
            if (og + 1u == (tg + 1u) * nx) xb_add(&bar[XB_TOPGEN], 1u);
            else XB_SPIN(xb_ld(&bar[XB_TOPGEN]) == tg, bar);
            __builtin_amdgcn_fence(__ATOMIC_ACQUIRE, "agent");
            xb_add(&bar[XB_XGEN(b.x)], 1u);
            asm volatile("s_waitcnt vmcnt(0)" ::: "memory");
        } else {
            XB_SPIN(xb_ld(&bar[XB_XGEN(b.x)]) == gen, bar);
            __builtin_amdgcn_fence(__ATOMIC_ACQUIRE, "agent");
            asm volatile("s_waitcnt vmcnt(0)" ::: "memory");
        }
    }
    __syncthreads();
}

#ifndef V8_LPR
#define V8_LPR 32
#endif
constexpr int LDS_BYTES = 147456;
extern __shared__ __attribute__((aligned(16))) unsigned char dyn_lds[];

__global__ void __launch_bounds__(NT, 2) mega_fwd(Params p) {
    cg::grid_group grid = cg::this_grid();
    const int vb = blockIdx.x, nvb = gridDim.x, ngw = nvb * NWV;
    volatile LAS unsigned* xst = (volatile LAS unsigned*)((LAS unsigned char*)dyn_lds + (LDS_BYTES - 16));
    if (threadIdx.x < 4) xst[threadIdx.x] = 0u;
    __syncthreads();
    const XcdBarrier xbar = xcd_barrier_post((unsigned*)(p.ws + WS_CTL), xst);
#define TID_LAUNDER int tid_ = threadIdx.x; asm volatile("" : "+v"(tid_)); const int lane = tid_ & 63, wv = tid_ >> 6, gw = vb * NWV + wv; (void)lane; (void)gw;
    grid.sync();
    ph_mod(p, (float*)dyn_lds, vb, nvb);
    { TID_LAUNDER ph_prep_weights(p, (LAS float*)dyn_lds + wv * (64 * 33), gw, ngw, lane); }
    xcd_barrier(xbar);
    { TID_LAUNDER ph_hrows(p, p.x, p.norm1_g, 0, 1024, gw, ngw, lane); }
    xcd_barrier(xbar);
    {   pg8::Gemm g{(const bf16*)(p.ws + WS_H), (const bf16*)(p.ws + WS_WIN), T, NP, 1024}; pg8::StaticOrder S; S.init(T, NP, nvb, vb);
        EpiNormBf16 E{(bf16*)(p.ws + WS_PROJ), p.a_qk_gain, p.b_q_gain, p.b_kv_gain, (LAS float*)((LAS unsigned char*)dyn_lds + 131072), (bf16*)(p.ws + WS_KVC)};
        pg8::gemm_phase<EpiNormBf16, pg8::StaticOrder, true, true>((LAS unsigned char*)dyn_lds, g, S, E); }
    xcd_barrier(xbar);
    ph_attnA(p, dyn_lds, vb, nvb);
    __syncthreads();
    ph_dsa(p, dyn_lds, vb, nvb);
    xcd_barrier(xbar);
    {   pg8::Gemm g{(const bf16*)(p.ws + WS_MIX), (const bf16*)(p.ws + WS_WO2), T, 1024, MIXW}; pg8::StaticOrder S; S.init(T, 1024, nvb, vb);
        EpiResGate E{p.x, p.out, (const float*)(p.ws + WS_MOD) + 2048};
        pg8::gemm_phase<EpiResGate, pg8::StaticOrder, true, true>((LAS unsigned char*)dyn_lds, g, S, E); }
    xcd_barrier(xbar);
    { TID_LAUNDER ph_hrows(p, p.out, p.norm2_g, 3072, 4096, gw, ngw, lane); }
    xcd_barrier(xbar);
    {   pg8::Gemm g{(const bf16*)(p.ws + WS_H), (const bf16*)(p.ws + WS_WQ), T, 1024, 1024}; pg8::StaticOrder S; S.init(T, 1024, nvb, vb);
        pg8::EpiBf16<0> E{(bf16*)(p.ws + WS_Q3), 1024, nullptr, 0, 0, 1.f};
        pg8::gemm_phase<pg8::EpiBf16<0>, pg8::StaticOrder, true, true>((LAS unsigned char*)dyn_lds, g, S, E); }
    xcd_barrier(xbar);
    ph_route(p, dyn_lds, vb, nvb);
    xcd_barrier(xbar);

    { TID_LAUNDER ph_peer_u8p(p, dyn_lds + wv * 1024, gw, ngw, lane); }
    xcd_barrier(xbar);
    ph_peer_v8g<V8_LPR>(p, dyn_lds);

}

extern "C" void kernel_launch(void* const* d_in, const int* in_sizes, int n_in, void* d_out, int out_size, void* d_ws, size_t ws_size, hipStream_t stream) {
    static int grid_blocks = 0;
    if (grid_blocks == 0) {
        if (n_in != 18 || in_sizes[0] != T * DM || out_size != T * DM || ws_size < WS_END) { fprintf(stderr, "kernel_launch: unexpected shapes n_in %d in0 %d out %d ws %zu\n", n_in, n_in > 0 ? in_sizes[0] : -1, out_size, ws_size); grid_blocks = -1; return; }
        int dev = 0, cus = 0, per_cu = 0;
        (void)hipGetDevice(&dev);
        (void)hipDeviceGetAttribute(&cus, hipDeviceAttributeMultiprocessorCount, dev);
        (void)hipFuncSetAttribute((const void*)mega_fwd, hipFuncAttributeMaxDynamicSharedMemorySize, LDS_BYTES);
        (void)hipOccupancyMaxActiveBlocksPerMultiprocessor(&per_cu, (const void*)mega_fwd, NT, LDS_BYTES);
        if (per_cu < 1 || cus < 1) { fprintf(stderr, "kernel_launch: occupancy query gave %d blocks/CU on %d CUs\n", per_cu, cus); grid_blocks = -1; return; }
        grid_blocks = cus;
    }
    if (grid_blocks < 0) return;
    Params p{};
    const float** pp = (const float**)&p;
    for (int i = 0; i < 18; ++i) pp[i] = (const float*)d_in[i];
    p.out = (float*)d_out; p.ws = (unsigned char*)d_ws;
    if (hipMemsetAsync((char*)d_ws + WS_CTL, 0, CTL_BYTES, stream) != hipSuccess) { fprintf(stderr, "kernel_launch: memset failed\n"); return; }
    void* args[] = {&p};
    const hipError_t e = hipLaunchCooperativeKernel((const void*)mega_fwd, dim3(grid_blocks), dim3(NT), args, LDS_BYTES, stream);
    if (e != hipSuccess) fprintf(stderr, "kernel_launch: cooperative launch failed: %s (grid %d)\n", hipGetErrorString(e), grid_blocks);
}
```

```cpp
#include <hip/hip_runtime.h>
#include <hip/hip_cooperative_groups.h>
#include <cstdio>
#include <cstdint>
#include <cmath>
namespace pg8 {
#define PG8_LAS __attribute__((address_space(3)))
typedef unsigned short bf16_t;
typedef short bf16x8 __attribute__((ext_vector_type(8)));
typedef float f32x4 __attribute__((ext_vector_type(4)));
typedef unsigned u32x4 __attribute__((ext_vector_type(4)));
constexpr int BM = 256, BK = 64, HALF = 128, HTB = HALF * BK * 2  , STAGE_BYTES = 8 * HTB, NXCD = 8, WGM = 8;

__host__ __device__ __forceinline__ int lds_byte(int r, int c) { const int st = (r >> 4) * 2 + (c >> 5), rr = r & 15, cc = c & 31, ob = rr * 64 + cc * 2; return st * 1024 + (ob ^ (((ob >> 9) & 1) << 5)); }
__host__ __device__ __forceinline__ void stage_rc(int b, int& R, int& C) { const int st = b / 1024, sb = b % 1024, swz = sb ^ (((sb >> 9) & 1) << 5); R = (st >> 1) * 16 + swz / 64; C = (st & 1) * 32 + (swz % 64) / 2; }
__host__ __device__ __forceinline__ int perm32(int rho) { const int n = rho >> 4, i = rho & 15; return 8 * (i >> 2) + 4 * n + (i & 3); }

struct Unit { int pm, pn; };
struct Gemm { const bf16_t* A; const bf16_t* Bt; int M, N, K; };

struct StaticOrder {
    int nM, nN, nwg, G, c;
    __host__ __device__ void init(int M, int N, int G_, int c_) { nM = M / BM; nN = N / BM; nwg = nM * nN; G = G_; c = c_; }
    __host__ __device__ bool next(int i, Unit& u) const {
        const long L = (long)i * G + c; if (L >= nwg) return false;
        int wgid = (int)L; { const int q = nwg / NXCD, r = nwg % NXCD, xcd = wgid % NXCD, off = wgid / NXCD; wgid = (xcd < r ? xcd * (q + 1) : r * (q + 1) + (xcd - r) * q) + off; }
        const int nig = WGM * nN, gid = wgid / nig, fm = gid * WGM, gsz = (nM - fm) < WGM ? (nM - fm) : WGM;
        u.pm = fm + ((wgid % nig) % gsz); u.pn = (wgid % nig) / gsz; return true;
    }
    __device__ __forceinline__ void a_ready(const Unit&) const {}
    __device__ __forceinline__ void done(const Unit&) const {}
};

__device__ __forceinline__ unsigned cvt_pk_bf16(float lo, float hi) { unsigned r; asm volatile("v_cvt_pk_bf16_f32 %0, %1, %2" : "=v"(r) : "v"(lo), "v"(hi)); return r; }
typedef float f32x2 __attribute__((ext_vector_type(2)));
__device__ __forceinline__ f32x2 gelu_pk(f32x2 v) {
    const f32x2 av = __builtin_elementwise_abs(v), d = av * 0.2316418882f + 1.0f;
    f32x2 t; t.x = __builtin_amdgcn_rcpf(d.x); t.y = __builtin_amdgcn_rcpf(d.y);
    f32x2 q = t * 0.5307027145f + (-0.7265760135f); q = q * t + 0.7107068705f; q = q * t + (-0.142248368f); q = q * t + 0.127414796f; q = q * t;
    const f32x2 s = (v * v) * (-0.72134752044f);
    f32x2 e; e.x = __builtin_amdgcn_exp2f(s.x); e.y = __builtin_amdgcn_exp2f(s.y);
    const f32x2 m = v * (q * e), r = v - m;
    f32x2 o; o.x = v.x < 0.f ? m.x : r.x; o.y = v.y < 0.f ? m.y : r.y; return o;
}

template <int ACT  > struct EpiBf16 {
    static constexpr bool PERM = true, AFTER_DRAIN = false; static_assert(ACT == 0 || ACT == 1, "EpiBf16: ACT is 0 (none) or 1 (gelu_pk)");
    bf16_t* O; int ldc; const float* bias; int split_cols; size_t split_stride; float scale0;
    __device__ __forceinline__ void operator()(const f32x4 (&acc)[2][2][4][2], const Unit& u, int wr, int wc, int fr, int fq) const {
        const int row0 = u.pm * BM + wr * 64 + fr; int colt = u.pn * BM; bf16_t* base = O;
        float sc = 1.f; if (split_cols) { const int t = colt / split_cols; base += (size_t)t * split_stride; colt -= t * split_cols; if (t == 0) sc = scale0; }
        const int col0 = colt + wc * 32 + 8 * fq, bcol0 = u.pn * BM + wc * 32 + 8 * fq;
        f32x4 bv[2][2];
#pragma unroll
        for (int bj = 0; bj < 2; ++bj)
#pragma unroll
            for (int n = 0; n < 2; ++n) bv[bj][n] = bias ? *(const f32x4*)(bias + bcol0 + bj * HALF + 4 * n) : (f32x4){0.f, 0.f, 0.f, 0.f};
#pragma unroll
        for (int ai = 0; ai < 2; ++ai)
#pragma unroll
            for (int m = 0; m < 4; ++m) { bf16_t* rowp = base + (size_t)(row0 + ai * HALF + m * 16) * ldc + col0;
#pragma unroll
                for (int bj = 0; bj < 2; ++bj) { f32x4 v0 = acc[ai][bj][m][0] + bv[bj][0], v1 = acc[ai][bj][m][1] + bv[bj][1];
                    if (ACT == 1) { f32x2 a = gelu_pk((f32x2){v0[0], v0[1]}), b = gelu_pk((f32x2){v0[2], v0[3]}), c = gelu_pk((f32x2){v1[0], v1[1]}), d = gelu_pk((f32x2){v1[2], v1[3]});
                        v0 = (f32x4){a.x, a.y, b.x, b.y}; v1 = (f32x4){c.x, c.y, d.x, d.y}; }
                    v0 = v0 * sc; v1 = v1 * sc; u32x4 w; w.x = cvt_pk_bf16(v0[0], v0[1]); w.y = cvt_pk_bf16(v0[2], v0[3]); w.z = cvt_pk_bf16(v1[0], v1[1]); w.w = cvt_pk_bf16(v1[2], v1[3]);
                    *(u32x4*)(rowp + bj * HALF) = w; } }
    }
};

template <class Epi, class Sched, bool ALIGN_EPI = false, bool SP2 = false>
__device__ __forceinline__ void gemm_phase(PG8_LAS unsigned char* lds, const Gemm g, const Sched& S, const Epi& E) {
    int tid = threadIdx.x; asm volatile("" : "+v"(tid)); const int wid = __builtin_amdgcn_readfirstlane(tid >> 6), lane = tid & 63, wr = wid >> 2, wc = wid & 3, fr = lane & 15, fq = lane >> 4;
    const int K = g.K, nt = K / BK;
    unsigned voffA[2], voffB[2];
#pragma unroll
    for (int i = 0; i < 2; ++i) { int R, C; stage_rc(tid * 16 + i * 8192, R, C); const int Rb = Epi::PERM ? ((R & ~31) + perm32(R & 31)) : R;
        voffA[i] = (unsigned)(R * K + C) * 2u; voffB[i] = (unsigned)(Rb * K + C) * 2u; }
    const size_t kstep = (size_t)(BK * 2);
    const size_t hstep = (size_t)HALF * K * 2;
    const size_t tstep = 2 * hstep;
    const unsigned ldsw = (unsigned)wid * 1024u;
    const int aoff = lds_byte(wr * 64 + fr, fq * 8), boff = lds_byte(wc * 32 + fr, fq * 8);
#define PG8_SA(b, h) (((b) * 2 + (h)) * HTB)
#define PG8_SB(b, h) ((4 + (b) * 2 + (h)) * HTB)
#define PG8_STAGE(bufoff, gbase, voff) do { _Pragma("unroll") for (int _i = 0; _i < 2; ++_i) \
        __builtin_amdgcn_global_load_lds((const unsigned*)((const char*)(gbase) + (voff)[_i]), (PG8_LAS unsigned*)(lds + (bufoff) + ldsw + _i * 8192), 16, 0, 0); } while (0)
#define PG8_LDA(dst, b, h) do { _Pragma("unroll") for (int m = 0; m < 4; ++m) _Pragma("unroll") for (int k = 0; k < 2; ++k) dst[m][k] = *(const PG8_LAS bf16x8*)(lds + PG8_SA(b, h) + aoff + m * 2048 + k * 1024); } while (0)
#define PG8_LDB(dst, b, h) do { _Pragma("unroll") for (int n = 0; n < 2; ++n) _Pragma("unroll") for (int k = 0; k < 2; ++k) dst[n][k] = *(const PG8_LAS bf16x8*)(lds + PG8_SB(b, h) + boff + n * 2048 + k * 1024); } while (0)
#define PG8_MMA(ai, bj, At, Bt) do { __builtin_amdgcn_s_setprio(1); _Pragma("unroll") for (int m = 0; m < 4; ++m) _Pragma("unroll") for (int n = 0; n < 2; ++n) _Pragma("unroll") for (int k = 0; k < 2; ++k) \
        acc[ai][bj][m][n] = __builtin_amdgcn_mfma_f32_16x16x32_bf16(Bt[n][k], At[m][k], acc[ai][bj][m][n], 0, 0, 0); __builtin_amdgcn_s_setprio(0); } while (0)
#define PG8_WAIT_V(n) asm volatile("s_waitcnt vmcnt(" #n ")" ::: "memory")
#define PG8_WAIT_L(n) asm volatile("s_waitcnt lgkmcnt(" #n ")" ::: "memory")
#define PG8_BAR __builtin_amdgcn_s_barrier()
#define PG8_SCHED __builtin_amdgcn_sched_barrier(0)
    Unit cur, nxt; int ui = 0;
    if (!S.next(0, cur)) return;
    f32x4 acc[2][2][4][2];
#pragma unroll
    for (int a = 0; a < 2; ++a)
#pragma unroll
        for (int b = 0; b < 2; ++b)
#pragma unroll
            for (int m = 0; m < 4; ++m)
#pragma unroll
                for (int n = 0; n < 2; ++n) acc[a][b][m][n] = (f32x4){0.f, 0.f, 0.f, 0.f};
    bf16x8 At[4][2], B0[2][2], B1[2][2];
    const char* cA = (const char*)g.A + (size_t)cur.pm * tstep; const char* cB = (const char*)g.Bt + (size_t)cur.pn * tstep;
    S.a_ready(cur);
    if constexpr (SP2) {
        PG8_STAGE(PG8_SB(0, 0), cB, voffB); PG8_STAGE(PG8_SB(0, 1), cB + hstep, voffB); PG8_STAGE(PG8_SA(0, 0), cA, voffA); PG8_STAGE(PG8_SA(0, 1), cA + hstep, voffA);
        if (wr == 1) PG8_BAR;
        PG8_WAIT_V(2); PG8_BAR;
        PG8_STAGE(PG8_SB(1, 0), cB + kstep, voffB); PG8_STAGE(PG8_SA(1, 0), cA + kstep, voffA); PG8_STAGE(PG8_SB(1, 1), cB + hstep + kstep, voffB);
        PG8_WAIT_V(6); PG8_BAR;
    } else {
        PG8_STAGE(PG8_SB(0, 0), cB, voffB); PG8_STAGE(PG8_SA(0, 0), cA, voffA); PG8_STAGE(PG8_SB(0, 1), cB + hstep, voffB); PG8_STAGE(PG8_SA(0, 1), cA + hstep, voffA);
        if (wr == 1) PG8_BAR;
        PG8_WAIT_V(4); PG8_BAR;
        PG8_STAGE(PG8_SB(1, 0), cB + kstep, voffB); PG8_STAGE(PG8_SA(1, 0), cA + kstep, voffA); PG8_STAGE(PG8_SB(1, 1), cB + hstep + kstep, voffB);
        PG8_WAIT_V(6); PG8_BAR;
    }
    for (;;) {
        const bool has_next = S.next(ui + 1, nxt);
        const char* nA = has_next ? (const char*)g.A + (size_t)nxt.pm * tstep : cA; const char* nB = has_next ? (const char*)g.Bt + (size_t)nxt.pn * tstep : cB;
        for (int t = 0; t < nt; t += 2) {
            const bool last = (t == nt - 2);
            const char* a1 = cA + (size_t)(t + 1) * kstep;
            const char* a2 = last ? nA : cA + (size_t)(t + 2) * kstep; const char* b2 = last ? nB : cB + (size_t)(t + 2) * kstep;
            const char* a3 = a2 + kstep; const char* b3 = b2 + kstep;
            if (last && has_next) S.a_ready(nxt);
            if constexpr (SP2) {
            PG8_LDB(B0, 0, 0); PG8_LDB(B1, 0, 1); PG8_SCHED; PG8_LDA(At, 0, 0); PG8_STAGE(PG8_SA(1, 1), a1 + hstep, voffA);
            PG8_WAIT_V(8); PG8_WAIT_L(0); PG8_BAR; PG8_MMA(0, 0, At, B0); PG8_MMA(0, 1, At, B1); PG8_BAR; PG8_SCHED;
            PG8_LDA(At, 0, 1); PG8_STAGE(PG8_SB(0, 0), b2, voffB); PG8_STAGE(PG8_SB(0, 1), b2 + hstep, voffB); PG8_STAGE(PG8_SA(0, 0), a2, voffA);
            PG8_WAIT_V(8); PG8_WAIT_L(0); PG8_BAR; PG8_MMA(1, 0, At, B0); PG8_MMA(1, 1, At, B1); PG8_BAR; PG8_SCHED;
            PG8_LDB(B0, 1, 0); PG8_LDB(B1, 1, 1); PG8_SCHED; PG8_LDA(At, 1, 0); PG8_STAGE(PG8_SA(0, 1), a2 + hstep, voffA);
            PG8_WAIT_V(8); PG8_WAIT_L(0); PG8_BAR; PG8_MMA(0, 0, At, B0); PG8_MMA(0, 1, At, B1); PG8_BAR; PG8_SCHED;
            PG8_LDA(At, 1, 1); PG8_STAGE(PG8_SB(1, 0), b3, voffB); PG8_STAGE(PG8_SB(1, 1), b3 + hstep, voffB); PG8_STAGE(PG8_SA(1, 0), a3, voffA);
            PG8_WAIT_V(8); PG8_WAIT_L(0); PG8_BAR; PG8_MMA(1, 0, At, B0); PG8_MMA(1, 1, At, B1); PG8_BAR; PG8_SCHED;
            } else {
            PG8_LDB(B0, 0, 0); PG8_SCHED; PG8_LDA(At, 0, 0); PG8_STAGE(PG8_SA(1, 1), a1 + hstep, voffA);
            PG8_WAIT_L(8); PG8_BAR; PG8_WAIT_L(0); PG8_MMA(0, 0, At, B0); PG8_BAR; PG8_SCHED;
            PG8_LDB(B1, 0, 1); PG8_STAGE(PG8_SB(0, 0), b2, voffB);
            PG8_BAR; PG8_WAIT_L(0); PG8_MMA(0, 1, At, B1); PG8_BAR;
            PG8_LDA(At, 0, 1); PG8_STAGE(PG8_SA(0, 0), a2, voffA);
            PG8_BAR; PG8_WAIT_L(0); PG8_MMA(1, 0, At, B0); PG8_BAR; PG8_SCHED;
            PG8_STAGE(PG8_SB(0, 1), b2 + hstep, voffB);
            PG8_WAIT_V(6); PG8_BAR; PG8_MMA(1, 1, At, B1); PG8_BAR;
            PG8_LDB(B0, 1, 0); PG8_SCHED; PG8_LDA(At, 1, 0); PG8_STAGE(PG8_SA(0, 1), a2 + hstep, voffA);
            PG8_WAIT_L(8); PG8_BAR; PG8_WAIT_L(0); PG8_MMA(0, 0, At, B0); PG8_BAR; PG8_SCHED;
            PG8_LDB(B1, 1, 1); PG8_STAGE(PG8_SB(1, 0), b3, voffB);
            PG8_BAR; PG8_WAIT_L(0); PG8_MMA(0, 1, At, B1); PG8_BAR;
            PG8_LDA(At, 1, 1); PG8_STAGE(PG8_SA(1, 0), a3, voffA);
            PG8_BAR; PG8_WAIT_L(0); PG8_MMA(1, 0, At, B0); PG8_BAR; PG8_SCHED;
            PG8_STAGE(PG8_SB(1, 1), b3 + hstep, voffB);
            PG8_WAIT_V(6); PG8_BAR; PG8_MMA(1, 1, At, B1); PG8_BAR;
            }
        }
        if constexpr (ALIGN_EPI) { if (wr == 0) PG8_BAR; }
        if constexpr (!Epi::AFTER_DRAIN) { E(acc, cur, wr, wc, fr, fq); S.done(cur); }
        if (!has_next) break;
#pragma unroll
        for (int a = 0; a < 2; ++a)
#pragma unroll
            for (int b = 0; b < 2; ++b)
#pragma unroll
                for (int m = 0; m < 4; ++m)
#pragma unroll
                    for (int n = 0; n < 2; ++n) acc[a][b][m][n] = (f32x4){0.f, 0.f, 0.f, 0.f};
        cur = nxt; cA = nA; cB = nB; ++ui;
        if constexpr (ALIGN_EPI) { if (wr == 1) PG8_BAR; }
    }
    PG8_WAIT_V(0);
    if constexpr (!ALIGN_EPI) { if (wr == 0) PG8_BAR; }
    PG8_BAR;
    if constexpr (Epi::AFTER_DRAIN) { E.fused(acc, cur, wr, wc, fr, fq, lds, wid, lane); S.done(cur); }
#undef PG8_SA
#undef PG8_SB
#undef PG8_STAGE
#undef PG8_LDA
#undef PG8_LDB
#undef PG8_MMA
#undef PG8_WAIT_V
#undef PG8_WAIT_L
#undef PG8_BAR
#undef PG8_SCHED
}
}
namespace cg = cooperative_groups;
#define LAS __attribute__((address_space(3)))
typedef unsigned short bf16;
typedef float f32x4 __attribute__((ext_vector_type(4)));
typedef float f32x8 __attribute__((ext_vector_type(8)));
typedef float f32x16 __attribute__((ext_vector_type(16)));
typedef unsigned u32x4 __attribute__((ext_vector_type(4)));
typedef unsigned u32x2 __attribute__((ext_vector_type(2)));
typedef short bf16x8 __attribute__((ext_vector_type(8)));
typedef short s16x4 __attribute__((ext_vector_type(4)));

constexpr int BATCH = 16, SEQ = 2048, DM = 1024, T = BATCH * SEQ;
constexpr int NP = 3072;
constexpr int IN_COLS = 3012;
constexpr int C_QA = 0, C_KA = 512, C_VA = 1024, C_QB = 1536, C_KV = 2560, C_QI = 2688, C_KI = 2944, C_WI = 3008;
constexpr int MIXW = 1536;
constexpr int NEXP = 16384;
constexpr float EPS = 1e-6f;
constexpr int NT = 512;
constexpr int NWV = 8;

constexpr size_t MiB = 1u << 20;
constexpr size_t WS_CTL = 0;
constexpr size_t CTL_BYTES = 64 * 1024;
constexpr size_t WS_MOD = 1 * MiB;
constexpr size_t WS_SCAL = WS_MOD + 512 * 1024;
constexpr size_t WS_WIN = 2 * MiB;
constexpr size_t WS_WO2 = 8 * MiB;
constexpr size_t WS_WQ = 11 * MiB;
constexpr size_t WS_SUBK = 13 * MiB;
constexpr size_t WS_U16 = 14 * MiB;
constexpr size_t WS_V16 = 46 * MiB;
constexpr size_t WS_H = 78 * MiB;
constexpr size_t WS_PROJ = 142 * MiB;
constexpr size_t WS_Q3 = WS_PROJ;
constexpr size_t WS_MIX = 334 * MiB;
constexpr size_t WS_EXP = 430 * MiB;
constexpr size_t WS_KVC = WS_EXP;
constexpr size_t WS_GATE = 446 * MiB;
constexpr size_t WS_ATMP = 462 * MiB;
constexpr size_t WS_CBUF = 494 * MiB;
constexpr size_t WS_ABUF1 = WS_MIX;
constexpr size_t WS_END = 510 * MiB;

struct Params {
    const float *x, *c, *ada_w, *ada_b, *norm1_g, *norm2_g, *w_in, *a_qk_gain, *a_lambda, *a_sub_gain, *b_q_gain, *b_kv_gain, *b_w_uv, *w_out, *peer_wq, *peer_subkeys, *peer_u, *peer_v;
    float* out; unsigned char* ws;
};

enum { SC_LAM = 0, SC_MA = 1, SC_MB = 2 };

__device__ __forceinline__ unsigned f2bf(float f) { unsigned u = __float_as_uint(f); return (u + 0x7fffu + ((u >> 16) & 1u)) >> 16; }
__device__ __forceinline__ float bf2f(unsigned h) { return __uint_as_float(h << 16); }
__device__ __forceinline__ unsigned pk2(float lo, float hi) { return f2bf(lo) | (f2bf(hi) << 16); }
__device__ __forceinline__ float bflo(unsigned w) { return __uint_as_float(w << 16); }
__device__ __forceinline__ float bfhi(unsigned w) { return __uint_as_float(w & 0xffff0000u); }
__device__ __forceinline__ float wave_sum(float v) {
#pragma unroll
    for (int o = 1; o < 64; o <<= 1) v += __shfl_xor(v, o);
    return v;
}
__device__ __forceinline__ float wave_max(float v) {
#pragma unroll
    for (int o = 1; o < 64; o <<= 1) v = fmaxf(v, __shfl_xor(v, o));
    return v;
}
#define LDS_WAIT() asm volatile("s_waitcnt lgkmcnt(0)" ::: "memory")
__device__ __forceinline__ void ph_mod(const Params& p, float* ldsf, int vb, int nvb) {
    if (vb >= 96) return;
    int tid = threadIdx.x; asm volatile("" : "+v"(tid));
    const int lane = tid & 63, wv = tid >> 6;
    for (int i = tid; i < 16 * 1024; i += NT) { const float v = p.c[i]; ldsf[i] = v / (1.f + __expf(-v)); }
    __syncthreads();
    float* MOD = (float*)(p.ws + WS_MOD); float* part = ldsf + 16 * 1024;
    for (int it = vb; it < 96; it += nvb) {
        const int j = it * 64 + lane;
        float acc[16];
#pragma unroll
        for (int b = 0; b < 16; ++b) acc[b] = 0.f;
        const float* wp = p.ada_w + (size_t)(128 * wv) * 6144 + j;
#pragma unroll 1
        for (int k0 = 0; k0 < 128; k0 += 8) {
            float w[8];
#pragma unroll
            for (int u = 0; u < 8; ++u) w[u] = wp[(size_t)(k0 + u) * 6144];
#pragma unroll
            for (int u = 0; u < 8; ++u)
#pragma unroll
                for (int b = 0; b < 16; ++b) acc[b] = fmaf(ldsf[b * 1024 + 128 * wv + k0 + u], w[u], acc[b]);
        }
#pragma unroll
        for (int b = 0; b < 16; ++b) part[(wv * 16 + b) * 64 + lane] = acc[b];
        __syncthreads();
        for (int o = tid; o < 16 * 64; o += NT) { const int b = o >> 6, c = o & 63; float s = 0.f;
#pragma unroll
            for (int w = 0; w < 8; ++w) s += part[(w * 16 + b) * 64 + c];
            MOD[b * 6144 + it * 64 + c] = s + p.ada_b[it * 64 + c]; }
        __syncthreads();
    }
}

__device__ __forceinline__ void transpose_item(const float* W, int N, bf16* WT, int ldt, LAS float* scr, int kb, int nb, int lane) {
    const int k0 = 64 * kb, n0 = 32 * nb;
#pragma unroll 8
    for (int i = 0; i < 32; ++i) { const int kk = 2 * i + (lane >> 5); const int n = n0 + (lane & 31); scr[kk * 33 + (lane & 31)] = (n < N) ? W[(size_t)(k0 + kk) * N + n] : 0.f; }
    LDS_WAIT(); asm volatile("" ::: "memory");
    const int c = lane & 7;
#pragma unroll
    for (int j = 0; j < 4; ++j) { const int n = (lane >> 3) + 8 * j; const LAS float* s = scr + (8 * c) * 33 + n;
        u32x4 o; o.x = pk2(s[0 * 33], s[1 * 33]); o.y = pk2(s[2 * 33], s[3 * 33]); o.z = pk2(s[4 * 33], s[5 * 33]); o.w = pk2(s[6 * 33], s[7 * 33]);
        *(u32x4*)(WT + (size_t)(n0 + n) * ldt + k0 + 8 * c) = o; }
    LDS_WAIT(); asm volatile("" ::: "memory");
}

__device__ __forceinline__ void ph_prep_weights(const Params& p, LAS float* scr, int gw, int ngw, int lane) {
    bf16* WIN = (bf16*)(p.ws + WS_WIN); bf16* WO2 = (bf16*)(p.ws + WS_WO2); bf16* WQ = (bf16*)(p.ws + WS_WQ);
    constexpr int I_IN = 16 * 96, I_O = 8 * 32, I_Q = 16 * 32;
    for (int it = gw; it < I_IN + I_O + I_Q; it += ngw) {
        int r = it;
        if (r < I_IN) { transpose_item(p.w_in, IN_COLS, WIN, 1024, scr, r / 96, r % 96, lane); continue; } r -= I_IN;
        if (r < I_O) { transpose_item(p.w_out, 1024, WO2, MIXW, scr, r / 32, r % 32, lane); continue; } r -= I_O;
        transpose_item(p.peer_wq, 1024, WQ, 1024, scr, r / 32, r % 32, lane);
    }
    const size_t gt = (size_t)gw * 64 + lane, ngt = (size_t)ngw * 64;
    for (size_t i = gt; i < (size_t)1024 * 1024; i += ngt) {
        const int n = (int)(i & 1023), kk = (int)(i >> 10), h = kk >> 7;
        const float* wu = p.b_w_uv + (size_t)kk * 64; const float* wo = p.w_out + (size_t)(512 + 64 * h) * 1024 + n;
        float a = 0.f;
#pragma unroll 8
        for (int e = 0; e < 64; ++e) a = fmaf(wu[e], wo[(size_t)e * 1024], a);
        WO2[(size_t)n * MIXW + 512 + kk] = (bf16)f2bf(a);
    }
    unsigned char* U8 = (unsigned char*)(p.ws + WS_U16); unsigned char* V8 = (unsigned char*)(p.ws + WS_V16); bf16* SUBK = (bf16*)(p.ws + WS_SUBK);
    constexpr size_t NTAB8 = (size_t)NEXP * 1024 / 8, NSUB8 = 2 * 128 * 64 / 8;
    for (size_t i = gt; i < 2 * NTAB8 + NSUB8; i += ngt) {
        if (i < 2 * NTAB8) {
            const bool isu = i < NTAB8; const size_t j = isu ? i : i - NTAB8; const float sc = isu ? 32.0f : 1.0f;
            const f32x8 v = *(const f32x8*)((isu ? p.peer_u : p.peer_v) + j * 8);
            int w0 = 0, w1 = 0;
            w0 = __builtin_amdgcn_cvt_pk_fp8_f32(v[0] * sc, v[1] * sc, w0, false); w0 = __builtin_amdgcn_cvt_pk_fp8_f32(v[2] * sc, v[3] * sc, w0, true);
            w1 = __builtin_amdgcn_cvt_pk_fp8_f32(v[4] * sc, v[5] * sc, w1, false); w1 = __builtin_amdgcn_cvt_pk_fp8_f32(v[6] * sc, v[7] * sc, w1, true);
            u32x2 o; o.x = (unsigned)w0; o.y = (unsigned)w1;
            *(u32x2*)((isu ? U8 : V8) + j * 8) = o;
        } else {
            const size_t j = i - 2 * NTAB8;
            const f32x8 v = *(const f32x8*)(p.peer_subkeys + j * 8);
            u32x4 o; o.x = pk2(v[0], v[1]); o.y = pk2(v[2], v[3]); o.z = pk2(v[4], v[5]); o.w = pk2(v[6], v[7]);
            *(u32x4*)(SUBK + j * 8) = o;
        }
    }
    if (gt == 0) {
        float* SC = (float*)(p.ws + WS_SCAL);
        float s01 = 0.f, s23 = 0.f;
        for (int i = 0; i < 64; ++i) { s01 += p.a_lambda[i] * p.a_lambda[64 + i]; s23 += p.a_lambda[128 + i] * p.a_lambda[192 + i]; }
        SC[SC_LAM] = __expf(s01) - __expf(s23) + 0.2f;
        float g0 = 0.f, g1 = 0.f, gq = 0.f, gk = 0.f;
        for (int i = 0; i < 64; ++i) { g0 = fmaxf(g0, fabsf(p.a_qk_gain[i])); g1 = fmaxf(g1, fabsf(p.a_qk_gain[64 + i])); }
        for (int i = 0; i < 128; ++i) { gq = fmaxf(gq, fabsf(p.b_q_gain[i])); gk = fmaxf(gk, fabsf(p.b_kv_gain[i])); }
        SC[SC_MA] = 8.0f * g0 * g1 * 1.02f;
        SC[SC_MB] = 11.3137085f * gq * gk * 1.02f;
    }
}

__device__ __forceinline__ void ph_hrows(const Params& p, const float* X, const float* g, int shOff, int scOff, int gw, int ngw, int lane) {
    const float* MOD = (const float*)(p.ws + WS_MOD); bf16* H = (bf16*)(p.ws + WS_H);
    for (int m = gw; m < T; m += ngw) {
        const f32x4* xr = (const f32x4*)(X + (size_t)m * 1024) + lane;
        f32x4 v[4]; float s = 0.f;
#pragma unroll
        for (int j = 0; j < 4; ++j) { v[j] = xr[64 * j]; s += (v[j].x * v[j].x + v[j].y * v[j].y) + (v[j].z * v[j].z + v[j].w * v[j].w); }
        const float rstd = rsqrtf(wave_sum(s) * (1.f / 1024.f) + EPS);
        const float* mb = MOD + (size_t)(m >> 11) * 6144;
#pragma unroll
        for (int j = 0; j < 4; ++j) {
            const int col = 4 * (lane + 64 * j);
            const f32x4 gg = *(const f32x4*)(g + col), sc = *(const f32x4*)(mb + scOff + col), sh = *(const f32x4*)(mb + shOff + col);
            const f32x4 y = v[j] * rstd * gg * (sc + 1.0f) + sh;
            u32x2 o; o.x = pk2(y.x, y.y); o.y = pk2(y.z, y.w);
            *(u32x2*)(H + (size_t)m * 1024 + col) = o;
        }
    }
}

__device__ __forceinline__ void ph_norm_proj(const Params& p, int gw, int ngw, int lane) {
    bf16* PROJ = (bf16*)(p.ws + WS_PROJ);
    for (int m = gw; m < T; m += ngw) {
        bf16* row = PROJ + (size_t)m * NP;
#pragma unroll
        for (int j = 0; j < 6; ++j) {
            if (j == 2) continue;
            const int col = 8 * lane + 512 * j;
            const u32x4 raw = *(const u32x4*)(row + col);
            float v[8] = {bflo(raw.x), bfhi(raw.x), bflo(raw.y), bfhi(raw.y), bflo(raw.z), bfhi(raw.z), bflo(raw.w), bfhi(raw.w)};
            float ss = 0.f;
#pragma unroll
            for (int i = 0; i < 8; ++i) ss += v[i] * v[i];
            ss += __shfl_xor(ss, 1); ss += __shfl_xor(ss, 2); ss += __shfl_xor(ss, 4);
            float rstd; const float* gp;
            if (j < 2) { rstd = rsqrtf(ss * (1.f / 64.f) + EPS); gp = p.a_qk_gain + 64 * j + (col & 63); }
            else { ss += __shfl_xor(ss, 8); rstd = rsqrtf(ss * (1.f / 128.f) + EPS); gp = (j == 5 ? p.b_kv_gain : p.b_q_gain) + (col & 127); }
            if (j == 5 && lane >= 16) continue;
            const f32x4 g0 = *(const f32x4*)gp, g1 = *(const f32x4*)(gp + 4);
            u32x4 o; o.x = pk2(v[0] * rstd * g0.x, v[1] * rstd * g0.y); o.y = pk2(v[2] * rstd * g0.z, v[3] * rstd * g0.w);
            o.z = pk2(v[4] * rstd * g1.x, v[5] * rstd * g1.y); o.w = pk2(v[6] * rstd * g1.z, v[7] * rstd * g1.w);
            *(u32x4*)(row + col) = o;
        }
    }
}
struct EpiResGate {
    static constexpr bool PERM = false, AFTER_DRAIN = false;
    const float* X; float* Out; const float* gate;
    __device__ __forceinline__ void operator()(const pg8::f32x4 (&acc)[2][2][4][2], const pg8::Unit& u, int wr, int wc, int fr, int fq) const {
        const int col0 = u.pn * 256 + wc * 32 + 4 * fq;
#pragma unroll
        for (int ai = 0; ai < 2; ++ai)
#pragma unroll
            for (int m = 0; m < 4; ++m) {
                const int r = u.pm * 256 + ai * 128 + wr * 64 + m * 16 + fr; const float* gb = gate + (size_t)(r >> 11) * 6144;
#pragma unroll
                for (int bj = 0; bj < 2; ++bj)
#pragma unroll
                    for (int n = 0; n < 2; ++n) { const int c = col0 + bj * 128 + n * 16; const size_t off = (size_t)r * 1024 + c;
                        const pg8::f32x4 xv = *(const pg8::f32x4*)(X + off), gv = *(const pg8::f32x4*)(gb + c);
                        *(pg8::f32x4*)(Out + off) = xv + gv * acc[ai][bj][m][n]; }
            }
    }
};


struct EpiNormBf16 {
    static constexpr bool PERM = true, AFTER_DRAIN = false;
    bf16* O; const float* gqk; const float* gbq; const float* gbkv; LAS float* P; bf16* KVC;
    __device__ __forceinline__ void operator()(const pg8::f32x4 (&acc)[2][2][4][2], const pg8::Unit& u, int wr, int wc, int fr, int fq) const {
        const int pn = u.pn;
        const int mode = pn < 4 ? 1 : ((pn == 4 || pn == 5 || pn == 11) ? 0 : (pn == 10 ? 3 : 2));
        if (mode != 0) {
#pragma unroll
            for (int ai = 0; ai < 2; ++ai)
#pragma unroll
                for (int m = 0; m < 4; ++m)
#pragma unroll
                    for (int bj = 0; bj < 2; ++bj) {
                        const pg8::f32x4 a = acc[ai][bj][m][0], b = acc[ai][bj][m][1];
                        float ss = (a[0] * a[0] + a[1] * a[1]) + (a[2] * a[2] + a[3] * a[3]) + (b[0] * b[0] + b[1] * b[1]) + (b[2] * b[2] + b[3] * b[3]);
                        ss += __shfl_xor(ss, 16); ss += __shfl_xor(ss, 32);
                        if (fq == 0) P[(ai * 128 + wr * 64 + m * 16 + fr) * 8 + bj * 4 + wc] = ss;
                    }
            asm volatile("s_waitcnt lgkmcnt(0)" ::: "memory"); __builtin_amdgcn_s_barrier(); asm volatile("" ::: "memory");
        }
        const int row0 = u.pm * 256 + wr * 64 + fr, col0 = u.pn * 256 + wc * 32 + 8 * fq;
        pg8::f32x4 g0[2], g1[2];
#pragma unroll
        for (int bj = 0; bj < 2; ++bj) {
            const float* gp = nullptr;
            if (mode == 1) gp = gqk + (pn >= 2 ? 64 : 0) + 32 * (wc & 1) + 8 * fq;
            else if (mode == 2) gp = gbq + 32 * wc + 8 * fq;
            else if (mode == 3 && bj == 0) gp = gbkv + 32 * wc + 8 * fq;
            if (gp) { g0[bj] = *(const pg8::f32x4*)gp; g1[bj] = *(const pg8::f32x4*)(gp + 4); } else { g0[bj] = (pg8::f32x4){1.f, 1.f, 1.f, 1.f}; g1[bj] = g0[bj]; }
        }
#pragma unroll
        for (int ai = 0; ai < 2; ++ai)
#pragma unroll
            for (int m = 0; m < 4; ++m) { bf16* rowp = O + (size_t)(row0 + ai * 128 + m * 16) * NP + col0;
#pragma unroll
                for (int bj = 0; bj < 2; ++bj) {
                    float s = 1.f;
                    if (mode != 0 && !(mode == 3 && bj == 1)) {
                        const pg8::f32x4 q = *(const LAS pg8::f32x4*)(P + (ai * 128 + wr * 64 + m * 16 + fr) * 8 + bj * 4);
                        s = (mode == 1) ? rsqrtf(((wc < 2) ? (q[0] + q[1]) : (q[2] + q[3])) * (1.f / 64.f) + EPS) : rsqrtf(((q[0] + q[1]) + (q[2] + q[3])) * (1.f / 128.f) + EPS);
                    }
                    const pg8::f32x4 v0 = acc[ai][bj][m][0] * s * g0[bj], v1 = acc[ai][bj][m][1] * s * g1[bj];
                    pg8::u32x4 w; w.x = pg8::cvt_pk_bf16(v0[0], v0[1]); w.y = pg8::cvt_pk_bf16(v0[2], v0[3]); w.z = pg8::cvt_pk_bf16(v1[0], v1[1]); w.w = pg8::cvt_pk_bf16(v1[2], v1[3]);
                    if (pn == 10 && bj == 0) *(pg8::u32x4*)(KVC + (size_t)(row0 + ai * 128 + m * 16) * 128 + wc * 32 + 8 * fq) = w;
                    else *(pg8::u32x4*)(rowp + bj * 128) = w; } }
    }
};
typedef __bf16 bf16x2_t __attribute__((ext_vector_type(2)));
__device__ __forceinline__ float dot2bf(unsigned a, unsigned b, float acc) { return __builtin_amdgcn_fdot2_f32_bf16(__builtin_bit_cast(bf16x2_t, a), __builtin_bit_cast(bf16x2_t, b), acc, false); }
template <int CTRL> __device__ __forceinline__ float dpp_f(float v) { return __int_as_float(__builtin_amdgcn_update_dpp(0, __float_as_int(v), CTRL, 0xf, 0xf, false)); }
__device__ __forceinline__ float row16_sum(float v) {
    v += dpp_f<0x128>(v); v += dpp_f<0x124>(v); v += dpp_f<0x122>(v); v += dpp_f<0x121>(v); return v;
}
__device__ __forceinline__ float gelu_erf(float v) {
    const float av = fabsf(v), t = __builtin_amdgcn_rcpf(fmaf(av, 0.2316418882f, 1.0f));
    float q = fmaf(t, 0.5307027145f, -0.7265760135f); q = fmaf(q, t, 0.7107068705f); q = fmaf(q, t, -0.142248368f); q = fmaf(q, t, 0.127414796f); q = q * t;
    const float e = __builtin_amdgcn_exp2f(v * v * -0.72134752044f);
    const float m = v * (q * e);
    return v < 0.f ? m : v - m;
}

#ifndef DSA_PB
#define DSA_PB 0
#endif
typedef short v4i16_t __attribute__((ext_vector_type(4)));
#ifndef DSA_REP_A
#define DSA_REP_A 1
#endif
#ifndef DSA_REP_B
#define DSA_REP_B 1
#endif
#ifndef DSA_REP_C
#define DSA_REP_C 1
#endif
constexpr int DSA_SROW = 2048 * 4 + 16;
constexpr int DSA_SEL_OFF = 16 * DSA_SROW;
constexpr int DSA_LDS = DSA_SEL_OFF + 16 * 512;
constexpr int DSA_KVROW = 272;

__device__ __forceinline__ unsigned sortkey(float s) { const unsigned u = __float_as_uint(s); return u ^ ((u >> 31) ? 0xffffffffu : 0x80000000u); }
__device__ __forceinline__ unsigned cvtpk_bf16(float lo, float hi) { unsigned r; asm volatile("v_cvt_pk_bf16_f32 %0, %1, %2" : "=v"(r) : "v"(lo), "v"(hi)); return r; }

__device__ __forceinline__ void ph_dsa(const Params& p, unsigned char* lds, int vb, int nvb) {
    const bf16* PROJ = (const bf16*)(p.ws + WS_PROJ); bf16* MIX = (bf16*)(p.ws + WS_MIX);
    const float MB = ((const float*)(p.ws + WS_SCAL))[SC_MB];
    int tid = threadIdx.x; asm volatile("" : "+v"(tid)); const int lane = tid & 63, wv = __builtin_amdgcn_readfirstlane(tid >> 6);
    const int l15 = lane & 15, g = lane >> 4;
    LAS unsigned char* ldsl = (LAS unsigned char*)lds;
    for (int it = vb; it < 2048; it += nvb) {
        const int vbb = it & 255, kk = it >> 8, xg = vbb & 7, ix = vbb >> 3, b = 2 * xg + (ix & 1), G = (ix >> 1) & 3, sub = ix >> 3;
        const int c = (kk & 1) ? (31 - G - 8 * (kk >> 1)) : (G + 8 * (kk >> 1));
        const int cend = (c + 1) * 64, t0 = c * 64 + sub * 16;
        const bf16* Pb = PROJ + (size_t)b * SEQ * NP;
        const bf16* KVb = (const bf16*)(p.ws + WS_KVC) + (size_t)b * SEQ * 128;
#pragma unroll 1
        for (int repa = 0; repa < DSA_REP_A; ++repa)
        if (c >= 4) {
            const bf16* qrow = Pb + (size_t)(t0 + l15) * NP;
            bf16x8 bq[4][2]; float wsc[4];
#pragma unroll
            for (int h = 0; h < 4; ++h) { wsc[h] = bf2f(qrow[C_WI + h]) * 0.0625f;
#pragma unroll
                for (int ks = 0; ks < 2; ++ks) bq[h][ks] = *(const bf16x8*)(qrow + C_QI + h * 64 + 32 * ks + 8 * g); }
            for (int k0 = 16 * wv; k0 < cend; k0 += 128) {
                const bf16* krow = Pb + (size_t)(k0 + l15) * NP + C_KI + 8 * g;
                const bf16x8 ka0 = *(const bf16x8*)krow, ka1 = *(const bf16x8*)(krow + 32);
                f32x4 sc = {0.f, 0.f, 0.f, 0.f};
#pragma unroll
                for (int h = 0; h < 4; ++h) { f32x4 a = {0.f, 0.f, 0.f, 0.f};
                    a = __builtin_amdgcn_mfma_f32_16x16x32_bf16(ka0, bq[h][0], a, 0, 0, 0);
                    a = __builtin_amdgcn_mfma_f32_16x16x32_bf16(ka1, bq[h][1], a, 0, 0, 0);
#pragma unroll
                    for (int r = 0; r < 4; ++r) sc[r] = fmaf(fmaxf(a[r], 0.f), wsc[h], sc[r]); }
#pragma unroll
                for (int r = 0; r < 4; ++r) sc[r] = (sc[r] == 0.f) ? 0.f : sc[r];
                *(LAS f32x4*)(ldsl + l15 * DSA_SROW + (k0 + 4 * g) * 4) = sc;
            }
        }
        __syncthreads();
        LAS unsigned short* selw = (LAS unsigned short*)(ldsl + DSA_SEL_OFF);
        int mind0 = 0, mind1 = 0;
        if (c < 4) {
            for (int j = lane; j < 256; j += 64) { selw[(2 * wv) * 256 + j] = (unsigned short)j; selw[(2 * wv + 1) * 256 + j] = (unsigned short)j; }
        } else {
            const int nreg = cend >> 6;
            unsigned keyA[32], keyB[32];
            { const LAS float* srA = (const LAS float*)(ldsl + (2 * wv) * DSA_SROW) + lane; const LAS float* srB = (const LAS float*)(ldsl + (2 * wv + 1) * DSA_SROW) + lane;
#pragma unroll
              for (int i = 0; i < 32; ++i) { keyA[i] = (i < nreg) ? sortkey(srA[64 * i]) : 0u; keyB[i] = (i < nreg) ? sortkey(srB[64 * i]) : 0u; } }
#define DSA_WSUM(V, OUT) do { int v_ = (V); v_ += __builtin_amdgcn_update_dpp(0, v_, 0x128, 0xf, 0xf, false); v_ += __builtin_amdgcn_update_dpp(0, v_, 0x124, 0xf, 0xf, false); \
        v_ += __builtin_amdgcn_update_dpp(0, v_, 0x122, 0xf, 0xf, false); v_ += __builtin_amdgcn_update_dpp(0, v_, 0x121, 0xf, 0xf, false);                                     \
        OUT = __builtin_amdgcn_readlane(v_, 0) + __builtin_amdgcn_readlane(v_, 16) + __builtin_amdgcn_readlane(v_, 32) + __builtin_amdgcn_readlane(v_, 48); } while (0)
            unsigned prefA = 0u, prefB = 0u; bool exA = false, exB = false;
#pragma unroll 1
            for (int rep_ = 0; rep_ < (DSA_PB == 1 ? 2 : 1); ++rep_) { prefA = 0u; prefB = 0u; exA = false; exB = false;
#pragma unroll 1
            for (int bit = 31; bit >= 0; --bit) {
                const unsigned candA = exA ? prefA : (prefA | (1u << bit)), candB = exB ? prefB : (prefB | (1u << bit));
                int ca = 0, cb = 0;
#pragma unroll
                for (int i = 0; i < 32; ++i) { ca += (keyA[i] >= candA) ? 1 : 0; cb += (keyB[i] >= candB) ? 1 : 0; }
                int cntA, cntB; DSA_WSUM(ca, cntA); DSA_WSUM(cb, cntB);
                if (!exA && cntA >= 256) { prefA = candA; exA = (cntA == 256); }
                if (!exB && cntB >= 256) { prefB = candB; exB = (cntB == 256); }
                if (exA && exB) break;
            }
            asm volatile("" : "+s"(prefA), "+s"(prefB)); }
#define DSA_COMPACT(KEY, PREFIX, EXACT, QQ, MIND) do {                                                                                              \
            const int t_ = t0 + (QQ); LAS unsigned short* sel = selw + (QQ) * 256;                                                                    \
            int need_ties = 0;                                                                                                                        \
            if (!(EXACT)) { int cg_ = 0; if ((PREFIX) != 0xffffffffu) { _Pragma("unroll") for (int i = 0; i < 32; ++i) cg_ += (KEY[i] > (PREFIX)) ? 1 : 0; } \
                int cgt; DSA_WSUM(cg_, cgt); need_ties = 256 - cgt; }                                                                                 \
            int base = 0, tbase = 0, md = 4096;                                                                                                       \
            _Pragma("unroll") for (int i = 0; i < 32; ++i) { if (i < nreg) {                                                                          \
                bool selb;                                                                                                                            \
                if (EXACT) selb = KEY[i] >= (PREFIX);                                                                                                 \
                else { const bool tie = KEY[i] == (PREFIX); const unsigned long long mt = __ballot(tie);                                              \
                    const int trank = tbase + (int)__builtin_amdgcn_mbcnt_hi((unsigned)(mt >> 32), __builtin_amdgcn_mbcnt_lo((unsigned)mt, 0u));      \
                    selb = (KEY[i] > (PREFIX)) || (tie && trank < need_ties); tbase += __popcll(mt); }                                                \
                const unsigned long long m = __ballot(selb);                                                                                          \
                const int pos = base + (int)__builtin_amdgcn_mbcnt_hi((unsigned)(m >> 32), __builtin_amdgcn_mbcnt_lo((unsigned)m, 0u));               \
                const int kidx = i * 64 + lane;                                                                                                       \
                if (selb) { sel[pos] = (unsigned short)kidx; const int d = t_ > kidx ? t_ - kidx : kidx - t_; md = d < md ? d : md; }                 \
                base += __popcll(m); } }                                                                                                              \
            _Pragma("unroll") for (int o = 1; o < 64; o <<= 1) { const int x = __shfl_xor(md, o); md = x < md ? x : md; }                             \
            MIND = md; } while (0)
            DSA_COMPACT(keyA, prefA, exA, 2 * wv, mind0);
            DSA_COMPACT(keyB, prefB, exB, 2 * wv + 1, mind1);
            if (DSA_PB == 2) { DSA_COMPACT(keyA, prefA, exA, 2 * wv, mind0); DSA_COMPACT(keyB, prefB, exB, 2 * wv + 1, mind1); }
#undef DSA_COMPACT
#undef DSA_WSUM
        }
        LDS_WAIT(); asm volatile("" ::: "memory");
        const int nvalid = cend < 256 ? cend : 256;
        const int head = lane & 7;
        const float slopeL2 = exp2f(-(float)(head + 1)) * 1.4426950409f;
#pragma unroll 1
        for (int qi2 = 0; qi2 < 2 * DSA_REP_C; ++qi2) { const int qi = qi2 & 1;
            const int qq = 2 * wv + qi, t = t0 + qq;
            const LAS unsigned short* sel = selw + qq * 256;
            LAS unsigned char* stg = ldsl + (2 * wv) * DSA_SROW;
            const bf16* qrow = Pb + (size_t)t * NP + C_QB + head * 128 + 8 * g;
            bf16x8 bq[4];
#pragma unroll
            for (int ks = 0; ks < 4; ++ks) bq[ks] = *(const bf16x8*)(qrow + 32 * ks);
            const float refL2 = MB * 1.4426950409f - slopeL2 * (float)(qi == 0 ? mind0 : mind1);
            f32x4 o[8];
#pragma unroll
            for (int dt = 0; dt < 8; ++dt) o[dt] = (f32x4){0.f, 0.f, 0.f, 0.f};
            float lsum = 0.f;
#define DSA_GATHER(S, KA) do { _Pragma("unroll") for (int i_ = 0; i_ < 8; ++i_) { const int jr = 32 * (S) + 4 * i_ + g; const int keyr = sel[jr < nvalid ? jr : 0];   \
        KA[i_] = *(const bf16x8*)(KVb + (size_t)keyr * 128 + 8 * l15); } } while (0)
#define DSA_COMPUTE(S, KA) do { unsigned pb[4];                                                                                                        \
        _Pragma("unroll") for (int i_ = 0; i_ < 8; ++i_) *(LAS bf16x8*)(stg + (4 * i_ + g) * DSA_KVROW + 16 * l15) = KA[i_];                              \
        LDS_WAIT(); asm volatile("" ::: "memory");                                                                                                        \
        _Pragma("unroll") for (int tl = 0; tl < 2; ++tl) { const int j0 = 32 * (S) + 16 * tl;                                                           \
            f32x4 a = {0.f, 0.f, 0.f, 0.f};                                                                                                             \
            _Pragma("unroll") for (int ks = 0; ks < 4; ++ks) { const bf16x8 ka_ = *(const LAS bf16x8*)(stg + (16 * tl + l15) * DSA_KVROW + (32 * ks + 8 * g) * 2); \
                a = __builtin_amdgcn_mfma_f32_16x16x32_bf16(ka_, bq[ks], a, 0, 0, 0); }                                                                 \
            const u32x2 kw = *(const LAS u32x2*)(sel + j0 + 4 * g);                                                                                     \
            const int kx[4] = {(int)(kw.x & 0xffffu), (int)(kw.x >> 16), (int)(kw.y & 0xffffu), (int)(kw.y >> 16)};                                     \
            float pr[4];                                                                                                                                \
            _Pragma("unroll") for (int r = 0; r < 4; ++r) { const int dd = t > kx[r] ? t - kx[r] : kx[r] - t;                                            \
                const float e = __builtin_amdgcn_exp2f(fmaf(a[r], 0.1275174f, -slopeL2 * (float)dd - refL2));                                            \
                pr[r] = (j0 + 4 * g + r < nvalid) ? e : 0.f; lsum += pr[r]; }                                                                           \
            pb[2 * tl] = cvtpk_bf16(pr[0], pr[1]); pb[2 * tl + 1] = cvtpk_bf16(pr[2], pr[3]); }                                                         \
        LDS_WAIT(); asm volatile("" ::: "memory");                                                                                                      \
        u32x4 pw4; pw4.x = pb[0]; pw4.y = pb[1]; pw4.z = pb[2]; pw4.w = pb[3];                                                                          \
        const bf16x8 pfrag = __builtin_bit_cast(bf16x8, pw4);                                                                                           \
        const LAS unsigned char* trb = stg + (4 * g + (l15 >> 2)) * DSA_KVROW + (4 * (lane & 3)) * 2;                                                   \
        _Pragma("unroll") for (int dt = 0; dt < 8; ++dt) {                                                                                              \
            const s16x4 lo = __builtin_bit_cast(s16x4, __builtin_amdgcn_ds_read_tr16_b64_v4i16((LAS v4i16_t*)(trb + dt * 32)));                         \
            const s16x4 hi = __builtin_bit_cast(s16x4, __builtin_amdgcn_ds_read_tr16_b64_v4i16((LAS v4i16_t*)(trb + 16 * DSA_KVROW + dt * 32)));        \
            const bf16x8 af = {lo[0], lo[1], lo[2], lo[3], hi[0], hi[1], hi[2], hi[3]};                                                                 \
            o[dt] = __builtin_amdgcn_mfma_f32_16x16x32_bf16(af, pfrag, o[dt], 0, 0, 0); }                                                               \
        LDS_WAIT(); asm volatile("" ::: "memory"); } while (0)
            const int nch = (nvalid + 31) >> 5;
            bf16x8 KA[8], KB[8];
            DSA_GATHER(0, KA);
#pragma unroll 1
            for (int s = 0; s < nch; s += 2) {
                if (s + 1 < nch) DSA_GATHER(s + 1, KB);
                DSA_COMPUTE(s, KA);
                if (s + 1 < nch) { if (s + 2 < nch) DSA_GATHER(s + 2, KA); DSA_COMPUTE(s + 1, KB); }
            }
#undef DSA_GATHER
#undef DSA_COMPUTE
            lsum += __shfl_xor(lsum, 16); lsum += __shfl_xor(lsum, 32);
            const float il = 1.f / lsum;
            if (l15 < 8) {
                bf16* orow = MIX + (size_t)(b * SEQ + t) * MIXW + 512 + head * 128 + 4 * g;
#pragma unroll
                for (int dt = 0; dt < 8; ++dt) { u32x2 w; w.x = pk2(o[dt][0] * il, o[dt][1] * il); w.y = pk2(o[dt][2] * il, o[dt][3] * il); *(u32x2*)(orow + 16 * dt) = w; }
            }
        }
        __syncthreads();
    }
}
typedef __attribute__((address_space(1))) float GASF;
#ifndef ATT_PROBE
#define ATT_PROBE 0
#endif
#ifndef ATT_REMAP
#define ATT_REMAP 1
#endif
__device__ __forceinline__ int crow(int r, int hi) { return (r & 3) + 8 * (r >> 2) + 4 * hi; }
#define KSWZ64(row, cb) ((row) * 128 + ((cb) ^ ((((row) >> 1) & 7) << 4)))
__device__ __forceinline__ int v_st(int k, int c) { const int kk = (k & ~0xC) | ((k & 4) << 1) | ((k & 8) >> 1); return ((kk >> 3) * 4 + (c >> 5)) * 512 + ((kk & 7) * 32 + (c & 31)) * 2; }
__device__ __forceinline__ int v_rd_base(int lane) { return ((lane & 3) << 3) | (((lane >> 2) & 3) << 6) | (((lane >> 4) & 1) << 5) | (((lane >> 5) & 1) << 8); }
constexpr int v_rd_off(int d0, int ks, int half) { return d0 * 512 + ks * 4096 + half * 2048; }
template <int OFF> __device__ __forceinline__ s16x4 tr_read(int vb) {
    s16x4 r; asm volatile("ds_read_b64_tr_b16 %0, %1 offset:%2" : "=&v"(r) : "v"(vb), "i"(OFF) : "memory"); return r;
}
template <int D0> __device__ __forceinline__ void pv_one(f32x16& od, int vb, bf16x8 pa0, bf16x8 pa1, bf16x8 pa2, bf16x8 pa3) {
    const s16x4 l0 = tr_read<v_rd_off(D0, 0, 0)>(vb), h0 = tr_read<v_rd_off(D0, 0, 1)>(vb), l1 = tr_read<v_rd_off(D0, 1, 0)>(vb), h1 = tr_read<v_rd_off(D0, 1, 1)>(vb);
    const s16x4 l2 = tr_read<v_rd_off(D0, 2, 0)>(vb), h2 = tr_read<v_rd_off(D0, 2, 1)>(vb), l3 = tr_read<v_rd_off(D0, 3, 0)>(vb), h3 = tr_read<v_rd_off(D0, 3, 1)>(vb);
    asm volatile("s_waitcnt lgkmcnt(0)" ::: "memory"); __builtin_amdgcn_sched_barrier(0);
#define PK(L, H) (bf16x8){L[0], L[1], L[2], L[3], H[0], H[1], H[2], H[3]}
    od = __builtin_amdgcn_mfma_f32_32x32x16_bf16(pa0, PK(l0, h0), od, 0, 0, 0);
    od = __builtin_amdgcn_mfma_f32_32x32x16_bf16(pa1, PK(l1, h1), od, 0, 0, 0);
    od = __builtin_amdgcn_mfma_f32_32x32x16_bf16(pa2, PK(l2, h2), od, 0, 0, 0);
    od = __builtin_amdgcn_mfma_f32_32x32x16_bf16(pa3, PK(l3, h3), od, 0, 0, 0);
#undef PK
}

__device__ __forceinline__ void att_tile(f32x16 (&o)[4], float& lsum, const unsigned char* Kb, int vb0, const unsigned char* Qw, int r32, int hi, int tq, int j, bool past, float slopeL2, float refL2) {
    constexpr float C = 0.125f * 1.4426950409f;
    bf16x8 qr[4];
#pragma unroll
    for (int d0 = 0; d0 < 4; ++d0) qr[d0] = *(const bf16x8*)(Qw + KSWZ64(r32, (d0 * 16 + hi * 8) * 2));
    const float dq = (float)(tq - 64 * j - 4 * hi);
    const float B0 = -slopeL2 * dq - refL2;
    float ps = 0.f;
    bf16x8 pa0, pa1, pa2, pa3;
#define PK4(P, BASE, OUT) do { unsigned a0 = cvtpk_bf16(P[BASE + 0], P[BASE + 1]), a1 = cvtpk_bf16(P[BASE + 2], P[BASE + 3]);   \
    unsigned b0_ = cvtpk_bf16(P[BASE + 4], P[BASE + 5]), b1_ = cvtpk_bf16(P[BASE + 6], P[BASE + 7]);                              \
    auto r0 = __builtin_amdgcn_permlane32_swap(a0, b0_, false, false); auto r1 = __builtin_amdgcn_permlane32_swap(a1, b1_, false, false); \
    u32x4 w = {r0[0], r1[0], r0[1], r1[1]}; OUT = __builtin_bit_cast(bf16x8, w); } while (0)
#define HALF_TILE(KOFF, FOFF, PA, PB) do { f32x16 pp = f32x16{};                                                                     \
    _Pragma("unroll") for (int d0 = 0; d0 < 4; ++d0) { const int cb = (d0 * 16 + hi * 8) * 2;                                        \
        const bf16x8 bk = *(const bf16x8*)(Kb + KSWZ64((KOFF) + r32, cb)); pp = __builtin_amdgcn_mfma_f32_32x32x16_bf16(bk, qr[d0], pp, 0, 0, 0); } \
    if (past) { _Pragma("unroll") for (int r = 0; r < 16; ++r) { const float off = (float)((r & 3) + 8 * (r >> 2)) + (FOFF);          \
            pp[r] = __builtin_amdgcn_exp2f(fmaf(pp[r], C, fmaf(slopeL2, off, B0))); } }                                               \
    else { _Pragma("unroll") for (int r = 0; r < 16; ++r) { const float off = (float)((r & 3) + 8 * (r >> 2)) + (FOFF);               \
            pp[r] = __builtin_amdgcn_exp2f(fmaf(pp[r], C, -slopeL2 * fabsf(dq - off) - refL2)); } }                                   \
    _Pragma("unroll") for (int r = 0; r < 16; ++r) ps += pp[r];                                                                       \
    PK4(pp, 0, PA); PK4(pp, 8, PB); __builtin_amdgcn_sched_barrier(0); } while (0)
    HALF_TILE(0, 0.f, pa0, pa1);
    HALF_TILE(32, 32.f, pa2, pa3);
#undef HALF_TILE
#undef PK4
    { auto rr = __builtin_amdgcn_permlane32_swap(__float_as_uint(ps), __float_as_uint(ps), false, false);
      ps = __uint_as_float(rr[0]) + __uint_as_float(rr[1]); }
    lsum += ps;
    pv_one<0>(o[0], vb0, pa0, pa1, pa2, pa3); pv_one<1>(o[1], vb0, pa0, pa1, pa2, pa3); pv_one<2>(o[2], vb0, pa0, pa1, pa2, pa3); pv_one<3>(o[3], vb0, pa0, pa1, pa2, pa3);
}
constexpr int ATT_LDS = 2 * 16384 + 2 * 8192 + 8 * 256 + 8 * 4096;

__device__ __forceinline__ void ph_attnA(const Params& p, unsigned char* lds, int vb, int nvb) {
    const bf16* PROJ = (const bf16*)(p.ws + WS_PROJ); bf16* MIX = (bf16*)(p.ws + WS_MIX);
    const float* SC = (const float*)(p.ws + WS_SCAL);
    const float lam = SC[SC_LAM], refL2 = SC[SC_MA] * 1.4426950409f;
    constexpr float C = 0.125f * 1.4426950409f;
    int tid = threadIdx.x; asm volatile("" : "+v"(tid)); const int lane = tid & 63, wid = __builtin_amdgcn_readfirstlane(tid >> 6), r32 = lane & 31, hi = lane >> 5;
    unsigned char* V_lds = lds; unsigned char* K_lds = lds + 32768;
    float* wsf = (float*)(lds + 49152) + wid * 64;
    GASF* tmpw = (GASF*)(p.ws + WS_ATMP) + ((size_t)(vb * NWV + wid) * 64) * 64 + lane;
    const int vbase = (int)(uintptr_t)V_lds + v_rd_base(lane);
    const int krow = tid >> 3, kch = tid & 7, kdst = KSWZ64(krow, kch * 16);
    const int sr = tid >> 4, sc = (tid & 15) * 8, vst0 = v_st(sr, sc), vst1 = v_st(32 + sr, sc);
    for (int it = vb; it < 256; it += nvb) {
        #if ATT_REMAP
        const int xg_ = it & 7, m_ = it >> 3, pidx = xg_ * 8 + (m_ >> 2), qbl = m_ & 3, b = pidx >> 2, h = pidx & 3;
#else
        const int b = it >> 4, h = (it >> 2) & 3, qbl = it & 3;
#endif
        const float slopeL2 = exp2f(-2.0f * (float)(h + 1)) * 1.4426950409f;
        const bf16* Pb = PROJ + (size_t)b * SEQ * NP;
#pragma unroll 1
        for (int half = 0; half < 2; ++half) {
            const int qb = half ? 7 - qbl : qbl, q0 = 256 * qb, NTu = 4 * (qb + 1), cw = 4 * qb + (wid >> 1);
            const int tq = q0 + 32 * wid + r32;
#pragma unroll 1
            for (int mi = 0; mi < 2; ++mi) {
                const int m = 1 - mi;
                const bf16* Kg = Pb + C_KA + h * 128 + m * 64 + (size_t)krow * NP + kch * 8;
                const bf16* Vg = Pb + C_VA + h * 128 + (size_t)sr * NP + sc;
                unsigned char* Qw = lds + 51200 + wid * 4096;
                { const bf16* qp = Pb + (size_t)tq * NP + C_QA + h * 128 + m * 64 + hi * 8;
#pragma unroll
                  for (int d0 = 0; d0 < 4; ++d0) *(bf16x8*)(Qw + KSWZ64(r32, (d0 * 16 + hi * 8) * 2)) = *(const bf16x8*)(qp + d0 * 16); }
                f32x16 o[4];
#pragma unroll
                for (int d = 0; d < 4; ++d) o[d] = f32x16{};
                float lsum = 0.f;
                bf16x8 ak, av0, av1;
#define ATT_LOAD(K_, V0_, V1_, TJ) do { const size_t go_ = (size_t)(TJ) * 64 * NP; K_ = *(const bf16x8*)(Kg + go_); V0_ = *(const bf16x8*)(Vg + go_); V1_ = *(const bf16x8*)(Vg + go_ + (size_t)32 * NP); \
        if (ATT_PROBE == 2) { bf16x8 d0_ = *(const volatile bf16x8*)(Kg + go_); bf16x8 d1_ = *(const volatile bf16x8*)(Vg + go_); bf16x8 d2_ = *(const volatile bf16x8*)(Vg + go_ + (size_t)32 * NP); asm volatile("" :: "v"(d0_), "v"(d1_), "v"(d2_)); } } while (0)
#define ATT_WRITE(K_, V0_, V1_, NB) do { *(bf16x8*)(K_lds + (NB) * 8192 + kdst) = K_; *(bf16x8*)(V_lds + (NB) * 16384 + vst0) = V0_; *(bf16x8*)(V_lds + (NB) * 16384 + vst1) = V1_; } while (0)
                ATT_LOAD(ak, av0, av1, 0); ATT_WRITE(ak, av0, av1, 0);
                __syncthreads();
#pragma unroll 1
                for (int j = 0; j < NTu; ++j) {
                    const int buf = j & 1;
                    if (j + 1 < NTu) ATT_LOAD(ak, av0, av1, j + 1);
                    if (j <= cw) { att_tile(o, lsum, K_lds + buf * 8192, vbase + buf * 16384, Qw, r32, hi, tq, j, j < cw, slopeL2, refL2);
#if ATT_PROBE == 1
                        { f32x16 o2[4]; o2[0] = o[0]; o2[1] = o[1]; o2[2] = o[2]; o2[3] = o[3]; float l2 = 0.f; att_tile(o2, l2, K_lds + buf * 8192, vbase + buf * 16384, Qw, r32, hi, tq, j, j < cw, slopeL2, refL2);
                          asm volatile("" :: "v"(o2[0]), "v"(o2[1]), "v"(o2[2]), "v"(o2[3]), "v"(l2)); }
#endif
                    }
                    if (j + 1 < NTu) ATT_WRITE(ak, av0, av1, buf ^ 1);
                    __syncthreads();
                }
#undef ATT_LOAD
#undef ATT_WRITE
                if (hi == 0) wsf[r32] = lsum;
                LDS_WAIT(); asm volatile("" ::: "memory");
                float rli[16];
#pragma unroll
                for (int r = 0; r < 16; ++r) rli[r] = 1.f / wsf[crow(r, hi)];
                LDS_WAIT(); asm volatile("" ::: "memory");
                if (mi == 0) {
#pragma unroll
                    for (int d = 0; d < 4; ++d) { GASF* td = tmpw + d * 1024; asm volatile("" : "+v"(td));
#pragma unroll
                        for (int r = 0; r < 16; ++r) td[r * 64] = o[d][r] * rli[r]; }
                } else {
                    float gsub[4];
#pragma unroll
                    for (int d = 0; d < 4; ++d) gsub[d] = p.a_sub_gain[32 * d + r32];
                    GASF* tdp[4];
#pragma unroll
                    for (int d = 0; d < 4; ++d) { tdp[d] = tmpw + d * 1024; asm volatile("" : "+v"(tdp[d])); }
#pragma unroll
                    for (int r = 0; r < 16; ++r) {
                        float v[4]; float ss = 0.f;
#pragma unroll
                        for (int d = 0; d < 4; ++d) { v[d] = o[d][r] * rli[r] - lam * tdp[d][r * 64]; ss += v[d] * v[d]; }
                        ss += __shfl_xor(ss, 1); ss += __shfl_xor(ss, 2); ss += __shfl_xor(ss, 4); ss += __shfl_xor(ss, 8); ss += __shfl_xor(ss, 16);
                        const float rs = rsqrtf(ss * (1.f / 128.f) + EPS) * 0.8f;
                        bf16* orow = MIX + (size_t)(b * SEQ + q0 + 32 * wid + crow(r, hi)) * MIXW + h * 128 + r32;
#pragma unroll
                        for (int d = 0; d < 4; ++d) orow[32 * d] = (bf16)f2bf(v[d] * rs * gsub[d]);
                        asm volatile("" ::: "memory");
                    }
                }
            }
        }
    }
}
constexpr int RT_WAVE_BYTES = 12288;
constexpr int RT_LDS = 32768 + 8 * RT_WAVE_BYTES;

__device__ __forceinline__ int pl32_sum(int v) { auto rr = __builtin_amdgcn_permlane32_swap((unsigned)v, (unsigned)v, false, false); return (int)(rr[0] + rr[1]); }
__device__ __forceinline__ int pl32_other(int v) { auto rr = __builtin_amdgcn_permlane32_swap((unsigned)v, (unsigned)v, false, false); return (int)(rr[0] + rr[1]) - v; }
__device__ __forceinline__ float unsortkey(unsigned k) { return __uint_as_float((k & 0x80000000u) ? (k ^ 0x80000000u) : ~k); }

template <int N> __device__ __forceinline__ unsigned bisect16(const unsigned (&key)[N]) {
    unsigned prefix = 0u; bool done = false;
#pragma unroll 1
    for (int bit = 31; bit >= 0; --bit) {
        const unsigned cand = done ? prefix : (prefix | (1u << bit));
        int cnt = 0;
#pragma unroll
        for (int i = 0; i < N; ++i) cnt += (key[i] >= cand) ? 1 : 0;
        const int tot = pl32_sum(cnt);
        if (!done && tot >= 16) { prefix = cand; done = (tot == 16); }
        if (__all(done)) break;
    }
    return prefix;
}

__device__ __forceinline__ void ph_route(const Params& p, unsigned char* lds, int vb, int nvb) {
    const bf16* Q3 = (const bf16*)(p.ws + WS_Q3); const bf16* SUBK = (const bf16*)(p.ws + WS_SUBK);
    int* EXPI = (int*)(p.ws + WS_EXP); float* GATE = (float*)(p.ws + WS_GATE);
    int tid = threadIdx.x; asm volatile("" : "+v"(tid));
    const int lane = tid & 63, wv = __builtin_amdgcn_readfirstlane(tid >> 6), r32 = lane & 31, hi = lane >> 5;
    for (int i = tid; i < 2048; i += NT) { const int row = i >> 3, ch = i & 7; ((u32x4*)lds)[row * 8 + (ch ^ ((row >> 1) & 7))] = ((const u32x4*)SUBK)[i]; }
    __syncthreads();
    unsigned char* wl = lds + 32768 + wv * RT_WAVE_BYTES;
    float* sv = (float*)wl; int* si = (int*)(wl + 4096); float* fv = (float*)(wl + 8192); int* fe = (int*)(wl + 10240);
    const int gw = vb * NWV + wv, ngw = nvb * NWV;
    for (int item = gw; item < (T / 32) * 8; item += ngw) {
        const int h = item & 7, tok0 = (item >> 3) * 32;
        const bf16* qrow = Q3 + (size_t)(tok0 + r32) * 1024 + h * 128 + hi * 8;
#pragma unroll 1
        for (int c = 0; c < 2; ++c) {
            bf16x8 bq[4];
#pragma unroll
            for (int d0 = 0; d0 < 4; ++d0) bq[d0] = *(const bf16x8*)(qrow + c * 64 + d0 * 16);
            unsigned key[64];
#pragma unroll
            for (int nt = 0; nt < 4; ++nt) {
                f32x16 acc = f32x16{};
                const int krow = c * 128 + nt * 32 + r32, ksw = (krow >> 1) & 7;
                const unsigned char* kp = lds + krow * 128;
#pragma unroll
                for (int d0 = 0; d0 < 4; ++d0) { const bf16x8 ak = *(const bf16x8*)(kp + (((2 * d0 + hi) ^ ksw) << 4)); acc = __builtin_amdgcn_mfma_f32_32x32x16_bf16(ak, bq[d0], acc, 0, 0, 0); }
#pragma unroll
                for (int r = 0; r < 16; ++r) key[nt * 16 + r] = sortkey(acc[r]);
            }
            const unsigned thr = bisect16<64>(key);
            int cnt = 0;
#pragma unroll
            for (int i = 0; i < 64; ++i) cnt += (key[i] >= thr) ? 1 : 0;
            const int other_ = pl32_other(cnt); int slot = hi ? other_ : 0;
            float* svp = sv + (r32 * 2 + c) * 16; int* sip = si + (r32 * 2 + c) * 16;
#pragma unroll
            for (int i = 0; i < 64; ++i) {
                if (key[i] >= thr && slot < 16) { svp[slot] = unsortkey(key[i]); sip[slot] = 32 * (i >> 4) + ((i & 3) + 8 * ((i & 15) >> 2)) + 4 * hi; ++slot; }
            }
        }
        LDS_WAIT(); asm volatile("" ::: "memory");
        {
            float* sv0 = sv + (r32 * 2) * 16; float* sv1 = sv0 + 16; int* si0 = si + (r32 * 2) * 16; int* si1 = si0 + 16;
            {
                float a[16], bl[16];
#pragma unroll
                for (int k = 0; k < 16; ++k) { a[k] = sv0[k]; bl[k] = sv1[k]; }
                int ia[8], ib[8], ra[8], rb[8]; float va[8], vb[8];
#pragma unroll
                for (int q = 0; q < 8; ++q) { const int e = 8 * hi + q; va[q] = sv0[e]; vb[q] = sv1[e]; ia[q] = si0[e]; ib[q] = si1[e]; int r0 = 0, r1 = 0;
#pragma unroll
                    for (int k = 0; k < 16; ++k) { r0 += (a[k] > va[q] || (a[k] == va[q] && k < e)) ? 1 : 0; r1 += (bl[k] > vb[q] || (bl[k] == vb[q] && k < e)) ? 1 : 0; }
                    ra[q] = r0; rb[q] = r1; }
                LDS_WAIT(); asm volatile("" ::: "memory");
                { auto rr = __builtin_amdgcn_permlane32_swap(0u, 0u, false, false); (void)rr; }
#pragma unroll
                for (int q = 0; q < 8; ++q) { sv0[ra[q]] = va[q]; si0[ra[q]] = ia[q]; sv1[rb[q]] = vb[q]; si1[rb[q]] = ib[q]; }
                LDS_WAIT(); asm volatile("" ::: "memory");
            }
            const float* X = hi ? sv1 : sv0; const float* Y = hi ? sv0 : sv1;
            float x[4], y[16];
#pragma unroll
            for (int k = 0; k < 4; ++k) x[k] = X[k];
#pragma unroll
            for (int k = 0; k < 16; ++k) y[k] = Y[k];
            unsigned key[27]; int pi[27], pj[27]; int np = 0;
#pragma unroll
            for (int i = 0; i < 3; ++i)
#pragma unroll
                for (int j = i + 1; j < 16; ++j) if ((i + 1) * (j + 1) <= 16) { key[np] = sortkey(x[i] + y[j]); pi[np] = i; pj[np] = j; ++np; }
#pragma unroll
            for (int i = 0; i < 4; ++i) { key[23 + i] = hi ? 0u : sortkey(x[i] + y[i]); pi[23 + i] = i; pj[23 + i] = i; }
            const unsigned thr = bisect16<27>(key);
            int cnt = 0;
#pragma unroll
            for (int i = 0; i < 27; ++i) cnt += (key[i] >= thr) ? 1 : 0;
            const int other_ = pl32_other(cnt); int slot = hi ? other_ : 0;
            const int* IX = hi ? si1 : si0; const int* IY = hi ? si0 : si1;
            float* fvp = fv + r32 * 16; int* fep = fe + r32 * 16;
#pragma unroll
            for (int i = 0; i < 27; ++i) {
                if (key[i] >= thr && slot < 16) { const int ex = IX[pi[i]], ey = IY[pj[i]]; fvp[slot] = unsortkey(key[i]); fep[slot] = hi ? (ey * 128 + ex) : (ex * 128 + ey); ++slot; }
            }
        }
        LDS_WAIT(); asm volatile("" ::: "memory");
        {
            const float* fvp = fv + r32 * 16;
            float v[16]; float mx = -3e38f;
#pragma unroll
            for (int k = 0; k < 16; ++k) { v[k] = fvp[k]; mx = fmaxf(mx, v[k]); }
            float l = 0.f;
#pragma unroll
            for (int k = 0; k < 16; ++k) { v[k] = __expf(v[k] - mx); l += v[k]; }
            const float il = 1.f / l;
            const size_t ob = (size_t)(tok0 + r32) * 128 + h * 16 + 8 * hi;
            const int* fep = fe + r32 * 16 + 8 * hi;
            f32x4 g0, g1; u32x4 e0, e1;
            if (hi == 0) { g0 = (f32x4){v[0] * il, v[1] * il, v[2] * il, v[3] * il}; g1 = (f32x4){v[4] * il, v[5] * il, v[6] * il, v[7] * il}; }
            else { g0 = (f32x4){v[8] * il, v[9] * il, v[10] * il, v[11] * il}; g1 = (f32x4){v[12] * il, v[13] * il, v[14] * il, v[15] * il}; }
            e0 = *(const u32x4*)fep; e1 = *(const u32x4*)(fep + 4);
            *(f32x4*)(GATE + ob) = g0; *(f32x4*)(GATE + ob + 4) = g1;
            *(u32x4*)(EXPI + ob) = e0; *(u32x4*)(EXPI + ob + 4) = e1;
        }
        LDS_WAIT(); asm volatile("" ::: "memory");
    }
    __syncthreads();
}
typedef float f32x2_t __attribute__((ext_vector_type(2)));
constexpr int P8_UNITS = T / 64;
constexpr int CW_P8_U = 4096, CW_P8_V = 4096 + 32 * 64;
constexpr float U8_SCALE = 32.0f;
__device__ __forceinline__ unsigned peer_xcc() { return (unsigned)__builtin_amdgcn_s_getreg((3 << 11) | 20) & 7u; }
#ifndef U8_HALVES
#define U8_HALVES 0
#endif
template <int LPR>
__device__ __forceinline__ void ph_peer_v8g(const Params& p, unsigned char* lds) {
    constexpr int RPI = 64 / LPR, NI = 128 / RPI, G = NI / 8, NS = 64 / LPR, SLB = 16 * LPR;
    const unsigned char* V8 = (const unsigned char*)(p.ws + WS_V16);
    const int* EXPI = (const int*)(p.ws + WS_EXP); const float* CBUF = (const float*)(p.ws + WS_CBUF); const float* MOD = (const float*)(p.ws + WS_MOD);
    const float* AB1 = (const float*)(p.ws + WS_ABUF1); const float* GATEP = (const float*)(p.ws + WS_GATE); (void)AB1; (void)GATEP;
    unsigned* ctl = (unsigned*)(p.ws + WS_CTL);
    int tid = threadIdx.x; asm volatile("" : "+v"(tid));
    const int lane = tid & 63, wv = __builtin_amdgcn_readfirstlane(tid >> 6), gR = lane / LPR, iC = lane % LPR;
    volatile LAS unsigned* slot = (volatile LAS unsigned*)(LAS unsigned char*)lds;
    const unsigned xcc = peer_xcc();
#pragma unroll 1
    for (int k = 0; k < NS; ++k) {
        const int sl = (int)((((xcc * NS) >> 3) + (unsigned)k) % (unsigned)NS);
        const unsigned char* vcol = V8 + SLB * sl + 16 * iC;
#pragma unroll 1
        for (;;) {
            if (tid == 0) *slot = __hip_atomic_fetch_add(ctl + CW_P8_V + 64 * sl, 1u, __ATOMIC_RELAXED, __HIP_MEMORY_SCOPE_AGENT);
            __syncthreads();
            const unsigned unit = *slot;
            __syncthreads();
            if (unit >= (unsigned)P8_UNITS) break;
            const int tbase = (int)unit * 64 + wv * 8;
            int ne0, ne1; float nc0, nc1;
#if U8_HALVES
#define VG_FETCH(T) do { const size_t tn_ = (size_t)(T); ne0 = EXPI[tn_ * 128 + lane]; ne1 = EXPI[tn_ * 128 + 64 + lane];                              \
        nc0 = gelu_erf(CBUF[tn_ * 128 + lane] + AB1[tn_ * 128 + lane]) * GATEP[tn_ * 128 + lane];                                              \
        nc1 = gelu_erf(CBUF[tn_ * 128 + 64 + lane] + AB1[tn_ * 128 + 64 + lane]) * GATEP[tn_ * 128 + 64 + lane]; } while (0)
#else
#define VG_FETCH(T) do { const size_t tn_ = (size_t)(T); ne0 = EXPI[tn_ * 128 + lane]; ne1 = EXPI[tn_ * 128 + 64 + lane]; nc0 = CBUF[tn_ * 128 + lane]; nc1 = CBUF[tn_ * 128 + 64 + lane]; } while (0)
#endif
#define VG_LISTS(LE, LC) do { LE[lane] = ne0; LE[64 + lane] = ne1; LC[lane] = nc0; LC[64 + lane] = nc1; } while (0)
#define VG_ROWS(R, LE, GI) do { _Pragma("unroll") for (int kk = 0; kk < 8; ++kk) R[kk] = *(const u32x4*)(vcol + (size_t)LE[RPI * (8 * (GI) + kk) + gR] * 1024); } while (0)
#define VG_GROUP(R, LC, GI) do { _Pragma("unroll") for (int kk = 0; kk < 8; ++kk) { const float cj = LC[RPI * (8 * (GI) + kk) + gR];                       \
            const unsigned w_[4] = {R[kk].x, R[kk].y, R[kk].z, R[kk].w};                                                                       \
            _Pragma("unroll") for (int c = 0; c < 4; ++c) { const f32x2_t lo = __builtin_amdgcn_cvt_pk_f32_fp8((int)w_[c], false), hi = __builtin_amdgcn_cvt_pk_f32_fp8((int)w_[c], true); \
                acc[4 * c] = fmaf(cj, lo.x, acc[4 * c]); acc[4 * c + 1] = fmaf(cj, lo.y, acc[4 * c + 1]); acc[4 * c + 2] = fmaf(cj, hi.x, acc[4 * c + 2]); acc[4 * c + 3] = fmaf(cj, hi.y, acc[4 * c + 3]); } } } while (0)
            u32x4 RA[8], RB[8];
            int* lecur = (int*)(lds + 1024 + wv * 2048); int* lenxt = lecur + 256;
            VG_FETCH(tbase); VG_LISTS(lecur, ((float*)(lecur + 128))); VG_FETCH(tbase + 1);
            LDS_WAIT(); asm volatile("" ::: "memory");
            VG_ROWS(RA, lecur, 0);
#pragma unroll 1
            for (int tt = 0; tt < 8; ++tt) {
                const int t = tbase + tt;
                float* lccur = (float*)(lecur + 128); float* lcnxt = (float*)(lenxt + 128);
                float acc[16];
#pragma unroll
                for (int q = 0; q < 16; ++q) acc[q] = 0.f;
                if (tt + 1 < 8) { VG_LISTS(lenxt, lcnxt); if (tt + 2 < 8) VG_FETCH(t + 2); }
#pragma unroll 1
                for (int gi = 0; gi < G; gi += 2) {
                    VG_ROWS(RB, lecur, gi + 1);
                    VG_GROUP(RA, lccur, gi);
                    if (gi + 2 < G) VG_ROWS(RA, lecur, gi + 2);
                    else if (tt + 1 < 8) { LDS_WAIT(); asm volatile("" ::: "memory"); VG_ROWS(RA, lenxt, 0); }
                    VG_GROUP(RB, lccur, gi + 1);
                }
#pragma unroll
                for (int q = 0; q < 16; ++q) { if (LPR <= 8) acc[q] += dpp_f<0x128>(acc[q]); if (LPR <= 16) acc[q] += __shfl_xor(acc[q], 16); if (LPR <= 32) acc[q] += __shfl_xor(acc[q], 32); }
                if (gR == 0) { const int col = SLB * sl + 16 * iC; const float* g2 = MOD + (size_t)(t >> 11) * 6144 + 5120 + col; float* orow = p.out + (size_t)t * 1024 + col;
#pragma unroll
                    for (int q = 0; q < 4; ++q) { const f32x4 xv = *(const f32x4*)(orow + 4 * q), hv = *(const f32x4*)(g2 + 4 * q);
                        f32x4 r; r.x = acc[4 * q]; r.y = acc[4 * q + 1]; r.z = acc[4 * q + 2]; r.w = acc[4 * q + 3]; *(f32x4*)(orow + 4 * q) = xv + hv * r; } }
                { int* tmp_ = lecur; lecur = lenxt; lenxt = tmp_; }
            }
#undef VG_FETCH
#undef VG_LISTS
#undef VG_ROWS
#undef VG_GROUP
            LDS_WAIT(); asm volatile("" ::: "memory");
        }
    }
}
__device__ __forceinline__ void ph_peer_u8p(const Params& p, unsigned char* lds_w, int gw, int ngw, int lane_) {
    int lane = lane_; asm volatile("" : "+v"(lane));
    const bf16* H = (const bf16*)(p.ws + WS_H); const unsigned char* U8 = (const unsigned char*)(p.ws + WS_U16); const unsigned char* V8 = (const unsigned char*)(p.ws + WS_V16);
    const int* EXPI = (const int*)(p.ws + WS_EXP); const float* GATE = (const float*)(p.ws + WS_GATE); const float* MOD = (const float*)(p.ws + WS_MOD);
    int* e_lds = (int*)lds_w; float* a_lds = (float*)(lds_w + 512);
    const int g = lane >> 4, i = lane & 15;
#pragma unroll 1
    for (int t = gw; t < T; t += ngw) {
        const int e0 = EXPI[(size_t)t * 128 + lane], e1 = EXPI[(size_t)t * 128 + 64 + lane];
        const float g0 = GATE[(size_t)t * 128 + lane], g1 = GATE[(size_t)t * 128 + 64 + lane];
        e_lds[lane] = e0; e_lds[64 + lane] = e1;
        float xf[64];
        { const u32x4* xrow = (const u32x4*)(H + (size_t)t * 1024) + 2 * i;
#pragma unroll
          for (int q = 0; q < 4; ++q) { const u32x4 a = xrow[32 * q], b = xrow[32 * q + 1];
              xf[16 * q] = bflo(a.x); xf[16 * q + 1] = bfhi(a.x); xf[16 * q + 2] = bflo(a.y); xf[16 * q + 3] = bfhi(a.y); xf[16 * q + 4] = bflo(a.z); xf[16 * q + 5] = bfhi(a.z); xf[16 * q + 6] = bflo(a.w); xf[16 * q + 7] = bfhi(a.w);
              xf[16 * q + 8] = bflo(b.x); xf[16 * q + 9] = bfhi(b.x); xf[16 * q + 10] = bflo(b.y); xf[16 * q + 11] = bfhi(b.y); xf[16 * q + 12] = bflo(b.z); xf[16 * q + 13] = bfhi(b.z); xf[16 * q + 14] = bflo(b.w); xf[16 * q + 15] = bfhi(b.w); } }
        LDS_WAIT(); asm volatile("" ::: "memory");
#define P8T_ULOAD(R, S) do { const u32x4* r_ = (const u32x4*)(U8 + (size_t)e_lds[4 * (S) + g] * 1024) + i; _Pragma("unroll") for (int q = 0; q < 4; ++q) R[q] = r_[16 * q]; } while (0)
#define P8T_UDOT(R, S) do { float a0 = 0.f, a1 = 0.f, a2 = 0.f, a3 = 0.f;                                                                               \
        _Pragma("unroll") for (int q = 0; q < 4; ++q) { const unsigned w_[4] = {R[q].x, R[q].y, R[q].z, R[q].w};                                           \
            _Pragma("unroll") for (int c = 0; c < 4; ++c) { const f32x2_t lo = __builtin_amdgcn_cvt_pk_f32_fp8((int)w_[c], false), hi = __builtin_amdgcn_cvt_pk_f32_fp8((int)w_[c], true); \
                a0 = fmaf(lo.x, xf[16 * q + 4 * c], a0); a1 = fmaf(lo.y, xf[16 * q + 4 * c + 1], a1); a2 = fmaf(hi.x, xf[16 * q + 4 * c + 2], a2); a3 = fmaf(hi.y, xf[16 * q + 4 * c + 3], a3); } } \
        const float a_ = row16_sum((a0 + a1) + (a2 + a3)) * (1.0f / U8_SCALE); if (i == 0) a_lds[4 * (S) + g] = a_; } while (0)
        { u32x4 RA[4], RB[4], RC[4];
          P8T_ULOAD(RA, 0); P8T_ULOAD(RB, 1);
#pragma unroll 1
          for (int s = 0; s < 30; s += 3) {
              P8T_ULOAD(RC, s + 2); P8T_UDOT(RA, s);
              P8T_ULOAD(RA, s + 3); P8T_UDOT(RB, s + 1);
              P8T_ULOAD(RB, s + 4); P8T_UDOT(RC, s + 2);
          }
          P8T_UDOT(RA, 30); P8T_UDOT(RB, 31); }
#undef P8T_ULOAD
#undef P8T_UDOT
        LDS_WAIT(); asm volatile("" ::: "memory");
        const float c0 = gelu_erf(a_lds[lane]) * g0, c1 = gelu_erf(a_lds[64 + lane]) * g1;
        float* CB = (float*)(p.ws + WS_CBUF) + (size_t)t * 128; CB[lane] = c0; CB[64 + lane] = c1;
    }
}
__device__ __forceinline__ void ph_peer_u8h(const Params& p, unsigned char* lds) {
    const bf16* H = (const bf16*)(p.ws + WS_H); const unsigned char* U8 = (const unsigned char*)(p.ws + WS_U16);
    const int* EXPI = (const int*)(p.ws + WS_EXP);
    unsigned* ctl = (unsigned*)(p.ws + WS_CTL);
    int tid = threadIdx.x; asm volatile("" : "+v"(tid));
    const int lane = tid & 63, wv = __builtin_amdgcn_readfirstlane(tid >> 6), hw = lane >> 5, i5 = lane & 31;
    volatile LAS unsigned* slot = (volatile LAS unsigned*)(LAS unsigned char*)lds;
    float* a_lds = (float*)(lds + 1024 + wv * 2048 + 1024);
    const unsigned xcc = peer_xcc();
#pragma unroll 1
    for (int k = 0; k < 2; ++k) {
        const int sl = (int)(((xcc >> 2) + (unsigned)k) & 1u);
        float* AB = (float*)(p.ws + (sl ? WS_ABUF1 : WS_CBUF));
        const unsigned char* ucol = U8 + 512 * sl + 16 * i5;
#pragma unroll 1
        for (;;) {
            if (tid == 0) *slot = __hip_atomic_fetch_add(ctl + CW_P8_U + 64 * sl, 1u, __ATOMIC_RELAXED, __HIP_MEMORY_SCOPE_AGENT);
            __syncthreads();
            const unsigned unit = *slot;
            __syncthreads();
            if (unit >= (unsigned)P8_UNITS) break;
            const int tbase = (int)unit * 64 + wv * 8;
            int ne0, ne1; u32x4 nx0, nx1;
#define UH_FETCH(T) do { const size_t tn_ = (size_t)(T); ne0 = EXPI[tn_ * 128 + lane]; ne1 = EXPI[tn_ * 128 + 64 + lane];                          \
        const u32x4* xr_ = (const u32x4*)(H + tn_ * 1024 + 512 * sl) + 2 * i5; nx0 = xr_[0]; nx1 = xr_[1]; } while (0)
#define UH_LISTS(LE) do { LE[lane] = ne0; LE[64 + lane] = ne1; } while (0)
#define UH_ROWS(R, LE, GI) do { _Pragma("unroll") for (int kk = 0; kk < 8; ++kk) R[kk] = *(const u32x4*)(ucol + (size_t)LE[2 * (8 * (GI) + kk) + hw] * 1024); } while (0)
#define UH_GROUP(R, GI) do { _Pragma("unroll") for (int kk = 0; kk < 8; ++kk) { float a0 = 0.f, a1 = 0.f, a2 = 0.f, a3 = 0.f;                         \
            const unsigned w_[4] = {R[kk].x, R[kk].y, R[kk].z, R[kk].w};                                                                       \
            _Pragma("unroll") for (int c = 0; c < 4; ++c) { const f32x2_t lo = __builtin_amdgcn_cvt_pk_f32_fp8((int)w_[c], false), hi = __builtin_amdgcn_cvt_pk_f32_fp8((int)w_[c], true); \
                a0 = fmaf(lo.x, xf[4 * c], a0); a1 = fmaf(lo.y, xf[4 * c + 1], a1); a2 = fmaf(hi.x, xf[4 * c + 2], a2); a3 = fmaf(hi.y, xf[4 * c + 3], a3); }                        \
            float s_ = row16_sum((a0 + a1) + (a2 + a3)); s_ += __shfl_xor(s_, 16);                                                              \
            if (i5 == 0) a_lds[2 * (8 * (GI) + kk) + hw] = s_ * (1.0f / U8_SCALE); } } while (0)
            u32x4 RA[8], RB[8];
            int* lecur = (int*)(lds + 1024 + wv * 2048); int* lenxt = lecur + 128;
            UH_FETCH(tbase); UH_LISTS(lecur);
            float xf[16];
#define UH_XF() do { xf[0] = bflo(nx0.x); xf[1] = bfhi(nx0.x); xf[2] = bflo(nx0.y); xf[3] = bfhi(nx0.y); xf[4] = bflo(nx0.z); xf[5] = bfhi(nx0.z); xf[6] = bflo(nx0.w); xf[7] = bfhi(nx0.w); \
        xf[8] = bflo(nx1.x); xf[9] = bfhi(nx1.x); xf[10] = bflo(nx1.y); xf[11] = bfhi(nx1.y); xf[12] = bflo(nx1.z); xf[13] = bfhi(nx1.z); xf[14] = bflo(nx1.w); xf[15] = bfhi(nx1.w); } while (0)
            UH_XF();
            UH_FETCH(tbase + 1);
            LDS_WAIT(); asm volatile("" ::: "memory");
            UH_ROWS(RA, lecur, 0);
#pragma unroll 1
            for (int tt = 0; tt < 8; ++tt) {
                const int t = tbase + tt;
                float xn[16];
                if (tt + 1 < 8) { UH_LISTS(lenxt);
#pragma unroll
                    for (int q = 0; q < 16; ++q) xn[q] = 0.f;
                    xn[0] = bflo(nx0.x); xn[1] = bfhi(nx0.x); xn[2] = bflo(nx0.y); xn[3] = bfhi(nx0.y); xn[4] = bflo(nx0.z); xn[5] = bfhi(nx0.z); xn[6] = bflo(nx0.w); xn[7] = bfhi(nx0.w);
                    xn[8] = bflo(nx1.x); xn[9] = bfhi(nx1.x); xn[10] = bflo(nx1.y); xn[11] = bfhi(nx1.y); xn[12] = bflo(nx1.z); xn[13] = bfhi(nx1.z); xn[14] = bflo(nx1.w); xn[15] = bfhi(nx1.w);
                    if (tt + 2 < 8) UH_FETCH(t + 2); }
#pragma unroll 1
                for (int gi = 0; gi < 8; gi += 2) {
                    UH_ROWS(RB, lecur, gi + 1);
                    UH_GROUP(RA, gi);
                    if (gi + 2 < 8) UH_ROWS(RA, lecur, gi + 2);
                    else if (tt + 1 < 8) { LDS_WAIT(); asm volatile("" ::: "memory"); UH_ROWS(RA, lenxt, 0); }
                    UH_GROUP(RB, gi + 1);
                }
                LDS_WAIT(); asm volatile("" ::: "memory");
                { float* ab = AB + (size_t)t * 128; ab[lane] = a_lds[lane]; ab[64 + lane] = a_lds[64 + lane]; }
                LDS_WAIT(); asm volatile("" ::: "memory");
                if (tt + 1 < 8) {
#pragma unroll
                    for (int q = 0; q < 16; ++q) xf[q] = xn[q]; }
                { int* tmp_ = lecur; lecur = lenxt; lenxt = tmp_; }
            }
#undef UH_FETCH
#undef UH_LISTS
#undef UH_ROWS
#undef UH_GROUP
#undef UH_XF
        }
    }
}
#define XB_TMO      128
#define XB_XCNT(j)  (256  + 64 * (j))
#define XB_XSUB(j)  (1280 + 64 * (j))
#define XB_XGEN(j)  (2304 + 64 * (j))
#define XB_TOP      3328
#define XB_TOPGEN   3392
#define XCD_BAR_WORDS 3456
#define XB_SPIN_CAP (1u << 18)

__device__ __forceinline__ unsigned xb_ld(unsigned* p)              { return __hip_atomic_load(p, __ATOMIC_RELAXED, __HIP_MEMORY_SCOPE_AGENT); }
__device__ __forceinline__ unsigned xb_add(unsigned* p, unsigned v) { return __hip_atomic_fetch_add(p, v, __ATOMIC_RELAXED, __HIP_MEMORY_SCOPE_AGENT); }
__device__ __forceinline__ unsigned xb_xcc_id() { return (unsigned)__builtin_amdgcn_s_getreg((3 << 11) | 20) & 0xFu; }
#define XB_SPIN(cond, bar) do { unsigned _sp = 0; while (cond) { __builtin_amdgcn_s_sleep(1); \
    if ((++_sp & 255u) == 0u) { if (xb_ld(&(bar)[XB_TMO])) break; if (_sp > XB_SPIN_CAP) { atomicAdd(&(bar)[XB_TMO], 1u); break; } } } } while (0)

struct XcdBarrier {
    unsigned* bar; unsigned x;
    volatile LAS unsigned* st;
};

__device__ __forceinline__ XcdBarrier xcd_barrier_post(unsigned* bar, volatile LAS unsigned* st) {
    XcdBarrier b; b.bar = bar; b.x = xb_xcc_id(); b.st = st;
    if (threadIdx.x == 0) (void)xb_add(&bar[XB_XCNT(b.x)], 1u);
    return b;
}
__device__ __forceinline__ void xcd_barrier_complete(unsigned* bar, unsigned x, unsigned& nloc, unsigned& nx) {
    const unsigned G = gridDim.x * gridDim.y * gridDim.z;
    unsigned sum, cnt, mine, sp = 0u;
    for (;;) {
        sum = 0u; cnt = 0u; mine = 0u;
#pragma unroll
        for (unsigned j = 0; j < 16; ++j) { const unsigned c = xb_ld(&bar[XB_XCNT(j)]); sum += c; cnt += (c > 0u) ? 1u : 0u; mine = (j == x) ? c : mine; }
        if (sum == G) break;
        __builtin_amdgcn_s_sleep(1);
        if ((++sp & 255u) == 0u) { if (xb_ld(&bar[XB_TMO])) break; if (sp > XB_SPIN_CAP) { atomicAdd(&bar[XB_TMO], 1u); break; } }
    }
    nloc = mine > 0u ? mine : 1u; nx = cnt > 0u ? cnt : 1u;
}

__device__ __forceinline__ void xcd_barrier(const XcdBarrier& b) {
    asm volatile("s_waitcnt vmcnt(0)" ::: "memory");
    __syncthreads();
    if (threadIdx.x == 0) {
        unsigned* bar = b.bar;
        __builtin_amdgcn_s_waitcnt(0);
        unsigned nloc = b.st[0], nx = b.st[1];
        if (nloc == 0u) { xcd_barrier_complete(bar, b.x, nloc, nx); b.st[0] = nloc; b.st[1] = nx; }
        const unsigned old = xb_add(&bar[XB_XSUB(b.x)], 1u);
        const unsigned gen = old / nloc;
        if (old + 1u == (gen + 1u) * nloc) {
            __builtin_amdgcn_fence(__ATOMIC_RELEASE, "agent");
            asm volatile("s_waitcnt vmcnt(0)" ::: "memory");
            const unsigned og = xb_add(&bar[XB_TOP], 1u);
            const unsigned tg = og / nx;
            if (og + 1u == (tg + 1u) * nx) xb_add(&bar[XB_TOPGEN], 1u);
            else XB_SPIN(xb_ld(&bar[XB_TOPGEN]) == tg, bar);
            __builtin_amdgcn_fence(__ATOMIC_ACQUIRE, "agent");
            xb_add(&bar[XB_XGEN(b.x)], 1u);
            asm volatile("s_waitcnt vmcnt(0)" ::: "memory");
        } else {
            XB_SPIN(xb_ld(&bar[XB_XGEN(b.x)]) == gen, bar);
            __builtin_amdgcn_fence(__ATOMIC_ACQUIRE, "agent");
            asm volatile("s_waitcnt vmcnt(0)" ::: "memory");
        }
    }
    __syncthreads();
}

#ifndef V8_LPR
#define V8_LPR 32
#endif
constexpr int LDS_BYTES = 147456;
extern __shared__ __attribute__((aligned(16))) unsigned char dyn_lds[];

__global__ void __launch_bounds__(NT, 2) mega_fwd(Params p) {
    cg::grid_group grid = cg::this_grid();
    const int vb = blockIdx.x, nvb = gridDim.x, ngw = nvb * NWV;
    volatile LAS unsigned* xst = (volatile LAS unsigned*)((LAS unsigned char*)dyn_lds + (LDS_BYTES - 16));
    if (threadIdx.x < 4) xst[threadIdx.x] = 0u;
    __syncthreads();
    const XcdBarrier xbar = xcd_barrier_post((unsigned*)(p.ws + WS_CTL), xst);
#define TID_LAUNDER int tid_ = threadIdx.x; asm volatile("" : "+v"(tid_)); const int lane = tid_ & 63, wv = tid_ >> 6, gw = vb * NWV + wv; (void)lane; (void)gw;
    grid.sync();
    ph_mod(p, (float*)dyn_lds, vb, nvb);
    { TID_LAUNDER ph_prep_weights(p, (LAS float*)dyn_lds + wv * (64 * 33), gw, ngw, lane); }
    xcd_barrier(xbar);
    { TID_LAUNDER ph_hrows(p, p.x, p.norm1_g, 0, 1024, gw, ngw, lane); }
    xcd_barrier(xbar);
    {   pg8::Gemm g{(const bf16*)(p.ws + WS_H), (const bf16*)(p.ws + WS_WIN), T, NP, 1024}; pg8::StaticOrder S; S.init(T, NP, nvb, vb);
        EpiNormBf16 E{(bf16*)(p.ws + WS_PROJ), p.a_qk_gain, p.b_q_gain, p.b_kv_gain, (LAS float*)((LAS unsigned char*)dyn_lds + 131072), (bf16*)(p.ws + WS_KVC)};
        pg8::gemm_phase<EpiNormBf16, pg8::StaticOrder, true, true>((LAS unsigned char*)dyn_lds, g, S, E); }
    xcd_barrier(xbar);
    ph_attnA(p, dyn_lds, vb, nvb);
    __syncthreads();
    ph_dsa(p, dyn_lds, vb, nvb);
    xcd_barrier(xbar);
    {   pg8::Gemm g{(const bf16*)(p.ws + WS_MIX), (const bf16*)(p.ws + WS_WO2), T, 1024, MIXW}; pg8::StaticOrder S; S.init(T, 1024, nvb, vb);
        EpiResGate E{p.x, p.out, (const float*)(p.ws + WS_MOD) + 2048};
        pg8::gemm_phase<EpiResGate, pg8::StaticOrder, true, true>((LAS unsigned char*)dyn_lds, g, S, E); }
    xcd_barrier(xbar);
    { TID_LAUNDER ph_hrows(p, p.out, p.norm2_g, 3072, 4096, gw, ngw, lane); }
    xcd_barrier(xbar);
    {   pg8::Gemm g{(const bf16*)(p.ws + WS_H), (const bf16*)(p.ws + WS_WQ), T, 1024, 1024}; pg8::StaticOrder S; S.init(T, 1024, nvb, vb);
        pg8::EpiBf16<0> E{(bf16*)(p.ws + WS_Q3), 1024, nullptr, 0, 0, 1.f};
        pg8::gemm_phase<pg8::EpiBf16<0>, pg8::StaticOrder, true, true>((LAS unsigned char*)dyn_lds, g, S, E); }
    xcd_barrier(xbar);
    ph_route(p, dyn_lds, vb, nvb);
    xcd_barrier(xbar);

#if U8_HALVES
    ph_peer_u8h(p, dyn_lds);
#else
    { TID_LAUNDER ph_peer_u8p(p, dyn_lds + wv * 1024, gw, ngw, lane); }
#endif
    xcd_barrier(xbar);
    ph_peer_v8g<V8_LPR>(p, dyn_lds);

}

extern "C" void kernel_launch(void* const* d_in, const int* in_sizes, int n_in, void* d_out, int out_size, void* d_ws, size_t ws_size, hipStream_t stream) {
    static int grid_blocks = 0;
    if (grid_blocks == 0) {
        if (n_in != 18 || in_sizes[0] != T * DM || out_size != T * DM || ws_size < WS_END) { fprintf(stderr, "kernel_launch: unexpected shapes n_in %d in0 %d out %d ws %zu\n", n_in, n_in > 0 ? in_sizes[0] : -1, out_size, ws_size); grid_blocks = -1; return; }
        int dev = 0, cus = 0, per_cu = 0;
        (void)hipGetDevice(&dev);
        (void)hipDeviceGetAttribute(&cus, hipDeviceAttributeMultiprocessorCount, dev);
        (void)hipFuncSetAttribute((const void*)mega_fwd, hipFuncAttributeMaxDynamicSharedMemorySize, LDS_BYTES);
        (void)hipOccupancyMaxActiveBlocksPerMultiprocessor(&per_cu, (const void*)mega_fwd, NT, LDS_BYTES);
        if (per_cu < 1 || cus < 1) { fprintf(stderr, "kernel_launch: occupancy query gave %d blocks/CU on %d CUs\n", per_cu, cus); grid_blocks = -1; return; }
        grid_blocks = cus;
    }
    if (grid_blocks < 0) return;
    Params p{};
    const float** pp = (const float**)&p;
    for (int i = 0; i < 18; ++i) pp[i] = (const float*)d_in[i];
    p.out = (float*)d_out; p.ws = (unsigned char*)d_ws;
    if (hipMemsetAsync((char*)d_ws + WS_CTL, 0, CTL_BYTES, stream) != hipSuccess) { fprintf(stderr, "kernel_launch: memset failed\n"); return; }
    void* args[] = {&p};
    const hipError_t e = hipLaunchCooperativeKernel((const void*)mega_fwd, dim3(grid_blocks), dim3(NT), args, LDS_BYTES, stream);
    if (e != hipSuccess) fprintf(stderr, "kernel_launch: cooperative launch failed: %s (grid %d)\n", hipGetErrorString(e), grid_blocks);
}
```

```cpp
#include <hip/hip_runtime.h>
#include <hip/hip_cooperative_groups.h>
#include <cstdio>
#include <cstdint>
#include <cmath>
namespace pg8 {
#define PG8_LAS __attribute__((address_space(3)))
typedef unsigned short bf16_t;
typedef short bf16x8 __attribute__((ext_vector_type(8)));
typedef float f32x4 __attribute__((ext_vector_type(4)));
typedef unsigned u32x4 __attribute__((ext_vector_type(4)));
constexpr int BM = 256, BK = 64, HALF = 128, HTB = HALF * BK * 2  , STAGE_BYTES = 8 * HTB, NXCD = 8, WGM = 8;

__host__ __device__ __forceinline__ int lds_byte(int r, int c) { const int st = (r >> 4) * 2 + (c >> 5), rr = r & 15, cc = c & 31, ob = rr * 64 + cc * 2; return st * 1024 + (ob ^ (((ob >> 9) & 1) << 5)); }
__host__ __device__ __forceinline__ void stage_rc(int b, int& R, int& C) { const int st = b / 1024, sb = b % 1024, swz = sb ^ (((sb >> 9) & 1) << 5); R = (st >> 1) * 16 + swz / 64; C = (st & 1) * 32 + (swz % 64) / 2; }
__host__ __device__ __forceinline__ int perm32(int rho) { const int n = rho >> 4, i = rho & 15; return 8 * (i >> 2) + 4 * n + (i & 3); }

struct Unit { int pm, pn; };
struct Gemm { const bf16_t* A; const bf16_t* Bt; int M, N, K; };

struct StaticOrder {
    int nM, nN, nwg, G, c;
    __host__ __device__ void init(int M, int N, int G_, int c_) { nM = M / BM; nN = N / BM; nwg = nM * nN; G = G_; c = c_; }
    __host__ __device__ bool next(int i, Unit& u) const {
        const long L = (long)i * G + c; if (L >= nwg) return false;
        int wgid = (int)L; { const int q = nwg / NXCD, r = nwg % NXCD, xcd = wgid % NXCD, off = wgid / NXCD; wgid = (xcd < r ? xcd * (q + 1) : r * (q + 1) + (xcd - r) * q) + off; }
        const int nig = WGM * nN, gid = wgid / nig, fm = gid * WGM, gsz = (nM - fm) < WGM ? (nM - fm) : WGM;
        u.pm = fm + ((wgid % nig) % gsz); u.pn = (wgid % nig) / gsz; return true;
    }
    __device__ __forceinline__ void a_ready(const Unit&) const {}
    __device__ __forceinline__ void done(const Unit&) const {}
};

__device__ __forceinline__ unsigned cvt_pk_bf16(float lo, float hi) { unsigned r; asm volatile("v_cvt_pk_bf16_f32 %0, %1, %2" : "=v"(r) : "v"(lo), "v"(hi)); return r; }
typedef float f32x2 __attribute__((ext_vector_type(2)));
__device__ __forceinline__ f32x2 gelu_pk(f32x2 v) {
    const f32x2 av = __builtin_elementwise_abs(v), d = av * 0.2316418882f + 1.0f;
    f32x2 t; t.x = __builtin_amdgcn_rcpf(d.x); t.y = __builtin_amdgcn_rcpf(d.y);
    f32x2 q = t * 0.5307027145f + (-0.7265760135f); q = q * t + 0.7107068705f; q = q * t + (-0.142248368f); q = q * t + 0.127414796f; q = q * t;
    const f32x2 s = (v * v) * (-0.72134752044f);
    f32x2 e; e.x = __builtin_amdgcn_exp2f(s.x); e.y = __builtin_amdgcn_exp2f(s.y);
    const f32x2 m = v * (q * e), r = v - m;
    f32x2 o; o.x = v.x < 0.f ? m.x : r.x; o.y = v.y < 0.f ? m.y : r.y; return o;
}

template <int ACT  > struct EpiBf16 {
    static constexpr bool PERM = true, AFTER_DRAIN = false; static_assert(ACT == 0 || ACT == 1, "EpiBf16: ACT is 0 (none) or 1 (gelu_pk)");
    bf16_t* O; int ldc; const float* bias; int split_cols; size_t split_stride; float scale0;
    __device__ __forceinline__ void operator()(const f32x4 (&acc)[2][2][4][2], const Unit& u, int wr, int wc, int fr, int fq) const {
        const int row0 = u.pm * BM + wr * 64 + fr; int colt = u.pn * BM; bf16_t* base = O;
        float sc = 1.f; if (split_cols) { const int t = colt / split_cols; base += (size_t)t * split_stride; colt -= t * split_cols; if (t == 0) sc = scale0; }
        const int col0 = colt + wc * 32 + 8 * fq, bcol0 = u.pn * BM + wc * 32 + 8 * fq;
        f32x4 bv[2][2];
#pragma unroll
        for (int bj = 0; bj < 2; ++bj)
#pragma unroll
            for (int n = 0; n < 2; ++n) bv[bj][n] = bias ? *(const f32x4*)(bias + bcol0 + bj * HALF + 4 * n) : (f32x4){0.f, 0.f, 0.f, 0.f};
#pragma unroll
        for (int ai = 0; ai < 2; ++ai)
#pragma unroll
            for (int m = 0; m < 4; ++m) { bf16_t* rowp = base + (size_t)(row0 + ai * HALF + m * 16) * ldc + col0;
#pragma unroll
                for (int bj = 0; bj < 2; ++bj) { f32x4 v0 = acc[ai][bj][m][0] + bv[bj][0], v1 = acc[ai][bj][m][1] + bv[bj][1];
                    if (ACT == 1) { f32x2 a = gelu_pk((f32x2){v0[0], v0[1]}), b = gelu_pk((f32x2){v0[2], v0[3]}), c = gelu_pk((f32x2){v1[0], v1[1]}), d = gelu_pk((f32x2){v1[2], v1[3]});
                        v0 = (f32x4){a.x, a.y, b.x, b.y}; v1 = (f32x4){c.x, c.y, d.x, d.y}; }
                    v0 = v0 * sc; v1 = v1 * sc; u32x4 w; w.x = cvt_pk_bf16(v0[0], v0[1]); w.y = cvt_pk_bf16(v0[2], v0[3]); w.z = cvt_pk_bf16(v1[0], v1[1]); w.w = cvt_pk_bf16(v1[2], v1[3]);
                    *(u32x4*)(rowp + bj * HALF) = w; } }
    }
};

template <class Epi, class Sched, bool ALIGN_EPI = false, bool SP2 = false>
__device__ __forceinline__ void gemm_phase(PG8_LAS unsigned char* lds, const Gemm g, const Sched& S, const Epi& E) {
    int tid = threadIdx.x; asm volatile("" : "+v"(tid)); const int wid = __builtin_amdgcn_readfirstlane(tid >> 6), lane = tid & 63, wr = wid >> 2, wc = wid & 3, fr = lane & 15, fq = lane >> 4;
    const int K = g.K, nt = K / BK;
    unsigned voffA[2], voffB[2];
#pragma unroll
    for (int i = 0; i < 2; ++i) { int R, C; stage_rc(tid * 16 + i * 8192, R, C); const int Rb = Epi::PERM ? ((R & ~31) + perm32(R & 31)) : R;
        voffA[i] = (unsigned)(R * K + C) * 2u; voffB[i] = (unsigned)(Rb * K + C) * 2u; }
    const size_t kstep = (size_t)(BK * 2);
    const size_t hstep = (size_t)HALF * K * 2;
    const size_t tstep = 2 * hstep;
    const unsigned ldsw = (unsigned)wid * 1024u;
    const int aoff = lds_byte(wr * 64 + fr, fq * 8), boff = lds_byte(wc * 32 + fr, fq * 8);
#define PG8_SA(b, h) (((b) * 2 + (h)) * HTB)
#define PG8_SB(b, h) ((4 + (b) * 2 + (h)) * HTB)
#define PG8_STAGE(bufoff, gbase, voff) do { _Pragma("unroll") for (int _i = 0; _i < 2; ++_i) \
        __builtin_amdgcn_global_load_lds((const unsigned*)((const char*)(gbase) + (voff)[_i]), (PG8_LAS unsigned*)(lds + (bufoff) + ldsw + _i * 8192), 16, 0, 0); } while (0)
#define PG8_LDA(dst, b, h) do { _Pragma("unroll") for (int m = 0; m < 4; ++m) _Pragma("unroll") for (int k = 0; k < 2; ++k) dst[m][k] = *(const PG8_LAS bf16x8*)(lds + PG8_SA(b, h) + aoff + m * 2048 + k * 1024); } while (0)
#define PG8_LDB(dst, b, h) do { _Pragma("unroll") for (int n = 0; n < 2; ++n) _Pragma("unroll") for (int k = 0; k < 2; ++k) dst[n][k] = *(const PG8_LAS bf16x8*)(lds + PG8_SB(b, h) + boff + n * 2048 + k * 1024); } while (0)
#define PG8_MMA(ai, bj, At, Bt) do { __builtin_amdgcn_s_setprio(1); _Pragma("unroll") for (int m = 0; m < 4; ++m) _Pragma("unroll") for (int n = 0; n < 2; ++n) _Pragma("unroll") for (int k = 0; k < 2; ++k) \
        acc[ai][bj][m][n] = __builtin_amdgcn_mfma_f32_16x16x32_bf16(Bt[n][k], At[m][k], acc[ai][bj][m][n], 0, 0, 0); __builtin_amdgcn_s_setprio(0); } while (0)
#define PG8_WAIT_V(n) asm volatile("s_waitcnt vmcnt(" #n ")" ::: "memory")
#define PG8_WAIT_L(n) asm volatile("s_waitcnt lgkmcnt(" #n ")" ::: "memory")
#define PG8_BAR __builtin_amdgcn_s_barrier()
#define PG8_SCHED __builtin_amdgcn_sched_barrier(0)
    Unit cur, nxt; int ui = 0;
    if (!S.next(0, cur)) return;
    f32x4 acc[2][2][4][2];
#pragma unroll
    for (int a = 0; a < 2; ++a)
#pragma unroll
        for (int b = 0; b < 2; ++b)
#pragma unroll
            for (int m = 0; m < 4; ++m)
#pragma unroll
                for (int n = 0; n < 2; ++n) acc[a][b][m][n] = (f32x4){0.f, 0.f, 0.f, 0.f};
    bf16x8 At[4][2], B0[2][2], B1[2][2];
    const char* cA = (const char*)g.A + (size_t)cur.pm * tstep; const char* cB = (const char*)g.Bt + (size_t)cur.pn * tstep;
    S.a_ready(cur);
    if constexpr (SP2) {
        PG8_STAGE(PG8_SB(0, 0), cB, voffB); PG8_STAGE(PG8_SB(0, 1), cB + hstep, voffB); PG8_STAGE(PG8_SA(0, 0), cA, voffA); PG8_STAGE(PG8_SA(0, 1), cA + hstep, voffA);
        if (wr == 1) PG8_BAR;
        PG8_WAIT_V(2); PG8_BAR;
        PG8_STAGE(PG8_SB(1, 0), cB + kstep, voffB); PG8_STAGE(PG8_SA(1, 0), cA + kstep, voffA); PG8_STAGE(PG8_SB(1, 1), cB + hstep + kstep, voffB);
        PG8_WAIT_V(6); PG8_BAR;
    } else {
        PG8_STAGE(PG8_SB(0, 0), cB, voffB); PG8_STAGE(PG8_SA(0, 0), cA, voffA); PG8_STAGE(PG8_SB(0, 1), cB + hstep, voffB); PG8_STAGE(PG8_SA(0, 1), cA + hstep, voffA);
        if (wr == 1) PG8_BAR;
        PG8_WAIT_V(4); PG8_BAR;
        PG8_STAGE(PG8_SB(1, 0), cB + kstep, voffB); PG8_STAGE(PG8_SA(1, 0), cA + kstep, voffA); PG8_STAGE(PG8_SB(1, 1), cB + hstep + kstep, voffB);
        PG8_WAIT_V(6); PG8_BAR;
    }
    for (;;) {
        const bool has_next = S.next(ui + 1, nxt);
        const char* nA = has_next ? (const char*)g.A + (size_t)nxt.pm * tstep : cA; const char* nB = has_next ? (const char*)g.Bt + (size_t)nxt.pn * tstep : cB;
        for (int t = 0; t < nt; t += 2) {
            const bool last = (t == nt - 2);
            const char* a1 = cA + (size_t)(t + 1) * kstep;
            const char* a2 = last ? nA : cA + (size_t)(t + 2) * kstep; const char* b2 = last ? nB : cB + (size_t)(t + 2) * kstep;
            const char* a3 = a2 + kstep; const char* b3 = b2 + kstep;
            if (last && has_next) S.a_ready(nxt);
            if constexpr (SP2) {
            PG8_LDB(B0, 0, 0); PG8_LDB(B1, 0, 1); PG8_SCHED; PG8_LDA(At, 0, 0); PG8_STAGE(PG8_SA(1, 1), a1 + hstep, voffA);
            PG8_WAIT_V(8); PG8_WAIT_L(0); PG8_BAR; PG8_MMA(0, 0, At, B0); PG8_MMA(0, 1, At, B1); PG8_BAR; PG8_SCHED;
            PG8_LDA(At, 0, 1); PG8_STAGE(PG8_SB(0, 0), b2, voffB); PG8_STAGE(PG8_SB(0, 1), b2 + hstep, voffB); PG8_STAGE(PG8_SA(0, 0), a2, voffA);
            PG8_WAIT_V(8); PG8_WAIT_L(0); PG8_BAR; PG8_MMA(1, 0, At, B0); PG8_MMA(1, 1, At, B1); PG8_BAR; PG8_SCHED;
            PG8_LDB(B0, 1, 0); PG8_LDB(B1, 1, 1); PG8_SCHED; PG8_LDA(At, 1, 0); PG8_STAGE(PG8_SA(0, 1), a2 + hstep, voffA);
            PG8_WAIT_V(8); PG8_WAIT_L(0); PG8_BAR; PG8_MMA(0, 0, At, B0); PG8_MMA(0, 1, At, B1); PG8_BAR; PG8_SCHED;
            PG8_LDA(At, 1, 1); PG8_STAGE(PG8_SB(1, 0), b3, voffB); PG8_STAGE(PG8_SB(1, 1), b3 + hstep, voffB); PG8_STAGE(PG8_SA(1, 0), a3, voffA);
            PG8_WAIT_V(8); PG8_WAIT_L(0); PG8_BAR; PG8_MMA(1, 0, At, B0); PG8_MMA(1, 1, At, B1); PG8_BAR; PG8_SCHED;
            } else {
            PG8_LDB(B0, 0, 0); PG8_SCHED; PG8_LDA(At, 0, 0); PG8_STAGE(PG8_SA(1, 1), a1 + hstep, voffA);
            PG8_WAIT_L(8); PG8_BAR; PG8_WAIT_L(0); PG8_MMA(0, 0, At, B0); PG8_BAR; PG8_SCHED;
            PG8_LDB(B1, 0, 1); PG8_STAGE(PG8_SB(0, 0), b2, voffB);
            PG8_BAR; PG8_WAIT_L(0); PG8_MMA(0, 1, At, B1); PG8_BAR;
            PG8_LDA(At, 0, 1); PG8_STAGE(PG8_SA(0, 0), a2, voffA);
            PG8_BAR; PG8_WAIT_L(0); PG8_MMA(1, 0, At, B0); PG8_BAR; PG8_SCHED;
            PG8_STAGE(PG8_SB(0, 1), b2 + hstep, voffB);
            PG8_WAIT_V(6); PG8_BAR; PG8_MMA(1, 1, At, B1); PG8_BAR;
            PG8_LDB(B0, 1, 0); PG8_SCHED; PG8_LDA(At, 1, 0); PG8_STAGE(PG8_SA(0, 1), a2 + hstep, voffA);
            PG8_WAIT_L(8); PG8_BAR; PG8_WAIT_L(0); PG8_MMA(0, 0, At, B0); PG8_BAR; PG8_SCHED;
            PG8_LDB(B1, 1, 1); PG8_STAGE(PG8_SB(1, 0), b3, voffB);
            PG8_BAR; PG8_WAIT_L(0); PG8_MMA(0, 1, At, B1); PG8_BAR;
            PG8_LDA(At, 1, 1); PG8_STAGE(PG8_SA(1, 0), a3, voffA);
            PG8_BAR; PG8_WAIT_L(0); PG8_MMA(1, 0, At, B0); PG8_BAR; PG8_SCHED;
            PG8_STAGE(PG8_SB(1, 1), b3 + hstep, voffB);
            PG8_WAIT_V(6); PG8_BAR; PG8_MMA(1, 1, At, B1); PG8_BAR;
            }
        }
        if constexpr (ALIGN_EPI) { if (wr == 0) PG8_BAR; }
        if constexpr (!Epi::AFTER_DRAIN) { E(acc, cur, wr, wc, fr, fq); S.done(cur); }
        if (!has_next) break;
#pragma unroll
        for (int a = 0; a < 2; ++a)
#pragma unroll
            for (int b = 0; b < 2; ++b)
#pragma unroll
                for (int m = 0; m < 4; ++m)
#pragma unroll
                    for (int n = 0; n < 2; ++n) acc[a][b][m][n] = (f32x4){0.f, 0.f, 0.f, 0.f};
        cur = nxt; cA = nA; cB = nB; ++ui;
        if constexpr (ALIGN_EPI) { if (wr == 1) PG8_BAR; }
    }
    PG8_WAIT_V(0);
    if constexpr (!ALIGN_EPI) { if (wr == 0) PG8_BAR; }
    PG8_BAR;
    if constexpr (Epi::AFTER_DRAIN) { E.fused(acc, cur, wr, wc, fr, fq, lds, wid, lane); S.done(cur); }
#undef PG8_SA
#undef PG8_SB
#undef PG8_STAGE
#undef PG8_LDA
#undef PG8_LDB
#undef PG8_MMA
#undef PG8_WAIT_V
#undef PG8_WAIT_L
#undef PG8_BAR
#undef PG8_SCHED
}
}
namespace cg = cooperative_groups;
#define LAS __attribute__((address_space(3)))
typedef unsigned short bf16;
typedef float f32x4 __attribute__((ext_vector_type(4)));
typedef float f32x8 __attribute__((ext_vector_type(8)));
typedef float f32x16 __attribute__((ext_vector_type(16)));
typedef unsigned u32x4 __attribute__((ext_vector_type(4)));
typedef unsigned u32x2 __attribute__((ext_vector_type(2)));
typedef short bf16x8 __attribute__((ext_vector_type(8)));
typedef short s16x4 __attribute__((ext_vector_type(4)));

constexpr int BATCH = 16, SEQ = 2048, DM = 1024, T = BATCH * SEQ;
constexpr int NP = 3072;
constexpr int IN_COLS = 3012;
constexpr int C_QA = 0, C_KA = 512, C_VA = 1024, C_QB = 1536, C_KV = 2560, C_QI = 2688, C_KI = 2944, C_WI = 3008;
constexpr int MIXW = 1536;
constexpr int NEXP = 16384;
constexpr float EPS = 1e-6f;
constexpr int NT = 512;
constexpr int NWV = 8;

constexpr size_t MiB = 1u << 20;
constexpr size_t WS_CTL = 0;
constexpr size_t CTL_BYTES = 64 * 1024;
constexpr size_t WS_MOD = 1 * MiB;
constexpr size_t WS_SCAL = WS_MOD + 512 * 1024;
constexpr size_t WS_WIN = 2 * MiB;
constexpr size_t WS_WO2 = 8 * MiB;
constexpr size_t WS_WQ = 11 * MiB;
constexpr size_t WS_SUBK = 13 * MiB;
constexpr size_t WS_U16 = 14 * MiB;
constexpr size_t WS_V16 = 46 * MiB;
constexpr size_t WS_H = 78 * MiB;
constexpr size_t WS_PROJ = 142 * MiB;
constexpr size_t WS_Q3 = WS_PROJ;
constexpr size_t WS_MIX = 334 * MiB;
constexpr size_t WS_EXP = 430 * MiB;
constexpr size_t WS_KVC = WS_EXP;
constexpr size_t WS_GATE = 446 * MiB;
constexpr size_t WS_ATMP = 462 * MiB;
constexpr size_t WS_CBUF = 494 * MiB;
constexpr size_t WS_ABUF1 = WS_MIX;
constexpr size_t WS_END = 510 * MiB;

struct Params {
    const float *x, *c, *ada_w, *ada_b, *norm1_g, *norm2_g, *w_in, *a_qk_gain, *a_lambda, *a_sub_gain, *b_q_gain, *b_kv_gain, *b_w_uv, *w_out, *peer_wq, *peer_subkeys, *peer_u, *peer_v;
    float* out; unsigned char* ws;
};

enum { SC_LAM = 0, SC_MA = 1, SC_MB = 2 };

__device__ __forceinline__ unsigned f2bf(float f) { unsigned u = __float_as_uint(f); return (u + 0x7fffu + ((u >> 16) & 1u)) >> 16; }
__device__ __forceinline__ float bf2f(unsigned h) { return __uint_as_float(h << 16); }
__device__ __forceinline__ unsigned pk2(float lo, float hi) { return f2bf(lo) | (f2bf(hi) << 16); }
__device__ __forceinline__ float bflo(unsigned w) { return __uint_as_float(w << 16); }
__device__ __forceinline__ float bfhi(unsigned w) { return __uint_as_float(w & 0xffff0000u); }
__device__ __forceinline__ float wave_sum(float v) {
#pragma unroll
    for (int o = 1; o < 64; o <<= 1) v += __shfl_xor(v, o);
    return v;
}
__device__ __forceinline__ float wave_max(float v) {
#pragma unroll
    for (int o = 1; o < 64; o <<= 1) v = fmaxf(v, __shfl_xor(v, o));
    return v;
}
#define LDS_WAIT() asm volatile("s_waitcnt lgkmcnt(0)" ::: "memory")
__device__ __forceinline__ void ph_mod(const Params& p, float* ldsf, int vb, int nvb) {
    if (vb >= 96) return;
    int tid = threadIdx.x; asm volatile("" : "+v"(tid));
    const int lane = tid & 63, wv = tid >> 6;
    for (int i = tid; i < 16 * 1024; i += NT) { const float v = p.c[i]; ldsf[i] = v / (1.f + __expf(-v)); }
    __syncthreads();
    float* MOD = (float*)(p.ws + WS_MOD); float* part = ldsf + 16 * 1024;
    for (int it = vb; it < 96; it += nvb) {
        const int j = it * 64 + lane;
        float acc[16];
#pragma unroll
        for (int b = 0; b < 16; ++b) acc[b] = 0.f;
        const float* wp = p.ada_w + (size_t)(128 * wv) * 6144 + j;
#pragma unroll 1
        for (int k0 = 0; k0 < 128; k0 += 8) {
            float w[8];
#pragma unroll
            for (int u = 0; u < 8; ++u) w[u] = wp[(size_t)(k0 + u) * 6144];
#pragma unroll
            for (int u = 0; u < 8; ++u)
#pragma unroll
                for (int b = 0; b < 16; ++b) acc[b] = fmaf(ldsf[b * 1024 + 128 * wv + k0 + u], w[u], acc[b]);
        }
#pragma unroll
        for (int b = 0; b < 16; ++b) part[(wv * 16 + b) * 64 + lane] = acc[b];
        __syncthreads();
        for (int o = tid; o < 16 * 64; o += NT) { const int b = o >> 6, c = o & 63; float s = 0.f;
#pragma unroll
            for (int w = 0; w < 8; ++w) s += part[(w * 16 + b) * 64 + c];
            MOD[b * 6144 + it * 64 + c] = s + p.ada_b[it * 64 + c]; }
        __syncthreads();
    }
}

__device__ __forceinline__ void transpose_item(const float* W, int N, bf16* WT, int ldt, LAS float* scr, int kb, int nb, int lane) {
    const int k0 = 64 * kb, n0 = 32 * nb;
#pragma unroll 8
    for (int i = 0; i < 32; ++i) { const int kk = 2 * i + (lane >> 5); const int n = n0 + (lane & 31); scr[kk * 33 + (lane & 31)] = (n < N) ? W[(size_t)(k0 + kk) * N + n] : 0.f; }
    LDS_WAIT(); asm volatile("" ::: "memory");
    const int c = lane & 7;
#pragma unroll
    for (int j = 0; j < 4; ++j) { const int n = (lane >> 3) + 8 * j; const LAS float* s = scr + (8 * c) * 33 + n;
        u32x4 o; o.x = pk2(s[0 * 33], s[1 * 33]); o.y = pk2(s[2 * 33], s[3 * 33]); o.z = pk2(s[4 * 33], s[5 * 33]); o.w = pk2(s[6 * 33], s[7 * 33]);
        *(u32x4*)(WT + (size_t)(n0 + n) * ldt + k0 + 8 * c) = o; }
    LDS_WAIT(); asm volatile("" ::: "memory");
}

__device__ __forceinline__ void ph_prep_weights(const Params& p, LAS float* scr, int gw, int ngw, int lane) {
    bf16* WIN = (bf16*)(p.ws + WS_WIN); bf16* WO2 = (bf16*)(p.ws + WS_WO2); bf16* WQ = (bf16*)(p.ws + WS_WQ);
    constexpr int I_IN = 16 * 96, I_O = 8 * 32, I_Q = 16 * 32;
    for (int it = gw; it < I_IN + I_O + I_Q; it += ngw) {
        int r = it;
        if (r < I_IN) { transpose_item(p.w_in, IN_COLS, WIN, 1024, scr, r / 96, r % 96, lane); continue; } r -= I_IN;
        if (r < I_O) { transpose_item(p.w_out, 1024, WO2, MIXW, scr, r / 32, r % 32, lane); continue; } r -= I_O;
        transpose_item(p.peer_wq, 1024, WQ, 1024, scr, r / 32, r % 32, lane);
    }
    const size_t gt = (size_t)gw * 64 + lane, ngt = (size_t)ngw * 64;
    for (size_t i = gt; i < (size_t)1024 * 1024; i += ngt) {
        const int n = (int)(i & 1023), kk = (int)(i >> 10), h = kk >> 7;
        const float* wu = p.b_w_uv + (size_t)kk * 64; const float* wo = p.w_out + (size_t)(512 + 64 * h) * 1024 + n;
        float a = 0.f;
#pragma unroll 8
        for (int e = 0; e < 64; ++e) a = fmaf(wu[e], wo[(size_t)e * 1024], a);
        WO2[(size_t)n * MIXW + 512 + kk] = (bf16)f2bf(a);
    }
    unsigned char* U8 = (unsigned char*)(p.ws + WS_U16); unsigned char* V8 = (unsigned char*)(p.ws + WS_V16); bf16* SUBK = (bf16*)(p.ws + WS_SUBK);
    constexpr size_t NTAB8 = (size_t)NEXP * 1024 / 8, NSUB8 = 2 * 128 * 64 / 8;
    for (size_t i = gt; i < 2 * NTAB8 + NSUB8; i += ngt) {
        if (i < 2 * NTAB8) {
            const bool isu = i < NTAB8; const size_t j = isu ? i : i - NTAB8; const float sc = isu ? 32.0f : 1.0f;
            const f32x8 v = *(const f32x8*)((isu ? p.peer_u : p.peer_v) + j * 8);
            int w0 = 0, w1 = 0;
            w0 = __builtin_amdgcn_cvt_pk_fp8_f32(v[0] * sc, v[1] * sc, w0, false); w0 = __builtin_amdgcn_cvt_pk_fp8_f32(v[2] * sc, v[3] * sc, w0, true);
            w1 = __builtin_amdgcn_cvt_pk_fp8_f32(v[4] * sc, v[5] * sc, w1, false); w1 = __builtin_amdgcn_cvt_pk_fp8_f32(v[6] * sc, v[7] * sc, w1, true);
            u32x2 o; o.x = (unsigned)w0; o.y = (unsigned)w1;
            *(u32x2*)((isu ? U8 : V8) + j * 8) = o;
        } else {
            const size_t j = i - 2 * NTAB8;
            const f32x8 v = *(const f32x8*)(p.peer_subkeys + j * 8);
            u32x4 o; o.x = pk2(v[0], v[1]); o.y = pk2(v[2], v[3]); o.z = pk2(v[4], v[5]); o.w = pk2(v[6], v[7]);
            *(u32x4*)(SUBK + j * 8) = o;
        }
    }
    if (gt == 0) {
        float* SC = (float*)(p.ws + WS_SCAL);
        float s01 = 0.f, s23 = 0.f;
        for (int i = 0; i < 64; ++i) { s01 += p.a_lambda[i] * p.a_lambda[64 + i]; s23 += p.a_lambda[128 + i] * p.a_lambda[192 + i]; }
        SC[SC_LAM] = __expf(s01) - __expf(s23) + 0.2f;
        float g0 = 0.f, g1 = 0.f, gq = 0.f, gk = 0.f;
        for (int i = 0; i < 64; ++i) { g0 = fmaxf(g0, fabsf(p.a_qk_gain[i])); g1 = fmaxf(g1, fabsf(p.a_qk_gain[64 + i])); }
        for (int i = 0; i < 128; ++i) { gq = fmaxf(gq, fabsf(p.b_q_gain[i])); gk = fmaxf(gk, fabsf(p.b_kv_gain[i])); }
        SC[SC_MA] = 8.0f * g0 * g1 * 1.02f;
        SC[SC_MB] = 11.3137085f * gq * gk * 1.02f;
    }
}

__device__ __forceinline__ void ph_hrows(const Params& p, const float* X, const float* g, int shOff, int scOff, int gw, int ngw, int lane) {
    const float* MOD = (const float*)(p.ws + WS_MOD); bf16* H = (bf16*)(p.ws + WS_H);
    for (int m = gw; m < T; m += ngw) {
        const f32x4* xr = (const f32x4*)(X + (size_t)m * 1024) + lane;
        f32x4 v[4]; float s = 0.f;
#pragma unroll
        for (int j = 0; j < 4; ++j) { v[j] = xr[64 * j]; s += (v[j].x * v[j].x + v[j].y * v[j].y) + (v[j].z * v[j].z + v[j].w * v[j].w); }
        const float rstd = rsqrtf(wave_sum(s) * (1.f / 1024.f) + EPS);
        const float* mb = MOD + (size_t)(m >> 11) * 6144;
#pragma unroll
        for (int j = 0; j < 4; ++j) {
            const int col = 4 * (lane + 64 * j);
            const f32x4 gg = *(const f32x4*)(g + col), sc = *(const f32x4*)(mb + scOff + col), sh = *(const f32x4*)(mb + shOff + col);
            const f32x4 y = v[j] * rstd * gg * (sc + 1.0f) + sh;
            u32x2 o; o.x = pk2(y.x, y.y); o.y = pk2(y.z, y.w);
            *(u32x2*)(H + (size_t)m * 1024 + col) = o;
        }
    }
}

__device__ __forceinline__ void ph_norm_proj(const Params& p, int gw, int ngw, int lane) {
    bf16* PROJ = (bf16*)(p.ws + WS_PROJ);
    for (int m = gw; m < T; m += ngw) {
        bf16* row = PROJ + (size_t)m * NP;
#pragma unroll
        for (int j = 0; j < 6; ++j) {
            if (j == 2) continue;
            const int col = 8 * lane + 512 * j;
            const u32x4 raw = *(const u32x4*)(row + col);
            float v[8] = {bflo(raw.x), bfhi(raw.x), bflo(raw.y), bfhi(raw.y), bflo(raw.z), bfhi(raw.z), bflo(raw.w), bfhi(raw.w)};
            float ss = 0.f;
#pragma unroll
            for (int i = 0; i < 8; ++i) ss += v[i] * v[i];
            ss += __shfl_xor(ss, 1); ss += __shfl_xor(ss, 2); ss += __shfl_xor(ss, 4);
            float rstd; const float* gp;
            if (j < 2) { rstd = rsqrtf(ss * (1.f / 64.f) + EPS); gp = p.a_qk_gain + 64 * j + (col & 63); }
            else { ss += __shfl_xor(ss, 8); rstd = rsqrtf(ss * (1.f / 128.f) + EPS); gp = (j == 5 ? p.b_kv_gain : p.b_q_gain) + (col & 127); }
            if (j == 5 && lane >= 16) continue;
            const f32x4 g0 = *(const f32x4*)gp, g1 = *(const f32x4*)(gp + 4);
            u32x4 o; o.x = pk2(v[0] * rstd * g0.x, v[1] * rstd * g0.y); o.y = pk2(v[2] * rstd * g0.z, v[3] * rstd * g0.w);
            o.z = pk2(v[4] * rstd * g1.x, v[5] * rstd * g1.y); o.w = pk2(v[6] * rstd * g1.z, v[7] * rstd * g1.w);
            *(u32x4*)(row + col) = o;
        }
    }
}
struct EpiResGate {
    static constexpr bool PERM = false, AFTER_DRAIN = false;
    const float* X; float* Out; const float* gate;
    __device__ __forceinline__ void operator()(const pg8::f32x4 (&acc)[2][2][4][2], const pg8::Unit& u, int wr, int wc, int fr, int fq) const {
        const int col0 = u.pn * 256 + wc * 32 + 4 * fq;
#pragma unroll
        for (int ai = 0; ai < 2; ++ai)
#pragma unroll
            for (int m = 0; m < 4; ++m) {
                const int r = u.pm * 256 + ai * 128 + wr * 64 + m * 16 + fr; const float* gb = gate + (size_t)(r >> 11) * 6144;
#pragma unroll
                for (int bj = 0; bj < 2; ++bj)
#pragma unroll
                    for (int n = 0; n < 2; ++n) { const int c = col0 + bj * 128 + n * 16; const size_t off = (size_t)r * 1024 + c;
                        const pg8::f32x4 xv = *(const pg8::f32x4*)(X + off), gv = *(const pg8::f32x4*)(gb + c);
                        *(pg8::f32x4*)(Out + off) = xv + gv * acc[ai][bj][m][n]; }
            }
    }
};


struct EpiNormBf16 {
    static constexpr bool PERM = true, AFTER_DRAIN = false;
    bf16* O; const float* gqk; const float* gbq; const float* gbkv; LAS float* P; bf16* KVC;
    __device__ __forceinline__ void operator()(const pg8::f32x4 (&acc)[2][2][4][2], const pg8::Unit& u, int wr, int wc, int fr, int fq) const {
        const int pn = u.pn;
        const int mode = pn < 4 ? 1 : ((pn == 4 || pn == 5 || pn == 11) ? 0 : (pn == 10 ? 3 : 2));
        if (mode != 0) {
#pragma unroll
            for (int ai = 0; ai < 2; ++ai)
#pragma unroll
                for (int m = 0; m < 4; ++m)
#pragma unroll
                    for (int bj = 0; bj < 2; ++bj) {
                        const pg8::f32x4 a = acc[ai][bj][m][0], b = acc[ai][bj][m][1];
                        float ss = (a[0] * a[0] + a[1] * a[1]) + (a[2] * a[2] + a[3] * a[3]) + (b[0] * b[0] + b[1] * b[1]) + (b[2] * b[2] + b[3] * b[3]);
                        ss += __shfl_xor(ss, 16); ss += __shfl_xor(ss, 32);
                        if (fq == 0) P[(ai * 128 + wr * 64 + m * 16 + fr) * 8 + bj * 4 + wc] = ss;
                    }
            asm volatile("s_waitcnt lgkmcnt(0)" ::: "memory"); __builtin_amdgcn_s_barrier(); asm volatile("" ::: "memory");
        }
        const int row0 = u.pm * 256 + wr * 64 + fr, col0 = u.pn * 256 + wc * 32 + 8 * fq;
        pg8::f32x4 g0[2], g1[2];
#pragma unroll
        for (int bj = 0; bj < 2; ++bj) {
            const float* gp = nullptr;
            if (mode == 1) gp = gqk + (pn >= 2 ? 64 : 0) + 32 * (wc & 1) + 8 * fq;
            else if (mode == 2) gp = gbq + 32 * wc + 8 * fq;
            else if (mode == 3 && bj == 0) gp = gbkv + 32 * wc + 8 * fq;
            if (gp) { g0[bj] = *(const pg8::f32x4*)gp; g1[bj] = *(const pg8::f32x4*)(gp + 4); } else { g0[bj] = (pg8::f32x4){1.f, 1.f, 1.f, 1.f}; g1[bj] = g0[bj]; }
        }
#pragma unroll
        for (int ai = 0; ai < 2; ++ai)
#pragma unroll
            for (int m = 0; m < 4; ++m) { bf16* rowp = O + (size_t)(row0 + ai * 128 + m * 16) * NP + col0;
#pragma unroll
                for (int bj = 0; bj < 2; ++bj) {
                    float s = 1.f;
                    if (mode != 0 && !(mode == 3 && bj == 1)) {
                        const pg8::f32x4 q = *(const LAS pg8::f32x4*)(P + (ai * 128 + wr * 64 + m * 16 + fr) * 8 + bj * 4);
                        s = (mode == 1) ? rsqrtf(((wc < 2) ? (q[0] + q[1]) : (q[2] + q[3])) * (1.f / 64.f) + EPS) : rsqrtf(((q[0] + q[1]) + (q[2] + q[3])) * (1.f / 128.f) + EPS);
                    }
                    const pg8::f32x4 v0 = acc[ai][bj][m][0] * s * g0[bj], v1 = acc[ai][bj][m][1] * s * g1[bj];
                    pg8::u32x4 w; w.x = pg8::cvt_pk_bf16(v0[0], v0[1]); w.y = pg8::cvt_pk_bf16(v0[2], v0[3]); w.z = pg8::cvt_pk_bf16(v1[0], v1[1]); w.w = pg8::cvt_pk_bf16(v1[2], v1[3]);
                    if (pn == 10 && bj == 0) *(pg8::u32x4*)(KVC + (size_t)(row0 + ai * 128 + m * 16) * 128 + wc * 32 + 8 * fq) = w;
                    else *(pg8::u32x4*)(rowp + bj * 128) = w; } }
    }
};
typedef __bf16 bf16x2_t __attribute__((ext_vector_type(2)));
__device__ __forceinline__ float dot2bf(unsigned a, unsigned b, float acc) { return __builtin_amdgcn_fdot2_f32_bf16(__builtin_bit_cast(bf16x2_t, a), __builtin_bit_cast(bf16x2_t, b), acc, false); }
template <int CTRL> __device__ __forceinline__ float dpp_f(float v) { return __int_as_float(__builtin_amdgcn_update_dpp(0, __float_as_int(v), CTRL, 0xf, 0xf, false)); }
__device__ __forceinline__ float row16_sum(float v) {
    v += dpp_f<0x128>(v); v += dpp_f<0x124>(v); v += dpp_f<0x122>(v); v += dpp_f<0x121>(v); return v;
}
__device__ __forceinline__ float gelu_erf(float v) {
    const float av = fabsf(v), t = __builtin_amdgcn_rcpf(fmaf(av, 0.2316418882f, 1.0f));
    float q = fmaf(t, 0.5307027145f, -0.7265760135f); q = fmaf(q, t, 0.7107068705f); q = fmaf(q, t, -0.142248368f); q = fmaf(q, t, 0.127414796f); q = q * t;
    const float e = __builtin_amdgcn_exp2f(v * v * -0.72134752044f);
    const float m = v * (q * e);
    return v < 0.f ? m : v - m;
}

#ifndef DSA_PB
#define DSA_PB 0
#endif
typedef short v4i16_t __attribute__((ext_vector_type(4)));
#ifndef DSA_REP_A
#define DSA_REP_A 1
#endif
#ifndef DSA_REP_B
#define DSA_REP_B 1
#endif
#ifndef DSA_REP_C
#define DSA_REP_C 1
#endif
constexpr int DSA_SROW = 2048 * 4 + 16;
constexpr int DSA_SEL_OFF = 16 * DSA_SROW;
constexpr int DSA_LDS = DSA_SEL_OFF + 16 * 512;
constexpr int DSA_KVROW = 272;

__device__ __forceinline__ unsigned sortkey(float s) { const unsigned u = __float_as_uint(s); return u ^ ((u >> 31) ? 0xffffffffu : 0x80000000u); }
__device__ __forceinline__ unsigned cvtpk_bf16(float lo, float hi) { unsigned r; asm volatile("v_cvt_pk_bf16_f32 %0, %1, %2" : "=v"(r) : "v"(lo), "v"(hi)); return r; }

__device__ __forceinline__ void cnt_ge4(int& acc, unsigned k0, unsigned k1, unsigned k2, unsigned k3, unsigned cand) {
    asm volatile("v_cmp_ge_u32_e64 s[40:41], %1, %5\n\t"
                 "v_cmp_ge_u32_e64 s[42:43], %2, %5\n\t"
                 "v_cmp_ge_u32_e64 s[44:45], %3, %5\n\t"
                 "v_cmp_ge_u32_e64 s[46:47], %4, %5\n\t"
                 "v_addc_co_u32_e64 %0, s[48:49], %0, 0, s[40:41]\n\t"
                 "v_addc_co_u32_e64 %0, s[48:49], %0, 0, s[42:43]\n\t"
                 "v_addc_co_u32_e64 %0, s[48:49], %0, 0, s[44:45]\n\t"
                 "v_addc_co_u32_e64 %0, s[48:49], %0, 0, s[46:47]"
                 : "+v"(acc) : "v"(k0), "v"(k1), "v"(k2), "v"(k3), "v"(cand)
                 : "s40", "s41", "s42", "s43", "s44", "s45", "s46", "s47", "s48", "s49");
}
__device__ __forceinline__ void ph_dsa(const Params& p, unsigned char* lds, int vb, int nvb) {
    const bf16* PROJ = (const bf16*)(p.ws + WS_PROJ); bf16* MIX = (bf16*)(p.ws + WS_MIX);
    const float MB = ((const float*)(p.ws + WS_SCAL))[SC_MB];
    int tid = threadIdx.x; asm volatile("" : "+v"(tid)); const int lane = tid & 63, wv = __builtin_amdgcn_readfirstlane(tid >> 6);
    const int l15 = lane & 15, g = lane >> 4;
    LAS unsigned char* ldsl = (LAS unsigned char*)lds;
    for (int it = vb; it < 2048; it += nvb) {
        const int vbb = it & 255, kk = it >> 8, xg = vbb & 7, ix = vbb >> 3, b = 2 * xg + (ix & 1), G = (ix >> 1) & 3, sub = ix >> 3;
        const int c = (kk & 1) ? (31 - G - 8 * (kk >> 1)) : (G + 8 * (kk >> 1));
        const int cend = (c + 1) * 64, t0 = c * 64 + sub * 16;
        const bf16* Pb = PROJ + (size_t)b * SEQ * NP;
        const bf16* KVb = (const bf16*)(p.ws + WS_KVC) + (size_t)b * SEQ * 128;
#pragma unroll 1
        for (int repa = 0; repa < DSA_REP_A; ++repa)
        if (c >= 4) {
            const bf16* qrow = Pb + (size_t)(t0 + l15) * NP;
            bf16x8 bq[4][2]; float wsc[4];
#pragma unroll
            for (int h = 0; h < 4; ++h) { wsc[h] = bf2f(qrow[C_WI + h]) * 0.0625f;
#pragma unroll
                for (int ks = 0; ks < 2; ++ks) bq[h][ks] = *(const bf16x8*)(qrow + C_QI + h * 64 + 32 * ks + 8 * g); }
            for (int k0 = 16 * wv; k0 < cend; k0 += 128) {
                const bf16* krow = Pb + (size_t)(k0 + l15) * NP + C_KI + 8 * g;
                const bf16x8 ka0 = *(const bf16x8*)krow, ka1 = *(const bf16x8*)(krow + 32);
                f32x4 sc = {0.f, 0.f, 0.f, 0.f};
#pragma unroll
                for (int h = 0; h < 4; ++h) { f32x4 a = {0.f, 0.f, 0.f, 0.f};
                    a = __builtin_amdgcn_mfma_f32_16x16x32_bf16(ka0, bq[h][0], a, 0, 0, 0);
                    a = __builtin_amdgcn_mfma_f32_16x16x32_bf16(ka1, bq[h][1], a, 0, 0, 0);
#pragma unroll
                    for (int r = 0; r < 4; ++r) sc[r] = fmaf(fmaxf(a[r], 0.f), wsc[h], sc[r]); }
#pragma unroll
                for (int r = 0; r < 4; ++r) sc[r] = (sc[r] == 0.f) ? 0.f : sc[r];
                *(LAS f32x4*)(ldsl + l15 * DSA_SROW + (k0 + 4 * g) * 4) = sc;
            }
        }
        __syncthreads();
        LAS unsigned short* selw = (LAS unsigned short*)(ldsl + DSA_SEL_OFF);
        int mind0 = 0, mind1 = 0;
        if (c < 4) {
            for (int j = lane; j < 256; j += 64) { selw[(2 * wv) * 256 + j] = (unsigned short)j; selw[(2 * wv + 1) * 256 + j] = (unsigned short)j; }
        } else {
            const int nreg = cend >> 6;
            unsigned keyA[32], keyB[32];
            { const LAS float* srA = (const LAS float*)(ldsl + (2 * wv) * DSA_SROW) + lane; const LAS float* srB = (const LAS float*)(ldsl + (2 * wv + 1) * DSA_SROW) + lane;
#pragma unroll
              for (int i = 0; i < 32; ++i) { keyA[i] = (i < nreg) ? sortkey(srA[64 * i]) : 0u; keyB[i] = (i < nreg) ? sortkey(srB[64 * i]) : 0u; } }
#define DSA_WSUM(V, OUT) do { int v_ = (V); v_ += __builtin_amdgcn_update_dpp(0, v_, 0x128, 0xf, 0xf, false); v_ += __builtin_amdgcn_update_dpp(0, v_, 0x124, 0xf, 0xf, false); \
        v_ += __builtin_amdgcn_update_dpp(0, v_, 0x122, 0xf, 0xf, false); v_ += __builtin_amdgcn_update_dpp(0, v_, 0x121, 0xf, 0xf, false);                                     \
        OUT = __builtin_amdgcn_readlane(v_, 0) + __builtin_amdgcn_readlane(v_, 16) + __builtin_amdgcn_readlane(v_, 32) + __builtin_amdgcn_readlane(v_, 48); } while (0)
            unsigned prefA = 0u, prefB = 0u; bool exA = false, exB = false;
#pragma unroll 1
            for (int bit = 31; bit >= 0; --bit) {
                const unsigned candA = exA ? prefA : (prefA | (1u << bit)), candB = exB ? prefB : (prefB | (1u << bit));
                int ca = 0, cb = 0;
#pragma unroll
                for (int i = 0; i < 32; i += 4) { cnt_ge4(ca, keyA[i], keyA[i + 1], keyA[i + 2], keyA[i + 3], candA); cnt_ge4(cb, keyB[i], keyB[i + 1], keyB[i + 2], keyB[i + 3], candB); }
                int cntA, cntB; DSA_WSUM(ca, cntA); DSA_WSUM(cb, cntB);
                if (!exA && cntA >= 256) { prefA = candA; exA = (cntA == 256); }
                if (!exB && cntB >= 256) { prefB = candB; exB = (cntB == 256); }
                if (exA && exB) break;
            }
#define DSA_COMPACT(KEY, PREFIX, EXACT, QQ, MIND) do {                                                                                              \
            const int t_ = t0 + (QQ); LAS unsigned short* sel = selw + (QQ) * 256;                                                                    \
            int need_ties = 0;                                                                                                                        \
            if (!(EXACT)) { int cg_ = 0; if ((PREFIX) != 0xffffffffu) { _Pragma("unroll") for (int i = 0; i < 32; ++i) cg_ += (KEY[i] > (PREFIX)) ? 1 : 0; } \
                int cgt; DSA_WSUM(cg_, cgt); need_ties = 256 - cgt; }                                                                                 \
            int base = 0, tbase = 0, md = 4096;                                                                                                       \
            _Pragma("unroll") for (int i = 0; i < 32; ++i) { if (i < nreg) {                                                                          \
                bool selb;                                                                                                                            \
                if (EXACT) selb = KEY[i] >= (PREFIX);                                                                                                 \
                else { const bool tie = KEY[i] == (PREFIX); const unsigned long long mt = __ballot(tie);                                              \
                    const int trank = tbase + (int)__builtin_amdgcn_mbcnt_hi((unsigned)(mt >> 32), __builtin_amdgcn_mbcnt_lo((unsigned)mt, 0u));      \
                    selb = (KEY[i] > (PREFIX)) || (tie && trank < need_ties); tbase += __popcll(mt); }                                                \
                const unsigned long long m = __ballot(selb);                                                                                          \
                const int pos = base + (int)__builtin_amdgcn_mbcnt_hi((unsigned)(m >> 32), __builtin_amdgcn_mbcnt_lo((unsigned)m, 0u));               \
                const int kidx = i * 64 + lane;                                                                                                       \
                if (selb) { sel[pos] = (unsigned short)kidx; const int d = t_ > kidx ? t_ - kidx : kidx - t_; md = d < md ? d : md; }                 \
                base += __popcll(m); } }                                                                                                              \
            _Pragma("unroll") for (int o = 1; o < 64; o <<= 1) { const int x = __shfl_xor(md, o); md = x < md ? x : md; }                             \
            MIND = md; } while (0)
            DSA_COMPACT(keyA, prefA, exA, 2 * wv, mind0);
            DSA_COMPACT(keyB, prefB, exB, 2 * wv + 1, mind1);
#undef DSA_COMPACT
#undef DSA_WSUM
        }
        LDS_WAIT(); asm volatile("" ::: "memory");
        const int nvalid = cend < 256 ? cend : 256;
        const int head = lane & 7;
        const float slopeL2 = exp2f(-(float)(head + 1)) * 1.4426950409f;
#pragma unroll 1
        for (int qi2 = 0; qi2 < 2 * DSA_REP_C; ++qi2) { const int qi = qi2 & 1;
            const int qq = 2 * wv + qi, t = t0 + qq;
            const LAS unsigned short* sel = selw + qq * 256;
            LAS unsigned char* stg = ldsl + (2 * wv) * DSA_SROW;
            const bf16* qrow = Pb + (size_t)t * NP + C_QB + head * 128 + 8 * g;
            bf16x8 bq[4];
#pragma unroll
            for (int ks = 0; ks < 4; ++ks) bq[ks] = *(const bf16x8*)(qrow + 32 * ks);
            const float refL2 = MB * 1.4426950409f - slopeL2 * (float)(qi == 0 ? mind0 : mind1);
            f32x4 o[8];
#pragma unroll
            for (int dt = 0; dt < 8; ++dt) o[dt] = (f32x4){0.f, 0.f, 0.f, 0.f};
            float lsum = 0.f;
#define DSA_GATHER(S, KA) do { _Pragma("unroll") for (int i_ = 0; i_ < 8; ++i_) { const int jr = 32 * (S) + 4 * i_ + g; const int keyr = sel[jr < nvalid ? jr : 0];   \
        KA[i_] = *(const bf16x8*)(KVb + (size_t)keyr * 128 + 8 * l15); } } while (0)
#define DSA_COMPUTE(S, KA) do { unsigned pb[4];                                                                                                        \
        _Pragma("unroll") for (int i_ = 0; i_ < 8; ++i_) *(LAS bf16x8*)(stg + (4 * i_ + g) * DSA_KVROW + 16 * l15) = KA[i_];                              \
        LDS_WAIT(); asm volatile("" ::: "memory");                                                                                                        \
        _Pragma("unroll") for (int tl = 0; tl < 2; ++tl) { const int j0 = 32 * (S) + 16 * tl;                                                           \
            f32x4 a = {0.f, 0.f, 0.f, 0.f};                                                                                                             \
            _Pragma("unroll") for (int ks = 0; ks < 4; ++ks) { const bf16x8 ka_ = *(const LAS bf16x8*)(stg + (16 * tl + l15) * DSA_KVROW + (32 * ks + 8 * g) * 2); \
                a = __builtin_amdgcn_mfma_f32_16x16x32_bf16(ka_, bq[ks], a, 0, 0, 0); }                                                                 \
            const u32x2 kw = *(const LAS u32x2*)(sel + j0 + 4 * g);                                                                                     \
            const int kx[4] = {(int)(kw.x & 0xffffu), (int)(kw.x >> 16), (int)(kw.y & 0xffffu), (int)(kw.y >> 16)};                                     \
            float pr[4];                                                                                                                                \
            _Pragma("unroll") for (int r = 0; r < 4; ++r) { const int dd = t > kx[r] ? t - kx[r] : kx[r] - t;                                            \
                const float e = __builtin_amdgcn_exp2f(fmaf(a[r], 0.1275174f, -slopeL2 * (float)dd - refL2));                                            \
                pr[r] = (j0 + 4 * g + r < nvalid) ? e : 0.f; lsum += pr[r]; }                                                                           \
            pb[2 * tl] = cvtpk_bf16(pr[0], pr[1]); pb[2 * tl + 1] = cvtpk_bf16(pr[2], pr[3]); }                                                         \
        LDS_WAIT(); asm volatile("" ::: "memory");                                                                                                      \
        u32x4 pw4; pw4.x = pb[0]; pw4.y = pb[1]; pw4.z = pb[2]; pw4.w = pb[3];                                                                          \
        const bf16x8 pfrag = __builtin_bit_cast(bf16x8, pw4);                                                                                           \
        const LAS unsigned char* trb = stg + (4 * g + (l15 >> 2)) * DSA_KVROW + (4 * (lane & 3)) * 2;                                                   \
        _Pragma("unroll") for (int dt = 0; dt < 8; ++dt) {                                                                                              \
            const s16x4 lo = __builtin_bit_cast(s16x4, __builtin_amdgcn_ds_read_tr16_b64_v4i16((LAS v4i16_t*)(trb + dt * 32)));                         \
            const s16x4 hi = __builtin_bit_cast(s16x4, __builtin_amdgcn_ds_read_tr16_b64_v4i16((LAS v4i16_t*)(trb + 16 * DSA_KVROW + dt * 32)));        \
            const bf16x8 af = {lo[0], lo[1], lo[2], lo[3], hi[0], hi[1], hi[2], hi[3]};                                                                 \
            o[dt] = __builtin_amdgcn_mfma_f32_16x16x32_bf16(af, pfrag, o[dt], 0, 0, 0); }                                                               \
        LDS_WAIT(); asm volatile("" ::: "memory"); } while (0)
            const int nch = (nvalid + 31) >> 5;
            bf16x8 KA[8], KB[8];
            DSA_GATHER(0, KA);
#pragma unroll 1
            for (int s = 0; s < nch; s += 2) {
                if (s + 1 < nch) DSA_GATHER(s + 1, KB);
                DSA_COMPUTE(s, KA);
                if (s + 1 < nch) { if (s + 2 < nch) DSA_GATHER(s + 2, KA); DSA_COMPUTE(s + 1, KB); }
            }
#undef DSA_GATHER
#undef DSA_COMPUTE
            lsum += __shfl_xor(lsum, 16); lsum += __shfl_xor(lsum, 32);
            const float il = 1.f / lsum;
            if (l15 < 8) {
                bf16* orow = MIX + (size_t)(b * SEQ + t) * MIXW + 512 + head * 128 + 4 * g;
#pragma unroll
                for (int dt = 0; dt < 8; ++dt) { u32x2 w; w.x = pk2(o[dt][0] * il, o[dt][1] * il); w.y = pk2(o[dt][2] * il, o[dt][3] * il); *(u32x2*)(orow + 16 * dt) = w; }
            }
        }
        __syncthreads();
    }
}
typedef __attribute__((address_space(1))) float GASF;
#ifndef ATT_PROBE
#define ATT_PROBE 0
#endif
#ifndef ATT_REMAP
#define ATT_REMAP 1
#endif
__device__ __forceinline__ int crow(int r, int hi) { return (r & 3) + 8 * (r >> 2) + 4 * hi; }
#define KSWZ64(row, cb) ((row) * 128 + ((cb) ^ ((((row) >> 1) & 7) << 4)))
__device__ __forceinline__ int v_st(int k, int c) { const int kk = (k & ~0xC) | ((k & 4) << 1) | ((k & 8) >> 1); return ((kk >> 3) * 4 + (c >> 5)) * 512 + ((kk & 7) * 32 + (c & 31)) * 2; }
__device__ __forceinline__ int v_rd_base(int lane) { return ((lane & 3) << 3) | (((lane >> 2) & 3) << 6) | (((lane >> 4) & 1) << 5) | (((lane >> 5) & 1) << 8); }
constexpr int v_rd_off(int d0, int ks, int half) { return d0 * 512 + ks * 4096 + half * 2048; }
template <int OFF> __device__ __forceinline__ s16x4 tr_read(int vb) {
    s16x4 r; asm volatile("ds_read_b64_tr_b16 %0, %1 offset:%2" : "=&v"(r) : "v"(vb), "i"(OFF) : "memory"); return r;
}
template <int D0> __device__ __forceinline__ void pv_one(f32x16& od, int vb, bf16x8 pa0, bf16x8 pa1, bf16x8 pa2, bf16x8 pa3) {
    const s16x4 l0 = tr_read<v_rd_off(D0, 0, 0)>(vb), h0 = tr_read<v_rd_off(D0, 0, 1)>(vb), l1 = tr_read<v_rd_off(D0, 1, 0)>(vb), h1 = tr_read<v_rd_off(D0, 1, 1)>(vb);
    const s16x4 l2 = tr_read<v_rd_off(D0, 2, 0)>(vb), h2 = tr_read<v_rd_off(D0, 2, 1)>(vb), l3 = tr_read<v_rd_off(D0, 3, 0)>(vb), h3 = tr_read<v_rd_off(D0, 3, 1)>(vb);
    asm volatile("s_waitcnt lgkmcnt(0)" ::: "memory"); __builtin_amdgcn_sched_barrier(0);
#define PK(L, H) (bf16x8){L[0], L[1], L[2], L[3], H[0], H[1], H[2], H[3]}
    od = __builtin_amdgcn_mfma_f32_32x32x16_bf16(pa0, PK(l0, h0), od, 0, 0, 0);
    od = __builtin_amdgcn_mfma_f32_32x32x16_bf16(pa1, PK(l1, h1), od, 0, 0, 0);
    od = __builtin_amdgcn_mfma_f32_32x32x16_bf16(pa2, PK(l2, h2), od, 0, 0, 0);
    od = __builtin_amdgcn_mfma_f32_32x32x16_bf16(pa3, PK(l3, h3), od, 0, 0, 0);
#undef PK
}

__device__ __forceinline__ void att_tile(f32x16 (&o)[4], float& lsum, const unsigned char* Kb, int vb0, const unsigned char* Qw, int r32, int hi, int tq, int j, bool past, float slopeL2, float refL2) {
    constexpr float C = 0.125f * 1.4426950409f;
    bf16x8 qr[4];
#pragma unroll
    for (int d0 = 0; d0 < 4; ++d0) qr[d0] = *(const bf16x8*)(Qw + KSWZ64(r32, (d0 * 16 + hi * 8) * 2));
    const float dq = (float)(tq - 64 * j - 4 * hi);
    const float B0 = -slopeL2 * dq - refL2;
    float ps = 0.f;
    bf16x8 pa0, pa1, pa2, pa3;
#define PK4(P, BASE, OUT) do { unsigned a0 = cvtpk_bf16(P[BASE + 0], P[BASE + 1]), a1 = cvtpk_bf16(P[BASE + 2], P[BASE + 3]);   \
    unsigned b0_ = cvtpk_bf16(P[BASE + 4], P[BASE + 5]), b1_ = cvtpk_bf16(P[BASE + 6], P[BASE + 7]);                              \
    auto r0 = __builtin_amdgcn_permlane32_swap(a0, b0_, false, false); auto r1 = __builtin_amdgcn_permlane32_swap(a1, b1_, false, false); \
    u32x4 w = {r0[0], r1[0], r0[1], r1[1]}; OUT = __builtin_bit_cast(bf16x8, w); } while (0)
#define HALF_TILE(KOFF, FOFF, PA, PB) do { f32x16 pp = f32x16{};                                                                     \
    _Pragma("unroll") for (int d0 = 0; d0 < 4; ++d0) { const int cb = (d0 * 16 + hi * 8) * 2;                                        \
        const bf16x8 bk = *(const bf16x8*)(Kb + KSWZ64((KOFF) + r32, cb)); pp = __builtin_amdgcn_mfma_f32_32x32x16_bf16(bk, qr[d0], pp, 0, 0, 0); } \
    if (past) { _Pragma("unroll") for (int r = 0; r < 16; ++r) { const float off = (float)((r & 3) + 8 * (r >> 2)) + (FOFF);          \
            pp[r] = __builtin_amdgcn_exp2f(fmaf(pp[r], C, fmaf(slopeL2, off, B0))); } }                                               \
    else { _Pragma("unroll") for (int r = 0; r < 16; ++r) { const float off = (float)((r & 3) + 8 * (r >> 2)) + (FOFF);               \
            pp[r] = __builtin_amdgcn_exp2f(fmaf(pp[r], C, -slopeL2 * fabsf(dq - off) - refL2)); } }                                   \
    _Pragma("unroll") for (int r = 0; r < 16; ++r) ps += pp[r];                                                                       \
    PK4(pp, 0, PA); PK4(pp, 8, PB); __builtin_amdgcn_sched_barrier(0); } while (0)
    HALF_TILE(0, 0.f, pa0, pa1);
    HALF_TILE(32, 32.f, pa2, pa3);
#undef HALF_TILE
#undef PK4
    { auto rr = __builtin_amdgcn_permlane32_swap(__float_as_uint(ps), __float_as_uint(ps), false, false);
      ps = __uint_as_float(rr[0]) + __uint_as_float(rr[1]); }
    lsum += ps;
    pv_one<0>(o[0], vb0, pa0, pa1, pa2, pa3); pv_one<1>(o[1], vb0, pa0, pa1, pa2, pa3); pv_one<2>(o[2], vb0, pa0, pa1, pa2, pa3); pv_one<3>(o[3], vb0, pa0, pa1, pa2, pa3);
}
constexpr int ATT_LDS = 2 * 16384 + 2 * 8192 + 8 * 256 + 8 * 4096;

__device__ __forceinline__ void ph_attnA(const Params& p, unsigned char* lds, int vb, int nvb) {
    const bf16* PROJ = (const bf16*)(p.ws + WS_PROJ); bf16* MIX = (bf16*)(p.ws + WS_MIX);
    const float* SC = (const float*)(p.ws + WS_SCAL);
    const float lam = SC[SC_LAM], refL2 = SC[SC_MA] * 1.4426950409f;
    constexpr float C = 0.125f * 1.4426950409f;
    int tid = threadIdx.x; asm volatile("" : "+v"(tid)); const int lane = tid & 63, wid = __builtin_amdgcn_readfirstlane(tid >> 6), r32 = lane & 31, hi = lane >> 5;
    unsigned char* V_lds = lds; unsigned char* K_lds = lds + 32768;
    float* wsf = (float*)(lds + 49152) + wid * 64;
    GASF* tmpw = (GASF*)(p.ws + WS_ATMP) + ((size_t)(vb * NWV + wid) * 64) * 64 + lane;
    const int vbase = (int)(uintptr_t)V_lds + v_rd_base(lane);
    const int krow = tid >> 3, kch = tid & 7, kdst = KSWZ64(krow, kch * 16);
    const int sr = tid >> 4, sc = (tid & 15) * 8, vst0 = v_st(sr, sc), vst1 = v_st(32 + sr, sc);
    for (int it = vb; it < 256; it += nvb) {
        #if ATT_REMAP
        const int xg_ = it & 7, m_ = it >> 3, pidx = xg_ * 8 + (m_ >> 2), qbl = m_ & 3, b = pidx >> 2, h = pidx & 3;
#else
        const int b = it >> 4, h = (it >> 2) & 3, qbl = it & 3;
#endif
        const float slopeL2 = exp2f(-2.0f * (float)(h + 1)) * 1.4426950409f;
        const bf16* Pb = PROJ + (size_t)b * SEQ * NP;
#pragma unroll 1
        for (int half = 0; half < 2; ++half) {
            const int qb = half ? 7 - qbl : qbl, q0 = 256 * qb, NTu = 4 * (qb + 1), cw = 4 * qb + (wid >> 1);
            const int tq = q0 + 32 * wid + r32;
#pragma unroll 1
            for (int mi = 0; mi < 2; ++mi) {
                const int m = 1 - mi;
                const bf16* Kg = Pb + C_KA + h * 128 + m * 64 + (size_t)krow * NP + kch * 8;
                const bf16* Vg = Pb + C_VA + h * 128 + (size_t)sr * NP + sc;
                unsigned char* Qw = lds + 51200 + wid * 4096;
                { const bf16* qp = Pb + (size_t)tq * NP + C_QA + h * 128 + m * 64 + hi * 8;
#pragma unroll
                  for (int d0 = 0; d0 < 4; ++d0) *(bf16x8*)(Qw + KSWZ64(r32, (d0 * 16 + hi * 8) * 2)) = *(const bf16x8*)(qp + d0 * 16); }
                f32x16 o[4];
#pragma unroll
                for (int d = 0; d < 4; ++d) o[d] = f32x16{};
                float lsum = 0.f;
                bf16x8 ak, av0, av1;
#define ATT_LOAD(K_, V0_, V1_, TJ) do { const size_t go_ = (size_t)(TJ) * 64 * NP; K_ = *(const bf16x8*)(Kg + go_); V0_ = *(const bf16x8*)(Vg + go_); V1_ = *(const bf16x8*)(Vg + go_ + (size_t)32 * NP); \
        if (ATT_PROBE == 2) { bf16x8 d0_ = *(const volatile bf16x8*)(Kg + go_); bf16x8 d1_ = *(const volatile bf16x8*)(Vg + go_); bf16x8 d2_ = *(const volatile bf16x8*)(Vg + go_ + (size_t)32 * NP); asm volatile("" :: "v"(d0_), "v"(d1_), "v"(d2_)); } } while (0)
#define ATT_WRITE(K_, V0_, V1_, NB) do { *(bf16x8*)(K_lds + (NB) * 8192 + kdst) = K_; *(bf16x8*)(V_lds + (NB) * 16384 + vst0) = V0_; *(bf16x8*)(V_lds + (NB) * 16384 + vst1) = V1_; } while (0)
                ATT_LOAD(ak, av0, av1, 0); ATT_WRITE(ak, av0, av1, 0);
                __syncthreads();
#pragma unroll 1
                for (int j = 0; j < NTu; ++j) {
                    const int buf = j & 1;
                    if (j + 1 < NTu) ATT_LOAD(ak, av0, av1, j + 1);
                    if (j <= cw) { att_tile(o, lsum, K_lds + buf * 8192, vbase + buf * 16384, Qw, r32, hi, tq, j, j < cw, slopeL2, refL2);
#if ATT_PROBE == 1
                        { f32x16 o2[4]; o2[0] = o[0]; o2[1] = o[1]; o2[2] = o[2]; o2[3] = o[3]; float l2 = 0.f; att_tile(o2, l2, K_lds + buf * 8192, vbase + buf * 16384, Qw, r32, hi, tq, j, j < cw, slopeL2, refL2);
                          asm volatile("" :: "v"(o2[0]), "v"(o2[1]), "v"(o2[2]), "v"(o2[3]), "v"(l2)); }
#endif
                    }
                    if (j + 1 < NTu) ATT_WRITE(ak, av0, av1, buf ^ 1);
                    __syncthreads();
                }
#undef ATT_LOAD
#undef ATT_WRITE
                if (hi == 0) wsf[r32] = lsum;
                LDS_WAIT(); asm volatile("" ::: "memory");
                float rli[16];
#pragma unroll
                for (int r = 0; r < 16; ++r) rli[r] = 1.f / wsf[crow(r, hi)];
                LDS_WAIT(); asm volatile("" ::: "memory");
                if (mi == 0) {
#pragma unroll
                    for (int d = 0; d < 4; ++d) { GASF* td = tmpw + d * 1024; asm volatile("" : "+v"(td));
#pragma unroll
                        for (int r = 0; r < 16; ++r) td[r * 64] = o[d][r] * rli[r]; }
                } else {
                    float gsub[4];
#pragma unroll
                    for (int d = 0; d < 4; ++d) gsub[d] = p.a_sub_gain[32 * d + r32];
                    GASF* tdp[4];
#pragma unroll
                    for (int d = 0; d < 4; ++d) { tdp[d] = tmpw + d * 1024; asm volatile("" : "+v"(tdp[d])); }
#pragma unroll
                    for (int r = 0; r < 16; ++r) {
                        float v[4]; float ss = 0.f;
#pragma unroll
                        for (int d = 0; d < 4; ++d) { v[d] = o[d][r] * rli[r] - lam * tdp[d][r * 64]; ss += v[d] * v[d]; }
                        ss += __shfl_xor(ss, 1); ss += __shfl_xor(ss, 2); ss += __shfl_xor(ss, 4); ss += __shfl_xor(ss, 8); ss += __shfl_xor(ss, 16);
                        const float rs = rsqrtf(ss * (1.f / 128.f) + EPS) * 0.8f;
                        bf16* orow = MIX + (size_t)(b * SEQ + q0 + 32 * wid + crow(r, hi)) * MIXW + h * 128 + r32;
#pragma unroll
                        for (int d = 0; d < 4; ++d) orow[32 * d] = (bf16)f2bf(v[d] * rs * gsub[d]);
                        asm volatile("" ::: "memory");
                    }
                }
            }
        }
    }
}
constexpr int RT_WAVE_BYTES = 12288;
constexpr int RT_LDS = 32768 + 8 * RT_WAVE_BYTES;

__device__ __forceinline__ int pl32_sum(int v) { auto rr = __builtin_amdgcn_permlane32_swap((unsigned)v, (unsigned)v, false, false); return (int)(rr[0] + rr[1]); }
__device__ __forceinline__ int pl32_other(int v) { auto rr = __builtin_amdgcn_permlane32_swap((unsigned)v, (unsigned)v, false, false); return (int)(rr[0] + rr[1]) - v; }
__device__ __forceinline__ float unsortkey(unsigned k) { return __uint_as_float((k & 0x80000000u) ? (k ^ 0x80000000u) : ~k); }

template <int N> __device__ __forceinline__ unsigned bisect16(const unsigned (&key)[N]) {
    unsigned prefix = 0u; bool done = false;
#pragma unroll 1
    for (int bit = 31; bit >= 0; --bit) {
        const unsigned cand = done ? prefix : (prefix | (1u << bit));
        int cnt = 0;
#pragma unroll
        for (int i = 0; i + 3 < N; i += 4) cnt_ge4(cnt, key[i], key[i + 1], key[i + 2], key[i + 3], cand);
#pragma unroll
        for (int i = N & ~3; i < N; ++i) cnt += (key[i] >= cand) ? 1 : 0;
        const int tot = pl32_sum(cnt);
        if (!done && tot >= 16) { prefix = cand; done = (tot == 16); }
        if (__all(done)) break;
    }
    return prefix;
}

__device__ __forceinline__ void ph_route(const Params& p, unsigned char* lds, int vb, int nvb) {
    const bf16* Q3 = (const bf16*)(p.ws + WS_Q3); const bf16* SUBK = (const bf16*)(p.ws + WS_SUBK);
    int* EXPI = (int*)(p.ws + WS_EXP); float* GATE = (float*)(p.ws + WS_GATE);
    int tid = threadIdx.x; asm volatile("" : "+v"(tid));
    const int lane = tid & 63, wv = __builtin_amdgcn_readfirstlane(tid >> 6), r32 = lane & 31, hi = lane >> 5;
    for (int i = tid; i < 2048; i += NT) { const int row = i >> 3, ch = i & 7; ((u32x4*)lds)[row * 8 + (ch ^ ((row >> 1) & 7))] = ((const u32x4*)SUBK)[i]; }
    __syncthreads();
    unsigned char* wl = lds + 32768 + wv * RT_WAVE_BYTES;
    float* sv = (float*)wl; int* si = (int*)(wl + 4096); float* fv = (float*)(wl + 8192); int* fe = (int*)(wl + 10240);
    const int gw = vb * NWV + wv, ngw = nvb * NWV;
    for (int item = gw; item < (T / 32) * 8; item += ngw) {
        const int h = item & 7, tok0 = (item >> 3) * 32;
        const bf16* qrow = Q3 + (size_t)(tok0 + r32) * 1024 + h * 128 + hi * 8;
#pragma unroll 1
        for (int c = 0; c < 2; ++c) {
            bf16x8 bq[4];
#pragma unroll
            for (int d0 = 0; d0 < 4; ++d0) bq[d0] = *(const bf16x8*)(qrow + c * 64 + d0 * 16);
            unsigned key[64];
#pragma unroll
            for (int nt = 0; nt < 4; ++nt) {
                f32x16 acc = f32x16{};
                const int krow = c * 128 + nt * 32 + r32, ksw = (krow >> 1) & 7;
                const unsigned char* kp = lds + krow * 128;
#pragma unroll
                for (int d0 = 0; d0 < 4; ++d0) { const bf16x8 ak = *(const bf16x8*)(kp + (((2 * d0 + hi) ^ ksw) << 4)); acc = __builtin_amdgcn_mfma_f32_32x32x16_bf16(ak, bq[d0], acc, 0, 0, 0); }
#pragma unroll
                for (int r = 0; r < 16; ++r) key[nt * 16 + r] = sortkey(acc[r]);
            }
            const unsigned thr = bisect16<64>(key);
            int cnt = 0;
#pragma unroll
            for (int i = 0; i < 64; ++i) cnt += (key[i] >= thr) ? 1 : 0;
            const int other_ = pl32_other(cnt); int slot = hi ? other_ : 0;
            float* svp = sv + (r32 * 2 + c) * 16; int* sip = si + (r32 * 2 + c) * 16;
#pragma unroll
            for (int i = 0; i < 64; ++i) {
                if (key[i] >= thr && slot < 16) { svp[slot] = unsortkey(key[i]); sip[slot] = 32 * (i >> 4) + ((i & 3) + 8 * ((i & 15) >> 2)) + 4 * hi; ++slot; }
            }
        }
        LDS_WAIT(); asm volatile("" ::: "memory");
        {
            float* sv0 = sv + (r32 * 2) * 16; float* sv1 = sv0 + 16; int* si0 = si + (r32 * 2) * 16; int* si1 = si0 + 16;
            {
                float a[16], bl[16];
#pragma unroll
                for (int k = 0; k < 16; ++k) { a[k] = sv0[k]; bl[k] = sv1[k]; }
                int ia[8], ib[8], ra[8], rb[8]; float va[8], vb[8];
#pragma unroll
                for (int q = 0; q < 8; ++q) { const int e = 8 * hi + q; va[q] = sv0[e]; vb[q] = sv1[e]; ia[q] = si0[e]; ib[q] = si1[e]; int r0 = 0, r1 = 0;
#pragma unroll
                    for (int k = 0; k < 16; ++k) { r0 += (a[k] > va[q] || (a[k] == va[q] && k < e)) ? 1 : 0; r1 += (bl[k] > vb[q] || (bl[k] == vb[q] && k < e)) ? 1 : 0; }
                    ra[q] = r0; rb[q] = r1; }
                LDS_WAIT(); asm volatile("" ::: "memory");
                { auto rr = __builtin_amdgcn_permlane32_swap(0u, 0u, false, false); (void)rr; }
#pragma unroll
                for (int q = 0; q < 8; ++q) { sv0[ra[q]] = va[q]; si0[ra[q]] = ia[q]; sv1[rb[q]] = vb[q]; si1[rb[q]] = ib[q]; }
                LDS_WAIT(); asm volatile("" ::: "memory");
            }
            const float* X = hi ? sv1 : sv0; const float* Y = hi ? sv0 : sv1;
            float x[4], y[16];
#pragma unroll
            for (int k = 0; k < 4; ++k) x[k] = X[k];
#pragma unroll
            for (int k = 0; k < 16; ++k) y[k] = Y[k];
            unsigned key[27]; int pi[27], pj[27]; int np = 0;
#pragma unroll
            for (int i = 0; i < 3; ++i)
#pragma unroll
                for (int j = i + 1; j < 16; ++j) if ((i + 1) * (j + 1) <= 16) { key[np] = sortkey(x[i] + y[j]); pi[np] = i; pj[np] = j; ++np; }
#pragma unroll
            for (int i = 0; i < 4; ++i) { key[23 + i] = hi ? 0u : sortkey(x[i] + y[i]); pi[23 + i] = i; pj[23 + i] = i; }
            const unsigned thr = bisect16<27>(key);
            int cnt = 0;
#pragma unroll
            for (int i = 0; i < 27; ++i) cnt += (key[i] >= thr) ? 1 : 0;
            const int other_ = pl32_other(cnt); int slot = hi ? other_ : 0;
            const int* IX = hi ? si1 : si0; const int* IY = hi ? si0 : si1;
            float* fvp = fv + r32 * 16; int* fep = fe + r32 * 16;
#pragma unroll
            for (int i = 0; i < 27; ++i) {
                if (key[i] >= thr && slot < 16) { const int ex = IX[pi[i]], ey = IY[pj[i]]; fvp[slot] = unsortkey(key[i]); fep[slot] = hi ? (ey * 128 + ex) : (ex * 128 + ey); ++slot; }
            }
        }
        LDS_WAIT(); asm volatile("" ::: "memory");
        {
            const float* fvp = fv + r32 * 16;
            float v[16]; float mx = -3e38f;
#pragma unroll
            for (int k = 0; k < 16; ++k) { v[k] = fvp[k]; mx = fmaxf(mx, v[k]); }
            float l = 0.f;
#pragma unroll
            for (int k = 0; k < 16; ++k) { v[k] = __expf(v[k] - mx); l += v[k]; }
            const float il = 1.f / l;
            const size_t ob = (size_t)(tok0 + r32) * 128 + h * 16 + 8 * hi;
            const int* fep = fe + r32 * 16 + 8 * hi;
            f32x4 g0, g1; u32x4 e0, e1;
            if (hi == 0) { g0 = (f32x4){v[0] * il, v[1] * il, v[2] * il, v[3] * il}; g1 = (f32x4){v[4] * il, v[5] * il, v[6] * il, v[7] * il}; }
            else { g0 = (f32x4){v[8] * il, v[9] * il, v[10] * il, v[11] * il}; g1 = (f32x4){v[12] * il, v[13] * il, v[14] * il, v[15] * il}; }
            e0 = *(const u32x4*)fep; e1 = *(const u32x4*)(fep + 4);
            *(f32x4*)(GATE + ob) = g0; *(f32x4*)(GATE + ob + 4) = g1;
            *(u32x4*)(EXPI + ob) = e0; *(u32x4*)(EXPI + ob + 4) = e1;
        }
        LDS_WAIT(); asm volatile("" ::: "memory");
    }
    __syncthreads();
}
typedef float f32x2_t __attribute__((ext_vector_type(2)));
constexpr int P8_UNITS = T / 64;
constexpr int CW_P8_U = 4096, CW_P8_V = 4096 + 32 * 64;
constexpr float U8_SCALE = 32.0f;
__device__ __forceinline__ unsigned peer_xcc() { return (unsigned)__builtin_amdgcn_s_getreg((3 << 11) | 20) & 7u; }
#ifndef U8_HALVES
#define U8_HALVES 0
#endif
template <int LPR>
__device__ __forceinline__ void ph_peer_v8g(const Params& p, unsigned char* lds) {
    constexpr int RPI = 64 / LPR, NI = 128 / RPI, G = NI / 8, NS = 64 / LPR, SLB = 16 * LPR;
    const unsigned char* V8 = (const unsigned char*)(p.ws + WS_V16);
    const int* EXPI = (const int*)(p.ws + WS_EXP); const float* CBUF = (const float*)(p.ws + WS_CBUF); const float* MOD = (const float*)(p.ws + WS_MOD);
    const float* AB1 = (const float*)(p.ws + WS_ABUF1); const float* GATEP = (const float*)(p.ws + WS_GATE); (void)AB1; (void)GATEP;
    unsigned* ctl = (unsigned*)(p.ws + WS_CTL);
    int tid = threadIdx.x; asm volatile("" : "+v"(tid));
    const int lane = tid & 63, wv = __builtin_amdgcn_readfirstlane(tid >> 6), gR = lane / LPR, iC = lane % LPR;
    volatile LAS unsigned* slot = (volatile LAS unsigned*)(LAS unsigned char*)lds;
    const unsigned xcc = peer_xcc();
#pragma unroll 1
    for (int k = 0; k < NS; ++k) {
        const int sl = (int)((((xcc * NS) >> 3) + (unsigned)k) % (unsigned)NS);
        const unsigned char* vcol = V8 + SLB * sl + 16 * iC;
#pragma unroll 1
        for (;;) {
            if (tid == 0) *slot = __hip_atomic_fetch_add(ctl + CW_P8_V + 64 * sl, 1u, __ATOMIC_RELAXED, __HIP_MEMORY_SCOPE_AGENT);
            __syncthreads();
            const unsigned unit = *slot;
            __syncthreads();
            if (unit >= (unsigned)P8_UNITS) break;
            const int tbase = (int)unit * 64 + wv * 8;
            int ne0, ne1; float nc0, nc1;
#if U8_HALVES
#define VG_FETCH(T) do { const size_t tn_ = (size_t)(T); ne0 = EXPI[tn_ * 128 + lane]; ne1 = EXPI[tn_ * 128 + 64 + lane];                              \
        nc0 = gelu_erf(CBUF[tn_ * 128 + lane] + AB1[tn_ * 128 + lane]) * GATEP[tn_ * 128 + lane];                                              \
        nc1 = gelu_erf(CBUF[tn_ * 128 + 64 + lane] + AB1[tn_ * 128 + 64 + lane]) * GATEP[tn_ * 128 + 64 + lane]; } while (0)
#else
#define VG_FETCH(T) do { const size_t tn_ = (size_t)(T); ne0 = EXPI[tn_ * 128 + lane]; ne1 = EXPI[tn_ * 128 + 64 + lane]; nc0 = CBUF[tn_ * 128 + lane]; nc1 = CBUF[tn_ * 128 + 64 + lane]; } while (0)
#endif
#define VG_LISTS(LE, LC) do { LE[lane] = ne0; LE[64 + lane] = ne1; LC[lane] = nc0; LC[64 + lane] = nc1; } while (0)
#define VG_ROWS(R, LE, GI) do { _Pragma("unroll") for (int kk = 0; kk < 8; ++kk) R[kk] = *(const u32x4*)(vcol + (size_t)LE[RPI * (8 * (GI) + kk) + gR] * 1024); } while (0)
#define VG_GROUP(R, LC, GI) do { _Pragma("unroll") for (int kk = 0; kk < 8; ++kk) { const float cj = LC[RPI * (8 * (GI) + kk) + gR];                       \
            const unsigned w_[4] = {R[kk].x, R[kk].y, R[kk].z, R[kk].w};                                                                       \
            _Pragma("unroll") for (int c = 0; c < 4; ++c) { const f32x2_t lo = __builtin_amdgcn_cvt_pk_f32_fp8((int)w_[c], false), hi = __builtin_amdgcn_cvt_pk_f32_fp8((int)w_[c], true); \
                acc[4 * c] = fmaf(cj, lo.x, acc[4 * c]); acc[4 * c + 1] = fmaf(cj, lo.y, acc[4 * c + 1]); acc[4 * c + 2] = fmaf(cj, hi.x, acc[4 * c + 2]); acc[4 * c + 3] = fmaf(cj, hi.y, acc[4 * c + 3]); } } } while (0)
            u32x4 RA[8], RB[8];
            int* lecur = (int*)(lds + 1024 + wv * 2048); int* lenxt = lecur + 256;
            VG_FETCH(tbase); VG_LISTS(lecur, ((float*)(lecur + 128))); VG_FETCH(tbase + 1);
            LDS_WAIT(); asm volatile("" ::: "memory");
            VG_ROWS(RA, lecur, 0);
#pragma unroll 1
            for (int tt = 0; tt < 8; ++tt) {
                const int t = tbase + tt;
                float* lccur = (float*)(lecur + 128); float* lcnxt = (float*)(lenxt + 128);
                float acc[16];
#pragma unroll
                for (int q = 0; q < 16; ++q) acc[q] = 0.f;
                if (tt + 1 < 8) { VG_LISTS(lenxt, lcnxt); if (tt + 2 < 8) VG_FETCH(t + 2); }
#pragma unroll 1
                for (int gi = 0; gi < G; gi += 2) {
                    VG_ROWS(RB, lecur, gi + 1);
                    VG_GROUP(RA, lccur, gi);
                    if (gi + 2 < G) VG_ROWS(RA, lecur, gi + 2);
                    else if (tt + 1 < 8) { LDS_WAIT(); asm volatile("" ::: "memory"); VG_ROWS(RA, lenxt, 0); }
                    VG_GROUP(RB, lccur, gi + 1);
                }
#pragma unroll
                for (int q = 0; q < 16; ++q) { if (LPR <= 8) acc[q] += dpp_f<0x128>(acc[q]); if (LPR <= 16) acc[q] += __shfl_xor(acc[q], 16); if (LPR <= 32) acc[q] += __shfl_xor(acc[q], 32); }
                if (gR == 0) { const int col = SLB * sl + 16 * iC; const float* g2 = MOD + (size_t)(t >> 11) * 6144 + 5120 + col; float* orow = p.out + (size_t)t * 1024 + col;
#pragma unroll
                    for (int q = 0; q < 4; ++q) { const f32x4 xv = *(const f32x4*)(orow + 4 * q), hv = *(const f32x4*)(g2 + 4 * q);
                        f32x4 r; r.x = acc[4 * q]; r.y = acc[4 * q + 1]; r.z = acc[4 * q + 2]; r.w = acc[4 * q + 3]; *(f32x4*)(orow + 4 * q) = xv + hv * r; } }
                { int* tmp_ = lecur; lecur = lenxt; lenxt = tmp_; }
            }
#undef VG_FETCH
#undef VG_LISTS
#undef VG_ROWS
#undef VG_GROUP
            LDS_WAIT(); asm volatile("" ::: "memory");
        }
    }
}
__device__ __forceinline__ void ph_peer_u8p(const Params& p, unsigned char* lds_w, int gw, int ngw, int lane_) {
    int lane = lane_; asm volatile("" : "+v"(lane));
    const bf16* H = (const bf16*)(p.ws + WS_H); const unsigned char* U8 = (const unsigned char*)(p.ws + WS_U16); const unsigned char* V8 = (const unsigned char*)(p.ws + WS_V16);
    const int* EXPI = (const int*)(p.ws + WS_EXP); const float* GATE = (const float*)(p.ws + WS_GATE); const float* MOD = (const float*)(p.ws + WS_MOD);
    int* e_lds = (int*)lds_w; float* a_lds = (float*)(lds_w + 512);
    const int g = lane >> 4, i = lane & 15;
#pragma unroll 1
    for (int t = gw; t < T; t += ngw) {
        const int e0 = EXPI[(size_t)t * 128 + lane], e1 = EXPI[(size_t)t * 128 + 64 + lane];
        const float g0 = GATE[(size_t)t * 128 + lane], g1 = GATE[(size_t)t * 128 + 64 + lane];
        e_lds[lane] = e0; e_lds[64 + lane] = e1;
        float xf[64];
        { const u32x4* xrow = (const u32x4*)(H + (size_t)t * 1024) + 2 * i;
#pragma unroll
          for (int q = 0; q < 4; ++q) { const u32x4 a = xrow[32 * q], b = xrow[32 * q + 1];
              xf[16 * q] = bflo(a.x); xf[16 * q + 1] = bfhi(a.x); xf[16 * q + 2] = bflo(a.y); xf[16 * q + 3] = bfhi(a.y); xf[16 * q + 4] = bflo(a.z); xf[16 * q + 5] = bfhi(a.z); xf[16 * q + 6] = bflo(a.w); xf[16 * q + 7] = bfhi(a.w);
              xf[16 * q + 8] = bflo(b.x); xf[16 * q + 9] = bfhi(b.x); xf[16 * q + 10] = bflo(b.y); xf[16 * q + 11] = bfhi(b.y); xf[16 * q + 12] = bflo(b.z); xf[16 * q + 13] = bfhi(b.z); xf[16 * q + 14] = bflo(b.w); xf[16 * q + 15] = bfhi(b.w); } }
        LDS_WAIT(); asm volatile("" ::: "memory");
#define P8T_ULOAD(R, S) do { const u32x4* r_ = (const u32x4*)(U8 + (size_t)e_lds[4 * (S) + g] * 1024) + i; _Pragma("unroll") for (int q = 0; q < 4; ++q) R[q] = r_[16 * q]; } while (0)
#define P8T_UDOT(R, S) do { float a0 = 0.f, a1 = 0.f, a2 = 0.f, a3 = 0.f;                                                                               \
        _Pragma("unroll") for (int q = 0; q < 4; ++q) { const unsigned w_[4] = {R[q].x, R[q].y, R[q].z, R[q].w};                                           \
            _Pragma("unroll") for (int c = 0; c < 4; ++c) { const f32x2_t lo = __builtin_amdgcn_cvt_pk_f32_fp8((int)w_[c], false), hi = __builtin_amdgcn_cvt_pk_f32_fp8((int)w_[c], true); \
                a0 = fmaf(lo.x, xf[16 * q + 4 * c], a0); a1 = fmaf(lo.y, xf[16 * q + 4 * c + 1], a1); a2 = fmaf(hi.x, xf[16 * q + 4 * c + 2], a2); a3 = fmaf(hi.y, xf[16 * q + 4 * c + 3], a3); } } \
        const float a_ = row16_sum((a0 + a1) + (a2 + a3)) * (1.0f / U8_SCALE); if (i == 0) a_lds[4 * (S) + g] = a_; } while (0)
        { u32x4 RA[4], RB[4], RC[4];
          P8T_ULOAD(RA, 0); P8T_ULOAD(RB, 1);
#pragma unroll 1
          for (int s = 0; s < 30; s += 3) {
              P8T_ULOAD(RC, s + 2); P8T_UDOT(RA, s);
              P8T_ULOAD(RA, s + 3); P8T_UDOT(RB, s + 1);
              P8T_ULOAD(RB, s + 4); P8T_UDOT(RC, s + 2);
          }
          P8T_UDOT(RA, 30); P8T_UDOT(RB, 31); }
#undef P8T_ULOAD
#undef P8T_UDOT
        LDS_WAIT(); asm volatile("" ::: "memory");
        const float c0 = gelu_erf(a_lds[lane]) * g0, c1 = gelu_erf(a_lds[64 + lane]) * g1;
        float* CB = (float*)(p.ws + WS_CBUF) + (size_t)t * 128; CB[lane] = c0; CB[64 + lane] = c1;
    }
}
__device__ __forceinline__ void ph_peer_u8h(const Params& p, unsigned char* lds) {
    const bf16* H = (const bf16*)(p.ws + WS_H); const unsigned char* U8 = (const unsigned char*)(p.ws + WS_U16);
    const int* EXPI = (const int*)(p.ws + WS_EXP);
    unsigned* ctl = (unsigned*)(p.ws + WS_CTL);
    int tid = threadIdx.x; asm volatile("" : "+v"(tid));
    const int lane = tid & 63, wv = __builtin_amdgcn_readfirstlane(tid >> 6), hw = lane >> 5, i5 = lane & 31;
    volatile LAS unsigned* slot = (volatile LAS unsigned*)(LAS unsigned char*)lds;
    float* a_lds = (float*)(lds + 1024 + wv * 2048 + 1024);
    const unsigned xcc = peer_xcc();
#pragma unroll 1
    for (int k = 0; k < 2; ++k) {
        const int sl = (int)(((xcc >> 2) + (unsigned)k) & 1u);
        float* AB = (float*)(p.ws + (sl ? WS_ABUF1 : WS_CBUF));
        const unsigned char* ucol = U8 + 512 * sl + 16 * i5;
#pragma unroll 1
        for (;;) {
            if (tid == 0) *slot = __hip_atomic_fetch_add(ctl + CW_P8_U + 64 * sl, 1u, __ATOMIC_RELAXED, __HIP_MEMORY_SCOPE_AGENT);
            __syncthreads();
            const unsigned unit = *slot;
            __syncthreads();
            if (unit >= (unsigned)P8_UNITS) break;
            const int tbase = (int)unit * 64 + wv * 8;
            int ne0, ne1; u32x4 nx0, nx1;
#define UH_FETCH(T) do { const size_t tn_ = (size_t)(T); ne0 = EXPI[tn_ * 128 + lane]; ne1 = EXPI[tn_ * 128 + 64 + lane];                          \
        const u32x4* xr_ = (const u32x4*)(H + tn_ * 1024 + 512 * sl) + 2 * i5; nx0 = xr_[0]; nx1 = xr_[1]; } while (0)
#define UH_LISTS(LE) do { LE[lane] = ne0; LE[64 + lane] = ne1; } while (0)
#define UH_ROWS(R, LE, GI) do { _Pragma("unroll") for (int kk = 0; kk < 8; ++kk) R[kk] = *(const u32x4*)(ucol + (size_t)LE[2 * (8 * (GI) + kk) + hw] * 1024); } while (0)
#define UH_GROUP(R, GI) do { _Pragma("unroll") for (int kk = 0; kk < 8; ++kk) { float a0 = 0.f, a1 = 0.f, a2 = 0.f, a3 = 0.f;                         \
            const unsigned w_[4] = {R[kk].x, R[kk].y, R[kk].z, R[kk].w};                                                                       \
            _Pragma("unroll") for (int c = 0; c < 4; ++c) { const f32x2_t lo = __builtin_amdgcn_cvt_pk_f32_fp8((int)w_[c], false), hi = __builtin_amdgcn_cvt_pk_f32_fp8((int)w_[c], true); \
                a0 = fmaf(lo.x, xf[4 * c], a0); a1 = fmaf(lo.y, xf[4 * c + 1], a1); a2 = fmaf(hi.x, xf[4 * c + 2], a2); a3 = fmaf(hi.y, xf[4 * c + 3], a3); }                        \
            float s_ = row16_sum((a0 + a1) + (a2 + a3)); s_ += __shfl_xor(s_, 16);                                                              \
            if (i5 == 0) a_lds[2 * (8 * (GI) + kk) + hw] = s_ * (1.0f / U8_SCALE); } } while (0)
            u32x4 RA[8], RB[8];
            int* lecur = (int*)(lds + 1024 + wv * 2048); int* lenxt = lecur + 128;
            UH_FETCH(tbase); UH_LISTS(lecur);
            float xf[16];
#define UH_XF() do { xf[0] = bflo(nx0.x); xf[1] = bfhi(nx0.x); xf[2] = bflo(nx0.y); xf[3] = bfhi(nx0.y); xf[4] = bflo(nx0.z); xf[5] = bfhi(nx0.z); xf[6] = bflo(nx0.w); xf[7] = bfhi(nx0.w); \
        xf[8] = bflo(nx1.x); xf[9] = bfhi(nx1.x); xf[10] = bflo(nx1.y); xf[11] = bfhi(nx1.y); xf[12] = bflo(nx1.z); xf[13] = bfhi(nx1.z); xf[14] = bflo(nx1.w); xf[15] = bfhi(nx1.w); } while (0)
            UH_XF();
            UH_FETCH(tbase + 1);
            LDS_WAIT(); asm volatile("" ::: "memory");
            UH_ROWS(RA, lecur, 0);
#pragma unroll 1
            for (int tt = 0; tt < 8; ++tt) {
                const int t = tbase + tt;
                float xn[16];
                if (tt + 1 < 8) { UH_LISTS(lenxt);
#pragma unroll
                    for (int q = 0; q < 16; ++q) xn[q] = 0.f;
                    xn[0] = bflo(nx0.x); xn[1] = bfhi(nx0.x); xn[2] = bflo(nx0.y); xn[3] = bfhi(nx0.y); xn[4] = bflo(nx0.z); xn[5] = bfhi(nx0.z); xn[6] = bflo(nx0.w); xn[7] = bfhi(nx0.w);
                    xn[8] = bflo(nx1.x); xn[9] = bfhi(nx1.x); xn[10] = bflo(nx1.y); xn[11] = bfhi(nx1.y); xn[12] = bflo(nx1.z); xn[13] = bfhi(nx1.z); xn[14] = bflo(nx1.w); xn[15] = bfhi(nx1.w);
                    if (tt + 2 < 8) UH_FETCH(t + 2); }
#pragma unroll 1
                for (int gi = 0; gi < 8; gi += 2) {
                    UH_ROWS(RB, lecur, gi + 1);
                    UH_GROUP(RA, gi);
                    if (gi + 2 < 8) UH_ROWS(RA, lecur, gi + 2);
                    else if (tt + 1 < 8) { LDS_WAIT(); asm volatile("" ::: "memory"); UH_ROWS(RA, lenxt, 0); }
                    UH_GROUP(RB, gi + 1);
                }
                LDS_WAIT(); asm volatile("" ::: "memory");
                { float* ab = AB + (size_t)t * 128; ab[lane] = a_lds[lane]; ab[64 + lane] = a_lds[64 + lane]; }
                LDS_WAIT(); asm volatile("" ::: "memory");
                if (tt + 1 < 8) {
#pragma unroll
                    for (int q = 0; q < 16; ++q) xf[q] = xn[q]; }
                { int* tmp_ = lecur; lecur = lenxt; lenxt = tmp_; }
            }
#undef UH_FETCH
#undef UH_LISTS
#undef UH_ROWS
#undef UH_GROUP
#undef UH_XF
        }
    }
}
#define XB_TMO      128
#define XB_XCNT(j)  (256  + 64 * (j))
#define XB_XSUB(j)  (1280 + 64 * (j))
#define XB_XGEN(j)  (2304 + 64 * (j))
#define XB_TOP      3328
#define XB_TOPGEN   3392
#define XCD_BAR_WORDS 3456
#define XB_SPIN_CAP (1u << 18)

__device__ __forceinline__ unsigned xb_ld(unsigned* p)              { return __hip_atomic_load(p, __ATOMIC_RELAXED, __HIP_MEMORY_SCOPE_AGENT); }
__device__ __forceinline__ unsigned xb_add(unsigned* p, unsigned v) { return __hip_atomic_fetch_add(p, v, __ATOMIC_RELAXED, __HIP_MEMORY_SCOPE_AGENT); }
__device__ __forceinline__ unsigned xb_xcc_id() { return (unsigned)__builtin_amdgcn_s_getreg((3 << 11) | 20) & 0xFu; }
#define XB_SPIN(cond, bar) do { unsigned _sp = 0; while (cond) { __builtin_amdgcn_s_sleep(1); \
    if ((++_sp & 255u) == 0u) { if (xb_ld(&(bar)[XB_TMO])) break; if (_sp > XB_SPIN_CAP) { atomicAdd(&(bar)[XB_TMO], 1u); break; } } } } while (0)

struct XcdBarrier {
    unsigned* bar; unsigned x;
    volatile LAS unsigned* st;
};

__device__ __forceinline__ XcdBarrier xcd_barrier_post(unsigned* bar, volatile LAS unsigned* st) {
    XcdBarrier b; b.bar = bar; b.x = xb_xcc_id(); b.st = st;
    if (threadIdx.x == 0) (void)xb_add(&bar[XB_XCNT(b.x)], 1u);
    return b;
}
__device__ __forceinline__ void xcd_barrier_complete(unsigned* bar, unsigned x, unsigned& nloc, unsigned& nx) {
    const unsigned G = gridDim.x * gridDim.y * gridDim.z;
    unsigned sum, cnt, mine, sp = 0u;
    for (;;) {
        sum = 0u; cnt = 0u; mine = 0u;
#pragma unroll
        for (unsigned j = 0; j < 16; ++j) { const unsigned c = xb_ld(&bar[XB_XCNT(j)]); sum += c; cnt += (c > 0u) ? 1u : 0u; mine = (j == x) ? c : mine; }
        if (sum == G) break;
        __builtin_amdgcn_s_sleep(1);
        if ((++sp & 255u) == 0u) { if (xb_ld(&bar[XB_TMO])) break; if (sp > XB_SPIN_CAP) { atomicAdd(&bar[XB_TMO], 1u); break; } }
    }
    nloc = mine > 0u ? mine : 1u; nx = cnt > 0u ? cnt : 1u;
}

__device__ __forceinline__ void xcd_barrier(const XcdBarrier& b) {
    asm volatile("s_waitcnt vmcnt(0)" ::: "memory");
    __syncthreads();
    if (threadIdx.x == 0) {
        unsigned* bar = b.bar;
        __builtin_amdgcn_s_waitcnt(0);
        unsigned nloc = b.st[0], nx = b.st[1];
        if (nloc == 0u) { xcd_barrier_complete(bar, b.x, nloc, nx); b.st[0] = nloc; b.st[1] = nx; }
        const unsigned old = xb_add(&bar[XB_XSUB(b.x)], 1u);
        const unsigned gen = old / nloc;
        if (old + 1u == (gen + 1u) * nloc) {
            __builtin_amdgcn_fence(__ATOMIC_RELEASE, "agent");
            asm volatile("s_waitcnt vmcnt(0)" ::: "memory");
            const unsigned og = xb_add(&bar[XB_TOP], 1u);
            const unsigned tg = og / nx;
            if (og + 1u == (tg + 1u) * nx) xb_add(&bar[XB_TOPGEN], 1u);
            else XB_SPIN(xb_ld(&bar[XB_TOPGEN]) == tg, bar);
            __builtin_amdgcn_fence(__ATOMIC_ACQUIRE, "agent");
            xb_add(&bar[XB_XGEN(b.x)], 1u);
            asm volatile("s_waitcnt vmcnt(0)" ::: "memory");
        } else {
            XB_SPIN(xb_ld(&bar[XB_XGEN(b.x)]) == gen, bar);
            __builtin_amdgcn_fence(__ATOMIC_ACQUIRE, "agent");
            asm volatile("s_waitcnt vmcnt(0)" ::: "memory");
        }
    }
    __syncthreads();
}

#ifndef V8_LPR
#define V8_LPR 32
#endif
constexpr int LDS_BYTES = 147456;
extern __shared__ __attribute__((aligned(16))) unsigned char dyn_lds[];

__global__ void __launch_bounds__(NT, 2) mega_fwd(Params p) {
    cg::grid_group grid = cg::this_grid();
    const int vb = blockIdx.x, nvb = gridDim.x, ngw = nvb * NWV;
    volatile LAS unsigned* xst = (volatile LAS unsigned*)((LAS unsigned char*)dyn_lds + (LDS_BYTES - 16));
    if (threadIdx.x < 4) xst[threadIdx.x] = 0u;
    __syncthreads();
    const XcdBarrier xbar = xcd_barrier_post((unsigned*)(p.ws + WS_CTL), xst);
#define TID_LAUNDER int tid_ = threadIdx.x; asm volatile("" : "+v"(tid_)); const int lane = tid_ & 63, wv = tid_ >> 6, gw = vb * NWV + wv; (void)lane; (void)gw;
    grid.sync();
    ph_mod(p, (float*)dyn_lds, vb, nvb);
    { TID_LAUNDER ph_prep_weights(p, (LAS float*)dyn_lds + wv * (64 * 33), gw, ngw, lane); }
    xcd_barrier(xbar);
    { TID_LAUNDER ph_hrows(p, p.x, p.norm1_g, 0, 1024, gw, ngw, lane); }
    xcd_barrier(xbar);
    {   pg8::Gemm g{(const bf16*)(p.ws + WS_H), (const bf16*)(p.ws + WS_WIN), T, NP, 1024}; pg8::StaticOrder S; S.init(T, NP, nvb, vb);
        EpiNormBf16 E{(bf16*)(p.ws + WS_PROJ), p.a_qk_gain, p.b_q_gain, p.b_kv_gain, (LAS float*)((LAS unsigned char*)dyn_lds + 131072), (bf16*)(p.ws + WS_KVC)};
        pg8::gemm_phase<EpiNormBf16, pg8::StaticOrder, true, true>((LAS unsigned char*)dyn_lds, g, S, E); }
    xcd_barrier(xbar);
    ph_attnA(p, dyn_lds, vb, nvb);
    __syncthreads();
    ph_dsa(p, dyn_lds, vb, nvb);
    xcd_barrier(xbar);
    {   pg8::Gemm g{(const bf16*)(p.ws + WS_MIX), (const bf16*)(p.ws + WS_WO2), T, 1024, MIXW}; pg8::StaticOrder S; S.init(T, 1024, nvb, vb);
        EpiResGate E{p.x, p.out, (const float*)(p.ws + WS_MOD) + 2048};
        pg8::gemm_phase<EpiResGate, pg8::StaticOrder, true, true>((LAS unsigned char*)dyn_lds, g, S, E); }
    xcd_barrier(xbar);
    { TID_LAUNDER ph_hrows(p, p.out, p.norm2_g, 3072, 4096, gw, ngw, lane); }
    xcd_barrier(xbar);
    {   pg8::Gemm g{(const bf16*)(p.ws + WS_H), (const bf16*)(p.ws + WS_WQ), T, 1024, 1024}; pg8::StaticOrder S; S.init(T, 1024, nvb, vb);
        pg8::EpiBf16<0> E{(bf16*)(p.ws + WS_Q3), 1024, nullptr, 0, 0, 1.f};
        pg8::gemm_phase<pg8::EpiBf16<0>, pg8::StaticOrder, true, true>((LAS unsigned char*)dyn_lds, g, S, E); }
    xcd_barrier(xbar);
    ph_route(p, dyn_lds, vb, nvb);
    xcd_barrier(xbar);

#if U8_HALVES
    ph_peer_u8h(p, dyn_lds);
#else
    { TID_LAUNDER ph_peer_u8p(p, dyn_lds + wv * 1024, gw, ngw, lane); }
#endif
    xcd_barrier(xbar);
    ph_peer_v8g<V8_LPR>(p, dyn_lds);

}

extern "C" void kernel_launch(void* const* d_in, const int* in_sizes, int n_in, void* d_out, int out_size, void* d_ws, size_t ws_size, hipStream_t stream) {
    static int grid_blocks = 0;
    if (grid_blocks == 0) {
        if (n_in != 18 || in_sizes[0] != T * DM || out_size != T * DM || ws_size < WS_END) { fprintf(stderr, "kernel_launch: unexpected shapes n_in %d in0 %d out %d ws %zu\n", n_in, n_in > 0 ? in_sizes[0] : -1, out_size, ws_size); grid_blocks = -1; return; }
        int dev = 0, cus = 0, per_cu = 0;
        (void)hipGetDevice(&dev);
        (void)hipDeviceGetAttribute(&cus, hipDeviceAttributeMultiprocessorCount, dev);
        (void)hipFuncSetAttribute((const void*)mega_fwd, hipFuncAttributeMaxDynamicSharedMemorySize, LDS_BYTES);
        (void)hipOccupancyMaxActiveBlocksPerMultiprocessor(&per_cu, (const void*)mega_fwd, NT, LDS_BYTES);
        if (per_cu < 1 || cus < 1) { fprintf(stderr, "kernel_launch: occupancy query gave %d blocks/CU on %d CUs\n", per_cu, cus); grid_blocks = -1; return; }
        grid_blocks = cus;
    }
    if (grid_blocks < 0) return;
    Params p{};
    const float** pp = (const float**)&p;
    for (int i = 0; i < 18; ++i) pp[i] = (const float*)d_in[i];
    p.out = (float*)d_out; p.ws = (unsigned char*)d_ws;
    if (hipMemsetAsync((char*)d_ws + WS_CTL, 0, CTL_BYTES, stream) != hipSuccess) { fprintf(stderr, "kernel_launch: memset failed\n"); return; }
    void* args[] = {&p};
    const hipError_t e = hipLaunchCooperativeKernel((const void*)mega_fwd, dim3(grid_blocks), dim3(NT), args, LDS_BYTES, stream);
    if (e != hipSuccess) fprintf(stderr, "kernel_launch: cooperative launch failed: %s (grid %d)\n", hipGetErrorString(e), grid_blocks);
}
```

```cpp
#include <hip/hip_runtime.h>
#include <hip/hip_cooperative_groups.h>
#include <cstdio>
#include <cstdint>
#include <cmath>
namespace pg8 {
#define PG8_LAS __attribute__((address_space(3)))
typedef unsigned short bf16_t;
typedef short bf16x8 __attribute__((ext_vector_type(8)));
typedef float f32x4 __attribute__((ext_vector_type(4)));
typedef unsigned u32x4 __attribute__((ext_vector_type(4)));
constexpr int BM = 256, BK = 64, HALF = 128, HTB = HALF * BK * 2  , STAGE_BYTES = 8 * HTB, NXCD = 8, WGM = 8;

__host__ __device__ __forceinline__ int lds_byte(int r, int c) { const int st = (r >> 4) * 2 + (c >> 5), rr = r & 15, cc = c & 31, ob = rr * 64 + cc * 2; return st * 1024 + (ob ^ (((ob >> 9) & 1) << 5)); }
__host__ __device__ __forceinline__ void stage_rc(int b, int& R, int& C) { const int st = b / 1024, sb = b % 1024, swz = sb ^ (((sb >> 9) & 1) << 5); R = (st >> 1) * 16 + swz / 64; C = (st & 1) * 32 + (swz % 64) / 2; }
__host__ __device__ __forceinline__ int perm32(int rho) { const int n = rho >> 4, i = rho & 15; return 8 * (i >> 2) + 4 * n + (i & 3); }

struct Unit { int pm, pn; };
struct Gemm { const bf16_t* A; const bf16_t* Bt; int M, N, K; };

struct StaticOrder {
    int nM, nN, nwg, G, c;
    __host__ __device__ void init(int M, int N, int G_, int c_) { nM = M / BM; nN = N / BM; nwg = nM * nN; G = G_; c = c_; }
    __host__ __device__ bool next(int i, Unit& u) const {
        const long L = (long)i * G + c; if (L >= nwg) return false;
        int wgid = (int)L; { const int q = nwg / NXCD, r = nwg % NXCD, xcd = wgid % NXCD, off = wgid / NXCD; wgid = (xcd < r ? xcd * (q + 1) : r * (q + 1) + (xcd - r) * q) + off; }
        const int nig = WGM * nN, gid = wgid / nig, fm = gid * WGM, gsz = (nM - fm) < WGM ? (nM - fm) : WGM;
        u.pm = fm + ((wgid % nig) % gsz); u.pn = (wgid % nig) / gsz; return true;
    }
    __device__ __forceinline__ void a_ready(const Unit&) const {}
    __device__ __forceinline__ void done(const Unit&) const {}
};

__device__ __forceinline__ unsigned cvt_pk_bf16(float lo, float hi) { unsigned r; asm volatile("v_cvt_pk_bf16_f32 %0, %1, %2" : "=v"(r) : "v"(lo), "v"(hi)); return r; }
typedef float f32x2 __attribute__((ext_vector_type(2)));
__device__ __forceinline__ f32x2 gelu_pk(f32x2 v) {
    const f32x2 av = __builtin_elementwise_abs(v), d = av * 0.2316418882f + 1.0f;
    f32x2 t; t.x = __builtin_amdgcn_rcpf(d.x); t.y = __builtin_amdgcn_rcpf(d.y);
    f32x2 q = t * 0.5307027145f + (-0.7265760135f); q = q * t + 0.7107068705f; q = q * t + (-0.142248368f); q = q * t + 0.127414796f; q = q * t;
    const f32x2 s = (v * v) * (-0.72134752044f);
    f32x2 e; e.x = __builtin_amdgcn_exp2f(s.x); e.y = __builtin_amdgcn_exp2f(s.y);
    const f32x2 m = v * (q * e), r = v - m;
    f32x2 o; o.x = v.x < 0.f ? m.x : r.x; o.y = v.y < 0.f ? m.y : r.y; return o;
}

template <int ACT  > struct EpiBf16 {
    static constexpr bool PERM = true, AFTER_DRAIN = false; static_assert(ACT == 0 || ACT == 1, "EpiBf16: ACT is 0 (none) or 1 (gelu_pk)");
    bf16_t* O; int ldc; const float* bias; int split_cols; size_t split_stride; float scale0;
    __device__ __forceinline__ void operator()(const f32x4 (&acc)[2][2][4][2], const Unit& u, int wr, int wc, int fr, int fq) const {
        const int row0 = u.pm * BM + wr * 64 + fr; int colt = u.pn * BM; bf16_t* base = O;
        float sc = 1.f; if (split_cols) { const int t = colt / split_cols; base += (size_t)t * split_stride; colt -= t * split_cols; if (t == 0) sc = scale0; }
        const int col0 = colt + wc * 32 + 8 * fq, bcol0 = u.pn * BM + wc * 32 + 8 * fq;
        f32x4 bv[2][2];
#pragma unroll
        for (int bj = 0; bj < 2; ++bj)
#pragma unroll
            for (int n = 0; n < 2; ++n) bv[bj][n] = bias ? *(const f32x4*)(bias + bcol0 + bj * HALF + 4 * n) : (f32x4){0.f, 0.f, 0.f, 0.f};
#pragma unroll
        for (int ai = 0; ai < 2; ++ai)
#pragma unroll
            for (int m = 0; m < 4; ++m) { bf16_t* rowp = base + (size_t)(row0 + ai * HALF + m * 16) * ldc + col0;
#pragma unroll
                for (int bj = 0; bj < 2; ++bj) { f32x4 v0 = acc[ai][bj][m][0] + bv[bj][0], v1 = acc[ai][bj][m][1] + bv[bj][1];
                    if (ACT == 1) { f32x2 a = gelu_pk((f32x2){v0[0], v0[1]}), b = gelu_pk((f32x2){v0[2], v0[3]}), c = gelu_pk((f32x2){v1[0], v1[1]}), d = gelu_pk((f32x2){v1[2], v1[3]});
                        v0 = (f32x4){a.x, a.y, b.x, b.y}; v1 = (f32x4){c.x, c.y, d.x, d.y}; }
                    v0 = v0 * sc; v1 = v1 * sc; u32x4 w; w.x = cvt_pk_bf16(v0[0], v0[1]); w.y = cvt_pk_bf16(v0[2], v0[3]); w.z = cvt_pk_bf16(v1[0], v1[1]); w.w = cvt_pk_bf16(v1[2], v1[3]);
                    *(u32x4*)(rowp + bj * HALF) = w; } }
    }
};

template <class Epi, class Sched, bool ALIGN_EPI = false, bool SP2 = false>
__device__ __forceinline__ void gemm_phase(PG8_LAS unsigned char* lds, const Gemm g, const Sched& S, const Epi& E) {
    int tid = threadIdx.x; asm volatile("" : "+v"(tid)); const int wid = __builtin_amdgcn_readfirstlane(tid >> 6), lane = tid & 63, wr = wid >> 2, wc = wid & 3, fr = lane & 15, fq = lane >> 4;
    const int K = g.K, nt = K / BK;
    unsigned voffA[2], voffB[2];
#pragma unroll
    for (int i = 0; i < 2; ++i) { int R, C; stage_rc(tid * 16 + i * 8192, R, C); const int Rb = Epi::PERM ? ((R & ~31) + perm32(R & 31)) : R;
        voffA[i] = (unsigned)(R * K + C) * 2u; voffB[i] = (unsigned)(Rb * K + C) * 2u; }
    const size_t kstep = (size_t)(BK * 2);
    const size_t hstep = (size_t)HALF * K * 2;
    const size_t tstep = 2 * hstep;
    const unsigned ldsw = (unsigned)wid * 1024u;
    const int aoff = lds_byte(wr * 64 + fr, fq * 8), boff = lds_byte(wc * 32 + fr, fq * 8);
#define PG8_SA(b, h) (((b) * 2 + (h)) * HTB)
#define PG8_SB(b, h) ((4 + (b) * 2 + (h)) * HTB)
#define PG8_STAGE(bufoff, gbase, voff) do { _Pragma("unroll") for (int _i = 0; _i < 2; ++_i) \
        __builtin_amdgcn_global_load_lds((const unsigned*)((const char*)(gbase) + (voff)[_i]), (PG8_LAS unsigned*)(lds + (bufoff) + ldsw + _i * 8192), 16, 0, 0); } while (0)
#define PG8_LDA(dst, b, h) do { _Pragma("unroll") for (int m = 0; m < 4; ++m) _Pragma("unroll") for (int k = 0; k < 2; ++k) dst[m][k] = *(const PG8_LAS bf16x8*)(lds + PG8_SA(b, h) + aoff + m * 2048 + k * 1024); } while (0)
#define PG8_LDB(dst, b, h) do { _Pragma("unroll") for (int n = 0; n < 2; ++n) _Pragma("unroll") for (int k = 0; k < 2; ++k) dst[n][k] = *(const PG8_LAS bf16x8*)(lds + PG8_SB(b, h) + boff + n * 2048 + k * 1024); } while (0)
#define PG8_MMA(ai, bj, At, Bt) do { __builtin_amdgcn_s_setprio(1); _Pragma("unroll") for (int m = 0; m < 4; ++m) _Pragma("unroll") for (int n = 0; n < 2; ++n) _Pragma("unroll") for (int k = 0; k < 2; ++k) \
        acc[ai][bj][m][n] = __builtin_amdgcn_mfma_f32_16x16x32_bf16(Bt[n][k], At[m][k], acc[ai][bj][m][n], 0, 0, 0); __builtin_amdgcn_s_setprio(0); } while (0)
#define PG8_WAIT_V(n) asm volatile("s_waitcnt vmcnt(" #n ")" ::: "memory")
#define PG8_WAIT_L(n) asm volatile("s_waitcnt lgkmcnt(" #n ")" ::: "memory")
#define PG8_BAR __builtin_amdgcn_s_barrier()
#define PG8_SCHED __builtin_amdgcn_sched_barrier(0)
    Unit cur, nxt; int ui = 0;
    if (!S.next(0, cur)) return;
    f32x4 acc[2][2][4][2];
#pragma unroll
    for (int a = 0; a < 2; ++a)
#pragma unroll
        for (int b = 0; b < 2; ++b)
#pragma unroll
            for (int m = 0; m < 4; ++m)
#pragma unroll
                for (int n = 0; n < 2; ++n) acc[a][b][m][n] = (f32x4){0.f, 0.f, 0.f, 0.f};
    bf16x8 At[4][2], B0[2][2], B1[2][2];
    const char* cA = (const char*)g.A + (size_t)cur.pm * tstep; const char* cB = (const char*)g.Bt + (size_t)cur.pn * tstep;
    S.a_ready(cur);
    if constexpr (SP2) {
        PG8_STAGE(PG8_SB(0, 0), cB, voffB); PG8_STAGE(PG8_SB(0, 1), cB + hstep, voffB); PG8_STAGE(PG8_SA(0, 0), cA, voffA); PG8_STAGE(PG8_SA(0, 1), cA + hstep, voffA);
        if (wr == 1) PG8_BAR;
        PG8_WAIT_V(2); PG8_BAR;
        PG8_STAGE(PG8_SB(1, 0), cB + kstep, voffB); PG8_STAGE(PG8_SA(1, 0), cA + kstep, voffA); PG8_STAGE(PG8_SB(1, 1), cB + hstep + kstep, voffB);
        PG8_WAIT_V(6); PG8_BAR;
    } else {
        PG8_STAGE(PG8_SB(0, 0), cB, voffB); PG8_STAGE(PG8_SA(0, 0), cA, voffA); PG8_STAGE(PG8_SB(0, 1), cB + hstep, voffB); PG8_STAGE(PG8_SA(0, 1), cA + hstep, voffA);
        if (wr == 1) PG8_BAR;
        PG8_WAIT_V(4); PG8_BAR;
        PG8_STAGE(PG8_SB(1, 0), cB + kstep, voffB); PG8_STAGE(PG8_SA(1, 0), cA + kstep, voffA); PG8_STAGE(PG8_SB(1, 1), cB + hstep + kstep, voffB);
        PG8_WAIT_V(6); PG8_BAR;
    }
    for (;;) {
        const bool has_next = S.next(ui + 1, nxt);
        const char* nA = has_next ? (const char*)g.A + (size_t)nxt.pm * tstep : cA; const char* nB = has_next ? (const char*)g.Bt + (size_t)nxt.pn * tstep : cB;
        for (int t = 0; t < nt; t += 2) {
            const bool last = (t == nt - 2);
            const char* a1 = cA + (size_t)(t + 1) * kstep;
            const char* a2 = last ? nA : cA + (size_t)(t + 2) * kstep; const char* b2 = last ? nB : cB + (size_t)(t + 2) * kstep;
            const char* a3 = a2 + kstep; const char* b3 = b2 + kstep;
            if (last && has_next) S.a_ready(nxt);
            if constexpr (SP2) {
            PG8_LDB(B0, 0, 0); PG8_LDB(B1, 0, 1); PG8_SCHED; PG8_LDA(At, 0, 0); PG8_STAGE(PG8_SA(1, 1), a1 + hstep, voffA);
            PG8_WAIT_V(8); PG8_WAIT_L(0); PG8_BAR; PG8_MMA(0, 0, At, B0); PG8_MMA(0, 1, At, B1); PG8_BAR; PG8_SCHED;
            PG8_LDA(At, 0, 1); PG8_STAGE(PG8_SB(0, 0), b2, voffB); PG8_STAGE(PG8_SB(0, 1), b2 + hstep, voffB); PG8_STAGE(PG8_SA(0, 0), a2, voffA);
            PG8_WAIT_V(8); PG8_WAIT_L(0); PG8_BAR; PG8_MMA(1, 0, At, B0); PG8_MMA(1, 1, At, B1); PG8_BAR; PG8_SCHED;
            PG8_LDB(B0, 1, 0); PG8_LDB(B1, 1, 1); PG8_SCHED; PG8_LDA(At, 1, 0); PG8_STAGE(PG8_SA(0, 1), a2 + hstep, voffA);
            PG8_WAIT_V(8); PG8_WAIT_L(0); PG8_BAR; PG8_MMA(0, 0, At, B0); PG8_MMA(0, 1, At, B1); PG8_BAR; PG8_SCHED;
            PG8_LDA(At, 1, 1); PG8_STAGE(PG8_SB(1, 0), b3, voffB); PG8_STAGE(PG8_SB(1, 1), b3 + hstep, voffB); PG8_STAGE(PG8_SA(1, 0), a3, voffA);
            PG8_WAIT_V(8); PG8_WAIT_L(0); PG8_BAR; PG8_MMA(1, 0, At, B0); PG8_MMA(1, 1, At, B1); PG8_BAR; PG8_SCHED;
            } else {
            PG8_LDB(B0, 0, 0); PG8_SCHED; PG8_LDA(At, 0, 0); PG8_STAGE(PG8_SA(1, 1), a1 + hstep, voffA);
            PG8_WAIT_L(8); PG8_BAR; PG8_WAIT_L(0); PG8_MMA(0, 0, At, B0); PG8_BAR; PG8_SCHED;
            PG8_LDB(B1, 0, 1); PG8_STAGE(PG8_SB(0, 0), b2, voffB);
            PG8_BAR; PG8_WAIT_L(0); PG8_MMA(0, 1, At, B1); PG8_BAR;
            PG8_LDA(At, 0, 1); PG8_STAGE(PG8_SA(0, 0), a2, voffA);
            PG8_BAR; PG8_WAIT_L(0); PG8_MMA(1, 0, At, B0); PG8_BAR; PG8_SCHED;
            PG8_STAGE(PG8_SB(0, 1), b2 + hstep, voffB);
            PG8_WAIT_V(6); PG8_BAR; PG8_MMA(1, 1, At, B1); PG8_BAR;
            PG8_LDB(B0, 1, 0); PG8_SCHED; PG8_LDA(At, 1, 0); PG8_STAGE(PG8_SA(0, 1), a2 + hstep, voffA);
            PG8_WAIT_L(8); PG8_BAR; PG8_WAIT_L(0); PG8_MMA(0, 0, At, B0); PG8_BAR; PG8_SCHED;
            PG8_LDB(B1, 1, 1); PG8_STAGE(PG8_SB(1, 0), b3, voffB);
            PG8_BAR; PG8_WAIT_L(0); PG8_MMA(0, 1, At, B1); PG8_BAR;
            PG8_LDA(At, 1, 1); PG8_STAGE(PG8_SA(1, 0), a3, voffA);
            PG8_BAR; PG8_WAIT_L(0); PG8_MMA(1, 0, At, B0); PG8_BAR; PG8_SCHED;
            PG8_STAGE(PG8_SB(1, 1), b3 + hstep, voffB);
            PG8_WAIT_V(6); PG8_BAR; PG8_MMA(1, 1, At, B1); PG8_BAR;
            }
        }
        if constexpr (ALIGN_EPI) { if (wr == 0) PG8_BAR; }
        if constexpr (!Epi::AFTER_DRAIN) { E(acc, cur, wr, wc, fr, fq); S.done(cur); }
        if (!has_next) break;
#pragma unroll
        for (int a = 0; a < 2; ++a)
#pragma unroll
            for (int b = 0; b < 2; ++b)
#pragma unroll
                for (int m = 0; m < 4; ++m)
#pragma unroll
                    for (int n = 0; n < 2; ++n) acc[a][b][m][n] = (f32x4){0.f, 0.f, 0.f, 0.f};
        cur = nxt; cA = nA; cB = nB; ++ui;
        if constexpr (ALIGN_EPI) { if (wr == 1) PG8_BAR; }
    }
    PG8_WAIT_V(0);
    if constexpr (!ALIGN_EPI) { if (wr == 0) PG8_BAR; }
    PG8_BAR;
    if constexpr (Epi::AFTER_DRAIN) { E.fused(acc, cur, wr, wc, fr, fq, lds, wid, lane); S.done(cur); }
#undef PG8_SA
#undef PG8_SB
#undef PG8_STAGE
#undef PG8_LDA
#undef PG8_LDB
#undef PG8_MMA
#undef PG8_WAIT_V
#undef PG8_WAIT_L
#undef PG8_BAR
#undef PG8_SCHED
}
}
namespace cg = cooperative_groups;
#define LAS __attribute__((address_space(3)))
typedef unsigned short bf16;
typedef float f32x4 __attribute__((ext_vector_type(4)));
typedef float f32x8 __attribute__((ext_vector_type(8)));
typedef float f32x16 __attribute__((ext_vector_type(16)));
typedef unsigned u32x4 __attribute__((ext_vector_type(4)));
typedef unsigned u32x2 __attribute__((ext_vector_type(2)));
typedef short bf16x8 __attribute__((ext_vector_type(8)));
typedef short s16x4 __attribute__((ext_vector_type(4)));

constexpr int BATCH = 16, SEQ = 2048, DM = 1024, T = BATCH * SEQ;
constexpr int NP = 3072;
constexpr int IN_COLS = 3012;
constexpr int C_QA = 0, C_KA = 512, C_VA = 1024, C_QB = 1536, C_KV = 2560, C_QI = 2688, C_KI = 2944, C_WI = 3008;
constexpr int MIXW = 1536;
constexpr int NEXP = 16384;
constexpr float EPS = 1e-6f;
constexpr int NT = 512;
constexpr int NWV = 8;

constexpr size_t MiB = 1u << 20;
constexpr size_t WS_CTL = 0;
constexpr size_t CTL_BYTES = 64 * 1024;
constexpr size_t WS_MOD = 1 * MiB;
constexpr size_t WS_SCAL = WS_MOD + 512 * 1024;
constexpr size_t WS_WIN = 2 * MiB;
constexpr size_t WS_WO2 = 8 * MiB;
constexpr size_t WS_WQ = 11 * MiB;
constexpr size_t WS_SUBK = 13 * MiB;
constexpr size_t WS_U16 = 14 * MiB;
constexpr size_t WS_V16 = 46 * MiB;
constexpr size_t WS_H = 78 * MiB;
constexpr size_t WS_PROJ = 142 * MiB;
constexpr size_t WS_Q3 = WS_PROJ;
constexpr size_t WS_MIX = 334 * MiB;
constexpr size_t WS_EXP = 430 * MiB;
constexpr size_t WS_KVC = WS_EXP;
constexpr size_t WS_GATE = 446 * MiB;
constexpr size_t WS_ATMP = 462 * MiB;
constexpr size_t WS_CBUF = 494 * MiB;
constexpr size_t WS_ABUF1 = WS_MIX;
constexpr size_t WS_END = 510 * MiB;

struct Params {
    const float *x, *c, *ada_w, *ada_b, *norm1_g, *norm2_g, *w_in, *a_qk_gain, *a_lambda, *a_sub_gain, *b_q_gain, *b_kv_gain, *b_w_uv, *w_out, *peer_wq, *peer_subkeys, *peer_u, *peer_v;
    float* out; unsigned char* ws;
};

enum { SC_LAM = 0, SC_MA = 1, SC_MB = 2 };

__device__ __forceinline__ unsigned f2bf(float f) { unsigned u = __float_as_uint(f); return (u + 0x7fffu + ((u >> 16) & 1u)) >> 16; }
__device__ __forceinline__ float bf2f(unsigned h) { return __uint_as_float(h << 16); }
__device__ __forceinline__ unsigned pk2(float lo, float hi) { return f2bf(lo) | (f2bf(hi) << 16); }
__device__ __forceinline__ float bflo(unsigned w) { return __uint_as_float(w << 16); }
__device__ __forceinline__ float bfhi(unsigned w) { return __uint_as_float(w & 0xffff0000u); }
__device__ __forceinline__ float wave_sum(float v) {
#pragma unroll
    for (int o = 1; o < 64; o <<= 1) v += __shfl_xor(v, o);
    return v;
}
__device__ __forceinline__ float wave_max(float v) {
#pragma unroll
    for (int o = 1; o < 64; o <<= 1) v = fmaxf(v, __shfl_xor(v, o));
    return v;
}
#define LDS_WAIT() asm volatile("s_waitcnt lgkmcnt(0)" ::: "memory")
__device__ __forceinline__ void ph_mod(const Params& p, float* ldsf, int vb, int nvb) {
    if (vb >= 96) return;
    int tid = threadIdx.x; asm volatile("" : "+v"(tid));
    const int lane = tid & 63, wv = tid >> 6;
    for (int i = tid; i < 16 * 1024; i += NT) { const float v = p.c[i]; ldsf[i] = v / (1.f + __expf(-v)); }
    __syncthreads();
    float* MOD = (float*)(p.ws + WS_MOD); float* part = ldsf + 16 * 1024;
    for (int it = vb; it < 96; it += nvb) {
        const int j = it * 64 + lane;
        float acc[16];
#pragma unroll
        for (int b = 0; b < 16; ++b) acc[b] = 0.f;
        const float* wp = p.ada_w + (size_t)(128 * wv) * 6144 + j;
#pragma unroll 1
        for (int k0 = 0; k0 < 128; k0 += 8) {
            float w[8];
#pragma unroll
            for (int u = 0; u < 8; ++u) w[u] = wp[(size_t)(k0 + u) * 6144];
#pragma unroll
            for (int u = 0; u < 8; ++u)
#pragma unroll
                for (int b = 0; b < 16; ++b) acc[b] = fmaf(ldsf[b * 1024 + 128 * wv + k0 + u], w[u], acc[b]);
        }
#pragma unroll
        for (int b = 0; b < 16; ++b) part[(wv * 16 + b) * 64 + lane] = acc[b];
        __syncthreads();
        for (int o = tid; o < 16 * 64; o += NT) { const int b = o >> 6, c = o & 63; float s = 0.f;
#pragma unroll
            for (int w = 0; w < 8; ++w) s += part[(w * 16 + b) * 64 + c];
            MOD[b * 6144 + it * 64 + c] = s + p.ada_b[it * 64 + c]; }
        __syncthreads();
    }
}

__device__ __forceinline__ void transpose_item(const float* W, int N, bf16* WT, int ldt, LAS float* scr, int kb, int nb, int lane) {
    const int k0 = 64 * kb, n0 = 32 * nb;
#pragma unroll 8
    for (int i = 0; i < 32; ++i) { const int kk = 2 * i + (lane >> 5); const int n = n0 + (lane & 31); scr[kk * 33 + (lane & 31)] = (n < N) ? W[(size_t)(k0 + kk) * N + n] : 0.f; }
    LDS_WAIT(); asm volatile("" ::: "memory");
    const int c = lane & 7;
#pragma unroll
    for (int j = 0; j < 4; ++j) { const int n = (lane >> 3) + 8 * j; const LAS float* s = scr + (8 * c) * 33 + n;
        u32x4 o; o.x = pk2(s[0 * 33], s[1 * 33]); o.y = pk2(s[2 * 33], s[3 * 33]); o.z = pk2(s[4 * 33], s[5 * 33]); o.w = pk2(s[6 * 33], s[7 * 33]);
        *(u32x4*)(WT + (size_t)(n0 + n) * ldt + k0 + 8 * c) = o; }
    LDS_WAIT(); asm volatile("" ::: "memory");
}

__device__ __forceinline__ void ph_prep_weights(const Params& p, LAS float* scr, int gw, int ngw, int lane) {
    bf16* WIN = (bf16*)(p.ws + WS_WIN); bf16* WO2 = (bf16*)(p.ws + WS_WO2); bf16* WQ = (bf16*)(p.ws + WS_WQ);
    constexpr int I_IN = 16 * 96, I_O = 8 * 32, I_Q = 16 * 32;
    for (int it = gw; it < I_IN + I_O + I_Q; it += ngw) {
        int r = it;
        if (r < I_IN) { transpose_item(p.w_in, IN_COLS, WIN, 1024, scr, r / 96, r % 96, lane); continue; } r -= I_IN;
        if (r < I_O) { transpose_item(p.w_out, 1024, WO2, MIXW, scr, r / 32, r % 32, lane); continue; } r -= I_O;
        transpose_item(p.peer_wq, 1024, WQ, 1024, scr, r / 32, r % 32, lane);
    }
    const size_t gt = (size_t)gw * 64 + lane, ngt = (size_t)ngw * 64;
    for (size_t i = gt; i < (size_t)1024 * 1024; i += ngt) {
        const int n = (int)(i & 1023), kk = (int)(i >> 10), h = kk >> 7;
        const float* wu = p.b_w_uv + (size_t)kk * 64; const float* wo = p.w_out + (size_t)(512 + 64 * h) * 1024 + n;
        float a = 0.f;
#pragma unroll 8
        for (int e = 0; e < 64; ++e) a = fmaf(wu[e], wo[(size_t)e * 1024], a);
        WO2[(size_t)n * MIXW + 512 + kk] = (bf16)f2bf(a);
    }
    unsigned char* U8 = (unsigned char*)(p.ws + WS_U16); unsigned char* V8 = (unsigned char*)(p.ws + WS_V16); bf16* SUBK = (bf16*)(p.ws + WS_SUBK);
    constexpr size_t NTAB8 = (size_t)NEXP * 1024 / 8, NSUB8 = 2 * 128 * 64 / 8;
    for (size_t i = gt; i < 2 * NTAB8 + NSUB8; i += ngt) {
        if (i < 2 * NTAB8) {
            const bool isu = i < NTAB8; const size_t j = isu ? i : i - NTAB8; const float sc = isu ? 32.0f : 1.0f;
            const f32x8 v = *(const f32x8*)((isu ? p.peer_u : p.peer_v) + j * 8);
            int w0 = 0, w1 = 0;
            w0 = __builtin_amdgcn_cvt_pk_fp8_f32(v[0] * sc, v[1] * sc, w0, false); w0 = __builtin_amdgcn_cvt_pk_fp8_f32(v[2] * sc, v[3] * sc, w0, true);
            w1 = __builtin_amdgcn_cvt_pk_fp8_f32(v[4] * sc, v[5] * sc, w1, false); w1 = __builtin_amdgcn_cvt_pk_fp8_f32(v[6] * sc, v[7] * sc, w1, true);
            u32x2 o; o.x = (unsigned)w0; o.y = (unsigned)w1;
            *(u32x2*)((isu ? U8 : V8) + j * 8) = o;
        } else {
            const size_t j = i - 2 * NTAB8;
            const f32x8 v = *(const f32x8*)(p.peer_subkeys + j * 8);
            u32x4 o; o.x = pk2(v[0], v[1]); o.y = pk2(v[2], v[3]); o.z = pk2(v[4], v[5]); o.w = pk2(v[6], v[7]);
            *(u32x4*)(SUBK + j * 8) = o;
        }
    }
    if (gt == 0) {
        float* SC = (float*)(p.ws + WS_SCAL);
        float s01 = 0.f, s23 = 0.f;
        for (int i = 0; i < 64; ++i) { s01 += p.a_lambda[i] * p.a_lambda[64 + i]; s23 += p.a_lambda[128 + i] * p.a_lambda[192 + i]; }
        SC[SC_LAM] = __expf(s01) - __expf(s23) + 0.2f;
        float g0 = 0.f, g1 = 0.f, gq = 0.f, gk = 0.f;
        for (int i = 0; i < 64; ++i) { g0 = fmaxf(g0, fabsf(p.a_qk_gain[i])); g1 = fmaxf(g1, fabsf(p.a_qk_gain[64 + i])); }
        for (int i = 0; i < 128; ++i) { gq = fmaxf(gq, fabsf(p.b_q_gain[i])); gk = fmaxf(gk, fabsf(p.b_kv_gain[i])); }
        SC[SC_MA] = 8.0f * g0 * g1 * 1.02f;
        SC[SC_MB] = 11.3137085f * gq * gk * 1.02f;
    }
}

__device__ __forceinline__ void ph_hrows(const Params& p, const float* X, const float* g, int shOff, int scOff, int gw, int ngw, int lane) {
    const float* MOD = (const float*)(p.ws + WS_MOD); bf16* H = (bf16*)(p.ws + WS_H);
    for (int m = gw; m < T; m += ngw) {
        const f32x4* xr = (const f32x4*)(X + (size_t)m * 1024) + lane;
        f32x4 v[4]; float s = 0.f;
#pragma unroll
        for (int j = 0; j < 4; ++j) { v[j] = xr[64 * j]; s += (v[j].x * v[j].x + v[j].y * v[j].y) + (v[j].z * v[j].z + v[j].w * v[j].w); }
        const float rstd = rsqrtf(wave_sum(s) * (1.f / 1024.f) + EPS);
        const float* mb = MOD + (size_t)(m >> 11) * 6144;
#pragma unroll
        for (int j = 0; j < 4; ++j) {
            const int col = 4 * (lane + 64 * j);
            const f32x4 gg = *(const f32x4*)(g + col), sc = *(const f32x4*)(mb + scOff + col), sh = *(const f32x4*)(mb + shOff + col);
            const f32x4 y = v[j] * rstd * gg * (sc + 1.0f) + sh;
            u32x2 o; o.x = pk2(y.x, y.y); o.y = pk2(y.z, y.w);
            *(u32x2*)(H + (size_t)m * 1024 + col) = o;
        }
    }
}

__device__ __forceinline__ void ph_norm_proj(const Params& p, int gw, int ngw, int lane) {
    bf16* PROJ = (bf16*)(p.ws + WS_PROJ);
    for (int m = gw; m < T; m += ngw) {
        bf16* row = PROJ + (size_t)m * NP;
#pragma unroll
        for (int j = 0; j < 6; ++j) {
            if (j == 2) continue;
            const int col = 8 * lane + 512 * j;
            const u32x4 raw = *(const u32x4*)(row + col);
            float v[8] = {bflo(raw.x), bfhi(raw.x), bflo(raw.y), bfhi(raw.y), bflo(raw.z), bfhi(raw.z), bflo(raw.w), bfhi(raw.w)};
            float ss = 0.f;
#pragma unroll
            for (int i = 0; i < 8; ++i) ss += v[i] * v[i];
            ss += __shfl_xor(ss, 1); ss += __shfl_xor(ss, 2); ss += __shfl_xor(ss, 4);
            float rstd; const float* gp;
            if (j < 2) { rstd = rsqrtf(ss * (1.f / 64.f) + EPS); gp = p.a_qk_gain + 64 * j + (col & 63); }
            else { ss += __shfl_xor(ss, 8); rstd = rsqrtf(ss * (1.f / 128.f) + EPS); gp = (j == 5 ? p.b_kv_gain : p.b_q_gain) + (col & 127); }
            if (j == 5 && lane >= 16) continue;
            const f32x4 g0 = *(const f32x4*)gp, g1 = *(const f32x4*)(gp + 4);
            u32x4 o; o.x = pk2(v[0] * rstd * g0.x, v[1] * rstd * g0.y); o.y = pk2(v[2] * rstd * g0.z, v[3] * rstd * g0.w);
            o.z = pk2(v[4] * rstd * g1.x, v[5] * rstd * g1.y); o.w = pk2(v[6] * rstd * g1.z, v[7] * rstd * g1.w);
            *(u32x4*)(row + col) = o;
        }
    }
}
struct EpiResGate {
    static constexpr bool PERM = false, AFTER_DRAIN = false;
    const float* X; float* Out; const float* gate;
    __device__ __forceinline__ void operator()(const pg8::f32x4 (&acc)[2][2][4][2], const pg8::Unit& u, int wr, int wc, int fr, int fq) const {
        const int col0 = u.pn * 256 + wc * 32 + 4 * fq;
#pragma unroll
        for (int ai = 0; ai < 2; ++ai)
#pragma unroll
            for (int m = 0; m < 4; ++m) {
                const int r = u.pm * 256 + ai * 128 + wr * 64 + m * 16 + fr; const float* gb = gate + (size_t)(r >> 11) * 6144;
#pragma unroll
                for (int bj = 0; bj < 2; ++bj)
#pragma unroll
                    for (int n = 0; n < 2; ++n) { const int c = col0 + bj * 128 + n * 16; const size_t off = (size_t)r * 1024 + c;
                        const pg8::f32x4 xv = *(const pg8::f32x4*)(X + off), gv = *(const pg8::f32x4*)(gb + c);
                        *(pg8::f32x4*)(Out + off) = xv + gv * acc[ai][bj][m][n]; }
            }
    }
};


struct EpiNormBf16 {
    static constexpr bool PERM = true, AFTER_DRAIN = false;
    bf16* O; const float* gqk; const float* gbq; const float* gbkv; LAS float* P; bf16* KVC;
    __device__ __forceinline__ void operator()(const pg8::f32x4 (&acc)[2][2][4][2], const pg8::Unit& u, int wr, int wc, int fr, int fq) const {
        const int pn = u.pn;
        const int mode = pn < 4 ? 1 : ((pn == 4 || pn == 5 || pn == 11) ? 0 : (pn == 10 ? 3 : 2));
        if (mode != 0) {
#pragma unroll
            for (int ai = 0; ai < 2; ++ai)
#pragma unroll
                for (int m = 0; m < 4; ++m)
#pragma unroll
                    for (int bj = 0; bj < 2; ++bj) {
                        const pg8::f32x4 a = acc[ai][bj][m][0], b = acc[ai][bj][m][1];
                        float ss = (a[0] * a[0] + a[1] * a[1]) + (a[2] * a[2] + a[3] * a[3]) + (b[0] * b[0] + b[1] * b[1]) + (b[2] * b[2] + b[3] * b[3]);
                        ss += __shfl_xor(ss, 16); ss += __shfl_xor(ss, 32);
                        if (fq == 0) P[(ai * 128 + wr * 64 + m * 16 + fr) * 8 + bj * 4 + wc] = ss;
                    }
            asm volatile("s_waitcnt lgkmcnt(0)" ::: "memory"); __builtin_amdgcn_s_barrier(); asm volatile("" ::: "memory");
        }
        const int row0 = u.pm * 256 + wr * 64 + fr, col0 = u.pn * 256 + wc * 32 + 8 * fq;
        pg8::f32x4 g0[2], g1[2];
#pragma unroll
        for (int bj = 0; bj < 2; ++bj) {
            const float* gp = nullptr;
            if (mode == 1) gp = gqk + (pn >= 2 ? 64 : 0) + 32 * (wc & 1) + 8 * fq;
            else if (mode == 2) gp = gbq + 32 * wc + 8 * fq;
            else if (mode == 3 && bj == 0) gp = gbkv + 32 * wc + 8 * fq;
            if (gp) { g0[bj] = *(const pg8::f32x4*)gp; g1[bj] = *(const pg8::f32x4*)(gp + 4); } else { g0[bj] = (pg8::f32x4){1.f, 1.f, 1.f, 1.f}; g1[bj] = g0[bj]; }
        }
#pragma unroll
        for (int ai = 0; ai < 2; ++ai)
#pragma unroll
            for (int m = 0; m < 4; ++m) { bf16* rowp = O + (size_t)(row0 + ai * 128 + m * 16) * NP + col0;
#pragma unroll
                for (int bj = 0; bj < 2; ++bj) {
                    float s = 1.f;
                    if (mode != 0 && !(mode == 3 && bj == 1)) {
                        const pg8::f32x4 q = *(const LAS pg8::f32x4*)(P + (ai * 128 + wr * 64 + m * 16 + fr) * 8 + bj * 4);
                        s = (mode == 1) ? rsqrtf(((wc < 2) ? (q[0] + q[1]) : (q[2] + q[3])) * (1.f / 64.f) + EPS) : rsqrtf(((q[0] + q[1]) + (q[2] + q[3])) * (1.f / 128.f) + EPS);
                    }
                    const pg8::f32x4 v0 = acc[ai][bj][m][0] * s * g0[bj], v1 = acc[ai][bj][m][1] * s * g1[bj];
                    pg8::u32x4 w; w.x = pg8::cvt_pk_bf16(v0[0], v0[1]); w.y = pg8::cvt_pk_bf16(v0[2], v0[3]); w.z = pg8::cvt_pk_bf16(v1[0], v1[1]); w.w = pg8::cvt_pk_bf16(v1[2], v1[3]);
                    if (pn == 10 && bj == 0) *(pg8::u32x4*)(KVC + (size_t)(row0 + ai * 128 + m * 16) * 128 + wc * 32 + 8 * fq) = w;
                    else *(pg8::u32x4*)(rowp + bj * 128) = w; } }
    }
};
typedef __bf16 bf16x2_t __attribute__((ext_vector_type(2)));
__device__ __forceinline__ float dot2bf(unsigned a, unsigned b, float acc) { return __builtin_amdgcn_fdot2_f32_bf16(__builtin_bit_cast(bf16x2_t, a), __builtin_bit_cast(bf16x2_t, b), acc, false); }
template <int CTRL> __device__ __forceinline__ float dpp_f(float v) { return __int_as_float(__builtin_amdgcn_update_dpp(0, __float_as_int(v), CTRL, 0xf, 0xf, false)); }
__device__ __forceinline__ float row16_sum(float v) {
    v += dpp_f<0x128>(v); v += dpp_f<0x124>(v); v += dpp_f<0x122>(v); v += dpp_f<0x121>(v); return v;
}
__device__ __forceinline__ float gelu_erf(float v) {
    const float av = fabsf(v), t = __builtin_amdgcn_rcpf(fmaf(av, 0.2316418882f, 1.0f));
    float q = fmaf(t, 0.5307027145f, -0.7265760135f); q = fmaf(q, t, 0.7107068705f); q = fmaf(q, t, -0.142248368f); q = fmaf(q, t, 0.127414796f); q = q * t;
    const float e = __builtin_amdgcn_exp2f(v * v * -0.72134752044f);
    const float m = v * (q * e);
    return v < 0.f ? m : v - m;
}

#ifndef DSA_PB
#define DSA_PB 0
#endif
typedef short v4i16_t __attribute__((ext_vector_type(4)));
#ifndef DSA_REP_A
#define DSA_REP_A 1
#endif
#ifndef DSA_REP_B
#define DSA_REP_B 1
#endif
#ifndef DSA_REP_C
#define DSA_REP_C 1
#endif
constexpr int DSA_SROW = 2048 * 4 + 16;
constexpr int DSA_SEL_OFF = 16 * DSA_SROW;
constexpr int DSA_LDS = DSA_SEL_OFF + 16 * 512;
constexpr int DSA_KVROW = 272;

__device__ __forceinline__ unsigned sortkey(float s) { const unsigned u = __float_as_uint(s); return u ^ ((u >> 31) ? 0xffffffffu : 0x80000000u); }
__device__ __forceinline__ unsigned cvtpk_bf16(float lo, float hi) { unsigned r; asm volatile("v_cvt_pk_bf16_f32 %0, %1, %2" : "=v"(r) : "v"(lo), "v"(hi)); return r; }

__device__ __forceinline__ void cnt_ge4(int& acc, unsigned k0, unsigned k1, unsigned k2, unsigned k3, unsigned cand) {
    asm volatile("v_cmp_ge_u32_e64 s[40:41], %1, %5\n\t"
                 "v_cmp_ge_u32_e64 s[42:43], %2, %5\n\t"
                 "v_cmp_ge_u32_e64 s[44:45], %3, %5\n\t"
                 "v_cmp_ge_u32_e64 s[46:47], %4, %5\n\t"
                 "v_addc_co_u32_e64 %0, s[48:49], %0, 0, s[40:41]\n\t"
                 "v_addc_co_u32_e64 %0, s[48:49], %0, 0, s[42:43]\n\t"
                 "v_addc_co_u32_e64 %0, s[48:49], %0, 0, s[44:45]\n\t"
                 "v_addc_co_u32_e64 %0, s[48:49], %0, 0, s[46:47]"
                 : "+v"(acc) : "v"(k0), "v"(k1), "v"(k2), "v"(k3), "v"(cand)
                 : "s40", "s41", "s42", "s43", "s44", "s45", "s46", "s47", "s48", "s49");
}
__device__ __forceinline__ void ph_dsa(const Params& p, unsigned char* lds, int vb, int nvb) {
    const bf16* PROJ = (const bf16*)(p.ws + WS_PROJ); bf16* MIX = (bf16*)(p.ws + WS_MIX);
    const float MB = ((const float*)(p.ws + WS_SCAL))[SC_MB];
    int tid = threadIdx.x; asm volatile("" : "+v"(tid)); const int lane = tid & 63, wv = __builtin_amdgcn_readfirstlane(tid >> 6);
    const int l15 = lane & 15, g = lane >> 4;
    LAS unsigned char* ldsl = (LAS unsigned char*)lds;
    for (int it = vb; it < 2048; it += nvb) {
        const int vbb = it & 255, kk = it >> 8, xg = vbb & 7, ix = vbb >> 3, b = 2 * xg + (ix & 1), G = (ix >> 1) & 3, sub = ix >> 3;
        const int c = (kk & 1) ? (31 - G - 8 * (kk >> 1)) : (G + 8 * (kk >> 1));
        const int cend = (c + 1) * 64, t0 = c * 64 + sub * 16;
        const bf16* Pb = PROJ + (size_t)b * SEQ * NP;
        const bf16* KVb = (const bf16*)(p.ws + WS_KVC) + (size_t)b * SEQ * 128;
#pragma unroll 1
        for (int repa = 0; repa < DSA_REP_A; ++repa)
        if (c >= 4) {
            const bf16* qrow = Pb + (size_t)(t0 + l15) * NP;
            bf16x8 bq[4][2]; float wsc[4];
#pragma unroll
            for (int h = 0; h < 4; ++h) { wsc[h] = bf2f(qrow[C_WI + h]) * 0.0625f;
#pragma unroll
                for (int ks = 0; ks < 2; ++ks) bq[h][ks] = *(const bf16x8*)(qrow + C_QI + h * 64 + 32 * ks + 8 * g); }
            for (int k0 = 16 * wv; k0 < cend; k0 += 128) {
                const bf16* krow = Pb + (size_t)(k0 + l15) * NP + C_KI + 8 * g;
                const bf16x8 ka0 = *(const bf16x8*)krow, ka1 = *(const bf16x8*)(krow + 32);
                f32x4 sc = {0.f, 0.f, 0.f, 0.f};
#pragma unroll
                for (int h = 0; h < 4; ++h) { f32x4 a = {0.f, 0.f, 0.f, 0.f};
                    a = __builtin_amdgcn_mfma_f32_16x16x32_bf16(ka0, bq[h][0], a, 0, 0, 0);
                    a = __builtin_amdgcn_mfma_f32_16x16x32_bf16(ka1, bq[h][1], a, 0, 0, 0);
#pragma unroll
                    for (int r = 0; r < 4; ++r) sc[r] = fmaf(fmaxf(a[r], 0.f), wsc[h], sc[r]); }
#pragma unroll
                for (int r = 0; r < 4; ++r) sc[r] = (sc[r] == 0.f) ? 0.f : sc[r];
                *(LAS f32x4*)(ldsl + l15 * DSA_SROW + (k0 + 4 * g) * 4) = sc;
            }
        }
        __syncthreads();
        LAS unsigned short* selw = (LAS unsigned short*)(ldsl + DSA_SEL_OFF);
        int mind0 = 0, mind1 = 0;
        if (c < 4) {
            for (int j = lane; j < 256; j += 64) { selw[(2 * wv) * 256 + j] = (unsigned short)j; selw[(2 * wv + 1) * 256 + j] = (unsigned short)j; }
        } else {
            const int nreg = cend >> 6;
            unsigned keyA[32], keyB[32];
            { const LAS float* srA = (const LAS float*)(ldsl + (2 * wv) * DSA_SROW) + lane; const LAS float* srB = (const LAS float*)(ldsl + (2 * wv + 1) * DSA_SROW) + lane;
#pragma unroll
              for (int i = 0; i < 32; ++i) { keyA[i] = (i < nreg) ? sortkey(srA[64 * i]) : 0u; keyB[i] = (i < nreg) ? sortkey(srB[64 * i]) : 0u; } }
#define DSA_WSUM(V, OUT) do { int v_ = (V); v_ += __builtin_amdgcn_update_dpp(0, v_, 0x128, 0xf, 0xf, false); v_ += __builtin_amdgcn_update_dpp(0, v_, 0x124, 0xf, 0xf, false); \
        v_ += __builtin_amdgcn_update_dpp(0, v_, 0x122, 0xf, 0xf, false); v_ += __builtin_amdgcn_update_dpp(0, v_, 0x121, 0xf, 0xf, false);                                     \
        OUT = __builtin_amdgcn_readlane(v_, 0) + __builtin_amdgcn_readlane(v_, 16) + __builtin_amdgcn_readlane(v_, 32) + __builtin_amdgcn_readlane(v_, 48); } while (0)
            unsigned prefA = 0u, prefB = 0u; bool exA = false, exB = false;
#pragma unroll 1
            for (int bit = 31; bit >= 0; --bit) {
                const unsigned candA = exA ? prefA : (prefA | (1u << bit)), candB = exB ? prefB : (prefB | (1u << bit));
                int ca = 0, cb = 0;
#pragma unroll
                for (int i = 0; i < 32; i += 4) { cnt_ge4(ca, keyA[i], keyA[i + 1], keyA[i + 2], keyA[i + 3], candA); cnt_ge4(cb, keyB[i], keyB[i + 1], keyB[i + 2], keyB[i + 3], candB); }
                int cntA, cntB; DSA_WSUM(ca, cntA); DSA_WSUM(cb, cntB);
                if (!exA && cntA >= 256) { prefA = candA; exA = (cntA == 256); }
                if (!exB && cntB >= 256) { prefB = candB; exB = (cntB == 256); }
                if (exA && exB) break;
            }
#define DSA_COMPACT(KEY, PREFIX, EXACT, QQ, MIND) do {                                                                                              \
            const int t_ = t0 + (QQ); LAS unsigned short* sel = selw + (QQ) * 256;                                                                    \
            int need_ties = 0;                                                                                                                        \
            if (!(EXACT)) { int cg_ = 0; if ((PREFIX) != 0xffffffffu) { _Pragma("unroll") for (int i = 0; i < 32; ++i) cg_ += (KEY[i] > (PREFIX)) ? 1 : 0; } \
                int cgt; DSA_WSUM(cg_, cgt); need_ties = 256 - cgt; }                                                                                 \
            int base = 0, tbase = 0, md = 4096;                                                                                                       \
            _Pragma("unroll") for (int i = 0; i < 32; ++i) { if (i < nreg) {                                                                          \
                bool selb;                                                                                                                            \
                if (EXACT) selb = KEY[i] >= (PREFIX);                                                                                                 \
                else { const bool tie = KEY[i] == (PREFIX); const unsigned long long mt = __ballot(tie);                                              \
                    const int trank = tbase + (int)__builtin_amdgcn_mbcnt_hi((unsigned)(mt >> 32), __builtin_amdgcn_mbcnt_lo((unsigned)mt, 0u));      \
                    selb = (KEY[i] > (PREFIX)) || (tie && trank < need_ties); tbase += __popcll(mt); }                                                \
                const unsigned long long m = __ballot(selb);                                                                                          \
                const int pos = base + (int)__builtin_amdgcn_mbcnt_hi((unsigned)(m >> 32), __builtin_amdgcn_mbcnt_lo((unsigned)m, 0u));               \
                const int kidx = i * 64 + lane;                                                                                                       \
                if (selb) { sel[pos] = (unsigned short)kidx; const int d = t_ > kidx ? t_ - kidx : kidx - t_; md = d < md ? d : md; }                 \
                base += __popcll(m); } }                                                                                                              \
            _Pragma("unroll") for (int o = 1; o < 64; o <<= 1) { const int x = __shfl_xor(md, o); md = x < md ? x : md; }                             \
            MIND = md; } while (0)
            DSA_COMPACT(keyA, prefA, exA, 2 * wv, mind0);
            DSA_COMPACT(keyB, prefB, exB, 2 * wv + 1, mind1);
#undef DSA_COMPACT
#undef DSA_WSUM
        }
        LDS_WAIT(); asm volatile("" ::: "memory");
        const int nvalid = cend < 256 ? cend : 256;
        const int head = lane & 7;
        const float slopeL2 = exp2f(-(float)(head + 1)) * 1.4426950409f;
#pragma unroll 1
        for (int qi2 = 0; qi2 < 2 * DSA_REP_C; ++qi2) { const int qi = qi2 & 1;
            const int qq = 2 * wv + qi, t = t0 + qq;
            const LAS unsigned short* sel = selw + qq * 256;
            LAS unsigned char* stg = ldsl + (2 * wv) * DSA_SROW;
            const bf16* qrow = Pb + (size_t)t * NP + C_QB + head * 128 + 8 * g;
            bf16x8 bq[4];
#pragma unroll
            for (int ks = 0; ks < 4; ++ks) bq[ks] = *(const bf16x8*)(qrow + 32 * ks);
            const float refL2 = MB * 1.4426950409f - slopeL2 * (float)(qi == 0 ? mind0 : mind1);
            f32x4 o[8];
#pragma unroll
            for (int dt = 0; dt < 8; ++dt) o[dt] = (f32x4){0.f, 0.f, 0.f, 0.f};
            float lsum = 0.f;
#define DSA_GATHER(S, KA) do { _Pragma("unroll") for (int i_ = 0; i_ < 8; ++i_) { const int jr = 32 * (S) + 4 * i_ + g; const int keyr = sel[jr < nvalid ? jr : 0];   \
        KA[i_] = *(const bf16x8*)(KVb + (size_t)keyr * 128 + 8 * l15); } } while (0)
#define DSA_COMPUTE(S, KA) do { unsigned pb[4];                                                                                                        \
        _Pragma("unroll") for (int i_ = 0; i_ < 8; ++i_) *(LAS bf16x8*)(stg + (4 * i_ + g) * DSA_KVROW + 16 * l15) = KA[i_];                              \
        LDS_WAIT(); asm volatile("" ::: "memory");                                                                                                        \
        _Pragma("unroll") for (int tl = 0; tl < 2; ++tl) { const int j0 = 32 * (S) + 16 * tl;                                                           \
            f32x4 a = {0.f, 0.f, 0.f, 0.f};                                                                                                             \
            _Pragma("unroll") for (int ks = 0; ks < 4; ++ks) { const bf16x8 ka_ = *(const LAS bf16x8*)(stg + (16 * tl + l15) * DSA_KVROW + (32 * ks + 8 * g) * 2); \
                a = __builtin_amdgcn_mfma_f32_16x16x32_bf16(ka_, bq[ks], a, 0, 0, 0); }                                                                 \
            const u32x2 kw = *(const LAS u32x2*)(sel + j0 + 4 * g);                                                                                     \
            const int kx[4] = {(int)(kw.x & 0xffffu), (int)(kw.x >> 16), (int)(kw.y & 0xffffu), (int)(kw.y >> 16)};                                     \
            float pr[4];                                                                                                                                \
            _Pragma("unroll") for (int r = 0; r < 4; ++r) { const int dd = t > kx[r] ? t - kx[r] : kx[r] - t;                                            \
                const float e = __builtin_amdgcn_exp2f(fmaf(a[r], 0.1275174f, -slopeL2 * (float)dd - refL2));                                            \
                pr[r] = (j0 + 4 * g + r < nvalid) ? e : 0.f; lsum += pr[r]; }                                                                           \
            pb[2 * tl] = cvtpk_bf16(pr[0], pr[1]); pb[2 * tl + 1] = cvtpk_bf16(pr[2], pr[3]); }                                                         \
        LDS_WAIT(); asm volatile("" ::: "memory");                                                                                                      \
        u32x4 pw4; pw4.x = pb[0]; pw4.y = pb[1]; pw4.z = pb[2]; pw4.w = pb[3];                                                                          \
        const bf16x8 pfrag = __builtin_bit_cast(bf16x8, pw4);                                                                                           \
        const LAS unsigned char* trb = stg + (4 * g + (l15 >> 2)) * DSA_KVROW + (4 * (lane & 3)) * 2;                                                   \
        _Pragma("unroll") for (int dt = 0; dt < 8; ++dt) {                                                                                              \
            const s16x4 lo = __builtin_bit_cast(s16x4, __builtin_amdgcn_ds_read_tr16_b64_v4i16((LAS v4i16_t*)(trb + dt * 32)));                         \
            const s16x4 hi = __builtin_bit_cast(s16x4, __builtin_amdgcn_ds_read_tr16_b64_v4i16((LAS v4i16_t*)(trb + 16 * DSA_KVROW + dt * 32)));        \
            const bf16x8 af = {lo[0], lo[1], lo[2], lo[3], hi[0], hi[1], hi[2], hi[3]};                                                                 \
            o[dt] = __builtin_amdgcn_mfma_f32_16x16x32_bf16(af, pfrag, o[dt], 0, 0, 0); }                                                               \
        LDS_WAIT(); asm volatile("" ::: "memory"); } while (0)
            const int nch = (nvalid + 31) >> 5;
            bf16x8 KA[8], KB[8];
            DSA_GATHER(0, KA);
#pragma unroll 1
            for (int s = 0; s < nch; s += 2) {
                if (s + 1 < nch) DSA_GATHER(s + 1, KB);
                DSA_COMPUTE(s, KA);
                if (s + 1 < nch) { if (s + 2 < nch) DSA_GATHER(s + 2, KA); DSA_COMPUTE(s + 1, KB); }
            }
#undef DSA_GATHER
#undef DSA_COMPUTE
            lsum += __shfl_xor(lsum, 16); lsum += __shfl_xor(lsum, 32);
            const float il = 1.f / lsum;
            if (l15 < 8) {
                bf16* orow = MIX + (size_t)(b * SEQ + t) * MIXW + 512 + head * 128 + 4 * g;
#pragma unroll
                for (int dt = 0; dt < 8; ++dt) { u32x2 w; w.x = pk2(o[dt][0] * il, o[dt][1] * il); w.y = pk2(o[dt][2] * il, o[dt][3] * il); *(u32x2*)(orow + 16 * dt) = w; }
            }
        }
        __syncthreads();
    }
}
typedef __attribute__((address_space(1))) float GASF;
#ifndef ATT_PROBE
#define ATT_PROBE 0
#endif
#ifndef ATT_REMAP
#define ATT_REMAP 1
#endif
__device__ __forceinline__ int crow(int r, int hi) { return (r & 3) + 8 * (r >> 2) + 4 * hi; }
#define KSWZ64(row, cb) ((row) * 128 + ((cb) ^ ((((row) >> 1) & 7) << 4)))
__device__ __forceinline__ int v_st(int k, int c) { const int kk = (k & ~0xC) | ((k & 4) << 1) | ((k & 8) >> 1); return ((kk >> 3) * 4 + (c >> 5)) * 512 + ((kk & 7) * 32 + (c & 31)) * 2; }
__device__ __forceinline__ int v_rd_base(int lane) { return ((lane & 3) << 3) | (((lane >> 2) & 3) << 6) | (((lane >> 4) & 1) << 5) | (((lane >> 5) & 1) << 8); }
constexpr int v_rd_off(int d0, int ks, int half) { return d0 * 512 + ks * 4096 + half * 2048; }
template <int OFF> __device__ __forceinline__ s16x4 tr_read(int vb) {
    s16x4 r; asm volatile("ds_read_b64_tr_b16 %0, %1 offset:%2" : "=&v"(r) : "v"(vb), "i"(OFF) : "memory"); return r;
}
template <int D0> __device__ __forceinline__ void pv_one(f32x16& od, int vb, bf16x8 pa0, bf16x8 pa1, bf16x8 pa2, bf16x8 pa3) {
    const s16x4 l0 = tr_read<v_rd_off(D0, 0, 0)>(vb), h0 = tr_read<v_rd_off(D0, 0, 1)>(vb), l1 = tr_read<v_rd_off(D0, 1, 0)>(vb), h1 = tr_read<v_rd_off(D0, 1, 1)>(vb);
    const s16x4 l2 = tr_read<v_rd_off(D0, 2, 0)>(vb), h2 = tr_read<v_rd_off(D0, 2, 1)>(vb), l3 = tr_read<v_rd_off(D0, 3, 0)>(vb), h3 = tr_read<v_rd_off(D0, 3, 1)>(vb);
    asm volatile("s_waitcnt lgkmcnt(0)" ::: "memory"); __builtin_amdgcn_sched_barrier(0);
#define PK(L, H) (bf16x8){L[0], L[1], L[2], L[3], H[0], H[1], H[2], H[3]}
    od = __builtin_amdgcn_mfma_f32_32x32x16_bf16(pa0, PK(l0, h0), od, 0, 0, 0);
    od = __builtin_amdgcn_mfma_f32_32x32x16_bf16(pa1, PK(l1, h1), od, 0, 0, 0);
    od = __builtin_amdgcn_mfma_f32_32x32x16_bf16(pa2, PK(l2, h2), od, 0, 0, 0);
    od = __builtin_amdgcn_mfma_f32_32x32x16_bf16(pa3, PK(l3, h3), od, 0, 0, 0);
#undef PK
}

__device__ __forceinline__ void att_tile(f32x16 (&o)[4], float& lsum, const unsigned char* Kb, int vb0, const unsigned char* Qw, int r32, int hi, int tq, int j, bool past, float slopeL2, float refL2) {
    constexpr float C = 0.125f * 1.4426950409f;
    bf16x8 qr[4];
#pragma unroll
    for (int d0 = 0; d0 < 4; ++d0) qr[d0] = *(const bf16x8*)(Qw + KSWZ64(r32, (d0 * 16 + hi * 8) * 2));
    const float dq = (float)(tq - 64 * j - 4 * hi);
    const float B0 = -slopeL2 * dq - refL2;
    float ps = 0.f;
    bf16x8 pa0, pa1, pa2, pa3;
#define PK4(P, BASE, OUT) do { unsigned a0 = cvtpk_bf16(P[BASE + 0], P[BASE + 1]), a1 = cvtpk_bf16(P[BASE + 2], P[BASE + 3]);   \
    unsigned b0_ = cvtpk_bf16(P[BASE + 4], P[BASE + 5]), b1_ = cvtpk_bf16(P[BASE + 6], P[BASE + 7]);                              \
    auto r0 = __builtin_amdgcn_permlane32_swap(a0, b0_, false, false); auto r1 = __builtin_amdgcn_permlane32_swap(a1, b1_, false, false); \
    u32x4 w = {r0[0], r1[0], r0[1], r1[1]}; OUT = __builtin_bit_cast(bf16x8, w); } while (0)
#define HALF_TILE(KOFF, FOFF, PA, PB) do { f32x16 pp = f32x16{};                                                                     \
    _Pragma("unroll") for (int d0 = 0; d0 < 4; ++d0) { const int cb = (d0 * 16 + hi * 8) * 2;                                        \
        const bf16x8 bk = *(const bf16x8*)(Kb + KSWZ64((KOFF) + r32, cb)); pp = __builtin_amdgcn_mfma_f32_32x32x16_bf16(bk, qr[d0], pp, 0, 0, 0); } \
    if (past) { _Pragma("unroll") for (int r = 0; r < 16; ++r) { const float off = (float)((r & 3) + 8 * (r >> 2)) + (FOFF);          \
            pp[r] = __builtin_amdgcn_exp2f(fmaf(pp[r], C, fmaf(slopeL2, off, B0))); } }                                               \
    else { _Pragma("unroll") for (int r = 0; r < 16; ++r) { const float off = (float)((r & 3) + 8 * (r >> 2)) + (FOFF);               \
            pp[r] = __builtin_amdgcn_exp2f(fmaf(pp[r], C, -slopeL2 * fabsf(dq - off) - refL2)); } }                                   \
    _Pragma("unroll") for (int r = 0; r < 16; ++r) ps += pp[r];                                                                       \
    PK4(pp, 0, PA); PK4(pp, 8, PB); __builtin_amdgcn_sched_barrier(0); } while (0)
    HALF_TILE(0, 0.f, pa0, pa1);
    HALF_TILE(32, 32.f, pa2, pa3);
#undef HALF_TILE
#undef PK4
    { auto rr = __builtin_amdgcn_permlane32_swap(__float_as_uint(ps), __float_as_uint(ps), false, false);
      ps = __uint_as_float(rr[0]) + __uint_as_float(rr[1]); }
    lsum += ps;
    pv_one<0>(o[0], vb0, pa0, pa1, pa2, pa3); pv_one<1>(o[1], vb0, pa0, pa1, pa2, pa3); pv_one<2>(o[2], vb0, pa0, pa1, pa2, pa3); pv_one<3>(o[3], vb0, pa0, pa1, pa2, pa3);
}
constexpr int ATT_LDS = 2 * 16384 + 2 * 8192 + 8 * 256 + 8 * 4096;

__device__ __forceinline__ void ph_attnA(const Params& p, unsigned char* lds, int vb, int nvb) {
    const bf16* PROJ = (const bf16*)(p.ws + WS_PROJ); bf16* MIX = (bf16*)(p.ws + WS_MIX);
    const float* SC = (const float*)(p.ws + WS_SCAL);
    const float lam = SC[SC_LAM], refL2 = SC[SC_MA] * 1.4426950409f;
    constexpr float C = 0.125f * 1.4426950409f;
    int tid = threadIdx.x; asm volatile("" : "+v"(tid)); const int lane = tid & 63, wid = __builtin_amdgcn_readfirstlane(tid >> 6), r32 = lane & 31, hi = lane >> 5;
    unsigned char* V_lds = lds; unsigned char* K_lds = lds + 32768;
    float* wsf = (float*)(lds + 49152) + wid * 64;
    GASF* tmpw = (GASF*)(p.ws + WS_ATMP) + ((size_t)(vb * NWV + wid) * 64) * 64 + lane;
    const int vbase = (int)(uintptr_t)V_lds + v_rd_base(lane);
    const int krow = tid >> 3, kch = tid & 7, kdst = KSWZ64(krow, kch * 16);
    const int sr = tid >> 4, sc = (tid & 15) * 8, vst0 = v_st(sr, sc), vst1 = v_st(32 + sr, sc);
    for (int it = vb; it < 256; it += nvb) {
        #if ATT_REMAP
        const int xg_ = it & 7, m_ = it >> 3, pidx = xg_ * 8 + (m_ >> 2), qbl = m_ & 3, b = pidx >> 2, h = pidx & 3;
#else
        const int b = it >> 4, h = (it >> 2) & 3, qbl = it & 3;
#endif
        const float slopeL2 = exp2f(-2.0f * (float)(h + 1)) * 1.4426950409f;
        const bf16* Pb = PROJ + (size_t)b * SEQ * NP;
#pragma unroll 1
        for (int half = 0; half < 2; ++half) {
            const int qb = half ? 7 - qbl : qbl, q0 = 256 * qb, NTu = 4 * (qb + 1), cw = 4 * qb + (wid >> 1);
            const int tq = q0 + 32 * wid + r32;
#pragma unroll 1
            for (int mi = 0; mi < 2; ++mi) {
                const int m = 1 - mi;
                const bf16* Kg = Pb + C_KA + h * 128 + m * 64 + (size_t)krow * NP + kch * 8;
                const bf16* Vg = Pb + C_VA + h * 128 + (size_t)sr * NP + sc;
                unsigned char* Qw = lds + 51200 + wid * 4096;
                { const bf16* qp = Pb + (size_t)tq * NP + C_QA + h * 128 + m * 64 + hi * 8;
#pragma unroll
                  for (int d0 = 0; d0 < 4; ++d0) *(bf16x8*)(Qw + KSWZ64(r32, (d0 * 16 + hi * 8) * 2)) = *(const bf16x8*)(qp + d0 * 16); }
                f32x16 o[4];
#pragma unroll
                for (int d = 0; d < 4; ++d) o[d] = f32x16{};
                float lsum = 0.f;
                bf16x8 ak, av0, av1;
#define ATT_LOAD(K_, V0_, V1_, TJ) do { const size_t go_ = (size_t)(TJ) * 64 * NP; K_ = *(const bf16x8*)(Kg + go_); V0_ = *(const bf16x8*)(Vg + go_); V1_ = *(const bf16x8*)(Vg + go_ + (size_t)32 * NP); \
        if (ATT_PROBE == 2) { bf16x8 d0_ = *(const volatile bf16x8*)(Kg + go_); bf16x8 d1_ = *(const volatile bf16x8*)(Vg + go_); bf16x8 d2_ = *(const volatile bf16x8*)(Vg + go_ + (size_t)32 * NP); asm volatile("" :: "v"(d0_), "v"(d1_), "v"(d2_)); } } while (0)
#define ATT_WRITE(K_, V0_, V1_, NB) do { *(bf16x8*)(K_lds + (NB) * 8192 + kdst) = K_; *(bf16x8*)(V_lds + (NB) * 16384 + vst0) = V0_; *(bf16x8*)(V_lds + (NB) * 16384 + vst1) = V1_; } while (0)
                ATT_LOAD(ak, av0, av1, 0); ATT_WRITE(ak, av0, av1, 0);
                __syncthreads();
#pragma unroll 1
                for (int j = 0; j < NTu; ++j) {
                    const int buf = j & 1;
                    if (j + 1 < NTu) ATT_LOAD(ak, av0, av1, j + 1);
                    if (j <= cw) { att_tile(o, lsum, K_lds + buf * 8192, vbase + buf * 16384, Qw, r32, hi, tq, j, j < cw, slopeL2, refL2);
#if ATT_PROBE == 1
                        { f32x16 o2[4]; o2[0] = o[0]; o2[1] = o[1]; o2[2] = o[2]; o2[3] = o[3]; float l2 = 0.f; att_tile(o2, l2, K_lds + buf * 8192, vbase + buf * 16384, Qw, r32, hi, tq, j, j < cw, slopeL2, refL2);
                          asm volatile("" :: "v"(o2[0]), "v"(o2[1]), "v"(o2[2]), "v"(o2[3]), "v"(l2)); }
#endif
                    }
                    if (j + 1 < NTu) ATT_WRITE(ak, av0, av1, buf ^ 1);
                    __syncthreads();
                }
#undef ATT_LOAD
#undef ATT_WRITE
                if (hi == 0) wsf[r32] = lsum;
                LDS_WAIT(); asm volatile("" ::: "memory");
                float rli[16];
#pragma unroll
                for (int r = 0; r < 16; ++r) rli[r] = 1.f / wsf[crow(r, hi)];
                LDS_WAIT(); asm volatile("" ::: "memory");
                if (mi == 0) {
#pragma unroll
                    for (int d = 0; d < 4; ++d) { GASF* td = tmpw + d * 1024; asm volatile("" : "+v"(td));
#pragma unroll
                        for (int r = 0; r < 16; ++r) td[r * 64] = o[d][r] * rli[r]; }
                } else {
                    float gsub[4];
#pragma unroll
                    for (int d = 0; d < 4; ++d) gsub[d] = p.a_sub_gain[32 * d + r32];
                    GASF* tdp[4];
#pragma unroll
                    for (int d = 0; d < 4; ++d) { tdp[d] = tmpw + d * 1024; asm volatile("" : "+v"(tdp[d])); }
#pragma unroll
                    for (int r = 0; r < 16; ++r) {
                        float v[4]; float ss = 0.f;
#pragma unroll
                        for (int d = 0; d < 4; ++d) { v[d] = o[d][r] * rli[r] - lam * tdp[d][r * 64]; ss += v[d] * v[d]; }
                        ss += __shfl_xor(ss, 1); ss += __shfl_xor(ss, 2); ss += __shfl_xor(ss, 4); ss += __shfl_xor(ss, 8); ss += __shfl_xor(ss, 16);
                        const float rs = rsqrtf(ss * (1.f / 128.f) + EPS) * 0.8f;
                        bf16* orow = MIX + (size_t)(b * SEQ + q0 + 32 * wid + crow(r, hi)) * MIXW + h * 128 + r32;
#pragma unroll
                        for (int d = 0; d < 4; ++d) orow[32 * d] = (bf16)f2bf(v[d] * rs * gsub[d]);
                        asm volatile("" ::: "memory");
                    }
                }
            }
        }
    }
}
constexpr int RT_WAVE_BYTES = 12288;
constexpr int RT_LDS = 32768 + 8 * RT_WAVE_BYTES;

__device__ __forceinline__ int pl32_sum(int v) { auto rr = __builtin_amdgcn_permlane32_swap((unsigned)v, (unsigned)v, false, false); return (int)(rr[0] + rr[1]); }
__device__ __forceinline__ int pl32_other(int v) { auto rr = __builtin_amdgcn_permlane32_swap((unsigned)v, (unsigned)v, false, false); return (int)(rr[0] + rr[1]) - v; }
__device__ __forceinline__ float unsortkey(unsigned k) { return __uint_as_float((k & 0x80000000u) ? (k ^ 0x80000000u) : ~k); }

template <int N> __device__ __forceinline__ unsigned bisect16(const unsigned (&key)[N]) {
    unsigned prefix = 0u; bool done = false;
#pragma unroll 1
    for (int bit = 31; bit >= 0; --bit) {
        const unsigned cand = done ? prefix : (prefix | (1u << bit));
        int cnt = 0;
#pragma unroll
        for (int i = 0; i + 3 < N; i += 4) cnt_ge4(cnt, key[i], key[i + 1], key[i + 2], key[i + 3], cand);
#pragma unroll
        for (int i = N & ~3; i < N; ++i) cnt += (key[i] >= cand) ? 1 : 0;
        const int tot = pl32_sum(cnt);
        if (!done && tot >= 16) { prefix = cand; done = (tot == 16); }
        if (__all(done)) break;
    }
    return prefix;
}

__device__ __forceinline__ void ph_route(const Params& p, unsigned char* lds, int vb, int nvb) {
    const bf16* Q3 = (const bf16*)(p.ws + WS_Q3); const bf16* SUBK = (const bf16*)(p.ws + WS_SUBK);
    int* EXPI = (int*)(p.ws + WS_EXP); float* GATE = (float*)(p.ws + WS_GATE);
    int tid = threadIdx.x; asm volatile("" : "+v"(tid));
    const int lane = tid & 63, wv = __builtin_amdgcn_readfirstlane(tid >> 6), r32 = lane & 31, hi = lane >> 5;
    for (int i = tid; i < 2048; i += NT) { const int row = i >> 3, ch = i & 7; ((u32x4*)lds)[row * 8 + (ch ^ ((row >> 1) & 7))] = ((const u32x4*)SUBK)[i]; }
    __syncthreads();
    unsigned char* wl = lds + 32768 + wv * RT_WAVE_BYTES;
    float* sv = (float*)wl; int* si = (int*)(wl + 4096); float* fv = (float*)(wl + 8192); int* fe = (int*)(wl + 10240);
    const int gw = vb * NWV + wv, ngw = nvb * NWV;
    for (int item = gw; item < (T / 32) * 8; item += ngw) {
        const int h = item & 7, tok0 = (item >> 3) * 32;
        const bf16* qrow = Q3 + (size_t)(tok0 + r32) * 1024 + h * 128 + hi * 8;
#pragma unroll 1
        for (int c = 0; c < 2; ++c) {
            bf16x8 bq[4];
#pragma unroll
            for (int d0 = 0; d0 < 4; ++d0) bq[d0] = *(const bf16x8*)(qrow + c * 64 + d0 * 16);
            unsigned key[64];
#pragma unroll
            for (int nt = 0; nt < 4; ++nt) {
                f32x16 acc = f32x16{};
                const int krow = c * 128 + nt * 32 + r32, ksw = (krow >> 1) & 7;
                const unsigned char* kp = lds + krow * 128;
#pragma unroll
                for (int d0 = 0; d0 < 4; ++d0) { const bf16x8 ak = *(const bf16x8*)(kp + (((2 * d0 + hi) ^ ksw) << 4)); acc = __builtin_amdgcn_mfma_f32_32x32x16_bf16(ak, bq[d0], acc, 0, 0, 0); }
#pragma unroll
                for (int r = 0; r < 16; ++r) key[nt * 16 + r] = sortkey(acc[r]);
            }
            const unsigned thr = bisect16<64>(key);
            int cnt = 0;
#pragma unroll
            for (int i = 0; i < 64; ++i) cnt += (key[i] >= thr) ? 1 : 0;
            const int other_ = pl32_other(cnt); int slot = hi ? other_ : 0;
            float* svp = sv + (r32 * 2 + c) * 16; int* sip = si + (r32 * 2 + c) * 16;
#pragma unroll
            for (int i = 0; i < 64; ++i) {
                if (key[i] >= thr && slot < 16) { svp[slot] = unsortkey(key[i]); sip[slot] = 32 * (i >> 4) + ((i & 3) + 8 * ((i & 15) >> 2)) + 4 * hi; ++slot; }
            }
        }
        LDS_WAIT(); asm volatile("" ::: "memory");
        {
            float* sv0 = sv + (r32 * 2) * 16; float* sv1 = sv0 + 16; int* si0 = si + (r32 * 2) * 16; int* si1 = si0 + 16;
            {
                float a[16], bl[16];
#pragma unroll
                for (int k = 0; k < 16; ++k) { a[k] = sv0[k]; bl[k] = sv1[k]; }
                int ia[8], ib[8], ra[8], rb[8]; float va[8], vb[8];
#pragma unroll
                for (int q = 0; q < 8; ++q) { const int e = 8 * hi + q; va[q] = sv0[e]; vb[q] = sv1[e]; ia[q] = si0[e]; ib[q] = si1[e]; int r0 = 0, r1 = 0;
#pragma unroll
                    for (int k = 0; k < 16; ++k) { r0 += (a[k] > va[q] || (a[k] == va[q] && k < e)) ? 1 : 0; r1 += (bl[k] > vb[q] || (bl[k] == vb[q] && k < e)) ? 1 : 0; }
                    ra[q] = r0; rb[q] = r1; }
                LDS_WAIT(); asm volatile("" ::: "memory");
                { auto rr = __builtin_amdgcn_permlane32_swap(0u, 0u, false, false); (void)rr; }
#pragma unroll
                for (int q = 0; q < 8; ++q) { sv0[ra[q]] = va[q]; si0[ra[q]] = ia[q]; sv1[rb[q]] = vb[q]; si1[rb[q]] = ib[q]; }
                LDS_WAIT(); asm volatile("" ::: "memory");
            }
            const float* X = hi ? sv1 : sv0; const float* Y = hi ? sv0 : sv1;
            float x[4], y[16];
#pragma unroll
            for (int k = 0; k < 4; ++k) x[k] = X[k];
#pragma unroll
            for (int k = 0; k < 16; ++k) y[k] = Y[k];
            unsigned key[27]; int pi[27], pj[27]; int np = 0;
#pragma unroll
            for (int i = 0; i < 3; ++i)
#pragma unroll
                for (int j = i + 1; j < 16; ++j) if ((i + 1) * (j + 1) <= 16) { key[np] = sortkey(x[i] + y[j]); pi[np] = i; pj[np] = j; ++np; }
#pragma unroll
            for (int i = 0; i < 4; ++i) { key[23 + i] = hi ? 0u : sortkey(x[i] + y[i]); pi[23 + i] = i; pj[23 + i] = i; }
            const unsigned thr = bisect16<27>(key);
            int cnt = 0;
#pragma unroll
            for (int i = 0; i < 27; ++i) cnt += (key[i] >= thr) ? 1 : 0;
            const int other_ = pl32_other(cnt); int slot = hi ? other_ : 0;
            const int* IX = hi ? si1 : si0; const int* IY = hi ? si0 : si1;
            float* fvp = fv + r32 * 16; int* fep = fe + r32 * 16;
#pragma unroll
            for (int i = 0; i < 27; ++i) {
                if (key[i] >= thr && slot < 16) { const int ex = IX[pi[i]], ey = IY[pj[i]]; fvp[slot] = unsortkey(key[i]); fep[slot] = hi ? (ey * 128 + ex) : (ex * 128 + ey); ++slot; }
            }
        }
        LDS_WAIT(); asm volatile("" ::: "memory");
        {
            const float* fvp = fv + r32 * 16;
            float v[16]; float mx = -3e38f;
#pragma unroll
            for (int k = 0; k < 16; ++k) { v[k] = fvp[k]; mx = fmaxf(mx, v[k]); }
            float l = 0.f;
#pragma unroll
            for (int k = 0; k < 16; ++k) { v[k] = __expf(v[k] - mx); l += v[k]; }
            const float il = 1.f / l;
            const size_t ob = (size_t)(tok0 + r32) * 128 + h * 16 + 8 * hi;
            const int* fep = fe + r32 * 16 + 8 * hi;
            f32x4 g0, g1; u32x4 e0, e1;
            if (hi == 0) { g0 = (f32x4){v[0] * il, v[1] * il, v[2] * il, v[3] * il}; g1 = (f32x4){v[4] * il, v[5] * il, v[6] * il, v[7] * il}; }
            else { g0 = (f32x4){v[8] * il, v[9] * il, v[10] * il, v[11] * il}; g1 = (f32x4){v[12] * il, v[13] * il, v[14] * il, v[15] * il}; }
            e0 = *(const u32x4*)fep; e1 = *(const u32x4*)(fep + 4);
            *(f32x4*)(GATE + ob) = g0; *(f32x4*)(GATE + ob + 4) = g1;
            *(u32x4*)(EXPI + ob) = e0; *(u32x4*)(EXPI + ob + 4) = e1;
        }
        LDS_WAIT(); asm volatile("" ::: "memory");
    }
    __syncthreads();
}
typedef float f32x2_t __attribute__((ext_vector_type(2)));
constexpr int P8_UNITS = T / 64;
constexpr int CW_P8_U = 4096, CW_P8_V = 4096 + 32 * 64;
constexpr float U8_SCALE = 32.0f;
__device__ __forceinline__ unsigned peer_xcc() { return (unsigned)__builtin_amdgcn_s_getreg((3 << 11) | 20) & 7u; }
#ifndef U8_HALVES
#define U8_HALVES 0
#endif
template <int LPR>
__device__ __forceinline__ void ph_peer_v8g(const Params& p, unsigned char* lds) {
    constexpr int RPI = 64 / LPR, NI = 128 / RPI, G = NI / 8, NS = 64 / LPR, SLB = 16 * LPR;
    const unsigned char* V8 = (const unsigned char*)(p.ws + WS_V16);
    const int* EXPI = (const int*)(p.ws + WS_EXP); const float* CBUF = (const float*)(p.ws + WS_CBUF); const float* MOD = (const float*)(p.ws + WS_MOD);
    const float* AB1 = (const float*)(p.ws + WS_ABUF1); const float* GATEP = (const float*)(p.ws + WS_GATE); (void)AB1; (void)GATEP;
    unsigned* ctl = (unsigned*)(p.ws + WS_CTL);
    int tid = threadIdx.x; asm volatile("" : "+v"(tid));
    const int lane = tid & 63, wv = __builtin_amdgcn_readfirstlane(tid >> 6), gR = lane / LPR, iC = lane % LPR;
    volatile LAS unsigned* slot = (volatile LAS unsigned*)(LAS unsigned char*)lds;
    const unsigned xcc = peer_xcc();
#pragma unroll 1
    for (int k = 0; k < NS; ++k) {
        const int sl = (int)((((xcc * NS) >> 3) + (unsigned)k) % (unsigned)NS);
        const unsigned char* vcol = V8 + SLB * sl + 16 * iC;
#pragma unroll 1
        for (;;) {
            if (tid == 0) *slot = __hip_atomic_fetch_add(ctl + CW_P8_V + 64 * sl, 1u, __ATOMIC_RELAXED, __HIP_MEMORY_SCOPE_AGENT);
            __syncthreads();
            const unsigned unit = *slot;
            __syncthreads();
            if (unit >= (unsigned)P8_UNITS) break;
            const int tbase = (int)unit * 64 + wv * 8;
            int ne0, ne1; float nc0, nc1;
#if U8_HALVES
#define VG_FETCH(T) do { const size_t tn_ = (size_t)(T); ne0 = EXPI[tn_ * 128 + lane]; ne1 = EXPI[tn_ * 128 + 64 + lane];                              \
        nc0 = gelu_erf(CBUF[tn_ * 128 + lane] + AB1[tn_ * 128 + lane]) * GATEP[tn_ * 128 + lane];                                              \
        nc1 = gelu_erf(CBUF[tn_ * 128 + 64 + lane] + AB1[tn_ * 128 + 64 + lane]) * GATEP[tn_ * 128 + 64 + lane]; } while (0)
#else
#define VG_FETCH(T) do { const size_t tn_ = (size_t)(T); ne0 = EXPI[tn_ * 128 + lane]; ne1 = EXPI[tn_ * 128 + 64 + lane]; nc0 = CBUF[tn_ * 128 + lane]; nc1 = CBUF[tn_ * 128 + 64 + lane]; } while (0)
#endif
#define VG_LISTS(LE, LC) do { LE[lane] = ne0; LE[64 + lane] = ne1; LC[lane] = nc0; LC[64 + lane] = nc1; } while (0)
#define VG_ROWS(R, LE, GI) do { _Pragma("unroll") for (int kk = 0; kk < 8; ++kk) R[kk] = *(const u32x4*)(vcol + (size_t)LE[RPI * (8 * (GI) + kk) + gR] * 1024); } while (0)
#define VG_GROUP(R, LC, GI) do { _Pragma("unroll") for (int kk = 0; kk < 8; ++kk) { const float cj = LC[RPI * (8 * (GI) + kk) + gR];                       \
            const unsigned w_[4] = {R[kk].x, R[kk].y, R[kk].z, R[kk].w};                                                                       \
            _Pragma("unroll") for (int c = 0; c < 4; ++c) { const f32x2_t lo = __builtin_amdgcn_cvt_pk_f32_fp8((int)w_[c], false), hi = __builtin_amdgcn_cvt_pk_f32_fp8((int)w_[c], true); \
                acc[4 * c] = fmaf(cj, lo.x, acc[4 * c]); acc[4 * c + 1] = fmaf(cj, lo.y, acc[4 * c + 1]); acc[4 * c + 2] = fmaf(cj, hi.x, acc[4 * c + 2]); acc[4 * c + 3] = fmaf(cj, hi.y, acc[4 * c + 3]); } } } while (0)
            u32x4 RA[8], RB[8];
            int* lecur = (int*)(lds + 1024 + wv * 2048); int* lenxt = lecur + 256;
            VG_FETCH(tbase); VG_LISTS(lecur, ((float*)(lecur + 128))); VG_FETCH(tbase + 1);
            LDS_WAIT(); asm volatile("" ::: "memory");
            VG_ROWS(RA, lecur, 0);
#pragma unroll 1
            for (int tt = 0; tt < 8; ++tt) {
                const int t = tbase + tt;
                float* lccur = (float*)(lecur + 128); float* lcnxt = (float*)(lenxt + 128);
                float acc[16];
#pragma unroll
                for (int q = 0; q < 16; ++q) acc[q] = 0.f;
                if (tt + 1 < 8) { VG_LISTS(lenxt, lcnxt); if (tt + 2 < 8) VG_FETCH(t + 2); }
#pragma unroll 1
                for (int gi = 0; gi < G; gi += 2) {
                    VG_ROWS(RB, lecur, gi + 1);
                    VG_GROUP(RA, lccur, gi);
                    if (gi + 2 < G) VG_ROWS(RA, lecur, gi + 2);
                    else if (tt + 1 < 8) { LDS_WAIT(); asm volatile("" ::: "memory"); VG_ROWS(RA, lenxt, 0); }
                    VG_GROUP(RB, lccur, gi + 1);
                }
#pragma unroll
                for (int q = 0; q < 16; ++q) { if (LPR <= 8) acc[q] += dpp_f<0x128>(acc[q]); if (LPR <= 16) acc[q] += __shfl_xor(acc[q], 16); if (LPR <= 32) acc[q] += __shfl_xor(acc[q], 32); }
                if (gR == 0) { const int col = SLB * sl + 16 * iC; const float* g2 = MOD + (size_t)(t >> 11) * 6144 + 5120 + col; float* orow = p.out + (size_t)t * 1024 + col;
#pragma unroll
                    for (int q = 0; q < 4; ++q) { const f32x4 xv = *(const f32x4*)(orow + 4 * q), hv = *(const f32x4*)(g2 + 4 * q);
                        f32x4 r; r.x = acc[4 * q]; r.y = acc[4 * q + 1]; r.z = acc[4 * q + 2]; r.w = acc[4 * q + 3]; *(f32x4*)(orow + 4 * q) = xv + hv * r; } }
                { int* tmp_ = lecur; lecur = lenxt; lenxt = tmp_; }
            }
#undef VG_FETCH
#undef VG_LISTS
#undef VG_ROWS
#undef VG_GROUP
            LDS_WAIT(); asm volatile("" ::: "memory");
        }
    }
}
#ifndef PEER_SORT
#define PEER_SORT 1
#endif
__device__ __forceinline__ void ph_peer_u8p(const Params& p, unsigned char* lds_w, int gw, int ngw, int lane_) {
    int lane = lane_; asm volatile("" : "+v"(lane));
    const bf16* H = (const bf16*)(p.ws + WS_H); const unsigned char* U8 = (const unsigned char*)(p.ws + WS_U16); const unsigned char* V8 = (const unsigned char*)(p.ws + WS_V16);
    const int* EXPI = (const int*)(p.ws + WS_EXP); const float* GATE = (const float*)(p.ws + WS_GATE); const float* MOD = (const float*)(p.ws + WS_MOD);
    int* e_lds = (int*)lds_w; float* a_lds = (float*)(lds_w + 512); float* g_lds = (float*)(lds_w + 1024); (void)g_lds;
    const int g = lane >> 4, i = lane & 15;
#pragma unroll 1
    for (int t = gw; t < T; t += ngw) {
        int e0 = EXPI[(size_t)t * 128 + lane], e1 = EXPI[(size_t)t * 128 + 64 + lane];
        float g0 = GATE[(size_t)t * 128 + lane], g1 = GATE[(size_t)t * 128 + 64 + lane];
#if PEER_SORT
        {
            const int d0 = e0 >> 11, d1 = e1 >> 11; int pos0 = 0, pos1 = 0, run = 0;
#pragma unroll
            for (int d = 0; d < 8; ++d) {
                const unsigned long long m0 = __ballot(d0 == d), m1 = __ballot(d1 == d);
                const int c0 = __popcll(m0), c1 = __popcll(m1);
                const int r0 = (int)__builtin_amdgcn_mbcnt_hi((unsigned)(m0 >> 32), __builtin_amdgcn_mbcnt_lo((unsigned)m0, 0u));
                const int r1 = (int)__builtin_amdgcn_mbcnt_hi((unsigned)(m1 >> 32), __builtin_amdgcn_mbcnt_lo((unsigned)m1, 0u));
                pos0 = (d0 == d) ? run + r0 : pos0; pos1 = (d1 == d) ? run + c0 + r1 : pos1; run += c0 + c1;
            }
            e_lds[pos0] = e0; e_lds[pos1] = e1; g_lds[pos0] = g0; g_lds[pos1] = g1;
            LDS_WAIT(); asm volatile("" ::: "memory");
            e0 = e_lds[lane]; e1 = e_lds[64 + lane]; g0 = g_lds[lane]; g1 = g_lds[64 + lane];
            int* EW = (int*)(p.ws + WS_EXP) + (size_t)t * 128; EW[lane] = e0; EW[64 + lane] = e1;
        }
#else
        e_lds[lane] = e0; e_lds[64 + lane] = e1;
#endif
        float xf[64];
        { const u32x4* xrow = (const u32x4*)(H + (size_t)t * 1024) + 2 * i;
#pragma unroll
          for (int q = 0; q < 4; ++q) { const u32x4 a = xrow[32 * q], b = xrow[32 * q + 1];
              xf[16 * q] = bflo(a.x); xf[16 * q + 1] = bfhi(a.x); xf[16 * q + 2] = bflo(a.y); xf[16 * q + 3] = bfhi(a.y); xf[16 * q + 4] = bflo(a.z); xf[16 * q + 5] = bfhi(a.z); xf[16 * q + 6] = bflo(a.w); xf[16 * q + 7] = bfhi(a.w);
              xf[16 * q + 8] = bflo(b.x); xf[16 * q + 9] = bfhi(b.x); xf[16 * q + 10] = bflo(b.y); xf[16 * q + 11] = bfhi(b.y); xf[16 * q + 12] = bflo(b.z); xf[16 * q + 13] = bfhi(b.z); xf[16 * q + 14] = bflo(b.w); xf[16 * q + 15] = bfhi(b.w); } }
        LDS_WAIT(); asm volatile("" ::: "memory");
#define P8T_ULOAD(R, S) do { const u32x4* r_ = (const u32x4*)(U8 + (size_t)e_lds[4 * (S) + g] * 1024) + i; _Pragma("unroll") for (int q = 0; q < 4; ++q) R[q] = r_[16 * q]; } while (0)
#define P8T_UDOT(R, S) do { float a0 = 0.f, a1 = 0.f, a2 = 0.f, a3 = 0.f;                                                                               \
        _Pragma("unroll") for (int q = 0; q < 4; ++q) { const unsigned w_[4] = {R[q].x, R[q].y, R[q].z, R[q].w};                                           \
            _Pragma("unroll") for (int c = 0; c < 4; ++c) { const f32x2_t lo = __builtin_amdgcn_cvt_pk_f32_fp8((int)w_[c], false), hi = __builtin_amdgcn_cvt_pk_f32_fp8((int)w_[c], true); \
                a0 = fmaf(lo.x, xf[16 * q + 4 * c], a0); a1 = fmaf(lo.y, xf[16 * q + 4 * c + 1], a1); a2 = fmaf(hi.x, xf[16 * q + 4 * c + 2], a2); a3 = fmaf(hi.y, xf[16 * q + 4 * c + 3], a3); } } \
        const float a_ = row16_sum((a0 + a1) + (a2 + a3)) * (1.0f / U8_SCALE); if (i == 0) a_lds[4 * (S) + g] = a_; } while (0)
        { u32x4 RA[4], RB[4], RC[4];
          P8T_ULOAD(RA, 0); P8T_ULOAD(RB, 1);
#pragma unroll 1
          for (int s = 0; s < 30; s += 3) {
              P8T_ULOAD(RC, s + 2); P8T_UDOT(RA, s);
              P8T_ULOAD(RA, s + 3); P8T_UDOT(RB, s + 1);
              P8T_ULOAD(RB, s + 4); P8T_UDOT(RC, s + 2);
          }
          P8T_UDOT(RA, 30); P8T_UDOT(RB, 31); }
#undef P8T_ULOAD
#undef P8T_UDOT
        LDS_WAIT(); asm volatile("" ::: "memory");
        const float c0 = gelu_erf(a_lds[lane]) * g0, c1 = gelu_erf(a_lds[64 + lane]) * g1;
        float* CB = (float*)(p.ws + WS_CBUF) + (size_t)t * 128; CB[lane] = c0; CB[64 + lane] = c1;
    }
}
__device__ __forceinline__ void ph_peer_u8h(const Params& p, unsigned char* lds) {
    const bf16* H = (const bf16*)(p.ws + WS_H); const unsigned char* U8 = (const unsigned char*)(p.ws + WS_U16);
    const int* EXPI = (const int*)(p.ws + WS_EXP);
    unsigned* ctl = (unsigned*)(p.ws + WS_CTL);
    int tid = threadIdx.x; asm volatile("" : "+v"(tid));
    const int lane = tid & 63, wv = __builtin_amdgcn_readfirstlane(tid >> 6), hw = lane >> 5, i5 = lane & 31;
    volatile LAS unsigned* slot = (volatile LAS unsigned*)(LAS unsigned char*)lds;
    float* a_lds = (float*)(lds + 1024 + wv * 2048 + 1024);
    const unsigned xcc = peer_xcc();
#pragma unroll 1
    for (int k = 0; k < 2; ++k) {
        const int sl = (int)(((xcc >> 2) + (unsigned)k) & 1u);
        float* AB = (float*)(p.ws + (sl ? WS_ABUF1 : WS_CBUF));
        const unsigned char* ucol = U8 + 512 * sl + 16 * i5;
#pragma unroll 1
        for (;;) {
            if (tid == 0) *slot = __hip_atomic_fetch_add(ctl + CW_P8_U + 64 * sl, 1u, __ATOMIC_RELAXED, __HIP_MEMORY_SCOPE_AGENT);
            __syncthreads();
            const unsigned unit = *slot;
            __syncthreads();
            if (unit >= (unsigned)P8_UNITS) break;
            const int tbase = (int)unit * 64 + wv * 8;
            int ne0, ne1; u32x4 nx0, nx1;
#define UH_FETCH(T) do { const size_t tn_ = (size_t)(T); ne0 = EXPI[tn_ * 128 + lane]; ne1 = EXPI[tn_ * 128 + 64 + lane];                          \
        const u32x4* xr_ = (const u32x4*)(H + tn_ * 1024 + 512 * sl) + 2 * i5; nx0 = xr_[0]; nx1 = xr_[1]; } while (0)
#define UH_LISTS(LE) do { LE[lane] = ne0; LE[64 + lane] = ne1; } while (0)
#define UH_ROWS(R, LE, GI) do { _Pragma("unroll") for (int kk = 0; kk < 8; ++kk) R[kk] = *(const u32x4*)(ucol + (size_t)LE[2 * (8 * (GI) + kk) + hw] * 1024); } while (0)
#define UH_GROUP(R, GI) do { _Pragma("unroll") for (int kk = 0; kk < 8; ++kk) { float a0 = 0.f, a1 = 0.f, a2 = 0.f, a3 = 0.f;                         \
            const unsigned w_[4] = {R[kk].x, R[kk].y, R[kk].z, R[kk].w};                                                                       \
            _Pragma("unroll") for (int c = 0; c < 4; ++c) { const f32x2_t lo = __builtin_amdgcn_cvt_pk_f32_fp8((int)w_[c], false), hi = __builtin_amdgcn_cvt_pk_f32_fp8((int)w_[c], true); \
                a0 = fmaf(lo.x, xf[4 * c], a0); a1 = fmaf(lo.y, xf[4 * c + 1], a1); a2 = fmaf(hi.x, xf[4 * c + 2], a2); a3 = fmaf(hi.y, xf[4 * c + 3], a3); }                        \
            float s_ = row16_sum((a0 + a1) + (a2 + a3)); s_ += __shfl_xor(s_, 16);                                                              \
            if (i5 == 0) a_lds[2 * (8 * (GI) + kk) + hw] = s_ * (1.0f / U8_SCALE); } } while (0)
            u32x4 RA[8], RB[8];
            int* lecur = (int*)(lds + 1024 + wv * 2048); int* lenxt = lecur + 128;
            UH_FETCH(tbase); UH_LISTS(lecur);
            float xf[16];
#define UH_XF() do { xf[0] = bflo(nx0.x); xf[1] = bfhi(nx0.x); xf[2] = bflo(nx0.y); xf[3] = bfhi(nx0.y); xf[4] = bflo(nx0.z); xf[5] = bfhi(nx0.z); xf[6] = bflo(nx0.w); xf[7] = bfhi(nx0.w); \
        xf[8] = bflo(nx1.x); xf[9] = bfhi(nx1.x); xf[10] = bflo(nx1.y); xf[11] = bfhi(nx1.y); xf[12] = bflo(nx1.z); xf[13] = bfhi(nx1.z); xf[14] = bflo(nx1.w); xf[15] = bfhi(nx1.w); } while (0)
            UH_XF();
            UH_FETCH(tbase + 1);
            LDS_WAIT(); asm volatile("" ::: "memory");
            UH_ROWS(RA, lecur, 0);
#pragma unroll 1
            for (int tt = 0; tt < 8; ++tt) {
                const int t = tbase + tt;
                float xn[16];
                if (tt + 1 < 8) { UH_LISTS(lenxt);
#pragma unroll
                    for (int q = 0; q < 16; ++q) xn[q] = 0.f;
                    xn[0] = bflo(nx0.x); xn[1] = bfhi(nx0.x); xn[2] = bflo(nx0.y); xn[3] = bfhi(nx0.y); xn[4] = bflo(nx0.z); xn[5] = bfhi(nx0.z); xn[6] = bflo(nx0.w); xn[7] = bfhi(nx0.w);
                    xn[8] = bflo(nx1.x); xn[9] = bfhi(nx1.x); xn[10] = bflo(nx1.y); xn[11] = bfhi(nx1.y); xn[12] = bflo(nx1.z); xn[13] = bfhi(nx1.z); xn[14] = bflo(nx1.w); xn[15] = bfhi(nx1.w);
                    if (tt + 2 < 8) UH_FETCH(t + 2); }
#pragma unroll 1
                for (int gi = 0; gi < 8; gi += 2) {
                    UH_ROWS(RB, lecur, gi + 1);
                    UH_GROUP(RA, gi);
                    if (gi + 2 < 8) UH_ROWS(RA, lecur, gi + 2);
                    else if (tt + 1 < 8) { LDS_WAIT(); asm volatile("" ::: "memory"); UH_ROWS(RA, lenxt, 0); }
                    UH_GROUP(RB, gi + 1);
                }
                LDS_WAIT(); asm volatile("" ::: "memory");
                { float* ab = AB + (size_t)t * 128; ab[lane] = a_lds[lane]; ab[64 + lane] = a_lds[64 + lane]; }
                LDS_WAIT(); asm volatile("" ::: "memory");
                if (tt + 1 < 8) {
#pragma unroll
                    for (int q = 0; q < 16; ++q) xf[q] = xn[q]; }
                { int* tmp_ = lecur; lecur = lenxt; lenxt = tmp_; }
            }
#undef UH_FETCH
#undef UH_LISTS
#undef UH_ROWS
#undef UH_GROUP
#undef UH_XF
        }
    }
}
#define XB_TMO      128
#define XB_XCNT(j)  (256  + 64 * (j))
#define XB_XSUB(j)  (1280 + 64 * (j))
#define XB_XGEN(j)  (2304 + 64 * (j))
#define XB_TOP      3328
#define XB_TOPGEN   3392
#define XCD_BAR_WORDS 3456
#define XB_SPIN_CAP (1u << 18)

__device__ __forceinline__ unsigned xb_ld(unsigned* p)              { return __hip_atomic_load(p, __ATOMIC_RELAXED, __HIP_MEMORY_SCOPE_AGENT); }
__device__ __forceinline__ unsigned xb_add(unsigned* p, unsigned v) { return __hip_atomic_fetch_add(p, v, __ATOMIC_RELAXED, __HIP_MEMORY_SCOPE_AGENT); }
__device__ __forceinline__ unsigned xb_xcc_id() { return (unsigned)__builtin_amdgcn_s_getreg((3 << 11) | 20) & 0xFu; }
#define XB_SPIN(cond, bar) do { unsigned _sp = 0; while (cond) { __builtin_amdgcn_s_sleep(1); \
    if ((++_sp & 255u) == 0u) { if (xb_ld(&(bar)[XB_TMO])) break; if (_sp > XB_SPIN_CAP) { atomicAdd(&(bar)[XB_TMO], 1u); break; } } } } while (0)

struct XcdBarrier {
    unsigned* bar; unsigned x;
    volatile LAS unsigned* st;
};

__device__ __forceinline__ XcdBarrier xcd_barrier_post(unsigned* bar, volatile LAS unsigned* st) {
    XcdBarrier b; b.bar = bar; b.x = xb_xcc_id(); b.st = st;
    if (threadIdx.x == 0) (void)xb_add(&bar[XB_XCNT(b.x)], 1u);
    return b;
}
__device__ __forceinline__ void xcd_barrier_complete(unsigned* bar, unsigned x, unsigned& nloc, unsigned& nx) {
    const unsigned G = gridDim.x * gridDim.y * gridDim.z;
    unsigned sum, cnt, mine, sp = 0u;
    for (;;) {
        sum = 0u; cnt = 0u; mine = 0u;
#pragma unroll
        for (unsigned j = 0; j < 16; ++j) { const unsigned c = xb_ld(&bar[XB_XCNT(j)]); sum += c; cnt += (c > 0u) ? 1u : 0u; mine = (j == x) ? c : mine; }
        if (sum == G) break;
        __builtin_amdgcn_s_sleep(1);
        if ((++sp & 255u) == 0u) { if (xb_ld(&bar[XB_TMO])) break; if (sp > XB_SPIN_CAP) { atomicAdd(&bar[XB_TMO], 1u); break; } }
    }
    nloc = mine > 0u ? mine : 1u; nx = cnt > 0u ? cnt : 1u;
}

__device__ __forceinline__ void xcd_barrier(const XcdBarrier& b) {
    asm volatile("s_waitcnt vmcnt(0)" ::: "memory");
    __syncthreads();
    if (threadIdx.x == 0) {
        unsigned* bar = b.bar;
        __builtin_amdgcn_s_waitcnt(0);
        unsigned nloc = b.st[0], nx = b.st[1];
        if (nloc == 0u) { xcd_barrier_complete(bar, b.x, nloc, nx); b.st[0] = nloc; b.st[1] = nx; }
        const unsigned old = xb_add(&bar[XB_XSUB(b.x)], 1u);
        const unsigned gen = old / nloc;
        if (old + 1u == (gen + 1u) * nloc) {
            __builtin_amdgcn_fence(__ATOMIC_RELEASE, "agent");
            asm volatile("s_waitcnt vmcnt(0)" ::: "memory");
            const unsigned og = xb_add(&bar[XB_TOP], 1u);
            const unsigned tg = og / nx;
            if (og + 1u == (tg + 1u) * nx) xb_add(&bar[XB_TOPGEN], 1u);
            else XB_SPIN(xb_ld(&bar[XB_TOPGEN]) == tg, bar);
            __builtin_amdgcn_fence(__ATOMIC_ACQUIRE, "agent");
            xb_add(&bar[XB_XGEN(b.x)], 1u);
            asm volatile("s_waitcnt vmcnt(0)" ::: "memory");
        } else {
            XB_SPIN(xb_ld(&bar[XB_XGEN(b.x)]) == gen, bar);
            __builtin_amdgcn_fence(__ATOMIC_ACQUIRE, "agent");
            asm volatile("s_waitcnt vmcnt(0)" ::: "memory");
        }
    }
    __syncthreads();
}

#ifndef V8_LPR
#define V8_LPR 32
#endif
constexpr int LDS_BYTES = 147456;
extern __shared__ __attribute__((aligned(16))) unsigned char dyn_lds[];

__global__ void __launch_bounds__(NT, 2) mega_fwd(Params p) {
    cg::grid_group grid = cg::this_grid();
    const int vb = blockIdx.x, nvb = gridDim.x, ngw = nvb * NWV;
    volatile LAS unsigned* xst = (volatile LAS unsigned*)((LAS unsigned char*)dyn_lds + (LDS_BYTES - 16));
    if (threadIdx.x < 4) xst[threadIdx.x] = 0u;
    __syncthreads();
    const XcdBarrier xbar = xcd_barrier_post((unsigned*)(p.ws + WS_CTL), xst);
#define TID_LAUNDER int tid_ = threadIdx.x; asm volatile("" : "+v"(tid_)); const int lane = tid_ & 63, wv = tid_ >> 6, gw = vb * NWV + wv; (void)lane; (void)gw;
    grid.sync();
    ph_mod(p, (float*)dyn_lds, vb, nvb);
    { TID_LAUNDER ph_prep_weights(p, (LAS float*)dyn_lds + wv * (64 * 33), gw, ngw, lane); }
    xcd_barrier(xbar);
    { TID_LAUNDER ph_hrows(p, p.x, p.norm1_g, 0, 1024, gw, ngw, lane); }
    xcd_barrier(xbar);
    {   pg8::Gemm g{(const bf16*)(p.ws + WS_H), (const bf16*)(p.ws + WS_WIN), T, NP, 1024}; pg8::StaticOrder S; S.init(T, NP, nvb, vb);
        EpiNormBf16 E{(bf16*)(p.ws + WS_PROJ), p.a_qk_gain, p.b_q_gain, p.b_kv_gain, (LAS float*)((LAS unsigned char*)dyn_lds + 131072), (bf16*)(p.ws + WS_KVC)};
        pg8::gemm_phase<EpiNormBf16, pg8::StaticOrder, true, true>((LAS unsigned char*)dyn_lds, g, S, E); }
    xcd_barrier(xbar);
    ph_attnA(p, dyn_lds, vb, nvb);
    __syncthreads();
    ph_dsa(p, dyn_lds, vb, nvb);
    xcd_barrier(xbar);
    {   pg8::Gemm g{(const bf16*)(p.ws + WS_MIX), (const bf16*)(p.ws + WS_WO2), T, 1024, MIXW}; pg8::StaticOrder S; S.init(T, 1024, nvb, vb);
        EpiResGate E{p.x, p.out, (const float*)(p.ws + WS_MOD) + 2048};
        pg8::gemm_phase<EpiResGate, pg8::StaticOrder, true, true>((LAS unsigned char*)dyn_lds, g, S, E); }
    xcd_barrier(xbar);
    { TID_LAUNDER ph_hrows(p, p.out, p.norm2_g, 3072, 4096, gw, ngw, lane); }
    xcd_barrier(xbar);
    {   pg8::Gemm g{(const bf16*)(p.ws + WS_H), (const bf16*)(p.ws + WS_WQ), T, 1024, 1024}; pg8::StaticOrder S; S.init(T, 1024, nvb, vb);
        pg8::EpiBf16<0> E{(bf16*)(p.ws + WS_Q3), 1024, nullptr, 0, 0, 1.f};
        pg8::gemm_phase<pg8::EpiBf16<0>, pg8::StaticOrder, true, true>((LAS unsigned char*)dyn_lds, g, S, E); }
    xcd_barrier(xbar);
    ph_route(p, dyn_lds, vb, nvb);
    xcd_barrier(xbar);

#if U8_HALVES
    ph_peer_u8h(p, dyn_lds);
#else
    { TID_LAUNDER ph_peer_u8p(p, dyn_lds + wv * 2048, gw, ngw, lane); }
#endif
    xcd_barrier(xbar);
    ph_peer_v8g<V8_LPR>(p, dyn_lds);

}

extern "C" void kernel_launch(void* const* d_in, const int* in_sizes, int n_in, void* d_out, int out_size, void* d_ws, size_t ws_size, hipStream_t stream) {
    static int grid_blocks = 0;
    if (grid_blocks == 0) {
        if (n_in != 18 || in_sizes[0] != T * DM || out_size != T * DM || ws_size < WS_END) { fprintf(stderr, "kernel_launch: unexpected shapes n_in %d in0 %d out %d ws %zu\n", n_in, n_in > 0 ? in_sizes[0] : -1, out_size, ws_size); grid_blocks = -1; return; }
        int dev = 0, cus = 0, per_cu = 0;
        (void)hipGetDevice(&dev);
        (void)hipDeviceGetAttribute(&cus, hipDeviceAttributeMultiprocessorCount, dev);
        (void)hipFuncSetAttribute((const void*)mega_fwd, hipFuncAttributeMaxDynamicSharedMemorySize, LDS_BYTES);
        (void)hipOccupancyMaxActiveBlocksPerMultiprocessor(&per_cu, (const void*)mega_fwd, NT, LDS_BYTES);
        if (per_cu < 1 || cus < 1) { fprintf(stderr, "kernel_launch: occupancy query gave %d blocks/CU on %d CUs\n", per_cu, cus); grid_blocks = -1; return; }
        grid_blocks = cus;
    }
    if (grid_blocks < 0) return;
    Params p{};
    const float** pp = (const float**)&p;
    for (int i = 0; i < 18; ++i) pp[i] = (const float*)d_in[i];
    p.out = (float*)d_out; p.ws = (unsigned char*)d_ws;
    if (hipMemsetAsync((char*)d_ws + WS_CTL, 0, CTL_BYTES, stream) != hipSuccess) { fprintf(stderr, "kernel_launch: memset failed\n"); return; }
    void* args[] = {&p};
    const hipError_t e = hipLaunchCooperativeKernel((const void*)mega_fwd, dim3(grid_blocks), dim3(NT), args, LDS_BYTES, stream);
    if (e != hipSuccess) fprintf(stderr, "kernel_launch: cooperative launch failed: %s (grid %d)\n", hipGetErrorString(e), grid_blocks);
}
```

```cpp
#include <hip/hip_runtime.h>
#include <hip/hip_cooperative_groups.h>
#include <cstdio>
#include <cstdint>
#include <cmath>
namespace pg8 {
#define PG8_LAS __attribute__((address_space(3)))
typedef unsigned short bf16_t;
typedef short bf16x8 __attribute__((ext_vector_type(8)));
typedef float f32x4 __attribute__((ext_vector_type(4)));
typedef unsigned u32x4 __attribute__((ext_vector_type(4)));
constexpr int BM = 256, BK = 64, HALF = 128, HTB = HALF * BK * 2  , STAGE_BYTES = 8 * HTB, NXCD = 8, WGM = 8;

__host__ __device__ __forceinline__ int lds_byte(int r, int c) { const int st = (r >> 4) * 2 + (c >> 5), rr = r & 15, cc = c & 31, ob = rr * 64 + cc * 2; return st * 1024 + (ob ^ (((ob >> 9) & 1) << 5)); }
__host__ __device__ __forceinline__ void stage_rc(int b, int& R, int& C) { const int st = b / 1024, sb = b % 1024, swz = sb ^ (((sb >> 9) & 1) << 5); R = (st >> 1) * 16 + swz / 64; C = (st & 1) * 32 + (swz % 64) / 2; }
__host__ __device__ __forceinline__ int perm32(int rho) { const int n = rho >> 4, i = rho & 15; return 8 * (i >> 2) + 4 * n + (i & 3); }

struct Unit { int pm, pn; };
struct Gemm { const bf16_t* A; const bf16_t* Bt; int M, N, K; };

struct StaticOrder {
    int nM, nN, nwg, G, c;
    __host__ __device__ void init(int M, int N, int G_, int c_) { nM = M / BM; nN = N / BM; nwg = nM * nN; G = G_; c = c_; }
    __host__ __device__ bool next(int i, Unit& u) const {
        const long L = (long)i * G + c; if (L >= nwg) return false;
        int wgid = (int)L; { const int q = nwg / NXCD, r = nwg % NXCD, xcd = wgid % NXCD, off = wgid / NXCD; wgid = (xcd < r ? xcd * (q + 1) : r * (q + 1) + (xcd - r) * q) + off; }
        const int nig = WGM * nN, gid = wgid / nig, fm = gid * WGM, gsz = (nM - fm) < WGM ? (nM - fm) : WGM;
        u.pm = fm + ((wgid % nig) % gsz); u.pn = (wgid % nig) / gsz; return true;
    }
    __device__ __forceinline__ void a_ready(const Unit&) const {}
    __device__ __forceinline__ void done(const Unit&) const {}
};

__device__ __forceinline__ unsigned cvt_pk_bf16(float lo, float hi) { unsigned r; asm volatile("v_cvt_pk_bf16_f32 %0, %1, %2" : "=v"(r) : "v"(lo), "v"(hi)); return r; }
typedef float f32x2 __attribute__((ext_vector_type(2)));
__device__ __forceinline__ f32x2 gelu_pk(f32x2 v) {
    const f32x2 av = __builtin_elementwise_abs(v), d = av * 0.2316418882f + 1.0f;
    f32x2 t; t.x = __builtin_amdgcn_rcpf(d.x); t.y = __builtin_amdgcn_rcpf(d.y);
    f32x2 q = t * 0.5307027145f + (-0.7265760135f); q = q * t + 0.7107068705f; q = q * t + (-0.142248368f); q = q * t + 0.127414796f; q = q * t;
    const f32x2 s = (v * v) * (-0.72134752044f);
    f32x2 e; e.x = __builtin_amdgcn_exp2f(s.x); e.y = __builtin_amdgcn_exp2f(s.y);
    const f32x2 m = v * (q * e), r = v - m;
    f32x2 o; o.x = v.x < 0.f ? m.x : r.x; o.y = v.y < 0.f ? m.y : r.y; return o;
}

template <int ACT  > struct EpiBf16 {
    static constexpr bool PERM = true, AFTER_DRAIN = false; static_assert(ACT == 0 || ACT == 1, "EpiBf16: ACT is 0 (none) or 1 (gelu_pk)");
    bf16_t* O; int ldc; const float* bias; int split_cols; size_t split_stride; float scale0;
    __device__ __forceinline__ void operator()(const f32x4 (&acc)[2][2][4][2], const Unit& u, int wr, int wc, int fr, int fq) const {
        const int row0 = u.pm * BM + wr * 64 + fr; int colt = u.pn * BM; bf16_t* base = O;
        float sc = 1.f; if (split_cols) { const int t = colt / split_cols; base += (size_t)t * split_stride; colt -= t * split_cols; if (t == 0) sc = scale0; }
        const int col0 = colt + wc * 32 + 8 * fq, bcol0 = u.pn * BM + wc * 32 + 8 * fq;
        f32x4 bv[2][2];
#pragma unroll
        for (int bj = 0; bj < 2; ++bj)
#pragma unroll
            for (int n = 0; n < 2; ++n) bv[bj][n] = bias ? *(const f32x4*)(bias + bcol0 + bj * HALF + 4 * n) : (f32x4){0.f, 0.f, 0.f, 0.f};
#pragma unroll
        for (int ai = 0; ai < 2; ++ai)
#pragma unroll
            for (int m = 0; m < 4; ++m) { bf16_t* rowp = base + (size_t)(row0 + ai * HALF + m * 16) * ldc + col0;
#pragma unroll
                for (int bj = 0; bj < 2; ++bj) { f32x4 v0 = acc[ai][bj][m][0] + bv[bj][0], v1 = acc[ai][bj][m][1] + bv[bj][1];
                    if (ACT == 1) { f32x2 a = gelu_pk((f32x2){v0[0], v0[1]}), b = gelu_pk((f32x2){v0[2], v0[3]}), c = gelu_pk((f32x2){v1[0], v1[1]}), d = gelu_pk((f32x2){v1[2], v1[3]});
                        v0 = (f32x4){a.x, a.y, b.x, b.y}; v1 = (f32x4){c.x, c.y, d.x, d.y}; }
                    v0 = v0 * sc; v1 = v1 * sc; u32x4 w; w.x = cvt_pk_bf16(v0[0], v0[1]); w.y = cvt_pk_bf16(v0[2], v0[3]); w.z = cvt_pk_bf16(v1[0], v1[1]); w.w = cvt_pk_bf16(v1[2], v1[3]);
                    *(u32x4*)(rowp + bj * HALF) = w; } }
    }
};

template <class Epi, class Sched, bool ALIGN_EPI = false, bool SP2 = false>
__device__ __forceinline__ void gemm_phase(PG8_LAS unsigned char* lds, const Gemm g, const Sched& S, const Epi& E) {
    int tid = threadIdx.x; asm volatile("" : "+v"(tid)); const int wid = __builtin_amdgcn_readfirstlane(tid >> 6), lane = tid & 63, wr = wid >> 2, wc = wid & 3, fr = lane & 15, fq = lane >> 4;
    const int K = g.K, nt = K / BK;
    unsigned voffA[2], voffB[2];
#pragma unroll
    for (int i = 0; i < 2; ++i) { int R, C; stage_rc(tid * 16 + i * 8192, R, C); const int Rb = Epi::PERM ? ((R & ~31) + perm32(R & 31)) : R;
        voffA[i] = (unsigned)(R * K + C) * 2u; voffB[i] = (unsigned)(Rb * K + C) * 2u; }
    const size_t kstep = (size_t)(BK * 2);
    const size_t hstep = (size_t)HALF * K * 2;
    const size_t tstep = 2 * hstep;
    const unsigned ldsw = (unsigned)wid * 1024u;
    const int aoff = lds_byte(wr * 64 + fr, fq * 8), boff = lds_byte(wc * 32 + fr, fq * 8);
#define PG8_SA(b, h) (((b) * 2 + (h)) * HTB)
#define PG8_SB(b, h) ((4 + (b) * 2 + (h)) * HTB)
#define PG8_STAGE(bufoff, gbase, voff) do { _Pragma("unroll") for (int _i = 0; _i < 2; ++_i) \
        __builtin_amdgcn_global_load_lds((const unsigned*)((const char*)(gbase) + (voff)[_i]), (PG8_LAS unsigned*)(lds + (bufoff) + ldsw + _i * 8192), 16, 0, 0); } while (0)
#define PG8_LDA(dst, b, h) do { _Pragma("unroll") for (int m = 0; m < 4; ++m) _Pragma("unroll") for (int k = 0; k < 2; ++k) dst[m][k] = *(const PG8_LAS bf16x8*)(lds + PG8_SA(b, h) + aoff + m * 2048 + k * 1024); } while (0)
#define PG8_LDB(dst, b, h) do { _Pragma("unroll") for (int n = 0; n < 2; ++n) _Pragma("unroll") for (int k = 0; k < 2; ++k) dst[n][k] = *(const PG8_LAS bf16x8*)(lds + PG8_SB(b, h) + boff + n * 2048 + k * 1024); } while (0)
#define PG8_MMA(ai, bj, At, Bt) do { __builtin_amdgcn_s_setprio(1); _Pragma("unroll") for (int m = 0; m < 4; ++m) _Pragma("unroll") for (int n = 0; n < 2; ++n) _Pragma("unroll") for (int k = 0; k < 2; ++k) \
        acc[ai][bj][m][n] = __builtin_amdgcn_mfma_f32_16x16x32_bf16(Bt[n][k], At[m][k], acc[ai][bj][m][n], 0, 0, 0); __builtin_amdgcn_s_setprio(0); } while (0)
#define PG8_WAIT_V(n) asm volatile("s_waitcnt vmcnt(" #n ")" ::: "memory")
#define PG8_WAIT_L(n) asm volatile("s_waitcnt lgkmcnt(" #n ")" ::: "memory")
#define PG8_BAR __builtin_amdgcn_s_barrier()
#define PG8_SCHED __builtin_amdgcn_sched_barrier(0)
    Unit cur, nxt; int ui = 0;
    if (!S.next(0, cur)) return;
    f32x4 acc[2][2][4][2];
#pragma unroll
    for (int a = 0; a < 2; ++a)
#pragma unroll
        for (int b = 0; b < 2; ++b)
#pragma unroll
            for (int m = 0; m < 4; ++m)
#pragma unroll
                for (int n = 0; n < 2; ++n) acc[a][b][m][n] = (f32x4){0.f, 0.f, 0.f, 0.f};
    bf16x8 At[4][2], B0[2][2], B1[2][2];
    const char* cA = (const char*)g.A + (size_t)cur.pm * tstep; const char* cB = (const char*)g.Bt + (size_t)cur.pn * tstep;
    S.a_ready(cur);
    if constexpr (SP2) {
        PG8_STAGE(PG8_SB(0, 0), cB, voffB); PG8_STAGE(PG8_SB(0, 1), cB + hstep, voffB); PG8_STAGE(PG8_SA(0, 0), cA, voffA); PG8_STAGE(PG8_SA(0, 1), cA + hstep, voffA);
        if (wr == 1) PG8_BAR;
        PG8_WAIT_V(2); PG8_BAR;
        PG8_STAGE(PG8_SB(1, 0), cB + kstep, voffB); PG8_STAGE(PG8_SA(1, 0), cA + kstep, voffA); PG8_STAGE(PG8_SB(1, 1), cB + hstep + kstep, voffB);
        PG8_WAIT_V(6); PG8_BAR;
    } else {
        PG8_STAGE(PG8_SB(0, 0), cB, voffB); PG8_STAGE(PG8_SA(0, 0), cA, voffA); PG8_STAGE(PG8_SB(0, 1), cB + hstep, voffB); PG8_STAGE(PG8_SA(0, 1), cA + hstep, voffA);
        if (wr == 1) PG8_BAR;
        PG8_WAIT_V(4); PG8_BAR;
        PG8_STAGE(PG8_SB(1, 0), cB + kstep, voffB); PG8_STAGE(PG8_SA(1, 0), cA + kstep, voffA); PG8_STAGE(PG8_SB(1, 1), cB + hstep + kstep, voffB);
        PG8_WAIT_V(6); PG8_BAR;
    }
    for (;;) {
        const bool has_next = S.next(ui + 1, nxt);
        const char* nA = has_next ? (const char*)g.A + (size_t)nxt.pm * tstep : cA; const char* nB = has_next ? (const char*)g.Bt + (size_t)nxt.pn * tstep : cB;
        for (int t = 0; t < nt; t += 2) {
            const bool last = (t == nt - 2);
            const char* a1 = cA + (size_t)(t + 1) * kstep;
            const char* a2 = last ? nA : cA + (size_t)(t + 2) * kstep; const char* b2 = last ? nB : cB + (size_t)(t + 2) * kstep;
            const char* a3 = a2 + kstep; const char* b3 = b2 + kstep;
            if (last && has_next) S.a_ready(nxt);
            if constexpr (SP2) {
            PG8_LDB(B0, 0, 0); PG8_LDB(B1, 0, 1); PG8_SCHED; PG8_LDA(At, 0, 0); PG8_STAGE(PG8_SA(1, 1), a1 + hstep, voffA);
            PG8_WAIT_V(8); PG8_WAIT_L(0); PG8_BAR; PG8_MMA(0, 0, At, B0); PG8_MMA(0, 1, At, B1); PG8_BAR; PG8_SCHED;
            PG8_LDA(At, 0, 1); PG8_STAGE(PG8_SB(0, 0), b2, voffB); PG8_STAGE(PG8_SB(0, 1), b2 + hstep, voffB); PG8_STAGE(PG8_SA(0, 0), a2, voffA);
            PG8_WAIT_V(8); PG8_WAIT_L(0); PG8_BAR; PG8_MMA(1, 0, At, B0); PG8_MMA(1, 1, At, B1); PG8_BAR; PG8_SCHED;
            PG8_LDB(B0, 1, 0); PG8_LDB(B1, 1, 1); PG8_SCHED; PG8_LDA(At, 1, 0); PG8_STAGE(PG8_SA(0, 1), a2 + hstep, voffA);
            PG8_WAIT_V(8); PG8_WAIT_L(0); PG8_BAR; PG8_MMA(0, 0, At, B0); PG8_MMA(0, 1, At, B1); PG8_BAR; PG8_SCHED;
            PG8_LDA(At, 1, 1); PG8_STAGE(PG8_SB(1, 0), b3, voffB); PG8_STAGE(PG8_SB(1, 1), b3 + hstep, voffB); PG8_STAGE(PG8_SA(1, 0), a3, voffA);
            PG8_WAIT_V(8); PG8_WAIT_L(0); PG8_BAR; PG8_MMA(1, 0, At, B0); PG8_MMA(1, 1, At, B1); PG8_BAR; PG8_SCHED;
            } else {
            PG8_LDB(B0, 0, 0); PG8_SCHED; PG8_LDA(At, 0, 0); PG8_STAGE(PG8_SA(1, 1), a1 + hstep, voffA);
            PG8_WAIT_L(8); PG8_BAR; PG8_WAIT_L(0); PG8_MMA(0, 0, At, B0); PG8_BAR; PG8_SCHED;
            PG8_LDB(B1, 0, 1); PG8_STAGE(PG8_SB(0, 0), b2, voffB);
            PG8_BAR; PG8_WAIT_L(0); PG8_MMA(0, 1, At, B1); PG8_BAR;
            PG8_LDA(At, 0, 1); PG8_STAGE(PG8_SA(0, 0), a2, voffA);
            PG8_BAR; PG8_WAIT_L(0); PG8_MMA(1, 0, At, B0); PG8_BAR; PG8_SCHED;
            PG8_STAGE(PG8_SB(0, 1), b2 + hstep, voffB);
            PG8_WAIT_V(6); PG8_BAR; PG8_MMA(1, 1, At, B1); PG8_BAR;
            PG8_LDB(B0, 1, 0); PG8_SCHED; PG8_LDA(At, 1, 0); PG8_STAGE(PG8_SA(0, 1), a2 + hstep, voffA);
            PG8_WAIT_L(8); PG8_BAR; PG8_WAIT_L(0); PG8_MMA(0, 0, At, B0); PG8_BAR; PG8_SCHED;
            PG8_LDB(B1, 1, 1); PG8_STAGE(PG8_SB(1, 0), b3, voffB);
            PG8_BAR; PG8_WAIT_L(0); PG8_MMA(0, 1, At, B1); PG8_BAR;
            PG8_LDA(At, 1, 1); PG8_STAGE(PG8_SA(1, 0), a3, voffA);
            PG8_BAR; PG8_WAIT_L(0); PG8_MMA(1, 0, At, B0); PG8_BAR; PG8_SCHED;
            PG8_STAGE(PG8_SB(1, 1), b3 + hstep, voffB);
            PG8_WAIT_V(6); PG8_BAR; PG8_MMA(1, 1, At, B1); PG8_BAR;
            }
        }
        if constexpr (ALIGN_EPI) { if (wr == 0) PG8_BAR; }
        if constexpr (!Epi::AFTER_DRAIN) { E(acc, cur, wr, wc, fr, fq); S.done(cur); }
        if (!has_next) break;
#pragma unroll
        for (int a = 0; a < 2; ++a)
#pragma unroll
            for (int b = 0; b < 2; ++b)
#pragma unroll
                for (int m = 0; m < 4; ++m)
#pragma unroll
                    for (int n = 0; n < 2; ++n) acc[a][b][m][n] = (f32x4){0.f, 0.f, 0.f, 0.f};
        cur = nxt; cA = nA; cB = nB; ++ui;
        if constexpr (ALIGN_EPI) { if (wr == 1) PG8_BAR; }
    }
    PG8_WAIT_V(0);
    if constexpr (!ALIGN_EPI) { if (wr == 0) PG8_BAR; }
    PG8_BAR;
    if constexpr (Epi::AFTER_DRAIN) { E.fused(acc, cur, wr, wc, fr, fq, lds, wid, lane); S.done(cur); }
#undef PG8_SA
#undef PG8_SB
#undef PG8_STAGE
#undef PG8_LDA
#undef PG8_LDB
#undef PG8_MMA
#undef PG8_WAIT_V
#undef PG8_WAIT_L
#undef PG8_BAR
#undef PG8_SCHED
}
}
namespace cg = cooperative_groups;
#define LAS __attribute__((address_space(3)))
typedef unsigned short bf16;
typedef float f32x4 __attribute__((ext_vector_type(4)));
typedef float f32x8 __attribute__((ext_vector_type(8)));
typedef float f32x16 __attribute__((ext_vector_type(16)));
typedef unsigned u32x4 __attribute__((ext_vector_type(4)));
typedef unsigned u32x2 __attribute__((ext_vector_type(2)));
typedef short bf16x8 __attribute__((ext_vector_type(8)));
typedef short s16x4 __attribute__((ext_vector_type(4)));

constexpr int BATCH = 16, SEQ = 2048, DM = 1024, T = BATCH * SEQ;
constexpr int NP = 3072;
constexpr int IN_COLS = 3012;
constexpr int C_QA = 0, C_KA = 512, C_VA = 1024, C_QB = 1536, C_KV = 2560, C_QI = 2688, C_KI = 2944, C_WI = 3008;
constexpr int MIXW = 1536;
constexpr int NEXP = 16384;
constexpr float EPS = 1e-6f;
constexpr int NT = 512;
constexpr int NWV = 8;

constexpr size_t MiB = 1u << 20;
constexpr size_t WS_CTL = 0;
constexpr size_t CTL_BYTES = 64 * 1024;
constexpr size_t WS_MOD = 1 * MiB;
constexpr size_t WS_SCAL = WS_MOD + 512 * 1024;
constexpr size_t WS_WIN = 2 * MiB;
constexpr size_t WS_WO2 = 8 * MiB;
constexpr size_t WS_WQ = 11 * MiB;
constexpr size_t WS_SUBK = 13 * MiB;
constexpr size_t WS_U16 = 14 * MiB;
constexpr size_t WS_V16 = 46 * MiB;
constexpr size_t WS_H = 78 * MiB;
constexpr size_t WS_PROJ = 142 * MiB;
constexpr size_t WS_Q3 = WS_PROJ;
constexpr size_t WS_MIX = 334 * MiB;
constexpr size_t WS_EXP = 430 * MiB;
constexpr size_t WS_KVC = WS_EXP;
constexpr size_t WS_GATE = 446 * MiB;
constexpr size_t WS_ATMP = 462 * MiB;
constexpr size_t WS_CBUF = 494 * MiB;
constexpr size_t WS_ABUF1 = WS_MIX;
constexpr size_t WS_END = 510 * MiB;

struct Params {
    const float *x, *c, *ada_w, *ada_b, *norm1_g, *norm2_g, *w_in, *a_qk_gain, *a_lambda, *a_sub_gain, *b_q_gain, *b_kv_gain, *b_w_uv, *w_out, *peer_wq, *peer_subkeys, *peer_u, *peer_v;
    float* out; unsigned char* ws;
};

enum { SC_LAM = 0, SC_MA = 1, SC_MB = 2 };

__device__ __forceinline__ unsigned f2bf(float f) { unsigned u = __float_as_uint(f); return (u + 0x7fffu + ((u >> 16) & 1u)) >> 16; }
__device__ __forceinline__ float bf2f(unsigned h) { return __uint_as_float(h << 16); }
__device__ __forceinline__ unsigned pk2(float lo, float hi) { return f2bf(lo) | (f2bf(hi) << 16); }
__device__ __forceinline__ float bflo(unsigned w) { return __uint_as_float(w << 16); }
__device__ __forceinline__ float bfhi(unsigned w) { return __uint_as_float(w & 0xffff0000u); }
__device__ __forceinline__ float wave_sum(float v) {
#pragma unroll
    for (int o = 1; o < 64; o <<= 1) v += __shfl_xor(v, o);
    return v;
}
__device__ __forceinline__ float wave_max(float v) {
#pragma unroll
    for (int o = 1; o < 64; o <<= 1) v = fmaxf(v, __shfl_xor(v, o));
    return v;
}
#define LDS_WAIT() asm volatile("s_waitcnt lgkmcnt(0)" ::: "memory")
__device__ __forceinline__ void ph_mod(const Params& p, float* ldsf, int vb, int nvb) {
    if (vb >= 96) return;
    int tid = threadIdx.x; asm volatile("" : "+v"(tid));
    const int lane = tid & 63, wv = tid >> 6;
    for (int i = tid; i < 16 * 1024; i += NT) { const float v = p.c[i]; ldsf[i] = v / (1.f + __expf(-v)); }
    __syncthreads();
    float* MOD = (float*)(p.ws + WS_MOD); float* part = ldsf + 16 * 1024;
    for (int it = vb; it < 96; it += nvb) {
        const int j = it * 64 + lane;
        float acc[16];
#pragma unroll
        for (int b = 0; b < 16; ++b) acc[b] = 0.f;
        const float* wp = p.ada_w + (size_t)(128 * wv) * 6144 + j;
#pragma unroll 1
        for (int k0 = 0; k0 < 128; k0 += 8) {
            float w[8];
#pragma unroll
            for (int u = 0; u < 8; ++u) w[u] = wp[(size_t)(k0 + u) * 6144];
#pragma unroll
            for (int u = 0; u < 8; ++u)
#pragma unroll
                for (int b = 0; b < 16; ++b) acc[b] = fmaf(ldsf[b * 1024 + 128 * wv + k0 + u], w[u], acc[b]);
        }
#pragma unroll
        for (int b = 0; b < 16; ++b) part[(wv * 16 + b) * 64 + lane] = acc[b];
        __syncthreads();
        for (int o = tid; o < 16 * 64; o += NT) { const int b = o >> 6, c = o & 63; float s = 0.f;
#pragma unroll
            for (int w = 0; w < 8; ++w) s += part[(w * 16 + b) * 64 + c];
            MOD[b * 6144 + it * 64 + c] = s + p.ada_b[it * 64 + c]; }
        __syncthreads();
    }
}

__device__ __forceinline__ void transpose_item(const float* W, int N, bf16* WT, int ldt, LAS float* scr, int kb, int nb, int lane) {
    const int k0 = 64 * kb, n0 = 32 * nb;
#pragma unroll 8
    for (int i = 0; i < 32; ++i) { const int kk = 2 * i + (lane >> 5); const int n = n0 + (lane & 31); scr[kk * 33 + (lane & 31)] = (n < N) ? W[(size_t)(k0 + kk) * N + n] : 0.f; }
    LDS_WAIT(); asm volatile("" ::: "memory");
    const int c = lane & 7;
#pragma unroll
    for (int j = 0; j < 4; ++j) { const int n = (lane >> 3) + 8 * j; const LAS float* s = scr + (8 * c) * 33 + n;
        u32x4 o; o.x = pk2(s[0 * 33], s[1 * 33]); o.y = pk2(s[2 * 33], s[3 * 33]); o.z = pk2(s[4 * 33], s[5 * 33]); o.w = pk2(s[6 * 33], s[7 * 33]);
        *(u32x4*)(WT + (size_t)(n0 + n) * ldt + k0 + 8 * c) = o; }
    LDS_WAIT(); asm volatile("" ::: "memory");
}

__device__ __forceinline__ void ph_prep_weights(const Params& p, LAS float* scr, int gw, int ngw, int lane) {
    bf16* WIN = (bf16*)(p.ws + WS_WIN); bf16* WO2 = (bf16*)(p.ws + WS_WO2); bf16* WQ = (bf16*)(p.ws + WS_WQ);
    constexpr int I_IN = 16 * 96, I_O = 8 * 32, I_Q = 16 * 32;
    for (int it = gw; it < I_IN + I_O + I_Q; it += ngw) {
        int r = it;
        if (r < I_IN) { transpose_item(p.w_in, IN_COLS, WIN, 1024, scr, r / 96, r % 96, lane); continue; } r -= I_IN;
        if (r < I_O) { transpose_item(p.w_out, 1024, WO2, MIXW, scr, r / 32, r % 32, lane); continue; } r -= I_O;
        transpose_item(p.peer_wq, 1024, WQ, 1024, scr, r / 32, r % 32, lane);
    }
    const size_t gt = (size_t)gw * 64 + lane, ngt = (size_t)ngw * 64;
    for (size_t i = gt; i < (size_t)1024 * 1024; i += ngt) {
        const int n = (int)(i & 1023), kk = (int)(i >> 10), h = kk >> 7;
        const float* wu = p.b_w_uv + (size_t)kk * 64; const float* wo = p.w_out + (size_t)(512 + 64 * h) * 1024 + n;
        float a = 0.f;
#pragma unroll 8
        for (int e = 0; e < 64; ++e) a = fmaf(wu[e], wo[(size_t)e * 1024], a);
        WO2[(size_t)n * MIXW + 512 + kk] = (bf16)f2bf(a);
    }
    unsigned char* U8 = (unsigned char*)(p.ws + WS_U16); unsigned char* V8 = (unsigned char*)(p.ws + WS_V16); bf16* SUBK = (bf16*)(p.ws + WS_SUBK);
    constexpr size_t NTAB8 = (size_t)NEXP * 1024 / 8, NSUB8 = 2 * 128 * 64 / 8;
    for (size_t i = gt; i < 2 * NTAB8 + NSUB8; i += ngt) {
        if (i < 2 * NTAB8) {
            const bool isu = i < NTAB8; const size_t j = isu ? i : i - NTAB8; const float sc = isu ? 32.0f : 1.0f;
            const f32x8 v = *(const f32x8*)((isu ? p.peer_u : p.peer_v) + j * 8);
            int w0 = 0, w1 = 0;
            w0 = __builtin_amdgcn_cvt_pk_fp8_f32(v[0] * sc, v[1] * sc, w0, false); w0 = __builtin_amdgcn_cvt_pk_fp8_f32(v[2] * sc, v[3] * sc, w0, true);
            w1 = __builtin_amdgcn_cvt_pk_fp8_f32(v[4] * sc, v[5] * sc, w1, false); w1 = __builtin_amdgcn_cvt_pk_fp8_f32(v[6] * sc, v[7] * sc, w1, true);
            u32x2 o; o.x = (unsigned)w0; o.y = (unsigned)w1;
            *(u32x2*)((isu ? U8 : V8) + j * 8) = o;
        } else {
            const size_t j = i - 2 * NTAB8;
            const f32x8 v = *(const f32x8*)(p.peer_subkeys + j * 8);
            u32x4 o; o.x = pk2(v[0], v[1]); o.y = pk2(v[2], v[3]); o.z = pk2(v[4], v[5]); o.w = pk2(v[6], v[7]);
            *(u32x4*)(SUBK + j * 8) = o;
        }
    }
    if (gt == 0) {
        float* SC = (float*)(p.ws + WS_SCAL);
        float s01 = 0.f, s23 = 0.f;
        for (int i = 0; i < 64; ++i) { s01 += p.a_lambda[i] * p.a_lambda[64 + i]; s23 += p.a_lambda[128 + i] * p.a_lambda[192 + i]; }
        SC[SC_LAM] = __expf(s01) - __expf(s23) + 0.2f;
        float g0 = 0.f, g1 = 0.f, gq = 0.f, gk = 0.f;
        for (int i = 0; i < 64; ++i) { g0 = fmaxf(g0, fabsf(p.a_qk_gain[i])); g1 = fmaxf(g1, fabsf(p.a_qk_gain[64 + i])); }
        for (int i = 0; i < 128; ++i) { gq = fmaxf(gq, fabsf(p.b_q_gain[i])); gk = fmaxf(gk, fabsf(p.b_kv_gain[i])); }
        SC[SC_MA] = 8.0f * g0 * g1 * 1.02f;
        SC[SC_MB] = 11.3137085f * gq * gk * 1.02f;
    }
}

__device__ __forceinline__ void ph_hrows(const Params& p, const float* X, const float* g, int shOff, int scOff, int gw, int ngw, int lane) {
    const float* MOD = (const float*)(p.ws + WS_MOD); bf16* H = (bf16*)(p.ws + WS_H);
    for (int m = gw; m < T; m += ngw) {
        const f32x4* xr = (const f32x4*)(X + (size_t)m * 1024) + lane;
        f32x4 v[4]; float s = 0.f;
#pragma unroll
        for (int j = 0; j < 4; ++j) { v[j] = xr[64 * j]; s += (v[j].x * v[j].x + v[j].y * v[j].y) + (v[j].z * v[j].z + v[j].w * v[j].w); }
        const float rstd = rsqrtf(wave_sum(s) * (1.f / 1024.f) + EPS);
        const float* mb = MOD + (size_t)(m >> 11) * 6144;
#pragma unroll
        for (int j = 0; j < 4; ++j) {
            const int col = 4 * (lane + 64 * j);
            const f32x4 gg = *(const f32x4*)(g + col), sc = *(const f32x4*)(mb + scOff + col), sh = *(const f32x4*)(mb + shOff + col);
            const f32x4 y = v[j] * rstd * gg * (sc + 1.0f) + sh;
            u32x2 o; o.x = pk2(y.x, y.y); o.y = pk2(y.z, y.w);
            *(u32x2*)(H + (size_t)m * 1024 + col) = o;
        }
    }
}

__device__ __forceinline__ void ph_norm_proj(const Params& p, int gw, int ngw, int lane) {
    bf16* PROJ = (bf16*)(p.ws + WS_PROJ);
    for (int m = gw; m < T; m += ngw) {
        bf16* row = PROJ + (size_t)m * NP;
#pragma unroll
        for (int j = 0; j < 6; ++j) {
            if (j == 2) continue;
            const int col = 8 * lane + 512 * j;
            const u32x4 raw = *(const u32x4*)(row + col);
            float v[8] = {bflo(raw.x), bfhi(raw.x), bflo(raw.y), bfhi(raw.y), bflo(raw.z), bfhi(raw.z), bflo(raw.w), bfhi(raw.w)};
            float ss = 0.f;
#pragma unroll
            for (int i = 0; i < 8; ++i) ss += v[i] * v[i];
            ss += __shfl_xor(ss, 1); ss += __shfl_xor(ss, 2); ss += __shfl_xor(ss, 4);
            float rstd; const float* gp;
            if (j < 2) { rstd = rsqrtf(ss * (1.f / 64.f) + EPS); gp = p.a_qk_gain + 64 * j + (col & 63); }
            else { ss += __shfl_xor(ss, 8); rstd = rsqrtf(ss * (1.f / 128.f) + EPS); gp = (j == 5 ? p.b_kv_gain : p.b_q_gain) + (col & 127); }
            if (j == 5 && lane >= 16) continue;
            const f32x4 g0 = *(const f32x4*)gp, g1 = *(const f32x4*)(gp + 4);
            u32x4 o; o.x = pk2(v[0] * rstd * g0.x, v[1] * rstd * g0.y); o.y = pk2(v[2] * rstd * g0.z, v[3] * rstd * g0.w);
            o.z = pk2(v[4] * rstd * g1.x, v[5] * rstd * g1.y); o.w = pk2(v[6] * rstd * g1.z, v[7] * rstd * g1.w);
            *(u32x4*)(row + col) = o;
        }
    }
}
struct EpiResGate {
    static constexpr bool PERM = false, AFTER_DRAIN = false;
    const float* X; float* Out; const float* gate;
    __device__ __forceinline__ void operator()(const pg8::f32x4 (&acc)[2][2][4][2], const pg8::Unit& u, int wr, int wc, int fr, int fq) const {
        const int col0 = u.pn * 256 + wc * 32 + 4 * fq;
#pragma unroll
        for (int ai = 0; ai < 2; ++ai)
#pragma unroll
            for (int m = 0; m < 4; ++m) {
                const int r = u.pm * 256 + ai * 128 + wr * 64 + m * 16 + fr; const float* gb = gate + (size_t)(r >> 11) * 6144;
#pragma unroll
                for (int bj = 0; bj < 2; ++bj)
#pragma unroll
                    for (int n = 0; n < 2; ++n) { const int c = col0 + bj * 128 + n * 16; const size_t off = (size_t)r * 1024 + c;
                        const pg8::f32x4 xv = *(const pg8::f32x4*)(X + off), gv = *(const pg8::f32x4*)(gb + c);
                        *(pg8::f32x4*)(Out + off) = xv + gv * acc[ai][bj][m][n]; }
            }
    }
};


struct EpiNormBf16 {
    static constexpr bool PERM = true, AFTER_DRAIN = false;
    bf16* O; const float* gqk; const float* gbq; const float* gbkv; LAS float* P; bf16* KVC;
    __device__ __forceinline__ void operator()(const pg8::f32x4 (&acc)[2][2][4][2], const pg8::Unit& u, int wr, int wc, int fr, int fq) const {
        const int pn = u.pn;
        const int mode = pn < 4 ? 1 : ((pn == 4 || pn == 5 || pn == 11) ? 0 : (pn == 10 ? 3 : 2));
        if (mode != 0) {
#pragma unroll
            for (int ai = 0; ai < 2; ++ai)
#pragma unroll
                for (int m = 0; m < 4; ++m)
#pragma unroll
                    for (int bj = 0; bj < 2; ++bj) {
                        const pg8::f32x4 a = acc[ai][bj][m][0], b = acc[ai][bj][m][1];
                        float ss = (a[0] * a[0] + a[1] * a[1]) + (a[2] * a[2] + a[3] * a[3]) + (b[0] * b[0] + b[1] * b[1]) + (b[2] * b[2] + b[3] * b[3]);
                        ss += __shfl_xor(ss, 16); ss += __shfl_xor(ss, 32);
                        if (fq == 0) P[(ai * 128 + wr * 64 + m * 16 + fr) * 8 + bj * 4 + wc] = ss;
                    }
            asm volatile("s_waitcnt lgkmcnt(0)" ::: "memory"); __builtin_amdgcn_s_barrier(); asm volatile("" ::: "memory");
        }
        const int row0 = u.pm * 256 + wr * 64 + fr, col0 = u.pn * 256 + wc * 32 + 8 * fq;
        pg8::f32x4 g0[2], g1[2];
#pragma unroll
        for (int bj = 0; bj < 2; ++bj) {
            const float* gp = nullptr;
            if (mode == 1) gp = gqk + (pn >= 2 ? 64 : 0) + 32 * (wc & 1) + 8 * fq;
            else if (mode == 2) gp = gbq + 32 * wc + 8 * fq;
            else if (mode == 3 && bj == 0) gp = gbkv + 32 * wc + 8 * fq;
            if (gp) { g0[bj] = *(const pg8::f32x4*)gp; g1[bj] = *(const pg8::f32x4*)(gp + 4); } else { g0[bj] = (pg8::f32x4){1.f, 1.f, 1.f, 1.f}; g1[bj] = g0[bj]; }
        }
#pragma unroll
        for (int ai = 0; ai < 2; ++ai)
#pragma unroll
            for (int m = 0; m < 4; ++m) { bf16* rowp = O + (size_t)(row0 + ai * 128 + m * 16) * NP + col0;
#pragma unroll
                for (int bj = 0; bj < 2; ++bj) {
                    float s = 1.f;
                    if (mode != 0 && !(mode == 3 && bj == 1)) {
                        const pg8::f32x4 q = *(const LAS pg8::f32x4*)(P + (ai * 128 + wr * 64 + m * 16 + fr) * 8 + bj * 4);
                        s = (mode == 1) ? rsqrtf(((wc < 2) ? (q[0] + q[1]) : (q[2] + q[3])) * (1.f / 64.f) + EPS) : rsqrtf(((q[0] + q[1]) + (q[2] + q[3])) * (1.f / 128.f) + EPS);
                    }
                    const pg8::f32x4 v0 = acc[ai][bj][m][0] * s * g0[bj], v1 = acc[ai][bj][m][1] * s * g1[bj];
                    pg8::u32x4 w; w.x = pg8::cvt_pk_bf16(v0[0], v0[1]); w.y = pg8::cvt_pk_bf16(v0[2], v0[3]); w.z = pg8::cvt_pk_bf16(v1[0], v1[1]); w.w = pg8::cvt_pk_bf16(v1[2], v1[3]);
                    if (pn == 10 && bj == 0) *(pg8::u32x4*)(KVC + (size_t)(row0 + ai * 128 + m * 16) * 128 + wc * 32 + 8 * fq) = w;
                    else *(pg8::u32x4*)(rowp + bj * 128) = w; } }
    }
};
typedef __bf16 bf16x2_t __attribute__((ext_vector_type(2)));
__device__ __forceinline__ float dot2bf(unsigned a, unsigned b, float acc) { return __builtin_amdgcn_fdot2_f32_bf16(__builtin_bit_cast(bf16x2_t, a), __builtin_bit_cast(bf16x2_t, b), acc, false); }
template <int CTRL> __device__ __forceinline__ float dpp_f(float v) { return __int_as_float(__builtin_amdgcn_update_dpp(0, __float_as_int(v), CTRL, 0xf, 0xf, false)); }
__device__ __forceinline__ float row16_sum(float v) {
    v += dpp_f<0x128>(v); v += dpp_f<0x124>(v); v += dpp_f<0x122>(v); v += dpp_f<0x121>(v); return v;
}
__device__ __forceinline__ float gelu_erf(float v) {
    const float av = fabsf(v), t = __builtin_amdgcn_rcpf(fmaf(av, 0.2316418882f, 1.0f));
    float q = fmaf(t, 0.5307027145f, -0.7265760135f); q = fmaf(q, t, 0.7107068705f); q = fmaf(q, t, -0.142248368f); q = fmaf(q, t, 0.127414796f); q = q * t;
    const float e = __builtin_amdgcn_exp2f(v * v * -0.72134752044f);
    const float m = v * (q * e);
    return v < 0.f ? m : v - m;
}

#ifndef DSA_PB
#define DSA_PB 0
#endif
typedef short v4i16_t __attribute__((ext_vector_type(4)));
#ifndef DSA_REP_A
#define DSA_REP_A 1
#endif
#ifndef DSA_REP_B
#define DSA_REP_B 1
#endif
#ifndef DSA_REP_C
#define DSA_REP_C 1
#endif
constexpr int DSA_SROW = 2048 * 4 + 16;
constexpr int DSA_SEL_OFF = 16 * DSA_SROW;
constexpr int DSA_LDS = DSA_SEL_OFF + 16 * 512;
constexpr int DSA_KVROW = 272;

__device__ __forceinline__ unsigned sortkey(float s) { const unsigned u = __float_as_uint(s); return u ^ ((u >> 31) ? 0xffffffffu : 0x80000000u); }
__device__ __forceinline__ unsigned cvtpk_bf16(float lo, float hi) { unsigned r; asm volatile("v_cvt_pk_bf16_f32 %0, %1, %2" : "=v"(r) : "v"(lo), "v"(hi)); return r; }

__device__ __forceinline__ void cnt_ge4(int& acc, unsigned k0, unsigned k1, unsigned k2, unsigned k3, unsigned cand) {
    asm volatile("v_cmp_ge_u32_e64 s[40:41], %1, %5\n\t"
                 "v_cmp_ge_u32_e64 s[42:43], %2, %5\n\t"
                 "v_cmp_ge_u32_e64 s[44:45], %3, %5\n\t"
                 "v_cmp_ge_u32_e64 s[46:47], %4, %5\n\t"
                 "v_addc_co_u32_e64 %0, s[48:49], %0, 0, s[40:41]\n\t"
                 "v_addc_co_u32_e64 %0, s[48:49], %0, 0, s[42:43]\n\t"
                 "v_addc_co_u32_e64 %0, s[48:49], %0, 0, s[44:45]\n\t"
                 "v_addc_co_u32_e64 %0, s[48:49], %0, 0, s[46:47]"
                 : "+v"(acc) : "v"(k0), "v"(k1), "v"(k2), "v"(k3), "v"(cand)
                 : "s40", "s41", "s42", "s43", "s44", "s45", "s46", "s47", "s48", "s49");
}
__device__ __forceinline__ void ph_dsa(const Params& p, unsigned char* lds, int vb, int nvb) {
    const bf16* PROJ = (const bf16*)(p.ws + WS_PROJ); bf16* MIX = (bf16*)(p.ws + WS_MIX);
    const float MB = ((const float*)(p.ws + WS_SCAL))[SC_MB];
    int tid = threadIdx.x; asm volatile("" : "+v"(tid)); const int lane = tid & 63, wv = __builtin_amdgcn_readfirstlane(tid >> 6);
    const int l15 = lane & 15, g = lane >> 4;
    LAS unsigned char* ldsl = (LAS unsigned char*)lds;
    for (int it = vb; it < 2048; it += nvb) {
        const int vbb = it & 255, kk = it >> 8, xg = vbb & 7, ix = vbb >> 3, b = 2 * xg + (ix & 1), G = (ix >> 1) & 3, sub = ix >> 3;
        const int c = (kk & 1) ? (31 - G - 8 * (kk >> 1)) : (G + 8 * (kk >> 1));
        const int cend = (c + 1) * 64, t0 = c * 64 + sub * 16;
        const bf16* Pb = PROJ + (size_t)b * SEQ * NP;
        const bf16* KVb = (const bf16*)(p.ws + WS_KVC) + (size_t)b * SEQ * 128;
#pragma unroll 1
        for (int repa = 0; repa < DSA_REP_A; ++repa)
        if (c >= 4) {
            const bf16* qrow = Pb + (size_t)(t0 + l15) * NP;
            bf16x8 bq[4][2]; float wsc[4];
#pragma unroll
            for (int h = 0; h < 4; ++h) { wsc[h] = bf2f(qrow[C_WI + h]) * 0.0625f;
#pragma unroll
                for (int ks = 0; ks < 2; ++ks) bq[h][ks] = *(const bf16x8*)(qrow + C_QI + h * 64 + 32 * ks + 8 * g); }
            for (int k0 = 16 * wv; k0 < cend; k0 += 128) {
                const bf16* krow = Pb + (size_t)(k0 + l15) * NP + C_KI + 8 * g;
                const bf16x8 ka0 = *(const bf16x8*)krow, ka1 = *(const bf16x8*)(krow + 32);
                f32x4 sc = {0.f, 0.f, 0.f, 0.f};
#pragma unroll
                for (int h = 0; h < 4; ++h) { f32x4 a = {0.f, 0.f, 0.f, 0.f};
                    a = __builtin_amdgcn_mfma_f32_16x16x32_bf16(ka0, bq[h][0], a, 0, 0, 0);
                    a = __builtin_amdgcn_mfma_f32_16x16x32_bf16(ka1, bq[h][1], a, 0, 0, 0);
#pragma unroll
                    for (int r = 0; r < 4; ++r) sc[r] = fmaf(fmaxf(a[r], 0.f), wsc[h], sc[r]); }
#pragma unroll
                for (int r = 0; r < 4; ++r) sc[r] = (sc[r] == 0.f) ? 0.f : sc[r];
                *(LAS f32x4*)(ldsl + l15 * DSA_SROW + (k0 + 4 * g) * 4) = sc;
            }
        }
        __syncthreads();
        LAS unsigned short* selw = (LAS unsigned short*)(ldsl + DSA_SEL_OFF);
        int mind0 = 0, mind1 = 0;
        if (c < 4) {
            for (int j = lane; j < 256; j += 64) { selw[(2 * wv) * 256 + j] = (unsigned short)j; selw[(2 * wv + 1) * 256 + j] = (unsigned short)j; }
        } else {
            const int nreg = cend >> 6;
            unsigned keyA[32], keyB[32];
            { const LAS float* srA = (const LAS float*)(ldsl + (2 * wv) * DSA_SROW) + lane; const LAS float* srB = (const LAS float*)(ldsl + (2 * wv + 1) * DSA_SROW) + lane;
#pragma unroll
              for (int i = 0; i < 32; ++i) { keyA[i] = (i < nreg) ? sortkey(srA[64 * i]) : 0u; keyB[i] = (i < nreg) ? sortkey(srB[64 * i]) : 0u; } }
#define DSA_WSUM(V, OUT) do { int v_ = (V); v_ += __builtin_amdgcn_update_dpp(0, v_, 0x128, 0xf, 0xf, false); v_ += __builtin_amdgcn_update_dpp(0, v_, 0x124, 0xf, 0xf, false); \
        v_ += __builtin_amdgcn_update_dpp(0, v_, 0x122, 0xf, 0xf, false); v_ += __builtin_amdgcn_update_dpp(0, v_, 0x121, 0xf, 0xf, false);                                     \
        OUT = __builtin_amdgcn_readlane(v_, 0) + __builtin_amdgcn_readlane(v_, 16) + __builtin_amdgcn_readlane(v_, 32) + __builtin_amdgcn_readlane(v_, 48); } while (0)
            unsigned prefA = 0u, prefB = 0u; bool exA = false, exB = false;
#pragma unroll 1
            for (int bit = 31; bit >= 0; --bit) {
                const unsigned candA = exA ? prefA : (prefA | (1u << bit)), candB = exB ? prefB : (prefB | (1u << bit));
                int ca = 0, cb = 0;
#pragma unroll
                for (int i = 0; i < 32; i += 4) { cnt_ge4(ca, keyA[i], keyA[i + 1], keyA[i + 2], keyA[i + 3], candA); cnt_ge4(cb, keyB[i], keyB[i + 1], keyB[i + 2], keyB[i + 3], candB); }
                int cntA, cntB; DSA_WSUM(ca, cntA); DSA_WSUM(cb, cntB);
                if (!exA && cntA >= 256) { prefA = candA; exA = (cntA == 256); }
                if (!exB && cntB >= 256) { prefB = candB; exB = (cntB == 256); }
                if (exA && exB) break;
            }
#define DSA_COMPACT(KEY, PREFIX, EXACT, QQ, MIND) do {                                                                                              \
            const int t_ = t0 + (QQ); LAS unsigned short* sel = selw + (QQ) * 256;                                                                    \
            int need_ties = 0;                                                                                                                        \
            if (!(EXACT)) { int cg_ = 0; if ((PREFIX) != 0xffffffffu) { _Pragma("unroll") for (int i = 0; i < 32; ++i) cg_ += (KEY[i] > (PREFIX)) ? 1 : 0; } \
                int cgt; DSA_WSUM(cg_, cgt); need_ties = 256 - cgt; }                                                                                 \
            int base = 0, tbase = 0, md = 4096;                                                                                                       \
            _Pragma("unroll") for (int i = 0; i < 32; ++i) { if (i < nreg) {                                                                          \
                bool selb;                                                                                                                            \
                if (EXACT) selb = KEY[i] >= (PREFIX);                                                                                                 \
                else { const bool tie = KEY[i] == (PREFIX); const unsigned long long mt = __ballot(tie);                                              \
                    const int trank = tbase + (int)__builtin_amdgcn_mbcnt_hi((unsigned)(mt >> 32), __builtin_amdgcn_mbcnt_lo((unsigned)mt, 0u));      \
                    selb = (KEY[i] > (PREFIX)) || (tie && trank < need_ties); tbase += __popcll(mt); }                                                \
                const unsigned long long m = __ballot(selb);                                                                                          \
                const int pos = base + (int)__builtin_amdgcn_mbcnt_hi((unsigned)(m >> 32), __builtin_amdgcn_mbcnt_lo((unsigned)m, 0u));               \
                const int kidx = i * 64 + lane;                                                                                                       \
                if (selb) { sel[pos] = (unsigned short)kidx; const int d = t_ > kidx ? t_ - kidx : kidx - t_; md = d < md ? d : md; }                 \
                base += __popcll(m); } }                                                                                                              \
            _Pragma("unroll") for (int o = 1; o < 64; o <<= 1) { const int x = __shfl_xor(md, o); md = x < md ? x : md; }                             \
            MIND = md; } while (0)
            DSA_COMPACT(keyA, prefA, exA, 2 * wv, mind0);
            DSA_COMPACT(keyB, prefB, exB, 2 * wv + 1, mind1);
#undef DSA_COMPACT
#undef DSA_WSUM
        }
        LDS_WAIT(); asm volatile("" ::: "memory");
        const int nvalid = cend < 256 ? cend : 256;
        const int head = lane & 7;
        const float slopeL2 = exp2f(-(float)(head + 1)) * 1.4426950409f;
#pragma unroll 1
        for (int qi2 = 0; qi2 < 2 * DSA_REP_C; ++qi2) { const int qi = qi2 & 1;
            const int qq = 2 * wv + qi, t = t0 + qq;
            const LAS unsigned short* sel = selw + qq * 256;
            LAS unsigned char* stg = ldsl + (2 * wv) * DSA_SROW;
            const bf16* qrow = Pb + (size_t)t * NP + C_QB + head * 128 + 8 * g;
            bf16x8 bq[4];
#pragma unroll
            for (int ks = 0; ks < 4; ++ks) bq[ks] = *(const bf16x8*)(qrow + 32 * ks);
            const float refL2 = MB * 1.4426950409f - slopeL2 * (float)(qi == 0 ? mind0 : mind1);
            f32x4 o[8];
#pragma unroll
            for (int dt = 0; dt < 8; ++dt) o[dt] = (f32x4){0.f, 0.f, 0.f, 0.f};
            float lsum = 0.f;
#define DSA_GATHER(S, KA) do { _Pragma("unroll") for (int i_ = 0; i_ < 8; ++i_) { const int jr = 32 * (S) + 4 * i_ + g; const int keyr = sel[jr < nvalid ? jr : 0];   \
        KA[i_] = *(const bf16x8*)(KVb + (size_t)keyr * 128 + 8 * l15); } } while (0)
#define DSA_COMPUTE(S, KA) do { unsigned pb[4];                                                                                                        \
        _Pragma("unroll") for (int i_ = 0; i_ < 8; ++i_) *(LAS bf16x8*)(stg + (4 * i_ + g) * DSA_KVROW + 16 * l15) = KA[i_];                              \
        LDS_WAIT(); asm volatile("" ::: "memory");                                                                                                        \
        _Pragma("unroll") for (int tl = 0; tl < 2; ++tl) { const int j0 = 32 * (S) + 16 * tl;                                                           \
            f32x4 a = {0.f, 0.f, 0.f, 0.f};                                                                                                             \
            _Pragma("unroll") for (int ks = 0; ks < 4; ++ks) { const bf16x8 ka_ = *(const LAS bf16x8*)(stg + (16 * tl + l15) * DSA_KVROW + (32 * ks + 8 * g) * 2); \
                a = __builtin_amdgcn_mfma_f32_16x16x32_bf16(ka_, bq[ks], a, 0, 0, 0); }                                                                 \
            const u32x2 kw = *(const LAS u32x2*)(sel + j0 + 4 * g);                                                                                     \
            const int kx[4] = {(int)(kw.x & 0xffffu), (int)(kw.x >> 16), (int)(kw.y & 0xffffu), (int)(kw.y >> 16)};                                     \
            float pr[4];                                                                                                                                \
            _Pragma("unroll") for (int r = 0; r < 4; ++r) { const int dd = t > kx[r] ? t - kx[r] : kx[r] - t;                                            \
                const float e = __builtin_amdgcn_exp2f(fmaf(a[r], 0.1275174f, -slopeL2 * (float)dd - refL2));                                            \
                pr[r] = (j0 + 4 * g + r < nvalid) ? e : 0.f; lsum += pr[r]; }                                                                           \
            pb[2 * tl] = cvtpk_bf16(pr[0], pr[1]); pb[2 * tl + 1] = cvtpk_bf16(pr[2], pr[3]); }                                                         \
        LDS_WAIT(); asm volatile("" ::: "memory");                                                                                                      \
        u32x4 pw4; pw4.x = pb[0]; pw4.y = pb[1]; pw4.z = pb[2]; pw4.w = pb[3];                                                                          \
        const bf16x8 pfrag = __builtin_bit_cast(bf16x8, pw4);                                                                                           \
        const LAS unsigned char* trb = stg + (4 * g + (l15 >> 2)) * DSA_KVROW + (4 * (lane & 3)) * 2;                                                   \
        _Pragma("unroll") for (int dt = 0; dt < 8; ++dt) {                                                                                              \
            const s16x4 lo = __builtin_bit_cast(s16x4, __builtin_amdgcn_ds_read_tr16_b64_v4i16((LAS v4i16_t*)(trb + dt * 32)));                         \
            const s16x4 hi = __builtin_bit_cast(s16x4, __builtin_amdgcn_ds_read_tr16_b64_v4i16((LAS v4i16_t*)(trb + 16 * DSA_KVROW + dt * 32)));        \
            const bf16x8 af = {lo[0], lo[1], lo[2], lo[3], hi[0], hi[1], hi[2], hi[3]};                                                                 \
            o[dt] = __builtin_amdgcn_mfma_f32_16x16x32_bf16(af, pfrag, o[dt], 0, 0, 0); }                                                               \
        LDS_WAIT(); asm volatile("" ::: "memory"); } while (0)
            const int nch = (nvalid + 31) >> 5;
            bf16x8 KA[8], KB[8];
            DSA_GATHER(0, KA);
#pragma unroll 1
            for (int s = 0; s < nch; s += 2) {
                if (s + 1 < nch) DSA_GATHER(s + 1, KB);
                DSA_COMPUTE(s, KA);
                if (s + 1 < nch) { if (s + 2 < nch) DSA_GATHER(s + 2, KA); DSA_COMPUTE(s + 1, KB); }
            }
#undef DSA_GATHER
#undef DSA_COMPUTE
            lsum += __shfl_xor(lsum, 16); lsum += __shfl_xor(lsum, 32);
            const float il = 1.f / lsum;
            if (l15 < 8) {
                bf16* orow = MIX + (size_t)(b * SEQ + t) * MIXW + 512 + head * 128 + 4 * g;
#pragma unroll
                for (int dt = 0; dt < 8; ++dt) { u32x2 w; w.x = pk2(o[dt][0] * il, o[dt][1] * il); w.y = pk2(o[dt][2] * il, o[dt][3] * il); *(u32x2*)(orow + 16 * dt) = w; }
            }
        }
        __syncthreads();
    }
}
typedef __attribute__((address_space(1))) float GASF;
#ifndef ATT_PROBE
#define ATT_PROBE 0
#endif
#ifndef ATT_REMAP
#define ATT_REMAP 1
#endif
__device__ __forceinline__ int crow(int r, int hi) { return (r & 3) + 8 * (r >> 2) + 4 * hi; }
#define KSWZ64(row, cb) ((row) * 128 + ((cb) ^ ((((row) >> 1) & 7) << 4)))
__device__ __forceinline__ int v_st(int k, int c) { const int kk = (k & ~0xC) | ((k & 4) << 1) | ((k & 8) >> 1); return ((kk >> 3) * 4 + (c >> 5)) * 512 + ((kk & 7) * 32 + (c & 31)) * 2; }
__device__ __forceinline__ int v_rd_base(int lane) { return ((lane & 3) << 3) | (((lane >> 2) & 3) << 6) | (((lane >> 4) & 1) << 5) | (((lane >> 5) & 1) << 8); }
constexpr int v_rd_off(int d0, int ks, int half) { return d0 * 512 + ks * 4096 + half * 2048; }
template <int OFF> __device__ __forceinline__ s16x4 tr_read(int vb) {
    s16x4 r; asm volatile("ds_read_b64_tr_b16 %0, %1 offset:%2" : "=&v"(r) : "v"(vb), "i"(OFF) : "memory"); return r;
}
template <int D0> __device__ __forceinline__ void pv_one(f32x16& od, int vb, bf16x8 pa0, bf16x8 pa1, bf16x8 pa2, bf16x8 pa3) {
    const s16x4 l0 = tr_read<v_rd_off(D0, 0, 0)>(vb), h0 = tr_read<v_rd_off(D0, 0, 1)>(vb), l1 = tr_read<v_rd_off(D0, 1, 0)>(vb), h1 = tr_read<v_rd_off(D0, 1, 1)>(vb);
    const s16x4 l2 = tr_read<v_rd_off(D0, 2, 0)>(vb), h2 = tr_read<v_rd_off(D0, 2, 1)>(vb), l3 = tr_read<v_rd_off(D0, 3, 0)>(vb), h3 = tr_read<v_rd_off(D0, 3, 1)>(vb);
    asm volatile("s_waitcnt lgkmcnt(0)" ::: "memory"); __builtin_amdgcn_sched_barrier(0);
#define PK(L, H) (bf16x8){L[0], L[1], L[2], L[3], H[0], H[1], H[2], H[3]}
    od = __builtin_amdgcn_mfma_f32_32x32x16_bf16(pa0, PK(l0, h0), od, 0, 0, 0);
    od = __builtin_amdgcn_mfma_f32_32x32x16_bf16(pa1, PK(l1, h1), od, 0, 0, 0);
    od = __builtin_amdgcn_mfma_f32_32x32x16_bf16(pa2, PK(l2, h2), od, 0, 0, 0);
    od = __builtin_amdgcn_mfma_f32_32x32x16_bf16(pa3, PK(l3, h3), od, 0, 0, 0);
#undef PK
}

__device__ __forceinline__ void att_tile(f32x16 (&o)[4], float& lsum, const unsigned char* Kb, int vb0, const unsigned char* Qw, int r32, int hi, int tq, int j, bool past, float slopeL2, float refL2) {
    constexpr float C = 0.125f * 1.4426950409f;
    bf16x8 qr[4];
#pragma unroll
    for (int d0 = 0; d0 < 4; ++d0) qr[d0] = *(const bf16x8*)(Qw + KSWZ64(r32, (d0 * 16 + hi * 8) * 2));
    const float dq = (float)(tq - 64 * j - 4 * hi);
    const float B0 = -slopeL2 * dq - refL2;
    float ps = 0.f;
    bf16x8 pa0, pa1, pa2, pa3;
#define PK4(P, BASE, OUT) do { unsigned a0 = cvtpk_bf16(P[BASE + 0], P[BASE + 1]), a1 = cvtpk_bf16(P[BASE + 2], P[BASE + 3]);   \
    unsigned b0_ = cvtpk_bf16(P[BASE + 4], P[BASE + 5]), b1_ = cvtpk_bf16(P[BASE + 6], P[BASE + 7]);                              \
    auto r0 = __builtin_amdgcn_permlane32_swap(a0, b0_, false, false); auto r1 = __builtin_amdgcn_permlane32_swap(a1, b1_, false, false); \
    u32x4 w = {r0[0], r1[0], r0[1], r1[1]}; OUT = __builtin_bit_cast(bf16x8, w); } while (0)
#define HALF_TILE(KOFF, FOFF, PA, PB) do { f32x16 pp = f32x16{};                                                                     \
    _Pragma("unroll") for (int d0 = 0; d0 < 4; ++d0) { const int cb = (d0 * 16 + hi * 8) * 2;                                        \
        const bf16x8 bk = *(const bf16x8*)(Kb + KSWZ64((KOFF) + r32, cb)); pp = __builtin_amdgcn_mfma_f32_32x32x16_bf16(bk, qr[d0], pp, 0, 0, 0); } \
    if (past) { _Pragma("unroll") for (int r = 0; r < 16; ++r) { const float off = (float)((r & 3) + 8 * (r >> 2)) + (FOFF);          \
            pp[r] = __builtin_amdgcn_exp2f(fmaf(pp[r], C, fmaf(slopeL2, off, B0))); } }                                               \
    else { _Pragma("unroll") for (int r = 0; r < 16; ++r) { const float off = (float)((r & 3) + 8 * (r >> 2)) + (FOFF);               \
            pp[r] = __builtin_amdgcn_exp2f(fmaf(pp[r], C, -slopeL2 * fabsf(dq - off) - refL2)); } }                                   \
    _Pragma("unroll") for (int r = 0; r < 16; ++r) ps += pp[r];                                                                       \
    PK4(pp, 0, PA); PK4(pp, 8, PB); __builtin_amdgcn_sched_barrier(0); } while (0)
    HALF_TILE(0, 0.f, pa0, pa1);
    HALF_TILE(32, 32.f, pa2, pa3);
#undef HALF_TILE
#undef PK4
    { auto rr = __builtin_amdgcn_permlane32_swap(__float_as_uint(ps), __float_as_uint(ps), false, false);
      ps = __uint_as_float(rr[0]) + __uint_as_float(rr[1]); }
    lsum += ps;
    pv_one<0>(o[0], vb0, pa0, pa1, pa2, pa3); pv_one<1>(o[1], vb0, pa0, pa1, pa2, pa3); pv_one<2>(o[2], vb0, pa0, pa1, pa2, pa3); pv_one<3>(o[3], vb0, pa0, pa1, pa2, pa3);
}
constexpr int ATT_LDS = 2 * 16384 + 2 * 8192 + 8 * 256 + 8 * 4096;

__device__ __forceinline__ void ph_attnA(const Params& p, unsigned char* lds, int vb, int nvb) {
    const bf16* PROJ = (const bf16*)(p.ws + WS_PROJ); bf16* MIX = (bf16*)(p.ws + WS_MIX);
    const float* SC = (const float*)(p.ws + WS_SCAL);
    const float lam = SC[SC_LAM], refL2 = SC[SC_MA] * 1.4426950409f;
    constexpr float C = 0.125f * 1.4426950409f;
    int tid = threadIdx.x; asm volatile("" : "+v"(tid)); const int lane = tid & 63, wid = __builtin_amdgcn_readfirstlane(tid >> 6), r32 = lane & 31, hi = lane >> 5;
    unsigned char* V_lds = lds; unsigned char* K_lds = lds + 32768;
    float* wsf = (float*)(lds + 49152) + wid * 64;
    GASF* tmpw = (GASF*)(p.ws + WS_ATMP) + ((size_t)(vb * NWV + wid) * 64) * 64 + lane;
    const int vbase = (int)(uintptr_t)V_lds + v_rd_base(lane);
    const int krow = tid >> 3, kch = tid & 7, kdst = KSWZ64(krow, kch * 16);
    const int sr = tid >> 4, sc = (tid & 15) * 8, vst0 = v_st(sr, sc), vst1 = v_st(32 + sr, sc);
    for (int it = vb; it < 256; it += nvb) {
        #if ATT_REMAP
        const int xg_ = it & 7, m_ = it >> 3, pidx = xg_ * 8 + (m_ >> 2), qbl = m_ & 3, b = pidx >> 2, h = pidx & 3;
#else
        const int b = it >> 4, h = (it >> 2) & 3, qbl = it & 3;
#endif
        const float slopeL2 = exp2f(-2.0f * (float)(h + 1)) * 1.4426950409f;
        const bf16* Pb = PROJ + (size_t)b * SEQ * NP;
#pragma unroll 1
        for (int half = 0; half < 2; ++half) {
            const int qb = half ? 7 - qbl : qbl, q0 = 256 * qb, NTu = 4 * (qb + 1), cw = 4 * qb + (wid >> 1);
            const int tq = q0 + 32 * wid + r32;
#pragma unroll 1
            for (int mi = 0; mi < 2; ++mi) {
                const int m = 1 - mi;
                const bf16* Kg = Pb + C_KA + h * 128 + m * 64 + (size_t)krow * NP + kch * 8;
                const bf16* Vg = Pb + C_VA + h * 128 + (size_t)sr * NP + sc;
                unsigned char* Qw = lds + 51200 + wid * 4096;
                { const bf16* qp = Pb + (size_t)tq * NP + C_QA + h * 128 + m * 64 + hi * 8;
#pragma unroll
                  for (int d0 = 0; d0 < 4; ++d0) *(bf16x8*)(Qw + KSWZ64(r32, (d0 * 16 + hi * 8) * 2)) = *(const bf16x8*)(qp + d0 * 16); }
                f32x16 o[4];
#pragma unroll
                for (int d = 0; d < 4; ++d) o[d] = f32x16{};
                float lsum = 0.f;
                bf16x8 ak, av0, av1;
#define ATT_LOAD(K_, V0_, V1_, TJ) do { const size_t go_ = (size_t)(TJ) * 64 * NP; K_ = *(const bf16x8*)(Kg + go_); V0_ = *(const bf16x8*)(Vg + go_); V1_ = *(const bf16x8*)(Vg + go_ + (size_t)32 * NP); \
        if (ATT_PROBE == 2) { bf16x8 d0_ = *(const volatile bf16x8*)(Kg + go_); bf16x8 d1_ = *(const volatile bf16x8*)(Vg + go_); bf16x8 d2_ = *(const volatile bf16x8*)(Vg + go_ + (size_t)32 * NP); asm volatile("" :: "v"(d0_), "v"(d1_), "v"(d2_)); } } while (0)
#define ATT_WRITE(K_, V0_, V1_, NB) do { *(bf16x8*)(K_lds + (NB) * 8192 + kdst) = K_; *(bf16x8*)(V_lds + (NB) * 16384 + vst0) = V0_; *(bf16x8*)(V_lds + (NB) * 16384 + vst1) = V1_; } while (0)
                ATT_LOAD(ak, av0, av1, 0); ATT_WRITE(ak, av0, av1, 0);
                __syncthreads();
#pragma unroll 1
                for (int j = 0; j < NTu; ++j) {
                    const int buf = j & 1;
                    if (j + 1 < NTu) ATT_LOAD(ak, av0, av1, j + 1);
                    if (j <= cw) { att_tile(o, lsum, K_lds + buf * 8192, vbase + buf * 16384, Qw, r32, hi, tq, j, j < cw, slopeL2, refL2);
#if ATT_PROBE == 1
                        { f32x16 o2[4]; o2[0] = o[0]; o2[1] = o[1]; o2[2] = o[2]; o2[3] = o[3]; float l2 = 0.f; att_tile(o2, l2, K_lds + buf * 8192, vbase + buf * 16384, Qw, r32, hi, tq, j, j < cw, slopeL2, refL2);
                          asm volatile("" :: "v"(o2[0]), "v"(o2[1]), "v"(o2[2]), "v"(o2[3]), "v"(l2)); }
#endif
                    }
                    if (j + 1 < NTu) ATT_WRITE(ak, av0, av1, buf ^ 1);
                    __syncthreads();
                }
#undef ATT_LOAD
#undef ATT_WRITE
                if (hi == 0) wsf[r32] = lsum;
                LDS_WAIT(); asm volatile("" ::: "memory");
                float rli[16];
#pragma unroll
                for (int r = 0; r < 16; ++r) rli[r] = 1.f / wsf[crow(r, hi)];
                LDS_WAIT(); asm volatile("" ::: "memory");
                if (mi == 0) {
#pragma unroll
                    for (int d = 0; d < 4; ++d) { GASF* td = tmpw + d * 1024; asm volatile("" : "+v"(td));
#pragma unroll
                        for (int r = 0; r < 16; ++r) td[r * 64] = o[d][r] * rli[r]; }
                } else {
                    float gsub[4];
#pragma unroll
                    for (int d = 0; d < 4; ++d) gsub[d] = p.a_sub_gain[32 * d + r32];
                    GASF* tdp[4];
#pragma unroll
                    for (int d = 0; d < 4; ++d) { tdp[d] = tmpw + d * 1024; asm volatile("" : "+v"(tdp[d])); }
#pragma unroll
                    for (int r = 0; r < 16; ++r) {
                        float v[4]; float ss = 0.f;
#pragma unroll
                        for (int d = 0; d < 4; ++d) { v[d] = o[d][r] * rli[r] - lam * tdp[d][r * 64]; ss += v[d] * v[d]; }
                        ss += __shfl_xor(ss, 1); ss += __shfl_xor(ss, 2); ss += __shfl_xor(ss, 4); ss += __shfl_xor(ss, 8); ss += __shfl_xor(ss, 16);
                        const float rs = rsqrtf(ss * (1.f / 128.f) + EPS) * 0.8f;
                        bf16* orow = MIX + (size_t)(b * SEQ + q0 + 32 * wid + crow(r, hi)) * MIXW + h * 128 + r32;
#pragma unroll
                        for (int d = 0; d < 4; ++d) orow[32 * d] = (bf16)f2bf(v[d] * rs * gsub[d]);
                        asm volatile("" ::: "memory");
                    }
                }
            }
        }
    }
}
constexpr int RT_WAVE_BYTES = 12288;
constexpr int RT_LDS = 32768 + 8 * RT_WAVE_BYTES;

__device__ __forceinline__ int pl32_sum(int v) { auto rr = __builtin_amdgcn_permlane32_swap((unsigned)v, (unsigned)v, false, false); return (int)(rr[0] + rr[1]); }
__device__ __forceinline__ int pl32_other(int v) { auto rr = __builtin_amdgcn_permlane32_swap((unsigned)v, (unsigned)v, false, false); return (int)(rr[0] + rr[1]) - v; }
__device__ __forceinline__ float unsortkey(unsigned k) { return __uint_as_float((k & 0x80000000u) ? (k ^ 0x80000000u) : ~k); }

template <int N> __device__ __forceinline__ unsigned bisect16(const unsigned (&key)[N]) {
    unsigned prefix = 0u; bool done = false;
#pragma unroll 1
    for (int bit = 31; bit >= 0; --bit) {
        const unsigned cand = done ? prefix : (prefix | (1u << bit));
        int cnt = 0;
#pragma unroll
        for (int i = 0; i + 3 < N; i += 4) cnt_ge4(cnt, key[i], key[i + 1], key[i + 2], key[i + 3], cand);
#pragma unroll
        for (int i = N & ~3; i < N; ++i) cnt += (key[i] >= cand) ? 1 : 0;
        const int tot = pl32_sum(cnt);
        if (!done && tot >= 16) { prefix = cand; done = (tot == 16); }
        if (__all(done)) break;
    }
    return prefix;
}

__device__ __forceinline__ void ph_route(const Params& p, unsigned char* lds, int vb, int nvb) {
    const bf16* Q3 = (const bf16*)(p.ws + WS_Q3); const bf16* SUBK = (const bf16*)(p.ws + WS_SUBK);
    int* EXPI = (int*)(p.ws + WS_EXP); float* GATE = (float*)(p.ws + WS_GATE);
    int tid = threadIdx.x; asm volatile("" : "+v"(tid));
    const int lane = tid & 63, wv = __builtin_amdgcn_readfirstlane(tid >> 6), r32 = lane & 31, hi = lane >> 5;
    for (int i = tid; i < 2048; i += NT) { const int row = i >> 3, ch = i & 7; ((u32x4*)lds)[row * 8 + (ch ^ ((row >> 1) & 7))] = ((const u32x4*)SUBK)[i]; }
    __syncthreads();
    unsigned char* wl = lds + 32768 + wv * RT_WAVE_BYTES;
    float* sv = (float*)wl; int* si = (int*)(wl + 4096); float* fv = (float*)(wl + 8192); int* fe = (int*)(wl + 10240);
    const int gw = vb * NWV + wv, ngw = nvb * NWV;
    for (int item = gw; item < (T / 32) * 8; item += ngw) {
        const int h = item & 7, tok0 = (item >> 3) * 32;
        const bf16* qrow = Q3 + (size_t)(tok0 + r32) * 1024 + h * 128 + hi * 8;
#pragma unroll 1
        for (int c = 0; c < 2; ++c) {
            bf16x8 bq[4];
#pragma unroll
            for (int d0 = 0; d0 < 4; ++d0) bq[d0] = *(const bf16x8*)(qrow + c * 64 + d0 * 16);
            unsigned key[64];
#pragma unroll
            for (int nt = 0; nt < 4; ++nt) {
                f32x16 acc = f32x16{};
                const int krow = c * 128 + nt * 32 + r32, ksw = (krow >> 1) & 7;
                const unsigned char* kp = lds + krow * 128;
#pragma unroll
                for (int d0 = 0; d0 < 4; ++d0) { const bf16x8 ak = *(const bf16x8*)(kp + (((2 * d0 + hi) ^ ksw) << 4)); acc = __builtin_amdgcn_mfma_f32_32x32x16_bf16(ak, bq[d0], acc, 0, 0, 0); }
#pragma unroll
                for (int r = 0; r < 16; ++r) key[nt * 16 + r] = sortkey(acc[r]);
            }
            const unsigned thr = bisect16<64>(key);
            int cnt = 0;
#pragma unroll
            for (int i = 0; i < 64; ++i) cnt += (key[i] >= thr) ? 1 : 0;
            const int other_ = pl32_other(cnt); int slot = hi ? other_ : 0;
            float* svp = sv + (r32 * 2 + c) * 16; int* sip = si + (r32 * 2 + c) * 16;
#pragma unroll
            for (int i = 0; i < 64; ++i) {
                if (key[i] >= thr && slot < 16) { svp[slot] = unsortkey(key[i]); sip[slot] = 32 * (i >> 4) + ((i & 3) + 8 * ((i & 15) >> 2)) + 4 * hi; ++slot; }
            }
        }
        LDS_WAIT(); asm volatile("" ::: "memory");
        {
            float* sv0 = sv + (r32 * 2) * 16; float* sv1 = sv0 + 16; int* si0 = si + (r32 * 2) * 16; int* si1 = si0 + 16;
            {
                float a[16], bl[16];
#pragma unroll
                for (int k = 0; k < 16; ++k) { a[k] = sv0[k]; bl[k] = sv1[k]; }
                int ia[8], ib[8], ra[8], rb[8]; float va[8], vb[8];
#pragma unroll
                for (int q = 0; q < 8; ++q) { const int e = 8 * hi + q; va[q] = sv0[e]; vb[q] = sv1[e]; ia[q] = si0[e]; ib[q] = si1[e]; int r0 = 0, r1 = 0;
#pragma unroll
                    for (int k = 0; k < 16; ++k) { r0 += (a[k] > va[q] || (a[k] == va[q] && k < e)) ? 1 : 0; r1 += (bl[k] > vb[q] || (bl[k] == vb[q] && k < e)) ? 1 : 0; }
                    ra[q] = r0; rb[q] = r1; }
                LDS_WAIT(); asm volatile("" ::: "memory");
                { auto rr = __builtin_amdgcn_permlane32_swap(0u, 0u, false, false); (void)rr; }
#pragma unroll
                for (int q = 0; q < 8; ++q) { sv0[ra[q]] = va[q]; si0[ra[q]] = ia[q]; sv1[rb[q]] = vb[q]; si1[rb[q]] = ib[q]; }
                LDS_WAIT(); asm volatile("" ::: "memory");
            }
            const float* X = hi ? sv1 : sv0; const float* Y = hi ? sv0 : sv1;
            float x[4], y[16];
#pragma unroll
            for (int k = 0; k < 4; ++k) x[k] = X[k];
#pragma unroll
            for (int k = 0; k < 16; ++k) y[k] = Y[k];
            unsigned key[27]; int pi[27], pj[27]; int np = 0;
#pragma unroll
            for (int i = 0; i < 3; ++i)
#pragma unroll
                for (int j = i + 1; j < 16; ++j) if ((i + 1) * (j + 1) <= 16) { key[np] = sortkey(x[i] + y[j]); pi[np] = i; pj[np] = j; ++np; }
#pragma unroll
            for (int i = 0; i < 4; ++i) { key[23 + i] = hi ? 0u : sortkey(x[i] + y[i]); pi[23 + i] = i; pj[23 + i] = i; }
            const unsigned thr = bisect16<27>(key);
            int cnt = 0;
#pragma unroll
            for (int i = 0; i < 27; ++i) cnt += (key[i] >= thr) ? 1 : 0;
            const int other_ = pl32_other(cnt); int slot = hi ? other_ : 0;
            const int* IX = hi ? si1 : si0; const int* IY = hi ? si0 : si1;
            float* fvp = fv + r32 * 16; int* fep = fe + r32 * 16;
#pragma unroll
            for (int i = 0; i < 27; ++i) {
                if (key[i] >= thr && slot < 16) { const int ex = IX[pi[i]], ey = IY[pj[i]]; fvp[slot] = unsortkey(key[i]); fep[slot] = hi ? (ey * 128 + ex) : (ex * 128 + ey); ++slot; }
            }
        }
        LDS_WAIT(); asm volatile("" ::: "memory");
        {
            const float* fvp = fv + r32 * 16;
            float v[16]; float mx = -3e38f;
#pragma unroll
            for (int k = 0; k < 16; ++k) { v[k] = fvp[k]; mx = fmaxf(mx, v[k]); }
            float l = 0.f;
#pragma unroll
            for (int k = 0; k < 16; ++k) { v[k] = __expf(v[k] - mx); l += v[k]; }
            const float il = 1.f / l;
            const size_t ob = (size_t)(tok0 + r32) * 128 + h * 16 + 8 * hi;
            const int* fep = fe + r32 * 16 + 8 * hi;
            f32x4 g0, g1; u32x4 e0, e1;
            if (hi == 0) { g0 = (f32x4){v[0] * il, v[1] * il, v[2] * il, v[3] * il}; g1 = (f32x4){v[4] * il, v[5] * il, v[6] * il, v[7] * il}; }
            else { g0 = (f32x4){v[8] * il, v[9] * il, v[10] * il, v[11] * il}; g1 = (f32x4){v[12] * il, v[13] * il, v[14] * il, v[15] * il}; }
            e0 = *(const u32x4*)fep; e1 = *(const u32x4*)(fep + 4);
            *(f32x4*)(GATE + ob) = g0; *(f32x4*)(GATE + ob + 4) = g1;
            *(u32x4*)(EXPI + ob) = e0; *(u32x4*)(EXPI + ob + 4) = e1;
        }
        LDS_WAIT(); asm volatile("" ::: "memory");
    }
    __syncthreads();
}
typedef float f32x2_t __attribute__((ext_vector_type(2)));
constexpr int P8_UNITS = T / 64;
constexpr int CW_P8_U = 4096, CW_P8_V = 4096 + 32 * 64;
constexpr float U8_SCALE = 32.0f;
__device__ __forceinline__ unsigned peer_xcc() { return (unsigned)__builtin_amdgcn_s_getreg((3 << 11) | 20) & 7u; }
#ifndef U8_HALVES
#define U8_HALVES 0
#endif
template <int LPR>
__device__ __forceinline__ void ph_peer_v8g(const Params& p, unsigned char* lds) {
    constexpr int RPI = 64 / LPR, NI = 128 / RPI, G = NI / 8, NS = 64 / LPR, SLB = 16 * LPR;
    const unsigned char* V8 = (const unsigned char*)(p.ws + WS_V16);
    const int* EXPI = (const int*)(p.ws + WS_EXP); const float* CBUF = (const float*)(p.ws + WS_CBUF); const float* MOD = (const float*)(p.ws + WS_MOD);
    const float* AB1 = (const float*)(p.ws + WS_ABUF1); const float* GATEP = (const float*)(p.ws + WS_GATE); (void)AB1; (void)GATEP;
    unsigned* ctl = (unsigned*)(p.ws + WS_CTL);
    int tid = threadIdx.x; asm volatile("" : "+v"(tid));
    const int lane = tid & 63, wv = __builtin_amdgcn_readfirstlane(tid >> 6), gR = lane / LPR, iC = lane % LPR;
    volatile LAS unsigned* slot = (volatile LAS unsigned*)(LAS unsigned char*)lds;
    const unsigned xcc = peer_xcc();
#pragma unroll 1
    for (int k = 0; k < NS; ++k) {
        const int sl = (int)((((xcc * NS) >> 3) + (unsigned)k) % (unsigned)NS);
        const unsigned char* vcol = V8 + SLB * sl + 16 * iC;
#pragma unroll 1
        for (;;) {
            if (tid == 0) *slot = __hip_atomic_fetch_add(ctl + CW_P8_V + 64 * sl, 1u, __ATOMIC_RELAXED, __HIP_MEMORY_SCOPE_AGENT);
            __syncthreads();
            const unsigned unit = *slot;
            __syncthreads();
            if (unit >= (unsigned)P8_UNITS) break;
            const int tbase = (int)unit * 64 + wv * 8;
            int ne0, ne1; float nc0, nc1;
#if U8_HALVES
#define VG_FETCH(T) do { const size_t tn_ = (size_t)(T); ne0 = EXPI[tn_ * 128 + lane]; ne1 = EXPI[tn_ * 128 + 64 + lane];                              \
        nc0 = gelu_erf(CBUF[tn_ * 128 + lane] + AB1[tn_ * 128 + lane]) * GATEP[tn_ * 128 + lane];                                              \
        nc1 = gelu_erf(CBUF[tn_ * 128 + 64 + lane] + AB1[tn_ * 128 + 64 + lane]) * GATEP[tn_ * 128 + 64 + lane]; } while (0)
#else
#define VG_FETCH(T) do { const size_t tn_ = (size_t)(T); ne0 = EXPI[tn_ * 128 + lane]; ne1 = EXPI[tn_ * 128 + 64 + lane]; nc0 = CBUF[tn_ * 128 + lane]; nc1 = CBUF[tn_ * 128 + 64 + lane]; } while (0)
#endif
#define VG_LISTS(LE, LC) do { LE[lane] = ne0; LE[64 + lane] = ne1; LC[lane] = nc0; LC[64 + lane] = nc1; } while (0)
#define VG_ROWS(R, LE, GI) do { _Pragma("unroll") for (int kk = 0; kk < 8; ++kk) R[kk] = *(const u32x4*)(vcol + (size_t)LE[RPI * (8 * (GI) + kk) + gR] * 1024); } while (0)
#define VG_GROUP(R, LC, GI) do { _Pragma("unroll") for (int kk = 0; kk < 8; ++kk) { const float cj = LC[RPI * (8 * (GI) + kk) + gR];                       \
            const unsigned w_[4] = {R[kk].x, R[kk].y, R[kk].z, R[kk].w};                                                                       \
            _Pragma("unroll") for (int c = 0; c < 4; ++c) { const f32x2_t lo = __builtin_amdgcn_cvt_pk_f32_fp8((int)w_[c], false), hi = __builtin_amdgcn_cvt_pk_f32_fp8((int)w_[c], true); \
                acc[4 * c] = fmaf(cj, lo.x, acc[4 * c]); acc[4 * c + 1] = fmaf(cj, lo.y, acc[4 * c + 1]); acc[4 * c + 2] = fmaf(cj, hi.x, acc[4 * c + 2]); acc[4 * c + 3] = fmaf(cj, hi.y, acc[4 * c + 3]); } } } while (0)
            u32x4 RA[8], RB[8];
            int* lecur = (int*)(lds + 1024 + wv * 2048); int* lenxt = lecur + 256;
            VG_FETCH(tbase); VG_LISTS(lecur, ((float*)(lecur + 128))); VG_FETCH(tbase + 1);
            LDS_WAIT(); asm volatile("" ::: "memory");
            VG_ROWS(RA, lecur, 0);
#pragma unroll 1
            for (int tt = 0; tt < 8; ++tt) {
                const int t = tbase + tt;
                float* lccur = (float*)(lecur + 128); float* lcnxt = (float*)(lenxt + 128);
                float acc[16];
#pragma unroll
                for (int q = 0; q < 16; ++q) acc[q] = 0.f;
                if (tt + 1 < 8) { VG_LISTS(lenxt, lcnxt); if (tt + 2 < 8) VG_FETCH(t + 2); }
#pragma unroll 1
                for (int gi = 0; gi < G; gi += 2) {
                    VG_ROWS(RB, lecur, gi + 1);
                    VG_GROUP(RA, lccur, gi);
                    if (gi + 2 < G) VG_ROWS(RA, lecur, gi + 2);
                    else if (tt + 1 < 8) { LDS_WAIT(); asm volatile("" ::: "memory"); VG_ROWS(RA, lenxt, 0); }
                    VG_GROUP(RB, lccur, gi + 1);
                }
#pragma unroll
                for (int q = 0; q < 16; ++q) { if (LPR <= 8) acc[q] += dpp_f<0x128>(acc[q]); if (LPR <= 16) acc[q] += __shfl_xor(acc[q], 16); if (LPR <= 32) acc[q] += __shfl_xor(acc[q], 32); }
                if (gR == 0) { const int col = SLB * sl + 16 * iC; const float* g2 = MOD + (size_t)(t >> 11) * 6144 + 5120 + col; float* orow = p.out + (size_t)t * 1024 + col;
#pragma unroll
                    for (int q = 0; q < 4; ++q) { const f32x4 xv = *(const f32x4*)(orow + 4 * q), hv = *(const f32x4*)(g2 + 4 * q);
                        f32x4 r; r.x = acc[4 * q]; r.y = acc[4 * q + 1]; r.z = acc[4 * q + 2]; r.w = acc[4 * q + 3]; *(f32x4*)(orow + 4 * q) = xv + hv * r; } }
                { int* tmp_ = lecur; lecur = lenxt; lenxt = tmp_; }
            }
#undef VG_FETCH
#undef VG_LISTS
#undef VG_ROWS
#undef VG_GROUP
            LDS_WAIT(); asm volatile("" ::: "memory");
        }
    }
}
#ifndef SORT_BITS
#define SORT_BITS 3
#endif
#ifndef PEER_SORT
#define PEER_SORT 1
#endif
__device__ __forceinline__ void ph_peer_u8p(const Params& p, unsigned char* lds_w, int gw, int ngw, int lane_) {
    int lane = lane_; asm volatile("" : "+v"(lane));
    const bf16* H = (const bf16*)(p.ws + WS_H); const unsigned char* U8 = (const unsigned char*)(p.ws + WS_U16); const unsigned char* V8 = (const unsigned char*)(p.ws + WS_V16);
    const int* EXPI = (const int*)(p.ws + WS_EXP); const float* GATE = (const float*)(p.ws + WS_GATE); const float* MOD = (const float*)(p.ws + WS_MOD);
    int* e_lds = (int*)lds_w; float* a_lds = (float*)(lds_w + 512); float* g_lds = (float*)(lds_w + 1024); (void)g_lds;
    const int g = lane >> 4, i = lane & 15;
#pragma unroll 1
    for (int t = gw; t < T; t += ngw) {
        int e0 = EXPI[(size_t)t * 128 + lane], e1 = EXPI[(size_t)t * 128 + 64 + lane];
        float g0 = GATE[(size_t)t * 128 + lane], g1 = GATE[(size_t)t * 128 + 64 + lane];
#if PEER_SORT
        {
            const int flip_ = ((t / ngw) & 1) ? ((1 << SORT_BITS) - 1) : 0;
            const int d0 = (e0 >> (14 - SORT_BITS)) ^ flip_, d1 = (e1 >> (14 - SORT_BITS)) ^ flip_; int pos0 = 0, pos1 = 0, run = 0;
#pragma unroll
            for (int d = 0; d < (1 << SORT_BITS); ++d) {
                const unsigned long long m0 = __ballot(d0 == d), m1 = __ballot(d1 == d);
                const int c0 = __popcll(m0), c1 = __popcll(m1);
                const int r0 = (int)__builtin_amdgcn_mbcnt_hi((unsigned)(m0 >> 32), __builtin_amdgcn_mbcnt_lo((unsigned)m0, 0u));
                const int r1 = (int)__builtin_amdgcn_mbcnt_hi((unsigned)(m1 >> 32), __builtin_amdgcn_mbcnt_lo((unsigned)m1, 0u));
                pos0 = (d0 == d) ? run + r0 : pos0; pos1 = (d1 == d) ? run + c0 + r1 : pos1; run += c0 + c1;
            }
            e_lds[pos0] = e0; e_lds[pos1] = e1; g_lds[pos0] = g0; g_lds[pos1] = g1;
            LDS_WAIT(); asm volatile("" ::: "memory");
            e0 = e_lds[lane]; e1 = e_lds[64 + lane]; g0 = g_lds[lane]; g1 = g_lds[64 + lane];
            int* EW = (int*)(p.ws + WS_EXP) + (size_t)t * 128; EW[lane] = e0; EW[64 + lane] = e1;
        }
#else
        e_lds[lane] = e0; e_lds[64 + lane] = e1;
#endif
        float xf[64];
        { const u32x4* xrow = (const u32x4*)(H + (size_t)t * 1024) + 2 * i;
#pragma unroll
          for (int q = 0; q < 4; ++q) { const u32x4 a = xrow[32 * q], b = xrow[32 * q + 1];
              xf[16 * q] = bflo(a.x); xf[16 * q + 1] = bfhi(a.x); xf[16 * q + 2] = bflo(a.y); xf[16 * q + 3] = bfhi(a.y); xf[16 * q + 4] = bflo(a.z); xf[16 * q + 5] = bfhi(a.z); xf[16 * q + 6] = bflo(a.w); xf[16 * q + 7] = bfhi(a.w);
              xf[16 * q + 8] = bflo(b.x); xf[16 * q + 9] = bfhi(b.x); xf[16 * q + 10] = bflo(b.y); xf[16 * q + 11] = bfhi(b.y); xf[16 * q + 12] = bflo(b.z); xf[16 * q + 13] = bfhi(b.z); xf[16 * q + 14] = bflo(b.w); xf[16 * q + 15] = bfhi(b.w); } }
        LDS_WAIT(); asm volatile("" ::: "memory");
#define P8T_ULOAD(R, S) do { const u32x4* r_ = (const u32x4*)(U8 + (size_t)e_lds[4 * (S) + g] * 1024) + i; _Pragma("unroll") for (int q = 0; q < 4; ++q) R[q] = r_[16 * q]; } while (0)
#define P8T_UDOT(R, S) do { float a0 = 0.f, a1 = 0.f, a2 = 0.f, a3 = 0.f;                                                                               \
        _Pragma("unroll") for (int q = 0; q < 4; ++q) { const unsigned w_[4] = {R[q].x, R[q].y, R[q].z, R[q].w};                                           \
            _Pragma("unroll") for (int c = 0; c < 4; ++c) { const f32x2_t lo = __builtin_amdgcn_cvt_pk_f32_fp8((int)w_[c], false), hi = __builtin_amdgcn_cvt_pk_f32_fp8((int)w_[c], true); \
                a0 = fmaf(lo.x, xf[16 * q + 4 * c], a0); a1 = fmaf(lo.y, xf[16 * q + 4 * c + 1], a1); a2 = fmaf(hi.x, xf[16 * q + 4 * c + 2], a2); a3 = fmaf(hi.y, xf[16 * q + 4 * c + 3], a3); } } \
        const float a_ = row16_sum((a0 + a1) + (a2 + a3)) * (1.0f / U8_SCALE); if (i == 0) a_lds[4 * (S) + g] = a_; } while (0)
        { u32x4 RA[4], RB[4], RC[4];
          P8T_ULOAD(RA, 0); P8T_ULOAD(RB, 1);
#pragma unroll 1
          for (int s = 0; s < 30; s += 3) {
              P8T_ULOAD(RC, s + 2); P8T_UDOT(RA, s);
              P8T_ULOAD(RA, s + 3); P8T_UDOT(RB, s + 1);
              P8T_ULOAD(RB, s + 4); P8T_UDOT(RC, s + 2);
          }
          P8T_UDOT(RA, 30); P8T_UDOT(RB, 31); }
#undef P8T_ULOAD
#undef P8T_UDOT
        LDS_WAIT(); asm volatile("" ::: "memory");
        const float c0 = gelu_erf(a_lds[lane]) * g0, c1 = gelu_erf(a_lds[64 + lane]) * g1;
        float* CB = (float*)(p.ws + WS_CBUF) + (size_t)t * 128; CB[lane] = c0; CB[64 + lane] = c1;
    }
}
__device__ __forceinline__ void ph_peer_u8h(const Params& p, unsigned char* lds) {
    const bf16* H = (const bf16*)(p.ws + WS_H); const unsigned char* U8 = (const unsigned char*)(p.ws + WS_U16);
    const int* EXPI = (const int*)(p.ws + WS_EXP);
    unsigned* ctl = (unsigned*)(p.ws + WS_CTL);
    int tid = threadIdx.x; asm volatile("" : "+v"(tid));
    const int lane = tid & 63, wv = __builtin_amdgcn_readfirstlane(tid >> 6), hw = lane >> 5, i5 = lane & 31;
    volatile LAS unsigned* slot = (volatile LAS unsigned*)(LAS unsigned char*)lds;
    float* a_lds = (float*)(lds + 1024 + wv * 2048 + 1024);
    const unsigned xcc = peer_xcc();
#pragma unroll 1
    for (int k = 0; k < 2; ++k) {
        const int sl = (int)(((xcc >> 2) + (unsigned)k) & 1u);
        float* AB = (float*)(p.ws + (sl ? WS_ABUF1 : WS_CBUF));
        const unsigned char* ucol = U8 + 512 * sl + 16 * i5;
#pragma unroll 1
        for (;;) {
            if (tid == 0) *slot = __hip_atomic_fetch_add(ctl + CW_P8_U + 64 * sl, 1u, __ATOMIC_RELAXED, __HIP_MEMORY_SCOPE_AGENT);
            __syncthreads();
            const unsigned unit = *slot;
            __syncthreads();
            if (unit >= (unsigned)P8_UNITS) break;
            const int tbase = (int)unit * 64 + wv * 8;
            int ne0, ne1; u32x4 nx0, nx1;
#define UH_FETCH(T) do { const size_t tn_ = (size_t)(T); ne0 = EXPI[tn_ * 128 + lane]; ne1 = EXPI[tn_ * 128 + 64 + lane];                          \
        const u32x4* xr_ = (const u32x4*)(H + tn_ * 1024 + 512 * sl) + 2 * i5; nx0 = xr_[0]; nx1 = xr_[1]; } while (0)
#define UH_LISTS(LE) do { LE[lane] = ne0; LE[64 + lane] = ne1; } while (0)
#define UH_ROWS(R, LE, GI) do { _Pragma("unroll") for (int kk = 0; kk < 8; ++kk) R[kk] = *(const u32x4*)(ucol + (size_t)LE[2 * (8 * (GI) + kk) + hw] * 1024); } while (0)
#define UH_GROUP(R, GI) do { _Pragma("unroll") for (int kk = 0; kk < 8; ++kk) { float a0 = 0.f, a1 = 0.f, a2 = 0.f, a3 = 0.f;                         \
            const unsigned w_[4] = {R[kk].x, R[kk].y, R[kk].z, R[kk].w};                                                                       \
            _Pragma("unroll") for (int c = 0; c < 4; ++c) { const f32x2_t lo = __builtin_amdgcn_cvt_pk_f32_fp8((int)w_[c], false), hi = __builtin_amdgcn_cvt_pk_f32_fp8((int)w_[c], true); \
                a0 = fmaf(lo.x, xf[4 * c], a0); a1 = fmaf(lo.y, xf[4 * c + 1], a1); a2 = fmaf(hi.x, xf[4 * c + 2], a2); a3 = fmaf(hi.y, xf[4 * c + 3], a3); }                        \
            float s_ = row16_sum((a0 + a1) + (a2 + a3)); s_ += __shfl_xor(s_, 16);                                                              \
            if (i5 == 0) a_lds[2 * (8 * (GI) + kk) + hw] = s_ * (1.0f / U8_SCALE); } } while (0)
            u32x4 RA[8], RB[8];
            int* lecur = (int*)(lds + 1024 + wv * 2048); int* lenxt = lecur + 128;
            UH_FETCH(tbase); UH_LISTS(lecur);
            float xf[16];
#define UH_XF() do { xf[0] = bflo(nx0.x); xf[1] = bfhi(nx0.x); xf[2] = bflo(nx0.y); xf[3] = bfhi(nx0.y); xf[4] = bflo(nx0.z); xf[5] = bfhi(nx0.z); xf[6] = bflo(nx0.w); xf[7] = bfhi(nx0.w); \
        xf[8] = bflo(nx1.x); xf[9] = bfhi(nx1.x); xf[10] = bflo(nx1.y); xf[11] = bfhi(nx1.y); xf[12] = bflo(nx1.z); xf[13] = bfhi(nx1.z); xf[14] = bflo(nx1.w); xf[15] = bfhi(nx1.w); } while (0)
            UH_XF();
            UH_FETCH(tbase + 1);
            LDS_WAIT(); asm volatile("" ::: "memory");
            UH_ROWS(RA, lecur, 0);
#pragma unroll 1
            for (int tt = 0; tt < 8; ++tt) {
                const int t = tbase + tt;
                float xn[16];
                if (tt + 1 < 8) { UH_LISTS(lenxt);
#pragma unroll
                    for (int q = 0; q < 16; ++q) xn[q] = 0.f;
                    xn[0] = bflo(nx0.x); xn[1] = bfhi(nx0.x); xn[2] = bflo(nx0.y); xn[3] = bfhi(nx0.y); xn[4] = bflo(nx0.z); xn[5] = bfhi(nx0.z); xn[6] = bflo(nx0.w); xn[7] = bfhi(nx0.w);
                    xn[8] = bflo(nx1.x); xn[9] = bfhi(nx1.x); xn[10] = bflo(nx1.y); xn[11] = bfhi(nx1.y); xn[12] = bflo(nx1.z); xn[13] = bfhi(nx1.z); xn[14] = bflo(nx1.w); xn[15] = bfhi(nx1.w);
                    if (tt + 2 < 8) UH_FETCH(t + 2); }
#pragma unroll 1
                for (int gi = 0; gi < 8; gi += 2) {
                    UH_ROWS(RB, lecur, gi + 1);
                    UH_GROUP(RA, gi);
                    if (gi + 2 < 8) UH_ROWS(RA, lecur, gi + 2);
                    else if (tt + 1 < 8) { LDS_WAIT(); asm volatile("" ::: "memory"); UH_ROWS(RA, lenxt, 0); }
                    UH_GROUP(RB, gi + 1);
                }
                LDS_WAIT(); asm volatile("" ::: "memory");
                { float* ab = AB + (size_t)t * 128; ab[lane] = a_lds[lane]; ab[64 + lane] = a_lds[64 + lane]; }
                LDS_WAIT(); asm volatile("" ::: "memory");
                if (tt + 1 < 8) {
#pragma unroll
                    for (int q = 0; q < 16; ++q) xf[q] = xn[q]; }
                { int* tmp_ = lecur; lecur = lenxt; lenxt = tmp_; }
            }
#undef UH_FETCH
#undef UH_LISTS
#undef UH_ROWS
#undef UH_GROUP
#undef UH_XF
        }
    }
}
#define XB_TMO      128
#define XB_XCNT(j)  (256  + 64 * (j))
#define XB_XSUB(j)  (1280 + 64 * (j))
#define XB_XGEN(j)  (2304 + 64 * (j))
#define XB_TOP      3328
#define XB_TOPGEN   3392
#define XCD_BAR_WORDS 3456
#define XB_SPIN_CAP (1u << 18)

__device__ __forceinline__ unsigned xb_ld(unsigned* p)              { return __hip_atomic_load(p, __ATOMIC_RELAXED, __HIP_MEMORY_SCOPE_AGENT); }
__device__ __forceinline__ unsigned xb_add(unsigned* p, unsigned v) { return __hip_atomic_fetch_add(p, v, __ATOMIC_RELAXED, __HIP_MEMORY_SCOPE_AGENT); }
__device__ __forceinline__ unsigned xb_xcc_id() { return (unsigned)__builtin_amdgcn_s_getreg((3 << 11) | 20) & 0xFu; }
#define XB_SPIN(cond, bar) do { unsigned _sp = 0; while (cond) { __builtin_amdgcn_s_sleep(1); \
    if ((++_sp & 255u) == 0u) { if (xb_ld(&(bar)[XB_TMO])) break; if (_sp > XB_SPIN_CAP) { atomicAdd(&(bar)[XB_TMO], 1u); break; } } } } while (0)

struct XcdBarrier {
    unsigned* bar; unsigned x;
    volatile LAS unsigned* st;
};

__device__ __forceinline__ XcdBarrier xcd_barrier_post(unsigned* bar, volatile LAS unsigned* st) {
    XcdBarrier b; b.bar = bar; b.x = xb_xcc_id(); b.st = st;
    if (threadIdx.x == 0) (void)xb_add(&bar[XB_XCNT(b.x)], 1u);
    return b;
}
__device__ __forceinline__ void xcd_barrier_complete(unsigned* bar, unsigned x, unsigned& nloc, unsigned& nx) {
    const unsigned G = gridDim.x * gridDim.y * gridDim.z;
    unsigned sum, cnt, mine, sp = 0u;
    for (;;) {
        sum = 0u; cnt = 0u; mine = 0u;
#pragma unroll
        for (unsigned j = 0; j < 16; ++j) { const unsigned c = xb_ld(&bar[XB_XCNT(j)]); sum += c; cnt += (c > 0u) ? 1u : 0u; mine = (j == x) ? c : mine; }
        if (sum == G) break;
        __builtin_amdgcn_s_sleep(1);
        if ((++sp & 255u) == 0u) { if (xb_ld(&bar[XB_TMO])) break; if (sp > XB_SPIN_CAP) { atomicAdd(&bar[XB_TMO], 1u); break; } }
    }
    nloc = mine > 0u ? mine : 1u; nx = cnt > 0u ? cnt : 1u;
}

__device__ __forceinline__ void xcd_barrier(const XcdBarrier& b) {
    asm volatile("s_waitcnt vmcnt(0)" ::: "memory");
    __syncthreads();
    if (threadIdx.x == 0) {
        unsigned* bar = b.bar;
        __builtin_amdgcn_s_waitcnt(0);
        unsigned nloc = b.st[0], nx = b.st[1];
        if (nloc == 0u) { xcd_barrier_complete(bar, b.x, nloc, nx); b.st[0] = nloc; b.st[1] = nx; }
        const unsigned old = xb_add(&bar[XB_XSUB(b.x)], 1u);
        const unsigned gen = old / nloc;
        if (old + 1u == (gen + 1u) * nloc) {
            __builtin_amdgcn_fence(__ATOMIC_RELEASE, "agent");
            asm volatile("s_waitcnt vmcnt(0)" ::: "memory");
            const unsigned og = xb_add(&bar[XB_TOP], 1u);
            const unsigned tg = og / nx;
            if (og + 1u == (tg + 1u) * nx) xb_add(&bar[XB_TOPGEN], 1u);
            else XB_SPIN(xb_ld(&bar[XB_TOPGEN]) == tg, bar);
            __builtin_amdgcn_fence(__ATOMIC_ACQUIRE, "agent");
            xb_add(&bar[XB_XGEN(b.x)], 1u);
            asm volatile("s_waitcnt vmcnt(0)" ::: "memory");
        } else {
            XB_SPIN(xb_ld(&bar[XB_XGEN(b.x)]) == gen, bar);
            __builtin_amdgcn_fence(__ATOMIC_ACQUIRE, "agent");
            asm volatile("s_waitcnt vmcnt(0)" ::: "memory");
        }
    }
    __syncthreads();
}

#ifndef V8_LPR
#define V8_LPR 32
#endif
constexpr int LDS_BYTES = 147456;
extern __shared__ __attribute__((aligned(16))) unsigned char dyn_lds[];

__global__ void __launch_bounds__(NT, 2) mega_fwd(Params p) {
    cg::grid_group grid = cg::this_grid();
    const int vb = blockIdx.x, nvb = gridDim.x, ngw = nvb * NWV;
    volatile LAS unsigned* xst = (volatile LAS unsigned*)((LAS unsigned char*)dyn_lds + (LDS_BYTES - 16));
    if (threadIdx.x < 4) xst[threadIdx.x] = 0u;
    __syncthreads();
    const XcdBarrier xbar = xcd_barrier_post((unsigned*)(p.ws + WS_CTL), xst);
#define TID_LAUNDER int tid_ = threadIdx.x; asm volatile("" : "+v"(tid_)); const int lane = tid_ & 63, wv = tid_ >> 6, gw = vb * NWV + wv; (void)lane; (void)gw;
    grid.sync();
    ph_mod(p, (float*)dyn_lds, vb, nvb);
    { TID_LAUNDER ph_prep_weights(p, (LAS float*)dyn_lds + wv * (64 * 33), gw, ngw, lane); }
    xcd_barrier(xbar);
    { TID_LAUNDER ph_hrows(p, p.x, p.norm1_g, 0, 1024, gw, ngw, lane); }
    xcd_barrier(xbar);
    {   pg8::Gemm g{(const bf16*)(p.ws + WS_H), (const bf16*)(p.ws + WS_WIN), T, NP, 1024}; pg8::StaticOrder S; S.init(T, NP, nvb, vb);
        EpiNormBf16 E{(bf16*)(p.ws + WS_PROJ), p.a_qk_gain, p.b_q_gain, p.b_kv_gain, (LAS float*)((LAS unsigned char*)dyn_lds + 131072), (bf16*)(p.ws + WS_KVC)};
        pg8::gemm_phase<EpiNormBf16, pg8::StaticOrder, true, true>((LAS unsigned char*)dyn_lds, g, S, E); }
    xcd_barrier(xbar);
    ph_attnA(p, dyn_lds, vb, nvb);
    __syncthreads();
    ph_dsa(p, dyn_lds, vb, nvb);
    xcd_barrier(xbar);
    {   pg8::Gemm g{(const bf16*)(p.ws + WS_MIX), (const bf16*)(p.ws + WS_WO2), T, 1024, MIXW}; pg8::StaticOrder S; S.init(T, 1024, nvb, vb);
        EpiResGate E{p.x, p.out, (const float*)(p.ws + WS_MOD) + 2048};
        pg8::gemm_phase<EpiResGate, pg8::StaticOrder, true, true>((LAS unsigned char*)dyn_lds, g, S, E); }
    xcd_barrier(xbar);
    { TID_LAUNDER ph_hrows(p, p.out, p.norm2_g, 3072, 4096, gw, ngw, lane); }
    xcd_barrier(xbar);
    {   pg8::Gemm g{(const bf16*)(p.ws + WS_H), (const bf16*)(p.ws + WS_WQ), T, 1024, 1024}; pg8::StaticOrder S; S.init(T, 1024, nvb, vb);
        pg8::EpiBf16<0> E{(bf16*)(p.ws + WS_Q3), 1024, nullptr, 0, 0, 1.f};
        pg8::gemm_phase<pg8::EpiBf16<0>, pg8::StaticOrder, true, true>((LAS unsigned char*)dyn_lds, g, S, E); }
    xcd_barrier(xbar);
    ph_route(p, dyn_lds, vb, nvb);
    xcd_barrier(xbar);

#if U8_HALVES
    ph_peer_u8h(p, dyn_lds);
#else
    { TID_LAUNDER ph_peer_u8p(p, dyn_lds + wv * 2048, gw, ngw, lane); }
#endif
    xcd_barrier(xbar);
    ph_peer_v8g<V8_LPR>(p, dyn_lds);

}

extern "C" void kernel_launch(void* const* d_in, const int* in_sizes, int n_in, void* d_out, int out_size, void* d_ws, size_t ws_size, hipStream_t stream) {
    static int grid_blocks = 0;
    if (grid_blocks == 0) {
        if (n_in != 18 || in_sizes[0] != T * DM || out_size != T * DM || ws_size < WS_END) { fprintf(stderr, "kernel_launch: unexpected shapes n_in %d in0 %d out %d ws %zu\n", n_in, n_in > 0 ? in_sizes[0] : -1, out_size, ws_size); grid_blocks = -1; return; }
        int dev = 0, cus = 0, per_cu = 0;
        (void)hipGetDevice(&dev);
        (void)hipDeviceGetAttribute(&cus, hipDeviceAttributeMultiprocessorCount, dev);
        (void)hipFuncSetAttribute((const void*)mega_fwd, hipFuncAttributeMaxDynamicSharedMemorySize, LDS_BYTES);
        (void)hipOccupancyMaxActiveBlocksPerMultiprocessor(&per_cu, (const void*)mega_fwd, NT, LDS_BYTES);
        if (per_cu < 1 || cus < 1) { fprintf(stderr, "kernel_launch: occupancy query gave %d blocks/CU on %d CUs\n", per_cu, cus); grid_blocks = -1; return; }
        grid_blocks = cus;
    }
    if (grid_blocks < 0) return;
    Params p{};
    const float** pp = (const float**)&p;
    for (int i = 0; i < 18; ++i) pp[i] = (const float*)d_in[i];
    p.out = (float*)d_out; p.ws = (unsigned char*)d_ws;
    if (hipMemsetAsync((char*)d_ws + WS_CTL, 0, CTL_BYTES, stream) != hipSuccess) { fprintf(stderr, "kernel_launch: memset failed\n"); return; }
    void* args[] = {&p};
    const hipError_t e = hipLaunchCooperativeKernel((const void*)mega_fwd, dim3(grid_blocks), dim3(NT), args, LDS_BYTES, stream);
    if (e != hipSuccess) fprintf(stderr, "kernel_launch: cooperative launch failed: %s (grid %d)\n", hipGetErrorString(e), grid_blocks);
}
```

```cpp
#include <hip/hip_runtime.h>
#include <hip/hip_cooperative_groups.h>
#include <cstdio>
#include <cstdint>
#include <cmath>
namespace pg8 {
#define PG8_LAS __attribute__((address_space(3)))
typedef unsigned short bf16_t;
typedef short bf16x8 __attribute__((ext_vector_type(8)));
typedef float f32x4 __attribute__((ext_vector_type(4)));
typedef unsigned u32x4 __attribute__((ext_vector_type(4)));
constexpr int BM = 256, BK = 64, HALF = 128, HTB = HALF * BK * 2  , STAGE_BYTES = 8 * HTB, NXCD = 8, WGM = 8;

__host__ __device__ __forceinline__ int lds_byte(int r, int c) { const int st = (r >> 4) * 2 + (c >> 5), rr = r & 15, cc = c & 31, ob = rr * 64 + cc * 2; return st * 1024 + (ob ^ (((ob >> 9) & 1) << 5)); }
__host__ __device__ __forceinline__ void stage_rc(int b, int& R, int& C) { const int st = b / 1024, sb = b % 1024, swz = sb ^ (((sb >> 9) & 1) << 5); R = (st >> 1) * 16 + swz / 64; C = (st & 1) * 32 + (swz % 64) / 2; }
__host__ __device__ __forceinline__ int perm32(int rho) { const int n = rho >> 4, i = rho & 15; return 8 * (i >> 2) + 4 * n + (i & 3); }

struct Unit { int pm, pn; };
struct Gemm { const bf16_t* A; const bf16_t* Bt; int M, N, K; };

struct StaticOrder {
    int nM, nN, nwg, G, c;
    __host__ __device__ void init(int M, int N, int G_, int c_) { nM = M / BM; nN = N / BM; nwg = nM * nN; G = G_; c = c_; }
    __host__ __device__ bool next(int i, Unit& u) const {
        const long L = (long)i * G + c; if (L >= nwg) return false;
        int wgid = (int)L; { const int q = nwg / NXCD, r = nwg % NXCD, xcd = wgid % NXCD, off = wgid / NXCD; wgid = (xcd < r ? xcd * (q + 1) : r * (q + 1) + (xcd - r) * q) + off; }
        const int nig = WGM * nN, gid = wgid / nig, fm = gid * WGM, gsz = (nM - fm) < WGM ? (nM - fm) : WGM;
        u.pm = fm + ((wgid % nig) % gsz); u.pn = (wgid % nig) / gsz; return true;
    }
    __device__ __forceinline__ void a_ready(const Unit&) const {}
    __device__ __forceinline__ void done(const Unit&) const {}
};

__device__ __forceinline__ unsigned cvt_pk_bf16(float lo, float hi) { unsigned r; asm volatile("v_cvt_pk_bf16_f32 %0, %1, %2" : "=v"(r) : "v"(lo), "v"(hi)); return r; }
typedef float f32x2 __attribute__((ext_vector_type(2)));
__device__ __forceinline__ f32x2 gelu_pk(f32x2 v) {
    const f32x2 av = __builtin_elementwise_abs(v), d = av * 0.2316418882f + 1.0f;
    f32x2 t; t.x = __builtin_amdgcn_rcpf(d.x); t.y = __builtin_amdgcn_rcpf(d.y);
    f32x2 q = t * 0.5307027145f + (-0.7265760135f); q = q * t + 0.7107068705f; q = q * t + (-0.142248368f); q = q * t + 0.127414796f; q = q * t;
    const f32x2 s = (v * v) * (-0.72134752044f);
    f32x2 e; e.x = __builtin_amdgcn_exp2f(s.x); e.y = __builtin_amdgcn_exp2f(s.y);
    const f32x2 m = v * (q * e), r = v - m;
    f32x2 o; o.x = v.x < 0.f ? m.x : r.x; o.y = v.y < 0.f ? m.y : r.y; return o;
}

template <int ACT  > struct EpiBf16 {
    static constexpr bool PERM = true, AFTER_DRAIN = false; static_assert(ACT == 0 || ACT == 1, "EpiBf16: ACT is 0 (none) or 1 (gelu_pk)");
    bf16_t* O; int ldc; const float* bias; int split_cols; size_t split_stride; float scale0;
    __device__ __forceinline__ void operator()(const f32x4 (&acc)[2][2][4][2], const Unit& u, int wr, int wc, int fr, int fq) const {
        const int row0 = u.pm * BM + wr * 64 + fr; int colt = u.pn * BM; bf16_t* base = O;
        float sc = 1.f; if (split_cols) { const int t = colt / split_cols; base += (size_t)t * split_stride; colt -= t * split_cols; if (t == 0) sc = scale0; }
        const int col0 = colt + wc * 32 + 8 * fq, bcol0 = u.pn * BM + wc * 32 + 8 * fq;
        f32x4 bv[2][2];
#pragma unroll
        for (int bj = 0; bj < 2; ++bj)
#pragma unroll
            for (int n = 0; n < 2; ++n) bv[bj][n] = bias ? *(const f32x4*)(bias + bcol0 + bj * HALF + 4 * n) : (f32x4){0.f, 0.f, 0.f, 0.f};
#pragma unroll
        for (int ai = 0; ai < 2; ++ai)
#pragma unroll
            for (int m = 0; m < 4; ++m) { bf16_t* rowp = base + (size_t)(row0 + ai * HALF + m * 16) * ldc + col0;
#pragma unroll
                for (int bj = 0; bj < 2; ++bj) { f32x4 v0 = acc[ai][bj][m][0] + bv[bj][0], v1 = acc[ai][bj][m][1] + bv[bj][1];
                    if (ACT == 1) { f32x2 a = gelu_pk((f32x2){v0[0], v0[1]}), b = gelu_pk((f32x2){v0[2], v0[3]}), c = gelu_pk((f32x2){v1[0], v1[1]}), d = gelu_pk((f32x2){v1[2], v1[3]});
                        v0 = (f32x4){a.x, a.y, b.x, b.y}; v1 = (f32x4){c.x, c.y, d.x, d.y}; }
                    v0 = v0 * sc; v1 = v1 * sc; u32x4 w; w.x = cvt_pk_bf16(v0[0], v0[1]); w.y = cvt_pk_bf16(v0[2], v0[3]); w.z = cvt_pk_bf16(v1[0], v1[1]); w.w = cvt_pk_bf16(v1[2], v1[3]);
                    *(u32x4*)(rowp + bj * HALF) = w; } }
    }
};

template <class Epi, class Sched, bool ALIGN_EPI = false, bool SP2 = false>
__device__ __forceinline__ void gemm_phase(PG8_LAS unsigned char* lds, const Gemm g, const Sched& S, const Epi& E) {
    int tid = threadIdx.x; asm volatile("" : "+v"(tid)); const int wid = __builtin_amdgcn_readfirstlane(tid >> 6), lane = tid & 63, wr = wid >> 2, wc = wid & 3, fr = lane & 15, fq = lane >> 4;
    const int K = g.K, nt = K / BK;
    unsigned voffA[2], voffB[2];
#pragma unroll
    for (int i = 0; i < 2; ++i) { int R, C; stage_rc(tid * 16 + i * 8192, R, C); const int Rb = Epi::PERM ? ((R & ~31) + perm32(R & 31)) : R;
        voffA[i] = (unsigned)(R * K + C) * 2u; voffB[i] = (unsigned)(Rb * K + C) * 2u; }
    const size_t kstep = (size_t)(BK * 2);
    const size_t hstep = (size_t)HALF * K * 2;
    const size_t tstep = 2 * hstep;
    const unsigned ldsw = (unsigned)wid * 1024u;
    const int aoff = lds_byte(wr * 64 + fr, fq * 8), boff = lds_byte(wc * 32 + fr, fq * 8);
#define PG8_SA(b, h) (((b) * 2 + (h)) * HTB)
#define PG8_SB(b, h) ((4 + (b) * 2 + (h)) * HTB)
#define PG8_STAGE(bufoff, gbase, voff) do { _Pragma("unroll") for (int _i = 0; _i < 2; ++_i) \
        __builtin_amdgcn_global_load_lds((const unsigned*)((const char*)(gbase) + (voff)[_i]), (PG8_LAS unsigned*)(lds + (bufoff) + ldsw + _i * 8192), 16, 0, 0); } while (0)
#define PG8_LDA(dst, b, h) do { _Pragma("unroll") for (int m = 0; m < 4; ++m) _Pragma("unroll") for (int k = 0; k < 2; ++k) dst[m][k] = *(const PG8_LAS bf16x8*)(lds + PG8_SA(b, h) + aoff + m * 2048 + k * 1024); } while (0)
#define PG8_LDB(dst, b, h) do { _Pragma("unroll") for (int n = 0; n < 2; ++n) _Pragma("unroll") for (int k = 0; k < 2; ++k) dst[n][k] = *(const PG8_LAS bf16x8*)(lds + PG8_SB(b, h) + boff + n * 2048 + k * 1024); } while (0)
#define PG8_MMA(ai, bj, At, Bt) do { __builtin_amdgcn_s_setprio(1); _Pragma("unroll") for (int m = 0; m < 4; ++m) _Pragma("unroll") for (int n = 0; n < 2; ++n) _Pragma("unroll") for (int k = 0; k < 2; ++k) \
        acc[ai][bj][m][n] = __builtin_amdgcn_mfma_f32_16x16x32_bf16(Bt[n][k], At[m][k], acc[ai][bj][m][n], 0, 0, 0); __builtin_amdgcn_s_setprio(0); } while (0)
#define PG8_WAIT_V(n) asm volatile("s_waitcnt vmcnt(" #n ")" ::: "memory")
#define PG8_WAIT_L(n) asm volatile("s_waitcnt lgkmcnt(" #n ")" ::: "memory")
#define PG8_BAR __builtin_amdgcn_s_barrier()
#define PG8_SCHED __builtin_amdgcn_sched_barrier(0)
    Unit cur, nxt; int ui = 0;
    if (!S.next(0, cur)) return;
    f32x4 acc[2][2][4][2];
#pragma unroll
    for (int a = 0; a < 2; ++a)
#pragma unroll
        for (int b = 0; b < 2; ++b)
#pragma unroll
            for (int m = 0; m < 4; ++m)
#pragma unroll
                for (int n = 0; n < 2; ++n) acc[a][b][m][n] = (f32x4){0.f, 0.f, 0.f, 0.f};
    bf16x8 At[4][2], B0[2][2], B1[2][2];
    const char* cA = (const char*)g.A + (size_t)cur.pm * tstep; const char* cB = (const char*)g.Bt + (size_t)cur.pn * tstep;
    S.a_ready(cur);
    if constexpr (SP2) {
        PG8_STAGE(PG8_SB(0, 0), cB, voffB); PG8_STAGE(PG8_SB(0, 1), cB + hstep, voffB); PG8_STAGE(PG8_SA(0, 0), cA, voffA); PG8_STAGE(PG8_SA(0, 1), cA + hstep, voffA);
        if (wr == 1) PG8_BAR;
        PG8_WAIT_V(2); PG8_BAR;
        PG8_STAGE(PG8_SB(1, 0), cB + kstep, voffB); PG8_STAGE(PG8_SA(1, 0), cA + kstep, voffA); PG8_STAGE(PG8_SB(1, 1), cB + hstep + kstep, voffB);
        PG8_WAIT_V(6); PG8_BAR;
    } else {
        PG8_STAGE(PG8_SB(0, 0), cB, voffB); PG8_STAGE(PG8_SA(0, 0), cA, voffA); PG8_STAGE(PG8_SB(0, 1), cB + hstep, voffB); PG8_STAGE(PG8_SA(0, 1), cA + hstep, voffA);
        if (wr == 1) PG8_BAR;
        PG8_WAIT_V(4); PG8_BAR;
        PG8_STAGE(PG8_SB(1, 0), cB + kstep, voffB); PG8_STAGE(PG8_SA(1, 0), cA + kstep, voffA); PG8_STAGE(PG8_SB(1, 1), cB + hstep + kstep, voffB);
        PG8_WAIT_V(6); PG8_BAR;
    }
    for (;;) {
        const bool has_next = S.next(ui + 1, nxt);
        const char* nA = has_next ? (const char*)g.A + (size_t)nxt.pm * tstep : cA; const char* nB = has_next ? (const char*)g.Bt + (size_t)nxt.pn * tstep : cB;
        for (int t = 0; t < nt; t += 2) {
            const bool last = (t == nt - 2);
            const char* a1 = cA + (size_t)(t + 1) * kstep;
            const char* a2 = last ? nA : cA + (size_t)(t + 2) * kstep; const char* b2 = last ? nB : cB + (size_t)(t + 2) * kstep;
            const char* a3 = a2 + kstep; const char* b3 = b2 + kstep;
            if (last && has_next) S.a_ready(nxt);
            if constexpr (SP2) {
            PG8_LDB(B0, 0, 0); PG8_LDB(B1, 0, 1); PG8_SCHED; PG8_LDA(At, 0, 0); PG8_STAGE(PG8_SA(1, 1), a1 + hstep, voffA);
            PG8_WAIT_V(8); PG8_WAIT_L(0); PG8_BAR; PG8_MMA(0, 0, At, B0); PG8_MMA(0, 1, At, B1); PG8_BAR; PG8_SCHED;
            PG8_LDA(At, 0, 1); PG8_STAGE(PG8_SB(0, 0), b2, voffB); PG8_STAGE(PG8_SB(0, 1), b2 + hstep, voffB); PG8_STAGE(PG8_SA(0, 0), a2, voffA);
            PG8_WAIT_V(8); PG8_WAIT_L(0); PG8_BAR; PG8_MMA(1, 0, At, B0); PG8_MMA(1, 1, At, B1); PG8_BAR; PG8_SCHED;
            PG8_LDB(B0, 1, 0); PG8_LDB(B1, 1, 1); PG8_SCHED; PG8_LDA(At, 1, 0); PG8_STAGE(PG8_SA(0, 1), a2 + hstep, voffA);
            PG8_WAIT_V(8); PG8_WAIT_L(0); PG8_BAR; PG8_MMA(0, 0, At, B0); PG8_MMA(0, 1, At, B1); PG8_BAR; PG8_SCHED;
            PG8_LDA(At, 1, 1); PG8_STAGE(PG8_SB(1, 0), b3, voffB); PG8_STAGE(PG8_SB(1, 1), b3 + hstep, voffB); PG8_STAGE(PG8_SA(1, 0), a3, voffA);
            PG8_WAIT_V(8); PG8_WAIT_L(0); PG8_BAR; PG8_MMA(1, 0, At, B0); PG8_MMA(1, 1, At, B1); PG8_BAR; PG8_SCHED;
            } else {
            PG8_LDB(B0, 0, 0); PG8_SCHED; PG8_LDA(At, 0, 0); PG8_STAGE(PG8_SA(1, 1), a1 + hstep, voffA);
            PG8_WAIT_L(8); PG8_BAR; PG8_WAIT_L(0); PG8_MMA(0, 0, At, B0); PG8_BAR; PG8_SCHED;
            PG8_LDB(B1, 0, 1); PG8_STAGE(PG8_SB(0, 0), b2, voffB);
            PG8_BAR; PG8_WAIT_L(0); PG8_MMA(0, 1, At, B1); PG8_BAR;
            PG8_LDA(At, 0, 1); PG8_STAGE(PG8_SA(0, 0), a2, voffA);
            PG8_BAR; PG8_WAIT_L(0); PG8_MMA(1, 0, At, B0); PG8_BAR; PG8_SCHED;
            PG8_STAGE(PG8_SB(0, 1), b2 + hstep, voffB);
            PG8_WAIT_V(6); PG8_BAR; PG8_MMA(1, 1, At, B1); PG8_BAR;
            PG8_LDB(B0, 1, 0); PG8_SCHED; PG8_LDA(At, 1, 0); PG8_STAGE(PG8_SA(0, 1), a2 + hstep, voffA);
            PG8_WAIT_L(8); PG8_BAR; PG8_WAIT_L(0); PG8_MMA(0, 0, At, B0); PG8_BAR; PG8_SCHED;
            PG8_LDB(B1, 1, 1); PG8_STAGE(PG8_SB(1, 0), b3, voffB);
            PG8_BAR; PG8_WAIT_L(0); PG8_MMA(0, 1, At, B1); PG8_BAR;
            PG8_LDA(At, 1, 1); PG8_STAGE(PG8_SA(1, 0), a3, voffA);
            PG8_BAR; PG8_WAIT_L(0); PG8_MMA(1, 0, At, B0); PG8_BAR; PG8_SCHED;
            PG8_STAGE(PG8_SB(1, 1), b3 + hstep, voffB);
            PG8_WAIT_V(6); PG8_BAR; PG8_MMA(1, 1, At, B1); PG8_BAR;
            }
        }
        if constexpr (ALIGN_EPI) { if (wr == 0) PG8_BAR; }
        if constexpr (!Epi::AFTER_DRAIN) { E(acc, cur, wr, wc, fr, fq); S.done(cur); }
        if (!has_next) break;
#pragma unroll
        for (int a = 0; a < 2; ++a)
#pragma unroll
            for (int b = 0; b < 2; ++b)
#pragma unroll
                for (int m = 0; m < 4; ++m)
#pragma unroll
                    for (int n = 0; n < 2; ++n) acc[a][b][m][n] = (f32x4){0.f, 0.f, 0.f, 0.f};
        cur = nxt; cA = nA; cB = nB; ++ui;
        if constexpr (ALIGN_EPI) { if (wr == 1) PG8_BAR; }
    }
    PG8_WAIT_V(0);
    if constexpr (!ALIGN_EPI) { if (wr == 0) PG8_BAR; }
    PG8_BAR;
    if constexpr (Epi::AFTER_DRAIN) { E.fused(acc, cur, wr, wc, fr, fq, lds, wid, lane); S.done(cur); }
#undef PG8_SA
#undef PG8_SB
#undef PG8_STAGE
#undef PG8_LDA
#undef PG8_LDB
#undef PG8_MMA
#undef PG8_WAIT_V
#undef PG8_WAIT_L
#undef PG8_BAR
#undef PG8_SCHED
}
}
namespace cg = cooperative_groups;
#define LAS __attribute__((address_space(3)))
typedef unsigned short bf16;
typedef float f32x4 __attribute__((ext_vector_type(4)));
typedef float f32x8 __attribute__((ext_vector_type(8)));
typedef float f32x16 __attribute__((ext_vector_type(16)));
typedef unsigned u32x4 __attribute__((ext_vector_type(4)));
typedef unsigned u32x2 __attribute__((ext_vector_type(2)));
typedef short bf16x8 __attribute__((ext_vector_type(8)));
typedef short s16x4 __attribute__((ext_vector_type(4)));

constexpr int BATCH = 16, SEQ = 2048, DM = 1024, T = BATCH * SEQ;
constexpr int NP = 3072;
constexpr int IN_COLS = 3012;
constexpr int C_QA = 0, C_KA = 512, C_VA = 1024, C_QB = 1536, C_KV = 2560, C_QI = 2688, C_KI = 2944, C_WI = 3008;
constexpr int MIXW = 1536;
constexpr int NEXP = 16384;
constexpr float EPS = 1e-6f;
constexpr int NT = 512;
constexpr int NWV = 8;

constexpr size_t MiB = 1u << 20;
constexpr size_t WS_CTL = 0;
constexpr size_t CTL_BYTES = 64 * 1024;
constexpr size_t WS_MOD = 1 * MiB;
constexpr size_t WS_SCAL = WS_MOD + 512 * 1024;
constexpr size_t WS_WIN = 2 * MiB;
constexpr size_t WS_WO2 = 8 * MiB;
constexpr size_t WS_WQ = 11 * MiB;
constexpr size_t WS_SUBK = 13 * MiB;
constexpr size_t WS_U16 = 14 * MiB;
constexpr size_t WS_V16 = 46 * MiB;
constexpr size_t WS_H = 78 * MiB;
constexpr size_t WS_PROJ = 142 * MiB;
constexpr size_t WS_Q3 = WS_PROJ;
constexpr size_t WS_MIX = 334 * MiB;
constexpr size_t WS_EXP = 430 * MiB;
constexpr size_t WS_KVC = WS_EXP;
constexpr size_t WS_GATE = 446 * MiB;
constexpr size_t WS_ATMP = 462 * MiB;
constexpr size_t WS_CBUF = 494 * MiB;
constexpr size_t WS_ABUF1 = WS_MIX;
constexpr size_t WS_END = 510 * MiB;

struct Params {
    const float *x, *c, *ada_w, *ada_b, *norm1_g, *norm2_g, *w_in, *a_qk_gain, *a_lambda, *a_sub_gain, *b_q_gain, *b_kv_gain, *b_w_uv, *w_out, *peer_wq, *peer_subkeys, *peer_u, *peer_v;
    float* out; unsigned char* ws;
};

enum { SC_LAM = 0, SC_MA = 1, SC_MB = 2 };

__device__ __forceinline__ unsigned f2bf(float f) { unsigned u = __float_as_uint(f); return (u + 0x7fffu + ((u >> 16) & 1u)) >> 16; }
__device__ __forceinline__ float bf2f(unsigned h) { return __uint_as_float(h << 16); }
__device__ __forceinline__ unsigned pk2(float lo, float hi) { return f2bf(lo) | (f2bf(hi) << 16); }
__device__ __forceinline__ float bflo(unsigned w) { return __uint_as_float(w << 16); }
__device__ __forceinline__ float bfhi(unsigned w) { return __uint_as_float(w & 0xffff0000u); }
__device__ __forceinline__ float wave_sum(float v) {
#pragma unroll
    for (int o = 1; o < 64; o <<= 1) v += __shfl_xor(v, o);
    return v;
}
__device__ __forceinline__ float wave_max(float v) {
#pragma unroll
    for (int o = 1; o < 64; o <<= 1) v = fmaxf(v, __shfl_xor(v, o));
    return v;
}
#define LDS_WAIT() asm volatile("s_waitcnt lgkmcnt(0)" ::: "memory")
__device__ __forceinline__ void ph_mod(const Params& p, float* ldsf, int vb, int nvb) {
    if (vb >= 96) return;
    int tid = threadIdx.x; asm volatile("" : "+v"(tid));
    const int lane = tid & 63, wv = tid >> 6;
    for (int i = tid; i < 16 * 1024; i += NT) { const float v = p.c[i]; ldsf[i] = v / (1.f + __expf(-v)); }
    __syncthreads();
    float* MOD = (float*)(p.ws + WS_MOD); float* part = ldsf + 16 * 1024;
    for (int it = vb; it < 96; it += nvb) {
        const int j = it * 64 + lane;
        float acc[16];
#pragma unroll
        for (int b = 0; b < 16; ++b) acc[b] = 0.f;
        const float* wp = p.ada_w + (size_t)(128 * wv) * 6144 + j;
#pragma unroll 1
        for (int k0 = 0; k0 < 128; k0 += 8) {
            float w[8];
#pragma unroll
            for (int u = 0; u < 8; ++u) w[u] = wp[(size_t)(k0 + u) * 6144];
#pragma unroll
            for (int u = 0; u < 8; ++u)
#pragma unroll
                for (int b = 0; b < 16; ++b) acc[b] = fmaf(ldsf[b * 1024 + 128 * wv + k0 + u], w[u], acc[b]);
        }
#pragma unroll
        for (int b = 0; b < 16; ++b) part[(wv * 16 + b) * 64 + lane] = acc[b];
        __syncthreads();
        for (int o = tid; o < 16 * 64; o += NT) { const int b = o >> 6, c = o & 63; float s = 0.f;
#pragma unroll
            for (int w = 0; w < 8; ++w) s += part[(w * 16 + b) * 64 + c];
            MOD[b * 6144 + it * 64 + c] = s + p.ada_b[it * 64 + c]; }
        __syncthreads();
    }
}

__device__ __forceinline__ void transpose_item(const float* W, int N, bf16* WT, int ldt, LAS float* scr, int kb, int nb, int lane) {
    const int k0 = 64 * kb, n0 = 32 * nb;
#pragma unroll 8
    for (int i = 0; i < 32; ++i) { const int kk = 2 * i + (lane >> 5); const int n = n0 + (lane & 31); scr[kk * 33 + (lane & 31)] = (n < N) ? W[(size_t)(k0 + kk) * N + n] : 0.f; }
    LDS_WAIT(); asm volatile("" ::: "memory");
    const int c = lane & 7;
#pragma unroll
    for (int j = 0; j < 4; ++j) { const int n = (lane >> 3) + 8 * j; const LAS float* s = scr + (8 * c) * 33 + n;
        u32x4 o; o.x = pk2(s[0 * 33], s[1 * 33]); o.y = pk2(s[2 * 33], s[3 * 33]); o.z = pk2(s[4 * 33], s[5 * 33]); o.w = pk2(s[6 * 33], s[7 * 33]);
        *(u32x4*)(WT + (size_t)(n0 + n) * ldt + k0 + 8 * c) = o; }
    LDS_WAIT(); asm volatile("" ::: "memory");
}

__device__ __forceinline__ void ph_prep_weights(const Params& p, LAS float* scr, int gw, int ngw, int lane) {
    bf16* WIN = (bf16*)(p.ws + WS_WIN); bf16* WO2 = (bf16*)(p.ws + WS_WO2); bf16* WQ = (bf16*)(p.ws + WS_WQ);
    constexpr int I_IN = 16 * 96, I_O = 8 * 32, I_Q = 16 * 32;
    for (int it = gw; it < I_IN + I_O + I_Q; it += ngw) {
        int r = it;
        if (r < I_IN) { transpose_item(p.w_in, IN_COLS, WIN, 1024, scr, r / 96, r % 96, lane); continue; } r -= I_IN;
        if (r < I_O) { transpose_item(p.w_out, 1024, WO2, MIXW, scr, r / 32, r % 32, lane); continue; } r -= I_O;
        transpose_item(p.peer_wq, 1024, WQ, 1024, scr, r / 32, r % 32, lane);
    }
    const size_t gt = (size_t)gw * 64 + lane, ngt = (size_t)ngw * 64;
    for (size_t i = gt; i < (size_t)1024 * 1024; i += ngt) {
        const int n = (int)(i & 1023), kk = (int)(i >> 10), h = kk >> 7;
        const float* wu = p.b_w_uv + (size_t)kk * 64; const float* wo = p.w_out + (size_t)(512 + 64 * h) * 1024 + n;
        float a = 0.f;
#pragma unroll 8
        for (int e = 0; e < 64; ++e) a = fmaf(wu[e], wo[(size_t)e * 1024], a);
        WO2[(size_t)n * MIXW + 512 + kk] = (bf16)f2bf(a);
    }
    unsigned char* U8 = (unsigned char*)(p.ws + WS_U16); unsigned char* V8 = (unsigned char*)(p.ws + WS_V16); bf16* SUBK = (bf16*)(p.ws + WS_SUBK);
    constexpr size_t NTAB8 = (size_t)NEXP * 1024 / 8, NSUB8 = 2 * 128 * 64 / 8;
    for (size_t i = gt; i < 2 * NTAB8 + NSUB8; i += ngt) {
        if (i < 2 * NTAB8) {
            const bool isu = i < NTAB8; const size_t j = isu ? i : i - NTAB8; const float sc = isu ? 32.0f : 1.0f;
            const f32x8 v = *(const f32x8*)((isu ? p.peer_u : p.peer_v) + j * 8);
            int w0 = 0, w1 = 0;
            w0 = __builtin_amdgcn_cvt_pk_fp8_f32(v[0] * sc, v[1] * sc, w0, false); w0 = __builtin_amdgcn_cvt_pk_fp8_f32(v[2] * sc, v[3] * sc, w0, true);
            w1 = __builtin_amdgcn_cvt_pk_fp8_f32(v[4] * sc, v[5] * sc, w1, false); w1 = __builtin_amdgcn_cvt_pk_fp8_f32(v[6] * sc, v[7] * sc, w1, true);
            u32x2 o; o.x = (unsigned)w0; o.y = (unsigned)w1;
            *(u32x2*)((isu ? U8 : V8) + j * 8) = o;
        } else {
            const size_t j = i - 2 * NTAB8;
            const f32x8 v = *(const f32x8*)(p.peer_subkeys + j * 8);
            u32x4 o; o.x = pk2(v[0], v[1]); o.y = pk2(v[2], v[3]); o.z = pk2(v[4], v[5]); o.w = pk2(v[6], v[7]);
            *(u32x4*)(SUBK + j * 8) = o;
        }
    }
    if (gt == 0) {
        float* SC = (float*)(p.ws + WS_SCAL);
        float s01 = 0.f, s23 = 0.f;
        for (int i = 0; i < 64; ++i) { s01 += p.a_lambda[i] * p.a_lambda[64 + i]; s23 += p.a_lambda[128 + i] * p.a_lambda[192 + i]; }
        SC[SC_LAM] = __expf(s01) - __expf(s23) + 0.2f;
        float g0 = 0.f, g1 = 0.f, gq = 0.f, gk = 0.f;
        for (int i = 0; i < 64; ++i) { g0 = fmaxf(g0, fabsf(p.a_qk_gain[i])); g1 = fmaxf(g1, fabsf(p.a_qk_gain[64 + i])); }
        for (int i = 0; i < 128; ++i) { gq = fmaxf(gq, fabsf(p.b_q_gain[i])); gk = fmaxf(gk, fabsf(p.b_kv_gain[i])); }
        SC[SC_MA] = 8.0f * g0 * g1 * 1.02f;
        SC[SC_MB] = 11.3137085f * gq * gk * 1.02f;
    }
}

__device__ __forceinline__ void ph_hrows(const Params& p, const float* X, const float* g, int shOff, int scOff, int gw, int ngw, int lane) {
    const float* MOD = (const float*)(p.ws + WS_MOD); bf16* H = (bf16*)(p.ws + WS_H);
    for (int m = gw; m < T; m += ngw) {
        const f32x4* xr = (const f32x4*)(X + (size_t)m * 1024) + lane;
        f32x4 v[4]; float s = 0.f;
#pragma unroll
        for (int j = 0; j < 4; ++j) { v[j] = xr[64 * j]; s += (v[j].x * v[j].x + v[j].y * v[j].y) + (v[j].z * v[j].z + v[j].w * v[j].w); }
        const float rstd = rsqrtf(wave_sum(s) * (1.f / 1024.f) + EPS);
        const float* mb = MOD + (size_t)(m >> 11) * 6144;
#pragma unroll
        for (int j = 0; j < 4; ++j) {
            const int col = 4 * (lane + 64 * j);
            const f32x4 gg = *(const f32x4*)(g + col), sc = *(const f32x4*)(mb + scOff + col), sh = *(const f32x4*)(mb + shOff + col);
            const f32x4 y = v[j] * rstd * gg * (sc + 1.0f) + sh;
            u32x2 o; o.x = pk2(y.x, y.y); o.y = pk2(y.z, y.w);
            *(u32x2*)(H + (size_t)m * 1024 + col) = o;
        }
    }
}

__device__ __forceinline__ void ph_norm_proj(const Params& p, int gw, int ngw, int lane) {
    bf16* PROJ = (bf16*)(p.ws + WS_PROJ);
    for (int m = gw; m < T; m += ngw) {
        bf16* row = PROJ + (size_t)m * NP;
#pragma unroll
        for (int j = 0; j < 6; ++j) {
            if (j == 2) continue;
            const int col = 8 * lane + 512 * j;
            const u32x4 raw = *(const u32x4*)(row + col);
            float v[8] = {bflo(raw.x), bfhi(raw.x), bflo(raw.y), bfhi(raw.y), bflo(raw.z), bfhi(raw.z), bflo(raw.w), bfhi(raw.w)};
            float ss = 0.f;
#pragma unroll
            for (int i = 0; i < 8; ++i) ss += v[i] * v[i];
            ss += __shfl_xor(ss, 1); ss += __shfl_xor(ss, 2); ss += __shfl_xor(ss, 4);
            float rstd; const float* gp;
            if (j < 2) { rstd = rsqrtf(ss * (1.f / 64.f) + EPS); gp = p.a_qk_gain + 64 * j + (col & 63); }
            else { ss += __shfl_xor(ss, 8); rstd = rsqrtf(ss * (1.f / 128.f) + EPS); gp = (j == 5 ? p.b_kv_gain : p.b_q_gain) + (col & 127); }
            if (j == 5 && lane >= 16) continue;
            const f32x4 g0 = *(const f32x4*)gp, g1 = *(const f32x4*)(gp + 4);
            u32x4 o; o.x = pk2(v[0] * rstd * g0.x, v[1] * rstd * g0.y); o.y = pk2(v[2] * rstd * g0.z, v[3] * rstd * g0.w);
            o.z = pk2(v[4] * rstd * g1.x, v[5] * rstd * g1.y); o.w = pk2(v[6] * rstd * g1.z, v[7] * rstd * g1.w);
            *(u32x4*)(row + col) = o;
        }
    }
}
struct EpiResGate {
    static constexpr bool PERM = false, AFTER_DRAIN = false;
    const float* X; float* Out; const float* gate;
    __device__ __forceinline__ void operator()(const pg8::f32x4 (&acc)[2][2][4][2], const pg8::Unit& u, int wr, int wc, int fr, int fq) const {
        const int col0 = u.pn * 256 + wc * 32 + 4 * fq;
#pragma unroll
        for (int ai = 0; ai < 2; ++ai)
#pragma unroll
            for (int m = 0; m < 4; ++m) {
                const int r = u.pm * 256 + ai * 128 + wr * 64 + m * 16 + fr; const float* gb = gate + (size_t)(r >> 11) * 6144;
#pragma unroll
                for (int bj = 0; bj < 2; ++bj)
#pragma unroll
                    for (int n = 0; n < 2; ++n) { const int c = col0 + bj * 128 + n * 16; const size_t off = (size_t)r * 1024 + c;
                        const pg8::f32x4 xv = *(const pg8::f32x4*)(X + off), gv = *(const pg8::f32x4*)(gb + c);
                        *(pg8::f32x4*)(Out + off) = xv + gv * acc[ai][bj][m][n]; }
            }
    }
};


struct EpiNormBf16 {
    static constexpr bool PERM = true, AFTER_DRAIN = false;
    bf16* O; const float* gqk; const float* gbq; const float* gbkv; LAS float* P; bf16* KVC;
    __device__ __forceinline__ void operator()(const pg8::f32x4 (&acc)[2][2][4][2], const pg8::Unit& u, int wr, int wc, int fr, int fq) const {
        const int pn = u.pn;
        const int mode = pn < 4 ? 1 : ((pn == 4 || pn == 5 || pn == 11) ? 0 : (pn == 10 ? 3 : 2));
        if (mode != 0) {
#pragma unroll
            for (int ai = 0; ai < 2; ++ai)
#pragma unroll
                for (int m = 0; m < 4; ++m)
#pragma unroll
                    for (int bj = 0; bj < 2; ++bj) {
                        const pg8::f32x4 a = acc[ai][bj][m][0], b = acc[ai][bj][m][1];
                        float ss = (a[0] * a[0] + a[1] * a[1]) + (a[2] * a[2] + a[3] * a[3]) + (b[0] * b[0] + b[1] * b[1]) + (b[2] * b[2] + b[3] * b[3]);
                        ss += __shfl_xor(ss, 16); ss += __shfl_xor(ss, 32);
                        if (fq == 0) P[(ai * 128 + wr * 64 + m * 16 + fr) * 8 + bj * 4 + wc] = ss;
                    }
            asm volatile("s_waitcnt lgkmcnt(0)" ::: "memory"); __builtin_amdgcn_s_barrier(); asm volatile("" ::: "memory");
        }
        const int row0 = u.pm * 256 + wr * 64 + fr, col0 = u.pn * 256 + wc * 32 + 8 * fq;
        pg8::f32x4 g0[2], g1[2];
#pragma unroll
        for (int bj = 0; bj < 2; ++bj) {
            const float* gp = nullptr;
            if (mode == 1) gp = gqk + (pn >= 2 ? 64 : 0) + 32 * (wc & 1) + 8 * fq;
            else if (mode == 2) gp = gbq + 32 * wc + 8 * fq;
            else if (mode == 3 && bj == 0) gp = gbkv + 32 * wc + 8 * fq;
            if (gp) { g0[bj] = *(const pg8::f32x4*)gp; g1[bj] = *(const pg8::f32x4*)(gp + 4); } else { g0[bj] = (pg8::f32x4){1.f, 1.f, 1.f, 1.f}; g1[bj] = g0[bj]; }
        }
#pragma unroll
        for (int ai = 0; ai < 2; ++ai)
#pragma unroll
            for (int m = 0; m < 4; ++m) { bf16* rowp = O + (size_t)(row0 + ai * 128 + m * 16) * NP + col0;
#pragma unroll
                for (int bj = 0; bj < 2; ++bj) {
                    float s = 1.f;
                    if (mode != 0 && !(mode == 3 && bj == 1)) {
                        const pg8::f32x4 q = *(const LAS pg8::f32x4*)(P + (ai * 128 + wr * 64 + m * 16 + fr) * 8 + bj * 4);
                        s = (mode == 1) ? rsqrtf(((wc < 2) ? (q[0] + q[1]) : (q[2] + q[3])) * (1.f / 64.f) + EPS) : rsqrtf(((q[0] + q[1]) + (q[2] + q[3])) * (1.f / 128.f) + EPS);
                    }
                    const pg8::f32x4 v0 = acc[ai][bj][m][0] * s * g0[bj], v1 = acc[ai][bj][m][1] * s * g1[bj];
                    pg8::u32x4 w; w.x = pg8::cvt_pk_bf16(v0[0], v0[1]); w.y = pg8::cvt_pk_bf16(v0[2], v0[3]); w.z = pg8::cvt_pk_bf16(v1[0], v1[1]); w.w = pg8::cvt_pk_bf16(v1[2], v1[3]);
                    if (pn == 10 && bj == 0) *(pg8::u32x4*)(KVC + (size_t)(row0 + ai * 128 + m * 16) * 128 + wc * 32 + 8 * fq) = w;
                    else *(pg8::u32x4*)(rowp + bj * 128) = w; } }
    }
};
typedef __bf16 bf16x2_t __attribute__((ext_vector_type(2)));
__device__ __forceinline__ float dot2bf(unsigned a, unsigned b, float acc) { return __builtin_amdgcn_fdot2_f32_bf16(__builtin_bit_cast(bf16x2_t, a), __builtin_bit_cast(bf16x2_t, b), acc, false); }
template <int CTRL> __device__ __forceinline__ float dpp_f(float v) { return __int_as_float(__builtin_amdgcn_update_dpp(0, __float_as_int(v), CTRL, 0xf, 0xf, false)); }
__device__ __forceinline__ float row16_sum(float v) {
    v += dpp_f<0x128>(v); v += dpp_f<0x124>(v); v += dpp_f<0x122>(v); v += dpp_f<0x121>(v); return v;
}
__device__ __forceinline__ float gelu_erf(float v) {
    const float av = fabsf(v), t = __builtin_amdgcn_rcpf(fmaf(av, 0.2316418882f, 1.0f));
    float q = fmaf(t, 0.5307027145f, -0.7265760135f); q = fmaf(q, t, 0.7107068705f); q = fmaf(q, t, -0.142248368f); q = fmaf(q, t, 0.127414796f); q = q * t;
    const float e = __builtin_amdgcn_exp2f(v * v * -0.72134752044f);
    const float m = v * (q * e);
    return v < 0.f ? m : v - m;
}

#ifndef DSA_PB
#define DSA_PB 0
#endif
typedef short v4i16_t __attribute__((ext_vector_type(4)));
#ifndef DSA_REP_A
#define DSA_REP_A 1
#endif
#ifndef DSA_REP_B
#define DSA_REP_B 1
#endif
#ifndef DSA_REP_C
#define DSA_REP_C 1
#endif
constexpr int DSA_SROW = 2048 * 4 + 16;
constexpr int DSA_SEL_OFF = 16 * DSA_SROW;
constexpr int DSA_LDS = DSA_SEL_OFF + 16 * 512;
constexpr int DSA_KVROW = 272;

__device__ __forceinline__ unsigned sortkey(float s) { const unsigned u = __float_as_uint(s); return u ^ ((u >> 31) ? 0xffffffffu : 0x80000000u); }
__device__ __forceinline__ unsigned cvtpk_bf16(float lo, float hi) { unsigned r; asm volatile("v_cvt_pk_bf16_f32 %0, %1, %2" : "=v"(r) : "v"(lo), "v"(hi)); return r; }

__device__ __forceinline__ void cnt_ge4(int& acc, unsigned k0, unsigned k1, unsigned k2, unsigned k3, unsigned cand) {
    asm volatile("v_cmp_ge_u32_e64 s[40:41], %1, %5\n\t"
                 "v_cmp_ge_u32_e64 s[42:43], %2, %5\n\t"
                 "v_cmp_ge_u32_e64 s[44:45], %3, %5\n\t"
                 "v_cmp_ge_u32_e64 s[46:47], %4, %5\n\t"
                 "v_addc_co_u32_e64 %0, s[48:49], %0, 0, s[40:41]\n\t"
                 "v_addc_co_u32_e64 %0, s[48:49], %0, 0, s[42:43]\n\t"
                 "v_addc_co_u32_e64 %0, s[48:49], %0, 0, s[44:45]\n\t"
                 "v_addc_co_u32_e64 %0, s[48:49], %0, 0, s[46:47]"
                 : "+v"(acc) : "v"(k0), "v"(k1), "v"(k2), "v"(k3), "v"(cand)
                 : "s40", "s41", "s42", "s43", "s44", "s45", "s46", "s47", "s48", "s49");
}
__device__ __forceinline__ void ph_dsa(const Params& p, unsigned char* lds, int vb, int nvb) {
    const bf16* PROJ = (const bf16*)(p.ws + WS_PROJ); bf16* MIX = (bf16*)(p.ws + WS_MIX);
    const float MB = ((const float*)(p.ws + WS_SCAL))[SC_MB];
    int tid = threadIdx.x; asm volatile("" : "+v"(tid)); const int lane = tid & 63, wv = __builtin_amdgcn_readfirstlane(tid >> 6);
    const int l15 = lane & 15, g = lane >> 4;
    LAS unsigned char* ldsl = (LAS unsigned char*)lds;
    for (int it = vb; it < 2048; it += nvb) {
        const int vbb = it & 255, kk = it >> 8, xg = vbb & 7, ix = vbb >> 3, b = 2 * xg + (ix & 1), G = (ix >> 1) & 3, sub = ix >> 3;
        const int c = (kk & 1) ? (31 - G - 8 * (kk >> 1)) : (G + 8 * (kk >> 1));
        const int cend = (c + 1) * 64, t0 = c * 64 + sub * 16;
        const bf16* Pb = PROJ + (size_t)b * SEQ * NP;
        const bf16* KVb = (const bf16*)(p.ws + WS_KVC) + (size_t)b * SEQ * 128;
#pragma unroll 1
        for (int repa = 0; repa < DSA_REP_A; ++repa)
        if (c >= 4) {
            const bf16* qrow = Pb + (size_t)(t0 + l15) * NP;
            bf16x8 bq[4][2]; float wsc[4];
#pragma unroll
            for (int h = 0; h < 4; ++h) { wsc[h] = bf2f(qrow[C_WI + h]) * 0.0625f;
#pragma unroll
                for (int ks = 0; ks < 2; ++ks) bq[h][ks] = *(const bf16x8*)(qrow + C_QI + h * 64 + 32 * ks + 8 * g); }
            for (int k0 = 16 * wv; k0 < cend; k0 += 128) {
                const bf16* krow = Pb + (size_t)(k0 + l15) * NP + C_KI + 8 * g;
                const bf16x8 ka0 = *(const bf16x8*)krow, ka1 = *(const bf16x8*)(krow + 32);
                f32x4 sc = {0.f, 0.f, 0.f, 0.f};
#pragma unroll
                for (int h = 0; h < 4; ++h) { f32x4 a = {0.f, 0.f, 0.f, 0.f};
                    a = __builtin_amdgcn_mfma_f32_16x16x32_bf16(ka0, bq[h][0], a, 0, 0, 0);
                    a = __builtin_amdgcn_mfma_f32_16x16x32_bf16(ka1, bq[h][1], a, 0, 0, 0);
#pragma unroll
                    for (int r = 0; r < 4; ++r) sc[r] = fmaf(fmaxf(a[r], 0.f), wsc[h], sc[r]); }
#pragma unroll
                for (int r = 0; r < 4; ++r) sc[r] = (sc[r] == 0.f) ? 0.f : sc[r];
                *(LAS f32x4*)(ldsl + l15 * DSA_SROW + (k0 + 4 * g) * 4) = sc;
            }
        }
        __syncthreads();
        LAS unsigned short* selw = (LAS unsigned short*)(ldsl + DSA_SEL_OFF);
        int mind0 = 0, mind1 = 0;
        if (c < 4) {
            for (int j = lane; j < 256; j += 64) { selw[(2 * wv) * 256 + j] = (unsigned short)j; selw[(2 * wv + 1) * 256 + j] = (unsigned short)j; }
        } else {
            const int nreg = cend >> 6;
            unsigned keyA[32], keyB[32];
            { const LAS float* srA = (const LAS float*)(ldsl + (2 * wv) * DSA_SROW) + lane; const LAS float* srB = (const LAS float*)(ldsl + (2 * wv + 1) * DSA_SROW) + lane;
#pragma unroll
              for (int i = 0; i < 32; ++i) { keyA[i] = (i < nreg) ? sortkey(srA[64 * i]) : 0u; keyB[i] = (i < nreg) ? sortkey(srB[64 * i]) : 0u; } }
#define DSA_WSUM(V, OUT) do { int v_ = (V); v_ += __builtin_amdgcn_update_dpp(0, v_, 0x128, 0xf, 0xf, false); v_ += __builtin_amdgcn_update_dpp(0, v_, 0x124, 0xf, 0xf, false); \
        v_ += __builtin_amdgcn_update_dpp(0, v_, 0x122, 0xf, 0xf, false); v_ += __builtin_amdgcn_update_dpp(0, v_, 0x121, 0xf, 0xf, false);                                     \
        OUT = __builtin_amdgcn_readlane(v_, 0) + __builtin_amdgcn_readlane(v_, 16) + __builtin_amdgcn_readlane(v_, 32) + __builtin_amdgcn_readlane(v_, 48); } while (0)
            unsigned prefA = 0u, prefB = 0u; bool exA = false, exB = false;
#pragma unroll 1
            for (int bit = 31; bit >= 0; --bit) {
                const unsigned candA = exA ? prefA : (prefA | (1u << bit)), candB = exB ? prefB : (prefB | (1u << bit));
                int ca = 0, cb = 0;
#pragma unroll
                for (int i = 0; i < 32; i += 4) { cnt_ge4(ca, keyA[i], keyA[i + 1], keyA[i + 2], keyA[i + 3], candA); cnt_ge4(cb, keyB[i], keyB[i + 1], keyB[i + 2], keyB[i + 3], candB); }
                int cntA, cntB; DSA_WSUM(ca, cntA); DSA_WSUM(cb, cntB);
                if (!exA && cntA >= 256) { prefA = candA; exA = (cntA == 256); }
                if (!exB && cntB >= 256) { prefB = candB; exB = (cntB == 256); }
                if (exA && exB) break;
            }
#define DSA_COMPACT(KEY, PREFIX, EXACT, QQ, MIND) do {                                                                                              \
            const int t_ = t0 + (QQ); LAS unsigned short* sel = selw + (QQ) * 256;                                                                    \
            int need_ties = 0;                                                                                                                        \
            if (!(EXACT)) { int cg_ = 0; if ((PREFIX) != 0xffffffffu) { _Pragma("unroll") for (int i = 0; i < 32; ++i) cg_ += (KEY[i] > (PREFIX)) ? 1 : 0; } \
                int cgt; DSA_WSUM(cg_, cgt); need_ties = 256 - cgt; }                                                                                 \
            int base = 0, tbase = 0, md = 4096;                                                                                                       \
            _Pragma("unroll") for (int i = 0; i < 32; ++i) { if (i < nreg) {                                                                          \
                bool selb;                                                                                                                            \
                if (EXACT) selb = KEY[i] >= (PREFIX);                                                                                                 \
                else { const bool tie = KEY[i] == (PREFIX); const unsigned long long mt = __ballot(tie);                                              \
                    const int trank = tbase + (int)__builtin_amdgcn_mbcnt_hi((unsigned)(mt >> 32), __builtin_amdgcn_mbcnt_lo((unsigned)mt, 0u));      \
                    selb = (KEY[i] > (PREFIX)) || (tie && trank < need_ties); tbase += __popcll(mt); }                                                \
                const unsigned long long m = __ballot(selb);                                                                                          \
                const int pos = base + (int)__builtin_amdgcn_mbcnt_hi((unsigned)(m >> 32), __builtin_amdgcn_mbcnt_lo((unsigned)m, 0u));               \
                const int kidx = i * 64 + lane;                                                                                                       \
                if (selb) { sel[pos] = (unsigned short)kidx; const int d = t_ > kidx ? t_ - kidx : kidx - t_; md = d < md ? d : md; }                 \
                base += __popcll(m); } }                                                                                                              \
            _Pragma("unroll") for (int o = 1; o < 64; o <<= 1) { const int x = __shfl_xor(md, o); md = x < md ? x : md; }                             \
            MIND = md; } while (0)
            DSA_COMPACT(keyA, prefA, exA, 2 * wv, mind0);
            DSA_COMPACT(keyB, prefB, exB, 2 * wv + 1, mind1);
#undef DSA_COMPACT
#undef DSA_WSUM
        }
        LDS_WAIT(); asm volatile("" ::: "memory");
        const int nvalid = cend < 256 ? cend : 256;
        const int head = lane & 7;
        const float slopeL2 = exp2f(-(float)(head + 1)) * 1.4426950409f;
#pragma unroll 1
        for (int qi2 = 0; qi2 < 2 * DSA_REP_C; ++qi2) { const int qi = qi2 & 1;
            const int qq = 2 * wv + qi, t = t0 + qq;
            const LAS unsigned short* sel = selw + qq * 256;
            LAS unsigned char* stg = ldsl + (2 * wv) * DSA_SROW;
            const bf16* qrow = Pb + (size_t)t * NP + C_QB + head * 128 + 8 * g;
            bf16x8 bq[4];
#pragma unroll
            for (int ks = 0; ks < 4; ++ks) bq[ks] = *(const bf16x8*)(qrow + 32 * ks);
            const float refL2 = MB * 1.4426950409f - slopeL2 * (float)(qi == 0 ? mind0 : mind1);
            f32x4 o[8];
#pragma unroll
            for (int dt = 0; dt < 8; ++dt) o[dt] = (f32x4){0.f, 0.f, 0.f, 0.f};
            float lsum = 0.f;
#define DSA_GATHER(S, KA) do { _Pragma("unroll") for (int i_ = 0; i_ < 8; ++i_) { const int jr = 32 * (S) + 4 * i_ + g; const int keyr = sel[jr < nvalid ? jr : 0];   \
        KA[i_] = *(const bf16x8*)(KVb + (size_t)keyr * 128 + 8 * l15); } } while (0)
#define DSA_COMPUTE(S, KA) do { unsigned pb[4];                                                                                                        \
        _Pragma("unroll") for (int i_ = 0; i_ < 8; ++i_) *(LAS bf16x8*)(stg + (4 * i_ + g) * DSA_KVROW + 16 * l15) = KA[i_];                              \
        LDS_WAIT(); asm volatile("" ::: "memory");                                                                                                        \
        _Pragma("unroll") for (int tl = 0; tl < 2; ++tl) { const int j0 = 32 * (S) + 16 * tl;                                                           \
            f32x4 a = {0.f, 0.f, 0.f, 0.f};                                                                                                             \
            _Pragma("unroll") for (int ks = 0; ks < 4; ++ks) { const bf16x8 ka_ = *(const LAS bf16x8*)(stg + (16 * tl + l15) * DSA_KVROW + (32 * ks + 8 * g) * 2); \
                a = __builtin_amdgcn_mfma_f32_16x16x32_bf16(ka_, bq[ks], a, 0, 0, 0); }                                                                 \
            const u32x2 kw = *(const LAS u32x2*)(sel + j0 + 4 * g);                                                                                     \
            const int kx[4] = {(int)(kw.x & 0xffffu), (int)(kw.x >> 16), (int)(kw.y & 0xffffu), (int)(kw.y >> 16)};                                     \
            float pr[4];                                                                                                                                \
            _Pragma("unroll") for (int r = 0; r < 4; ++r) { const int dd = t > kx[r] ? t - kx[r] : kx[r] - t;                                            \
                const float e = __builtin_amdgcn_exp2f(fmaf(a[r], 0.1275174f, -slopeL2 * (float)dd - refL2));                                            \
                pr[r] = (j0 + 4 * g + r < nvalid) ? e : 0.f; lsum += pr[r]; }                                                                           \
            pb[2 * tl] = cvtpk_bf16(pr[0], pr[1]); pb[2 * tl + 1] = cvtpk_bf16(pr[2], pr[3]); }                                                         \
        LDS_WAIT(); asm volatile("" ::: "memory");                                                                                                      \
        u32x4 pw4; pw4.x = pb[0]; pw4.y = pb[1]; pw4.z = pb[2]; pw4.w = pb[3];                                                                          \
        const bf16x8 pfrag = __builtin_bit_cast(bf16x8, pw4);                                                                                           \
        const LAS unsigned char* trb = stg + (4 * g + (l15 >> 2)) * DSA_KVROW + (4 * (lane & 3)) * 2;                                                   \
        _Pragma("unroll") for (int dt = 0; dt < 8; ++dt) {                                                                                              \
            const s16x4 lo = __builtin_bit_cast(s16x4, __builtin_amdgcn_ds_read_tr16_b64_v4i16((LAS v4i16_t*)(trb + dt * 32)));                         \
            const s16x4 hi = __builtin_bit_cast(s16x4, __builtin_amdgcn_ds_read_tr16_b64_v4i16((LAS v4i16_t*)(trb + 16 * DSA_KVROW + dt * 32)));        \
            const bf16x8 af = {lo[0], lo[1], lo[2], lo[3], hi[0], hi[1], hi[2], hi[3]};                                                                 \
            o[dt] = __builtin_amdgcn_mfma_f32_16x16x32_bf16(af, pfrag, o[dt], 0, 0, 0); }                                                               \
        LDS_WAIT(); asm volatile("" ::: "memory"); } while (0)
            const int nch = (nvalid + 31) >> 5;
            bf16x8 KA[8], KB[8];
            DSA_GATHER(0, KA);
#pragma unroll 1
            for (int s = 0; s < nch; s += 2) {
                if (s + 1 < nch) DSA_GATHER(s + 1, KB);
                DSA_COMPUTE(s, KA);
                if (s + 1 < nch) { if (s + 2 < nch) DSA_GATHER(s + 2, KA); DSA_COMPUTE(s + 1, KB); }
            }
#undef DSA_GATHER
#undef DSA_COMPUTE
            lsum += __shfl_xor(lsum, 16); lsum += __shfl_xor(lsum, 32);
            const float il = 1.f / lsum;
            if (l15 < 8) {
                bf16* orow = MIX + (size_t)(b * SEQ + t) * MIXW + 512 + head * 128 + 4 * g;
#pragma unroll
                for (int dt = 0; dt < 8; ++dt) { u32x2 w; w.x = pk2(o[dt][0] * il, o[dt][1] * il); w.y = pk2(o[dt][2] * il, o[dt][3] * il); *(u32x2*)(orow + 16 * dt) = w; }
            }
        }
        __syncthreads();
    }
}
typedef __attribute__((address_space(1))) float GASF;
#ifndef ATT_PROBE
#define ATT_PROBE 0
#endif
#ifndef ATT_REMAP
#define ATT_REMAP 1
#endif
__device__ __forceinline__ int crow(int r, int hi) { return (r & 3) + 8 * (r >> 2) + 4 * hi; }
#define KSWZ64(row, cb) ((row) * 128 + ((cb) ^ ((((row) >> 1) & 7) << 4)))
__device__ __forceinline__ int v_st(int k, int c) { const int kk = (k & ~0xC) | ((k & 4) << 1) | ((k & 8) >> 1); return ((kk >> 3) * 4 + (c >> 5)) * 512 + ((kk & 7) * 32 + (c & 31)) * 2; }
__device__ __forceinline__ int v_rd_base(int lane) { return ((lane & 3) << 3) | (((lane >> 2) & 3) << 6) | (((lane >> 4) & 1) << 5) | (((lane >> 5) & 1) << 8); }
constexpr int v_rd_off(int d0, int ks, int half) { return d0 * 512 + ks * 4096 + half * 2048; }
template <int OFF> __device__ __forceinline__ s16x4 tr_read(int vb) {
    s16x4 r; asm volatile("ds_read_b64_tr_b16 %0, %1 offset:%2" : "=&v"(r) : "v"(vb), "i"(OFF) : "memory"); return r;
}
template <int D0> __device__ __forceinline__ void pv_one(f32x16& od, int vb, bf16x8 pa0, bf16x8 pa1, bf16x8 pa2, bf16x8 pa3) {
    const s16x4 l0 = tr_read<v_rd_off(D0, 0, 0)>(vb), h0 = tr_read<v_rd_off(D0, 0, 1)>(vb), l1 = tr_read<v_rd_off(D0, 1, 0)>(vb), h1 = tr_read<v_rd_off(D0, 1, 1)>(vb);
    const s16x4 l2 = tr_read<v_rd_off(D0, 2, 0)>(vb), h2 = tr_read<v_rd_off(D0, 2, 1)>(vb), l3 = tr_read<v_rd_off(D0, 3, 0)>(vb), h3 = tr_read<v_rd_off(D0, 3, 1)>(vb);
    asm volatile("s_waitcnt lgkmcnt(0)" ::: "memory"); __builtin_amdgcn_sched_barrier(0);
#define PK(L, H) (bf16x8){L[0], L[1], L[2], L[3], H[0], H[1], H[2], H[3]}
    od = __builtin_amdgcn_mfma_f32_32x32x16_bf16(pa0, PK(l0, h0), od, 0, 0, 0);
    od = __builtin_amdgcn_mfma_f32_32x32x16_bf16(pa1, PK(l1, h1), od, 0, 0, 0);
    od = __builtin_amdgcn_mfma_f32_32x32x16_bf16(pa2, PK(l2, h2), od, 0, 0, 0);
    od = __builtin_amdgcn_mfma_f32_32x32x16_bf16(pa3, PK(l3, h3), od, 0, 0, 0);
#undef PK
}

__device__ __forceinline__ void att_tile(f32x16 (&o)[4], float& lsum, const unsigned char* Kb, int vb0, const unsigned char* Qw, int r32, int hi, int tq, int j, bool past, float slopeL2, float refL2) {
    constexpr float C = 0.125f * 1.4426950409f;
    bf16x8 qr[4];
#pragma unroll
    for (int d0 = 0; d0 < 4; ++d0) qr[d0] = *(const bf16x8*)(Qw + KSWZ64(r32, (d0 * 16 + hi * 8) * 2));
    const float dq = (float)(tq - 64 * j - 4 * hi);
    const float B0 = -slopeL2 * dq - refL2;
    float ps = 0.f;
    bf16x8 pa0, pa1, pa2, pa3;
#define PK4(P, BASE, OUT) do { unsigned a0 = cvtpk_bf16(P[BASE + 0], P[BASE + 1]), a1 = cvtpk_bf16(P[BASE + 2], P[BASE + 3]);   \
    unsigned b0_ = cvtpk_bf16(P[BASE + 4], P[BASE + 5]), b1_ = cvtpk_bf16(P[BASE + 6], P[BASE + 7]);                              \
    auto r0 = __builtin_amdgcn_permlane32_swap(a0, b0_, false, false); auto r1 = __builtin_amdgcn_permlane32_swap(a1, b1_, false, false); \
    u32x4 w = {r0[0], r1[0], r0[1], r1[1]}; OUT = __builtin_bit_cast(bf16x8, w); } while (0)
#define HALF_TILE(KOFF, FOFF, PA, PB) do { f32x16 pp = f32x16{};                                                                     \
    _Pragma("unroll") for (int d0 = 0; d0 < 4; ++d0) { const int cb = (d0 * 16 + hi * 8) * 2;                                        \
        const bf16x8 bk = *(const bf16x8*)(Kb + KSWZ64((KOFF) + r32, cb)); pp = __builtin_amdgcn_mfma_f32_32x32x16_bf16(bk, qr[d0], pp, 0, 0, 0); } \
    if (past) { _Pragma("unroll") for (int r = 0; r < 16; ++r) { const float off = (float)((r & 3) + 8 * (r >> 2)) + (FOFF);          \
            pp[r] = __builtin_amdgcn_exp2f(fmaf(pp[r], C, fmaf(slopeL2, off, B0))); } }                                               \
    else { _Pragma("unroll") for (int r = 0; r < 16; ++r) { const float off = (float)((r & 3) + 8 * (r >> 2)) + (FOFF);               \
            pp[r] = __builtin_amdgcn_exp2f(fmaf(pp[r], C, -slopeL2 * fabsf(dq - off) - refL2)); } }                                   \
    _Pragma("unroll") for (int r = 0; r < 16; ++r) ps += pp[r];                                                                       \
    PK4(pp, 0, PA); PK4(pp, 8, PB); __builtin_amdgcn_sched_barrier(0); } while (0)
    HALF_TILE(0, 0.f, pa0, pa1);
    HALF_TILE(32, 32.f, pa2, pa3);
#undef HALF_TILE
#undef PK4
    { auto rr = __builtin_amdgcn_permlane32_swap(__float_as_uint(ps), __float_as_uint(ps), false, false);
      ps = __uint_as_float(rr[0]) + __uint_as_float(rr[1]); }
    lsum += ps;
    pv_one<0>(o[0], vb0, pa0, pa1, pa2, pa3); pv_one<1>(o[1], vb0, pa0, pa1, pa2, pa3); pv_one<2>(o[2], vb0, pa0, pa1, pa2, pa3); pv_one<3>(o[3], vb0, pa0, pa1, pa2, pa3);
}
constexpr int ATT_LDS = 2 * 16384 + 2 * 8192 + 8 * 256 + 8 * 4096;

__device__ __forceinline__ void ph_attnA(const Params& p, unsigned char* lds, int vb, int nvb) {
    const bf16* PROJ = (const bf16*)(p.ws + WS_PROJ); bf16* MIX = (bf16*)(p.ws + WS_MIX);
    const float* SC = (const float*)(p.ws + WS_SCAL);
    const float lam = SC[SC_LAM], refL2 = SC[SC_MA] * 1.4426950409f;
    constexpr float C = 0.125f * 1.4426950409f;
    int tid = threadIdx.x; asm volatile("" : "+v"(tid)); const int lane = tid & 63, wid = __builtin_amdgcn_readfirstlane(tid >> 6), r32 = lane & 31, hi = lane >> 5;
    unsigned char* V_lds = lds; unsigned char* K_lds = lds + 32768;
    float* wsf = (float*)(lds + 49152) + wid * 64;
    GASF* tmpw = (GASF*)(p.ws + WS_ATMP) + ((size_t)(vb * NWV + wid) * 64) * 64 + lane;
    const int vbase = (int)(uintptr_t)V_lds + v_rd_base(lane);
    const int krow = tid >> 3, kch = tid & 7, kdst = KSWZ64(krow, kch * 16);
    const int sr = tid >> 4, sc = (tid & 15) * 8, vst0 = v_st(sr, sc), vst1 = v_st(32 + sr, sc);
    for (int it = vb; it < 256; it += nvb) {
        #if ATT_REMAP
        const int xg_ = it & 7, m_ = it >> 3, pidx = xg_ * 8 + (m_ >> 2), qbl = m_ & 3, b = pidx >> 2, h = pidx & 3;
#else
        const int b = it >> 4, h = (it >> 2) & 3, qbl = it & 3;
#endif
        const float slopeL2 = exp2f(-2.0f * (float)(h + 1)) * 1.4426950409f;
        const bf16* Pb = PROJ + (size_t)b * SEQ * NP;
#pragma unroll 1
        for (int half = 0; half < 2; ++half) {
            const int qb = half ? 7 - qbl : qbl, q0 = 256 * qb, NTu = 4 * (qb + 1), cw = 4 * qb + (wid >> 1);
            const int tq = q0 + 32 * wid + r32;
#pragma unroll 1
            for (int mi = 0; mi < 2; ++mi) {
                const int m = 1 - mi;
                const bf16* Kg = Pb + C_KA + h * 128 + m * 64 + (size_t)krow * NP + kch * 8;
                const bf16* Vg = Pb + C_VA + h * 128 + (size_t)sr * NP + sc;
                unsigned char* Qw = lds + 51200 + wid * 4096;
                { const bf16* qp = Pb + (size_t)tq * NP + C_QA + h * 128 + m * 64 + hi * 8;
#pragma unroll
                  for (int d0 = 0; d0 < 4; ++d0) *(bf16x8*)(Qw + KSWZ64(r32, (d0 * 16 + hi * 8) * 2)) = *(const bf16x8*)(qp + d0 * 16); }
                f32x16 o[4];
#pragma unroll
                for (int d = 0; d < 4; ++d) o[d] = f32x16{};
                float lsum = 0.f;
                bf16x8 ak, av0, av1;
#define ATT_LOAD(K_, V0_, V1_, TJ) do { const size_t go_ = (size_t)(TJ) * 64 * NP; K_ = *(const bf16x8*)(Kg + go_); V0_ = *(const bf16x8*)(Vg + go_); V1_ = *(const bf16x8*)(Vg + go_ + (size_t)32 * NP); \
        if (ATT_PROBE == 2) { bf16x8 d0_ = *(const volatile bf16x8*)(Kg + go_); bf16x8 d1_ = *(const volatile bf16x8*)(Vg + go_); bf16x8 d2_ = *(const volatile bf16x8*)(Vg + go_ + (size_t)32 * NP); asm volatile("" :: "v"(d0_), "v"(d1_), "v"(d2_)); } } while (0)
#define ATT_WRITE(K_, V0_, V1_, NB) do { *(bf16x8*)(K_lds + (NB) * 8192 + kdst) = K_; *(bf16x8*)(V_lds + (NB) * 16384 + vst0) = V0_; *(bf16x8*)(V_lds + (NB) * 16384 + vst1) = V1_; } while (0)
                ATT_LOAD(ak, av0, av1, 0); ATT_WRITE(ak, av0, av1, 0);
                __syncthreads();
#pragma unroll 1
                for (int j = 0; j < NTu; ++j) {
                    const int buf = j & 1;
                    if (j + 1 < NTu) ATT_LOAD(ak, av0, av1, j + 1);
                    if (j <= cw) { att_tile(o, lsum, K_lds + buf * 8192, vbase + buf * 16384, Qw, r32, hi, tq, j, j < cw, slopeL2, refL2);
#if ATT_PROBE == 1
                        { f32x16 o2[4]; o2[0] = o[0]; o2[1] = o[1]; o2[2] = o[2]; o2[3] = o[3]; float l2 = 0.f; att_tile(o2, l2, K_lds + buf * 8192, vbase + buf * 16384, Qw, r32, hi, tq, j, j < cw, slopeL2, refL2);
                          asm volatile("" :: "v"(o2[0]), "v"(o2[1]), "v"(o2[2]), "v"(o2[3]), "v"(l2)); }
#endif
                    }
                    if (j + 1 < NTu) ATT_WRITE(ak, av0, av1, buf ^ 1);
                    __syncthreads();
                }
#undef ATT_LOAD
#undef ATT_WRITE
                if (hi == 0) wsf[r32] = lsum;
                LDS_WAIT(); asm volatile("" ::: "memory");
                float rli[16];
#pragma unroll
                for (int r = 0; r < 16; ++r) rli[r] = 1.f / wsf[crow(r, hi)];
                LDS_WAIT(); asm volatile("" ::: "memory");
                if (mi == 0) {
#pragma unroll
                    for (int d = 0; d < 4; ++d) { GASF* td = tmpw + d * 1024; asm volatile("" : "+v"(td));
#pragma unroll
                        for (int r = 0; r < 16; ++r) td[r * 64] = o[d][r] * rli[r]; }
                } else {
                    float gsub[4];
#pragma unroll
                    for (int d = 0; d < 4; ++d) gsub[d] = p.a_sub_gain[32 * d + r32];
                    GASF* tdp[4];
#pragma unroll
                    for (int d = 0; d < 4; ++d) { tdp[d] = tmpw + d * 1024; asm volatile("" : "+v"(tdp[d])); }
#pragma unroll
                    for (int r = 0; r < 16; ++r) {
                        float v[4]; float ss = 0.f;
#pragma unroll
                        for (int d = 0; d < 4; ++d) { v[d] = o[d][r] * rli[r] - lam * tdp[d][r * 64]; ss += v[d] * v[d]; }
                        ss += __shfl_xor(ss, 1); ss += __shfl_xor(ss, 2); ss += __shfl_xor(ss, 4); ss += __shfl_xor(ss, 8); ss += __shfl_xor(ss, 16);
                        const float rs = rsqrtf(ss * (1.f / 128.f) + EPS) * 0.8f;
                        bf16* orow = MIX + (size_t)(b * SEQ + q0 + 32 * wid + crow(r, hi)) * MIXW + h * 128 + r32;
#pragma unroll
                        for (int d = 0; d < 4; ++d) orow[32 * d] = (bf16)f2bf(v[d] * rs * gsub[d]);
                        asm volatile("" ::: "memory");
                    }
                }
            }
        }
    }
}
constexpr int RT_WAVE_BYTES = 12288;
constexpr int RT_LDS = 32768 + 8 * RT_WAVE_BYTES;

__device__ __forceinline__ int pl32_sum(int v) { auto rr = __builtin_amdgcn_permlane32_swap((unsigned)v, (unsigned)v, false, false); return (int)(rr[0] + rr[1]); }
__device__ __forceinline__ int pl32_other(int v) { auto rr = __builtin_amdgcn_permlane32_swap((unsigned)v, (unsigned)v, false, false); return (int)(rr[0] + rr[1]) - v; }
__device__ __forceinline__ float unsortkey(unsigned k) { return __uint_as_float((k & 0x80000000u) ? (k ^ 0x80000000u) : ~k); }

__device__ __forceinline__ unsigned wave_or(unsigned v) {
    v |= (unsigned)__builtin_amdgcn_update_dpp(0, (int)v, 0x128, 0xf, 0xf, false); v |= (unsigned)__builtin_amdgcn_update_dpp(0, (int)v, 0x124, 0xf, 0xf, false);
    v |= (unsigned)__builtin_amdgcn_update_dpp(0, (int)v, 0x122, 0xf, 0xf, false); v |= (unsigned)__builtin_amdgcn_update_dpp(0, (int)v, 0x121, 0xf, 0xf, false);
    return (unsigned)(__builtin_amdgcn_readlane((int)v, 0) | __builtin_amdgcn_readlane((int)v, 16) | __builtin_amdgcn_readlane((int)v, 32) | __builtin_amdgcn_readlane((int)v, 48));
}
template <int N> __device__ __forceinline__ unsigned bisect16(const unsigned (&key)[N]) {
    unsigned kmx, lo;
    { unsigned gm[8];
#pragma unroll
      for (int g = 0; g < 8; ++g) { gm[g] = key[g];
#pragma unroll
          for (int i = g + 8; i < N; i += 8) gm[g] = key[i] > gm[g] ? key[i] : gm[g]; }
      kmx = gm[0]; lo = gm[0];
#pragma unroll
      for (int g = 1; g < 8; ++g) { kmx = gm[g] > kmx ? gm[g] : kmx; lo = gm[g] < lo ? gm[g] : lo; }
      const unsigned okmx = (unsigned)pl32_other((int)kmx), olo = (unsigned)pl32_other((int)lo);
      kmx = okmx > kmx ? okmx : kmx; lo = olo < lo ? olo : lo; }
    const unsigned x = kmx - lo;
    int pb = x ? 31 - __clz(x) : -1;
    unsigned prefix = 0u; bool done = (x == 0u);
#pragma unroll 1
    while (!__all(done)) {
        const unsigned c_ = done ? prefix : (prefix | (1u << pb));
        unsigned cand = lo + c_; cand = cand < lo ? 0xffffffffu : cand;
        int cnt = 0;
#pragma unroll
        for (int i = 0; i + 3 < N; i += 4) cnt_ge4(cnt, key[i], key[i + 1], key[i + 2], key[i + 3], cand);
#pragma unroll
        for (int i = N & ~3; i < N; ++i) cnt += (key[i] >= cand) ? 1 : 0;
        const int tot = pl32_sum(cnt);
        if (!done && tot >= 16) { prefix = c_; done = (tot == 16); }
        --pb; done = done || (pb < 0);
    }
    prefix += lo;
    return prefix;
}

__device__ __forceinline__ void ph_route(const Params& p, unsigned char* lds, int vb, int nvb) {
    const bf16* Q3 = (const bf16*)(p.ws + WS_Q3); const bf16* SUBK = (const bf16*)(p.ws + WS_SUBK);
    int* EXPI = (int*)(p.ws + WS_EXP); float* GATE = (float*)(p.ws + WS_GATE);
    int tid = threadIdx.x; asm volatile("" : "+v"(tid));
    const int lane = tid & 63, wv = __builtin_amdgcn_readfirstlane(tid >> 6), r32 = lane & 31, hi = lane >> 5;
    for (int i = tid; i < 2048; i += NT) { const int row = i >> 3, ch = i & 7; ((u32x4*)lds)[row * 8 + (ch ^ ((row >> 1) & 7))] = ((const u32x4*)SUBK)[i]; }
    __syncthreads();
    unsigned char* wl = lds + 32768 + wv * RT_WAVE_BYTES;
    float* sv = (float*)wl; int* si = (int*)(wl + 4096); float* fv = (float*)(wl + 8192); int* fe = (int*)(wl + 10240);
    const int gw = vb * NWV + wv, ngw = nvb * NWV;
    for (int item = gw; item < (T / 32) * 8; item += ngw) {
        const int h = item & 7, tok0 = (item >> 3) * 32;
        const bf16* qrow = Q3 + (size_t)(tok0 + r32) * 1024 + h * 128 + hi * 8;
#pragma unroll 1
        for (int c = 0; c < 2; ++c) {
            bf16x8 bq[4];
#pragma unroll
            for (int d0 = 0; d0 < 4; ++d0) bq[d0] = *(const bf16x8*)(qrow + c * 64 + d0 * 16);
            unsigned key[64];
#pragma unroll
            for (int nt = 0; nt < 4; ++nt) {
                f32x16 acc = f32x16{};
                const int krow = c * 128 + nt * 32 + r32, ksw = (krow >> 1) & 7;
                const unsigned char* kp = lds + krow * 128;
#pragma unroll
                for (int d0 = 0; d0 < 4; ++d0) { const bf16x8 ak = *(const bf16x8*)(kp + (((2 * d0 + hi) ^ ksw) << 4)); acc = __builtin_amdgcn_mfma_f32_32x32x16_bf16(ak, bq[d0], acc, 0, 0, 0); }
#pragma unroll
                for (int r = 0; r < 16; ++r) key[nt * 16 + r] = sortkey(acc[r]);
            }
            const unsigned thr = bisect16<64>(key);
            int cnt = 0;
#pragma unroll
            for (int i = 0; i < 64; ++i) cnt += (key[i] >= thr) ? 1 : 0;
            const int other_ = pl32_other(cnt); int slot = hi ? other_ : 0;
            float* svp = sv + (r32 * 2 + c) * 16; int* sip = si + (r32 * 2 + c) * 16;
#pragma unroll
            for (int i = 0; i < 64; ++i) {
                if (key[i] >= thr && slot < 16) { svp[slot] = unsortkey(key[i]); sip[slot] = 32 * (i >> 4) + ((i & 3) + 8 * ((i & 15) >> 2)) + 4 * hi; ++slot; }
            }
        }
        LDS_WAIT(); asm volatile("" ::: "memory");
        {
            float* sv0 = sv + (r32 * 2) * 16; float* sv1 = sv0 + 16; int* si0 = si + (r32 * 2) * 16; int* si1 = si0 + 16;
            {
                float a[16], bl[16];
#pragma unroll
                for (int k = 0; k < 16; ++k) { a[k] = sv0[k]; bl[k] = sv1[k]; }
                int ia[8], ib[8], ra[8], rb[8]; float va[8], vb[8];
#pragma unroll
                for (int q = 0; q < 8; ++q) { const int e = 8 * hi + q; va[q] = sv0[e]; vb[q] = sv1[e]; ia[q] = si0[e]; ib[q] = si1[e]; int r0 = 0, r1 = 0;
#pragma unroll
                    for (int k = 0; k < 16; ++k) { r0 += (a[k] > va[q] || (a[k] == va[q] && k < e)) ? 1 : 0; r1 += (bl[k] > vb[q] || (bl[k] == vb[q] && k < e)) ? 1 : 0; }
                    ra[q] = r0; rb[q] = r1; }
                LDS_WAIT(); asm volatile("" ::: "memory");
                { auto rr = __builtin_amdgcn_permlane32_swap(0u, 0u, false, false); (void)rr; }
#pragma unroll
                for (int q = 0; q < 8; ++q) { sv0[ra[q]] = va[q]; si0[ra[q]] = ia[q]; sv1[rb[q]] = vb[q]; si1[rb[q]] = ib[q]; }
                LDS_WAIT(); asm volatile("" ::: "memory");
            }
            const float* X = hi ? sv1 : sv0; const float* Y = hi ? sv0 : sv1;
            float x[4], y[16];
#pragma unroll
            for (int k = 0; k < 4; ++k) x[k] = X[k];
#pragma unroll
            for (int k = 0; k < 16; ++k) y[k] = Y[k];
            unsigned key[27]; int pi[27], pj[27]; int np = 0;
#pragma unroll
            for (int i = 0; i < 3; ++i)
#pragma unroll
                for (int j = i + 1; j < 16; ++j) if ((i + 1) * (j + 1) <= 16) { key[np] = sortkey(x[i] + y[j]); pi[np] = i; pj[np] = j; ++np; }
#pragma unroll
            for (int i = 0; i < 4; ++i) { key[23 + i] = hi ? 0u : sortkey(x[i] + y[i]); pi[23 + i] = i; pj[23 + i] = i; }
            const unsigned thr = bisect16<27>(key);
            int cnt = 0;
#pragma unroll
            for (int i = 0; i < 27; ++i) cnt += (key[i] >= thr) ? 1 : 0;
            const int other_ = pl32_other(cnt); int slot = hi ? other_ : 0;
            const int* IX = hi ? si1 : si0; const int* IY = hi ? si0 : si1;
            float* fvp = fv + r32 * 16; int* fep = fe + r32 * 16;
#pragma unroll
            for (int i = 0; i < 27; ++i) {
                if (key[i] >= thr && slot < 16) { const int ex = IX[pi[i]], ey = IY[pj[i]]; fvp[slot] = unsortkey(key[i]); fep[slot] = hi ? (ey * 128 + ex) : (ex * 128 + ey); ++slot; }
            }
        }
        LDS_WAIT(); asm volatile("" ::: "memory");
        {
            const float* fvp = fv + r32 * 16;
            float v[16]; float mx = -3e38f;
#pragma unroll
            for (int k = 0; k < 16; ++k) { v[k] = fvp[k]; mx = fmaxf(mx, v[k]); }
            float l = 0.f;
#pragma unroll
            for (int k = 0; k < 16; ++k) { v[k] = __expf(v[k] - mx); l += v[k]; }
            const float il = 1.f / l;
            const size_t ob = (size_t)(tok0 + r32) * 128 + h * 16 + 8 * hi;
            const int* fep = fe + r32 * 16 + 8 * hi;
            f32x4 g0, g1; u32x4 e0, e1;
            if (hi == 0) { g0 = (f32x4){v[0] * il, v[1] * il, v[2] * il, v[3] * il}; g1 = (f32x4){v[4] * il, v[5] * il, v[6] * il, v[7] * il}; }
            else { g0 = (f32x4){v[8] * il, v[9] * il, v[10] * il, v[11] * il}; g1 = (f32x4){v[12] * il, v[13] * il, v[14] * il, v[15] * il}; }
            e0 = *(const u32x4*)fep; e1 = *(const u32x4*)(fep + 4);
            *(f32x4*)(GATE + ob) = g0; *(f32x4*)(GATE + ob + 4) = g1;
            *(u32x4*)(EXPI + ob) = e0; *(u32x4*)(EXPI + ob + 4) = e1;
        }
        LDS_WAIT(); asm volatile("" ::: "memory");
    }
    __syncthreads();
}
typedef float f32x2_t __attribute__((ext_vector_type(2)));
constexpr int P8_UNITS = T / 64;
constexpr int CW_P8_U = 4096, CW_P8_V = 4096 + 32 * 64;
constexpr float U8_SCALE = 32.0f;
__device__ __forceinline__ unsigned peer_xcc() { return (unsigned)__builtin_amdgcn_s_getreg((3 << 11) | 20) & 7u; }
#ifndef U8_HALVES
#define U8_HALVES 0
#endif
template <int LPR>
__device__ __forceinline__ void ph_peer_v8g(const Params& p, unsigned char* lds) {
    constexpr int RPI = 64 / LPR, NI = 128 / RPI, G = NI / 8, NS = 64 / LPR, SLB = 16 * LPR;
    const unsigned char* V8 = (const unsigned char*)(p.ws + WS_V16);
    const int* EXPI = (const int*)(p.ws + WS_EXP); const float* CBUF = (const float*)(p.ws + WS_CBUF); const float* MOD = (const float*)(p.ws + WS_MOD);
    const float* AB1 = (const float*)(p.ws + WS_ABUF1); const float* GATEP = (const float*)(p.ws + WS_GATE); (void)AB1; (void)GATEP;
    unsigned* ctl = (unsigned*)(p.ws + WS_CTL);
    int tid = threadIdx.x; asm volatile("" : "+v"(tid));
    const int lane = tid & 63, wv = __builtin_amdgcn_readfirstlane(tid >> 6), gR = lane / LPR, iC = lane % LPR;
    volatile LAS unsigned* slot = (volatile LAS unsigned*)(LAS unsigned char*)lds;
    const unsigned xcc = peer_xcc();
#pragma unroll 1
    for (int k = 0; k < NS; ++k) {
        const int sl = (int)((((xcc * NS) >> 3) + (unsigned)k) % (unsigned)NS);
        const unsigned char* vcol = V8 + SLB * sl + 16 * iC;
#pragma unroll 1
        for (;;) {
            if (tid == 0) *slot = __hip_atomic_fetch_add(ctl + CW_P8_V + 64 * sl, 1u, __ATOMIC_RELAXED, __HIP_MEMORY_SCOPE_AGENT);
            __syncthreads();
            const unsigned unit = *slot;
            __syncthreads();
            if (unit >= (unsigned)P8_UNITS) break;
            const int tbase = (int)unit * 64 + wv * 8;
            int ne0, ne1; float nc0, nc1;
#if U8_HALVES
#define VG_FETCH(T) do { const size_t tn_ = (size_t)(T); ne0 = EXPI[tn_ * 128 + lane]; ne1 = EXPI[tn_ * 128 + 64 + lane];                              \
        nc0 = gelu_erf(CBUF[tn_ * 128 + lane] + AB1[tn_ * 128 + lane]) * GATEP[tn_ * 128 + lane];                                              \
        nc1 = gelu_erf(CBUF[tn_ * 128 + 64 + lane] + AB1[tn_ * 128 + 64 + lane]) * GATEP[tn_ * 128 + 64 + lane]; } while (0)
#else
#define VG_FETCH(T) do { const size_t tn_ = (size_t)(T); ne0 = EXPI[tn_ * 128 + lane]; ne1 = EXPI[tn_ * 128 + 64 + lane]; nc0 = CBUF[tn_ * 128 + lane]; nc1 = CBUF[tn_ * 128 + 64 + lane]; } while (0)
#endif
#define VG_LISTS(LE, LC) do { LE[lane] = ne0; LE[64 + lane] = ne1; LC[lane] = nc0; LC[64 + lane] = nc1; } while (0)
#define VG_ROWS(R, LE, GI) do { _Pragma("unroll") for (int kk = 0; kk < 8; ++kk) R[kk] = *(const u32x4*)(vcol + (size_t)LE[RPI * (8 * (GI) + kk) + gR] * 1024); } while (0)
#define VG_GROUP(R, LC, GI) do { _Pragma("unroll") for (int kk = 0; kk < 8; ++kk) { const float cj = LC[RPI * (8 * (GI) + kk) + gR];                       \
            const unsigned w_[4] = {R[kk].x, R[kk].y, R[kk].z, R[kk].w};                                                                       \
            _Pragma("unroll") for (int c = 0; c < 4; ++c) { const f32x2_t lo = __builtin_amdgcn_cvt_pk_f32_fp8((int)w_[c], false), hi = __builtin_amdgcn_cvt_pk_f32_fp8((int)w_[c], true); \
                acc[4 * c] = fmaf(cj, lo.x, acc[4 * c]); acc[4 * c + 1] = fmaf(cj, lo.y, acc[4 * c + 1]); acc[4 * c + 2] = fmaf(cj, hi.x, acc[4 * c + 2]); acc[4 * c + 3] = fmaf(cj, hi.y, acc[4 * c + 3]); } } } while (0)
            u32x4 RA[8], RB[8];
            int* lecur = (int*)(lds + 1024 + wv * 2048); int* lenxt = lecur + 256;
            VG_FETCH(tbase); VG_LISTS(lecur, ((float*)(lecur + 128))); VG_FETCH(tbase + 1);
            LDS_WAIT(); asm volatile("" ::: "memory");
            VG_ROWS(RA, lecur, 0);
#pragma unroll 1
            for (int tt = 0; tt < 8; ++tt) {
                const int t = tbase + tt;
                float* lccur = (float*)(lecur + 128); float* lcnxt = (float*)(lenxt + 128);
                float acc[16];
#pragma unroll
                for (int q = 0; q < 16; ++q) acc[q] = 0.f;
                if (tt + 1 < 8) { VG_LISTS(lenxt, lcnxt); if (tt + 2 < 8) VG_FETCH(t + 2); }
#pragma unroll 1
                for (int gi = 0; gi < G; gi += 2) {
                    VG_ROWS(RB, lecur, gi + 1);
                    VG_GROUP(RA, lccur, gi);
                    if (gi + 2 < G) VG_ROWS(RA, lecur, gi + 2);
                    else if (tt + 1 < 8) { LDS_WAIT(); asm volatile("" ::: "memory"); VG_ROWS(RA, lenxt, 0); }
                    VG_GROUP(RB, lccur, gi + 1);
                }
#pragma unroll
                for (int q = 0; q < 16; ++q) { if (LPR <= 8) acc[q] += dpp_f<0x128>(acc[q]); if (LPR <= 16) acc[q] += __shfl_xor(acc[q], 16); if (LPR <= 32) acc[q] += __shfl_xor(acc[q], 32); }
                if (gR == 0) { const int col = SLB * sl + 16 * iC; const float* g2 = MOD + (size_t)(t >> 11) * 6144 + 5120 + col; float* orow = p.out + (size_t)t * 1024 + col;
#pragma unroll
                    for (int q = 0; q < 4; ++q) { const f32x4 xv = *(const f32x4*)(orow + 4 * q), hv = *(const f32x4*)(g2 + 4 * q);
                        f32x4 r; r.x = acc[4 * q]; r.y = acc[4 * q + 1]; r.z = acc[4 * q + 2]; r.w = acc[4 * q + 3]; *(f32x4*)(orow + 4 * q) = xv + hv * r; } }
                { int* tmp_ = lecur; lecur = lenxt; lenxt = tmp_; }
            }
#undef VG_FETCH
#undef VG_LISTS
#undef VG_ROWS
#undef VG_GROUP
            LDS_WAIT(); asm volatile("" ::: "memory");
        }
    }
}
#ifndef SORT_BITS
#define SORT_BITS 3
#endif
#ifndef PEER_SORT
#define PEER_SORT 1
#endif
__device__ __forceinline__ void ph_peer_u8p(const Params& p, unsigned char* lds_w, int gw, int ngw, int lane_) {
    int lane = lane_; asm volatile("" : "+v"(lane));
    const bf16* H = (const bf16*)(p.ws + WS_H); const unsigned char* U8 = (const unsigned char*)(p.ws + WS_U16); const unsigned char* V8 = (const unsigned char*)(p.ws + WS_V16);
    const int* EXPI = (const int*)(p.ws + WS_EXP); const float* GATE = (const float*)(p.ws + WS_GATE); const float* MOD = (const float*)(p.ws + WS_MOD);
    int* e_lds = (int*)lds_w; float* a_lds = (float*)(lds_w + 512); float* g_lds = (float*)(lds_w + 1024); (void)g_lds;
    const int g = lane >> 4, i = lane & 15;
#pragma unroll 1
    for (int t = gw; t < T; t += ngw) {
        int e0 = EXPI[(size_t)t * 128 + lane], e1 = EXPI[(size_t)t * 128 + 64 + lane];
        float g0 = GATE[(size_t)t * 128 + lane], g1 = GATE[(size_t)t * 128 + 64 + lane];
#if PEER_SORT
        {
            const int flip_ = ((t / ngw) & 1) ? ((1 << SORT_BITS) - 1) : 0;
            const int d0 = (e0 >> (14 - SORT_BITS)) ^ flip_, d1 = (e1 >> (14 - SORT_BITS)) ^ flip_; int pos0 = 0, pos1 = 0, run = 0;
#pragma unroll
            for (int d = 0; d < (1 << SORT_BITS); ++d) {
                const unsigned long long m0 = __ballot(d0 == d), m1 = __ballot(d1 == d);
                const int c0 = __popcll(m0), c1 = __popcll(m1);
                const int r0 = (int)__builtin_amdgcn_mbcnt_hi((unsigned)(m0 >> 32), __builtin_amdgcn_mbcnt_lo((unsigned)m0, 0u));
                const int r1 = (int)__builtin_amdgcn_mbcnt_hi((unsigned)(m1 >> 32), __builtin_amdgcn_mbcnt_lo((unsigned)m1, 0u));
                pos0 = (d0 == d) ? run + r0 : pos0; pos1 = (d1 == d) ? run + c0 + r1 : pos1; run += c0 + c1;
            }
            e_lds[pos0] = e0; e_lds[pos1] = e1; g_lds[pos0] = g0; g_lds[pos1] = g1;
            LDS_WAIT(); asm volatile("" ::: "memory");
            e0 = e_lds[lane]; e1 = e_lds[64 + lane]; g0 = g_lds[lane]; g1 = g_lds[64 + lane];
            int* EW = (int*)(p.ws + WS_EXP) + (size_t)t * 128; EW[lane] = e0; EW[64 + lane] = e1;
        }
#else
        e_lds[lane] = e0; e_lds[64 + lane] = e1;
#endif
        float xf[64];
        { const u32x4* xrow = (const u32x4*)(H + (size_t)t * 1024) + 2 * i;
#pragma unroll
          for (int q = 0; q < 4; ++q) { const u32x4 a = xrow[32 * q], b = xrow[32 * q + 1];
              xf[16 * q] = bflo(a.x); xf[16 * q + 1] = bfhi(a.x); xf[16 * q + 2] = bflo(a.y); xf[16 * q + 3] = bfhi(a.y); xf[16 * q + 4] = bflo(a.z); xf[16 * q + 5] = bfhi(a.z); xf[16 * q + 6] = bflo(a.w); xf[16 * q + 7] = bfhi(a.w);
              xf[16 * q + 8] = bflo(b.x); xf[16 * q + 9] = bfhi(b.x); xf[16 * q + 10] = bflo(b.y); xf[16 * q + 11] = bfhi(b.y); xf[16 * q + 12] = bflo(b.z); xf[16 * q + 13] = bfhi(b.z); xf[16 * q + 14] = bflo(b.w); xf[16 * q + 15] = bfhi(b.w); } }
        LDS_WAIT(); asm volatile("" ::: "memory");
#define P8T_ULOAD(R, S) do { const u32x4* r_ = (const u32x4*)(U8 + (size_t)e_lds[4 * (S) + g] * 1024) + i; _Pragma("unroll") for (int q = 0; q < 4; ++q) R[q] = r_[16 * q]; } while (0)
#define P8T_UDOT(R, S) do { float a0 = 0.f, a1 = 0.f, a2 = 0.f, a3 = 0.f;                                                                               \
        _Pragma("unroll") for (int q = 0; q < 4; ++q) { const unsigned w_[4] = {R[q].x, R[q].y, R[q].z, R[q].w};                                           \
            _Pragma("unroll") for (int c = 0; c < 4; ++c) { const f32x2_t lo = __builtin_amdgcn_cvt_pk_f32_fp8((int)w_[c], false), hi = __builtin_amdgcn_cvt_pk_f32_fp8((int)w_[c], true); \
                a0 = fmaf(lo.x, xf[16 * q + 4 * c], a0); a1 = fmaf(lo.y, xf[16 * q + 4 * c + 1], a1); a2 = fmaf(hi.x, xf[16 * q + 4 * c + 2], a2); a3 = fmaf(hi.y, xf[16 * q + 4 * c + 3], a3); } } \
        const float a_ = row16_sum((a0 + a1) + (a2 + a3)) * (1.0f / U8_SCALE); if (i == 0) a_lds[4 * (S) + g] = a_; } while (0)
        { u32x4 RA[4], RB[4], RC[4];
          P8T_ULOAD(RA, 0); P8T_ULOAD(RB, 1);
#pragma unroll 1
          for (int s = 0; s < 30; s += 3) {
              P8T_ULOAD(RC, s + 2); P8T_UDOT(RA, s);
              P8T_ULOAD(RA, s + 3); P8T_UDOT(RB, s + 1);
              P8T_ULOAD(RB, s + 4); P8T_UDOT(RC, s + 2);
          }
          P8T_UDOT(RA, 30); P8T_UDOT(RB, 31); }
#undef P8T_ULOAD
#undef P8T_UDOT
        LDS_WAIT(); asm volatile("" ::: "memory");
        const float c0 = gelu_erf(a_lds[lane]) * g0, c1 = gelu_erf(a_lds[64 + lane]) * g1;
        float* CB = (float*)(p.ws + WS_CBUF) + (size_t)t * 128; CB[lane] = c0; CB[64 + lane] = c1;
    }
}
__device__ __forceinline__ void ph_peer_u8h(const Params& p, unsigned char* lds) {
    const bf16* H = (const bf16*)(p.ws + WS_H); const unsigned char* U8 = (const unsigned char*)(p.ws + WS_U16);
    const int* EXPI = (const int*)(p.ws + WS_EXP);
    unsigned* ctl = (unsigned*)(p.ws + WS_CTL);
    int tid = threadIdx.x; asm volatile("" : "+v"(tid));
    const int lane = tid & 63, wv = __builtin_amdgcn_readfirstlane(tid >> 6), hw = lane >> 5, i5 = lane & 31;
    volatile LAS unsigned* slot = (volatile LAS unsigned*)(LAS unsigned char*)lds;
    float* a_lds = (float*)(lds + 1024 + wv * 2048 + 1024);
    const unsigned xcc = peer_xcc();
#pragma unroll 1
    for (int k = 0; k < 2; ++k) {
        const int sl = (int)(((xcc >> 2) + (unsigned)k) & 1u);
        float* AB = (float*)(p.ws + (sl ? WS_ABUF1 : WS_CBUF));
        const unsigned char* ucol = U8 + 512 * sl + 16 * i5;
#pragma unroll 1
        for (;;) {
            if (tid == 0) *slot = __hip_atomic_fetch_add(ctl + CW_P8_U + 64 * sl, 1u, __ATOMIC_RELAXED, __HIP_MEMORY_SCOPE_AGENT);
            __syncthreads();
            const unsigned unit = *slot;
            __syncthreads();
            if (unit >= (unsigned)P8_UNITS) break;
            const int tbase = (int)unit * 64 + wv * 8;
            int ne0, ne1; u32x4 nx0, nx1;
#define UH_FETCH(T) do { const size_t tn_ = (size_t)(T); ne0 = EXPI[tn_ * 128 + lane]; ne1 = EXPI[tn_ * 128 + 64 + lane];                          \
        const u32x4* xr_ = (const u32x4*)(H + tn_ * 1024 + 512 * sl) + 2 * i5; nx0 = xr_[0]; nx1 = xr_[1]; } while (0)
#define UH_LISTS(LE) do { LE[lane] = ne0; LE[64 + lane] = ne1; } while (0)
#define UH_ROWS(R, LE, GI) do { _Pragma("unroll") for (int kk = 0; kk < 8; ++kk) R[kk] = *(const u32x4*)(ucol + (size_t)LE[2 * (8 * (GI) + kk) + hw] * 1024); } while (0)
#define UH_GROUP(R, GI) do { _Pragma("unroll") for (int kk = 0; kk < 8; ++kk) { float a0 = 0.f, a1 = 0.f, a2 = 0.f, a3 = 0.f;                         \
            const unsigned w_[4] = {R[kk].x, R[kk].y, R[kk].z, R[kk].w};                                                                       \
            _Pragma("unroll") for (int c = 0; c < 4; ++c) { const f32x2_t lo = __builtin_amdgcn_cvt_pk_f32_fp8((int)w_[c], false), hi = __builtin_amdgcn_cvt_pk_f32_fp8((int)w_[c], true); \
                a0 = fmaf(lo.x, xf[4 * c], a0); a1 = fmaf(lo.y, xf[4 * c + 1], a1); a2 = fmaf(hi.x, xf[4 * c + 2], a2); a3 = fmaf(hi.y, xf[4 * c + 3], a3); }                        \
            float s_ = row16_sum((a0 + a1) + (a2 + a3)); s_ += __shfl_xor(s_, 16);                                                              \
            if (i5 == 0) a_lds[2 * (8 * (GI) + kk) + hw] = s_ * (1.0f / U8_SCALE); } } while (0)
            u32x4 RA[8], RB[8];
            int* lecur = (int*)(lds + 1024 + wv * 2048); int* lenxt = lecur + 128;
            UH_FETCH(tbase); UH_LISTS(lecur);
            float xf[16];
#define UH_XF() do { xf[0] = bflo(nx0.x); xf[1] = bfhi(nx0.x); xf[2] = bflo(nx0.y); xf[3] = bfhi(nx0.y); xf[4] = bflo(nx0.z); xf[5] = bfhi(nx0.z); xf[6] = bflo(nx0.w); xf[7] = bfhi(nx0.w); \
        xf[8] = bflo(nx1.x); xf[9] = bfhi(nx1.x); xf[10] = bflo(nx1.y); xf[11] = bfhi(nx1.y); xf[12] = bflo(nx1.z); xf[13] = bfhi(nx1.z); xf[14] = bflo(nx1.w); xf[15] = bfhi(nx1.w); } while (0)
            UH_XF();
            UH_FETCH(tbase + 1);
            LDS_WAIT(); asm volatile("" ::: "memory");
            UH_ROWS(RA, lecur, 0);
#pragma unroll 1
            for (int tt = 0; tt < 8; ++tt) {
                const int t = tbase + tt;
                float xn[16];
                if (tt + 1 < 8) { UH_LISTS(lenxt);
#pragma unroll
                    for (int q = 0; q < 16; ++q) xn[q] = 0.f;
                    xn[0] = bflo(nx0.x); xn[1] = bfhi(nx0.x); xn[2] = bflo(nx0.y); xn[3] = bfhi(nx0.y); xn[4] = bflo(nx0.z); xn[5] = bfhi(nx0.z); xn[6] = bflo(nx0.w); xn[7] = bfhi(nx0.w);
                    xn[8] = bflo(nx1.x); xn[9] = bfhi(nx1.x); xn[10] = bflo(nx1.y); xn[11] = bfhi(nx1.y); xn[12] = bflo(nx1.z); xn[13] = bfhi(nx1.z); xn[14] = bflo(nx1.w); xn[15] = bfhi(nx1.w);
                    if (tt + 2 < 8) UH_FETCH(t + 2); }
#pragma unroll 1
                for (int gi = 0; gi < 8; gi += 2) {
                    UH_ROWS(RB, lecur, gi + 1);
                    UH_GROUP(RA, gi);
                    if (gi + 2 < 8) UH_ROWS(RA, lecur, gi + 2);
                    else if (tt + 1 < 8) { LDS_WAIT(); asm volatile("" ::: "memory"); UH_ROWS(RA, lenxt, 0); }
                    UH_GROUP(RB, gi + 1);
                }
                LDS_WAIT(); asm volatile("" ::: "memory");
                { float* ab = AB + (size_t)t * 128; ab[lane] = a_lds[lane]; ab[64 + lane] = a_lds[64 + lane]; }
                LDS_WAIT(); asm volatile("" ::: "memory");
                if (tt + 1 < 8) {
#pragma unroll
                    for (int q = 0; q < 16; ++q) xf[q] = xn[q]; }
                { int* tmp_ = lecur; lecur = lenxt; lenxt = tmp_; }
            }
#undef UH_FETCH
#undef UH_LISTS
#undef UH_ROWS
#undef UH_GROUP
#undef UH_XF
        }
    }
}
#define XB_TMO      128
#define XB_XCNT(j)  (256  + 64 * (j))
#define XB_XSUB(j)  (1280 + 64 * (j))
#define XB_XGEN(j)  (2304 + 64 * (j))
#define XB_TOP      3328
#define XB_TOPGEN   3392
#define XCD_BAR_WORDS 3456
#define XB_SPIN_CAP (1u << 18)

__device__ __forceinline__ unsigned xb_ld(unsigned* p)              { return __hip_atomic_load(p, __ATOMIC_RELAXED, __HIP_MEMORY_SCOPE_AGENT); }
__device__ __forceinline__ unsigned xb_add(unsigned* p, unsigned v) { return __hip_atomic_fetch_add(p, v, __ATOMIC_RELAXED, __HIP_MEMORY_SCOPE_AGENT); }
__device__ __forceinline__ unsigned xb_xcc_id() { return (unsigned)__builtin_amdgcn_s_getreg((3 << 11) | 20) & 0xFu; }
#define XB_SPIN(cond, bar) do { unsigned _sp = 0; while (cond) { __builtin_amdgcn_s_sleep(1); \
    if ((++_sp & 255u) == 0u) { if (xb_ld(&(bar)[XB_TMO])) break; if (_sp > XB_SPIN_CAP) { atomicAdd(&(bar)[XB_TMO], 1u); break; } } } } while (0)

struct XcdBarrier {
    unsigned* bar; unsigned x;
    volatile LAS unsigned* st;
};

__device__ __forceinline__ XcdBarrier xcd_barrier_post(unsigned* bar, volatile LAS unsigned* st) {
    XcdBarrier b; b.bar = bar; b.x = xb_xcc_id(); b.st = st;
    if (threadIdx.x == 0) (void)xb_add(&bar[XB_XCNT(b.x)], 1u);
    return b;
}
__device__ __forceinline__ void xcd_barrier_complete(unsigned* bar, unsigned x, unsigned& nloc, unsigned& nx) {
    const unsigned G = gridDim.x * gridDim.y * gridDim.z;
    unsigned sum, cnt, mine, sp = 0u;
    for (;;) {
        sum = 0u; cnt = 0u; mine = 0u;
#pragma unroll
        for (unsigned j = 0; j < 16; ++j) { const unsigned c = xb_ld(&bar[XB_XCNT(j)]); sum += c; cnt += (c > 0u) ? 1u : 0u; mine = (j == x) ? c : mine; }
        if (sum == G) break;
        __builtin_amdgcn_s_sleep(1);
        if ((++sp & 255u) == 0u) { if (xb_ld(&bar[XB_TMO])) break; if (sp > XB_SPIN_CAP) { atomicAdd(&bar[XB_TMO], 1u); break; } }
    }
    nloc = mine > 0u ? mine : 1u; nx = cnt > 0u ? cnt : 1u;
}

__device__ __forceinline__ void xcd_barrier(const XcdBarrier& b) {
    asm volatile("s_waitcnt vmcnt(0)" ::: "memory");
    __syncthreads();
    if (threadIdx.x == 0) {
        unsigned* bar = b.bar;
        __builtin_amdgcn_s_waitcnt(0);
        unsigned nloc = b.st[0], nx = b.st[1];
        if (nloc == 0u) { xcd_barrier_complete(bar, b.x, nloc, nx); b.st[0] = nloc; b.st[1] = nx; }
        const unsigned old = xb_add(&bar[XB_XSUB(b.x)], 1u);
        const unsigned gen = old / nloc;
        if (old + 1u == (gen + 1u) * nloc) {
            __builtin_amdgcn_fence(__ATOMIC_RELEASE, "agent");
            asm volatile("s_waitcnt vmcnt(0)" ::: "memory");
            const unsigned og = xb_add(&bar[XB_TOP], 1u);
            const unsigned tg = og / nx;
            if (og + 1u == (tg + 1u) * nx) xb_add(&bar[XB_TOPGEN], 1u);
            else XB_SPIN(xb_ld(&bar[XB_TOPGEN]) == tg, bar);
            __builtin_amdgcn_fence(__ATOMIC_ACQUIRE, "agent");
            xb_add(&bar[XB_XGEN(b.x)], 1u);
            asm volatile("s_waitcnt vmcnt(0)" ::: "memory");
        } else {
            XB_SPIN(xb_ld(&bar[XB_XGEN(b.x)]) == gen, bar);
            __builtin_amdgcn_fence(__ATOMIC_ACQUIRE, "agent");
            asm volatile("s_waitcnt vmcnt(0)" ::: "memory");
        }
    }
    __syncthreads();
}

#ifndef V8_LPR
#define V8_LPR 32
#endif
constexpr int LDS_BYTES = 147456;
extern __shared__ __attribute__((aligned(16))) unsigned char dyn_lds[];

__global__ void __launch_bounds__(NT, 2) mega_fwd(Params p) {
    cg::grid_group grid = cg::this_grid();
    const int vb = blockIdx.x, nvb = gridDim.x, ngw = nvb * NWV;
    volatile LAS unsigned* xst = (volatile LAS unsigned*)((LAS unsigned char*)dyn_lds + (LDS_BYTES - 16));
    if (threadIdx.x < 4) xst[threadIdx.x] = 0u;
    __syncthreads();
    const XcdBarrier xbar = xcd_barrier_post((unsigned*)(p.ws + WS_CTL), xst);
#define TID_LAUNDER int tid_ = threadIdx.x; asm volatile("" : "+v"(tid_)); const int lane = tid_ & 63, wv = tid_ >> 6, gw = vb * NWV + wv; (void)lane; (void)gw;
    grid.sync();
    ph_mod(p, (float*)dyn_lds, vb, nvb);
    { TID_LAUNDER ph_prep_weights(p, (LAS float*)dyn_lds + wv * (64 * 33), gw, ngw, lane); }
    xcd_barrier(xbar);
    { TID_LAUNDER ph_hrows(p, p.x, p.norm1_g, 0, 1024, gw, ngw, lane); }
    xcd_barrier(xbar);
    {   pg8::Gemm g{(const bf16*)(p.ws + WS_H), (const bf16*)(p.ws + WS_WIN), T, NP, 1024}; pg8::StaticOrder S; S.init(T, NP, nvb, vb);
        EpiNormBf16 E{(bf16*)(p.ws + WS_PROJ), p.a_qk_gain, p.b_q_gain, p.b_kv_gain, (LAS float*)((LAS unsigned char*)dyn_lds + 131072), (bf16*)(p.ws + WS_KVC)};
        pg8::gemm_phase<EpiNormBf16, pg8::StaticOrder, true, true>((LAS unsigned char*)dyn_lds, g, S, E); }
    xcd_barrier(xbar);
    ph_attnA(p, dyn_lds, vb, nvb);
    __syncthreads();
    ph_dsa(p, dyn_lds, vb, nvb);
    xcd_barrier(xbar);
    {   pg8::Gemm g{(const bf16*)(p.ws + WS_MIX), (const bf16*)(p.ws + WS_WO2), T, 1024, MIXW}; pg8::StaticOrder S; S.init(T, 1024, nvb, vb);
        EpiResGate E{p.x, p.out, (const float*)(p.ws + WS_MOD) + 2048};
        pg8::gemm_phase<EpiResGate, pg8::StaticOrder, true, true>((LAS unsigned char*)dyn_lds, g, S, E); }
    xcd_barrier(xbar);
    { TID_LAUNDER ph_hrows(p, p.out, p.norm2_g, 3072, 4096, gw, ngw, lane); }
    xcd_barrier(xbar);
    {   pg8::Gemm g{(const bf16*)(p.ws + WS_H), (const bf16*)(p.ws + WS_WQ), T, 1024, 1024}; pg8::StaticOrder S; S.init(T, 1024, nvb, vb);
        pg8::EpiBf16<0> E{(bf16*)(p.ws + WS_Q3), 1024, nullptr, 0, 0, 1.f};
        pg8::gemm_phase<pg8::EpiBf16<0>, pg8::StaticOrder, true, true>((LAS unsigned char*)dyn_lds, g, S, E); }
    xcd_barrier(xbar);
    ph_route(p, dyn_lds, vb, nvb);
    xcd_barrier(xbar);

#if U8_HALVES
    ph_peer_u8h(p, dyn_lds);
#else
    { TID_LAUNDER ph_peer_u8p(p, dyn_lds + wv * 2048, gw, ngw, lane); }
#endif
    xcd_barrier(xbar);
    ph_peer_v8g<V8_LPR>(p, dyn_lds);

}

extern "C" void kernel_launch(void* const* d_in, const int* in_sizes, int n_in, void* d_out, int out_size, void* d_ws, size_t ws_size, hipStream_t stream) {
    static int grid_blocks = 0;
    if (grid_blocks == 0) {
        if (n_in != 18 || in_sizes[0] != T * DM || out_size != T * DM || ws_size < WS_END) { fprintf(stderr, "kernel_launch: unexpected shapes n_in %d in0 %d out %d ws %zu\n", n_in, n_in > 0 ? in_sizes[0] : -1, out_size, ws_size); grid_blocks = -1; return; }
        int dev = 0, cus = 0, per_cu = 0;
        (void)hipGetDevice(&dev);
        (void)hipDeviceGetAttribute(&cus, hipDeviceAttributeMultiprocessorCount, dev);
        (void)hipFuncSetAttribute((const void*)mega_fwd, hipFuncAttributeMaxDynamicSharedMemorySize, LDS_BYTES);
        (void)hipOccupancyMaxActiveBlocksPerMultiprocessor(&per_cu, (const void*)mega_fwd, NT, LDS_BYTES);
        if (per_cu < 1 || cus < 1) { fprintf(stderr, "kernel_launch: occupancy query gave %d blocks/CU on %d CUs\n", per_cu, cus); grid_blocks = -1; return; }
        grid_blocks = cus;
    }
    if (grid_blocks < 0) return;
    Params p{};
    const float** pp = (const float**)&p;
    for (int i = 0; i < 18; ++i) pp[i] = (const float*)d_in[i];
    p.out = (float*)d_out; p.ws = (unsigned char*)d_ws;
    if (hipMemsetAsync((char*)d_ws + WS_CTL, 0, CTL_BYTES, stream) != hipSuccess) { fprintf(stderr, "kernel_launch: memset failed\n"); return; }
    void* args[] = {&p};
    const hipError_t e = hipLaunchCooperativeKernel((const void*)mega_fwd, dim3(grid_blocks), dim3(NT), args, LDS_BYTES, stream);
    if (e != hipSuccess) fprintf(stderr, "kernel_launch: cooperative launch failed: %s (grid %d)\n", hipGetErrorString(e), grid_blocks);
}
```

```cpp
#include <hip/hip_runtime.h>
#include <hip/hip_cooperative_groups.h>
#include <cstdio>
#include <cstdint>
#include <cmath>
namespace pg8 {
#define PG8_LAS __attribute__((address_space(3)))
typedef unsigned short bf16_t;
typedef short bf16x8 __attribute__((ext_vector_type(8)));
typedef float f32x4 __attribute__((ext_vector_type(4)));
typedef unsigned u32x4 __attribute__((ext_vector_type(4)));
constexpr int BM = 256, BK = 64, HALF = 128, HTB = HALF * BK * 2  , STAGE_BYTES = 8 * HTB, NXCD = 8, WGM = 8;

__host__ __device__ __forceinline__ int lds_byte(int r, int c) { const int st = (r >> 4) * 2 + (c >> 5), rr = r & 15, cc = c & 31, ob = rr * 64 + cc * 2; return st * 1024 + (ob ^ (((ob >> 9) & 1) << 5)); }
__host__ __device__ __forceinline__ void stage_rc(int b, int& R, int& C) { const int st = b / 1024, sb = b % 1024, swz = sb ^ (((sb >> 9) & 1) << 5); R = (st >> 1) * 16 + swz / 64; C = (st & 1) * 32 + (swz % 64) / 2; }
__host__ __device__ __forceinline__ int perm32(int rho) { const int n = rho >> 4, i = rho & 15; return 8 * (i >> 2) + 4 * n + (i & 3); }

struct Unit { int pm, pn; };
struct Gemm { const bf16_t* A; const bf16_t* Bt; int M, N, K; };

struct StaticOrder {
    int nM, nN, nwg, G, c;
    __host__ __device__ void init(int M, int N, int G_, int c_) { nM = M / BM; nN = N / BM; nwg = nM * nN; G = G_; c = c_; }
    __host__ __device__ bool next(int i, Unit& u) const {
        const long L = (long)i * G + c; if (L >= nwg) return false;
        int wgid = (int)L; { const int q = nwg / NXCD, r = nwg % NXCD, xcd = wgid % NXCD, off = wgid / NXCD; wgid = (xcd < r ? xcd * (q + 1) : r * (q + 1) + (xcd - r) * q) + off; }
        const int nig = WGM * nN, gid = wgid / nig, fm = gid * WGM, gsz = (nM - fm) < WGM ? (nM - fm) : WGM;
        u.pm = fm + ((wgid % nig) % gsz); u.pn = (wgid % nig) / gsz; return true;
    }
    __device__ __forceinline__ void a_ready(const Unit&) const {}
    __device__ __forceinline__ void done(const Unit&) const {}
};

__device__ __forceinline__ unsigned cvt_pk_bf16(float lo, float hi) { unsigned r; asm volatile("v_cvt_pk_bf16_f32 %0, %1, %2" : "=v"(r) : "v"(lo), "v"(hi)); return r; }
typedef float f32x2 __attribute__((ext_vector_type(2)));
__device__ __forceinline__ f32x2 gelu_pk(f32x2 v) {
    const f32x2 av = __builtin_elementwise_abs(v), d = av * 0.2316418882f + 1.0f;
    f32x2 t; t.x = __builtin_amdgcn_rcpf(d.x); t.y = __builtin_amdgcn_rcpf(d.y);
    f32x2 q = t * 0.5307027145f + (-0.7265760135f); q = q * t + 0.7107068705f; q = q * t + (-0.142248368f); q = q * t + 0.127414796f; q = q * t;
    const f32x2 s = (v * v) * (-0.72134752044f);
    f32x2 e; e.x = __builtin_amdgcn_exp2f(s.x); e.y = __builtin_amdgcn_exp2f(s.y);
    const f32x2 m = v * (q * e), r = v - m;
    f32x2 o; o.x = v.x < 0.f ? m.x : r.x; o.y = v.y < 0.f ? m.y : r.y; return o;
}

template <int ACT  > struct EpiBf16 {
    static constexpr bool PERM = true, AFTER_DRAIN = false; static_assert(ACT == 0 || ACT == 1, "EpiBf16: ACT is 0 (none) or 1 (gelu_pk)");
    bf16_t* O; int ldc; const float* bias; int split_cols; size_t split_stride; float scale0;
    __device__ __forceinline__ void operator()(const f32x4 (&acc)[2][2][4][2], const Unit& u, int wr, int wc, int fr, int fq) const {
        const int row0 = u.pm * BM + wr * 64 + fr; int colt = u.pn * BM; bf16_t* base = O;
        float sc = 1.f; if (split_cols) { const int t = colt / split_cols; base += (size_t)t * split_stride; colt -= t * split_cols; if (t == 0) sc = scale0; }
        const int col0 = colt + wc * 32 + 8 * fq, bcol0 = u.pn * BM + wc * 32 + 8 * fq;
        f32x4 bv[2][2];
#pragma unroll
        for (int bj = 0; bj < 2; ++bj)
#pragma unroll
            for (int n = 0; n < 2; ++n) bv[bj][n] = bias ? *(const f32x4*)(bias + bcol0 + bj * HALF + 4 * n) : (f32x4){0.f, 0.f, 0.f, 0.f};
#pragma unroll
        for (int ai = 0; ai < 2; ++ai)
#pragma unroll
            for (int m = 0; m < 4; ++m) { bf16_t* rowp = base + (size_t)(row0 + ai * HALF + m * 16) * ldc + col0;
#pragma unroll
                for (int bj = 0; bj < 2; ++bj) { f32x4 v0 = acc[ai][bj][m][0] + bv[bj][0], v1 = acc[ai][bj][m][1] + bv[bj][1];
                    if (ACT == 1) { f32x2 a = gelu_pk((f32x2){v0[0], v0[1]}), b = gelu_pk((f32x2){v0[2], v0[3]}), c = gelu_pk((f32x2){v1[0], v1[1]}), d = gelu_pk((f32x2){v1[2], v1[3]});
                        v0 = (f32x4){a.x, a.y, b.x, b.y}; v1 = (f32x4){c.x, c.y, d.x, d.y}; }
                    v0 = v0 * sc; v1 = v1 * sc; u32x4 w; w.x = cvt_pk_bf16(v0[0], v0[1]); w.y = cvt_pk_bf16(v0[2], v0[3]); w.z = cvt_pk_bf16(v1[0], v1[1]); w.w = cvt_pk_bf16(v1[2], v1[3]);
                    *(u32x4*)(rowp + bj * HALF) = w; } }
    }
};

template <class Epi, class Sched, bool ALIGN_EPI = false, bool SP2 = false>
__device__ __forceinline__ void gemm_phase(PG8_LAS unsigned char* lds, const Gemm g, const Sched& S, const Epi& E) {
    int tid = threadIdx.x; asm volatile("" : "+v"(tid)); const int wid = __builtin_amdgcn_readfirstlane(tid >> 6), lane = tid & 63, wr = wid >> 2, wc = wid & 3, fr = lane & 15, fq = lane >> 4;
    const int K = g.K, nt = K / BK;
    unsigned voffA[2], voffB[2];
#pragma unroll
    for (int i = 0; i < 2; ++i) { int R, C; stage_rc(tid * 16 + i * 8192, R, C); const int Rb = Epi::PERM ? ((R & ~31) + perm32(R & 31)) : R;
        voffA[i] = (unsigned)(R * K + C) * 2u; voffB[i] = (unsigned)(Rb * K + C) * 2u; }
    const size_t kstep = (size_t)(BK * 2);
    const size_t hstep = (size_t)HALF * K * 2;
    const size_t tstep = 2 * hstep;
    const unsigned ldsw = (unsigned)wid * 1024u;
    const int aoff = lds_byte(wr * 64 + fr, fq * 8), boff = lds_byte(wc * 32 + fr, fq * 8);
#define PG8_SA(b, h) (((b) * 2 + (h)) * HTB)
#define PG8_SB(b, h) ((4 + (b) * 2 + (h)) * HTB)
#define PG8_STAGE(bufoff, gbase, voff) do { _Pragma("unroll") for (int _i = 0; _i < 2; ++_i) \
        __builtin_amdgcn_global_load_lds((const unsigned*)((const char*)(gbase) + (voff)[_i]), (PG8_LAS unsigned*)(lds + (bufoff) + ldsw + _i * 8192), 16, 0, 0); } while (0)
#define PG8_LDA(dst, b, h) do { _Pragma("unroll") for (int m = 0; m < 4; ++m) _Pragma("unroll") for (int k = 0; k < 2; ++k) dst[m][k] = *(const PG8_LAS bf16x8*)(lds + PG8_SA(b, h) + aoff + m * 2048 + k * 1024); } while (0)
#define PG8_LDB(dst, b, h) do { _Pragma("unroll") for (int n = 0; n < 2; ++n) _Pragma("unroll") for (int k = 0; k < 2; ++k) dst[n][k] = *(const PG8_LAS bf16x8*)(lds + PG8_SB(b, h) + boff + n * 2048 + k * 1024); } while (0)
#define PG8_MMA(ai, bj, At, Bt) do { __builtin_amdgcn_s_setprio(1); _Pragma("unroll") for (int m = 0; m < 4; ++m) _Pragma("unroll") for (int n = 0; n < 2; ++n) _Pragma("unroll") for (int k = 0; k < 2; ++k) \
        acc[ai][bj][m][n] = __builtin_amdgcn_mfma_f32_16x16x32_bf16(Bt[n][k], At[m][k], acc[ai][bj][m][n], 0, 0, 0); __builtin_amdgcn_s_setprio(0); } while (0)
#define PG8_WAIT_V(n) asm volatile("s_waitcnt vmcnt(" #n ")" ::: "memory")
#define PG8_WAIT_L(n) asm volatile("s_waitcnt lgkmcnt(" #n ")" ::: "memory")
#define PG8_BAR __builtin_amdgcn_s_barrier()
#define PG8_SCHED __builtin_amdgcn_sched_barrier(0)
    Unit cur, nxt; int ui = 0;
    if (!S.next(0, cur)) return;
    f32x4 acc[2][2][4][2];
#pragma unroll
    for (int a = 0; a < 2; ++a)
#pragma unroll
        for (int b = 0; b < 2; ++b)
#pragma unroll
            for (int m = 0; m < 4; ++m)
#pragma unroll
                for (int n = 0; n < 2; ++n) acc[a][b][m][n] = (f32x4){0.f, 0.f, 0.f, 0.f};
    bf16x8 At[4][2], B0[2][2], B1[2][2];
    const char* cA = (const char*)g.A + (size_t)cur.pm * tstep; const char* cB = (const char*)g.Bt + (size_t)cur.pn * tstep;
    S.a_ready(cur);
    if constexpr (SP2) {
        PG8_STAGE(PG8_SB(0, 0), cB, voffB); PG8_STAGE(PG8_SB(0, 1), cB + hstep, voffB); PG8_STAGE(PG8_SA(0, 0), cA, voffA); PG8_STAGE(PG8_SA(0, 1), cA + hstep, voffA);
        if (wr == 1) PG8_BAR;
        PG8_WAIT_V(2); PG8_BAR;
        PG8_STAGE(PG8_SB(1, 0), cB + kstep, voffB); PG8_STAGE(PG8_SA(1, 0), cA + kstep, voffA); PG8_STAGE(PG8_SB(1, 1), cB + hstep + kstep, voffB);
        PG8_WAIT_V(6); PG8_BAR;
    } else {
        PG8_STAGE(PG8_SB(0, 0), cB, voffB); PG8_STAGE(PG8_SA(0, 0), cA, voffA); PG8_STAGE(PG8_SB(0, 1), cB + hstep, voffB); PG8_STAGE(PG8_SA(0, 1), cA + hstep, voffA);
        if (wr == 1) PG8_BAR;
        PG8_WAIT_V(4); PG8_BAR;
        PG8_STAGE(PG8_SB(1, 0), cB + kstep, voffB); PG8_STAGE(PG8_SA(1, 0), cA + kstep, voffA); PG8_STAGE(PG8_SB(1, 1), cB + hstep + kstep, voffB);
        PG8_WAIT_V(6); PG8_BAR;
    }
    for (;;) {
        const bool has_next = S.next(ui + 1, nxt);
        const char* nA = has_next ? (const char*)g.A + (size_t)nxt.pm * tstep : cA; const char* nB = has_next ? (const char*)g.Bt + (size_t)nxt.pn * tstep : cB;
        for (int t = 0; t < nt; t += 2) {
            const bool last = (t == nt - 2);
            const char* a1 = cA + (size_t)(t + 1) * kstep;
            const char* a2 = last ? nA : cA + (size_t)(t + 2) * kstep; const char* b2 = last ? nB : cB + (size_t)(t + 2) * kstep;
            const char* a3 = a2 + kstep; const char* b3 = b2 + kstep;
            if (last && has_next) S.a_ready(nxt);
            if constexpr (SP2) {
            PG8_LDB(B0, 0, 0); PG8_LDB(B1, 0, 1); PG8_SCHED; PG8_LDA(At, 0, 0); PG8_STAGE(PG8_SA(1, 1), a1 + hstep, voffA);
            PG8_WAIT_V(8); PG8_WAIT_L(0); PG8_BAR; PG8_MMA(0, 0, At, B0); PG8_MMA(0, 1, At, B1); PG8_BAR; PG8_SCHED;
            PG8_LDA(At, 0, 1); PG8_STAGE(PG8_SB(0, 0), b2, voffB); PG8_STAGE(PG8_SB(0, 1), b2 + hstep, voffB); PG8_STAGE(PG8_SA(0, 0), a2, voffA);
            PG8_WAIT_V(8); PG8_WAIT_L(0); PG8_BAR; PG8_MMA(1, 0, At, B0); PG8_MMA(1, 1, At, B1); PG8_BAR; PG8_SCHED;
            PG8_LDB(B0, 1, 0); PG8_LDB(B1, 1, 1); PG8_SCHED; PG8_LDA(At, 1, 0); PG8_STAGE(PG8_SA(0, 1), a2 + hstep, voffA);
            PG8_WAIT_V(8); PG8_WAIT_L(0); PG8_BAR; PG8_MMA(0, 0, At, B0); PG8_MMA(0, 1, At, B1); PG8_BAR; PG8_SCHED;
            PG8_LDA(At, 1, 1); PG8_STAGE(PG8_SB(1, 0), b3, voffB); PG8_STAGE(PG8_SB(1, 1), b3 + hstep, voffB); PG8_STAGE(PG8_SA(1, 0), a3, voffA);
            PG8_WAIT_V(8); PG8_WAIT_L(0); PG8_BAR; PG8_MMA(1, 0, At, B0); PG8_MMA(1, 1, At, B1); PG8_BAR; PG8_SCHED;
            } else {
            PG8_LDB(B0, 0, 0); PG8_SCHED; PG8_LDA(At, 0, 0); PG8_STAGE(PG8_SA(1, 1), a1 + hstep, voffA);
            PG8_WAIT_L(8); PG8_BAR; PG8_WAIT_L(0); PG8_MMA(0, 0, At, B0); PG8_BAR; PG8_SCHED;
            PG8_LDB(B1, 0, 1); PG8_STAGE(PG8_SB(0, 0), b2, voffB);
            PG8_BAR; PG8_WAIT_L(0); PG8_MMA(0, 1, At, B1); PG8_BAR;
            PG8_LDA(At, 0, 1); PG8_STAGE(PG8_SA(0, 0), a2, voffA);
            PG8_BAR; PG8_WAIT_L(0); PG8_MMA(1, 0, At, B0); PG8_BAR; PG8_SCHED;
            PG8_STAGE(PG8_SB(0, 1), b2 + hstep, voffB);
            PG8_WAIT_V(6); PG8_BAR; PG8_MMA(1, 1, At, B1); PG8_BAR;
            PG8_LDB(B0, 1, 0); PG8_SCHED; PG8_LDA(At, 1, 0); PG8_STAGE(PG8_SA(0, 1), a2 + hstep, voffA);
            PG8_WAIT_L(8); PG8_BAR; PG8_WAIT_L(0); PG8_MMA(0, 0, At, B0); PG8_BAR; PG8_SCHED;
            PG8_LDB(B1, 1, 1); PG8_STAGE(PG8_SB(1, 0), b3, voffB);
            PG8_BAR; PG8_WAIT_L(0); PG8_MMA(0, 1, At, B1); PG8_BAR;
            PG8_LDA(At, 1, 1); PG8_STAGE(PG8_SA(1, 0), a3, voffA);
            PG8_BAR; PG8_WAIT_L(0); PG8_MMA(1, 0, At, B0); PG8_BAR; PG8_SCHED;
            PG8_STAGE(PG8_SB(1, 1), b3 + hstep, voffB);
            PG8_WAIT_V(6); PG8_BAR; PG8_MMA(1, 1, At, B1); PG8_BAR;
            }
        }
        if constexpr (ALIGN_EPI) { if (wr == 0) PG8_BAR; }
        if constexpr (!Epi::AFTER_DRAIN) { E(acc, cur, wr, wc, fr, fq); S.done(cur); }
        if (!has_next) break;
#pragma unroll
        for (int a = 0; a < 2; ++a)
#pragma unroll
            for (int b = 0; b < 2; ++b)
#pragma unroll
                for (int m = 0; m < 4; ++m)
#pragma unroll
                    for (int n = 0; n < 2; ++n) acc[a][b][m][n] = (f32x4){0.f, 0.f, 0.f, 0.f};
        cur = nxt; cA = nA; cB = nB; ++ui;
        if constexpr (ALIGN_EPI) { if (wr == 1) PG8_BAR; }
    }
    PG8_WAIT_V(0);
    if constexpr (!ALIGN_EPI) { if (wr == 0) PG8_BAR; }
    PG8_BAR;
    if constexpr (Epi::AFTER_DRAIN) { E.fused(acc, cur, wr, wc, fr, fq, lds, wid, lane); S.done(cur); }
#undef PG8_SA
#undef PG8_SB
#undef PG8_STAGE
#undef PG8_LDA
#undef PG8_LDB
#undef PG8_MMA
#undef PG8_WAIT_V
#undef PG8_WAIT_L
#undef PG8_BAR
#undef PG8_SCHED
}
}
namespace cg = cooperative_groups;
#define LAS __attribute__((address_space(3)))
typedef unsigned short bf16;
typedef float f32x4 __attribute__((ext_vector_type(4)));
typedef float f32x8 __attribute__((ext_vector_type(8)));
typedef float f32x16 __attribute__((ext_vector_type(16)));
typedef unsigned u32x4 __attribute__((ext_vector_type(4)));
typedef unsigned u32x2 __attribute__((ext_vector_type(2)));
typedef short bf16x8 __attribute__((ext_vector_type(8)));
typedef short s16x4 __attribute__((ext_vector_type(4)));

constexpr int BATCH = 16, SEQ = 2048, DM = 1024, T = BATCH * SEQ;
constexpr int NP = 3072;
constexpr int IN_COLS = 3012;
constexpr int C_QA = 0, C_KA = 512, C_VA = 1024, C_QB = 1536, C_KV = 2560, C_QI = 2688, C_KI = 2944, C_WI = 3008;
constexpr int MIXW = 1536;
constexpr int NEXP = 16384;
constexpr float EPS = 1e-6f;
constexpr int NT = 512;
constexpr int NWV = 8;

constexpr size_t MiB = 1u << 20;
constexpr size_t WS_CTL = 0;
constexpr size_t CTL_BYTES = 64 * 1024;
constexpr size_t WS_MOD = 1 * MiB;
constexpr size_t WS_SCAL = WS_MOD + 512 * 1024;
constexpr size_t WS_WIN = 2 * MiB;
constexpr size_t WS_WO2 = 8 * MiB;
constexpr size_t WS_WQ = 11 * MiB;
constexpr size_t WS_SUBK = 13 * MiB;
constexpr size_t WS_U16 = 14 * MiB;
constexpr size_t WS_V16 = 46 * MiB;
constexpr size_t WS_H = 78 * MiB;
constexpr size_t WS_PROJ = 142 * MiB;
constexpr size_t WS_Q3 = WS_PROJ;
constexpr size_t WS_MIX = 334 * MiB;
constexpr size_t WS_EXP = 430 * MiB;
constexpr size_t WS_KVC = WS_EXP;
constexpr size_t WS_GATE = 446 * MiB;
constexpr size_t WS_ATMP = 462 * MiB;
constexpr size_t WS_CBUF = 494 * MiB;
constexpr size_t WS_ABUF1 = WS_MIX;
constexpr size_t WS_END = 510 * MiB;

struct Params {
    const float *x, *c, *ada_w, *ada_b, *norm1_g, *norm2_g, *w_in, *a_qk_gain, *a_lambda, *a_sub_gain, *b_q_gain, *b_kv_gain, *b_w_uv, *w_out, *peer_wq, *peer_subkeys, *peer_u, *peer_v;
    float* out; unsigned char* ws;
};

enum { SC_LAM = 0, SC_MA = 1, SC_MB = 2 };

__device__ __forceinline__ unsigned f2bf(float f) { unsigned u = __float_as_uint(f); return (u + 0x7fffu + ((u >> 16) & 1u)) >> 16; }
__device__ __forceinline__ float bf2f(unsigned h) { return __uint_as_float(h << 16); }
__device__ __forceinline__ unsigned pk2(float lo, float hi) { return f2bf(lo) | (f2bf(hi) << 16); }
__device__ __forceinline__ float bflo(unsigned w) { return __uint_as_float(w << 16); }
__device__ __forceinline__ float bfhi(unsigned w) { return __uint_as_float(w & 0xffff0000u); }
__device__ __forceinline__ float wave_sum(float v) {
#pragma unroll
    for (int o = 1; o < 64; o <<= 1) v += __shfl_xor(v, o);
    return v;
}
__device__ __forceinline__ float wave_max(float v) {
#pragma unroll
    for (int o = 1; o < 64; o <<= 1) v = fmaxf(v, __shfl_xor(v, o));
    return v;
}
#define LDS_WAIT() asm volatile("s_waitcnt lgkmcnt(0)" ::: "memory")
__device__ __forceinline__ void ph_mod(const Params& p, float* ldsf, int vb, int nvb) {
    if (vb >= 96) return;
    int tid = threadIdx.x; asm volatile("" : "+v"(tid));
    const int lane = tid & 63, wv = tid >> 6;
    for (int i = tid; i < 16 * 1024; i += NT) { const float v = p.c[i]; ldsf[i] = v / (1.f + __expf(-v)); }
    __syncthreads();
    float* MOD = (float*)(p.ws + WS_MOD); float* part = ldsf + 16 * 1024;
    for (int it = vb; it < 96; it += nvb) {
        const int j = it * 64 + lane;
        float acc[16];
#pragma unroll
        for (int b = 0; b < 16; ++b) acc[b] = 0.f;
        const float* wp = p.ada_w + (size_t)(128 * wv) * 6144 + j;
#pragma unroll 1
        for (int k0 = 0; k0 < 128; k0 += 8) {
            float w[8];
#pragma unroll
            for (int u = 0; u < 8; ++u) w[u] = wp[(size_t)(k0 + u) * 6144];
#pragma unroll
            for (int u = 0; u < 8; ++u)
#pragma unroll
                for (int b = 0; b < 16; ++b) acc[b] = fmaf(ldsf[b * 1024 + 128 * wv + k0 + u], w[u], acc[b]);
        }
#pragma unroll
        for (int b = 0; b < 16; ++b) part[(wv * 16 + b) * 64 + lane] = acc[b];
        __syncthreads();
        for (int o = tid; o < 16 * 64; o += NT) { const int b = o >> 6, c = o & 63; float s = 0.f;
#pragma unroll
            for (int w = 0; w < 8; ++w) s += part[(w * 16 + b) * 64 + c];
            MOD[b * 6144 + it * 64 + c] = s + p.ada_b[it * 64 + c]; }
        __syncthreads();
    }
}

__device__ __forceinline__ void transpose_item(const float* W, int N, bf16* WT, int ldt, LAS float* scr, int kb, int nb, int lane) {
    const int k0 = 64 * kb, n0 = 32 * nb;
#pragma unroll 8
    for (int i = 0; i < 32; ++i) { const int kk = 2 * i + (lane >> 5); const int n = n0 + (lane & 31); scr[kk * 33 + (lane & 31)] = (n < N) ? W[(size_t)(k0 + kk) * N + n] : 0.f; }
    LDS_WAIT(); asm volatile("" ::: "memory");
    const int c = lane & 7;
#pragma unroll
    for (int j = 0; j < 4; ++j) { const int n = (lane >> 3) + 8 * j; const LAS float* s = scr + (8 * c) * 33 + n;
        u32x4 o; o.x = pk2(s[0 * 33], s[1 * 33]); o.y = pk2(s[2 * 33], s[3 * 33]); o.z = pk2(s[4 * 33], s[5 * 33]); o.w = pk2(s[6 * 33], s[7 * 33]);
        *(u32x4*)(WT + (size_t)(n0 + n) * ldt + k0 + 8 * c) = o; }
    LDS_WAIT(); asm volatile("" ::: "memory");
}

__device__ __forceinline__ void ph_prep_weights(const Params& p, LAS float* scr, int gw, int ngw, int lane) {
    bf16* WIN = (bf16*)(p.ws + WS_WIN); bf16* WO2 = (bf16*)(p.ws + WS_WO2); bf16* WQ = (bf16*)(p.ws + WS_WQ);
    constexpr int I_IN = 16 * 96, I_O = 8 * 32, I_Q = 16 * 32;
    for (int it = gw; it < I_IN + I_O + I_Q; it += ngw) {
        int r = it;
        if (r < I_IN) { transpose_item(p.w_in, IN_COLS, WIN, 1024, scr, r / 96, r % 96, lane); continue; } r -= I_IN;
        if (r < I_O) { transpose_item(p.w_out, 1024, WO2, MIXW, scr, r / 32, r % 32, lane); continue; } r -= I_O;
        transpose_item(p.peer_wq, 1024, WQ, 1024, scr, r / 32, r % 32, lane);
    }
    const size_t gt = (size_t)gw * 64 + lane, ngt = (size_t)ngw * 64;
    for (size_t i = gt; i < (size_t)1024 * 1024; i += ngt) {
        const int n = (int)(i & 1023), kk = (int)(i >> 10), h = kk >> 7;
        const float* wu = p.b_w_uv + (size_t)kk * 64; const float* wo = p.w_out + (size_t)(512 + 64 * h) * 1024 + n;
        float a = 0.f;
#pragma unroll 8
        for (int e = 0; e < 64; ++e) a = fmaf(wu[e], wo[(size_t)e * 1024], a);
        WO2[(size_t)n * MIXW + 512 + kk] = (bf16)f2bf(a);
    }
    bf16* SUBK = (bf16*)(p.ws + WS_SUBK);
    constexpr size_t NSUB8 = 2 * 128 * 64 / 8;
    for (size_t j = gt; j < NSUB8; j += ngt) {
        const f32x8 v = *(const f32x8*)(p.peer_subkeys + j * 8);
        u32x4 o; o.x = pk2(v[0], v[1]); o.y = pk2(v[2], v[3]); o.z = pk2(v[4], v[5]); o.w = pk2(v[6], v[7]);
        *(u32x4*)(SUBK + j * 8) = o;
    }
    if (gt == 0) {
        float* SC = (float*)(p.ws + WS_SCAL);
        float s01 = 0.f, s23 = 0.f;
        for (int i = 0; i < 64; ++i) { s01 += p.a_lambda[i] * p.a_lambda[64 + i]; s23 += p.a_lambda[128 + i] * p.a_lambda[192 + i]; }
        SC[SC_LAM] = __expf(s01) - __expf(s23) + 0.2f;
        float g0 = 0.f, g1 = 0.f, gq = 0.f, gk = 0.f;
        for (int i = 0; i < 64; ++i) { g0 = fmaxf(g0, fabsf(p.a_qk_gain[i])); g1 = fmaxf(g1, fabsf(p.a_qk_gain[64 + i])); }
        for (int i = 0; i < 128; ++i) { gq = fmaxf(gq, fabsf(p.b_q_gain[i])); gk = fmaxf(gk, fabsf(p.b_kv_gain[i])); }
        SC[SC_MA] = 8.0f * g0 * g1 * 1.02f;
        SC[SC_MB] = 11.3137085f * gq * gk * 1.02f;
    }
}

__device__ __forceinline__ void ph_hrows(const Params& p, const float* X, const float* g, int shOff, int scOff, int gw, int ngw, int lane) {
    const float* MOD = (const float*)(p.ws + WS_MOD); bf16* H = (bf16*)(p.ws + WS_H);
    for (int m = gw; m < T; m += ngw) {
        const f32x4* xr = (const f32x4*)(X + (size_t)m * 1024) + lane;
        f32x4 v[4]; float s = 0.f;
#pragma unroll
        for (int j = 0; j < 4; ++j) { v[j] = xr[64 * j]; s += (v[j].x * v[j].x + v[j].y * v[j].y) + (v[j].z * v[j].z + v[j].w * v[j].w); }
        const float rstd = rsqrtf(wave_sum(s) * (1.f / 1024.f) + EPS);
        const float* mb = MOD + (size_t)(m >> 11) * 6144;
#pragma unroll
        for (int j = 0; j < 4; ++j) {
            const int col = 4 * (lane + 64 * j);
            const f32x4 gg = *(const f32x4*)(g + col), sc = *(const f32x4*)(mb + scOff + col), sh = *(const f32x4*)(mb + shOff + col);
            const f32x4 y = v[j] * rstd * gg * (sc + 1.0f) + sh;
            u32x2 o; o.x = pk2(y.x, y.y); o.y = pk2(y.z, y.w);
            *(u32x2*)(H + (size_t)m * 1024 + col) = o;
        }
    }
}

__device__ __forceinline__ void ph_norm_proj(const Params& p, int gw, int ngw, int lane) {
    bf16* PROJ = (bf16*)(p.ws + WS_PROJ);
    for (int m = gw; m < T; m += ngw) {
        bf16* row = PROJ + (size_t)m * NP;
#pragma unroll
        for (int j = 0; j < 6; ++j) {
            if (j == 2) continue;
            const int col = 8 * lane + 512 * j;
            const u32x4 raw = *(const u32x4*)(row + col);
            float v[8] = {bflo(raw.x), bfhi(raw.x), bflo(raw.y), bfhi(raw.y), bflo(raw.z), bfhi(raw.z), bflo(raw.w), bfhi(raw.w)};
            float ss = 0.f;
#pragma unroll
            for (int i = 0; i < 8; ++i) ss += v[i] * v[i];
            ss += __shfl_xor(ss, 1); ss += __shfl_xor(ss, 2); ss += __shfl_xor(ss, 4);
            float rstd; const float* gp;
            if (j < 2) { rstd = rsqrtf(ss * (1.f / 64.f) + EPS); gp = p.a_qk_gain + 64 * j + (col & 63); }
            else { ss += __shfl_xor(ss, 8); rstd = rsqrtf(ss * (1.f / 128.f) + EPS); gp = (j == 5 ? p.b_kv_gain : p.b_q_gain) + (col & 127); }
            if (j == 5 && lane >= 16) continue;
            const f32x4 g0 = *(const f32x4*)gp, g1 = *(const f32x4*)(gp + 4);
            u32x4 o; o.x = pk2(v[0] * rstd * g0.x, v[1] * rstd * g0.y); o.y = pk2(v[2] * rstd * g0.z, v[3] * rstd * g0.w);
            o.z = pk2(v[4] * rstd * g1.x, v[5] * rstd * g1.y); o.w = pk2(v[6] * rstd * g1.z, v[7] * rstd * g1.w);
            *(u32x4*)(row + col) = o;
        }
    }
}
struct EpiResGate {
    static constexpr bool PERM = false, AFTER_DRAIN = false;
    const float* X; float* Out; const float* gate;
    __device__ __forceinline__ void operator()(const pg8::f32x4 (&acc)[2][2][4][2], const pg8::Unit& u, int wr, int wc, int fr, int fq) const {
        const int col0 = u.pn * 256 + wc * 32 + 4 * fq;
#pragma unroll
        for (int ai = 0; ai < 2; ++ai)
#pragma unroll
            for (int m = 0; m < 4; ++m) {
                const int r = u.pm * 256 + ai * 128 + wr * 64 + m * 16 + fr; const float* gb = gate + (size_t)(r >> 11) * 6144;
#pragma unroll
                for (int bj = 0; bj < 2; ++bj)
#pragma unroll
                    for (int n = 0; n < 2; ++n) { const int c = col0 + bj * 128 + n * 16; const size_t off = (size_t)r * 1024 + c;
                        const pg8::f32x4 xv = *(const pg8::f32x4*)(X + off), gv = *(const pg8::f32x4*)(gb + c);
                        *(pg8::f32x4*)(Out + off) = xv + gv * acc[ai][bj][m][n]; }
            }
    }
};


struct EpiNormBf16 {
    static constexpr bool PERM = true, AFTER_DRAIN = false;
    bf16* O; const float* gqk; const float* gbq; const float* gbkv; LAS float* P; bf16* KVC;
    __device__ __forceinline__ void operator()(const pg8::f32x4 (&acc)[2][2][4][2], const pg8::Unit& u, int wr, int wc, int fr, int fq) const {
        const int pn = u.pn;
        const int mode = pn < 4 ? 1 : ((pn == 4 || pn == 5 || pn == 11) ? 0 : (pn == 10 ? 3 : 2));
        if (mode != 0) {
#pragma unroll
            for (int ai = 0; ai < 2; ++ai)
#pragma unroll
                for (int m = 0; m < 4; ++m)
#pragma unroll
                    for (int bj = 0; bj < 2; ++bj) {
                        const pg8::f32x4 a = acc[ai][bj][m][0], b = acc[ai][bj][m][1];
                        float ss = (a[0] * a[0] + a[1] * a[1]) + (a[2] * a[2] + a[3] * a[3]) + (b[0] * b[0] + b[1] * b[1]) + (b[2] * b[2] + b[3] * b[3]);
                        ss += __shfl_xor(ss, 16); ss += __shfl_xor(ss, 32);
                        if (fq == 0) P[(ai * 128 + wr * 64 + m * 16 + fr) * 8 + bj * 4 + wc] = ss;
                    }
            asm volatile("s_waitcnt lgkmcnt(0)" ::: "memory"); __builtin_amdgcn_s_barrier(); asm volatile("" ::: "memory");
        }
        const int row0 = u.pm * 256 + wr * 64 + fr, col0 = u.pn * 256 + wc * 32 + 8 * fq;
        pg8::f32x4 g0[2], g1[2];
#pragma unroll
        for (int bj = 0; bj < 2; ++bj) {
            const float* gp = nullptr;
            if (mode == 1) gp = gqk + (pn >= 2 ? 64 : 0) + 32 * (wc & 1) + 8 * fq;
            else if (mode == 2) gp = gbq + 32 * wc + 8 * fq;
            else if (mode == 3 && bj == 0) gp = gbkv + 32 * wc + 8 * fq;
            if (gp) { g0[bj] = *(const pg8::f32x4*)gp; g1[bj] = *(const pg8::f32x4*)(gp + 4); } else { g0[bj] = (pg8::f32x4){1.f, 1.f, 1.f, 1.f}; g1[bj] = g0[bj]; }
        }
#pragma unroll
        for (int ai = 0; ai < 2; ++ai)
#pragma unroll
            for (int m = 0; m < 4; ++m) { bf16* rowp = O + (size_t)(row0 + ai * 128 + m * 16) * NP + col0;
#pragma unroll
                for (int bj = 0; bj < 2; ++bj) {
                    float s = 1.f;
                    if (mode != 0 && !(mode == 3 && bj == 1)) {
                        const pg8::f32x4 q = *(const LAS pg8::f32x4*)(P + (ai * 128 + wr * 64 + m * 16 + fr) * 8 + bj * 4);
                        s = (mode == 1) ? rsqrtf(((wc < 2) ? (q[0] + q[1]) : (q[2] + q[3])) * (1.f / 64.f) + EPS) : rsqrtf(((q[0] + q[1]) + (q[2] + q[3])) * (1.f / 128.f) + EPS);
                    }
                    const pg8::f32x4 v0 = acc[ai][bj][m][0] * s * g0[bj], v1 = acc[ai][bj][m][1] * s * g1[bj];
                    pg8::u32x4 w; w.x = pg8::cvt_pk_bf16(v0[0], v0[1]); w.y = pg8::cvt_pk_bf16(v0[2], v0[3]); w.z = pg8::cvt_pk_bf16(v1[0], v1[1]); w.w = pg8::cvt_pk_bf16(v1[2], v1[3]);
                    if (pn == 10 && bj == 0) *(pg8::u32x4*)(KVC + (size_t)(row0 + ai * 128 + m * 16) * 128 + wc * 32 + 8 * fq) = w;
                    else *(pg8::u32x4*)(rowp + bj * 128) = w; } }
    }
};
typedef __bf16 bf16x2_t __attribute__((ext_vector_type(2)));
__device__ __forceinline__ float dot2bf(unsigned a, unsigned b, float acc) { return __builtin_amdgcn_fdot2_f32_bf16(__builtin_bit_cast(bf16x2_t, a), __builtin_bit_cast(bf16x2_t, b), acc, false); }
template <int CTRL> __device__ __forceinline__ float dpp_f(float v) { return __int_as_float(__builtin_amdgcn_update_dpp(0, __float_as_int(v), CTRL, 0xf, 0xf, false)); }
__device__ __forceinline__ float row16_sum(float v) {
    v += dpp_f<0x128>(v); v += dpp_f<0x124>(v); v += dpp_f<0x122>(v); v += dpp_f<0x121>(v); return v;
}
__device__ __forceinline__ float gelu_erf(float v) {
    const float av = fabsf(v), t = __builtin_amdgcn_rcpf(fmaf(av, 0.2316418882f, 1.0f));
    float q = fmaf(t, 0.5307027145f, -0.7265760135f); q = fmaf(q, t, 0.7107068705f); q = fmaf(q, t, -0.142248368f); q = fmaf(q, t, 0.127414796f); q = q * t;
    const float e = __builtin_amdgcn_exp2f(v * v * -0.72134752044f);
    const float m = v * (q * e);
    return v < 0.f ? m : v - m;
}

#ifndef DSA_PB
#define DSA_PB 0
#endif
typedef short v4i16_t __attribute__((ext_vector_type(4)));
#ifndef DSA_REP_A
#define DSA_REP_A 1
#endif
#ifndef DSA_REP_B
#define DSA_REP_B 1
#endif
#ifndef DSA_REP_C
#define DSA_REP_C 1
#endif
constexpr int DSA_SROW = 2048 * 4 + 16;
constexpr int DSA_SEL_OFF = 16 * DSA_SROW;
constexpr int DSA_LDS = DSA_SEL_OFF + 16 * 512;
constexpr int DSA_KVROW = 272;

__device__ __forceinline__ unsigned sortkey(float s) { const unsigned u = __float_as_uint(s); return u ^ ((u >> 31) ? 0xffffffffu : 0x80000000u); }
__device__ __forceinline__ unsigned cvtpk_bf16(float lo, float hi) { unsigned r; asm volatile("v_cvt_pk_bf16_f32 %0, %1, %2" : "=v"(r) : "v"(lo), "v"(hi)); return r; }

__device__ __forceinline__ void cnt_ge4(int& acc, unsigned k0, unsigned k1, unsigned k2, unsigned k3, unsigned cand) {
    asm volatile("v_cmp_ge_u32_e64 s[40:41], %1, %5\n\t"
                 "v_cmp_ge_u32_e64 s[42:43], %2, %5\n\t"
                 "v_cmp_ge_u32_e64 s[44:45], %3, %5\n\t"
                 "v_cmp_ge_u32_e64 s[46:47], %4, %5\n\t"
                 "v_addc_co_u32_e64 %0, s[48:49], %0, 0, s[40:41]\n\t"
                 "v_addc_co_u32_e64 %0, s[48:49], %0, 0, s[42:43]\n\t"
                 "v_addc_co_u32_e64 %0, s[48:49], %0, 0, s[44:45]\n\t"
                 "v_addc_co_u32_e64 %0, s[48:49], %0, 0, s[46:47]"
                 : "+v"(acc) : "v"(k0), "v"(k1), "v"(k2), "v"(k3), "v"(cand)
                 : "s40", "s41", "s42", "s43", "s44", "s45", "s46", "s47", "s48", "s49");
}
__device__ __forceinline__ void ph_dsa(const Params& p, unsigned char* lds, int vb, int nvb) {
    const bf16* PROJ = (const bf16*)(p.ws + WS_PROJ); bf16* MIX = (bf16*)(p.ws + WS_MIX);
    const float MB = ((const float*)(p.ws + WS_SCAL))[SC_MB];
    int tid = threadIdx.x; asm volatile("" : "+v"(tid)); const int lane = tid & 63, wv = __builtin_amdgcn_readfirstlane(tid >> 6);
    const int l15 = lane & 15, g = lane >> 4;
    LAS unsigned char* ldsl = (LAS unsigned char*)lds;
    for (int it = vb; it < 2048; it += nvb) {
        const int vbb = it & 255, kk = it >> 8, xg = vbb & 7, ix = vbb >> 3, b = 2 * xg + (ix & 1), G = (ix >> 1) & 3, sub = ix >> 3;
        const int c = (kk & 1) ? (31 - G - 8 * (kk >> 1)) : (G + 8 * (kk >> 1));
        const int cend = (c + 1) * 64, t0 = c * 64 + sub * 16;
        const bf16* Pb = PROJ + (size_t)b * SEQ * NP;
        const bf16* KVb = (const bf16*)(p.ws + WS_KVC) + (size_t)b * SEQ * 128;
#pragma unroll 1
        for (int repa = 0; repa < DSA_REP_A; ++repa)
        if (c >= 4) {
            const bf16* qrow = Pb + (size_t)(t0 + l15) * NP;
            bf16x8 bq[4][2]; float wsc[4];
#pragma unroll
            for (int h = 0; h < 4; ++h) { wsc[h] = bf2f(qrow[C_WI + h]) * 0.0625f;
#pragma unroll
                for (int ks = 0; ks < 2; ++ks) bq[h][ks] = *(const bf16x8*)(qrow + C_QI + h * 64 + 32 * ks + 8 * g); }
            for (int k0 = 16 * wv; k0 < cend; k0 += 128) {
                const bf16* krow = Pb + (size_t)(k0 + l15) * NP + C_KI + 8 * g;
                const bf16x8 ka0 = *(const bf16x8*)krow, ka1 = *(const bf16x8*)(krow + 32);
                f32x4 sc = {0.f, 0.f, 0.f, 0.f};
#pragma unroll
                for (int h = 0; h < 4; ++h) { f32x4 a = {0.f, 0.f, 0.f, 0.f};
                    a = __builtin_amdgcn_mfma_f32_16x16x32_bf16(ka0, bq[h][0], a, 0, 0, 0);
                    a = __builtin_amdgcn_mfma_f32_16x16x32_bf16(ka1, bq[h][1], a, 0, 0, 0);
#pragma unroll
                    for (int r = 0; r < 4; ++r) sc[r] = fmaf(fmaxf(a[r], 0.f), wsc[h], sc[r]); }
#pragma unroll
                for (int r = 0; r < 4; ++r) sc[r] = (sc[r] == 0.f) ? 0.f : sc[r];
                *(LAS f32x4*)(ldsl + l15 * DSA_SROW + (k0 + 4 * g) * 4) = sc;
            }
        }
        __syncthreads();
        LAS unsigned short* selw = (LAS unsigned short*)(ldsl + DSA_SEL_OFF);
        int mind0 = 0, mind1 = 0;
        if (c < 4) {
            for (int j = lane; j < 256; j += 64) { selw[(2 * wv) * 256 + j] = (unsigned short)j; selw[(2 * wv + 1) * 256 + j] = (unsigned short)j; }
        } else {
            const int nreg = cend >> 6;
            unsigned keyA[32], keyB[32];
            { const LAS float* srA = (const LAS float*)(ldsl + (2 * wv) * DSA_SROW) + lane; const LAS float* srB = (const LAS float*)(ldsl + (2 * wv + 1) * DSA_SROW) + lane;
#pragma unroll
              for (int i = 0; i < 32; ++i) { keyA[i] = (i < nreg) ? sortkey(srA[64 * i]) : 0u; keyB[i] = (i < nreg) ? sortkey(srB[64 * i]) : 0u; } }
#define DSA_WSUM(V, OUT) do { int v_ = (V); v_ += __builtin_amdgcn_update_dpp(0, v_, 0x128, 0xf, 0xf, false); v_ += __builtin_amdgcn_update_dpp(0, v_, 0x124, 0xf, 0xf, false); \
        v_ += __builtin_amdgcn_update_dpp(0, v_, 0x122, 0xf, 0xf, false); v_ += __builtin_amdgcn_update_dpp(0, v_, 0x121, 0xf, 0xf, false);                                     \
        OUT = __builtin_amdgcn_readlane(v_, 0) + __builtin_amdgcn_readlane(v_, 16) + __builtin_amdgcn_readlane(v_, 32) + __builtin_amdgcn_readlane(v_, 48); } while (0)
            unsigned prefA = 0u, prefB = 0u; bool exA = false, exB = false;
#pragma unroll 1
            for (int bit = 31; bit >= 0; --bit) {
                const unsigned candA = exA ? prefA : (prefA | (1u << bit)), candB = exB ? prefB : (prefB | (1u << bit));
                int ca = 0, cb = 0;
#pragma unroll
                for (int i = 0; i < 32; i += 4) { cnt_ge4(ca, keyA[i], keyA[i + 1], keyA[i + 2], keyA[i + 3], candA); cnt_ge4(cb, keyB[i], keyB[i + 1], keyB[i + 2], keyB[i + 3], candB); }
                int cntA, cntB; DSA_WSUM(ca, cntA); DSA_WSUM(cb, cntB);
                if (!exA && cntA >= 256) { prefA = candA; exA = (cntA == 256); }
                if (!exB && cntB >= 256) { prefB = candB; exB = (cntB == 256); }
                if (exA && exB) break;
            }
#define DSA_COMPACT(KEY, PREFIX, EXACT, QQ, MIND) do {                                                                                              \
            const int t_ = t0 + (QQ); LAS unsigned short* sel = selw + (QQ) * 256;                                                                    \
            int need_ties = 0;                                                                                                                        \
            if (!(EXACT)) { int cg_ = 0; if ((PREFIX) != 0xffffffffu) { _Pragma("unroll") for (int i = 0; i < 32; ++i) cg_ += (KEY[i] > (PREFIX)) ? 1 : 0; } \
                int cgt; DSA_WSUM(cg_, cgt); need_ties = 256 - cgt; }                                                                                 \
            int base = 0, tbase = 0, md = 4096;                                                                                                       \
            _Pragma("unroll") for (int i = 0; i < 32; ++i) { if (i < nreg) {                                                                          \
                bool selb;                                                                                                                            \
                if (EXACT) selb = KEY[i] >= (PREFIX);                                                                                                 \
                else { const bool tie = KEY[i] == (PREFIX); const unsigned long long mt = __ballot(tie);                                              \
                    const int trank = tbase + (int)__builtin_amdgcn_mbcnt_hi((unsigned)(mt >> 32), __builtin_amdgcn_mbcnt_lo((unsigned)mt, 0u));      \
                    selb = (KEY[i] > (PREFIX)) || (tie && trank < need_ties); tbase += __popcll(mt); }                                                \
                const unsigned long long m = __ballot(selb);                                                                                          \
                const int pos = base + (int)__builtin_amdgcn_mbcnt_hi((unsigned)(m >> 32), __builtin_amdgcn_mbcnt_lo((unsigned)m, 0u));               \
                const int kidx = i * 64 + lane;                                                                                                       \
                if (selb) { sel[pos] = (unsigned short)kidx; const int d = t_ > kidx ? t_ - kidx : kidx - t_; md = d < md ? d : md; }                 \
                base += __popcll(m); } }                                                                                                              \
            _Pragma("unroll") for (int o = 1; o < 64; o <<= 1) { const int x = __shfl_xor(md, o); md = x < md ? x : md; }                             \
            MIND = md; } while (0)
            DSA_COMPACT(keyA, prefA, exA, 2 * wv, mind0);
            DSA_COMPACT(keyB, prefB, exB, 2 * wv + 1, mind1);
#undef DSA_COMPACT
#undef DSA_WSUM
        }
        LDS_WAIT(); asm volatile("" ::: "memory");
        const int nvalid = cend < 256 ? cend : 256;
        const int head = lane & 7;
        const float slopeL2 = exp2f(-(float)(head + 1)) * 1.4426950409f;
#pragma unroll 1
        for (int qi2 = 0; qi2 < 2 * DSA_REP_C; ++qi2) { const int qi = qi2 & 1;
            const int qq = 2 * wv + qi, t = t0 + qq;
            const LAS unsigned short* sel = selw + qq * 256;
            LAS unsigned char* stg = ldsl + (2 * wv) * DSA_SROW;
            const bf16* qrow = Pb + (size_t)t * NP + C_QB + head * 128 + 8 * g;
            bf16x8 bq[4];
#pragma unroll
            for (int ks = 0; ks < 4; ++ks) bq[ks] = *(const bf16x8*)(qrow + 32 * ks);
            const float refL2 = MB * 1.4426950409f - slopeL2 * (float)(qi == 0 ? mind0 : mind1);
            f32x4 o[8];
#pragma unroll
            for (int dt = 0; dt < 8; ++dt) o[dt] = (f32x4){0.f, 0.f, 0.f, 0.f};
            float lsum = 0.f;
#define DSA_GATHER(S, KA) do { _Pragma("unroll") for (int i_ = 0; i_ < 8; ++i_) { const int jr = 32 * (S) + 4 * i_ + g; const int keyr = sel[jr < nvalid ? jr : 0];   \
        KA[i_] = *(const bf16x8*)(KVb + (size_t)keyr * 128 + 8 * l15); } } while (0)
#define DSA_COMPUTE(S, KA) do { unsigned pb[4];                                                                                                        \
        _Pragma("unroll") for (int i_ = 0; i_ < 8; ++i_) *(LAS bf16x8*)(stg + (4 * i_ + g) * DSA_KVROW + 16 * l15) = KA[i_];                              \
        LDS_WAIT(); asm volatile("" ::: "memory");                                                                                                        \
        _Pragma("unroll") for (int tl = 0; tl < 2; ++tl) { const int j0 = 32 * (S) + 16 * tl;                                                           \
            f32x4 a = {0.f, 0.f, 0.f, 0.f};                                                                                                             \
            _Pragma("unroll") for (int ks = 0; ks < 4; ++ks) { const bf16x8 ka_ = *(const LAS bf16x8*)(stg + (16 * tl + l15) * DSA_KVROW + (32 * ks + 8 * g) * 2); \
                a = __builtin_amdgcn_mfma_f32_16x16x32_bf16(ka_, bq[ks], a, 0, 0, 0); }                                                                 \
            const u32x2 kw = *(const LAS u32x2*)(sel + j0 + 4 * g);                                                                                     \
            const int kx[4] = {(int)(kw.x & 0xffffu), (int)(kw.x >> 16), (int)(kw.y & 0xffffu), (int)(kw.y >> 16)};                                     \
            float pr[4];                                                                                                                                \
            _Pragma("unroll") for (int r = 0; r < 4; ++r) { const int dd = t > kx[r] ? t - kx[r] : kx[r] - t;                                            \
                const float e = __builtin_amdgcn_exp2f(fmaf(a[r], 0.1275174f, -slopeL2 * (float)dd - refL2));                                            \
                pr[r] = (j0 + 4 * g + r < nvalid) ? e : 0.f; lsum += pr[r]; }                                                                           \
            pb[2 * tl] = cvtpk_bf16(pr[0], pr[1]); pb[2 * tl + 1] = cvtpk_bf16(pr[2], pr[3]); }                                                         \
        LDS_WAIT(); asm volatile("" ::: "memory");                                                                                                      \
        u32x4 pw4; pw4.x = pb[0]; pw4.y = pb[1]; pw4.z = pb[2]; pw4.w = pb[3];                                                                          \
        const bf16x8 pfrag = __builtin_bit_cast(bf16x8, pw4);                                                                                           \
        const LAS unsigned char* trb = stg + (4 * g + (l15 >> 2)) * DSA_KVROW + (4 * (lane & 3)) * 2;                                                   \
        _Pragma("unroll") for (int dt = 0; dt < 8; ++dt) {                                                                                              \
            const s16x4 lo = __builtin_bit_cast(s16x4, __builtin_amdgcn_ds_read_tr16_b64_v4i16((LAS v4i16_t*)(trb + dt * 32)));                         \
            const s16x4 hi = __builtin_bit_cast(s16x4, __builtin_amdgcn_ds_read_tr16_b64_v4i16((LAS v4i16_t*)(trb + 16 * DSA_KVROW + dt * 32)));        \
            const bf16x8 af = {lo[0], lo[1], lo[2], lo[3], hi[0], hi[1], hi[2], hi[3]};                                                                 \
            o[dt] = __builtin_amdgcn_mfma_f32_16x16x32_bf16(af, pfrag, o[dt], 0, 0, 0); }                                                               \
        LDS_WAIT(); asm volatile("" ::: "memory"); } while (0)
            const int nch = (nvalid + 31) >> 5;
            bf16x8 KA[8], KB[8];
            DSA_GATHER(0, KA);
#pragma unroll 1
            for (int s = 0; s < nch; s += 2) {
                if (s + 1 < nch) DSA_GATHER(s + 1, KB);
                DSA_COMPUTE(s, KA);
                if (s + 1 < nch) { if (s + 2 < nch) DSA_GATHER(s + 2, KA); DSA_COMPUTE(s + 1, KB); }
            }
#undef DSA_GATHER
#undef DSA_COMPUTE
            lsum += __shfl_xor(lsum, 16); lsum += __shfl_xor(lsum, 32);
            const float il = 1.f / lsum;
            if (l15 < 8) {
                bf16* orow = MIX + (size_t)(b * SEQ + t) * MIXW + 512 + head * 128 + 4 * g;
#pragma unroll
                for (int dt = 0; dt < 8; ++dt) { u32x2 w; w.x = pk2(o[dt][0] * il, o[dt][1] * il); w.y = pk2(o[dt][2] * il, o[dt][3] * il); *(u32x2*)(orow + 16 * dt) = w; }
            }
        }
        __syncthreads();
    }
}
typedef __attribute__((address_space(1))) float GASF;
#ifndef ATT_PROBE
#define ATT_PROBE 0
#endif
#ifndef ATT_REMAP
#define ATT_REMAP 1
#endif
__device__ __forceinline__ int crow(int r, int hi) { return (r & 3) + 8 * (r >> 2) + 4 * hi; }
#define KSWZ64(row, cb) ((row) * 128 + ((cb) ^ ((((row) >> 1) & 7) << 4)))
__device__ __forceinline__ int v_st(int k, int c) { const int kk = (k & ~0xC) | ((k & 4) << 1) | ((k & 8) >> 1); return ((kk >> 3) * 4 + (c >> 5)) * 512 + ((kk & 7) * 32 + (c & 31)) * 2; }
__device__ __forceinline__ int v_rd_base(int lane) { return ((lane & 3) << 3) | (((lane >> 2) & 3) << 6) | (((lane >> 4) & 1) << 5) | (((lane >> 5) & 1) << 8); }
constexpr int v_rd_off(int d0, int ks, int half) { return d0 * 512 + ks * 4096 + half * 2048; }
template <int OFF> __device__ __forceinline__ s16x4 tr_read(int vb) {
    s16x4 r; asm volatile("ds_read_b64_tr_b16 %0, %1 offset:%2" : "=&v"(r) : "v"(vb), "i"(OFF) : "memory"); return r;
}
template <int D0> __device__ __forceinline__ void pv_one(f32x16& od, int vb, bf16x8 pa0, bf16x8 pa1, bf16x8 pa2, bf16x8 pa3) {
    const s16x4 l0 = tr_read<v_rd_off(D0, 0, 0)>(vb), h0 = tr_read<v_rd_off(D0, 0, 1)>(vb), l1 = tr_read<v_rd_off(D0, 1, 0)>(vb), h1 = tr_read<v_rd_off(D0, 1, 1)>(vb);
    const s16x4 l2 = tr_read<v_rd_off(D0, 2, 0)>(vb), h2 = tr_read<v_rd_off(D0, 2, 1)>(vb), l3 = tr_read<v_rd_off(D0, 3, 0)>(vb), h3 = tr_read<v_rd_off(D0, 3, 1)>(vb);
    asm volatile("s_waitcnt lgkmcnt(0)" ::: "memory"); __builtin_amdgcn_sched_barrier(0);
#define PK(L, H) (bf16x8){L[0], L[1], L[2], L[3], H[0], H[1], H[2], H[3]}
    od = __builtin_amdgcn_mfma_f32_32x32x16_bf16(pa0, PK(l0, h0), od, 0, 0, 0);
    od = __builtin_amdgcn_mfma_f32_32x32x16_bf16(pa1, PK(l1, h1), od, 0, 0, 0);
    od = __builtin_amdgcn_mfma_f32_32x32x16_bf16(pa2, PK(l2, h2), od, 0, 0, 0);
    od = __builtin_amdgcn_mfma_f32_32x32x16_bf16(pa3, PK(l3, h3), od, 0, 0, 0);
#undef PK
}

__device__ __forceinline__ void att_tile(f32x16 (&o)[4], float& lsum, const unsigned char* Kb, int vb0, const unsigned char* Qw, int r32, int hi, int tq, int j, bool past, float slopeL2, float refL2) {
    constexpr float C = 0.125f * 1.4426950409f;
    bf16x8 qr[4];
#pragma unroll
    for (int d0 = 0; d0 < 4; ++d0) qr[d0] = *(const bf16x8*)(Qw + KSWZ64(r32, (d0 * 16 + hi * 8) * 2));
    const float dq = (float)(tq - 64 * j - 4 * hi);
    const float B0 = -slopeL2 * dq - refL2;
    float ps = 0.f;
    bf16x8 pa0, pa1, pa2, pa3;
#define PK4(P, BASE, OUT) do { unsigned a0 = cvtpk_bf16(P[BASE + 0], P[BASE + 1]), a1 = cvtpk_bf16(P[BASE + 2], P[BASE + 3]);   \
    unsigned b0_ = cvtpk_bf16(P[BASE + 4], P[BASE + 5]), b1_ = cvtpk_bf16(P[BASE + 6], P[BASE + 7]);                              \
    auto r0 = __builtin_amdgcn_permlane32_swap(a0, b0_, false, false); auto r1 = __builtin_amdgcn_permlane32_swap(a1, b1_, false, false); \
    u32x4 w = {r0[0], r1[0], r0[1], r1[1]}; OUT = __builtin_bit_cast(bf16x8, w); } while (0)
#define HALF_TILE(KOFF, FOFF, PA, PB) do { f32x16 pp = f32x16{};                                                                     \
    _Pragma("unroll") for (int d0 = 0; d0 < 4; ++d0) { const int cb = (d0 * 16 + hi * 8) * 2;                                        \
        const bf16x8 bk = *(const bf16x8*)(Kb + KSWZ64((KOFF) + r32, cb)); pp = __builtin_amdgcn_mfma_f32_32x32x16_bf16(bk, qr[d0], pp, 0, 0, 0); } \
    if (past) { _Pragma("unroll") for (int r = 0; r < 16; ++r) { const float off = (float)((r & 3) + 8 * (r >> 2)) + (FOFF);          \
            pp[r] = __builtin_amdgcn_exp2f(fmaf(pp[r], C, fmaf(slopeL2, off, B0))); } }                                               \
    else { _Pragma("unroll") for (int r = 0; r < 16; ++r) { const float off = (float)((r & 3) + 8 * (r >> 2)) + (FOFF);               \
            pp[r] = __builtin_amdgcn_exp2f(fmaf(pp[r], C, -slopeL2 * fabsf(dq - off) - refL2)); } }                                   \
    _Pragma("unroll") for (int r = 0; r < 16; ++r) ps += pp[r];                                                                       \
    PK4(pp, 0, PA); PK4(pp, 8, PB); __builtin_amdgcn_sched_barrier(0); } while (0)
    HALF_TILE(0, 0.f, pa0, pa1);
    HALF_TILE(32, 32.f, pa2, pa3);
#undef HALF_TILE
#undef PK4
    { auto rr = __builtin_amdgcn_permlane32_swap(__float_as_uint(ps), __float_as_uint(ps), false, false);
      ps = __uint_as_float(rr[0]) + __uint_as_float(rr[1]); }
    lsum += ps;
    pv_one<0>(o[0], vb0, pa0, pa1, pa2, pa3); pv_one<1>(o[1], vb0, pa0, pa1, pa2, pa3); pv_one<2>(o[2], vb0, pa0, pa1, pa2, pa3); pv_one<3>(o[3], vb0, pa0, pa1, pa2, pa3);
}
constexpr int ATT_LDS = 2 * 16384 + 2 * 8192 + 8 * 256 + 8 * 4096;

__device__ __forceinline__ void ph_attnA(const Params& p, unsigned char* lds, int vb, int nvb) {
    const bf16* PROJ = (const bf16*)(p.ws + WS_PROJ); bf16* MIX = (bf16*)(p.ws + WS_MIX);
    const float* SC = (const float*)(p.ws + WS_SCAL);
    const float lam = SC[SC_LAM], refL2 = SC[SC_MA] * 1.4426950409f;
    constexpr float C = 0.125f * 1.4426950409f;
    int tid = threadIdx.x; asm volatile("" : "+v"(tid)); const int lane = tid & 63, wid = __builtin_amdgcn_readfirstlane(tid >> 6), r32 = lane & 31, hi = lane >> 5;
    unsigned char* V_lds = lds; unsigned char* K_lds = lds + 32768;
    float* wsf = (float*)(lds + 49152) + wid * 64;
    GASF* tmpw = (GASF*)(p.ws + WS_ATMP) + ((size_t)(vb * NWV + wid) * 64) * 64 + lane;
    const int vbase = (int)(uintptr_t)V_lds + v_rd_base(lane);
    const int krow = tid >> 3, kch = tid & 7, kdst = KSWZ64(krow, kch * 16);
    const int sr = tid >> 4, sc = (tid & 15) * 8, vst0 = v_st(sr, sc), vst1 = v_st(32 + sr, sc);
    for (int it = vb; it < 256; it += nvb) {
        #if ATT_REMAP
        const int xg_ = it & 7, m_ = it >> 3, pidx = xg_ * 8 + (m_ >> 2), qbl = m_ & 3, b = pidx >> 2, h = pidx & 3;
#else
        const int b = it >> 4, h = (it >> 2) & 3, qbl = it & 3;
#endif
        const float slopeL2 = exp2f(-2.0f * (float)(h + 1)) * 1.4426950409f;
        const bf16* Pb = PROJ + (size_t)b * SEQ * NP;
#pragma unroll 1
        for (int half = 0; half < 2; ++half) {
            const int qb = half ? 7 - qbl : qbl, q0 = 256 * qb, NTu = 4 * (qb + 1), cw = 4 * qb + (wid >> 1);
            const int tq = q0 + 32 * wid + r32;
#pragma unroll 1
            for (int mi = 0; mi < 2; ++mi) {
                const int m = 1 - mi;
                const bf16* Kg = Pb + C_KA + h * 128 + m * 64 + (size_t)krow * NP + kch * 8;
                const bf16* Vg = Pb + C_VA + h * 128 + (size_t)sr * NP + sc;
                unsigned char* Qw = lds + 51200 + wid * 4096;
                { const bf16* qp = Pb + (size_t)tq * NP + C_QA + h * 128 + m * 64 + hi * 8;
#pragma unroll
                  for (int d0 = 0; d0 < 4; ++d0) *(bf16x8*)(Qw + KSWZ64(r32, (d0 * 16 + hi * 8) * 2)) = *(const bf16x8*)(qp + d0 * 16); }
                f32x16 o[4];
#pragma unroll
                for (int d = 0; d < 4; ++d) o[d] = f32x16{};
                float lsum = 0.f;
                bf16x8 ak, av0, av1;
#define ATT_LOAD(K_, V0_, V1_, TJ) do { const size_t go_ = (size_t)(TJ) * 64 * NP; K_ = *(const bf16x8*)(Kg + go_); V0_ = *(const bf16x8*)(Vg + go_); V1_ = *(const bf16x8*)(Vg + go_ + (size_t)32 * NP); \
        if (ATT_PROBE == 2) { bf16x8 d0_ = *(const volatile bf16x8*)(Kg + go_); bf16x8 d1_ = *(const volatile bf16x8*)(Vg + go_); bf16x8 d2_ = *(const volatile bf16x8*)(Vg + go_ + (size_t)32 * NP); asm volatile("" :: "v"(d0_), "v"(d1_), "v"(d2_)); } } while (0)
#define ATT_WRITE(K_, V0_, V1_, NB) do { *(bf16x8*)(K_lds + (NB) * 8192 + kdst) = K_; *(bf16x8*)(V_lds + (NB) * 16384 + vst0) = V0_; *(bf16x8*)(V_lds + (NB) * 16384 + vst1) = V1_; } while (0)
                ATT_LOAD(ak, av0, av1, 0); ATT_WRITE(ak, av0, av1, 0);
                __syncthreads();
#pragma unroll 1
                for (int j = 0; j < NTu; ++j) {
                    const int buf = j & 1;
                    if (j + 1 < NTu) ATT_LOAD(ak, av0, av1, j + 1);
                    if (j <= cw) { att_tile(o, lsum, K_lds + buf * 8192, vbase + buf * 16384, Qw, r32, hi, tq, j, j < cw, slopeL2, refL2);
#if ATT_PROBE == 1
                        { f32x16 o2[4]; o2[0] = o[0]; o2[1] = o[1]; o2[2] = o[2]; o2[3] = o[3]; float l2 = 0.f; att_tile(o2, l2, K_lds + buf * 8192, vbase + buf * 16384, Qw, r32, hi, tq, j, j < cw, slopeL2, refL2);
                          asm volatile("" :: "v"(o2[0]), "v"(o2[1]), "v"(o2[2]), "v"(o2[3]), "v"(l2)); }
#endif
                    }
                    if (j + 1 < NTu) ATT_WRITE(ak, av0, av1, buf ^ 1);
                    __syncthreads();
                }
#undef ATT_LOAD
#undef ATT_WRITE
                if (hi == 0) wsf[r32] = lsum;
                LDS_WAIT(); asm volatile("" ::: "memory");
                float rli[16];
#pragma unroll
                for (int r = 0; r < 16; ++r) rli[r] = 1.f / wsf[crow(r, hi)];
                LDS_WAIT(); asm volatile("" ::: "memory");
                if (mi == 0) {
#pragma unroll
                    for (int d = 0; d < 4; ++d) { GASF* td = tmpw + d * 1024; asm volatile("" : "+v"(td));
#pragma unroll
                        for (int r = 0; r < 16; ++r) td[r * 64] = o[d][r] * rli[r]; }
                } else {
                    float gsub[4];
#pragma unroll
                    for (int d = 0; d < 4; ++d) gsub[d] = p.a_sub_gain[32 * d + r32];
                    GASF* tdp[4];
#pragma unroll
                    for (int d = 0; d < 4; ++d) { tdp[d] = tmpw + d * 1024; asm volatile("" : "+v"(tdp[d])); }
#pragma unroll
                    for (int r = 0; r < 16; ++r) {
                        float v[4]; float ss = 0.f;
#pragma unroll
                        for (int d = 0; d < 4; ++d) { v[d] = o[d][r] * rli[r] - lam * tdp[d][r * 64]; ss += v[d] * v[d]; }
                        ss += __shfl_xor(ss, 1); ss += __shfl_xor(ss, 2); ss += __shfl_xor(ss, 4); ss += __shfl_xor(ss, 8); ss += __shfl_xor(ss, 16);
                        const float rs = rsqrtf(ss * (1.f / 128.f) + EPS) * 0.8f;
                        bf16* orow = MIX + (size_t)(b * SEQ + q0 + 32 * wid + crow(r, hi)) * MIXW + h * 128 + r32;
#pragma unroll
                        for (int d = 0; d < 4; ++d) orow[32 * d] = (bf16)f2bf(v[d] * rs * gsub[d]);
                        asm volatile("" ::: "memory");
                    }
                }
            }
        }
    }
}
constexpr int RT_WAVE_BYTES = 12288;
constexpr int RT_LDS = 32768 + 8 * RT_WAVE_BYTES;

__device__ __forceinline__ int pl32_sum(int v) { auto rr = __builtin_amdgcn_permlane32_swap((unsigned)v, (unsigned)v, false, false); return (int)(rr[0] + rr[1]); }
__device__ __forceinline__ int pl32_other(int v) { auto rr = __builtin_amdgcn_permlane32_swap((unsigned)v, (unsigned)v, false, false); return (int)(rr[0] + rr[1]) - v; }
__device__ __forceinline__ float unsortkey(unsigned k) { return __uint_as_float((k & 0x80000000u) ? (k ^ 0x80000000u) : ~k); }

__device__ __forceinline__ unsigned wave_or(unsigned v) {
    v |= (unsigned)__builtin_amdgcn_update_dpp(0, (int)v, 0x128, 0xf, 0xf, false); v |= (unsigned)__builtin_amdgcn_update_dpp(0, (int)v, 0x124, 0xf, 0xf, false);
    v |= (unsigned)__builtin_amdgcn_update_dpp(0, (int)v, 0x122, 0xf, 0xf, false); v |= (unsigned)__builtin_amdgcn_update_dpp(0, (int)v, 0x121, 0xf, 0xf, false);
    return (unsigned)(__builtin_amdgcn_readlane((int)v, 0) | __builtin_amdgcn_readlane((int)v, 16) | __builtin_amdgcn_readlane((int)v, 32) | __builtin_amdgcn_readlane((int)v, 48));
}
template <int N> __device__ __forceinline__ unsigned bisect16(const unsigned (&key)[N]) {
    unsigned kmx, lo;
    { unsigned gm[8];
#pragma unroll
      for (int g = 0; g < 8; ++g) { gm[g] = key[g];
#pragma unroll
          for (int i = g + 8; i < N; i += 8) gm[g] = key[i] > gm[g] ? key[i] : gm[g]; }
      kmx = gm[0]; lo = gm[0];
#pragma unroll
      for (int g = 1; g < 8; ++g) { kmx = gm[g] > kmx ? gm[g] : kmx; lo = gm[g] < lo ? gm[g] : lo; }
      const unsigned okmx = (unsigned)pl32_other((int)kmx), olo = (unsigned)pl32_other((int)lo);
      kmx = okmx > kmx ? okmx : kmx; lo = olo < lo ? olo : lo; }
    const unsigned x = kmx - lo;
    int pb = x ? 31 - __clz(x) : -1;
    unsigned prefix = 0u; bool done = (x == 0u);
#pragma unroll 1
    while (!__all(done)) {
        const unsigned c_ = done ? prefix : (prefix | (1u << pb));
        unsigned cand = lo + c_; cand = cand < lo ? 0xffffffffu : cand;
        int cnt = 0;
#pragma unroll
        for (int i = 0; i + 3 < N; i += 4) cnt_ge4(cnt, key[i], key[i + 1], key[i + 2], key[i + 3], cand);
#pragma unroll
        for (int i = N & ~3; i < N; ++i) cnt += (key[i] >= cand) ? 1 : 0;
        const int tot = pl32_sum(cnt);
        if (!done && tot >= 16) { prefix = c_; done = (tot == 16); }
        --pb; done = done || (pb < 0);
    }
    prefix += lo;
    return prefix;
}

__device__ __forceinline__ void ph_route(const Params& p, unsigned char* lds, int vb, int nvb) {
    const bf16* Q3 = (const bf16*)(p.ws + WS_Q3); const bf16* SUBK = (const bf16*)(p.ws + WS_SUBK);
    int* EXPI = (int*)(p.ws + WS_EXP); float* GATE = (float*)(p.ws + WS_GATE);
    int tid = threadIdx.x; asm volatile("" : "+v"(tid));
    const int lane = tid & 63, wv = __builtin_amdgcn_readfirstlane(tid >> 6), r32 = lane & 31, hi = lane >> 5;
    for (int i = tid; i < 2048; i += NT) { const int row = i >> 3, ch = i & 7; ((u32x4*)lds)[row * 8 + (ch ^ ((row >> 1) & 7))] = ((const u32x4*)SUBK)[i]; }
    __syncthreads();
    unsigned char* wl = lds + 32768 + wv * RT_WAVE_BYTES;
    float* sv = (float*)wl; int* si = (int*)(wl + 4096); float* fv = (float*)(wl + 8192); int* fe = (int*)(wl + 10240);
    const int gw = vb * NWV + wv, ngw = nvb * NWV;
    for (int item = gw; item < (T / 32) * 8; item += ngw) {
        const int h = item & 7, tok0 = (item >> 3) * 32;
        const bf16* qrow = Q3 + (size_t)(tok0 + r32) * 1024 + h * 128 + hi * 8;
#pragma unroll 1
        for (int c = 0; c < 2; ++c) {
            f32x4 cv[8]; const int crow = (item * 2 + c) * 2;
            { const float* src_ = (crow < NEXP ? p.peer_u + (size_t)crow * 1024 : p.peer_v + (size_t)(crow - NEXP) * 1024) + lane * 4;
#pragma unroll
              for (int j = 0; j < 8; ++j) cv[j] = *(const f32x4*)(src_ + 256 * j); }
            bf16x8 bq[4];
#pragma unroll
            for (int d0 = 0; d0 < 4; ++d0) bq[d0] = *(const bf16x8*)(qrow + c * 64 + d0 * 16);
            unsigned key[64];
#pragma unroll
            for (int nt = 0; nt < 4; ++nt) {
                f32x16 acc = f32x16{};
                const int krow = c * 128 + nt * 32 + r32, ksw = (krow >> 1) & 7;
                const unsigned char* kp = lds + krow * 128;
#pragma unroll
                for (int d0 = 0; d0 < 4; ++d0) { const bf16x8 ak = *(const bf16x8*)(kp + (((2 * d0 + hi) ^ ksw) << 4)); acc = __builtin_amdgcn_mfma_f32_32x32x16_bf16(ak, bq[d0], acc, 0, 0, 0); }
#pragma unroll
                for (int r = 0; r < 16; ++r) key[nt * 16 + r] = sortkey(acc[r]);
            }
            const unsigned thr = bisect16<64>(key);
            int cnt = 0;
#pragma unroll
            for (int i = 0; i < 64; ++i) cnt += (key[i] >= thr) ? 1 : 0;
            const int other_ = pl32_other(cnt); int slot = hi ? other_ : 0;
            float* svp = sv + (r32 * 2 + c) * 16; int* sip = si + (r32 * 2 + c) * 16;
#pragma unroll
            for (int i = 0; i < 64; ++i) {
                if (key[i] >= thr && slot < 16) { svp[slot] = unsortkey(key[i]); sip[slot] = 32 * (i >> 4) + ((i & 3) + 8 * ((i & 15) >> 2)) + 4 * hi; ++slot; }
            }
            { const float csc = crow < NEXP ? 32.0f : 1.0f;
              unsigned char* dst_ = (unsigned char*)(p.ws + (crow < NEXP ? WS_U16 : WS_V16)) + (size_t)(crow < NEXP ? crow : crow - NEXP) * 1024 + lane * 4;
#pragma unroll
              for (int j = 0; j < 8; ++j) { int w_ = 0; w_ = __builtin_amdgcn_cvt_pk_fp8_f32(cv[j].x * csc, cv[j].y * csc, w_, false); w_ = __builtin_amdgcn_cvt_pk_fp8_f32(cv[j].z * csc, cv[j].w * csc, w_, true);
                  *(unsigned*)(dst_ + 256 * j) = (unsigned)w_; } }
        }
        LDS_WAIT(); asm volatile("" ::: "memory");
        {
            float* sv0 = sv + (r32 * 2) * 16; float* sv1 = sv0 + 16; int* si0 = si + (r32 * 2) * 16; int* si1 = si0 + 16;
            {
                float a[16], bl[16];
#pragma unroll
                for (int k = 0; k < 16; ++k) { a[k] = sv0[k]; bl[k] = sv1[k]; }
                int ia[8], ib[8], ra[8], rb[8]; float va[8], vb[8];
#pragma unroll
                for (int q = 0; q < 8; ++q) { const int e = 8 * hi + q; va[q] = sv0[e]; vb[q] = sv1[e]; ia[q] = si0[e]; ib[q] = si1[e]; int r0 = 0, r1 = 0;
#pragma unroll
                    for (int k = 0; k < 16; ++k) { r0 += (a[k] > va[q] || (a[k] == va[q] && k < e)) ? 1 : 0; r1 += (bl[k] > vb[q] || (bl[k] == vb[q] && k < e)) ? 1 : 0; }
                    ra[q] = r0; rb[q] = r1; }
                LDS_WAIT(); asm volatile("" ::: "memory");
                { auto rr = __builtin_amdgcn_permlane32_swap(0u, 0u, false, false); (void)rr; }
#pragma unroll
                for (int q = 0; q < 8; ++q) { sv0[ra[q]] = va[q]; si0[ra[q]] = ia[q]; sv1[rb[q]] = vb[q]; si1[rb[q]] = ib[q]; }
                LDS_WAIT(); asm volatile("" ::: "memory");
            }
            const float* X = hi ? sv1 : sv0; const float* Y = hi ? sv0 : sv1;
            float x[4], y[16];
#pragma unroll
            for (int k = 0; k < 4; ++k) x[k] = X[k];
#pragma unroll
            for (int k = 0; k < 16; ++k) y[k] = Y[k];
            unsigned key[27]; int pi[27], pj[27]; int np = 0;
#pragma unroll
            for (int i = 0; i < 3; ++i)
#pragma unroll
                for (int j = i + 1; j < 16; ++j) if ((i + 1) * (j + 1) <= 16) { key[np] = sortkey(x[i] + y[j]); pi[np] = i; pj[np] = j; ++np; }
#pragma unroll
            for (int i = 0; i < 4; ++i) { key[23 + i] = hi ? 0u : sortkey(x[i] + y[i]); pi[23 + i] = i; pj[23 + i] = i; }
            const unsigned thr = bisect16<27>(key);
            int cnt = 0;
#pragma unroll
            for (int i = 0; i < 27; ++i) cnt += (key[i] >= thr) ? 1 : 0;
            const int other_ = pl32_other(cnt); int slot = hi ? other_ : 0;
            const int* IX = hi ? si1 : si0; const int* IY = hi ? si0 : si1;
            float* fvp = fv + r32 * 16; int* fep = fe + r32 * 16;
#pragma unroll
            for (int i = 0; i < 27; ++i) {
                if (key[i] >= thr && slot < 16) { const int ex = IX[pi[i]], ey = IY[pj[i]]; fvp[slot] = unsortkey(key[i]); fep[slot] = hi ? (ey * 128 + ex) : (ex * 128 + ey); ++slot; }
            }
        }
        LDS_WAIT(); asm volatile("" ::: "memory");
        {
            const float* fvp = fv + r32 * 16;
            float v[16]; float mx = -3e38f;
#pragma unroll
            for (int k = 0; k < 16; ++k) { v[k] = fvp[k]; mx = fmaxf(mx, v[k]); }
            float l = 0.f;
#pragma unroll
            for (int k = 0; k < 16; ++k) { v[k] = __expf(v[k] - mx); l += v[k]; }
            const float il = 1.f / l;
            const size_t ob = (size_t)(tok0 + r32) * 128 + h * 16 + 8 * hi;
            const int* fep = fe + r32 * 16 + 8 * hi;
            f32x4 g0, g1; u32x4 e0, e1;
            if (hi == 0) { g0 = (f32x4){v[0] * il, v[1] * il, v[2] * il, v[3] * il}; g1 = (f32x4){v[4] * il, v[5] * il, v[6] * il, v[7] * il}; }
            else { g0 = (f32x4){v[8] * il, v[9] * il, v[10] * il, v[11] * il}; g1 = (f32x4){v[12] * il, v[13] * il, v[14] * il, v[15] * il}; }
            e0 = *(const u32x4*)fep; e1 = *(const u32x4*)(fep + 4);
            *(f32x4*)(GATE + ob) = g0; *(f32x4*)(GATE + ob + 4) = g1;
            *(u32x4*)(EXPI + ob) = e0; *(u32x4*)(EXPI + ob + 4) = e1;
        }
        LDS_WAIT(); asm volatile("" ::: "memory");
    }
    __syncthreads();
}
typedef float f32x2_t __attribute__((ext_vector_type(2)));
constexpr int P8_UNITS = T / 64;
constexpr int CW_P8_U = 4096, CW_P8_V = 4096 + 32 * 64;
constexpr float U8_SCALE = 32.0f;
__device__ __forceinline__ unsigned peer_xcc() { return (unsigned)__builtin_amdgcn_s_getreg((3 << 11) | 20) & 7u; }
#ifndef U8_HALVES
#define U8_HALVES 0
#endif
template <int LPR>
__device__ __forceinline__ void ph_peer_v8g(const Params& p, unsigned char* lds) {
    constexpr int RPI = 64 / LPR, NI = 128 / RPI, G = NI / 8, NS = 64 / LPR, SLB = 16 * LPR;
    const unsigned char* V8 = (const unsigned char*)(p.ws + WS_V16);
    const int* EXPI = (const int*)(p.ws + WS_EXP); const float* CBUF = (const float*)(p.ws + WS_CBUF); const float* MOD = (const float*)(p.ws + WS_MOD);
    const float* AB1 = (const float*)(p.ws + WS_ABUF1); const float* GATEP = (const float*)(p.ws + WS_GATE); (void)AB1; (void)GATEP;
    unsigned* ctl = (unsigned*)(p.ws + WS_CTL);
    int tid = threadIdx.x; asm volatile("" : "+v"(tid));
    const int lane = tid & 63, wv = __builtin_amdgcn_readfirstlane(tid >> 6), gR = lane / LPR, iC = lane % LPR;
    volatile LAS unsigned* slot = (volatile LAS unsigned*)(LAS unsigned char*)lds;
    const unsigned xcc = peer_xcc();
#pragma unroll 1
    for (int k = 0; k < NS; ++k) {
        const int sl = (int)((((xcc * NS) >> 3) + (unsigned)k) % (unsigned)NS);
        const unsigned char* vcol = V8 + SLB * sl + 16 * iC;
#pragma unroll 1
        for (;;) {
            if (tid == 0) *slot = __hip_atomic_fetch_add(ctl + CW_P8_V + 64 * sl, 1u, __ATOMIC_RELAXED, __HIP_MEMORY_SCOPE_AGENT);
            __syncthreads();
            const unsigned unit = *slot;
            __syncthreads();
            if (unit >= (unsigned)P8_UNITS) break;
            const int tbase = (int)unit * 64 + wv * 8;
            int ne0, ne1; float nc0, nc1;
#if U8_HALVES
#define VG_FETCH(T) do { const size_t tn_ = (size_t)(T); ne0 = EXPI[tn_ * 128 + lane]; ne1 = EXPI[tn_ * 128 + 64 + lane];                              \
        nc0 = gelu_erf(CBUF[tn_ * 128 + lane] + AB1[tn_ * 128 + lane]) * GATEP[tn_ * 128 + lane];                                              \
        nc1 = gelu_erf(CBUF[tn_ * 128 + 64 + lane] + AB1[tn_ * 128 + 64 + lane]) * GATEP[tn_ * 128 + 64 + lane]; } while (0)
#else
#define VG_FETCH(T) do { const size_t tn_ = (size_t)(T); ne0 = EXPI[tn_ * 128 + lane]; ne1 = EXPI[tn_ * 128 + 64 + lane]; nc0 = CBUF[tn_ * 128 + lane]; nc1 = CBUF[tn_ * 128 + 64 + lane]; } while (0)
#endif
#define VG_LISTS(LE, LC) do { LE[lane] = ne0; LE[64 + lane] = ne1; LC[lane] = nc0; LC[64 + lane] = nc1; } while (0)
#define VG_ROWS(R, LE, GI) do { _Pragma("unroll") for (int kk = 0; kk < 8; ++kk) R[kk] = *(const u32x4*)(vcol + (size_t)LE[RPI * (8 * (GI) + kk) + gR] * 1024); } while (0)
#define VG_GROUP(R, LC, GI) do { _Pragma("unroll") for (int kk = 0; kk < 8; ++kk) { const float cj = LC[RPI * (8 * (GI) + kk) + gR];                       \
            const unsigned w_[4] = {R[kk].x, R[kk].y, R[kk].z, R[kk].w};                                                                       \
            _Pragma("unroll") for (int c = 0; c < 4; ++c) { const f32x2_t lo = __builtin_amdgcn_cvt_pk_f32_fp8((int)w_[c], false), hi = __builtin_amdgcn_cvt_pk_f32_fp8((int)w_[c], true); \
                acc[4 * c] = fmaf(cj, lo.x, acc[4 * c]); acc[4 * c + 1] = fmaf(cj, lo.y, acc[4 * c + 1]); acc[4 * c + 2] = fmaf(cj, hi.x, acc[4 * c + 2]); acc[4 * c + 3] = fmaf(cj, hi.y, acc[4 * c + 3]); } } } while (0)
            u32x4 RA[8], RB[8];
            int* lecur = (int*)(lds + 1024 + wv * 2048); int* lenxt = lecur + 256;
            VG_FETCH(tbase); VG_LISTS(lecur, ((float*)(lecur + 128))); VG_FETCH(tbase + 1);
            LDS_WAIT(); asm volatile("" ::: "memory");
            VG_ROWS(RA, lecur, 0);
#pragma unroll 1
            for (int tt = 0; tt < 8; ++tt) {
                const int t = tbase + tt;
                float* lccur = (float*)(lecur + 128); float* lcnxt = (float*)(lenxt + 128);
                float acc[16];
#pragma unroll
                for (int q = 0; q < 16; ++q) acc[q] = 0.f;
                if (tt + 1 < 8) { VG_LISTS(lenxt, lcnxt); if (tt + 2 < 8) VG_FETCH(t + 2); }
#pragma unroll 1
                for (int gi = 0; gi < G; gi += 2) {
                    VG_ROWS(RB, lecur, gi + 1);
                    VG_GROUP(RA, lccur, gi);
                    if (gi + 2 < G) VG_ROWS(RA, lecur, gi + 2);
                    else if (tt + 1 < 8) { LDS_WAIT(); asm volatile("" ::: "memory"); VG_ROWS(RA, lenxt, 0); }
                    VG_GROUP(RB, lccur, gi + 1);
                }
#pragma unroll
                for (int q = 0; q < 16; ++q) { if (LPR <= 8) acc[q] += dpp_f<0x128>(acc[q]); if (LPR <= 16) acc[q] += __shfl_xor(acc[q], 16); if (LPR <= 32) acc[q] += __shfl_xor(acc[q], 32); }
                if (gR == 0) { const int col = SLB * sl + 16 * iC; const float* g2 = MOD + (size_t)(t >> 11) * 6144 + 5120 + col; float* orow = p.out + (size_t)t * 1024 + col;
#pragma unroll
                    for (int q = 0; q < 4; ++q) { const f32x4 xv = *(const f32x4*)(orow + 4 * q), hv = *(const f32x4*)(g2 + 4 * q);
                        f32x4 r; r.x = acc[4 * q]; r.y = acc[4 * q + 1]; r.z = acc[4 * q + 2]; r.w = acc[4 * q + 3]; *(f32x4*)(orow + 4 * q) = xv + hv * r; } }
                { int* tmp_ = lecur; lecur = lenxt; lenxt = tmp_; }
            }
#undef VG_FETCH
#undef VG_LISTS
#undef VG_ROWS
#undef VG_GROUP
            LDS_WAIT(); asm volatile("" ::: "memory");
        }
    }
}
#ifndef SORT_BITS
#define SORT_BITS 3
#endif
#ifndef PEER_SORT
#define PEER_SORT 1
#endif
__device__ __forceinline__ void ph_peer_u8p(const Params& p, unsigned char* lds_w, int gw, int ngw, int lane_) {
    int lane = lane_; asm volatile("" : "+v"(lane));
    const bf16* H = (const bf16*)(p.ws + WS_H); const unsigned char* U8 = (const unsigned char*)(p.ws + WS_U16); const unsigned char* V8 = (const unsigned char*)(p.ws + WS_V16);
    const int* EXPI = (const int*)(p.ws + WS_EXP); const float* GATE = (const float*)(p.ws + WS_GATE); const float* MOD = (const float*)(p.ws + WS_MOD);
    int* e_lds = (int*)lds_w; float* a_lds = (float*)(lds_w + 512); float* g_lds = (float*)(lds_w + 1024); (void)g_lds;
    const int g = lane >> 4, i = lane & 15;
#pragma unroll 1
    for (int t = gw; t < T; t += ngw) {
        int e0 = EXPI[(size_t)t * 128 + lane], e1 = EXPI[(size_t)t * 128 + 64 + lane];
        float g0 = GATE[(size_t)t * 128 + lane], g1 = GATE[(size_t)t * 128 + 64 + lane];
#if PEER_SORT
        {
            const int flip_ = ((t / ngw) & 1) ? ((1 << SORT_BITS) - 1) : 0;
            const int d0 = (e0 >> (14 - SORT_BITS)) ^ flip_, d1 = (e1 >> (14 - SORT_BITS)) ^ flip_; int pos0 = 0, pos1 = 0, run = 0;
#pragma unroll
            for (int d = 0; d < (1 << SORT_BITS); ++d) {
                const unsigned long long m0 = __ballot(d0 == d), m1 = __ballot(d1 == d);
                const int c0 = __popcll(m0), c1 = __popcll(m1);
                const int r0 = (int)__builtin_amdgcn_mbcnt_hi((unsigned)(m0 >> 32), __builtin_amdgcn_mbcnt_lo((unsigned)m0, 0u));
                const int r1 = (int)__builtin_amdgcn_mbcnt_hi((unsigned)(m1 >> 32), __builtin_amdgcn_mbcnt_lo((unsigned)m1, 0u));
                pos0 = (d0 == d) ? run + r0 : pos0; pos1 = (d1 == d) ? run + c0 + r1 : pos1; run += c0 + c1;
            }
            e_lds[pos0] = e0; e_lds[pos1] = e1; g_lds[pos0] = g0; g_lds[pos1] = g1;
            LDS_WAIT(); asm volatile("" ::: "memory");
            e0 = e_lds[lane]; e1 = e_lds[64 + lane]; g0 = g_lds[lane]; g1 = g_lds[64 + lane];
            int* EW = (int*)(p.ws + WS_EXP) + (size_t)t * 128; EW[lane] = e0; EW[64 + lane] = e1;
        }
#else
        e_lds[lane] = e0; e_lds[64 + lane] = e1;
#endif
        float xf[64];
        { const u32x4* xrow = (const u32x4*)(H + (size_t)t * 1024) + 2 * i;
#pragma unroll
          for (int q = 0; q < 4; ++q) { const u32x4 a = xrow[32 * q], b = xrow[32 * q + 1];
              xf[16 * q] = bflo(a.x); xf[16 * q + 1] = bfhi(a.x); xf[16 * q + 2] = bflo(a.y); xf[16 * q + 3] = bfhi(a.y); xf[16 * q + 4] = bflo(a.z); xf[16 * q + 5] = bfhi(a.z); xf[16 * q + 6] = bflo(a.w); xf[16 * q + 7] = bfhi(a.w);
              xf[16 * q + 8] = bflo(b.x); xf[16 * q + 9] = bfhi(b.x); xf[16 * q + 10] = bflo(b.y); xf[16 * q + 11] = bfhi(b.y); xf[16 * q + 12] = bflo(b.z); xf[16 * q + 13] = bfhi(b.z); xf[16 * q + 14] = bflo(b.w); xf[16 * q + 15] = bfhi(b.w); } }
        LDS_WAIT(); asm volatile("" ::: "memory");
#define P8T_ULOAD(R, S) do { const u32x4* r_ = (const u32x4*)(U8 + (size_t)e_lds[4 * (S) + g] * 1024) + i; _Pragma("unroll") for (int q = 0; q < 4; ++q) R[q] = r_[16 * q]; } while (0)
#define P8T_UDOT(R, S) do { float a0 = 0.f, a1 = 0.f, a2 = 0.f, a3 = 0.f;                                                                               \
        _Pragma("unroll") for (int q = 0; q < 4; ++q) { const unsigned w_[4] = {R[q].x, R[q].y, R[q].z, R[q].w};                                           \
            _Pragma("unroll") for (int c = 0; c < 4; ++c) { const f32x2_t lo = __builtin_amdgcn_cvt_pk_f32_fp8((int)w_[c], false), hi = __builtin_amdgcn_cvt_pk_f32_fp8((int)w_[c], true); \
                a0 = fmaf(lo.x, xf[16 * q + 4 * c], a0); a1 = fmaf(lo.y, xf[16 * q + 4 * c + 1], a1); a2 = fmaf(hi.x, xf[16 * q + 4 * c + 2], a2); a3 = fmaf(hi.y, xf[16 * q + 4 * c + 3], a3); } } \
        const float a_ = row16_sum((a0 + a1) + (a2 + a3)) * (1.0f / U8_SCALE); if (i == 0) a_lds[4 * (S) + g] = a_; } while (0)
        { u32x4 RA[4], RB[4], RC[4];
          P8T_ULOAD(RA, 0); P8T_ULOAD(RB, 1);
#pragma unroll 1
          for (int s = 0; s < 30; s += 3) {
              P8T_ULOAD(RC, s + 2); P8T_UDOT(RA, s);
              P8T_ULOAD(RA, s + 3); P8T_UDOT(RB, s + 1);
              P8T_ULOAD(RB, s + 4); P8T_UDOT(RC, s + 2);
          }
          P8T_UDOT(RA, 30); P8T_UDOT(RB, 31); }
#undef P8T_ULOAD
#undef P8T_UDOT
        LDS_WAIT(); asm volatile("" ::: "memory");
        const float c0 = gelu_erf(a_lds[lane]) * g0, c1 = gelu_erf(a_lds[64 + lane]) * g1;
        float* CB = (float*)(p.ws + WS_CBUF) + (size_t)t * 128; CB[lane] = c0; CB[64 + lane] = c1;
    }
}
__device__ __forceinline__ void ph_peer_u8h(const Params& p, unsigned char* lds) {
    const bf16* H = (const bf16*)(p.ws + WS_H); const unsigned char* U8 = (const unsigned char*)(p.ws + WS_U16);
    const int* EXPI = (const int*)(p.ws + WS_EXP);
    unsigned* ctl = (unsigned*)(p.ws + WS_CTL);
    int tid = threadIdx.x; asm volatile("" : "+v"(tid));
    const int lane = tid & 63, wv = __builtin_amdgcn_readfirstlane(tid >> 6), hw = lane >> 5, i5 = lane & 31;
    volatile LAS unsigned* slot = (volatile LAS unsigned*)(LAS unsigned char*)lds;
    float* a_lds = (float*)(lds + 1024 + wv * 2048 + 1024);
    const unsigned xcc = peer_xcc();
#pragma unroll 1
    for (int k = 0; k < 2; ++k) {
        const int sl = (int)(((xcc >> 2) + (unsigned)k) & 1u);
        float* AB = (float*)(p.ws + (sl ? WS_ABUF1 : WS_CBUF));
        const unsigned char* ucol = U8 + 512 * sl + 16 * i5;
#pragma unroll 1
        for (;;) {
            if (tid == 0) *slot = __hip_atomic_fetch_add(ctl + CW_P8_U + 64 * sl, 1u, __ATOMIC_RELAXED, __HIP_MEMORY_SCOPE_AGENT);
            __syncthreads();
            const unsigned unit = *slot;
            __syncthreads();
            if (unit >= (unsigned)P8_UNITS) break;
            const int tbase = (int)unit * 64 + wv * 8;
            int ne0, ne1; u32x4 nx0, nx1;
#define UH_FETCH(T) do { const size_t tn_ = (size_t)(T); ne0 = EXPI[tn_ * 128 + lane]; ne1 = EXPI[tn_ * 128 + 64 + lane];                          \
        const u32x4* xr_ = (const u32x4*)(H + tn_ * 1024 + 512 * sl) + 2 * i5; nx0 = xr_[0]; nx1 = xr_[1]; } while (0)
#define UH_LISTS(LE) do { LE[lane] = ne0; LE[64 + lane] = ne1; } while (0)
#define UH_ROWS(R, LE, GI) do { _Pragma("unroll") for (int kk = 0; kk < 8; ++kk) R[kk] = *(const u32x4*)(ucol + (size_t)LE[2 * (8 * (GI) + kk) + hw] * 1024); } while (0)
#define UH_GROUP(R, GI) do { _Pragma("unroll") for (int kk = 0; kk < 8; ++kk) { float a0 = 0.f, a1 = 0.f, a2 = 0.f, a3 = 0.f;                         \
            const unsigned w_[4] = {R[kk].x, R[kk].y, R[kk].z, R[kk].w};                                                                       \
            _Pragma("unroll") for (int c = 0; c < 4; ++c) { const f32x2_t lo = __builtin_amdgcn_cvt_pk_f32_fp8((int)w_[c], false), hi = __builtin_amdgcn_cvt_pk_f32_fp8((int)w_[c], true); \
                a0 = fmaf(lo.x, xf[4 * c], a0); a1 = fmaf(lo.y, xf[4 * c + 1], a1); a2 = fmaf(hi.x, xf[4 * c + 2], a2); a3 = fmaf(hi.y, xf[4 * c + 3], a3); }                        \
            float s_ = row16_sum((a0 + a1) + (a2 + a3)); s_ += __shfl_xor(s_, 16);                                                              \
            if (i5 == 0) a_lds[2 * (8 * (GI) + kk) + hw] = s_ * (1.0f / U8_SCALE); } } while (0)
            u32x4 RA[8], RB[8];
            int* lecur = (int*)(lds + 1024 + wv * 2048); int* lenxt = lecur + 128;
            UH_FETCH(tbase); UH_LISTS(lecur);
            float xf[16];
#define UH_XF() do { xf[0] = bflo(nx0.x); xf[1] = bfhi(nx0.x); xf[2] = bflo(nx0.y); xf[3] = bfhi(nx0.y); xf[4] = bflo(nx0.z); xf[5] = bfhi(nx0.z); xf[6] = bflo(nx0.w); xf[7] = bfhi(nx0.w); \
        xf[8] = bflo(nx1.x); xf[9] = bfhi(nx1.x); xf[10] = bflo(nx1.y); xf[11] = bfhi(nx1.y); xf[12] = bflo(nx1.z); xf[13] = bfhi(nx1.z); xf[14] = bflo(nx1.w); xf[15] = bfhi(nx1.w); } while (0)
            UH_XF();
            UH_FETCH(tbase + 1);
            LDS_WAIT(); asm volatile("" ::: "memory");
            UH_ROWS(RA, lecur, 0);
#pragma unroll 1
            for (int tt = 0; tt < 8; ++tt) {
                const int t = tbase + tt;
                float xn[16];
                if (tt + 1 < 8) { UH_LISTS(lenxt);
#pragma unroll
                    for (int q = 0; q < 16; ++q) xn[q] = 0.f;
                    xn[0] = bflo(nx0.x); xn[1] = bfhi(nx0.x); xn[2] = bflo(nx0.y); xn[3] = bfhi(nx0.y); xn[4] = bflo(nx0.z); xn[5] = bfhi(nx0.z); xn[6] = bflo(nx0.w); xn[7] = bfhi(nx0.w);
                    xn[8] = bflo(nx1.x); xn[9] = bfhi(nx1.x); xn[10] = bflo(nx1.y); xn[11] = bfhi(nx1.y); xn[12] = bflo(nx1.z); xn[13] = bfhi(nx1.z); xn[14] = bflo(nx1.w); xn[15] = bfhi(nx1.w);
                    if (tt + 2 < 8) UH_FETCH(t + 2); }
#pragma unroll 1
                for (int gi = 0; gi < 8; gi += 2) {
                    UH_ROWS(RB, lecur, gi + 1);
                    UH_GROUP(RA, gi);
                    if (gi + 2 < 8) UH_ROWS(RA, lecur, gi + 2);
                    else if (tt + 1 < 8) { LDS_WAIT(); asm volatile("" ::: "memory"); UH_ROWS(RA, lenxt, 0); }
                    UH_GROUP(RB, gi + 1);
                }
                LDS_WAIT(); asm volatile("" ::: "memory");
                { float* ab = AB + (size_t)t * 128; ab[lane] = a_lds[lane]; ab[64 + lane] = a_lds[64 + lane]; }
                LDS_WAIT(); asm volatile("" ::: "memory");
                if (tt + 1 < 8) {
#pragma unroll
                    for (int q = 0; q < 16; ++q) xf[q] = xn[q]; }
                { int* tmp_ = lecur; lecur = lenxt; lenxt = tmp_; }
            }
#undef UH_FETCH
#undef UH_LISTS
#undef UH_ROWS
#undef UH_GROUP
#undef UH_XF
        }
    }
}
#define XB_TMO      128
#define XB_XCNT(j)  (256  + 64 * (j))
#define XB_XSUB(j)  (1280 + 64 * (j))
#define XB_XGEN(j)  (2304 + 64 * (j))
#define XB_TOP      3328
#define XB_TOPGEN   3392
#define XCD_BAR_WORDS 3456
#define XB_SPIN_CAP (1u << 18)

__device__ __forceinline__ unsigned xb_ld(unsigned* p)              { return __hip_atomic_load(p, __ATOMIC_RELAXED, __HIP_MEMORY_SCOPE_AGENT); }
__device__ __forceinline__ unsigned xb_add(unsigned* p, unsigned v) { return __hip_atomic_fetch_add(p, v, __ATOMIC_RELAXED, __HIP_MEMORY_SCOPE_AGENT); }
__device__ __forceinline__ unsigned xb_xcc_id() { return (unsigned)__builtin_amdgcn_s_getreg((3 << 11) | 20) & 0xFu; }
#define XB_SPIN(cond, bar) do { unsigned _sp = 0; while (cond) { __builtin_amdgcn_s_sleep(1); \
    if ((++_sp & 255u) == 0u) { if (xb_ld(&(bar)[XB_TMO])) break; if (_sp > XB_SPIN_CAP) { atomicAdd(&(bar)[XB_TMO], 1u); break; } } } } while (0)

struct XcdBarrier {
    unsigned* bar; unsigned x;
    volatile LAS unsigned* st;
};

__device__ __forceinline__ XcdBarrier xcd_barrier_post(unsigned* bar, volatile LAS unsigned* st) {
    XcdBarrier b; b.bar = bar; b.x = xb_xcc_id(); b.st = st;
    if (threadIdx.x == 0) (void)xb_add(&bar[XB_XCNT(b.x)], 1u);
    return b;
}
__device__ __forceinline__ void xcd_barrier_complete(unsigned* bar, unsigned x, unsigned& nloc, unsigned& nx) {
    const unsigned G = gridDim.x * gridDim.y * gridDim.z;
    unsigned sum, cnt, mine, sp = 0u;
    for (;;) {
        sum = 0u; cnt = 0u; mine = 0u;
#pragma unroll
        for (unsigned j = 0; j < 16; ++j) { const unsigned c = xb_ld(&bar[XB_XCNT(j)]); sum += c; cnt += (c > 0u) ? 1u : 0u; mine = (j == x) ? c : mine; }
        if (sum == G) break;
        __builtin_amdgcn_s_sleep(1);
        if ((++sp & 255u) == 0u) { if (xb_ld(&bar[XB_TMO])) break; if (sp > XB_SPIN_CAP) { atomicAdd(&bar[XB_TMO], 1u); break; } }
    }
    nloc = mine > 0u ? mine : 1u; nx = cnt > 0u ? cnt : 1u;
}

__device__ __forceinline__ void xcd_barrier(const XcdBarrier& b) {
    asm volatile("s_waitcnt vmcnt(0)" ::: "memory");
    __syncthreads();
    if (threadIdx.x == 0) {
        unsigned* bar = b.bar;
        __builtin_amdgcn_s_waitcnt(0);
        unsigned nloc = b.st[0], nx = b.st[1];
        if (nloc == 0u) { xcd_barrier_complete(bar, b.x, nloc, nx); b.st[0] = nloc; b.st[1] = nx; }
        const unsigned old = xb_add(&bar[XB_XSUB(b.x)], 1u);
        const unsigned gen = old / nloc;
        if (old + 1u == (gen + 1u) * nloc) {
            __builtin_amdgcn_fence(__ATOMIC_RELEASE, "agent");
            asm volatile("s_waitcnt vmcnt(0)" ::: "memory");
            const unsigned og = xb_add(&bar[XB_TOP], 1u);
            const unsigned tg = og / nx;
            if (og + 1u == (tg + 1u) * nx) xb_add(&bar[XB_TOPGEN], 1u);
            else XB_SPIN(xb_ld(&bar[XB_TOPGEN]) == tg, bar);
            __builtin_amdgcn_fence(__ATOMIC_ACQUIRE, "agent");
            xb_add(&bar[XB_XGEN(b.x)], 1u);
            asm volatile("s_waitcnt vmcnt(0)" ::: "memory");
        } else {
            XB_SPIN(xb_ld(&bar[XB_XGEN(b.x)]) == gen, bar);
            __builtin_amdgcn_fence(__ATOMIC_ACQUIRE, "agent");
            asm volatile("s_waitcnt vmcnt(0)" ::: "memory");
        }
    }
    __syncthreads();
}

#ifndef V8_LPR
#define V8_LPR 32
#endif
constexpr int LDS_BYTES = 147456;
extern __shared__ __attribute__((aligned(16))) unsigned char dyn_lds[];

__global__ void __launch_bounds__(NT, 2) mega_fwd(Params p) {
    cg::grid_group grid = cg::this_grid();
    const int vb = blockIdx.x, nvb = gridDim.x, ngw = nvb * NWV;
    volatile LAS unsigned* xst = (volatile LAS unsigned*)((LAS unsigned char*)dyn_lds + (LDS_BYTES - 16));
    if (threadIdx.x < 4) xst[threadIdx.x] = 0u;
    __syncthreads();
    const XcdBarrier xbar = xcd_barrier_post((unsigned*)(p.ws + WS_CTL), xst);
#define TID_LAUNDER int tid_ = threadIdx.x; asm volatile("" : "+v"(tid_)); const int lane = tid_ & 63, wv = tid_ >> 6, gw = vb * NWV + wv; (void)lane; (void)gw;
    grid.sync();
    ph_mod(p, (float*)dyn_lds, vb, nvb);
    { TID_LAUNDER ph_prep_weights(p, (LAS float*)dyn_lds + wv * (64 * 33), gw, ngw, lane); }
    xcd_barrier(xbar);
    { TID_LAUNDER ph_hrows(p, p.x, p.norm1_g, 0, 1024, gw, ngw, lane); }
    xcd_barrier(xbar);
    {   pg8::Gemm g{(const bf16*)(p.ws + WS_H), (const bf16*)(p.ws + WS_WIN), T, NP, 1024}; pg8::StaticOrder S; S.init(T, NP, nvb, vb);
        EpiNormBf16 E{(bf16*)(p.ws + WS_PROJ), p.a_qk_gain, p.b_q_gain, p.b_kv_gain, (LAS float*)((LAS unsigned char*)dyn_lds + 131072), (bf16*)(p.ws + WS_KVC)};
        pg8::gemm_phase<EpiNormBf16, pg8::StaticOrder, true, true>((LAS unsigned char*)dyn_lds, g, S, E); }
    xcd_barrier(xbar);
    ph_attnA(p, dyn_lds, vb, nvb);
    __syncthreads();
    ph_dsa(p, dyn_lds, vb, nvb);
    xcd_barrier(xbar);
    {   pg8::Gemm g{(const bf16*)(p.ws + WS_MIX), (const bf16*)(p.ws + WS_WO2), T, 1024, MIXW}; pg8::StaticOrder S; S.init(T, 1024, nvb, vb);
        EpiResGate E{p.x, p.out, (const float*)(p.ws + WS_MOD) + 2048};
        pg8::gemm_phase<EpiResGate, pg8::StaticOrder, true, true>((LAS unsigned char*)dyn_lds, g, S, E); }
    xcd_barrier(xbar);
    { TID_LAUNDER ph_hrows(p, p.out, p.norm2_g, 3072, 4096, gw, ngw, lane); }
    xcd_barrier(xbar);
    {   pg8::Gemm g{(const bf16*)(p.ws + WS_H), (const bf16*)(p.ws + WS_WQ), T, 1024, 1024}; pg8::StaticOrder S; S.init(T, 1024, nvb, vb);
        pg8::EpiBf16<0> E{(bf16*)(p.ws + WS_Q3), 1024, nullptr, 0, 0, 1.f};
        pg8::gemm_phase<pg8::EpiBf16<0>, pg8::StaticOrder, true, true>((LAS unsigned char*)dyn_lds, g, S, E); }
    xcd_barrier(xbar);
    ph_route(p, dyn_lds, vb, nvb);
    xcd_barrier(xbar);

#if U8_HALVES
    ph_peer_u8h(p, dyn_lds);
#else
    { TID_LAUNDER ph_peer_u8p(p, dyn_lds + wv * 2048, gw, ngw, lane); }
#endif
    xcd_barrier(xbar);
    ph_peer_v8g<V8_LPR>(p, dyn_lds);

}

extern "C" void kernel_launch(void* const* d_in, const int* in_sizes, int n_in, void* d_out, int out_size, void* d_ws, size_t ws_size, hipStream_t stream) {
    static int grid_blocks = 0;
    if (grid_blocks == 0) {
        if (n_in != 18 || in_sizes[0] != T * DM || out_size != T * DM || ws_size < WS_END) { fprintf(stderr, "kernel_launch: unexpected shapes n_in %d in0 %d out %d ws %zu\n", n_in, n_in > 0 ? in_sizes[0] : -1, out_size, ws_size); grid_blocks = -1; return; }
        int dev = 0, cus = 0, per_cu = 0;
        (void)hipGetDevice(&dev);
        (void)hipDeviceGetAttribute(&cus, hipDeviceAttributeMultiprocessorCount, dev);
        (void)hipFuncSetAttribute((const void*)mega_fwd, hipFuncAttributeMaxDynamicSharedMemorySize, LDS_BYTES);
        (void)hipOccupancyMaxActiveBlocksPerMultiprocessor(&per_cu, (const void*)mega_fwd, NT, LDS_BYTES);
        if (per_cu < 1 || cus < 1) { fprintf(stderr, "kernel_launch: occupancy query gave %d blocks/CU on %d CUs\n", per_cu, cus); grid_blocks = -1; return; }
        grid_blocks = cus;
    }
    if (grid_blocks < 0) return;
    Params p{};
    const float** pp = (const float**)&p;
    for (int i = 0; i < 18; ++i) pp[i] = (const float*)d_in[i];
    p.out = (float*)d_out; p.ws = (unsigned char*)d_ws;
    if (hipMemsetAsync((char*)d_ws + WS_CTL, 0, CTL_BYTES, stream) != hipSuccess) { fprintf(stderr, "kernel_launch: memset failed\n"); return; }
    void* args[] = {&p};
    const hipError_t e = hipLaunchCooperativeKernel((const void*)mega_fwd, dim3(grid_blocks), dim3(NT), args, LDS_BYTES, stream);
    if (e != hipSuccess) fprintf(stderr, "kernel_launch: cooperative launch failed: %s (grid %d)\n", hipGetErrorString(e), grid_blocks);
}
```

```cpp
#include <hip/hip_runtime.h>
#include <hip/hip_cooperative_groups.h>
#include <cstdio>
#include <cstdint>
#include <cmath>
namespace pg8 {
#define PG8_LAS __attribute__((address_space(3)))
typedef unsigned short bf16_t;
typedef short bf16x8 __attribute__((ext_vector_type(8)));
typedef float f32x4 __attribute__((ext_vector_type(4)));
typedef unsigned u32x4 __attribute__((ext_vector_type(4)));
constexpr int BM = 256, BK = 64, HALF = 128, HTB = HALF * BK * 2  , STAGE_BYTES = 8 * HTB, NXCD = 8, WGM = 8;

__host__ __device__ __forceinline__ int lds_byte(int r, int c) { const int st = (r >> 4) * 2 + (c >> 5), rr = r & 15, cc = c & 31, ob = rr * 64 + cc * 2; return st * 1024 + (ob ^ (((ob >> 9) & 1) << 5)); }
__host__ __device__ __forceinline__ void stage_rc(int b, int& R, int& C) { const int st = b / 1024, sb = b % 1024, swz = sb ^ (((sb >> 9) & 1) << 5); R = (st >> 1) * 16 + swz / 64; C = (st & 1) * 32 + (swz % 64) / 2; }
__host__ __device__ __forceinline__ int perm32(int rho) { const int n = rho >> 4, i = rho & 15; return 8 * (i >> 2) + 4 * n + (i & 3); }

struct Unit { int pm, pn; };
struct Gemm { const bf16_t* A; const bf16_t* Bt; int M, N, K; };

struct StaticOrder {
    int nM, nN, nwg, G, c;
    __host__ __device__ void init(int M, int N, int G_, int c_) { nM = M / BM; nN = N / BM; nwg = nM * nN; G = G_; c = c_; }
    __host__ __device__ bool next(int i, Unit& u) const {
        const long L = (long)i * G + c; if (L >= nwg) return false;
        int wgid = (int)L; { const int q = nwg / NXCD, r = nwg % NXCD, xcd = wgid % NXCD, off = wgid / NXCD; wgid = (xcd < r ? xcd * (q + 1) : r * (q + 1) + (xcd - r) * q) + off; }
        const int nig = WGM * nN, gid = wgid / nig, fm = gid * WGM, gsz = (nM - fm) < WGM ? (nM - fm) : WGM;
        u.pm = fm + ((wgid % nig) % gsz); u.pn = (wgid % nig) / gsz; return true;
    }
    __device__ __forceinline__ void a_ready(const Unit&) const {}
    __device__ __forceinline__ void done(const Unit&) const {}
};

__device__ __forceinline__ unsigned cvt_pk_bf16(float lo, float hi) { unsigned r; asm volatile("v_cvt_pk_bf16_f32 %0, %1, %2" : "=v"(r) : "v"(lo), "v"(hi)); return r; }
typedef float f32x2 __attribute__((ext_vector_type(2)));
__device__ __forceinline__ f32x2 gelu_pk(f32x2 v) {
    const f32x2 av = __builtin_elementwise_abs(v), d = av * 0.2316418882f + 1.0f;
    f32x2 t; t.x = __builtin_amdgcn_rcpf(d.x); t.y = __builtin_amdgcn_rcpf(d.y);
    f32x2 q = t * 0.5307027145f + (-0.7265760135f); q = q * t + 0.7107068705f; q = q * t + (-0.142248368f); q = q * t + 0.127414796f; q = q * t;
    const f32x2 s = (v * v) * (-0.72134752044f);
    f32x2 e; e.x = __builtin_amdgcn_exp2f(s.x); e.y = __builtin_amdgcn_exp2f(s.y);
    const f32x2 m = v * (q * e), r = v - m;
    f32x2 o; o.x = v.x < 0.f ? m.x : r.x; o.y = v.y < 0.f ? m.y : r.y; return o;
}

template <int ACT  > struct EpiBf16 {
    static constexpr bool PERM = true, AFTER_DRAIN = false; static_assert(ACT == 0 || ACT == 1, "EpiBf16: ACT is 0 (none) or 1 (gelu_pk)");
    bf16_t* O; int ldc; const float* bias; int split_cols; size_t split_stride; float scale0;
    __device__ __forceinline__ void operator()(const f32x4 (&acc)[2][2][4][2], const Unit& u, int wr, int wc, int fr, int fq) const {
        const int row0 = u.pm * BM + wr * 64 + fr; int colt = u.pn * BM; bf16_t* base = O;
        float sc = 1.f; if (split_cols) { const int t = colt / split_cols; base += (size_t)t * split_stride; colt -= t * split_cols; if (t == 0) sc = scale0; }
        const int col0 = colt + wc * 32 + 8 * fq, bcol0 = u.pn * BM + wc * 32 + 8 * fq;
        f32x4 bv[2][2];
#pragma unroll
        for (int bj = 0; bj < 2; ++bj)
#pragma unroll
            for (int n = 0; n < 2; ++n) bv[bj][n] = bias ? *(const f32x4*)(bias + bcol0 + bj * HALF + 4 * n) : (f32x4){0.f, 0.f, 0.f, 0.f};
#pragma unroll
        for (int ai = 0; ai < 2; ++ai)
#pragma unroll
            for (int m = 0; m < 4; ++m) { bf16_t* rowp = base + (size_t)(row0 + ai * HALF + m * 16) * ldc + col0;
#pragma unroll
                for (int bj = 0; bj < 2; ++bj) { f32x4 v0 = acc[ai][bj][m][0] + bv[bj][0], v1 = acc[ai][bj][m][1] + bv[bj][1];
                    if (ACT == 1) { f32x2 a = gelu_pk((f32x2){v0[0], v0[1]}), b = gelu_pk((f32x2){v0[2], v0[3]}), c = gelu_pk((f32x2){v1[0], v1[1]}), d = gelu_pk((f32x2){v1[2], v1[3]});
                        v0 = (f32x4){a.x, a.y, b.x, b.y}; v1 = (f32x4){c.x, c.y, d.x, d.y}; }
                    v0 = v0 * sc; v1 = v1 * sc; u32x4 w; w.x = cvt_pk_bf16(v0[0], v0[1]); w.y = cvt_pk_bf16(v0[2], v0[3]); w.z = cvt_pk_bf16(v1[0], v1[1]); w.w = cvt_pk_bf16(v1[2], v1[3]);
                    *(u32x4*)(rowp + bj * HALF) = w; } }
    }
};

template <class Epi, class Sched, bool ALIGN_EPI = false, bool SP2 = false>
__device__ __forceinline__ void gemm_phase(PG8_LAS unsigned char* lds, const Gemm g, const Sched& S, const Epi& E) {
    int tid = threadIdx.x; asm volatile("" : "+v"(tid)); const int wid = __builtin_amdgcn_readfirstlane(tid >> 6), lane = tid & 63, wr = wid >> 2, wc = wid & 3, fr = lane & 15, fq = lane >> 4;
    const int K = g.K, nt = K / BK;
    unsigned voffA[2], voffB[2];
#pragma unroll
    for (int i = 0; i < 2; ++i) { int R, C; stage_rc(tid * 16 + i * 8192, R, C); const int Rb = Epi::PERM ? ((R & ~31) + perm32(R & 31)) : R;
        voffA[i] = (unsigned)(R * K + C) * 2u; voffB[i] = (unsigned)(Rb * K + C) * 2u; }
    const size_t kstep = (size_t)(BK * 2);
    const size_t hstep = (size_t)HALF * K * 2;
    const size_t tstep = 2 * hstep;
    const unsigned ldsw = (unsigned)wid * 1024u;
    const int aoff = lds_byte(wr * 64 + fr, fq * 8), boff = lds_byte(wc * 32 + fr, fq * 8);
#define PG8_SA(b, h) (((b) * 2 + (h)) * HTB)
#define PG8_SB(b, h) ((4 + (b) * 2 + (h)) * HTB)
#define PG8_STAGE(bufoff, gbase, voff) do { _Pragma("unroll") for (int _i = 0; _i < 2; ++_i) \
        __builtin_amdgcn_global_load_lds((const unsigned*)((const char*)(gbase) + (voff)[_i]), (PG8_LAS unsigned*)(lds + (bufoff) + ldsw + _i * 8192), 16, 0, 0); } while (0)
#define PG8_LDA(dst, b, h) do { _Pragma("unroll") for (int m = 0; m < 4; ++m) _Pragma("unroll") for (int k = 0; k < 2; ++k) dst[m][k] = *(const PG8_LAS bf16x8*)(lds + PG8_SA(b, h) + aoff + m * 2048 + k * 1024); } while (0)
#define PG8_LDB(dst, b, h) do { _Pragma("unroll") for (int n = 0; n < 2; ++n) _Pragma("unroll") for (int k = 0; k < 2; ++k) dst[n][k] = *(const PG8_LAS bf16x8*)(lds + PG8_SB(b, h) + boff + n * 2048 + k * 1024); } while (0)
#define PG8_MMA(ai, bj, At, Bt) do { __builtin_amdgcn_s_setprio(1); _Pragma("unroll") for (int m = 0; m < 4; ++m) _Pragma("unroll") for (int n = 0; n < 2; ++n) _Pragma("unroll") for (int k = 0; k < 2; ++k) \
        acc[ai][bj][m][n] = __builtin_amdgcn_mfma_f32_16x16x32_bf16(Bt[n][k], At[m][k], acc[ai][bj][m][n], 0, 0, 0); __builtin_amdgcn_s_setprio(0); } while (0)
#define PG8_WAIT_V(n) asm volatile("s_waitcnt vmcnt(" #n ")" ::: "memory")
#define PG8_WAIT_L(n) asm volatile("s_waitcnt lgkmcnt(" #n ")" ::: "memory")
#define PG8_BAR __builtin_amdgcn_s_barrier()
#define PG8_SCHED __builtin_amdgcn_sched_barrier(0)
    Unit cur, nxt; int ui = 0;
    if (!S.next(0, cur)) return;
    f32x4 acc[2][2][4][2];
#pragma unroll
    for (int a = 0; a < 2; ++a)
#pragma unroll
        for (int b = 0; b < 2; ++b)
#pragma unroll
            for (int m = 0; m < 4; ++m)
#pragma unroll
                for (int n = 0; n < 2; ++n) acc[a][b][m][n] = (f32x4){0.f, 0.f, 0.f, 0.f};
    bf16x8 At[4][2], B0[2][2], B1[2][2];
    const char* cA = (const char*)g.A + (size_t)cur.pm * tstep; const char* cB = (const char*)g.Bt + (size_t)cur.pn * tstep;
    S.a_ready(cur);
    if constexpr (SP2) {
        PG8_STAGE(PG8_SB(0, 0), cB, voffB); PG8_STAGE(PG8_SB(0, 1), cB + hstep, voffB); PG8_STAGE(PG8_SA(0, 0), cA, voffA); PG8_STAGE(PG8_SA(0, 1), cA + hstep, voffA);
        if (wr == 1) PG8_BAR;
        PG8_WAIT_V(2); PG8_BAR;
        PG8_STAGE(PG8_SB(1, 0), cB + kstep, voffB); PG8_STAGE(PG8_SA(1, 0), cA + kstep, voffA); PG8_STAGE(PG8_SB(1, 1), cB + hstep + kstep, voffB);
        PG8_WAIT_V(6); PG8_BAR;
    } else {
        PG8_STAGE(PG8_SB(0, 0), cB, voffB); PG8_STAGE(PG8_SA(0, 0), cA, voffA); PG8_STAGE(PG8_SB(0, 1), cB + hstep, voffB); PG8_STAGE(PG8_SA(0, 1), cA + hstep, voffA);
        if (wr == 1) PG8_BAR;
        PG8_WAIT_V(4); PG8_BAR;
        PG8_STAGE(PG8_SB(1, 0), cB + kstep, voffB); PG8_STAGE(PG8_SA(1, 0), cA + kstep, voffA); PG8_STAGE(PG8_SB(1, 1), cB + hstep + kstep, voffB);
        PG8_WAIT_V(6); PG8_BAR;
    }
    for (;;) {
        const bool has_next = S.next(ui + 1, nxt);
        const char* nA = has_next ? (const char*)g.A + (size_t)nxt.pm * tstep : cA; const char* nB = has_next ? (const char*)g.Bt + (size_t)nxt.pn * tstep : cB;
        for (int t = 0; t < nt; t += 2) {
            const bool last = (t == nt - 2);
            const char* a1 = cA + (size_t)(t + 1) * kstep;
            const char* a2 = last ? nA : cA + (size_t)(t + 2) * kstep; const char* b2 = last ? nB : cB + (size_t)(t + 2) * kstep;
            const char* a3 = a2 + kstep; const char* b3 = b2 + kstep;
            if (last && has_next) S.a_ready(nxt);
            if constexpr (SP2) {
            PG8_LDB(B0, 0, 0); PG8_LDB(B1, 0, 1); PG8_SCHED; PG8_LDA(At, 0, 0); PG8_STAGE(PG8_SA(1, 1), a1 + hstep, voffA);
            PG8_WAIT_V(8); PG8_WAIT_L(0); PG8_BAR; PG8_MMA(0, 0, At, B0); PG8_MMA(0, 1, At, B1); PG8_BAR; PG8_SCHED;
            PG8_LDA(At, 0, 1); PG8_STAGE(PG8_SB(0, 0), b2, voffB); PG8_STAGE(PG8_SB(0, 1), b2 + hstep, voffB); PG8_STAGE(PG8_SA(0, 0), a2, voffA);
            PG8_WAIT_V(8); PG8_WAIT_L(0); PG8_BAR; PG8_MMA(1, 0, At, B0); PG8_MMA(1, 1, At, B1); PG8_BAR; PG8_SCHED;
            PG8_LDB(B0, 1, 0); PG8_LDB(B1, 1, 1); PG8_SCHED; PG8_LDA(At, 1, 0); PG8_STAGE(PG8_SA(0, 1), a2 + hstep, voffA);
            PG8_WAIT_V(8); PG8_WAIT_L(0); PG8_BAR; PG8_MMA(0, 0, At, B0); PG8_MMA(0, 1, At, B1); PG8_BAR; PG8_SCHED;
            PG8_LDA(At, 1, 1); PG8_STAGE(PG8_SB(1, 0), b3, voffB); PG8_STAGE(PG8_SB(1, 1), b3 + hstep, voffB); PG8_STAGE(PG8_SA(1, 0), a3, voffA);
            PG8_WAIT_V(8); PG8_WAIT_L(0); PG8_BAR; PG8_MMA(1, 0, At, B0); PG8_MMA(1, 1, At, B1); PG8_BAR; PG8_SCHED;
            } else {
            PG8_LDB(B0, 0, 0); PG8_SCHED; PG8_LDA(At, 0, 0); PG8_STAGE(PG8_SA(1, 1), a1 + hstep, voffA);
            PG8_WAIT_L(8); PG8_BAR; PG8_WAIT_L(0); PG8_MMA(0, 0, At, B0); PG8_BAR; PG8_SCHED;
            PG8_LDB(B1, 0, 1); PG8_STAGE(PG8_SB(0, 0), b2, voffB);
            PG8_BAR; PG8_WAIT_L(0); PG8_MMA(0, 1, At, B1); PG8_BAR;
            PG8_LDA(At, 0, 1); PG8_STAGE(PG8_SA(0, 0), a2, voffA);
            PG8_BAR; PG8_WAIT_L(0); PG8_MMA(1, 0, At, B0); PG8_BAR; PG8_SCHED;
            PG8_STAGE(PG8_SB(0, 1), b2 + hstep, voffB);
            PG8_WAIT_V(6); PG8_BAR; PG8_MMA(1, 1, At, B1); PG8_BAR;
            PG8_LDB(B0, 1, 0); PG8_SCHED; PG8_LDA(At, 1, 0); PG8_STAGE(PG8_SA(0, 1), a2 + hstep, voffA);
            PG8_WAIT_L(8); PG8_BAR; PG8_WAIT_L(0); PG8_MMA(0, 0, At, B0); PG8_BAR; PG8_SCHED;
            PG8_LDB(B1, 1, 1); PG8_STAGE(PG8_SB(1, 0), b3, voffB);
            PG8_BAR; PG8_WAIT_L(0); PG8_MMA(0, 1, At, B1); PG8_BAR;
            PG8_LDA(At, 1, 1); PG8_STAGE(PG8_SA(1, 0), a3, voffA);
            PG8_BAR; PG8_WAIT_L(0); PG8_MMA(1, 0, At, B0); PG8_BAR; PG8_SCHED;
            PG8_STAGE(PG8_SB(1, 1), b3 + hstep, voffB);
            PG8_WAIT_V(6); PG8_BAR; PG8_MMA(1, 1, At, B1); PG8_BAR;
            }
        }
        if constexpr (ALIGN_EPI) { if (wr == 0) PG8_BAR; }
        if constexpr (!Epi::AFTER_DRAIN) { E(acc, cur, wr, wc, fr, fq); S.done(cur); }
        if (!has_next) break;
#pragma unroll
        for (int a = 0; a < 2; ++a)
#pragma unroll
            for (int b = 0; b < 2; ++b)
#pragma unroll
                for (int m = 0; m < 4; ++m)
#pragma unroll
                    for (int n = 0; n < 2; ++n) acc[a][b][m][n] = (f32x4){0.f, 0.f, 0.f, 0.f};
        cur = nxt; cA = nA; cB = nB; ++ui;
        if constexpr (ALIGN_EPI) { if (wr == 1) PG8_BAR; }
    }
    PG8_WAIT_V(0);
    if constexpr (!ALIGN_EPI) { if (wr == 0) PG8_BAR; }
    PG8_BAR;
    if constexpr (Epi::AFTER_DRAIN) { E.fused(acc, cur, wr, wc, fr, fq, lds, wid, lane); S.done(cur); }
#undef PG8_SA
#undef PG8_SB
#undef PG8_STAGE
#undef PG8_LDA
#undef PG8_LDB
#undef PG8_MMA
#undef PG8_WAIT_V
#undef PG8_WAIT_L
#undef PG8_BAR
#undef PG8_SCHED
}
}
namespace cg = cooperative_groups;
#define LAS __attribute__((address_space(3)))
typedef unsigned short bf16;
typedef float f32x4 __attribute__((ext_vector_type(4)));
typedef float f32x8 __attribute__((ext_vector_type(8)));
typedef float f32x16 __attribute__((ext_vector_type(16)));
typedef unsigned u32x4 __attribute__((ext_vector_type(4)));
typedef unsigned u32x2 __attribute__((ext_vector_type(2)));
typedef short bf16x8 __attribute__((ext_vector_type(8)));
typedef short s16x4 __attribute__((ext_vector_type(4)));

constexpr int BATCH = 16, SEQ = 2048, DM = 1024, T = BATCH * SEQ;
constexpr int NP = 3072;
constexpr int IN_COLS = 3012;
constexpr int C_QA = 0, C_KA = 512, C_VA = 1024, C_QB = 1536, C_KV = 2560, C_QI = 2688, C_KI = 2944, C_WI = 3008;
constexpr int MIXW = 1536;
constexpr int NEXP = 16384;
constexpr float EPS = 1e-6f;
constexpr int NT = 512;
constexpr int NWV = 8;

constexpr size_t MiB = 1u << 20;
constexpr size_t WS_CTL = 0;
constexpr size_t CTL_BYTES = 64 * 1024;
constexpr size_t WS_MOD = 1 * MiB;
constexpr size_t WS_SCAL = WS_MOD + 512 * 1024;
constexpr size_t WS_QBIAS = WS_MOD + 400 * 1024;
constexpr size_t WS_WIN = 2 * MiB;
constexpr size_t WS_WO2 = 8 * MiB;
constexpr size_t WS_WQ = 11 * MiB;
constexpr size_t WS_SUBK = 13 * MiB;
constexpr size_t WS_U16 = 14 * MiB;
constexpr size_t WS_V16 = 46 * MiB;
constexpr size_t WS_H = 78 * MiB;
constexpr size_t WS_PROJ = 142 * MiB;
constexpr size_t WS_Q3 = WS_PROJ;
constexpr size_t WS_MIX = 334 * MiB;
constexpr size_t WS_EXP = 430 * MiB;
constexpr size_t WS_KVC = WS_EXP;
constexpr size_t WS_GATE = 446 * MiB;
constexpr size_t WS_ATMP = 462 * MiB;
constexpr size_t WS_CBUF = 494 * MiB;
constexpr size_t WS_SSQ = WS_ATMP;
constexpr size_t WS_ABUF1 = WS_MIX;
constexpr size_t WS_END = 510 * MiB;

struct Params {
    const float *x, *c, *ada_w, *ada_b, *norm1_g, *norm2_g, *w_in, *a_qk_gain, *a_lambda, *a_sub_gain, *b_q_gain, *b_kv_gain, *b_w_uv, *w_out, *peer_wq, *peer_subkeys, *peer_u, *peer_v;
    float* out; unsigned char* ws;
};

enum { SC_LAM = 0, SC_MA = 1, SC_MB = 2 };

__device__ __forceinline__ unsigned f2bf(float f) { unsigned u = __float_as_uint(f); return (u + 0x7fffu + ((u >> 16) & 1u)) >> 16; }
__device__ __forceinline__ float bf2f(unsigned h) { return __uint_as_float(h << 16); }
__device__ __forceinline__ unsigned pk2(float lo, float hi) { return f2bf(lo) | (f2bf(hi) << 16); }
__device__ __forceinline__ float bflo(unsigned w) { return __uint_as_float(w << 16); }
__device__ __forceinline__ float bfhi(unsigned w) { return __uint_as_float(w & 0xffff0000u); }
__device__ __forceinline__ float wave_sum(float v) {
#pragma unroll
    for (int o = 1; o < 64; o <<= 1) v += __shfl_xor(v, o);
    return v;
}
__device__ __forceinline__ float wave_max(float v) {
#pragma unroll
    for (int o = 1; o < 64; o <<= 1) v = fmaxf(v, __shfl_xor(v, o));
    return v;
}
#define LDS_WAIT() asm volatile("s_waitcnt lgkmcnt(0)" ::: "memory")
__device__ __forceinline__ void ph_mod(const Params& p, float* ldsf, int vb, int nvb) {
    if (vb >= 96) return;
    int tid = threadIdx.x; asm volatile("" : "+v"(tid));
    const int lane = tid & 63, wv = tid >> 6;
    for (int i = tid; i < 16 * 1024; i += NT) { const float v = p.c[i]; ldsf[i] = v / (1.f + __expf(-v)); }
    __syncthreads();
    float* MOD = (float*)(p.ws + WS_MOD); float* part = ldsf + 16 * 1024;
    for (int it = vb; it < 96; it += nvb) {
        const int j = it * 64 + lane;
        float acc[16];
#pragma unroll
        for (int b = 0; b < 16; ++b) acc[b] = 0.f;
        const float* wp = p.ada_w + (size_t)(128 * wv) * 6144 + j;
#pragma unroll 1
        for (int k0 = 0; k0 < 128; k0 += 8) {
            float w[8];
#pragma unroll
            for (int u = 0; u < 8; ++u) w[u] = wp[(size_t)(k0 + u) * 6144];
#pragma unroll
            for (int u = 0; u < 8; ++u)
#pragma unroll
                for (int b = 0; b < 16; ++b) acc[b] = fmaf(ldsf[b * 1024 + 128 * wv + k0 + u], w[u], acc[b]);
        }
#pragma unroll
        for (int b = 0; b < 16; ++b) part[(wv * 16 + b) * 64 + lane] = acc[b];
        __syncthreads();
        for (int o = tid; o < 16 * 64; o += NT) { const int b = o >> 6, c = o & 63; float s = 0.f;
#pragma unroll
            for (int w = 0; w < 8; ++w) s += part[(w * 16 + b) * 64 + c];
            MOD[b * 6144 + it * 64 + c] = s + p.ada_b[it * 64 + c]; }
        __syncthreads();
    }
}

__device__ __forceinline__ void transpose_item(const float* W, int N, bf16* WT, int ldt, LAS float* scr, int kb, int nb, int lane) {
    const int k0 = 64 * kb, n0 = 32 * nb;
#pragma unroll 8
    for (int i = 0; i < 32; ++i) { const int kk = 2 * i + (lane >> 5); const int n = n0 + (lane & 31); scr[kk * 33 + (lane & 31)] = (n < N) ? W[(size_t)(k0 + kk) * N + n] : 0.f; }
    LDS_WAIT(); asm volatile("" ::: "memory");
    const int c = lane & 7;
#pragma unroll
    for (int j = 0; j < 4; ++j) { const int n = (lane >> 3) + 8 * j; const LAS float* s = scr + (8 * c) * 33 + n;
        u32x4 o; o.x = pk2(s[0 * 33], s[1 * 33]); o.y = pk2(s[2 * 33], s[3 * 33]); o.z = pk2(s[4 * 33], s[5 * 33]); o.w = pk2(s[6 * 33], s[7 * 33]);
        *(u32x4*)(WT + (size_t)(n0 + n) * ldt + k0 + 8 * c) = o; }
    LDS_WAIT(); asm volatile("" ::: "memory");
}

__device__ __forceinline__ void ph_prep_weights(const Params& p, LAS float* scr, int gw, int ngw, int lane) {
    bf16* WIN = (bf16*)(p.ws + WS_WIN); bf16* WO2 = (bf16*)(p.ws + WS_WO2); bf16* WQ = (bf16*)(p.ws + WS_WQ);
    constexpr int I_IN = 16 * 96, I_O = 8 * 32, I_Q = 16 * 32;
    for (int it = gw; it < I_IN + I_O + I_Q; it += ngw) {
        int r = it;
        if (r < I_IN) { transpose_item(p.w_in, IN_COLS, WIN, 1024, scr, r / 96, r % 96, lane); continue; } r -= I_IN;
        if (r < I_O) { transpose_item(p.w_out, 1024, WO2, MIXW, scr, r / 32, r % 32, lane); continue; } r -= I_O;
        transpose_item(p.peer_wq, 1024, WQ, 1024, scr, r / 32, r % 32, lane);
    }
    const size_t gt = (size_t)gw * 64 + lane, ngt = (size_t)ngw * 64;
    for (size_t i = gt; i < (size_t)1024 * 1024; i += ngt) {
        const int n = (int)(i & 1023), kk = (int)(i >> 10), h = kk >> 7;
        const float* wu = p.b_w_uv + (size_t)kk * 64; const float* wo = p.w_out + (size_t)(512 + 64 * h) * 1024 + n;
        float a = 0.f;
#pragma unroll 8
        for (int e = 0; e < 64; ++e) a = fmaf(wu[e], wo[(size_t)e * 1024], a);
        WO2[(size_t)n * MIXW + 512 + kk] = (bf16)f2bf(a);
    }
    bf16* SUBK = (bf16*)(p.ws + WS_SUBK);
    constexpr size_t NSUB8 = 2 * 128 * 64 / 8;
    for (size_t j = gt; j < NSUB8; j += ngt) {
        const f32x8 v = *(const f32x8*)(p.peer_subkeys + j * 8);
        u32x4 o; o.x = pk2(v[0], v[1]); o.y = pk2(v[2], v[3]); o.z = pk2(v[4], v[5]); o.w = pk2(v[6], v[7]);
        *(u32x4*)(SUBK + j * 8) = o;
    }
    if (gt == 0) {
        float* SC = (float*)(p.ws + WS_SCAL);
        float s01 = 0.f, s23 = 0.f;
        for (int i = 0; i < 64; ++i) { s01 += p.a_lambda[i] * p.a_lambda[64 + i]; s23 += p.a_lambda[128 + i] * p.a_lambda[192 + i]; }
        SC[SC_LAM] = __expf(s01) - __expf(s23) + 0.2f;
        float g0 = 0.f, g1 = 0.f, gq = 0.f, gk = 0.f;
        for (int i = 0; i < 64; ++i) { g0 = fmaxf(g0, fabsf(p.a_qk_gain[i])); g1 = fmaxf(g1, fabsf(p.a_qk_gain[64 + i])); }
        for (int i = 0; i < 128; ++i) { gq = fmaxf(gq, fabsf(p.b_q_gain[i])); gk = fmaxf(gk, fabsf(p.b_kv_gain[i])); }
        SC[SC_MA] = 8.0f * g0 * g1 * 1.02f;
        SC[SC_MB] = 11.3137085f * gq * gk * 1.02f;
    }
}

__device__ __forceinline__ void ph_hrows(const Params& p, const float* X, const float* g, int shOff, int scOff, int gw, int ngw, int lane) {
    const float* MOD = (const float*)(p.ws + WS_MOD); bf16* H = (bf16*)(p.ws + WS_H);
    for (int m = gw; m < T; m += ngw) {
        const f32x4* xr = (const f32x4*)(X + (size_t)m * 1024) + lane;
        f32x4 v[4]; float s = 0.f;
#pragma unroll
        for (int j = 0; j < 4; ++j) { v[j] = xr[64 * j]; s += (v[j].x * v[j].x + v[j].y * v[j].y) + (v[j].z * v[j].z + v[j].w * v[j].w); }
        const float rstd = rsqrtf(wave_sum(s) * (1.f / 1024.f) + EPS);
        const float* mb = MOD + (size_t)(m >> 11) * 6144;
#pragma unroll
        for (int j = 0; j < 4; ++j) {
            const int col = 4 * (lane + 64 * j);
            const f32x4 gg = *(const f32x4*)(g + col), sc = *(const f32x4*)(mb + scOff + col), sh = *(const f32x4*)(mb + shOff + col);
            const f32x4 y = v[j] * rstd * gg * (sc + 1.0f) + sh;
            u32x2 o; o.x = pk2(y.x, y.y); o.y = pk2(y.z, y.w);
            *(u32x2*)(H + (size_t)m * 1024 + col) = o;
        }
    }
}

__device__ __forceinline__ void ph_norm_proj(const Params& p, int gw, int ngw, int lane) {
    bf16* PROJ = (bf16*)(p.ws + WS_PROJ);
    for (int m = gw; m < T; m += ngw) {
        bf16* row = PROJ + (size_t)m * NP;
#pragma unroll
        for (int j = 0; j < 6; ++j) {
            if (j == 2) continue;
            const int col = 8 * lane + 512 * j;
            const u32x4 raw = *(const u32x4*)(row + col);
            float v[8] = {bflo(raw.x), bfhi(raw.x), bflo(raw.y), bfhi(raw.y), bflo(raw.z), bfhi(raw.z), bflo(raw.w), bfhi(raw.w)};
            float ss = 0.f;
#pragma unroll
            for (int i = 0; i < 8; ++i) ss += v[i] * v[i];
            ss += __shfl_xor(ss, 1); ss += __shfl_xor(ss, 2); ss += __shfl_xor(ss, 4);
            float rstd; const float* gp;
            if (j < 2) { rstd = rsqrtf(ss * (1.f / 64.f) + EPS); gp = p.a_qk_gain + 64 * j + (col & 63); }
            else { ss += __shfl_xor(ss, 8); rstd = rsqrtf(ss * (1.f / 128.f) + EPS); gp = (j == 5 ? p.b_kv_gain : p.b_q_gain) + (col & 127); }
            if (j == 5 && lane >= 16) continue;
            const f32x4 g0 = *(const f32x4*)gp, g1 = *(const f32x4*)(gp + 4);
            u32x4 o; o.x = pk2(v[0] * rstd * g0.x, v[1] * rstd * g0.y); o.y = pk2(v[2] * rstd * g0.z, v[3] * rstd * g0.w);
            o.z = pk2(v[4] * rstd * g1.x, v[5] * rstd * g1.y); o.w = pk2(v[6] * rstd * g1.z, v[7] * rstd * g1.w);
            *(u32x4*)(row + col) = o;
        }
    }
}
struct EpiResGate {
    static constexpr bool PERM = false, AFTER_DRAIN = false;
    const float* X; float* Out; const float* gate;
    __device__ __forceinline__ void operator()(const pg8::f32x4 (&acc)[2][2][4][2], const pg8::Unit& u, int wr, int wc, int fr, int fq) const {
        const int col0 = u.pn * 256 + wc * 32 + 4 * fq;
#pragma unroll
        for (int ai = 0; ai < 2; ++ai)
#pragma unroll
            for (int m = 0; m < 4; ++m) {
                const int r = u.pm * 256 + ai * 128 + wr * 64 + m * 16 + fr; const float* gb = gate + (size_t)(r >> 11) * 6144;
#pragma unroll
                for (int bj = 0; bj < 2; ++bj)
#pragma unroll
                    for (int n = 0; n < 2; ++n) { const int c = col0 + bj * 128 + n * 16; const size_t off = (size_t)r * 1024 + c;
                        const pg8::f32x4 xv = *(const pg8::f32x4*)(X + off), gv = *(const pg8::f32x4*)(gb + c);
                        *(pg8::f32x4*)(Out + off) = xv + gv * acc[ai][bj][m][n]; }
            }
    }
};


struct EpiResGateA2 {
    static constexpr bool PERM = true, AFTER_DRAIN = false;
    const float* X; float* Out; const float* MODp; const float* g2; bf16* A2; float* SSQ;
    __device__ __forceinline__ void operator()(const pg8::f32x4 (&acc)[2][2][4][2], const pg8::Unit& u, int wr, int wc, int fr, int fq) const {
        const int row0 = u.pm * 256 + wr * 64 + fr, col0 = u.pn * 256 + wc * 32 + 8 * fq;
        const float* mb = MODp + (size_t)((u.pm * 256) >> 11) * 6144;
        pg8::f32x4 gt[2][2], gm[2][2];
#pragma unroll
        for (int bj = 0; bj < 2; ++bj)
#pragma unroll
            for (int n = 0; n < 2; ++n) { const int c = col0 + bj * 128 + 4 * n; gt[bj][n] = *(const pg8::f32x4*)(mb + 2048 + c);
                const pg8::f32x4 gg = *(const pg8::f32x4*)(g2 + c), sc = *(const pg8::f32x4*)(mb + 4096 + c); gm[bj][n] = gg * (sc + 1.0f); }
#pragma unroll
        for (int ai = 0; ai < 2; ++ai)
#pragma unroll
            for (int m = 0; m < 4; ++m) { const int r = row0 + ai * 128 + m * 16; float ss = 0.f;
#pragma unroll
                for (int bj = 0; bj < 2; ++bj) { const size_t off = (size_t)r * 1024 + col0 + bj * 128;
                    const pg8::f32x4 v0 = *(const pg8::f32x4*)(X + off) + gt[bj][0] * acc[ai][bj][m][0], v1 = *(const pg8::f32x4*)(X + off + 4) + gt[bj][1] * acc[ai][bj][m][1];
                    *(pg8::f32x4*)(Out + off) = v0; *(pg8::f32x4*)(Out + off + 4) = v1;
                    ss += ((v0[0] * v0[0] + v0[1] * v0[1]) + (v0[2] * v0[2] + v0[3] * v0[3])) + ((v1[0] * v1[0] + v1[1] * v1[1]) + (v1[2] * v1[2] + v1[3] * v1[3]));
                    const pg8::f32x4 a0 = v0 * gm[bj][0], a1 = v1 * gm[bj][1];
                    pg8::u32x4 w; w.x = pg8::cvt_pk_bf16(a0[0], a0[1]); w.y = pg8::cvt_pk_bf16(a0[2], a0[3]); w.z = pg8::cvt_pk_bf16(a1[0], a1[1]); w.w = pg8::cvt_pk_bf16(a1[2], a1[3]);
                    *(pg8::u32x4*)(A2 + off) = w; }
                ss += __shfl_xor(ss, 16); ss += __shfl_xor(ss, 32);
                if (fq == 0) SSQ[(size_t)r * 16 + u.pn * 4 + wc] = ss; }
    }
};

struct EpiQ3 {
    static constexpr bool PERM = true, AFTER_DRAIN = false;
    const float* SSQ; const float* BIAS; bf16* O;
    __device__ __forceinline__ void operator()(const pg8::f32x4 (&acc)[2][2][4][2], const pg8::Unit& u, int wr, int wc, int fr, int fq) const {
        const int row0 = u.pm * 256 + wr * 64 + fr, col0 = u.pn * 256 + wc * 32 + 8 * fq;
        const float* bb = BIAS + (size_t)((u.pm * 256) >> 11) * 1024 + col0;
        pg8::f32x4 bv[2][2];
#pragma unroll
        for (int bj = 0; bj < 2; ++bj)
#pragma unroll
            for (int n = 0; n < 2; ++n) bv[bj][n] = *(const pg8::f32x4*)(bb + bj * 128 + 4 * n);
#pragma unroll
        for (int ai = 0; ai < 2; ++ai)
#pragma unroll
            for (int m = 0; m < 4; ++m) { const int r = row0 + ai * 128 + m * 16; const pg8::f32x4 s4 = *((const pg8::f32x4*)(SSQ + (size_t)r * 16) + fq);
                float s_ = (s4[0] + s4[1]) + (s4[2] + s4[3]); s_ += __shfl_xor(s_, 16); s_ += __shfl_xor(s_, 32); const float rs = rsqrtf(s_ * (1.f / 1024.f) + EPS);
#pragma unroll
                for (int bj = 0; bj < 2; ++bj) { const pg8::f32x4 v0 = acc[ai][bj][m][0] * rs + bv[bj][0], v1 = acc[ai][bj][m][1] * rs + bv[bj][1];
                    pg8::u32x4 w; w.x = pg8::cvt_pk_bf16(v0[0], v0[1]); w.y = pg8::cvt_pk_bf16(v0[2], v0[3]); w.z = pg8::cvt_pk_bf16(v1[0], v1[1]); w.w = pg8::cvt_pk_bf16(v1[2], v1[3]);
                    *(pg8::u32x4*)(O + (size_t)r * 1024 + col0 + bj * 128) = w; } }
    }
};

__device__ __forceinline__ void ph_q3bias(const Params& p, int gw, int lane) {
    if (gw >= 64) return;
    const float* MOD = (const float*)(p.ws + WS_MOD); const bf16* WQ = (const bf16*)(p.ws + WS_WQ); float* BIAS = (float*)(p.ws + WS_QBIAS);
    const int l15 = lane & 15, g = lane >> 4, n0 = gw * 16;
    const float* ar = MOD + (size_t)l15 * 6144 + 3072 + 8 * g; const bf16* br = WQ + (size_t)(n0 + l15) * 1024 + 8 * g;
    f32x4 a = {0.f, 0.f, 0.f, 0.f};
#pragma unroll 4
    for (int ks = 0; ks < 32; ++ks) {
        const f32x4 s0 = *(const f32x4*)(ar + 32 * ks), s1 = *(const f32x4*)(ar + 32 * ks + 4);
        u32x4 aw; aw.x = pk2(s0[0], s0[1]); aw.y = pk2(s0[2], s0[3]); aw.z = pk2(s1[0], s1[1]); aw.w = pk2(s1[2], s1[3]);
        bf16x8 av; __builtin_memcpy(&av, &aw, 16);
        const bf16x8 bvv = *(const bf16x8*)(br + 32 * ks);
        a = __builtin_amdgcn_mfma_f32_16x16x32_bf16(av, bvv, a, 0, 0, 0);
    }
#pragma unroll
    for (int r = 0; r < 4; ++r) BIAS[(size_t)(4 * g + r) * 1024 + n0 + l15] = a[r];
}


struct EpiNormBf16 {
    static constexpr bool PERM = true, AFTER_DRAIN = false;
    bf16* O; const float* gqk; const float* gbq; const float* gbkv; LAS float* P; bf16* KVC;
    __device__ __forceinline__ void operator()(const pg8::f32x4 (&acc)[2][2][4][2], const pg8::Unit& u, int wr, int wc, int fr, int fq) const {
        const int pn = u.pn;
        const int mode = pn < 4 ? 1 : ((pn == 4 || pn == 5 || pn == 11) ? 0 : (pn == 10 ? 3 : 2));
        if (mode != 0) {
#pragma unroll
            for (int ai = 0; ai < 2; ++ai)
#pragma unroll
                for (int m = 0; m < 4; ++m)
#pragma unroll
                    for (int bj = 0; bj < 2; ++bj) {
                        const pg8::f32x4 a = acc[ai][bj][m][0], b = acc[ai][bj][m][1];
                        float ss = (a[0] * a[0] + a[1] * a[1]) + (a[2] * a[2] + a[3] * a[3]) + (b[0] * b[0] + b[1] * b[1]) + (b[2] * b[2] + b[3] * b[3]);
                        ss += __shfl_xor(ss, 16); ss += __shfl_xor(ss, 32);
                        if (fq == 0) P[(ai * 128 + wr * 64 + m * 16 + fr) * 8 + bj * 4 + wc] = ss;
                    }
            asm volatile("s_waitcnt lgkmcnt(0)" ::: "memory"); __builtin_amdgcn_s_barrier(); asm volatile("" ::: "memory");
        }
        const int row0 = u.pm * 256 + wr * 64 + fr, col0 = u.pn * 256 + wc * 32 + 8 * fq;
        pg8::f32x4 g0[2], g1[2];
#pragma unroll
        for (int bj = 0; bj < 2; ++bj) {
            const float* gp = nullptr;
            if (mode == 1) gp = gqk + (pn >= 2 ? 64 : 0) + 32 * (wc & 1) + 8 * fq;
            else if (mode == 2) gp = gbq + 32 * wc + 8 * fq;
            else if (mode == 3 && bj == 0) gp = gbkv + 32 * wc + 8 * fq;
            if (gp) { g0[bj] = *(const pg8::f32x4*)gp; g1[bj] = *(const pg8::f32x4*)(gp + 4); } else { g0[bj] = (pg8::f32x4){1.f, 1.f, 1.f, 1.f}; g1[bj] = g0[bj]; }
        }
#pragma unroll
        for (int ai = 0; ai < 2; ++ai)
#pragma unroll
            for (int m = 0; m < 4; ++m) { bf16* rowp = O + (size_t)(row0 + ai * 128 + m * 16) * NP + col0;
#pragma unroll
                for (int bj = 0; bj < 2; ++bj) {
                    float s = 1.f;
                    if (mode != 0 && !(mode == 3 && bj == 1)) {
                        const pg8::f32x4 q = *(const LAS pg8::f32x4*)(P + (ai * 128 + wr * 64 + m * 16 + fr) * 8 + bj * 4);
                        s = (mode == 1) ? rsqrtf(((wc < 2) ? (q[0] + q[1]) : (q[2] + q[3])) * (1.f / 64.f) + EPS) : rsqrtf(((q[0] + q[1]) + (q[2] + q[3])) * (1.f / 128.f) + EPS);
                    }
                    const pg8::f32x4 v0 = acc[ai][bj][m][0] * s * g0[bj], v1 = acc[ai][bj][m][1] * s * g1[bj];
                    pg8::u32x4 w; w.x = pg8::cvt_pk_bf16(v0[0], v0[1]); w.y = pg8::cvt_pk_bf16(v0[2], v0[3]); w.z = pg8::cvt_pk_bf16(v1[0], v1[1]); w.w = pg8::cvt_pk_bf16(v1[2], v1[3]);
                    if (pn == 10 && bj == 0) *(pg8::u32x4*)(KVC + (size_t)(row0 + ai * 128 + m * 16) * 128 + wc * 32 + 8 * fq) = w;
                    else *(pg8::u32x4*)(rowp + bj * 128) = w; } }
    }
};
typedef __bf16 bf16x2_t __attribute__((ext_vector_type(2)));
__device__ __forceinline__ float dot2bf(unsigned a, unsigned b, float acc) { return __builtin_amdgcn_fdot2_f32_bf16(__builtin_bit_cast(bf16x2_t, a), __builtin_bit_cast(bf16x2_t, b), acc, false); }
template <int CTRL> __device__ __forceinline__ float dpp_f(float v) { return __int_as_float(__builtin_amdgcn_update_dpp(0, __float_as_int(v), CTRL, 0xf, 0xf, false)); }
__device__ __forceinline__ float row16_sum(float v) {
    v += dpp_f<0x128>(v); v += dpp_f<0x124>(v); v += dpp_f<0x122>(v); v += dpp_f<0x121>(v); return v;
}
__device__ __forceinline__ float gelu_erf(float v) {
    const float av = fabsf(v), t = __builtin_amdgcn_rcpf(fmaf(av, 0.2316418882f, 1.0f));
    float q = fmaf(t, 0.5307027145f, -0.7265760135f); q = fmaf(q, t, 0.7107068705f); q = fmaf(q, t, -0.142248368f); q = fmaf(q, t, 0.127414796f); q = q * t;
    const float e = __builtin_amdgcn_exp2f(v * v * -0.72134752044f);
    const float m = v * (q * e);
    return v < 0.f ? m : v - m;
}

#ifndef DSA_PB
#define DSA_PB 0
#endif
typedef short v4i16_t __attribute__((ext_vector_type(4)));
#ifndef DSA_REP_A
#define DSA_REP_A 1
#endif
#ifndef DSA_REP_B
#define DSA_REP_B 1
#endif
#ifndef DSA_REP_C
#define DSA_REP_C 1
#endif
constexpr int DSA_SROW = 2048 * 4 + 16;
constexpr int DSA_SEL_OFF = 16 * DSA_SROW;
constexpr int DSA_LDS = DSA_SEL_OFF + 16 * 512;
constexpr int DSA_KVROW = 272;

__device__ __forceinline__ unsigned sortkey(float s) { const unsigned u = __float_as_uint(s); return u ^ ((u >> 31) ? 0xffffffffu : 0x80000000u); }
__device__ __forceinline__ unsigned cvtpk_bf16(float lo, float hi) { unsigned r; asm volatile("v_cvt_pk_bf16_f32 %0, %1, %2" : "=v"(r) : "v"(lo), "v"(hi)); return r; }

__device__ __forceinline__ void cnt_ge4(int& acc, unsigned k0, unsigned k1, unsigned k2, unsigned k3, unsigned cand) {
    asm volatile("v_cmp_ge_u32_e64 s[40:41], %1, %5\n\t"
                 "v_cmp_ge_u32_e64 s[42:43], %2, %5\n\t"
                 "v_cmp_ge_u32_e64 s[44:45], %3, %5\n\t"
                 "v_cmp_ge_u32_e64 s[46:47], %4, %5\n\t"
                 "v_addc_co_u32_e64 %0, s[48:49], %0, 0, s[40:41]\n\t"
                 "v_addc_co_u32_e64 %0, s[48:49], %0, 0, s[42:43]\n\t"
                 "v_addc_co_u32_e64 %0, s[48:49], %0, 0, s[44:45]\n\t"
                 "v_addc_co_u32_e64 %0, s[48:49], %0, 0, s[46:47]"
                 : "+v"(acc) : "v"(k0), "v"(k1), "v"(k2), "v"(k3), "v"(cand)
                 : "s40", "s41", "s42", "s43", "s44", "s45", "s46", "s47", "s48", "s49");
}
__device__ __forceinline__ void ph_dsa(const Params& p, unsigned char* lds, int vb, int nvb) {
    const bf16* PROJ = (const bf16*)(p.ws + WS_PROJ); bf16* MIX = (bf16*)(p.ws + WS_MIX);
    const float MB = ((const float*)(p.ws + WS_SCAL))[SC_MB];
    int tid = threadIdx.x; asm volatile("" : "+v"(tid)); const int lane = tid & 63, wv = __builtin_amdgcn_readfirstlane(tid >> 6);
    const int l15 = lane & 15, g = lane >> 4;
    LAS unsigned char* ldsl = (LAS unsigned char*)lds;
    for (int it = vb; it < 2048; it += nvb) {
        const int vbb = it & 255, kk = it >> 8, xg = vbb & 7, ix = vbb >> 3, b = 2 * xg + (ix & 1), G = (ix >> 1) & 3, sub = ix >> 3;
        const int c = (kk & 1) ? (31 - G - 8 * (kk >> 1)) : (G + 8 * (kk >> 1));
        const int cend = (c + 1) * 64, t0 = c * 64 + sub * 16;
        const bf16* Pb = PROJ + (size_t)b * SEQ * NP;
        const bf16* KVb = (const bf16*)(p.ws + WS_KVC) + (size_t)b * SEQ * 128;
#pragma unroll 1
        for (int repa = 0; repa < DSA_REP_A; ++repa)
        if (c >= 4) {
            const bf16* qrow = Pb + (size_t)(t0 + l15) * NP;
            bf16x8 bq[4][2]; float wsc[4];
#pragma unroll
            for (int h = 0; h < 4; ++h) { wsc[h] = bf2f(qrow[C_WI + h]) * 0.0625f;
#pragma unroll
                for (int ks = 0; ks < 2; ++ks) bq[h][ks] = *(const bf16x8*)(qrow + C_QI + h * 64 + 32 * ks + 8 * g); }
            for (int k0 = 16 * wv; k0 < cend; k0 += 128) {
                const bf16* krow = Pb + (size_t)(k0 + l15) * NP + C_KI + 8 * g;
                const bf16x8 ka0 = *(const bf16x8*)krow, ka1 = *(const bf16x8*)(krow + 32);
                f32x4 sc = {0.f, 0.f, 0.f, 0.f};
#pragma unroll
                for (int h = 0; h < 4; ++h) { f32x4 a = {0.f, 0.f, 0.f, 0.f};
                    a = __builtin_amdgcn_mfma_f32_16x16x32_bf16(ka0, bq[h][0], a, 0, 0, 0);
                    a = __builtin_amdgcn_mfma_f32_16x16x32_bf16(ka1, bq[h][1], a, 0, 0, 0);
#pragma unroll
                    for (int r = 0; r < 4; ++r) sc[r] = fmaf(fmaxf(a[r], 0.f), wsc[h], sc[r]); }
#pragma unroll
                for (int r = 0; r < 4; ++r) sc[r] = (sc[r] == 0.f) ? 0.f : sc[r];
                *(LAS f32x4*)(ldsl + l15 * DSA_SROW + (k0 + 4 * g) * 4) = sc;
            }
        }
        __syncthreads();
        LAS unsigned short* selw = (LAS unsigned short*)(ldsl + DSA_SEL_OFF);
        int mind0 = 0, mind1 = 0;
        if (c < 4) {
            for (int j = lane; j < 256; j += 64) { selw[(2 * wv) * 256 + j] = (unsigned short)j; selw[(2 * wv + 1) * 256 + j] = (unsigned short)j; }
        } else {
            const int nreg = cend >> 6;
            unsigned keyA[32], keyB[32];
            { const LAS float* srA = (const LAS float*)(ldsl + (2 * wv) * DSA_SROW) + lane; const LAS float* srB = (const LAS float*)(ldsl + (2 * wv + 1) * DSA_SROW) + lane;
#pragma unroll
              for (int i = 0; i < 32; ++i) { keyA[i] = (i < nreg) ? sortkey(srA[64 * i]) : 0u; keyB[i] = (i < nreg) ? sortkey(srB[64 * i]) : 0u; } }
#define DSA_WSUM(V, OUT) do { int v_ = (V); v_ += __builtin_amdgcn_update_dpp(0, v_, 0x128, 0xf, 0xf, false); v_ += __builtin_amdgcn_update_dpp(0, v_, 0x124, 0xf, 0xf, false); \
        v_ += __builtin_amdgcn_update_dpp(0, v_, 0x122, 0xf, 0xf, false); v_ += __builtin_amdgcn_update_dpp(0, v_, 0x121, 0xf, 0xf, false);                                     \
        OUT = __builtin_amdgcn_readlane(v_, 0) + __builtin_amdgcn_readlane(v_, 16) + __builtin_amdgcn_readlane(v_, 32) + __builtin_amdgcn_readlane(v_, 48); } while (0)
            unsigned prefA = 0u, prefB = 0u; bool exA = false, exB = false;
#pragma unroll 1
            for (int bit = 31; bit >= 0; --bit) {
                const unsigned candA = exA ? prefA : (prefA | (1u << bit)), candB = exB ? prefB : (prefB | (1u << bit));
                int ca = 0, cb = 0;
#pragma unroll
                for (int i = 0; i < 32; i += 4) { cnt_ge4(ca, keyA[i], keyA[i + 1], keyA[i + 2], keyA[i + 3], candA); cnt_ge4(cb, keyB[i], keyB[i + 1], keyB[i + 2], keyB[i + 3], candB); }
                int cntA, cntB; DSA_WSUM(ca, cntA); DSA_WSUM(cb, cntB);
                if (!exA && cntA >= 256) { prefA = candA; exA = (cntA == 256); }
                if (!exB && cntB >= 256) { prefB = candB; exB = (cntB == 256); }
                if (exA && exB) break;
            }
#define DSA_COMPACT(KEY, PREFIX, EXACT, QQ, MIND) do {                                                                                              \
            const int t_ = t0 + (QQ); LAS unsigned short* sel = selw + (QQ) * 256;                                                                    \
            int need_ties = 0;                                                                                                                        \
            if (!(EXACT)) { int cg_ = 0; if ((PREFIX) != 0xffffffffu) { _Pragma("unroll") for (int i = 0; i < 32; ++i) cg_ += (KEY[i] > (PREFIX)) ? 1 : 0; } \
                int cgt; DSA_WSUM(cg_, cgt); need_ties = 256 - cgt; }                                                                                 \
            int base = 0, tbase = 0, md = 4096;                                                                                                       \
            _Pragma("unroll") for (int i = 0; i < 32; ++i) { if (i < nreg) {                                                                          \
                bool selb;                                                                                                                            \
                if (EXACT) selb = KEY[i] >= (PREFIX);                                                                                                 \
                else { const bool tie = KEY[i] == (PREFIX); const unsigned long long mt = __ballot(tie);                                              \
                    const int trank = tbase + (int)__builtin_amdgcn_mbcnt_hi((unsigned)(mt >> 32), __builtin_amdgcn_mbcnt_lo((unsigned)mt, 0u));      \
                    selb = (KEY[i] > (PREFIX)) || (tie && trank < need_ties); tbase += __popcll(mt); }                                                \
                const unsigned long long m = __ballot(selb);                                                                                          \
                const int pos = base + (int)__builtin_amdgcn_mbcnt_hi((unsigned)(m >> 32), __builtin_amdgcn_mbcnt_lo((unsigned)m, 0u));               \
                const int kidx = i * 64 + lane;                                                                                                       \
                if (selb) { sel[pos] = (unsigned short)kidx; const int d = t_ > kidx ? t_ - kidx : kidx - t_; md = d < md ? d : md; }                 \
                base += __popcll(m); } }                                                                                                              \
            _Pragma("unroll") for (int o = 1; o < 64; o <<= 1) { const int x = __shfl_xor(md, o); md = x < md ? x : md; }                             \
            MIND = md; } while (0)
            DSA_COMPACT(keyA, prefA, exA, 2 * wv, mind0);
            DSA_COMPACT(keyB, prefB, exB, 2 * wv + 1, mind1);
#undef DSA_COMPACT
#undef DSA_WSUM
        }
        LDS_WAIT(); asm volatile("" ::: "memory");
        const int nvalid = cend < 256 ? cend : 256;
        const int head = lane & 7;
        const float slopeL2 = exp2f(-(float)(head + 1)) * 1.4426950409f;
#pragma unroll 1
        for (int qi2 = 0; qi2 < 2 * DSA_REP_C; ++qi2) { const int qi = qi2 & 1;
            const int qq = 2 * wv + qi, t = t0 + qq;
            const LAS unsigned short* sel = selw + qq * 256;
            LAS unsigned char* stg = ldsl + (2 * wv) * DSA_SROW;
            const bf16* qrow = Pb + (size_t)t * NP + C_QB + head * 128 + 8 * g;
            bf16x8 bq[4];
#pragma unroll
            for (int ks = 0; ks < 4; ++ks) bq[ks] = *(const bf16x8*)(qrow + 32 * ks);
            const float refL2 = MB * 1.4426950409f - slopeL2 * (float)(qi == 0 ? mind0 : mind1);
            f32x4 o[8];
#pragma unroll
            for (int dt = 0; dt < 8; ++dt) o[dt] = (f32x4){0.f, 0.f, 0.f, 0.f};
            float lsum = 0.f;
#define DSA_GATHER(S, KA) do { _Pragma("unroll") for (int i_ = 0; i_ < 8; ++i_) { const int jr = 32 * (S) + 4 * i_ + g; const int keyr = sel[jr < nvalid ? jr : 0];   \
        KA[i_] = *(const bf16x8*)(KVb + (size_t)keyr * 128 + 8 * l15); } } while (0)
#define DSA_COMPUTE(S, KA) do { unsigned pb[4];                                                                                                        \
        _Pragma("unroll") for (int i_ = 0; i_ < 8; ++i_) *(LAS bf16x8*)(stg + (4 * i_ + g) * DSA_KVROW + 16 * l15) = KA[i_];                              \
        LDS_WAIT(); asm volatile("" ::: "memory");                                                                                                        \
        _Pragma("unroll") for (int tl = 0; tl < 2; ++tl) { const int j0 = 32 * (S) + 16 * tl;                                                           \
            f32x4 a = {0.f, 0.f, 0.f, 0.f};                                                                                                             \
            _Pragma("unroll") for (int ks = 0; ks < 4; ++ks) { const bf16x8 ka_ = *(const LAS bf16x8*)(stg + (16 * tl + l15) * DSA_KVROW + (32 * ks + 8 * g) * 2); \
                a = __builtin_amdgcn_mfma_f32_16x16x32_bf16(ka_, bq[ks], a, 0, 0, 0); }                                                                 \
            const u32x2 kw = *(const LAS u32x2*)(sel + j0 + 4 * g);                                                                                     \
            const int kx[4] = {(int)(kw.x & 0xffffu), (int)(kw.x >> 16), (int)(kw.y & 0xffffu), (int)(kw.y >> 16)};                                     \
            float pr[4];                                                                                                                                \
            _Pragma("unroll") for (int r = 0; r < 4; ++r) { const int dd = t > kx[r] ? t - kx[r] : kx[r] - t;                                            \
                const float e = __builtin_amdgcn_exp2f(fmaf(a[r], 0.1275174f, -slopeL2 * (float)dd - refL2));                                            \
                pr[r] = (j0 + 4 * g + r < nvalid) ? e : 0.f; lsum += pr[r]; }                                                                           \
            pb[2 * tl] = cvtpk_bf16(pr[0], pr[1]); pb[2 * tl + 1] = cvtpk_bf16(pr[2], pr[3]); }                                                         \
        LDS_WAIT(); asm volatile("" ::: "memory");                                                                                                      \
        u32x4 pw4; pw4.x = pb[0]; pw4.y = pb[1]; pw4.z = pb[2]; pw4.w = pb[3];                                                                          \
        const bf16x8 pfrag = __builtin_bit_cast(bf16x8, pw4);                                                                                           \
        const LAS unsigned char* trb = stg + (4 * g + (l15 >> 2)) * DSA_KVROW + (4 * (lane & 3)) * 2;                                                   \
        _Pragma("unroll") for (int dt = 0; dt < 8; ++dt) {                                                                                              \
            const s16x4 lo = __builtin_bit_cast(s16x4, __builtin_amdgcn_ds_read_tr16_b64_v4i16((LAS v4i16_t*)(trb + dt * 32)));                         \
            const s16x4 hi = __builtin_bit_cast(s16x4, __builtin_amdgcn_ds_read_tr16_b64_v4i16((LAS v4i16_t*)(trb + 16 * DSA_KVROW + dt * 32)));        \
            const bf16x8 af = {lo[0], lo[1], lo[2], lo[3], hi[0], hi[1], hi[2], hi[3]};                                                                 \
            o[dt] = __builtin_amdgcn_mfma_f32_16x16x32_bf16(af, pfrag, o[dt], 0, 0, 0); }                                                               \
        LDS_WAIT(); asm volatile("" ::: "memory"); } while (0)
            const int nch = (nvalid + 31) >> 5;
            bf16x8 KA[8], KB[8];
            DSA_GATHER(0, KA);
#pragma unroll 1
            for (int s = 0; s < nch; s += 2) {
                if (s + 1 < nch) DSA_GATHER(s + 1, KB);
                DSA_COMPUTE(s, KA);
                if (s + 1 < nch) { if (s + 2 < nch) DSA_GATHER(s + 2, KA); DSA_COMPUTE(s + 1, KB); }
            }
#undef DSA_GATHER
#undef DSA_COMPUTE
            lsum += __shfl_xor(lsum, 16); lsum += __shfl_xor(lsum, 32);
            const float il = 1.f / lsum;
            if (l15 < 8) {
                bf16* orow = MIX + (size_t)(b * SEQ + t) * MIXW + 512 + head * 128 + 4 * g;
#pragma unroll
                for (int dt = 0; dt < 8; ++dt) { u32x2 w; w.x = pk2(o[dt][0] * il, o[dt][1] * il); w.y = pk2(o[dt][2] * il, o[dt][3] * il); *(u32x2*)(orow + 16 * dt) = w; }
            }
        }
        __syncthreads();
    }
}
typedef __attribute__((address_space(1))) float GASF;
#ifndef ATT_PROBE
#define ATT_PROBE 0
#endif
#ifndef ATT_REMAP
#define ATT_REMAP 1
#endif
__device__ __forceinline__ int crow(int r, int hi) { return (r & 3) + 8 * (r >> 2) + 4 * hi; }
#define KSWZ64(row, cb) ((row) * 128 + ((cb) ^ ((((row) >> 1) & 7) << 4)))
__device__ __forceinline__ int v_st(int k, int c) { const int kk = (k & ~0xC) | ((k & 4) << 1) | ((k & 8) >> 1); return ((kk >> 3) * 4 + (c >> 5)) * 512 + ((kk & 7) * 32 + (c & 31)) * 2; }
__device__ __forceinline__ int v_rd_base(int lane) { return ((lane & 3) << 3) | (((lane >> 2) & 3) << 6) | (((lane >> 4) & 1) << 5) | (((lane >> 5) & 1) << 8); }
constexpr int v_rd_off(int d0, int ks, int half) { return d0 * 512 + ks * 4096 + half * 2048; }
template <int OFF> __device__ __forceinline__ s16x4 tr_read(int vb) {
    s16x4 r; asm volatile("ds_read_b64_tr_b16 %0, %1 offset:%2" : "=&v"(r) : "v"(vb), "i"(OFF) : "memory"); return r;
}
template <int D0> __device__ __forceinline__ void pv_one(f32x16& od, int vb, bf16x8 pa0, bf16x8 pa1, bf16x8 pa2, bf16x8 pa3) {
    const s16x4 l0 = tr_read<v_rd_off(D0, 0, 0)>(vb), h0 = tr_read<v_rd_off(D0, 0, 1)>(vb), l1 = tr_read<v_rd_off(D0, 1, 0)>(vb), h1 = tr_read<v_rd_off(D0, 1, 1)>(vb);
    const s16x4 l2 = tr_read<v_rd_off(D0, 2, 0)>(vb), h2 = tr_read<v_rd_off(D0, 2, 1)>(vb), l3 = tr_read<v_rd_off(D0, 3, 0)>(vb), h3 = tr_read<v_rd_off(D0, 3, 1)>(vb);
    asm volatile("s_waitcnt lgkmcnt(0)" ::: "memory"); __builtin_amdgcn_sched_barrier(0);
#define PK(L, H) (bf16x8){L[0], L[1], L[2], L[3], H[0], H[1], H[2], H[3]}
    od = __builtin_amdgcn_mfma_f32_32x32x16_bf16(pa0, PK(l0, h0), od, 0, 0, 0);
    od = __builtin_amdgcn_mfma_f32_32x32x16_bf16(pa1, PK(l1, h1), od, 0, 0, 0);
    od = __builtin_amdgcn_mfma_f32_32x32x16_bf16(pa2, PK(l2, h2), od, 0, 0, 0);
    od = __builtin_amdgcn_mfma_f32_32x32x16_bf16(pa3, PK(l3, h3), od, 0, 0, 0);
#undef PK
}

__device__ __forceinline__ void att_tile(f32x16 (&o)[4], float& lsum, const unsigned char* Kb, int vb0, const unsigned char* Qw, int r32, int hi, int tq, int j, bool past, float slopeL2, float refL2) {
    constexpr float C = 0.125f * 1.4426950409f;
    bf16x8 qr[4];
#pragma unroll
    for (int d0 = 0; d0 < 4; ++d0) qr[d0] = *(const bf16x8*)(Qw + KSWZ64(r32, (d0 * 16 + hi * 8) * 2));
    const float dq = (float)(tq - 64 * j - 4 * hi);
    const float B0 = -slopeL2 * dq - refL2;
    float ps = 0.f;
    bf16x8 pa0, pa1, pa2, pa3;
#define PK4(P, BASE, OUT) do { unsigned a0 = cvtpk_bf16(P[BASE + 0], P[BASE + 1]), a1 = cvtpk_bf16(P[BASE + 2], P[BASE + 3]);   \
    unsigned b0_ = cvtpk_bf16(P[BASE + 4], P[BASE + 5]), b1_ = cvtpk_bf16(P[BASE + 6], P[BASE + 7]);                              \
    auto r0 = __builtin_amdgcn_permlane32_swap(a0, b0_, false, false); auto r1 = __builtin_amdgcn_permlane32_swap(a1, b1_, false, false); \
    u32x4 w = {r0[0], r1[0], r0[1], r1[1]}; OUT = __builtin_bit_cast(bf16x8, w); } while (0)
#define HALF_TILE(KOFF, FOFF, PA, PB) do { f32x16 pp = f32x16{};                                                                     \
    _Pragma("unroll") for (int d0 = 0; d0 < 4; ++d0) { const int cb = (d0 * 16 + hi * 8) * 2;                                        \
        const bf16x8 bk = *(const bf16x8*)(Kb + KSWZ64((KOFF) + r32, cb)); pp = __builtin_amdgcn_mfma_f32_32x32x16_bf16(bk, qr[d0], pp, 0, 0, 0); } \
    if (past) { _Pragma("unroll") for (int r = 0; r < 16; ++r) { const float off = (float)((r & 3) + 8 * (r >> 2)) + (FOFF);          \
            pp[r] = __builtin_amdgcn_exp2f(fmaf(pp[r], C, fmaf(slopeL2, off, B0))); } }                                               \
    else { _Pragma("unroll") for (int r = 0; r < 16; ++r) { const float off = (float)((r & 3) + 8 * (r >> 2)) + (FOFF);               \
            pp[r] = __builtin_amdgcn_exp2f(fmaf(pp[r], C, -slopeL2 * fabsf(dq - off) - refL2)); } }                                   \
    _Pragma("unroll") for (int r = 0; r < 16; ++r) ps += pp[r];                                                                       \
    PK4(pp, 0, PA); PK4(pp, 8, PB); __builtin_amdgcn_sched_barrier(0); } while (0)
    HALF_TILE(0, 0.f, pa0, pa1);
    HALF_TILE(32, 32.f, pa2, pa3);
#undef HALF_TILE
#undef PK4
    { auto rr = __builtin_amdgcn_permlane32_swap(__float_as_uint(ps), __float_as_uint(ps), false, false);
      ps = __uint_as_float(rr[0]) + __uint_as_float(rr[1]); }
    lsum += ps;
    pv_one<0>(o[0], vb0, pa0, pa1, pa2, pa3); pv_one<1>(o[1], vb0, pa0, pa1, pa2, pa3); pv_one<2>(o[2], vb0, pa0, pa1, pa2, pa3); pv_one<3>(o[3], vb0, pa0, pa1, pa2, pa3);
}
constexpr int ATT_LDS = 2 * 16384 + 2 * 8192 + 8 * 256 + 8 * 4096;

__device__ __forceinline__ void ph_attnA(const Params& p, unsigned char* lds, int vb, int nvb) {
    const bf16* PROJ = (const bf16*)(p.ws + WS_PROJ); bf16* MIX = (bf16*)(p.ws + WS_MIX);
    const float* SC = (const float*)(p.ws + WS_SCAL);
    const float lam = SC[SC_LAM], refL2 = SC[SC_MA] * 1.4426950409f;
    constexpr float C = 0.125f * 1.4426950409f;
    int tid = threadIdx.x; asm volatile("" : "+v"(tid)); const int lane = tid & 63, wid = __builtin_amdgcn_readfirstlane(tid >> 6), r32 = lane & 31, hi = lane >> 5;
    unsigned char* V_lds = lds; unsigned char* K_lds = lds + 32768;
    float* wsf = (float*)(lds + 49152) + wid * 64;
    GASF* tmpw = (GASF*)(p.ws + WS_ATMP) + ((size_t)(vb * NWV + wid) * 64) * 64 + lane;
    const int vbase = (int)(uintptr_t)V_lds + v_rd_base(lane);
    const int krow = tid >> 3, kch = tid & 7, kdst = KSWZ64(krow, kch * 16);
    const int sr = tid >> 4, sc = (tid & 15) * 8, vst0 = v_st(sr, sc), vst1 = v_st(32 + sr, sc);
    for (int it = vb; it < 256; it += nvb) {
        #if ATT_REMAP
        const int xg_ = it & 7, m_ = it >> 3, pidx = xg_ * 8 + (m_ >> 2), qbl = m_ & 3, b = pidx >> 2, h = pidx & 3;
#else
        const int b = it >> 4, h = (it >> 2) & 3, qbl = it & 3;
#endif
        const float slopeL2 = exp2f(-2.0f * (float)(h + 1)) * 1.4426950409f;
        const bf16* Pb = PROJ + (size_t)b * SEQ * NP;
#pragma unroll 1
        for (int half = 0; half < 2; ++half) {
            const int qb = half ? 7 - qbl : qbl, q0 = 256 * qb, NTu = 4 * (qb + 1), cw = 4 * qb + (wid >> 1);
            const int tq = q0 + 32 * wid + r32;
#pragma unroll 1
            for (int mi = 0; mi < 2; ++mi) {
                const int m = 1 - mi;
                const bf16* Kg = Pb + C_KA + h * 128 + m * 64 + (size_t)krow * NP + kch * 8;
                const bf16* Vg = Pb + C_VA + h * 128 + (size_t)sr * NP + sc;
                unsigned char* Qw = lds + 51200 + wid * 4096;
                { const bf16* qp = Pb + (size_t)tq * NP + C_QA + h * 128 + m * 64 + hi * 8;
#pragma unroll
                  for (int d0 = 0; d0 < 4; ++d0) *(bf16x8*)(Qw + KSWZ64(r32, (d0 * 16 + hi * 8) * 2)) = *(const bf16x8*)(qp + d0 * 16); }
                f32x16 o[4];
#pragma unroll
                for (int d = 0; d < 4; ++d) o[d] = f32x16{};
                float lsum = 0.f;
                bf16x8 ak, av0, av1;
#define ATT_LOAD(K_, V0_, V1_, TJ) do { const size_t go_ = (size_t)(TJ) * 64 * NP; K_ = *(const bf16x8*)(Kg + go_); V0_ = *(const bf16x8*)(Vg + go_); V1_ = *(const bf16x8*)(Vg + go_ + (size_t)32 * NP); \
        if (ATT_PROBE == 2) { bf16x8 d0_ = *(const volatile bf16x8*)(Kg + go_); bf16x8 d1_ = *(const volatile bf16x8*)(Vg + go_); bf16x8 d2_ = *(const volatile bf16x8*)(Vg + go_ + (size_t)32 * NP); asm volatile("" :: "v"(d0_), "v"(d1_), "v"(d2_)); } } while (0)
#define ATT_WRITE(K_, V0_, V1_, NB) do { *(bf16x8*)(K_lds + (NB) * 8192 + kdst) = K_; *(bf16x8*)(V_lds + (NB) * 16384 + vst0) = V0_; *(bf16x8*)(V_lds + (NB) * 16384 + vst1) = V1_; } while (0)
                ATT_LOAD(ak, av0, av1, 0); ATT_WRITE(ak, av0, av1, 0);
                __syncthreads();
#pragma unroll 1
                for (int j = 0; j < NTu; ++j) {
                    const int buf = j & 1;
                    if (j + 1 < NTu) ATT_LOAD(ak, av0, av1, j + 1);
                    if (j <= cw) { att_tile(o, lsum, K_lds + buf * 8192, vbase + buf * 16384, Qw, r32, hi, tq, j, j < cw, slopeL2, refL2);
#if ATT_PROBE == 1
                        { f32x16 o2[4]; o2[0] = o[0]; o2[1] = o[1]; o2[2] = o[2]; o2[3] = o[3]; float l2 = 0.f; att_tile(o2, l2, K_lds + buf * 8192, vbase + buf * 16384, Qw, r32, hi, tq, j, j < cw, slopeL2, refL2);
                          asm volatile("" :: "v"(o2[0]), "v"(o2[1]), "v"(o2[2]), "v"(o2[3]), "v"(l2)); }
#endif
                    }
                    if (j + 1 < NTu) ATT_WRITE(ak, av0, av1, buf ^ 1);
                    __syncthreads();
                }
#undef ATT_LOAD
#undef ATT_WRITE
                if (hi == 0) wsf[r32] = lsum;
                LDS_WAIT(); asm volatile("" ::: "memory");
                float rli[16];
#pragma unroll
                for (int r = 0; r < 16; ++r) rli[r] = 1.f / wsf[crow(r, hi)];
                LDS_WAIT(); asm volatile("" ::: "memory");
                if (mi == 0) {
#pragma unroll
                    for (int d = 0; d < 4; ++d) { GASF* td = tmpw + d * 1024; asm volatile("" : "+v"(td));
#pragma unroll
                        for (int r = 0; r < 16; ++r) td[r * 64] = o[d][r] * rli[r]; }
                } else {
                    float gsub[4];
#pragma unroll
                    for (int d = 0; d < 4; ++d) gsub[d] = p.a_sub_gain[32 * d + r32];
                    GASF* tdp[4];
#pragma unroll
                    for (int d = 0; d < 4; ++d) { tdp[d] = tmpw + d * 1024; asm volatile("" : "+v"(tdp[d])); }
#pragma unroll
                    for (int r = 0; r < 16; ++r) {
                        float v[4]; float ss = 0.f;
#pragma unroll
                        for (int d = 0; d < 4; ++d) { v[d] = o[d][r] * rli[r] - lam * tdp[d][r * 64]; ss += v[d] * v[d]; }
                        ss += __shfl_xor(ss, 1); ss += __shfl_xor(ss, 2); ss += __shfl_xor(ss, 4); ss += __shfl_xor(ss, 8); ss += __shfl_xor(ss, 16);
                        const float rs = rsqrtf(ss * (1.f / 128.f) + EPS) * 0.8f;
                        bf16* orow = MIX + (size_t)(b * SEQ + q0 + 32 * wid + crow(r, hi)) * MIXW + h * 128 + r32;
#pragma unroll
                        for (int d = 0; d < 4; ++d) orow[32 * d] = (bf16)f2bf(v[d] * rs * gsub[d]);
                        asm volatile("" ::: "memory");
                    }
                }
            }
        }
    }
}
constexpr int RT_WAVE_BYTES = 12288;
constexpr int RT_LDS = 32768 + 8 * RT_WAVE_BYTES;

__device__ __forceinline__ int pl32_sum(int v) { auto rr = __builtin_amdgcn_permlane32_swap((unsigned)v, (unsigned)v, false, false); return (int)(rr[0] + rr[1]); }
__device__ __forceinline__ int pl32_other(int v) { auto rr = __builtin_amdgcn_permlane32_swap((unsigned)v, (unsigned)v, false, false); return (int)(rr[0] + rr[1]) - v; }
__device__ __forceinline__ float unsortkey(unsigned k) { return __uint_as_float((k & 0x80000000u) ? (k ^ 0x80000000u) : ~k); }

__device__ __forceinline__ unsigned wave_or(unsigned v) {
    v |= (unsigned)__builtin_amdgcn_update_dpp(0, (int)v, 0x128, 0xf, 0xf, false); v |= (unsigned)__builtin_amdgcn_update_dpp(0, (int)v, 0x124, 0xf, 0xf, false);
    v |= (unsigned)__builtin_amdgcn_update_dpp(0, (int)v, 0x122, 0xf, 0xf, false); v |= (unsigned)__builtin_amdgcn_update_dpp(0, (int)v, 0x121, 0xf, 0xf, false);
    return (unsigned)(__builtin_amdgcn_readlane((int)v, 0) | __builtin_amdgcn_readlane((int)v, 16) | __builtin_amdgcn_readlane((int)v, 32) | __builtin_amdgcn_readlane((int)v, 48));
}
template <int N> __device__ __forceinline__ unsigned bisect16(const unsigned (&key)[N]) {
    unsigned kmx, lo;
    { unsigned gm[8];
#pragma unroll
      for (int g = 0; g < 8; ++g) { gm[g] = key[g];
#pragma unroll
          for (int i = g + 8; i < N; i += 8) gm[g] = key[i] > gm[g] ? key[i] : gm[g]; }
      kmx = gm[0]; lo = gm[0];
#pragma unroll
      for (int g = 1; g < 8; ++g) { kmx = gm[g] > kmx ? gm[g] : kmx; lo = gm[g] < lo ? gm[g] : lo; }
      const unsigned okmx = (unsigned)pl32_other((int)kmx), olo = (unsigned)pl32_other((int)lo);
      kmx = okmx > kmx ? okmx : kmx; lo = olo < lo ? olo : lo; }
    const unsigned x = kmx - lo;
    int pb = x ? 31 - __clz(x) : -1;
    unsigned prefix = 0u; bool done = (x == 0u);
#pragma unroll 1
    while (!__all(done)) {
        const unsigned c_ = done ? prefix : (prefix | (1u << pb));
        unsigned cand = lo + c_; cand = cand < lo ? 0xffffffffu : cand;
        int cnt = 0;
#pragma unroll
        for (int i = 0; i + 3 < N; i += 4) cnt_ge4(cnt, key[i], key[i + 1], key[i + 2], key[i + 3], cand);
#pragma unroll
        for (int i = N & ~3; i < N; ++i) cnt += (key[i] >= cand) ? 1 : 0;
        const int tot = pl32_sum(cnt);
        if (!done && tot >= 16) { prefix = c_; done = (tot == 16); }
        --pb; done = done || (pb < 0);
    }
    prefix += lo;
    return prefix;
}

__device__ __forceinline__ void ph_route(const Params& p, unsigned char* lds, int vb, int nvb) {
    const bf16* Q3 = (const bf16*)(p.ws + WS_Q3); const bf16* SUBK = (const bf16*)(p.ws + WS_SUBK);
    int* EXPI = (int*)(p.ws + WS_EXP); float* GATE = (float*)(p.ws + WS_GATE);
    int tid = threadIdx.x; asm volatile("" : "+v"(tid));
    const int lane = tid & 63, wv = __builtin_amdgcn_readfirstlane(tid >> 6), r32 = lane & 31, hi = lane >> 5;
    for (int i = tid; i < 2048; i += NT) { const int row = i >> 3, ch = i & 7; ((u32x4*)lds)[row * 8 + (ch ^ ((row >> 1) & 7))] = ((const u32x4*)SUBK)[i]; }
    __syncthreads();
    unsigned char* wl = lds + 32768 + wv * RT_WAVE_BYTES;
    float* sv = (float*)wl; int* si = (int*)(wl + 4096); float* fv = (float*)(wl + 8192); int* fe = (int*)(wl + 10240);
    const int gw = vb * NWV + wv, ngw = nvb * NWV;
    for (int item = gw; item < (T / 32) * 8; item += ngw) {
        const int h = item & 7, tok0 = (item >> 3) * 32;
        const bf16* qrow = Q3 + (size_t)(tok0 + r32) * 1024 + h * 128 + hi * 8;
#pragma unroll 1
        for (int c = 0; c < 2; ++c) {
            f32x4 cv[8]; const int crow = (item * 2 + c) * 2;
            { const float* src_ = (crow < NEXP ? p.peer_u + (size_t)crow * 1024 : p.peer_v + (size_t)(crow - NEXP) * 1024) + lane * 4;
#pragma unroll
              for (int j = 0; j < 8; ++j) cv[j] = *(const f32x4*)(src_ + 256 * j); }
            bf16x8 bq[4];
#pragma unroll
            for (int d0 = 0; d0 < 4; ++d0) bq[d0] = *(const bf16x8*)(qrow + c * 64 + d0 * 16);
            unsigned key[64];
#pragma unroll
            for (int nt = 0; nt < 4; ++nt) {
                f32x16 acc = f32x16{};
                const int krow = c * 128 + nt * 32 + r32, ksw = (krow >> 1) & 7;
                const unsigned char* kp = lds + krow * 128;
#pragma unroll
                for (int d0 = 0; d0 < 4; ++d0) { const bf16x8 ak = *(const bf16x8*)(kp + (((2 * d0 + hi) ^ ksw) << 4)); acc = __builtin_amdgcn_mfma_f32_32x32x16_bf16(ak, bq[d0], acc, 0, 0, 0); }
#pragma unroll
                for (int r = 0; r < 16; ++r) key[nt * 16 + r] = sortkey(acc[r]);
            }
            const unsigned thr = bisect16<64>(key);
            int cnt = 0;
#pragma unroll
            for (int i = 0; i < 64; ++i) cnt += (key[i] >= thr) ? 1 : 0;
            const int other_ = pl32_other(cnt); int slot = hi ? other_ : 0;
            float* svp = sv + (r32 * 2 + c) * 16; int* sip = si + (r32 * 2 + c) * 16;
#pragma unroll
            for (int i = 0; i < 64; ++i) {
                if (key[i] >= thr && slot < 16) { svp[slot] = unsortkey(key[i]); sip[slot] = 32 * (i >> 4) + ((i & 3) + 8 * ((i & 15) >> 2)) + 4 * hi; ++slot; }
            }
            { const float csc = crow < NEXP ? 32.0f : 1.0f;
              unsigned char* dst_ = (unsigned char*)(p.ws + (crow < NEXP ? WS_U16 : WS_V16)) + (size_t)(crow < NEXP ? crow : crow - NEXP) * 1024 + lane * 4;
#pragma unroll
              for (int j = 0; j < 8; ++j) { int w_ = 0; w_ = __builtin_amdgcn_cvt_pk_fp8_f32(cv[j].x * csc, cv[j].y * csc, w_, false); w_ = __builtin_amdgcn_cvt_pk_fp8_f32(cv[j].z * csc, cv[j].w * csc, w_, true);
                  *(unsigned*)(dst_ + 256 * j) = (unsigned)w_; } }
        }
        u32x4 hb[4]; f32x4 hs, hsh[4];
#define RT_H2_LOAD(HALF) do { const int tk_ = tok0 + 16 * (HALF) + (lane >> 3), p8_ = lane & 7; const int cc_ = h * 128 + 8 * p8_;                            \
            const bf16* hp_ = (const bf16*)(p.ws + WS_H) + (size_t)tk_ * 1024 + cc_;                                                                       \
            const float* sh_ = (const float*)(p.ws + WS_MOD) + (size_t)(tk_ >> 11) * 6144 + 3072 + cc_;                                                    \
            _Pragma("unroll") for (int j = 0; j < 4; ++j) hb[j] = *(const u32x4*)(hp_ + (size_t)(j >> 1) * 8 * 1024 + 64 * (j & 1));                        \
            hs = *((const f32x4*)(p.ws + WS_SSQ) + (size_t)(tk_ + 8 * (p8_ >> 2)) * 4 + (p8_ & 3));                                                        \
            hsh[0] = *(const f32x4*)sh_; hsh[1] = *(const f32x4*)(sh_ + 4); hsh[2] = *(const f32x4*)(sh_ + 64); hsh[3] = *(const f32x4*)(sh_ + 68); } while (0)
#define RT_H2_STORE(HALF) do { const int tk_ = tok0 + 16 * (HALF) + (lane >> 3), p8_ = lane & 7; const int cc_ = h * 128 + 8 * p8_;                           \
            bf16* hp_ = (bf16*)(p.ws + WS_H) + (size_t)tk_ * 1024 + cc_;                                                                                   \
            float s_ = (hs[0] + hs[1]) + (hs[2] + hs[3]); s_ += __shfl_xor(s_, 1); s_ += __shfl_xor(s_, 2);                                                 \
            const float so_ = __shfl_xor(s_, 4); const float rsme_ = rsqrtf(s_ * (1.f / 1024.f) + EPS), rsot_ = rsqrtf(so_ * (1.f / 1024.f) + EPS);           \
            const float rs0_ = (p8_ & 4) ? rsot_ : rsme_, rs1_ = (p8_ & 4) ? rsme_ : rsot_;                           \
            _Pragma("unroll") for (int j = 0; j < 4; ++j) { const f32x4 a_ = hsh[2 * (j & 1)], b_ = hsh[2 * (j & 1) + 1]; const float rs_ = (j >> 1) ? rs1_ : rs0_; u32x4 w_; \
                w_.x = cvtpk_bf16(fmaf(bflo(hb[j].x), rs_, a_[0]), fmaf(bfhi(hb[j].x), rs_, a_[1])); w_.y = cvtpk_bf16(fmaf(bflo(hb[j].y), rs_, a_[2]), fmaf(bfhi(hb[j].y), rs_, a_[3])); \
                w_.z = cvtpk_bf16(fmaf(bflo(hb[j].z), rs_, b_[0]), fmaf(bfhi(hb[j].z), rs_, b_[1])); w_.w = cvtpk_bf16(fmaf(bflo(hb[j].w), rs_, b_[2]), fmaf(bfhi(hb[j].w), rs_, b_[3])); \
                *(u32x4*)(hp_ + (size_t)(j >> 1) * 8 * 1024 + 64 * (j & 1)) = w_; } } while (0)
        RT_H2_LOAD(0);
        LDS_WAIT(); asm volatile("" ::: "memory");
        {
            float* sv0 = sv + (r32 * 2) * 16; float* sv1 = sv0 + 16; int* si0 = si + (r32 * 2) * 16; int* si1 = si0 + 16;
            {
                float a[16], bl[16];
#pragma unroll
                for (int k = 0; k < 16; ++k) { a[k] = sv0[k]; bl[k] = sv1[k]; }
                int ia[8], ib[8], ra[8], rb[8]; float va[8], vb[8];
#pragma unroll
                for (int q = 0; q < 8; ++q) { const int e = 8 * hi + q; va[q] = sv0[e]; vb[q] = sv1[e]; ia[q] = si0[e]; ib[q] = si1[e]; int r0 = 0, r1 = 0;
#pragma unroll
                    for (int k = 0; k < 16; ++k) { r0 += (a[k] > va[q] || (a[k] == va[q] && k < e)) ? 1 : 0; r1 += (bl[k] > vb[q] || (bl[k] == vb[q] && k < e)) ? 1 : 0; }
                    ra[q] = r0; rb[q] = r1; }
                LDS_WAIT(); asm volatile("" ::: "memory");
                { auto rr = __builtin_amdgcn_permlane32_swap(0u, 0u, false, false); (void)rr; }
#pragma unroll
                for (int q = 0; q < 8; ++q) { sv0[ra[q]] = va[q]; si0[ra[q]] = ia[q]; sv1[rb[q]] = vb[q]; si1[rb[q]] = ib[q]; }
                LDS_WAIT(); asm volatile("" ::: "memory");
            }
            const float* X = hi ? sv1 : sv0; const float* Y = hi ? sv0 : sv1;
            float x[4], y[16];
#pragma unroll
            for (int k = 0; k < 4; ++k) x[k] = X[k];
#pragma unroll
            for (int k = 0; k < 16; ++k) y[k] = Y[k];
            unsigned key[27]; int pi[27], pj[27]; int np = 0;
#pragma unroll
            for (int i = 0; i < 3; ++i)
#pragma unroll
                for (int j = i + 1; j < 16; ++j) if ((i + 1) * (j + 1) <= 16) { key[np] = sortkey(x[i] + y[j]); pi[np] = i; pj[np] = j; ++np; }
#pragma unroll
            for (int i = 0; i < 4; ++i) { key[23 + i] = hi ? 0u : sortkey(x[i] + y[i]); pi[23 + i] = i; pj[23 + i] = i; }
            RT_H2_STORE(0); RT_H2_LOAD(1);
            const unsigned thr = bisect16<27>(key);
            int cnt = 0;
#pragma unroll
            for (int i = 0; i < 27; ++i) cnt += (key[i] >= thr) ? 1 : 0;
            const int other_ = pl32_other(cnt); int slot = hi ? other_ : 0;
            const int* IX = hi ? si1 : si0; const int* IY = hi ? si0 : si1;
            float* fvp = fv + r32 * 16; int* fep = fe + r32 * 16;
#pragma unroll
            for (int i = 0; i < 27; ++i) {
                if (key[i] >= thr && slot < 16) { const int ex = IX[pi[i]], ey = IY[pj[i]]; fvp[slot] = unsortkey(key[i]); fep[slot] = hi ? (ey * 128 + ex) : (ex * 128 + ey); ++slot; }
            }
        }
        LDS_WAIT(); asm volatile("" ::: "memory");
        {
            const float* fvp = fv + r32 * 16;
            float v[16]; float mx = -3e38f;
#pragma unroll
            for (int k = 0; k < 16; ++k) { v[k] = fvp[k]; mx = fmaxf(mx, v[k]); }
            float l = 0.f;
#pragma unroll
            for (int k = 0; k < 16; ++k) { v[k] = __expf(v[k] - mx); l += v[k]; }
            const float il = 1.f / l;
            const size_t ob = (size_t)(tok0 + r32) * 128 + h * 16 + 8 * hi;
            const int* fep = fe + r32 * 16 + 8 * hi;
            f32x4 g0, g1; u32x4 e0, e1;
            if (hi == 0) { g0 = (f32x4){v[0] * il, v[1] * il, v[2] * il, v[3] * il}; g1 = (f32x4){v[4] * il, v[5] * il, v[6] * il, v[7] * il}; }
            else { g0 = (f32x4){v[8] * il, v[9] * il, v[10] * il, v[11] * il}; g1 = (f32x4){v[12] * il, v[13] * il, v[14] * il, v[15] * il}; }
            e0 = *(const u32x4*)fep; e1 = *(const u32x4*)(fep + 4);
            *(f32x4*)(GATE + ob) = g0; *(f32x4*)(GATE + ob + 4) = g1;
            *(u32x4*)(EXPI + ob) = e0; *(u32x4*)(EXPI + ob + 4) = e1;
        }
        RT_H2_STORE(1);
#undef RT_H2_LOAD
#undef RT_H2_STORE
        LDS_WAIT(); asm volatile("" ::: "memory");
    }
    __syncthreads();
}
typedef float f32x2_t __attribute__((ext_vector_type(2)));
constexpr int P8_UNITS = T / 64;
constexpr int CW_P8_U = 4096, CW_P8_V = 4096 + 32 * 64;
constexpr float U8_SCALE = 32.0f;
__device__ __forceinline__ unsigned peer_xcc() { return (unsigned)__builtin_amdgcn_s_getreg((3 << 11) | 20) & 7u; }
#ifndef U8_HALVES
#define U8_HALVES 0
#endif
template <int LPR>
__device__ __forceinline__ void ph_peer_v8g(const Params& p, unsigned char* lds) {
    constexpr int RPI = 64 / LPR, NI = 128 / RPI, G = NI / 8, NS = 64 / LPR, SLB = 16 * LPR;
    const unsigned char* V8 = (const unsigned char*)(p.ws + WS_V16);
    const int* EXPI = (const int*)(p.ws + WS_EXP); const float* CBUF = (const float*)(p.ws + WS_CBUF); const float* MOD = (const float*)(p.ws + WS_MOD);
    const float* AB1 = (const float*)(p.ws + WS_ABUF1); const float* GATEP = (const float*)(p.ws + WS_GATE); (void)AB1; (void)GATEP;
    unsigned* ctl = (unsigned*)(p.ws + WS_CTL);
    int tid = threadIdx.x; asm volatile("" : "+v"(tid));
    const int lane = tid & 63, wv = __builtin_amdgcn_readfirstlane(tid >> 6), gR = lane / LPR, iC = lane % LPR;
    volatile LAS unsigned* slot = (volatile LAS unsigned*)(LAS unsigned char*)lds;
    const unsigned xcc = peer_xcc();
#pragma unroll 1
    for (int k = 0; k < NS; ++k) {
        const int sl = (int)((((xcc * NS) >> 3) + (unsigned)k) % (unsigned)NS);
        const unsigned char* vcol = V8 + SLB * sl + 16 * iC;
#pragma unroll 1
        for (;;) {
            if (tid == 0) *slot = __hip_atomic_fetch_add(ctl + CW_P8_V + 64 * sl, 1u, __ATOMIC_RELAXED, __HIP_MEMORY_SCOPE_AGENT);
            __syncthreads();
            const unsigned unit = *slot;
            __syncthreads();
            if (unit >= (unsigned)P8_UNITS) break;
            const int tbase = (int)unit * 64 + wv * 8;
            int ne0, ne1; float nc0, nc1;
#if U8_HALVES
#define VG_FETCH(T) do { const size_t tn_ = (size_t)(T); ne0 = EXPI[tn_ * 128 + lane]; ne1 = EXPI[tn_ * 128 + 64 + lane];                              \
        nc0 = gelu_erf(CBUF[tn_ * 128 + lane] + AB1[tn_ * 128 + lane]) * GATEP[tn_ * 128 + lane];                                              \
        nc1 = gelu_erf(CBUF[tn_ * 128 + 64 + lane] + AB1[tn_ * 128 + 64 + lane]) * GATEP[tn_ * 128 + 64 + lane]; } while (0)
#else
#define VG_FETCH(T) do { const size_t tn_ = (size_t)(T); ne0 = EXPI[tn_ * 128 + lane]; ne1 = EXPI[tn_ * 128 + 64 + lane]; nc0 = CBUF[tn_ * 128 + lane]; nc1 = CBUF[tn_ * 128 + 64 + lane]; } while (0)
#endif
#define VG_LISTS(LE, LC) do { LE[lane] = ne0; LE[64 + lane] = ne1; LC[lane] = nc0; LC[64 + lane] = nc1; } while (0)
#define VG_ROWS(R, LE, GI) do { _Pragma("unroll") for (int kk = 0; kk < 8; ++kk) R[kk] = *(const u32x4*)(vcol + (size_t)LE[RPI * (8 * (GI) + kk) + gR] * 1024); } while (0)
#define VG_GROUP(R, LC, GI) do { _Pragma("unroll") for (int kk = 0; kk < 8; ++kk) { const float cj = LC[RPI * (8 * (GI) + kk) + gR];                       \
            const unsigned w_[4] = {R[kk].x, R[kk].y, R[kk].z, R[kk].w};                                                                       \
            _Pragma("unroll") for (int c = 0; c < 4; ++c) { const f32x2_t lo = __builtin_amdgcn_cvt_pk_f32_fp8((int)w_[c], false), hi = __builtin_amdgcn_cvt_pk_f32_fp8((int)w_[c], true); \
                acc[4 * c] = fmaf(cj, lo.x, acc[4 * c]); acc[4 * c + 1] = fmaf(cj, lo.y, acc[4 * c + 1]); acc[4 * c + 2] = fmaf(cj, hi.x, acc[4 * c + 2]); acc[4 * c + 3] = fmaf(cj, hi.y, acc[4 * c + 3]); } } } while (0)
            u32x4 RA[8], RB[8];
            int* lecur = (int*)(lds + 1024 + wv * 2048); int* lenxt = lecur + 256;
            VG_FETCH(tbase); VG_LISTS(lecur, ((float*)(lecur + 128))); VG_FETCH(tbase + 1);
            LDS_WAIT(); asm volatile("" ::: "memory");
            VG_ROWS(RA, lecur, 0);
#pragma unroll 1
            for (int tt = 0; tt < 8; ++tt) {
                const int t = tbase + tt;
                float* lccur = (float*)(lecur + 128); float* lcnxt = (float*)(lenxt + 128);
                float acc[16];
#pragma unroll
                for (int q = 0; q < 16; ++q) acc[q] = 0.f;
                if (tt + 1 < 8) { VG_LISTS(lenxt, lcnxt); if (tt + 2 < 8) VG_FETCH(t + 2); }
#pragma unroll 1
                for (int gi = 0; gi < G; gi += 2) {
                    VG_ROWS(RB, lecur, gi + 1);
                    VG_GROUP(RA, lccur, gi);
                    if (gi + 2 < G) VG_ROWS(RA, lecur, gi + 2);
                    else if (tt + 1 < 8) { LDS_WAIT(); asm volatile("" ::: "memory"); VG_ROWS(RA, lenxt, 0); }
                    VG_GROUP(RB, lccur, gi + 1);
                }
#pragma unroll
                for (int q = 0; q < 16; ++q) { if (LPR <= 8) acc[q] += dpp_f<0x128>(acc[q]); if (LPR <= 16) acc[q] += __shfl_xor(acc[q], 16); if (LPR <= 32) acc[q] += __shfl_xor(acc[q], 32); }
                if (gR == 0) { const int col = SLB * sl + 16 * iC; const float* g2 = MOD + (size_t)(t >> 11) * 6144 + 5120 + col; float* orow = p.out + (size_t)t * 1024 + col;
#pragma unroll
                    for (int q = 0; q < 4; ++q) { const f32x4 xv = *(const f32x4*)(orow + 4 * q), hv = *(const f32x4*)(g2 + 4 * q);
                        f32x4 r; r.x = acc[4 * q]; r.y = acc[4 * q + 1]; r.z = acc[4 * q + 2]; r.w = acc[4 * q + 3]; *(f32x4*)(orow + 4 * q) = xv + hv * r; } }
                { int* tmp_ = lecur; lecur = lenxt; lenxt = tmp_; }
            }
#undef VG_FETCH
#undef VG_LISTS
#undef VG_ROWS
#undef VG_GROUP
            LDS_WAIT(); asm volatile("" ::: "memory");
        }
    }
}
#ifndef SORT_BITS
#define SORT_BITS 3
#endif
#ifndef PEER_SORT
#define PEER_SORT 1
#endif
__device__ __forceinline__ void ph_peer_u8p(const Params& p, unsigned char* lds_w, int gw, int ngw, int lane_) {
    int lane = lane_; asm volatile("" : "+v"(lane));
    const bf16* H = (const bf16*)(p.ws + WS_H); const unsigned char* U8 = (const unsigned char*)(p.ws + WS_U16); const unsigned char* V8 = (const unsigned char*)(p.ws + WS_V16);
    const int* EXPI = (const int*)(p.ws + WS_EXP); const float* GATE = (const float*)(p.ws + WS_GATE); const float* MOD = (const float*)(p.ws + WS_MOD);
    int* e_lds = (int*)lds_w; float* a_lds = (float*)(lds_w + 512); float* g_lds = (float*)(lds_w + 1024); (void)g_lds;
    const int g = lane >> 4, i = lane & 15;
#pragma unroll 1
    for (int t = gw; t < T; t += ngw) {
        int e0 = EXPI[(size_t)t * 128 + lane], e1 = EXPI[(size_t)t * 128 + 64 + lane];
        float g0 = GATE[(size_t)t * 128 + lane], g1 = GATE[(size_t)t * 128 + 64 + lane];
#if PEER_SORT
        {
            const int flip_ = ((t / ngw) & 1) ? ((1 << SORT_BITS) - 1) : 0;
            const int d0 = (e0 >> (14 - SORT_BITS)) ^ flip_, d1 = (e1 >> (14 - SORT_BITS)) ^ flip_; int pos0 = 0, pos1 = 0, run = 0;
#pragma unroll
            for (int d = 0; d < (1 << SORT_BITS); ++d) {
                const unsigned long long m0 = __ballot(d0 == d), m1 = __ballot(d1 == d);
                const int c0 = __popcll(m0), c1 = __popcll(m1);
                const int r0 = (int)__builtin_amdgcn_mbcnt_hi((unsigned)(m0 >> 32), __builtin_amdgcn_mbcnt_lo((unsigned)m0, 0u));
                const int r1 = (int)__builtin_amdgcn_mbcnt_hi((unsigned)(m1 >> 32), __builtin_amdgcn_mbcnt_lo((unsigned)m1, 0u));
                pos0 = (d0 == d) ? run + r0 : pos0; pos1 = (d1 == d) ? run + c0 + r1 : pos1; run += c0 + c1;
            }
            e_lds[pos0] = e0; e_lds[pos1] = e1; g_lds[pos0] = g0; g_lds[pos1] = g1;
            LDS_WAIT(); asm volatile("" ::: "memory");
            e0 = e_lds[lane]; e1 = e_lds[64 + lane]; g0 = g_lds[lane]; g1 = g_lds[64 + lane];
            int* EW = (int*)(p.ws + WS_EXP) + (size_t)t * 128; EW[lane] = e0; EW[64 + lane] = e1;
        }
#else
        e_lds[lane] = e0; e_lds[64 + lane] = e1;
#endif
        float xf[64];
        { const u32x4* xrow = (const u32x4*)(H + (size_t)t * 1024) + 2 * i;
#pragma unroll
          for (int q = 0; q < 4; ++q) { const u32x4 a = xrow[32 * q], b = xrow[32 * q + 1];
              xf[16 * q] = bflo(a.x); xf[16 * q + 1] = bfhi(a.x); xf[16 * q + 2] = bflo(a.y); xf[16 * q + 3] = bfhi(a.y); xf[16 * q + 4] = bflo(a.z); xf[16 * q + 5] = bfhi(a.z); xf[16 * q + 6] = bflo(a.w); xf[16 * q + 7] = bfhi(a.w);
              xf[16 * q + 8] = bflo(b.x); xf[16 * q + 9] = bfhi(b.x); xf[16 * q + 10] = bflo(b.y); xf[16 * q + 11] = bfhi(b.y); xf[16 * q + 12] = bflo(b.z); xf[16 * q + 13] = bfhi(b.z); xf[16 * q + 14] = bflo(b.w); xf[16 * q + 15] = bfhi(b.w); } }
        LDS_WAIT(); asm volatile("" ::: "memory");
#define P8T_ULOAD(R, S) do { const u32x4* r_ = (const u32x4*)(U8 + (size_t)e_lds[4 * (S) + g] * 1024) + i; _Pragma("unroll") for (int q = 0; q < 4; ++q) R[q] = r_[16 * q]; } while (0)
#define P8T_UDOT(R, S) do { float a0 = 0.f, a1 = 0.f, a2 = 0.f, a3 = 0.f;                                                                               \
        _Pragma("unroll") for (int q = 0; q < 4; ++q) { const unsigned w_[4] = {R[q].x, R[q].y, R[q].z, R[q].w};                                           \
            _Pragma("unroll") for (int c = 0; c < 4; ++c) { const f32x2_t lo = __builtin_amdgcn_cvt_pk_f32_fp8((int)w_[c], false), hi = __builtin_amdgcn_cvt_pk_f32_fp8((int)w_[c], true); \
                a0 = fmaf(lo.x, xf[16 * q + 4 * c], a0); a1 = fmaf(lo.y, xf[16 * q + 4 * c + 1], a1); a2 = fmaf(hi.x, xf[16 * q + 4 * c + 2], a2); a3 = fmaf(hi.y, xf[16 * q + 4 * c + 3], a3); } } \
        const float a_ = row16_sum((a0 + a1) + (a2 + a3)) * (1.0f / U8_SCALE); if (i == 0) a_lds[4 * (S) + g] = a_; } while (0)
        { u32x4 RA[4], RB[4], RC[4];
          P8T_ULOAD(RA, 0); P8T_ULOAD(RB, 1);
#pragma unroll 1
          for (int s = 0; s < 30; s += 3) {
              P8T_ULOAD(RC, s + 2); P8T_UDOT(RA, s);
              P8T_ULOAD(RA, s + 3); P8T_UDOT(RB, s + 1);
              P8T_ULOAD(RB, s + 4); P8T_UDOT(RC, s + 2);
          }
          P8T_UDOT(RA, 30); P8T_UDOT(RB, 31); }
#undef P8T_ULOAD
#undef P8T_UDOT
        LDS_WAIT(); asm volatile("" ::: "memory");
        const float c0 = gelu_erf(a_lds[lane]) * g0, c1 = gelu_erf(a_lds[64 + lane]) * g1;
        float* CB = (float*)(p.ws + WS_CBUF) + (size_t)t * 128; CB[lane] = c0; CB[64 + lane] = c1;
    }
}
__device__ __forceinline__ void ph_peer_u8h(const Params& p, unsigned char* lds) {
    const bf16* H = (const bf16*)(p.ws + WS_H); const unsigned char* U8 = (const unsigned char*)(p.ws + WS_U16);
    const int* EXPI = (const int*)(p.ws + WS_EXP);
    unsigned* ctl = (unsigned*)(p.ws + WS_CTL);
    int tid = threadIdx.x; asm volatile("" : "+v"(tid));
    const int lane = tid & 63, wv = __builtin_amdgcn_readfirstlane(tid >> 6), hw = lane >> 5, i5 = lane & 31;
    volatile LAS unsigned* slot = (volatile LAS unsigned*)(LAS unsigned char*)lds;
    float* a_lds = (float*)(lds + 1024 + wv * 2048 + 1024);
    const unsigned xcc = peer_xcc();
#pragma unroll 1
    for (int k = 0; k < 2; ++k) {
        const int sl = (int)(((xcc >> 2) + (unsigned)k) & 1u);
        float* AB = (float*)(p.ws + (sl ? WS_ABUF1 : WS_CBUF));
        const unsigned char* ucol = U8 + 512 * sl + 16 * i5;
#pragma unroll 1
        for (;;) {
            if (tid == 0) *slot = __hip_atomic_fetch_add(ctl + CW_P8_U + 64 * sl, 1u, __ATOMIC_RELAXED, __HIP_MEMORY_SCOPE_AGENT);
            __syncthreads();
            const unsigned unit = *slot;
            __syncthreads();
            if (unit >= (unsigned)P8_UNITS) break;
            const int tbase = (int)unit * 64 + wv * 8;
            int ne0, ne1; u32x4 nx0, nx1;
#define UH_FETCH(T) do { const size_t tn_ = (size_t)(T); ne0 = EXPI[tn_ * 128 + lane]; ne1 = EXPI[tn_ * 128 + 64 + lane];                          \
        const u32x4* xr_ = (const u32x4*)(H + tn_ * 1024 + 512 * sl) + 2 * i5; nx0 = xr_[0]; nx1 = xr_[1]; } while (0)
#define UH_LISTS(LE) do { LE[lane] = ne0; LE[64 + lane] = ne1; } while (0)
#define UH_ROWS(R, LE, GI) do { _Pragma("unroll") for (int kk = 0; kk < 8; ++kk) R[kk] = *(const u32x4*)(ucol + (size_t)LE[2 * (8 * (GI) + kk) + hw] * 1024); } while (0)
#define UH_GROUP(R, GI) do { _Pragma("unroll") for (int kk = 0; kk < 8; ++kk) { float a0 = 0.f, a1 = 0.f, a2 = 0.f, a3 = 0.f;                         \
            const unsigned w_[4] = {R[kk].x, R[kk].y, R[kk].z, R[kk].w};                                                                       \
            _Pragma("unroll") for (int c = 0; c < 4; ++c) { const f32x2_t lo = __builtin_amdgcn_cvt_pk_f32_fp8((int)w_[c], false), hi = __builtin_amdgcn_cvt_pk_f32_fp8((int)w_[c], true); \
                a0 = fmaf(lo.x, xf[4 * c], a0); a1 = fmaf(lo.y, xf[4 * c + 1], a1); a2 = fmaf(hi.x, xf[4 * c + 2], a2); a3 = fmaf(hi.y, xf[4 * c + 3], a3); }                        \
            float s_ = row16_sum((a0 + a1) + (a2 + a3)); s_ += __shfl_xor(s_, 16);                                                              \
            if (i5 == 0) a_lds[2 * (8 * (GI) + kk) + hw] = s_ * (1.0f / U8_SCALE); } } while (0)
            u32x4 RA[8], RB[8];
            int* lecur = (int*)(lds + 1024 + wv * 2048); int* lenxt = lecur + 128;
            UH_FETCH(tbase); UH_LISTS(lecur);
            float xf[16];
#define UH_XF() do { xf[0] = bflo(nx0.x); xf[1] = bfhi(nx0.x); xf[2] = bflo(nx0.y); xf[3] = bfhi(nx0.y); xf[4] = bflo(nx0.z); xf[5] = bfhi(nx0.z); xf[6] = bflo(nx0.w); xf[7] = bfhi(nx0.w); \
        xf[8] = bflo(nx1.x); xf[9] = bfhi(nx1.x); xf[10] = bflo(nx1.y); xf[11] = bfhi(nx1.y); xf[12] = bflo(nx1.z); xf[13] = bfhi(nx1.z); xf[14] = bflo(nx1.w); xf[15] = bfhi(nx1.w); } while (0)
            UH_XF();
            UH_FETCH(tbase + 1);
            LDS_WAIT(); asm volatile("" ::: "memory");
            UH_ROWS(RA, lecur, 0);
#pragma unroll 1
            for (int tt = 0; tt < 8; ++tt) {
                const int t = tbase + tt;
                float xn[16];
                if (tt + 1 < 8) { UH_LISTS(lenxt);
#pragma unroll
                    for (int q = 0; q < 16; ++q) xn[q] = 0.f;
                    xn[0] = bflo(nx0.x); xn[1] = bfhi(nx0.x); xn[2] = bflo(nx0.y); xn[3] = bfhi(nx0.y); xn[4] = bflo(nx0.z); xn[5] = bfhi(nx0.z); xn[6] = bflo(nx0.w); xn[7] = bfhi(nx0.w);
                    xn[8] = bflo(nx1.x); xn[9] = bfhi(nx1.x); xn[10] = bflo(nx1.y); xn[11] = bfhi(nx1.y); xn[12] = bflo(nx1.z); xn[13] = bfhi(nx1.z); xn[14] = bflo(nx1.w); xn[15] = bfhi(nx1.w);
                    if (tt + 2 < 8) UH_FETCH(t + 2); }
#pragma unroll 1
                for (int gi = 0; gi < 8; gi += 2) {
                    UH_ROWS(RB, lecur, gi + 1);
                    UH_GROUP(RA, gi);
                    if (gi + 2 < 8) UH_ROWS(RA, lecur, gi + 2);
                    else if (tt + 1 < 8) { LDS_WAIT(); asm volatile("" ::: "memory"); UH_ROWS(RA, lenxt, 0); }
                    UH_GROUP(RB, gi + 1);
                }
                LDS_WAIT(); asm volatile("" ::: "memory");
                { float* ab = AB + (size_t)t * 128; ab[lane] = a_lds[lane]; ab[64 + lane] = a_lds[64 + lane]; }
                LDS_WAIT(); asm volatile("" ::: "memory");
                if (tt + 1 < 8) {
#pragma unroll
                    for (int q = 0; q < 16; ++q) xf[q] = xn[q]; }
                { int* tmp_ = lecur; lecur = lenxt; lenxt = tmp_; }
            }
#undef UH_FETCH
#undef UH_LISTS
#undef UH_ROWS
#undef UH_GROUP
#undef UH_XF
        }
    }
}
#define XB_TMO      128
#define XB_XCNT(j)  (256  + 64 * (j))
#define XB_XSUB(j)  (1280 + 64 * (j))
#define XB_XGEN(j)  (2304 + 64 * (j))
#define XB_TOP      3328
#define XB_TOPGEN   3392
#define XCD_BAR_WORDS 3456
#define XB_SPIN_CAP (1u << 18)

__device__ __forceinline__ unsigned xb_ld(unsigned* p)              { return __hip_atomic_load(p, __ATOMIC_RELAXED, __HIP_MEMORY_SCOPE_AGENT); }
__device__ __forceinline__ unsigned xb_add(unsigned* p, unsigned v) { return __hip_atomic_fetch_add(p, v, __ATOMIC_RELAXED, __HIP_MEMORY_SCOPE_AGENT); }
__device__ __forceinline__ unsigned xb_xcc_id() { return (unsigned)__builtin_amdgcn_s_getreg((3 << 11) | 20) & 0xFu; }
#define XB_SPIN(cond, bar) do { unsigned _sp = 0; while (cond) { __builtin_amdgcn_s_sleep(1); \
    if ((++_sp & 255u) == 0u) { if (xb_ld(&(bar)[XB_TMO])) break; if (_sp > XB_SPIN_CAP) { atomicAdd(&(bar)[XB_TMO], 1u); break; } } } } while (0)

struct XcdBarrier {
    unsigned* bar; unsigned x;
    volatile LAS unsigned* st;
};

__device__ __forceinline__ XcdBarrier xcd_barrier_post(unsigned* bar, volatile LAS unsigned* st) {
    XcdBarrier b; b.bar = bar; b.x = xb_xcc_id(); b.st = st;
    if (threadIdx.x == 0) (void)xb_add(&bar[XB_XCNT(b.x)], 1u);
    return b;
}
__device__ __forceinline__ void xcd_barrier_complete(unsigned* bar, unsigned x, unsigned& nloc, unsigned& nx) {
    const unsigned G = gridDim.x * gridDim.y * gridDim.z;
    unsigned sum, cnt, mine, sp = 0u;
    for (;;) {
        sum = 0u; cnt = 0u; mine = 0u;
#pragma unroll
        for (unsigned j = 0; j < 16; ++j) { const unsigned c = xb_ld(&bar[XB_XCNT(j)]); sum += c; cnt += (c > 0u) ? 1u : 0u; mine = (j == x) ? c : mine; }
        if (sum == G) break;
        __builtin_amdgcn_s_sleep(1);
        if ((++sp & 255u) == 0u) { if (xb_ld(&bar[XB_TMO])) break; if (sp > XB_SPIN_CAP) { atomicAdd(&bar[XB_TMO], 1u); break; } }
    }
    nloc = mine > 0u ? mine : 1u; nx = cnt > 0u ? cnt : 1u;
}

__device__ __forceinline__ void xcd_barrier(const XcdBarrier& b) {
    asm volatile("s_waitcnt vmcnt(0)" ::: "memory");
    __syncthreads();
    if (threadIdx.x == 0) {
        unsigned* bar = b.bar;
        __builtin_amdgcn_s_waitcnt(0);
        unsigned nloc = b.st[0], nx = b.st[1];
        if (nloc == 0u) { xcd_barrier_complete(bar, b.x, nloc, nx); b.st[0] = nloc; b.st[1] = nx; }
        const unsigned old = xb_add(&bar[XB_XSUB(b.x)], 1u);
        const unsigned gen = old / nloc;
        if (old + 1u == (gen + 1u) * nloc) {
            __builtin_amdgcn_fence(__ATOMIC_RELEASE, "agent");
            asm volatile("s_waitcnt vmcnt(0)" ::: "memory");
            const unsigned og = xb_add(&bar[XB_TOP], 1u);
            const unsigned tg = og / nx;
            if (og + 1u == (tg + 1u) * nx) xb_add(&bar[XB_TOPGEN], 1u);
            else XB_SPIN(xb_ld(&bar[XB_TOPGEN]) == tg, bar);
            __builtin_amdgcn_fence(__ATOMIC_ACQUIRE, "agent");
            xb_add(&bar[XB_XGEN(b.x)], 1u);
            asm volatile("s_waitcnt vmcnt(0)" ::: "memory");
        } else {
            XB_SPIN(xb_ld(&bar[XB_XGEN(b.x)]) == gen, bar);
            __builtin_amdgcn_fence(__ATOMIC_ACQUIRE, "agent");
            asm volatile("s_waitcnt vmcnt(0)" ::: "memory");
        }
    }
    __syncthreads();
}

#ifndef V8_LPR
#define V8_LPR 32
#endif
constexpr int LDS_BYTES = 147456;
extern __shared__ __attribute__((aligned(16))) unsigned char dyn_lds[];

__global__ void __launch_bounds__(NT, 2) mega_fwd(Params p) {
    cg::grid_group grid = cg::this_grid();
    const int vb = blockIdx.x, nvb = gridDim.x, ngw = nvb * NWV;
    volatile LAS unsigned* xst = (volatile LAS unsigned*)((LAS unsigned char*)dyn_lds + (LDS_BYTES - 16));
    if (threadIdx.x < 4) xst[threadIdx.x] = 0u;
    __syncthreads();
    const XcdBarrier xbar = xcd_barrier_post((unsigned*)(p.ws + WS_CTL), xst);
#define TID_LAUNDER int tid_ = threadIdx.x; asm volatile("" : "+v"(tid_)); const int lane = tid_ & 63, wv = tid_ >> 6, gw = vb * NWV + wv; (void)lane; (void)gw;
    grid.sync();
    ph_mod(p, (float*)dyn_lds, vb, nvb);
    { TID_LAUNDER ph_prep_weights(p, (LAS float*)dyn_lds + wv * (64 * 33), gw, ngw, lane); }
    xcd_barrier(xbar);
    { TID_LAUNDER ph_hrows(p, p.x, p.norm1_g, 0, 1024, gw, ngw, lane); ph_q3bias(p, gw, lane); }
    xcd_barrier(xbar);
    {   pg8::Gemm g{(const bf16*)(p.ws + WS_H), (const bf16*)(p.ws + WS_WIN), T, NP, 1024}; pg8::StaticOrder S; S.init(T, NP, nvb, vb);
        EpiNormBf16 E{(bf16*)(p.ws + WS_PROJ), p.a_qk_gain, p.b_q_gain, p.b_kv_gain, (LAS float*)((LAS unsigned char*)dyn_lds + 131072), (bf16*)(p.ws + WS_KVC)};
        pg8::gemm_phase<EpiNormBf16, pg8::StaticOrder, true, true>((LAS unsigned char*)dyn_lds, g, S, E); }
    xcd_barrier(xbar);
    ph_attnA(p, dyn_lds, vb, nvb);
    __syncthreads();
    ph_dsa(p, dyn_lds, vb, nvb);
    xcd_barrier(xbar);
    {   pg8::Gemm g{(const bf16*)(p.ws + WS_MIX), (const bf16*)(p.ws + WS_WO2), T, 1024, MIXW}; pg8::StaticOrder S; S.init(T, 1024, nvb, vb);
        EpiResGateA2 E{p.x, p.out, (const float*)(p.ws + WS_MOD), p.norm2_g, (bf16*)(p.ws + WS_H), (float*)(p.ws + WS_SSQ)};
        pg8::gemm_phase<EpiResGateA2, pg8::StaticOrder, true, true>((LAS unsigned char*)dyn_lds, g, S, E); }
    xcd_barrier(xbar);
    {   pg8::Gemm g{(const bf16*)(p.ws + WS_H), (const bf16*)(p.ws + WS_WQ), T, 1024, 1024}; pg8::StaticOrder S; S.init(T, 1024, nvb, vb);
        EpiQ3 E{(const float*)(p.ws + WS_SSQ), (const float*)(p.ws + WS_QBIAS), (bf16*)(p.ws + WS_Q3)};
        pg8::gemm_phase<EpiQ3, pg8::StaticOrder, true, true>((LAS unsigned char*)dyn_lds, g, S, E); }
    xcd_barrier(xbar);
    ph_route(p, dyn_lds, vb, nvb);
    xcd_barrier(xbar);

#if U8_HALVES
    ph_peer_u8h(p, dyn_lds);
#else
    { TID_LAUNDER ph_peer_u8p(p, dyn_lds + wv * 2048, gw, ngw, lane); }
#endif
    xcd_barrier(xbar);
    ph_peer_v8g<V8_LPR>(p, dyn_lds);

}

extern "C" void kernel_launch(void* const* d_in, const int* in_sizes, int n_in, void* d_out, int out_size, void* d_ws, size_t ws_size, hipStream_t stream) {
    static int grid_blocks = 0;
    if (grid_blocks == 0) {
        if (n_in != 18 || in_sizes[0] != T * DM || out_size != T * DM || ws_size < WS_END) { fprintf(stderr, "kernel_launch: unexpected shapes n_in %d in0 %d out %d ws %zu\n", n_in, n_in > 0 ? in_sizes[0] : -1, out_size, ws_size); grid_blocks = -1; return; }
        int dev = 0, cus = 0, per_cu = 0;
        (void)hipGetDevice(&dev);
        (void)hipDeviceGetAttribute(&cus, hipDeviceAttributeMultiprocessorCount, dev);
        (void)hipFuncSetAttribute((const void*)mega_fwd, hipFuncAttributeMaxDynamicSharedMemorySize, LDS_BYTES);
        (void)hipOccupancyMaxActiveBlocksPerMultiprocessor(&per_cu, (const void*)mega_fwd, NT, LDS_BYTES);
        if (per_cu < 1 || cus < 1) { fprintf(stderr, "kernel_launch: occupancy query gave %d blocks/CU on %d CUs\n", per_cu, cus); grid_blocks = -1; return; }
        grid_blocks = cus;
    }
    if (grid_blocks < 0) return;
    Params p{};
    const float** pp = (const float**)&p;
    for (int i = 0; i < 18; ++i) pp[i] = (const float*)d_in[i];
    p.out = (float*)d_out; p.ws = (unsigned char*)d_ws;
    if (hipMemsetAsync((char*)d_ws + WS_CTL, 0, CTL_BYTES, stream) != hipSuccess) { fprintf(stderr, "kernel_launch: memset failed\n"); return; }
    void* args[] = {&p};
    const hipError_t e = hipLaunchCooperativeKernel((const void*)mega_fwd, dim3(grid_blocks), dim3(NT), args, LDS_BYTES, stream);
    if (e != hipSuccess) fprintf(stderr, "kernel_launch: cooperative launch failed: %s (grid %d)\n", hipGetErrorString(e), grid_blocks);
}
```

```cpp
#include <hip/hip_runtime.h>
#include <hip/hip_cooperative_groups.h>
#include <cstdio>
#include <cstdint>
#include <cmath>
namespace pg8 {
#define PG8_LAS __attribute__((address_space(3)))
typedef unsigned short bf16_t;
typedef short bf16x8 __attribute__((ext_vector_type(8)));
typedef float f32x4 __attribute__((ext_vector_type(4)));
typedef unsigned u32x4 __attribute__((ext_vector_type(4)));
constexpr int BM = 256, BK = 64, HALF = 128, HTB = HALF * BK * 2  , STAGE_BYTES = 8 * HTB, NXCD = 8, WGM = 8;

__host__ __device__ __forceinline__ int lds_byte(int r, int c) { const int st = (r >> 4) * 2 + (c >> 5), rr = r & 15, cc = c & 31, ob = rr * 64 + cc * 2; return st * 1024 + (ob ^ (((ob >> 9) & 1) << 5)); }
__host__ __device__ __forceinline__ void stage_rc(int b, int& R, int& C) { const int st = b / 1024, sb = b % 1024, swz = sb ^ (((sb >> 9) & 1) << 5); R = (st >> 1) * 16 + swz / 64; C = (st & 1) * 32 + (swz % 64) / 2; }
__host__ __device__ __forceinline__ int perm32(int rho) { const int n = rho >> 4, i = rho & 15; return 8 * (i >> 2) + 4 * n + (i & 3); }

struct Unit { int pm, pn; };
struct Gemm { const bf16_t* A; const bf16_t* Bt; int M, N, K; };

struct StaticOrder {
    int nM, nN, nwg, G, c;
    __host__ __device__ void init(int M, int N, int G_, int c_) { nM = M / BM; nN = N / BM; nwg = nM * nN; G = G_; c = c_; }
    __host__ __device__ bool next(int i, Unit& u) const {
        const long L = (long)i * G + c; if (L >= nwg) return false;
        int wgid = (int)L; { const int q = nwg / NXCD, r = nwg % NXCD, xcd = wgid % NXCD, off = wgid / NXCD; wgid = (xcd < r ? xcd * (q + 1) : r * (q + 1) + (xcd - r) * q) + off; }
        const int nig = WGM * nN, gid = wgid / nig, fm = gid * WGM, gsz = (nM - fm) < WGM ? (nM - fm) : WGM;
        u.pm = fm + ((wgid % nig) % gsz); u.pn = (wgid % nig) / gsz; return true;
    }
    __device__ __forceinline__ void a_ready(const Unit&) const {}
    __device__ __forceinline__ void done(const Unit&) const {}
};

__device__ __forceinline__ unsigned cvt_pk_bf16(float lo, float hi) { unsigned r; asm volatile("v_cvt_pk_bf16_f32 %0, %1, %2" : "=v"(r) : "v"(lo), "v"(hi)); return r; }
typedef float f32x2 __attribute__((ext_vector_type(2)));
__device__ __forceinline__ f32x2 gelu_pk(f32x2 v) {
    const f32x2 av = __builtin_elementwise_abs(v), d = av * 0.2316418882f + 1.0f;
    f32x2 t; t.x = __builtin_amdgcn_rcpf(d.x); t.y = __builtin_amdgcn_rcpf(d.y);
    f32x2 q = t * 0.5307027145f + (-0.7265760135f); q = q * t + 0.7107068705f; q = q * t + (-0.142248368f); q = q * t + 0.127414796f; q = q * t;
    const f32x2 s = (v * v) * (-0.72134752044f);
    f32x2 e; e.x = __builtin_amdgcn_exp2f(s.x); e.y = __builtin_amdgcn_exp2f(s.y);
    const f32x2 m = v * (q * e), r = v - m;
    f32x2 o; o.x = v.x < 0.f ? m.x : r.x; o.y = v.y < 0.f ? m.y : r.y; return o;
}

template <int ACT  > struct EpiBf16 {
    static constexpr bool PERM = true, AFTER_DRAIN = false; static_assert(ACT == 0 || ACT == 1, "EpiBf16: ACT is 0 (none) or 1 (gelu_pk)");
    bf16_t* O; int ldc; const float* bias; int split_cols; size_t split_stride; float scale0;
    __device__ __forceinline__ void operator()(const f32x4 (&acc)[2][2][4][2], const Unit& u, int wr, int wc, int fr, int fq) const {
        const int row0 = u.pm * BM + wr * 64 + fr; int colt = u.pn * BM; bf16_t* base = O;
        float sc = 1.f; if (split_cols) { const int t = colt / split_cols; base += (size_t)t * split_stride; colt -= t * split_cols; if (t == 0) sc = scale0; }
        const int col0 = colt + wc * 32 + 8 * fq, bcol0 = u.pn * BM + wc * 32 + 8 * fq;
        f32x4 bv[2][2];
#pragma unroll
        for (int bj = 0; bj < 2; ++bj)
#pragma unroll
            for (int n = 0; n < 2; ++n) bv[bj][n] = bias ? *(const f32x4*)(bias + bcol0 + bj * HALF + 4 * n) : (f32x4){0.f, 0.f, 0.f, 0.f};
#pragma unroll
        for (int ai = 0; ai < 2; ++ai)
#pragma unroll
            for (int m = 0; m < 4; ++m) { bf16_t* rowp = base + (size_t)(row0 + ai * HALF + m * 16) * ldc + col0;
#pragma unroll
                for (int bj = 0; bj < 2; ++bj) { f32x4 v0 = acc[ai][bj][m][0] + bv[bj][0], v1 = acc[ai][bj][m][1] + bv[bj][1];
                    if (ACT == 1) { f32x2 a = gelu_pk((f32x2){v0[0], v0[1]}), b = gelu_pk((f32x2){v0[2], v0[3]}), c = gelu_pk((f32x2){v1[0], v1[1]}), d = gelu_pk((f32x2){v1[2], v1[3]});
                        v0 = (f32x4){a.x, a.y, b.x, b.y}; v1 = (f32x4){c.x, c.y, d.x, d.y}; }
                    v0 = v0 * sc; v1 = v1 * sc; u32x4 w; w.x = cvt_pk_bf16(v0[0], v0[1]); w.y = cvt_pk_bf16(v0[2], v0[3]); w.z = cvt_pk_bf16(v1[0], v1[1]); w.w = cvt_pk_bf16(v1[2], v1[3]);
                    *(u32x4*)(rowp + bj * HALF) = w; } }
    }
};

template <class Epi, class Sched, bool ALIGN_EPI = false, bool SP2 = false>
__device__ __forceinline__ void gemm_phase(PG8_LAS unsigned char* lds, const Gemm g, const Sched& S, const Epi& E) {
    int tid = threadIdx.x; asm volatile("" : "+v"(tid)); const int wid = __builtin_amdgcn_readfirstlane(tid >> 6), lane = tid & 63, wr = wid >> 2, wc = wid & 3, fr = lane & 15, fq = lane >> 4;
    const int K = g.K, nt = K / BK;
    unsigned voffA[2], voffB[2];
#pragma unroll
    for (int i = 0; i < 2; ++i) { int R, C; stage_rc(tid * 16 + i * 8192, R, C); const int Rb = Epi::PERM ? ((R & ~31) + perm32(R & 31)) : R;
        voffA[i] = (unsigned)(R * K + C) * 2u; voffB[i] = (unsigned)(Rb * K + C) * 2u; }
    const size_t kstep = (size_t)(BK * 2);
    const size_t hstep = (size_t)HALF * K * 2;
    const size_t tstep = 2 * hstep;
    const unsigned ldsw = (unsigned)wid * 1024u;
    const int aoff = lds_byte(wr * 64 + fr, fq * 8), boff = lds_byte(wc * 32 + fr, fq * 8);
#define PG8_SA(b, h) (((b) * 2 + (h)) * HTB)
#define PG8_SB(b, h) ((4 + (b) * 2 + (h)) * HTB)
#define PG8_STAGE(bufoff, gbase, voff) do { _Pragma("unroll") for (int _i = 0; _i < 2; ++_i) \
        __builtin_amdgcn_global_load_lds((const unsigned*)((const char*)(gbase) + (voff)[_i]), (PG8_LAS unsigned*)(lds + (bufoff) + ldsw + _i * 8192), 16, 0, 0); } while (0)
#define PG8_LDA(dst, b, h) do { _Pragma("unroll") for (int m = 0; m < 4; ++m) _Pragma("unroll") for (int k = 0; k < 2; ++k) dst[m][k] = *(const PG8_LAS bf16x8*)(lds + PG8_SA(b, h) + aoff + m * 2048 + k * 1024); } while (0)
#define PG8_LDB(dst, b, h) do { _Pragma("unroll") for (int n = 0; n < 2; ++n) _Pragma("unroll") for (int k = 0; k < 2; ++k) dst[n][k] = *(const PG8_LAS bf16x8*)(lds + PG8_SB(b, h) + boff + n * 2048 + k * 1024); } while (0)
#define PG8_MMA(ai, bj, At, Bt) do { __builtin_amdgcn_s_setprio(1); _Pragma("unroll") for (int m = 0; m < 4; ++m) _Pragma("unroll") for (int n = 0; n < 2; ++n) _Pragma("unroll") for (int k = 0; k < 2; ++k) \
        acc[ai][bj][m][n] = __builtin_amdgcn_mfma_f32_16x16x32_bf16(Bt[n][k], At[m][k], acc[ai][bj][m][n], 0, 0, 0); __builtin_amdgcn_s_setprio(0); } while (0)
#define PG8_WAIT_V(n) asm volatile("s_waitcnt vmcnt(" #n ")" ::: "memory")
#define PG8_WAIT_L(n) asm volatile("s_waitcnt lgkmcnt(" #n ")" ::: "memory")
#define PG8_BAR __builtin_amdgcn_s_barrier()
#define PG8_SCHED __builtin_amdgcn_sched_barrier(0)
    Unit cur, nxt; int ui = 0;
    if (!S.next(0, cur)) return;
    f32x4 acc[2][2][4][2];
#pragma unroll
    for (int a = 0; a < 2; ++a)
#pragma unroll
        for (int b = 0; b < 2; ++b)
#pragma unroll
            for (int m = 0; m < 4; ++m)
#pragma unroll
                for (int n = 0; n < 2; ++n) acc[a][b][m][n] = (f32x4){0.f, 0.f, 0.f, 0.f};
    bf16x8 At[4][2], B0[2][2], B1[2][2];
    const char* cA = (const char*)g.A + (size_t)cur.pm * tstep; const char* cB = (const char*)g.Bt + (size_t)cur.pn * tstep;
    S.a_ready(cur);
    if constexpr (SP2) {
        PG8_STAGE(PG8_SB(0, 0), cB, voffB); PG8_STAGE(PG8_SB(0, 1), cB + hstep, voffB); PG8_STAGE(PG8_SA(0, 0), cA, voffA); PG8_STAGE(PG8_SA(0, 1), cA + hstep, voffA);
        if (wr == 1) PG8_BAR;
        PG8_WAIT_V(2); PG8_BAR;
        PG8_STAGE(PG8_SB(1, 0), cB + kstep, voffB); PG8_STAGE(PG8_SA(1, 0), cA + kstep, voffA); PG8_STAGE(PG8_SB(1, 1), cB + hstep + kstep, voffB);
        PG8_WAIT_V(6); PG8_BAR;
    } else {
        PG8_STAGE(PG8_SB(0, 0), cB, voffB); PG8_STAGE(PG8_SA(0, 0), cA, voffA); PG8_STAGE(PG8_SB(0, 1), cB + hstep, voffB); PG8_STAGE(PG8_SA(0, 1), cA + hstep, voffA);
        if (wr == 1) PG8_BAR;
        PG8_WAIT_V(4); PG8_BAR;
        PG8_STAGE(PG8_SB(1, 0), cB + kstep, voffB); PG8_STAGE(PG8_SA(1, 0), cA + kstep, voffA); PG8_STAGE(PG8_SB(1, 1), cB + hstep + kstep, voffB);
        PG8_WAIT_V(6); PG8_BAR;
    }
    for (;;) {
        const bool has_next = S.next(ui + 1, nxt);
        const char* nA = has_next ? (const char*)g.A + (size_t)nxt.pm * tstep : cA; const char* nB = has_next ? (const char*)g.Bt + (size_t)nxt.pn * tstep : cB;
        for (int t = 0; t < nt; t += 2) {
            const bool last = (t == nt - 2);
            const char* a1 = cA + (size_t)(t + 1) * kstep;
            const char* a2 = last ? nA : cA + (size_t)(t + 2) * kstep; const char* b2 = last ? nB : cB + (size_t)(t + 2) * kstep;
            const char* a3 = a2 + kstep; const char* b3 = b2 + kstep;
            if (last && has_next) S.a_ready(nxt);
            if constexpr (SP2) {
            PG8_LDB(B0, 0, 0); PG8_LDB(B1, 0, 1); PG8_SCHED; PG8_LDA(At, 0, 0); PG8_STAGE(PG8_SA(1, 1), a1 + hstep, voffA);
            PG8_WAIT_V(8); PG8_WAIT_L(0); PG8_BAR; PG8_MMA(0, 0, At, B0); PG8_MMA(0, 1, At, B1); PG8_BAR; PG8_SCHED;
            PG8_LDA(At, 0, 1); PG8_STAGE(PG8_SB(0, 0), b2, voffB); PG8_STAGE(PG8_SB(0, 1), b2 + hstep, voffB); PG8_STAGE(PG8_SA(0, 0), a2, voffA);
            PG8_WAIT_V(8); PG8_WAIT_L(0); PG8_BAR; PG8_MMA(1, 0, At, B0); PG8_MMA(1, 1, At, B1); PG8_BAR; PG8_SCHED;
            PG8_LDB(B0, 1, 0); PG8_LDB(B1, 1, 1); PG8_SCHED; PG8_LDA(At, 1, 0); PG8_STAGE(PG8_SA(0, 1), a2 + hstep, voffA);
            PG8_WAIT_V(8); PG8_WAIT_L(0); PG8_BAR; PG8_MMA(0, 0, At, B0); PG8_MMA(0, 1, At, B1); PG8_BAR; PG8_SCHED;
            PG8_LDA(At, 1, 1); PG8_STAGE(PG8_SB(1, 0), b3, voffB); PG8_STAGE(PG8_SB(1, 1), b3 + hstep, voffB); PG8_STAGE(PG8_SA(1, 0), a3, voffA);
            PG8_WAIT_V(8); PG8_WAIT_L(0); PG8_BAR; PG8_MMA(1, 0, At, B0); PG8_MMA(1, 1, At, B1); PG8_BAR; PG8_SCHED;
            } else {
            PG8_LDB(B0, 0, 0); PG8_SCHED; PG8_LDA(At, 0, 0); PG8_STAGE(PG8_SA(1, 1), a1 + hstep, voffA);
            PG8_WAIT_L(8); PG8_BAR; PG8_WAIT_L(0); PG8_MMA(0, 0, At, B0); PG8_BAR; PG8_SCHED;
            PG8_LDB(B1, 0, 1); PG8_STAGE(PG8_SB(0, 0), b2, voffB);
            PG8_BAR; PG8_WAIT_L(0); PG8_MMA(0, 1, At, B1); PG8_BAR;
            PG8_LDA(At, 0, 1); PG8_STAGE(PG8_SA(0, 0), a2, voffA);
            PG8_BAR; PG8_WAIT_L(0); PG8_MMA(1, 0, At, B0); PG8_BAR; PG8_SCHED;
            PG8_STAGE(PG8_SB(0, 1), b2 + hstep, voffB);
            PG8_WAIT_V(6); PG8_BAR; PG8_MMA(1, 1, At, B1); PG8_BAR;
            PG8_LDB(B0, 1, 0); PG8_SCHED; PG8_LDA(At, 1, 0); PG8_STAGE(PG8_SA(0, 1), a2 + hstep, voffA);
            PG8_WAIT_L(8); PG8_BAR; PG8_WAIT_L(0); PG8_MMA(0, 0, At, B0); PG8_BAR; PG8_SCHED;
            PG8_LDB(B1, 1, 1); PG8_STAGE(PG8_SB(1, 0), b3, voffB);
            PG8_BAR; PG8_WAIT_L(0); PG8_MMA(0, 1, At, B1); PG8_BAR;
            PG8_LDA(At, 1, 1); PG8_STAGE(PG8_SA(1, 0), a3, voffA);
            PG8_BAR; PG8_WAIT_L(0); PG8_MMA(1, 0, At, B0); PG8_BAR; PG8_SCHED;
            PG8_STAGE(PG8_SB(1, 1), b3 + hstep, voffB);
            PG8_WAIT_V(6); PG8_BAR; PG8_MMA(1, 1, At, B1); PG8_BAR;
            }
        }
        if constexpr (ALIGN_EPI) { if (wr == 0) PG8_BAR; }
        if constexpr (!Epi::AFTER_DRAIN) { E(acc, cur, wr, wc, fr, fq); S.done(cur); }
        if (!has_next) break;
#pragma unroll
        for (int a = 0; a < 2; ++a)
#pragma unroll
            for (int b = 0; b < 2; ++b)
#pragma unroll
                for (int m = 0; m < 4; ++m)
#pragma unroll
                    for (int n = 0; n < 2; ++n) acc[a][b][m][n] = (f32x4){0.f, 0.f, 0.f, 0.f};
        cur = nxt; cA = nA; cB = nB; ++ui;
        if constexpr (ALIGN_EPI) { if (wr == 1) PG8_BAR; }
    }
    PG8_WAIT_V(0);
    if constexpr (!ALIGN_EPI) { if (wr == 0) PG8_BAR; }
    PG8_BAR;
    if constexpr (Epi::AFTER_DRAIN) { E.fused(acc, cur, wr, wc, fr, fq, lds, wid, lane); S.done(cur); }
#undef PG8_SA
#undef PG8_SB
#undef PG8_STAGE
#undef PG8_LDA
#undef PG8_LDB
#undef PG8_MMA
#undef PG8_WAIT_V
#undef PG8_WAIT_L
#undef PG8_BAR
#undef PG8_SCHED
}
}
namespace cg = cooperative_groups;
#define LAS __attribute__((address_space(3)))
typedef unsigned short bf16;
typedef float f32x4 __attribute__((ext_vector_type(4)));
typedef float f32x8 __attribute__((ext_vector_type(8)));
typedef float f32x16 __attribute__((ext_vector_type(16)));
typedef unsigned u32x4 __attribute__((ext_vector_type(4)));
typedef unsigned u32x2 __attribute__((ext_vector_type(2)));
typedef short bf16x8 __attribute__((ext_vector_type(8)));
typedef short s16x4 __attribute__((ext_vector_type(4)));

constexpr int BATCH = 16, SEQ = 2048, DM = 1024, T = BATCH * SEQ;
constexpr int NP = 3072;
constexpr int IN_COLS = 3012;
constexpr int C_QA = 0, C_KA = 512, C_VA = 1024, C_QB = 1536, C_KV = 2560, C_QI = 2688, C_KI = 2944, C_WI = 3008;
constexpr int MIXW = 1536;
constexpr int NEXP = 16384;
constexpr float EPS = 1e-6f;
constexpr int NT = 512;
constexpr int NWV = 8;

constexpr size_t MiB = 1u << 20;
constexpr size_t WS_CTL = 0;
constexpr size_t CTL_BYTES = 64 * 1024;
constexpr size_t WS_MOD = 1 * MiB;
constexpr size_t WS_SCAL = WS_MOD + 512 * 1024;
constexpr size_t WS_QBIAS = WS_MOD + 400 * 1024;
constexpr size_t WS_WIN = 2 * MiB;
constexpr size_t WS_WO2 = 8 * MiB;
constexpr size_t WS_WQ = 11 * MiB;
constexpr size_t WS_SUBK = 13 * MiB;
constexpr size_t WS_U16 = 14 * MiB;
constexpr size_t WS_V16 = 46 * MiB;
constexpr size_t WS_H = 78 * MiB;
constexpr size_t WS_PROJ = 142 * MiB;
constexpr size_t WS_Q3 = WS_PROJ;
constexpr size_t WS_MIX = 334 * MiB;
constexpr size_t WS_EXP = 430 * MiB;
constexpr size_t WS_KVC = WS_EXP;
constexpr size_t WS_GATE = 446 * MiB;
constexpr size_t WS_ATMP = 462 * MiB;
constexpr size_t WS_CBUF = 494 * MiB;
constexpr size_t WS_SSQ = WS_ATMP;
constexpr size_t WS_ABUF1 = WS_MIX;
constexpr size_t WS_END = 510 * MiB;

struct Params {
    const float *x, *c, *ada_w, *ada_b, *norm1_g, *norm2_g, *w_in, *a_qk_gain, *a_lambda, *a_sub_gain, *b_q_gain, *b_kv_gain, *b_w_uv, *w_out, *peer_wq, *peer_subkeys, *peer_u, *peer_v;
    float* out; unsigned char* ws;
};

enum { SC_LAM = 0, SC_MA = 1, SC_MB = 2 };

__device__ __forceinline__ unsigned f2bf(float f) { unsigned u = __float_as_uint(f); return (u + 0x7fffu + ((u >> 16) & 1u)) >> 16; }
__device__ __forceinline__ float bf2f(unsigned h) { return __uint_as_float(h << 16); }
__device__ __forceinline__ unsigned pk2(float lo, float hi) { return f2bf(lo) | (f2bf(hi) << 16); }
__device__ __forceinline__ float bflo(unsigned w) { return __uint_as_float(w << 16); }
__device__ __forceinline__ float bfhi(unsigned w) { return __uint_as_float(w & 0xffff0000u); }
__device__ __forceinline__ float wave_sum(float v) {
#pragma unroll
    for (int o = 1; o < 64; o <<= 1) v += __shfl_xor(v, o);
    return v;
}
__device__ __forceinline__ float wave_max(float v) {
#pragma unroll
    for (int o = 1; o < 64; o <<= 1) v = fmaxf(v, __shfl_xor(v, o));
    return v;
}
#define LDS_WAIT() asm volatile("s_waitcnt lgkmcnt(0)" ::: "memory")
__device__ __forceinline__ void ph_mod(const Params& p, float* ldsf, int vb, int nvb) {
    if (vb >= 96) return;
    int tid = threadIdx.x; asm volatile("" : "+v"(tid));
    const int lane = tid & 63, wv = tid >> 6;
    for (int i = tid; i < 16 * 1024; i += NT) { const float v = p.c[i]; ldsf[i] = v / (1.f + __expf(-v)); }
    __syncthreads();
    float* MOD = (float*)(p.ws + WS_MOD); float* part = ldsf + 16 * 1024;
    for (int it = vb; it < 96; it += nvb) {
        const int j = it * 64 + lane;
        float acc[16];
#pragma unroll
        for (int b = 0; b < 16; ++b) acc[b] = 0.f;
        const float* wp = p.ada_w + (size_t)(128 * wv) * 6144 + j;
#pragma unroll 1
        for (int k0 = 0; k0 < 128; k0 += 8) {
            float w[8];
#pragma unroll
            for (int u = 0; u < 8; ++u) w[u] = wp[(size_t)(k0 + u) * 6144];
#pragma unroll
            for (int u = 0; u < 8; ++u)
#pragma unroll
                for (int b = 0; b < 16; ++b) acc[b] = fmaf(ldsf[b * 1024 + 128 * wv + k0 + u], w[u], acc[b]);
        }
#pragma unroll
        for (int b = 0; b < 16; ++b) part[(wv * 16 + b) * 64 + lane] = acc[b];
        __syncthreads();
        for (int o = tid; o < 16 * 64; o += NT) { const int b = o >> 6, c = o & 63; float s = 0.f;
#pragma unroll
            for (int w = 0; w < 8; ++w) s += part[(w * 16 + b) * 64 + c];
            MOD[b * 6144 + it * 64 + c] = s + p.ada_b[it * 64 + c]; }
        __syncthreads();
    }
}

__device__ __forceinline__ void transpose_item(const float* W, int N, bf16* WT, int ldt, LAS float* scr, int kb, int nb, int lane) {
    const int k0 = 64 * kb, n0 = 32 * nb;
#pragma unroll 8
    for (int i = 0; i < 32; ++i) { const int kk = 2 * i + (lane >> 5); const int n = n0 + (lane & 31); scr[kk * 33 + (lane & 31)] = (n < N) ? W[(size_t)(k0 + kk) * N + n] : 0.f; }
    LDS_WAIT(); asm volatile("" ::: "memory");
    const int c = lane & 7;
#pragma unroll
    for (int j = 0; j < 4; ++j) { const int n = (lane >> 3) + 8 * j; const LAS float* s = scr + (8 * c) * 33 + n;
        u32x4 o; o.x = pk2(s[0 * 33], s[1 * 33]); o.y = pk2(s[2 * 33], s[3 * 33]); o.z = pk2(s[4 * 33], s[5 * 33]); o.w = pk2(s[6 * 33], s[7 * 33]);
        *(u32x4*)(WT + (size_t)(n0 + n) * ldt + k0 + 8 * c) = o; }
    LDS_WAIT(); asm volatile("" ::: "memory");
}

__device__ __forceinline__ void ph_prep_weights(const Params& p, LAS float* scr, int gw, int ngw, int lane) {
    bf16* WIN = (bf16*)(p.ws + WS_WIN); bf16* WO2 = (bf16*)(p.ws + WS_WO2); bf16* WQ = (bf16*)(p.ws + WS_WQ);
    constexpr int I_IN = 16 * 96, I_O = 8 * 32, I_Q = 16 * 32;
    for (int it = gw; it < I_IN + I_O + I_Q; it += ngw) {
        int r = it;
        if (r < I_IN) { transpose_item(p.w_in, IN_COLS, WIN, 1024, scr, r / 96, r % 96, lane); continue; } r -= I_IN;
        if (r < I_O) { transpose_item(p.w_out, 1024, WO2, MIXW, scr, r / 32, r % 32, lane); continue; } r -= I_O;
        transpose_item(p.peer_wq, 1024, WQ, 1024, scr, r / 32, r % 32, lane);
    }
    const size_t gt = (size_t)gw * 64 + lane, ngt = (size_t)ngw * 64;
    for (size_t i = gt; i < (size_t)1024 * 1024; i += ngt) {
        const int n = (int)(i & 1023), kk = (int)(i >> 10), h = kk >> 7;
        const float* wu = p.b_w_uv + (size_t)kk * 64; const float* wo = p.w_out + (size_t)(512 + 64 * h) * 1024 + n;
        float a = 0.f;
#pragma unroll 8
        for (int e = 0; e < 64; ++e) a = fmaf(wu[e], wo[(size_t)e * 1024], a);
        WO2[(size_t)n * MIXW + 512 + kk] = (bf16)f2bf(a);
    }
    bf16* SUBK = (bf16*)(p.ws + WS_SUBK);
    constexpr size_t NSUB8 = 2 * 128 * 64 / 8;
    for (size_t j = gt; j < NSUB8; j += ngt) {
        const f32x8 v = *(const f32x8*)(p.peer_subkeys + j * 8);
        u32x4 o; o.x = pk2(v[0], v[1]); o.y = pk2(v[2], v[3]); o.z = pk2(v[4], v[5]); o.w = pk2(v[6], v[7]);
        *(u32x4*)(SUBK + j * 8) = o;
    }
    if (gt == 0) {
        float* SC = (float*)(p.ws + WS_SCAL);
        float s01 = 0.f, s23 = 0.f;
        for (int i = 0; i < 64; ++i) { s01 += p.a_lambda[i] * p.a_lambda[64 + i]; s23 += p.a_lambda[128 + i] * p.a_lambda[192 + i]; }
        SC[SC_LAM] = __expf(s01) - __expf(s23) + 0.2f;
        float g0 = 0.f, g1 = 0.f, gq = 0.f, gk = 0.f;
        for (int i = 0; i < 64; ++i) { g0 = fmaxf(g0, fabsf(p.a_qk_gain[i])); g1 = fmaxf(g1, fabsf(p.a_qk_gain[64 + i])); }
        for (int i = 0; i < 128; ++i) { gq = fmaxf(gq, fabsf(p.b_q_gain[i])); gk = fmaxf(gk, fabsf(p.b_kv_gain[i])); }
        SC[SC_MA] = 8.0f * g0 * g1 * 1.02f;
        SC[SC_MB] = 11.3137085f * gq * gk * 1.02f;
    }
}

__device__ __forceinline__ void ph_hrows(const Params& p, const float* X, const float* g, int shOff, int scOff, int gw, int ngw, int lane) {
    const float* MOD = (const float*)(p.ws + WS_MOD); bf16* H = (bf16*)(p.ws + WS_H);
    for (int m = gw; m < T; m += ngw) {
        const f32x4* xr = (const f32x4*)(X + (size_t)m * 1024) + lane;
        f32x4 v[4]; float s = 0.f;
#pragma unroll
        for (int j = 0; j < 4; ++j) { v[j] = xr[64 * j]; s += (v[j].x * v[j].x + v[j].y * v[j].y) + (v[j].z * v[j].z + v[j].w * v[j].w); }
        const float rstd = rsqrtf(wave_sum(s) * (1.f / 1024.f) + EPS);
        const float* mb = MOD + (size_t)(m >> 11) * 6144;
#pragma unroll
        for (int j = 0; j < 4; ++j) {
            const int col = 4 * (lane + 64 * j);
            const f32x4 gg = *(const f32x4*)(g + col), sc = *(const f32x4*)(mb + scOff + col), sh = *(const f32x4*)(mb + shOff + col);
            const f32x4 y = v[j] * rstd * gg * (sc + 1.0f) + sh;
            u32x2 o; o.x = pk2(y.x, y.y); o.y = pk2(y.z, y.w);
            *(u32x2*)(H + (size_t)m * 1024 + col) = o;
        }
    }
}

__device__ __forceinline__ void ph_norm_proj(const Params& p, int gw, int ngw, int lane) {
    bf16* PROJ = (bf16*)(p.ws + WS_PROJ);
    for (int m = gw; m < T; m += ngw) {
        bf16* row = PROJ + (size_t)m * NP;
#pragma unroll
        for (int j = 0; j < 6; ++j) {
            if (j == 2) continue;
            const int col = 8 * lane + 512 * j;
            const u32x4 raw = *(const u32x4*)(row + col);
            float v[8] = {bflo(raw.x), bfhi(raw.x), bflo(raw.y), bfhi(raw.y), bflo(raw.z), bfhi(raw.z), bflo(raw.w), bfhi(raw.w)};
            float ss = 0.f;
#pragma unroll
            for (int i = 0; i < 8; ++i) ss += v[i] * v[i];
            ss += __shfl_xor(ss, 1); ss += __shfl_xor(ss, 2); ss += __shfl_xor(ss, 4);
            float rstd; const float* gp;
            if (j < 2) { rstd = rsqrtf(ss * (1.f / 64.f) + EPS); gp = p.a_qk_gain + 64 * j + (col & 63); }
            else { ss += __shfl_xor(ss, 8); rstd = rsqrtf(ss * (1.f / 128.f) + EPS); gp = (j == 5 ? p.b_kv_gain : p.b_q_gain) + (col & 127); }
            if (j == 5 && lane >= 16) continue;
            const f32x4 g0 = *(const f32x4*)gp, g1 = *(const f32x4*)(gp + 4);
            u32x4 o; o.x = pk2(v[0] * rstd * g0.x, v[1] * rstd * g0.y); o.y = pk2(v[2] * rstd * g0.z, v[3] * rstd * g0.w);
            o.z = pk2(v[4] * rstd * g1.x, v[5] * rstd * g1.y); o.w = pk2(v[6] * rstd * g1.z, v[7] * rstd * g1.w);
            *(u32x4*)(row + col) = o;
        }
    }
}
struct EpiResGate {
    static constexpr bool PERM = false, AFTER_DRAIN = false;
    const float* X; float* Out; const float* gate;
    __device__ __forceinline__ void operator()(const pg8::f32x4 (&acc)[2][2][4][2], const pg8::Unit& u, int wr, int wc, int fr, int fq) const {
        const int col0 = u.pn * 256 + wc * 32 + 4 * fq;
#pragma unroll
        for (int ai = 0; ai < 2; ++ai)
#pragma unroll
            for (int m = 0; m < 4; ++m) {
                const int r = u.pm * 256 + ai * 128 + wr * 64 + m * 16 + fr; const float* gb = gate + (size_t)(r >> 11) * 6144;
#pragma unroll
                for (int bj = 0; bj < 2; ++bj)
#pragma unroll
                    for (int n = 0; n < 2; ++n) { const int c = col0 + bj * 128 + n * 16; const size_t off = (size_t)r * 1024 + c;
                        const pg8::f32x4 xv = *(const pg8::f32x4*)(X + off), gv = *(const pg8::f32x4*)(gb + c);
                        *(pg8::f32x4*)(Out + off) = xv + gv * acc[ai][bj][m][n]; }
            }
    }
};


struct EpiResGateA2 {
    static constexpr bool PERM = true, AFTER_DRAIN = false;
    const float* X; float* Out; const float* MODp; const float* g2; bf16* A2; float* SSQ;
    __device__ __forceinline__ void operator()(const pg8::f32x4 (&acc)[2][2][4][2], const pg8::Unit& u, int wr, int wc, int fr, int fq) const {
        const int row0 = u.pm * 256 + wr * 64 + fr, col0 = u.pn * 256 + wc * 32 + 8 * fq;
        const float* mb = MODp + (size_t)((u.pm * 256) >> 11) * 6144;
        pg8::f32x4 gt[2][2], gm[2][2];
#pragma unroll
        for (int bj = 0; bj < 2; ++bj)
#pragma unroll
            for (int n = 0; n < 2; ++n) { const int c = col0 + bj * 128 + 4 * n; gt[bj][n] = *(const pg8::f32x4*)(mb + 2048 + c);
                const pg8::f32x4 gg = *(const pg8::f32x4*)(g2 + c), sc = *(const pg8::f32x4*)(mb + 4096 + c); gm[bj][n] = gg * (sc + 1.0f); }
#pragma unroll
        for (int ai = 0; ai < 2; ++ai)
#pragma unroll
            for (int m = 0; m < 4; ++m) { const int r = row0 + ai * 128 + m * 16; float ss = 0.f;
#pragma unroll
                for (int bj = 0; bj < 2; ++bj) { const size_t off = (size_t)r * 1024 + col0 + bj * 128;
                    const pg8::f32x4 v0 = *(const pg8::f32x4*)(X + off) + gt[bj][0] * acc[ai][bj][m][0], v1 = *(const pg8::f32x4*)(X + off + 4) + gt[bj][1] * acc[ai][bj][m][1];
                    *(pg8::f32x4*)(Out + off) = v0; *(pg8::f32x4*)(Out + off + 4) = v1;
                    ss += ((v0[0] * v0[0] + v0[1] * v0[1]) + (v0[2] * v0[2] + v0[3] * v0[3])) + ((v1[0] * v1[0] + v1[1] * v1[1]) + (v1[2] * v1[2] + v1[3] * v1[3]));
                    const pg8::f32x4 a0 = v0 * gm[bj][0], a1 = v1 * gm[bj][1];
                    pg8::u32x4 w; w.x = pg8::cvt_pk_bf16(a0[0], a0[1]); w.y = pg8::cvt_pk_bf16(a0[2], a0[3]); w.z = pg8::cvt_pk_bf16(a1[0], a1[1]); w.w = pg8::cvt_pk_bf16(a1[2], a1[3]);
                    *(pg8::u32x4*)(A2 + off) = w; }
                ss += __shfl_xor(ss, 16); ss += __shfl_xor(ss, 32);
                if (fq == 0) SSQ[(size_t)r * 16 + u.pn * 4 + wc] = ss; }
    }
};

struct EpiQ3 {
    static constexpr bool PERM = true, AFTER_DRAIN = false;
    const float* SSQ; const float* BIAS; bf16* O;
    __device__ __forceinline__ void operator()(const pg8::f32x4 (&acc)[2][2][4][2], const pg8::Unit& u, int wr, int wc, int fr, int fq) const {
        const int row0 = u.pm * 256 + wr * 64 + fr, col0 = u.pn * 256 + wc * 32 + 8 * fq;
        const float* bb = BIAS + (size_t)((u.pm * 256) >> 11) * 1024 + col0;
        pg8::f32x4 bv[2][2];
#pragma unroll
        for (int bj = 0; bj < 2; ++bj)
#pragma unroll
            for (int n = 0; n < 2; ++n) bv[bj][n] = *(const pg8::f32x4*)(bb + bj * 128 + 4 * n);
#pragma unroll
        for (int ai = 0; ai < 2; ++ai)
#pragma unroll
            for (int m = 0; m < 4; ++m) { const int r = row0 + ai * 128 + m * 16; const pg8::f32x4 s4 = *((const pg8::f32x4*)(SSQ + (size_t)r * 16) + fq);
                float s_ = (s4[0] + s4[1]) + (s4[2] + s4[3]); s_ += __shfl_xor(s_, 16); s_ += __shfl_xor(s_, 32); const float rs = rsqrtf(s_ * (1.f / 1024.f) + EPS);
#pragma unroll
                for (int bj = 0; bj < 2; ++bj) { const pg8::f32x4 v0 = acc[ai][bj][m][0] * rs + bv[bj][0], v1 = acc[ai][bj][m][1] * rs + bv[bj][1];
                    pg8::u32x4 w; w.x = pg8::cvt_pk_bf16(v0[0], v0[1]); w.y = pg8::cvt_pk_bf16(v0[2], v0[3]); w.z = pg8::cvt_pk_bf16(v1[0], v1[1]); w.w = pg8::cvt_pk_bf16(v1[2], v1[3]);
                    *(pg8::u32x4*)(O + (size_t)r * 1024 + col0 + bj * 128) = w; } }
    }
};

__device__ __forceinline__ void ph_q3bias(const Params& p, int gw, int lane) {
    if (gw >= 64) return;
    const float* MOD = (const float*)(p.ws + WS_MOD); const bf16* WQ = (const bf16*)(p.ws + WS_WQ); float* BIAS = (float*)(p.ws + WS_QBIAS);
    const int l15 = lane & 15, g = lane >> 4, n0 = gw * 16;
    const float* ar = MOD + (size_t)l15 * 6144 + 3072 + 8 * g; const bf16* br = WQ + (size_t)(n0 + l15) * 1024 + 8 * g;
    f32x4 a = {0.f, 0.f, 0.f, 0.f};
#pragma unroll 4
    for (int ks = 0; ks < 32; ++ks) {
        const f32x4 s0 = *(const f32x4*)(ar + 32 * ks), s1 = *(const f32x4*)(ar + 32 * ks + 4);
        u32x4 aw; aw.x = pk2(s0[0], s0[1]); aw.y = pk2(s0[2], s0[3]); aw.z = pk2(s1[0], s1[1]); aw.w = pk2(s1[2], s1[3]);
        bf16x8 av; __builtin_memcpy(&av, &aw, 16);
        const bf16x8 bvv = *(const bf16x8*)(br + 32 * ks);
        a = __builtin_amdgcn_mfma_f32_16x16x32_bf16(av, bvv, a, 0, 0, 0);
    }
#pragma unroll
    for (int r = 0; r < 4; ++r) BIAS[(size_t)(4 * g + r) * 1024 + n0 + l15] = a[r];
}


struct EpiNormBf16 {
    static constexpr bool PERM = true, AFTER_DRAIN = false;
    bf16* O; const float* gqk; const float* gbq; const float* gbkv; LAS float* P; bf16* KVC;
    __device__ __forceinline__ void operator()(const pg8::f32x4 (&acc)[2][2][4][2], const pg8::Unit& u, int wr, int wc, int fr, int fq) const {
        const int pn = u.pn;
        const int mode = pn < 4 ? 1 : ((pn == 4 || pn == 5 || pn == 11) ? 0 : (pn == 10 ? 3 : 2));
        if (mode != 0) {
#pragma unroll
            for (int ai = 0; ai < 2; ++ai)
#pragma unroll
                for (int m = 0; m < 4; ++m)
#pragma unroll
                    for (int bj = 0; bj < 2; ++bj) {
                        const pg8::f32x4 a = acc[ai][bj][m][0], b = acc[ai][bj][m][1];
                        float ss = (a[0] * a[0] + a[1] * a[1]) + (a[2] * a[2] + a[3] * a[3]) + (b[0] * b[0] + b[1] * b[1]) + (b[2] * b[2] + b[3] * b[3]);
                        ss += __shfl_xor(ss, 16); ss += __shfl_xor(ss, 32);
                        if (fq == 0) P[(ai * 128 + wr * 64 + m * 16 + fr) * 8 + bj * 4 + wc] = ss;
                    }
            asm volatile("s_waitcnt lgkmcnt(0)" ::: "memory"); __builtin_amdgcn_s_barrier(); asm volatile("" ::: "memory");
        }
        const int row0 = u.pm * 256 + wr * 64 + fr, col0 = u.pn * 256 + wc * 32 + 8 * fq;
        pg8::f32x4 g0[2], g1[2];
#pragma unroll
        for (int bj = 0; bj < 2; ++bj) {
            const float* gp = nullptr;
            if (mode == 1) gp = gqk + (pn >= 2 ? 64 : 0) + 32 * (wc & 1) + 8 * fq;
            else if (mode == 2) gp = gbq + 32 * wc + 8 * fq;
            else if (mode == 3 && bj == 0) gp = gbkv + 32 * wc + 8 * fq;
            if (gp) { g0[bj] = *(const pg8::f32x4*)gp; g1[bj] = *(const pg8::f32x4*)(gp + 4); } else { g0[bj] = (pg8::f32x4){1.f, 1.f, 1.f, 1.f}; g1[bj] = g0[bj]; }
        }
#pragma unroll
        for (int ai = 0; ai < 2; ++ai)
#pragma unroll
            for (int m = 0; m < 4; ++m) { bf16* rowp = O + (size_t)(row0 + ai * 128 + m * 16) * NP + col0;
#pragma unroll
                for (int bj = 0; bj < 2; ++bj) {
                    float s = 1.f;
                    if (mode != 0 && !(mode == 3 && bj == 1)) {
                        const pg8::f32x4 q = *(const LAS pg8::f32x4*)(P + (ai * 128 + wr * 64 + m * 16 + fr) * 8 + bj * 4);
                        s = (mode == 1) ? rsqrtf(((wc < 2) ? (q[0] + q[1]) : (q[2] + q[3])) * (1.f / 64.f) + EPS) : rsqrtf(((q[0] + q[1]) + (q[2] + q[3])) * (1.f / 128.f) + EPS);
                    }
                    const pg8::f32x4 v0 = acc[ai][bj][m][0] * s * g0[bj], v1 = acc[ai][bj][m][1] * s * g1[bj];
                    pg8::u32x4 w; w.x = pg8::cvt_pk_bf16(v0[0], v0[1]); w.y = pg8::cvt_pk_bf16(v0[2], v0[3]); w.z = pg8::cvt_pk_bf16(v1[0], v1[1]); w.w = pg8::cvt_pk_bf16(v1[2], v1[3]);
                    if (pn == 10 && bj == 0) *(pg8::u32x4*)(KVC + (size_t)(row0 + ai * 128 + m * 16) * 128 + wc * 32 + 8 * fq) = w;
                    else *(pg8::u32x4*)(rowp + bj * 128) = w; } }
    }
};
typedef __bf16 bf16x2_t __attribute__((ext_vector_type(2)));
__device__ __forceinline__ float dot2bf(unsigned a, unsigned b, float acc) { return __builtin_amdgcn_fdot2_f32_bf16(__builtin_bit_cast(bf16x2_t, a), __builtin_bit_cast(bf16x2_t, b), acc, false); }
template <int CTRL> __device__ __forceinline__ float dpp_f(float v) { return __int_as_float(__builtin_amdgcn_update_dpp(0, __float_as_int(v), CTRL, 0xf, 0xf, false)); }
__device__ __forceinline__ float row16_sum(float v) {
    v += dpp_f<0x128>(v); v += dpp_f<0x124>(v); v += dpp_f<0x122>(v); v += dpp_f<0x121>(v); return v;
}
__device__ __forceinline__ float gelu_erf(float v) {
    const float av = fabsf(v), t = __builtin_amdgcn_rcpf(fmaf(av, 0.2316418882f, 1.0f));
    float q = fmaf(t, 0.5307027145f, -0.7265760135f); q = fmaf(q, t, 0.7107068705f); q = fmaf(q, t, -0.142248368f); q = fmaf(q, t, 0.127414796f); q = q * t;
    const float e = __builtin_amdgcn_exp2f(v * v * -0.72134752044f);
    const float m = v * (q * e);
    return v < 0.f ? m : v - m;
}

#ifndef DSA_PB
#define DSA_PB 0
#endif
typedef short v4i16_t __attribute__((ext_vector_type(4)));
#ifndef DSA_REP_A
#define DSA_REP_A 1
#endif
#ifndef DSA_REP_B
#define DSA_REP_B 1
#endif
#ifndef DSA_REP_C
#define DSA_REP_C 1
#endif
constexpr int DSA_SROW = 2048 * 4 + 16;
constexpr int DSA_SEL_OFF = 16 * DSA_SROW;
constexpr int DSA_LDS = DSA_SEL_OFF + 16 * 512;
constexpr int DSA_KVROW = 272;

__device__ __forceinline__ unsigned sortkey(float s) { const unsigned u = __float_as_uint(s); return u ^ ((u >> 31) ? 0xffffffffu : 0x80000000u); }
__device__ __forceinline__ unsigned cvtpk_bf16(float lo, float hi) { unsigned r; asm volatile("v_cvt_pk_bf16_f32 %0, %1, %2" : "=v"(r) : "v"(lo), "v"(hi)); return r; }

__device__ __forceinline__ void cnt_ge4(int& acc, unsigned k0, unsigned k1, unsigned k2, unsigned k3, unsigned cand) {
    asm volatile("v_cmp_ge_u32_e64 s[40:41], %1, %5\n\t"
                 "v_cmp_ge_u32_e64 s[42:43], %2, %5\n\t"
                 "v_cmp_ge_u32_e64 s[44:45], %3, %5\n\t"
                 "v_cmp_ge_u32_e64 s[46:47], %4, %5\n\t"
                 "v_addc_co_u32_e64 %0, s[48:49], %0, 0, s[40:41]\n\t"
                 "v_addc_co_u32_e64 %0, s[48:49], %0, 0, s[42:43]\n\t"
                 "v_addc_co_u32_e64 %0, s[48:49], %0, 0, s[44:45]\n\t"
                 "v_addc_co_u32_e64 %0, s[48:49], %0, 0, s[46:47]"
                 : "+v"(acc) : "v"(k0), "v"(k1), "v"(k2), "v"(k3), "v"(cand)
                 : "s40", "s41", "s42", "s43", "s44", "s45", "s46", "s47", "s48", "s49");
}
__device__ __forceinline__ void ph_dsa(const Params& p, unsigned char* lds, int vb, int nvb) {
    const bf16* PROJ = (const bf16*)(p.ws + WS_PROJ); bf16* MIX = (bf16*)(p.ws + WS_MIX);
    const float MB = ((const float*)(p.ws + WS_SCAL))[SC_MB];
    int tid = threadIdx.x; asm volatile("" : "+v"(tid)); const int lane = tid & 63, wv = __builtin_amdgcn_readfirstlane(tid >> 6);
    const int l15 = lane & 15, g = lane >> 4;
    LAS unsigned char* ldsl = (LAS unsigned char*)lds;
    for (int it = vb; it < 2048; it += nvb) {
        const int vbb = it & 255, kk = it >> 8, xg = vbb & 7, ix = vbb >> 3, b = 2 * xg + (ix & 1), G = (ix >> 1) & 3, sub = ix >> 3;
        const int c = (kk & 1) ? (31 - G - 8 * (kk >> 1)) : (G + 8 * (kk >> 1));
        const int cend = (c + 1) * 64, t0 = c * 64 + sub * 16;
        const bf16* Pb = PROJ + (size_t)b * SEQ * NP;
        const bf16* KVb = (const bf16*)(p.ws + WS_KVC) + (size_t)b * SEQ * 128;
#pragma unroll 1
        for (int repa = 0; repa < DSA_REP_A; ++repa)
        if (c >= 4) {
            const bf16* qrow = Pb + (size_t)(t0 + l15) * NP;
            bf16x8 bq[4][2]; float wsc[4];
#pragma unroll
            for (int h = 0; h < 4; ++h) { wsc[h] = bf2f(qrow[C_WI + h]) * 0.0625f;
#pragma unroll
                for (int ks = 0; ks < 2; ++ks) bq[h][ks] = *(const bf16x8*)(qrow + C_QI + h * 64 + 32 * ks + 8 * g); }
            for (int k0 = 16 * wv; k0 < cend; k0 += 128) {
                const bf16* krow = Pb + (size_t)(k0 + l15) * NP + C_KI + 8 * g;
                const bf16x8 ka0 = *(const bf16x8*)krow, ka1 = *(const bf16x8*)(krow + 32);
                f32x4 sc = {0.f, 0.f, 0.f, 0.f};
#pragma unroll
                for (int h = 0; h < 4; ++h) { f32x4 a = {0.f, 0.f, 0.f, 0.f};
                    a = __builtin_amdgcn_mfma_f32_16x16x32_bf16(ka0, bq[h][0], a, 0, 0, 0);
                    a = __builtin_amdgcn_mfma_f32_16x16x32_bf16(ka1, bq[h][1], a, 0, 0, 0);
#pragma unroll
                    for (int r = 0; r < 4; ++r) sc[r] = fmaf(fmaxf(a[r], 0.f), wsc[h], sc[r]); }
#pragma unroll
                for (int r = 0; r < 4; ++r) sc[r] = (sc[r] == 0.f) ? 0.f : sc[r];
                *(LAS f32x4*)(ldsl + l15 * DSA_SROW + (k0 + 4 * g) * 4) = sc;
            }
        }
        __syncthreads();
        LAS unsigned short* selw = (LAS unsigned short*)(ldsl + DSA_SEL_OFF);
        int mind0 = 0, mind1 = 0;
        if (c < 4) {
            for (int j = lane; j < 256; j += 64) { selw[(2 * wv) * 256 + j] = (unsigned short)j; selw[(2 * wv + 1) * 256 + j] = (unsigned short)j; }
        } else {
            const int nreg = cend >> 6;
            unsigned keyA[32], keyB[32];
            { const LAS float* srA = (const LAS float*)(ldsl + (2 * wv) * DSA_SROW) + lane; const LAS float* srB = (const LAS float*)(ldsl + (2 * wv + 1) * DSA_SROW) + lane;
#pragma unroll
              for (int i = 0; i < 32; ++i) { keyA[i] = (i < nreg) ? sortkey(srA[64 * i]) : 0u; keyB[i] = (i < nreg) ? sortkey(srB[64 * i]) : 0u; } }
#define DSA_WSUM(V, OUT) do { int v_ = (V); v_ += __builtin_amdgcn_update_dpp(0, v_, 0x128, 0xf, 0xf, false); v_ += __builtin_amdgcn_update_dpp(0, v_, 0x124, 0xf, 0xf, false); \
        v_ += __builtin_amdgcn_update_dpp(0, v_, 0x122, 0xf, 0xf, false); v_ += __builtin_amdgcn_update_dpp(0, v_, 0x121, 0xf, 0xf, false);                                     \
        OUT = __builtin_amdgcn_readlane(v_, 0) + __builtin_amdgcn_readlane(v_, 16) + __builtin_amdgcn_readlane(v_, 32) + __builtin_amdgcn_readlane(v_, 48); } while (0)
            unsigned prefA = 0u, prefB = 0u; bool exA = false, exB = false;
#pragma unroll 1
            for (int bit = 31; bit >= 0; --bit) {
                const unsigned candA = exA ? prefA : (prefA | (1u << bit)), candB = exB ? prefB : (prefB | (1u << bit));
                int ca = 0, cb = 0;
#pragma unroll
                for (int i = 0; i < 32; i += 4) { cnt_ge4(ca, keyA[i], keyA[i + 1], keyA[i + 2], keyA[i + 3], candA); cnt_ge4(cb, keyB[i], keyB[i + 1], keyB[i + 2], keyB[i + 3], candB); }
                int cntA, cntB; DSA_WSUM(ca, cntA); DSA_WSUM(cb, cntB);
                if (!exA && cntA >= 256) { prefA = candA; exA = (cntA == 256); }
                if (!exB && cntB >= 256) { prefB = candB; exB = (cntB == 256); }
                if (exA && exB) break;
            }
#define DSA_COMPACT(KEY, PREFIX, EXACT, QQ, MIND) do {                                                                                              \
            const int t_ = t0 + (QQ); LAS unsigned short* sel = selw + (QQ) * 256;                                                                    \
            int need_ties = 0;                                                                                                                        \
            if (!(EXACT)) { int cg_ = 0; if ((PREFIX) != 0xffffffffu) { _Pragma("unroll") for (int i = 0; i < 32; ++i) cg_ += (KEY[i] > (PREFIX)) ? 1 : 0; } \
                int cgt; DSA_WSUM(cg_, cgt); need_ties = 256 - cgt; }                                                                                 \
            int base = 0, tbase = 0, md = 4096;                                                                                                       \
            _Pragma("unroll") for (int i = 0; i < 32; ++i) { if (i < nreg) {                                                                          \
                bool selb;                                                                                                                            \
                if (EXACT) selb = KEY[i] >= (PREFIX);                                                                                                 \
                else { const bool tie = KEY[i] == (PREFIX); const unsigned long long mt = __ballot(tie);                                              \
                    const int trank = tbase + (int)__builtin_amdgcn_mbcnt_hi((unsigned)(mt >> 32), __builtin_amdgcn_mbcnt_lo((unsigned)mt, 0u));      \
                    selb = (KEY[i] > (PREFIX)) || (tie && trank < need_ties); tbase += __popcll(mt); }                                                \
                const unsigned long long m = __ballot(selb);                                                                                          \
                const int pos = base + (int)__builtin_amdgcn_mbcnt_hi((unsigned)(m >> 32), __builtin_amdgcn_mbcnt_lo((unsigned)m, 0u));               \
                const int kidx = i * 64 + lane;                                                                                                       \
                if (selb) { sel[pos] = (unsigned short)kidx; const int d = t_ > kidx ? t_ - kidx : kidx - t_; md = d < md ? d : md; }                 \
                base += __popcll(m); } }                                                                                                              \
            _Pragma("unroll") for (int o = 1; o < 64; o <<= 1) { const int x = __shfl_xor(md, o); md = x < md ? x : md; }                             \
            MIND = md; } while (0)
            DSA_COMPACT(keyA, prefA, exA, 2 * wv, mind0);
            DSA_COMPACT(keyB, prefB, exB, 2 * wv + 1, mind1);
#undef DSA_COMPACT
#undef DSA_WSUM
        }
        LDS_WAIT(); asm volatile("" ::: "memory");
        const int nvalid = cend < 256 ? cend : 256;
        const int head = lane & 7;
        const float slopeL2 = exp2f(-(float)(head + 1)) * 1.4426950409f;
#pragma unroll 1
        for (int qi2 = 0; qi2 < 2 * DSA_REP_C; ++qi2) { const int qi = qi2 & 1;
            const int qq = 2 * wv + qi, t = t0 + qq;
            const LAS unsigned short* sel = selw + qq * 256;
            const bf16* qrow = Pb + (size_t)t * NP + C_QB + head * 128 + 8 * g;
            bf16x8 bq[4];
#pragma unroll
            for (int ks = 0; ks < 4; ++ks) bq[ks] = *(const bf16x8*)(qrow + 32 * ks);
            const float refL2 = MB * 1.4426950409f - slopeL2 * (float)(qi == 0 ? mind0 : mind1);
            f32x4 o[8];
#pragma unroll
            for (int dt = 0; dt < 8; ++dt) o[dt] = (f32x4){0.f, 0.f, 0.f, 0.f};
            float lsum = 0.f;
#define DSA_GATHER(S, BUF) do { _Pragma("unroll") for (int i_ = 0; i_ < 8; ++i_) { const int jr = 32 * (S) + 4 * i_ + g; const int keyr = sel[jr < nvalid ? jr : 0];   \
        __builtin_amdgcn_global_load_lds((const unsigned*)(KVb + (size_t)keyr * 128 + 8 * (l15 ^ ((4 * i_ + g) & 15))), (unsigned*)((BUF) + 1024 * i_), 16, 0, 0); } } while (0)
#define DSA_COMPUTE(S, BUF) do { unsigned pb[4]; const LAS unsigned char* stg = (const LAS unsigned char*)(BUF);                                          \
        _Pragma("unroll") for (int tl = 0; tl < 2; ++tl) { const int j0 = 32 * (S) + 16 * tl;                                                           \
            f32x4 a = {0.f, 0.f, 0.f, 0.f};                                                                                                             \
            _Pragma("unroll") for (int ks = 0; ks < 4; ++ks) { const bf16x8 ka_ = *(const LAS bf16x8*)(stg + (16 * tl + l15) * 256 + (((4 * ks + g) ^ l15) << 4)); \
                a = __builtin_amdgcn_mfma_f32_16x16x32_bf16(ka_, bq[ks], a, 0, 0, 0); }                                                                 \
            const u32x2 kw = *(const LAS u32x2*)(sel + j0 + 4 * g);                                                                                     \
            const int kx[4] = {(int)(kw.x & 0xffffu), (int)(kw.x >> 16), (int)(kw.y & 0xffffu), (int)(kw.y >> 16)};                                     \
            float pr[4];                                                                                                                                \
            _Pragma("unroll") for (int r = 0; r < 4; ++r) { const int dd = t > kx[r] ? t - kx[r] : kx[r] - t;                                            \
                const float e = __builtin_amdgcn_exp2f(fmaf(a[r], 0.1275174f, -slopeL2 * (float)dd - refL2));                                            \
                pr[r] = (j0 + 4 * g + r < nvalid) ? e : 0.f; lsum += pr[r]; }                                                                           \
            pb[2 * tl] = cvtpk_bf16(pr[0], pr[1]); pb[2 * tl + 1] = cvtpk_bf16(pr[2], pr[3]); }                                                         \
        u32x4 pw4; pw4.x = pb[0]; pw4.y = pb[1]; pw4.z = pb[2]; pw4.w = pb[3];                                                                          \
        const bf16x8 pfrag = __builtin_bit_cast(bf16x8, pw4);                                                                                           \
        const int rr_ = 4 * g + (l15 >> 2);                                                                                                             \
        _Pragma("unroll") for (int dt = 0; dt < 8; ++dt) {                                                                                              \
            const LAS unsigned char* trp = stg + rr_ * 256 + (((2 * dt + ((lane & 3) >> 1)) ^ rr_) << 4) + 8 * (lane & 1);                                \
            const s16x4 lo = __builtin_bit_cast(s16x4, __builtin_amdgcn_ds_read_tr16_b64_v4i16((LAS v4i16_t*)trp));                                    \
            const s16x4 hi = __builtin_bit_cast(s16x4, __builtin_amdgcn_ds_read_tr16_b64_v4i16((LAS v4i16_t*)(trp + 16 * 256)));                        \
            const bf16x8 af = {lo[0], lo[1], lo[2], lo[3], hi[0], hi[1], hi[2], hi[3]};                                                                 \
            o[dt] = __builtin_amdgcn_mfma_f32_16x16x32_bf16(af, pfrag, o[dt], 0, 0, 0); }                                                               \
        LDS_WAIT(); asm volatile("" ::: "memory"); } while (0)
            const int nch = (nvalid + 31) >> 5;
            unsigned char* buf0 = lds + (2 * wv) * DSA_SROW; unsigned char* buf1 = buf0 + 8192;
            DSA_GATHER(0, buf0);
#pragma unroll 1
            for (int s = 0; s < nch; s += 2) {
                if (s + 1 < nch) DSA_GATHER(s + 1, buf1);
                if (s + 1 < nch) asm volatile("s_waitcnt vmcnt(8)" ::: "memory"); else asm volatile("s_waitcnt vmcnt(0)" ::: "memory");
                DSA_COMPUTE(s, buf0);
                if (s + 1 < nch) { if (s + 2 < nch) DSA_GATHER(s + 2, buf0);
                    if (s + 2 < nch) asm volatile("s_waitcnt vmcnt(8)" ::: "memory"); else asm volatile("s_waitcnt vmcnt(0)" ::: "memory");
                    DSA_COMPUTE(s + 1, buf1); }
            }
#undef DSA_GATHER
#undef DSA_COMPUTE
            lsum += __shfl_xor(lsum, 16); lsum += __shfl_xor(lsum, 32);
            const float il = 1.f / lsum;
            if (l15 < 8) {
                bf16* orow = MIX + (size_t)(b * SEQ + t) * MIXW + 512 + head * 128 + 4 * g;
#pragma unroll
                for (int dt = 0; dt < 8; ++dt) { u32x2 w; w.x = pk2(o[dt][0] * il, o[dt][1] * il); w.y = pk2(o[dt][2] * il, o[dt][3] * il); *(u32x2*)(orow + 16 * dt) = w; }
            }
        }
        __syncthreads();
    }
}
typedef __attribute__((address_space(1))) float GASF;
#ifndef ATT_PROBE
#define ATT_PROBE 0
#endif
#ifndef ATT_REMAP
#define ATT_REMAP 1
#endif
__device__ __forceinline__ int crow(int r, int hi) { return (r & 3) + 8 * (r >> 2) + 4 * hi; }
#define KSWZ64(row, cb) ((row) * 128 + ((cb) ^ ((((row) >> 1) & 7) << 4)))
__device__ __forceinline__ int v_st(int k, int c) { const int kk = (k & ~0xC) | ((k & 4) << 1) | ((k & 8) >> 1); return ((kk >> 3) * 4 + (c >> 5)) * 512 + ((kk & 7) * 32 + (c & 31)) * 2; }
__device__ __forceinline__ int v_rd_base(int lane) { return ((lane & 3) << 3) | (((lane >> 2) & 3) << 6) | (((lane >> 4) & 1) << 5) | (((lane >> 5) & 1) << 8); }
constexpr int v_rd_off(int d0, int ks, int half) { return d0 * 512 + ks * 4096 + half * 2048; }
template <int OFF> __device__ __forceinline__ s16x4 tr_read(int vb) {
    s16x4 r; asm volatile("ds_read_b64_tr_b16 %0, %1 offset:%2" : "=&v"(r) : "v"(vb), "i"(OFF) : "memory"); return r;
}
template <int D0> __device__ __forceinline__ void pv_one(f32x16& od, int vb, bf16x8 pa0, bf16x8 pa1, bf16x8 pa2, bf16x8 pa3) {
    const s16x4 l0 = tr_read<v_rd_off(D0, 0, 0)>(vb), h0 = tr_read<v_rd_off(D0, 0, 1)>(vb), l1 = tr_read<v_rd_off(D0, 1, 0)>(vb), h1 = tr_read<v_rd_off(D0, 1, 1)>(vb);
    const s16x4 l2 = tr_read<v_rd_off(D0, 2, 0)>(vb), h2 = tr_read<v_rd_off(D0, 2, 1)>(vb), l3 = tr_read<v_rd_off(D0, 3, 0)>(vb), h3 = tr_read<v_rd_off(D0, 3, 1)>(vb);
    asm volatile("s_waitcnt lgkmcnt(0)" ::: "memory"); __builtin_amdgcn_sched_barrier(0);
#define PK(L, H) (bf16x8){L[0], L[1], L[2], L[3], H[0], H[1], H[2], H[3]}
    od = __builtin_amdgcn_mfma_f32_32x32x16_bf16(pa0, PK(l0, h0), od, 0, 0, 0);
    od = __builtin_amdgcn_mfma_f32_32x32x16_bf16(pa1, PK(l1, h1), od, 0, 0, 0);
    od = __builtin_amdgcn_mfma_f32_32x32x16_bf16(pa2, PK(l2, h2), od, 0, 0, 0);
    od = __builtin_amdgcn_mfma_f32_32x32x16_bf16(pa3, PK(l3, h3), od, 0, 0, 0);
#undef PK
}

__device__ __forceinline__ void att_tile(f32x16 (&o)[4], float& lsum, const unsigned char* Kb, int vb0, const unsigned char* Qw, int r32, int hi, int tq, int j, bool past, float slopeL2, float refL2) {
    constexpr float C = 0.125f * 1.4426950409f;
    bf16x8 qr[4];
#pragma unroll
    for (int d0 = 0; d0 < 4; ++d0) qr[d0] = *(const bf16x8*)(Qw + KSWZ64(r32, (d0 * 16 + hi * 8) * 2));
    const float dq = (float)(tq - 64 * j - 4 * hi);
    const float B0 = -slopeL2 * dq - refL2;
    float ps = 0.f;
    bf16x8 pa0, pa1, pa2, pa3;
#define PK4(P, BASE, OUT) do { unsigned a0 = cvtpk_bf16(P[BASE + 0], P[BASE + 1]), a1 = cvtpk_bf16(P[BASE + 2], P[BASE + 3]);   \
    unsigned b0_ = cvtpk_bf16(P[BASE + 4], P[BASE + 5]), b1_ = cvtpk_bf16(P[BASE + 6], P[BASE + 7]);                              \
    auto r0 = __builtin_amdgcn_permlane32_swap(a0, b0_, false, false); auto r1 = __builtin_amdgcn_permlane32_swap(a1, b1_, false, false); \
    u32x4 w = {r0[0], r1[0], r0[1], r1[1]}; OUT = __builtin_bit_cast(bf16x8, w); } while (0)
#define HALF_TILE(KOFF, FOFF, PA, PB) do { f32x16 pp = f32x16{};                                                                     \
    _Pragma("unroll") for (int d0 = 0; d0 < 4; ++d0) { const int cb = (d0 * 16 + hi * 8) * 2;                                        \
        const bf16x8 bk = *(const bf16x8*)(Kb + KSWZ64((KOFF) + r32, cb)); pp = __builtin_amdgcn_mfma_f32_32x32x16_bf16(bk, qr[d0], pp, 0, 0, 0); } \
    if (past) { _Pragma("unroll") for (int r = 0; r < 16; ++r) { const float off = (float)((r & 3) + 8 * (r >> 2)) + (FOFF);          \
            pp[r] = __builtin_amdgcn_exp2f(fmaf(pp[r], C, fmaf(slopeL2, off, B0))); } }                                               \
    else { _Pragma("unroll") for (int r = 0; r < 16; ++r) { const float off = (float)((r & 3) + 8 * (r >> 2)) + (FOFF);               \
            pp[r] = __builtin_amdgcn_exp2f(fmaf(pp[r], C, -slopeL2 * fabsf(dq - off) - refL2)); } }                                   \
    _Pragma("unroll") for (int r = 0; r < 16; ++r) ps += pp[r];                                                                       \
    PK4(pp, 0, PA); PK4(pp, 8, PB); __builtin_amdgcn_sched_barrier(0); } while (0)
    HALF_TILE(0, 0.f, pa0, pa1);
    HALF_TILE(32, 32.f, pa2, pa3);
#undef HALF_TILE
#undef PK4
    { auto rr = __builtin_amdgcn_permlane32_swap(__float_as_uint(ps), __float_as_uint(ps), false, false);
      ps = __uint_as_float(rr[0]) + __uint_as_float(rr[1]); }
    lsum += ps;
    pv_one<0>(o[0], vb0, pa0, pa1, pa2, pa3); pv_one<1>(o[1], vb0, pa0, pa1, pa2, pa3); pv_one<2>(o[2], vb0, pa0, pa1, pa2, pa3); pv_one<3>(o[3], vb0, pa0, pa1, pa2, pa3);
}
constexpr int ATT_LDS = 2 * 16384 + 2 * 8192 + 8 * 256 + 8 * 4096;

__device__ __forceinline__ void ph_attnA(const Params& p, unsigned char* lds, int vb, int nvb) {
    const bf16* PROJ = (const bf16*)(p.ws + WS_PROJ); bf16* MIX = (bf16*)(p.ws + WS_MIX);
    const float* SC = (const float*)(p.ws + WS_SCAL);
    const float lam = SC[SC_LAM], refL2 = SC[SC_MA] * 1.4426950409f;
    constexpr float C = 0.125f * 1.4426950409f;
    int tid = threadIdx.x; asm volatile("" : "+v"(tid)); const int lane = tid & 63, wid = __builtin_amdgcn_readfirstlane(tid >> 6), r32 = lane & 31, hi = lane >> 5;
    unsigned char* V_lds = lds; unsigned char* K_lds = lds + 32768;
    float* wsf = (float*)(lds + 49152) + wid * 64;
    GASF* tmpw = (GASF*)(p.ws + WS_ATMP) + ((size_t)(vb * NWV + wid) * 64) * 64 + lane;
    const int vbase = (int)(uintptr_t)V_lds + v_rd_base(lane);
    const int krow = tid >> 3, kch = tid & 7, kdst = KSWZ64(krow, kch * 16);
    const int sr = tid >> 4, sc = (tid & 15) * 8, vst0 = v_st(sr, sc), vst1 = v_st(32 + sr, sc);
    for (int it = vb; it < 256; it += nvb) {
        #if ATT_REMAP
        const int xg_ = it & 7, m_ = it >> 3, pidx = xg_ * 8 + (m_ >> 2), qbl = m_ & 3, b = pidx >> 2, h = pidx & 3;
#else
        const int b = it >> 4, h = (it >> 2) & 3, qbl = it & 3;
#endif
        const float slopeL2 = exp2f(-2.0f * (float)(h + 1)) * 1.4426950409f;
        const bf16* Pb = PROJ + (size_t)b * SEQ * NP;
#pragma unroll 1
        for (int half = 0; half < 2; ++half) {
            const int qb = half ? 7 - qbl : qbl, q0 = 256 * qb, NTu = 4 * (qb + 1), cw = 4 * qb + (wid >> 1);
            const int tq = q0 + 32 * wid + r32;
#pragma unroll 1
            for (int mi = 0; mi < 2; ++mi) {
                const int m = 1 - mi;
                const bf16* Kg = Pb + C_KA + h * 128 + m * 64 + (size_t)krow * NP + kch * 8;
                const bf16* Vg = Pb + C_VA + h * 128 + (size_t)sr * NP + sc;
                unsigned char* Qw = lds + 51200 + wid * 4096;
                { const bf16* qp = Pb + (size_t)tq * NP + C_QA + h * 128 + m * 64 + hi * 8;
#pragma unroll
                  for (int d0 = 0; d0 < 4; ++d0) *(bf16x8*)(Qw + KSWZ64(r32, (d0 * 16 + hi * 8) * 2)) = *(const bf16x8*)(qp + d0 * 16); }
                f32x16 o[4];
#pragma unroll
                for (int d = 0; d < 4; ++d) o[d] = f32x16{};
                float lsum = 0.f;
                bf16x8 ak, av0, av1;
#define ATT_LOAD(K_, V0_, V1_, TJ) do { const size_t go_ = (size_t)(TJ) * 64 * NP; K_ = *(const bf16x8*)(Kg + go_); V0_ = *(const bf16x8*)(Vg + go_); V1_ = *(const bf16x8*)(Vg + go_ + (size_t)32 * NP); \
        if (ATT_PROBE == 2) { bf16x8 d0_ = *(const volatile bf16x8*)(Kg + go_); bf16x8 d1_ = *(const volatile bf16x8*)(Vg + go_); bf16x8 d2_ = *(const volatile bf16x8*)(Vg + go_ + (size_t)32 * NP); asm volatile("" :: "v"(d0_), "v"(d1_), "v"(d2_)); } } while (0)
#define ATT_WRITE(K_, V0_, V1_, NB) do { *(bf16x8*)(K_lds + (NB) * 8192 + kdst) = K_; *(bf16x8*)(V_lds + (NB) * 16384 + vst0) = V0_; *(bf16x8*)(V_lds + (NB) * 16384 + vst1) = V1_; } while (0)
                ATT_LOAD(ak, av0, av1, 0); ATT_WRITE(ak, av0, av1, 0);
                __syncthreads();
#pragma unroll 1
                for (int j = 0; j < NTu; ++j) {
                    const int buf = j & 1;
                    if (j + 1 < NTu) ATT_LOAD(ak, av0, av1, j + 1);
                    if (j <= cw) { att_tile(o, lsum, K_lds + buf * 8192, vbase + buf * 16384, Qw, r32, hi, tq, j, j < cw, slopeL2, refL2);
#if ATT_PROBE == 1
                        { f32x16 o2[4]; o2[0] = o[0]; o2[1] = o[1]; o2[2] = o[2]; o2[3] = o[3]; float l2 = 0.f; att_tile(o2, l2, K_lds + buf * 8192, vbase + buf * 16384, Qw, r32, hi, tq, j, j < cw, slopeL2, refL2);
                          asm volatile("" :: "v"(o2[0]), "v"(o2[1]), "v"(o2[2]), "v"(o2[3]), "v"(l2)); }
#endif
                    }
                    if (j + 1 < NTu) ATT_WRITE(ak, av0, av1, buf ^ 1);
                    __syncthreads();
                }
#undef ATT_LOAD
#undef ATT_WRITE
                if (hi == 0) wsf[r32] = lsum;
                LDS_WAIT(); asm volatile("" ::: "memory");
                float rli[16];
#pragma unroll
                for (int r = 0; r < 16; ++r) rli[r] = 1.f / wsf[crow(r, hi)];
                LDS_WAIT(); asm volatile("" ::: "memory");
                if (mi == 0) {
#pragma unroll
                    for (int d = 0; d < 4; ++d) { GASF* td = tmpw + d * 1024; asm volatile("" : "+v"(td));
#pragma unroll
                        for (int r = 0; r < 16; ++r) td[r * 64] = o[d][r] * rli[r]; }
                } else {
                    float gsub[4];
#pragma unroll
                    for (int d = 0; d < 4; ++d) gsub[d] = p.a_sub_gain[32 * d + r32];
                    GASF* tdp[4];
#pragma unroll
                    for (int d = 0; d < 4; ++d) { tdp[d] = tmpw + d * 1024; asm volatile("" : "+v"(tdp[d])); }
#pragma unroll
                    for (int r = 0; r < 16; ++r) {
                        float v[4]; float ss = 0.f;
#pragma unroll
                        for (int d = 0; d < 4; ++d) { v[d] = o[d][r] * rli[r] - lam * tdp[d][r * 64]; ss += v[d] * v[d]; }
                        ss += __shfl_xor(ss, 1); ss += __shfl_xor(ss, 2); ss += __shfl_xor(ss, 4); ss += __shfl_xor(ss, 8); ss += __shfl_xor(ss, 16);
                        const float rs = rsqrtf(ss * (1.f / 128.f) + EPS) * 0.8f;
                        bf16* orow = MIX + (size_t)(b * SEQ + q0 + 32 * wid + crow(r, hi)) * MIXW + h * 128 + r32;
#pragma unroll
                        for (int d = 0; d < 4; ++d) orow[32 * d] = (bf16)f2bf(v[d] * rs * gsub[d]);
                        asm volatile("" ::: "memory");
                    }
                }
            }
        }
    }
}
constexpr int RT_WAVE_BYTES = 12288;
constexpr int RT_LDS = 32768 + 8 * RT_WAVE_BYTES;

__device__ __forceinline__ int pl32_sum(int v) { auto rr = __builtin_amdgcn_permlane32_swap((unsigned)v, (unsigned)v, false, false); return (int)(rr[0] + rr[1]); }
__device__ __forceinline__ int pl32_other(int v) { auto rr = __builtin_amdgcn_permlane32_swap((unsigned)v, (unsigned)v, false, false); return (int)(rr[0] + rr[1]) - v; }
__device__ __forceinline__ float unsortkey(unsigned k) { return __uint_as_float((k & 0x80000000u) ? (k ^ 0x80000000u) : ~k); }

__device__ __forceinline__ unsigned wave_or(unsigned v) {
    v |= (unsigned)__builtin_amdgcn_update_dpp(0, (int)v, 0x128, 0xf, 0xf, false); v |= (unsigned)__builtin_amdgcn_update_dpp(0, (int)v, 0x124, 0xf, 0xf, false);
    v |= (unsigned)__builtin_amdgcn_update_dpp(0, (int)v, 0x122, 0xf, 0xf, false); v |= (unsigned)__builtin_amdgcn_update_dpp(0, (int)v, 0x121, 0xf, 0xf, false);
    return (unsigned)(__builtin_amdgcn_readlane((int)v, 0) | __builtin_amdgcn_readlane((int)v, 16) | __builtin_amdgcn_readlane((int)v, 32) | __builtin_amdgcn_readlane((int)v, 48));
}
template <int N> __device__ __forceinline__ unsigned bisect16(const unsigned (&key)[N]) {
    unsigned kmx, lo;
    { unsigned gm[8];
#pragma unroll
      for (int g = 0; g < 8; ++g) { gm[g] = key[g];
#pragma unroll
          for (int i = g + 8; i < N; i += 8) gm[g] = key[i] > gm[g] ? key[i] : gm[g]; }
      kmx = gm[0]; lo = gm[0];
#pragma unroll
      for (int g = 1; g < 8; ++g) { kmx = gm[g] > kmx ? gm[g] : kmx; lo = gm[g] < lo ? gm[g] : lo; }
      const unsigned okmx = (unsigned)pl32_other((int)kmx), olo = (unsigned)pl32_other((int)lo);
      kmx = okmx > kmx ? okmx : kmx; lo = olo < lo ? olo : lo; }
    const unsigned x = kmx - lo;
    int pb = x ? 31 - __clz(x) : -1;
    unsigned prefix = 0u; bool done = (x == 0u);
#pragma unroll 1
    while (!__all(done)) {
        const unsigned c_ = done ? prefix : (prefix | (1u << pb));
        unsigned cand = lo + c_; cand = cand < lo ? 0xffffffffu : cand;
        int cnt = 0;
#pragma unroll
        for (int i = 0; i + 3 < N; i += 4) cnt_ge4(cnt, key[i], key[i + 1], key[i + 2], key[i + 3], cand);
#pragma unroll
        for (int i = N & ~3; i < N; ++i) cnt += (key[i] >= cand) ? 1 : 0;
        const int tot = pl32_sum(cnt);
        if (!done && tot >= 16) { prefix = c_; done = (tot == 16); }
        --pb; done = done || (pb < 0);
    }
    prefix += lo;
    return prefix;
}

__device__ __forceinline__ void ph_route(const Params& p, unsigned char* lds, int vb, int nvb) {
    const bf16* Q3 = (const bf16*)(p.ws + WS_Q3); const bf16* SUBK = (const bf16*)(p.ws + WS_SUBK);
    int* EXPI = (int*)(p.ws + WS_EXP); float* GATE = (float*)(p.ws + WS_GATE);
    int tid = threadIdx.x; asm volatile("" : "+v"(tid));
    const int lane = tid & 63, wv = __builtin_amdgcn_readfirstlane(tid >> 6), r32 = lane & 31, hi = lane >> 5;
    for (int i = tid; i < 2048; i += NT) { const int row = i >> 3, ch = i & 7; ((u32x4*)lds)[row * 8 + (ch ^ ((row >> 1) & 7))] = ((const u32x4*)SUBK)[i]; }
    __syncthreads();
    unsigned char* wl = lds + 32768 + wv * RT_WAVE_BYTES;
    float* sv = (float*)wl; int* si = (int*)(wl + 4096); float* fv = (float*)(wl + 8192); int* fe = (int*)(wl + 10240);
    const int gw = vb * NWV + wv, ngw = nvb * NWV;
    for (int item = gw; item < (T / 32) * 8; item += ngw) {
        const int h = item & 7, tok0 = (item >> 3) * 32;
        const bf16* qrow = Q3 + (size_t)(tok0 + r32) * 1024 + h * 128 + hi * 8;
#pragma unroll 1
        for (int c = 0; c < 2; ++c) {
            f32x4 cv[8]; const int crow = (item * 2 + c) * 2;
            { const float* src_ = (crow < NEXP ? p.peer_u + (size_t)crow * 1024 : p.peer_v + (size_t)(crow - NEXP) * 1024) + lane * 4;
#pragma unroll
              for (int j = 0; j < 8; ++j) cv[j] = *(const f32x4*)(src_ + 256 * j); }
            bf16x8 bq[4];
#pragma unroll
            for (int d0 = 0; d0 < 4; ++d0) bq[d0] = *(const bf16x8*)(qrow + c * 64 + d0 * 16);
            unsigned key[64];
#pragma unroll
            for (int nt = 0; nt < 4; ++nt) {
                f32x16 acc = f32x16{};
                const int krow = c * 128 + nt * 32 + r32, ksw = (krow >> 1) & 7;
                const unsigned char* kp = lds + krow * 128;
#pragma unroll
                for (int d0 = 0; d0 < 4; ++d0) { const bf16x8 ak = *(const bf16x8*)(kp + (((2 * d0 + hi) ^ ksw) << 4)); acc = __builtin_amdgcn_mfma_f32_32x32x16_bf16(ak, bq[d0], acc, 0, 0, 0); }
#pragma unroll
                for (int r = 0; r < 16; ++r) key[nt * 16 + r] = sortkey(acc[r]);
            }
            const unsigned thr = bisect16<64>(key);
            int cnt = 0;
#pragma unroll
            for (int i = 0; i < 64; ++i) cnt += (key[i] >= thr) ? 1 : 0;
            const int other_ = pl32_other(cnt); int slot = hi ? other_ : 0;
            float* svp = sv + (r32 * 2 + c) * 16; int* sip = si + (r32 * 2 + c) * 16;
#pragma unroll
            for (int i = 0; i < 64; ++i) {
                if (key[i] >= thr && slot < 16) { svp[slot] = unsortkey(key[i]); sip[slot] = 32 * (i >> 4) + ((i & 3) + 8 * ((i & 15) >> 2)) + 4 * hi; ++slot; }
            }
            { const float csc = crow < NEXP ? 32.0f : 1.0f;
              unsigned char* dst_ = (unsigned char*)(p.ws + (crow < NEXP ? WS_U16 : WS_V16)) + (size_t)(crow < NEXP ? crow : crow - NEXP) * 1024 + lane * 4;
#pragma unroll
              for (int j = 0; j < 8; ++j) { int w_ = 0; w_ = __builtin_amdgcn_cvt_pk_fp8_f32(cv[j].x * csc, cv[j].y * csc, w_, false); w_ = __builtin_amdgcn_cvt_pk_fp8_f32(cv[j].z * csc, cv[j].w * csc, w_, true);
                  *(unsigned*)(dst_ + 256 * j) = (unsigned)w_; } }
        }
        u32x4 hb[4]; f32x4 hs, hsh[4];
#define RT_H2_LOAD(HALF) do { const int tk_ = tok0 + 16 * (HALF) + (lane >> 3), p8_ = lane & 7; const int cc_ = h * 128 + 8 * p8_;                            \
            const bf16* hp_ = (const bf16*)(p.ws + WS_H) + (size_t)tk_ * 1024 + cc_;                                                                       \
            const float* sh_ = (const float*)(p.ws + WS_MOD) + (size_t)(tk_ >> 11) * 6144 + 3072 + cc_;                                                    \
            _Pragma("unroll") for (int j = 0; j < 4; ++j) hb[j] = *(const u32x4*)(hp_ + (size_t)(j >> 1) * 8 * 1024 + 64 * (j & 1));                        \
            hs = *((const f32x4*)(p.ws + WS_SSQ) + (size_t)(tk_ + 8 * (p8_ >> 2)) * 4 + (p8_ & 3));                                                        \
            hsh[0] = *(const f32x4*)sh_; hsh[1] = *(const f32x4*)(sh_ + 4); hsh[2] = *(const f32x4*)(sh_ + 64); hsh[3] = *(const f32x4*)(sh_ + 68); } while (0)
#define RT_H2_STORE(HALF) do { const int tk_ = tok0 + 16 * (HALF) + (lane >> 3), p8_ = lane & 7; const int cc_ = h * 128 + 8 * p8_;                           \
            bf16* hp_ = (bf16*)(p.ws + WS_H) + (size_t)tk_ * 1024 + cc_;                                                                                   \
            float s_ = (hs[0] + hs[1]) + (hs[2] + hs[3]); s_ += __shfl_xor(s_, 1); s_ += __shfl_xor(s_, 2);                                                 \
            const float so_ = __shfl_xor(s_, 4); const float rsme_ = rsqrtf(s_ * (1.f / 1024.f) + EPS), rsot_ = rsqrtf(so_ * (1.f / 1024.f) + EPS);           \
            const float rs0_ = (p8_ & 4) ? rsot_ : rsme_, rs1_ = (p8_ & 4) ? rsme_ : rsot_;                           \
            _Pragma("unroll") for (int j = 0; j < 4; ++j) { const f32x4 a_ = hsh[2 * (j & 1)], b_ = hsh[2 * (j & 1) + 1]; const float rs_ = (j >> 1) ? rs1_ : rs0_; u32x4 w_; \
                w_.x = cvtpk_bf16(fmaf(bflo(hb[j].x), rs_, a_[0]), fmaf(bfhi(hb[j].x), rs_, a_[1])); w_.y = cvtpk_bf16(fmaf(bflo(hb[j].y), rs_, a_[2]), fmaf(bfhi(hb[j].y), rs_, a_[3])); \
                w_.z = cvtpk_bf16(fmaf(bflo(hb[j].z), rs_, b_[0]), fmaf(bfhi(hb[j].z), rs_, b_[1])); w_.w = cvtpk_bf16(fmaf(bflo(hb[j].w), rs_, b_[2]), fmaf(bfhi(hb[j].w), rs_, b_[3])); \
                *(u32x4*)(hp_ + (size_t)(j >> 1) * 8 * 1024 + 64 * (j & 1)) = w_; } } while (0)
        RT_H2_LOAD(0);
        LDS_WAIT(); asm volatile("" ::: "memory");
        {
            float* sv0 = sv + (r32 * 2) * 16; float* sv1 = sv0 + 16; int* si0 = si + (r32 * 2) * 16; int* si1 = si0 + 16;
            {
                float a[16], bl[16];
#pragma unroll
                for (int k = 0; k < 16; ++k) { a[k] = sv0[k]; bl[k] = sv1[k]; }
                int ia[8], ib[8], ra[8], rb[8]; float va[8], vb[8];
#pragma unroll
                for (int q = 0; q < 8; ++q) { const int e = 8 * hi + q; va[q] = sv0[e]; vb[q] = sv1[e]; ia[q] = si0[e]; ib[q] = si1[e]; int r0 = 0, r1 = 0;
#pragma unroll
                    for (int k = 0; k < 16; ++k) { r0 += (a[k] > va[q] || (a[k] == va[q] && k < e)) ? 1 : 0; r1 += (bl[k] > vb[q] || (bl[k] == vb[q] && k < e)) ? 1 : 0; }
                    ra[q] = r0; rb[q] = r1; }
                LDS_WAIT(); asm volatile("" ::: "memory");
                { auto rr = __builtin_amdgcn_permlane32_swap(0u, 0u, false, false); (void)rr; }
#pragma unroll
                for (int q = 0; q < 8; ++q) { sv0[ra[q]] = va[q]; si0[ra[q]] = ia[q]; sv1[rb[q]] = vb[q]; si1[rb[q]] = ib[q]; }
                LDS_WAIT(); asm volatile("" ::: "memory");
            }
            const float* X = hi ? sv1 : sv0; const float* Y = hi ? sv0 : sv1;
            float x[4], y[16];
#pragma unroll
            for (int k = 0; k < 4; ++k) x[k] = X[k];
#pragma unroll
            for (int k = 0; k < 16; ++k) y[k] = Y[k];
            unsigned key[27]; int pi[27], pj[27]; int np = 0;
#pragma unroll
            for (int i = 0; i < 3; ++i)
#pragma unroll
                for (int j = i + 1; j < 16; ++j) if ((i + 1) * (j + 1) <= 16) { key[np] = sortkey(x[i] + y[j]); pi[np] = i; pj[np] = j; ++np; }
#pragma unroll
            for (int i = 0; i < 4; ++i) { key[23 + i] = hi ? 0u : sortkey(x[i] + y[i]); pi[23 + i] = i; pj[23 + i] = i; }
            RT_H2_STORE(0); RT_H2_LOAD(1);
            const unsigned thr = bisect16<27>(key);
            int cnt = 0;
#pragma unroll
            for (int i = 0; i < 27; ++i) cnt += (key[i] >= thr) ? 1 : 0;
            const int other_ = pl32_other(cnt); int slot = hi ? other_ : 0;
            const int* IX = hi ? si1 : si0; const int* IY = hi ? si0 : si1;
            float* fvp = fv + r32 * 16; int* fep = fe + r32 * 16;
#pragma unroll
            for (int i = 0; i < 27; ++i) {
                if (key[i] >= thr && slot < 16) { const int ex = IX[pi[i]], ey = IY[pj[i]]; fvp[slot] = unsortkey(key[i]); fep[slot] = hi ? (ey * 128 + ex) : (ex * 128 + ey); ++slot; }
            }
        }
        LDS_WAIT(); asm volatile("" ::: "memory");
        {
            const float* fvp = fv + r32 * 16;
            float v[16]; float mx = -3e38f;
#pragma unroll
            for (int k = 0; k < 16; ++k) { v[k] = fvp[k]; mx = fmaxf(mx, v[k]); }
            float l = 0.f;
#pragma unroll
            for (int k = 0; k < 16; ++k) { v[k] = __expf(v[k] - mx); l += v[k]; }
            const float il = 1.f / l;
            const size_t ob = (size_t)(tok0 + r32) * 128 + h * 16 + 8 * hi;
            const int* fep = fe + r32 * 16 + 8 * hi;
            f32x4 g0, g1; u32x4 e0, e1;
            if (hi == 0) { g0 = (f32x4){v[0] * il, v[1] * il, v[2] * il, v[3] * il}; g1 = (f32x4){v[4] * il, v[5] * il, v[6] * il, v[7] * il}; }
            else { g0 = (f32x4){v[8] * il, v[9] * il, v[10] * il, v[11] * il}; g1 = (f32x4){v[12] * il, v[13] * il, v[14] * il, v[15] * il}; }
            e0 = *(const u32x4*)fep; e1 = *(const u32x4*)(fep + 4);
            *(f32x4*)(GATE + ob) = g0; *(f32x4*)(GATE + ob + 4) = g1;
            *(u32x4*)(EXPI + ob) = e0; *(u32x4*)(EXPI + ob + 4) = e1;
        }
        RT_H2_STORE(1);
#undef RT_H2_LOAD
#undef RT_H2_STORE
        LDS_WAIT(); asm volatile("" ::: "memory");
    }
    __syncthreads();
}
typedef float f32x2_t __attribute__((ext_vector_type(2)));
constexpr int P8_UNITS = T / 64;
constexpr int CW_P8_U = 4096, CW_P8_V = 4096 + 32 * 64;
constexpr float U8_SCALE = 32.0f;
__device__ __forceinline__ unsigned peer_xcc() { return (unsigned)__builtin_amdgcn_s_getreg((3 << 11) | 20) & 7u; }
#ifndef U8_HALVES
#define U8_HALVES 0
#endif
template <int LPR>
__device__ __forceinline__ void ph_peer_v8g(const Params& p, unsigned char* lds) {
    constexpr int RPI = 64 / LPR, NI = 128 / RPI, G = NI / 8, NS = 64 / LPR, SLB = 16 * LPR;
    const unsigned char* V8 = (const unsigned char*)(p.ws + WS_V16);
    const int* EXPI = (const int*)(p.ws + WS_EXP); const float* CBUF = (const float*)(p.ws + WS_CBUF); const float* MOD = (const float*)(p.ws + WS_MOD);
    const float* AB1 = (const float*)(p.ws + WS_ABUF1); const float* GATEP = (const float*)(p.ws + WS_GATE); (void)AB1; (void)GATEP;
    unsigned* ctl = (unsigned*)(p.ws + WS_CTL);
    int tid = threadIdx.x; asm volatile("" : "+v"(tid));
    const int lane = tid & 63, wv = __builtin_amdgcn_readfirstlane(tid >> 6), gR = lane / LPR, iC = lane % LPR;
    volatile LAS unsigned* slot = (volatile LAS unsigned*)(LAS unsigned char*)lds;
    const unsigned xcc = peer_xcc();
#pragma unroll 1
    for (int k = 0; k < NS; ++k) {
        const int sl = (int)((((xcc * NS) >> 3) + (unsigned)k) % (unsigned)NS);
        const unsigned char* vcol = V8 + SLB * sl + 16 * iC;
#pragma unroll 1
        for (;;) {
            if (tid == 0) *slot = __hip_atomic_fetch_add(ctl + CW_P8_V + 64 * sl, 1u, __ATOMIC_RELAXED, __HIP_MEMORY_SCOPE_AGENT);
            __syncthreads();
            const unsigned unit = *slot;
            __syncthreads();
            if (unit >= (unsigned)P8_UNITS) break;
            const int tbase = (int)unit * 64 + wv * 8;
            int ne0, ne1; float nc0, nc1;
#if U8_HALVES
#define VG_FETCH(T) do { const size_t tn_ = (size_t)(T); ne0 = EXPI[tn_ * 128 + lane]; ne1 = EXPI[tn_ * 128 + 64 + lane];                              \
        nc0 = gelu_erf(CBUF[tn_ * 128 + lane] + AB1[tn_ * 128 + lane]) * GATEP[tn_ * 128 + lane];                                              \
        nc1 = gelu_erf(CBUF[tn_ * 128 + 64 + lane] + AB1[tn_ * 128 + 64 + lane]) * GATEP[tn_ * 128 + 64 + lane]; } while (0)
#else
#define VG_FETCH(T) do { const size_t tn_ = (size_t)(T); ne0 = EXPI[tn_ * 128 + lane]; ne1 = EXPI[tn_ * 128 + 64 + lane]; nc0 = CBUF[tn_ * 128 + lane]; nc1 = CBUF[tn_ * 128 + 64 + lane]; } while (0)
#endif
#define VG_LISTS(LE, LC) do { LE[lane] = ne0; LE[64 + lane] = ne1; LC[lane] = nc0; LC[64 + lane] = nc1; } while (0)
#define VG_ROWS(R, LE, GI) do { _Pragma("unroll") for (int kk = 0; kk < 8; ++kk) R[kk] = *(const u32x4*)(vcol + (size_t)LE[RPI * (8 * (GI) + kk) + gR] * 1024); } while (0)
#define VG_GROUP(R, LC, GI) do { _Pragma("unroll") for (int kk = 0; kk < 8; ++kk) { const float cj = LC[RPI * (8 * (GI) + kk) + gR];                       \
            const unsigned w_[4] = {R[kk].x, R[kk].y, R[kk].z, R[kk].w};                                                                       \
            _Pragma("unroll") for (int c = 0; c < 4; ++c) { const f32x2_t lo = __builtin_amdgcn_cvt_pk_f32_fp8((int)w_[c], false), hi = __builtin_amdgcn_cvt_pk_f32_fp8((int)w_[c], true); \
                acc[4 * c] = fmaf(cj, lo.x, acc[4 * c]); acc[4 * c + 1] = fmaf(cj, lo.y, acc[4 * c + 1]); acc[4 * c + 2] = fmaf(cj, hi.x, acc[4 * c + 2]); acc[4 * c + 3] = fmaf(cj, hi.y, acc[4 * c + 3]); } } } while (0)
            u32x4 RA[8], RB[8];
            int* lecur = (int*)(lds + 1024 + wv * 2048); int* lenxt = lecur + 256;
            VG_FETCH(tbase); VG_LISTS(lecur, ((float*)(lecur + 128))); VG_FETCH(tbase + 1);
            LDS_WAIT(); asm volatile("" ::: "memory");
            VG_ROWS(RA, lecur, 0);
#pragma unroll 1
            for (int tt = 0; tt < 8; ++tt) {
                const int t = tbase + tt;
                float* lccur = (float*)(lecur + 128); float* lcnxt = (float*)(lenxt + 128);
                float acc[16];
#pragma unroll
                for (int q = 0; q < 16; ++q) acc[q] = 0.f;
                if (tt + 1 < 8) { VG_LISTS(lenxt, lcnxt); if (tt + 2 < 8) VG_FETCH(t + 2); }
#pragma unroll 1
                for (int gi = 0; gi < G; gi += 2) {
                    VG_ROWS(RB, lecur, gi + 1);
                    VG_GROUP(RA, lccur, gi);
                    if (gi + 2 < G) VG_ROWS(RA, lecur, gi + 2);
                    else if (tt + 1 < 8) { LDS_WAIT(); asm volatile("" ::: "memory"); VG_ROWS(RA, lenxt, 0); }
                    VG_GROUP(RB, lccur, gi + 1);
                }
#pragma unroll
                for (int q = 0; q < 16; ++q) { if (LPR <= 8) acc[q] += dpp_f<0x128>(acc[q]); if (LPR <= 16) acc[q] += __shfl_xor(acc[q], 16); if (LPR <= 32) acc[q] += __shfl_xor(acc[q], 32); }
                if (gR == 0) { const int col = SLB * sl + 16 * iC; const float* g2 = MOD + (size_t)(t >> 11) * 6144 + 5120 + col; float* orow = p.out + (size_t)t * 1024 + col;
#pragma unroll
                    for (int q = 0; q < 4; ++q) { const f32x4 xv = *(const f32x4*)(orow + 4 * q), hv = *(const f32x4*)(g2 + 4 * q);
                        f32x4 r; r.x = acc[4 * q]; r.y = acc[4 * q + 1]; r.z = acc[4 * q + 2]; r.w = acc[4 * q + 3]; *(f32x4*)(orow + 4 * q) = xv + hv * r; } }
                { int* tmp_ = lecur; lecur = lenxt; lenxt = tmp_; }
            }
#undef VG_FETCH
#undef VG_LISTS
#undef VG_ROWS
#undef VG_GROUP
            LDS_WAIT(); asm volatile("" ::: "memory");
        }
    }
}
#ifndef SORT_BITS
#define SORT_BITS 3
#endif
#ifndef PEER_SORT
#define PEER_SORT 1
#endif
__device__ __forceinline__ void ph_peer_u8p(const Params& p, unsigned char* lds_w, int gw, int ngw, int lane_) {
    int lane = lane_; asm volatile("" : "+v"(lane));
    const bf16* H = (const bf16*)(p.ws + WS_H); const unsigned char* U8 = (const unsigned char*)(p.ws + WS_U16); const unsigned char* V8 = (const unsigned char*)(p.ws + WS_V16);
    const int* EXPI = (const int*)(p.ws + WS_EXP); const float* GATE = (const float*)(p.ws + WS_GATE); const float* MOD = (const float*)(p.ws + WS_MOD);
    int* e_lds = (int*)lds_w; float* a_lds = (float*)(lds_w + 512); float* g_lds = (float*)(lds_w + 1024); (void)g_lds;
    const int g = lane >> 4, i = lane & 15;
#pragma unroll 1
    for (int t = gw; t < T; t += ngw) {
        int e0 = EXPI[(size_t)t * 128 + lane], e1 = EXPI[(size_t)t * 128 + 64 + lane];
        float g0 = GATE[(size_t)t * 128 + lane], g1 = GATE[(size_t)t * 128 + 64 + lane];
#if PEER_SORT
        {
            const int flip_ = ((t / ngw) & 1) ? ((1 << SORT_BITS) - 1) : 0;
            const int d0 = (e0 >> (14 - SORT_BITS)) ^ flip_, d1 = (e1 >> (14 - SORT_BITS)) ^ flip_; int pos0 = 0, pos1 = 0, run = 0;
#pragma unroll
            for (int d = 0; d < (1 << SORT_BITS); ++d) {
                const unsigned long long m0 = __ballot(d0 == d), m1 = __ballot(d1 == d);
                const int c0 = __popcll(m0), c1 = __popcll(m1);
                const int r0 = (int)__builtin_amdgcn_mbcnt_hi((unsigned)(m0 >> 32), __builtin_amdgcn_mbcnt_lo((unsigned)m0, 0u));
                const int r1 = (int)__builtin_amdgcn_mbcnt_hi((unsigned)(m1 >> 32), __builtin_amdgcn_mbcnt_lo((unsigned)m1, 0u));
                pos0 = (d0 == d) ? run + r0 : pos0; pos1 = (d1 == d) ? run + c0 + r1 : pos1; run += c0 + c1;
            }
            e_lds[pos0] = e0; e_lds[pos1] = e1; g_lds[pos0] = g0; g_lds[pos1] = g1;
            LDS_WAIT(); asm volatile("" ::: "memory");
            e0 = e_lds[lane]; e1 = e_lds[64 + lane]; g0 = g_lds[lane]; g1 = g_lds[64 + lane];
            int* EW = (int*)(p.ws + WS_EXP) + (size_t)t * 128; EW[lane] = e0; EW[64 + lane] = e1;
        }
#else
        e_lds[lane] = e0; e_lds[64 + lane] = e1;
#endif
        float xf[64];
        { const u32x4* xrow = (const u32x4*)(H + (size_t)t * 1024) + 2 * i;
#pragma unroll
          for (int q = 0; q < 4; ++q) { const u32x4 a = xrow[32 * q], b = xrow[32 * q + 1];
              xf[16 * q] = bflo(a.x); xf[16 * q + 1] = bfhi(a.x); xf[16 * q + 2] = bflo(a.y); xf[16 * q + 3] = bfhi(a.y); xf[16 * q + 4] = bflo(a.z); xf[16 * q + 5] = bfhi(a.z); xf[16 * q + 6] = bflo(a.w); xf[16 * q + 7] = bfhi(a.w);
              xf[16 * q + 8] = bflo(b.x); xf[16 * q + 9] = bfhi(b.x); xf[16 * q + 10] = bflo(b.y); xf[16 * q + 11] = bfhi(b.y); xf[16 * q + 12] = bflo(b.z); xf[16 * q + 13] = bfhi(b.z); xf[16 * q + 14] = bflo(b.w); xf[16 * q + 15] = bfhi(b.w); } }
        LDS_WAIT(); asm volatile("" ::: "memory");
#define P8T_ULOAD(R, S) do { const u32x4* r_ = (const u32x4*)(U8 + (size_t)e_lds[4 * (S) + g] * 1024) + i; _Pragma("unroll") for (int q = 0; q < 4; ++q) R[q] = r_[16 * q]; } while (0)
#define P8T_UDOT(R, S) do { float a0 = 0.f, a1 = 0.f, a2 = 0.f, a3 = 0.f;                                                                               \
        _Pragma("unroll") for (int q = 0; q < 4; ++q) { const unsigned w_[4] = {R[q].x, R[q].y, R[q].z, R[q].w};                                           \
            _Pragma("unroll") for (int c = 0; c < 4; ++c) { const f32x2_t lo = __builtin_amdgcn_cvt_pk_f32_fp8((int)w_[c], false), hi = __builtin_amdgcn_cvt_pk_f32_fp8((int)w_[c], true); \
                a0 = fmaf(lo.x, xf[16 * q + 4 * c], a0); a1 = fmaf(lo.y, xf[16 * q + 4 * c + 1], a1); a2 = fmaf(hi.x, xf[16 * q + 4 * c + 2], a2); a3 = fmaf(hi.y, xf[16 * q + 4 * c + 3], a3); } } \
        const float a_ = row16_sum((a0 + a1) + (a2 + a3)) * (1.0f / U8_SCALE); if (i == 0) a_lds[4 * (S) + g] = a_; } while (0)
        { u32x4 RA[4], RB[4], RC[4];
          P8T_ULOAD(RA, 0); P8T_ULOAD(RB, 1);
#pragma unroll 1
          for (int s = 0; s < 30; s += 3) {
              P8T_ULOAD(RC, s + 2); P8T_UDOT(RA, s);
              P8T_ULOAD(RA, s + 3); P8T_UDOT(RB, s + 1);
              P8T_ULOAD(RB, s + 4); P8T_UDOT(RC, s + 2);
          }
          P8T_UDOT(RA, 30); P8T_UDOT(RB, 31); }
#undef P8T_ULOAD
#undef P8T_UDOT
        LDS_WAIT(); asm volatile("" ::: "memory");
        const float c0 = gelu_erf(a_lds[lane]) * g0, c1 = gelu_erf(a_lds[64 + lane]) * g1;
        float* CB = (float*)(p.ws + WS_CBUF) + (size_t)t * 128; CB[lane] = c0; CB[64 + lane] = c1;
    }
}
__device__ __forceinline__ void ph_peer_u8h(const Params& p, unsigned char* lds) {
    const bf16* H = (const bf16*)(p.ws + WS_H); const unsigned char* U8 = (const unsigned char*)(p.ws + WS_U16);
    const int* EXPI = (const int*)(p.ws + WS_EXP);
    unsigned* ctl = (unsigned*)(p.ws + WS_CTL);
    int tid = threadIdx.x; asm volatile("" : "+v"(tid));
    const int lane = tid & 63, wv = __builtin_amdgcn_readfirstlane(tid >> 6), hw = lane >> 5, i5 = lane & 31;
    volatile LAS unsigned* slot = (volatile LAS unsigned*)(LAS unsigned char*)lds;
    float* a_lds = (float*)(lds + 1024 + wv * 2048 + 1024);
    const unsigned xcc = peer_xcc();
#pragma unroll 1
    for (int k = 0; k < 2; ++k) {
        const int sl = (int)(((xcc >> 2) + (unsigned)k) & 1u);
        float* AB = (float*)(p.ws + (sl ? WS_ABUF1 : WS_CBUF));
        const unsigned char* ucol = U8 + 512 * sl + 16 * i5;
#pragma unroll 1
        for (;;) {
            if (tid == 0) *slot = __hip_atomic_fetch_add(ctl + CW_P8_U + 64 * sl, 1u, __ATOMIC_RELAXED, __HIP_MEMORY_SCOPE_AGENT);
            __syncthreads();
            const unsigned unit = *slot;
            __syncthreads();
            if (unit >= (unsigned)P8_UNITS) break;
            const int tbase = (int)unit * 64 + wv * 8;
            int ne0, ne1; u32x4 nx0, nx1;
#define UH_FETCH(T) do { const size_t tn_ = (size_t)(T); ne0 = EXPI[tn_ * 128 + lane]; ne1 = EXPI[tn_ * 128 + 64 + lane];                          \
        const u32x4* xr_ = (const u32x4*)(H + tn_ * 1024 + 512 * sl) + 2 * i5; nx0 = xr_[0]; nx1 = xr_[1]; } while (0)
#define UH_LISTS(LE) do { LE[lane] = ne0; LE[64 + lane] = ne1; } while (0)
#define UH_ROWS(R, LE, GI) do { _Pragma("unroll") for (int kk = 0; kk < 8; ++kk) R[kk] = *(const u32x4*)(ucol + (size_t)LE[2 * (8 * (GI) + kk) + hw] * 1024); } while (0)
#define UH_GROUP(R, GI) do { _Pragma("unroll") for (int kk = 0; kk < 8; ++kk) { float a0 = 0.f, a1 = 0.f, a2 = 0.f, a3 = 0.f;                         \
            const unsigned w_[4] = {R[kk].x, R[kk].y, R[kk].z, R[kk].w};                                                                       \
            _Pragma("unroll") for (int c = 0; c < 4; ++c) { const f32x2_t lo = __builtin_amdgcn_cvt_pk_f32_fp8((int)w_[c], false), hi = __builtin_amdgcn_cvt_pk_f32_fp8((int)w_[c], true); \
                a0 = fmaf(lo.x, xf[4 * c], a0); a1 = fmaf(lo.y, xf[4 * c + 1], a1); a2 = fmaf(hi.x, xf[4 * c + 2], a2); a3 = fmaf(hi.y, xf[4 * c + 3], a3); }                        \
            float s_ = row16_sum((a0 + a1) + (a2 + a3)); s_ += __shfl_xor(s_, 16);                                                              \
            if (i5 == 0) a_lds[2 * (8 * (GI) + kk) + hw] = s_ * (1.0f / U8_SCALE); } } while (0)
            u32x4 RA[8], RB[8];
            int* lecur = (int*)(lds + 1024 + wv * 2048); int* lenxt = lecur + 128;
            UH_FETCH(tbase); UH_LISTS(lecur);
            float xf[16];
#define UH_XF() do { xf[0] = bflo(nx0.x); xf[1] = bfhi(nx0.x); xf[2] = bflo(nx0.y); xf[3] = bfhi(nx0.y); xf[4] = bflo(nx0.z); xf[5] = bfhi(nx0.z); xf[6] = bflo(nx0.w); xf[7] = bfhi(nx0.w); \
        xf[8] = bflo(nx1.x); xf[9] = bfhi(nx1.x); xf[10] = bflo(nx1.y); xf[11] = bfhi(nx1.y); xf[12] = bflo(nx1.z); xf[13] = bfhi(nx1.z); xf[14] = bflo(nx1.w); xf[15] = bfhi(nx1.w); } while (0)
            UH_XF();
            UH_FETCH(tbase + 1);
            LDS_WAIT(); asm volatile("" ::: "memory");
            UH_ROWS(RA, lecur, 0);
#pragma unroll 1
            for (int tt = 0; tt < 8; ++tt) {
                const int t = tbase + tt;
                float xn[16];
                if (tt + 1 < 8) { UH_LISTS(lenxt);
#pragma unroll
                    for (int q = 0; q < 16; ++q) xn[q] = 0.f;
                    xn[0] = bflo(nx0.x); xn[1] = bfhi(nx0.x); xn[2] = bflo(nx0.y); xn[3] = bfhi(nx0.y); xn[4] = bflo(nx0.z); xn[5] = bfhi(nx0.z); xn[6] = bflo(nx0.w); xn[7] = bfhi(nx0.w);
                    xn[8] = bflo(nx1.x); xn[9] = bfhi(nx1.x); xn[10] = bflo(nx1.y); xn[11] = bfhi(nx1.y); xn[12] = bflo(nx1.z); xn[13] = bfhi(nx1.z); xn[14] = bflo(nx1.w); xn[15] = bfhi(nx1.w);
                    if (tt + 2 < 8) UH_FETCH(t + 2); }
#pragma unroll 1
                for (int gi = 0; gi < 8; gi += 2) {
                    UH_ROWS(RB, lecur, gi + 1);
                    UH_GROUP(RA, gi);
                    if (gi + 2 < 8) UH_ROWS(RA, lecur, gi + 2);
                    else if (tt + 1 < 8) { LDS_WAIT(); asm volatile("" ::: "memory"); UH_ROWS(RA, lenxt, 0); }
                    UH_GROUP(RB, gi + 1);
                }
                LDS_WAIT(); asm volatile("" ::: "memory");
                { float* ab = AB + (size_t)t * 128; ab[lane] = a_lds[lane]; ab[64 + lane] = a_lds[64 + lane]; }
                LDS_WAIT(); asm volatile("" ::: "memory");
                if (tt + 1 < 8) {
#pragma unroll
                    for (int q = 0; q < 16; ++q) xf[q] = xn[q]; }
                { int* tmp_ = lecur; lecur = lenxt; lenxt = tmp_; }
            }
#undef UH_FETCH
#undef UH_LISTS
#undef UH_ROWS
#undef UH_GROUP
#undef UH_XF
        }
    }
}
#define XB_TMO      128
#define XB_XCNT(j)  (256  + 64 * (j))
#define XB_XSUB(j)  (1280 + 64 * (j))
#define XB_XGEN(j)  (2304 + 64 * (j))
#define XB_TOP      3328
#define XB_TOPGEN   3392
#define XCD_BAR_WORDS 3456
#define XB_SPIN_CAP (1u << 18)

__device__ __forceinline__ unsigned xb_ld(unsigned* p)              { return __hip_atomic_load(p, __ATOMIC_RELAXED, __HIP_MEMORY_SCOPE_AGENT); }
__device__ __forceinline__ unsigned xb_add(unsigned* p, unsigned v) { return __hip_atomic_fetch_add(p, v, __ATOMIC_RELAXED, __HIP_MEMORY_SCOPE_AGENT); }
__device__ __forceinline__ unsigned xb_xcc_id() { return (unsigned)__builtin_amdgcn_s_getreg((3 << 11) | 20) & 0xFu; }
#define XB_SPIN(cond, bar) do { unsigned _sp = 0; while (cond) { __builtin_amdgcn_s_sleep(1); \
    if ((++_sp & 255u) == 0u) { if (xb_ld(&(bar)[XB_TMO])) break; if (_sp > XB_SPIN_CAP) { atomicAdd(&(bar)[XB_TMO], 1u); break; } } } } while (0)

struct XcdBarrier {
    unsigned* bar; unsigned x;
    volatile LAS unsigned* st;
};

__device__ __forceinline__ XcdBarrier xcd_barrier_post(unsigned* bar, volatile LAS unsigned* st) {
    XcdBarrier b; b.bar = bar; b.x = xb_xcc_id(); b.st = st;
    if (threadIdx.x == 0) (void)xb_add(&bar[XB_XCNT(b.x)], 1u);
    return b;
}
__device__ __forceinline__ void xcd_barrier_complete(unsigned* bar, unsigned x, unsigned& nloc, unsigned& nx) {
    const unsigned G = gridDim.x * gridDim.y * gridDim.z;
    unsigned sum, cnt, mine, sp = 0u;
    for (;;) {
        sum = 0u; cnt = 0u; mine = 0u;
#pragma unroll
        for (unsigned j = 0; j < 16; ++j) { const unsigned c = xb_ld(&bar[XB_XCNT(j)]); sum += c; cnt += (c > 0u) ? 1u : 0u; mine = (j == x) ? c : mine; }
        if (sum == G) break;
        __builtin_amdgcn_s_sleep(1);
        if ((++sp & 255u) == 0u) { if (xb_ld(&bar[XB_TMO])) break; if (sp > XB_SPIN_CAP) { atomicAdd(&bar[XB_TMO], 1u); break; } }
    }
    nloc = mine > 0u ? mine : 1u; nx = cnt > 0u ? cnt : 1u;
}

__device__ __forceinline__ void xcd_barrier(const XcdBarrier& b) {
    asm volatile("s_waitcnt vmcnt(0)" ::: "memory");
    __syncthreads();
    if (threadIdx.x == 0) {
        unsigned* bar = b.bar;
        __builtin_amdgcn_s_waitcnt(0);
        unsigned nloc = b.st[0], nx = b.st[1];
        if (nloc == 0u) { xcd_barrier_complete(bar, b.x, nloc, nx); b.st[0] = nloc; b.st[1] = nx; }
        const unsigned old = xb_add(&bar[XB_XSUB(b.x)], 1u);
        const unsigned gen = old / nloc;
        if (old + 1u == (gen + 1u) * nloc) {
            __builtin_amdgcn_fence(__ATOMIC_RELEASE, "agent");
            asm volatile("s_waitcnt vmcnt(0)" ::: "memory");
            const unsigned og = xb_add(&bar[XB_TOP], 1u);
            const unsigned tg = og / nx;
            if (og + 1u == (tg + 1u) * nx) xb_add(&bar[XB_TOPGEN], 1u);
            else XB_SPIN(xb_ld(&bar[XB_TOPGEN]) == tg, bar);
            __builtin_amdgcn_fence(__ATOMIC_ACQUIRE, "agent");
            xb_add(&bar[XB_XGEN(b.x)], 1u);
            asm volatile("s_waitcnt vmcnt(0)" ::: "memory");
        } else {
            XB_SPIN(xb_ld(&bar[XB_XGEN(b.x)]) == gen, bar);
            __builtin_amdgcn_fence(__ATOMIC_ACQUIRE, "agent");
            asm volatile("s_waitcnt vmcnt(0)" ::: "memory");
        }
    }
    __syncthreads();
}

#ifndef V8_LPR
#define V8_LPR 32
#endif
constexpr int LDS_BYTES = 147456;
extern __shared__ __attribute__((aligned(16))) unsigned char dyn_lds[];

__global__ void __launch_bounds__(NT, 2) mega_fwd(Params p) {
    cg::grid_group grid = cg::this_grid();
    const int vb = blockIdx.x, nvb = gridDim.x, ngw = nvb * NWV;
    volatile LAS unsigned* xst = (volatile LAS unsigned*)((LAS unsigned char*)dyn_lds + (LDS_BYTES - 16));
    if (threadIdx.x < 4) xst[threadIdx.x] = 0u;
    __syncthreads();
    const XcdBarrier xbar = xcd_barrier_post((unsigned*)(p.ws + WS_CTL), xst);
#define TID_LAUNDER int tid_ = threadIdx.x; asm volatile("" : "+v"(tid_)); const int lane = tid_ & 63, wv = tid_ >> 6, gw = vb * NWV + wv; (void)lane; (void)gw;
    grid.sync();
    ph_mod(p, (float*)dyn_lds, vb, nvb);
    { TID_LAUNDER ph_prep_weights(p, (LAS float*)dyn_lds + wv * (64 * 33), gw, ngw, lane); }
    xcd_barrier(xbar);
    { TID_LAUNDER ph_hrows(p, p.x, p.norm1_g, 0, 1024, gw, ngw, lane); ph_q3bias(p, gw, lane); }
    xcd_barrier(xbar);
    {   pg8::Gemm g{(const bf16*)(p.ws + WS_H), (const bf16*)(p.ws + WS_WIN), T, NP, 1024}; pg8::StaticOrder S; S.init(T, NP, nvb, vb);
        EpiNormBf16 E{(bf16*)(p.ws + WS_PROJ), p.a_qk_gain, p.b_q_gain, p.b_kv_gain, (LAS float*)((LAS unsigned char*)dyn_lds + 131072), (bf16*)(p.ws + WS_KVC)};
        pg8::gemm_phase<EpiNormBf16, pg8::StaticOrder, true, true>((LAS unsigned char*)dyn_lds, g, S, E); }
    xcd_barrier(xbar);
    ph_attnA(p, dyn_lds, vb, nvb);
    __syncthreads();
    ph_dsa(p, dyn_lds, vb, nvb);
    xcd_barrier(xbar);
    {   pg8::Gemm g{(const bf16*)(p.ws + WS_MIX), (const bf16*)(p.ws + WS_WO2), T, 1024, MIXW}; pg8::StaticOrder S; S.init(T, 1024, nvb, vb);
        EpiResGateA2 E{p.x, p.out, (const float*)(p.ws + WS_MOD), p.norm2_g, (bf16*)(p.ws + WS_H), (float*)(p.ws + WS_SSQ)};
        pg8::gemm_phase<EpiResGateA2, pg8::StaticOrder, true, true>((LAS unsigned char*)dyn_lds, g, S, E); }
    xcd_barrier(xbar);
    {   pg8::Gemm g{(const bf16*)(p.ws + WS_H), (const bf16*)(p.ws + WS_WQ), T, 1024, 1024}; pg8::StaticOrder S; S.init(T, 1024, nvb, vb);
        EpiQ3 E{(const float*)(p.ws + WS_SSQ), (const float*)(p.ws + WS_QBIAS), (bf16*)(p.ws + WS_Q3)};
        pg8::gemm_phase<EpiQ3, pg8::StaticOrder, true, true>((LAS unsigned char*)dyn_lds, g, S, E); }
    xcd_barrier(xbar);
    ph_route(p, dyn_lds, vb, nvb);
    xcd_barrier(xbar);

#if U8_HALVES
    ph_peer_u8h(p, dyn_lds);
#else
    { TID_LAUNDER ph_peer_u8p(p, dyn_lds + wv * 2048, gw, ngw, lane); }
#endif
    xcd_barrier(xbar);
    ph_peer_v8g<V8_LPR>(p, dyn_lds);

}

extern "C" void kernel_launch(void* const* d_in, const int* in_sizes, int n_in, void* d_out, int out_size, void* d_ws, size_t ws_size, hipStream_t stream) {
    static int grid_blocks = 0;
    if (grid_blocks == 0) {
        if (n_in != 18 || in_sizes[0] != T * DM || out_size != T * DM || ws_size < WS_END) { fprintf(stderr, "kernel_launch: unexpected shapes n_in %d in0 %d out %d ws %zu\n", n_in, n_in > 0 ? in_sizes[0] : -1, out_size, ws_size); grid_blocks = -1; return; }
        int dev = 0, cus = 0, per_cu = 0;
        (void)hipGetDevice(&dev);
        (void)hipDeviceGetAttribute(&cus, hipDeviceAttributeMultiprocessorCount, dev);
        (void)hipFuncSetAttribute((const void*)mega_fwd, hipFuncAttributeMaxDynamicSharedMemorySize, LDS_BYTES);
        (void)hipOccupancyMaxActiveBlocksPerMultiprocessor(&per_cu, (const void*)mega_fwd, NT, LDS_BYTES);
        if (per_cu < 1 || cus < 1) { fprintf(stderr, "kernel_launch: occupancy query gave %d blocks/CU on %d CUs\n", per_cu, cus); grid_blocks = -1; return; }
        grid_blocks = cus;
    }
    if (grid_blocks < 0) return;
    Params p{};
    const float** pp = (const float**)&p;
    for (int i = 0; i < 18; ++i) pp[i] = (const float*)d_in[i];
    p.out = (float*)d_out; p.ws = (unsigned char*)d_ws;
    if (hipMemsetAsync((char*)d_ws + WS_CTL, 0, CTL_BYTES, stream) != hipSuccess) { fprintf(stderr, "kernel_launch: memset failed\n"); return; }
    void* args[] = {&p};
    const hipError_t e = hipLaunchCooperativeKernel((const void*)mega_fwd, dim3(grid_blocks), dim3(NT), args, LDS_BYTES, stream);
    if (e != hipSuccess) fprintf(stderr, "kernel_launch: cooperative launch failed: %s (grid %d)\n", hipGetErrorString(e), grid_blocks);
}
```

```cpp
#include <hip/hip_runtime.h>
#include <hip/hip_cooperative_groups.h>
#include <cstdio>
#include <cstdint>
#include <cmath>
namespace pg8 {
#define PG8_LAS __attribute__((address_space(3)))
typedef unsigned short bf16_t;
typedef short bf16x8 __attribute__((ext_vector_type(8)));
typedef float f32x4 __attribute__((ext_vector_type(4)));
typedef unsigned u32x4 __attribute__((ext_vector_type(4)));
constexpr int BM = 256, BK = 64, HALF = 128, HTB = HALF * BK * 2  , STAGE_BYTES = 8 * HTB, NXCD = 8, WGM = 8;

__host__ __device__ __forceinline__ int lds_byte(int r, int c) { const int st = (r >> 4) * 2 + (c >> 5), rr = r & 15, cc = c & 31, ob = rr * 64 + cc * 2; return st * 1024 + (ob ^ (((ob >> 9) & 1) << 5)); }
__host__ __device__ __forceinline__ void stage_rc(int b, int& R, int& C) { const int st = b / 1024, sb = b % 1024, swz = sb ^ (((sb >> 9) & 1) << 5); R = (st >> 1) * 16 + swz / 64; C = (st & 1) * 32 + (swz % 64) / 2; }
__host__ __device__ __forceinline__ int perm32(int rho) { const int n = rho >> 4, i = rho & 15; return 8 * (i >> 2) + 4 * n + (i & 3); }

struct Unit { int pm, pn; };
struct Gemm { const bf16_t* A; const bf16_t* Bt; int M, N, K; };

struct StaticOrder {
    int nM, nN, nwg, G, c;
    __host__ __device__ void init(int M, int N, int G_, int c_) { nM = M / BM; nN = N / BM; nwg = nM * nN; G = G_; c = c_; }
    __host__ __device__ bool next(int i, Unit& u) const {
        const long L = (long)i * G + c; if (L >= nwg) return false;
        int wgid = (int)L; { const int q = nwg / NXCD, r = nwg % NXCD, xcd = wgid % NXCD, off = wgid / NXCD; wgid = (xcd < r ? xcd * (q + 1) : r * (q + 1) + (xcd - r) * q) + off; }
        const int nig = WGM * nN, gid = wgid / nig, fm = gid * WGM, gsz = (nM - fm) < WGM ? (nM - fm) : WGM;
        u.pm = fm + ((wgid % nig) % gsz); u.pn = (wgid % nig) / gsz; return true;
    }
    __device__ __forceinline__ void a_ready(const Unit&) const {}
    __device__ __forceinline__ void done(const Unit&) const {}
};

__device__ __forceinline__ unsigned cvt_pk_bf16(float lo, float hi) { unsigned r; asm volatile("v_cvt_pk_bf16_f32 %0, %1, %2" : "=v"(r) : "v"(lo), "v"(hi)); return r; }
typedef float f32x2 __attribute__((ext_vector_type(2)));
__device__ __forceinline__ f32x2 gelu_pk(f32x2 v) {
    const f32x2 av = __builtin_elementwise_abs(v), d = av * 0.2316418882f + 1.0f;
    f32x2 t; t.x = __builtin_amdgcn_rcpf(d.x); t.y = __builtin_amdgcn_rcpf(d.y);
    f32x2 q = t * 0.5307027145f + (-0.7265760135f); q = q * t + 0.7107068705f; q = q * t + (-0.142248368f); q = q * t + 0.127414796f; q = q * t;
    const f32x2 s = (v * v) * (-0.72134752044f);
    f32x2 e; e.x = __builtin_amdgcn_exp2f(s.x); e.y = __builtin_amdgcn_exp2f(s.y);
    const f32x2 m = v * (q * e), r = v - m;
    f32x2 o; o.x = v.x < 0.f ? m.x : r.x; o.y = v.y < 0.f ? m.y : r.y; return o;
}

template <int ACT  > struct EpiBf16 {
    static constexpr bool PERM = true, AFTER_DRAIN = false; static_assert(ACT == 0 || ACT == 1, "EpiBf16: ACT is 0 (none) or 1 (gelu_pk)");
    bf16_t* O; int ldc; const float* bias; int split_cols; size_t split_stride; float scale0;
    __device__ __forceinline__ void operator()(const f32x4 (&acc)[2][2][4][2], const Unit& u, int wr, int wc, int fr, int fq) const {
        const int row0 = u.pm * BM + wr * 64 + fr; int colt = u.pn * BM; bf16_t* base = O;
        float sc = 1.f; if (split_cols) { const int t = colt / split_cols; base += (size_t)t * split_stride; colt -= t * split_cols; if (t == 0) sc = scale0; }
        const int col0 = colt + wc * 32 + 8 * fq, bcol0 = u.pn * BM + wc * 32 + 8 * fq;
        f32x4 bv[2][2];
#pragma unroll
        for (int bj = 0; bj < 2; ++bj)
#pragma unroll
            for (int n = 0; n < 2; ++n) bv[bj][n] = bias ? *(const f32x4*)(bias + bcol0 + bj * HALF + 4 * n) : (f32x4){0.f, 0.f, 0.f, 0.f};
#pragma unroll
        for (int ai = 0; ai < 2; ++ai)
#pragma unroll
            for (int m = 0; m < 4; ++m) { bf16_t* rowp = base + (size_t)(row0 + ai * HALF + m * 16) * ldc + col0;
#pragma unroll
                for (int bj = 0; bj < 2; ++bj) { f32x4 v0 = acc[ai][bj][m][0] + bv[bj][0], v1 = acc[ai][bj][m][1] + bv[bj][1];
                    if (ACT == 1) { f32x2 a = gelu_pk((f32x2){v0[0], v0[1]}), b = gelu_pk((f32x2){v0[2], v0[3]}), c = gelu_pk((f32x2){v1[0], v1[1]}), d = gelu_pk((f32x2){v1[2], v1[3]});
                        v0 = (f32x4){a.x, a.y, b.x, b.y}; v1 = (f32x4){c.x, c.y, d.x, d.y}; }
                    v0 = v0 * sc; v1 = v1 * sc; u32x4 w; w.x = cvt_pk_bf16(v0[0], v0[1]); w.y = cvt_pk_bf16(v0[2], v0[3]); w.z = cvt_pk_bf16(v1[0], v1[1]); w.w = cvt_pk_bf16(v1[2], v1[3]);
                    *(u32x4*)(rowp + bj * HALF) = w; } }
    }
};

template <class Epi, class Sched, bool ALIGN_EPI = false, bool SP2 = false>
__device__ __forceinline__ void gemm_phase(PG8_LAS unsigned char* lds, const Gemm g, const Sched& S, const Epi& E) {
    int tid = threadIdx.x; asm volatile("" : "+v"(tid)); const int wid = __builtin_amdgcn_readfirstlane(tid >> 6), lane = tid & 63, wr = wid >> 2, wc = wid & 3, fr = lane & 15, fq = lane >> 4;
    const int K = g.K, nt = K / BK;
    unsigned voffA[2], voffB[2];
#pragma unroll
    for (int i = 0; i < 2; ++i) { int R, C; stage_rc(tid * 16 + i * 8192, R, C); const int Rb = Epi::PERM ? ((R & ~31) + perm32(R & 31)) : R;
        voffA[i] = (unsigned)(R * K + C) * 2u; voffB[i] = (unsigned)(Rb * K + C) * 2u; }
    const size_t kstep = (size_t)(BK * 2);
    const size_t hstep = (size_t)HALF * K * 2;
    const size_t tstep = 2 * hstep;
    const unsigned ldsw = (unsigned)wid * 1024u;
    const int aoff = lds_byte(wr * 64 + fr, fq * 8), boff = lds_byte(wc * 32 + fr, fq * 8);
#define PG8_SA(b, h) (((b) * 2 + (h)) * HTB)
#define PG8_SB(b, h) ((4 + (b) * 2 + (h)) * HTB)
#define PG8_STAGE(bufoff, gbase, voff) do { _Pragma("unroll") for (int _i = 0; _i < 2; ++_i) \
        __builtin_amdgcn_global_load_lds((const unsigned*)((const char*)(gbase) + (voff)[_i]), (PG8_LAS unsigned*)(lds + (bufoff) + ldsw + _i * 8192), 16, 0, 0); } while (0)
#define PG8_LDA(dst, b, h) do { _Pragma("unroll") for (int m = 0; m < 4; ++m) _Pragma("unroll") for (int k = 0; k < 2; ++k) dst[m][k] = *(const PG8_LAS bf16x8*)(lds + PG8_SA(b, h) + aoff + m * 2048 + k * 1024); } while (0)
#define PG8_LDB(dst, b, h) do { _Pragma("unroll") for (int n = 0; n < 2; ++n) _Pragma("unroll") for (int k = 0; k < 2; ++k) dst[n][k] = *(const PG8_LAS bf16x8*)(lds + PG8_SB(b, h) + boff + n * 2048 + k * 1024); } while (0)
#define PG8_MMA(ai, bj, At, Bt) do { __builtin_amdgcn_s_setprio(1); _Pragma("unroll") for (int m = 0; m < 4; ++m) _Pragma("unroll") for (int n = 0; n < 2; ++n) _Pragma("unroll") for (int k = 0; k < 2; ++k) \
        acc[ai][bj][m][n] = __builtin_amdgcn_mfma_f32_16x16x32_bf16(Bt[n][k], At[m][k], acc[ai][bj][m][n], 0, 0, 0); __builtin_amdgcn_s_setprio(0); } while (0)
#define PG8_WAIT_V(n) asm volatile("s_waitcnt vmcnt(" #n ")" ::: "memory")
#define PG8_WAIT_L(n) asm volatile("s_waitcnt lgkmcnt(" #n ")" ::: "memory")
#define PG8_BAR __builtin_amdgcn_s_barrier()
#define PG8_SCHED __builtin_amdgcn_sched_barrier(0)
    Unit cur, nxt; int ui = 0;
    if (!S.next(0, cur)) return;
    f32x4 acc[2][2][4][2];
#pragma unroll
    for (int a = 0; a < 2; ++a)
#pragma unroll
        for (int b = 0; b < 2; ++b)
#pragma unroll
            for (int m = 0; m < 4; ++m)
#pragma unroll
                for (int n = 0; n < 2; ++n) acc[a][b][m][n] = (f32x4){0.f, 0.f, 0.f, 0.f};
    bf16x8 At[4][2], B0[2][2], B1[2][2];
    const char* cA = (const char*)g.A + (size_t)cur.pm * tstep; const char* cB = (const char*)g.Bt + (size_t)cur.pn * tstep;
    S.a_ready(cur);
    if constexpr (SP2) {
        PG8_STAGE(PG8_SB(0, 0), cB, voffB); PG8_STAGE(PG8_SB(0, 1), cB + hstep, voffB); PG8_STAGE(PG8_SA(0, 0), cA, voffA); PG8_STAGE(PG8_SA(0, 1), cA + hstep, voffA);
        if (wr == 1) PG8_BAR;
        PG8_WAIT_V(2); PG8_BAR;
        PG8_STAGE(PG8_SB(1, 0), cB + kstep, voffB); PG8_STAGE(PG8_SA(1, 0), cA + kstep, voffA); PG8_STAGE(PG8_SB(1, 1), cB + hstep + kstep, voffB);
        PG8_WAIT_V(6); PG8_BAR;
    } else {
        PG8_STAGE(PG8_SB(0, 0), cB, voffB); PG8_STAGE(PG8_SA(0, 0), cA, voffA); PG8_STAGE(PG8_SB(0, 1), cB + hstep, voffB); PG8_STAGE(PG8_SA(0, 1), cA + hstep, voffA);
        if (wr == 1) PG8_BAR;
        PG8_WAIT_V(4); PG8_BAR;
        PG8_STAGE(PG8_SB(1, 0), cB + kstep, voffB); PG8_STAGE(PG8_SA(1, 0), cA + kstep, voffA); PG8_STAGE(PG8_SB(1, 1), cB + hstep + kstep, voffB);
        PG8_WAIT_V(6); PG8_BAR;
    }
    for (;;) {
        const bool has_next = S.next(ui + 1, nxt);
        const char* nA = has_next ? (const char*)g.A + (size_t)nxt.pm * tstep : cA; const char* nB = has_next ? (const char*)g.Bt + (size_t)nxt.pn * tstep : cB;
        for (int t = 0; t < nt; t += 2) {
            const bool last = (t == nt - 2);
            const char* a1 = cA + (size_t)(t + 1) * kstep;
            const char* a2 = last ? nA : cA + (size_t)(t + 2) * kstep; const char* b2 = last ? nB : cB + (size_t)(t + 2) * kstep;
            const char* a3 = a2 + kstep; const char* b3 = b2 + kstep;
            if (last && has_next) S.a_ready(nxt);
            if constexpr (SP2) {
            PG8_LDB(B0, 0, 0); PG8_LDB(B1, 0, 1); PG8_SCHED; PG8_LDA(At, 0, 0); PG8_STAGE(PG8_SA(1, 1), a1 + hstep, voffA);
            PG8_WAIT_V(8); PG8_WAIT_L(0); PG8_BAR; PG8_MMA(0, 0, At, B0); PG8_MMA(0, 1, At, B1); PG8_BAR; PG8_SCHED;
            PG8_LDA(At, 0, 1); PG8_STAGE(PG8_SB(0, 0), b2, voffB); PG8_STAGE(PG8_SB(0, 1), b2 + hstep, voffB); PG8_STAGE(PG8_SA(0, 0), a2, voffA);
            PG8_WAIT_V(8); PG8_WAIT_L(0); PG8_BAR; PG8_MMA(1, 0, At, B0); PG8_MMA(1, 1, At, B1); PG8_BAR; PG8_SCHED;
            PG8_LDB(B0, 1, 0); PG8_LDB(B1, 1, 1); PG8_SCHED; PG8_LDA(At, 1, 0); PG8_STAGE(PG8_SA(0, 1), a2 + hstep, voffA);
            PG8_WAIT_V(8); PG8_WAIT_L(0); PG8_BAR; PG8_MMA(0, 0, At, B0); PG8_MMA(0, 1, At, B1); PG8_BAR; PG8_SCHED;
            PG8_LDA(At, 1, 1); PG8_STAGE(PG8_SB(1, 0), b3, voffB); PG8_STAGE(PG8_SB(1, 1), b3 + hstep, voffB); PG8_STAGE(PG8_SA(1, 0), a3, voffA);
            PG8_WAIT_V(8); PG8_WAIT_L(0); PG8_BAR; PG8_MMA(1, 0, At, B0); PG8_MMA(1, 1, At, B1); PG8_BAR; PG8_SCHED;
            } else {
            PG8_LDB(B0, 0, 0); PG8_SCHED; PG8_LDA(At, 0, 0); PG8_STAGE(PG8_SA(1, 1), a1 + hstep, voffA);
            PG8_WAIT_L(8); PG8_BAR; PG8_WAIT_L(0); PG8_MMA(0, 0, At, B0); PG8_BAR; PG8_SCHED;
            PG8_LDB(B1, 0, 1); PG8_STAGE(PG8_SB(0, 0), b2, voffB);
            PG8_BAR; PG8_WAIT_L(0); PG8_MMA(0, 1, At, B1); PG8_BAR;
            PG8_LDA(At, 0, 1); PG8_STAGE(PG8_SA(0, 0), a2, voffA);
            PG8_BAR; PG8_WAIT_L(0); PG8_MMA(1, 0, At, B0); PG8_BAR; PG8_SCHED;
            PG8_STAGE(PG8_SB(0, 1), b2 + hstep, voffB);
            PG8_WAIT_V(6); PG8_BAR; PG8_MMA(1, 1, At, B1); PG8_BAR;
            PG8_LDB(B0, 1, 0); PG8_SCHED; PG8_LDA(At, 1, 0); PG8_STAGE(PG8_SA(0, 1), a2 + hstep, voffA);
            PG8_WAIT_L(8); PG8_BAR; PG8_WAIT_L(0); PG8_MMA(0, 0, At, B0); PG8_BAR; PG8_SCHED;
            PG8_LDB(B1, 1, 1); PG8_STAGE(PG8_SB(1, 0), b3, voffB);
            PG8_BAR; PG8_WAIT_L(0); PG8_MMA(0, 1, At, B1); PG8_BAR;
            PG8_LDA(At, 1, 1); PG8_STAGE(PG8_SA(1, 0), a3, voffA);
            PG8_BAR; PG8_WAIT_L(0); PG8_MMA(1, 0, At, B0); PG8_BAR; PG8_SCHED;
            PG8_STAGE(PG8_SB(1, 1), b3 + hstep, voffB);
            PG8_WAIT_V(6); PG8_BAR; PG8_MMA(1, 1, At, B1); PG8_BAR;
            }
        }
        if constexpr (ALIGN_EPI) { if (wr == 0) PG8_BAR; }
        if constexpr (!Epi::AFTER_DRAIN) { E(acc, cur, wr, wc, fr, fq); S.done(cur); }
        if (!has_next) break;
#pragma unroll
        for (int a = 0; a < 2; ++a)
#pragma unroll
            for (int b = 0; b < 2; ++b)
#pragma unroll
                for (int m = 0; m < 4; ++m)
#pragma unroll
                    for (int n = 0; n < 2; ++n) acc[a][b][m][n] = (f32x4){0.f, 0.f, 0.f, 0.f};
        cur = nxt; cA = nA; cB = nB; ++ui;
        if constexpr (ALIGN_EPI) { if (wr == 1) PG8_BAR; }
    }
    PG8_WAIT_V(0);
    if constexpr (!ALIGN_EPI) { if (wr == 0) PG8_BAR; }
    PG8_BAR;
    if constexpr (Epi::AFTER_DRAIN) { E.fused(acc, cur, wr, wc, fr, fq, lds, wid, lane); S.done(cur); }
#undef PG8_SA
#undef PG8_SB
#undef PG8_STAGE
#undef PG8_LDA
#undef PG8_LDB
#undef PG8_MMA
#undef PG8_WAIT_V
#undef PG8_WAIT_L
#undef PG8_BAR
#undef PG8_SCHED
}
}
namespace cg = cooperative_groups;
#define LAS __attribute__((address_space(3)))
typedef unsigned short bf16;
typedef float f32x4 __attribute__((ext_vector_type(4)));
typedef float f32x8 __attribute__((ext_vector_type(8)));
typedef float f32x16 __attribute__((ext_vector_type(16)));
typedef unsigned u32x4 __attribute__((ext_vector_type(4)));
typedef unsigned u32x2 __attribute__((ext_vector_type(2)));
typedef short bf16x8 __attribute__((ext_vector_type(8)));
typedef short s16x4 __attribute__((ext_vector_type(4)));

constexpr int BATCH = 16, SEQ = 2048, DM = 1024, T = BATCH * SEQ;
constexpr int NP = 3072;
constexpr int IN_COLS = 3012;
constexpr int C_QA = 0, C_KA = 512, C_VA = 1024, C_QB = 1536, C_KV = 2560, C_QI = 2688, C_KI = 2944, C_WI = 3008;
constexpr int MIXW = 1536;
constexpr int NEXP = 16384;
constexpr float EPS = 1e-6f;
constexpr int NT = 512;
constexpr int NWV = 8;

constexpr size_t MiB = 1u << 20;
constexpr size_t WS_CTL = 0;
constexpr size_t CTL_BYTES = 64 * 1024;
constexpr size_t WS_MOD = 1 * MiB;
constexpr size_t WS_SCAL = WS_MOD + 512 * 1024;
constexpr size_t WS_QBIAS = WS_MOD + 400 * 1024;
constexpr size_t WS_WIN = 2 * MiB;
constexpr size_t WS_WO2 = 8 * MiB;
constexpr size_t WS_WQ = 11 * MiB;
constexpr size_t WS_SUBK = 13 * MiB;
constexpr size_t WS_U16 = 14 * MiB;
constexpr size_t WS_V16 = 46 * MiB;
constexpr size_t WS_H = 78 * MiB;
constexpr size_t WS_PROJ = 142 * MiB;
constexpr size_t WS_Q3 = WS_PROJ;
constexpr size_t WS_MIX = 334 * MiB;
constexpr size_t WS_EXP = 430 * MiB;
constexpr size_t WS_KVC = WS_EXP;
constexpr size_t WS_GATE = 446 * MiB;
constexpr size_t WS_ATMP = 462 * MiB;
constexpr size_t WS_CBUF = 494 * MiB;
constexpr size_t WS_SSQ = WS_ATMP;
constexpr size_t WS_ABUF1 = WS_MIX;
constexpr size_t WS_END = 510 * MiB;

struct Params {
    const float *x, *c, *ada_w, *ada_b, *norm1_g, *norm2_g, *w_in, *a_qk_gain, *a_lambda, *a_sub_gain, *b_q_gain, *b_kv_gain, *b_w_uv, *w_out, *peer_wq, *peer_subkeys, *peer_u, *peer_v;
    float* out; unsigned char* ws;
};

enum { SC_LAM = 0, SC_MA = 1, SC_MB = 2 };

__device__ __forceinline__ unsigned f2bf(float f) { unsigned u = __float_as_uint(f); return (u + 0x7fffu + ((u >> 16) & 1u)) >> 16; }
__device__ __forceinline__ float bf2f(unsigned h) { return __uint_as_float(h << 16); }
__device__ __forceinline__ unsigned pk2(float lo, float hi) { return f2bf(lo) | (f2bf(hi) << 16); }
__device__ __forceinline__ float bflo(unsigned w) { return __uint_as_float(w << 16); }
__device__ __forceinline__ float bfhi(unsigned w) { return __uint_as_float(w & 0xffff0000u); }
__device__ __forceinline__ float wave_sum(float v) {
#pragma unroll
    for (int o = 1; o < 64; o <<= 1) v += __shfl_xor(v, o);
    return v;
}
__device__ __forceinline__ float wave_max(float v) {
#pragma unroll
    for (int o = 1; o < 64; o <<= 1) v = fmaxf(v, __shfl_xor(v, o));
    return v;
}
#define LDS_WAIT() asm volatile("s_waitcnt lgkmcnt(0)" ::: "memory")
__device__ __forceinline__ void ph_mod(const Params& p, float* ldsf, int vb, int nvb) {
    if (vb >= 96) return;
    int tid = threadIdx.x; asm volatile("" : "+v"(tid));
    const int lane = tid & 63, wv = tid >> 6;
    for (int i = tid; i < 16 * 1024; i += NT) { const float v = p.c[i]; ldsf[i] = v / (1.f + __expf(-v)); }
    __syncthreads();
    float* MOD = (float*)(p.ws + WS_MOD); float* part = ldsf + 16 * 1024;
    for (int it = vb; it < 96; it += nvb) {
        const int j = it * 64 + lane;
        float acc[16];
#pragma unroll
        for (int b = 0; b < 16; ++b) acc[b] = 0.f;
        const float* wp = p.ada_w + (size_t)(128 * wv) * 6144 + j;
#pragma unroll 1
        for (int k0 = 0; k0 < 128; k0 += 8) {
            float w[8];
#pragma unroll
            for (int u = 0; u < 8; ++u) w[u] = wp[(size_t)(k0 + u) * 6144];
#pragma unroll
            for (int u = 0; u < 8; ++u)
#pragma unroll
                for (int b = 0; b < 16; ++b) acc[b] = fmaf(ldsf[b * 1024 + 128 * wv + k0 + u], w[u], acc[b]);
        }
#pragma unroll
        for (int b = 0; b < 16; ++b) part[(wv * 16 + b) * 64 + lane] = acc[b];
        __syncthreads();
        for (int o = tid; o < 16 * 64; o += NT) { const int b = o >> 6, c = o & 63; float s = 0.f;
#pragma unroll
            for (int w = 0; w < 8; ++w) s += part[(w * 16 + b) * 64 + c];
            MOD[b * 6144 + it * 64 + c] = s + p.ada_b[it * 64 + c]; }
        __syncthreads();
    }
}

__device__ __forceinline__ void transpose_item(const float* W, int N, bf16* WT, int ldt, LAS float* scr, int kb, int nb, int lane) {
    const int k0 = 64 * kb, n0 = 32 * nb;
#pragma unroll 8
    for (int i = 0; i < 32; ++i) { const int kk = 2 * i + (lane >> 5); const int n = n0 + (lane & 31); scr[kk * 33 + (lane & 31)] = (n < N) ? W[(size_t)(k0 + kk) * N + n] : 0.f; }
    LDS_WAIT(); asm volatile("" ::: "memory");
    const int c = lane & 7;
#pragma unroll
    for (int j = 0; j < 4; ++j) { const int n = (lane >> 3) + 8 * j; const LAS float* s = scr + (8 * c) * 33 + n;
        u32x4 o; o.x = pk2(s[0 * 33], s[1 * 33]); o.y = pk2(s[2 * 33], s[3 * 33]); o.z = pk2(s[4 * 33], s[5 * 33]); o.w = pk2(s[6 * 33], s[7 * 33]);
        *(u32x4*)(WT + (size_t)(n0 + n) * ldt + k0 + 8 * c) = o; }
    LDS_WAIT(); asm volatile("" ::: "memory");
}

__device__ __forceinline__ void ph_prep_weights(const Params& p, LAS float* scr, int gw, int ngw, int lane) {
    bf16* WIN = (bf16*)(p.ws + WS_WIN); bf16* WO2 = (bf16*)(p.ws + WS_WO2); bf16* WQ = (bf16*)(p.ws + WS_WQ);
    constexpr int I_IN = 16 * 96, I_O = 8 * 32, I_Q = 16 * 32;
    for (int it = gw; it < I_IN + I_O + I_Q; it += ngw) {
        int r = it;
        if (r < I_IN) { transpose_item(p.w_in, IN_COLS, WIN, 1024, scr, r / 96, r % 96, lane); continue; } r -= I_IN;
        if (r < I_O) { transpose_item(p.w_out, 1024, WO2, MIXW, scr, r / 32, r % 32, lane); continue; } r -= I_O;
        transpose_item(p.peer_wq, 1024, WQ, 1024, scr, r / 32, r % 32, lane);
    }
    const size_t gt = (size_t)gw * 64 + lane, ngt = (size_t)ngw * 64;
    for (size_t i = gt; i < (size_t)1024 * 1024; i += ngt) {
        const int n = (int)(i & 1023), kk = (int)(i >> 10), h = kk >> 7;
        const float* wu = p.b_w_uv + (size_t)kk * 64; const float* wo = p.w_out + (size_t)(512 + 64 * h) * 1024 + n;
        float a = 0.f;
#pragma unroll 8
        for (int e = 0; e < 64; ++e) a = fmaf(wu[e], wo[(size_t)e * 1024], a);
        WO2[(size_t)n * MIXW + 512 + kk] = (bf16)f2bf(a);
    }
    bf16* SUBK = (bf16*)(p.ws + WS_SUBK);
    constexpr size_t NSUB8 = 2 * 128 * 64 / 8;
    for (size_t j = gt; j < NSUB8; j += ngt) {
        const f32x8 v = *(const f32x8*)(p.peer_subkeys + j * 8);
        u32x4 o; o.x = pk2(v[0], v[1]); o.y = pk2(v[2], v[3]); o.z = pk2(v[4], v[5]); o.w = pk2(v[6], v[7]);
        *(u32x4*)(SUBK + j * 8) = o;
    }
    if (gt == 0) {
        float* SC = (float*)(p.ws + WS_SCAL);
        float s01 = 0.f, s23 = 0.f;
        for (int i = 0; i < 64; ++i) { s01 += p.a_lambda[i] * p.a_lambda[64 + i]; s23 += p.a_lambda[128 + i] * p.a_lambda[192 + i]; }
        SC[SC_LAM] = __expf(s01) - __expf(s23) + 0.2f;
        float g0 = 0.f, g1 = 0.f, gq = 0.f, gk = 0.f;
        for (int i = 0; i < 64; ++i) { g0 = fmaxf(g0, fabsf(p.a_qk_gain[i])); g1 = fmaxf(g1, fabsf(p.a_qk_gain[64 + i])); }
        for (int i = 0; i < 128; ++i) { gq = fmaxf(gq, fabsf(p.b_q_gain[i])); gk = fmaxf(gk, fabsf(p.b_kv_gain[i])); }
        SC[SC_MA] = 8.0f * g0 * g1 * 1.02f;
        SC[SC_MB] = 11.3137085f * gq * gk * 1.02f;
    }
}

__device__ __forceinline__ void ph_hrows(const Params& p, const float* X, const float* g, int shOff, int scOff, int gw, int ngw, int lane) {
    const float* MOD = (const float*)(p.ws + WS_MOD); bf16* H = (bf16*)(p.ws + WS_H);
    for (int m = gw; m < T; m += ngw) {
        const f32x4* xr = (const f32x4*)(X + (size_t)m * 1024) + lane;
        f32x4 v[4]; float s = 0.f;
#pragma unroll
        for (int j = 0; j < 4; ++j) { v[j] = xr[64 * j]; s += (v[j].x * v[j].x + v[j].y * v[j].y) + (v[j].z * v[j].z + v[j].w * v[j].w); }
        const float rstd = rsqrtf(wave_sum(s) * (1.f / 1024.f) + EPS);
        const float* mb = MOD + (size_t)(m >> 11) * 6144;
#pragma unroll
        for (int j = 0; j < 4; ++j) {
            const int col = 4 * (lane + 64 * j);
            const f32x4 gg = *(const f32x4*)(g + col), sc = *(const f32x4*)(mb + scOff + col), sh = *(const f32x4*)(mb + shOff + col);
            const f32x4 y = v[j] * rstd * gg * (sc + 1.0f) + sh;
            u32x2 o; o.x = pk2(y.x, y.y); o.y = pk2(y.z, y.w);
            *(u32x2*)(H + (size_t)m * 1024 + col) = o;
        }
    }
}

__device__ __forceinline__ void ph_norm_proj(const Params& p, int gw, int ngw, int lane) {
    bf16* PROJ = (bf16*)(p.ws + WS_PROJ);
    for (int m = gw; m < T; m += ngw) {
        bf16* row = PROJ + (size_t)m * NP;
#pragma unroll
        for (int j = 0; j < 6; ++j) {
            if (j == 2) continue;
            const int col = 8 * lane + 512 * j;
            const u32x4 raw = *(const u32x4*)(row + col);
            float v[8] = {bflo(raw.x), bfhi(raw.x), bflo(raw.y), bfhi(raw.y), bflo(raw.z), bfhi(raw.z), bflo(raw.w), bfhi(raw.w)};
            float ss = 0.f;
#pragma unroll
            for (int i = 0; i < 8; ++i) ss += v[i] * v[i];
            ss += __shfl_xor(ss, 1); ss += __shfl_xor(ss, 2); ss += __shfl_xor(ss, 4);
            float rstd; const float* gp;
            if (j < 2) { rstd = rsqrtf(ss * (1.f / 64.f) + EPS); gp = p.a_qk_gain + 64 * j + (col & 63); }
            else { ss += __shfl_xor(ss, 8); rstd = rsqrtf(ss * (1.f / 128.f) + EPS); gp = (j == 5 ? p.b_kv_gain : p.b_q_gain) + (col & 127); }
            if (j == 5 && lane >= 16) continue;
            const f32x4 g0 = *(const f32x4*)gp, g1 = *(const f32x4*)(gp + 4);
            u32x4 o; o.x = pk2(v[0] * rstd * g0.x, v[1] * rstd * g0.y); o.y = pk2(v[2] * rstd * g0.z, v[3] * rstd * g0.w);
            o.z = pk2(v[4] * rstd * g1.x, v[5] * rstd * g1.y); o.w = pk2(v[6] * rstd * g1.z, v[7] * rstd * g1.w);
            *(u32x4*)(row + col) = o;
        }
    }
}
struct EpiResGate {
    static constexpr bool PERM = false, AFTER_DRAIN = false;
    const float* X; float* Out; const float* gate;
    __device__ __forceinline__ void operator()(const pg8::f32x4 (&acc)[2][2][4][2], const pg8::Unit& u, int wr, int wc, int fr, int fq) const {
        const int col0 = u.pn * 256 + wc * 32 + 4 * fq;
#pragma unroll
        for (int ai = 0; ai < 2; ++ai)
#pragma unroll
            for (int m = 0; m < 4; ++m) {
                const int r = u.pm * 256 + ai * 128 + wr * 64 + m * 16 + fr; const float* gb = gate + (size_t)(r >> 11) * 6144;
#pragma unroll
                for (int bj = 0; bj < 2; ++bj)
#pragma unroll
                    for (int n = 0; n < 2; ++n) { const int c = col0 + bj * 128 + n * 16; const size_t off = (size_t)r * 1024 + c;
                        const pg8::f32x4 xv = *(const pg8::f32x4*)(X + off), gv = *(const pg8::f32x4*)(gb + c);
                        *(pg8::f32x4*)(Out + off) = xv + gv * acc[ai][bj][m][n]; }
            }
    }
};


struct EpiResGateA2 {
    static constexpr bool PERM = true, AFTER_DRAIN = false;
    const float* X; float* Out; const float* MODp; const float* g2; bf16* A2; float* SSQ;
    __device__ __forceinline__ void operator()(const pg8::f32x4 (&acc)[2][2][4][2], const pg8::Unit& u, int wr, int wc, int fr, int fq) const {
        const int row0 = u.pm * 256 + wr * 64 + fr, col0 = u.pn * 256 + wc * 32 + 8 * fq;
        const float* mb = MODp + (size_t)((u.pm * 256) >> 11) * 6144;
        pg8::f32x4 gt[2][2], gm[2][2];
#pragma unroll
        for (int bj = 0; bj < 2; ++bj)
#pragma unroll
            for (int n = 0; n < 2; ++n) { const int c = col0 + bj * 128 + 4 * n; gt[bj][n] = *(const pg8::f32x4*)(mb + 2048 + c);
                const pg8::f32x4 gg = *(const pg8::f32x4*)(g2 + c), sc = *(const pg8::f32x4*)(mb + 4096 + c); gm[bj][n] = gg * (sc + 1.0f); }
#pragma unroll
        for (int ai = 0; ai < 2; ++ai)
#pragma unroll
            for (int m = 0; m < 4; ++m) { const int r = row0 + ai * 128 + m * 16; float ss = 0.f;
#pragma unroll
                for (int bj = 0; bj < 2; ++bj) { const size_t off = (size_t)r * 1024 + col0 + bj * 128;
                    const pg8::f32x4 v0 = *(const pg8::f32x4*)(X + off) + gt[bj][0] * acc[ai][bj][m][0], v1 = *(const pg8::f32x4*)(X + off + 4) + gt[bj][1] * acc[ai][bj][m][1];
                    *(pg8::f32x4*)(Out + off) = v0; *(pg8::f32x4*)(Out + off + 4) = v1;
                    ss += ((v0[0] * v0[0] + v0[1] * v0[1]) + (v0[2] * v0[2] + v0[3] * v0[3])) + ((v1[0] * v1[0] + v1[1] * v1[1]) + (v1[2] * v1[2] + v1[3] * v1[3]));
                    const pg8::f32x4 a0 = v0 * gm[bj][0], a1 = v1 * gm[bj][1];
                    pg8::u32x4 w; w.x = pg8::cvt_pk_bf16(a0[0], a0[1]); w.y = pg8::cvt_pk_bf16(a0[2], a0[3]); w.z = pg8::cvt_pk_bf16(a1[0], a1[1]); w.w = pg8::cvt_pk_bf16(a1[2], a1[3]);
                    *(pg8::u32x4*)(A2 + off) = w; }
                ss += __shfl_xor(ss, 16); ss += __shfl_xor(ss, 32);
                if (fq == 0) SSQ[(size_t)r * 16 + u.pn * 4 + wc] = ss; }
    }
};

struct EpiQ3 {
    static constexpr bool PERM = true, AFTER_DRAIN = false;
    const float* SSQ; const float* BIAS; bf16* O;
    __device__ __forceinline__ void operator()(const pg8::f32x4 (&acc)[2][2][4][2], const pg8::Unit& u, int wr, int wc, int fr, int fq) const {
        const int row0 = u.pm * 256 + wr * 64 + fr, col0 = u.pn * 256 + wc * 32 + 8 * fq;
        const float* bb = BIAS + (size_t)((u.pm * 256) >> 11) * 1024 + col0;
        pg8::f32x4 bv[2][2];
#pragma unroll
        for (int bj = 0; bj < 2; ++bj)
#pragma unroll
            for (int n = 0; n < 2; ++n) bv[bj][n] = *(const pg8::f32x4*)(bb + bj * 128 + 4 * n);
#pragma unroll
        for (int ai = 0; ai < 2; ++ai)
#pragma unroll
            for (int m = 0; m < 4; ++m) { const int r = row0 + ai * 128 + m * 16; const pg8::f32x4 s4 = *((const pg8::f32x4*)(SSQ + (size_t)r * 16) + fq);
                float s_ = (s4[0] + s4[1]) + (s4[2] + s4[3]); s_ += __shfl_xor(s_, 16); s_ += __shfl_xor(s_, 32); const float rs = rsqrtf(s_ * (1.f / 1024.f) + EPS);
#pragma unroll
                for (int bj = 0; bj < 2; ++bj) { const pg8::f32x4 v0 = acc[ai][bj][m][0] * rs + bv[bj][0], v1 = acc[ai][bj][m][1] * rs + bv[bj][1];
                    pg8::u32x4 w; w.x = pg8::cvt_pk_bf16(v0[0], v0[1]); w.y = pg8::cvt_pk_bf16(v0[2], v0[3]); w.z = pg8::cvt_pk_bf16(v1[0], v1[1]); w.w = pg8::cvt_pk_bf16(v1[2], v1[3]);
                    *(pg8::u32x4*)(O + (size_t)r * 1024 + col0 + bj * 128) = w; } }
    }
};

__device__ __forceinline__ void ph_q3bias(const Params& p, int gw, int lane) {
    if (gw >= 64) return;
    const float* MOD = (const float*)(p.ws + WS_MOD); const bf16* WQ = (const bf16*)(p.ws + WS_WQ); float* BIAS = (float*)(p.ws + WS_QBIAS);
    const int l15 = lane & 15, g = lane >> 4, n0 = gw * 16;
    const float* ar = MOD + (size_t)l15 * 6144 + 3072 + 8 * g; const bf16* br = WQ + (size_t)(n0 + l15) * 1024 + 8 * g;
    f32x4 a = {0.f, 0.f, 0.f, 0.f};
#pragma unroll 4
    for (int ks = 0; ks < 32; ++ks) {
        const f32x4 s0 = *(const f32x4*)(ar + 32 * ks), s1 = *(const f32x4*)(ar + 32 * ks + 4);
        u32x4 aw; aw.x = pk2(s0[0], s0[1]); aw.y = pk2(s0[2], s0[3]); aw.z = pk2(s1[0], s1[1]); aw.w = pk2(s1[2], s1[3]);
        bf16x8 av; __builtin_memcpy(&av, &aw, 16);
        const bf16x8 bvv = *(const bf16x8*)(br + 32 * ks);
        a = __builtin_amdgcn_mfma_f32_16x16x32_bf16(av, bvv, a, 0, 0, 0);
    }
#pragma unroll
    for (int r = 0; r < 4; ++r) BIAS[(size_t)(4 * g + r) * 1024 + n0 + l15] = a[r];
}


struct EpiNormBf16 {
    static constexpr bool PERM = true, AFTER_DRAIN = false;
    bf16* O; const float* gqk; const float* gbq; const float* gbkv; LAS float* P; bf16* KVC;
    __device__ __forceinline__ void operator()(const pg8::f32x4 (&acc)[2][2][4][2], const pg8::Unit& u, int wr, int wc, int fr, int fq) const {
        const int pn = u.pn;
        const int mode = pn < 4 ? 1 : ((pn == 4 || pn == 5 || pn == 11) ? 0 : (pn == 10 ? 3 : 2));
        if (mode != 0) {
#pragma unroll
            for (int ai = 0; ai < 2; ++ai)
#pragma unroll
                for (int m = 0; m < 4; ++m)
#pragma unroll
                    for (int bj = 0; bj < 2; ++bj) {
                        const pg8::f32x4 a = acc[ai][bj][m][0], b = acc[ai][bj][m][1];
                        float ss = (a[0] * a[0] + a[1] * a[1]) + (a[2] * a[2] + a[3] * a[3]) + (b[0] * b[0] + b[1] * b[1]) + (b[2] * b[2] + b[3] * b[3]);
                        ss += __shfl_xor(ss, 16); ss += __shfl_xor(ss, 32);
                        if (fq == 0) P[(ai * 128 + wr * 64 + m * 16 + fr) * 8 + bj * 4 + wc] = ss;
                    }
            asm volatile("s_waitcnt lgkmcnt(0)" ::: "memory"); __builtin_amdgcn_s_barrier(); asm volatile("" ::: "memory");
        }
        const int row0 = u.pm * 256 + wr * 64 + fr, col0 = u.pn * 256 + wc * 32 + 8 * fq;
        pg8::f32x4 g0[2], g1[2];
#pragma unroll
        for (int bj = 0; bj < 2; ++bj) {
            const float* gp = nullptr;
            if (mode == 1) gp = gqk + (pn >= 2 ? 64 : 0) + 32 * (wc & 1) + 8 * fq;
            else if (mode == 2) gp = gbq + 32 * wc + 8 * fq;
            else if (mode == 3 && bj == 0) gp = gbkv + 32 * wc + 8 * fq;
            if (gp) { g0[bj] = *(const pg8::f32x4*)gp; g1[bj] = *(const pg8::f32x4*)(gp + 4); } else { g0[bj] = (pg8::f32x4){1.f, 1.f, 1.f, 1.f}; g1[bj] = g0[bj]; }
        }
#pragma unroll
        for (int ai = 0; ai < 2; ++ai)
#pragma unroll
            for (int m = 0; m < 4; ++m) { bf16* rowp = O + (size_t)(row0 + ai * 128 + m * 16) * NP + col0;
#pragma unroll
                for (int bj = 0; bj < 2; ++bj) {
                    float s = 1.f;
                    if (mode != 0 && !(mode == 3 && bj == 1)) {
                        const pg8::f32x4 q = *(const LAS pg8::f32x4*)(P + (ai * 128 + wr * 64 + m * 16 + fr) * 8 + bj * 4);
                        s = (mode == 1) ? rsqrtf(((wc < 2) ? (q[0] + q[1]) : (q[2] + q[3])) * (1.f / 64.f) + EPS) : rsqrtf(((q[0] + q[1]) + (q[2] + q[3])) * (1.f / 128.f) + EPS);
                    }
                    const pg8::f32x4 v0 = acc[ai][bj][m][0] * s * g0[bj], v1 = acc[ai][bj][m][1] * s * g1[bj];
                    pg8::u32x4 w; w.x = pg8::cvt_pk_bf16(v0[0], v0[1]); w.y = pg8::cvt_pk_bf16(v0[2], v0[3]); w.z = pg8::cvt_pk_bf16(v1[0], v1[1]); w.w = pg8::cvt_pk_bf16(v1[2], v1[3]);
                    if (pn == 10 && bj == 0) *(pg8::u32x4*)(KVC + (size_t)(row0 + ai * 128 + m * 16) * 128 + wc * 32 + 8 * fq) = w;
                    else *(pg8::u32x4*)(rowp + bj * 128) = w; } }
    }
};
typedef __bf16 bf16x2_t __attribute__((ext_vector_type(2)));
__device__ __forceinline__ float dot2bf(unsigned a, unsigned b, float acc) { return __builtin_amdgcn_fdot2_f32_bf16(__builtin_bit_cast(bf16x2_t, a), __builtin_bit_cast(bf16x2_t, b), acc, false); }
template <int CTRL> __device__ __forceinline__ float dpp_f(float v) { return __int_as_float(__builtin_amdgcn_update_dpp(0, __float_as_int(v), CTRL, 0xf, 0xf, false)); }
__device__ __forceinline__ float row16_sum(float v) {
    v += dpp_f<0x128>(v); v += dpp_f<0x124>(v); v += dpp_f<0x122>(v); v += dpp_f<0x121>(v); return v;
}
__device__ __forceinline__ float gelu_erf(float v) {
    const float av = fabsf(v), t = __builtin_amdgcn_rcpf(fmaf(av, 0.2316418882f, 1.0f));
    float q = fmaf(t, 0.5307027145f, -0.7265760135f); q = fmaf(q, t, 0.7107068705f); q = fmaf(q, t, -0.142248368f); q = fmaf(q, t, 0.127414796f); q = q * t;
    const float e = __builtin_amdgcn_exp2f(v * v * -0.72134752044f);
    const float m = v * (q * e);
    return v < 0.f ? m : v - m;
}

#ifndef DSA_PB
#define DSA_PB 0
#endif
typedef short v4i16_t __attribute__((ext_vector_type(4)));
#ifndef DSA_REP_A
#define DSA_REP_A 1
#endif
#ifndef DSA_REP_B
#define DSA_REP_B 1
#endif
#ifndef DSA_REP_C
#define DSA_REP_C 1
#endif
constexpr int DSA_SROW = 2048 * 4 + 16;
constexpr int DSA_SEL_OFF = 16 * DSA_SROW;
constexpr int DSA_LDS = DSA_SEL_OFF + 16 * 512;
constexpr int DSA_KVROW = 272;

__device__ __forceinline__ unsigned sortkey(float s) { const unsigned u = __float_as_uint(s); return u ^ ((u >> 31) ? 0xffffffffu : 0x80000000u); }
__device__ __forceinline__ unsigned cvtpk_bf16(float lo, float hi) { unsigned r; asm volatile("v_cvt_pk_bf16_f32 %0, %1, %2" : "=v"(r) : "v"(lo), "v"(hi)); return r; }

__device__ __forceinline__ void cnt_ge4(int& acc, unsigned k0, unsigned k1, unsigned k2, unsigned k3, unsigned cand) {
    asm volatile("v_cmp_ge_u32_e64 s[40:41], %1, %5\n\t"
                 "v_cmp_ge_u32_e64 s[42:43], %2, %5\n\t"
                 "v_cmp_ge_u32_e64 s[44:45], %3, %5\n\t"
                 "v_cmp_ge_u32_e64 s[46:47], %4, %5\n\t"
                 "v_addc_co_u32_e64 %0, s[48:49], %0, 0, s[40:41]\n\t"
                 "v_addc_co_u32_e64 %0, s[48:49], %0, 0, s[42:43]\n\t"
                 "v_addc_co_u32_e64 %0, s[48:49], %0, 0, s[44:45]\n\t"
                 "v_addc_co_u32_e64 %0, s[48:49], %0, 0, s[46:47]"
                 : "+v"(acc) : "v"(k0), "v"(k1), "v"(k2), "v"(k3), "v"(cand)
                 : "s40", "s41", "s42", "s43", "s44", "s45", "s46", "s47", "s48", "s49");
}
__device__ __forceinline__ void ph_dsa(const Params& p, unsigned char* lds, int vb, int nvb) {
    const bf16* PROJ = (const bf16*)(p.ws + WS_PROJ); bf16* MIX = (bf16*)(p.ws + WS_MIX);
    const float MB = ((const float*)(p.ws + WS_SCAL))[SC_MB];
    int tid = threadIdx.x; asm volatile("" : "+v"(tid)); const int lane = tid & 63, wv = __builtin_amdgcn_readfirstlane(tid >> 6);
    const int l15 = lane & 15, g = lane >> 4;
    LAS unsigned char* ldsl = (LAS unsigned char*)lds;
    for (int it = vb; it < 2048; it += nvb) {
        const int vbb = it & 255, kk = it >> 8, xg = vbb & 7, ix = vbb >> 3, b = 2 * xg + (ix & 1), G = (ix >> 1) & 3, sub = ix >> 3;
        const int c = (kk & 1) ? (31 - G - 8 * (kk >> 1)) : (G + 8 * (kk >> 1));
        const int cend = (c + 1) * 64, t0 = c * 64 + sub * 16;
        const bf16* Pb = PROJ + (size_t)b * SEQ * NP;
        const bf16* KVb = (const bf16*)(p.ws + WS_KVC) + (size_t)b * SEQ * 128;
#pragma unroll 1
        for (int repa = 0; repa < DSA_REP_A; ++repa)
        if (c >= 4) {
            const bf16* qrow = Pb + (size_t)(t0 + l15) * NP;
            bf16x8 bq[4][2]; float wsc[4];
#pragma unroll
            for (int h = 0; h < 4; ++h) { wsc[h] = bf2f(qrow[C_WI + h]) * 0.0625f;
#pragma unroll
                for (int ks = 0; ks < 2; ++ks) bq[h][ks] = *(const bf16x8*)(qrow + C_QI + h * 64 + 32 * ks + 8 * g); }
            for (int k0 = 16 * wv; k0 < cend; k0 += 128) {
                const bf16* krow = Pb + (size_t)(k0 + l15) * NP + C_KI + 8 * g;
                const bf16x8 ka0 = *(const bf16x8*)krow, ka1 = *(const bf16x8*)(krow + 32);
                f32x4 sc = {0.f, 0.f, 0.f, 0.f};
#pragma unroll
                for (int h = 0; h < 4; ++h) { f32x4 a = {0.f, 0.f, 0.f, 0.f};
                    a = __builtin_amdgcn_mfma_f32_16x16x32_bf16(ka0, bq[h][0], a, 0, 0, 0);
                    a = __builtin_amdgcn_mfma_f32_16x16x32_bf16(ka1, bq[h][1], a, 0, 0, 0);
#pragma unroll
                    for (int r = 0; r < 4; ++r) sc[r] = fmaf(fmaxf(a[r], 0.f), wsc[h], sc[r]); }
#pragma unroll
                for (int r = 0; r < 4; ++r) sc[r] = (sc[r] == 0.f) ? 0.f : sc[r];
                *(LAS f32x4*)(ldsl + l15 * DSA_SROW + (k0 + 4 * g) * 4) = sc;
            }
        }
        __syncthreads();
        f32x4 cu[4];
        { const float* src_ = p.peer_u + (size_t)(it * 8 + wv) * 1024 + lane * 4;
#pragma unroll
          for (int j = 0; j < 4; ++j) cu[j] = *(const f32x4*)(src_ + 256 * j); }
        LAS unsigned short* selw = (LAS unsigned short*)(ldsl + DSA_SEL_OFF);
        int mind0 = 0, mind1 = 0;
        if (c < 4) {
            for (int j = lane; j < 256; j += 64) { selw[(2 * wv) * 256 + j] = (unsigned short)j; selw[(2 * wv + 1) * 256 + j] = (unsigned short)j; }
        } else {
            const int nreg = cend >> 6;
            unsigned keyA[32], keyB[32];
            { const LAS float* srA = (const LAS float*)(ldsl + (2 * wv) * DSA_SROW) + lane; const LAS float* srB = (const LAS float*)(ldsl + (2 * wv + 1) * DSA_SROW) + lane;
#pragma unroll
              for (int i = 0; i < 32; ++i) { keyA[i] = (i < nreg) ? sortkey(srA[64 * i]) : 0u; keyB[i] = (i < nreg) ? sortkey(srB[64 * i]) : 0u; } }
#define DSA_WSUM(V, OUT) do { int v_ = (V); v_ += __builtin_amdgcn_update_dpp(0, v_, 0x128, 0xf, 0xf, false); v_ += __builtin_amdgcn_update_dpp(0, v_, 0x124, 0xf, 0xf, false); \
        v_ += __builtin_amdgcn_update_dpp(0, v_, 0x122, 0xf, 0xf, false); v_ += __builtin_amdgcn_update_dpp(0, v_, 0x121, 0xf, 0xf, false);                                     \
        OUT = __builtin_amdgcn_readlane(v_, 0) + __builtin_amdgcn_readlane(v_, 16) + __builtin_amdgcn_readlane(v_, 32) + __builtin_amdgcn_readlane(v_, 48); } while (0)
            unsigned prefA = 0u, prefB = 0u; bool exA = false, exB = false;
#pragma unroll 1
            for (int bit = 31; bit >= 0; --bit) {
                const unsigned candA = exA ? prefA : (prefA | (1u << bit)), candB = exB ? prefB : (prefB | (1u << bit));
                int ca = 0, cb = 0;
#pragma unroll
                for (int i = 0; i < 32; i += 4) { cnt_ge4(ca, keyA[i], keyA[i + 1], keyA[i + 2], keyA[i + 3], candA); cnt_ge4(cb, keyB[i], keyB[i + 1], keyB[i + 2], keyB[i + 3], candB); }
                int cntA, cntB; DSA_WSUM(ca, cntA); DSA_WSUM(cb, cntB);
                if (!exA && cntA >= 256) { prefA = candA; exA = (cntA == 256); }
                if (!exB && cntB >= 256) { prefB = candB; exB = (cntB == 256); }
                if (exA && exB) break;
            }
#define DSA_COMPACT(KEY, PREFIX, EXACT, QQ, MIND) do {                                                                                              \
            const int t_ = t0 + (QQ); LAS unsigned short* sel = selw + (QQ) * 256;                                                                    \
            int need_ties = 0;                                                                                                                        \
            if (!(EXACT)) { int cg_ = 0; if ((PREFIX) != 0xffffffffu) { _Pragma("unroll") for (int i = 0; i < 32; ++i) cg_ += (KEY[i] > (PREFIX)) ? 1 : 0; } \
                int cgt; DSA_WSUM(cg_, cgt); need_ties = 256 - cgt; }                                                                                 \
            int base = 0, tbase = 0, md = 4096;                                                                                                       \
            _Pragma("unroll") for (int i = 0; i < 32; ++i) { if (i < nreg) {                                                                          \
                bool selb;                                                                                                                            \
                if (EXACT) selb = KEY[i] >= (PREFIX);                                                                                                 \
                else { const bool tie = KEY[i] == (PREFIX); const unsigned long long mt = __ballot(tie);                                              \
                    const int trank = tbase + (int)__builtin_amdgcn_mbcnt_hi((unsigned)(mt >> 32), __builtin_amdgcn_mbcnt_lo((unsigned)mt, 0u));      \
                    selb = (KEY[i] > (PREFIX)) || (tie && trank < need_ties); tbase += __popcll(mt); }                                                \
                const unsigned long long m = __ballot(selb);                                                                                          \
                const int pos = base + (int)__builtin_amdgcn_mbcnt_hi((unsigned)(m >> 32), __builtin_amdgcn_mbcnt_lo((unsigned)m, 0u));               \
                const int kidx = i * 64 + lane;                                                                                                       \
                if (selb) { sel[pos] = (unsigned short)kidx; const int d = t_ > kidx ? t_ - kidx : kidx - t_; md = d < md ? d : md; }                 \
                base += __popcll(m); } }                                                                                                              \
            _Pragma("unroll") for (int o = 1; o < 64; o <<= 1) { const int x = __shfl_xor(md, o); md = x < md ? x : md; }                             \
            MIND = md; } while (0)
            DSA_COMPACT(keyA, prefA, exA, 2 * wv, mind0);
            DSA_COMPACT(keyB, prefB, exB, 2 * wv + 1, mind1);
#undef DSA_COMPACT
#undef DSA_WSUM
        }
        { unsigned char* dst_ = (unsigned char*)(p.ws + WS_U16) + (size_t)(it * 8 + wv) * 1024 + lane * 4;
#pragma unroll
          for (int j = 0; j < 4; ++j) { int w_ = 0; w_ = __builtin_amdgcn_cvt_pk_fp8_f32(cu[j].x * 32.0f, cu[j].y * 32.0f, w_, false); w_ = __builtin_amdgcn_cvt_pk_fp8_f32(cu[j].z * 32.0f, cu[j].w * 32.0f, w_, true);
              *(unsigned*)(dst_ + 256 * j) = (unsigned)w_; } }
        LDS_WAIT(); asm volatile("" ::: "memory");
        const int nvalid = cend < 256 ? cend : 256;
        const int head = lane & 7;
        const float slopeL2 = exp2f(-(float)(head + 1)) * 1.4426950409f;
#pragma unroll 1
        for (int qi2 = 0; qi2 < 2 * DSA_REP_C; ++qi2) { const int qi = qi2 & 1;
            const int qq = 2 * wv + qi, t = t0 + qq;
            const LAS unsigned short* sel = selw + qq * 256;
            const bf16* qrow = Pb + (size_t)t * NP + C_QB + head * 128 + 8 * g;
            bf16x8 bq[4];
#pragma unroll
            for (int ks = 0; ks < 4; ++ks) bq[ks] = *(const bf16x8*)(qrow + 32 * ks);
            const float refL2 = MB * 1.4426950409f - slopeL2 * (float)(qi == 0 ? mind0 : mind1);
            f32x4 o[8];
#pragma unroll
            for (int dt = 0; dt < 8; ++dt) o[dt] = (f32x4){0.f, 0.f, 0.f, 0.f};
            float lsum = 0.f;
#define DSA_GATHER(S, BUF) do { _Pragma("unroll") for (int i_ = 0; i_ < 8; ++i_) { const int jr = 32 * (S) + 4 * i_ + g; const int keyr = sel[jr < nvalid ? jr : 0];   \
        __builtin_amdgcn_global_load_lds((const unsigned*)(KVb + (size_t)keyr * 128 + 8 * (l15 ^ ((4 * i_ + g) & 15))), (unsigned*)((BUF) + 1024 * i_), 16, 0, 0); } } while (0)
#define DSA_COMPUTE(S, BUF) do { unsigned pb[4]; const LAS unsigned char* stg = (const LAS unsigned char*)(BUF);                                          \
        _Pragma("unroll") for (int tl = 0; tl < 2; ++tl) { const int j0 = 32 * (S) + 16 * tl;                                                           \
            f32x4 a = {0.f, 0.f, 0.f, 0.f};                                                                                                             \
            _Pragma("unroll") for (int ks = 0; ks < 4; ++ks) { const bf16x8 ka_ = *(const LAS bf16x8*)(stg + (16 * tl + l15) * 256 + (((4 * ks + g) ^ l15) << 4)); \
                a = __builtin_amdgcn_mfma_f32_16x16x32_bf16(ka_, bq[ks], a, 0, 0, 0); }                                                                 \
            const u32x2 kw = *(const LAS u32x2*)(sel + j0 + 4 * g);                                                                                     \
            const int kx[4] = {(int)(kw.x & 0xffffu), (int)(kw.x >> 16), (int)(kw.y & 0xffffu), (int)(kw.y >> 16)};                                     \
            float pr[4];                                                                                                                                \
            _Pragma("unroll") for (int r = 0; r < 4; ++r) { const int dd = t > kx[r] ? t - kx[r] : kx[r] - t;                                            \
                const float e = __builtin_amdgcn_exp2f(fmaf(a[r], 0.1275174f, -slopeL2 * (float)dd - refL2));                                            \
                pr[r] = (j0 + 4 * g + r < nvalid) ? e : 0.f; lsum += pr[r]; }                                                                           \
            pb[2 * tl] = cvtpk_bf16(pr[0], pr[1]); pb[2 * tl + 1] = cvtpk_bf16(pr[2], pr[3]); }                                                         \
        u32x4 pw4; pw4.x = pb[0]; pw4.y = pb[1]; pw4.z = pb[2]; pw4.w = pb[3];                                                                          \
        const bf16x8 pfrag = __builtin_bit_cast(bf16x8, pw4);                                                                                           \
        const int rr_ = 4 * g + (l15 >> 2);                                                                                                             \
        _Pragma("unroll") for (int dt = 0; dt < 8; ++dt) {                                                                                              \
            const LAS unsigned char* trp = stg + rr_ * 256 + (((2 * dt + ((lane & 3) >> 1)) ^ rr_) << 4) + 8 * (lane & 1);                                \
            const s16x4 lo = __builtin_bit_cast(s16x4, __builtin_amdgcn_ds_read_tr16_b64_v4i16((LAS v4i16_t*)trp));                                    \
            const s16x4 hi = __builtin_bit_cast(s16x4, __builtin_amdgcn_ds_read_tr16_b64_v4i16((LAS v4i16_t*)(trp + 16 * 256)));                        \
            const bf16x8 af = {lo[0], lo[1], lo[2], lo[3], hi[0], hi[1], hi[2], hi[3]};                                                                 \
            o[dt] = __builtin_amdgcn_mfma_f32_16x16x32_bf16(af, pfrag, o[dt], 0, 0, 0); }                                                               \
        LDS_WAIT(); asm volatile("" ::: "memory"); } while (0)
            const int nch = (nvalid + 31) >> 5;
            unsigned char* buf0 = lds + (2 * wv) * DSA_SROW; unsigned char* buf1 = buf0 + 8192;
            DSA_GATHER(0, buf0);
#pragma unroll 1
            for (int s = 0; s < nch; s += 2) {
                if (s + 1 < nch) DSA_GATHER(s + 1, buf1);
                if (s + 1 < nch) asm volatile("s_waitcnt vmcnt(8)" ::: "memory"); else asm volatile("s_waitcnt vmcnt(0)" ::: "memory");
                DSA_COMPUTE(s, buf0);
                if (s + 1 < nch) { if (s + 2 < nch) DSA_GATHER(s + 2, buf0);
                    if (s + 2 < nch) asm volatile("s_waitcnt vmcnt(8)" ::: "memory"); else asm volatile("s_waitcnt vmcnt(0)" ::: "memory");
                    DSA_COMPUTE(s + 1, buf1); }
            }
#undef DSA_GATHER
#undef DSA_COMPUTE
            lsum += __shfl_xor(lsum, 16); lsum += __shfl_xor(lsum, 32);
            const float il = 1.f / lsum;
            if (l15 < 8) {
                bf16* orow = MIX + (size_t)(b * SEQ + t) * MIXW + 512 + head * 128 + 4 * g;
#pragma unroll
                for (int dt = 0; dt < 8; ++dt) { u32x2 w; w.x = pk2(o[dt][0] * il, o[dt][1] * il); w.y = pk2(o[dt][2] * il, o[dt][3] * il); *(u32x2*)(orow + 16 * dt) = w; }
            }
        }
        __syncthreads();
    }
}
typedef __attribute__((address_space(1))) float GASF;
#ifndef ATT_PROBE
#define ATT_PROBE 0
#endif
#ifndef ATT_REMAP
#define ATT_REMAP 1
#endif
__device__ __forceinline__ int crow(int r, int hi) { return (r & 3) + 8 * (r >> 2) + 4 * hi; }
#define KSWZ64(row, cb) ((row) * 128 + ((cb) ^ ((((row) >> 1) & 7) << 4)))
__device__ __forceinline__ int v_st(int k, int c) { const int kk = (k & ~0xC) | ((k & 4) << 1) | ((k & 8) >> 1); return ((kk >> 3) * 4 + (c >> 5)) * 512 + ((kk & 7) * 32 + (c & 31)) * 2; }
__device__ __forceinline__ int v_rd_base(int lane) { return ((lane & 3) << 3) | (((lane >> 2) & 3) << 6) | (((lane >> 4) & 1) << 5) | (((lane >> 5) & 1) << 8); }
constexpr int v_rd_off(int d0, int ks, int half) { return d0 * 512 + ks * 4096 + half * 2048; }
template <int OFF> __device__ __forceinline__ s16x4 tr_read(int vb) {
    s16x4 r; asm volatile("ds_read_b64_tr_b16 %0, %1 offset:%2" : "=&v"(r) : "v"(vb), "i"(OFF) : "memory"); return r;
}
template <int D0> __device__ __forceinline__ void pv_one(f32x16& od, int vb, bf16x8 pa0, bf16x8 pa1, bf16x8 pa2, bf16x8 pa3) {
    const s16x4 l0 = tr_read<v_rd_off(D0, 0, 0)>(vb), h0 = tr_read<v_rd_off(D0, 0, 1)>(vb), l1 = tr_read<v_rd_off(D0, 1, 0)>(vb), h1 = tr_read<v_rd_off(D0, 1, 1)>(vb);
    const s16x4 l2 = tr_read<v_rd_off(D0, 2, 0)>(vb), h2 = tr_read<v_rd_off(D0, 2, 1)>(vb), l3 = tr_read<v_rd_off(D0, 3, 0)>(vb), h3 = tr_read<v_rd_off(D0, 3, 1)>(vb);
    asm volatile("s_waitcnt lgkmcnt(0)" ::: "memory"); __builtin_amdgcn_sched_barrier(0);
#define PK(L, H) (bf16x8){L[0], L[1], L[2], L[3], H[0], H[1], H[2], H[3]}
    od = __builtin_amdgcn_mfma_f32_32x32x16_bf16(pa0, PK(l0, h0), od, 0, 0, 0);
    od = __builtin_amdgcn_mfma_f32_32x32x16_bf16(pa1, PK(l1, h1), od, 0, 0, 0);
    od = __builtin_amdgcn_mfma_f32_32x32x16_bf16(pa2, PK(l2, h2), od, 0, 0, 0);
    od = __builtin_amdgcn_mfma_f32_32x32x16_bf16(pa3, PK(l3, h3), od, 0, 0, 0);
#undef PK
}

__device__ __forceinline__ void att_tile(f32x16 (&o)[4], float& lsum, const unsigned char* Kb, int vb0, const unsigned char* Qw, int r32, int hi, int tq, int j, bool past, float slopeL2, float refL2) {
    constexpr float C = 0.125f * 1.4426950409f;
    bf16x8 qr[4];
#pragma unroll
    for (int d0 = 0; d0 < 4; ++d0) qr[d0] = *(const bf16x8*)(Qw + KSWZ64(r32, (d0 * 16 + hi * 8) * 2));
    const float dq = (float)(tq - 64 * j - 4 * hi);
    const float B0 = -slopeL2 * dq - refL2;
    float ps = 0.f;
    bf16x8 pa0, pa1, pa2, pa3;
#define PK4(P, BASE, OUT) do { unsigned a0 = cvtpk_bf16(P[BASE + 0], P[BASE + 1]), a1 = cvtpk_bf16(P[BASE + 2], P[BASE + 3]);   \
    unsigned b0_ = cvtpk_bf16(P[BASE + 4], P[BASE + 5]), b1_ = cvtpk_bf16(P[BASE + 6], P[BASE + 7]);                              \
    auto r0 = __builtin_amdgcn_permlane32_swap(a0, b0_, false, false); auto r1 = __builtin_amdgcn_permlane32_swap(a1, b1_, false, false); \
    u32x4 w = {r0[0], r1[0], r0[1], r1[1]}; OUT = __builtin_bit_cast(bf16x8, w); } while (0)
#define HALF_TILE(KOFF, FOFF, PA, PB) do { f32x16 pp = f32x16{};                                                                     \
    _Pragma("unroll") for (int d0 = 0; d0 < 4; ++d0) { const int cb = (d0 * 16 + hi * 8) * 2;                                        \
        const bf16x8 bk = *(const bf16x8*)(Kb + KSWZ64((KOFF) + r32, cb)); pp = __builtin_amdgcn_mfma_f32_32x32x16_bf16(bk, qr[d0], pp, 0, 0, 0); } \
    if (past) { _Pragma("unroll") for (int r = 0; r < 16; ++r) { const float off = (float)((r & 3) + 8 * (r >> 2)) + (FOFF);          \
            pp[r] = __builtin_amdgcn_exp2f(fmaf(pp[r], C, fmaf(slopeL2, off, B0))); } }                                               \
    else { _Pragma("unroll") for (int r = 0; r < 16; ++r) { const float off = (float)((r & 3) + 8 * (r >> 2)) + (FOFF);               \
            pp[r] = __builtin_amdgcn_exp2f(fmaf(pp[r], C, -slopeL2 * fabsf(dq - off) - refL2)); } }                                   \
    _Pragma("unroll") for (int r = 0; r < 16; ++r) ps += pp[r];                                                                       \
    PK4(pp, 0, PA); PK4(pp, 8, PB); __builtin_amdgcn_sched_barrier(0); } while (0)
    HALF_TILE(0, 0.f, pa0, pa1);
    HALF_TILE(32, 32.f, pa2, pa3);
#undef HALF_TILE
#undef PK4
    { auto rr = __builtin_amdgcn_permlane32_swap(__float_as_uint(ps), __float_as_uint(ps), false, false);
      ps = __uint_as_float(rr[0]) + __uint_as_float(rr[1]); }
    lsum += ps;
    pv_one<0>(o[0], vb0, pa0, pa1, pa2, pa3); pv_one<1>(o[1], vb0, pa0, pa1, pa2, pa3); pv_one<2>(o[2], vb0, pa0, pa1, pa2, pa3); pv_one<3>(o[3], vb0, pa0, pa1, pa2, pa3);
}
constexpr int ATT_LDS = 2 * 16384 + 2 * 8192 + 8 * 256 + 8 * 4096;

__device__ __forceinline__ void ph_attnA(const Params& p, unsigned char* lds, int vb, int nvb) {
    const bf16* PROJ = (const bf16*)(p.ws + WS_PROJ); bf16* MIX = (bf16*)(p.ws + WS_MIX);
    const float* SC = (const float*)(p.ws + WS_SCAL);
    const float lam = SC[SC_LAM], refL2 = SC[SC_MA] * 1.4426950409f;
    constexpr float C = 0.125f * 1.4426950409f;
    int tid = threadIdx.x; asm volatile("" : "+v"(tid)); const int lane = tid & 63, wid = __builtin_amdgcn_readfirstlane(tid >> 6), r32 = lane & 31, hi = lane >> 5;
    unsigned char* V_lds = lds; unsigned char* K_lds = lds + 32768;
    float* wsf = (float*)(lds + 49152) + wid * 64;
    GASF* tmpw = (GASF*)(p.ws + WS_ATMP) + ((size_t)(vb * NWV + wid) * 64) * 64 + lane;
    const int vbase = (int)(uintptr_t)V_lds + v_rd_base(lane);
    const int krow = tid >> 3, kch = tid & 7, kdst = KSWZ64(krow, kch * 16);
    const int sr = tid >> 4, sc = (tid & 15) * 8, vst0 = v_st(sr, sc), vst1 = v_st(32 + sr, sc);
    for (int it = vb; it < 256; it += nvb) {
        #if ATT_REMAP
        const int xg_ = it & 7, m_ = it >> 3, pidx = xg_ * 8 + (m_ >> 2), qbl = m_ & 3, b = pidx >> 2, h = pidx & 3;
#else
        const int b = it >> 4, h = (it >> 2) & 3, qbl = it & 3;
#endif
        const float slopeL2 = exp2f(-2.0f * (float)(h + 1)) * 1.4426950409f;
        const bf16* Pb = PROJ + (size_t)b * SEQ * NP;
#pragma unroll 1
        for (int half = 0; half < 2; ++half) {
            const int qb = half ? 7 - qbl : qbl, q0 = 256 * qb, NTu = 4 * (qb + 1), cw = 4 * qb + (wid >> 1);
            const int tq = q0 + 32 * wid + r32;
#pragma unroll 1
            for (int mi = 0; mi < 2; ++mi) {
                const int m = 1 - mi;
                const bf16* Kg = Pb + C_KA + h * 128 + m * 64 + (size_t)krow * NP + kch * 8;
                const bf16* Vg = Pb + C_VA + h * 128 + (size_t)sr * NP + sc;
                unsigned char* Qw = lds + 51200 + wid * 4096;
                { const bf16* qp = Pb + (size_t)tq * NP + C_QA + h * 128 + m * 64 + hi * 8;
#pragma unroll
                  for (int d0 = 0; d0 < 4; ++d0) *(bf16x8*)(Qw + KSWZ64(r32, (d0 * 16 + hi * 8) * 2)) = *(const bf16x8*)(qp + d0 * 16); }
                f32x16 o[4];
#pragma unroll
                for (int d = 0; d < 4; ++d) o[d] = f32x16{};
                float lsum = 0.f;
                bf16x8 ak, av0, av1;
#define ATT_LOAD(K_, V0_, V1_, TJ) do { const size_t go_ = (size_t)(TJ) * 64 * NP; K_ = *(const bf16x8*)(Kg + go_); V0_ = *(const bf16x8*)(Vg + go_); V1_ = *(const bf16x8*)(Vg + go_ + (size_t)32 * NP); \
        if (ATT_PROBE == 2) { bf16x8 d0_ = *(const volatile bf16x8*)(Kg + go_); bf16x8 d1_ = *(const volatile bf16x8*)(Vg + go_); bf16x8 d2_ = *(const volatile bf16x8*)(Vg + go_ + (size_t)32 * NP); asm volatile("" :: "v"(d0_), "v"(d1_), "v"(d2_)); } } while (0)
#define ATT_WRITE(K_, V0_, V1_, NB) do { *(bf16x8*)(K_lds + (NB) * 8192 + kdst) = K_; *(bf16x8*)(V_lds + (NB) * 16384 + vst0) = V0_; *(bf16x8*)(V_lds + (NB) * 16384 + vst1) = V1_; } while (0)
                ATT_LOAD(ak, av0, av1, 0); ATT_WRITE(ak, av0, av1, 0);
                __syncthreads();
#pragma unroll 1
                for (int j = 0; j < NTu; ++j) {
                    const int buf = j & 1;
                    if (j + 1 < NTu) ATT_LOAD(ak, av0, av1, j + 1);
                    if (j <= cw) { att_tile(o, lsum, K_lds + buf * 8192, vbase + buf * 16384, Qw, r32, hi, tq, j, j < cw, slopeL2, refL2);
#if ATT_PROBE == 1
                        { f32x16 o2[4]; o2[0] = o[0]; o2[1] = o[1]; o2[2] = o[2]; o2[3] = o[3]; float l2 = 0.f; att_tile(o2, l2, K_lds + buf * 8192, vbase + buf * 16384, Qw, r32, hi, tq, j, j < cw, slopeL2, refL2);
                          asm volatile("" :: "v"(o2[0]), "v"(o2[1]), "v"(o2[2]), "v"(o2[3]), "v"(l2)); }
#endif
                    }
                    if (j + 1 < NTu) ATT_WRITE(ak, av0, av1, buf ^ 1);
                    __syncthreads();
                }
#undef ATT_LOAD
#undef ATT_WRITE
                if (hi == 0) wsf[r32] = lsum;
                LDS_WAIT(); asm volatile("" ::: "memory");
                float rli[16];
#pragma unroll
                for (int r = 0; r < 16; ++r) rli[r] = 1.f / wsf[crow(r, hi)];
                LDS_WAIT(); asm volatile("" ::: "memory");
                if (mi == 0) {
#pragma unroll
                    for (int d = 0; d < 4; ++d) { GASF* td = tmpw + d * 1024; asm volatile("" : "+v"(td));
#pragma unroll
                        for (int r = 0; r < 16; ++r) td[r * 64] = o[d][r] * rli[r]; }
                } else {
                    float gsub[4];
#pragma unroll
                    for (int d = 0; d < 4; ++d) gsub[d] = p.a_sub_gain[32 * d + r32];
                    GASF* tdp[4];
#pragma unroll
                    for (int d = 0; d < 4; ++d) { tdp[d] = tmpw + d * 1024; asm volatile("" : "+v"(tdp[d])); }
#pragma unroll
                    for (int r = 0; r < 16; ++r) {
                        float v[4]; float ss = 0.f;
#pragma unroll
                        for (int d = 0; d < 4; ++d) { v[d] = o[d][r] * rli[r] - lam * tdp[d][r * 64]; ss += v[d] * v[d]; }
                        ss += __shfl_xor(ss, 1); ss += __shfl_xor(ss, 2); ss += __shfl_xor(ss, 4); ss += __shfl_xor(ss, 8); ss += __shfl_xor(ss, 16);
                        const float rs = rsqrtf(ss * (1.f / 128.f) + EPS) * 0.8f;
                        bf16* orow = MIX + (size_t)(b * SEQ + q0 + 32 * wid + crow(r, hi)) * MIXW + h * 128 + r32;
#pragma unroll
                        for (int d = 0; d < 4; ++d) orow[32 * d] = (bf16)f2bf(v[d] * rs * gsub[d]);
                        asm volatile("" ::: "memory");
                    }
                }
            }
        }
    }
}
constexpr int RT_WAVE_BYTES = 12288;
constexpr int RT_LDS = 32768 + 8 * RT_WAVE_BYTES;

__device__ __forceinline__ int pl32_sum(int v) { auto rr = __builtin_amdgcn_permlane32_swap((unsigned)v, (unsigned)v, false, false); return (int)(rr[0] + rr[1]); }
__device__ __forceinline__ int pl32_other(int v) { auto rr = __builtin_amdgcn_permlane32_swap((unsigned)v, (unsigned)v, false, false); return (int)(rr[0] + rr[1]) - v; }
__device__ __forceinline__ float unsortkey(unsigned k) { return __uint_as_float((k & 0x80000000u) ? (k ^ 0x80000000u) : ~k); }

__device__ __forceinline__ unsigned wave_or(unsigned v) {
    v |= (unsigned)__builtin_amdgcn_update_dpp(0, (int)v, 0x128, 0xf, 0xf, false); v |= (unsigned)__builtin_amdgcn_update_dpp(0, (int)v, 0x124, 0xf, 0xf, false);
    v |= (unsigned)__builtin_amdgcn_update_dpp(0, (int)v, 0x122, 0xf, 0xf, false); v |= (unsigned)__builtin_amdgcn_update_dpp(0, (int)v, 0x121, 0xf, 0xf, false);
    return (unsigned)(__builtin_amdgcn_readlane((int)v, 0) | __builtin_amdgcn_readlane((int)v, 16) | __builtin_amdgcn_readlane((int)v, 32) | __builtin_amdgcn_readlane((int)v, 48));
}
template <int N> __device__ __forceinline__ unsigned bisect16(const unsigned (&key)[N]) {
    unsigned kmx, lo;
    { unsigned gm[8];
#pragma unroll
      for (int g = 0; g < 8; ++g) { gm[g] = key[g];
#pragma unroll
          for (int i = g + 8; i < N; i += 8) gm[g] = key[i] > gm[g] ? key[i] : gm[g]; }
      kmx = gm[0]; lo = gm[0];
#pragma unroll
      for (int g = 1; g < 8; ++g) { kmx = gm[g] > kmx ? gm[g] : kmx; lo = gm[g] < lo ? gm[g] : lo; }
      const unsigned okmx = (unsigned)pl32_other((int)kmx), olo = (unsigned)pl32_other((int)lo);
      kmx = okmx > kmx ? okmx : kmx; lo = olo < lo ? olo : lo; }
    const unsigned x = kmx - lo;
    int pb = x ? 31 - __clz(x) : -1;
    unsigned prefix = 0u; bool done = (x == 0u);
#pragma unroll 1
    while (!__all(done)) {
        const unsigned c_ = done ? prefix : (prefix | (1u << pb));
        unsigned cand = lo + c_; cand = cand < lo ? 0xffffffffu : cand;
        int cnt = 0;
#pragma unroll
        for (int i = 0; i + 3 < N; i += 4) cnt_ge4(cnt, key[i], key[i + 1], key[i + 2], key[i + 3], cand);
#pragma unroll
        for (int i = N & ~3; i < N; ++i) cnt += (key[i] >= cand) ? 1 : 0;
        const int tot = pl32_sum(cnt);
        if (!done && tot >= 16) { prefix = c_; done = (tot == 16); }
        --pb; done = done || (pb < 0);
    }
    prefix += lo;
    return prefix;
}

__device__ __forceinline__ void ph_route_subk(const Params& p, unsigned char* lds) {
    const bf16* SUBK = (const bf16*)(p.ws + WS_SUBK);
    int tid = threadIdx.x; asm volatile("" : "+v"(tid));
    for (int i = tid; i < 2048; i += NT) { const int row = i >> 3, ch = i & 7; ((u32x4*)lds)[row * 8 + (ch ^ ((row >> 1) & 7))] = ((const u32x4*)SUBK)[i]; }
    __syncthreads();
}
__device__ __forceinline__ void ph_route(const Params& p, unsigned char* lds, int item0, int item1, int wrank, int nwr) {
    const bf16* Q3 = (const bf16*)(p.ws + WS_Q3);
    int* EXPI = (int*)(p.ws + WS_EXP); float* GATE = (float*)(p.ws + WS_GATE);
    int tid = threadIdx.x; asm volatile("" : "+v"(tid));
    const int lane = tid & 63, wv = __builtin_amdgcn_readfirstlane(tid >> 6), r32 = lane & 31, hi = lane >> 5;
    unsigned char* wl = lds + 32768 + wv * RT_WAVE_BYTES;
    float* sv = (float*)wl; int* si = (int*)(wl + 4096); float* fv = (float*)(wl + 8192); int* fe = (int*)(wl + 10240);
    for (int item = item0 + wrank; item < item1; item += nwr) {
        const int h = item & 7, tok0 = (item >> 3) * 32;
        const bf16* qrow = Q3 + (size_t)(tok0 + r32) * 1024 + h * 128 + hi * 8;
#pragma unroll 1
        for (int c = 0; c < 2; ++c) {
            f32x4 cv[4]; const int crow = item * 2 + c;
            { const float* src_ = p.peer_v + (size_t)crow * 1024 + lane * 4;
#pragma unroll
              for (int j = 0; j < 4; ++j) cv[j] = *(const f32x4*)(src_ + 256 * j); }
            bf16x8 bq[4];
#pragma unroll
            for (int d0 = 0; d0 < 4; ++d0) bq[d0] = *(const bf16x8*)(qrow + c * 64 + d0 * 16);
            unsigned key[64];
#pragma unroll
            for (int nt = 0; nt < 4; ++nt) {
                f32x16 acc = f32x16{};
                const int krow = c * 128 + nt * 32 + r32, ksw = (krow >> 1) & 7;
                const unsigned char* kp = lds + krow * 128;
#pragma unroll
                for (int d0 = 0; d0 < 4; ++d0) { const bf16x8 ak = *(const bf16x8*)(kp + (((2 * d0 + hi) ^ ksw) << 4)); acc = __builtin_amdgcn_mfma_f32_32x32x16_bf16(ak, bq[d0], acc, 0, 0, 0); }
#pragma unroll
                for (int r = 0; r < 16; ++r) key[nt * 16 + r] = sortkey(acc[r]);
            }
            const unsigned thr = bisect16<64>(key);
            int cnt = 0;
#pragma unroll
            for (int i = 0; i < 64; ++i) cnt += (key[i] >= thr) ? 1 : 0;
            const int other_ = pl32_other(cnt); int slot = hi ? other_ : 0;
            float* svp = sv + (r32 * 2 + c) * 16; int* sip = si + (r32 * 2 + c) * 16;
#pragma unroll
            for (int i = 0; i < 64; ++i) {
                if (key[i] >= thr && slot < 16) { svp[slot] = unsortkey(key[i]); sip[slot] = 32 * (i >> 4) + ((i & 3) + 8 * ((i & 15) >> 2)) + 4 * hi; ++slot; }
            }
            { unsigned char* dst_ = (unsigned char*)(p.ws + WS_V16) + (size_t)crow * 1024 + lane * 4;
#pragma unroll
              for (int j = 0; j < 4; ++j) { int w_ = 0; w_ = __builtin_amdgcn_cvt_pk_fp8_f32(cv[j].x, cv[j].y, w_, false); w_ = __builtin_amdgcn_cvt_pk_fp8_f32(cv[j].z, cv[j].w, w_, true);
                  *(unsigned*)(dst_ + 256 * j) = (unsigned)w_; } }
        }
        LDS_WAIT(); asm volatile("" ::: "memory");
        u32x4 hb[4]; f32x4 hs, hsh[4];
#define RT_H2_LOAD(HALF) do { const int tk_ = tok0 + 16 * (HALF) + (lane >> 3), p8_ = lane & 7; const int cc_ = h * 128 + 8 * p8_;                            \
            const bf16* hp_ = (const bf16*)(p.ws + WS_H) + (size_t)tk_ * 1024 + cc_;                                                                       \
            const float* sh_ = (const float*)(p.ws + WS_MOD) + (size_t)(tk_ >> 11) * 6144 + 3072 + cc_;                                                    \
            _Pragma("unroll") for (int j = 0; j < 4; ++j) hb[j] = *(const u32x4*)(hp_ + (size_t)(j >> 1) * 8 * 1024 + 64 * (j & 1));                        \
            hs = *((const f32x4*)(p.ws + WS_SSQ) + (size_t)(tk_ + 8 * (p8_ >> 2)) * 4 + (p8_ & 3));                                                        \
            hsh[0] = *(const f32x4*)sh_; hsh[1] = *(const f32x4*)(sh_ + 4); hsh[2] = *(const f32x4*)(sh_ + 64); hsh[3] = *(const f32x4*)(sh_ + 68); } while (0)
#define RT_H2_STORE(HALF) do { const int tk_ = tok0 + 16 * (HALF) + (lane >> 3), p8_ = lane & 7; const int cc_ = h * 128 + 8 * p8_;                           \
            bf16* hp_ = (bf16*)(p.ws + WS_H) + (size_t)tk_ * 1024 + cc_;                                                                                   \
            float s_ = (hs[0] + hs[1]) + (hs[2] + hs[3]); s_ += __shfl_xor(s_, 1); s_ += __shfl_xor(s_, 2);                                                 \
            const float so_ = __shfl_xor(s_, 4); const float rsme_ = rsqrtf(s_ * (1.f / 1024.f) + EPS), rsot_ = rsqrtf(so_ * (1.f / 1024.f) + EPS);           \
            const float rs0_ = (p8_ & 4) ? rsot_ : rsme_, rs1_ = (p8_ & 4) ? rsme_ : rsot_;                           \
            _Pragma("unroll") for (int j = 0; j < 4; ++j) { const f32x4 a_ = hsh[2 * (j & 1)], b_ = hsh[2 * (j & 1) + 1]; const float rs_ = (j >> 1) ? rs1_ : rs0_; u32x4 w_; \
                w_.x = cvtpk_bf16(fmaf(bflo(hb[j].x), rs_, a_[0]), fmaf(bfhi(hb[j].x), rs_, a_[1])); w_.y = cvtpk_bf16(fmaf(bflo(hb[j].y), rs_, a_[2]), fmaf(bfhi(hb[j].y), rs_, a_[3])); \
                w_.z = cvtpk_bf16(fmaf(bflo(hb[j].z), rs_, b_[0]), fmaf(bfhi(hb[j].z), rs_, b_[1])); w_.w = cvtpk_bf16(fmaf(bflo(hb[j].w), rs_, b_[2]), fmaf(bfhi(hb[j].w), rs_, b_[3])); \
                *(u32x4*)(hp_ + (size_t)(j >> 1) * 8 * 1024 + 64 * (j & 1)) = w_; } } while (0)
        RT_H2_LOAD(0);
        LDS_WAIT(); asm volatile("" ::: "memory");
        {
            float* sv0 = sv + (r32 * 2) * 16; float* sv1 = sv0 + 16; int* si0 = si + (r32 * 2) * 16; int* si1 = si0 + 16;
            {
                float a[16], bl[16];
#pragma unroll
                for (int k = 0; k < 16; ++k) { a[k] = sv0[k]; bl[k] = sv1[k]; }
                int ia[8], ib[8], ra[8], rb[8]; float va[8], vb[8];
#pragma unroll
                for (int q = 0; q < 8; ++q) { const int e = 8 * hi + q; va[q] = sv0[e]; vb[q] = sv1[e]; ia[q] = si0[e]; ib[q] = si1[e]; int r0 = 0, r1 = 0;
#pragma unroll
                    for (int k = 0; k < 16; ++k) { r0 += (a[k] > va[q] || (a[k] == va[q] && k < e)) ? 1 : 0; r1 += (bl[k] > vb[q] || (bl[k] == vb[q] && k < e)) ? 1 : 0; }
                    ra[q] = r0; rb[q] = r1; }
                LDS_WAIT(); asm volatile("" ::: "memory");
                { auto rr = __builtin_amdgcn_permlane32_swap(0u, 0u, false, false); (void)rr; }
#pragma unroll
                for (int q = 0; q < 8; ++q) { sv0[ra[q]] = va[q]; si0[ra[q]] = ia[q]; sv1[rb[q]] = vb[q]; si1[rb[q]] = ib[q]; }
                LDS_WAIT(); asm volatile("" ::: "memory");
            }
            const float* X = hi ? sv1 : sv0; const float* Y = hi ? sv0 : sv1;
            float x[4], y[16];
#pragma unroll
            for (int k = 0; k < 4; ++k) x[k] = X[k];
#pragma unroll
            for (int k = 0; k < 16; ++k) y[k] = Y[k];
            unsigned key[27]; int pi[27], pj[27]; int np = 0;
#pragma unroll
            for (int i = 0; i < 3; ++i)
#pragma unroll
                for (int j = i + 1; j < 16; ++j) if ((i + 1) * (j + 1) <= 16) { key[np] = sortkey(x[i] + y[j]); pi[np] = i; pj[np] = j; ++np; }
#pragma unroll
            for (int i = 0; i < 4; ++i) { key[23 + i] = hi ? 0u : sortkey(x[i] + y[i]); pi[23 + i] = i; pj[23 + i] = i; }
            RT_H2_STORE(0); RT_H2_LOAD(1);
            const unsigned thr = bisect16<27>(key);
            int cnt = 0;
#pragma unroll
            for (int i = 0; i < 27; ++i) cnt += (key[i] >= thr) ? 1 : 0;
            const int other_ = pl32_other(cnt); int slot = hi ? other_ : 0;
            const int* IX = hi ? si1 : si0; const int* IY = hi ? si0 : si1;
            float* fvp = fv + r32 * 16; int* fep = fe + r32 * 16;
#pragma unroll
            for (int i = 0; i < 27; ++i) {
                if (key[i] >= thr && slot < 16) { const int ex = IX[pi[i]], ey = IY[pj[i]]; fvp[slot] = unsortkey(key[i]); fep[slot] = hi ? (ey * 128 + ex) : (ex * 128 + ey); ++slot; }
            }
        }
        LDS_WAIT(); asm volatile("" ::: "memory");
        {
            const float* fvp = fv + r32 * 16;
            float v[16]; float mx = -3e38f;
#pragma unroll
            for (int k = 0; k < 16; ++k) { v[k] = fvp[k]; mx = fmaxf(mx, v[k]); }
            float l = 0.f;
#pragma unroll
            for (int k = 0; k < 16; ++k) { v[k] = __expf(v[k] - mx); l += v[k]; }
            const float il = 1.f / l;
            const size_t ob = (size_t)(tok0 + r32) * 128 + h * 16 + 8 * hi;
            const int* fep = fe + r32 * 16 + 8 * hi;
            f32x4 g0, g1; u32x4 e0, e1;
            if (hi == 0) { g0 = (f32x4){v[0] * il, v[1] * il, v[2] * il, v[3] * il}; g1 = (f32x4){v[4] * il, v[5] * il, v[6] * il, v[7] * il}; }
            else { g0 = (f32x4){v[8] * il, v[9] * il, v[10] * il, v[11] * il}; g1 = (f32x4){v[12] * il, v[13] * il, v[14] * il, v[15] * il}; }
            e0 = *(const u32x4*)fep; e1 = *(const u32x4*)(fep + 4);
            *(f32x4*)(GATE + ob) = g0; *(f32x4*)(GATE + ob + 4) = g1;
            *(u32x4*)(EXPI + ob) = e0; *(u32x4*)(EXPI + ob + 4) = e1;
        }
        RT_H2_STORE(1);
#undef RT_H2_LOAD
#undef RT_H2_STORE
        LDS_WAIT(); asm volatile("" ::: "memory");
    }
}
typedef float f32x2_t __attribute__((ext_vector_type(2)));
constexpr int P8_UNITS = T / 64;
constexpr int CW_P8_U = 4096, CW_P8_V = 4096 + 32 * 64;
constexpr float U8_SCALE = 32.0f;
__device__ __forceinline__ unsigned peer_xcc() { return (unsigned)__builtin_amdgcn_s_getreg((3 << 11) | 20) & 7u; }
#ifndef U8_HALVES
#define U8_HALVES 0
#endif
template <int LPR>
__device__ __forceinline__ void ph_peer_v8g(const Params& p, unsigned char* lds) {
    constexpr int RPI = 64 / LPR, NI = 128 / RPI, G = NI / 8, NS = 64 / LPR, SLB = 16 * LPR;
    const unsigned char* V8 = (const unsigned char*)(p.ws + WS_V16);
    const int* EXPI = (const int*)(p.ws + WS_EXP); const float* CBUF = (const float*)(p.ws + WS_CBUF); const float* MOD = (const float*)(p.ws + WS_MOD);
    const float* AB1 = (const float*)(p.ws + WS_ABUF1); const float* GATEP = (const float*)(p.ws + WS_GATE); (void)AB1; (void)GATEP;
    unsigned* ctl = (unsigned*)(p.ws + WS_CTL);
    int tid = threadIdx.x; asm volatile("" : "+v"(tid));
    const int lane = tid & 63, wv = __builtin_amdgcn_readfirstlane(tid >> 6), gR = lane / LPR, iC = lane % LPR;
    volatile LAS unsigned* slot = (volatile LAS unsigned*)(LAS unsigned char*)lds;
    const unsigned xcc = peer_xcc();
#pragma unroll 1
    for (int k = 0; k < NS; ++k) {
        const int sl = (int)((((xcc * NS) >> 3) + (unsigned)k) % (unsigned)NS);
        const unsigned char* vcol = V8 + SLB * sl + 16 * iC;
#pragma unroll 1
        for (;;) {
            if (tid == 0) *slot = __hip_atomic_fetch_add(ctl + CW_P8_V + 64 * sl, 1u, __ATOMIC_RELAXED, __HIP_MEMORY_SCOPE_AGENT);
            __syncthreads();
            const unsigned unit = *slot;
            __syncthreads();
            if (unit >= (unsigned)P8_UNITS) break;
            const int tbase = (int)unit * 64 + wv * 8;
            int ne0, ne1; float nc0, nc1;
#if U8_HALVES
#define VG_FETCH(T) do { const size_t tn_ = (size_t)(T); ne0 = EXPI[tn_ * 128 + lane]; ne1 = EXPI[tn_ * 128 + 64 + lane];                              \
        nc0 = gelu_erf(CBUF[tn_ * 128 + lane] + AB1[tn_ * 128 + lane]) * GATEP[tn_ * 128 + lane];                                              \
        nc1 = gelu_erf(CBUF[tn_ * 128 + 64 + lane] + AB1[tn_ * 128 + 64 + lane]) * GATEP[tn_ * 128 + 64 + lane]; } while (0)
#else
#define VG_FETCH(T) do { const size_t tn_ = (size_t)(T); ne0 = EXPI[tn_ * 128 + lane]; ne1 = EXPI[tn_ * 128 + 64 + lane]; nc0 = CBUF[tn_ * 128 + lane]; nc1 = CBUF[tn_ * 128 + 64 + lane]; } while (0)
#endif
#define VG_LISTS(LE, LC) do { LE[lane] = ne0; LE[64 + lane] = ne1; LC[lane] = nc0; LC[64 + lane] = nc1; } while (0)
#define VG_ROWS(R, LE, GI) do { _Pragma("unroll") for (int kk = 0; kk < 8; ++kk) R[kk] = *(const u32x4*)(vcol + (size_t)LE[RPI * (8 * (GI) + kk) + gR] * 1024); } while (0)
#define VG_GROUP(R, LC, GI) do { _Pragma("unroll") for (int kk = 0; kk < 8; ++kk) { const float cj = LC[RPI * (8 * (GI) + kk) + gR];                       \
            const unsigned w_[4] = {R[kk].x, R[kk].y, R[kk].z, R[kk].w};                                                                       \
            _Pragma("unroll") for (int c = 0; c < 4; ++c) { const f32x2_t lo = __builtin_amdgcn_cvt_pk_f32_fp8((int)w_[c], false), hi = __builtin_amdgcn_cvt_pk_f32_fp8((int)w_[c], true); \
                acc[4 * c] = fmaf(cj, lo.x, acc[4 * c]); acc[4 * c + 1] = fmaf(cj, lo.y, acc[4 * c + 1]); acc[4 * c + 2] = fmaf(cj, hi.x, acc[4 * c + 2]); acc[4 * c + 3] = fmaf(cj, hi.y, acc[4 * c + 3]); } } } while (0)
            u32x4 RA[8], RB[8];
            int* lecur = (int*)(lds + 1024 + wv * 2048); int* lenxt = lecur + 256;
            VG_FETCH(tbase); VG_LISTS(lecur, ((float*)(lecur + 128))); VG_FETCH(tbase + 1);
            LDS_WAIT(); asm volatile("" ::: "memory");
            VG_ROWS(RA, lecur, 0);
#pragma unroll 1
            for (int tt = 0; tt < 8; ++tt) {
                const int t = tbase + tt;
                float* lccur = (float*)(lecur + 128); float* lcnxt = (float*)(lenxt + 128);
                float acc[16];
#pragma unroll
                for (int q = 0; q < 16; ++q) acc[q] = 0.f;
                if (tt + 1 < 8) { VG_LISTS(lenxt, lcnxt); if (tt + 2 < 8) VG_FETCH(t + 2); }
#pragma unroll 1
                for (int gi = 0; gi < G; gi += 2) {
                    VG_ROWS(RB, lecur, gi + 1);
                    VG_GROUP(RA, lccur, gi);
                    if (gi + 2 < G) VG_ROWS(RA, lecur, gi + 2);
                    else if (tt + 1 < 8) { LDS_WAIT(); asm volatile("" ::: "memory"); VG_ROWS(RA, lenxt, 0); }
                    VG_GROUP(RB, lccur, gi + 1);
                }
#pragma unroll
                for (int q = 0; q < 16; ++q) { if (LPR <= 8) acc[q] += dpp_f<0x128>(acc[q]); if (LPR <= 16) acc[q] += __shfl_xor(acc[q], 16); if (LPR <= 32) acc[q] += __shfl_xor(acc[q], 32); }
                if (gR == 0) { const int col = SLB * sl + 16 * iC; const float* g2 = MOD + (size_t)(t >> 11) * 6144 + 5120 + col; float* orow = p.out + (size_t)t * 1024 + col;
#pragma unroll
                    for (int q = 0; q < 4; ++q) { const f32x4 xv = *(const f32x4*)(orow + 4 * q), hv = *(const f32x4*)(g2 + 4 * q);
                        f32x4 r; r.x = acc[4 * q]; r.y = acc[4 * q + 1]; r.z = acc[4 * q + 2]; r.w = acc[4 * q + 3]; *(f32x4*)(orow + 4 * q) = xv + hv * r; } }
                { int* tmp_ = lecur; lecur = lenxt; lenxt = tmp_; }
            }
#undef VG_FETCH
#undef VG_LISTS
#undef VG_ROWS
#undef VG_GROUP
            LDS_WAIT(); asm volatile("" ::: "memory");
        }
    }
}
#ifndef SORT_BITS
#define SORT_BITS 3
#endif
#ifndef PEER_SORT
#define PEER_SORT 1
#endif
template <bool DEEP> __device__ __forceinline__ void ph_peer_u8p(const Params& p, unsigned char* lds_w, int tb, int te, int gw, int ngw, int lane_) {
    int lane = lane_; asm volatile("" : "+v"(lane));
    const bf16* H = (const bf16*)(p.ws + WS_H); const unsigned char* U8 = (const unsigned char*)(p.ws + WS_U16); const unsigned char* V8 = (const unsigned char*)(p.ws + WS_V16);
    const int* EXPI = (const int*)(p.ws + WS_EXP); const float* GATE = (const float*)(p.ws + WS_GATE); const float* MOD = (const float*)(p.ws + WS_MOD);
    int* e_lds = (int*)lds_w; float* a_lds = (float*)(lds_w + 512); float* g_lds = (float*)(lds_w + 1024); (void)g_lds;
    const int g = lane >> 4, i = lane & 15;
    if (DEEP) __builtin_amdgcn_s_setprio(3);
#pragma unroll 1
    for (int t = tb + gw, k_ = 0; t < te; t += ngw, ++k_) {
        int e0 = EXPI[(size_t)t * 128 + lane], e1 = EXPI[(size_t)t * 128 + 64 + lane];
        float g0 = GATE[(size_t)t * 128 + lane], g1 = GATE[(size_t)t * 128 + 64 + lane];
#if PEER_SORT
        {
            const int flip_ = (k_ & 1) ? ((1 << SORT_BITS) - 1) : 0;
            const int d0 = (e0 >> (14 - SORT_BITS)) ^ flip_, d1 = (e1 >> (14 - SORT_BITS)) ^ flip_; int pos0 = 0, pos1 = 0, run = 0;
#pragma unroll
            for (int d = 0; d < (1 << SORT_BITS); ++d) {
                const unsigned long long m0 = __ballot(d0 == d), m1 = __ballot(d1 == d);
                const int c0 = __popcll(m0), c1 = __popcll(m1);
                const int r0 = (int)__builtin_amdgcn_mbcnt_hi((unsigned)(m0 >> 32), __builtin_amdgcn_mbcnt_lo((unsigned)m0, 0u));
                const int r1 = (int)__builtin_amdgcn_mbcnt_hi((unsigned)(m1 >> 32), __builtin_amdgcn_mbcnt_lo((unsigned)m1, 0u));
                pos0 = (d0 == d) ? run + r0 : pos0; pos1 = (d1 == d) ? run + c0 + r1 : pos1; run += c0 + c1;
            }
            e_lds[pos0] = e0; e_lds[pos1] = e1; g_lds[pos0] = g0; g_lds[pos1] = g1;
            LDS_WAIT(); asm volatile("" ::: "memory");
            e0 = e_lds[lane]; e1 = e_lds[64 + lane]; g0 = g_lds[lane]; g1 = g_lds[64 + lane];
            int* EW = (int*)(p.ws + WS_EXP) + (size_t)t * 128; EW[lane] = e0; EW[64 + lane] = e1;
        }
#else
        e_lds[lane] = e0; e_lds[64 + lane] = e1;
#endif
        float xf[64];
        { const u32x4* xrow = (const u32x4*)(H + (size_t)t * 1024) + 2 * i;
#pragma unroll
          for (int q = 0; q < 4; ++q) { const u32x4 a = xrow[32 * q], b = xrow[32 * q + 1];
              xf[16 * q] = bflo(a.x); xf[16 * q + 1] = bfhi(a.x); xf[16 * q + 2] = bflo(a.y); xf[16 * q + 3] = bfhi(a.y); xf[16 * q + 4] = bflo(a.z); xf[16 * q + 5] = bfhi(a.z); xf[16 * q + 6] = bflo(a.w); xf[16 * q + 7] = bfhi(a.w);
              xf[16 * q + 8] = bflo(b.x); xf[16 * q + 9] = bfhi(b.x); xf[16 * q + 10] = bflo(b.y); xf[16 * q + 11] = bfhi(b.y); xf[16 * q + 12] = bflo(b.z); xf[16 * q + 13] = bfhi(b.z); xf[16 * q + 14] = bflo(b.w); xf[16 * q + 15] = bfhi(b.w); } }
        LDS_WAIT(); asm volatile("" ::: "memory");
#define P8T_ULOAD(R, S) do { const u32x4* r_ = (const u32x4*)(U8 + (size_t)e_lds[4 * (S) + g] * 1024) + i; _Pragma("unroll") for (int q = 0; q < 4; ++q) R[q] = r_[16 * q]; } while (0)
#define P8T_UDOT(R, S) do { float a0 = 0.f, a1 = 0.f, a2 = 0.f, a3 = 0.f;                                                                               \
        _Pragma("unroll") for (int q = 0; q < 4; ++q) { const unsigned w_[4] = {R[q].x, R[q].y, R[q].z, R[q].w};                                           \
            _Pragma("unroll") for (int c = 0; c < 4; ++c) { const f32x2_t lo = __builtin_amdgcn_cvt_pk_f32_fp8((int)w_[c], false), hi = __builtin_amdgcn_cvt_pk_f32_fp8((int)w_[c], true); \
                a0 = fmaf(lo.x, xf[16 * q + 4 * c], a0); a1 = fmaf(lo.y, xf[16 * q + 4 * c + 1], a1); a2 = fmaf(hi.x, xf[16 * q + 4 * c + 2], a2); a3 = fmaf(hi.y, xf[16 * q + 4 * c + 3], a3); } } \
        const float a_ = row16_sum((a0 + a1) + (a2 + a3)) * (1.0f / U8_SCALE); if (i == 0) a_lds[4 * (S) + g] = a_; } while (0)
        if (!DEEP) { u32x4 RA[4], RB[4], RC[4];
          P8T_ULOAD(RA, 0); P8T_ULOAD(RB, 1);
#pragma unroll 1
          for (int s = 0; s < 30; s += 3) {
              P8T_ULOAD(RC, s + 2); P8T_UDOT(RA, s);
              P8T_ULOAD(RA, s + 3); P8T_UDOT(RB, s + 1);
              P8T_ULOAD(RB, s + 4); P8T_UDOT(RC, s + 2);
          }
          P8T_UDOT(RA, 30); P8T_UDOT(RB, 31); }
        else { u32x4 R0[4], R1[4], R2[4], R3[4], R4[4], R5[4];
          P8T_ULOAD(R0, 0); P8T_ULOAD(R1, 1); P8T_ULOAD(R2, 2); P8T_ULOAD(R3, 3); P8T_ULOAD(R4, 4);
#pragma unroll 1
          for (int s = 0; s < 24; s += 6) {
              P8T_ULOAD(R5, s + 5); P8T_UDOT(R0, s);
              P8T_ULOAD(R0, s + 6); P8T_UDOT(R1, s + 1);
              P8T_ULOAD(R1, s + 7); P8T_UDOT(R2, s + 2);
              P8T_ULOAD(R2, s + 8); P8T_UDOT(R3, s + 3);
              P8T_ULOAD(R3, s + 9); P8T_UDOT(R4, s + 4);
              P8T_ULOAD(R4, s + 10); P8T_UDOT(R5, s + 5);
          }
          P8T_ULOAD(R5, 29); P8T_UDOT(R0, 24);
          P8T_ULOAD(R0, 30); P8T_UDOT(R1, 25);
          P8T_ULOAD(R1, 31); P8T_UDOT(R2, 26);
          P8T_UDOT(R3, 27); P8T_UDOT(R4, 28); P8T_UDOT(R5, 29); P8T_UDOT(R0, 30); P8T_UDOT(R1, 31); }
#undef P8T_ULOAD
#undef P8T_UDOT
        LDS_WAIT(); asm volatile("" ::: "memory");
        const float c0 = gelu_erf(a_lds[lane]) * g0, c1 = gelu_erf(a_lds[64 + lane]) * g1;
        float* CB = (float*)(p.ws + WS_CBUF) + (size_t)t * 128; CB[lane] = c0; CB[64 + lane] = c1;
    }
    if (DEEP) __builtin_amdgcn_s_setprio(0);
}
__device__ __forceinline__ void ph_peer_u8h(const Params& p, unsigned char* lds) {
    const bf16* H = (const bf16*)(p.ws + WS_H); const unsigned char* U8 = (const unsigned char*)(p.ws + WS_U16);
    const int* EXPI = (const int*)(p.ws + WS_EXP);
    unsigned* ctl = (unsigned*)(p.ws + WS_CTL);
    int tid = threadIdx.x; asm volatile("" : "+v"(tid));
    const int lane = tid & 63, wv = __builtin_amdgcn_readfirstlane(tid >> 6), hw = lane >> 5, i5 = lane & 31;
    volatile LAS unsigned* slot = (volatile LAS unsigned*)(LAS unsigned char*)lds;
    float* a_lds = (float*)(lds + 1024 + wv * 2048 + 1024);
    const unsigned xcc = peer_xcc();
#pragma unroll 1
    for (int k = 0; k < 2; ++k) {
        const int sl = (int)(((xcc >> 2) + (unsigned)k) & 1u);
        float* AB = (float*)(p.ws + (sl ? WS_ABUF1 : WS_CBUF));
        const unsigned char* ucol = U8 + 512 * sl + 16 * i5;
#pragma unroll 1
        for (;;) {
            if (tid == 0) *slot = __hip_atomic_fetch_add(ctl + CW_P8_U + 64 * sl, 1u, __ATOMIC_RELAXED, __HIP_MEMORY_SCOPE_AGENT);
            __syncthreads();
            const unsigned unit = *slot;
            __syncthreads();
            if (unit >= (unsigned)P8_UNITS) break;
            const int tbase = (int)unit * 64 + wv * 8;
            int ne0, ne1; u32x4 nx0, nx1;
#define UH_FETCH(T) do { const size_t tn_ = (size_t)(T); ne0 = EXPI[tn_ * 128 + lane]; ne1 = EXPI[tn_ * 128 + 64 + lane];                          \
        const u32x4* xr_ = (const u32x4*)(H + tn_ * 1024 + 512 * sl) + 2 * i5; nx0 = xr_[0]; nx1 = xr_[1]; } while (0)
#define UH_LISTS(LE) do { LE[lane] = ne0; LE[64 + lane] = ne1; } while (0)
#define UH_ROWS(R, LE, GI) do { _Pragma("unroll") for (int kk = 0; kk < 8; ++kk) R[kk] = *(const u32x4*)(ucol + (size_t)LE[2 * (8 * (GI) + kk) + hw] * 1024); } while (0)
#define UH_GROUP(R, GI) do { _Pragma("unroll") for (int kk = 0; kk < 8; ++kk) { float a0 = 0.f, a1 = 0.f, a2 = 0.f, a3 = 0.f;                         \
            const unsigned w_[4] = {R[kk].x, R[kk].y, R[kk].z, R[kk].w};                                                                       \
            _Pragma("unroll") for (int c = 0; c < 4; ++c) { const f32x2_t lo = __builtin_amdgcn_cvt_pk_f32_fp8((int)w_[c], false), hi = __builtin_amdgcn_cvt_pk_f32_fp8((int)w_[c], true); \
                a0 = fmaf(lo.x, xf[4 * c], a0); a1 = fmaf(lo.y, xf[4 * c + 1], a1); a2 = fmaf(hi.x, xf[4 * c + 2], a2); a3 = fmaf(hi.y, xf[4 * c + 3], a3); }                        \
            float s_ = row16_sum((a0 + a1) + (a2 + a3)); s_ += __shfl_xor(s_, 16);                                                              \
            if (i5 == 0) a_lds[2 * (8 * (GI) + kk) + hw] = s_ * (1.0f / U8_SCALE); } } while (0)
            u32x4 RA[8], RB[8];
            int* lecur = (int*)(lds + 1024 + wv * 2048); int* lenxt = lecur + 128;
            UH_FETCH(tbase); UH_LISTS(lecur);
            float xf[16];
#define UH_XF() do { xf[0] = bflo(nx0.x); xf[1] = bfhi(nx0.x); xf[2] = bflo(nx0.y); xf[3] = bfhi(nx0.y); xf[4] = bflo(nx0.z); xf[5] = bfhi(nx0.z); xf[6] = bflo(nx0.w); xf[7] = bfhi(nx0.w); \
        xf[8] = bflo(nx1.x); xf[9] = bfhi(nx1.x); xf[10] = bflo(nx1.y); xf[11] = bfhi(nx1.y); xf[12] = bflo(nx1.z); xf[13] = bfhi(nx1.z); xf[14] = bflo(nx1.w); xf[15] = bfhi(nx1.w); } while (0)
            UH_XF();
            UH_FETCH(tbase + 1);
            LDS_WAIT(); asm volatile("" ::: "memory");
            UH_ROWS(RA, lecur, 0);
#pragma unroll 1
            for (int tt = 0; tt < 8; ++tt) {
                const int t = tbase + tt;
                float xn[16];
                if (tt + 1 < 8) { UH_LISTS(lenxt);
#pragma unroll
                    for (int q = 0; q < 16; ++q) xn[q] = 0.f;
                    xn[0] = bflo(nx0.x); xn[1] = bfhi(nx0.x); xn[2] = bflo(nx0.y); xn[3] = bfhi(nx0.y); xn[4] = bflo(nx0.z); xn[5] = bfhi(nx0.z); xn[6] = bflo(nx0.w); xn[7] = bfhi(nx0.w);
                    xn[8] = bflo(nx1.x); xn[9] = bfhi(nx1.x); xn[10] = bflo(nx1.y); xn[11] = bfhi(nx1.y); xn[12] = bflo(nx1.z); xn[13] = bfhi(nx1.z); xn[14] = bflo(nx1.w); xn[15] = bfhi(nx1.w);
                    if (tt + 2 < 8) UH_FETCH(t + 2); }
#pragma unroll 1
                for (int gi = 0; gi < 8; gi += 2) {
                    UH_ROWS(RB, lecur, gi + 1);
                    UH_GROUP(RA, gi);
                    if (gi + 2 < 8) UH_ROWS(RA, lecur, gi + 2);
                    else if (tt + 1 < 8) { LDS_WAIT(); asm volatile("" ::: "memory"); UH_ROWS(RA, lenxt, 0); }
                    UH_GROUP(RB, gi + 1);
                }
                LDS_WAIT(); asm volatile("" ::: "memory");
                { float* ab = AB + (size_t)t * 128; ab[lane] = a_lds[lane]; ab[64 + lane] = a_lds[64 + lane]; }
                LDS_WAIT(); asm volatile("" ::: "memory");
                if (tt + 1 < 8) {
#pragma unroll
                    for (int q = 0; q < 16; ++q) xf[q] = xn[q]; }
                { int* tmp_ = lecur; lecur = lenxt; lenxt = tmp_; }
            }
#undef UH_FETCH
#undef UH_LISTS
#undef UH_ROWS
#undef UH_GROUP
#undef UH_XF
        }
    }
}
#define XB_TMO      128
#define XB_XCNT(j)  (256  + 64 * (j))
#define XB_XSUB(j)  (1280 + 64 * (j))
#define XB_XGEN(j)  (2304 + 64 * (j))
#define XB_TOP      3328
#define XB_TOPGEN   3392
#define XCD_BAR_WORDS 3456
#define XB_SPIN_CAP (1u << 18)

__device__ __forceinline__ unsigned xb_ld(unsigned* p)              { return __hip_atomic_load(p, __ATOMIC_RELAXED, __HIP_MEMORY_SCOPE_AGENT); }
__device__ __forceinline__ unsigned xb_add(unsigned* p, unsigned v) { return __hip_atomic_fetch_add(p, v, __ATOMIC_RELAXED, __HIP_MEMORY_SCOPE_AGENT); }
__device__ __forceinline__ unsigned xb_xcc_id() { return (unsigned)__builtin_amdgcn_s_getreg((3 << 11) | 20) & 0xFu; }
#define XB_SPIN(cond, bar) do { unsigned _sp = 0; while (cond) { __builtin_amdgcn_s_sleep(1); \
    if ((++_sp & 255u) == 0u) { if (xb_ld(&(bar)[XB_TMO])) break; if (_sp > XB_SPIN_CAP) { atomicAdd(&(bar)[XB_TMO], 1u); break; } } } } while (0)

struct XcdBarrier {
    unsigned* bar; unsigned x;
    volatile LAS unsigned* st;
};

__device__ __forceinline__ XcdBarrier xcd_barrier_post(unsigned* bar, volatile LAS unsigned* st) {
    XcdBarrier b; b.bar = bar; b.x = xb_xcc_id(); b.st = st;
    if (threadIdx.x == 0) (void)xb_add(&bar[XB_XCNT(b.x)], 1u);
    return b;
}
__device__ __forceinline__ void xcd_barrier_complete(unsigned* bar, unsigned x, unsigned& nloc, unsigned& nx) {
    const unsigned G = gridDim.x * gridDim.y * gridDim.z;
    unsigned sum, cnt, mine, sp = 0u;
    for (;;) {
        sum = 0u; cnt = 0u; mine = 0u;
#pragma unroll
        for (unsigned j = 0; j < 16; ++j) { const unsigned c = xb_ld(&bar[XB_XCNT(j)]); sum += c; cnt += (c > 0u) ? 1u : 0u; mine = (j == x) ? c : mine; }
        if (sum == G) break;
        __builtin_amdgcn_s_sleep(1);
        if ((++sp & 255u) == 0u) { if (xb_ld(&bar[XB_TMO])) break; if (sp > XB_SPIN_CAP) { atomicAdd(&bar[XB_TMO], 1u); break; } }
    }
    nloc = mine > 0u ? mine : 1u; nx = cnt > 0u ? cnt : 1u;
}

__device__ __forceinline__ void xcd_barrier(const XcdBarrier& b) {
    asm volatile("s_waitcnt vmcnt(0)" ::: "memory");
    __syncthreads();
    if (threadIdx.x == 0) {
        unsigned* bar = b.bar;
        __builtin_amdgcn_s_waitcnt(0);
        unsigned nloc = b.st[0], nx = b.st[1];
        if (nloc == 0u) { xcd_barrier_complete(bar, b.x, nloc, nx); b.st[0] = nloc; b.st[1] = nx; }
        const unsigned old = xb_add(&bar[XB_XSUB(b.x)], 1u);
        const unsigned gen = old / nloc;
        if (old + 1u == (gen + 1u) * nloc) {
            __builtin_amdgcn_fence(__ATOMIC_RELEASE, "agent");
            asm volatile("s_waitcnt vmcnt(0)" ::: "memory");
            const unsigned og = xb_add(&bar[XB_TOP], 1u);
            const unsigned tg = og / nx;
            if (og + 1u == (tg + 1u) * nx) xb_add(&bar[XB_TOPGEN], 1u);
            else XB_SPIN(xb_ld(&bar[XB_TOPGEN]) == tg, bar);
            __builtin_amdgcn_fence(__ATOMIC_ACQUIRE, "agent");
            xb_add(&bar[XB_XGEN(b.x)], 1u);
            asm volatile("s_waitcnt vmcnt(0)" ::: "memory");
        } else {
            XB_SPIN(xb_ld(&bar[XB_XGEN(b.x)]) == gen, bar);
            __builtin_amdgcn_fence(__ATOMIC_ACQUIRE, "agent");
            asm volatile("s_waitcnt vmcnt(0)" ::: "memory");
        }
    }
    __syncthreads();
}

#ifndef V8_LPR
#define V8_LPR 32
#endif
constexpr int LDS_BYTES = 147456;
extern __shared__ __attribute__((aligned(16))) unsigned char dyn_lds[];

__global__ void __launch_bounds__(NT, 2) mega_fwd(Params p) {
    cg::grid_group grid = cg::this_grid();
    const int vb = blockIdx.x, nvb = gridDim.x, ngw = nvb * NWV;
    volatile LAS unsigned* xst = (volatile LAS unsigned*)((LAS unsigned char*)dyn_lds + (LDS_BYTES - 16));
    if (threadIdx.x < 4) xst[threadIdx.x] = 0u;
    __syncthreads();
    const XcdBarrier xbar = xcd_barrier_post((unsigned*)(p.ws + WS_CTL), xst);
#define TID_LAUNDER int tid_ = threadIdx.x; asm volatile("" : "+v"(tid_)); const int lane = tid_ & 63, wv = tid_ >> 6, gw = vb * NWV + wv; (void)lane; (void)gw;
    grid.sync();
    ph_mod(p, (float*)dyn_lds, vb, nvb);
    { TID_LAUNDER ph_prep_weights(p, (LAS float*)dyn_lds + wv * (64 * 33), gw, ngw, lane); }
    xcd_barrier(xbar);
    { TID_LAUNDER ph_hrows(p, p.x, p.norm1_g, 0, 1024, gw, ngw, lane); ph_q3bias(p, gw, lane); }
    xcd_barrier(xbar);
    {   pg8::Gemm g{(const bf16*)(p.ws + WS_H), (const bf16*)(p.ws + WS_WIN), T, NP, 1024}; pg8::StaticOrder S; S.init(T, NP, nvb, vb);
        EpiNormBf16 E{(bf16*)(p.ws + WS_PROJ), p.a_qk_gain, p.b_q_gain, p.b_kv_gain, (LAS float*)((LAS unsigned char*)dyn_lds + 131072), (bf16*)(p.ws + WS_KVC)};
        pg8::gemm_phase<EpiNormBf16, pg8::StaticOrder, true, true>((LAS unsigned char*)dyn_lds, g, S, E); }
    xcd_barrier(xbar);
    ph_attnA(p, dyn_lds, vb, nvb);
    __syncthreads();
    ph_dsa(p, dyn_lds, vb, nvb);
    xcd_barrier(xbar);
    {   pg8::Gemm g{(const bf16*)(p.ws + WS_MIX), (const bf16*)(p.ws + WS_WO2), T, 1024, MIXW}; pg8::StaticOrder S; S.init(T, 1024, nvb, vb);
        EpiResGateA2 E{p.x, p.out, (const float*)(p.ws + WS_MOD), p.norm2_g, (bf16*)(p.ws + WS_H), (float*)(p.ws + WS_SSQ)};
        pg8::gemm_phase<EpiResGateA2, pg8::StaticOrder, true, true>((LAS unsigned char*)dyn_lds, g, S, E); }
    xcd_barrier(xbar);
    {   pg8::Gemm g{(const bf16*)(p.ws + WS_H), (const bf16*)(p.ws + WS_WQ), T, 1024, 1024}; pg8::StaticOrder S; S.init(T, 1024, nvb, vb);
        EpiQ3 E{(const float*)(p.ws + WS_SSQ), (const float*)(p.ws + WS_QBIAS), (bf16*)(p.ws + WS_Q3)};
        pg8::gemm_phase<EpiQ3, pg8::StaticOrder, true, true>((LAS unsigned char*)dyn_lds, g, S, E); }
    xcd_barrier(xbar);
    ph_route_subk(p, dyn_lds);
    { TID_LAUNDER ph_route(p, dyn_lds, 0, 2048, gw, ngw); }
    xcd_barrier(xbar);
#pragma unroll 1
    for (int k = 1; k < 4; ++k) {
        { TID_LAUNDER
          if (wv < 4) ph_route(p, dyn_lds, k * 2048, (k + 1) * 2048, vb * 4 + wv, nvb * 4);
          else ph_peer_u8p<true>(p, dyn_lds + 131072 + wv * 2048, (k - 1) * 8192, k * 8192, vb * 4 + (wv - 4), nvb * 4, lane); }
        xcd_barrier(xbar);
    }
    { TID_LAUNDER ph_peer_u8p<false>(p, dyn_lds + 131072 + wv * 2048, 3 * 8192, 4 * 8192, gw, ngw, lane); }
    xcd_barrier(xbar);
    ph_peer_v8g<V8_LPR>(p, dyn_lds);

}

extern "C" void kernel_launch(void* const* d_in, const int* in_sizes, int n_in, void* d_out, int out_size, void* d_ws, size_t ws_size, hipStream_t stream) {
    static int grid_blocks = 0;
    if (grid_blocks == 0) {
        if (n_in != 18 || in_sizes[0] != T * DM || out_size != T * DM || ws_size < WS_END) { fprintf(stderr, "kernel_launch: unexpected shapes n_in %d in0 %d out %d ws %zu\n", n_in, n_in > 0 ? in_sizes[0] : -1, out_size, ws_size); grid_blocks = -1; return; }
        int dev = 0, cus = 0, per_cu = 0;
        (void)hipGetDevice(&dev);
        (void)hipDeviceGetAttribute(&cus, hipDeviceAttributeMultiprocessorCount, dev);
        (void)hipFuncSetAttribute((const void*)mega_fwd, hipFuncAttributeMaxDynamicSharedMemorySize, LDS_BYTES);
        (void)hipOccupancyMaxActiveBlocksPerMultiprocessor(&per_cu, (const void*)mega_fwd, NT, LDS_BYTES);
        if (per_cu < 1 || cus < 1) { fprintf(stderr, "kernel_launch: occupancy query gave %d blocks/CU on %d CUs\n", per_cu, cus); grid_blocks = -1; return; }
        grid_blocks = cus;
    }
    if (grid_blocks < 0) return;
    Params p{};
    const float** pp = (const float**)&p;
    for (int i = 0; i < 18; ++i) pp[i] = (const float*)d_in[i];
    p.out = (float*)d_out; p.ws = (unsigned char*)d_ws;
    if (hipMemsetAsync((char*)d_ws + WS_CTL, 0, CTL_BYTES, stream) != hipSuccess) { fprintf(stderr, "kernel_launch: memset failed\n"); return; }
    void* args[] = {&p};
    const hipError_t e = hipLaunchCooperativeKernel((const void*)mega_fwd, dim3(grid_blocks), dim3(NT), args, LDS_BYTES, stream);
    if (e != hipSuccess) fprintf(stderr, "kernel_launch: cooperative launch failed: %s (grid %d)\n", hipGetErrorString(e), grid_blocks);
}
```

```cpp
#include <hip/hip_runtime.h>
#include <hip/hip_cooperative_groups.h>
#include <cstdio>
#include <cstdint>
#include <cmath>
namespace pg8 {
#define PG8_LAS __attribute__((address_space(3)))
typedef unsigned short bf16_t;
typedef short bf16x8 __attribute__((ext_vector_type(8)));
typedef float f32x4 __attribute__((ext_vector_type(4)));
typedef unsigned u32x4 __attribute__((ext_vector_type(4)));
constexpr int BM = 256, BK = 64, HALF = 128, HTB = HALF * BK * 2  , STAGE_BYTES = 8 * HTB, NXCD = 8, WGM = 8;

__host__ __device__ __forceinline__ int lds_byte(int r, int c) { const int st = (r >> 4) * 2 + (c >> 5), rr = r & 15, cc = c & 31, ob = rr * 64 + cc * 2; return st * 1024 + (ob ^ (((ob >> 9) & 1) << 5)); }
__host__ __device__ __forceinline__ void stage_rc(int b, int& R, int& C) { const int st = b / 1024, sb = b % 1024, swz = sb ^ (((sb >> 9) & 1) << 5); R = (st >> 1) * 16 + swz / 64; C = (st & 1) * 32 + (swz % 64) / 2; }
__host__ __device__ __forceinline__ int perm32(int rho) { const int n = rho >> 4, i = rho & 15; return 8 * (i >> 2) + 4 * n + (i & 3); }

struct Unit { int pm, pn; };
struct Gemm { const bf16_t* A; const bf16_t* Bt; int M, N, K; };

struct StaticOrder {
    int nM, nN, nwg, G, c;
    __host__ __device__ void init(int M, int N, int G_, int c_) { nM = M / BM; nN = N / BM; nwg = nM * nN; G = G_; c = c_; }
    __host__ __device__ bool next(int i, Unit& u) const {
        const long L = (long)i * G + c; if (L >= nwg) return false;
        int wgid = (int)L; { const int q = nwg / NXCD, r = nwg % NXCD, xcd = wgid % NXCD, off = wgid / NXCD; wgid = (xcd < r ? xcd * (q + 1) : r * (q + 1) + (xcd - r) * q) + off; }
        const int nig = WGM * nN, gid = wgid / nig, fm = gid * WGM, gsz = (nM - fm) < WGM ? (nM - fm) : WGM;
        u.pm = fm + ((wgid % nig) % gsz); u.pn = (wgid % nig) / gsz; return true;
    }
    __device__ __forceinline__ void a_ready(const Unit&) const {}
    __device__ __forceinline__ void done(const Unit&) const {}
};

__device__ __forceinline__ unsigned cvt_pk_bf16(float lo, float hi) { unsigned r; asm volatile("v_cvt_pk_bf16_f32 %0, %1, %2" : "=v"(r) : "v"(lo), "v"(hi)); return r; }
typedef float f32x2 __attribute__((ext_vector_type(2)));
__device__ __forceinline__ f32x2 gelu_pk(f32x2 v) {
    const f32x2 av = __builtin_elementwise_abs(v), d = av * 0.2316418882f + 1.0f;
    f32x2 t; t.x = __builtin_amdgcn_rcpf(d.x); t.y = __builtin_amdgcn_rcpf(d.y);
    f32x2 q = t * 0.5307027145f + (-0.7265760135f); q = q * t + 0.7107068705f; q = q * t + (-0.142248368f); q = q * t + 0.127414796f; q = q * t;
    const f32x2 s = (v * v) * (-0.72134752044f);
    f32x2 e; e.x = __builtin_amdgcn_exp2f(s.x); e.y = __builtin_amdgcn_exp2f(s.y);
    const f32x2 m = v * (q * e), r = v - m;
    f32x2 o; o.x = v.x < 0.f ? m.x : r.x; o.y = v.y < 0.f ? m.y : r.y; return o;
}

template <int ACT  > struct EpiBf16 {
    static constexpr bool PERM = true, AFTER_DRAIN = false; static_assert(ACT == 0 || ACT == 1, "EpiBf16: ACT is 0 (none) or 1 (gelu_pk)");
    bf16_t* O; int ldc; const float* bias; int split_cols; size_t split_stride; float scale0;
    __device__ __forceinline__ void operator()(const f32x4 (&acc)[2][2][4][2], const Unit& u, int wr, int wc, int fr, int fq) const {
        const int row0 = u.pm * BM + wr * 64 + fr; int colt = u.pn * BM; bf16_t* base = O;
        float sc = 1.f; if (split_cols) { const int t = colt / split_cols; base += (size_t)t * split_stride; colt -= t * split_cols; if (t == 0) sc = scale0; }
        const int col0 = colt + wc * 32 + 8 * fq, bcol0 = u.pn * BM + wc * 32 + 8 * fq;
        f32x4 bv[2][2];
#pragma unroll
        for (int bj = 0; bj < 2; ++bj)
#pragma unroll
            for (int n = 0; n < 2; ++n) bv[bj][n] = bias ? *(const f32x4*)(bias + bcol0 + bj * HALF + 4 * n) : (f32x4){0.f, 0.f, 0.f, 0.f};
#pragma unroll
        for (int ai = 0; ai < 2; ++ai)
#pragma unroll
            for (int m = 0; m < 4; ++m) { bf16_t* rowp = base + (size_t)(row0 + ai * HALF + m * 16) * ldc + col0;
#pragma unroll
                for (int bj = 0; bj < 2; ++bj) { f32x4 v0 = acc[ai][bj][m][0] + bv[bj][0], v1 = acc[ai][bj][m][1] + bv[bj][1];
                    if (ACT == 1) { f32x2 a = gelu_pk((f32x2){v0[0], v0[1]}), b = gelu_pk((f32x2){v0[2], v0[3]}), c = gelu_pk((f32x2){v1[0], v1[1]}), d = gelu_pk((f32x2){v1[2], v1[3]});
                        v0 = (f32x4){a.x, a.y, b.x, b.y}; v1 = (f32x4){c.x, c.y, d.x, d.y}; }
                    v0 = v0 * sc; v1 = v1 * sc; u32x4 w; w.x = cvt_pk_bf16(v0[0], v0[1]); w.y = cvt_pk_bf16(v0[2], v0[3]); w.z = cvt_pk_bf16(v1[0], v1[1]); w.w = cvt_pk_bf16(v1[2], v1[3]);
                    *(u32x4*)(rowp + bj * HALF) = w; } }
    }
};

template <class Epi, class Sched, bool ALIGN_EPI = false, bool SP2 = false>
__device__ __forceinline__ void gemm_phase(PG8_LAS unsigned char* lds, const Gemm g, const Sched& S, const Epi& E) {
    int tid = threadIdx.x; asm volatile("" : "+v"(tid)); const int wid = __builtin_amdgcn_readfirstlane(tid >> 6), lane = tid & 63, wr = wid >> 2, wc = wid & 3, fr = lane & 15, fq = lane >> 4;
    const int K = g.K, nt = K / BK;
    unsigned voffA[2], voffB[2];
#pragma unroll
    for (int i = 0; i < 2; ++i) { int R, C; stage_rc(tid * 16 + i * 8192, R, C); const int Rb = Epi::PERM ? ((R & ~31) + perm32(R & 31)) : R;
        voffA[i] = (unsigned)(R * K + C) * 2u; voffB[i] = (unsigned)(Rb * K + C) * 2u; }
    const size_t kstep = (size_t)(BK * 2);
    const size_t hstep = (size_t)HALF * K * 2;
    const size_t tstep = 2 * hstep;
    const unsigned ldsw = (unsigned)wid * 1024u;
    const int aoff = lds_byte(wr * 64 + fr, fq * 8), boff = lds_byte(wc * 32 + fr, fq * 8);
#define PG8_SA(b, h) (((b) * 2 + (h)) * HTB)
#define PG8_SB(b, h) ((4 + (b) * 2 + (h)) * HTB)
#define PG8_STAGE(bufoff, gbase, voff) do { _Pragma("unroll") for (int _i = 0; _i < 2; ++_i) \
        __builtin_amdgcn_global_load_lds((const unsigned*)((const char*)(gbase) + (voff)[_i]), (PG8_LAS unsigned*)(lds + (bufoff) + ldsw + _i * 8192), 16, 0, 0); } while (0)
#define PG8_LDA(dst, b, h) do { _Pragma("unroll") for (int m = 0; m < 4; ++m) _Pragma("unroll") for (int k = 0; k < 2; ++k) dst[m][k] = *(const PG8_LAS bf16x8*)(lds + PG8_SA(b, h) + aoff + m * 2048 + k * 1024); } while (0)
#define PG8_LDB(dst, b, h) do { _Pragma("unroll") for (int n = 0; n < 2; ++n) _Pragma("unroll") for (int k = 0; k < 2; ++k) dst[n][k] = *(const PG8_LAS bf16x8*)(lds + PG8_SB(b, h) + boff + n * 2048 + k * 1024); } while (0)
#define PG8_MMA(ai, bj, At, Bt) do { __builtin_amdgcn_s_setprio(1); _Pragma("unroll") for (int m = 0; m < 4; ++m) _Pragma("unroll") for (int n = 0; n < 2; ++n) _Pragma("unroll") for (int k = 0; k < 2; ++k) \
        acc[ai][bj][m][n] = __builtin_amdgcn_mfma_f32_16x16x32_bf16(Bt[n][k], At[m][k], acc[ai][bj][m][n], 0, 0, 0); __builtin_amdgcn_s_setprio(0); } while (0)
#define PG8_WAIT_V(n) asm volatile("s_waitcnt vmcnt(" #n ")" ::: "memory")
#define PG8_WAIT_L(n) asm volatile("s_waitcnt lgkmcnt(" #n ")" ::: "memory")
#define PG8_BAR __builtin_amdgcn_s_barrier()
#define PG8_SCHED __builtin_amdgcn_sched_barrier(0)
    Unit cur, nxt; int ui = 0;
    if (!S.next(0, cur)) return;
    f32x4 acc[2][2][4][2];
#pragma unroll
    for (int a = 0; a < 2; ++a)
#pragma unroll
        for (int b = 0; b < 2; ++b)
#pragma unroll
            for (int m = 0; m < 4; ++m)
#pragma unroll
                for (int n = 0; n < 2; ++n) acc[a][b][m][n] = (f32x4){0.f, 0.f, 0.f, 0.f};
    bf16x8 At[4][2], B0[2][2], B1[2][2];
    const char* cA = (const char*)g.A + (size_t)cur.pm * tstep; const char* cB = (const char*)g.Bt + (size_t)cur.pn * tstep;
    S.a_ready(cur);
    if constexpr (SP2) {
        PG8_STAGE(PG8_SB(0, 0), cB, voffB); PG8_STAGE(PG8_SB(0, 1), cB + hstep, voffB); PG8_STAGE(PG8_SA(0, 0), cA, voffA); PG8_STAGE(PG8_SA(0, 1), cA + hstep, voffA);
        if (wr == 1) PG8_BAR;
        PG8_WAIT_V(2); PG8_BAR;
        PG8_STAGE(PG8_SB(1, 0), cB + kstep, voffB); PG8_STAGE(PG8_SA(1, 0), cA + kstep, voffA); PG8_STAGE(PG8_SB(1, 1), cB + hstep + kstep, voffB);
        PG8_WAIT_V(6); PG8_BAR;
    } else {
        PG8_STAGE(PG8_SB(0, 0), cB, voffB); PG8_STAGE(PG8_SA(0, 0), cA, voffA); PG8_STAGE(PG8_SB(0, 1), cB + hstep, voffB); PG8_STAGE(PG8_SA(0, 1), cA + hstep, voffA);
        if (wr == 1) PG8_BAR;
        PG8_WAIT_V(4); PG8_BAR;
        PG8_STAGE(PG8_SB(1, 0), cB + kstep, voffB); PG8_STAGE(PG8_SA(1, 0), cA + kstep, voffA); PG8_STAGE(PG8_SB(1, 1), cB + hstep + kstep, voffB);
        PG8_WAIT_V(6); PG8_BAR;
    }
    for (;;) {
        const bool has_next = S.next(ui + 1, nxt);
        const char* nA = has_next ? (const char*)g.A + (size_t)nxt.pm * tstep : cA; const char* nB = has_next ? (const char*)g.Bt + (size_t)nxt.pn * tstep : cB;
        for (int t = 0; t < nt; t += 2) {
            const bool last = (t == nt - 2);
            const char* a1 = cA + (size_t)(t + 1) * kstep;
            const char* a2 = last ? nA : cA + (size_t)(t + 2) * kstep; const char* b2 = last ? nB : cB + (size_t)(t + 2) * kstep;
            const char* a3 = a2 + kstep; const char* b3 = b2 + kstep;
            if (last && has_next) S.a_ready(nxt);
            if constexpr (SP2) {
            PG8_LDB(B0, 0, 0); PG8_LDB(B1, 0, 1); PG8_SCHED; PG8_LDA(At, 0, 0); PG8_STAGE(PG8_SA(1, 1), a1 + hstep, voffA);
            PG8_WAIT_V(8); PG8_WAIT_L(0); PG8_BAR; PG8_MMA(0, 0, At, B0); PG8_MMA(0, 1, At, B1); PG8_BAR; PG8_SCHED;
            PG8_LDA(At, 0, 1); PG8_STAGE(PG8_SB(0, 0), b2, voffB); PG8_STAGE(PG8_SB(0, 1), b2 + hstep, voffB); PG8_STAGE(PG8_SA(0, 0), a2, voffA);
            PG8_WAIT_V(8); PG8_WAIT_L(0); PG8_BAR; PG8_MMA(1, 0, At, B0); PG8_MMA(1, 1, At, B1); PG8_BAR; PG8_SCHED;
            PG8_LDB(B0, 1, 0); PG8_LDB(B1, 1, 1); PG8_SCHED; PG8_LDA(At, 1, 0); PG8_STAGE(PG8_SA(0, 1), a2 + hstep, voffA);
            PG8_WAIT_V(8); PG8_WAIT_L(0); PG8_BAR; PG8_MMA(0, 0, At, B0); PG8_MMA(0, 1, At, B1); PG8_BAR; PG8_SCHED;
            PG8_LDA(At, 1, 1); PG8_STAGE(PG8_SB(1, 0), b3, voffB); PG8_STAGE(PG8_SB(1, 1), b3 + hstep, voffB); PG8_STAGE(PG8_SA(1, 0), a3, voffA);
            PG8_WAIT_V(8); PG8_WAIT_L(0); PG8_BAR; PG8_MMA(1, 0, At, B0); PG8_MMA(1, 1, At, B1); PG8_BAR; PG8_SCHED;
            } else {
            PG8_LDB(B0, 0, 0); PG8_SCHED; PG8_LDA(At, 0, 0); PG8_STAGE(PG8_SA(1, 1), a1 + hstep, voffA);
            PG8_WAIT_L(8); PG8_BAR; PG8_WAIT_L(0); PG8_MMA(0, 0, At, B0); PG8_BAR; PG8_SCHED;
            PG8_LDB(B1, 0, 1); PG8_STAGE(PG8_SB(0, 0), b2, voffB);
            PG8_BAR; PG8_WAIT_L(0); PG8_MMA(0, 1, At, B1); PG8_BAR;
            PG8_LDA(At, 0, 1); PG8_STAGE(PG8_SA(0, 0), a2, voffA);
            PG8_BAR; PG8_WAIT_L(0); PG8_MMA(1, 0, At, B0); PG8_BAR; PG8_SCHED;
            PG8_STAGE(PG8_SB(0, 1), b2 + hstep, voffB);
            PG8_WAIT_V(6); PG8_BAR; PG8_MMA(1, 1, At, B1); PG8_BAR;
            PG8_LDB(B0, 1, 0); PG8_SCHED; PG8_LDA(At, 1, 0); PG8_STAGE(PG8_SA(0, 1), a2 + hstep, voffA);
            PG8_WAIT_L(8); PG8_BAR; PG8_WAIT_L(0); PG8_MMA(0, 0, At, B0); PG8_BAR; PG8_SCHED;
            PG8_LDB(B1, 1, 1); PG8_STAGE(PG8_SB(1, 0), b3, voffB);
            PG8_BAR; PG8_WAIT_L(0); PG8_MMA(0, 1, At, B1); PG8_BAR;
            PG8_LDA(At, 1, 1); PG8_STAGE(PG8_SA(1, 0), a3, voffA);
            PG8_BAR; PG8_WAIT_L(0); PG8_MMA(1, 0, At, B0); PG8_BAR; PG8_SCHED;
            PG8_STAGE(PG8_SB(1, 1), b3 + hstep, voffB);
            PG8_WAIT_V(6); PG8_BAR; PG8_MMA(1, 1, At, B1); PG8_BAR;
            }
        }
        if constexpr (ALIGN_EPI) { if (wr == 0) PG8_BAR; }
        if constexpr (!Epi::AFTER_DRAIN) { E(acc, cur, wr, wc, fr, fq); S.done(cur); }
        if (!has_next) break;
#pragma unroll
        for (int a = 0; a < 2; ++a)
#pragma unroll
            for (int b = 0; b < 2; ++b)
#pragma unroll
                for (int m = 0; m < 4; ++m)
#pragma unroll
                    for (int n = 0; n < 2; ++n) acc[a][b][m][n] = (f32x4){0.f, 0.f, 0.f, 0.f};
        cur = nxt; cA = nA; cB = nB; ++ui;
        if constexpr (ALIGN_EPI) { if (wr == 1) PG8_BAR; }
    }
    PG8_WAIT_V(0);
    if constexpr (!ALIGN_EPI) { if (wr == 0) PG8_BAR; }
    PG8_BAR;
    if constexpr (Epi::AFTER_DRAIN) { E.fused(acc, cur, wr, wc, fr, fq, lds, wid, lane); S.done(cur); }
#undef PG8_SA
#undef PG8_SB
#undef PG8_STAGE
#undef PG8_LDA
#undef PG8_LDB
#undef PG8_MMA
#undef PG8_WAIT_V
#undef PG8_WAIT_L
#undef PG8_BAR
#undef PG8_SCHED
}
}
namespace cg = cooperative_groups;
#define LAS __attribute__((address_space(3)))
typedef unsigned short bf16;
typedef float f32x4 __attribute__((ext_vector_type(4)));
typedef float f32x8 __attribute__((ext_vector_type(8)));
typedef float f32x16 __attribute__((ext_vector_type(16)));
typedef unsigned u32x4 __attribute__((ext_vector_type(4)));
typedef unsigned u32x2 __attribute__((ext_vector_type(2)));
typedef short bf16x8 __attribute__((ext_vector_type(8)));
typedef short s16x4 __attribute__((ext_vector_type(4)));

constexpr int BATCH = 16, SEQ = 2048, DM = 1024, T = BATCH * SEQ;
constexpr int NP = 3072;
constexpr int IN_COLS = 3012;
constexpr int C_QA = 0, C_KA = 512, C_VA = 1024, C_QB = 1536, C_KV = 2560, C_QI = 2688, C_KI = 2944, C_WI = 3008;
constexpr int MIXW = 1536;
constexpr int NEXP = 16384;
constexpr float EPS = 1e-6f;
constexpr int NT = 512;
constexpr int NWV = 8;

constexpr size_t MiB = 1u << 20;
constexpr size_t WS_CTL = 0;
constexpr size_t CTL_BYTES = 64 * 1024;
constexpr size_t WS_MOD = 1 * MiB;
constexpr size_t WS_SCAL = WS_MOD + 512 * 1024;
constexpr size_t WS_QBIAS = WS_MOD + 400 * 1024;
constexpr size_t WS_WIN = 2 * MiB;
constexpr size_t WS_WO2 = 8 * MiB;
constexpr size_t WS_WQ = 11 * MiB;
constexpr size_t WS_SUBK = 13 * MiB;
constexpr size_t WS_U16 = 14 * MiB;
constexpr size_t WS_V16 = 46 * MiB;
constexpr size_t WS_H = 78 * MiB;
constexpr size_t WS_PROJ = 142 * MiB;
constexpr size_t WS_Q3 = WS_PROJ;
constexpr size_t WS_MIX = 334 * MiB;
constexpr size_t WS_EXP = 430 * MiB;
constexpr size_t WS_KVC = WS_EXP;
constexpr size_t WS_GATE = 446 * MiB;
constexpr size_t WS_ATMP = 462 * MiB;
constexpr size_t WS_CBUF = 494 * MiB;
constexpr size_t WS_SSQ = WS_ATMP;
constexpr size_t WS_ABUF1 = WS_MIX;
constexpr size_t WS_END = 510 * MiB;

struct Params {
    const float *x, *c, *ada_w, *ada_b, *norm1_g, *norm2_g, *w_in, *a_qk_gain, *a_lambda, *a_sub_gain, *b_q_gain, *b_kv_gain, *b_w_uv, *w_out, *peer_wq, *peer_subkeys, *peer_u, *peer_v;
    float* out; unsigned char* ws;
};

enum { SC_LAM = 0, SC_MA = 1, SC_MB = 2 };

__device__ __forceinline__ unsigned f2bf(float f) { unsigned u = __float_as_uint(f); return (u + 0x7fffu + ((u >> 16) & 1u)) >> 16; }
__device__ __forceinline__ float bf2f(unsigned h) { return __uint_as_float(h << 16); }
__device__ __forceinline__ unsigned pk2(float lo, float hi) { return f2bf(lo) | (f2bf(hi) << 16); }
__device__ __forceinline__ float bflo(unsigned w) { return __uint_as_float(w << 16); }
__device__ __forceinline__ float bfhi(unsigned w) { return __uint_as_float(w & 0xffff0000u); }
__device__ __forceinline__ float wave_sum(float v) {
#pragma unroll
    for (int o = 1; o < 64; o <<= 1) v += __shfl_xor(v, o);
    return v;
}
__device__ __forceinline__ float wave_max(float v) {
#pragma unroll
    for (int o = 1; o < 64; o <<= 1) v = fmaxf(v, __shfl_xor(v, o));
    return v;
}
#define LDS_WAIT() asm volatile("s_waitcnt lgkmcnt(0)" ::: "memory")
__device__ __forceinline__ void ph_mod(const Params& p, float* ldsf, int vb, int nvb) {
    if (vb >= 96) return;
    int tid = threadIdx.x; asm volatile("" : "+v"(tid));
    const int lane = tid & 63, wv = tid >> 6;
    for (int i = tid; i < 16 * 1024; i += NT) { const float v = p.c[i]; ldsf[i] = v / (1.f + __expf(-v)); }
    __syncthreads();
    float* MOD = (float*)(p.ws + WS_MOD); float* part = ldsf + 16 * 1024;
    for (int it = vb; it < 96; it += nvb) {
        const int j = it * 64 + lane;
        float acc[16];
#pragma unroll
        for (int b = 0; b < 16; ++b) acc[b] = 0.f;
        const float* wp = p.ada_w + (size_t)(128 * wv) * 6144 + j;
#pragma unroll 1
        for (int k0 = 0; k0 < 128; k0 += 8) {
            float w[8];
#pragma unroll
            for (int u = 0; u < 8; ++u) w[u] = wp[(size_t)(k0 + u) * 6144];
#pragma unroll
            for (int u = 0; u < 8; ++u)
#pragma unroll
                for (int b = 0; b < 16; ++b) acc[b] = fmaf(ldsf[b * 1024 + 128 * wv + k0 + u], w[u], acc[b]);
        }
#pragma unroll
        for (int b = 0; b < 16; ++b) part[(wv * 16 + b) * 64 + lane] = acc[b];
        __syncthreads();
        for (int o = tid; o < 16 * 64; o += NT) { const int b = o >> 6, c = o & 63; float s = 0.f;
#pragma unroll
            for (int w = 0; w < 8; ++w) s += part[(w * 16 + b) * 64 + c];
            MOD[b * 6144 + it * 64 + c] = s + p.ada_b[it * 64 + c]; }
        __syncthreads();
    }
}

__device__ __forceinline__ void transpose_item(const float* W, int N, bf16* WT, int ldt, LAS float* scr, int kb, int nb, int lane) {
    const int k0 = 64 * kb, n0 = 32 * nb;
#pragma unroll 8
    for (int i = 0; i < 32; ++i) { const int kk = 2 * i + (lane >> 5); const int n = n0 + (lane & 31); scr[kk * 33 + (lane & 31)] = (n < N) ? W[(size_t)(k0 + kk) * N + n] : 0.f; }
    LDS_WAIT(); asm volatile("" ::: "memory");
    const int c = lane & 7;
#pragma unroll
    for (int j = 0; j < 4; ++j) { const int n = (lane >> 3) + 8 * j; const LAS float* s = scr + (8 * c) * 33 + n;
        u32x4 o; o.x = pk2(s[0 * 33], s[1 * 33]); o.y = pk2(s[2 * 33], s[3 * 33]); o.z = pk2(s[4 * 33], s[5 * 33]); o.w = pk2(s[6 * 33], s[7 * 33]);
        *(u32x4*)(WT + (size_t)(n0 + n) * ldt + k0 + 8 * c) = o; }
    LDS_WAIT(); asm volatile("" ::: "memory");
}

template <int PART> __device__ __forceinline__ void ph_prep_weights(const Params& p, LAS float* scr, int gw, int ngw, int lane) {
    bf16* WIN = (bf16*)(p.ws + WS_WIN); bf16* WO2 = (bf16*)(p.ws + WS_WO2); bf16* WQ = (bf16*)(p.ws + WS_WQ);
    constexpr int I_IN = 16 * 96, I_O = 8 * 32, I_Q = 16 * 32;
    const size_t gt = (size_t)gw * 64 + lane, ngt = (size_t)ngw * 64;
    if (PART == 0) {
        for (int it = gw; it < I_IN; it += ngw) transpose_item(p.w_in, IN_COLS, WIN, 1024, scr, it / 96, it % 96, lane);
    } else {
        for (int it = gw; it < I_O + I_Q; it += ngw) {
            int r = it;
            if (r < I_O) { transpose_item(p.w_out, 1024, WO2, MIXW, scr, r / 32, r % 32, lane); continue; } r -= I_O;
            transpose_item(p.peer_wq, 1024, WQ, 1024, scr, r / 32, r % 32, lane);
        }
        for (size_t i = gt; i < (size_t)1024 * 1024; i += ngt) {
            const int n = (int)(i & 1023), kk = (int)(i >> 10), h = kk >> 7;
            const float* wu = p.b_w_uv + (size_t)kk * 64; const float* wo = p.w_out + (size_t)(512 + 64 * h) * 1024 + n;
            float a = 0.f;
#pragma unroll 8
            for (int e = 0; e < 64; ++e) a = fmaf(wu[e], wo[(size_t)e * 1024], a);
            WO2[(size_t)n * MIXW + 512 + kk] = (bf16)f2bf(a);
        }
        return;
    }
    bf16* SUBK = (bf16*)(p.ws + WS_SUBK);
    constexpr size_t NSUB8 = 2 * 128 * 64 / 8;
    for (size_t j = gt; j < NSUB8; j += ngt) {
        const f32x8 v = *(const f32x8*)(p.peer_subkeys + j * 8);
        u32x4 o; o.x = pk2(v[0], v[1]); o.y = pk2(v[2], v[3]); o.z = pk2(v[4], v[5]); o.w = pk2(v[6], v[7]);
        *(u32x4*)(SUBK + j * 8) = o;
    }
    if (gt == 0) {
        float* SC = (float*)(p.ws + WS_SCAL);
        float s01 = 0.f, s23 = 0.f;
        for (int i = 0; i < 64; ++i) { s01 += p.a_lambda[i] * p.a_lambda[64 + i]; s23 += p.a_lambda[128 + i] * p.a_lambda[192 + i]; }
        SC[SC_LAM] = __expf(s01) - __expf(s23) + 0.2f;
        float g0 = 0.f, g1 = 0.f, gq = 0.f, gk = 0.f;
        for (int i = 0; i < 64; ++i) { g0 = fmaxf(g0, fabsf(p.a_qk_gain[i])); g1 = fmaxf(g1, fabsf(p.a_qk_gain[64 + i])); }
        for (int i = 0; i < 128; ++i) { gq = fmaxf(gq, fabsf(p.b_q_gain[i])); gk = fmaxf(gk, fabsf(p.b_kv_gain[i])); }
        SC[SC_MA] = 8.0f * g0 * g1 * 1.02f;
        SC[SC_MB] = 11.3137085f * gq * gk * 1.02f;
    }
}

__device__ __forceinline__ void ph_hrows(const Params& p, const float* X, const float* g, int shOff, int scOff, int gw, int ngw, int lane) {
    const float* MOD = (const float*)(p.ws + WS_MOD); bf16* H = (bf16*)(p.ws + WS_H);
    for (int m = gw; m < T; m += ngw) {
        const f32x4* xr = (const f32x4*)(X + (size_t)m * 1024) + lane;
        f32x4 v[4]; float s = 0.f;
#pragma unroll
        for (int j = 0; j < 4; ++j) { v[j] = xr[64 * j]; s += (v[j].x * v[j].x + v[j].y * v[j].y) + (v[j].z * v[j].z + v[j].w * v[j].w); }
        const float rstd = rsqrtf(wave_sum(s) * (1.f / 1024.f) + EPS);
        const float* mb = MOD + (size_t)(m >> 11) * 6144;
#pragma unroll
        for (int j = 0; j < 4; ++j) {
            const int col = 4 * (lane + 64 * j);
            const f32x4 gg = *(const f32x4*)(g + col), sc = *(const f32x4*)(mb + scOff + col), sh = *(const f32x4*)(mb + shOff + col);
            const f32x4 y = v[j] * rstd * gg * (sc + 1.0f) + sh;
            u32x2 o; o.x = pk2(y.x, y.y); o.y = pk2(y.z, y.w);
            *(u32x2*)(H + (size_t)m * 1024 + col) = o;
        }
    }
}

__device__ __forceinline__ void ph_norm_proj(const Params& p, int gw, int ngw, int lane) {
    bf16* PROJ = (bf16*)(p.ws + WS_PROJ);
    for (int m = gw; m < T; m += ngw) {
        bf16* row = PROJ + (size_t)m * NP;
#pragma unroll
        for (int j = 0; j < 6; ++j) {
            if (j == 2) continue;
            const int col = 8 * lane + 512 * j;
            const u32x4 raw = *(const u32x4*)(row + col);
            float v[8] = {bflo(raw.x), bfhi(raw.x), bflo(raw.y), bfhi(raw.y), bflo(raw.z), bfhi(raw.z), bflo(raw.w), bfhi(raw.w)};
            float ss = 0.f;
#pragma unroll
            for (int i = 0; i < 8; ++i) ss += v[i] * v[i];
            ss += __shfl_xor(ss, 1); ss += __shfl_xor(ss, 2); ss += __shfl_xor(ss, 4);
            float rstd; const float* gp;
            if (j < 2) { rstd = rsqrtf(ss * (1.f / 64.f) + EPS); gp = p.a_qk_gain + 64 * j + (col & 63); }
            else { ss += __shfl_xor(ss, 8); rstd = rsqrtf(ss * (1.f / 128.f) + EPS); gp = (j == 5 ? p.b_kv_gain : p.b_q_gain) + (col & 127); }
            if (j == 5 && lane >= 16) continue;
            const f32x4 g0 = *(const f32x4*)gp, g1 = *(const f32x4*)(gp + 4);
            u32x4 o; o.x = pk2(v[0] * rstd * g0.x, v[1] * rstd * g0.y); o.y = pk2(v[2] * rstd * g0.z, v[3] * rstd * g0.w);
            o.z = pk2(v[4] * rstd * g1.x, v[5] * rstd * g1.y); o.w = pk2(v[6] * rstd * g1.z, v[7] * rstd * g1.w);
            *(u32x4*)(row + col) = o;
        }
    }
}
struct EpiResGate {
    static constexpr bool PERM = false, AFTER_DRAIN = false;
    const float* X; float* Out; const float* gate;
    __device__ __forceinline__ void operator()(const pg8::f32x4 (&acc)[2][2][4][2], const pg8::Unit& u, int wr, int wc, int fr, int fq) const {
        const int col0 = u.pn * 256 + wc * 32 + 4 * fq;
#pragma unroll
        for (int ai = 0; ai < 2; ++ai)
#pragma unroll
            for (int m = 0; m < 4; ++m) {
                const int r = u.pm * 256 + ai * 128 + wr * 64 + m * 16 + fr; const float* gb = gate + (size_t)(r >> 11) * 6144;
#pragma unroll
                for (int bj = 0; bj < 2; ++bj)
#pragma unroll
                    for (int n = 0; n < 2; ++n) { const int c = col0 + bj * 128 + n * 16; const size_t off = (size_t)r * 1024 + c;
                        const pg8::f32x4 xv = *(const pg8::f32x4*)(X + off), gv = *(const pg8::f32x4*)(gb + c);
                        *(pg8::f32x4*)(Out + off) = xv + gv * acc[ai][bj][m][n]; }
            }
    }
};


struct EpiResGateA2 {
    static constexpr bool PERM = true, AFTER_DRAIN = false;
    const float* X; float* Out; const float* MODp; const float* g2; bf16* A2; float* SSQ;
    __device__ __forceinline__ void operator()(const pg8::f32x4 (&acc)[2][2][4][2], const pg8::Unit& u, int wr, int wc, int fr, int fq) const {
        const int row0 = u.pm * 256 + wr * 64 + fr, col0 = u.pn * 256 + wc * 32 + 8 * fq;
        const float* mb = MODp + (size_t)((u.pm * 256) >> 11) * 6144;
        pg8::f32x4 gt[2][2], gm[2][2];
#pragma unroll
        for (int bj = 0; bj < 2; ++bj)
#pragma unroll
            for (int n = 0; n < 2; ++n) { const int c = col0 + bj * 128 + 4 * n; gt[bj][n] = *(const pg8::f32x4*)(mb + 2048 + c);
                const pg8::f32x4 gg = *(const pg8::f32x4*)(g2 + c), sc = *(const pg8::f32x4*)(mb + 4096 + c); gm[bj][n] = gg * (sc + 1.0f); }
#pragma unroll
        for (int ai = 0; ai < 2; ++ai)
#pragma unroll
            for (int m = 0; m < 4; ++m) { const int r = row0 + ai * 128 + m * 16; float ss = 0.f;
#pragma unroll
                for (int bj = 0; bj < 2; ++bj) { const size_t off = (size_t)r * 1024 + col0 + bj * 128;
                    const pg8::f32x4 v0 = *(const pg8::f32x4*)(X + off) + gt[bj][0] * acc[ai][bj][m][0], v1 = *(const pg8::f32x4*)(X + off + 4) + gt[bj][1] * acc[ai][bj][m][1];
                    *(pg8::f32x4*)(Out + off) = v0; *(pg8::f32x4*)(Out + off + 4) = v1;
                    ss += ((v0[0] * v0[0] + v0[1] * v0[1]) + (v0[2] * v0[2] + v0[3] * v0[3])) + ((v1[0] * v1[0] + v1[1] * v1[1]) + (v1[2] * v1[2] + v1[3] * v1[3]));
                    const pg8::f32x4 a0 = v0 * gm[bj][0], a1 = v1 * gm[bj][1];
                    pg8::u32x4 w; w.x = pg8::cvt_pk_bf16(a0[0], a0[1]); w.y = pg8::cvt_pk_bf16(a0[2], a0[3]); w.z = pg8::cvt_pk_bf16(a1[0], a1[1]); w.w = pg8::cvt_pk_bf16(a1[2], a1[3]);
                    *(pg8::u32x4*)(A2 + off) = w; }
                ss += __shfl_xor(ss, 16); ss += __shfl_xor(ss, 32);
                if (fq == 0) SSQ[(size_t)r * 16 + u.pn * 4 + wc] = ss; }
    }
};

struct EpiQ3 {
    static constexpr bool PERM = true, AFTER_DRAIN = false;
    const float* SSQ; const float* BIAS; bf16* O;
    __device__ __forceinline__ void operator()(const pg8::f32x4 (&acc)[2][2][4][2], const pg8::Unit& u, int wr, int wc, int fr, int fq) const {
        const int row0 = u.pm * 256 + wr * 64 + fr, col0 = u.pn * 256 + wc * 32 + 8 * fq;
        const float* bb = BIAS + (size_t)((u.pm * 256) >> 11) * 1024 + col0;
        pg8::f32x4 bv[2][2];
#pragma unroll
        for (int bj = 0; bj < 2; ++bj)
#pragma unroll
            for (int n = 0; n < 2; ++n) bv[bj][n] = *(const pg8::f32x4*)(bb + bj * 128 + 4 * n);
#pragma unroll
        for (int ai = 0; ai < 2; ++ai)
#pragma unroll
            for (int m = 0; m < 4; ++m) { const int r = row0 + ai * 128 + m * 16; const pg8::f32x4 s4 = *((const pg8::f32x4*)(SSQ + (size_t)r * 16) + fq);
                float s_ = (s4[0] + s4[1]) + (s4[2] + s4[3]); s_ += __shfl_xor(s_, 16); s_ += __shfl_xor(s_, 32); const float rs = rsqrtf(s_ * (1.f / 1024.f) + EPS);
#pragma unroll
                for (int bj = 0; bj < 2; ++bj) { const pg8::f32x4 v0 = acc[ai][bj][m][0] * rs + bv[bj][0], v1 = acc[ai][bj][m][1] * rs + bv[bj][1];
                    pg8::u32x4 w; w.x = pg8::cvt_pk_bf16(v0[0], v0[1]); w.y = pg8::cvt_pk_bf16(v0[2], v0[3]); w.z = pg8::cvt_pk_bf16(v1[0], v1[1]); w.w = pg8::cvt_pk_bf16(v1[2], v1[3]);
                    *(pg8::u32x4*)(O + (size_t)r * 1024 + col0 + bj * 128) = w; } }
    }
};

__device__ __forceinline__ void ph_q3bias(const Params& p, int gw, int lane) {
    if (gw >= 64) return;
    const float* MOD = (const float*)(p.ws + WS_MOD); const bf16* WQ = (const bf16*)(p.ws + WS_WQ); float* BIAS = (float*)(p.ws + WS_QBIAS);
    const int l15 = lane & 15, g = lane >> 4, n0 = gw * 16;
    const float* ar = MOD + (size_t)l15 * 6144 + 3072 + 8 * g; const bf16* br = WQ + (size_t)(n0 + l15) * 1024 + 8 * g;
    f32x4 a = {0.f, 0.f, 0.f, 0.f};
#pragma unroll 4
    for (int ks = 0; ks < 32; ++ks) {
        const f32x4 s0 = *(const f32x4*)(ar + 32 * ks), s1 = *(const f32x4*)(ar + 32 * ks + 4);
        u32x4 aw; aw.x = pk2(s0[0], s0[1]); aw.y = pk2(s0[2], s0[3]); aw.z = pk2(s1[0], s1[1]); aw.w = pk2(s1[2], s1[3]);
        bf16x8 av; __builtin_memcpy(&av, &aw, 16);
        const bf16x8 bvv = *(const bf16x8*)(br + 32 * ks);
        a = __builtin_amdgcn_mfma_f32_16x16x32_bf16(av, bvv, a, 0, 0, 0);
    }
#pragma unroll
    for (int r = 0; r < 4; ++r) BIAS[(size_t)(4 * g + r) * 1024 + n0 + l15] = a[r];
}


struct EpiNormBf16 {
    static constexpr bool PERM = true, AFTER_DRAIN = false;
    bf16* O; const float* gqk; const float* gbq; const float* gbkv; LAS float* P; bf16* KVC;
    __device__ __forceinline__ void operator()(const pg8::f32x4 (&acc)[2][2][4][2], const pg8::Unit& u, int wr, int wc, int fr, int fq) const {
        const int pn = u.pn;
        const int mode = pn < 4 ? 1 : ((pn == 4 || pn == 5 || pn == 11) ? 0 : (pn == 10 ? 3 : 2));
        if (mode != 0) {
#pragma unroll
            for (int ai = 0; ai < 2; ++ai)
#pragma unroll
                for (int m = 0; m < 4; ++m)
#pragma unroll
                    for (int bj = 0; bj < 2; ++bj) {
                        const pg8::f32x4 a = acc[ai][bj][m][0], b = acc[ai][bj][m][1];
                        float ss = (a[0] * a[0] + a[1] * a[1]) + (a[2] * a[2] + a[3] * a[3]) + (b[0] * b[0] + b[1] * b[1]) + (b[2] * b[2] + b[3] * b[3]);
                        ss += __shfl_xor(ss, 16); ss += __shfl_xor(ss, 32);
                        if (fq == 0) P[(ai * 128 + wr * 64 + m * 16 + fr) * 8 + bj * 4 + wc] = ss;
                    }
            asm volatile("s_waitcnt lgkmcnt(0)" ::: "memory"); __builtin_amdgcn_s_barrier(); asm volatile("" ::: "memory");
        }
        const int row0 = u.pm * 256 + wr * 64 + fr, col0 = u.pn * 256 + wc * 32 + 8 * fq;
        pg8::f32x4 g0[2], g1[2];
#pragma unroll
        for (int bj = 0; bj < 2; ++bj) {
            const float* gp = nullptr;
            if (mode == 1) gp = gqk + (pn >= 2 ? 64 : 0) + 32 * (wc & 1) + 8 * fq;
            else if (mode == 2) gp = gbq + 32 * wc + 8 * fq;
            else if (mode == 3 && bj == 0) gp = gbkv + 32 * wc + 8 * fq;
            if (gp) { g0[bj] = *(const pg8::f32x4*)gp; g1[bj] = *(const pg8::f32x4*)(gp + 4); } else { g0[bj] = (pg8::f32x4){1.f, 1.f, 1.f, 1.f}; g1[bj] = g0[bj]; }
        }
#pragma unroll
        for (int ai = 0; ai < 2; ++ai)
#pragma unroll
            for (int m = 0; m < 4; ++m) { bf16* rowp = O + (size_t)(row0 + ai * 128 + m * 16) * NP + col0;
#pragma unroll
                for (int bj = 0; bj < 2; ++bj) {
                    float s = 1.f;
                    if (mode != 0 && !(mode == 3 && bj == 1)) {
                        const pg8::f32x4 q = *(const LAS pg8::f32x4*)(P + (ai * 128 + wr * 64 + m * 16 + fr) * 8 + bj * 4);
                        s = (mode == 1) ? rsqrtf(((wc < 2) ? (q[0] + q[1]) : (q[2] + q[3])) * (1.f / 64.f) + EPS) : rsqrtf(((q[0] + q[1]) + (q[2] + q[3])) * (1.f / 128.f) + EPS);
                    }
                    const pg8::f32x4 v0 = acc[ai][bj][m][0] * s * g0[bj], v1 = acc[ai][bj][m][1] * s * g1[bj];
                    pg8::u32x4 w; w.x = pg8::cvt_pk_bf16(v0[0], v0[1]); w.y = pg8::cvt_pk_bf16(v0[2], v0[3]); w.z = pg8::cvt_pk_bf16(v1[0], v1[1]); w.w = pg8::cvt_pk_bf16(v1[2], v1[3]);
                    if (pn == 10 && bj == 0) *(pg8::u32x4*)(KVC + (size_t)(row0 + ai * 128 + m * 16) * 128 + wc * 32 + 8 * fq) = w;
                    else *(pg8::u32x4*)(rowp + bj * 128) = w; } }
    }
};
typedef __bf16 bf16x2_t __attribute__((ext_vector_type(2)));
__device__ __forceinline__ float dot2bf(unsigned a, unsigned b, float acc) { return __builtin_amdgcn_fdot2_f32_bf16(__builtin_bit_cast(bf16x2_t, a), __builtin_bit_cast(bf16x2_t, b), acc, false); }
template <int CTRL> __device__ __forceinline__ float dpp_f(float v) { return __int_as_float(__builtin_amdgcn_update_dpp(0, __float_as_int(v), CTRL, 0xf, 0xf, false)); }
__device__ __forceinline__ float row16_sum(float v) {
    v += dpp_f<0x128>(v); v += dpp_f<0x124>(v); v += dpp_f<0x122>(v); v += dpp_f<0x121>(v); return v;
}
__device__ __forceinline__ float gelu_erf(float v) {
    const float av = fabsf(v), t = __builtin_amdgcn_rcpf(fmaf(av, 0.2316418882f, 1.0f));
    float q = fmaf(t, 0.5307027145f, -0.7265760135f); q = fmaf(q, t, 0.7107068705f); q = fmaf(q, t, -0.142248368f); q = fmaf(q, t, 0.127414796f); q = q * t;
    const float e = __builtin_amdgcn_exp2f(v * v * -0.72134752044f);
    const float m = v * (q * e);
    return v < 0.f ? m : v - m;
}

#ifndef DSA_PB
#define DSA_PB 0
#endif
typedef short v4i16_t __attribute__((ext_vector_type(4)));
#ifndef DSA_REP_A
#define DSA_REP_A 1
#endif
#ifndef DSA_REP_B
#define DSA_REP_B 1
#endif
#ifndef DSA_REP_C
#define DSA_REP_C 1
#endif
constexpr int DSA_SROW = 2048 * 4 + 16;
constexpr int DSA_SEL_OFF = 16 * DSA_SROW;
constexpr int DSA_LDS = DSA_SEL_OFF + 16 * 512;
constexpr int DSA_KVROW = 272;

__device__ __forceinline__ unsigned sortkey(float s) { const unsigned u = __float_as_uint(s); return u ^ ((u >> 31) ? 0xffffffffu : 0x80000000u); }
__device__ __forceinline__ unsigned cvtpk_bf16(float lo, float hi) { unsigned r; asm volatile("v_cvt_pk_bf16_f32 %0, %1, %2" : "=v"(r) : "v"(lo), "v"(hi)); return r; }

__device__ __forceinline__ void cnt_ge4(int& acc, unsigned k0, unsigned k1, unsigned k2, unsigned k3, unsigned cand) {
    asm volatile("v_cmp_ge_u32_e64 s[40:41], %1, %5\n\t"
                 "v_cmp_ge_u32_e64 s[42:43], %2, %5\n\t"
                 "v_cmp_ge_u32_e64 s[44:45], %3, %5\n\t"
                 "v_cmp_ge_u32_e64 s[46:47], %4, %5\n\t"
                 "v_addc_co_u32_e64 %0, s[48:49], %0, 0, s[40:41]\n\t"
                 "v_addc_co_u32_e64 %0, s[48:49], %0, 0, s[42:43]\n\t"
                 "v_addc_co_u32_e64 %0, s[48:49], %0, 0, s[44:45]\n\t"
                 "v_addc_co_u32_e64 %0, s[48:49], %0, 0, s[46:47]"
                 : "+v"(acc) : "v"(k0), "v"(k1), "v"(k2), "v"(k3), "v"(cand)
                 : "s40", "s41", "s42", "s43", "s44", "s45", "s46", "s47", "s48", "s49");
}
__device__ __forceinline__ void ph_dsa(const Params& p, unsigned char* lds, int vb, int nvb) {
    const bf16* PROJ = (const bf16*)(p.ws + WS_PROJ); bf16* MIX = (bf16*)(p.ws + WS_MIX);
    const float MB = ((const float*)(p.ws + WS_SCAL))[SC_MB];
    int tid = threadIdx.x; asm volatile("" : "+v"(tid)); const int lane = tid & 63, wv = __builtin_amdgcn_readfirstlane(tid >> 6);
    const int l15 = lane & 15, g = lane >> 4;
    LAS unsigned char* ldsl = (LAS unsigned char*)lds;
    for (int it = vb; it < 2048; it += nvb) {
        const int vbb = it & 255, kk = it >> 8, xg = vbb & 7, ix = vbb >> 3, b = 2 * xg + (ix & 1), G = (ix >> 1) & 3, sub = ix >> 3;
        const int c = (kk & 1) ? (31 - G - 8 * (kk >> 1)) : (G + 8 * (kk >> 1));
        const int cend = (c + 1) * 64, t0 = c * 64 + sub * 16;
        const bf16* Pb = PROJ + (size_t)b * SEQ * NP;
        const bf16* KVb = (const bf16*)(p.ws + WS_KVC) + (size_t)b * SEQ * 128;
#pragma unroll 1
        for (int repa = 0; repa < DSA_REP_A; ++repa)
        if (c >= 4) {
            const bf16* qrow = Pb + (size_t)(t0 + l15) * NP;
            bf16x8 bq[4][2]; float wsc[4];
#pragma unroll
            for (int h = 0; h < 4; ++h) { wsc[h] = bf2f(qrow[C_WI + h]) * 0.0625f;
#pragma unroll
                for (int ks = 0; ks < 2; ++ks) bq[h][ks] = *(const bf16x8*)(qrow + C_QI + h * 64 + 32 * ks + 8 * g); }
            for (int k0 = 16 * wv; k0 < cend; k0 += 128) {
                const bf16* krow = Pb + (size_t)(k0 + l15) * NP + C_KI + 8 * g;
                const bf16x8 ka0 = *(const bf16x8*)krow, ka1 = *(const bf16x8*)(krow + 32);
                f32x4 sc = {0.f, 0.f, 0.f, 0.f};
#pragma unroll
                for (int h = 0; h < 4; ++h) { f32x4 a = {0.f, 0.f, 0.f, 0.f};
                    a = __builtin_amdgcn_mfma_f32_16x16x32_bf16(ka0, bq[h][0], a, 0, 0, 0);
                    a = __builtin_amdgcn_mfma_f32_16x16x32_bf16(ka1, bq[h][1], a, 0, 0, 0);
#pragma unroll
                    for (int r = 0; r < 4; ++r) sc[r] = fmaf(fmaxf(a[r], 0.f), wsc[h], sc[r]); }
#pragma unroll
                for (int r = 0; r < 4; ++r) sc[r] = (sc[r] == 0.f) ? 0.f : sc[r];
                *(LAS f32x4*)(ldsl + l15 * DSA_SROW + (k0 + 4 * g) * 4) = sc;
            }
        }
        __syncthreads();
        f32x4 cu[4];
        { const float* src_ = p.peer_u + (size_t)(it * 8 + wv) * 1024 + lane * 4;
#pragma unroll
          for (int j = 0; j < 4; ++j) cu[j] = *(const f32x4*)(src_ + 256 * j); }
        LAS unsigned short* selw = (LAS unsigned short*)(ldsl + DSA_SEL_OFF);
        int mind0 = 0, mind1 = 0;
        if (c < 4) {
            for (int j = lane; j < 256; j += 64) { selw[(2 * wv) * 256 + j] = (unsigned short)j; selw[(2 * wv + 1) * 256 + j] = (unsigned short)j; }
        } else {
            const int nreg = cend >> 6;
            unsigned keyA[32], keyB[32];
            { const LAS float* srA = (const LAS float*)(ldsl + (2 * wv) * DSA_SROW) + lane; const LAS float* srB = (const LAS float*)(ldsl + (2 * wv + 1) * DSA_SROW) + lane;
#pragma unroll
              for (int i = 0; i < 32; ++i) { keyA[i] = (i < nreg) ? sortkey(srA[64 * i]) : 0u; keyB[i] = (i < nreg) ? sortkey(srB[64 * i]) : 0u; } }
#define DSA_WSUM(V, OUT) do { int v_ = (V); v_ += __builtin_amdgcn_update_dpp(0, v_, 0x128, 0xf, 0xf, false); v_ += __builtin_amdgcn_update_dpp(0, v_, 0x124, 0xf, 0xf, false); \
        v_ += __builtin_amdgcn_update_dpp(0, v_, 0x122, 0xf, 0xf, false); v_ += __builtin_amdgcn_update_dpp(0, v_, 0x121, 0xf, 0xf, false);                                     \
        OUT = __builtin_amdgcn_readlane(v_, 0) + __builtin_amdgcn_readlane(v_, 16) + __builtin_amdgcn_readlane(v_, 32) + __builtin_amdgcn_readlane(v_, 48); } while (0)
            unsigned prefA = 0u, prefB = 0u; bool exA = false, exB = false;
#pragma unroll 1
            for (int bit = 31; bit >= 0; --bit) {
                const unsigned candA = exA ? prefA : (prefA | (1u << bit)), candB = exB ? prefB : (prefB | (1u << bit));
                int ca = 0, cb = 0;
#pragma unroll
                for (int i = 0; i < 32; i += 4) { cnt_ge4(ca, keyA[i], keyA[i + 1], keyA[i + 2], keyA[i + 3], candA); cnt_ge4(cb, keyB[i], keyB[i + 1], keyB[i + 2], keyB[i + 3], candB); }
                int cntA, cntB; DSA_WSUM(ca, cntA); DSA_WSUM(cb, cntB);
                if (!exA && cntA >= 256) { prefA = candA; exA = (cntA == 256); }
                if (!exB && cntB >= 256) { prefB = candB; exB = (cntB == 256); }
                if (exA && exB) break;
            }
#define DSA_COMPACT(KEY, PREFIX, EXACT, QQ, MIND) do {                                                                                              \
            const int t_ = t0 + (QQ); LAS unsigned short* sel = selw + (QQ) * 256;                                                                    \
            int need_ties = 0;                                                                                                                        \
            if (!(EXACT)) { int cg_ = 0; if ((PREFIX) != 0xffffffffu) { _Pragma("unroll") for (int i = 0; i < 32; ++i) cg_ += (KEY[i] > (PREFIX)) ? 1 : 0; } \
                int cgt; DSA_WSUM(cg_, cgt); need_ties = 256 - cgt; }                                                                                 \
            int base = 0, tbase = 0, md = 4096;                                                                                                       \
            _Pragma("unroll") for (int i = 0; i < 32; ++i) { if (i < nreg) {                                                                          \
                bool selb;                                                                                                                            \
                if (EXACT) selb = KEY[i] >= (PREFIX);                                                                                                 \
                else { const bool tie = KEY[i] == (PREFIX); const unsigned long long mt = __ballot(tie);                                              \
                    const int trank = tbase + (int)__builtin_amdgcn_mbcnt_hi((unsigned)(mt >> 32), __builtin_amdgcn_mbcnt_lo((unsigned)mt, 0u));      \
                    selb = (KEY[i] > (PREFIX)) || (tie && trank < need_ties); tbase += __popcll(mt); }                                                \
                const unsigned long long m = __ballot(selb);                                                                                          \
                const int pos = base + (int)__builtin_amdgcn_mbcnt_hi((unsigned)(m >> 32), __builtin_amdgcn_mbcnt_lo((unsigned)m, 0u));               \
                const int kidx = i * 64 + lane;                                                                                                       \
                if (selb) { sel[pos] = (unsigned short)kidx; const int d = t_ > kidx ? t_ - kidx : kidx - t_; md = d < md ? d : md; }                 \
                base += __popcll(m); } }                                                                                                              \
            _Pragma("unroll") for (int o = 1; o < 64; o <<= 1) { const int x = __shfl_xor(md, o); md = x < md ? x : md; }                             \
            MIND = md; } while (0)
            DSA_COMPACT(keyA, prefA, exA, 2 * wv, mind0);
            DSA_COMPACT(keyB, prefB, exB, 2 * wv + 1, mind1);
#undef DSA_COMPACT
#undef DSA_WSUM
        }
        { unsigned char* dst_ = (unsigned char*)(p.ws + WS_U16) + (size_t)(it * 8 + wv) * 1024 + lane * 4;
#pragma unroll
          for (int j = 0; j < 4; ++j) { int w_ = 0; w_ = __builtin_amdgcn_cvt_pk_fp8_f32(cu[j].x * 32.0f, cu[j].y * 32.0f, w_, false); w_ = __builtin_amdgcn_cvt_pk_fp8_f32(cu[j].z * 32.0f, cu[j].w * 32.0f, w_, true);
              *(unsigned*)(dst_ + 256 * j) = (unsigned)w_; } }
        LDS_WAIT(); asm volatile("" ::: "memory");
        const int nvalid = cend < 256 ? cend : 256;
        const int head = lane & 7;
        const float slopeL2 = exp2f(-(float)(head + 1)) * 1.4426950409f;
#pragma unroll 1
        for (int qi2 = 0; qi2 < 2 * DSA_REP_C; ++qi2) { const int qi = qi2 & 1;
            const int qq = 2 * wv + qi, t = t0 + qq;
            const LAS unsigned short* sel = selw + qq * 256;
            const bf16* qrow = Pb + (size_t)t * NP + C_QB + head * 128 + 8 * g;
            bf16x8 bq[4];
#pragma unroll
            for (int ks = 0; ks < 4; ++ks) bq[ks] = *(const bf16x8*)(qrow + 32 * ks);
            const float refL2 = MB * 1.4426950409f - slopeL2 * (float)(qi == 0 ? mind0 : mind1);
            f32x4 o[8];
#pragma unroll
            for (int dt = 0; dt < 8; ++dt) o[dt] = (f32x4){0.f, 0.f, 0.f, 0.f};
            float lsum = 0.f;
#define DSA_GATHER(S, BUF) do { _Pragma("unroll") for (int i_ = 0; i_ < 8; ++i_) { const int jr = 32 * (S) + 4 * i_ + g; const int keyr = sel[jr < nvalid ? jr : 0];   \
        __builtin_amdgcn_global_load_lds((const unsigned*)(KVb + (size_t)keyr * 128 + 8 * (l15 ^ ((4 * i_ + g) & 15))), (unsigned*)((BUF) + 1024 * i_), 16, 0, 0); } } while (0)
#define DSA_COMPUTE(S, BUF) do { unsigned pb[4]; const LAS unsigned char* stg = (const LAS unsigned char*)(BUF);                                          \
        _Pragma("unroll") for (int tl = 0; tl < 2; ++tl) { const int j0 = 32 * (S) + 16 * tl;                                                           \
            f32x4 a = {0.f, 0.f, 0.f, 0.f};                                                                                                             \
            _Pragma("unroll") for (int ks = 0; ks < 4; ++ks) { const bf16x8 ka_ = *(const LAS bf16x8*)(stg + (16 * tl + l15) * 256 + (((4 * ks + g) ^ l15) << 4)); \
                a = __builtin_amdgcn_mfma_f32_16x16x32_bf16(ka_, bq[ks], a, 0, 0, 0); }                                                                 \
            const u32x2 kw = *(const LAS u32x2*)(sel + j0 + 4 * g);                                                                                     \
            const int kx[4] = {(int)(kw.x & 0xffffu), (int)(kw.x >> 16), (int)(kw.y & 0xffffu), (int)(kw.y >> 16)};                                     \
            float pr[4];                                                                                                                                \
            _Pragma("unroll") for (int r = 0; r < 4; ++r) { const int dd = t > kx[r] ? t - kx[r] : kx[r] - t;                                            \
                const float e = __builtin_amdgcn_exp2f(fmaf(a[r], 0.1275174f, -slopeL2 * (float)dd - refL2));                                            \
                pr[r] = (j0 + 4 * g + r < nvalid) ? e : 0.f; lsum += pr[r]; }                                                                           \
            pb[2 * tl] = cvtpk_bf16(pr[0], pr[1]); pb[2 * tl + 1] = cvtpk_bf16(pr[2], pr[3]); }                                                         \
        u32x4 pw4; pw4.x = pb[0]; pw4.y = pb[1]; pw4.z = pb[2]; pw4.w = pb[3];                                                                          \
        const bf16x8 pfrag = __builtin_bit_cast(bf16x8, pw4);                                                                                           \
        const int rr_ = 4 * g + (l15 >> 2);                                                                                                             \
        _Pragma("unroll") for (int dt = 0; dt < 8; ++dt) {                                                                                              \
            const LAS unsigned char* trp = stg + rr_ * 256 + (((2 * dt + ((lane & 3) >> 1)) ^ rr_) << 4) + 8 * (lane & 1);                                \
            const s16x4 lo = __builtin_bit_cast(s16x4, __builtin_amdgcn_ds_read_tr16_b64_v4i16((LAS v4i16_t*)trp));                                    \
            const s16x4 hi = __builtin_bit_cast(s16x4, __builtin_amdgcn_ds_read_tr16_b64_v4i16((LAS v4i16_t*)(trp + 16 * 256)));                        \
            const bf16x8 af = {lo[0], lo[1], lo[2], lo[3], hi[0], hi[1], hi[2], hi[3]};                                                                 \
            o[dt] = __builtin_amdgcn_mfma_f32_16x16x32_bf16(af, pfrag, o[dt], 0, 0, 0); }                                                               \
        LDS_WAIT(); asm volatile("" ::: "memory"); } while (0)
            const int nch = (nvalid + 31) >> 5;
            unsigned char* buf0 = lds + (2 * wv) * DSA_SROW; unsigned char* buf1 = buf0 + 8192;
            DSA_GATHER(0, buf0);
#pragma unroll 1
            for (int s = 0; s < nch; s += 2) {
                if (s + 1 < nch) DSA_GATHER(s + 1, buf1);
                if (s + 1 < nch) asm volatile("s_waitcnt vmcnt(8)" ::: "memory"); else asm volatile("s_waitcnt vmcnt(0)" ::: "memory");
                DSA_COMPUTE(s, buf0);
                if (s + 1 < nch) { if (s + 2 < nch) DSA_GATHER(s + 2, buf0);
                    if (s + 2 < nch) asm volatile("s_waitcnt vmcnt(8)" ::: "memory"); else asm volatile("s_waitcnt vmcnt(0)" ::: "memory");
                    DSA_COMPUTE(s + 1, buf1); }
            }
#undef DSA_GATHER
#undef DSA_COMPUTE
            lsum += __shfl_xor(lsum, 16); lsum += __shfl_xor(lsum, 32);
            const float il = 1.f / lsum;
            if (l15 < 8) {
                bf16* orow = MIX + (size_t)(b * SEQ + t) * MIXW + 512 + head * 128 + 4 * g;
#pragma unroll
                for (int dt = 0; dt < 8; ++dt) { u32x2 w; w.x = pk2(o[dt][0] * il, o[dt][1] * il); w.y = pk2(o[dt][2] * il, o[dt][3] * il); *(u32x2*)(orow + 16 * dt) = w; }
            }
        }
        __syncthreads();
    }
}
typedef __attribute__((address_space(1))) float GASF;
#ifndef ATT_PROBE
#define ATT_PROBE 0
#endif
#ifndef ATT_REMAP
#define ATT_REMAP 1
#endif
__device__ __forceinline__ int crow(int r, int hi) { return (r & 3) + 8 * (r >> 2) + 4 * hi; }
#define KSWZ64(row, cb) ((row) * 128 + ((cb) ^ ((((row) >> 1) & 7) << 4)))
__device__ __forceinline__ int v_st(int k, int c) { const int kk = (k & ~0xC) | ((k & 4) << 1) | ((k & 8) >> 1); return ((kk >> 3) * 4 + (c >> 5)) * 512 + ((kk & 7) * 32 + (c & 31)) * 2; }
__device__ __forceinline__ int v_rd_base(int lane) { return ((lane & 3) << 3) | (((lane >> 2) & 3) << 6) | (((lane >> 4) & 1) << 5) | (((lane >> 5) & 1) << 8); }
constexpr int v_rd_off(int d0, int ks, int half) { return d0 * 512 + ks * 4096 + half * 2048; }
template <int OFF> __device__ __forceinline__ s16x4 tr_read(int vb) {
    s16x4 r; asm volatile("ds_read_b64_tr_b16 %0, %1 offset:%2" : "=&v"(r) : "v"(vb), "i"(OFF) : "memory"); return r;
}
template <int D0> __device__ __forceinline__ void pv_one(f32x16& od, int vb, bf16x8 pa0, bf16x8 pa1, bf16x8 pa2, bf16x8 pa3) {
    const s16x4 l0 = tr_read<v_rd_off(D0, 0, 0)>(vb), h0 = tr_read<v_rd_off(D0, 0, 1)>(vb), l1 = tr_read<v_rd_off(D0, 1, 0)>(vb), h1 = tr_read<v_rd_off(D0, 1, 1)>(vb);
    const s16x4 l2 = tr_read<v_rd_off(D0, 2, 0)>(vb), h2 = tr_read<v_rd_off(D0, 2, 1)>(vb), l3 = tr_read<v_rd_off(D0, 3, 0)>(vb), h3 = tr_read<v_rd_off(D0, 3, 1)>(vb);
    asm volatile("s_waitcnt lgkmcnt(0)" ::: "memory"); __builtin_amdgcn_sched_barrier(0);
#define PK(L, H) (bf16x8){L[0], L[1], L[2], L[3], H[0], H[1], H[2], H[3]}
    od = __builtin_amdgcn_mfma_f32_32x32x16_bf16(pa0, PK(l0, h0), od, 0, 0, 0);
    od = __builtin_amdgcn_mfma_f32_32x32x16_bf16(pa1, PK(l1, h1), od, 0, 0, 0);
    od = __builtin_amdgcn_mfma_f32_32x32x16_bf16(pa2, PK(l2, h2), od, 0, 0, 0);
    od = __builtin_amdgcn_mfma_f32_32x32x16_bf16(pa3, PK(l3, h3), od, 0, 0, 0);
#undef PK
}

__device__ __forceinline__ void att_tile(f32x16 (&o)[4], float& lsum, const unsigned char* Kb, int vb0, const unsigned char* Qw, int r32, int hi, int tq, int j, bool past, float slopeL2, float refL2) {
    constexpr float C = 0.125f * 1.4426950409f;
    bf16x8 qr[4];
#pragma unroll
    for (int d0 = 0; d0 < 4; ++d0) qr[d0] = *(const bf16x8*)(Qw + KSWZ64(r32, (d0 * 16 + hi * 8) * 2));
    const float dq = (float)(tq - 64 * j - 4 * hi);
    const float B0 = -slopeL2 * dq - refL2;
    float ps = 0.f;
    bf16x8 pa0, pa1, pa2, pa3;
#define PK4(P, BASE, OUT) do { unsigned a0 = cvtpk_bf16(P[BASE + 0], P[BASE + 1]), a1 = cvtpk_bf16(P[BASE + 2], P[BASE + 3]);   \
    unsigned b0_ = cvtpk_bf16(P[BASE + 4], P[BASE + 5]), b1_ = cvtpk_bf16(P[BASE + 6], P[BASE + 7]);                              \
    auto r0 = __builtin_amdgcn_permlane32_swap(a0, b0_, false, false); auto r1 = __builtin_amdgcn_permlane32_swap(a1, b1_, false, false); \
    u32x4 w = {r0[0], r1[0], r0[1], r1[1]}; OUT = __builtin_bit_cast(bf16x8, w); } while (0)
#define HALF_TILE(KOFF, FOFF, PA, PB) do { f32x16 pp = f32x16{};                                                                     \
    _Pragma("unroll") for (int d0 = 0; d0 < 4; ++d0) { const int cb = (d0 * 16 + hi * 8) * 2;                                        \
        const bf16x8 bk = *(const bf16x8*)(Kb + KSWZ64((KOFF) + r32, cb)); pp = __builtin_amdgcn_mfma_f32_32x32x16_bf16(bk, qr[d0], pp, 0, 0, 0); } \
    if (past) { _Pragma("unroll") for (int r = 0; r < 16; ++r) { const float off = (float)((r & 3) + 8 * (r >> 2)) + (FOFF);          \
            pp[r] = __builtin_amdgcn_exp2f(fmaf(pp[r], C, fmaf(slopeL2, off, B0))); } }                                               \
    else { _Pragma("unroll") for (int r = 0; r < 16; ++r) { const float off = (float)((r & 3) + 8 * (r >> 2)) + (FOFF);               \
            pp[r] = __builtin_amdgcn_exp2f(fmaf(pp[r], C, -slopeL2 * fabsf(dq - off) - refL2)); } }                                   \
    _Pragma("unroll") for (int r = 0; r < 16; ++r) ps += pp[r];                                                                       \
    PK4(pp, 0, PA); PK4(pp, 8, PB); __builtin_amdgcn_sched_barrier(0); } while (0)
    HALF_TILE(0, 0.f, pa0, pa1);
    HALF_TILE(32, 32.f, pa2, pa3);
#undef HALF_TILE
#undef PK4
    { auto rr = __builtin_amdgcn_permlane32_swap(__float_as_uint(ps), __float_as_uint(ps), false, false);
      ps = __uint_as_float(rr[0]) + __uint_as_float(rr[1]); }
    lsum += ps;
    pv_one<0>(o[0], vb0, pa0, pa1, pa2, pa3); pv_one<1>(o[1], vb0, pa0, pa1, pa2, pa3); pv_one<2>(o[2], vb0, pa0, pa1, pa2, pa3); pv_one<3>(o[3], vb0, pa0, pa1, pa2, pa3);
}
constexpr int ATT_LDS = 2 * 16384 + 2 * 8192 + 8 * 256 + 8 * 4096;

__device__ __forceinline__ void ph_attnA(const Params& p, unsigned char* lds, int vb, int nvb) {
    const bf16* PROJ = (const bf16*)(p.ws + WS_PROJ); bf16* MIX = (bf16*)(p.ws + WS_MIX);
    const float* SC = (const float*)(p.ws + WS_SCAL);
    const float lam = SC[SC_LAM], refL2 = SC[SC_MA] * 1.4426950409f;
    constexpr float C = 0.125f * 1.4426950409f;
    int tid = threadIdx.x; asm volatile("" : "+v"(tid)); const int lane = tid & 63, wid = __builtin_amdgcn_readfirstlane(tid >> 6), r32 = lane & 31, hi = lane >> 5;
    unsigned char* V_lds = lds; unsigned char* K_lds = lds + 32768;
    float* wsf = (float*)(lds + 49152) + wid * 64;
    GASF* tmpw = (GASF*)(p.ws + WS_ATMP) + ((size_t)(vb * NWV + wid) * 64) * 64 + lane;
    const int vbase = (int)(uintptr_t)V_lds + v_rd_base(lane);
    const int krow = tid >> 3, kch = tid & 7, kdst = KSWZ64(krow, kch * 16);
    const int sr = tid >> 4, sc = (tid & 15) * 8, vst0 = v_st(sr, sc), vst1 = v_st(32 + sr, sc);
    for (int it = vb; it < 256; it += nvb) {
        #if ATT_REMAP
        const int xg_ = it & 7, m_ = it >> 3, pidx = xg_ * 8 + (m_ >> 2), qbl = m_ & 3, b = pidx >> 2, h = pidx & 3;
#else
        const int b = it >> 4, h = (it >> 2) & 3, qbl = it & 3;
#endif
        const float slopeL2 = exp2f(-2.0f * (float)(h + 1)) * 1.4426950409f;
        const bf16* Pb = PROJ + (size_t)b * SEQ * NP;
#pragma unroll 1
        for (int half = 0; half < 2; ++half) {
            const int qb = half ? 7 - qbl : qbl, q0 = 256 * qb, NTu = 4 * (qb + 1), cw = 4 * qb + (wid >> 1);
            const int tq = q0 + 32 * wid + r32;
#pragma unroll 1
            for (int mi = 0; mi < 2; ++mi) {
                const int m = 1 - mi;
                const bf16* Kg = Pb + C_KA + h * 128 + m * 64 + (size_t)krow * NP + kch * 8;
                const bf16* Vg = Pb + C_VA + h * 128 + (size_t)sr * NP + sc;
                unsigned char* Qw = lds + 51200 + wid * 4096;
                { const bf16* qp = Pb + (size_t)tq * NP + C_QA + h * 128 + m * 64 + hi * 8;
#pragma unroll
                  for (int d0 = 0; d0 < 4; ++d0) *(bf16x8*)(Qw + KSWZ64(r32, (d0 * 16 + hi * 8) * 2)) = *(const bf16x8*)(qp + d0 * 16); }
                f32x16 o[4];
#pragma unroll
                for (int d = 0; d < 4; ++d) o[d] = f32x16{};
                float lsum = 0.f;
                bf16x8 ak, av0, av1;
#define ATT_LOAD(K_, V0_, V1_, TJ) do { const size_t go_ = (size_t)(TJ) * 64 * NP; K_ = *(const bf16x8*)(Kg + go_); V0_ = *(const bf16x8*)(Vg + go_); V1_ = *(const bf16x8*)(Vg + go_ + (size_t)32 * NP); \
        if (ATT_PROBE == 2) { bf16x8 d0_ = *(const volatile bf16x8*)(Kg + go_); bf16x8 d1_ = *(const volatile bf16x8*)(Vg + go_); bf16x8 d2_ = *(const volatile bf16x8*)(Vg + go_ + (size_t)32 * NP); asm volatile("" :: "v"(d0_), "v"(d1_), "v"(d2_)); } } while (0)
#define ATT_WRITE(K_, V0_, V1_, NB) do { *(bf16x8*)(K_lds + (NB) * 8192 + kdst) = K_; *(bf16x8*)(V_lds + (NB) * 16384 + vst0) = V0_; *(bf16x8*)(V_lds + (NB) * 16384 + vst1) = V1_; } while (0)
                ATT_LOAD(ak, av0, av1, 0); ATT_WRITE(ak, av0, av1, 0);
                __syncthreads();
#pragma unroll 1
                for (int j = 0; j < NTu; ++j) {
                    const int buf = j & 1;
                    if (j + 1 < NTu) ATT_LOAD(ak, av0, av1, j + 1);
                    if (j <= cw) { att_tile(o, lsum, K_lds + buf * 8192, vbase + buf * 16384, Qw, r32, hi, tq, j, j < cw, slopeL2, refL2);
#if ATT_PROBE == 1
                        { f32x16 o2[4]; o2[0] = o[0]; o2[1] = o[1]; o2[2] = o[2]; o2[3] = o[3]; float l2 = 0.f; att_tile(o2, l2, K_lds + buf * 8192, vbase + buf * 16384, Qw, r32, hi, tq, j, j < cw, slopeL2, refL2);
                          asm volatile("" :: "v"(o2[0]), "v"(o2[1]), "v"(o2[2]), "v"(o2[3]), "v"(l2)); }
#endif
                    }
                    if (j + 1 < NTu) ATT_WRITE(ak, av0, av1, buf ^ 1);
                    __syncthreads();
                }
#undef ATT_LOAD
#undef ATT_WRITE
                if (hi == 0) wsf[r32] = lsum;
                LDS_WAIT(); asm volatile("" ::: "memory");
                float rli[16];
#pragma unroll
                for (int r = 0; r < 16; ++r) rli[r] = 1.f / wsf[crow(r, hi)];
                LDS_WAIT(); asm volatile("" ::: "memory");
                if (mi == 0) {
#pragma unroll
                    for (int d = 0; d < 4; ++d) { GASF* td = tmpw + d * 1024; asm volatile("" : "+v"(td));
#pragma unroll
                        for (int r = 0; r < 16; ++r) td[r * 64] = o[d][r] * rli[r]; }
                } else {
                    float gsub[4];
#pragma unroll
                    for (int d = 0; d < 4; ++d) gsub[d] = p.a_sub_gain[32 * d + r32];
                    GASF* tdp[4];
#pragma unroll
                    for (int d = 0; d < 4; ++d) { tdp[d] = tmpw + d * 1024; asm volatile("" : "+v"(tdp[d])); }
#pragma unroll
                    for (int r = 0; r < 16; ++r) {
                        float v[4]; float ss = 0.f;
#pragma unroll
                        for (int d = 0; d < 4; ++d) { v[d] = o[d][r] * rli[r] - lam * tdp[d][r * 64]; ss += v[d] * v[d]; }
                        ss += __shfl_xor(ss, 1); ss += __shfl_xor(ss, 2); ss += __shfl_xor(ss, 4); ss += __shfl_xor(ss, 8); ss += __shfl_xor(ss, 16);
                        const float rs = rsqrtf(ss * (1.f / 128.f) + EPS) * 0.8f;
                        bf16* orow = MIX + (size_t)(b * SEQ + q0 + 32 * wid + crow(r, hi)) * MIXW + h * 128 + r32;
#pragma unroll
                        for (int d = 0; d < 4; ++d) orow[32 * d] = (bf16)f2bf(v[d] * rs * gsub[d]);
                        asm volatile("" ::: "memory");
                    }
                }
            }
        }
    }
}
constexpr int RT_WAVE_BYTES = 12288;
constexpr int RT_LDS = 32768 + 8 * RT_WAVE_BYTES;

__device__ __forceinline__ int pl32_sum(int v) { auto rr = __builtin_amdgcn_permlane32_swap((unsigned)v, (unsigned)v, false, false); return (int)(rr[0] + rr[1]); }
__device__ __forceinline__ int pl32_other(int v) { auto rr = __builtin_amdgcn_permlane32_swap((unsigned)v, (unsigned)v, false, false); return (int)(rr[0] + rr[1]) - v; }
__device__ __forceinline__ float unsortkey(unsigned k) { return __uint_as_float((k & 0x80000000u) ? (k ^ 0x80000000u) : ~k); }

__device__ __forceinline__ unsigned wave_or(unsigned v) {
    v |= (unsigned)__builtin_amdgcn_update_dpp(0, (int)v, 0x128, 0xf, 0xf, false); v |= (unsigned)__builtin_amdgcn_update_dpp(0, (int)v, 0x124, 0xf, 0xf, false);
    v |= (unsigned)__builtin_amdgcn_update_dpp(0, (int)v, 0x122, 0xf, 0xf, false); v |= (unsigned)__builtin_amdgcn_update_dpp(0, (int)v, 0x121, 0xf, 0xf, false);
    return (unsigned)(__builtin_amdgcn_readlane((int)v, 0) | __builtin_amdgcn_readlane((int)v, 16) | __builtin_amdgcn_readlane((int)v, 32) | __builtin_amdgcn_readlane((int)v, 48));
}
template <int N> __device__ __forceinline__ unsigned bisect16(const unsigned (&key)[N]) {
    unsigned kmx, lo;
    { unsigned gm[8];
#pragma unroll
      for (int g = 0; g < 8; ++g) { gm[g] = key[g];
#pragma unroll
          for (int i = g + 8; i < N; i += 8) gm[g] = key[i] > gm[g] ? key[i] : gm[g]; }
      kmx = gm[0]; lo = gm[0];
#pragma unroll
      for (int g = 1; g < 8; ++g) { kmx = gm[g] > kmx ? gm[g] : kmx; lo = gm[g] < lo ? gm[g] : lo; }
      const unsigned okmx = (unsigned)pl32_other((int)kmx), olo = (unsigned)pl32_other((int)lo);
      kmx = okmx > kmx ? okmx : kmx; lo = olo < lo ? olo : lo; }
    const unsigned x = kmx - lo;
    int pb = x ? 31 - __clz(x) : -1;
    unsigned prefix = 0u; bool done = (x == 0u);
#pragma unroll 1
    while (!__all(done)) {
        const unsigned c_ = done ? prefix : (prefix | (1u << pb));
        unsigned cand = lo + c_; cand = cand < lo ? 0xffffffffu : cand;
        int cnt = 0;
#pragma unroll
        for (int i = 0; i + 3 < N; i += 4) cnt_ge4(cnt, key[i], key[i + 1], key[i + 2], key[i + 3], cand);
#pragma unroll
        for (int i = N & ~3; i < N; ++i) cnt += (key[i] >= cand) ? 1 : 0;
        const int tot = pl32_sum(cnt);
        if (!done && tot >= 16) { prefix = c_; done = (tot == 16); }
        --pb; done = done || (pb < 0);
    }
    prefix += lo;
    return prefix;
}

__device__ __forceinline__ void ph_route_subk(const Params& p, unsigned char* lds) {
    const bf16* SUBK = (const bf16*)(p.ws + WS_SUBK);
    int tid = threadIdx.x; asm volatile("" : "+v"(tid));
    for (int i = tid; i < 2048; i += NT) { const int row = i >> 3, ch = i & 7; ((u32x4*)lds)[row * 8 + (ch ^ ((row >> 1) & 7))] = ((const u32x4*)SUBK)[i]; }
    __syncthreads();
}
__device__ __forceinline__ void ph_route(const Params& p, unsigned char* lds, int item0, int item1, int wrank, int nwr) {
    const bf16* Q3 = (const bf16*)(p.ws + WS_Q3);
    int* EXPI = (int*)(p.ws + WS_EXP); float* GATE = (float*)(p.ws + WS_GATE);
    int tid = threadIdx.x; asm volatile("" : "+v"(tid));
    const int lane = tid & 63, wv = __builtin_amdgcn_readfirstlane(tid >> 6), r32 = lane & 31, hi = lane >> 5;
    unsigned char* wl = lds + 32768 + wv * RT_WAVE_BYTES;
    float* sv = (float*)wl; int* si = (int*)(wl + 4096); float* fv = (float*)(wl + 8192); int* fe = (int*)(wl + 10240);
    for (int item = item0 + wrank; item < item1; item += nwr) {
        const int h = item & 7, tok0 = (item >> 3) * 32;
        const bf16* qrow = Q3 + (size_t)(tok0 + r32) * 1024 + h * 128 + hi * 8;
#pragma unroll 1
        for (int c = 0; c < 2; ++c) {
            f32x4 cv[4]; const int crow = item * 2 + c;
            { const float* src_ = p.peer_v + (size_t)crow * 1024 + lane * 4;
#pragma unroll
              for (int j = 0; j < 4; ++j) cv[j] = *(const f32x4*)(src_ + 256 * j); }
            bf16x8 bq[4];
#pragma unroll
            for (int d0 = 0; d0 < 4; ++d0) bq[d0] = *(const bf16x8*)(qrow + c * 64 + d0 * 16);
            unsigned key[64];
#pragma unroll
            for (int nt = 0; nt < 4; ++nt) {
                f32x16 acc = f32x16{};
                const int krow = c * 128 + nt * 32 + r32, ksw = (krow >> 1) & 7;
                const unsigned char* kp = lds + krow * 128;
#pragma unroll
                for (int d0 = 0; d0 < 4; ++d0) { const bf16x8 ak = *(const bf16x8*)(kp + (((2 * d0 + hi) ^ ksw) << 4)); acc = __builtin_amdgcn_mfma_f32_32x32x16_bf16(ak, bq[d0], acc, 0, 0, 0); }
#pragma unroll
                for (int r = 0; r < 16; ++r) key[nt * 16 + r] = sortkey(acc[r]);
            }
            const unsigned thr = bisect16<64>(key);
            int cnt = 0;
#pragma unroll
            for (int i = 0; i < 64; ++i) cnt += (key[i] >= thr) ? 1 : 0;
            const int other_ = pl32_other(cnt); int slot = hi ? other_ : 0;
            float* svp = sv + (r32 * 2 + c) * 16; int* sip = si + (r32 * 2 + c) * 16;
#pragma unroll
            for (int i = 0; i < 64; ++i) {
                if (key[i] >= thr && slot < 16) { svp[slot] = unsortkey(key[i]); sip[slot] = 32 * (i >> 4) + ((i & 3) + 8 * ((i & 15) >> 2)) + 4 * hi; ++slot; }
            }
            { unsigned char* dst_ = (unsigned char*)(p.ws + WS_V16) + (size_t)crow * 1024 + lane * 4;
#pragma unroll
              for (int j = 0; j < 4; ++j) { int w_ = 0; w_ = __builtin_amdgcn_cvt_pk_fp8_f32(cv[j].x, cv[j].y, w_, false); w_ = __builtin_amdgcn_cvt_pk_fp8_f32(cv[j].z, cv[j].w, w_, true);
                  *(unsigned*)(dst_ + 256 * j) = (unsigned)w_; } }
        }
        LDS_WAIT(); asm volatile("" ::: "memory");
        u32x4 hb[4]; f32x4 hs, hsh[4];
#define RT_H2_LOAD(HALF) do { const int tk_ = tok0 + 16 * (HALF) + (lane >> 3), p8_ = lane & 7; const int cc_ = h * 128 + 8 * p8_;                            \
            const bf16* hp_ = (const bf16*)(p.ws + WS_H) + (size_t)tk_ * 1024 + cc_;                                                                       \
            const float* sh_ = (const float*)(p.ws + WS_MOD) + (size_t)(tk_ >> 11) * 6144 + 3072 + cc_;                                                    \
            _Pragma("unroll") for (int j = 0; j < 4; ++j) hb[j] = *(const u32x4*)(hp_ + (size_t)(j >> 1) * 8 * 1024 + 64 * (j & 1));                        \
            hs = *((const f32x4*)(p.ws + WS_SSQ) + (size_t)(tk_ + 8 * (p8_ >> 2)) * 4 + (p8_ & 3));                                                        \
            hsh[0] = *(const f32x4*)sh_; hsh[1] = *(const f32x4*)(sh_ + 4); hsh[2] = *(const f32x4*)(sh_ + 64); hsh[3] = *(const f32x4*)(sh_ + 68); } while (0)
#define RT_H2_STORE(HALF) do { const int tk_ = tok0 + 16 * (HALF) + (lane >> 3), p8_ = lane & 7; const int cc_ = h * 128 + 8 * p8_;                           \
            bf16* hp_ = (bf16*)(p.ws + WS_H) + (size_t)tk_ * 1024 + cc_;                                                                                   \
            float s_ = (hs[0] + hs[1]) + (hs[2] + hs[3]); s_ += __shfl_xor(s_, 1); s_ += __shfl_xor(s_, 2);                                                 \
            const float so_ = __shfl_xor(s_, 4); const float rsme_ = rsqrtf(s_ * (1.f / 1024.f) + EPS), rsot_ = rsqrtf(so_ * (1.f / 1024.f) + EPS);           \
            const float rs0_ = (p8_ & 4) ? rsot_ : rsme_, rs1_ = (p8_ & 4) ? rsme_ : rsot_;                           \
            _Pragma("unroll") for (int j = 0; j < 4; ++j) { const f32x4 a_ = hsh[2 * (j & 1)], b_ = hsh[2 * (j & 1) + 1]; const float rs_ = (j >> 1) ? rs1_ : rs0_; u32x4 w_; \
                w_.x = cvtpk_bf16(fmaf(bflo(hb[j].x), rs_, a_[0]), fmaf(bfhi(hb[j].x), rs_, a_[1])); w_.y = cvtpk_bf16(fmaf(bflo(hb[j].y), rs_, a_[2]), fmaf(bfhi(hb[j].y), rs_, a_[3])); \
                w_.z = cvtpk_bf16(fmaf(bflo(hb[j].z), rs_, b_[0]), fmaf(bfhi(hb[j].z), rs_, b_[1])); w_.w = cvtpk_bf16(fmaf(bflo(hb[j].w), rs_, b_[2]), fmaf(bfhi(hb[j].w), rs_, b_[3])); \
                *(u32x4*)(hp_ + (size_t)(j >> 1) * 8 * 1024 + 64 * (j & 1)) = w_; } } while (0)
        RT_H2_LOAD(0);
        LDS_WAIT(); asm volatile("" ::: "memory");
        {
            float* sv0 = sv + (r32 * 2) * 16; float* sv1 = sv0 + 16; int* si0 = si + (r32 * 2) * 16; int* si1 = si0 + 16;
            {
                float a[16], bl[16];
#pragma unroll
                for (int k = 0; k < 16; ++k) { a[k] = sv0[k]; bl[k] = sv1[k]; }
                int ia[8], ib[8], ra[8], rb[8]; float va[8], vb[8];
#pragma unroll
                for (int q = 0; q < 8; ++q) { const int e = 8 * hi + q; va[q] = sv0[e]; vb[q] = sv1[e]; ia[q] = si0[e]; ib[q] = si1[e]; int r0 = 0, r1 = 0;
#pragma unroll
                    for (int k = 0; k < 16; ++k) { r0 += (a[k] > va[q] || (a[k] == va[q] && k < e)) ? 1 : 0; r1 += (bl[k] > vb[q] || (bl[k] == vb[q] && k < e)) ? 1 : 0; }
                    ra[q] = r0; rb[q] = r1; }
                LDS_WAIT(); asm volatile("" ::: "memory");
                { auto rr = __builtin_amdgcn_permlane32_swap(0u, 0u, false, false); (void)rr; }
#pragma unroll
                for (int q = 0; q < 8; ++q) { sv0[ra[q]] = va[q]; si0[ra[q]] = ia[q]; sv1[rb[q]] = vb[q]; si1[rb[q]] = ib[q]; }
                LDS_WAIT(); asm volatile("" ::: "memory");
            }
            const float* X = hi ? sv1 : sv0; const float* Y = hi ? sv0 : sv1;
            float x[4], y[16];
#pragma unroll
            for (int k = 0; k < 4; ++k) x[k] = X[k];
#pragma unroll
            for (int k = 0; k < 16; ++k) y[k] = Y[k];
            unsigned key[27]; int pi[27], pj[27]; int np = 0;
#pragma unroll
            for (int i = 0; i < 3; ++i)
#pragma unroll
                for (int j = i + 1; j < 16; ++j) if ((i + 1) * (j + 1) <= 16) { key[np] = sortkey(x[i] + y[j]); pi[np] = i; pj[np] = j; ++np; }
#pragma unroll
            for (int i = 0; i < 4; ++i) { key[23 + i] = hi ? 0u : sortkey(x[i] + y[i]); pi[23 + i] = i; pj[23 + i] = i; }
            RT_H2_STORE(0); RT_H2_LOAD(1);
            const unsigned thr = bisect16<27>(key);
            int cnt = 0;
#pragma unroll
            for (int i = 0; i < 27; ++i) cnt += (key[i] >= thr) ? 1 : 0;
            const int other_ = pl32_other(cnt); int slot = hi ? other_ : 0;
            const int* IX = hi ? si1 : si0; const int* IY = hi ? si0 : si1;
            float* fvp = fv + r32 * 16; int* fep = fe + r32 * 16;
#pragma unroll
            for (int i = 0; i < 27; ++i) {
                if (key[i] >= thr && slot < 16) { const int ex = IX[pi[i]], ey = IY[pj[i]]; fvp[slot] = unsortkey(key[i]); fep[slot] = hi ? (ey * 128 + ex) : (ex * 128 + ey); ++slot; }
            }
        }
        LDS_WAIT(); asm volatile("" ::: "memory");
        {
            const float* fvp = fv + r32 * 16;
            float v[16]; float mx = -3e38f;
#pragma unroll
            for (int k = 0; k < 16; ++k) { v[k] = fvp[k]; mx = fmaxf(mx, v[k]); }
            float l = 0.f;
#pragma unroll
            for (int k = 0; k < 16; ++k) { v[k] = __expf(v[k] - mx); l += v[k]; }
            const float il = 1.f / l;
            const size_t ob = (size_t)(tok0 + r32) * 128 + h * 16 + 8 * hi;
            const int* fep = fe + r32 * 16 + 8 * hi;
            f32x4 g0, g1; u32x4 e0, e1;
            if (hi == 0) { g0 = (f32x4){v[0] * il, v[1] * il, v[2] * il, v[3] * il}; g1 = (f32x4){v[4] * il, v[5] * il, v[6] * il, v[7] * il}; }
            else { g0 = (f32x4){v[8] * il, v[9] * il, v[10] * il, v[11] * il}; g1 = (f32x4){v[12] * il, v[13] * il, v[14] * il, v[15] * il}; }
            e0 = *(const u32x4*)fep; e1 = *(const u32x4*)(fep + 4);
            *(f32x4*)(GATE + ob) = g0; *(f32x4*)(GATE + ob + 4) = g1;
            *(u32x4*)(EXPI + ob) = e0; *(u32x4*)(EXPI + ob + 4) = e1;
        }
        RT_H2_STORE(1);
#undef RT_H2_LOAD
#undef RT_H2_STORE
        LDS_WAIT(); asm volatile("" ::: "memory");
    }
}
typedef float f32x2_t __attribute__((ext_vector_type(2)));
constexpr int P8_UNITS = T / 64;
constexpr int CW_P8_U = 4096, CW_P8_V = 4096 + 32 * 64;
constexpr float U8_SCALE = 32.0f;
__device__ __forceinline__ unsigned peer_xcc() { return (unsigned)__builtin_amdgcn_s_getreg((3 << 11) | 20) & 7u; }
#ifndef U8_HALVES
#define U8_HALVES 0
#endif
template <int LPR>
__device__ __forceinline__ void ph_peer_v8g(const Params& p, unsigned char* lds) {
    constexpr int RPI = 64 / LPR, NI = 128 / RPI, G = NI / 8, NS = 64 / LPR, SLB = 16 * LPR;
    const unsigned char* V8 = (const unsigned char*)(p.ws + WS_V16);
    const int* EXPI = (const int*)(p.ws + WS_EXP); const float* CBUF = (const float*)(p.ws + WS_CBUF); const float* MOD = (const float*)(p.ws + WS_MOD);
    const float* AB1 = (const float*)(p.ws + WS_ABUF1); const float* GATEP = (const float*)(p.ws + WS_GATE); (void)AB1; (void)GATEP;
    unsigned* ctl = (unsigned*)(p.ws + WS_CTL);
    int tid = threadIdx.x; asm volatile("" : "+v"(tid));
    const int lane = tid & 63, wv = __builtin_amdgcn_readfirstlane(tid >> 6), gR = lane / LPR, iC = lane % LPR;
    volatile LAS unsigned* slot = (volatile LAS unsigned*)(LAS unsigned char*)lds;
    const unsigned xcc = peer_xcc();
#pragma unroll 1
    for (int k = 0; k < NS; ++k) {
        const int sl = (int)((((xcc * NS) >> 3) + (unsigned)k) % (unsigned)NS);
        const unsigned char* vcol = V8 + SLB * sl + 16 * iC;
#pragma unroll 1
        for (;;) {
            if (tid == 0) *slot = __hip_atomic_fetch_add(ctl + CW_P8_V + 64 * sl, 1u, __ATOMIC_RELAXED, __HIP_MEMORY_SCOPE_AGENT);
            __syncthreads();
            const unsigned unit = *slot;
            __syncthreads();
            if (unit >= (unsigned)P8_UNITS) break;
            const int tbase = (int)unit * 64 + wv * 8;
            int ne0, ne1; float nc0, nc1;
#if U8_HALVES
#define VG_FETCH(T) do { const size_t tn_ = (size_t)(T); ne0 = EXPI[tn_ * 128 + lane]; ne1 = EXPI[tn_ * 128 + 64 + lane];                              \
        nc0 = gelu_erf(CBUF[tn_ * 128 + lane] + AB1[tn_ * 128 + lane]) * GATEP[tn_ * 128 + lane];                                              \
        nc1 = gelu_erf(CBUF[tn_ * 128 + 64 + lane] + AB1[tn_ * 128 + 64 + lane]) * GATEP[tn_ * 128 + 64 + lane]; } while (0)
#else
#define VG_FETCH(T) do { const size_t tn_ = (size_t)(T); ne0 = EXPI[tn_ * 128 + lane]; ne1 = EXPI[tn_ * 128 + 64 + lane]; nc0 = CBUF[tn_ * 128 + lane]; nc1 = CBUF[tn_ * 128 + 64 + lane]; } while (0)
#endif
#define VG_LISTS(LE, LC) do { LE[lane] = ne0; LE[64 + lane] = ne1; LC[lane] = nc0; LC[64 + lane] = nc1; } while (0)
#define VG_ROWS(R, LE, GI) do { _Pragma("unroll") for (int kk = 0; kk < 8; ++kk) R[kk] = *(const u32x4*)(vcol + (size_t)LE[RPI * (8 * (GI) + kk) + gR] * 1024); } while (0)
#define VG_GROUP(R, LC, GI) do { _Pragma("unroll") for (int kk = 0; kk < 8; ++kk) { const float cj = LC[RPI * (8 * (GI) + kk) + gR];                       \
            const unsigned w_[4] = {R[kk].x, R[kk].y, R[kk].z, R[kk].w};                                                                       \
            _Pragma("unroll") for (int c = 0; c < 4; ++c) { const f32x2_t lo = __builtin_amdgcn_cvt_pk_f32_fp8((int)w_[c], false), hi = __builtin_amdgcn_cvt_pk_f32_fp8((int)w_[c], true); \
                acc[4 * c] = fmaf(cj, lo.x, acc[4 * c]); acc[4 * c + 1] = fmaf(cj, lo.y, acc[4 * c + 1]); acc[4 * c + 2] = fmaf(cj, hi.x, acc[4 * c + 2]); acc[4 * c + 3] = fmaf(cj, hi.y, acc[4 * c + 3]); } } } while (0)
            u32x4 RA[8], RB[8];
            int* lecur = (int*)(lds + 1024 + wv * 2048); int* lenxt = lecur + 256;
            VG_FETCH(tbase); VG_LISTS(lecur, ((float*)(lecur + 128))); VG_FETCH(tbase + 1);
            LDS_WAIT(); asm volatile("" ::: "memory");
            VG_ROWS(RA, lecur, 0);
#pragma unroll 1
            for (int tt = 0; tt < 8; ++tt) {
                const int t = tbase + tt;
                float* lccur = (float*)(lecur + 128); float* lcnxt = (float*)(lenxt + 128);
                float acc[16];
#pragma unroll
                for (int q = 0; q < 16; ++q) acc[q] = 0.f;
                if (tt + 1 < 8) { VG_LISTS(lenxt, lcnxt); if (tt + 2 < 8) VG_FETCH(t + 2); }
#pragma unroll 1
                for (int gi = 0; gi < G; gi += 2) {
                    VG_ROWS(RB, lecur, gi + 1);
                    VG_GROUP(RA, lccur, gi);
                    if (gi + 2 < G) VG_ROWS(RA, lecur, gi + 2);
                    else if (tt + 1 < 8) { LDS_WAIT(); asm volatile("" ::: "memory"); VG_ROWS(RA, lenxt, 0); }
                    VG_GROUP(RB, lccur, gi + 1);
                }
#pragma unroll
                for (int q = 0; q < 16; ++q) { if (LPR <= 8) acc[q] += dpp_f<0x128>(acc[q]); if (LPR <= 16) acc[q] += __shfl_xor(acc[q], 16); if (LPR <= 32) acc[q] += __shfl_xor(acc[q], 32); }
                if (gR == 0) { const int col = SLB * sl + 16 * iC; const float* g2 = MOD + (size_t)(t >> 11) * 6144 + 5120 + col; float* orow = p.out + (size_t)t * 1024 + col;
#pragma unroll
                    for (int q = 0; q < 4; ++q) { const f32x4 xv = *(const f32x4*)(orow + 4 * q), hv = *(const f32x4*)(g2 + 4 * q);
                        f32x4 r; r.x = acc[4 * q]; r.y = acc[4 * q + 1]; r.z = acc[4 * q + 2]; r.w = acc[4 * q + 3]; *(f32x4*)(orow + 4 * q) = xv + hv * r; } }
                { int* tmp_ = lecur; lecur = lenxt; lenxt = tmp_; }
            }
#undef VG_FETCH
#undef VG_LISTS
#undef VG_ROWS
#undef VG_GROUP
            LDS_WAIT(); asm volatile("" ::: "memory");
        }
    }
}
#ifndef SORT_BITS
#define SORT_BITS 3
#endif
#ifndef PEER_SORT
#define PEER_SORT 1
#endif
template <bool DEEP> __device__ __forceinline__ void ph_peer_u8p(const Params& p, unsigned char* lds_w, int tb, int te, int gw, int ngw, int lane_) {
    int lane = lane_; asm volatile("" : "+v"(lane));
    const bf16* H = (const bf16*)(p.ws + WS_H); const unsigned char* U8 = (const unsigned char*)(p.ws + WS_U16); const unsigned char* V8 = (const unsigned char*)(p.ws + WS_V16);
    const int* EXPI = (const int*)(p.ws + WS_EXP); const float* GATE = (const float*)(p.ws + WS_GATE); const float* MOD = (const float*)(p.ws + WS_MOD);
    int* e_lds = (int*)lds_w; float* a_lds = (float*)(lds_w + 512); float* g_lds = (float*)(lds_w + 1024); (void)g_lds;
    const int g = lane >> 4, i = lane & 15;
    if (DEEP) __builtin_amdgcn_s_setprio(3);
#pragma unroll 1
    for (int t = tb + gw, k_ = 0; t < te; t += ngw, ++k_) {
        int e0 = EXPI[(size_t)t * 128 + lane], e1 = EXPI[(size_t)t * 128 + 64 + lane];
        float g0 = GATE[(size_t)t * 128 + lane], g1 = GATE[(size_t)t * 128 + 64 + lane];
#if PEER_SORT
        {
            const int flip_ = (k_ & 1) ? ((1 << SORT_BITS) - 1) : 0;
            const int d0 = (e0 >> (14 - SORT_BITS)) ^ flip_, d1 = (e1 >> (14 - SORT_BITS)) ^ flip_; int pos0 = 0, pos1 = 0, run = 0;
#pragma unroll
            for (int d = 0; d < (1 << SORT_BITS); ++d) {
                const unsigned long long m0 = __ballot(d0 == d), m1 = __ballot(d1 == d);
                const int c0 = __popcll(m0), c1 = __popcll(m1);
                const int r0 = (int)__builtin_amdgcn_mbcnt_hi((unsigned)(m0 >> 32), __builtin_amdgcn_mbcnt_lo((unsigned)m0, 0u));
                const int r1 = (int)__builtin_amdgcn_mbcnt_hi((unsigned)(m1 >> 32), __builtin_amdgcn_mbcnt_lo((unsigned)m1, 0u));
                pos0 = (d0 == d) ? run + r0 : pos0; pos1 = (d1 == d) ? run + c0 + r1 : pos1; run += c0 + c1;
            }
            e_lds[pos0] = e0; e_lds[pos1] = e1; g_lds[pos0] = g0; g_lds[pos1] = g1;
            LDS_WAIT(); asm volatile("" ::: "memory");
            e0 = e_lds[lane]; e1 = e_lds[64 + lane]; g0 = g_lds[lane]; g1 = g_lds[64 + lane];
            int* EW = (int*)(p.ws + WS_EXP) + (size_t)t * 128; EW[lane] = e0; EW[64 + lane] = e1;
        }
#else
        e_lds[lane] = e0; e_lds[64 + lane] = e1;
#endif
        float xf[64];
        { const u32x4* xrow = (const u32x4*)(H + (size_t)t * 1024) + 2 * i;
#pragma unroll
          for (int q = 0; q < 4; ++q) { const u32x4 a = xrow[32 * q], b = xrow[32 * q + 1];
              xf[16 * q] = bflo(a.x); xf[16 * q + 1] = bfhi(a.x); xf[16 * q + 2] = bflo(a.y); xf[16 * q + 3] = bfhi(a.y); xf[16 * q + 4] = bflo(a.z); xf[16 * q + 5] = bfhi(a.z); xf[16 * q + 6] = bflo(a.w); xf[16 * q + 7] = bfhi(a.w);
              xf[16 * q + 8] = bflo(b.x); xf[16 * q + 9] = bfhi(b.x); xf[16 * q + 10] = bflo(b.y); xf[16 * q + 11] = bfhi(b.y); xf[16 * q + 12] = bflo(b.z); xf[16 * q + 13] = bfhi(b.z); xf[16 * q + 14] = bflo(b.w); xf[16 * q + 15] = bfhi(b.w); } }
        LDS_WAIT(); asm volatile("" ::: "memory");
#define P8T_ULOAD(R, S) do { const u32x4* r_ = (const u32x4*)(U8 + (size_t)e_lds[4 * (S) + g] * 1024) + i; _Pragma("unroll") for (int q = 0; q < 4; ++q) R[q] = r_[16 * q]; } while (0)
#define P8T_UDOT(R, S) do { float a0 = 0.f, a1 = 0.f, a2 = 0.f, a3 = 0.f;                                                                               \
        _Pragma("unroll") for (int q = 0; q < 4; ++q) { const unsigned w_[4] = {R[q].x, R[q].y, R[q].z, R[q].w};                                           \
            _Pragma("unroll") for (int c = 0; c < 4; ++c) { const f32x2_t lo = __builtin_amdgcn_cvt_pk_f32_fp8((int)w_[c], false), hi = __builtin_amdgcn_cvt_pk_f32_fp8((int)w_[c], true); \
                a0 = fmaf(lo.x, xf[16 * q + 4 * c], a0); a1 = fmaf(lo.y, xf[16 * q + 4 * c + 1], a1); a2 = fmaf(hi.x, xf[16 * q + 4 * c + 2], a2); a3 = fmaf(hi.y, xf[16 * q + 4 * c + 3], a3); } } \
        const float a_ = row16_sum((a0 + a1) + (a2 + a3)) * (1.0f / U8_SCALE); if (i == 0) a_lds[4 * (S) + g] = a_; } while (0)
        if (!DEEP) { u32x4 RA[4], RB[4], RC[4];
          P8T_ULOAD(RA, 0); P8T_ULOAD(RB, 1);
#pragma unroll 1
          for (int s = 0; s < 30; s += 3) {
              P8T_ULOAD(RC, s + 2); P8T_UDOT(RA, s);
              P8T_ULOAD(RA, s + 3); P8T_UDOT(RB, s + 1);
              P8T_ULOAD(RB, s + 4); P8T_UDOT(RC, s + 2);
          }
          P8T_UDOT(RA, 30); P8T_UDOT(RB, 31); }
        else { u32x4 R0[4], R1[4], R2[4], R3[4], R4[4], R5[4];
          P8T_ULOAD(R0, 0); P8T_ULOAD(R1, 1); P8T_ULOAD(R2, 2); P8T_ULOAD(R3, 3); P8T_ULOAD(R4, 4);
#pragma unroll 1
          for (int s = 0; s < 24; s += 6) {
              P8T_ULOAD(R5, s + 5); P8T_UDOT(R0, s);
              P8T_ULOAD(R0, s + 6); P8T_UDOT(R1, s + 1);
              P8T_ULOAD(R1, s + 7); P8T_UDOT(R2, s + 2);
              P8T_ULOAD(R2, s + 8); P8T_UDOT(R3, s + 3);
              P8T_ULOAD(R3, s + 9); P8T_UDOT(R4, s + 4);
              P8T_ULOAD(R4, s + 10); P8T_UDOT(R5, s + 5);
          }
          P8T_ULOAD(R5, 29); P8T_UDOT(R0, 24);
          P8T_ULOAD(R0, 30); P8T_UDOT(R1, 25);
          P8T_ULOAD(R1, 31); P8T_UDOT(R2, 26);
          P8T_UDOT(R3, 27); P8T_UDOT(R4, 28); P8T_UDOT(R5, 29); P8T_UDOT(R0, 30); P8T_UDOT(R1, 31); }
#undef P8T_ULOAD
#undef P8T_UDOT
        LDS_WAIT(); asm volatile("" ::: "memory");
        const float c0 = gelu_erf(a_lds[lane]) * g0, c1 = gelu_erf(a_lds[64 + lane]) * g1;
        float* CB = (float*)(p.ws + WS_CBUF) + (size_t)t * 128; CB[lane] = c0; CB[64 + lane] = c1;
    }
    if (DEEP) __builtin_amdgcn_s_setprio(0);
}
__device__ __forceinline__ void ph_peer_u8h(const Params& p, unsigned char* lds) {
    const bf16* H = (const bf16*)(p.ws + WS_H); const unsigned char* U8 = (const unsigned char*)(p.ws + WS_U16);
    const int* EXPI = (const int*)(p.ws + WS_EXP);
    unsigned* ctl = (unsigned*)(p.ws + WS_CTL);
    int tid = threadIdx.x; asm volatile("" : "+v"(tid));
    const int lane = tid & 63, wv = __builtin_amdgcn_readfirstlane(tid >> 6), hw = lane >> 5, i5 = lane & 31;
    volatile LAS unsigned* slot = (volatile LAS unsigned*)(LAS unsigned char*)lds;
    float* a_lds = (float*)(lds + 1024 + wv * 2048 + 1024);
    const unsigned xcc = peer_xcc();
#pragma unroll 1
    for (int k = 0; k < 2; ++k) {
        const int sl = (int)(((xcc >> 2) + (unsigned)k) & 1u);
        float* AB = (float*)(p.ws + (sl ? WS_ABUF1 : WS_CBUF));
        const unsigned char* ucol = U8 + 512 * sl + 16 * i5;
#pragma unroll 1
        for (;;) {
            if (tid == 0) *slot = __hip_atomic_fetch_add(ctl + CW_P8_U + 64 * sl, 1u, __ATOMIC_RELAXED, __HIP_MEMORY_SCOPE_AGENT);
            __syncthreads();
            const unsigned unit = *slot;
            __syncthreads();
            if (unit >= (unsigned)P8_UNITS) break;
            const int tbase = (int)unit * 64 + wv * 8;
            int ne0, ne1; u32x4 nx0, nx1;
#define UH_FETCH(T) do { const size_t tn_ = (size_t)(T); ne0 = EXPI[tn_ * 128 + lane]; ne1 = EXPI[tn_ * 128 + 64 + lane];                          \
        const u32x4* xr_ = (const u32x4*)(H + tn_ * 1024 + 512 * sl) + 2 * i5; nx0 = xr_[0]; nx1 = xr_[1]; } while (0)
#define UH_LISTS(LE) do { LE[lane] = ne0; LE[64 + lane] = ne1; } while (0)
#define UH_ROWS(R, LE, GI) do { _Pragma("unroll") for (int kk = 0; kk < 8; ++kk) R[kk] = *(const u32x4*)(ucol + (size_t)LE[2 * (8 * (GI) + kk) + hw] * 1024); } while (0)
#define UH_GROUP(R, GI) do { _Pragma("unroll") for (int kk = 0; kk < 8; ++kk) { float a0 = 0.f, a1 = 0.f, a2 = 0.f, a3 = 0.f;                         \
            const unsigned w_[4] = {R[kk].x, R[kk].y, R[kk].z, R[kk].w};                                                                       \
            _Pragma("unroll") for (int c = 0; c < 4; ++c) { const f32x2_t lo = __builtin_amdgcn_cvt_pk_f32_fp8((int)w_[c], false), hi = __builtin_amdgcn_cvt_pk_f32_fp8((int)w_[c], true); \
                a0 = fmaf(lo.x, xf[4 * c], a0); a1 = fmaf(lo.y, xf[4 * c + 1], a1); a2 = fmaf(hi.x, xf[4 * c + 2], a2); a3 = fmaf(hi.y, xf[4 * c + 3], a3); }                        \
            float s_ = row16_sum((a0 + a1) + (a2 + a3)); s_ += __shfl_xor(s_, 16);                                                              \
            if (i5 == 0) a_lds[2 * (8 * (GI) + kk) + hw] = s_ * (1.0f / U8_SCALE); } } while (0)
            u32x4 RA[8], RB[8];
            int* lecur = (int*)(lds + 1024 + wv * 2048); int* lenxt = lecur + 128;
            UH_FETCH(tbase); UH_LISTS(lecur);
            float xf[16];
#define UH_XF() do { xf[0] = bflo(nx0.x); xf[1] = bfhi(nx0.x); xf[2] = bflo(nx0.y); xf[3] = bfhi(nx0.y); xf[4] = bflo(nx0.z); xf[5] = bfhi(nx0.z); xf[6] = bflo(nx0.w); xf[7] = bfhi(nx0.w); \
        xf[8] = bflo(nx1.x); xf[9] = bfhi(nx1.x); xf[10] = bflo(nx1.y); xf[11] = bfhi(nx1.y); xf[12] = bflo(nx1.z); xf[13] = bfhi(nx1.z); xf[14] = bflo(nx1.w); xf[15] = bfhi(nx1.w); } while (0)
            UH_XF();
            UH_FETCH(tbase + 1);
            LDS_WAIT(); asm volatile("" ::: "memory");
            UH_ROWS(RA, lecur, 0);
#pragma unroll 1
            for (int tt = 0; tt < 8; ++tt) {
                const int t = tbase + tt;
                float xn[16];
                if (tt + 1 < 8) { UH_LISTS(lenxt);
#pragma unroll
                    for (int q = 0; q < 16; ++q) xn[q] = 0.f;
                    xn[0] = bflo(nx0.x); xn[1] = bfhi(nx0.x); xn[2] = bflo(nx0.y); xn[3] = bfhi(nx0.y); xn[4] = bflo(nx0.z); xn[5] = bfhi(nx0.z); xn[6] = bflo(nx0.w); xn[7] = bfhi(nx0.w);
                    xn[8] = bflo(nx1.x); xn[9] = bfhi(nx1.x); xn[10] = bflo(nx1.y); xn[11] = bfhi(nx1.y); xn[12] = bflo(nx1.z); xn[13] = bfhi(nx1.z); xn[14] = bflo(nx1.w); xn[15] = bfhi(nx1.w);
                    if (tt + 2 < 8) UH_FETCH(t + 2); }
#pragma unroll 1
                for (int gi = 0; gi < 8; gi += 2) {
                    UH_ROWS(RB, lecur, gi + 1);
                    UH_GROUP(RA, gi);
                    if (gi + 2 < 8) UH_ROWS(RA, lecur, gi + 2);
                    else if (tt + 1 < 8) { LDS_WAIT(); asm volatile("" ::: "memory"); UH_ROWS(RA, lenxt, 0); }
                    UH_GROUP(RB, gi + 1);
                }
                LDS_WAIT(); asm volatile("" ::: "memory");
                { float* ab = AB + (size_t)t * 128; ab[lane] = a_lds[lane]; ab[64 + lane] = a_lds[64 + lane]; }
                LDS_WAIT(); asm volatile("" ::: "memory");
                if (tt + 1 < 8) {
#pragma unroll
                    for (int q = 0; q < 16; ++q) xf[q] = xn[q]; }
                { int* tmp_ = lecur; lecur = lenxt; lenxt = tmp_; }
            }
#undef UH_FETCH
#undef UH_LISTS
#undef UH_ROWS
#undef UH_GROUP
#undef UH_XF
        }
    }
}
#define XB_TMO      128
#define XB_XCNT(j)  (256  + 64 * (j))
#define XB_XSUB(j)  (1280 + 64 * (j))
#define XB_XGEN(j)  (2304 + 64 * (j))
#define XB_TOP      3328
#define XB_TOPGEN   3392
#define XCD_BAR_WORDS 3456
#define XB_SPIN_CAP (1u << 18)

__device__ __forceinline__ unsigned xb_ld(unsigned* p)              { return __hip_atomic_load(p, __ATOMIC_RELAXED, __HIP_MEMORY_SCOPE_AGENT); }
__device__ __forceinline__ unsigned xb_add(unsigned* p, unsigned v) { return __hip_atomic_fetch_add(p, v, __ATOMIC_RELAXED, __HIP_MEMORY_SCOPE_AGENT); }
__device__ __forceinline__ unsigned xb_xcc_id() { return (unsigned)__builtin_amdgcn_s_getreg((3 << 11) | 20) & 0xFu; }
#define XB_SPIN(cond, bar) do { unsigned _sp = 0; while (cond) { __builtin_amdgcn_s_sleep(1); \
    if ((++_sp & 255u) == 0u) { if (xb_ld(&(bar)[XB_TMO])) break; if (_sp > XB_SPIN_CAP) { atomicAdd(&(bar)[XB_TMO], 1u); break; } } } } while (0)

struct XcdBarrier {
    unsigned* bar; unsigned x;
    volatile LAS unsigned* st;
};

__device__ __forceinline__ XcdBarrier xcd_barrier_post(unsigned* bar, volatile LAS unsigned* st) {
    XcdBarrier b; b.bar = bar; b.x = xb_xcc_id(); b.st = st;
    if (threadIdx.x == 0) (void)xb_add(&bar[XB_XCNT(b.x)], 1u);
    return b;
}
__device__ __forceinline__ void xcd_barrier_complete(unsigned* bar, unsigned x, unsigned& nloc, unsigned& nx) {
    const unsigned G = gridDim.x * gridDim.y * gridDim.z;
    unsigned sum, cnt, mine, sp = 0u;
    for (;;) {
        sum = 0u; cnt = 0u; mine = 0u;
#pragma unroll
        for (unsigned j = 0; j < 16; ++j) { const unsigned c = xb_ld(&bar[XB_XCNT(j)]); sum += c; cnt += (c > 0u) ? 1u : 0u; mine = (j == x) ? c : mine; }
        if (sum == G) break;
        __builtin_amdgcn_s_sleep(1);
        if ((++sp & 255u) == 0u) { if (xb_ld(&bar[XB_TMO])) break; if (sp > XB_SPIN_CAP) { atomicAdd(&bar[XB_TMO], 1u); break; } }
    }
    nloc = mine > 0u ? mine : 1u; nx = cnt > 0u ? cnt : 1u;
}

__device__ __forceinline__ void xcd_barrier(const XcdBarrier& b) {
    asm volatile("s_waitcnt vmcnt(0)" ::: "memory");
    __syncthreads();
    if (threadIdx.x == 0) {
        unsigned* bar = b.bar;
        __builtin_amdgcn_s_waitcnt(0);
        unsigned nloc = b.st[0], nx = b.st[1];
        if (nloc == 0u) { xcd_barrier_complete(bar, b.x, nloc, nx); b.st[0] = nloc; b.st[1] = nx; }
        const unsigned old = xb_add(&bar[XB_XSUB(b.x)], 1u);
        const unsigned gen = old / nloc;
        if (old + 1u == (gen + 1u) * nloc) {
            __builtin_amdgcn_fence(__ATOMIC_RELEASE, "agent");
            asm volatile("s_waitcnt vmcnt(0)" ::: "memory");
            const unsigned og = xb_add(&bar[XB_TOP], 1u);
            const unsigned tg = og / nx;
            if (og + 1u == (tg + 1u) * nx) xb_add(&bar[XB_TOPGEN], 1u);
            else XB_SPIN(xb_ld(&bar[XB_TOPGEN]) == tg, bar);
            __builtin_amdgcn_fence(__ATOMIC_ACQUIRE, "agent");
            xb_add(&bar[XB_XGEN(b.x)], 1u);
            asm volatile("s_waitcnt vmcnt(0)" ::: "memory");
        } else {
            XB_SPIN(xb_ld(&bar[XB_XGEN(b.x)]) == gen, bar);
            __builtin_amdgcn_fence(__ATOMIC_ACQUIRE, "agent");
            asm volatile("s_waitcnt vmcnt(0)" ::: "memory");
        }
    }
    __syncthreads();
}

#ifndef V8_LPR
#define V8_LPR 32
#endif
constexpr int LDS_BYTES = 147456;
extern __shared__ __attribute__((aligned(16))) unsigned char dyn_lds[];

__global__ void __launch_bounds__(NT, 2) mega_fwd(Params p) {
    cg::grid_group grid = cg::this_grid();
    const int vb = blockIdx.x, nvb = gridDim.x, ngw = nvb * NWV;
    volatile LAS unsigned* xst = (volatile LAS unsigned*)((LAS unsigned char*)dyn_lds + (LDS_BYTES - 16));
    if (threadIdx.x < 4) xst[threadIdx.x] = 0u;
    __syncthreads();
    const XcdBarrier xbar = xcd_barrier_post((unsigned*)(p.ws + WS_CTL), xst);
#define TID_LAUNDER int tid_ = threadIdx.x; asm volatile("" : "+v"(tid_)); const int lane = tid_ & 63, wv = tid_ >> 6, gw = vb * NWV + wv; (void)lane; (void)gw;
    grid.sync();
    ph_mod(p, (float*)dyn_lds, vb, nvb);
    { TID_LAUNDER ph_prep_weights<0>(p, (LAS float*)dyn_lds + wv * (64 * 33), gw, ngw, lane); }
    xcd_barrier(xbar);
    { TID_LAUNDER ph_hrows(p, p.x, p.norm1_g, 0, 1024, gw, ngw, lane); ph_prep_weights<1>(p, (LAS float*)dyn_lds + wv * (64 * 33), gw, ngw, lane); }
    xcd_barrier(xbar);
    {   pg8::Gemm g{(const bf16*)(p.ws + WS_H), (const bf16*)(p.ws + WS_WIN), T, NP, 1024}; pg8::StaticOrder S; S.init(T, NP, nvb, vb);
        EpiNormBf16 E{(bf16*)(p.ws + WS_PROJ), p.a_qk_gain, p.b_q_gain, p.b_kv_gain, (LAS float*)((LAS unsigned char*)dyn_lds + 131072), (bf16*)(p.ws + WS_KVC)};
        pg8::gemm_phase<EpiNormBf16, pg8::StaticOrder, true, true>((LAS unsigned char*)dyn_lds, g, S, E); }
    xcd_barrier(xbar);
    { TID_LAUNDER ph_q3bias(p, gw, lane); }
    ph_attnA(p, dyn_lds, vb, nvb);
    __syncthreads();
    ph_dsa(p, dyn_lds, vb, nvb);
    xcd_barrier(xbar);
    {   pg8::Gemm g{(const bf16*)(p.ws + WS_MIX), (const bf16*)(p.ws + WS_WO2), T, 1024, MIXW}; pg8::StaticOrder S; S.init(T, 1024, nvb, vb);
        EpiResGateA2 E{p.x, p.out, (const float*)(p.ws + WS_MOD), p.norm2_g, (bf16*)(p.ws + WS_H), (float*)(p.ws + WS_SSQ)};
        pg8::gemm_phase<EpiResGateA2, pg8::StaticOrder, true, true>((LAS unsigned char*)dyn_lds, g, S, E); }
    xcd_barrier(xbar);
    {   pg8::Gemm g{(const bf16*)(p.ws + WS_H), (const bf16*)(p.ws + WS_WQ), T, 1024, 1024}; pg8::StaticOrder S; S.init(T, 1024, nvb, vb);
        EpiQ3 E{(const float*)(p.ws + WS_SSQ), (const float*)(p.ws + WS_QBIAS), (bf16*)(p.ws + WS_Q3)};
        pg8::gemm_phase<EpiQ3, pg8::StaticOrder, true, true>((LAS unsigned char*)dyn_lds, g, S, E); }
    xcd_barrier(xbar);
    ph_route_subk(p, dyn_lds);
    { TID_LAUNDER ph_route(p, dyn_lds, 0, 2048, gw, ngw); }
    xcd_barrier(xbar);
#pragma unroll 1
    for (int k = 1; k < 4; ++k) {
        { TID_LAUNDER
          if (wv < 4) ph_route(p, dyn_lds, k * 2048, (k + 1) * 2048, vb * 4 + wv, nvb * 4);
          else ph_peer_u8p<true>(p, dyn_lds + 131072 + wv * 2048, (k - 1) * 8192, k * 8192, vb * 4 + (wv - 4), nvb * 4, lane); }
        xcd_barrier(xbar);
    }
    { TID_LAUNDER ph_peer_u8p<false>(p, dyn_lds + 131072 + wv * 2048, 3 * 8192, 4 * 8192, gw, ngw, lane); }
    xcd_barrier(xbar);
    ph_peer_v8g<V8_LPR>(p, dyn_lds);

}

extern "C" void kernel_launch(void* const* d_in, const int* in_sizes, int n_in, void* d_out, int out_size, void* d_ws, size_t ws_size, hipStream_t stream) {
    static int grid_blocks = 0;
    if (grid_blocks == 0) {
        if (n_in != 18 || in_sizes[0] != T * DM || out_size != T * DM || ws_size < WS_END) { fprintf(stderr, "kernel_launch: unexpected shapes n_in %d in0 %d out %d ws %zu\n", n_in, n_in > 0 ? in_sizes[0] : -1, out_size, ws_size); grid_blocks = -1; return; }
        int dev = 0, cus = 0, per_cu = 0;
        (void)hipGetDevice(&dev);
        (void)hipDeviceGetAttribute(&cus, hipDeviceAttributeMultiprocessorCount, dev);
        (void)hipFuncSetAttribute((const void*)mega_fwd, hipFuncAttributeMaxDynamicSharedMemorySize, LDS_BYTES);
        (void)hipOccupancyMaxActiveBlocksPerMultiprocessor(&per_cu, (const void*)mega_fwd, NT, LDS_BYTES);
        if (per_cu < 1 || cus < 1) { fprintf(stderr, "kernel_launch: occupancy query gave %d blocks/CU on %d CUs\n", per_cu, cus); grid_blocks = -1; return; }
        grid_blocks = cus;
    }
    if (grid_blocks < 0) return;
    Params p{};
    const float** pp = (const float**)&p;
    for (int i = 0; i < 18; ++i) pp[i] = (const float*)d_in[i];
    p.out = (float*)d_out; p.ws = (unsigned char*)d_ws;
    if (hipMemsetAsync((char*)d_ws + WS_CTL, 0, CTL_BYTES, stream) != hipSuccess) { fprintf(stderr, "kernel_launch: memset failed\n"); return; }
    void* args[] = {&p};
    const hipError_t e = hipLaunchCooperativeKernel((const void*)mega_fwd, dim3(grid_blocks), dim3(NT), args, LDS_BYTES, stream);
    if (e != hipSuccess) fprintf(stderr, "kernel_launch: cooperative launch failed: %s (grid %d)\n", hipGetErrorString(e), grid_blocks);
}
```

```cpp
#include <hip/hip_runtime.h>
#include <hip/hip_cooperative_groups.h>
#include <cstdio>
#include <cstdint>
#include <cmath>
namespace pg8 {
#define PG8_LAS __attribute__((address_space(3)))
typedef unsigned short bf16_t;
typedef short bf16x8 __attribute__((ext_vector_type(8)));
typedef float f32x4 __attribute__((ext_vector_type(4)));
typedef unsigned u32x4 __attribute__((ext_vector_type(4)));
constexpr int BM = 256, BK = 64, HALF = 128, HTB = HALF * BK * 2  , STAGE_BYTES = 8 * HTB, NXCD = 8, WGM = 8;

__host__ __device__ __forceinline__ int lds_byte(int r, int c) { const int st = (r >> 4) * 2 + (c >> 5), rr = r & 15, cc = c & 31, ob = rr * 64 + cc * 2; return st * 1024 + (ob ^ (((ob >> 9) & 1) << 5)); }
__host__ __device__ __forceinline__ void stage_rc(int b, int& R, int& C) { const int st = b / 1024, sb = b % 1024, swz = sb ^ (((sb >> 9) & 1) << 5); R = (st >> 1) * 16 + swz / 64; C = (st & 1) * 32 + (swz % 64) / 2; }
__host__ __device__ __forceinline__ int perm32(int rho) { const int n = rho >> 4, i = rho & 15; return 8 * (i >> 2) + 4 * n + (i & 3); }

struct Unit { int pm, pn; };
struct Gemm { const bf16_t* A; const bf16_t* Bt; int M, N, K; };

struct StaticOrder {
    int nM, nN, nwg, G, c;
    __host__ __device__ void init(int M, int N, int G_, int c_) { nM = M / BM; nN = N / BM; nwg = nM * nN; G = G_; c = c_; }
    __host__ __device__ bool next(int i, Unit& u) const {
        const long L = (long)i * G + c; if (L >= nwg) return false;
        int wgid = (int)L; { const int q = nwg / NXCD, r = nwg % NXCD, xcd = wgid % NXCD, off = wgid / NXCD; wgid = (xcd < r ? xcd * (q + 1) : r * (q + 1) + (xcd - r) * q) + off; }
        const int nig = WGM * nN, gid = wgid / nig, fm = gid * WGM, gsz = (nM - fm) < WGM ? (nM - fm) : WGM;
        u.pm = fm + ((wgid % nig) % gsz); u.pn = (wgid % nig) / gsz; return true;
    }
    __device__ __forceinline__ void a_ready(const Unit&) const {}
    __device__ __forceinline__ void done(const Unit&) const {}
};

__device__ __forceinline__ unsigned cvt_pk_bf16(float lo, float hi) { unsigned r; asm volatile("v_cvt_pk_bf16_f32 %0, %1, %2" : "=v"(r) : "v"(lo), "v"(hi)); return r; }
typedef float f32x2 __attribute__((ext_vector_type(2)));
__device__ __forceinline__ f32x2 gelu_pk(f32x2 v) {
    const f32x2 av = __builtin_elementwise_abs(v), d = av * 0.2316418882f + 1.0f;
    f32x2 t; t.x = __builtin_amdgcn_rcpf(d.x); t.y = __builtin_amdgcn_rcpf(d.y);
    f32x2 q = t * 0.5307027145f + (-0.7265760135f); q = q * t + 0.7107068705f; q = q * t + (-0.142248368f); q = q * t + 0.127414796f; q = q * t;
    const f32x2 s = (v * v) * (-0.72134752044f);
    f32x2 e; e.x = __builtin_amdgcn_exp2f(s.x); e.y = __builtin_amdgcn_exp2f(s.y);
    const f32x2 m = v * (q * e), r = v - m;
    f32x2 o; o.x = v.x < 0.f ? m.x : r.x; o.y = v.y < 0.f ? m.y : r.y; return o;
}

template <int ACT  > struct EpiBf16 {
    static constexpr bool PERM = true, AFTER_DRAIN = false; static_assert(ACT == 0 || ACT == 1, "EpiBf16: ACT is 0 (none) or 1 (gelu_pk)");
    bf16_t* O; int ldc; const float* bias; int split_cols; size_t split_stride; float scale0;
    __device__ __forceinline__ void operator()(const f32x4 (&acc)[2][2][4][2], const Unit& u, int wr, int wc, int fr, int fq) const {
        const int row0 = u.pm * BM + wr * 64 + fr; int colt = u.pn * BM; bf16_t* base = O;
        float sc = 1.f; if (split_cols) { const int t = colt / split_cols; base += (size_t)t * split_stride; colt -= t * split_cols; if (t == 0) sc = scale0; }
        const int col0 = colt + wc * 32 + 8 * fq, bcol0 = u.pn * BM + wc * 32 + 8 * fq;
        f32x4 bv[2][2];
#pragma unroll
        for (int bj = 0; bj < 2; ++bj)
#pragma unroll
            for (int n = 0; n < 2; ++n) bv[bj][n] = bias ? *(const f32x4*)(bias + bcol0 + bj * HALF + 4 * n) : (f32x4){0.f, 0.f, 0.f, 0.f};
#pragma unroll
        for (int ai = 0; ai < 2; ++ai)
#pragma unroll
            for (int m = 0; m < 4; ++m) { bf16_t* rowp = base + (size_t)(row0 + ai * HALF + m * 16) * ldc + col0;
#pragma unroll
                for (int bj = 0; bj < 2; ++bj) { f32x4 v0 = acc[ai][bj][m][0] + bv[bj][0], v1 = acc[ai][bj][m][1] + bv[bj][1];
                    if (ACT == 1) { f32x2 a = gelu_pk((f32x2){v0[0], v0[1]}), b = gelu_pk((f32x2){v0[2], v0[3]}), c = gelu_pk((f32x2){v1[0], v1[1]}), d = gelu_pk((f32x2){v1[2], v1[3]});
                        v0 = (f32x4){a.x, a.y, b.x, b.y}; v1 = (f32x4){c.x, c.y, d.x, d.y}; }
                    v0 = v0 * sc; v1 = v1 * sc; u32x4 w; w.x = cvt_pk_bf16(v0[0], v0[1]); w.y = cvt_pk_bf16(v0[2], v0[3]); w.z = cvt_pk_bf16(v1[0], v1[1]); w.w = cvt_pk_bf16(v1[2], v1[3]);
                    *(u32x4*)(rowp + bj * HALF) = w; } }
    }
};

template <class Epi, class Sched, bool ALIGN_EPI = false, bool SP2 = false>
__device__ __forceinline__ void gemm_phase(PG8_LAS unsigned char* lds, const Gemm g, const Sched& S, const Epi& E) {
    int tid = threadIdx.x; asm volatile("" : "+v"(tid)); const int wid = __builtin_amdgcn_readfirstlane(tid >> 6), lane = tid & 63, wr = wid >> 2, wc = wid & 3, fr = lane & 15, fq = lane >> 4;
    const int K = g.K, nt = K / BK;
    unsigned voffA[2], voffB[2];
#pragma unroll
    for (int i = 0; i < 2; ++i) { int R, C; stage_rc(tid * 16 + i * 8192, R, C); const int Rb = Epi::PERM ? ((R & ~31) + perm32(R & 31)) : R;
        voffA[i] = (unsigned)(R * K + C) * 2u; voffB[i] = (unsigned)(Rb * K + C) * 2u; }
    const size_t kstep = (size_t)(BK * 2);
    const size_t hstep = (size_t)HALF * K * 2;
    const size_t tstep = 2 * hstep;
    const unsigned ldsw = (unsigned)wid * 1024u;
    const int aoff = lds_byte(wr * 64 + fr, fq * 8), boff = lds_byte(wc * 32 + fr, fq * 8);
#define PG8_SA(b, h) (((b) * 2 + (h)) * HTB)
#define PG8_SB(b, h) ((4 + (b) * 2 + (h)) * HTB)
#define PG8_STAGE(bufoff, gbase, voff) do { _Pragma("unroll") for (int _i = 0; _i < 2; ++_i) \
        __builtin_amdgcn_global_load_lds((const unsigned*)((const char*)(gbase) + (voff)[_i]), (PG8_LAS unsigned*)(lds + (bufoff) + ldsw + _i * 8192), 16, 0, 0); } while (0)
#define PG8_LDA(dst, b, h) do { _Pragma("unroll") for (int m = 0; m < 4; ++m) _Pragma("unroll") for (int k = 0; k < 2; ++k) dst[m][k] = *(const PG8_LAS bf16x8*)(lds + PG8_SA(b, h) + aoff + m * 2048 + k * 1024); } while (0)
#define PG8_LDB(dst, b, h) do { _Pragma("unroll") for (int n = 0; n < 2; ++n) _Pragma("unroll") for (int k = 0; k < 2; ++k) dst[n][k] = *(const PG8_LAS bf16x8*)(lds + PG8_SB(b, h) + boff + n * 2048 + k * 1024); } while (0)
#define PG8_MMA(ai, bj, At, Bt) do { __builtin_amdgcn_s_setprio(1); _Pragma("unroll") for (int m = 0; m < 4; ++m) _Pragma("unroll") for (int n = 0; n < 2; ++n) _Pragma("unroll") for (int k = 0; k < 2; ++k) \
        acc[ai][bj][m][n] = __builtin_amdgcn_mfma_f32_16x16x32_bf16(Bt[n][k], At[m][k], acc[ai][bj][m][n], 0, 0, 0); __builtin_amdgcn_s_setprio(0); } while (0)
#define PG8_WAIT_V(n) asm volatile("s_waitcnt vmcnt(" #n ")" ::: "memory")
#define PG8_WAIT_L(n) asm volatile("s_waitcnt lgkmcnt(" #n ")" ::: "memory")
#define PG8_BAR __builtin_amdgcn_s_barrier()
#define PG8_SCHED __builtin_amdgcn_sched_barrier(0)
    Unit cur, nxt; int ui = 0;
    if (!S.next(0, cur)) return;
    f32x4 acc[2][2][4][2];
#pragma unroll
    for (int a = 0; a < 2; ++a)
#pragma unroll
        for (int b = 0; b < 2; ++b)
#pragma unroll
            for (int m = 0; m < 4; ++m)
#pragma unroll
                for (int n = 0; n < 2; ++n) acc[a][b][m][n] = (f32x4){0.f, 0.f, 0.f, 0.f};
    bf16x8 At[4][2], B0[2][2], B1[2][2];
    const char* cA = (const char*)g.A + (size_t)cur.pm * tstep; const char* cB = (const char*)g.Bt + (size_t)cur.pn * tstep;
    S.a_ready(cur);
    if constexpr (SP2) {
        PG8_STAGE(PG8_SB(0, 0), cB, voffB); PG8_STAGE(PG8_SB(0, 1), cB + hstep, voffB); PG8_STAGE(PG8_SA(0, 0), cA, voffA); PG8_STAGE(PG8_SA(0, 1), cA + hstep, voffA);
        if (wr == 1) PG8_BAR;
        PG8_WAIT_V(2); PG8_BAR;
        PG8_STAGE(PG8_SB(1, 0), cB + kstep, voffB); PG8_STAGE(PG8_SA(1, 0), cA + kstep, voffA); PG8_STAGE(PG8_SB(1, 1), cB + hstep + kstep, voffB);
        PG8_WAIT_V(6); PG8_BAR;
    } else {
        PG8_STAGE(PG8_SB(0, 0), cB, voffB); PG8_STAGE(PG8_SA(0, 0), cA, voffA); PG8_STAGE(PG8_SB(0, 1), cB + hstep, voffB); PG8_STAGE(PG8_SA(0, 1), cA + hstep, voffA);
        if (wr == 1) PG8_BAR;
        PG8_WAIT_V(4); PG8_BAR;
        PG8_STAGE(PG8_SB(1, 0), cB + kstep, voffB); PG8_STAGE(PG8_SA(1, 0), cA + kstep, voffA); PG8_STAGE(PG8_SB(1, 1), cB + hstep + kstep, voffB);
        PG8_WAIT_V(6); PG8_BAR;
    }
    for (;;) {
        const bool has_next = S.next(ui + 1, nxt);
        const char* nA = has_next ? (const char*)g.A + (size_t)nxt.pm * tstep : cA; const char* nB = has_next ? (const char*)g.Bt + (size_t)nxt.pn * tstep : cB;
        for (int t = 0; t < nt; t += 2) {
            const bool last = (t == nt - 2);
            const char* a1 = cA + (size_t)(t + 1) * kstep;
            const char* a2 = last ? nA : cA + (size_t)(t + 2) * kstep; const char* b2 = last ? nB : cB + (size_t)(t + 2) * kstep;
            const char* a3 = a2 + kstep; const char* b3 = b2 + kstep;
            if (last && has_next) S.a_ready(nxt);
            if constexpr (SP2) {
            PG8_LDB(B0, 0, 0); PG8_LDB(B1, 0, 1); PG8_SCHED; PG8_LDA(At, 0, 0); PG8_STAGE(PG8_SA(1, 1), a1 + hstep, voffA);
            PG8_WAIT_V(8); PG8_WAIT_L(0); PG8_BAR; PG8_MMA(0, 0, At, B0); PG8_MMA(0, 1, At, B1); PG8_BAR; PG8_SCHED;
            PG8_LDA(At, 0, 1); PG8_STAGE(PG8_SB(0, 0), b2, voffB); PG8_STAGE(PG8_SB(0, 1), b2 + hstep, voffB); PG8_STAGE(PG8_SA(0, 0), a2, voffA);
            PG8_WAIT_V(8); PG8_WAIT_L(0); PG8_BAR; PG8_MMA(1, 0, At, B0); PG8_MMA(1, 1, At, B1); PG8_BAR; PG8_SCHED;
            PG8_LDB(B0, 1, 0); PG8_LDB(B1, 1, 1); PG8_SCHED; PG8_LDA(At, 1, 0); PG8_STAGE(PG8_SA(0, 1), a2 + hstep, voffA);
            PG8_WAIT_V(8); PG8_WAIT_L(0); PG8_BAR; PG8_MMA(0, 0, At, B0); PG8_MMA(0, 1, At, B1); PG8_BAR; PG8_SCHED;
            PG8_LDA(At, 1, 1); PG8_STAGE(PG8_SB(1, 0), b3, voffB); PG8_STAGE(PG8_SB(1, 1), b3 + hstep, voffB); PG8_STAGE(PG8_SA(1, 0), a3, voffA);
            PG8_WAIT_V(8); PG8_WAIT_L(0); PG8_BAR; PG8_MMA(1, 0, At, B0); PG8_MMA(1, 1, At, B1); PG8_BAR; PG8_SCHED;
            } else {
            PG8_LDB(B0, 0, 0); PG8_SCHED; PG8_LDA(At, 0, 0); PG8_STAGE(PG8_SA(1, 1), a1 + hstep, voffA);
            PG8_WAIT_L(8); PG8_BAR; PG8_WAIT_L(0); PG8_MMA(0, 0, At, B0); PG8_BAR; PG8_SCHED;
            PG8_LDB(B1, 0, 1); PG8_STAGE(PG8_SB(0, 0), b2, voffB);
            PG8_BAR; PG8_WAIT_L(0); PG8_MMA(0, 1, At, B1); PG8_BAR;
            PG8_LDA(At, 0, 1); PG8_STAGE(PG8_SA(0, 0), a2, voffA);
            PG8_BAR; PG8_WAIT_L(0); PG8_MMA(1, 0, At, B0); PG8_BAR; PG8_SCHED;
            PG8_STAGE(PG8_SB(0, 1), b2 + hstep, voffB);
            PG8_WAIT_V(6); PG8_BAR; PG8_MMA(1, 1, At, B1); PG8_BAR;
            PG8_LDB(B0, 1, 0); PG8_SCHED; PG8_LDA(At, 1, 0); PG8_STAGE(PG8_SA(0, 1), a2 + hstep, voffA);
            PG8_WAIT_L(8); PG8_BAR; PG8_WAIT_L(0); PG8_MMA(0, 0, At, B0); PG8_BAR; PG8_SCHED;
            PG8_LDB(B1, 1, 1); PG8_STAGE(PG8_SB(1, 0), b3, voffB);
            PG8_BAR; PG8_WAIT_L(0); PG8_MMA(0, 1, At, B1); PG8_BAR;
            PG8_LDA(At, 1, 1); PG8_STAGE(PG8_SA(1, 0), a3, voffA);
            PG8_BAR; PG8_WAIT_L(0); PG8_MMA(1, 0, At, B0); PG8_BAR; PG8_SCHED;
            PG8_STAGE(PG8_SB(1, 1), b3 + hstep, voffB);
            PG8_WAIT_V(6); PG8_BAR; PG8_MMA(1, 1, At, B1); PG8_BAR;
            }
        }
        if constexpr (ALIGN_EPI) { if (wr == 0) PG8_BAR; }
        if constexpr (!Epi::AFTER_DRAIN) { E(acc, cur, wr, wc, fr, fq); S.done(cur); }
        if (!has_next) break;
#pragma unroll
        for (int a = 0; a < 2; ++a)
#pragma unroll
            for (int b = 0; b < 2; ++b)
#pragma unroll
                for (int m = 0; m < 4; ++m)
#pragma unroll
                    for (int n = 0; n < 2; ++n) acc[a][b][m][n] = (f32x4){0.f, 0.f, 0.f, 0.f};
        cur = nxt; cA = nA; cB = nB; ++ui;
        if constexpr (ALIGN_EPI) { if (wr == 1) PG8_BAR; }
    }
    PG8_WAIT_V(0);
    if constexpr (!ALIGN_EPI) { if (wr == 0) PG8_BAR; }
    PG8_BAR;
    if constexpr (Epi::AFTER_DRAIN) { E.fused(acc, cur, wr, wc, fr, fq, lds, wid, lane); S.done(cur); }
#undef PG8_SA
#undef PG8_SB
#undef PG8_STAGE
#undef PG8_LDA
#undef PG8_LDB
#undef PG8_MMA
#undef PG8_WAIT_V
#undef PG8_WAIT_L
#undef PG8_BAR
#undef PG8_SCHED
}
}
namespace cg = cooperative_groups;
#define LAS __attribute__((address_space(3)))
typedef unsigned short bf16;
typedef float f32x4 __attribute__((ext_vector_type(4)));
typedef float f32x8 __attribute__((ext_vector_type(8)));
typedef float f32x16 __attribute__((ext_vector_type(16)));
typedef unsigned u32x4 __attribute__((ext_vector_type(4)));
typedef unsigned u32x2 __attribute__((ext_vector_type(2)));
typedef short bf16x8 __attribute__((ext_vector_type(8)));
typedef short s16x4 __attribute__((ext_vector_type(4)));

constexpr int BATCH = 16, SEQ = 2048, DM = 1024, T = BATCH * SEQ;
constexpr int NP = 3072;
constexpr int IN_COLS = 3012;
constexpr int C_QA = 0, C_KA = 512, C_VA = 1024, C_QB = 1536, C_KV = 2560, C_QI = 2688, C_KI = 2944, C_WI = 3008;
constexpr int MIXW = 1536;
constexpr int NEXP = 16384;
constexpr float EPS = 1e-6f;
constexpr int NT = 512;
constexpr int NWV = 8;

constexpr size_t MiB = 1u << 20;
constexpr size_t WS_CTL = 0;
constexpr size_t CTL_BYTES = 64 * 1024;
constexpr size_t WS_MOD = 1 * MiB;
constexpr size_t WS_SCAL = WS_MOD + 512 * 1024;
constexpr size_t WS_QBIAS = WS_MOD + 400 * 1024;
constexpr size_t WS_VS = WS_SCAL + 64 * 1024;
constexpr size_t WS_US = WS_SCAL + 128 * 1024;
constexpr size_t WS_WIN = 2 * MiB;
constexpr size_t WS_WO2 = 8 * MiB;
constexpr size_t WS_WQ = 11 * MiB;
constexpr size_t WS_SUBK = 13 * MiB;
constexpr size_t WS_U16 = 14 * MiB;
constexpr size_t WS_V16 = 46 * MiB;
constexpr size_t WS_H = 78 * MiB;
constexpr size_t WS_PROJ = 142 * MiB;
constexpr size_t WS_Q3 = WS_PROJ;
constexpr size_t WS_MIX = 334 * MiB;
constexpr size_t WS_EXP = 430 * MiB;
constexpr size_t WS_KVC = WS_EXP;
constexpr size_t WS_GATE = 446 * MiB;
constexpr size_t WS_ATMP = 462 * MiB;
constexpr size_t WS_CBUF = 494 * MiB;
constexpr size_t WS_SSQ = WS_ATMP;
constexpr size_t WS_ABUF1 = WS_MIX;
constexpr size_t WS_END = 510 * MiB;

struct Params {
    const float *x, *c, *ada_w, *ada_b, *norm1_g, *norm2_g, *w_in, *a_qk_gain, *a_lambda, *a_sub_gain, *b_q_gain, *b_kv_gain, *b_w_uv, *w_out, *peer_wq, *peer_subkeys, *peer_u, *peer_v;
    float* out; unsigned char* ws;
};

enum { SC_LAM = 0, SC_MA = 1, SC_MB = 2 };

__device__ __forceinline__ unsigned f2bf(float f) { unsigned u = __float_as_uint(f); return (u + 0x7fffu + ((u >> 16) & 1u)) >> 16; }
__device__ __forceinline__ float bf2f(unsigned h) { return __uint_as_float(h << 16); }
__device__ __forceinline__ unsigned pk2(float lo, float hi) { return f2bf(lo) | (f2bf(hi) << 16); }
__device__ __forceinline__ float bflo(unsigned w) { return __uint_as_float(w << 16); }
__device__ __forceinline__ float bfhi(unsigned w) { return __uint_as_float(w & 0xffff0000u); }
__device__ __forceinline__ float wave_sum(float v) {
#pragma unroll
    for (int o = 1; o < 64; o <<= 1) v += __shfl_xor(v, o);
    return v;
}
__device__ __forceinline__ float wave_max(float v) {
#pragma unroll
    for (int o = 1; o < 64; o <<= 1) v = fmaxf(v, __shfl_xor(v, o));
    return v;
}
#define LDS_WAIT() asm volatile("s_waitcnt lgkmcnt(0)" ::: "memory")
__device__ __forceinline__ void ph_mod(const Params& p, float* ldsf, int vb, int nvb) {
    if (vb >= 96) return;
    int tid = threadIdx.x; asm volatile("" : "+v"(tid));
    const int lane = tid & 63, wv = tid >> 6;
    float w[128];
    { float cv[32];
      const float* wp0 = p.ada_w + (size_t)(128 * wv) * 6144 + vb * 64 + lane;
#pragma unroll
      for (int q = 0; q < 32; ++q) cv[q] = p.c[tid + q * NT];
#pragma unroll
      for (int u = 0; u < 64; ++u) w[u] = wp0[(size_t)u * 6144];
#pragma unroll
      for (int q = 0; q < 32; ++q) { float v = cv[q]; asm volatile("" : "+v"(v)); ldsf[tid + q * NT] = v / (1.f + __expf(-v)); }
#pragma unroll
      for (int u = 64; u < 128; ++u) w[u] = wp0[(size_t)u * 6144]; }
    __syncthreads();
    float* MOD = (float*)(p.ws + WS_MOD); float* part = ldsf + 16 * 1024;
    for (int it = vb; it < 96; it += nvb) {
        const int j = it * 64 + lane;
        float acc[16];
#pragma unroll
        for (int b = 0; b < 16; ++b) acc[b] = 0.f;
        const float* wp = p.ada_w + (size_t)(128 * wv) * 6144 + j;
        {
            if (it != vb) {
#pragma unroll
                for (int u = 0; u < 128; ++u) w[u] = wp[(size_t)u * 6144]; }
#pragma unroll
            for (int u = 0; u < 128; ++u)
#pragma unroll
                for (int b = 0; b < 16; ++b) acc[b] = fmaf(ldsf[b * 1024 + 128 * wv + u], w[u], acc[b]);
        }
#pragma unroll
        for (int b = 0; b < 16; ++b) part[(wv * 16 + b) * 64 + lane] = acc[b];
        __syncthreads();
        for (int o = tid; o < 16 * 64; o += NT) { const int b = o >> 6, c = o & 63; float s = 0.f;
#pragma unroll
            for (int w = 0; w < 8; ++w) s += part[(w * 16 + b) * 64 + c];
            MOD[b * 6144 + it * 64 + c] = s + p.ada_b[it * 64 + c]; }
        __syncthreads();
    }
}

__device__ __forceinline__ void transpose_item(const float* W, int N, bf16* WT, int ldt, LAS float* scr, int kb, int nb, int lane) {
    const int k0 = 64 * kb, n0 = 32 * nb;
#pragma unroll
    for (int i = 0; i < 32; ++i) { const int kk = 2 * i + (lane >> 5); const int n = n0 + (lane & 31); scr[kk * 33 + (lane & 31)] = (n < N) ? W[(size_t)(k0 + kk) * N + n] : 0.f; }
    LDS_WAIT(); asm volatile("" ::: "memory");
    const int c = lane & 7;
#pragma unroll
    for (int j = 0; j < 4; ++j) { const int n = (lane >> 3) + 8 * j; const LAS float* s = scr + (8 * c) * 33 + n;
        u32x4 o; o.x = pk2(s[0 * 33], s[1 * 33]); o.y = pk2(s[2 * 33], s[3 * 33]); o.z = pk2(s[4 * 33], s[5 * 33]); o.w = pk2(s[6 * 33], s[7 * 33]);
        *(u32x4*)(WT + (size_t)(n0 + n) * ldt + k0 + 8 * c) = o; }
    LDS_WAIT(); asm volatile("" ::: "memory");
}

template <int PART> __device__ __forceinline__ void ph_prep_weights(const Params& p, LAS float* scr, int gw, int ngw, int lane) {
    bf16* WIN = (bf16*)(p.ws + WS_WIN); bf16* WO2 = (bf16*)(p.ws + WS_WO2); bf16* WQ = (bf16*)(p.ws + WS_WQ);
    constexpr int I_IN = 16 * 96, I_O = 8 * 32, I_Q = 16 * 32;
    const size_t gt = (size_t)gw * 64 + lane, ngt = (size_t)ngw * 64;
    if (PART == 0) {
        for (int it = gw; it < I_IN + I_O + I_Q; it += ngw) {
            int r = it;
            if (r < I_IN) { transpose_item(p.w_in, IN_COLS, WIN, 1024, scr, r / 96, r % 96, lane); continue; } r -= I_IN;
            if (r < I_O) { transpose_item(p.w_out, 1024, WO2, MIXW, scr, r / 32, r % 32, lane); continue; } r -= I_O;
            transpose_item(p.peer_wq, 1024, WQ, 1024, scr, r / 32, r % 32, lane);
        }
    } else {
        for (size_t i = gt; i < (size_t)1024 * 1024; i += 2 * ngt) {
            const size_t i2 = (i + ngt < (size_t)1024 * 1024) ? i + ngt : i;
            const int n = (int)(i & 1023), kk = (int)(i >> 10), h = kk >> 7, n2 = (int)(i2 & 1023), kk2 = (int)(i2 >> 10), h2 = kk2 >> 7;
            const float* wu = p.b_w_uv + (size_t)kk * 64; const float* wo = p.w_out + (size_t)(512 + 64 * h) * 1024 + n;
            const float* wu2 = p.b_w_uv + (size_t)kk2 * 64; const float* wo2 = p.w_out + (size_t)(512 + 64 * h2) * 1024 + n2;
            float wv_[64], wv2_[64];
#pragma unroll
            for (int e = 0; e < 64; ++e) wv_[e] = wo[(size_t)e * 1024];
#pragma unroll
            for (int e = 0; e < 64; ++e) wv2_[e] = wo2[(size_t)e * 1024];
            float a = 0.f, a2 = 0.f;
#pragma unroll
            for (int e = 0; e < 64; ++e) a = fmaf(wu[e], wv_[e], a);
#pragma unroll
            for (int e = 0; e < 64; ++e) a2 = fmaf(wu2[e], wv2_[e], a2);
            WO2[(size_t)n * MIXW + 512 + kk] = (bf16)f2bf(a);
            if (i2 != i) WO2[(size_t)n2 * MIXW + 512 + kk2] = (bf16)f2bf(a2);
        }
        return;
    }
    bf16* SUBK = (bf16*)(p.ws + WS_SUBK);
    constexpr size_t NSUB8 = 2 * 128 * 64 / 8;
    for (size_t j = gt; j < NSUB8; j += ngt) {
        const f32x8 v = *(const f32x8*)(p.peer_subkeys + j * 8);
        u32x4 o; o.x = pk2(v[0], v[1]); o.y = pk2(v[2], v[3]); o.z = pk2(v[4], v[5]); o.w = pk2(v[6], v[7]);
        *(u32x4*)(SUBK + j * 8) = o;
    }
    if (gw == ngw - 1) {
        float* SC = (float*)(p.ws + WS_SCAL);
        const float s01 = wave_sum(p.a_lambda[lane] * p.a_lambda[64 + lane]), s23 = wave_sum(p.a_lambda[128 + lane] * p.a_lambda[192 + lane]);
        float g0 = fabsf(p.a_qk_gain[lane]), g1 = fabsf(p.a_qk_gain[64 + lane]);
        float gq = fmaxf(fabsf(p.b_q_gain[lane]), fabsf(p.b_q_gain[64 + lane])), gk = fmaxf(fabsf(p.b_kv_gain[lane]), fabsf(p.b_kv_gain[64 + lane]));
#pragma unroll
        for (int o = 1; o < 64; o <<= 1) { g0 = fmaxf(g0, __shfl_xor(g0, o)); g1 = fmaxf(g1, __shfl_xor(g1, o)); gq = fmaxf(gq, __shfl_xor(gq, o)); gk = fmaxf(gk, __shfl_xor(gk, o)); }
        if (lane == 0) {
            SC[SC_LAM] = __expf(s01) - __expf(s23) + 0.2f;
            SC[SC_MA] = 8.0f * g0 * g1 * 1.02f;
            SC[SC_MB] = 11.3137085f * gq * gk * 1.02f;
        }
    }
}

__device__ __forceinline__ void ph_hrows(const Params& p, const float* X, const float* g, int shOff, int scOff, int gw, int ngw, int lane) {
    const float* MOD = (const float*)(p.ws + WS_MOD); bf16* H = (bf16*)(p.ws + WS_H);
    f32x4 gg4[4], v[4];
#pragma unroll
    for (int j = 0; j < 4; ++j) { gg4[j] = *(const f32x4*)(g + 4 * (lane + 64 * j)); if (gw < T) v[j] = ((const f32x4*)(X + (size_t)gw * 1024) + lane)[64 * j]; }
    for (int m = gw; m < T; m += ngw) {
        const float* mb = MOD + (size_t)(m >> 11) * 6144;
        f32x4 sc4[4], sh4[4], nv[4];
#pragma unroll
        for (int j = 0; j < 4; ++j) { const int col = 4 * (lane + 64 * j); sc4[j] = *(const f32x4*)(mb + scOff + col); sh4[j] = *(const f32x4*)(mb + shOff + col); }
        { const int mn = (m + ngw < T) ? m + ngw : m; const f32x4* xn = (const f32x4*)(X + (size_t)mn * 1024) + lane;
#pragma unroll
          for (int j = 0; j < 4; ++j) nv[j] = xn[64 * j]; }
        float s = 0.f;
#pragma unroll
        for (int j = 0; j < 4; ++j) s += (v[j].x * v[j].x + v[j].y * v[j].y) + (v[j].z * v[j].z + v[j].w * v[j].w);
        const float rstd = rsqrtf(wave_sum(s) * (1.f / 1024.f) + EPS);
#pragma unroll
        for (int j = 0; j < 4; ++j) {
            const int col = 4 * (lane + 64 * j);
            const f32x4 gg = gg4[j], sc = sc4[j], sh = sh4[j];
            const f32x4 y = v[j] * rstd * gg * (sc + 1.0f) + sh;
            u32x2 o; o.x = pk2(y.x, y.y); o.y = pk2(y.z, y.w);
            *(u32x2*)(H + (size_t)m * 1024 + col) = o;
        }
#pragma unroll
        for (int j = 0; j < 4; ++j) v[j] = nv[j];
    }
}

__device__ __forceinline__ void ph_norm_proj(const Params& p, int gw, int ngw, int lane) {
    bf16* PROJ = (bf16*)(p.ws + WS_PROJ);
    for (int m = gw; m < T; m += ngw) {
        bf16* row = PROJ + (size_t)m * NP;
#pragma unroll
        for (int j = 0; j < 6; ++j) {
            if (j == 2) continue;
            const int col = 8 * lane + 512 * j;
            const u32x4 raw = *(const u32x4*)(row + col);
            float v[8] = {bflo(raw.x), bfhi(raw.x), bflo(raw.y), bfhi(raw.y), bflo(raw.z), bfhi(raw.z), bflo(raw.w), bfhi(raw.w)};
            float ss = 0.f;
#pragma unroll
            for (int i = 0; i < 8; ++i) ss += v[i] * v[i];
            ss += __shfl_xor(ss, 1); ss += __shfl_xor(ss, 2); ss += __shfl_xor(ss, 4);
            float rstd; const float* gp;
            if (j < 2) { rstd = rsqrtf(ss * (1.f / 64.f) + EPS); gp = p.a_qk_gain + 64 * j + (col & 63); }
            else { ss += __shfl_xor(ss, 8); rstd = rsqrtf(ss * (1.f / 128.f) + EPS); gp = (j == 5 ? p.b_kv_gain : p.b_q_gain) + (col & 127); }
            if (j == 5 && lane >= 16) continue;
            const f32x4 g0 = *(const f32x4*)gp, g1 = *(const f32x4*)(gp + 4);
            u32x4 o; o.x = pk2(v[0] * rstd * g0.x, v[1] * rstd * g0.y); o.y = pk2(v[2] * rstd * g0.z, v[3] * rstd * g0.w);
            o.z = pk2(v[4] * rstd * g1.x, v[5] * rstd * g1.y); o.w = pk2(v[6] * rstd * g1.z, v[7] * rstd * g1.w);
            *(u32x4*)(row + col) = o;
        }
    }
}
struct EpiResGate {
    static constexpr bool PERM = false, AFTER_DRAIN = false;
    const float* X; float* Out; const float* gate;
    __device__ __forceinline__ void operator()(const pg8::f32x4 (&acc)[2][2][4][2], const pg8::Unit& u, int wr, int wc, int fr, int fq) const {
        const int col0 = u.pn * 256 + wc * 32 + 4 * fq;
#pragma unroll
        for (int ai = 0; ai < 2; ++ai)
#pragma unroll
            for (int m = 0; m < 4; ++m) {
                const int r = u.pm * 256 + ai * 128 + wr * 64 + m * 16 + fr; const float* gb = gate + (size_t)(r >> 11) * 6144;
#pragma unroll
                for (int bj = 0; bj < 2; ++bj)
#pragma unroll
                    for (int n = 0; n < 2; ++n) { const int c = col0 + bj * 128 + n * 16; const size_t off = (size_t)r * 1024 + c;
                        const pg8::f32x4 xv = *(const pg8::f32x4*)(X + off), gv = *(const pg8::f32x4*)(gb + c);
                        *(pg8::f32x4*)(Out + off) = xv + gv * acc[ai][bj][m][n]; }
            }
    }
};


struct EpiResGateA2 {
    static constexpr bool PERM = true, AFTER_DRAIN = false;
    const float* X; float* Out; const float* MODp; const float* g2; bf16* A2; float* SSQ;
    __device__ __forceinline__ void operator()(const pg8::f32x4 (&acc)[2][2][4][2], const pg8::Unit& u, int wr, int wc, int fr, int fq) const {
        const int row0 = u.pm * 256 + wr * 64 + fr, col0 = u.pn * 256 + wc * 32 + 8 * fq;
        const float* mb = MODp + (size_t)((u.pm * 256) >> 11) * 6144;
        pg8::f32x4 gt[2][2], gm[2][2];
#pragma unroll
        for (int bj = 0; bj < 2; ++bj)
#pragma unroll
            for (int n = 0; n < 2; ++n) { const int c = col0 + bj * 128 + 4 * n; gt[bj][n] = *(const pg8::f32x4*)(mb + 2048 + c);
                const pg8::f32x4 gg = *(const pg8::f32x4*)(g2 + c), sc = *(const pg8::f32x4*)(mb + 4096 + c); gm[bj][n] = gg * (sc + 1.0f); }
#pragma unroll
        for (int ai = 0; ai < 2; ++ai)
#pragma unroll
            for (int m = 0; m < 4; ++m) { const int r = row0 + ai * 128 + m * 16; float ss = 0.f;
#pragma unroll
                for (int bj = 0; bj < 2; ++bj) { const size_t off = (size_t)r * 1024 + col0 + bj * 128;
                    const pg8::f32x4 v0 = *(const pg8::f32x4*)(X + off) + gt[bj][0] * acc[ai][bj][m][0], v1 = *(const pg8::f32x4*)(X + off + 4) + gt[bj][1] * acc[ai][bj][m][1];
                    *(pg8::f32x4*)(Out + off) = v0; *(pg8::f32x4*)(Out + off + 4) = v1;
                    ss += ((v0[0] * v0[0] + v0[1] * v0[1]) + (v0[2] * v0[2] + v0[3] * v0[3])) + ((v1[0] * v1[0] + v1[1] * v1[1]) + (v1[2] * v1[2] + v1[3] * v1[3]));
                    const pg8::f32x4 a0 = v0 * gm[bj][0], a1 = v1 * gm[bj][1];
                    pg8::u32x4 w; w.x = pg8::cvt_pk_bf16(a0[0], a0[1]); w.y = pg8::cvt_pk_bf16(a0[2], a0[3]); w.z = pg8::cvt_pk_bf16(a1[0], a1[1]); w.w = pg8::cvt_pk_bf16(a1[2], a1[3]);
                    *(pg8::u32x4*)(A2 + off) = w; }
                ss += __shfl_xor(ss, 16); ss += __shfl_xor(ss, 32);
                if (fq == 0) SSQ[(size_t)r * 16 + u.pn * 4 + wc] = ss; }
    }
};

struct EpiQ3 {
    static constexpr bool PERM = true, AFTER_DRAIN = false;
    const float* SSQ; const float* BIAS; bf16* O;
    __device__ __forceinline__ void operator()(const pg8::f32x4 (&acc)[2][2][4][2], const pg8::Unit& u, int wr, int wc, int fr, int fq) const {
        const int row0 = u.pm * 256 + wr * 64 + fr, col0 = u.pn * 256 + wc * 32 + 8 * fq;
        const float* bb = BIAS + (size_t)((u.pm * 256) >> 11) * 1024 + col0;
        pg8::f32x4 bv[2][2];
#pragma unroll
        for (int bj = 0; bj < 2; ++bj)
#pragma unroll
            for (int n = 0; n < 2; ++n) bv[bj][n] = *(const pg8::f32x4*)(bb + bj * 128 + 4 * n);
#pragma unroll
        for (int ai = 0; ai < 2; ++ai)
#pragma unroll
            for (int m = 0; m < 4; ++m) { const int r = row0 + ai * 128 + m * 16; const pg8::f32x4 s4 = *((const pg8::f32x4*)(SSQ + (size_t)r * 16) + fq);
                float s_ = (s4[0] + s4[1]) + (s4[2] + s4[3]); s_ += __shfl_xor(s_, 16); s_ += __shfl_xor(s_, 32); const float rs = rsqrtf(s_ * (1.f / 1024.f) + EPS);
#pragma unroll
                for (int bj = 0; bj < 2; ++bj) { const pg8::f32x4 v0 = acc[ai][bj][m][0] * rs + bv[bj][0], v1 = acc[ai][bj][m][1] * rs + bv[bj][1];
                    pg8::u32x4 w; w.x = pg8::cvt_pk_bf16(v0[0], v0[1]); w.y = pg8::cvt_pk_bf16(v0[2], v0[3]); w.z = pg8::cvt_pk_bf16(v1[0], v1[1]); w.w = pg8::cvt_pk_bf16(v1[2], v1[3]);
                    *(pg8::u32x4*)(O + (size_t)r * 1024 + col0 + bj * 128) = w; } }
    }
};

__device__ __forceinline__ void ph_q3bias(const Params& p, int gw, int lane) {
    if (gw >= 64) return;
    const float* MOD = (const float*)(p.ws + WS_MOD); const bf16* WQ = (const bf16*)(p.ws + WS_WQ); float* BIAS = (float*)(p.ws + WS_QBIAS);
    const int l15 = lane & 15, g = lane >> 4, n0 = gw * 16;
    const float* ar = MOD + (size_t)l15 * 6144 + 3072 + 8 * g; const bf16* br = WQ + (size_t)(n0 + l15) * 1024 + 8 * g;
    f32x4 a = {0.f, 0.f, 0.f, 0.f};
#pragma unroll 4
    for (int ks = 0; ks < 32; ++ks) {
        const f32x4 s0 = *(const f32x4*)(ar + 32 * ks), s1 = *(const f32x4*)(ar + 32 * ks + 4);
        u32x4 aw; aw.x = pk2(s0[0], s0[1]); aw.y = pk2(s0[2], s0[3]); aw.z = pk2(s1[0], s1[1]); aw.w = pk2(s1[2], s1[3]);
        bf16x8 av; __builtin_memcpy(&av, &aw, 16);
        const bf16x8 bvv = *(const bf16x8*)(br + 32 * ks);
        a = __builtin_amdgcn_mfma_f32_16x16x32_bf16(av, bvv, a, 0, 0, 0);
    }
#pragma unroll
    for (int r = 0; r < 4; ++r) BIAS[(size_t)(4 * g + r) * 1024 + n0 + l15] = a[r];
}


struct EpiNormBf16 {
    static constexpr bool PERM = true, AFTER_DRAIN = false;
    bf16* O; const float* gqk; const float* gbq; const float* gbkv; LAS float* P; bf16* KVC;
    __device__ __forceinline__ void operator()(const pg8::f32x4 (&acc)[2][2][4][2], const pg8::Unit& u, int wr, int wc, int fr, int fq) const {
        const int pn = u.pn;
        const int mode = pn < 4 ? 1 : ((pn == 4 || pn == 5 || pn == 11) ? 0 : (pn == 10 ? 3 : 2));
        if (mode != 0) {
#pragma unroll
            for (int ai = 0; ai < 2; ++ai)
#pragma unroll
                for (int m = 0; m < 4; ++m)
#pragma unroll
                    for (int bj = 0; bj < 2; ++bj) {
                        const pg8::f32x4 a = acc[ai][bj][m][0], b = acc[ai][bj][m][1];
                        float ss = (a[0] * a[0] + a[1] * a[1]) + (a[2] * a[2] + a[3] * a[3]) + (b[0] * b[0] + b[1] * b[1]) + (b[2] * b[2] + b[3] * b[3]);
                        ss += __shfl_xor(ss, 16); ss += __shfl_xor(ss, 32);
                        if (fq == 0) P[(ai * 128 + wr * 64 + m * 16 + fr) * 8 + bj * 4 + wc] = ss;
                    }
            asm volatile("s_waitcnt lgkmcnt(0)" ::: "memory"); __builtin_amdgcn_s_barrier(); asm volatile("" ::: "memory");
        }
        const int row0 = u.pm * 256 + wr * 64 + fr, col0 = u.pn * 256 + wc * 32 + 8 * fq;
        pg8::f32x4 g0[2], g1[2];
#pragma unroll
        for (int bj = 0; bj < 2; ++bj) {
            const float* gp = nullptr;
            if (mode == 1) gp = gqk + (pn >= 2 ? 64 : 0) + 32 * (wc & 1) + 8 * fq;
            else if (mode == 2) gp = gbq + 32 * wc + 8 * fq;
            else if (mode == 3 && bj == 0) gp = gbkv + 32 * wc + 8 * fq;
            if (gp) { g0[bj] = *(const pg8::f32x4*)gp; g1[bj] = *(const pg8::f32x4*)(gp + 4); } else { g0[bj] = (pg8::f32x4){1.f, 1.f, 1.f, 1.f}; g1[bj] = g0[bj]; }
        }
#pragma unroll
        for (int ai = 0; ai < 2; ++ai)
#pragma unroll
            for (int m = 0; m < 4; ++m) { bf16* rowp = O + (size_t)(row0 + ai * 128 + m * 16) * NP + col0;
#pragma unroll
                for (int bj = 0; bj < 2; ++bj) {
                    float s = 1.f;
                    if (mode != 0 && !(mode == 3 && bj == 1)) {
                        const pg8::f32x4 q = *(const LAS pg8::f32x4*)(P + (ai * 128 + wr * 64 + m * 16 + fr) * 8 + bj * 4);
                        s = (mode == 1) ? rsqrtf(((wc < 2) ? (q[0] + q[1]) : (q[2] + q[3])) * (1.f / 64.f) + EPS) : rsqrtf(((q[0] + q[1]) + (q[2] + q[3])) * (1.f / 128.f) + EPS);
                    }
                    const pg8::f32x4 v0 = acc[ai][bj][m][0] * s * g0[bj], v1 = acc[ai][bj][m][1] * s * g1[bj];
                    pg8::u32x4 w; w.x = pg8::cvt_pk_bf16(v0[0], v0[1]); w.y = pg8::cvt_pk_bf16(v0[2], v0[3]); w.z = pg8::cvt_pk_bf16(v1[0], v1[1]); w.w = pg8::cvt_pk_bf16(v1[2], v1[3]);
                    if (pn == 10 && bj == 0) *(pg8::u32x4*)(KVC + (size_t)(row0 + ai * 128 + m * 16) * 128 + wc * 32 + 8 * fq) = w;
                    else *(pg8::u32x4*)(rowp + bj * 128) = w; } }
    }
};
typedef __bf16 bf16x2_t __attribute__((ext_vector_type(2)));
__device__ __forceinline__ float dot2bf(unsigned a, unsigned b, float acc) { return __builtin_amdgcn_fdot2_f32_bf16(__builtin_bit_cast(bf16x2_t, a), __builtin_bit_cast(bf16x2_t, b), acc, false); }
template <int CTRL> __device__ __forceinline__ float dpp_f(float v) { return __int_as_float(__builtin_amdgcn_update_dpp(0, __float_as_int(v), CTRL, 0xf, 0xf, false)); }
__device__ __forceinline__ float row16_sum(float v) {
    v += dpp_f<0x128>(v); v += dpp_f<0x124>(v); v += dpp_f<0x122>(v); v += dpp_f<0x121>(v); return v;
}
__device__ __forceinline__ float gelu_erf(float v) {
    const float av = fabsf(v), t = __builtin_amdgcn_rcpf(fmaf(av, 0.2316418882f, 1.0f));
    float q = fmaf(t, 0.5307027145f, -0.7265760135f); q = fmaf(q, t, 0.7107068705f); q = fmaf(q, t, -0.142248368f); q = fmaf(q, t, 0.127414796f); q = q * t;
    const float e = __builtin_amdgcn_exp2f(v * v * -0.72134752044f);
    const float m = v * (q * e);
    return v < 0.f ? m : v - m;
}

#ifndef DSA_PB
#define DSA_PB 0
#endif
typedef short v4i16_t __attribute__((ext_vector_type(4)));
typedef unsigned u32x6_t __attribute__((ext_vector_type(6)));
typedef unsigned u32x3_t __attribute__((ext_vector_type(3)));
typedef float f32x32_t __attribute__((ext_vector_type(32)));
#ifndef DSA_REP_A
#define DSA_REP_A 1
#endif
#ifndef DSA_REP_B
#define DSA_REP_B 1
#endif
#ifndef DSA_REP_C
#define DSA_REP_C 1
#endif
constexpr int DSA_SROW = 2048 * 4 + 16;
constexpr int DSA_SEL_OFF = 16 * DSA_SROW;
constexpr int DSA_LDS = DSA_SEL_OFF + 16 * 512;
constexpr int DSA_KVROW = 272;

__device__ __forceinline__ unsigned sortkey(float s) { const unsigned u = __float_as_uint(s); return u ^ ((u >> 31) ? 0xffffffffu : 0x80000000u); }
__device__ __forceinline__ unsigned cvtpk_bf16(float lo, float hi) { unsigned r; asm volatile("v_cvt_pk_bf16_f32 %0, %1, %2" : "=v"(r) : "v"(lo), "v"(hi)); return r; }

__device__ __forceinline__ void cnt_ge4(int& acc, unsigned k0, unsigned k1, unsigned k2, unsigned k3, unsigned cand) {
    asm volatile("v_cmp_ge_u32_e64 s[40:41], %1, %5\n\t"
                 "v_cmp_ge_u32_e64 s[42:43], %2, %5\n\t"
                 "v_cmp_ge_u32_e64 s[44:45], %3, %5\n\t"
                 "v_cmp_ge_u32_e64 s[46:47], %4, %5\n\t"
                 "v_addc_co_u32_e64 %0, s[48:49], %0, 0, s[40:41]\n\t"
                 "v_addc_co_u32_e64 %0, s[48:49], %0, 0, s[42:43]\n\t"
                 "v_addc_co_u32_e64 %0, s[48:49], %0, 0, s[44:45]\n\t"
                 "v_addc_co_u32_e64 %0, s[48:49], %0, 0, s[46:47]"
                 : "+v"(acc) : "v"(k0), "v"(k1), "v"(k2), "v"(k3), "v"(cand)
                 : "s40", "s41", "s42", "s43", "s44", "s45", "s46", "s47", "s48", "s49");
}
__device__ __forceinline__ void ph_dsa(const Params& p, unsigned char* lds, int vb, int nvb) {
    const bf16* PROJ = (const bf16*)(p.ws + WS_PROJ); bf16* MIX = (bf16*)(p.ws + WS_MIX);
    const float MB = ((const float*)(p.ws + WS_SCAL))[SC_MB];
    int tid = threadIdx.x; asm volatile("" : "+v"(tid)); const int lane = tid & 63, wv = __builtin_amdgcn_readfirstlane(tid >> 6);
    const int l15 = lane & 15, g = lane >> 4;
    LAS unsigned char* ldsl = (LAS unsigned char*)lds;
    bf16x8 nbq[4][2]; unsigned short nws[4];
#define DSA_QI_LOAD(IT) do { const int it_ = (IT); if (it_ < 2048) { const int vbb_ = it_ & 255, kk_ = it_ >> 8, xg_ = vbb_ & 7, ix_ = vbb_ >> 3, b_ = 2 * xg_ + (ix_ & 1), G_ = (ix_ >> 1) & 3, sub_ = ix_ >> 3; \
        const int c_ = (kk_ & 1) ? (31 - G_ - 8 * (kk_ >> 1)) : (G_ + 8 * (kk_ >> 1)); const int t0_ = c_ * 64 + sub_ * 16;                                                                       \
        if (c_ >= 4) { const bf16* qr_ = PROJ + (size_t)b_ * SEQ * NP + (size_t)(t0_ + l15) * NP;                                                                                              \
            _Pragma("unroll") for (int h = 0; h < 4; ++h) { nws[h] = qr_[C_WI + h];                                                                                                             \
                _Pragma("unroll") for (int ks = 0; ks < 2; ++ks) nbq[h][ks] = *(const bf16x8*)(qr_ + C_QI + h * 64 + 32 * ks + 8 * g); } } } } while (0)
    DSA_QI_LOAD(vb);
    for (int it = vb; it < 2048; it += nvb) {
        const int vbb = it & 255, kk = it >> 8, xg = vbb & 7, ix = vbb >> 3, b = 2 * xg + (ix & 1), G = (ix >> 1) & 3, sub = ix >> 3;
        const int c = (kk & 1) ? (31 - G - 8 * (kk >> 1)) : (G + 8 * (kk >> 1));
        const int cend = (c + 1) * 64, t0 = c * 64 + sub * 16;
        const bf16* Pb = PROJ + (size_t)b * SEQ * NP;
        const bf16* KVb = (const bf16*)(p.ws + WS_KVC) + (size_t)b * SEQ * 128;
#pragma unroll 1
        for (int repa = 0; repa < DSA_REP_A; ++repa)
        if (c >= 4) {
            bf16x8 bq[4][2]; float wsc[4];
#pragma unroll
            for (int h = 0; h < 4; ++h) { wsc[h] = bf2f(nws[h]) * 0.0625f;
#pragma unroll
                for (int ks = 0; ks < 2; ++ks) bq[h][ks] = nbq[h][ks]; }
            for (int k0 = 16 * wv; k0 < cend; k0 += 128) {
                const bf16* krow = Pb + (size_t)(k0 + l15) * NP + C_KI + 8 * g;
                const bf16x8 ka0 = *(const bf16x8*)krow, ka1 = *(const bf16x8*)(krow + 32);
                f32x4 sc = {0.f, 0.f, 0.f, 0.f};
#pragma unroll
                for (int h = 0; h < 4; ++h) { f32x4 a = {0.f, 0.f, 0.f, 0.f};
                    a = __builtin_amdgcn_mfma_f32_16x16x32_bf16(ka0, bq[h][0], a, 0, 0, 0);
                    a = __builtin_amdgcn_mfma_f32_16x16x32_bf16(ka1, bq[h][1], a, 0, 0, 0);
#pragma unroll
                    for (int r = 0; r < 4; ++r) sc[r] = fmaf(fmaxf(a[r], 0.f), wsc[h], sc[r]); }
#pragma unroll
                for (int r = 0; r < 4; ++r) sc[r] = (sc[r] == 0.f) ? 0.f : sc[r];
                *(LAS f32x4*)(ldsl + l15 * DSA_SROW + (k0 + 4 * g) * 4) = sc;
            }
        }
        __syncthreads();
        f32x4 cu[8], cw[8];
        { const float* src_ = p.peer_u + (size_t)(it * 8 + wv) * 1024 + (lane & 31) * 32;
#pragma unroll
          for (int j = 0; j < 8; ++j) cu[j] = *(const f32x4*)(src_ + 4 * j); }
        { const float* srv_ = p.peer_v + (size_t)(it * 8 + wv) * 1024 + (lane & 31) * 32;
#pragma unroll
          for (int j = 0; j < 8; ++j) cw[j] = *(const f32x4*)(srv_ + 4 * j); }
        LAS unsigned short* selw = (LAS unsigned short*)(ldsl + DSA_SEL_OFF);
        int mind0 = 0, mind1 = 0;
        if (c < 4) {
            for (int j = lane; j < 256; j += 64) { selw[(2 * wv) * 256 + j] = (unsigned short)j; selw[(2 * wv + 1) * 256 + j] = (unsigned short)j; }
        } else {
            const int nreg = cend >> 6;
            unsigned keyA[32], keyB[32];
            { const LAS float* srA = (const LAS float*)(ldsl + (2 * wv) * DSA_SROW) + lane; const LAS float* srB = (const LAS float*)(ldsl + (2 * wv + 1) * DSA_SROW) + lane;
#pragma unroll
              for (int i = 0; i < 32; ++i) { keyA[i] = (i < nreg) ? sortkey(srA[64 * i]) : 0u; keyB[i] = (i < nreg) ? sortkey(srB[64 * i]) : 0u; } }
#define DSA_WSUM(V, OUT) do { int v_ = (V); v_ += __builtin_amdgcn_update_dpp(0, v_, 0x128, 0xf, 0xf, false); v_ += __builtin_amdgcn_update_dpp(0, v_, 0x124, 0xf, 0xf, false); \
        v_ += __builtin_amdgcn_update_dpp(0, v_, 0x122, 0xf, 0xf, false); v_ += __builtin_amdgcn_update_dpp(0, v_, 0x121, 0xf, 0xf, false);                                     \
        OUT = __builtin_amdgcn_readlane(v_, 0) + __builtin_amdgcn_readlane(v_, 16) + __builtin_amdgcn_readlane(v_, 32) + __builtin_amdgcn_readlane(v_, 48); } while (0)
            unsigned prefA = 0u, prefB = 0u; bool exA = false, exB = false;
#pragma unroll 1
            for (int bit = 31; bit >= 0; --bit) {
                const unsigned candA = exA ? prefA : (prefA | (1u << bit)), candB = exB ? prefB : (prefB | (1u << bit));
                int ca = 0, cb = 0;
#pragma unroll
                for (int i = 0; i < 32; i += 4) { cnt_ge4(ca, keyA[i], keyA[i + 1], keyA[i + 2], keyA[i + 3], candA); cnt_ge4(cb, keyB[i], keyB[i + 1], keyB[i + 2], keyB[i + 3], candB); }
                int cntA, cntB; DSA_WSUM(ca, cntA); DSA_WSUM(cb, cntB);
                if (!exA && cntA >= 256) { prefA = candA; exA = (cntA == 256); }
                if (!exB && cntB >= 256) { prefB = candB; exB = (cntB == 256); }
                if (exA && exB) break;
            }
#define DSA_COMPACT(KEY, PREFIX, EXACT, QQ, MIND) do {                                                                                              \
            const int t_ = t0 + (QQ); LAS unsigned short* sel = selw + (QQ) * 256;                                                                    \
            int need_ties = 0;                                                                                                                        \
            if (!(EXACT)) { int cg_ = 0; if ((PREFIX) != 0xffffffffu) { _Pragma("unroll") for (int i = 0; i < 32; ++i) cg_ += (KEY[i] > (PREFIX)) ? 1 : 0; } \
                int cgt; DSA_WSUM(cg_, cgt); need_ties = 256 - cgt; }                                                                                 \
            int base = 0, tbase = 0, md = 4096;                                                                                                       \
            _Pragma("unroll") for (int i = 0; i < 32; ++i) { if (i < nreg) {                                                                          \
                bool selb;                                                                                                                            \
                if (EXACT) selb = KEY[i] >= (PREFIX);                                                                                                 \
                else { const bool tie = KEY[i] == (PREFIX); const unsigned long long mt = __ballot(tie);                                              \
                    const int trank = tbase + (int)__builtin_amdgcn_mbcnt_hi((unsigned)(mt >> 32), __builtin_amdgcn_mbcnt_lo((unsigned)mt, 0u));      \
                    selb = (KEY[i] > (PREFIX)) || (tie && trank < need_ties); tbase += __popcll(mt); }                                                \
                const unsigned long long m = __ballot(selb);                                                                                          \
                const int pos = base + (int)__builtin_amdgcn_mbcnt_hi((unsigned)(m >> 32), __builtin_amdgcn_mbcnt_lo((unsigned)m, 0u));               \
                const int kidx = i * 64 + lane;                                                                                                       \
                if (selb) { sel[pos] = (unsigned short)kidx; const int d = t_ > kidx ? t_ - kidx : kidx - t_; md = d < md ? d : md; }                 \
                base += __popcll(m); } }                                                                                                              \
            _Pragma("unroll") for (int o = 1; o < 64; o <<= 1) { const int x = __shfl_xor(md, o); md = x < md ? x : md; }                             \
            MIND = md; } while (0)
            DSA_COMPACT(keyA, prefA, exA, 2 * wv, mind0);
            DSA_COMPACT(keyB, prefB, exB, 2 * wv + 1, mind1);
#undef DSA_COMPACT
#undef DSA_WSUM
        }
#define DSA_FP6_ROW(CW, Q6, INVS) do { float mx = 0.f;                                                                                             \
            _Pragma("unroll") for (int j = 0; j < 8; ++j) mx = fmaxf(fmaxf(mx, fmaxf(fabsf(CW[j].x), fabsf(CW[j].y))), fmaxf(fabsf(CW[j].z), fabsf(CW[j].w))); \
            _Pragma("unroll") for (int o = 1; o < 32; o <<= 1) mx = fmaxf(mx, __shfl_xor(mx, o));                                                      \
            const unsigned mb_ = __float_as_uint(mx); const int k_ = (int)(mb_ >> 23) - 127; const float mant_ = __uint_as_float((mb_ & 0x7fffffu) | 0x3f800000u); \
            int E_ = (mant_ <= 1.875f) ? 2 - k_ : 1 - k_; E_ = (mx > 0.f) ? E_ : 0; E_ = E_ > 100 ? 100 : (E_ < -100 ? -100 : E_);                        \
            const float s_ = __uint_as_float((unsigned)(E_ + 127) << 23); INVS = __uint_as_float((unsigned)(127 - E_) << 23);                           \
            f32x16 xa, xb_;                                                                                                                            \
            _Pragma("unroll") for (int j = 0; j < 8; ++j) { xa[2 * j] = CW[j].x * s_; xb_[2 * j] = CW[j].y * s_; xa[2 * j + 1] = CW[j].z * s_; xb_[2 * j + 1] = CW[j].w * s_; } \
            Q6 = __builtin_amdgcn_cvt_scalef32_2xpk16_fp6_f32(xa, xb_, 1.0f); } while (0)
        {
            u32x6_t q6; float is_; DSA_FP6_ROW(cu, q6, is_);
            unsigned char* du_ = (unsigned char*)(p.ws + WS_U16) + (size_t)(it * 8 + wv) * 768; const int l5_ = lane & 31, ui_ = l5_ >> 1;
            if (lane < 32) {
                if ((l5_ & 1) == 0) { u32x4 w4; w4.x = q6[0]; w4.y = q6[1]; w4.z = q6[2]; w4.w = q6[3]; *(u32x4*)(du_ + 16 * ui_) = w4; u32x2 w2; w2.x = q6[4]; w2.y = q6[5]; *(u32x2*)(du_ + 256 + 16 * ui_) = w2; }
                else { u32x2 w2; w2.x = q6[0]; w2.y = q6[1]; *(u32x2*)(du_ + 256 + 16 * ui_ + 8) = w2; u32x4 w4; w4.x = q6[2]; w4.y = q6[3]; w4.z = q6[4]; w4.w = q6[5]; *(u32x4*)(du_ + 512 + 16 * ui_) = w4; } }
            if (lane == 0) ((float*)(p.ws + WS_US))[it * 8 + wv] = is_;
        }
        {
            u32x6_t q6; float is_; DSA_FP6_ROW(cw, q6, is_);
            unsigned char* dv_ = (unsigned char*)(p.ws + WS_V16) + (size_t)(it * 8 + wv) * 768 + (lane & 31) * 24;
            u32x3_t lo_, hi_; lo_.x = q6[0]; lo_.y = q6[1]; lo_.z = q6[2]; hi_.x = q6[3]; hi_.y = q6[4]; hi_.z = q6[5];
            if (lane < 32) { *(u32x3_t*)dv_ = lo_; *(u32x3_t*)(dv_ + 12) = hi_; }
            if (lane == 0) ((float*)(p.ws + WS_VS))[it * 8 + wv] = is_;
        }
#undef DSA_FP6_ROW
        LDS_WAIT(); asm volatile("" ::: "memory");
        DSA_QI_LOAD(it + nvb);
        const int nvalid = cend < 256 ? cend : 256;
        const int head = lane & 7;
        const float slopeL2 = exp2f(-(float)(head + 1)) * 1.4426950409f;
#pragma unroll 1
        for (int qi2 = 0; qi2 < 2 * DSA_REP_C; ++qi2) { const int qi = qi2 & 1;
            const int qq = 2 * wv + qi, t = t0 + qq;
            const LAS unsigned short* sel = selw + qq * 256;
            const bf16* qrow = Pb + (size_t)t * NP + C_QB + head * 128 + 8 * g;
            bf16x8 bq[4];
#pragma unroll
            for (int ks = 0; ks < 4; ++ks) bq[ks] = *(const bf16x8*)(qrow + 32 * ks);
            const float refL2 = MB * 1.4426950409f - slopeL2 * (float)(qi == 0 ? mind0 : mind1);
            f32x4 o[8];
#pragma unroll
            for (int dt = 0; dt < 8; ++dt) o[dt] = (f32x4){0.f, 0.f, 0.f, 0.f};
            float lsum = 0.f;
#define DSA_GATHER(S, BUF) do { _Pragma("unroll") for (int i_ = 0; i_ < 8; ++i_) { const int jr = 32 * (S) + 4 * i_ + g; const int keyr = sel[jr < nvalid ? jr : 0];   \
        __builtin_amdgcn_global_load_lds((const unsigned*)(KVb + (size_t)keyr * 128 + 8 * (l15 ^ ((4 * i_ + g) & 15))), (unsigned*)((BUF) + 1024 * i_), 16, 0, 0); } } while (0)
#define DSA_COMPUTE(S, BUF) do { unsigned pb[4]; const LAS unsigned char* stg = (const LAS unsigned char*)(BUF);                                          \
        _Pragma("unroll") for (int tl = 0; tl < 2; ++tl) { const int j0 = 32 * (S) + 16 * tl;                                                           \
            f32x4 a = {0.f, 0.f, 0.f, 0.f};                                                                                                             \
            _Pragma("unroll") for (int ks = 0; ks < 4; ++ks) { const bf16x8 ka_ = *(const LAS bf16x8*)(stg + (16 * tl + l15) * 256 + (((4 * ks + g) ^ l15) << 4)); \
                a = __builtin_amdgcn_mfma_f32_16x16x32_bf16(ka_, bq[ks], a, 0, 0, 0); }                                                                 \
            const u32x2 kw = *(const LAS u32x2*)(sel + j0 + 4 * g);                                                                                     \
            const int kx[4] = {(int)(kw.x & 0xffffu), (int)(kw.x >> 16), (int)(kw.y & 0xffffu), (int)(kw.y >> 16)};                                     \
            float pr[4];                                                                                                                                \
            _Pragma("unroll") for (int r = 0; r < 4; ++r) { const int dd = t > kx[r] ? t - kx[r] : kx[r] - t;                                            \
                const float e = __builtin_amdgcn_exp2f(fmaf(a[r], 0.1275174f, -slopeL2 * (float)dd - refL2));                                            \
                pr[r] = (j0 + 4 * g + r < nvalid) ? e : 0.f; lsum += pr[r]; }                                                                           \
            pb[2 * tl] = cvtpk_bf16(pr[0], pr[1]); pb[2 * tl + 1] = cvtpk_bf16(pr[2], pr[3]); }                                                         \
        u32x4 pw4; pw4.x = pb[0]; pw4.y = pb[1]; pw4.z = pb[2]; pw4.w = pb[3];                                                                          \
        const bf16x8 pfrag = __builtin_bit_cast(bf16x8, pw4);                                                                                           \
        const int rr_ = 4 * g + (l15 >> 2);                                                                                                             \
        _Pragma("unroll") for (int dt = 0; dt < 8; ++dt) {                                                                                              \
            const LAS unsigned char* trp = stg + rr_ * 256 + (((2 * dt + ((lane & 3) >> 1)) ^ rr_) << 4) + 8 * (lane & 1);                                \
            const s16x4 lo = __builtin_bit_cast(s16x4, __builtin_amdgcn_ds_read_tr16_b64_v4i16((LAS v4i16_t*)trp));                                    \
            const s16x4 hi = __builtin_bit_cast(s16x4, __builtin_amdgcn_ds_read_tr16_b64_v4i16((LAS v4i16_t*)(trp + 16 * 256)));                        \
            const bf16x8 af = {lo[0], lo[1], lo[2], lo[3], hi[0], hi[1], hi[2], hi[3]};                                                                 \
            o[dt] = __builtin_amdgcn_mfma_f32_16x16x32_bf16(af, pfrag, o[dt], 0, 0, 0); }                                                               \
        LDS_WAIT(); asm volatile("" ::: "memory"); } while (0)
            const int nch = (nvalid + 31) >> 5;
            unsigned char* buf0 = lds + (2 * wv) * DSA_SROW; unsigned char* buf1 = buf0 + 8192;
            DSA_GATHER(0, buf0);
#pragma unroll 1
            for (int s = 0; s < nch; s += 2) {
                if (s + 1 < nch) DSA_GATHER(s + 1, buf1);
                if (s + 1 < nch) asm volatile("s_waitcnt vmcnt(8)" ::: "memory"); else asm volatile("s_waitcnt vmcnt(0)" ::: "memory");
                DSA_COMPUTE(s, buf0);
                if (s + 1 < nch) { if (s + 2 < nch) DSA_GATHER(s + 2, buf0);
                    if (s + 2 < nch) asm volatile("s_waitcnt vmcnt(8)" ::: "memory"); else asm volatile("s_waitcnt vmcnt(0)" ::: "memory");
                    DSA_COMPUTE(s + 1, buf1); }
            }
#undef DSA_GATHER
#undef DSA_COMPUTE
            lsum += __shfl_xor(lsum, 16); lsum += __shfl_xor(lsum, 32);
            const float il = 1.f / lsum;
            if (l15 < 8) {
                bf16* orow = MIX + (size_t)(b * SEQ + t) * MIXW + 512 + head * 128 + 4 * g;
#pragma unroll
                for (int dt = 0; dt < 8; ++dt) { u32x2 w; w.x = pk2(o[dt][0] * il, o[dt][1] * il); w.y = pk2(o[dt][2] * il, o[dt][3] * il); *(u32x2*)(orow + 16 * dt) = w; }
            }
        }
        __syncthreads();
    }
}
typedef __attribute__((address_space(1))) float GASF;
#ifndef ATT_PROBE
#define ATT_PROBE 0
#endif
#ifndef ATT_REMAP
#define ATT_REMAP 1
#endif
__device__ __forceinline__ int crow(int r, int hi) { return (r & 3) + 8 * (r >> 2) + 4 * hi; }
#define KSWZ64(row, cb) ((row) * 128 + ((cb) ^ ((((row) >> 1) & 7) << 4)))
__device__ __forceinline__ int v_st(int k, int c) { const int kk = (k & ~0xC) | ((k & 4) << 1) | ((k & 8) >> 1); return ((kk >> 3) * 4 + (c >> 5)) * 512 + ((kk & 7) * 32 + (c & 31)) * 2; }
__device__ __forceinline__ int v_rd_base(int lane) { return ((lane & 3) << 3) | (((lane >> 2) & 3) << 6) | (((lane >> 4) & 1) << 5) | (((lane >> 5) & 1) << 8); }
constexpr int v_rd_off(int d0, int ks, int half) { return d0 * 512 + ks * 4096 + half * 2048; }
template <int OFF> __device__ __forceinline__ s16x4 tr_read(int vb) {
    s16x4 r; asm volatile("ds_read_b64_tr_b16 %0, %1 offset:%2" : "=&v"(r) : "v"(vb), "i"(OFF) : "memory"); return r;
}
template <int D0> __device__ __forceinline__ void pv_one(f32x16& od, int vb, bf16x8 pa0, bf16x8 pa1, bf16x8 pa2, bf16x8 pa3) {
    const s16x4 l0 = tr_read<v_rd_off(D0, 0, 0)>(vb), h0 = tr_read<v_rd_off(D0, 0, 1)>(vb), l1 = tr_read<v_rd_off(D0, 1, 0)>(vb), h1 = tr_read<v_rd_off(D0, 1, 1)>(vb);
    const s16x4 l2 = tr_read<v_rd_off(D0, 2, 0)>(vb), h2 = tr_read<v_rd_off(D0, 2, 1)>(vb), l3 = tr_read<v_rd_off(D0, 3, 0)>(vb), h3 = tr_read<v_rd_off(D0, 3, 1)>(vb);
    asm volatile("s_waitcnt lgkmcnt(0)" ::: "memory"); __builtin_amdgcn_sched_barrier(0);
#define PK(L, H) (bf16x8){L[0], L[1], L[2], L[3], H[0], H[1], H[2], H[3]}
    od = __builtin_amdgcn_mfma_f32_32x32x16_bf16(pa0, PK(l0, h0), od, 0, 0, 0);
    od = __builtin_amdgcn_mfma_f32_32x32x16_bf16(pa1, PK(l1, h1), od, 0, 0, 0);
    od = __builtin_amdgcn_mfma_f32_32x32x16_bf16(pa2, PK(l2, h2), od, 0, 0, 0);
    od = __builtin_amdgcn_mfma_f32_32x32x16_bf16(pa3, PK(l3, h3), od, 0, 0, 0);
#undef PK
}

__device__ __forceinline__ void att_tile(f32x16 (&o)[4], float& lsum, const unsigned char* Kb, int vb0, const unsigned char* Qw, int r32, int hi, int tq, int j, bool past, float slopeL2, float refL2) {
    constexpr float C = 0.125f * 1.4426950409f;
    bf16x8 qr[4];
#pragma unroll
    for (int d0 = 0; d0 < 4; ++d0) qr[d0] = *(const bf16x8*)(Qw + KSWZ64(r32, (d0 * 16 + hi * 8) * 2));
    const float dq = (float)(tq - 64 * j - 4 * hi);
    const float B0 = -slopeL2 * dq - refL2;
    float ps = 0.f;
    bf16x8 pa0, pa1, pa2, pa3;
#define PK4(P, BASE, OUT) do { unsigned a0 = cvtpk_bf16(P[BASE + 0], P[BASE + 1]), a1 = cvtpk_bf16(P[BASE + 2], P[BASE + 3]);   \
    unsigned b0_ = cvtpk_bf16(P[BASE + 4], P[BASE + 5]), b1_ = cvtpk_bf16(P[BASE + 6], P[BASE + 7]);                              \
    auto r0 = __builtin_amdgcn_permlane32_swap(a0, b0_, false, false); auto r1 = __builtin_amdgcn_permlane32_swap(a1, b1_, false, false); \
    u32x4 w = {r0[0], r1[0], r0[1], r1[1]}; OUT = __builtin_bit_cast(bf16x8, w); } while (0)
#define HALF_TILE(KOFF, FOFF, PA, PB) do { f32x16 pp = f32x16{};                                                                     \
    _Pragma("unroll") for (int d0 = 0; d0 < 4; ++d0) { const int cb = (d0 * 16 + hi * 8) * 2;                                        \
        const bf16x8 bk = *(const bf16x8*)(Kb + KSWZ64((KOFF) + r32, cb)); pp = __builtin_amdgcn_mfma_f32_32x32x16_bf16(bk, qr[d0], pp, 0, 0, 0); } \
    if (past) { _Pragma("unroll") for (int r = 0; r < 16; ++r) { const float off = (float)((r & 3) + 8 * (r >> 2)) + (FOFF);          \
            pp[r] = __builtin_amdgcn_exp2f(fmaf(pp[r], C, fmaf(slopeL2, off, B0))); } }                                               \
    else { _Pragma("unroll") for (int r = 0; r < 16; ++r) { const float off = (float)((r & 3) + 8 * (r >> 2)) + (FOFF);               \
            pp[r] = __builtin_amdgcn_exp2f(fmaf(pp[r], C, -slopeL2 * fabsf(dq - off) - refL2)); } }                                   \
    _Pragma("unroll") for (int r = 0; r < 16; ++r) ps += pp[r];                                                                       \
    PK4(pp, 0, PA); PK4(pp, 8, PB); __builtin_amdgcn_sched_barrier(0); } while (0)
    HALF_TILE(0, 0.f, pa0, pa1);
    HALF_TILE(32, 32.f, pa2, pa3);
#undef HALF_TILE
#undef PK4
    { auto rr = __builtin_amdgcn_permlane32_swap(__float_as_uint(ps), __float_as_uint(ps), false, false);
      ps = __uint_as_float(rr[0]) + __uint_as_float(rr[1]); }
    lsum += ps;
    pv_one<0>(o[0], vb0, pa0, pa1, pa2, pa3); pv_one<1>(o[1], vb0, pa0, pa1, pa2, pa3); pv_one<2>(o[2], vb0, pa0, pa1, pa2, pa3); pv_one<3>(o[3], vb0, pa0, pa1, pa2, pa3);
}
constexpr int ATT_LDS = 2 * 16384 + 2 * 8192 + 8 * 256 + 8 * 4096;

__device__ __forceinline__ void ph_attnA(const Params& p, unsigned char* lds, int vb, int nvb) {
    const bf16* PROJ = (const bf16*)(p.ws + WS_PROJ); bf16* MIX = (bf16*)(p.ws + WS_MIX);
    const float* SC = (const float*)(p.ws + WS_SCAL);
    const float lam = SC[SC_LAM], refL2 = SC[SC_MA] * 1.4426950409f;
    constexpr float C = 0.125f * 1.4426950409f;
    int tid = threadIdx.x; asm volatile("" : "+v"(tid)); const int lane = tid & 63, wid = __builtin_amdgcn_readfirstlane(tid >> 6), r32 = lane & 31, hi = lane >> 5;
    unsigned char* V_lds = lds; unsigned char* K_lds = lds + 32768;
    float* wsf = (float*)(lds + 49152) + wid * 64;
    GASF* tmpw = (GASF*)(p.ws + WS_ATMP) + ((size_t)(vb * NWV + wid) * 64) * 64 + lane;
    const int vbase = (int)(uintptr_t)V_lds + v_rd_base(lane);
    const int krow = tid >> 3, kch = tid & 7, kdst = KSWZ64(krow, kch * 16);
    const int sr = tid >> 4, sc = (tid & 15) * 8, vst0 = v_st(sr, sc), vst1 = v_st(32 + sr, sc);
    for (int it = vb; it < 256; it += nvb) {
        #if ATT_REMAP
        const int xg_ = it & 7, m_ = it >> 3, pidx = xg_ * 8 + (m_ >> 2), qbl = m_ & 3, b = pidx >> 2, h = pidx & 3;
#else
        const int b = it >> 4, h = (it >> 2) & 3, qbl = it & 3;
#endif
        const float slopeL2 = exp2f(-2.0f * (float)(h + 1)) * 1.4426950409f;
        const bf16* Pb = PROJ + (size_t)b * SEQ * NP;
#pragma unroll 1
        for (int half = 0; half < 2; ++half) {
            const int qb = half ? 7 - qbl : qbl, q0 = 256 * qb, NTu = 4 * (qb + 1), cw = 4 * qb + (wid >> 1);
            const int tq = q0 + 32 * wid + r32;
#pragma unroll 1
            for (int mi = 0; mi < 2; ++mi) {
                const int m = 1 - mi;
                const bf16* Kg = Pb + C_KA + h * 128 + m * 64 + (size_t)krow * NP + kch * 8;
                const bf16* Vg = Pb + C_VA + h * 128 + (size_t)sr * NP + sc;
                unsigned char* Qw = lds + 51200 + wid * 4096;
                { const bf16* qp = Pb + (size_t)tq * NP + C_QA + h * 128 + m * 64 + hi * 8;
#pragma unroll
                  for (int d0 = 0; d0 < 4; ++d0) *(bf16x8*)(Qw + KSWZ64(r32, (d0 * 16 + hi * 8) * 2)) = *(const bf16x8*)(qp + d0 * 16); }
                f32x16 o[4];
#pragma unroll
                for (int d = 0; d < 4; ++d) o[d] = f32x16{};
                float lsum = 0.f;
                bf16x8 ak, av0, av1;
#define ATT_LOAD(K_, V0_, V1_, TJ) do { const size_t go_ = (size_t)(TJ) * 64 * NP; K_ = *(const bf16x8*)(Kg + go_); V0_ = *(const bf16x8*)(Vg + go_); V1_ = *(const bf16x8*)(Vg + go_ + (size_t)32 * NP); \
        if (ATT_PROBE == 2) { bf16x8 d0_ = *(const volatile bf16x8*)(Kg + go_); bf16x8 d1_ = *(const volatile bf16x8*)(Vg + go_); bf16x8 d2_ = *(const volatile bf16x8*)(Vg + go_ + (size_t)32 * NP); asm volatile("" :: "v"(d0_), "v"(d1_), "v"(d2_)); } } while (0)
#define ATT_WRITE(K_, V0_, V1_, NB) do { *(bf16x8*)(K_lds + (NB) * 8192 + kdst) = K_; *(bf16x8*)(V_lds + (NB) * 16384 + vst0) = V0_; *(bf16x8*)(V_lds + (NB) * 16384 + vst1) = V1_; } while (0)
                ATT_LOAD(ak, av0, av1, 0); ATT_WRITE(ak, av0, av1, 0);
                __syncthreads();
#pragma unroll 1
                for (int j = 0; j < NTu; ++j) {
                    const int buf = j & 1;
                    if (j + 1 < NTu) ATT_LOAD(ak, av0, av1, j + 1);
                    if (j <= cw) { att_tile(o, lsum, K_lds + buf * 8192, vbase + buf * 16384, Qw, r32, hi, tq, j, j < cw, slopeL2, refL2);
#if ATT_PROBE == 1
                        { f32x16 o2[4]; o2[0] = o[0]; o2[1] = o[1]; o2[2] = o[2]; o2[3] = o[3]; float l2 = 0.f; att_tile(o2, l2, K_lds + buf * 8192, vbase + buf * 16384, Qw, r32, hi, tq, j, j < cw, slopeL2, refL2);
                          asm volatile("" :: "v"(o2[0]), "v"(o2[1]), "v"(o2[2]), "v"(o2[3]), "v"(l2)); }
#endif
                    }
                    if (j + 1 < NTu) ATT_WRITE(ak, av0, av1, buf ^ 1);
                    __syncthreads();
                }
#undef ATT_LOAD
#undef ATT_WRITE
                if (hi == 0) wsf[r32] = lsum;
                LDS_WAIT(); asm volatile("" ::: "memory");
                float rli[16];
#pragma unroll
                for (int r = 0; r < 16; ++r) rli[r] = 1.f / wsf[crow(r, hi)];
                LDS_WAIT(); asm volatile("" ::: "memory");
                if (mi == 0) {
#pragma unroll
                    for (int d = 0; d < 4; ++d) { GASF* td = tmpw + d * 1024; asm volatile("" : "+v"(td));
#pragma unroll
                        for (int r = 0; r < 16; ++r) td[r * 64] = o[d][r] * rli[r]; }
                } else {
                    float gsub[4];
#pragma unroll
                    for (int d = 0; d < 4; ++d) gsub[d] = p.a_sub_gain[32 * d + r32];
                    GASF* tdp[4];
#pragma unroll
                    for (int d = 0; d < 4; ++d) { tdp[d] = tmpw + d * 1024; asm volatile("" : "+v"(tdp[d])); }
                    float t1[4][4];
#pragma unroll
                    for (int rr = 0; rr < 4; ++rr)
#pragma unroll
                        for (int d = 0; d < 4; ++d) t1[rr][d] = tdp[d][rr * 64];
#pragma unroll
                    for (int r = 0; r < 16; ++r) {
                        float v[4]; float ss = 0.f;
#pragma unroll
                        for (int d = 0; d < 4; ++d) { v[d] = o[d][r] * rli[r] - lam * t1[r & 3][d]; ss += v[d] * v[d]; }
                        if (r + 4 < 16) {
#pragma unroll
                            for (int d = 0; d < 4; ++d) t1[r & 3][d] = tdp[d][(r + 4) * 64]; }
                        ss += __shfl_xor(ss, 1); ss += __shfl_xor(ss, 2); ss += __shfl_xor(ss, 4); ss += __shfl_xor(ss, 8); ss += __shfl_xor(ss, 16);
                        const float rs = rsqrtf(ss * (1.f / 128.f) + EPS) * 0.8f;
                        bf16* orow = MIX + (size_t)(b * SEQ + q0 + 32 * wid + crow(r, hi)) * MIXW + h * 128 + r32;
#pragma unroll
                        for (int d = 0; d < 4; ++d) orow[32 * d] = (bf16)f2bf(v[d] * rs * gsub[d]);
                        asm volatile("" ::: "memory");
                    }
                }
            }
        }
    }
}
constexpr int RT_WAVE_BYTES = 12288;
constexpr int RT_LDS = 32768 + 8 * RT_WAVE_BYTES;

__device__ __forceinline__ int pl32_sum(int v) { auto rr = __builtin_amdgcn_permlane32_swap((unsigned)v, (unsigned)v, false, false); return (int)(rr[0] + rr[1]); }
__device__ __forceinline__ int pl32_other(int v) { auto rr = __builtin_amdgcn_permlane32_swap((unsigned)v, (unsigned)v, false, false); return (int)(rr[0] + rr[1]) - v; }
__device__ __forceinline__ float unsortkey(unsigned k) { return __uint_as_float((k & 0x80000000u) ? (k ^ 0x80000000u) : ~k); }

__device__ __forceinline__ unsigned wave_or(unsigned v) {
    v |= (unsigned)__builtin_amdgcn_update_dpp(0, (int)v, 0x128, 0xf, 0xf, false); v |= (unsigned)__builtin_amdgcn_update_dpp(0, (int)v, 0x124, 0xf, 0xf, false);
    v |= (unsigned)__builtin_amdgcn_update_dpp(0, (int)v, 0x122, 0xf, 0xf, false); v |= (unsigned)__builtin_amdgcn_update_dpp(0, (int)v, 0x121, 0xf, 0xf, false);
    return (unsigned)(__builtin_amdgcn_readlane((int)v, 0) | __builtin_amdgcn_readlane((int)v, 16) | __builtin_amdgcn_readlane((int)v, 32) | __builtin_amdgcn_readlane((int)v, 48));
}
template <int N> __device__ __forceinline__ unsigned bisect16(const unsigned (&key)[N]) {
    unsigned kmx, lo;
    { unsigned gm[8];
#pragma unroll
      for (int g = 0; g < 8; ++g) { gm[g] = key[g];
#pragma unroll
          for (int i = g + 8; i < N; i += 8) gm[g] = key[i] > gm[g] ? key[i] : gm[g]; }
      kmx = gm[0]; lo = gm[0];
#pragma unroll
      for (int g = 1; g < 8; ++g) { kmx = gm[g] > kmx ? gm[g] : kmx; lo = gm[g] < lo ? gm[g] : lo; }
      const unsigned okmx = (unsigned)pl32_other((int)kmx), olo = (unsigned)pl32_other((int)lo);
      kmx = okmx > kmx ? okmx : kmx; lo = olo < lo ? olo : lo; }
    const unsigned x = kmx - lo;
    int pb = x ? 31 - __clz(x) : -1;
    unsigned prefix = 0u; bool done = (x == 0u);
#pragma unroll 1
    while (!__all(done)) {
        const unsigned c_ = done ? prefix : (prefix | (1u << pb));
        unsigned cand = lo + c_; cand = cand < lo ? 0xffffffffu : cand;
        int cnt = 0;
#pragma unroll
        for (int i = 0; i + 3 < N; i += 4) cnt_ge4(cnt, key[i], key[i + 1], key[i + 2], key[i + 3], cand);
#pragma unroll
        for (int i = N & ~3; i < N; ++i) cnt += (key[i] >= cand) ? 1 : 0;
        const int tot = pl32_sum(cnt);
        if (!done && tot >= 16) { prefix = c_; done = (tot == 16); }
        --pb; done = done || (pb < 0);
    }
    prefix += lo;
    return prefix;
}

__device__ __forceinline__ void ph_route_subk(const Params& p, unsigned char* lds) {
    const bf16* SUBK = (const bf16*)(p.ws + WS_SUBK);
    int tid = threadIdx.x; asm volatile("" : "+v"(tid));
    for (int i = tid; i < 2048; i += NT) { const int row = i >> 3, ch = i & 7; ((u32x4*)lds)[row * 8 + (ch ^ ((row >> 1) & 7))] = ((const u32x4*)SUBK)[i]; }
    __syncthreads();
}
__device__ __forceinline__ void ph_route(const Params& p, unsigned char* lds, int item0, int item1, int wrank, int nwr) {
    const bf16* Q3 = (const bf16*)(p.ws + WS_Q3);
    int* EXPI = (int*)(p.ws + WS_EXP); float* GATE = (float*)(p.ws + WS_GATE);
    int tid = threadIdx.x; asm volatile("" : "+v"(tid));
    const int lane = tid & 63, wv = __builtin_amdgcn_readfirstlane(tid >> 6), r32 = lane & 31, hi = lane >> 5;
    unsigned char* wl = lds + 32768 + wv * RT_WAVE_BYTES;
    float* sv = (float*)wl; int* si = (int*)(wl + 4096); float* fv = (float*)(wl + 8192); int* fe = (int*)(wl + 10240);
    bf16x8 bq[4];
#define RT_Q_LOAD(ITEM, C) do { const bf16* qr_ = Q3 + (size_t)((((ITEM) >> 3) * 32) + r32) * 1024 + ((ITEM) & 7) * 128 + hi * 8 + (C) * 64;                   \
        _Pragma("unroll") for (int d0 = 0; d0 < 4; ++d0) bq[d0] = *(const bf16x8*)(qr_ + d0 * 16); } while (0)
    if (item0 + wrank < item1) RT_Q_LOAD(item0 + wrank, 0);
    for (int item = item0 + wrank; item < item1; item += nwr) {
        const int h = item & 7, tok0 = (item >> 3) * 32;
#pragma unroll 1
        for (int c = 0; c < 2; ++c) {
            unsigned key[64];
#pragma unroll
            for (int nt = 0; nt < 4; ++nt) {
                f32x16 acc = f32x16{};
                const int krow = c * 128 + nt * 32 + r32, ksw = (krow >> 1) & 7;
                const unsigned char* kp = lds + krow * 128;
#pragma unroll
                for (int d0 = 0; d0 < 4; ++d0) { const bf16x8 ak = *(const bf16x8*)(kp + (((2 * d0 + hi) ^ ksw) << 4)); acc = __builtin_amdgcn_mfma_f32_32x32x16_bf16(ak, bq[d0], acc, 0, 0, 0); }
#pragma unroll
                for (int r = 0; r < 16; ++r) key[nt * 16 + r] = sortkey(acc[r]);
            }
            if (c == 0) RT_Q_LOAD(item, 1); else if (item + nwr < item1) RT_Q_LOAD(item + nwr, 0);
            const unsigned thr = bisect16<64>(key);
            int cnt = 0;
#pragma unroll
            for (int i = 0; i < 64; ++i) cnt += (key[i] >= thr) ? 1 : 0;
            const int other_ = pl32_other(cnt); int slot = hi ? other_ : 0;
            float* svp = sv + (r32 * 2 + c) * 16; int* sip = si + (r32 * 2 + c) * 16;
#pragma unroll
            for (int i = 0; i < 64; ++i) {
                if (key[i] >= thr && slot < 16) { svp[slot] = unsortkey(key[i]); sip[slot] = 32 * (i >> 4) + ((i & 3) + 8 * ((i & 15) >> 2)) + 4 * hi; ++slot; }
            }
        }
        LDS_WAIT(); asm volatile("" ::: "memory");
        u32x4 hb[4]; f32x4 hs, hsh[4];
#define RT_H2_LOAD(HALF) do { const int tk_ = tok0 + 16 * (HALF) + (lane >> 3), p8_ = lane & 7; const int cc_ = h * 128 + 8 * p8_;                            \
            const bf16* hp_ = (const bf16*)(p.ws + WS_H) + (size_t)tk_ * 1024 + cc_;                                                                       \
            const float* sh_ = (const float*)(p.ws + WS_MOD) + (size_t)(tk_ >> 11) * 6144 + 3072 + cc_;                                                    \
            _Pragma("unroll") for (int j = 0; j < 4; ++j) hb[j] = *(const u32x4*)(hp_ + (size_t)(j >> 1) * 8 * 1024 + 64 * (j & 1));                        \
            hs = *((const f32x4*)(p.ws + WS_SSQ) + (size_t)(tk_ + 8 * (p8_ >> 2)) * 4 + (p8_ & 3));                                                        \
            hsh[0] = *(const f32x4*)sh_; hsh[1] = *(const f32x4*)(sh_ + 4); hsh[2] = *(const f32x4*)(sh_ + 64); hsh[3] = *(const f32x4*)(sh_ + 68); } while (0)
#define RT_H2_STORE(HALF) do { const int tk_ = tok0 + 16 * (HALF) + (lane >> 3), p8_ = lane & 7; const int cc_ = h * 128 + 8 * p8_;                           \
            bf16* hp_ = (bf16*)(p.ws + WS_H) + (size_t)tk_ * 1024 + cc_;                                                                                   \
            float s_ = (hs[0] + hs[1]) + (hs[2] + hs[3]); s_ += __shfl_xor(s_, 1); s_ += __shfl_xor(s_, 2);                                                 \
            const float so_ = __shfl_xor(s_, 4); const float rsme_ = rsqrtf(s_ * (1.f / 1024.f) + EPS), rsot_ = rsqrtf(so_ * (1.f / 1024.f) + EPS);           \
            const float rs0_ = (p8_ & 4) ? rsot_ : rsme_, rs1_ = (p8_ & 4) ? rsme_ : rsot_;                           \
            _Pragma("unroll") for (int j = 0; j < 4; ++j) { const f32x4 a_ = hsh[2 * (j & 1)], b_ = hsh[2 * (j & 1) + 1]; const float rs_ = (j >> 1) ? rs1_ : rs0_; u32x4 w_; \
                w_.x = cvtpk_bf16(fmaf(bflo(hb[j].x), rs_, a_[0]), fmaf(bfhi(hb[j].x), rs_, a_[1])); w_.y = cvtpk_bf16(fmaf(bflo(hb[j].y), rs_, a_[2]), fmaf(bfhi(hb[j].y), rs_, a_[3])); \
                w_.z = cvtpk_bf16(fmaf(bflo(hb[j].z), rs_, b_[0]), fmaf(bfhi(hb[j].z), rs_, b_[1])); w_.w = cvtpk_bf16(fmaf(bflo(hb[j].w), rs_, b_[2]), fmaf(bfhi(hb[j].w), rs_, b_[3])); \
                *(u32x4*)(hp_ + (size_t)(j >> 1) * 8 * 1024 + 64 * (j & 1)) = w_; } } while (0)
        RT_H2_LOAD(0);
        LDS_WAIT(); asm volatile("" ::: "memory");
        {
            float* sv0 = sv + (r32 * 2) * 16; float* sv1 = sv0 + 16; int* si0 = si + (r32 * 2) * 16; int* si1 = si0 + 16;
            {
                float a[16], bl[16];
#pragma unroll
                for (int k = 0; k < 16; ++k) { a[k] = sv0[k]; bl[k] = sv1[k]; }
                int ia[8], ib[8], ra[8], rb[8]; float va[8], vb[8];
#pragma unroll
                for (int q = 0; q < 8; ++q) { const int e = 8 * hi + q; va[q] = sv0[e]; vb[q] = sv1[e]; ia[q] = si0[e]; ib[q] = si1[e]; int r0 = 0, r1 = 0;
#pragma unroll
                    for (int k = 0; k < 16; ++k) { r0 += (a[k] > va[q] || (a[k] == va[q] && k < e)) ? 1 : 0; r1 += (bl[k] > vb[q] || (bl[k] == vb[q] && k < e)) ? 1 : 0; }
                    ra[q] = r0; rb[q] = r1; }
                LDS_WAIT(); asm volatile("" ::: "memory");
                { auto rr = __builtin_amdgcn_permlane32_swap(0u, 0u, false, false); (void)rr; }
#pragma unroll
                for (int q = 0; q < 8; ++q) { sv0[ra[q]] = va[q]; si0[ra[q]] = ia[q]; sv1[rb[q]] = vb[q]; si1[rb[q]] = ib[q]; }
                LDS_WAIT(); asm volatile("" ::: "memory");
            }
            const float* X = hi ? sv1 : sv0; const float* Y = hi ? sv0 : sv1;
            float x[4], y[16];
#pragma unroll
            for (int k = 0; k < 4; ++k) x[k] = X[k];
#pragma unroll
            for (int k = 0; k < 16; ++k) y[k] = Y[k];
            unsigned key[27]; int pi[27], pj[27]; int np = 0;
#pragma unroll
            for (int i = 0; i < 3; ++i)
#pragma unroll
                for (int j = i + 1; j < 16; ++j) if ((i + 1) * (j + 1) <= 16) { key[np] = sortkey(x[i] + y[j]); pi[np] = i; pj[np] = j; ++np; }
#pragma unroll
            for (int i = 0; i < 4; ++i) { key[23 + i] = hi ? 0u : sortkey(x[i] + y[i]); pi[23 + i] = i; pj[23 + i] = i; }
            RT_H2_STORE(0); RT_H2_LOAD(1);
            const unsigned thr = bisect16<27>(key);
            int cnt = 0;
#pragma unroll
            for (int i = 0; i < 27; ++i) cnt += (key[i] >= thr) ? 1 : 0;
            const int other_ = pl32_other(cnt); int slot = hi ? other_ : 0;
            const int* IX = hi ? si1 : si0; const int* IY = hi ? si0 : si1;
            float* fvp = fv + r32 * 16; int* fep = fe + r32 * 16;
#pragma unroll
            for (int i = 0; i < 27; ++i) {
                if (key[i] >= thr && slot < 16) { const int ex = IX[pi[i]], ey = IY[pj[i]]; fvp[slot] = unsortkey(key[i]); fep[slot] = hi ? (ey * 128 + ex) : (ex * 128 + ey); ++slot; }
            }
        }
        LDS_WAIT(); asm volatile("" ::: "memory");
        {
            const float* fvp = fv + r32 * 16;
            float v[16]; float mx = -3e38f;
#pragma unroll
            for (int k = 0; k < 16; ++k) { v[k] = fvp[k]; mx = fmaxf(mx, v[k]); }
            float l = 0.f;
#pragma unroll
            for (int k = 0; k < 16; ++k) { v[k] = __expf(v[k] - mx); l += v[k]; }
            const float il = 1.f / l;
            const size_t ob = (size_t)(tok0 + r32) * 128 + h * 16 + 8 * hi;
            const int* fep = fe + r32 * 16 + 8 * hi;
            f32x4 g0, g1; u32x4 e0, e1;
            if (hi == 0) { g0 = (f32x4){v[0] * il, v[1] * il, v[2] * il, v[3] * il}; g1 = (f32x4){v[4] * il, v[5] * il, v[6] * il, v[7] * il}; }
            else { g0 = (f32x4){v[8] * il, v[9] * il, v[10] * il, v[11] * il}; g1 = (f32x4){v[12] * il, v[13] * il, v[14] * il, v[15] * il}; }
            e0 = *(const u32x4*)fep; e1 = *(const u32x4*)(fep + 4);
            *(f32x4*)(GATE + ob) = g0; *(f32x4*)(GATE + ob + 4) = g1;
            *(u32x4*)(EXPI + ob) = e0; *(u32x4*)(EXPI + ob + 4) = e1;
        }
        RT_H2_STORE(1);
#undef RT_H2_LOAD
#undef RT_H2_STORE
        LDS_WAIT(); asm volatile("" ::: "memory");
    }
#undef RT_Q_LOAD
}
typedef float f32x2_t __attribute__((ext_vector_type(2)));
constexpr int P8_UNITS = T / 64;
constexpr int CW_P8_U = 4096, CW_P8_V = 4096 + 32 * 64;
constexpr float U8_SCALE = 32.0f;
__device__ __forceinline__ unsigned peer_xcc() { return (unsigned)__builtin_amdgcn_s_getreg((3 << 11) | 20) & 7u; }
__device__ __forceinline__ void ph_peer_v6(const Params& p, unsigned char* lds) {
    constexpr int GS = 8, G = 64 / GS, NS = 2;
    const unsigned char* V6 = (const unsigned char*)(p.ws + WS_V16);
    const int* EXPI = (const int*)(p.ws + WS_EXP); const float* CBUF = (const float*)(p.ws + WS_CBUF); const float* MOD = (const float*)(p.ws + WS_MOD);
    unsigned* ctl = (unsigned*)(p.ws + WS_CTL);
    int tid = threadIdx.x; asm volatile("" : "+v"(tid));
    const int lane = tid & 63, wv = __builtin_amdgcn_readfirstlane(tid >> 6), gR = lane >> 5, l4 = lane & 31;
    volatile LAS unsigned* slot = (volatile LAS unsigned*)(LAS unsigned char*)lds;
    const unsigned xcc = peer_xcc();
#pragma unroll 1
    for (int ks = 0; ks < NS; ++ks) {
    const int sl = (int)((((xcc * NS) >> 3) + (unsigned)ks) % (unsigned)NS);
    const int loff = sl * 384 + l4 * 12;
#pragma unroll 1
    for (;;) {
        if (tid == 0) *slot = __hip_atomic_fetch_add(ctl + CW_P8_V + 64 * sl, 1u, __ATOMIC_RELAXED, __HIP_MEMORY_SCOPE_AGENT);
        __syncthreads();
        const unsigned unit = *slot;
        __syncthreads();
        if (unit >= (unsigned)P8_UNITS) break;
        const int tbase = (int)unit * 64 + wv * 8;
        int ne0, ne1; float nc0, nc1;
#define V6_FETCH(T_) do { const size_t tn_ = (size_t)(T_); ne0 = EXPI[tn_ * 128 + lane]; ne1 = EXPI[tn_ * 128 + 64 + lane]; nc0 = CBUF[tn_ * 128 + lane]; nc1 = CBUF[tn_ * 128 + 64 + lane]; } while (0)
#define V6_LISTS(LE, LC) do { LE[lane] = ne0; LE[64 + lane] = ne1; LC[lane] = nc0; LC[64 + lane] = nc1; } while (0)
#define V6_ROWS(R, LE, GI) do { _Pragma("unroll") for (int kk = 0; kk < GS; ++kk) R[kk] = *(const u32x3_t*)(V6 + (unsigned)(LE[2 * (GS * (GI) + kk) + gR] * 768 + loff)); } while (0)
#define V6_GROUP(R, LC, GI) do { _Pragma("unroll") for (int kk = 0; kk < GS; kk += 2) { const float ca = LC[2 * (GS * (GI) + kk) + gR], cb = LC[2 * (GS * (GI) + kk + 1) + gR];   \
            u32x6_t q_; q_[0] = R[kk].x; q_[1] = R[kk].y; q_[2] = R[kk].z; q_[3] = R[kk + 1].x; q_[4] = R[kk + 1].y; q_[5] = R[kk + 1].z;                                        \
            const f32x32_t d_ = __builtin_amdgcn_cvt_scalef32_pk32_f32_fp6(q_, 1.0f);                                                                                          \
            _Pragma("unroll") for (int k = 0; k < 16; ++k) acc[k] = fmaf(cb, d_[16 + k], fmaf(ca, d_[k], acc[k])); } } while (0)
        u32x3_t RA[GS], RB[GS];
        int* lecur = (int*)(lds + 1024 + wv * 2048); int* lenxt = lecur + 256;
        V6_FETCH(tbase); V6_LISTS(lecur, ((float*)(lecur + 128))); V6_FETCH(tbase + 1);
        LDS_WAIT(); asm volatile("" ::: "memory");
        V6_ROWS(RA, lecur, 0);
#pragma unroll 1
        for (int tt = 0; tt < 8; ++tt) {
            const int t = tbase + tt;
            float* lccur = (float*)(lecur + 128); float* lcnxt = (float*)(lenxt + 128);
            float acc[16];
#pragma unroll
            for (int q = 0; q < 16; ++q) acc[q] = 0.f;
            if (tt + 1 < 8) { V6_LISTS(lenxt, lcnxt); if (tt + 2 < 8) V6_FETCH(t + 2); }
#pragma unroll 1
            for (int gi = 0; gi < G; gi += 2) {
                V6_ROWS(RB, lecur, gi + 1);
                V6_GROUP(RA, lccur, gi);
                { const bool more = gi + 2 < G; if (!more) { LDS_WAIT(); asm volatile("" ::: "memory"); }
                  const int* lsrc = more ? lecur : lenxt; const int gnx = more ? gi + 2 : 0;
                  V6_ROWS(RA, lsrc, gnx); }
                V6_GROUP(RB, lccur, gi + 1);
            }
#pragma unroll
            for (int q = 0; q < 16; ++q) acc[q] += __shfl_xor(acc[q], 32);
            if (gR == 0) { const int col = 512 * sl + 16 * l4; const float* g2 = MOD + (size_t)(t >> 11) * 6144 + 5120 + col; float* orow = p.out + (size_t)t * 1024 + col;
#pragma unroll
                for (int q = 0; q < 4; ++q) { const f32x4 xv = *(const f32x4*)(orow + 4 * q), hv = *(const f32x4*)(g2 + 4 * q);
                    f32x4 r; r.x = acc[4 * q]; r.y = acc[4 * q + 1]; r.z = acc[4 * q + 2]; r.w = acc[4 * q + 3]; *(f32x4*)(orow + 4 * q) = xv + hv * r; } }
            { int* tmp_ = lecur; lecur = lenxt; lenxt = tmp_; }
        }
#undef V6_FETCH
#undef V6_LISTS
#undef V6_ROWS
#undef V6_GROUP
        LDS_WAIT(); asm volatile("" ::: "memory");
    }
    }
}
#ifndef SORT_BITS
#define SORT_BITS 3
#endif
#ifndef PEER_SORT
#define PEER_SORT 1
#endif
typedef int i32x8_t __attribute__((ext_vector_type(8)));
template <bool DEEP> __device__ __forceinline__ void ph_peer_u8p(const Params& p, unsigned char* lds_w, int tb, int te, int gw, int ngw, int lane_) {
    int lane = lane_; asm volatile("" : "+v"(lane));
    const bf16* H = (const bf16*)(p.ws + WS_H); const unsigned char* U8 = (const unsigned char*)(p.ws + WS_U16);
    const int* EXPI = (const int*)(p.ws + WS_EXP); const float* GATE = (const float*)(p.ws + WS_GATE);
    int* e_lds = (int*)lds_w; float* g_lds = (float*)(lds_w + 1024); unsigned char* x8 = lds_w + 512; float* a_lds = (float*)(lds_w + 512);
    const int m = lane & 15, kb = lane >> 4, es = m >> 2, w = 4 * kb + (m & 3);
    if (DEEP) __builtin_amdgcn_s_setprio(3);
#pragma unroll 1
    for (int t = tb + gw, k_ = 0; t < te; t += ngw, ++k_) {
        int e0 = EXPI[(size_t)t * 128 + lane], e1 = EXPI[(size_t)t * 128 + 64 + lane];
        float g0 = GATE[(size_t)t * 128 + lane], g1 = GATE[(size_t)t * 128 + 64 + lane];
        u32x4 xr_[4];
        { const u32x4* xp_ = (const u32x4*)(H + (size_t)t * 1024 + 32 * (lane & 31));
#pragma unroll
          for (int q = 0; q < 4; ++q) xr_[q] = xp_[q]; }
#if PEER_SORT
        {
            const int flip_ = (k_ & 1) ? ((1 << SORT_BITS) - 1) : 0;
            const int d0 = (e0 >> (14 - SORT_BITS)) ^ flip_, d1 = (e1 >> (14 - SORT_BITS)) ^ flip_; int pos0 = 0, pos1 = 0, run = 0;
#pragma unroll
            for (int d = 0; d < (1 << SORT_BITS); ++d) {
                const unsigned long long m0 = __ballot(d0 == d), m1 = __ballot(d1 == d);
                const int c0 = __popcll(m0), c1 = __popcll(m1);
                const int r0 = (int)__builtin_amdgcn_mbcnt_hi((unsigned)(m0 >> 32), __builtin_amdgcn_mbcnt_lo((unsigned)m0, 0u));
                const int r1 = (int)__builtin_amdgcn_mbcnt_hi((unsigned)(m1 >> 32), __builtin_amdgcn_mbcnt_lo((unsigned)m1, 0u));
                pos0 = (d0 == d) ? run + r0 : pos0; pos1 = (d1 == d) ? run + c0 + r1 : pos1; run += c0 + c1;
            }
            e_lds[pos0] = e0; e_lds[pos1] = e1; g_lds[pos0] = g0; g_lds[pos1] = g1;
            LDS_WAIT(); asm volatile("" ::: "memory");
            e0 = e_lds[lane]; e1 = e_lds[64 + lane]; g0 = g_lds[lane]; g1 = g_lds[64 + lane];
            int* EW = (int*)(p.ws + WS_EXP) + (size_t)t * 128; EW[lane] = e0; EW[64 + lane] = e1;
        }
#else
        e_lds[lane] = e0; e_lds[64 + lane] = e1;
#endif
        asm volatile("" ::: "memory");
        float isx_;
        {   float xv[32];
#pragma unroll
            for (int q = 0; q < 4; ++q) { xv[8 * q] = bflo(xr_[q].x); xv[8 * q + 1] = bfhi(xr_[q].x); xv[8 * q + 2] = bflo(xr_[q].y); xv[8 * q + 3] = bfhi(xr_[q].y);
                xv[8 * q + 4] = bflo(xr_[q].z); xv[8 * q + 5] = bfhi(xr_[q].z); xv[8 * q + 6] = bflo(xr_[q].w); xv[8 * q + 7] = bfhi(xr_[q].w); }
            float mx = 0.f;
#pragma unroll
            for (int q = 0; q < 32; ++q) mx = fmaxf(mx, fabsf(xv[q]));
#pragma unroll
            for (int o = 1; o < 32; o <<= 1) mx = fmaxf(mx, __shfl_xor(mx, o));
            const unsigned mb_ = __float_as_uint(mx); const int kx_ = (int)(mb_ >> 23) - 127; const float mant_ = __uint_as_float((mb_ & 0x7fffffu) | 0x3f800000u);
            int E_ = (mant_ <= 1.875f) ? 2 - kx_ : 1 - kx_; E_ = (mx > 0.f) ? E_ : 0; E_ = E_ > 100 ? 100 : (E_ < -100 ? -100 : E_);
            const float s_ = __uint_as_float((unsigned)(E_ + 127) << 23); isx_ = __uint_as_float((unsigned)(127 - E_) << 23);
            f32x16 ea, eb;
#pragma unroll
            for (int q = 0; q < 16; ++q) { ea[q] = xv[2 * q] * s_; eb[q] = xv[2 * q + 1] * s_; }
            const u32x6_t q6 = __builtin_amdgcn_cvt_scalef32_2xpk16_fp6_f32(ea, eb, 1.0f);
            u32x2 s0, s1, s2; s0.x = q6[0]; s0.y = q6[1]; s1.x = q6[2]; s1.y = q6[3]; s2.x = q6[4]; s2.y = q6[5];
            if (lane < 32) { unsigned char* d_ = x8 + 16 * (lane >> 1);
                if ((lane & 1) == 0) { u32x4 w4; w4.x = s0.x; w4.y = s0.y; w4.z = s1.x; w4.w = s1.y; *(u32x4*)d_ = w4; *(u32x2*)(d_ + 256) = s2; }
                else { *(u32x2*)(d_ + 256 + 8) = s0; u32x4 w4; w4.x = s1.x; w4.y = s1.y; w4.z = s2.x; w4.w = s2.y; *(u32x4*)(d_ + 512) = w4; } } }
        LDS_WAIT(); asm volatile("" ::: "memory");
        i32x8_t b0_, b1_;
        {   const unsigned char* xb_ = x8 + 16 * (4 * kb + (m & 3)); const u32x4 q0 = *(const u32x4*)xb_, q1 = *(const u32x4*)(xb_ + 256), q2 = *(const u32x4*)(xb_ + 512);
            b0_ = i32x8_t{(int)q0.x, (int)q0.y, (int)q0.z, (int)q0.w, (int)q1.x, (int)q1.y, 0, 0}; b1_ = i32x8_t{(int)q1.z, (int)q1.w, (int)q2.x, (int)q2.y, (int)q2.z, (int)q2.w, 0, 0}; }
        LDS_WAIT(); asm volatile("" ::: "memory");
        constexpr int UD = DEEP ? 3 : 8;
        u32x4 R0[UD], R1[UD], R2[UD];
#define P8M_LOAD(S) do { const unsigned char* r_ = U8 + (__umul24((unsigned)e_lds[4 * (S) + es], 768u) + 16u * (unsigned)w);                                                          \
        R0[(S) % UD] = *(const u32x4*)r_; R1[(S) % UD] = *(const u32x4*)(r_ + 256); R2[(S) % UD] = *(const u32x4*)(r_ + 512); } while (0)
#define P8M_MFMA(S) do { const i32x8_t a0_ = {(int)R0[(S) % UD].x, (int)R0[(S) % UD].y, (int)R0[(S) % UD].z, (int)R0[(S) % UD].w, (int)R1[(S) % UD].x, (int)R1[(S) % UD].y, 0, 0};             \
        const i32x8_t a1_ = {(int)R1[(S) % UD].z, (int)R1[(S) % UD].w, (int)R2[(S) % UD].x, (int)R2[(S) % UD].y, (int)R2[(S) % UD].z, (int)R2[(S) % UD].w, 0, 0};                              \
        f32x4 acc = {0.f, 0.f, 0.f, 0.f};                                                                                                                                          \
        acc = __builtin_amdgcn_mfma_scale_f32_16x16x128_f8f6f4(a0_, b0_, acc, 2, 2, 0, 0x7F7F7F7F, 0, 0x7F7F7F7F);                                                                  \
        acc = __builtin_amdgcn_mfma_scale_f32_16x16x128_f8f6f4(a1_, b1_, acc, 2, 2, 0, 0x7F7F7F7F, 0, 0x7F7F7F7F);                                                                  \
        asm volatile("" : "+v"(acc));                                                                         \
        float v_ = (m & 2) ? ((m & 1) ? acc[3] : acc[2]) : ((m & 1) ? acc[1] : acc[0]);        \
        v_ += __shfl_xor(v_, 1); v_ += __shfl_xor(v_, 2);                                                                                                                          \
        if (m == 0) a_lds[4 * (S) + kb] = v_; } while (0)
#pragma unroll
        for (int S = 0; S < UD - 1; ++S) P8M_LOAD(S);
#pragma unroll
        for (int S = 0; S < 32; ++S) { if (S + UD - 1 < 32) P8M_LOAD(S + UD - 1); P8M_MFMA(S); }
#undef P8M_LOAD
#undef P8M_MFMA
        LDS_WAIT(); asm volatile("" ::: "memory");
        const float* VS = (const float*)(p.ws + WS_VS);
        const float* US = (const float*)(p.ws + WS_US);
        const float c0 = gelu_erf(a_lds[lane] * (US[e0] * isx_)) * g0 * VS[e0], c1 = gelu_erf(a_lds[64 + lane] * (US[e1] * isx_)) * g1 * VS[e1];
        float* CB = (float*)(p.ws + WS_CBUF) + (size_t)t * 128; CB[lane] = c0; CB[64 + lane] = c1;
        asm volatile("" ::: "memory");
    }
    if (DEEP) __builtin_amdgcn_s_setprio(0);
}
#define XB_TMO      128
#define XB_XCNT(j)  (256  + 64 * (j))
#define XB_XSUB(j)  (1280 + 64 * (j))
#define XB_XGEN(j)  (2304 + 64 * (j))
#define XB_TOP      3328
#define XB_TOPGEN   3392
#define XCD_BAR_WORDS 3456
#define XB_SPIN_CAP (1u << 18)

__device__ __forceinline__ unsigned xb_ld(unsigned* p)              { return __hip_atomic_load(p, __ATOMIC_RELAXED, __HIP_MEMORY_SCOPE_AGENT); }
__device__ __forceinline__ unsigned xb_add(unsigned* p, unsigned v) { return __hip_atomic_fetch_add(p, v, __ATOMIC_RELAXED, __HIP_MEMORY_SCOPE_AGENT); }
__device__ __forceinline__ unsigned xb_xcc_id() { return (unsigned)__builtin_amdgcn_s_getreg((3 << 11) | 20) & 0xFu; }
#define XB_SPIN(cond, bar) do { unsigned _sp = 0; while (cond) { __builtin_amdgcn_s_sleep(1); \
    if ((++_sp & 255u) == 0u) { if (xb_ld(&(bar)[XB_TMO])) break; if (_sp > XB_SPIN_CAP) { atomicAdd(&(bar)[XB_TMO], 1u); break; } } } } while (0)

struct XcdBarrier {
    unsigned* bar; unsigned x;
    volatile LAS unsigned* st;
};

__device__ __forceinline__ XcdBarrier xcd_barrier_post(unsigned* bar, volatile LAS unsigned* st) {
    XcdBarrier b; b.bar = bar; b.x = xb_xcc_id(); b.st = st;
    if (threadIdx.x == 0) (void)xb_add(&bar[XB_XCNT(b.x)], 1u);
    return b;
}
__device__ __forceinline__ void xcd_barrier_complete(unsigned* bar, unsigned x, unsigned& nloc, unsigned& nx) {
    const unsigned G = gridDim.x * gridDim.y * gridDim.z;
    unsigned sum, cnt, mine, sp = 0u;
    for (;;) {
        sum = 0u; cnt = 0u; mine = 0u;
#pragma unroll
        for (unsigned j = 0; j < 16; ++j) { const unsigned c = xb_ld(&bar[XB_XCNT(j)]); sum += c; cnt += (c > 0u) ? 1u : 0u; mine = (j == x) ? c : mine; }
        if (sum == G) break;
        __builtin_amdgcn_s_sleep(1);
        if ((++sp & 255u) == 0u) { if (xb_ld(&bar[XB_TMO])) break; if (sp > XB_SPIN_CAP) { atomicAdd(&bar[XB_TMO], 1u); break; } }
    }
    nloc = mine > 0u ? mine : 1u; nx = cnt > 0u ? cnt : 1u;
}

__device__ __forceinline__ void xcd_barrier(const XcdBarrier& b) {
    asm volatile("s_waitcnt vmcnt(0)" ::: "memory");
    __syncthreads();
    if (threadIdx.x == 0) {
        unsigned* bar = b.bar;
        __builtin_amdgcn_s_waitcnt(0);
        unsigned nloc = b.st[0], nx = b.st[1];
        if (nloc == 0u) { xcd_barrier_complete(bar, b.x, nloc, nx); b.st[0] = nloc; b.st[1] = nx; }
        const unsigned old = xb_add(&bar[XB_XSUB(b.x)], 1u);
        const unsigned gen = old / nloc;
        if (old + 1u == (gen + 1u) * nloc) {
            __builtin_amdgcn_fence(__ATOMIC_RELEASE, "agent");
            asm volatile("s_waitcnt vmcnt(0)" ::: "memory");
            const unsigned og = xb_add(&bar[XB_TOP], 1u);
            const unsigned tg = og / nx;
            if (og + 1u == (tg + 1u) * nx) xb_add(&bar[XB_TOPGEN], 1u);
            else XB_SPIN(xb_ld(&bar[XB_TOPGEN]) == tg, bar);
            __builtin_amdgcn_fence(__ATOMIC_ACQUIRE, "agent");
            xb_add(&bar[XB_XGEN(b.x)], 1u);
            asm volatile("s_waitcnt vmcnt(0)" ::: "memory");
        } else {
            XB_SPIN(xb_ld(&bar[XB_XGEN(b.x)]) == gen, bar);
            __builtin_amdgcn_fence(__ATOMIC_ACQUIRE, "agent");
            asm volatile("s_waitcnt vmcnt(0)" ::: "memory");
        }
    }
    __syncthreads();
}

#ifndef V8_LPR
#define V8_LPR 32
#endif
constexpr int LDS_BYTES = 147456;
extern __shared__ __attribute__((aligned(16))) unsigned char dyn_lds[];

__global__ void __launch_bounds__(NT, 2) mega_fwd(Params p) {
    cg::grid_group grid = cg::this_grid();
    const int vb = blockIdx.x, nvb = gridDim.x, ngw = nvb * NWV;
    volatile LAS unsigned* xst = (volatile LAS unsigned*)((LAS unsigned char*)dyn_lds + (LDS_BYTES - 16));
    if (threadIdx.x < 4) xst[threadIdx.x] = 0u;
    __syncthreads();
    const XcdBarrier xbar = xcd_barrier_post((unsigned*)(p.ws + WS_CTL), xst);
#define TID_LAUNDER int tid_ = threadIdx.x; asm volatile("" : "+v"(tid_)); const int lane = tid_ & 63, wv = tid_ >> 6, gw = vb * NWV + wv; (void)lane; (void)gw;
    grid.sync();
    ph_mod(p, (float*)dyn_lds, vb, nvb);
    {   TID_LAUNDER
        if (nvb < 192) ph_prep_weights<0>(p, (LAS float*)dyn_lds + wv * (64 * 33), gw, ngw, lane);
        else if (vb >= 96) ph_prep_weights<0>(p, (LAS float*)dyn_lds + wv * (64 * 33), (vb - 96) * NWV + wv, (nvb - 96) * NWV, lane); }
    xcd_barrier(xbar);
    { TID_LAUNDER ph_hrows(p, p.x, p.norm1_g, 0, 1024, gw, ngw, lane); ph_prep_weights<1>(p, (LAS float*)dyn_lds + wv * (64 * 33), gw, ngw, lane); }
    xcd_barrier(xbar);
    {   pg8::Gemm g{(const bf16*)(p.ws + WS_H), (const bf16*)(p.ws + WS_WIN), T, NP, 1024}; pg8::StaticOrder S; S.init(T, NP, nvb, vb);
        EpiNormBf16 E{(bf16*)(p.ws + WS_PROJ), p.a_qk_gain, p.b_q_gain, p.b_kv_gain, (LAS float*)((LAS unsigned char*)dyn_lds + 131072), (bf16*)(p.ws + WS_KVC)};
        pg8::gemm_phase<EpiNormBf16, pg8::StaticOrder, true, true>((LAS unsigned char*)dyn_lds, g, S, E); }
    xcd_barrier(xbar);
    { TID_LAUNDER ph_q3bias(p, gw, lane); }
    ph_attnA(p, dyn_lds, vb, nvb);
    __syncthreads();
    ph_dsa(p, dyn_lds, vb, nvb);
    xcd_barrier(xbar);
    {   pg8::Gemm g{(const bf16*)(p.ws + WS_MIX), (const bf16*)(p.ws + WS_WO2), T, 1024, MIXW}; pg8::StaticOrder S; S.init(T, 1024, nvb, vb);
        EpiResGateA2 E{p.x, p.out, (const float*)(p.ws + WS_MOD), p.norm2_g, (bf16*)(p.ws + WS_H), (float*)(p.ws + WS_SSQ)};
        pg8::gemm_phase<EpiResGateA2, pg8::StaticOrder, true, true>((LAS unsigned char*)dyn_lds, g, S, E); }
    xcd_barrier(xbar);
    {   pg8::Gemm g{(const bf16*)(p.ws + WS_H), (const bf16*)(p.ws + WS_WQ), T, 1024, 1024}; pg8::StaticOrder S; S.init(T, 1024, nvb, vb);
        EpiQ3 E{(const float*)(p.ws + WS_SSQ), (const float*)(p.ws + WS_QBIAS), (bf16*)(p.ws + WS_Q3)};
        pg8::gemm_phase<EpiQ3, pg8::StaticOrder, true, true>((LAS unsigned char*)dyn_lds, g, S, E); }
    xcd_barrier(xbar);
    ph_route_subk(p, dyn_lds);
    {
        const int ngroups = T / 32;
        int gprev = -1;
#pragma unroll 1
        for (int gcur = vb;; gcur += nvb) {
            TID_LAUNDER
            const bool have = gcur < ngroups;
            if (gprev < 0) { if (have) ph_route(p, dyn_lds, gcur * 8, gcur * 8 + 8, wv, 8); }
            else if (!have) ph_peer_u8p<false>(p, dyn_lds + 131072 + wv * 2048, gprev * 32, gprev * 32 + 32, wv, 8, lane);
            else if (wv < 4) ph_route(p, dyn_lds, gcur * 8, gcur * 8 + 8, wv, 4);
            else ph_peer_u8p<true>(p, dyn_lds + 131072 + wv * 2048, gprev * 32, gprev * 32 + 32, wv - 4, 4, lane);
            __syncthreads();
            if (!have) break;
            gprev = gcur;
        }
    }
    xcd_barrier(xbar);
    ph_peer_v6(p, dyn_lds);

}

extern "C" void kernel_launch(void* const* d_in, const int* in_sizes, int n_in, void* d_out, int out_size, void* d_ws, size_t ws_size, hipStream_t stream) {
    static int grid_blocks = 0;
    if (grid_blocks == 0) {
        if (n_in != 18 || in_sizes[0] != T * DM || out_size != T * DM || ws_size < WS_END) { fprintf(stderr, "kernel_launch: unexpected shapes n_in %d in0 %d out %d ws %zu\n", n_in, n_in > 0 ? in_sizes[0] : -1, out_size, ws_size); grid_blocks = -1; return; }
        int dev = 0, cus = 0, per_cu = 0;
        (void)hipGetDevice(&dev);
        (void)hipDeviceGetAttribute(&cus, hipDeviceAttributeMultiprocessorCount, dev);
        (void)hipFuncSetAttribute((const void*)mega_fwd, hipFuncAttributeMaxDynamicSharedMemorySize, LDS_BYTES);
        (void)hipOccupancyMaxActiveBlocksPerMultiprocessor(&per_cu, (const void*)mega_fwd, NT, LDS_BYTES);
        if (per_cu < 1 || cus < 1) { fprintf(stderr, "kernel_launch: occupancy query gave %d blocks/CU on %d CUs\n", per_cu, cus); grid_blocks = -1; return; }
        grid_blocks = cus;
    }
    if (grid_blocks < 0) return;
    Params p{};
    const float** pp = (const float**)&p;
    for (int i = 0; i < 18; ++i) pp[i] = (const float*)d_in[i];
    p.out = (float*)d_out; p.ws = (unsigned char*)d_ws;
    if (hipMemsetAsync((char*)d_ws + WS_CTL, 0, CTL_BYTES, stream) != hipSuccess) { fprintf(stderr, "kernel_launch: memset failed\n"); return; }
    void* args[] = {&p};
    const hipError_t e = hipLaunchCooperativeKernel((const void*)mega_fwd, dim3(grid_blocks), dim3(NT), args, LDS_BYTES, stream);
    if (e != hipSuccess) fprintf(stderr, "kernel_launch: cooperative launch failed: %s (grid %d)\n", hipGetErrorString(e), grid_blocks);
}
```
